# Optimizing an MI355X kernel written in HIP

```python
import jax
import jax.numpy as jnp
from jax import lax
import numpy as np

D_MODEL = 1024
BATCH = 2
SEQ = 16384
DEPTH = 2

GRID_W = 64
CTX_LEN = 256

HEAD_DIM = 64
NA_WIDTH = D_MODEL // 2
NA_HEADS = NA_WIDTH // HEAD_DIM
NA_DH = HEAD_DIM
NA_KH = 8
NA_KW = 16
RW_WIDTH = D_MODEL // 4
RW_HEADS = RW_WIDTH // HEAD_DIM
RW_DH = HEAD_DIM
RW_DECAY_LORA = 32
RW_AAA_LORA = 32
RW_GATE_LORA = 64
RW_GN_EPS = 64e-5
RW_PROJ = 3 * RW_WIDTH + 2 * RW_DECAY_LORA + 2 * RW_AAA_LORA + RW_GATE_LORA
ML_WIDTH = D_MODEL // 4
ML_HEADS = ML_WIDTH // HEAD_DIM
ML_DQK = HEAD_DIM
ML_DV = HEAD_DIM
ML_QK_WIDTH = ML_HEADS * ML_DQK
ML_CONV = 3
ML_CHUNK = 64
ML_NORM_EPS = 1e-6
ML_PROJ = 2 * ML_QK_WIDTH + 2 * ML_WIDTH + 4 * ML_HEADS

MIX_WIDTH = NA_WIDTH + RW_WIDTH + ML_WIDTH
IN_PROJ = 3 * NA_WIDTH + RW_PROJ + ML_PROJ
ROPE_BASE = 10000.0
LN_EPS = 1e-5
N_GROUPS = 4
EXPERTS_PER_GROUP = 8
N_EXPERTS = N_GROUPS * EXPERTS_PER_GROUP
TOP_K = 2
D_EXPERT = D_MODEL // 2
MOE_BLOCK = 256

kernel_name = 'hybrid_natten_rwkv7_mlstm_hmoe'


def layer_norm(x, g, b):
    xf = x.astype(jnp.float32)
    mu = jnp.mean(xf, -1, keepdims=True)
    var = jnp.mean(jnp.square(xf - mu), -1, keepdims=True)
    return ((xf - mu) * lax.rsqrt(var + LN_EPS)).astype(x.dtype) * g + b


def head_norm(y, eps):
    yf = y.astype(jnp.float32)
    mu = jnp.mean(yf, -1, keepdims=True)
    var = jnp.mean(jnp.square(yf - mu), -1, keepdims=True)
    yn = (yf - mu) * lax.rsqrt(var + eps)
    return yn.reshape(*y.shape[:-2], -1)


def split_heads(t, n_heads):
    return t.reshape(*t.shape[:-1], n_heads, t.shape[-1] // n_heads)


def centred_shift_mix(p, mu_prev, mu_next):
    z = jnp.zeros_like(p[:, :1])
    prev = jnp.concatenate([z, p[:, :-1]], axis=1)
    nxt = jnp.concatenate([p[:, 1:], z], axis=1)
    return p + mu_prev * (prev - p) + mu_next * (nxt - p)


def centred_dwconv(p, w, b):
    pad = w.shape[0] // 2
    out = lax.conv_general_dilated(p, w[:, None, :].astype(p.dtype), window_strides=(1,), padding=[(pad, pad)],
                                   dimension_numbers=('NWC', 'WIO', 'NWC'), feature_group_count=p.shape[-1])
    return out + b


def axial_rope(t):
    n_tok, d = t.shape[1], t.shape[-1]
    half = d // 2
    nf = half // 2
    inv_freq = ROPE_BASE ** (-jnp.arange(nf, dtype=jnp.float32) / nf)
    pos = jnp.arange(n_tok, dtype=jnp.int32)

    def rotate(u, p):
        ang = p.astype(jnp.float32)[:, None] * inv_freq[None, :]
        cos = jnp.cos(ang)[None, :, None, :].astype(u.dtype)
        sin = jnp.sin(ang)[None, :, None, :].astype(u.dtype)
        u1, u2 = u[..., :nf], u[..., nf:]
        return jnp.concatenate([u1 * cos - u2 * sin, u1 * sin + u2 * cos], axis=-1)

    return jnp.concatenate([rotate(t[..., :half], pos // GRID_W), rotate(t[..., half:], pos % GRID_W)], axis=-1)


def neighbourhood_attention(q, k, v, k_ctx, v_ctx, rpb):
    B, n_tok, H, dh = q.shape
    rows = n_tok // GRID_W
    kh, kw = min(NA_KH, rows), NA_KW
    scale = dh ** -0.5
    qg = q.reshape(B, rows, GRID_W, H, dh)
    kg = k.reshape(B, rows, GRID_W, H, dh)
    vg = v.reshape(B, rows, GRID_W, H, dh)
    col = np.arange(GRID_W, dtype=np.int32)
    col_start = np.clip(col - kw // 2, 0, GRID_W - kw).astype(np.int32)
    col_idx = (col_start[:, None] + np.arange(kw, dtype=np.int32)[None, :]).astype(np.int32)
    bias_c = rpb[:, :, (col_idx - col[:, None] + (NA_KW - 1)).astype(np.int32)]

    def one_row(r):
        rs = jnp.clip(r - kh // 2, 0, rows - kh)
        q_r = lax.dynamic_index_in_dim(qg, r, axis=1, keepdims=False)
        k_w = lax.dynamic_slice_in_dim(kg, rs, kh, axis=1)[:, :, col_idx]
        v_w = lax.dynamic_slice_in_dim(vg, rs, kh, axis=1)[:, :, col_idx]
        bias = jnp.take(bias_c, rs + jnp.arange(kh, dtype=jnp.int32) - r + (NA_KH - 1), axis=1)
        s_loc = (jnp.einsum('bqhd,brqchd->bhqrc', q_r, k_w).astype(jnp.float32) * scale
                 + jnp.transpose(bias, (0, 2, 1, 3)).astype(jnp.float32)[None])
        s_ctx = jnp.einsum('bqhd,bkhd->bhqk', q_r, k_ctx).astype(jnp.float32) * scale
        s = jnp.concatenate([s_loc.reshape(B, H, GRID_W, kh * kw), s_ctx], axis=-1)
        p = jax.nn.softmax(s, axis=-1).astype(v.dtype)
        p_loc = p[..., :kh * kw].reshape(B, H, GRID_W, kh, kw)
        return (jnp.einsum('bhqrc,brqchd->bqhd', p_loc, v_w)
                + jnp.einsum('bhqk,bkhd->bqhd', p[..., kh * kw:], v_ctx))

    out = lax.map(one_row, jnp.arange(rows, dtype=jnp.int32))
    return jnp.moveaxis(out, 0, 1).reshape(B, n_tok, H * dh)


def context_attention(q, k, v):
    s = jnp.einsum('bqhd,bkhd->bhqk', q, k).astype(jnp.float32) * (q.shape[-1] ** -0.5)
    p = jax.nn.softmax(s, axis=-1).astype(v.dtype)
    out = jnp.einsum('bhqk,bkhd->bqhd', p, v)
    return out.reshape(*out.shape[:2], -1)


def na_mixer(pa_c, pa_l, rpb, need_ctx):
    q_c, k_c, v_c = [split_heads(t, NA_HEADS) for t in jnp.split(pa_c, 3, axis=-1)]
    q_l, k_l, v_l = [split_heads(t, NA_HEADS) for t in jnp.split(pa_l, 3, axis=-1)]
    y_l = neighbourhood_attention(q_l, k_l, v_l, k_c, v_c, rpb)
    y_c = context_attention(q_c, k_c, v_c) if need_ctx else None
    return y_c, y_l


def rwkv7_scan(r, w, k, v, a, b, S0, emit):
    xs = tuple(jnp.moveaxis(t.astype(jnp.float32), 1, 0) for t in (r, w, k, v, a, b))

    def step(S, inp):
        r_t, w_t, k_t, v_t, a_t, b_t = inp
        sa = jnp.einsum('bhvk,bhk->bhv', S, a_t)
        S = S * w_t[:, :, None, :] + sa[..., None] * b_t[:, :, None, :] + v_t[..., None] * k_t[:, :, None, :]
        return S, (jnp.einsum('bhvk,bhk->bhv', S, r_t) if emit else None)

    S, ys = lax.scan(step, S0, xs)
    return (jnp.moveaxis(ys, 0, 1) if emit else None), S


def _rwkv_features(pb, w0, w2, a0, a2, k_k, k_a):
    B, L, _ = pb.shape
    cuts = np.cumsum([RW_WIDTH, RW_WIDTH, RW_WIDTH, 2 * RW_DECAY_LORA, 2 * RW_AAA_LORA]).tolist()
    r, k, v, wd, ad, gd = jnp.split(pb.astype(jnp.float32), cuts, axis=-1)
    wd = jnp.tanh(wd.reshape(B, L, 2, RW_DECAY_LORA))
    ad = ad.reshape(B, L, 2, RW_AAA_LORA)
    log_w = -jax.nn.softplus(-(w0 + jnp.einsum('blzr,zrc->blzc', wd, w2))) - 0.5
    decay = jnp.exp(-jnp.exp(log_w))
    a = jax.nn.sigmoid(a0 + jnp.einsum('blzr,zrc->blzc', ad, a2))
    kk = split_heads(k * k_k, RW_HEADS)
    kk = kk / jnp.maximum(jnp.sqrt(jnp.sum(jnp.square(kk), -1, keepdims=True)), 1e-12)
    k_dir = k[:, :, None] * (1.0 + (a - 1.0) * k_a)
    b_dir = kk.reshape(B, L, 1, RW_WIDTH) * a
    hz = lambda t: split_heads(t, RW_HEADS)
    return hz(r), hz(k), hz(v), kk, gd, hz(decay), hz(k_dir), hz(b_dir)


def _rwkv_direction(f, d, S0, emit):
    r, k, v, kk, gd, decay, k_dir, b_dir = f
    seq = (r, decay[:, :, d], k_dir[:, :, d], v, -kk, b_dir[:, :, d])
    if d == 1:
        seq = tuple(jnp.flip(t, 1) for t in seq)
    y, S = rwkv7_scan(*seq, S0, emit)
    if emit and d == 1:
        y = jnp.flip(y, 1)
    return y, S


def _rwkv_output(y, f, g2, r_k, ln_w, ln_b, dtype):
    r, k, v, kk, gd = f[:5]
    bonus = jnp.sum(r * k * split_heads(r_k, RW_HEADS), -1, keepdims=True) * v
    out = head_norm(y, RW_GN_EPS) * ln_w + ln_b + bonus.reshape(*bonus.shape[:2], RW_WIDTH)
    gate = jnp.dot(jax.nn.sigmoid(gd), g2)
    return (out * gate).astype(dtype)


def rwkv7_mixer(pb_c, pb_l, mu_prev, mu_next, w0, w2, a0, a2, g2, k_k, k_a, r_k, ln_w, ln_b, need_ctx):
    f_c = _rwkv_features(centred_shift_mix(pb_c, mu_prev, mu_next), w0, w2, a0, a2, k_k, k_a)
    f_l = _rwkv_features(centred_shift_mix(pb_l, mu_prev, mu_next), w0, w2, a0, a2, k_k, k_a)
    S0 = jnp.zeros((pb_c.shape[0], RW_HEADS, RW_DH, RW_DH), jnp.float32)
    ys_c, ys_l = [], []
    for d in range(2):
        y_cd, S_ctx = _rwkv_direction(f_c, d, S0, need_ctx)
        y_ld, _ = _rwkv_direction(f_l, d, S_ctx, True)
        ys_c.append(y_cd)
        ys_l.append(y_ld)
    y_l = _rwkv_output(ys_l[0] + ys_l[1], f_l, g2, r_k, ln_w, ln_b, pb_l.dtype)
    y_c = _rwkv_output(ys_c[0] + ys_c[1], f_c, g2, r_k, ln_w, ln_b, pb_c.dtype) if need_ctx else None
    return y_c, y_l


def mlstm_chunk_scan(q, k, v, log_f, log_i, state, emit):
    B, H, L, _ = q.shape
    nc = L // ML_CHUNK

    def chunks(t):
        return jnp.moveaxis(t.reshape(B, H, nc, ML_CHUNK, *t.shape[3:]), 2, 0)

    causal = jnp.tril(jnp.ones((ML_CHUNK, ML_CHUNK), dtype=bool))

    def step(carry, inp):
        C, n, m = carry
        qc, kc, vc, lf, li = inp
        b = jnp.cumsum(lf, axis=-1)
        m_inter = b + m[..., None]
        g_last = b[..., -1:] - b + li
        m_last = jnp.maximum(m_inter[..., -1], jnp.max(g_last, -1))
        ws = jnp.exp(g_last - m_last[..., None])
        carry_decay = jnp.exp(m_inter[..., -1] - m_last)
        C_new = carry_decay[..., None, None] * C + jnp.einsum('bhs,bhsd,bhsv->bhdv', ws, kc, vc)
        n_new = carry_decay[..., None] * n + jnp.einsum('bhs,bhsd->bhd', ws, kc)
        if not emit:
            return (C_new, n_new, m_last), None
        log_d = jnp.where(causal, b[..., :, None] - b[..., None, :] + li[..., None, :], -jnp.inf)
        m_t = jnp.maximum(m_inter, jnp.max(log_d, -1))
        dw = jnp.exp(log_d - m_t[..., None]) * jnp.einsum('bhtd,bhsd->bhts', qc, kc)
        inter = jnp.exp(m_inter - m_t)
        num = jnp.einsum('bhts,bhsv->bhtv', dw, vc) + inter[..., None] * jnp.einsum('bhtd,bhdv->bhtv', qc, C)
        den = jnp.sum(dw, -1) + inter * jnp.einsum('bhtd,bhd->bht', qc, n)
        h = num / jnp.maximum(jnp.abs(den), jnp.exp(-m_t))[..., None]
        return (C_new, n_new, m_last), h

    state, hs = lax.scan(step, state, tuple(chunks(t) for t in (q, k, v, log_f, log_i)))
    if emit:
        hs = jnp.moveaxis(hs, 0, 2).reshape(B, H, L, -1)
    return hs, state


def _mlstm_prep(pc, conv_w, conv_b, i_bias, f_bias, use_rope):
    B, L, _ = pc.shape
    qk, v, o, gates = jnp.split(pc, [2 * ML_QK_WIDTH, 2 * ML_QK_WIDTH + ML_WIDTH, 2 * ML_QK_WIDTH + 2 * ML_WIDTH], axis=-1)
    qk = jax.nn.silu(centred_dwconv(qk, conv_w, conv_b)).astype(jnp.float32)
    q, k = jnp.split(qk, 2, axis=-1)
    q, k = split_heads(q, ML_HEADS), split_heads(k, ML_HEADS)
    if use_rope:
        q, k = axial_rope(q), axial_rope(k)
    k = k * (ML_DQK ** -0.5)
    v = split_heads(v.astype(jnp.float32), ML_HEADS)
    g = gates.astype(jnp.float32).reshape(B, L, 2, 2, ML_HEADS)
    log_i = jnp.transpose(g[:, :, 0] + i_bias, (2, 0, 3, 1))
    log_f = jnp.transpose(jax.nn.log_sigmoid(g[:, :, 1] + f_bias), (2, 0, 3, 1))
    to_bhl = lambda t: jnp.moveaxis(t, 1, 2)
    return to_bhl(q), to_bhl(k), to_bhl(v), o, log_i, log_f


def _mlstm_direction(prep, d, state, emit):
    q, k, v, _, log_i, log_f = prep
    seq = (q, k, v, log_f[d], log_i[d])
    if d == 1:
        seq = tuple(jnp.flip(t, 2) for t in seq)
    h, st = mlstm_chunk_scan(*seq, state, emit)
    if emit and d == 1:
        h = jnp.flip(h, 2)
    return h, st


def _mlstm_output(h, o, norm_w, dtype):
    y = head_norm(jnp.moveaxis(h, 1, 2), ML_NORM_EPS) * norm_w
    return (y * jax.nn.sigmoid(o.astype(jnp.float32))).astype(dtype)


def mlstm_mixer(pc_c, pc_l, conv_w, conv_b, i_bias, f_bias, norm_w, need_ctx):
    prep_c = _mlstm_prep(pc_c, conv_w, conv_b, i_bias, f_bias, False)
    prep_l = _mlstm_prep(pc_l, conv_w, conv_b, i_bias, f_bias, True)
    B = pc_c.shape[0]
    state0 = (jnp.zeros((B, ML_HEADS, ML_DQK, ML_DV), jnp.float32),
              jnp.zeros((B, ML_HEADS, ML_DQK), jnp.float32),
              jnp.zeros((B, ML_HEADS), jnp.float32))
    hs_c, hs_l = [], []
    for d in range(2):
        h_cd, st = _mlstm_direction(prep_c, d, state0, need_ctx)
        h_ld, _ = _mlstm_direction(prep_l, d, st, True)
        hs_c.append(h_cd)
        hs_l.append(h_ld)
    y_l = _mlstm_output(hs_l[0] + hs_l[1], prep_l[3], norm_w, pc_l.dtype)
    y_c = _mlstm_output(hs_c[0] + hs_c[1], prep_c[3], norm_w, pc_c.dtype) if need_ctx else None
    return y_c, y_l


def token_mixers(p_ctx, p_lat, rpb, mu_prev, mu_next, w0, w2, a0, a2, g2, k_k, k_a, r_k, rw_ln_w, rw_ln_b,
                 conv_w, conv_b, i_bias, f_bias, ml_norm_w, need_ctx):
    cuts = [3 * NA_WIDTH, 3 * NA_WIDTH + RW_PROJ]
    pa_c, pb_c, pc_c = jnp.split(p_ctx, cuts, axis=-1)
    pa_l, pb_l, pc_l = jnp.split(p_lat, cuts, axis=-1)
    ya_c, ya_l = na_mixer(pa_c, pa_l, rpb, need_ctx)
    yb_c, yb_l = rwkv7_mixer(pb_c, pb_l, mu_prev, mu_next, w0, w2, a0, a2, g2, k_k, k_a, r_k, rw_ln_w, rw_ln_b, need_ctx)
    yc_c, yc_l = mlstm_mixer(pc_c, pc_l, conv_w, conv_b, i_bias, f_bias, ml_norm_w, need_ctx)
    y_lat = jnp.concatenate([ya_l, yb_l, yc_l], axis=-1)
    if not need_ctx:
        return None, y_lat
    return jnp.concatenate([ya_c, yb_c, yc_c], axis=-1), y_lat


def routed_experts(h, expert_id, weight, w_gate, w_up, w_down):
    T, D = h.shape
    A = expert_id.shape[0]
    n_exp = w_gate.shape[0]
    tok = jnp.repeat(jnp.arange(T, dtype=jnp.int32), TOP_K)
    order = jnp.argsort(expert_id)
    e_sorted = expert_id[order]
    counts = jnp.bincount(expert_id, length=n_exp)
    starts = jnp.cumsum(counts) - counts
    padded = (counts + MOE_BLOCK - 1) // MOE_BLOCK * MOE_BLOCK
    p_ends = jnp.cumsum(padded)
    dest = (p_ends - padded)[e_sorted] + jnp.arange(A, dtype=jnp.int32) - starts[e_sorted]
    n_blocks = -(-A // MOE_BLOCK) + n_exp
    n_slots = n_blocks * MOE_BLOCK
    slot_tok = jnp.full((n_slots,), T, jnp.int32).at[dest].set(tok[order])
    slot_w = jnp.zeros((n_slots,), h.dtype).at[dest].set(weight[order].astype(h.dtype))
    block_exp = jnp.minimum(jnp.searchsorted(p_ends, jnp.arange(n_blocks, dtype=jnp.int32) * MOE_BLOCK, side='right'), n_exp - 1)
    xb = jnp.concatenate([h, jnp.zeros((1, D), h.dtype)], axis=0)[slot_tok].reshape(n_blocks, MOE_BLOCK, D)

    def expert_block(args):
        xblk, e = args
        return jnp.dot(jax.nn.silu(jnp.dot(xblk, w_gate[e])) * jnp.dot(xblk, w_up[e]), w_down[e])

    yb = lax.map(expert_block, (xb, block_exp)).reshape(n_slots, D) * slot_w[:, None]
    return jax.ops.segment_sum(yb, slot_tok, num_segments=T + 1)[:T]


def hierarchical_moe(h, wg_r, bg_r, we_r, be_r, w_gate, w_up, w_down):
    T = h.shape[0]
    t_idx = jnp.arange(T, dtype=jnp.int32)
    g_logits = jnp.dot(h, wg_r).astype(jnp.float32) + bg_r
    g_sel = jnp.argmax(g_logits, axis=-1)
    g_w = jax.nn.softmax(g_logits, axis=-1)[t_idx, g_sel]
    e_logits = (jnp.dot(h, we_r).astype(jnp.float32) + be_r).reshape(T, N_GROUPS, EXPERTS_PER_GROUP)
    top_v, top_i = lax.top_k(e_logits[t_idx, g_sel], TOP_K)
    weights = jax.nn.softmax(top_v, axis=-1) * g_w[:, None]
    expert_id = (g_sel[:, None] * EXPERTS_PER_GROUP + top_i).reshape(-1).astype(jnp.int32)
    return routed_experts(h, expert_id, weights.reshape(-1), w_gate, w_up, w_down)


def setup_inputs(seed: int = 0) -> dict:
    key = jax.random.key(seed)
    keys = iter(jax.random.split(key, 48))
    D = D_MODEL
    beta = (8.0 * DEPTH) ** -0.25

    def nrm(shape, scale):
        return jax.random.normal(next(keys), shape, jnp.float32) * scale

    def unif(shape, lo, hi):
        return jax.random.uniform(next(keys), shape, jnp.float32, lo, hi)

    gate_offset = jnp.repeat(jnp.array([0.0, 0.0, 1.0, 0.0, 0.0, 1.0], jnp.float32), D)
    decay_base = jnp.linspace(-6.0, -1.0, RW_WIDTH, dtype=jnp.float32)
    fgate_base = jnp.linspace(3.0, 6.0, ML_HEADS, dtype=jnp.float32)
    return {
        'x': nrm((BATCH, SEQ, D), 1.0),
        'c': nrm((BATCH, D), 1.0),
        'ctx': nrm((BATCH, CTX_LEN, D), 1.0),
        'c_ctx': nrm((D,), 1.0),
        'w_mod': nrm((DEPTH, D, 6 * D), 0.3 * D ** -0.5),
        'b_mod': nrm((DEPTH, 6 * D), 0.05) + gate_offset,
        'w_in': nrm((DEPTH, D, IN_PROJ), D ** -0.5),
        'na_rpb': nrm((DEPTH, NA_HEADS, 2 * NA_KH - 1, 2 * NA_KW - 1), 0.1),
        'rw_mu_prev': unif((DEPTH, RW_PROJ), 0.0, 0.5),
        'rw_mu_next': unif((DEPTH, RW_PROJ), 0.0, 0.5),
        'rw_w0': decay_base + nrm((DEPTH, 2, RW_WIDTH), 0.1),
        'rw_w2': nrm((DEPTH, 2, RW_DECAY_LORA, RW_WIDTH), 0.1 * RW_DECAY_LORA ** -0.5),
        'rw_a0': nrm((DEPTH, 2, RW_WIDTH), 0.1),
        'rw_a2': nrm((DEPTH, 2, RW_AAA_LORA, RW_WIDTH), RW_AAA_LORA ** -0.5),
        'rw_g2': nrm((DEPTH, RW_GATE_LORA, RW_WIDTH), RW_GATE_LORA ** -0.5),
        'rw_k_k': 0.85 + nrm((DEPTH, RW_WIDTH), 0.02),
        'rw_k_a': 1.0 + nrm((DEPTH, RW_WIDTH), 0.02),
        'rw_r_k': nrm((DEPTH, RW_WIDTH), 0.1),
        'rw_ln_w': 1.0 + nrm((DEPTH, RW_WIDTH), 0.02),
        'rw_ln_b': nrm((DEPTH, RW_WIDTH), 0.02),
        'ml_conv_w': nrm((DEPTH, ML_CONV, 2 * ML_QK_WIDTH), ML_CONV ** -0.5),
        'ml_conv_b': nrm((DEPTH, 2 * ML_QK_WIDTH), 0.02),
        'ml_i_bias': nrm((DEPTH, 2, ML_HEADS), 0.1),
        'ml_f_bias': fgate_base + nrm((DEPTH, 2, ML_HEADS), 0.1),
        'ml_norm_w': 1.0 + nrm((DEPTH, ML_WIDTH), 0.02),
        'w_out': nrm((DEPTH, MIX_WIDTH, D), beta * MIX_WIDTH ** -0.5),
        'ln1_g': 1.0 + nrm((DEPTH, D), 0.02),
        'ln1_b': nrm((DEPTH, D), 0.02),
        'router_group_w': nrm((DEPTH, D, N_GROUPS), D ** -0.5),
        'router_group_b': nrm((DEPTH, N_GROUPS), 0.01),
        'router_expert_w': nrm((DEPTH, D, N_EXPERTS), D ** -0.5),
        'router_expert_b': nrm((DEPTH, N_EXPERTS), 0.01),
        'exp_w_gate': nrm((DEPTH, N_EXPERTS, D, D_EXPERT), D ** -0.5),
        'exp_w_up': nrm((DEPTH, N_EXPERTS, D, D_EXPERT), D ** -0.5),
        'exp_w_down': nrm((DEPTH, N_EXPERTS, D_EXPERT, D), beta * D_EXPERT ** -0.5),
        'ln2_g': 1.0 + nrm((DEPTH, D), 0.02),
        'ln2_b': nrm((DEPTH, D), 0.02),
    }


def reference(x, c, ctx, c_ctx, w_mod, b_mod, w_in, na_rpb, rw_mu_prev, rw_mu_next, rw_w0, rw_w2, rw_a0, rw_a2,
              rw_g2, rw_k_k, rw_k_a, rw_r_k, rw_ln_w, rw_ln_b, ml_conv_w, ml_conv_b, ml_i_bias, ml_f_bias, ml_norm_w,
              w_out, ln1_g, ln1_b, router_group_w, router_group_b, router_expert_w, router_expert_b,
              exp_w_gate, exp_w_up, exp_w_down, ln2_g, ln2_b):
    B, L, D = x.shape
    Lc = ctx.shape[1]
    alpha = (2.0 * DEPTH) ** 0.25
    for l in range(DEPTH):
        last = l == DEPTH - 1
        mod = jnp.dot(jax.nn.silu(c), w_mod[l]) + b_mod[l]
        sh1, sc1, g1, sh2, sc2, g2 = [m[:, None, :] for m in jnp.split(mod, 6, axis=-1)]
        n_ctx_mod = 2 if last else 6
        mod_c = jnp.split(jnp.dot(jax.nn.silu(c_ctx), w_mod[l][:, :n_ctx_mod * D]) + b_mod[l][:n_ctx_mod * D], n_ctx_mod)
        p_lat = jnp.dot(x * (1 + sc1) + sh1, w_in[l])
        p_ctx = jnp.dot(ctx * (1 + mod_c[1]) + mod_c[0], w_in[l])
        y_ctx, y_lat = token_mixers(p_ctx, p_lat, na_rpb[l], rw_mu_prev[l], rw_mu_next[l], rw_w0[l], rw_w2[l],
                                    rw_a0[l], rw_a2[l], rw_g2[l], rw_k_k[l], rw_k_a[l], rw_r_k[l], rw_ln_w[l],
                                    rw_ln_b[l], ml_conv_w[l], ml_conv_b[l], ml_i_bias[l], ml_f_bias[l],
                                    ml_norm_w[l], not last)
        x = layer_norm(alpha * x + g1 * jnp.dot(y_lat, w_out[l]), ln1_g[l], ln1_b[l])
        h2 = (x * (1 + sc2) + sh2).reshape(B * L, D)
        moe_args = (router_group_w[l], router_group_b[l], router_expert_w[l], router_expert_b[l],
                    exp_w_gate[l], exp_w_up[l], exp_w_down[l])
        if last:
            f = hierarchical_moe(h2, *moe_args)
        else:
            ctx = layer_norm(alpha * ctx + mod_c[2] * jnp.dot(y_ctx, w_out[l]), ln1_g[l], ln1_b[l])
            hc2 = (ctx * (1 + mod_c[4]) + mod_c[3]).reshape(B * Lc, D)
            f_all = hierarchical_moe(jnp.concatenate([hc2, h2], axis=0), *moe_args)
            ctx = layer_norm(alpha * ctx + mod_c[5] * f_all[:B * Lc].reshape(B, Lc, D), ln2_g[l], ln2_b[l])
            f = f_all[B * Lc:]
        x = layer_norm(alpha * x + g2 * f.reshape(B, L, D), ln2_g[l], ln2_b[l])
    return x
```

```cpp
#include <hip/hip_runtime.h>
#include <hip/hip_bf16.h>
#include <stdint.h>
#include <stdio.h>

#define DEVINL __device__ __forceinline__
typedef unsigned short u16;
using bf16x8 = __attribute__((ext_vector_type(8))) short;
using f32x4 = __attribute__((ext_vector_type(4))) float;

constexpr int D = 1024, LAT = 16384, LCTX = 256, T = 33280, CTXROWS = 512;
constexpr int INP = 3536;
constexpr int NLAYER = 2;
constexpr float ALPHA = 1.41421356237309515f;
constexpr int NUNIT_CH = 520;
constexpr int NTC = 260;
constexpr int MAXSLOT = 70656;

constexpr size_t al(size_t x) { return (x + 255) & ~(size_t)255; }
constexpr size_t CTL_CNT = 16384;
constexpr size_t CTL_CUR = CTL_CNT + 256;
constexpr size_t CTL_BYTES = 32768;
constexpr size_t OFF_MOD = CTL_BYTES;
constexpr size_t OFF_ROPE = OFF_MOD + al(2 * 3 * 6144 * 4);
constexpr size_t OFF_WR = OFF_ROPE + al(10240 * 4);
constexpr size_t OFF_TILES = OFF_WR + al(2 * 128 * 1024 * 2);
constexpr size_t OFF_TOKE = OFF_TILES + al((64 + 2048) * 4);
constexpr size_t OFF_TOKW = OFF_TOKE + al((size_t)T * 2 * 4);
constexpr size_t OFF_TOKS = OFF_TOKW + al((size_t)T * 2 * 4);
constexpr size_t OFF_SLOTTOK = OFF_TOKS + al((size_t)T * 2 * 4);
constexpr size_t OFF_X2CTX = OFF_SLOTTOK + al((size_t)MAXSLOT * 4);
constexpr size_t OFF_WIN = OFF_X2CTX + al((size_t)512 * 1024 * 4);
constexpr size_t OFF_WOUT = OFF_WIN + al((size_t)3584 * 1024 * 2);
constexpr size_t OFF_X1 = OFF_WOUT + al((size_t)1024 * 1024 * 2);
constexpr size_t OFF_HM = OFF_X1 + al((size_t)T * 1024 * 4);
constexpr size_t OFF_P = OFF_HM + al((size_t)T * 1024 * 2);
constexpr size_t OFF_PQK = OFF_P;
constexpr size_t OFF_VTL = OFF_PQK + (size_t)T * 1024 * 2;
constexpr size_t OFF_VTC = OFF_VTL + (size_t)2 * 8 * 64 * 16384 * 2;
constexpr size_t OFF_PB = OFF_VTC + (size_t)2 * 8 * 64 * 256 * 2;
constexpr size_t OFF_PC = OFF_PB + (size_t)T * 960 * 2;
constexpr size_t OFF_Y = OFF_PC + (size_t)T * 1040 * 2;
constexpr size_t OFF_MLF = OFF_Y + (size_t)T * 1024 * 2;
constexpr size_t OFF_GATE = OFF_MLF + (size_t)T * 512 * 2;
constexpr size_t OFF_MLG = OFF_GATE + (size_t)T * 256 * 2;
constexpr size_t OFF_MLS = OFF_MLG + (size_t)T * 16 * 4;
constexpr size_t OFF_MST = OFF_MLS + al(16 * 260 * 2 * 4);
constexpr size_t OFF_NST = OFF_MST + al(16 * 260 * 4);
constexpr size_t OFF_END1 = OFF_NST + al(16 * 260 * 64 * 4);
constexpr size_t OFF_WGU = OFF_P;
constexpr size_t OFF_WDN = OFF_WGU + (size_t)32 * 1024 * 1024 * 2;
constexpr size_t OFF_ACT = OFF_WDN + (size_t)32 * 1024 * 512 * 2;
constexpr size_t OFF_SLOTOUT = OFF_ACT + (size_t)MAXSLOT * 512 * 2;
constexpr size_t OFF_LOGITS = OFF_SLOTOUT + (size_t)MAXSLOT * 1024 * 2;
constexpr size_t OFF_END2 = OFF_LOGITS + (size_t)T * 64 * 4;
constexpr size_t WS_NEED = OFF_END1 > OFF_END2 ? OFF_END1 : OFF_END2;
static_assert(OFF_WDN <= OFF_Y, "Wexp must not overlap y");
static_assert(OFF_LOGITS >= OFF_MLF, "logits placement");

struct P {
    const float *x, *c, *ctx, *c_ctx, *w_mod, *b_mod, *w_in, *na_rpb, *mu_prev, *mu_next, *rw_w0, *rw_w2, *rw_a0, *rw_a2,
        *rw_g2, *rw_kk, *rw_ka, *rw_rk, *rw_lnw, *rw_lnb, *ml_cw, *ml_cb, *ml_ib, *ml_fb, *ml_nw, *w_out, *ln1g, *ln1b,
        *rgw, *rgb, *rew, *reb, *egate, *eup, *edown, *ln2g, *ln2b;
    float* out;
    char* ws;
};

#define XB_TMO      128
#define XB_XCNT(j)  (256  + 64 * (j))
#define XB_XSUB(j)  (1280 + 64 * (j))
#define XB_XGEN(j)  (2304 + 64 * (j))
#define XB_TOP      3328
#define XB_TOPGEN   3392
#define XCD_BAR_WORDS 3456
#define XB_SPIN_CAP (1u << 18)
#define LAS __attribute__((address_space(3)))

__device__ __forceinline__ unsigned xb_ld(unsigned* p)              { return __hip_atomic_load(p, __ATOMIC_RELAXED, __HIP_MEMORY_SCOPE_AGENT); }
__device__ __forceinline__ unsigned xb_add(unsigned* p, unsigned v) { return __hip_atomic_fetch_add(p, v, __ATOMIC_RELAXED, __HIP_MEMORY_SCOPE_AGENT); }
__device__ __forceinline__ unsigned xb_xcc_id() { return (unsigned)__builtin_amdgcn_s_getreg((3 << 11) | 20) & 0xFu; }
#define XB_SPIN(cond, bar) do { unsigned _sp = 0; while (cond) { __builtin_amdgcn_s_sleep(1); \
    if ((++_sp & 255u) == 0u) { if (xb_ld(&(bar)[XB_TMO])) break; if (_sp > XB_SPIN_CAP) { atomicAdd(&(bar)[XB_TMO], 1u); break; } } } } while (0)

struct XcdBarrier {
    unsigned* bar; unsigned x;
    volatile LAS unsigned* st;
};

__device__ __forceinline__ XcdBarrier xcd_barrier_post(unsigned* bar, volatile LAS unsigned* st) {
    XcdBarrier b; b.bar = bar; b.x = xb_xcc_id(); b.st = st;
    if (threadIdx.x == 0) (void)xb_add(&bar[XB_XCNT(b.x)], 1u);
    return b;
}
__device__ __forceinline__ void xcd_barrier_complete(unsigned* bar, unsigned x, unsigned& nloc, unsigned& nx) {
    const unsigned G = gridDim.x * gridDim.y * gridDim.z;
    unsigned sum, cnt, mine, sp = 0u;
    for (;;) {
        sum = 0u; cnt = 0u; mine = 0u;
#pragma unroll
        for (unsigned j = 0; j < 16; ++j) { const unsigned c = xb_ld(&bar[XB_XCNT(j)]); sum += c; cnt += (c > 0u) ? 1u : 0u; mine = (j == x) ? c : mine; }
        if (sum == G) break;
        __builtin_amdgcn_s_sleep(1);
        if ((++sp & 255u) == 0u) { if (xb_ld(&bar[XB_TMO])) break; if (sp > XB_SPIN_CAP) { atomicAdd(&bar[XB_TMO], 1u); break; } }
    }
    nloc = mine > 0u ? mine : 1u; nx = cnt > 0u ? cnt : 1u;
}

__device__ __forceinline__ void xcd_barrier(const XcdBarrier& b) {
    asm volatile("s_waitcnt vmcnt(0)" ::: "memory");
    __syncthreads();
    if (threadIdx.x == 0) {
        unsigned* bar = b.bar;
        __builtin_amdgcn_s_waitcnt(0);
        unsigned nloc = b.st[0], nx = b.st[1];
        if (nloc == 0u) { xcd_barrier_complete(bar, b.x, nloc, nx); b.st[0] = nloc; b.st[1] = nx; }
        const unsigned old = xb_add(&bar[XB_XSUB(b.x)], 1u);
        const unsigned gen = old / nloc;
        if (old + 1u == (gen + 1u) * nloc) {
            __builtin_amdgcn_fence(__ATOMIC_RELEASE, "agent");
            asm volatile("s_waitcnt vmcnt(0)" ::: "memory");
            const unsigned og = xb_add(&bar[XB_TOP], 1u);
            const unsigned tg = og / nx;
            if (og + 1u == (tg + 1u) * nx) xb_add(&bar[XB_TOPGEN], 1u);
            else XB_SPIN(xb_ld(&bar[XB_TOPGEN]) == tg, bar);
            __builtin_amdgcn_fence(__ATOMIC_ACQUIRE, "agent");
            xb_add(&bar[XB_XGEN(b.x)], 1u);
            asm volatile("s_waitcnt vmcnt(0)" ::: "memory");
        } else {
            XB_SPIN(xb_ld(&bar[XB_XGEN(b.x)]) == gen, bar);
            __builtin_amdgcn_fence(__ATOMIC_ACQUIRE, "agent");
            asm volatile("s_waitcnt vmcnt(0)" ::: "memory");
        }
    }
    __syncthreads();
}


DEVINL int tid_() { int t = threadIdx.x; asm volatile("" : "+v"(t)); return t; }
DEVINL int bid_() { int b = blockIdx.x; asm volatile("" : "+s"(b)); return b; }
#define GAS __attribute__((address_space(1)))
DEVINL char* wsl_(char* w) { GAS char* g = (GAS char*)w; asm volatile("" : "+s"(g)); return (char*)g; }
template <class Tp> DEVINL const Tp* gl_(const Tp* q) { const GAS Tp* g = (const GAS Tp*)q; asm volatile("" : "+s"(g)); return (const Tp*)g; }
DEVINL u16 f2bf(float f) { unsigned u = __float_as_uint(f); u += 0x7FFFu + ((u >> 16) & 1u); return (u16)(u >> 16); }
DEVINL float bf2f(u16 h) { return __uint_as_float(((unsigned)h) << 16); }
DEVINL float wsum(float v) { for (int o = 32; o > 0; o >>= 1) v += __shfl_xor(v, o); return v; }
DEVINL float sigmoidf_(float x) { return 1.f / (1.f + __expf(-x)); }
DEVINL float siluf_(float x) { return x / (1.f + __expf(-x)); }
DEVINL float softplusf_(float x) { return fmaxf(x, 0.f) + log1pf(__expf(-fabsf(x))); }
DEVINL int row_sel(int row) { return row < CTXROWS ? 2 : ((row - CTXROWS) >> 14); }
template <int CTRL, int RM>
DEVINL float dpp_f(float v) { return __int_as_float(__builtin_amdgcn_update_dpp(0, __float_as_int(v), CTRL, RM, 0xF, false)); }
DEVINL float wave_sum_dpp(float v) {
    v += dpp_f<0xB1, 0xF>(v);
    v += dpp_f<0x4E, 0xF>(v);
    v += dpp_f<0x141, 0xF>(v);
    v += dpp_f<0x140, 0xF>(v);
    v += dpp_f<0x142, 0xA>(v);
    v += dpp_f<0x143, 0xC>(v);
    return __int_as_float(__builtin_amdgcn_readlane(__float_as_int(v), 63));
}
DEVINL void glds16(const void* g, void* l) {
    __builtin_amdgcn_global_load_lds((const __attribute__((address_space(1))) void*)g, (__attribute__((address_space(3))) void*)l, 16, 0, 0);
}

template <class RowA>
DEVINL void gemm128_acc(RowA rowA, const u16* __restrict__ Bt, int ldb, int K, char* smem, f32x4 (&acc)[4][4]) {
    const int tid = tid_(), lane = tid & 63, wid = tid >> 6, wr = wid >> 1, wc = wid & 1, fr = lane & 15, fq = lane >> 4;
#pragma unroll
    for (int m = 0; m < 4; ++m)
#pragma unroll
        for (int n = 0; n < 4; ++n) acc[m][n] = f32x4{0.f, 0.f, 0.f, 0.f};
    const u16* aS0 = rowA(tid >> 2) + (tid & 3) * 8;
    const u16* aS1 = rowA((tid >> 2) + 64) + (tid & 3) * 8;
    const u16* bS0 = Bt + (size_t)(tid >> 2) * ldb + (tid & 3) * 8;
    const u16* bS1 = Bt + (size_t)((tid >> 2) + 64) * ldb + (tid & 3) * 8;
    const int nt = K >> 5;
    __syncthreads();
    {
        char* SA = smem; char* SB = smem + 8192;
        glds16(aS0, SA + tid * 16); glds16(aS1, SA + tid * 16 + 4096);
        glds16(bS0, SB + tid * 16); glds16(bS1, SB + tid * 16 + 4096);
    }
    for (int t = 0; t < nt; ++t) {
        asm volatile("s_waitcnt vmcnt(0)" ::: "memory");
        __builtin_amdgcn_s_barrier();
        if (t + 1 < nt) {
            char* SA = smem + ((t + 1) & 1) * 16384; char* SB = SA + 8192;
            const int ko = (t + 1) * 32;
            glds16(aS0 + ko, SA + tid * 16); glds16(aS1 + ko, SA + tid * 16 + 4096);
            glds16(bS0 + ko, SB + tid * 16); glds16(bS1 + ko, SB + tid * 16 + 4096);
        }
        const char* SA = smem + (t & 1) * 16384; const char* SB = SA + 8192;
        bf16x8 af[4], bfr[4];
#pragma unroll
        for (int m = 0; m < 4; ++m) af[m] = *(const bf16x8*)(SA + (wr * 64 + m * 16 + fr) * 64 + fq * 16);
#pragma unroll
        for (int n = 0; n < 4; ++n) bfr[n] = *(const bf16x8*)(SB + (wc * 64 + n * 16 + fr) * 64 + fq * 16);
#pragma unroll
        for (int m = 0; m < 4; ++m)
#pragma unroll
            for (int n = 0; n < 4; ++n) acc[m][n] = __builtin_amdgcn_mfma_f32_16x16x32_bf16(af[m], bfr[n], acc[m][n], 0, 0, 0);
    }
}
template <class RowA, class Epi>
DEVINL void gemm128(RowA rowA, const u16* __restrict__ Bt, int ldb, int K, char* smem, Epi epi) {
    const int tid = tid_(), lane = tid & 63, wid = tid >> 6, wr = wid >> 1, wc = wid & 1, fr = lane & 15, fq = lane >> 4;
    f32x4 acc[4][4];
    gemm128_acc(rowA, Bt, ldb, K, smem, acc);
#pragma unroll
    for (int m = 0; m < 4; ++m)
#pragma unroll
        for (int n = 0; n < 4; ++n) epi(wr * 64 + m * 16 + fq * 4, wc * 64 + n * 16 + fr, acc[m][n]);
}

DEVINL void ph_prolog(const P& p, char* smem) {
    const int TIDX_ = tid_(); const int BIDX_ = bid_(); char* const WS_ = wsl_(p.ws); (void)TIDX_; (void)BIDX_; (void)WS_;
    const int tid = TIDX_;
    float* modv = (float*)(WS_ + OFF_MOD);
    float* sil = (float*)smem;
    float* red = sil + 3072;
    bool ready = false;
    for (int u = BIDX_; u < 192; u += gridDim.x) {
        if (!ready) {
            for (int i = tid; i < 3072; i += 256) { int v = i >> 10, k = i & 1023; float cv = v < 2 ? p.c[v * 1024 + k] : p.c_ctx[k]; sil[i] = cv / (1.f + expf(-cv)); }
            ready = true;
        }
        __syncthreads();
        const int l = u / 96, cg = u % 96;
        const float* W = p.w_mod + (size_t)l * 1024 * 6144 + cg * 64;
        const int c4 = (tid & 15) * 4, rg = tid >> 4;
        float a0[4] = {0, 0, 0, 0}, a1[4] = {0, 0, 0, 0}, a2[4] = {0, 0, 0, 0};
#pragma unroll 4
        for (int i = 0; i < 64; ++i) {
            const int k = rg + 16 * i;
            const float4 w = *(const float4*)(W + (size_t)k * 6144 + c4);
            const float s0 = sil[k], s1 = sil[1024 + k], s2 = sil[2048 + k];
            a0[0] += s0 * w.x; a0[1] += s0 * w.y; a0[2] += s0 * w.z; a0[3] += s0 * w.w;
            a1[0] += s1 * w.x; a1[1] += s1 * w.y; a1[2] += s1 * w.z; a1[3] += s1 * w.w;
            a2[0] += s2 * w.x; a2[1] += s2 * w.y; a2[2] += s2 * w.z; a2[3] += s2 * w.w;
        }
#pragma unroll
        for (int j = 0; j < 4; ++j) { red[(rg * 3 + 0) * 64 + c4 + j] = a0[j]; red[(rg * 3 + 1) * 64 + c4 + j] = a1[j]; red[(rg * 3 + 2) * 64 + c4 + j] = a2[j]; }
        __syncthreads();
        if (tid < 192) {
            const int v = tid >> 6, cc = tid & 63;
            float s = 0.f;
            for (int r = 0; r < 16; ++r) s += red[(r * 3 + v) * 64 + cc];
            const int col = cg * 64 + cc;
            modv[(l * 3 + v) * 6144 + col] = s + p.b_mod[l * 6144 + col];
        }
        __syncthreads();
    }
    float* rope = (float*)(WS_ + OFF_ROPE);
    for (int i = BIDX_ * 256 + tid; i < 320 * 16; i += gridDim.x * 256) {
        const int pos = (i < 4096) ? (i >> 4) : ((i - 4096) >> 4);
        const int f = i & 15;
        const float inv = powf(10000.0f, -(float)f / 16.0f);
        const float ang = (float)pos * inv;
        const double TWO_PI = 6.283185307179586476925;
        double a = (double)ang;
        a -= TWO_PI * rint(a / TWO_PI);
        const float cr = (float)cos(a), sr = (float)sin(a);
        if (i < 4096) { rope[i] = cr; rope[4096 + i] = sr; }
        else { rope[8192 + (i - 4096)] = cr; rope[8192 + 1024 + (i - 4096)] = sr; }
    }
    u16* wr = (u16*)(WS_ + OFF_WR);
    for (int i = BIDX_ * 256 + tid; i < 2 * 128 * 1024; i += gridDim.x * 256) {
        const int l = i >> 17, n = (i >> 10) & 127, k = i & 1023;
        float v = 0.f;
        if (n < 4) v = p.rgw[((size_t)l * 1024 + k) * 4 + n];
        else if (n < 36) v = p.rew[((size_t)l * 1024 + k) * 32 + (n - 4)];
        wr[i] = f2bf(v);
    }
}

DEVINL void conv_tile(const float* __restrict__ src, int N, int K, u16* __restrict__ dst, int k0, int n0, int mode, char* smem) {
    u16* t = (u16*)smem;
    const int tid = tid_();
    __syncthreads();
#pragma unroll 4
    for (int i = 0; i < 16; ++i) {
        const int k = i * 4 + (tid >> 6), n = tid & 63;
        float v = 0.f;
        if (n0 + n < N) v = src[(size_t)(k0 + k) * N + n0 + n];
        t[n * 68 + k] = f2bf(v);
    }
    __syncthreads();
#pragma unroll
    for (int i = 0; i < 4; ++i) {
        const int n = i * 16 + (tid >> 4), kq = (tid & 15) * 4;
        const int ng = n0 + n;
        int nd = ng;
        if (mode == 1) nd = 32 * (ng >> 4) + (ng & 15);
        else if (mode == 2) nd = 32 * (ng >> 4) + 16 + (ng & 15);
        uint2 v;
        v.x = (unsigned)t[n * 68 + kq] | ((unsigned)t[n * 68 + kq + 1] << 16);
        v.y = (unsigned)t[n * 68 + kq + 2] | ((unsigned)t[n * 68 + kq + 3] << 16);
        *(uint2*)(dst + (size_t)nd * K + k0 + kq) = v;
    }
}
DEVINL void ph_convw(const P& p, int l, char* smem) {
    const int TIDX_ = tid_(); const int BIDX_ = bid_(); char* const WS_ = wsl_(p.ws); (void)TIDX_; (void)BIDX_; (void)WS_;
    u16* win = (u16*)(WS_ + OFF_WIN); u16* wout = (u16*)(WS_ + OFF_WOUT);
    for (int u = BIDX_; u < 896 + 256; u += gridDim.x) {
        if (u < 896) conv_tile(p.w_in + (size_t)l * 1024 * INP, INP, 1024, win, (u / 56) * 64, (u % 56) * 64, 0, smem);
        else { const int v = u - 896; conv_tile(p.w_out + (size_t)l * 1024 * 1024, 1024, 1024, wout, (v / 16) * 64, (v % 16) * 64, 0, smem); }
    }
}
DEVINL void ph_convexp(const P& p, int l, char* smem) {
    const int TIDX_ = tid_(); const int BIDX_ = bid_(); char* const WS_ = wsl_(p.ws); (void)TIDX_; (void)BIDX_; (void)WS_;
    u16* wgu = (u16*)(WS_ + OFF_WGU); u16* wdn = (u16*)(WS_ + OFF_WDN);
    for (int u = BIDX_; u < 32 * 384; u += gridDim.x) {
        const int e = u / 384, v = u % 384;
        const size_t le = (size_t)l * 32 + e;
        if (v < 128) conv_tile(p.egate + le * 1024 * 512, 512, 1024, wgu + (size_t)e * 1024 * 1024, (v / 8) * 64, (v % 8) * 64, 1, smem);
        else if (v < 256) { const int w = v - 128; conv_tile(p.eup + le * 1024 * 512, 512, 1024, wgu + (size_t)e * 1024 * 1024, (w / 8) * 64, (w % 8) * 64, 2, smem); }
        else { const int w = v - 256; conv_tile(p.edown + le * 512 * 1024, 1024, 512, wdn + (size_t)e * 1024 * 512, (w / 16) * 64, (w % 16) * 64, 0, smem); }
    }
}

DEVINL void ph_xm0(const P& p) {
    const int TIDX_ = tid_(); const int BIDX_ = bid_(); char* const WS_ = wsl_(p.ws); (void)TIDX_; (void)BIDX_; (void)WS_;
    const float* modv = (const float*)(WS_ + OFF_MOD);
    u16* hm = (u16*)(WS_ + OFF_HM);
    for (size_t i = (size_t)BIDX_ * 256 + TIDX_; i < (size_t)T * 256; i += (size_t)gridDim.x * 256) {
        const int row = (int)(i >> 8), c4 = (int)(i & 255) * 4;
        const float* src = row < CTXROWS ? p.ctx + (size_t)row * 1024 : p.x + (size_t)(row - CTXROWS) * 1024;
        const float* mv = modv + row_sel(row) * 6144;
        const float4 v = *(const float4*)(src + c4);
        const float4 sh = *(const float4*)(mv + c4), sc = *(const float4*)(mv + 1024 + c4);
        uint2 o;
        o.x = (unsigned)f2bf(v.x * (1.f + sc.x) + sh.x) | ((unsigned)f2bf(v.y * (1.f + sc.y) + sh.y) << 16);
        o.y = (unsigned)f2bf(v.z * (1.f + sc.z) + sh.z) | ((unsigned)f2bf(v.w * (1.f + sc.w) + sh.w) << 16);
        *(uint2*)(hm + (size_t)row * 1024 + c4) = o;
    }
}

DEVINL void ph_inproj(const P& p, char* smem) {
    const int TIDX_ = tid_(); const int BIDX_ = bid_(); char* const WS_ = wsl_(p.ws); (void)TIDX_; (void)BIDX_; (void)WS_;
    const u16* hm = (const u16*)(WS_ + OFF_HM);
    const u16* win = (const u16*)(WS_ + OFF_WIN);
    u16* pqk = (u16*)(WS_ + OFF_PQK); u16* vtl = (u16*)(WS_ + OFF_VTL); u16* vtc = (u16*)(WS_ + OFF_VTC);
    u16* pb = (u16*)(WS_ + OFF_PB); u16* pc = (u16*)(WS_ + OFF_PC);
    for (int u = BIDX_; u < 260 * 28; u += gridDim.x) {
        const int mt = u / 28, nt = u % 28;
        const u16* A = hm + (size_t)mt * 128 * 1024;
        gemm128([&](int r) { return A + (size_t)r * 1024; }, win + (size_t)nt * 128 * 1024, 1024, 1024, smem,
                [&](int m, int n, f32x4 a) {
                    const int R = mt * 128 + m, N = nt * 128 + n;
                    if (N >= INP) return;
                    const u16 h0 = f2bf(a[0]), h1 = f2bf(a[1]), h2 = f2bf(a[2]), h3 = f2bf(a[3]);
                    if (N < 1024) {
                        u16* q = pqk + (size_t)R * 1024 + N; q[0] = h0; q[1024] = h1; q[2048] = h2; q[3072] = h3;
                    } else if (N < 1536) {
                        const int hh = (N - 1024) >> 6, d = (N - 1024) & 63;
                        uint2 v; v.x = (unsigned)h0 | ((unsigned)h1 << 16); v.y = (unsigned)h2 | ((unsigned)h3 << 16);
                        if (R < CTXROWS) { const int b = R >> 8, t = R & 255; *(uint2*)(vtc + ((size_t)((b * 8 + hh) * 64 + d)) * 256 + t) = v; }
                        else { const int R2 = R - CTXROWS, b = R2 >> 14, t = R2 & 16383; *(uint2*)(vtl + ((size_t)((b * 8 + hh) * 64 + d)) * 16384 + t) = v; }
                    } else if (N < 2496) {
                        u16* q = pb + (size_t)R * 960 + (N - 1536); q[0] = h0; q[960] = h1; q[1920] = h2; q[2880] = h3;
                    } else {
                        u16* q = pc + (size_t)R * 1040 + (N - 2496); q[0] = h0; q[1040] = h1; q[2080] = h2; q[3120] = h3;
                    }
                });
    }
}

DEVINL void ph_prep(const P& p, int l, char* smem) {
    const int TIDX_ = tid_(); const int BIDX_ = bid_(); char* const WS_ = wsl_(p.ws); (void)TIDX_; (void)BIDX_; (void)WS_;
    const int tid = TIDX_, lane = tid & 63, wid = tid >> 6;
    const u16* pb = (const u16*)(WS_ + OFF_PB);
    const u16* pc = (const u16*)(WS_ + OFF_PC);
    u16* rwf = (u16*)(WS_ + OFF_X1);
    u16* gate = (u16*)(WS_ + OFF_GATE);
    u16* mlf = (u16*)(WS_ + OFF_MLF);
    float* mlg = (float*)(WS_ + OFF_MLG);
    float* mls = (float*)(WS_ + OFF_MLS);
    float* nst = (float*)(WS_ + OFF_NST);
    float* cst = (float*)(WS_ + OFF_HM);
    const float* rope = (const float*)(WS_ + OFF_ROPE);
    const float* mup = p.mu_prev + l * 960; const float* mun = p.mu_next + l * 960;
    for (int u = BIDX_; u < NUNIT_CH; u += gridDim.x) {
        int b, ch, row0, seqlen; bool isctx;
        if (u < 8) { isctx = true; b = u >> 2; ch = u & 3; row0 = b * 256 + ch * 64; seqlen = 256; }
        else { isctx = false; b = (u - 8) >> 8; ch = (u - 8) & 255; row0 = CTXROWS + b * LAT + ch * 64; seqlen = LAT; }
        const int t0 = ch * 64;
        const int tc = isctx ? ch : 4 + ch;
        float* lwd = (float*)smem;
        float* lad = lwd + 4096;
        float* lgd = lad + 4096;
        __syncthreads();
        {
            const float mp0 = mup[tid], mn0 = mun[tid], mp1 = mup[256 + tid], mn1 = mun[256 + tid], mp2 = mup[512 + tid], mn2 = mun[512 + tid];
            const float mp3 = tid < 192 ? mup[768 + tid] : 0.f, mn3 = tid < 192 ? mun[768 + tid] : 0.f;
            const float kkw = p.rw_kk[l * 256 + tid];
            float pr0 = 0, pr1 = 0, pr2 = 0, pr3 = 0, cu0, cu1, cu2, cu3;
            if (t0 > 0) { const u16* r = pb + (size_t)(row0 - 1) * 960; pr0 = bf2f(r[tid]); pr1 = bf2f(r[256 + tid]); pr2 = bf2f(r[512 + tid]); pr3 = tid < 192 ? bf2f(r[768 + tid]) : 0.f; }
            { const u16* r = pb + (size_t)row0 * 960; cu0 = bf2f(r[tid]); cu1 = bf2f(r[256 + tid]); cu2 = bf2f(r[512 + tid]); cu3 = tid < 192 ? bf2f(r[768 + tid]) : 0.f; }
#pragma unroll 1
            for (int j = 0; j < 64; ++j) {
                float nx0 = 0, nx1 = 0, nx2 = 0, nx3 = 0;
                if (t0 + j + 1 < seqlen) { const u16* r = pb + (size_t)(row0 + j + 1) * 960; nx0 = bf2f(r[tid]); nx1 = bf2f(r[256 + tid]); nx2 = bf2f(r[512 + tid]); nx3 = tid < 192 ? bf2f(r[768 + tid]) : 0.f; }
                const float rr = cu0 + mp0 * (pr0 - cu0) + mn0 * (nx0 - cu0);
                const float kr = cu1 + mp1 * (pr1 - cu1) + mn1 * (nx1 - cu1);
                const float vr = cu2 + mp2 * (pr2 - cu2) + mn2 * (nx2 - cu2);
                const float xr = cu3 + mp3 * (pr3 - cu3) + mn3 * (nx3 - cu3);
                const float kkv = kr * kkw;
                const float ss = wsum(kkv * kkv);
                const float kkn = kkv / fmaxf(sqrtf(ss), 1e-12f);
                u16* f = rwf + ((size_t)(row0 + j) * 4 + wid) * 512;
                f[lane] = f2bf(rr); f[64 + lane] = f2bf(kr); f[128 + lane] = f2bf(vr); f[192 + lane] = f2bf(kkn);
                if (tid < 64) lwd[j * 64 + tid] = tanhf(xr);
                else if (tid < 128) lad[j * 64 + tid - 64] = xr;
                else if (tid < 192) lgd[j * 64 + tid - 128] = sigmoidf_(xr);
                pr0 = cu0; pr1 = cu1; pr2 = cu2; pr3 = cu3; cu0 = nx0; cu1 = nx1; cu2 = nx2; cu3 = nx3;
            }
        }
        __syncthreads();
        {
            const int c = tid;
            const float* w2p = gl_(p.rw_w2 + (size_t)l * 2 * 32 * 256); const float* a2p = gl_(p.rw_a2 + (size_t)l * 2 * 32 * 256); const float* g2p = gl_(p.rw_g2 + (size_t)l * 64 * 256);
#pragma unroll 1
            for (int pass = 0; pass < 5; ++pass) {
                const int z = pass & 1;
                const float* W = pass < 2 ? w2p + z * 32 * 256 : (pass < 4 ? a2p + z * 32 * 256 : g2p);
                const float* X = pass < 2 ? lwd + z * 32 : (pass < 4 ? lad + z * 32 : lgd);
                const int R = pass < 4 ? 32 : 64;
                const float bias = pass < 2 ? p.rw_w0[(l * 2 + z) * 256 + c] : (pass < 4 ? p.rw_a0[(l * 2 + z) * 256 + c] : 0.f);
#pragma unroll 1
                for (int jb = 0; jb < 64; jb += 16) {
                    float acc[16];
#pragma unroll
                    for (int jj = 0; jj < 16; ++jj) acc[jj] = bias;
#pragma unroll 1
                    for (int r = 0; r < R; r += 4) {
                        const float w0 = W[(r + 0) * 256 + c], w1 = W[(r + 1) * 256 + c], w2 = W[(r + 2) * 256 + c], w3 = W[(r + 3) * 256 + c];
#pragma unroll
                        for (int jj = 0; jj < 16; ++jj) {
                            const float4 x = *(const float4*)(X + (jb + jj) * 64 + r);
                            acc[jj] += x.x * w0 + x.y * w1 + x.z * w2 + x.w * w3;
                        }
                    }
#pragma unroll
                    for (int jj = 0; jj < 16; ++jj) {
                        const int j = jb + jj;
                        if (pass < 2) {
                            const float logw = -softplusf_(-acc[jj]) - 0.5f;
                            rwf[((size_t)(row0 + j) * 4 + wid) * 512 + (4 + z) * 64 + lane] = f2bf(expf(logw));
                        } else if (pass < 4) {
                            rwf[((size_t)(row0 + j) * 4 + wid) * 512 + (6 + z) * 64 + lane] = f2bf(sigmoidf_(acc[jj]));
                        } else {
                            gate[(size_t)(row0 + j) * 256 + c] = f2bf(acc[jj]);
                        }
                    }
                }
            }
        }
        __syncthreads();
        u16* kl = (u16*)smem;
        u16* vl = kl + 4096;
        float* wsl = (float*)(vl + 4096);
        float* lil = wsl + 512;
        {
            const float* cw = p.ml_cw + (size_t)l * 3 * 512;
            const float wq0 = cw[tid], wq1 = cw[512 + tid], wq2 = cw[1024 + tid], bq = p.ml_cb[l * 512 + tid];
            const float wk0 = cw[256 + tid], wk1 = cw[512 + 256 + tid], wk2 = cw[1024 + 256 + tid], bk = p.ml_cb[l * 512 + 256 + tid];
            float pq = 0, pk = 0, cq, ck;
            if (t0 > 0) { const u16* r = pc + (size_t)(row0 - 1) * 1040; pq = bf2f(r[tid]); pk = bf2f(r[256 + tid]); }
            { const u16* r = pc + (size_t)row0 * 1040; cq = bf2f(r[tid]); ck = bf2f(r[256 + tid]); }
            const int i16 = lane & 15; const bool second = (lane & 16) != 0; const int half = lane >> 5;
#pragma unroll 1
            for (int j = 0; j < 64; ++j) {
                float nq = 0, nk = 0;
                if (t0 + j + 1 < seqlen) { const u16* r = pc + (size_t)(row0 + j + 1) * 1040; nq = bf2f(r[tid]); nk = bf2f(r[256 + tid]); }
                float vq = siluf_(wq0 * pq + wq1 * cq + wq2 * nq + bq);
                float vk = siluf_(wk0 * pk + wk1 * ck + wk2 * nk + bk);
                if (!isctx) {
                    const int t = t0 + j;
                    const int pos = half == 0 ? (t >> 6) : (t & 63);
                    const float cs = half == 0 ? rope[pos * 16 + i16] : rope[8192 + pos * 16 + i16];
                    const float sn = half == 0 ? rope[4096 + pos * 16 + i16] : rope[9216 + pos * 16 + i16];
                    const float oq = __shfl_xor(vq, 16), ok = __shfl_xor(vk, 16);
                    vq = second ? (oq * sn + vq * cs) : (vq * cs - oq * sn);
                    vk = second ? (ok * sn + vk * cs) : (vk * cs - ok * sn);
                }
                mlf[(size_t)(row0 + j) * 512 + tid] = f2bf(vq);
                mlf[(size_t)(row0 + j) * 512 + 256 + tid] = f2bf(vk * 0.125f);
                pq = cq; pk = ck; cq = nq; ck = nk;
            }
            const int j = tid >> 2, q4 = tid & 3;
#pragma unroll
            for (int i = 0; i < 4; ++i) {
                const int idx = q4 * 4 + i;
                const float g = bf2f(pc[(size_t)(row0 + j) * 1040 + 1024 + idx]);
                float v;
                if (idx < 8) v = g + p.ml_ib[l * 8 + idx];
                else { const float xx = g + p.ml_fb[l * 8 + idx - 8]; v = fminf(xx, 0.f) - log1pf(__expf(-fabsf(xx))); }
                lil[j * 16 + idx] = v;
                mlg[(size_t)(row0 + j) * 16 + idx] = v;
            }
        }
        __syncthreads();
        if (tid < 8) {
            const int d = tid >> 2, h = tid & 3;
            float bacc = 0.f;
#pragma unroll 1
            for (int jj = 0; jj < 64; ++jj) { const int tok = d ? 63 - jj : jj; bacc += lil[tok * 16 + 8 + d * 4 + h]; wsl[tid * 64 + tok] = bacc; }
            const float Bs = bacc;
            float G = -3.0e38f;
#pragma unroll 1
            for (int tok = 0; tok < 64; ++tok) { const float g = Bs - wsl[tid * 64 + tok] + lil[tok * 16 + d * 4 + h]; G = fmaxf(G, g); }
#pragma unroll 1
            for (int tok = 0; tok < 64; ++tok) { const float g = Bs - wsl[tid * 64 + tok] + lil[tok * 16 + d * 4 + h]; wsl[tid * 64 + tok] = expf(g - G); }
            const int bhd = (b * 4 + h) * 2 + d;
            mls[(bhd * NTC + tc) * 2 + 0] = G; mls[(bhd * NTC + tc) * 2 + 1] = Bs;
        }
#pragma unroll 1
        for (int h = 0; h < 4; ++h) {
            __syncthreads();
            for (int i = tid; i < 64 * 16; i += 256) {
                const int tok = i >> 4, c4 = (i & 15) * 4;
                *(uint2*)(kl + tok * 64 + c4) = *(const uint2*)(mlf + (size_t)(row0 + tok) * 512 + 256 + h * 64 + c4);
                *(uint2*)(vl + tok * 64 + c4) = *(const uint2*)(pc + (size_t)(row0 + tok) * 1040 + 512 + h * 64 + c4);
            }
            __syncthreads();
            const int dk4 = (tid >> 4) * 4, dv4 = (tid & 15) * 4;
            float a0[4][4], a1[4][4], n0[4], n1[4];
#pragma unroll
            for (int a = 0; a < 4; ++a) { n0[a] = 0.f; n1[a] = 0.f;
#pragma unroll
                for (int c = 0; c < 4; ++c) { a0[a][c] = 0.f; a1[a][c] = 0.f; } }
#pragma unroll 2
            for (int j = 0; j < 64; ++j) {
                const uint2 kk = *(const uint2*)(kl + j * 64 + dk4);
                const uint2 vv = *(const uint2*)(vl + j * 64 + dv4);
                const float w0 = wsl[h * 64 + j], w1 = wsl[(4 + h) * 64 + j];
                const float kf[4] = {bf2f((u16)(kk.x & 0xFFFF)), bf2f((u16)(kk.x >> 16)), bf2f((u16)(kk.y & 0xFFFF)), bf2f((u16)(kk.y >> 16))};
                const float vf[4] = {bf2f((u16)(vv.x & 0xFFFF)), bf2f((u16)(vv.x >> 16)), bf2f((u16)(vv.y & 0xFFFF)), bf2f((u16)(vv.y >> 16))};
#pragma unroll
                for (int a = 0; a < 4; ++a) {
                    const float k0 = kf[a] * w0, k1 = kf[a] * w1;
                    n0[a] += k0; n1[a] += k1;
#pragma unroll
                    for (int c = 0; c < 4; ++c) { a0[a][c] += k0 * vf[c]; a1[a][c] += k1 * vf[c]; }
                }
            }
            const int bh0 = ((b * 4 + h) * 2 + 0) * NTC + tc, bh1 = ((b * 4 + h) * 2 + 1) * NTC + tc;
#pragma unroll
            for (int a = 0; a < 4; ++a) {
                *(float4*)(cst + (size_t)bh0 * 4096 + (dk4 + a) * 64 + dv4) = make_float4(a0[a][0], a0[a][1], a0[a][2], a0[a][3]);
                *(float4*)(cst + (size_t)bh1 * 4096 + (dk4 + a) * 64 + dv4) = make_float4(a1[a][0], a1[a][1], a1[a][2], a1[a][3]);
                if ((tid & 15) == 0) { nst[(size_t)bh0 * 64 + dk4 + a] = n0[a]; nst[(size_t)bh1 * 64 + dk4 + a] = n1[a]; }
            }
        }
    }
}

DEVINL void ph_mlB(const P& p, int bid, int nb) {
    const int TIDX_ = tid_(); const int BIDX_ = bid_(); char* const WS_ = wsl_(p.ws); (void)TIDX_; (void)BIDX_; (void)WS_;
    const int tid = TIDX_;
    float* mls = (float*)(WS_ + OFF_MLS);
    float* mst = (float*)(WS_ + OFF_MST);
    float* nst = (float*)(WS_ + OFF_NST);
    float* cst = (float*)(WS_ + OFF_HM);
    for (int u = bid; u < 64; u += nb) {
        const int bhd = u >> 2, q = u & 3, d = bhd & 1;
        float zz = 0.f; asm volatile("" : "+v"(zz));
        float4 C = make_float4(zz, zz, zz, zz);
        float nn = zz, m = zz;
        auto tcof = [&](int cs) { return cs < 4 ? (d ? 3 - cs : cs) : 4 + (d ? 255 - (cs - 4) : cs - 4); };
        float4 Unext = *(const float4*)(cst + ((size_t)bhd * NTC + tcof(0)) * 4096 + q * 1024 + tid * 4);
        for (int cs = 0; cs < NTC; ++cs) {
            const int tc = tcof(cs);
            const float4 U = Unext;
            float* cp = cst + ((size_t)bhd * NTC + tc) * 4096 + q * 1024 + tid * 4;
            if (cs + 1 < NTC) Unext = *(const float4*)(cst + ((size_t)bhd * NTC + tcof(cs + 1)) * 4096 + q * 1024 + tid * 4);
            const float G = mls[(bhd * NTC + tc) * 2 + 0], Bs = mls[(bhd * NTC + tc) * 2 + 1];
            float nU = 0.f;
            if (q == 0 && tid < 64) nU = nst[((size_t)bhd * NTC + tc) * 64 + tid];
            *(float4*)cp = C;
            if (q == 0 && tid < 64) nst[((size_t)bhd * NTC + tc) * 64 + tid] = nn;
            if (q == 0 && tid == 0) mst[bhd * NTC + tc] = m;
            const float ml = fmaxf(Bs + m, G);
            const float dC = expf(Bs + m - ml), dU = expf(G - ml);
            C.x = dC * C.x + dU * U.x; C.y = dC * C.y + dU * U.y; C.z = dC * C.z + dU * U.z; C.w = dC * C.w + dU * U.w;
            nn = dC * nn + dU * nU;
            m = ml;
        }
    }
}

DEVINL void ph_scan(const P& p, int l, int bid, int nb) {
    const int TIDX_ = tid_(); const int BIDX_ = bid_(); char* const WS_ = wsl_(p.ws); (void)TIDX_; (void)BIDX_; (void)WS_;
    const int tid = TIDX_, lane = tid & 63, wid = tid >> 6;
    const u16* rwf = (const u16*)(WS_ + OFF_X1);
    u16* yrw = (u16*)(WS_ + OFF_PB);
    const bool need_ctx = (l == 0);
    for (int u = bid; u < 256; u += nb) {
        const int b = u >> 7, h = (u >> 5) & 3, d = (u >> 4) & 1, rg = u & 15;
        const int vrow = rg * 4 + wid;
        const float ka = p.rw_ka[l * 256 + h * 64 + lane];
        float S = 0.f;
        for (int ph = 0; ph < 2; ++ph) {
            const int n = ph == 0 ? LCTX : LAT;
            const int rowbase = ph == 0 ? b * LCTX : CTXROWS + b * LAT;
            const bool emit = ph == 1 || need_ctx;
            unsigned rr_[8], kr_[8], kk_[8], ee_[8], aa_[8], vv_[8];
            auto loadg = [&](int s0) {
#pragma unroll
                for (int i = 0; i < 8; ++i) {
                    const int s = s0 + i; const int t = d ? n - 1 - s : s;
                    const u16* f = rwf + ((size_t)(rowbase + t) * 4 + h) * 512;
                    rr_[i] = f[lane]; kr_[i] = f[64 + lane]; vv_[i] = f[128 + vrow]; kk_[i] = f[192 + lane];
                    ee_[i] = f[(4 + d) * 64 + lane]; aa_[i] = f[(6 + d) * 64 + lane];
                }
            };
            loadg(0);
            for (int s0 = 0; s0 < n; s0 += 8) {
                float r_[8], kd_[8], v_[8], na_[8], w_[8], bd_[8];
#pragma unroll
                for (int i = 0; i < 8; ++i) {
                    const float k = bf2f((u16)kr_[i]), kk = bf2f((u16)kk_[i]), a = bf2f((u16)aa_[i]), e = bf2f((u16)ee_[i]);
                    r_[i] = bf2f((u16)rr_[i]); v_[i] = bf2f((u16)vv_[i]);
                    w_[i] = __expf(-e); kd_[i] = k * (1.f + (a - 1.f) * ka); bd_[i] = kk * a; na_[i] = -kk;
                }
                if (s0 + 8 < n) loadg(s0 + 8);
                float ys[8];
#pragma unroll
                for (int i = 0; i < 8; ++i) {
                    const float sa = wave_sum_dpp(S * na_[i]);
                    const float tmp = S * w_[i] + v_[i] * kd_[i];
                    S = sa * bd_[i] + tmp;
                    ys[i] = wave_sum_dpp(S * r_[i]);
                }
                if (emit) {
                    float yv = ys[0];
#pragma unroll
                    for (int i = 1; i < 8; ++i) yv = (lane == i) ? ys[i] : yv;
                    if (lane < 8) {
                        const int s = s0 + lane; const int t = d ? n - 1 - s : s;
                        yrw[((size_t)(rowbase + t) * 2 + d) * 256 + h * 64 + vrow] = f2bf(yv);
                    }
                }
            }
        }
    }
}

DEVINL void ph_na(const P& p, int l, char* smem, int bid, int nb) {
    const int TIDX_ = tid_(); const int BIDX_ = bid_(); char* const WS_ = wsl_(p.ws); (void)TIDX_; (void)BIDX_; (void)WS_;
    const int tid = TIDX_, lane = tid & 63, w = tid >> 6, fr = lane & 15, g = lane >> 4;
    const u16* pqk = (const u16*)(WS_ + OFF_PQK);
    const u16* vtl = (const u16*)(WS_ + OFF_VTL);
    const u16* vtc = (const u16*)(WS_ + OFF_VTC);
    u16* y = (u16*)(WS_ + OFF_Y);
    float* rpbl = (float*)smem;
    const int nunit = 4096 + (l == 0 ? 64 : 0);
    for (int u = bid; u < nunit; u += nb) {
        const bool isctx = u >= 4096;
        int b, h, r = 0, qg = 0;
        if (!isctx) { b = u >> 11; h = (u >> 8) & 7; r = u & 255; }
        else { const int v = u - 4096; b = v >> 5; h = (v >> 2) & 7; qg = v & 3; }
        __syncthreads();
        if (!isctx) for (int i = tid; i < 465; i += 256) rpbl[i] = p.na_rpb[((size_t)l * 8 + h) * 465 + i];
        __syncthreads();
        const int c = 16 * w + fr;
        const int qrow = isctx ? b * LCTX + qg * 64 + c : CTXROWS + b * LAT + r * 64 + c;
        bf16x8 qf[2];
        qf[0] = *(const bf16x8*)(pqk + (size_t)qrow * 1024 + h * 64 + 8 * g);
        qf[1] = *(const bf16x8*)(pqk + (size_t)qrow * 1024 + h * 64 + 32 + 8 * g);
        f32x4 O[4];
#pragma unroll
        for (int i = 0; i < 4; ++i) O[i] = f32x4{0.f, 0.f, 0.f, 0.f};
        float mrun = -1.0e30f, lrun = 0.f;
        auto chunk = [&](const u16* kbase0, const u16* kbase1, const u16* vb, int vstride, const float* bias0, const float* bias1, bool lo0, bool lo1, int kc0, int cs) {
            bf16x8 k00 = *(const bf16x8*)(kbase0 + 8 * g), k01 = *(const bf16x8*)(kbase0 + 32 + 8 * g);
            bf16x8 k10 = *(const bf16x8*)(kbase1 + 8 * g), k11 = *(const bf16x8*)(kbase1 + 32 + 8 * g);
            uint2 vlo[4], vhi[4];
#pragma unroll
            for (int dt = 0; dt < 4; ++dt) { vlo[dt] = *(const uint2*)(vb + (size_t)dt * 16 * vstride); vhi[dt] = *(const uint2*)(vb + (size_t)dt * 16 * vstride + 16); }
            f32x4 s0 = f32x4{0.f, 0.f, 0.f, 0.f}, s1 = f32x4{0.f, 0.f, 0.f, 0.f};
            s0 = __builtin_amdgcn_mfma_f32_16x16x32_bf16(k00, qf[0], s0, 0, 0, 0);
            s0 = __builtin_amdgcn_mfma_f32_16x16x32_bf16(k01, qf[1], s0, 0, 0, 0);
            s1 = __builtin_amdgcn_mfma_f32_16x16x32_bf16(k10, qf[0], s1, 0, 0, 0);
            s1 = __builtin_amdgcn_mfma_f32_16x16x32_bf16(k11, qf[1], s1, 0, 0, 0);
            float sv[8];
#pragma unroll
            for (int j = 0; j < 4; ++j) {
                float a = s0[j] * 0.125f, bb = s1[j] * 0.125f;
                if (lo0) {
                    const int k0c = kc0 + 4 * g + j, k1c = k0c + 16;
                    a = (k0c >= cs && k0c <= cs + 15) ? a + bias0[k0c] : -1.0e30f;
                    bb = (k1c >= cs && k1c <= cs + 15) ? bb + bias0[k1c] : -1.0e30f;
                }
                sv[j] = a; sv[4 + j] = bb;
            }
            (void)bias1; (void)lo1;
            float mx = sv[0];
#pragma unroll
            for (int j = 1; j < 8; ++j) mx = fmaxf(mx, sv[j]);
            mx = fmaxf(mx, __shfl_xor(mx, 16)); mx = fmaxf(mx, __shfl_xor(mx, 32));
            const float mnew = fmaxf(mrun, mx);
            const float sc = __expf(mrun - mnew);
            mrun = mnew;
            float ps = 0.f; bf16x8 pf;
#pragma unroll
            for (int j = 0; j < 8; ++j) { const float pv = __expf(sv[j] - mnew); ps += pv; pf[j] = (short)f2bf(pv); }
            lrun = lrun * sc + ps;
#pragma unroll
            for (int dt = 0; dt < 4; ++dt) {
                O[dt][0] *= sc; O[dt][1] *= sc; O[dt][2] *= sc; O[dt][3] *= sc;
                bf16x8 vf;
                vf[0] = (short)(vlo[dt].x & 0xFFFF); vf[1] = (short)(vlo[dt].x >> 16); vf[2] = (short)(vlo[dt].y & 0xFFFF); vf[3] = (short)(vlo[dt].y >> 16);
                vf[4] = (short)(vhi[dt].x & 0xFFFF); vf[5] = (short)(vhi[dt].x >> 16); vf[6] = (short)(vhi[dt].y & 0xFFFF); vf[7] = (short)(vhi[dt].y >> 16);
                O[dt] = __builtin_amdgcn_mfma_f32_16x16x32_bf16(vf, pf, O[dt], 0, 0, 0);
            }
        };
        if (!isctx) {
            const int rs = min(max(r - 4, 0), 248);
            const int cb = (w == 0) ? 0 : (w == 1) ? 8 : (w == 2) ? 24 : 32;
            const int cs = min(max(c - 8, 0), 48);
            for (int i = 0; i < 8; ++i) {
                const int krow = rs + i;
                const size_t tokb = (size_t)CTXROWS + (size_t)b * LAT + krow * 64 + cb;
                const u16* kb0 = pqk + (tokb + fr) * 1024 + 512 + h * 64;
                const u16* kb1 = pqk + (tokb + 16 + fr) * 1024 + 512 + h * 64;
                const u16* vb = vtl + ((size_t)((b * 8 + h) * 64 + fr)) * LAT + krow * 64 + cb + 4 * g;
                const float* bias0 = rpbl + (krow - r + 7) * 31 - c + 15;
                chunk(kb0, kb1, vb, LAT, bias0, bias0, true, true, cb, cs);
            }
        }
        for (int cc = 0; cc < 8; ++cc) {
            const size_t tokb = (size_t)b * LCTX + cc * 32;
            const u16* kb0 = pqk + (tokb + fr) * 1024 + 512 + h * 64;
            const u16* kb1 = pqk + (tokb + 16 + fr) * 1024 + 512 + h * 64;
            const u16* vb = vtc + ((size_t)((b * 8 + h) * 64 + fr)) * LCTX + cc * 32 + 4 * g;
            chunk(kb0, kb1, vb, LCTX, nullptr, nullptr, false, false, 0, 0);
        }
        float lt = lrun; lt += __shfl_xor(lt, 16); lt += __shfl_xor(lt, 32);
        const float inv = 1.f / lt;
#pragma unroll
        for (int dt = 0; dt < 4; ++dt) {
            uint2 o;
            o.x = (unsigned)f2bf(O[dt][0] * inv) | ((unsigned)f2bf(O[dt][1] * inv) << 16);
            o.y = (unsigned)f2bf(O[dt][2] * inv) | ((unsigned)f2bf(O[dt][3] * inv) << 16);
            *(uint2*)(y + (size_t)qrow * 1024 + h * 64 + dt * 16 + 4 * g) = o;
        }
    }
}

DEVINL void ph_mlC(const P& p, int l, char* smem) {
    const int TIDX_ = tid_(); const int BIDX_ = bid_(); char* const WS_ = wsl_(p.ws); (void)TIDX_; (void)BIDX_; (void)WS_;
    const int tid = TIDX_;
    const u16* mlf = (const u16*)(WS_ + OFF_MLF);
    const u16* pc = (const u16*)(WS_ + OFF_PC);
    const float* mlg = (const float*)(WS_ + OFF_MLG);
    const float* mst = (const float*)(WS_ + OFF_MST);
    const float* nst = (const float*)(WS_ + OFF_NST);
    const float* cst = (const float*)(WS_ + OFF_HM);
    u16* y = (u16*)(WS_ + OFF_Y);
    u16* ql = (u16*)smem;
    u16* kl = ql + 4096;
    u16* vl = kl + 4096;
    float* Cl = (float*)(vl + 4096);
    float* Sl = Cl + 4096;
    float* btl = Sl + 4096;
    float* lil = btl + 64;
    float* nl = lil + 64;
    const int t = tid >> 2, q4 = tid & 3;
    for (int u = BIDX_; u < 2 * NTC; u += gridDim.x) {
        const int b = u / NTC, tc = u % NTC;
        if (tc < 4 && l != 0) continue;
        const int row0 = tc < 4 ? b * LCTX + tc * 64 : CTXROWS + b * LAT + (tc - 4) * 64;
        for (int h = 0; h < 4; ++h) {
            float hs[16];
#pragma unroll
            for (int i = 0; i < 16; ++i) hs[i] = 0.f;
            __syncthreads();
            for (int i = tid; i < 64 * 16; i += 256) {
                const int tok = i >> 4, c4 = (i & 15) * 4;
                *(uint2*)(ql + tok * 64 + c4) = *(const uint2*)(mlf + (size_t)(row0 + tok) * 512 + h * 64 + c4);
                *(uint2*)(kl + tok * 64 + c4) = *(const uint2*)(mlf + (size_t)(row0 + tok) * 512 + 256 + h * 64 + c4);
                *(uint2*)(vl + tok * 64 + c4) = *(const uint2*)(pc + (size_t)(row0 + tok) * 1040 + 512 + h * 64 + c4);
            }
            for (int d = 0; d < 2; ++d) {
                const int bhd = (b * 4 + h) * 2 + d;
                __syncthreads();
                for (int i = tid; i < 1024; i += 256) *(float4*)(Cl + i * 4) = *(const float4*)(cst + ((size_t)bhd * NTC + tc) * 4096 + i * 4);
                if (tid < 64) { nl[tid] = nst[((size_t)bhd * NTC + tc) * 64 + tid]; lil[tid] = mlg[(size_t)(row0 + tid) * 16 + d * 4 + h]; }
                if (tid == 64) {
                    float bacc = 0.f;
#pragma unroll 1
                    for (int jj = 0; jj < 64; ++jj) { const int tok = d ? 63 - jj : jj; bacc += mlg[(size_t)(row0 + tok) * 16 + 8 + d * 4 + h]; btl[tok] = bacc; }
                }
                __syncthreads();
                const float m0 = mst[bhd * NTC + tc];
                float sc[16];
#pragma unroll
                for (int i = 0; i < 16; ++i) sc[i] = 0.f;
                for (int dk = 0; dk < 64; dk += 4) {
                    const uint2 qq = *(const uint2*)(ql + t * 64 + dk);
                    const float q0 = bf2f((u16)(qq.x & 0xFFFF)), q1 = bf2f((u16)(qq.x >> 16)), q2 = bf2f((u16)(qq.y & 0xFFFF)), q3 = bf2f((u16)(qq.y >> 16));
#pragma unroll
                    for (int i = 0; i < 16; ++i) {
                        const uint2 kk = *(const uint2*)(kl + (q4 * 16 + i) * 64 + dk);
                        sc[i] += q0 * bf2f((u16)(kk.x & 0xFFFF)) + q1 * bf2f((u16)(kk.x >> 16)) + q2 * bf2f((u16)(kk.y & 0xFFFF)) + q3 * bf2f((u16)(kk.y >> 16));
                    }
                }
                const float bt = btl[t];
                float ld[16]; float mx = -3.0e38f;
#pragma unroll
                for (int i = 0; i < 16; ++i) {
                    const int s = q4 * 16 + i;
                    const bool ok = d ? (s >= t) : (s <= t);
                    ld[i] = ok ? (bt - btl[s] + lil[s]) : -3.0e38f;
                    mx = fmaxf(mx, ld[i]);
                }
                mx = fmaxf(mx, __shfl_xor(mx, 1)); mx = fmaxf(mx, __shfl_xor(mx, 2));
                const float mt = fmaxf(bt + m0, mx);
                float rsum = 0.f;
#pragma unroll
                for (int i = 0; i < 16; ++i) {
                    const int s = q4 * 16 + i;
                    const bool ok = d ? (s >= t) : (s <= t);
                    const float dw = ok ? expf(ld[i] - mt) * sc[i] : 0.f;
                    rsum += dw;
                    Sl[t * 64 + s] = dw;
                }
                rsum += __shfl_xor(rsum, 1); rsum += __shfl_xor(rsum, 2);
                const float inter = expf(bt + m0 - mt);
                float qn = 0.f;
                for (int dk = q4 * 16; dk < q4 * 16 + 16; ++dk) qn += bf2f(ql[t * 64 + dk]) * nl[dk];
                qn += __shfl_xor(qn, 1); qn += __shfl_xor(qn, 2);
                const float den = rsum + inter * qn;
                __syncthreads();
                float num[16];
#pragma unroll
                for (int i = 0; i < 16; ++i) num[i] = 0.f;
                for (int s = 0; s < 64; ++s) {
                    const float dw = Sl[t * 64 + s];
                    const uint4 va = *(const uint4*)(vl + s * 64 + q4 * 16);
                    const uint4 vb2 = *(const uint4*)(vl + s * 64 + q4 * 16 + 8);
                    const unsigned vv[8] = {va.x, va.y, va.z, va.w, vb2.x, vb2.y, vb2.z, vb2.w};
#pragma unroll
                    for (int i = 0; i < 8; ++i) { num[2 * i] += dw * bf2f((u16)(vv[i] & 0xFFFF)); num[2 * i + 1] += dw * bf2f((u16)(vv[i] >> 16)); }
                }
                for (int dk = 0; dk < 64; ++dk) {
                    const float qv = bf2f(ql[t * 64 + dk]) * inter;
#pragma unroll
                    for (int i = 0; i < 16; i += 4) {
                        const float4 cv = *(const float4*)(Cl + dk * 64 + q4 * 16 + i);
                        num[i] += qv * cv.x; num[i + 1] += qv * cv.y; num[i + 2] += qv * cv.z; num[i + 3] += qv * cv.w;
                    }
                }
                const float dn = 1.f / fmaxf(fabsf(den), expf(-mt));
#pragma unroll
                for (int i = 0; i < 16; ++i) hs[i] += num[i] * dn;
            }
            float s1 = 0.f;
#pragma unroll
            for (int i = 0; i < 16; ++i) s1 += hs[i];
            s1 += __shfl_xor(s1, 1); s1 += __shfl_xor(s1, 2);
            const float mu = s1 * (1.f / 64.f);
            float s2 = 0.f;
#pragma unroll
            for (int i = 0; i < 16; ++i) { const float dlt = hs[i] - mu; s2 += dlt * dlt; }
            s2 += __shfl_xor(s2, 1); s2 += __shfl_xor(s2, 2);
            const float rstd = rsqrtf(s2 * (1.f / 64.f) + 1e-6f);
            const int row = row0 + t;
#pragma unroll
            for (int i = 0; i < 16; i += 2) {
                const int cc = h * 64 + q4 * 16 + i;
                const float o0 = bf2f(pc[(size_t)row * 1040 + 768 + cc]), o1 = bf2f(pc[(size_t)row * 1040 + 768 + cc + 1]);
                const float y0 = (hs[i] - mu) * rstd * p.ml_nw[l * 256 + cc] * sigmoidf_(o0);
                const float y1 = (hs[i + 1] - mu) * rstd * p.ml_nw[l * 256 + cc + 1] * sigmoidf_(o1);
                *(unsigned*)(y + (size_t)row * 1024 + 768 + cc) = (unsigned)f2bf(y0) | ((unsigned)f2bf(y1) << 16);
            }
        }
    }
}

DEVINL void ph_rwout(const P& p, int l) {
    const int TIDX_ = tid_(); const int BIDX_ = bid_(); char* const WS_ = wsl_(p.ws); (void)TIDX_; (void)BIDX_; (void)WS_;
    const int tid = TIDX_, lane = tid & 63, h = tid >> 6;
    const u16* rwf = (const u16*)(WS_ + OFF_X1);
    const u16* yrw = (const u16*)(WS_ + OFF_PB);
    const u16* gate = (const u16*)(WS_ + OFF_GATE);
    u16* y = (u16*)(WS_ + OFF_Y);
    const float rk = p.rw_rk[l * 256 + tid], lw = p.rw_lnw[l * 256 + tid], lb = p.rw_lnb[l * 256 + tid];
    const int rstart = (l == 0) ? 0 : CTXROWS;
    for (int row = rstart + BIDX_; row < T; row += gridDim.x) {
        const float yv = bf2f(yrw[((size_t)row * 2 + 0) * 256 + tid]) + bf2f(yrw[((size_t)row * 2 + 1) * 256 + tid]);
        const u16* f = rwf + ((size_t)row * 4 + h) * 512;
        const float r = bf2f(f[lane]), k = bf2f(f[64 + lane]), v = bf2f(f[128 + lane]);
        const float mu = wsum(yv) * (1.f / 64.f);
        const float dl = yv - mu;
        const float var = wsum(dl * dl) * (1.f / 64.f);
        const float bonus = wsum(r * k * rk) * v;
        const float o = (dl * rsqrtf(var + 64e-5f) * lw + lb + bonus) * bf2f(gate[(size_t)row * 256 + tid]);
        y[(size_t)row * 1024 + 512 + tid] = f2bf(o);
    }
}
DEVINL void ph_outproj(const P& p, int l, char* smem) {
    const int TIDX_ = tid_(); const int BIDX_ = bid_(); char* const WS_ = wsl_(p.ws); (void)TIDX_; (void)BIDX_; (void)WS_;
    const u16* y = (const u16*)(WS_ + OFF_Y);
    const u16* wout = (const u16*)(WS_ + OFF_WOUT);
    const float* modv = (const float*)(WS_ + OFF_MOD) + (size_t)l * 3 * 6144;
    const float* x2c = (const float*)(WS_ + OFF_X2CTX);
    float* x1 = (float*)(WS_ + OFF_X1);
    const int mt0 = (l == 0) ? 0 : 4;
    const int ntile = (260 - mt0) * 8;
    for (int u = BIDX_; u < ntile; u += gridDim.x) {
        const int mt = mt0 + u / 8, nt = u % 8;
        const u16* A = y + (size_t)mt * 128 * 1024;
        const int R0 = mt * 128;
        const float* xin;
        if (l == 0) xin = R0 < CTXROWS ? p.ctx + (size_t)R0 * 1024 : p.x + (size_t)(R0 - CTXROWS) * 1024;
        else xin = R0 < CTXROWS ? x2c + (size_t)R0 * 1024 : p.out + (size_t)(R0 - CTXROWS) * 1024;
        const float* g1 = modv + row_sel(R0) * 6144 + 2048;
        gemm128([&](int r) { return A + (size_t)r * 1024; }, wout + (size_t)nt * 128 * 1024, 1024, 1024, smem,
                [&](int m, int n, f32x4 a) {
                    const int N = nt * 128 + n;
                    const float gg = g1[N];
#pragma unroll
                    for (int j = 0; j < 4; ++j) x1[(size_t)(R0 + m + j) * 1024 + N] = ALPHA * xin[(size_t)(m + j) * 1024 + N] + gg * a[j];
                });
    }
}

DEVINL void ph_ln1(const P& p, int l) {
    const int TIDX_ = tid_(); const int BIDX_ = bid_(); char* const WS_ = wsl_(p.ws); (void)TIDX_; (void)BIDX_; (void)WS_;
    const int lane = TIDX_ & 63, wid = TIDX_ >> 6;
    const float* modv = (const float*)(WS_ + OFF_MOD) + (size_t)l * 3 * 6144;
    float* x1 = (float*)(WS_ + OFF_X1);
    u16* hm = (u16*)(WS_ + OFF_HM);
    const int rstart = (l == 0) ? 0 : CTXROWS;
    for (int row = rstart + BIDX_ * 4 + wid; row < T; row += gridDim.x * 4) {
        float4 v[4];
        float s = 0.f;
#pragma unroll
        for (int i = 0; i < 4; ++i) { v[i] = *(const float4*)(x1 + (size_t)row * 1024 + i * 256 + lane * 4); s += v[i].x + v[i].y + v[i].z + v[i].w; }
        const float mu = wsum(s) * (1.f / 1024.f);
        float q = 0.f;
#pragma unroll
        for (int i = 0; i < 4; ++i) { v[i].x -= mu; v[i].y -= mu; v[i].z -= mu; v[i].w -= mu; q += v[i].x * v[i].x + v[i].y * v[i].y + v[i].z * v[i].z + v[i].w * v[i].w; }
        const float rstd = rsqrtf(wsum(q) * (1.f / 1024.f) + 1e-5f);
        const float* mv = modv + row_sel(row) * 6144;
#pragma unroll
        for (int i = 0; i < 4; ++i) {
            const int c = i * 256 + lane * 4;
            const float4 g = *(const float4*)(p.ln1g + l * 1024 + c), bb = *(const float4*)(p.ln1b + l * 1024 + c);
            const float4 sh = *(const float4*)(mv + 3072 + c), sc = *(const float4*)(mv + 4096 + c);
            float4 o;
            o.x = v[i].x * rstd * g.x + bb.x; o.y = v[i].y * rstd * g.y + bb.y; o.z = v[i].z * rstd * g.z + bb.z; o.w = v[i].w * rstd * g.w + bb.w;
            *(float4*)(x1 + (size_t)row * 1024 + c) = o;
            uint2 hh;
            hh.x = (unsigned)f2bf(o.x * (1.f + sc.x) + sh.x) | ((unsigned)f2bf(o.y * (1.f + sc.y) + sh.y) << 16);
            hh.y = (unsigned)f2bf(o.z * (1.f + sc.z) + sh.z) | ((unsigned)f2bf(o.w * (1.f + sc.w) + sh.w) << 16);
            *(uint2*)(hm + (size_t)row * 1024 + c) = hh;
        }
    }
}

DEVINL void ph_router(const P& p, int l, char* smem) {
    const int TIDX_ = tid_(); const int BIDX_ = bid_(); char* const WS_ = wsl_(p.ws); (void)TIDX_; (void)BIDX_; (void)WS_;
    const u16* hm = (const u16*)(WS_ + OFF_HM);
    const u16* wr = (const u16*)(WS_ + OFF_WR) + (size_t)l * 128 * 1024;
    float* lg = (float*)(WS_ + OFF_LOGITS);
    const int mt0 = (l == 0) ? 0 : 4;
    for (int u = BIDX_; u < 260 - mt0; u += gridDim.x) {
        const int mt = mt0 + u;
        const u16* A = hm + (size_t)mt * 128 * 1024;
        gemm128([&](int r) { return A + (size_t)r * 1024; }, wr, 1024, 1024, smem,
                [&](int m, int n, f32x4 a) {
                    if (n < 36) {
#pragma unroll
                        for (int j = 0; j < 4; ++j) lg[(size_t)(mt * 128 + m + j) * 64 + n] = a[j];
                    }
                });
    }
}

DEVINL void ph_route1(const P& p, int l, char* smem) {
    const int TIDX_ = tid_(); const int BIDX_ = bid_(); char* const WS_ = wsl_(p.ws); (void)TIDX_; (void)BIDX_; (void)WS_;
    const int tid = TIDX_;
    const float* lg = (const float*)(WS_ + OFF_LOGITS);
    int* toke = (int*)(WS_ + OFF_TOKE); float* tokw = (float*)(WS_ + OFF_TOKW);
    int* cnt = (int*)(WS_ + CTL_CNT) + l * 32;
    int* hist = (int*)smem;
    __syncthreads();
    if (tid < 32) hist[tid] = 0;
    __syncthreads();
    const int rstart = (l == 0) ? 0 : CTXROWS;
    for (int row = rstart + BIDX_ * 256 + tid; row < T; row += gridDim.x * 256) {
        const float* q = lg + (size_t)row * 64;
        float gl[4]; int gs = 0; float gm = -3.0e38f;
#pragma unroll
        for (int i = 0; i < 4; ++i) { gl[i] = q[i] + p.rgb[l * 4 + i]; if (gl[i] > gm) { gm = gl[i]; gs = i; } }
        float se = 0.f;
#pragma unroll
        for (int i = 0; i < 4; ++i) se += expf(gl[i] - gm);
        const float gw = 1.f / se;
        float v1 = -3.0e38f, v2 = -3.0e38f; int i1 = 0, i2 = 0;
#pragma unroll
        for (int i = 0; i < 8; ++i) {
            const float e = q[4 + gs * 8 + i] + p.reb[l * 32 + gs * 8 + i];
            if (e > v1) { v2 = v1; i2 = i1; v1 = e; i1 = i; }
            else if (e > v2) { v2 = e; i2 = i; }
        }
        const float e2 = expf(v2 - v1);
        const float w1 = gw / (1.f + e2), w2 = gw * e2 / (1.f + e2);
        const int ea = gs * 8 + i1, eb = gs * 8 + i2;
        toke[row * 2] = ea; toke[row * 2 + 1] = eb; tokw[row * 2] = w1; tokw[row * 2 + 1] = w2;
        atomicAdd(&hist[ea], 1); atomicAdd(&hist[eb], 1);
    }
    __syncthreads();
    if (tid < 32 && hist[tid] > 0) atomicAdd(&cnt[tid], hist[tid]);
}

DEVINL void ph_route2(const P& p, int l, char* smem) {
    const int TIDX_ = tid_(); const int BIDX_ = bid_(); char* const WS_ = wsl_(p.ws); (void)TIDX_; (void)BIDX_; (void)WS_;
    const int tid = TIDX_;
    const int* toke = (const int*)(WS_ + OFF_TOKE);
    int* toks = (int*)(WS_ + OFF_TOKS);
    int* slottok = (int*)(WS_ + OFF_SLOTTOK);
    const int* cnt = (const int*)(WS_ + CTL_CNT) + l * 32;
    int* cur = (int*)(WS_ + CTL_CUR) + l * 32;
    int* tiles = (int*)(WS_ + OFF_TILES);
    int* off = (int*)smem;
    int* hist = off + 64;
    int* base = hist + 32;
    __syncthreads();
    if (tid == 0) { int a = 0; for (int e = 0; e < 32; ++e) { off[e] = a; a += (cnt[e] + 127) & ~127; } off[32] = a; }
    if (tid < 32) hist[tid] = 0;
    __syncthreads();
    if (BIDX_ == 0) {
        if (tid == 0) {
            int nt = 0;
            for (int e = 0; e < 32; ++e) for (int s = off[e]; s < off[e + 1]; s += 128) { tiles[64 + nt * 2] = e; tiles[64 + nt * 2 + 1] = s; ++nt; }
            tiles[40] = nt;
        }
        for (int e = 0; e < 32; ++e) for (int s = off[e] + cnt[e] + tid; s < off[e + 1]; s += 256) slottok[s] = (l == 0) ? 0 : CTXROWS;
    }
    const int rstart = (l == 0) ? 0 : CTXROWS;
    for (int a0 = rstart * 2 + BIDX_ * 256; a0 < T * 2; a0 += gridDim.x * 256) {
        const int a = a0 + tid;
        int e = -1, lpos = 0;
        if (a < T * 2) { e = toke[a]; lpos = atomicAdd(&hist[e], 1); }
        __syncthreads();
        if (tid < 32) { base[tid] = hist[tid] > 0 ? atomicAdd(&cur[tid], hist[tid]) : 0; }
        __syncthreads();
        if (e >= 0) { const int s = off[e] + base[e] + lpos; toks[a] = s; slottok[s] = a >> 1; }
        __syncthreads();
        if (tid < 32) hist[tid] = 0;
        __syncthreads();
    }
}

DEVINL void ph_gateup(const P& p, char* smem) {
    const int TIDX_ = tid_(); const int BIDX_ = bid_(); char* const WS_ = wsl_(p.ws); (void)TIDX_; (void)BIDX_; (void)WS_;
    const int tid = TIDX_, lane = tid & 63, wid = tid >> 6, wr = wid >> 1, wc = wid & 1, fr = lane & 15, fq = lane >> 4;
    const u16* hm = (const u16*)(WS_ + OFF_HM);
    const u16* wgu = (const u16*)(WS_ + OFF_WGU);
    const int* tiles = (const int*)(WS_ + OFF_TILES);
    const int* slottok = (const int*)(WS_ + OFF_SLOTTOK);
    u16* act = (u16*)(WS_ + OFF_ACT);
    const int ntile = tiles[40] * 8;
    for (int u = BIDX_; u < ntile; u += gridDim.x) {
        const int ti = u >> 3, nt = u & 7;
        const int e = tiles[64 + ti * 2], s0 = tiles[64 + ti * 2 + 1];
        f32x4 acc[4][4];
        gemm128_acc([&](int r) { return hm + (size_t)slottok[s0 + r] * 1024; }, wgu + ((size_t)e * 1024 + nt * 128) * 1024, 1024, 1024, smem, acc);
#pragma unroll
        for (int m = 0; m < 4; ++m)
#pragma unroll
            for (int n = 0; n < 4; n += 2) {
                const int jcol = (nt * 128 + wc * 64 + n * 16) / 2 + fr;
                const int srow = s0 + wr * 64 + m * 16 + fq * 4;
#pragma unroll
                for (int j = 0; j < 4; ++j) {
                    const float gte = acc[m][n][j], up = acc[m][n + 1][j];
                    act[(size_t)(srow + j) * 512 + jcol] = f2bf(gte / (1.f + __expf(-gte)) * up);
                }
            }
    }
}

DEVINL void ph_down(const P& p, char* smem) {
    const int TIDX_ = tid_(); const int BIDX_ = bid_(); char* const WS_ = wsl_(p.ws); (void)TIDX_; (void)BIDX_; (void)WS_;
    const u16* act = (const u16*)(WS_ + OFF_ACT);
    const u16* wdn = (const u16*)(WS_ + OFF_WDN);
    const int* tiles = (const int*)(WS_ + OFF_TILES);
    u16* so = (u16*)(WS_ + OFF_SLOTOUT);
    const int ntile = tiles[40] * 8;
    for (int u = BIDX_; u < ntile; u += gridDim.x) {
        const int ti = u >> 3, nt = u & 7;
        const int e = tiles[64 + ti * 2], s0 = tiles[64 + ti * 2 + 1];
        const u16* A = act + (size_t)s0 * 512;
        gemm128([&](int r) { return A + (size_t)r * 512; }, wdn + ((size_t)e * 1024 + nt * 128) * 512, 512, 512, smem,
                [&](int m, int n, f32x4 a) {
                    u16* q = so + (size_t)(s0 + m) * 1024 + nt * 128 + n;
                    q[0] = f2bf(a[0]); q[1024] = f2bf(a[1]); q[2048] = f2bf(a[2]); q[3072] = f2bf(a[3]);
                });
    }
}

DEVINL void ph_ln2(const P& p, int l) {
    const int TIDX_ = tid_(); const int BIDX_ = bid_(); char* const WS_ = wsl_(p.ws); (void)TIDX_; (void)BIDX_; (void)WS_;
    const int lane = TIDX_ & 63, wid = TIDX_ >> 6;
    const float* modv = (const float*)(WS_ + OFF_MOD) + (size_t)l * 3 * 6144;
    const float* modn = (const float*)(WS_ + OFF_MOD) + (size_t)(l + 1) * 3 * 6144;
    const float* x1 = (const float*)(WS_ + OFF_X1);
    const u16* so = (const u16*)(WS_ + OFF_SLOTOUT);
    const int* toks = (const int*)(WS_ + OFF_TOKS);
    const float* tokw = (const float*)(WS_ + OFF_TOKW);
    float* x2c = (float*)(WS_ + OFF_X2CTX);
    u16* hm = (u16*)(WS_ + OFF_HM);
    const int rstart = (l == 0) ? 0 : CTXROWS;
    for (int row = rstart + BIDX_ * 4 + wid; row < T; row += gridDim.x * 4) {
        const int sa = toks[row * 2], sb = toks[row * 2 + 1];
        const float wa = tokw[row * 2], wb = tokw[row * 2 + 1];
        const float* mv = modv + row_sel(row) * 6144;
        float4 v[4];
        float s = 0.f;
#pragma unroll
        for (int i = 0; i < 4; ++i) {
            const int c = i * 256 + lane * 4;
            const float4 xv = *(const float4*)(x1 + (size_t)row * 1024 + c);
            const uint2 ua = *(const uint2*)(so + (size_t)sa * 1024 + c), ub = *(const uint2*)(so + (size_t)sb * 1024 + c);
            const float4 g2 = *(const float4*)(mv + 5120 + c);
            const float f0 = wa * bf2f((u16)(ua.x & 0xFFFF)) + wb * bf2f((u16)(ub.x & 0xFFFF));
            const float f1 = wa * bf2f((u16)(ua.x >> 16)) + wb * bf2f((u16)(ub.x >> 16));
            const float f2 = wa * bf2f((u16)(ua.y & 0xFFFF)) + wb * bf2f((u16)(ub.y & 0xFFFF));
            const float f3 = wa * bf2f((u16)(ua.y >> 16)) + wb * bf2f((u16)(ub.y >> 16));
            v[i].x = ALPHA * xv.x + g2.x * f0; v[i].y = ALPHA * xv.y + g2.y * f1; v[i].z = ALPHA * xv.z + g2.z * f2; v[i].w = ALPHA * xv.w + g2.w * f3;
            s += v[i].x + v[i].y + v[i].z + v[i].w;
        }
        const float mu = wsum(s) * (1.f / 1024.f);
        float q = 0.f;
#pragma unroll
        for (int i = 0; i < 4; ++i) { v[i].x -= mu; v[i].y -= mu; v[i].z -= mu; v[i].w -= mu; q += v[i].x * v[i].x + v[i].y * v[i].y + v[i].z * v[i].z + v[i].w * v[i].w; }
        const float rstd = rsqrtf(wsum(q) * (1.f / 1024.f) + 1e-5f);
        float* dst = row < CTXROWS ? x2c + (size_t)row * 1024 : p.out + (size_t)(row - CTXROWS) * 1024;
        const float* mn = modn + row_sel(row) * 6144;
#pragma unroll
        for (int i = 0; i < 4; ++i) {
            const int c = i * 256 + lane * 4;
            const float4 g = *(const float4*)(p.ln2g + l * 1024 + c), bb = *(const float4*)(p.ln2b + l * 1024 + c);
            float4 o;
            o.x = v[i].x * rstd * g.x + bb.x; o.y = v[i].y * rstd * g.y + bb.y; o.z = v[i].z * rstd * g.z + bb.z; o.w = v[i].w * rstd * g.w + bb.w;
            *(float4*)(dst + c) = o;
            if (l == 0) {
                const float4 sh = *(const float4*)(mn + c), sc = *(const float4*)(mn + 1024 + c);
                uint2 hh;
                hh.x = (unsigned)f2bf(o.x * (1.f + sc.x) + sh.x) | ((unsigned)f2bf(o.y * (1.f + sc.y) + sh.y) << 16);
                hh.y = (unsigned)f2bf(o.z * (1.f + sc.z) + sh.z) | ((unsigned)f2bf(o.w * (1.f + sc.w) + sh.w) << 16);
                *(uint2*)(hm + (size_t)row * 1024 + c) = hh;
            }
        }
    }
}

DEVINL void gbar(XcdBarrier b) {
    unsigned x = b.x; GAS unsigned* q = (GAS unsigned*)b.bar;
    asm volatile("" : "+s"(x), "+s"(q));
    b.x = x; b.bar = (unsigned*)q;
    xcd_barrier(b);
}
__global__ void __launch_bounds__(256, 2) k_mega(P p) {
    __shared__ __attribute__((aligned(16))) char smem[65536];
    __shared__ uint4 xb_words;
    if (threadIdx.x == 0) xb_words = make_uint4(0u, 0u, 0u, 0u);
    __syncthreads();
    XcdBarrier bar = xcd_barrier_post((unsigned*)p.ws, (volatile LAS unsigned*)&xb_words);
    const int bid = blockIdx.x, nb = gridDim.x;
    ph_prolog(p, smem);
    ph_convw(p, 0, smem);
    gbar(bar);
    ph_xm0(p);
    gbar(bar);
#pragma unroll 1
    for (int l = 0; l < NLAYER; ++l) {
        ph_inproj(p, smem);
        gbar(bar);
        ph_prep(p, l, smem);
        gbar(bar);
        {
            const int nscan = nb >= 512 ? 256 : nb / 2;
            if (bid < nscan) ph_scan(p, l, bid, nscan);
            else { ph_mlB(p, bid - nscan, nb - nscan); ph_na(p, l, smem, bid - nscan, nb - nscan); }
        }
        gbar(bar);
        ph_mlC(p, l, smem);
        ph_rwout(p, l);
        gbar(bar);
        ph_outproj(p, l, smem);
        ph_convexp(p, l, smem);
        gbar(bar);
        ph_ln1(p, l);
        gbar(bar);
        ph_router(p, l, smem);
        gbar(bar);
        ph_route1(p, l, smem);
        gbar(bar);
        ph_route2(p, l, smem);
        gbar(bar);
        ph_gateup(p, smem);
        gbar(bar);
        ph_down(p, smem);
        gbar(bar);
        ph_ln2(p, l);
        if (l + 1 < NLAYER) ph_convw(p, l + 1, smem);
        gbar(bar);
    }
}

extern "C" void kernel_launch(void* const* d_in, const int* in_sizes, int n_in, void* d_out, int out_size, void* d_ws, size_t ws_size,
                              hipStream_t stream) {
    if (n_in != 37 || ws_size < WS_NEED) { fprintf(stderr, "kernel_launch: n_in %d ws %zu need %zu\n", n_in, ws_size, (size_t)WS_NEED); return; }
    static int grid = 0;
    if (!grid) {
        int dev = 0, cus = 0, per_cu = 0;
        (void)hipGetDevice(&dev);
        (void)hipDeviceGetAttribute(&cus, hipDeviceAttributeMultiprocessorCount, dev);
        (void)hipOccupancyMaxActiveBlocksPerMultiprocessor(&per_cu, (const void*)k_mega, 256, 0);
        if (per_cu < 1) per_cu = 1;
        grid = cus * (per_cu < 2 ? per_cu : 2);
    }
    P p{};
    const float** pp = (const float**)&p;
    for (int i = 0; i < 37; ++i) pp[i] = (const float*)d_in[i];
    p.out = (float*)d_out; p.ws = (char*)d_ws;
    (void)hipMemsetAsync(d_ws, 0, CTL_BYTES, stream);
    k_mega<<<dim3(grid), dim3(256), 0, stream>>>(p);
}
```

```cpp
#include <hip/hip_runtime.h>
#include <hip/hip_bf16.h>
#include <stdint.h>
#include <stdio.h>

#define DEVINL __device__ __forceinline__
typedef unsigned short u16;
using bf16x8 = __attribute__((ext_vector_type(8))) short;
using f32x4 = __attribute__((ext_vector_type(4))) float;

constexpr int D = 1024, LAT = 16384, LCTX = 256, T = 33280, CTXROWS = 512;
constexpr int INP = 3536;
constexpr int NLAYER = 2;
constexpr float ALPHA = 1.41421356237309515f;
constexpr int NUNIT_CH = 520;
constexpr int NTC = 260;
constexpr int MAXSLOT = 70656;

constexpr size_t al(size_t x) { return (x + 255) & ~(size_t)255; }
constexpr size_t CTL_CNT = 16384;
constexpr size_t CTL_CUR = CTL_CNT + 256;
constexpr size_t CTL_BYTES = 32768;
constexpr size_t OFF_MOD = CTL_BYTES;
constexpr size_t OFF_ROPE = OFF_MOD + al(2 * 3 * 6144 * 4);
constexpr size_t OFF_WR = OFF_ROPE + al(10240 * 4);
constexpr size_t OFF_LORA = OFF_WR + al(2 * 128 * 1024 * 2);
constexpr size_t OFF_TILES = OFF_LORA + al(3 * 65536);
constexpr size_t OFF_TOKE = OFF_TILES + al((64 + 2048) * 4);
constexpr size_t OFF_TOKW = OFF_TOKE + al((size_t)T * 2 * 4);
constexpr size_t OFF_TOKS = OFF_TOKW + al((size_t)T * 2 * 4);
constexpr size_t OFF_SLOTTOK = OFF_TOKS + al((size_t)T * 2 * 4);
constexpr size_t OFF_X2CTX = OFF_SLOTTOK + al((size_t)MAXSLOT * 4);
constexpr size_t OFF_WIN = OFF_X2CTX + al((size_t)512 * 1024 * 4);
constexpr size_t OFF_WOUT = OFF_WIN + al((size_t)3584 * 1024 * 2);
constexpr size_t OFF_X1 = OFF_WOUT + al((size_t)1024 * 1024 * 2);
constexpr size_t OFF_HM = OFF_X1 + al((size_t)T * 1024 * 4);
constexpr size_t OFF_P = OFF_HM + al((size_t)T * 1024 * 2);
constexpr size_t OFF_PQK = OFF_P;
constexpr size_t OFF_VTL = OFF_PQK + (size_t)T * 1024 * 2;
constexpr size_t OFF_VTC = OFF_VTL + (size_t)2 * 8 * 64 * 16384 * 2;
constexpr size_t OFF_PB = OFF_VTC + (size_t)2 * 8 * 64 * 256 * 2;
constexpr size_t OFF_PC = OFF_PB + (size_t)T * 960 * 2;
constexpr size_t OFF_Y = OFF_PC + (size_t)T * 1040 * 2;
constexpr size_t OFF_MLF = OFF_Y + (size_t)T * 1024 * 2;
constexpr size_t OFF_GATE = OFF_MLF + (size_t)T * 512 * 2;
constexpr size_t OFF_MLG = OFF_GATE + (size_t)T * 256 * 2;
constexpr size_t OFF_MLS = OFF_MLG + (size_t)T * 16 * 4;
constexpr size_t OFF_MST = OFF_MLS + al(16 * 260 * 2 * 4);
constexpr size_t OFF_NST = OFF_MST + al(16 * 260 * 4);
constexpr size_t OFF_END1 = OFF_NST + al(16 * 260 * 64 * 4);
constexpr size_t OFF_WGU = OFF_P;
constexpr size_t OFF_WDN = OFF_WGU + (size_t)32 * 1024 * 1024 * 2;
constexpr size_t OFF_ACT = OFF_WDN + (size_t)32 * 1024 * 512 * 2;
constexpr size_t OFF_SLOTOUT = OFF_ACT + (size_t)MAXSLOT * 512 * 2;
constexpr size_t OFF_LOGITS = OFF_SLOTOUT + (size_t)MAXSLOT * 1024 * 2;
constexpr size_t OFF_END2 = OFF_LOGITS + (size_t)T * 64 * 4;
constexpr size_t WS_NEED = OFF_END1 > OFF_END2 ? OFF_END1 : OFF_END2;
static_assert(OFF_WDN <= OFF_Y, "Wexp must not overlap y");
static_assert(OFF_LOGITS >= OFF_MLF, "logits placement");

struct P {
    const float *x, *c, *ctx, *c_ctx, *w_mod, *b_mod, *w_in, *na_rpb, *mu_prev, *mu_next, *rw_w0, *rw_w2, *rw_a0, *rw_a2,
        *rw_g2, *rw_kk, *rw_ka, *rw_rk, *rw_lnw, *rw_lnb, *ml_cw, *ml_cb, *ml_ib, *ml_fb, *ml_nw, *w_out, *ln1g, *ln1b,
        *rgw, *rgb, *rew, *reb, *egate, *eup, *edown, *ln2g, *ln2b;
    float* out;
    char* ws;
};

#define XB_TMO      128
#define XB_XCNT(j)  (256  + 64 * (j))
#define XB_XSUB(j)  (1280 + 64 * (j))
#define XB_XGEN(j)  (2304 + 64 * (j))
#define XB_TOP      3328
#define XB_TOPGEN   3392
#define XCD_BAR_WORDS 3456
#define XB_SPIN_CAP (1u << 18)
#define LAS __attribute__((address_space(3)))

__device__ __forceinline__ unsigned xb_ld(unsigned* p)              { return __hip_atomic_load(p, __ATOMIC_RELAXED, __HIP_MEMORY_SCOPE_AGENT); }
__device__ __forceinline__ unsigned xb_add(unsigned* p, unsigned v) { return __hip_atomic_fetch_add(p, v, __ATOMIC_RELAXED, __HIP_MEMORY_SCOPE_AGENT); }
__device__ __forceinline__ unsigned xb_xcc_id() { return (unsigned)__builtin_amdgcn_s_getreg((3 << 11) | 20) & 0xFu; }
#define XB_SPIN(cond, bar) do { unsigned _sp = 0; while (cond) { __builtin_amdgcn_s_sleep(1); \
    if ((++_sp & 255u) == 0u) { if (xb_ld(&(bar)[XB_TMO])) break; if (_sp > XB_SPIN_CAP) { atomicAdd(&(bar)[XB_TMO], 1u); break; } } } } while (0)

struct XcdBarrier {
    unsigned* bar; unsigned x;
    volatile LAS unsigned* st;
};

__device__ __forceinline__ XcdBarrier xcd_barrier_post(unsigned* bar, volatile LAS unsigned* st) {
    XcdBarrier b; b.bar = bar; b.x = xb_xcc_id(); b.st = st;
    if (threadIdx.x == 0) (void)xb_add(&bar[XB_XCNT(b.x)], 1u);
    return b;
}
__device__ __forceinline__ void xcd_barrier_complete(unsigned* bar, unsigned x, unsigned& nloc, unsigned& nx) {
    const unsigned G = gridDim.x * gridDim.y * gridDim.z;
    unsigned sum, cnt, mine, sp = 0u;
    for (;;) {
        sum = 0u; cnt = 0u; mine = 0u;
#pragma unroll
        for (unsigned j = 0; j < 16; ++j) { const unsigned c = xb_ld(&bar[XB_XCNT(j)]); sum += c; cnt += (c > 0u) ? 1u : 0u; mine = (j == x) ? c : mine; }
        if (sum == G) break;
        __builtin_amdgcn_s_sleep(1);
        if ((++sp & 255u) == 0u) { if (xb_ld(&bar[XB_TMO])) break; if (sp > XB_SPIN_CAP) { atomicAdd(&bar[XB_TMO], 1u); break; } }
    }
    nloc = mine > 0u ? mine : 1u; nx = cnt > 0u ? cnt : 1u;
}

__device__ __forceinline__ void xcd_barrier(const XcdBarrier& b) {
    asm volatile("s_waitcnt vmcnt(0)" ::: "memory");
    __syncthreads();
    if (threadIdx.x == 0) {
        unsigned* bar = b.bar;
        __builtin_amdgcn_s_waitcnt(0);
        unsigned nloc = b.st[0], nx = b.st[1];
        if (nloc == 0u) { xcd_barrier_complete(bar, b.x, nloc, nx); b.st[0] = nloc; b.st[1] = nx; }
        const unsigned old = xb_add(&bar[XB_XSUB(b.x)], 1u);
        const unsigned gen = old / nloc;
        if (old + 1u == (gen + 1u) * nloc) {
            __builtin_amdgcn_fence(__ATOMIC_RELEASE, "agent");
            asm volatile("s_waitcnt vmcnt(0)" ::: "memory");
            const unsigned og = xb_add(&bar[XB_TOP], 1u);
            const unsigned tg = og / nx;
            if (og + 1u == (tg + 1u) * nx) xb_add(&bar[XB_TOPGEN], 1u);
            else XB_SPIN(xb_ld(&bar[XB_TOPGEN]) == tg, bar);
            __builtin_amdgcn_fence(__ATOMIC_ACQUIRE, "agent");
            xb_add(&bar[XB_XGEN(b.x)], 1u);
            asm volatile("s_waitcnt vmcnt(0)" ::: "memory");
        } else {
            XB_SPIN(xb_ld(&bar[XB_XGEN(b.x)]) == gen, bar);
            __builtin_amdgcn_fence(__ATOMIC_ACQUIRE, "agent");
            asm volatile("s_waitcnt vmcnt(0)" ::: "memory");
        }
    }
    __syncthreads();
}


DEVINL int tid_() { int t = threadIdx.x; asm volatile("" : "+v"(t)); return t; }
DEVINL int bid_() { int b = blockIdx.x; asm volatile("" : "+s"(b)); return b; }
#define GAS __attribute__((address_space(1)))
DEVINL char* wsl_(char* w) { GAS char* g = (GAS char*)w; asm volatile("" : "+s"(g)); return (char*)g; }
template <class Tp> DEVINL const Tp* gl_(const Tp* q) { const GAS Tp* g = (const GAS Tp*)q; asm volatile("" : "+s"(g)); return (const Tp*)g; }
DEVINL u16 f2bf(float f) { unsigned u = __float_as_uint(f); u += 0x7FFFu + ((u >> 16) & 1u); return (u16)(u >> 16); }
DEVINL float bf2f(u16 h) { return __uint_as_float(((unsigned)h) << 16); }
DEVINL float wsum(float v) { for (int o = 32; o > 0; o >>= 1) v += __shfl_xor(v, o); return v; }
DEVINL float sigmoidf_(float x) { return 1.f / (1.f + __expf(-x)); }
DEVINL float siluf_(float x) { return x / (1.f + __expf(-x)); }
DEVINL float softplusf_(float x) { return fmaxf(x, 0.f) + log1pf(__expf(-fabsf(x))); }
DEVINL int row_sel(int row) { return row < CTXROWS ? 2 : ((row - CTXROWS) >> 14); }
template <int CTRL, int RM>
DEVINL float dpp_f(float v) { return __int_as_float(__builtin_amdgcn_update_dpp(0, __float_as_int(v), CTRL, RM, 0xF, false)); }
DEVINL float wave_sum_dpp(float v) {
    v += dpp_f<0xB1, 0xF>(v);
    v += dpp_f<0x4E, 0xF>(v);
    v += dpp_f<0x141, 0xF>(v);
    v += dpp_f<0x140, 0xF>(v);
    v += dpp_f<0x142, 0xA>(v);
    v += dpp_f<0x143, 0xC>(v);
    return __int_as_float(__builtin_amdgcn_readlane(__float_as_int(v), 63));
}
DEVINL void glds16(const void* g, void* l) {
    __builtin_amdgcn_global_load_lds((const __attribute__((address_space(1))) void*)g, (__attribute__((address_space(3))) void*)l, 16, 0, 0);
}

template <class RowA>
DEVINL void gemm128_acc(RowA rowA, const u16* __restrict__ Bt, int ldb, int K, char* smem, f32x4 (&acc)[4][4]) {
    const int tid = tid_(), lane = tid & 63, wid = tid >> 6, wr = wid >> 1, wc = wid & 1, fr = lane & 15, fq = lane >> 4;
#pragma unroll
    for (int m = 0; m < 4; ++m)
#pragma unroll
        for (int n = 0; n < 4; ++n) acc[m][n] = f32x4{0.f, 0.f, 0.f, 0.f};
    const u16* aS0 = rowA(tid >> 2) + (tid & 3) * 8;
    const u16* aS1 = rowA((tid >> 2) + 64) + (tid & 3) * 8;
    const u16* bS0 = Bt + (size_t)(tid >> 2) * ldb + (tid & 3) * 8;
    const u16* bS1 = Bt + (size_t)((tid >> 2) + 64) * ldb + (tid & 3) * 8;
    const int nt = K >> 5;
    __syncthreads();
    {
        char* SA = smem; char* SB = smem + 8192;
        glds16(aS0, SA + tid * 16); glds16(aS1, SA + tid * 16 + 4096);
        glds16(bS0, SB + tid * 16); glds16(bS1, SB + tid * 16 + 4096);
    }
    for (int t = 0; t < nt; ++t) {
        asm volatile("s_waitcnt vmcnt(0)" ::: "memory");
        __builtin_amdgcn_s_barrier();
        if (t + 1 < nt) {
            char* SA = smem + ((t + 1) & 1) * 16384; char* SB = SA + 8192;
            const int ko = (t + 1) * 32;
            glds16(aS0 + ko, SA + tid * 16); glds16(aS1 + ko, SA + tid * 16 + 4096);
            glds16(bS0 + ko, SB + tid * 16); glds16(bS1 + ko, SB + tid * 16 + 4096);
        }
        const char* SA = smem + (t & 1) * 16384; const char* SB = SA + 8192;
        bf16x8 af[4], bfr[4];
#pragma unroll
        for (int m = 0; m < 4; ++m) af[m] = *(const bf16x8*)(SA + (wr * 64 + m * 16 + fr) * 64 + fq * 16);
#pragma unroll
        for (int n = 0; n < 4; ++n) bfr[n] = *(const bf16x8*)(SB + (wc * 64 + n * 16 + fr) * 64 + fq * 16);
#pragma unroll
        for (int m = 0; m < 4; ++m)
#pragma unroll
            for (int n = 0; n < 4; ++n) acc[m][n] = __builtin_amdgcn_mfma_f32_16x16x32_bf16(af[m], bfr[n], acc[m][n], 0, 0, 0);
    }
}
template <class RowA, class Epi>
DEVINL void gemm128(RowA rowA, const u16* __restrict__ Bt, int ldb, int K, char* smem, Epi epi) {
    const int tid = tid_(), lane = tid & 63, wid = tid >> 6, wr = wid >> 1, wc = wid & 1, fr = lane & 15, fq = lane >> 4;
    f32x4 acc[4][4];
    gemm128_acc(rowA, Bt, ldb, K, smem, acc);
#pragma unroll
    for (int m = 0; m < 4; ++m)
#pragma unroll
        for (int n = 0; n < 4; ++n) epi(wr * 64 + m * 16 + fq * 4, wc * 64 + n * 16 + fr, acc[m][n]);
}

DEVINL void ph_prolog(const P& p, char* smem) {
    const int TIDX_ = tid_(); const int BIDX_ = bid_(); char* const WS_ = wsl_(p.ws); (void)TIDX_; (void)BIDX_; (void)WS_;
    const int tid = TIDX_;
    float* modv = (float*)(WS_ + OFF_MOD);
    float* sil = (float*)smem;
    float* red = sil + 3072;
    bool ready = false;
    for (int u = BIDX_; u < 192; u += gridDim.x) {
        if (!ready) {
            for (int i = tid; i < 3072; i += 256) { int v = i >> 10, k = i & 1023; float cv = v < 2 ? p.c[v * 1024 + k] : p.c_ctx[k]; sil[i] = cv / (1.f + expf(-cv)); }
            ready = true;
        }
        __syncthreads();
        const int l = u / 96, cg = u % 96;
        const float* W = p.w_mod + (size_t)l * 1024 * 6144 + cg * 64;
        const int c4 = (tid & 15) * 4, rg = tid >> 4;
        float a0[4] = {0, 0, 0, 0}, a1[4] = {0, 0, 0, 0}, a2[4] = {0, 0, 0, 0};
#pragma unroll 4
        for (int i = 0; i < 64; ++i) {
            const int k = rg + 16 * i;
            const float4 w = *(const float4*)(W + (size_t)k * 6144 + c4);
            const float s0 = sil[k], s1 = sil[1024 + k], s2 = sil[2048 + k];
            a0[0] += s0 * w.x; a0[1] += s0 * w.y; a0[2] += s0 * w.z; a0[3] += s0 * w.w;
            a1[0] += s1 * w.x; a1[1] += s1 * w.y; a1[2] += s1 * w.z; a1[3] += s1 * w.w;
            a2[0] += s2 * w.x; a2[1] += s2 * w.y; a2[2] += s2 * w.z; a2[3] += s2 * w.w;
        }
#pragma unroll
        for (int j = 0; j < 4; ++j) { red[(rg * 3 + 0) * 64 + c4 + j] = a0[j]; red[(rg * 3 + 1) * 64 + c4 + j] = a1[j]; red[(rg * 3 + 2) * 64 + c4 + j] = a2[j]; }
        __syncthreads();
        if (tid < 192) {
            const int v = tid >> 6, cc = tid & 63;
            float s = 0.f;
            for (int r = 0; r < 16; ++r) s += red[(r * 3 + v) * 64 + cc];
            const int col = cg * 64 + cc;
            modv[(l * 3 + v) * 6144 + col] = s + p.b_mod[l * 6144 + col];
        }
        __syncthreads();
    }
    float* rope = (float*)(WS_ + OFF_ROPE);
    for (int i = BIDX_ * 256 + tid; i < 320 * 16; i += gridDim.x * 256) {
        const int pos = (i < 4096) ? (i >> 4) : ((i - 4096) >> 4);
        const int f = i & 15;
        const float inv = powf(10000.0f, -(float)f / 16.0f);
        const float ang = (float)pos * inv;
        const double TWO_PI = 6.283185307179586476925;
        double a = (double)ang;
        a -= TWO_PI * rint(a / TWO_PI);
        const float cr = (float)cos(a), sr = (float)sin(a);
        if (i < 4096) { rope[i] = cr; rope[4096 + i] = sr; }
        else { rope[8192 + (i - 4096)] = cr; rope[8192 + 1024 + (i - 4096)] = sr; }
    }
    {
        u16* w2t = (u16*)(WS_ + OFF_LORA); u16* a2t = w2t + 2 * 2 * 256 * 32; u16* g2t = a2t + 2 * 2 * 256 * 32;
        for (int i = BIDX_ * 256 + tid; i < 2 * 2 * 256 * 32; i += gridDim.x * 256) {
            const int lz = i >> 13, c = (i >> 5) & 255, r = i & 31;
            w2t[i] = f2bf(p.rw_w2[((size_t)lz * 32 + r) * 256 + c]);
            a2t[i] = f2bf(p.rw_a2[((size_t)lz * 32 + r) * 256 + c]);
        }
        for (int i = BIDX_ * 256 + tid; i < 2 * 256 * 64; i += gridDim.x * 256) {
            const int l = i >> 14, c = (i >> 6) & 255, r = i & 63;
            g2t[i] = f2bf(p.rw_g2[((size_t)l * 64 + r) * 256 + c]);
        }
    }
    u16* wr = (u16*)(WS_ + OFF_WR);
    for (int i = BIDX_ * 256 + tid; i < 2 * 128 * 1024; i += gridDim.x * 256) {
        const int l = i >> 17, n = (i >> 10) & 127, k = i & 1023;
        float v = 0.f;
        if (n < 4) v = p.rgw[((size_t)l * 1024 + k) * 4 + n];
        else if (n < 36) v = p.rew[((size_t)l * 1024 + k) * 32 + (n - 4)];
        wr[i] = f2bf(v);
    }
}

DEVINL void conv_tile(const float* __restrict__ src, int N, int K, u16* __restrict__ dst, int k0, int n0, int mode, char* smem) {
    u16* t = (u16*)smem;
    const int tid = tid_();
    __syncthreads();
#pragma unroll 4
    for (int i = 0; i < 16; ++i) {
        const int k = i * 4 + (tid >> 6), n = tid & 63;
        float v = 0.f;
        if (n0 + n < N) v = src[(size_t)(k0 + k) * N + n0 + n];
        t[n * 68 + k] = f2bf(v);
    }
    __syncthreads();
#pragma unroll
    for (int i = 0; i < 4; ++i) {
        const int n = i * 16 + (tid >> 4), kq = (tid & 15) * 4;
        const int ng = n0 + n;
        int nd = ng;
        if (mode == 1) nd = 32 * (ng >> 4) + (ng & 15);
        else if (mode == 2) nd = 32 * (ng >> 4) + 16 + (ng & 15);
        uint2 v;
        v.x = (unsigned)t[n * 68 + kq] | ((unsigned)t[n * 68 + kq + 1] << 16);
        v.y = (unsigned)t[n * 68 + kq + 2] | ((unsigned)t[n * 68 + kq + 3] << 16);
        *(uint2*)(dst + (size_t)nd * K + k0 + kq) = v;
    }
}
DEVINL void ph_convw(const P& p, int l, char* smem) {
    const int TIDX_ = tid_(); const int BIDX_ = bid_(); char* const WS_ = wsl_(p.ws); (void)TIDX_; (void)BIDX_; (void)WS_;
    u16* win = (u16*)(WS_ + OFF_WIN); u16* wout = (u16*)(WS_ + OFF_WOUT);
    for (int u = BIDX_; u < 896 + 256; u += gridDim.x) {
        if (u < 896) conv_tile(p.w_in + (size_t)l * 1024 * INP, INP, 1024, win, (u / 56) * 64, (u % 56) * 64, 0, smem);
        else { const int v = u - 896; conv_tile(p.w_out + (size_t)l * 1024 * 1024, 1024, 1024, wout, (v / 16) * 64, (v % 16) * 64, 0, smem); }
    }
}
DEVINL void ph_convexp(const P& p, int l, char* smem) {
    const int TIDX_ = tid_(); const int BIDX_ = bid_(); char* const WS_ = wsl_(p.ws); (void)TIDX_; (void)BIDX_; (void)WS_;
    u16* wgu = (u16*)(WS_ + OFF_WGU); u16* wdn = (u16*)(WS_ + OFF_WDN);
    for (int u = BIDX_; u < 32 * 384; u += gridDim.x) {
        const int e = u / 384, v = u % 384;
        const size_t le = (size_t)l * 32 + e;
        if (v < 128) conv_tile(p.egate + le * 1024 * 512, 512, 1024, wgu + (size_t)e * 1024 * 1024, (v / 8) * 64, (v % 8) * 64, 1, smem);
        else if (v < 256) { const int w = v - 128; conv_tile(p.eup + le * 1024 * 512, 512, 1024, wgu + (size_t)e * 1024 * 1024, (w / 8) * 64, (w % 8) * 64, 2, smem); }
        else { const int w = v - 256; conv_tile(p.edown + le * 512 * 1024, 1024, 512, wdn + (size_t)e * 1024 * 512, (w / 16) * 64, (w % 16) * 64, 0, smem); }
    }
}

DEVINL void ph_xm0(const P& p) {
    const int TIDX_ = tid_(); const int BIDX_ = bid_(); char* const WS_ = wsl_(p.ws); (void)TIDX_; (void)BIDX_; (void)WS_;
    const float* modv = (const float*)(WS_ + OFF_MOD);
    u16* hm = (u16*)(WS_ + OFF_HM);
    for (size_t i = (size_t)BIDX_ * 256 + TIDX_; i < (size_t)T * 256; i += (size_t)gridDim.x * 256) {
        const int row = (int)(i >> 8), c4 = (int)(i & 255) * 4;
        const float* src = row < CTXROWS ? p.ctx + (size_t)row * 1024 : p.x + (size_t)(row - CTXROWS) * 1024;
        const float* mv = modv + row_sel(row) * 6144;
        const float4 v = *(const float4*)(src + c4);
        const float4 sh = *(const float4*)(mv + c4), sc = *(const float4*)(mv + 1024 + c4);
        uint2 o;
        o.x = (unsigned)f2bf(v.x * (1.f + sc.x) + sh.x) | ((unsigned)f2bf(v.y * (1.f + sc.y) + sh.y) << 16);
        o.y = (unsigned)f2bf(v.z * (1.f + sc.z) + sh.z) | ((unsigned)f2bf(v.w * (1.f + sc.w) + sh.w) << 16);
        *(uint2*)(hm + (size_t)row * 1024 + c4) = o;
    }
}

DEVINL void ph_inproj(const P& p, char* smem) {
    const int TIDX_ = tid_(); const int BIDX_ = bid_(); char* const WS_ = wsl_(p.ws); (void)TIDX_; (void)BIDX_; (void)WS_;
    const u16* hm = (const u16*)(WS_ + OFF_HM);
    const u16* win = (const u16*)(WS_ + OFF_WIN);
    u16* pqk = (u16*)(WS_ + OFF_PQK); u16* vtl = (u16*)(WS_ + OFF_VTL); u16* vtc = (u16*)(WS_ + OFF_VTC);
    u16* pb = (u16*)(WS_ + OFF_PB); u16* pc = (u16*)(WS_ + OFF_PC);
    for (int u = BIDX_; u < 260 * 28; u += gridDim.x) {
        const int mt = u / 28, nt = u % 28;
        const u16* A = hm + (size_t)mt * 128 * 1024;
        gemm128([&](int r) { return A + (size_t)r * 1024; }, win + (size_t)nt * 128 * 1024, 1024, 1024, smem,
                [&](int m, int n, f32x4 a) {
                    const int R = mt * 128 + m, N = nt * 128 + n;
                    if (N >= INP) return;
                    const u16 h0 = f2bf(a[0]), h1 = f2bf(a[1]), h2 = f2bf(a[2]), h3 = f2bf(a[3]);
                    if (N < 1024) {
                        u16* q = pqk + (size_t)R * 1024 + N; q[0] = h0; q[1024] = h1; q[2048] = h2; q[3072] = h3;
                    } else if (N < 1536) {
                        const int hh = (N - 1024) >> 6, d = (N - 1024) & 63;
                        uint2 v; v.x = (unsigned)h0 | ((unsigned)h1 << 16); v.y = (unsigned)h2 | ((unsigned)h3 << 16);
                        if (R < CTXROWS) { const int b = R >> 8, t = R & 255; *(uint2*)(vtc + ((size_t)((b * 8 + hh) * 64 + d)) * 256 + t) = v; }
                        else { const int R2 = R - CTXROWS, b = R2 >> 14, t = R2 & 16383; *(uint2*)(vtl + ((size_t)((b * 8 + hh) * 64 + d)) * 16384 + t) = v; }
                    } else if (N < 2496) {
                        u16* q = pb + (size_t)R * 960 + (N - 1536); q[0] = h0; q[960] = h1; q[1920] = h2; q[2880] = h3;
                    } else {
                        u16* q = pc + (size_t)R * 1040 + (N - 2496); q[0] = h0; q[1040] = h1; q[2080] = h2; q[3120] = h3;
                    }
                });
    }
}

constexpr size_t RWREC = 12288;
constexpr size_t RW_A1 = 0, RW_A4 = 2048, RW_A3 = 4096, RW_MKA = 8192, RW_TT = 8704, RW_MY = 9216, RW_V = 10240;
constexpr size_t OFF_RWOP = OFF_X1;
constexpr size_t OFF_RWWG = OFF_RWOP + (size_t)8 * 1040 * RWREC;
constexpr size_t OFF_YRWB = OFF_RWWG + (size_t)8 * 260 * 64 * 4;
constexpr size_t OFF_BONUS = OFF_YRWB + (size_t)T * 256 * 2;
static_assert(OFF_BONUS + (size_t)T * 4 * 4 <= OFF_HM, "rw operand store must fit the X1 region");

DEVINL float rw_mix(const u16* __restrict__ pb, const float* __restrict__ mup, const float* __restrict__ mun, int row, int t, int seqlen, int col) {
    const float cu = bf2f(pb[(size_t)row * 960 + col]);
    const float pr = t > 0 ? bf2f(pb[(size_t)(row - 1) * 960 + col]) : 0.f;
    const float nx = t + 1 < seqlen ? bf2f(pb[(size_t)(row + 1) * 960 + col]) : 0.f;
    return cu + mup[col] * (pr - cu) + mun[col] * (nx - cu);
}

DEVINL void ph_rwprep(const P& p, int l, int d, char* smem) {
    const int TIDX_ = tid_(); const int BIDX_ = bid_(); char* const WS_ = wsl_(p.ws);
    const int tid = TIDX_, lane = tid & 63, w = tid >> 6, fr = lane & 15, fq = lane >> 4;
    const u16* pb = (const u16*)(WS_ + OFF_PB);
    char* rwop = WS_ + OFF_RWOP;
    float* rwwg = (float*)(WS_ + OFF_RWWG);
    float* bonus = (float*)(WS_ + OFF_BONUS);
    u16* gate = (u16*)(WS_ + OFF_GATE);
    const float* mup = p.mu_prev + l * 960; const float* mun = p.mu_next + l * 960;
    u16* lwdh = (u16*)smem;
    u16* ladh = lwdh + 2048;
    u16* abuf = ladh + 2048;
    float* Lb = (float*)(smem + 16384);
    u16* SV = (u16*)(smem + 32768);
    float* tot = (float*)(smem + 32768);
    const u16* w2t = (const u16*)(WS_ + OFF_LORA);
    const u16* a2t = w2t + 2 * 2 * 256 * 32;
    const u16* g2t = a2t + 2 * 2 * 256 * 32;
    const int z = d;
    for (int u = BIDX_; u < NUNIT_CH; u += gridDim.x) {
        int b, gi, row0, seqlen, gscan;
        if (u < 8) { b = u >> 2; gi = u & 3; row0 = b * 256 + gi * 64; seqlen = 256; gscan = d ? 3 - gi : gi; }
        else { b = (u - 8) >> 8; gi = (u - 8) & 255; row0 = CTXROWS + b * LAT + gi * 64; seqlen = LAT; gscan = 4 + (d ? 255 - gi : gi); }
        const int t0 = gi * 64;
        __syncthreads();
#pragma unroll 1
        for (int i = 0; i < 8; ++i) {
            const int idx = tid + 256 * i, j = idx >> 5, cc = idx & 31;
            lwdh[idx] = f2bf(tanhf(rw_mix(pb, mup, mun, row0 + j, t0 + j, seqlen, 768 + z * 32 + cc)));
            ladh[idx] = f2bf(rw_mix(pb, mup, mun, row0 + j, t0 + j, seqlen, 832 + z * 32 + cc));
        }
        if (d == 0) {
            u16* lgd = (u16*)Lb;
#pragma unroll 1
            for (int i = 0; i < 16; ++i) {
                const int idx = tid + 256 * i, j = idx >> 6, cc = idx & 63;
                lgd[idx] = f2bf(sigmoidf_(rw_mix(pb, mup, mun, row0 + j, t0 + j, seqlen, 896 + cc)));
            }
            __syncthreads();
#pragma unroll 1
            for (int nt = 0; nt < 4; ++nt) {
                const u16* bp = g2t + ((size_t)l * 256 + 64 * w + 16 * nt + fr) * 64 + 8 * fq;
                const bf16x8 b0 = *(const bf16x8*)bp, b1 = *(const bf16x8*)(bp + 32);
#pragma unroll
                for (int mt = 0; mt < 4; ++mt) {
                    const bf16x8 x0 = *(const bf16x8*)(lgd + (16 * mt + fr) * 64 + 8 * fq), x1 = *(const bf16x8*)(lgd + (16 * mt + fr) * 64 + 32 + 8 * fq);
                    f32x4 acc = f32x4{0.f, 0.f, 0.f, 0.f};
                    acc = __builtin_amdgcn_mfma_f32_16x16x32_bf16(x0, b0, acc, 0, 0, 0);
                    acc = __builtin_amdgcn_mfma_f32_16x16x32_bf16(x1, b1, acc, 0, 0, 0);
#pragma unroll
                    for (int r = 0; r < 4; ++r) gate[(size_t)(row0 + 16 * mt + 4 * fq + r) * 256 + 64 * w + 16 * nt + fr] = f2bf(acc[r]);
                }
            }
        }
#pragma unroll 1
        for (int h = 0; h < 4; ++h) {
            const int bh = b * 4 + h;
            const int ch = h * 64 + lane;
            __syncthreads();
            {
                const bf16x8 xw = *(const bf16x8*)(lwdh + (16 * w + fr) * 32 + 8 * fq);
                const bf16x8 xa = *(const bf16x8*)(ladh + (16 * w + fr) * 32 + 8 * fq);
#pragma unroll 1
                for (int kt = 0; kt < 4; ++kt) {
                    const int key = 16 * kt + fr;
                    const size_t wrow = ((size_t)(l * 2 + z) * 256 + h * 64 + key) * 32 + 8 * fq;
                    const bf16x8 bw = *(const bf16x8*)(w2t + wrow), ba = *(const bf16x8*)(a2t + wrow);
                    f32x4 ae = f32x4{0.f, 0.f, 0.f, 0.f}, aa = f32x4{0.f, 0.f, 0.f, 0.f};
                    ae = __builtin_amdgcn_mfma_f32_16x16x32_bf16(xw, bw, ae, 0, 0, 0);
                    aa = __builtin_amdgcn_mfma_f32_16x16x32_bf16(xa, ba, aa, 0, 0, 0);
                    const float w0 = p.rw_w0[(l * 2 + z) * 256 + h * 64 + key], a0 = p.rw_a0[(l * 2 + z) * 256 + h * 64 + key];
#pragma unroll
                    for (int r = 0; r < 4; ++r) {
                        const int tok = 16 * w + 4 * fq + r;
                        const int s = d ? 63 - tok : tok;
                        Lb[s * 64 + key] = 0.60653065971263342f * sigmoidf_(ae[r] + w0);
                        abuf[tok * 64 + key] = f2bf(sigmoidf_(aa[r] + a0));
                    }
                }
            }
            __syncthreads();
            {
                float pre[16]; float run = 0.f;
#pragma unroll
                for (int i = 0; i < 16; ++i) { run += Lb[(16 * w + i) * 64 + lane]; pre[i] = run; }
                tot[w * 64 + lane] = run;
                __syncthreads();
                float offs = 0.f;
#pragma unroll
                for (int ww = 0; ww < 3; ++ww) offs += (ww < w) ? tot[ww * 64 + lane] : 0.f;
#pragma unroll
                for (int i = 0; i < 16; ++i) Lb[(16 * w + i) * 64 + lane] = -(offs + pre[i]);
            }
            __syncthreads();
            {
                const float kkw = p.rw_kk[l * 256 + ch], ka = p.rw_ka[l * 256 + ch], rk = p.rw_rk[l * 256 + ch];
#pragma unroll 1
                for (int i = 0; i < 16; ++i) {
                    const int j = w + 4 * i, row = row0 + j, tt = t0 + j;
                    const float rr = rw_mix(pb, mup, mun, row, tt, seqlen, ch);
                    const float kr = rw_mix(pb, mup, mun, row, tt, seqlen, 256 + ch);
                    const float a = bf2f(abuf[j * 64 + lane]);
                    const float kkv = kr * kkw;
                    const float ss = wsum(kkv * kkv);
                    const float kkn = kkv / fmaxf(sqrtf(ss), 1e-12f);
                    const int s = d ? 63 - j : j;
                    const float Lt = Lb[s * 64 + lane];
                    const float Lp = s > 0 ? Lb[(s - 1) * 64 + lane] : 0.f;
                    const float einv = expf(-Lt);
                    const int c = s >> 4, ts = s & 15;
                    u16* sv = SV + (size_t)(c * 4) * 1024 + ts * 64 + lane;
                    sv[0] = f2bf(-kkn * expf(Lp));
                    sv[1024] = f2bf(rr * expf(Lt));
                    sv[2048] = f2bf(kkn * a * einv);
                    sv[3072] = f2bf(kr * (1.f + (a - 1.f) * ka) * einv);
                    if (d == 0) { const float bs = wsum(rr * kr * rk); if (lane == 0) bonus[(size_t)row * 4 + h] = bs; }
                }
                if (w == 0) rwwg[((size_t)bh * 260 + gscan) * 64 + lane] = expf(Lb[63 * 64 + lane]);
            }
            __syncthreads();
            {
                char* rec = rwop + ((size_t)bh * 1040 + (size_t)gscan * 4 + w) * RWREC;
                const u16* Av = SV + (size_t)(w * 4) * 1024; const u16* Rv = Av + 1024; const u16* Bv = Av + 2048; const u16* Kv = Av + 3072;
                bf16x8 fa[2], frr[2], fb[2], fk[2];
#pragma unroll
                for (int ks = 0; ks < 2; ++ks) {
                    fa[ks] = *(const bf16x8*)(Av + fr * 64 + ks * 32 + fq * 8);
                    frr[ks] = *(const bf16x8*)(Rv + fr * 64 + ks * 32 + fq * 8);
                    fb[ks] = *(const bf16x8*)(Bv + fr * 64 + ks * 32 + fq * 8);
                    fk[ks] = *(const bf16x8*)(Kv + fr * 64 + ks * 32 + fq * 8);
                }
                f32x4 mka = f32x4{0.f, 0.f, 0.f, 0.f}, mba = mka, mkr = mka, mbr = mka;
#pragma unroll
                for (int ks = 0; ks < 2; ++ks) {
                    mka = __builtin_amdgcn_mfma_f32_16x16x32_bf16(fa[ks], fk[ks], mka, 0, 0, 0);
                    mba = __builtin_amdgcn_mfma_f32_16x16x32_bf16(fa[ks], fb[ks], mba, 0, 0, 0);
                    mkr = __builtin_amdgcn_mfma_f32_16x16x32_bf16(frr[ks], fk[ks], mkr, 0, 0, 0);
                    mbr = __builtin_amdgcn_mfma_f32_16x16x32_bf16(frr[ks], fb[ks], mbr, 0, 0, 0);
                }
                float* Ns = Lb + w * 256;
                u16* rmka = (u16*)(rec + RW_MKA); u16* rmy = (u16*)(rec + RW_MY); u16* rtt = (u16*)(rec + RW_TT);
                const int i_ = fr;
#pragma unroll
                for (int r = 0; r < 4; ++r) {
                    const int t_ = 4 * fq + r;
                    const int lp = (i_ >> 2) * 16 + t_;
                    rmka[lp * 4 + (i_ & 3)] = f2bf(i_ < t_ ? mka[r] : 0.f);
                    rmy[lp * 8 + (i_ & 3)] = f2bf(i_ <= t_ ? mbr[r] : 0.f);
                    rmy[lp * 8 + 4 + (i_ & 3)] = f2bf(i_ <= t_ ? mkr[r] : 0.f);
                    Ns[t_ * 16 + i_] = i_ < t_ ? mba[r] : 0.f;
                }
                if (lane < 16) {
                    float Tr[16];
#pragma unroll
                    for (int t_ = 0; t_ < 16; ++t_) {
                        float acc = (lane == t_) ? 1.f : 0.f;
#pragma unroll
                        for (int ii = 0; ii < t_; ++ii) acc += Tr[ii] * Ns[t_ * 16 + ii];
                        Tr[t_] = acc;
                        rtt[((lane >> 2) * 16 + t_) * 4 + (lane & 3)] = f2bf(acc);
                    }
                }
#pragma unroll
                for (int ks = 0; ks < 2; ++ks) {
                    uint4 o;
                    const uint2 lo = *(const uint2*)(Av + fr * 64 + 32 * ks + 4 * fq), hi = *(const uint2*)(Av + fr * 64 + 32 * ks + 16 + 4 * fq);
                    o.x = lo.x; o.y = lo.y; o.z = hi.x; o.w = hi.y;
                    *(uint4*)(rec + RW_A1 + (ks * 64 + lane) * 16) = o;
                    const uint2 lo2 = *(const uint2*)(Rv + fr * 64 + 32 * ks + 4 * fq), hi2 = *(const uint2*)(Rv + fr * 64 + 32 * ks + 16 + 4 * fq);
                    o.x = lo2.x; o.y = lo2.y; o.z = hi2.x; o.w = hi2.y;
                    *(uint4*)(rec + RW_A4 + (ks * 64 + lane) * 16) = o;
                }
#pragma unroll
                for (int m = 0; m < 4; ++m) {
                    unsigned e[8];
#pragma unroll
                    for (int j = 0; j < 4; ++j) { e[j] = Bv[(4 * fq + j) * 64 + 16 * m + fr]; e[4 + j] = Kv[(4 * fq + j) * 64 + 16 * m + fr]; }
                    uint4 o; o.x = e[0] | (e[1] << 16); o.y = e[2] | (e[3] << 16); o.z = e[4] | (e[5] << 16); o.w = e[6] | (e[7] << 16);
                    *(uint4*)(rec + RW_A3 + (m * 64 + lane) * 16) = o;
                }
#pragma unroll 1
                for (int q = 0; q < 4; ++q) {
                    unsigned e[4];
#pragma unroll
                    for (int j = 0; j < 4; ++j) {
                        const int s = 16 * w + 4 * fq + j; const int jt = d ? 63 - s : s;
                        e[j] = f2bf(rw_mix(pb, mup, mun, row0 + jt, t0 + jt, seqlen, 512 + h * 64 + 16 * q + fr));
                    }
                    uint2 o; o.x = e[0] | (e[1] << 16); o.y = e[2] | (e[3] << 16);
                    *(uint2*)(rec + RW_V + (q * 64 + lane) * 8) = o;
                }
            }
        }
    }
}

DEVINL void ph_rwscan(const P& p, int l, int d, int bid, int nb) {
    const int TIDX_ = tid_(); char* const WS_ = wsl_(p.ws);
    const int lane = TIDX_ & 63, q = TIDX_ >> 6, fr = lane & 15, fq = lane >> 4;
    const char* rwop = WS_ + OFF_RWOP;
    const float* rwwg = (const float*)(WS_ + OFF_RWWG);
    u16* yf = (u16*)(WS_ + OFF_Y);
    u16* yb = (u16*)(WS_ + OFF_YRWB);
    for (int bh = bid; bh < 8; bh += nb) {
        const int b = bh >> 2, h = bh & 3;
        f32x4 z[4];
#pragma unroll
        for (int m = 0; m < 4; ++m) z[m] = f32x4{0.f, 0.f, 0.f, 0.f};
        const char* rec0 = rwop + (size_t)bh * 1040 * RWREC;
        uint4 a1[2], a4[2], a3[4], my; uint2 mka, tt, vv;
        auto loadrec = [&](int c) {
            const char* rec = rec0 + (size_t)c * RWREC;
            a1[0] = *(const uint4*)(rec + RW_A1 + lane * 16); a1[1] = *(const uint4*)(rec + RW_A1 + (64 + lane) * 16);
            a4[0] = *(const uint4*)(rec + RW_A4 + lane * 16); a4[1] = *(const uint4*)(rec + RW_A4 + (64 + lane) * 16);
#pragma unroll
            for (int m = 0; m < 4; ++m) a3[m] = *(const uint4*)(rec + RW_A3 + (m * 64 + lane) * 16);
            mka = *(const uint2*)(rec + RW_MKA + lane * 8); tt = *(const uint2*)(rec + RW_TT + lane * 8);
            my = *(const uint4*)(rec + RW_MY + lane * 16);
            vv = *(const uint2*)(rec + RW_V + (q * 64 + lane) * 8);
        };
        auto asfrag = [](uint4 v) { union { uint4 u; bf16x8 f; } x; x.u = v; return x.f; };
        auto pack2 = [](float lo, float hi) { return (unsigned)f2bf(lo) | ((unsigned)f2bf(hi) << 16); };
        loadrec(0);
#pragma unroll 1
        for (int c = 0; c < 1040; ++c) {
            const bf16x8 A1_0 = asfrag(a1[0]), A1_1 = asfrag(a1[1]), A4_0 = asfrag(a4[0]), A4_1 = asfrag(a4[1]);
            const bf16x8 A3_0 = asfrag(a3[0]), A3_1 = asfrag(a3[1]), A3_2 = asfrag(a3[2]), A3_3 = asfrag(a3[3]);
            const bf16x8 MY = asfrag(my);
            const bf16x8 MKA = asfrag(make_uint4(mka.x, mka.y, 0u, 0u)), TT = asfrag(make_uint4(tt.x, tt.y, 0u, 0u));
            const uint2 vcur = vv;
            if (c + 1 < 1040) loadrec(c + 1);
            const bf16x8 VB = asfrag(make_uint4(vcur.x, vcur.y, 0u, 0u));
            const bf16x8 ZB0 = asfrag(make_uint4(pack2(z[0][0], z[0][1]), pack2(z[0][2], z[0][3]), pack2(z[1][0], z[1][1]), pack2(z[1][2], z[1][3])));
            const bf16x8 ZB1 = asfrag(make_uint4(pack2(z[2][0], z[2][1]), pack2(z[2][2], z[2][3]), pack2(z[3][0], z[3][1]), pack2(z[3][2], z[3][3])));
            f32x4 X = f32x4{0.f, 0.f, 0.f, 0.f};
            X = __builtin_amdgcn_mfma_f32_16x16x32_bf16(MKA, VB, X, 0, 0, 0);
            X = __builtin_amdgcn_mfma_f32_16x16x32_bf16(A1_0, ZB0, X, 0, 0, 0);
            X = __builtin_amdgcn_mfma_f32_16x16x32_bf16(A1_1, ZB1, X, 0, 0, 0);
            f32x4 Y = f32x4{0.f, 0.f, 0.f, 0.f};
            Y = __builtin_amdgcn_mfma_f32_16x16x32_bf16(A4_0, ZB0, Y, 0, 0, 0);
            Y = __builtin_amdgcn_mfma_f32_16x16x32_bf16(A4_1, ZB1, Y, 0, 0, 0);
            const bf16x8 XB = asfrag(make_uint4(pack2(X[0], X[1]), pack2(X[2], X[3]), 0u, 0u));
            f32x4 U = f32x4{0.f, 0.f, 0.f, 0.f};
            U = __builtin_amdgcn_mfma_f32_16x16x32_bf16(TT, XB, U, 0, 0, 0);
            const bf16x8 UV = asfrag(make_uint4(pack2(U[0], U[1]), pack2(U[2], U[3]), vcur.x, vcur.y));
            z[0] = __builtin_amdgcn_mfma_f32_16x16x32_bf16(A3_0, UV, z[0], 0, 0, 0);
            z[1] = __builtin_amdgcn_mfma_f32_16x16x32_bf16(A3_1, UV, z[1], 0, 0, 0);
            z[2] = __builtin_amdgcn_mfma_f32_16x16x32_bf16(A3_2, UV, z[2], 0, 0, 0);
            z[3] = __builtin_amdgcn_mfma_f32_16x16x32_bf16(A3_3, UV, z[3], 0, 0, 0);
            Y = __builtin_amdgcn_mfma_f32_16x16x32_bf16(MY, UV, Y, 0, 0, 0);
            const bool isctx = c < 16;
            if (!isctx || l == 0) {
                const int cc = isctx ? c : c - 16;
                const int n = isctx ? LCTX : LAT;
                const int rowbase = isctx ? b * LCTX : CTXROWS + b * LAT;
#pragma unroll
                for (int r = 0; r < 4; ++r) {
                    const int s = cc * 16 + 4 * fq + r;
                    const int t = d ? n - 1 - s : s;
                    const u16 o = f2bf(Y[r]);
                    if (d == 0) yf[(size_t)(rowbase + t) * 1024 + 512 + h * 64 + 16 * q + fr] = o;
                    else yb[(size_t)(rowbase + t) * 256 + h * 64 + 16 * q + fr] = o;
                }
            }
            if ((c & 3) == 3) {
                const float* wg = rwwg + ((size_t)bh * 260 + (c >> 2)) * 64;
#pragma unroll
                for (int m = 0; m < 4; ++m) {
                    const float4 g4 = *(const float4*)(wg + 16 * m + 4 * fq);
                    z[m][0] *= g4.x; z[m][1] *= g4.y; z[m][2] *= g4.z; z[m][3] *= g4.w;
                }
            }
        }
    }
}

DEVINL void ph_rwout(const P& p, int l) {
    const int TIDX_ = tid_(); const int BIDX_ = bid_(); char* const WS_ = wsl_(p.ws);
    const int tid = TIDX_, h = tid >> 6;
    const u16* pb = (const u16*)(WS_ + OFF_PB);
    const u16* yb = (const u16*)(WS_ + OFF_YRWB);
    const u16* gate = (const u16*)(WS_ + OFF_GATE);
    const float* bonus = (const float*)(WS_ + OFF_BONUS);
    u16* y = (u16*)(WS_ + OFF_Y);
    const float* mup = p.mu_prev + l * 960; const float* mun = p.mu_next + l * 960;
    const float lw = p.rw_lnw[l * 256 + tid], lb = p.rw_lnb[l * 256 + tid];
    const int rstart = (l == 0) ? 0 : CTXROWS;
    for (int row = rstart + BIDX_; row < T; row += gridDim.x) {
        int t, seqlen;
        if (row < CTXROWS) { t = row & 255; seqlen = LCTX; } else { t = (row - CTXROWS) & (LAT - 1); seqlen = LAT; }
        const float yv = bf2f(y[(size_t)row * 1024 + 512 + tid]) + bf2f(yb[(size_t)row * 256 + tid]);
        const float v = rw_mix(pb, mup, mun, row, t, seqlen, 512 + tid);
        const float mu = wsum(yv) * (1.f / 64.f);
        const float dl = yv - mu;
        const float var = wsum(dl * dl) * (1.f / 64.f);
        const float o = (dl * rsqrtf(var + 64e-5f) * lw + lb + bonus[(size_t)row * 4 + h] * v) * bf2f(gate[(size_t)row * 256 + tid]);
        y[(size_t)row * 1024 + 512 + tid] = f2bf(o);
    }
}
DEVINL void ph_prepM(const P& p, int l, char* smem) {
    const int TIDX_ = tid_(); const int BIDX_ = bid_(); char* const WS_ = wsl_(p.ws); (void)TIDX_; (void)BIDX_; (void)WS_;
    const int tid = TIDX_, lane = tid & 63, wid = tid >> 6;
    const u16* pb = (const u16*)(WS_ + OFF_PB);
    const u16* pc = (const u16*)(WS_ + OFF_PC);
    u16* rwf = (u16*)(WS_ + OFF_X1);
    u16* gate = (u16*)(WS_ + OFF_GATE);
    u16* mlf = (u16*)(WS_ + OFF_MLF);
    float* mlg = (float*)(WS_ + OFF_MLG);
    float* mls = (float*)(WS_ + OFF_MLS);
    float* nst = (float*)(WS_ + OFF_NST);
    float* cst = (float*)(WS_ + OFF_HM);
    const float* rope = (const float*)(WS_ + OFF_ROPE);
    const float* mup = p.mu_prev + l * 960; const float* mun = p.mu_next + l * 960;
    for (int u = BIDX_; u < NUNIT_CH; u += gridDim.x) {
        int b, ch, row0, seqlen; bool isctx;
        if (u < 8) { isctx = true; b = u >> 2; ch = u & 3; row0 = b * 256 + ch * 64; seqlen = 256; }
        else { isctx = false; b = (u - 8) >> 8; ch = (u - 8) & 255; row0 = CTXROWS + b * LAT + ch * 64; seqlen = LAT; }
        const int t0 = ch * 64;
        const int tc = isctx ? ch : 4 + ch;
        __syncthreads();
        u16* kl = (u16*)smem;
        u16* vl = kl + 4096;
        float* wsl = (float*)(vl + 4096);
        float* lil = wsl + 512;
        {
            const float* cw = p.ml_cw + (size_t)l * 3 * 512;
            const float wq0 = cw[tid], wq1 = cw[512 + tid], wq2 = cw[1024 + tid], bq = p.ml_cb[l * 512 + tid];
            const float wk0 = cw[256 + tid], wk1 = cw[512 + 256 + tid], wk2 = cw[1024 + 256 + tid], bk = p.ml_cb[l * 512 + 256 + tid];
            float pq = 0, pk = 0, cq, ck;
            if (t0 > 0) { const u16* r = pc + (size_t)(row0 - 1) * 1040; pq = bf2f(r[tid]); pk = bf2f(r[256 + tid]); }
            { const u16* r = pc + (size_t)row0 * 1040; cq = bf2f(r[tid]); ck = bf2f(r[256 + tid]); }
            const int i16 = lane & 15; const bool second = (lane & 16) != 0; const int half = lane >> 5;
#pragma unroll 1
            for (int j = 0; j < 64; ++j) {
                float nq = 0, nk = 0;
                if (t0 + j + 1 < seqlen) { const u16* r = pc + (size_t)(row0 + j + 1) * 1040; nq = bf2f(r[tid]); nk = bf2f(r[256 + tid]); }
                float vq = siluf_(wq0 * pq + wq1 * cq + wq2 * nq + bq);
                float vk = siluf_(wk0 * pk + wk1 * ck + wk2 * nk + bk);
                if (!isctx) {
                    const int t = t0 + j;
                    const int pos = half == 0 ? (t >> 6) : (t & 63);
                    const float cs = half == 0 ? rope[pos * 16 + i16] : rope[8192 + pos * 16 + i16];
                    const float sn = half == 0 ? rope[4096 + pos * 16 + i16] : rope[9216 + pos * 16 + i16];
                    const float oq = __shfl_xor(vq, 16), ok = __shfl_xor(vk, 16);
                    vq = second ? (oq * sn + vq * cs) : (vq * cs - oq * sn);
                    vk = second ? (ok * sn + vk * cs) : (vk * cs - ok * sn);
                }
                mlf[(size_t)(row0 + j) * 512 + tid] = f2bf(vq);
                mlf[(size_t)(row0 + j) * 512 + 256 + tid] = f2bf(vk * 0.125f);
                pq = cq; pk = ck; cq = nq; ck = nk;
            }
            const int j = tid >> 2, q4 = tid & 3;
#pragma unroll
            for (int i = 0; i < 4; ++i) {
                const int idx = q4 * 4 + i;
                const float g = bf2f(pc[(size_t)(row0 + j) * 1040 + 1024 + idx]);
                float v;
                if (idx < 8) v = g + p.ml_ib[l * 8 + idx];
                else { const float xx = g + p.ml_fb[l * 8 + idx - 8]; v = fminf(xx, 0.f) - log1pf(__expf(-fabsf(xx))); }
                lil[j * 16 + idx] = v;
                mlg[(size_t)(row0 + j) * 16 + idx] = v;
            }
        }
        __syncthreads();
        if (tid < 8) {
            const int d = tid >> 2, h = tid & 3;
            float bacc = 0.f;
#pragma unroll 1
            for (int jj = 0; jj < 64; ++jj) { const int tok = d ? 63 - jj : jj; bacc += lil[tok * 16 + 8 + d * 4 + h]; wsl[tid * 64 + tok] = bacc; }
            const float Bs = bacc;
            float G = -3.0e38f;
#pragma unroll 1
            for (int tok = 0; tok < 64; ++tok) { const float g = Bs - wsl[tid * 64 + tok] + lil[tok * 16 + d * 4 + h]; G = fmaxf(G, g); }
#pragma unroll 1
            for (int tok = 0; tok < 64; ++tok) { const float g = Bs - wsl[tid * 64 + tok] + lil[tok * 16 + d * 4 + h]; wsl[tid * 64 + tok] = expf(g - G); }
            const int bhd = (b * 4 + h) * 2 + d;
            mls[(bhd * NTC + tc) * 2 + 0] = G; mls[(bhd * NTC + tc) * 2 + 1] = Bs;
        }
#pragma unroll 1
        for (int h = 0; h < 4; ++h) {
            __syncthreads();
            for (int i = tid; i < 64 * 16; i += 256) {
                const int tok = i >> 4, c4 = (i & 15) * 4;
                *(uint2*)(kl + tok * 64 + c4) = *(const uint2*)(mlf + (size_t)(row0 + tok) * 512 + 256 + h * 64 + c4);
                *(uint2*)(vl + tok * 64 + c4) = *(const uint2*)(pc + (size_t)(row0 + tok) * 1040 + 512 + h * 64 + c4);
            }
            __syncthreads();
            const int dk4 = (tid >> 4) * 4, dv4 = (tid & 15) * 4;
            float a0[4][4], a1[4][4], n0[4], n1[4];
#pragma unroll
            for (int a = 0; a < 4; ++a) { n0[a] = 0.f; n1[a] = 0.f;
#pragma unroll
                for (int c = 0; c < 4; ++c) { a0[a][c] = 0.f; a1[a][c] = 0.f; } }
#pragma unroll 2
            for (int j = 0; j < 64; ++j) {
                const uint2 kk = *(const uint2*)(kl + j * 64 + dk4);
                const uint2 vv = *(const uint2*)(vl + j * 64 + dv4);
                const float w0 = wsl[h * 64 + j], w1 = wsl[(4 + h) * 64 + j];
                const float kf[4] = {bf2f((u16)(kk.x & 0xFFFF)), bf2f((u16)(kk.x >> 16)), bf2f((u16)(kk.y & 0xFFFF)), bf2f((u16)(kk.y >> 16))};
                const float vf[4] = {bf2f((u16)(vv.x & 0xFFFF)), bf2f((u16)(vv.x >> 16)), bf2f((u16)(vv.y & 0xFFFF)), bf2f((u16)(vv.y >> 16))};
#pragma unroll
                for (int a = 0; a < 4; ++a) {
                    const float k0 = kf[a] * w0, k1 = kf[a] * w1;
                    n0[a] += k0; n1[a] += k1;
#pragma unroll
                    for (int c = 0; c < 4; ++c) { a0[a][c] += k0 * vf[c]; a1[a][c] += k1 * vf[c]; }
                }
            }
            const int bh0 = ((b * 4 + h) * 2 + 0) * NTC + tc, bh1 = ((b * 4 + h) * 2 + 1) * NTC + tc;
#pragma unroll
            for (int a = 0; a < 4; ++a) {
                *(float4*)(cst + (size_t)bh0 * 4096 + (dk4 + a) * 64 + dv4) = make_float4(a0[a][0], a0[a][1], a0[a][2], a0[a][3]);
                *(float4*)(cst + (size_t)bh1 * 4096 + (dk4 + a) * 64 + dv4) = make_float4(a1[a][0], a1[a][1], a1[a][2], a1[a][3]);
                if ((tid & 15) == 0) { nst[(size_t)bh0 * 64 + dk4 + a] = n0[a]; nst[(size_t)bh1 * 64 + dk4 + a] = n1[a]; }
            }
        }
    }
}

DEVINL void ph_mlB(const P& p, int bid, int nb) {
    const int TIDX_ = tid_(); const int BIDX_ = bid_(); char* const WS_ = wsl_(p.ws); (void)TIDX_; (void)BIDX_; (void)WS_;
    const int tid = TIDX_;
    float* mls = (float*)(WS_ + OFF_MLS);
    float* mst = (float*)(WS_ + OFF_MST);
    float* nst = (float*)(WS_ + OFF_NST);
    float* cst = (float*)(WS_ + OFF_HM);
    for (int u = bid; u < 64; u += nb) {
        const int bhd = u >> 2, q = u & 3, d = bhd & 1;
        float zz = 0.f; asm volatile("" : "+v"(zz));
        float4 C = make_float4(zz, zz, zz, zz);
        float nn = zz, m = zz;
        auto tcof = [&](int cs) { return cs < 4 ? (d ? 3 - cs : cs) : 4 + (d ? 255 - (cs - 4) : cs - 4); };
        float4 Unext = *(const float4*)(cst + ((size_t)bhd * NTC + tcof(0)) * 4096 + q * 1024 + tid * 4);
        for (int cs = 0; cs < NTC; ++cs) {
            const int tc = tcof(cs);
            const float4 U = Unext;
            float* cp = cst + ((size_t)bhd * NTC + tc) * 4096 + q * 1024 + tid * 4;
            if (cs + 1 < NTC) Unext = *(const float4*)(cst + ((size_t)bhd * NTC + tcof(cs + 1)) * 4096 + q * 1024 + tid * 4);
            const float G = mls[(bhd * NTC + tc) * 2 + 0], Bs = mls[(bhd * NTC + tc) * 2 + 1];
            float nU = 0.f;
            if (q == 0 && tid < 64) nU = nst[((size_t)bhd * NTC + tc) * 64 + tid];
            *(float4*)cp = C;
            if (q == 0 && tid < 64) nst[((size_t)bhd * NTC + tc) * 64 + tid] = nn;
            if (q == 0 && tid == 0) mst[bhd * NTC + tc] = m;
            const float ml = fmaxf(Bs + m, G);
            const float dC = expf(Bs + m - ml), dU = expf(G - ml);
            C.x = dC * C.x + dU * U.x; C.y = dC * C.y + dU * U.y; C.z = dC * C.z + dU * U.z; C.w = dC * C.w + dU * U.w;
            nn = dC * nn + dU * nU;
            m = ml;
        }
    }
}

DEVINL void ph_na(const P& p, int l, char* smem, int bid, int nb) {
    const int TIDX_ = tid_(); const int BIDX_ = bid_(); char* const WS_ = wsl_(p.ws); (void)TIDX_; (void)BIDX_; (void)WS_;
    const int tid = TIDX_, lane = tid & 63, w = tid >> 6, fr = lane & 15, g = lane >> 4;
    const u16* pqk = (const u16*)(WS_ + OFF_PQK);
    const u16* vtl = (const u16*)(WS_ + OFF_VTL);
    const u16* vtc = (const u16*)(WS_ + OFF_VTC);
    u16* y = (u16*)(WS_ + OFF_Y);
    float* rpbl = (float*)smem;
    const int nunit = 4096 + (l == 0 ? 64 : 0);
    for (int u = bid; u < nunit; u += nb) {
        const bool isctx = u >= 4096;
        int b, h, r = 0, qg = 0;
        if (!isctx) { b = u >> 11; h = (u >> 8) & 7; r = u & 255; }
        else { const int v = u - 4096; b = v >> 5; h = (v >> 2) & 7; qg = v & 3; }
        __syncthreads();
        if (!isctx) for (int i = tid; i < 465; i += 256) rpbl[i] = p.na_rpb[((size_t)l * 8 + h) * 465 + i];
        __syncthreads();
        const int c = 16 * w + fr;
        const int qrow = isctx ? b * LCTX + qg * 64 + c : CTXROWS + b * LAT + r * 64 + c;
        bf16x8 qf[2];
        qf[0] = *(const bf16x8*)(pqk + (size_t)qrow * 1024 + h * 64 + 8 * g);
        qf[1] = *(const bf16x8*)(pqk + (size_t)qrow * 1024 + h * 64 + 32 + 8 * g);
        f32x4 O[4];
#pragma unroll
        for (int i = 0; i < 4; ++i) O[i] = f32x4{0.f, 0.f, 0.f, 0.f};
        float mrun = -1.0e30f, lrun = 0.f;
        auto chunk = [&](const u16* kbase0, const u16* kbase1, const u16* vb, int vstride, const float* bias0, const float* bias1, bool lo0, bool lo1, int kc0, int cs) {
            bf16x8 k00 = *(const bf16x8*)(kbase0 + 8 * g), k01 = *(const bf16x8*)(kbase0 + 32 + 8 * g);
            bf16x8 k10 = *(const bf16x8*)(kbase1 + 8 * g), k11 = *(const bf16x8*)(kbase1 + 32 + 8 * g);
            uint2 vlo[4], vhi[4];
#pragma unroll
            for (int dt = 0; dt < 4; ++dt) { vlo[dt] = *(const uint2*)(vb + (size_t)dt * 16 * vstride); vhi[dt] = *(const uint2*)(vb + (size_t)dt * 16 * vstride + 16); }
            f32x4 s0 = f32x4{0.f, 0.f, 0.f, 0.f}, s1 = f32x4{0.f, 0.f, 0.f, 0.f};
            s0 = __builtin_amdgcn_mfma_f32_16x16x32_bf16(k00, qf[0], s0, 0, 0, 0);
            s0 = __builtin_amdgcn_mfma_f32_16x16x32_bf16(k01, qf[1], s0, 0, 0, 0);
            s1 = __builtin_amdgcn_mfma_f32_16x16x32_bf16(k10, qf[0], s1, 0, 0, 0);
            s1 = __builtin_amdgcn_mfma_f32_16x16x32_bf16(k11, qf[1], s1, 0, 0, 0);
            float sv[8];
#pragma unroll
            for (int j = 0; j < 4; ++j) {
                float a = s0[j] * 0.125f, bb = s1[j] * 0.125f;
                if (lo0) {
                    const int k0c = kc0 + 4 * g + j, k1c = k0c + 16;
                    a = (k0c >= cs && k0c <= cs + 15) ? a + bias0[k0c] : -1.0e30f;
                    bb = (k1c >= cs && k1c <= cs + 15) ? bb + bias0[k1c] : -1.0e30f;
                }
                sv[j] = a; sv[4 + j] = bb;
            }
            (void)bias1; (void)lo1;
            float mx = sv[0];
#pragma unroll
            for (int j = 1; j < 8; ++j) mx = fmaxf(mx, sv[j]);
            mx = fmaxf(mx, __shfl_xor(mx, 16)); mx = fmaxf(mx, __shfl_xor(mx, 32));
            const float mnew = fmaxf(mrun, mx);
            const float sc = __expf(mrun - mnew);
            mrun = mnew;
            float ps = 0.f; bf16x8 pf;
#pragma unroll
            for (int j = 0; j < 8; ++j) { const float pv = __expf(sv[j] - mnew); ps += pv; pf[j] = (short)f2bf(pv); }
            lrun = lrun * sc + ps;
#pragma unroll
            for (int dt = 0; dt < 4; ++dt) {
                O[dt][0] *= sc; O[dt][1] *= sc; O[dt][2] *= sc; O[dt][3] *= sc;
                bf16x8 vf;
                vf[0] = (short)(vlo[dt].x & 0xFFFF); vf[1] = (short)(vlo[dt].x >> 16); vf[2] = (short)(vlo[dt].y & 0xFFFF); vf[3] = (short)(vlo[dt].y >> 16);
                vf[4] = (short)(vhi[dt].x & 0xFFFF); vf[5] = (short)(vhi[dt].x >> 16); vf[6] = (short)(vhi[dt].y & 0xFFFF); vf[7] = (short)(vhi[dt].y >> 16);
                O[dt] = __builtin_amdgcn_mfma_f32_16x16x32_bf16(vf, pf, O[dt], 0, 0, 0);
            }
        };
        if (!isctx) {
            const int rs = min(max(r - 4, 0), 248);
            const int cb = (w == 0) ? 0 : (w == 1) ? 8 : (w == 2) ? 24 : 32;
            const int cs = min(max(c - 8, 0), 48);
            for (int i = 0; i < 8; ++i) {
                const int krow = rs + i;
                const size_t tokb = (size_t)CTXROWS + (size_t)b * LAT + krow * 64 + cb;
                const u16* kb0 = pqk + (tokb + fr) * 1024 + 512 + h * 64;
                const u16* kb1 = pqk + (tokb + 16 + fr) * 1024 + 512 + h * 64;
                const u16* vb = vtl + ((size_t)((b * 8 + h) * 64 + fr)) * LAT + krow * 64 + cb + 4 * g;
                const float* bias0 = rpbl + (krow - r + 7) * 31 - c + 15;
                chunk(kb0, kb1, vb, LAT, bias0, bias0, true, true, cb, cs);
            }
        }
        for (int cc = 0; cc < 8; ++cc) {
            const size_t tokb = (size_t)b * LCTX + cc * 32;
            const u16* kb0 = pqk + (tokb + fr) * 1024 + 512 + h * 64;
            const u16* kb1 = pqk + (tokb + 16 + fr) * 1024 + 512 + h * 64;
            const u16* vb = vtc + ((size_t)((b * 8 + h) * 64 + fr)) * LCTX + cc * 32 + 4 * g;
            chunk(kb0, kb1, vb, LCTX, nullptr, nullptr, false, false, 0, 0);
        }
        float lt = lrun; lt += __shfl_xor(lt, 16); lt += __shfl_xor(lt, 32);
        const float inv = 1.f / lt;
#pragma unroll
        for (int dt = 0; dt < 4; ++dt) {
            uint2 o;
            o.x = (unsigned)f2bf(O[dt][0] * inv) | ((unsigned)f2bf(O[dt][1] * inv) << 16);
            o.y = (unsigned)f2bf(O[dt][2] * inv) | ((unsigned)f2bf(O[dt][3] * inv) << 16);
            *(uint2*)(y + (size_t)qrow * 1024 + h * 64 + dt * 16 + 4 * g) = o;
        }
    }
}

DEVINL void ph_mlC(const P& p, int l, char* smem, int bid, int nb) {
    const int TIDX_ = tid_(); const int BIDX_ = bid_(); char* const WS_ = wsl_(p.ws); (void)TIDX_; (void)BIDX_; (void)WS_;
    const int tid = TIDX_;
    const u16* mlf = (const u16*)(WS_ + OFF_MLF);
    const u16* pc = (const u16*)(WS_ + OFF_PC);
    const float* mlg = (const float*)(WS_ + OFF_MLG);
    const float* mst = (const float*)(WS_ + OFF_MST);
    const float* nst = (const float*)(WS_ + OFF_NST);
    const float* cst = (const float*)(WS_ + OFF_HM);
    u16* y = (u16*)(WS_ + OFF_Y);
    u16* ql = (u16*)smem;
    u16* kl = ql + 4096;
    u16* vl = kl + 4096;
    float* Cl = (float*)(vl + 4096);
    float* Sl = Cl + 4096;
    float* btl = Sl + 4096;
    float* lil = btl + 64;
    float* nl = lil + 64;
    const int t = tid >> 2, q4 = tid & 3;
    for (int u = bid; u < 2 * NTC; u += nb) {
        const int b = u / NTC, tc = u % NTC;
        if (tc < 4 && l != 0) continue;
        const int row0 = tc < 4 ? b * LCTX + tc * 64 : CTXROWS + b * LAT + (tc - 4) * 64;
        for (int h = 0; h < 4; ++h) {
            float hs[16];
#pragma unroll
            for (int i = 0; i < 16; ++i) hs[i] = 0.f;
            __syncthreads();
            for (int i = tid; i < 64 * 16; i += 256) {
                const int tok = i >> 4, c4 = (i & 15) * 4;
                *(uint2*)(ql + tok * 64 + c4) = *(const uint2*)(mlf + (size_t)(row0 + tok) * 512 + h * 64 + c4);
                *(uint2*)(kl + tok * 64 + c4) = *(const uint2*)(mlf + (size_t)(row0 + tok) * 512 + 256 + h * 64 + c4);
                *(uint2*)(vl + tok * 64 + c4) = *(const uint2*)(pc + (size_t)(row0 + tok) * 1040 + 512 + h * 64 + c4);
            }
            for (int d = 0; d < 2; ++d) {
                const int bhd = (b * 4 + h) * 2 + d;
                __syncthreads();
                for (int i = tid; i < 1024; i += 256) *(float4*)(Cl + i * 4) = *(const float4*)(cst + ((size_t)bhd * NTC + tc) * 4096 + i * 4);
                if (tid < 64) { nl[tid] = nst[((size_t)bhd * NTC + tc) * 64 + tid]; lil[tid] = mlg[(size_t)(row0 + tid) * 16 + d * 4 + h]; }
                if (tid == 64) {
                    float bacc = 0.f;
#pragma unroll 1
                    for (int jj = 0; jj < 64; ++jj) { const int tok = d ? 63 - jj : jj; bacc += mlg[(size_t)(row0 + tok) * 16 + 8 + d * 4 + h]; btl[tok] = bacc; }
                }
                __syncthreads();
                const float m0 = mst[bhd * NTC + tc];
                float sc[16];
#pragma unroll
                for (int i = 0; i < 16; ++i) sc[i] = 0.f;
                for (int dk = 0; dk < 64; dk += 4) {
                    const uint2 qq = *(const uint2*)(ql + t * 64 + dk);
                    const float q0 = bf2f((u16)(qq.x & 0xFFFF)), q1 = bf2f((u16)(qq.x >> 16)), q2 = bf2f((u16)(qq.y & 0xFFFF)), q3 = bf2f((u16)(qq.y >> 16));
#pragma unroll
                    for (int i = 0; i < 16; ++i) {
                        const uint2 kk = *(const uint2*)(kl + (q4 * 16 + i) * 64 + dk);
                        sc[i] += q0 * bf2f((u16)(kk.x & 0xFFFF)) + q1 * bf2f((u16)(kk.x >> 16)) + q2 * bf2f((u16)(kk.y & 0xFFFF)) + q3 * bf2f((u16)(kk.y >> 16));
                    }
                }
                const float bt = btl[t];
                float ld[16]; float mx = -3.0e38f;
#pragma unroll
                for (int i = 0; i < 16; ++i) {
                    const int s = q4 * 16 + i;
                    const bool ok = d ? (s >= t) : (s <= t);
                    ld[i] = ok ? (bt - btl[s] + lil[s]) : -3.0e38f;
                    mx = fmaxf(mx, ld[i]);
                }
                mx = fmaxf(mx, __shfl_xor(mx, 1)); mx = fmaxf(mx, __shfl_xor(mx, 2));
                const float mt = fmaxf(bt + m0, mx);
                float rsum = 0.f;
#pragma unroll
                for (int i = 0; i < 16; ++i) {
                    const int s = q4 * 16 + i;
                    const bool ok = d ? (s >= t) : (s <= t);
                    const float dw = ok ? expf(ld[i] - mt) * sc[i] : 0.f;
                    rsum += dw;
                    Sl[t * 64 + s] = dw;
                }
                rsum += __shfl_xor(rsum, 1); rsum += __shfl_xor(rsum, 2);
                const float inter = expf(bt + m0 - mt);
                float qn = 0.f;
                for (int dk = q4 * 16; dk < q4 * 16 + 16; ++dk) qn += bf2f(ql[t * 64 + dk]) * nl[dk];
                qn += __shfl_xor(qn, 1); qn += __shfl_xor(qn, 2);
                const float den = rsum + inter * qn;
                __syncthreads();
                float num[16];
#pragma unroll
                for (int i = 0; i < 16; ++i) num[i] = 0.f;
                for (int s = 0; s < 64; ++s) {
                    const float dw = Sl[t * 64 + s];
                    const uint4 va = *(const uint4*)(vl + s * 64 + q4 * 16);
                    const uint4 vb2 = *(const uint4*)(vl + s * 64 + q4 * 16 + 8);
                    const unsigned vv[8] = {va.x, va.y, va.z, va.w, vb2.x, vb2.y, vb2.z, vb2.w};
#pragma unroll
                    for (int i = 0; i < 8; ++i) { num[2 * i] += dw * bf2f((u16)(vv[i] & 0xFFFF)); num[2 * i + 1] += dw * bf2f((u16)(vv[i] >> 16)); }
                }
                for (int dk = 0; dk < 64; ++dk) {
                    const float qv = bf2f(ql[t * 64 + dk]) * inter;
#pragma unroll
                    for (int i = 0; i < 16; i += 4) {
                        const float4 cv = *(const float4*)(Cl + dk * 64 + q4 * 16 + i);
                        num[i] += qv * cv.x; num[i + 1] += qv * cv.y; num[i + 2] += qv * cv.z; num[i + 3] += qv * cv.w;
                    }
                }
                const float dn = 1.f / fmaxf(fabsf(den), expf(-mt));
#pragma unroll
                for (int i = 0; i < 16; ++i) hs[i] += num[i] * dn;
            }
            float s1 = 0.f;
#pragma unroll
            for (int i = 0; i < 16; ++i) s1 += hs[i];
            s1 += __shfl_xor(s1, 1); s1 += __shfl_xor(s1, 2);
            const float mu = s1 * (1.f / 64.f);
            float s2 = 0.f;
#pragma unroll
            for (int i = 0; i < 16; ++i) { const float dlt = hs[i] - mu; s2 += dlt * dlt; }
            s2 += __shfl_xor(s2, 1); s2 += __shfl_xor(s2, 2);
            const float rstd = rsqrtf(s2 * (1.f / 64.f) + 1e-6f);
            const int row = row0 + t;
#pragma unroll
            for (int i = 0; i < 16; i += 2) {
                const int cc = h * 64 + q4 * 16 + i;
                const float o0 = bf2f(pc[(size_t)row * 1040 + 768 + cc]), o1 = bf2f(pc[(size_t)row * 1040 + 768 + cc + 1]);
                const float y0 = (hs[i] - mu) * rstd * p.ml_nw[l * 256 + cc] * sigmoidf_(o0);
                const float y1 = (hs[i + 1] - mu) * rstd * p.ml_nw[l * 256 + cc + 1] * sigmoidf_(o1);
                *(unsigned*)(y + (size_t)row * 1024 + 768 + cc) = (unsigned)f2bf(y0) | ((unsigned)f2bf(y1) << 16);
            }
        }
    }
}

DEVINL void ph_outproj(const P& p, int l, char* smem) {
    const int TIDX_ = tid_(); const int BIDX_ = bid_(); char* const WS_ = wsl_(p.ws); (void)TIDX_; (void)BIDX_; (void)WS_;
    const u16* y = (const u16*)(WS_ + OFF_Y);
    const u16* wout = (const u16*)(WS_ + OFF_WOUT);
    const float* modv = (const float*)(WS_ + OFF_MOD) + (size_t)l * 3 * 6144;
    const float* x2c = (const float*)(WS_ + OFF_X2CTX);
    float* x1 = (float*)(WS_ + OFF_X1);
    const int mt0 = (l == 0) ? 0 : 4;
    const int ntile = (260 - mt0) * 8;
    for (int u = BIDX_; u < ntile; u += gridDim.x) {
        const int mt = mt0 + u / 8, nt = u % 8;
        const u16* A = y + (size_t)mt * 128 * 1024;
        const int R0 = mt * 128;
        const float* xin;
        if (l == 0) xin = R0 < CTXROWS ? p.ctx + (size_t)R0 * 1024 : p.x + (size_t)(R0 - CTXROWS) * 1024;
        else xin = R0 < CTXROWS ? x2c + (size_t)R0 * 1024 : p.out + (size_t)(R0 - CTXROWS) * 1024;
        const float* g1 = modv + row_sel(R0) * 6144 + 2048;
        gemm128([&](int r) { return A + (size_t)r * 1024; }, wout + (size_t)nt * 128 * 1024, 1024, 1024, smem,
                [&](int m, int n, f32x4 a) {
                    const int N = nt * 128 + n;
                    const float gg = g1[N];
#pragma unroll
                    for (int j = 0; j < 4; ++j) x1[(size_t)(R0 + m + j) * 1024 + N] = ALPHA * xin[(size_t)(m + j) * 1024 + N] + gg * a[j];
                });
    }
}

DEVINL void ph_ln1(const P& p, int l) {
    const int TIDX_ = tid_(); const int BIDX_ = bid_(); char* const WS_ = wsl_(p.ws); (void)TIDX_; (void)BIDX_; (void)WS_;
    const int lane = TIDX_ & 63, wid = TIDX_ >> 6;
    const float* modv = (const float*)(WS_ + OFF_MOD) + (size_t)l * 3 * 6144;
    float* x1 = (float*)(WS_ + OFF_X1);
    u16* hm = (u16*)(WS_ + OFF_HM);
    const int rstart = (l == 0) ? 0 : CTXROWS;
    for (int row = rstart + BIDX_ * 4 + wid; row < T; row += gridDim.x * 4) {
        float4 v[4];
        float s = 0.f;
#pragma unroll
        for (int i = 0; i < 4; ++i) { v[i] = *(const float4*)(x1 + (size_t)row * 1024 + i * 256 + lane * 4); s += v[i].x + v[i].y + v[i].z + v[i].w; }
        const float mu = wsum(s) * (1.f / 1024.f);
        float q = 0.f;
#pragma unroll
        for (int i = 0; i < 4; ++i) { v[i].x -= mu; v[i].y -= mu; v[i].z -= mu; v[i].w -= mu; q += v[i].x * v[i].x + v[i].y * v[i].y + v[i].z * v[i].z + v[i].w * v[i].w; }
        const float rstd = rsqrtf(wsum(q) * (1.f / 1024.f) + 1e-5f);
        const float* mv = modv + row_sel(row) * 6144;
#pragma unroll
        for (int i = 0; i < 4; ++i) {
            const int c = i * 256 + lane * 4;
            const float4 g = *(const float4*)(p.ln1g + l * 1024 + c), bb = *(const float4*)(p.ln1b + l * 1024 + c);
            const float4 sh = *(const float4*)(mv + 3072 + c), sc = *(const float4*)(mv + 4096 + c);
            float4 o;
            o.x = v[i].x * rstd * g.x + bb.x; o.y = v[i].y * rstd * g.y + bb.y; o.z = v[i].z * rstd * g.z + bb.z; o.w = v[i].w * rstd * g.w + bb.w;
            *(float4*)(x1 + (size_t)row * 1024 + c) = o;
            uint2 hh;
            hh.x = (unsigned)f2bf(o.x * (1.f + sc.x) + sh.x) | ((unsigned)f2bf(o.y * (1.f + sc.y) + sh.y) << 16);
            hh.y = (unsigned)f2bf(o.z * (1.f + sc.z) + sh.z) | ((unsigned)f2bf(o.w * (1.f + sc.w) + sh.w) << 16);
            *(uint2*)(hm + (size_t)row * 1024 + c) = hh;
        }
    }
}

DEVINL void ph_router(const P& p, int l, char* smem) {
    const int TIDX_ = tid_(); const int BIDX_ = bid_(); char* const WS_ = wsl_(p.ws); (void)TIDX_; (void)BIDX_; (void)WS_;
    const u16* hm = (const u16*)(WS_ + OFF_HM);
    const u16* wr = (const u16*)(WS_ + OFF_WR) + (size_t)l * 128 * 1024;
    float* lg = (float*)(WS_ + OFF_LOGITS);
    const int mt0 = (l == 0) ? 0 : 4;
    for (int u = BIDX_; u < 260 - mt0; u += gridDim.x) {
        const int mt = mt0 + u;
        const u16* A = hm + (size_t)mt * 128 * 1024;
        gemm128([&](int r) { return A + (size_t)r * 1024; }, wr, 1024, 1024, smem,
                [&](int m, int n, f32x4 a) {
                    if (n < 36) {
#pragma unroll
                        for (int j = 0; j < 4; ++j) lg[(size_t)(mt * 128 + m + j) * 64 + n] = a[j];
                    }
                });
    }
}

DEVINL void ph_route1(const P& p, int l, char* smem) {
    const int TIDX_ = tid_(); const int BIDX_ = bid_(); char* const WS_ = wsl_(p.ws); (void)TIDX_; (void)BIDX_; (void)WS_;
    const int tid = TIDX_;
    const float* lg = (const float*)(WS_ + OFF_LOGITS);
    int* toke = (int*)(WS_ + OFF_TOKE); float* tokw = (float*)(WS_ + OFF_TOKW);
    int* cnt = (int*)(WS_ + CTL_CNT) + l * 32;
    int* hist = (int*)smem;
    __syncthreads();
    if (tid < 32) hist[tid] = 0;
    __syncthreads();
    const int rstart = (l == 0) ? 0 : CTXROWS;
    for (int row = rstart + BIDX_ * 256 + tid; row < T; row += gridDim.x * 256) {
        const float* q = lg + (size_t)row * 64;
        float gl[4]; int gs = 0; float gm = -3.0e38f;
#pragma unroll
        for (int i = 0; i < 4; ++i) { gl[i] = q[i] + p.rgb[l * 4 + i]; if (gl[i] > gm) { gm = gl[i]; gs = i; } }
        float se = 0.f;
#pragma unroll
        for (int i = 0; i < 4; ++i) se += expf(gl[i] - gm);
        const float gw = 1.f / se;
        float v1 = -3.0e38f, v2 = -3.0e38f; int i1 = 0, i2 = 0;
#pragma unroll
        for (int i = 0; i < 8; ++i) {
            const float e = q[4 + gs * 8 + i] + p.reb[l * 32 + gs * 8 + i];
            if (e > v1) { v2 = v1; i2 = i1; v1 = e; i1 = i; }
            else if (e > v2) { v2 = e; i2 = i; }
        }
        const float e2 = expf(v2 - v1);
        const float w1 = gw / (1.f + e2), w2 = gw * e2 / (1.f + e2);
        const int ea = gs * 8 + i1, eb = gs * 8 + i2;
        toke[row * 2] = ea; toke[row * 2 + 1] = eb; tokw[row * 2] = w1; tokw[row * 2 + 1] = w2;
        atomicAdd(&hist[ea], 1); atomicAdd(&hist[eb], 1);
    }
    __syncthreads();
    if (tid < 32 && hist[tid] > 0) atomicAdd(&cnt[tid], hist[tid]);
}

DEVINL void ph_route2(const P& p, int l, char* smem) {
    const int TIDX_ = tid_(); const int BIDX_ = bid_(); char* const WS_ = wsl_(p.ws); (void)TIDX_; (void)BIDX_; (void)WS_;
    const int tid = TIDX_;
    const int* toke = (const int*)(WS_ + OFF_TOKE);
    int* toks = (int*)(WS_ + OFF_TOKS);
    int* slottok = (int*)(WS_ + OFF_SLOTTOK);
    const int* cnt = (const int*)(WS_ + CTL_CNT) + l * 32;
    int* cur = (int*)(WS_ + CTL_CUR) + l * 32;
    int* tiles = (int*)(WS_ + OFF_TILES);
    int* off = (int*)smem;
    int* hist = off + 64;
    int* base = hist + 32;
    __syncthreads();
    if (tid == 0) { int a = 0; for (int e = 0; e < 32; ++e) { off[e] = a; a += (cnt[e] + 127) & ~127; } off[32] = a; }
    if (tid < 32) hist[tid] = 0;
    __syncthreads();
    if (BIDX_ == 0) {
        if (tid == 0) {
            int nt = 0;
            for (int e = 0; e < 32; ++e) for (int s = off[e]; s < off[e + 1]; s += 128) { tiles[64 + nt * 2] = e; tiles[64 + nt * 2 + 1] = s; ++nt; }
            tiles[40] = nt;
        }
        for (int e = 0; e < 32; ++e) for (int s = off[e] + cnt[e] + tid; s < off[e + 1]; s += 256) slottok[s] = (l == 0) ? 0 : CTXROWS;
    }
    const int rstart = (l == 0) ? 0 : CTXROWS;
    for (int a0 = rstart * 2 + BIDX_ * 256; a0 < T * 2; a0 += gridDim.x * 256) {
        const int a = a0 + tid;
        int e = -1, lpos = 0;
        if (a < T * 2) { e = toke[a]; lpos = atomicAdd(&hist[e], 1); }
        __syncthreads();
        if (tid < 32) { base[tid] = hist[tid] > 0 ? atomicAdd(&cur[tid], hist[tid]) : 0; }
        __syncthreads();
        if (e >= 0) { const int s = off[e] + base[e] + lpos; toks[a] = s; slottok[s] = a >> 1; }
        __syncthreads();
        if (tid < 32) hist[tid] = 0;
        __syncthreads();
    }
}

DEVINL void ph_gateup(const P& p, char* smem) {
    const int TIDX_ = tid_(); const int BIDX_ = bid_(); char* const WS_ = wsl_(p.ws); (void)TIDX_; (void)BIDX_; (void)WS_;
    const int tid = TIDX_, lane = tid & 63, wid = tid >> 6, wr = wid >> 1, wc = wid & 1, fr = lane & 15, fq = lane >> 4;
    const u16* hm = (const u16*)(WS_ + OFF_HM);
    const u16* wgu = (const u16*)(WS_ + OFF_WGU);
    const int* tiles = (const int*)(WS_ + OFF_TILES);
    const int* slottok = (const int*)(WS_ + OFF_SLOTTOK);
    u16* act = (u16*)(WS_ + OFF_ACT);
    const int ntile = tiles[40] * 8;
    for (int u = BIDX_; u < ntile; u += gridDim.x) {
        const int ti = u >> 3, nt = u & 7;
        const int e = tiles[64 + ti * 2], s0 = tiles[64 + ti * 2 + 1];
        f32x4 acc[4][4];
        gemm128_acc([&](int r) { return hm + (size_t)slottok[s0 + r] * 1024; }, wgu + ((size_t)e * 1024 + nt * 128) * 1024, 1024, 1024, smem, acc);
#pragma unroll
        for (int m = 0; m < 4; ++m)
#pragma unroll
            for (int n = 0; n < 4; n += 2) {
                const int jcol = (nt * 128 + wc * 64 + n * 16) / 2 + fr;
                const int srow = s0 + wr * 64 + m * 16 + fq * 4;
#pragma unroll
                for (int j = 0; j < 4; ++j) {
                    const float gte = acc[m][n][j], up = acc[m][n + 1][j];
                    act[(size_t)(srow + j) * 512 + jcol] = f2bf(gte / (1.f + __expf(-gte)) * up);
                }
            }
    }
}

DEVINL void ph_down(const P& p, char* smem) {
    const int TIDX_ = tid_(); const int BIDX_ = bid_(); char* const WS_ = wsl_(p.ws); (void)TIDX_; (void)BIDX_; (void)WS_;
    const u16* act = (const u16*)(WS_ + OFF_ACT);
    const u16* wdn = (const u16*)(WS_ + OFF_WDN);
    const int* tiles = (const int*)(WS_ + OFF_TILES);
    u16* so = (u16*)(WS_ + OFF_SLOTOUT);
    const int ntile = tiles[40] * 8;
    for (int u = BIDX_; u < ntile; u += gridDim.x) {
        const int ti = u >> 3, nt = u & 7;
        const int e = tiles[64 + ti * 2], s0 = tiles[64 + ti * 2 + 1];
        const u16* A = act + (size_t)s0 * 512;
        gemm128([&](int r) { return A + (size_t)r * 512; }, wdn + ((size_t)e * 1024 + nt * 128) * 512, 512, 512, smem,
                [&](int m, int n, f32x4 a) {
                    u16* q = so + (size_t)(s0 + m) * 1024 + nt * 128 + n;
                    q[0] = f2bf(a[0]); q[1024] = f2bf(a[1]); q[2048] = f2bf(a[2]); q[3072] = f2bf(a[3]);
                });
    }
}

DEVINL void ph_ln2(const P& p, int l) {
    const int TIDX_ = tid_(); const int BIDX_ = bid_(); char* const WS_ = wsl_(p.ws); (void)TIDX_; (void)BIDX_; (void)WS_;
    const int lane = TIDX_ & 63, wid = TIDX_ >> 6;
    const float* modv = (const float*)(WS_ + OFF_MOD) + (size_t)l * 3 * 6144;
    const float* modn = (const float*)(WS_ + OFF_MOD) + (size_t)(l + 1) * 3 * 6144;
    const float* x1 = (const float*)(WS_ + OFF_X1);
    const u16* so = (const u16*)(WS_ + OFF_SLOTOUT);
    const int* toks = (const int*)(WS_ + OFF_TOKS);
    const float* tokw = (const float*)(WS_ + OFF_TOKW);
    float* x2c = (float*)(WS_ + OFF_X2CTX);
    u16* hm = (u16*)(WS_ + OFF_HM);
    const int rstart = (l == 0) ? 0 : CTXROWS;
    for (int row = rstart + BIDX_ * 4 + wid; row < T; row += gridDim.x * 4) {
        const int sa = toks[row * 2], sb = toks[row * 2 + 1];
        const float wa = tokw[row * 2], wb = tokw[row * 2 + 1];
        const float* mv = modv + row_sel(row) * 6144;
        float4 v[4];
        float s = 0.f;
#pragma unroll
        for (int i = 0; i < 4; ++i) {
            const int c = i * 256 + lane * 4;
            const float4 xv = *(const float4*)(x1 + (size_t)row * 1024 + c);
            const uint2 ua = *(const uint2*)(so + (size_t)sa * 1024 + c), ub = *(const uint2*)(so + (size_t)sb * 1024 + c);
            const float4 g2 = *(const float4*)(mv + 5120 + c);
            const float f0 = wa * bf2f((u16)(ua.x & 0xFFFF)) + wb * bf2f((u16)(ub.x & 0xFFFF));
            const float f1 = wa * bf2f((u16)(ua.x >> 16)) + wb * bf2f((u16)(ub.x >> 16));
            const float f2 = wa * bf2f((u16)(ua.y & 0xFFFF)) + wb * bf2f((u16)(ub.y & 0xFFFF));
            const float f3 = wa * bf2f((u16)(ua.y >> 16)) + wb * bf2f((u16)(ub.y >> 16));
            v[i].x = ALPHA * xv.x + g2.x * f0; v[i].y = ALPHA * xv.y + g2.y * f1; v[i].z = ALPHA * xv.z + g2.z * f2; v[i].w = ALPHA * xv.w + g2.w * f3;
            s += v[i].x + v[i].y + v[i].z + v[i].w;
        }
        const float mu = wsum(s) * (1.f / 1024.f);
        float q = 0.f;
#pragma unroll
        for (int i = 0; i < 4; ++i) { v[i].x -= mu; v[i].y -= mu; v[i].z -= mu; v[i].w -= mu; q += v[i].x * v[i].x + v[i].y * v[i].y + v[i].z * v[i].z + v[i].w * v[i].w; }
        const float rstd = rsqrtf(wsum(q) * (1.f / 1024.f) + 1e-5f);
        float* dst = row < CTXROWS ? x2c + (size_t)row * 1024 : p.out + (size_t)(row - CTXROWS) * 1024;
        const float* mn = modn + row_sel(row) * 6144;
#pragma unroll
        for (int i = 0; i < 4; ++i) {
            const int c = i * 256 + lane * 4;
            const float4 g = *(const float4*)(p.ln2g + l * 1024 + c), bb = *(const float4*)(p.ln2b + l * 1024 + c);
            float4 o;
            o.x = v[i].x * rstd * g.x + bb.x; o.y = v[i].y * rstd * g.y + bb.y; o.z = v[i].z * rstd * g.z + bb.z; o.w = v[i].w * rstd * g.w + bb.w;
            *(float4*)(dst + c) = o;
            if (l == 0) {
                const float4 sh = *(const float4*)(mn + c), sc = *(const float4*)(mn + 1024 + c);
                uint2 hh;
                hh.x = (unsigned)f2bf(o.x * (1.f + sc.x) + sh.x) | ((unsigned)f2bf(o.y * (1.f + sc.y) + sh.y) << 16);
                hh.y = (unsigned)f2bf(o.z * (1.f + sc.z) + sh.z) | ((unsigned)f2bf(o.w * (1.f + sc.w) + sh.w) << 16);
                *(uint2*)(hm + (size_t)row * 1024 + c) = hh;
            }
        }
    }
}

DEVINL void gbar(XcdBarrier b) {
    unsigned x = b.x; GAS unsigned* q = (GAS unsigned*)b.bar;
    asm volatile("" : "+s"(x), "+s"(q));
    b.x = x; b.bar = (unsigned*)q;
    xcd_barrier(b);
}
__global__ void __launch_bounds__(256, 2) k_mega(P p) {
    __shared__ __attribute__((aligned(16))) char smem[65536];
    __shared__ uint4 xb_words;
    if (threadIdx.x == 0) xb_words = make_uint4(0u, 0u, 0u, 0u);
    __syncthreads();
    XcdBarrier bar = xcd_barrier_post((unsigned*)p.ws, (volatile LAS unsigned*)&xb_words);
    const int bid = blockIdx.x, nb = gridDim.x;
    ph_prolog(p, smem);
    ph_convw(p, 0, smem);
    gbar(bar);
    ph_xm0(p);
    gbar(bar);
#pragma unroll 1
    for (int l = 0; l < NLAYER; ++l) {
        ph_inproj(p, smem);
        gbar(bar);
        ph_rwprep(p, l, 0, smem);
        ph_prepM(p, l, smem);
        gbar(bar);
        if (bid < 8) ph_rwscan(p, l, 0, bid, 8);
        else { ph_mlB(p, bid - 8, nb - 8); ph_na(p, l, smem, bid - 8, nb - 8); }
        gbar(bar);
        ph_rwprep(p, l, 1, smem);
        gbar(bar);
        if (bid < 8) ph_rwscan(p, l, 1, bid, 8);
        else ph_mlC(p, l, smem, bid - 8, nb - 8);
        gbar(bar);
        ph_rwout(p, l);
        gbar(bar);
        ph_outproj(p, l, smem);
        ph_convexp(p, l, smem);
        gbar(bar);
        ph_ln1(p, l);
        gbar(bar);
        ph_router(p, l, smem);
        gbar(bar);
        ph_route1(p, l, smem);
        gbar(bar);
        ph_route2(p, l, smem);
        gbar(bar);
        ph_gateup(p, smem);
        gbar(bar);
        ph_down(p, smem);
        gbar(bar);
        ph_ln2(p, l);
        if (l + 1 < NLAYER) ph_convw(p, l + 1, smem);
        gbar(bar);
    }
}

extern "C" void kernel_launch(void* const* d_in, const int* in_sizes, int n_in, void* d_out, int out_size, void* d_ws, size_t ws_size,
                              hipStream_t stream) {
    if (n_in != 37 || ws_size < WS_NEED) { fprintf(stderr, "kernel_launch: n_in %d ws %zu need %zu\n", n_in, ws_size, (size_t)WS_NEED); return; }
    static int grid = 0;
    if (!grid) {
        int dev = 0, cus = 0, per_cu = 0;
        (void)hipGetDevice(&dev);
        (void)hipDeviceGetAttribute(&cus, hipDeviceAttributeMultiprocessorCount, dev);
        (void)hipOccupancyMaxActiveBlocksPerMultiprocessor(&per_cu, (const void*)k_mega, 256, 0);
        if (per_cu < 1) per_cu = 1;
        grid = cus * (per_cu < 2 ? per_cu : 2);
    }
    P p{};
    const float** pp = (const float**)&p;
    for (int i = 0; i < 37; ++i) pp[i] = (const float*)d_in[i];
    p.out = (float*)d_out; p.ws = (char*)d_ws;
    (void)hipMemsetAsync(d_ws, 0, CTL_BYTES, stream);
    k_mega<<<dim3(grid), dim3(256), 0, stream>>>(p);
}
```

```cpp
#include <hip/hip_runtime.h>
#include <hip/hip_bf16.h>
#include <stdint.h>
#include <stdio.h>
#include <type_traits>

#define DEVINL __device__ __forceinline__
typedef unsigned short u16;
using bf16x8 = __attribute__((ext_vector_type(8))) short;
using f32x4 = __attribute__((ext_vector_type(4))) float;

constexpr int D = 1024, LAT = 16384, LCTX = 256, T = 33280, CTXROWS = 512;
constexpr int INP = 3536;
constexpr int NLAYER = 2;
constexpr float ALPHA = 1.41421356237309515f;
constexpr int NUNIT_CH = 520;
constexpr int NTC = 260;
constexpr int MAXSLOT = 70656;

constexpr size_t al(size_t x) { return (x + 255) & ~(size_t)255; }
constexpr size_t CTL_CNT = 16384;
constexpr size_t CTL_CUR = CTL_CNT + 256;
constexpr size_t CTL_BYTES = 32768;
constexpr size_t OFF_MOD = CTL_BYTES;
constexpr size_t OFF_ROPE = OFF_MOD + al(2 * 3 * 6144 * 4);
constexpr size_t OFF_WR = OFF_ROPE + al(10240 * 4);
constexpr size_t OFF_LORA = OFF_WR + al(2 * 128 * 1024 * 2);
constexpr size_t OFF_TILES = OFF_LORA + al(3 * 65536);
constexpr size_t OFF_TOKE = OFF_TILES + al((64 + 2048) * 4);
constexpr size_t OFF_TOKW = OFF_TOKE + al((size_t)T * 2 * 4);
constexpr size_t OFF_TOKS = OFF_TOKW + al((size_t)T * 2 * 4);
constexpr size_t OFF_SLOTTOK = OFF_TOKS + al((size_t)T * 2 * 4);
constexpr size_t OFF_X2CTX = OFF_SLOTTOK + al((size_t)MAXSLOT * 4);
constexpr size_t OFF_WIN = OFF_X2CTX + al((size_t)512 * 1024 * 4);
constexpr size_t OFF_WOUT = OFF_WIN + al((size_t)3584 * 1024 * 2);
constexpr size_t OFF_X1 = OFF_WOUT + al((size_t)1024 * 1024 * 2);
constexpr size_t OFF_HM = OFF_X1 + al((size_t)T * 1024 * 4);
constexpr size_t OFF_P = OFF_HM + al((size_t)T * 1024 * 2);
constexpr size_t OFF_PQK = OFF_P;
constexpr size_t OFF_VTL = OFF_PQK + (size_t)T * 1024 * 2;
constexpr size_t OFF_VTC = OFF_VTL + (size_t)2 * 8 * 64 * 16384 * 2;
constexpr size_t OFF_PB = OFF_VTC + (size_t)2 * 8 * 64 * 256 * 2;
constexpr size_t OFF_PC = OFF_PB + (size_t)T * 960 * 2;
constexpr size_t OFF_Y = OFF_PC + (size_t)T * 1040 * 2;
constexpr size_t OFF_MLF = OFF_Y + (size_t)T * 1024 * 2;
constexpr size_t OFF_GATE = OFF_MLF + (size_t)T * 512 * 2;
constexpr size_t OFF_MLG = OFF_GATE + (size_t)T * 256 * 2;
constexpr size_t OFF_MLS = OFF_MLG + (size_t)T * 16 * 4;
constexpr size_t OFF_MST = OFF_MLS + al(16 * 260 * 2 * 4);
constexpr size_t OFF_NST = OFF_MST + al(16 * 260 * 4);
constexpr size_t OFF_END1 = OFF_NST + al(16 * 260 * 64 * 4);
constexpr size_t OFF_WGU = OFF_P;
constexpr size_t OFF_WDN = OFF_WGU + (size_t)32 * 1024 * 1024 * 2;
constexpr size_t OFF_ACT = OFF_WDN + (size_t)32 * 1024 * 512 * 2;
constexpr size_t OFF_SLOTOUT = OFF_ACT + (size_t)MAXSLOT * 512 * 2;
constexpr size_t OFF_LOGITS = OFF_SLOTOUT + (size_t)MAXSLOT * 1024 * 2;
constexpr size_t OFF_END2 = OFF_LOGITS + (size_t)T * 64 * 4;
constexpr size_t WS_NEED = OFF_END1 > OFF_END2 ? OFF_END1 : OFF_END2;
static_assert(OFF_WDN <= OFF_Y, "Wexp must not overlap y");
static_assert(OFF_LOGITS >= OFF_MLF, "logits placement");

struct P {
    const float *x, *c, *ctx, *c_ctx, *w_mod, *b_mod, *w_in, *na_rpb, *mu_prev, *mu_next, *rw_w0, *rw_w2, *rw_a0, *rw_a2,
        *rw_g2, *rw_kk, *rw_ka, *rw_rk, *rw_lnw, *rw_lnb, *ml_cw, *ml_cb, *ml_ib, *ml_fb, *ml_nw, *w_out, *ln1g, *ln1b,
        *rgw, *rgb, *rew, *reb, *egate, *eup, *edown, *ln2g, *ln2b;
    float* out;
    char* ws;
};

#define XB_TMO      128
#define XB_XCNT(j)  (256  + 64 * (j))
#define XB_XSUB(j)  (1280 + 64 * (j))
#define XB_XGEN(j)  (2304 + 64 * (j))
#define XB_TOP      3328
#define XB_TOPGEN   3392
#define XCD_BAR_WORDS 3456
#define XB_SPIN_CAP (1u << 18)
#define LAS __attribute__((address_space(3)))

__device__ __forceinline__ unsigned xb_ld(unsigned* p)              { return __hip_atomic_load(p, __ATOMIC_RELAXED, __HIP_MEMORY_SCOPE_AGENT); }
__device__ __forceinline__ unsigned xb_add(unsigned* p, unsigned v) { return __hip_atomic_fetch_add(p, v, __ATOMIC_RELAXED, __HIP_MEMORY_SCOPE_AGENT); }
__device__ __forceinline__ unsigned xb_xcc_id() { return (unsigned)__builtin_amdgcn_s_getreg((3 << 11) | 20) & 0xFu; }
#define XB_SPIN(cond, bar) do { unsigned _sp = 0; while (cond) { __builtin_amdgcn_s_sleep(1); \
    if ((++_sp & 255u) == 0u) { if (xb_ld(&(bar)[XB_TMO])) break; if (_sp > XB_SPIN_CAP) { atomicAdd(&(bar)[XB_TMO], 1u); break; } } } } while (0)

struct XcdBarrier {
    unsigned* bar; unsigned x;
    volatile LAS unsigned* st;
};

__device__ __forceinline__ XcdBarrier xcd_barrier_post(unsigned* bar, volatile LAS unsigned* st) {
    XcdBarrier b; b.bar = bar; b.x = xb_xcc_id(); b.st = st;
    if (threadIdx.x == 0) (void)xb_add(&bar[XB_XCNT(b.x)], 1u);
    return b;
}
__device__ __forceinline__ void xcd_barrier_complete(unsigned* bar, unsigned x, unsigned& nloc, unsigned& nx) {
    const unsigned G = gridDim.x * gridDim.y * gridDim.z;
    unsigned sum, cnt, mine, sp = 0u;
    for (;;) {
        sum = 0u; cnt = 0u; mine = 0u;
#pragma unroll
        for (unsigned j = 0; j < 16; ++j) { const unsigned c = xb_ld(&bar[XB_XCNT(j)]); sum += c; cnt += (c > 0u) ? 1u : 0u; mine = (j == x) ? c : mine; }
        if (sum == G) break;
        __builtin_amdgcn_s_sleep(1);
        if ((++sp & 255u) == 0u) { if (xb_ld(&bar[XB_TMO])) break; if (sp > XB_SPIN_CAP) { atomicAdd(&bar[XB_TMO], 1u); break; } }
    }
    nloc = mine > 0u ? mine : 1u; nx = cnt > 0u ? cnt : 1u;
}

__device__ __forceinline__ void xcd_barrier(const XcdBarrier& b) {
    asm volatile("s_waitcnt vmcnt(0)" ::: "memory");
    __syncthreads();
    if (threadIdx.x == 0) {
        unsigned* bar = b.bar;
        __builtin_amdgcn_s_waitcnt(0);
        unsigned nloc = b.st[0], nx = b.st[1];
        if (nloc == 0u) { xcd_barrier_complete(bar, b.x, nloc, nx); b.st[0] = nloc; b.st[1] = nx; }
        const unsigned old = xb_add(&bar[XB_XSUB(b.x)], 1u);
        const unsigned gen = old / nloc;
        if (old + 1u == (gen + 1u) * nloc) {
            __builtin_amdgcn_fence(__ATOMIC_RELEASE, "agent");
            asm volatile("s_waitcnt vmcnt(0)" ::: "memory");
            const unsigned og = xb_add(&bar[XB_TOP], 1u);
            const unsigned tg = og / nx;
            if (og + 1u == (tg + 1u) * nx) xb_add(&bar[XB_TOPGEN], 1u);
            else XB_SPIN(xb_ld(&bar[XB_TOPGEN]) == tg, bar);
            __builtin_amdgcn_fence(__ATOMIC_ACQUIRE, "agent");
            xb_add(&bar[XB_XGEN(b.x)], 1u);
            asm volatile("s_waitcnt vmcnt(0)" ::: "memory");
        } else {
            XB_SPIN(xb_ld(&bar[XB_XGEN(b.x)]) == gen, bar);
            __builtin_amdgcn_fence(__ATOMIC_ACQUIRE, "agent");
            asm volatile("s_waitcnt vmcnt(0)" ::: "memory");
        }
    }
    __syncthreads();
}


DEVINL int tid_() { int t = threadIdx.x; asm volatile("" : "+v"(t)); return t; }
DEVINL int bid_() { int b = blockIdx.x; asm volatile("" : "+s"(b)); return b; }
#define GAS __attribute__((address_space(1)))
DEVINL char* wsl_(char* w) { GAS char* g = (GAS char*)w; asm volatile("" : "+s"(g)); return (char*)g; }
template <class Tp> DEVINL const Tp* gl_(const Tp* q) { const GAS Tp* g = (const GAS Tp*)q; asm volatile("" : "+s"(g)); return (const Tp*)g; }
DEVINL u16 f2bf(float f) { unsigned u = __float_as_uint(f); u += 0x7FFFu + ((u >> 16) & 1u); return (u16)(u >> 16); }
DEVINL float bf2f(u16 h) { return __uint_as_float(((unsigned)h) << 16); }
DEVINL float wsum(float v) { for (int o = 32; o > 0; o >>= 1) v += __shfl_xor(v, o); return v; }
DEVINL float sigmoidf_(float x) { return 1.f / (1.f + __expf(-x)); }
DEVINL float siluf_(float x) { return x / (1.f + __expf(-x)); }
DEVINL float softplusf_(float x) { return fmaxf(x, 0.f) + log1pf(__expf(-fabsf(x))); }
DEVINL int row_sel(int row) { return row < CTXROWS ? 2 : ((row - CTXROWS) >> 14); }
template <int CTRL, int RM>
DEVINL float dpp_f(float v) { return __int_as_float(__builtin_amdgcn_update_dpp(0, __float_as_int(v), CTRL, RM, 0xF, false)); }
DEVINL float wave_sum_dpp(float v) {
    v += dpp_f<0xB1, 0xF>(v);
    v += dpp_f<0x4E, 0xF>(v);
    v += dpp_f<0x141, 0xF>(v);
    v += dpp_f<0x140, 0xF>(v);
    v += dpp_f<0x142, 0xA>(v);
    v += dpp_f<0x143, 0xC>(v);
    return __int_as_float(__builtin_amdgcn_readlane(__float_as_int(v), 63));
}
DEVINL unsigned lds_addr(const void* p) { return (unsigned)(size_t)(const __attribute__((address_space(3))) char*)p; }
using u32x4 = __attribute__((ext_vector_type(4))) unsigned;
using u32x2 = __attribute__((ext_vector_type(2))) unsigned;
template <int OFF> DEVINL u32x4 lds_rd128(unsigned a) { u32x4 v; asm volatile("ds_read_b128 %0, %1 offset:%2" : "=v"(v) : "v"(a), "n"(OFF)); return v; }
template <int OFF> DEVINL u32x2 lds_rd64(unsigned a) { u32x2 v; asm volatile("ds_read_b64 %0, %1 offset:%2" : "=v"(v) : "v"(a), "n"(OFF)); return v; }
DEVINL void glds4(const void* g, void* l) {
    __builtin_amdgcn_global_load_lds((const __attribute__((address_space(1))) void*)g, (__attribute__((address_space(3))) void*)l, 4, 0, 0);
}
DEVINL void glds16(const void* g, void* l) {
    __builtin_amdgcn_global_load_lds((const __attribute__((address_space(1))) void*)g, (__attribute__((address_space(3))) void*)l, 16, 0, 0);
}

template <class RowA>
DEVINL void gemm128_acc(RowA rowA, const u16* __restrict__ Bt, int ldb, int K, char* smem, f32x4 (&acc)[4][4]) {
    const int tid = tid_(), lane = tid & 63, wid = tid >> 6, wr = wid >> 1, wc = wid & 1, fr = lane & 15, fq = lane >> 4;
#pragma unroll
    for (int m = 0; m < 4; ++m)
#pragma unroll
        for (int n = 0; n < 4; ++n) acc[m][n] = f32x4{0.f, 0.f, 0.f, 0.f};
    const u16* aS0 = rowA(tid >> 2) + (tid & 3) * 8;
    const u16* aS1 = rowA((tid >> 2) + 64) + (tid & 3) * 8;
    const u16* bS0 = Bt + (size_t)(tid >> 2) * ldb + (tid & 3) * 8;
    const u16* bS1 = Bt + (size_t)((tid >> 2) + 64) * ldb + (tid & 3) * 8;
    const int nt = K >> 5;
    __syncthreads();
    {
        char* SA = smem; char* SB = smem + 8192;
        glds16(aS0, SA + tid * 16); glds16(aS1, SA + tid * 16 + 4096);
        glds16(bS0, SB + tid * 16); glds16(bS1, SB + tid * 16 + 4096);
    }
    for (int t = 0; t < nt; ++t) {
        asm volatile("s_waitcnt vmcnt(0)" ::: "memory");
        __builtin_amdgcn_s_barrier();
        if (t + 1 < nt) {
            char* SA = smem + ((t + 1) & 1) * 16384; char* SB = SA + 8192;
            const int ko = (t + 1) * 32;
            glds16(aS0 + ko, SA + tid * 16); glds16(aS1 + ko, SA + tid * 16 + 4096);
            glds16(bS0 + ko, SB + tid * 16); glds16(bS1 + ko, SB + tid * 16 + 4096);
        }
        const char* SA = smem + (t & 1) * 16384; const char* SB = SA + 8192;
        bf16x8 af[4], bfr[4];
#pragma unroll
        for (int m = 0; m < 4; ++m) af[m] = *(const bf16x8*)(SA + (wr * 64 + m * 16 + fr) * 64 + fq * 16);
#pragma unroll
        for (int n = 0; n < 4; ++n) bfr[n] = *(const bf16x8*)(SB + (wc * 64 + n * 16 + fr) * 64 + fq * 16);
#pragma unroll
        for (int m = 0; m < 4; ++m)
#pragma unroll
            for (int n = 0; n < 4; ++n) acc[m][n] = __builtin_amdgcn_mfma_f32_16x16x32_bf16(af[m], bfr[n], acc[m][n], 0, 0, 0);
    }
}
template <class RowA, class Epi>
DEVINL void gemm128(RowA rowA, const u16* __restrict__ Bt, int ldb, int K, char* smem, Epi epi) {
    const int tid = tid_(), lane = tid & 63, wid = tid >> 6, wr = wid >> 1, wc = wid & 1, fr = lane & 15, fq = lane >> 4;
    f32x4 acc[4][4];
    gemm128_acc(rowA, Bt, ldb, K, smem, acc);
#pragma unroll
    for (int m = 0; m < 4; ++m)
#pragma unroll
        for (int n = 0; n < 4; ++n) epi(wr * 64 + m * 16 + fq * 4, wc * 64 + n * 16 + fr, acc[m][n]);
}

DEVINL void ph_prolog(const P& p, char* smem) {
    const int TIDX_ = tid_(); const int BIDX_ = bid_(); char* const WS_ = wsl_(p.ws); (void)TIDX_; (void)BIDX_; (void)WS_;
    const int tid = TIDX_;
    float* modv = (float*)(WS_ + OFF_MOD);
    float* sil = (float*)smem;
    float* red = sil + 3072;
    bool ready = false;
    for (int u = BIDX_; u < 192; u += gridDim.x) {
        if (!ready) {
            for (int i = tid; i < 3072; i += 256) { int v = i >> 10, k = i & 1023; float cv = v < 2 ? p.c[v * 1024 + k] : p.c_ctx[k]; sil[i] = cv / (1.f + expf(-cv)); }
            ready = true;
        }
        __syncthreads();
        const int l = u / 96, cg = u % 96;
        const float* W = p.w_mod + (size_t)l * 1024 * 6144 + cg * 64;
        const int c4 = (tid & 15) * 4, rg = tid >> 4;
        float a0[4] = {0, 0, 0, 0}, a1[4] = {0, 0, 0, 0}, a2[4] = {0, 0, 0, 0};
#pragma unroll 4
        for (int i = 0; i < 64; ++i) {
            const int k = rg + 16 * i;
            const float4 w = *(const float4*)(W + (size_t)k * 6144 + c4);
            const float s0 = sil[k], s1 = sil[1024 + k], s2 = sil[2048 + k];
            a0[0] += s0 * w.x; a0[1] += s0 * w.y; a0[2] += s0 * w.z; a0[3] += s0 * w.w;
            a1[0] += s1 * w.x; a1[1] += s1 * w.y; a1[2] += s1 * w.z; a1[3] += s1 * w.w;
            a2[0] += s2 * w.x; a2[1] += s2 * w.y; a2[2] += s2 * w.z; a2[3] += s2 * w.w;
        }
#pragma unroll
        for (int j = 0; j < 4; ++j) { red[(rg * 3 + 0) * 64 + c4 + j] = a0[j]; red[(rg * 3 + 1) * 64 + c4 + j] = a1[j]; red[(rg * 3 + 2) * 64 + c4 + j] = a2[j]; }
        __syncthreads();
        if (tid < 192) {
            const int v = tid >> 6, cc = tid & 63;
            float s = 0.f;
            for (int r = 0; r < 16; ++r) s += red[(r * 3 + v) * 64 + cc];
            const int col = cg * 64 + cc;
            modv[(l * 3 + v) * 6144 + col] = s + p.b_mod[l * 6144 + col];
        }
        __syncthreads();
    }
    float* rope = (float*)(WS_ + OFF_ROPE);
    for (int i = BIDX_ * 256 + tid; i < 320 * 16; i += gridDim.x * 256) {
        const int pos = (i < 4096) ? (i >> 4) : ((i - 4096) >> 4);
        const int f = i & 15;
        const float inv = powf(10000.0f, -(float)f / 16.0f);
        const float ang = (float)pos * inv;
        const double TWO_PI = 6.283185307179586476925;
        double a = (double)ang;
        a -= TWO_PI * rint(a / TWO_PI);
        const float cr = (float)cos(a), sr = (float)sin(a);
        if (i < 4096) { rope[i] = cr; rope[4096 + i] = sr; }
        else { rope[8192 + (i - 4096)] = cr; rope[8192 + 1024 + (i - 4096)] = sr; }
    }
    {
        u16* w2t = (u16*)(WS_ + OFF_LORA); u16* a2t = w2t + 2 * 2 * 256 * 32; u16* g2t = a2t + 2 * 2 * 256 * 32;
        for (int i = BIDX_ * 256 + tid; i < 2 * 2 * 256 * 32; i += gridDim.x * 256) {
            const int lz = i >> 13, c = (i >> 5) & 255, r = i & 31;
            w2t[i] = f2bf(p.rw_w2[((size_t)lz * 32 + r) * 256 + c]);
            a2t[i] = f2bf(p.rw_a2[((size_t)lz * 32 + r) * 256 + c]);
        }
        for (int i = BIDX_ * 256 + tid; i < 2 * 256 * 64; i += gridDim.x * 256) {
            const int l = i >> 14, c = (i >> 6) & 255, r = i & 63;
            g2t[i] = f2bf(p.rw_g2[((size_t)l * 64 + r) * 256 + c]);
        }
    }
    u16* wr = (u16*)(WS_ + OFF_WR);
    for (int i = BIDX_ * 256 + tid; i < 2 * 128 * 1024; i += gridDim.x * 256) {
        const int l = i >> 17, n = (i >> 10) & 127, k = i & 1023;
        float v = 0.f;
        if (n < 4) v = p.rgw[((size_t)l * 1024 + k) * 4 + n];
        else if (n < 36) v = p.rew[((size_t)l * 1024 + k) * 32 + (n - 4)];
        wr[i] = f2bf(v);
    }
}

DEVINL void conv_tile(const float* __restrict__ src, int N, int K, u16* __restrict__ dst, int k0, int n0, int mode, char* smem) {
    u16* t = (u16*)smem;
    const int tid = tid_();
    __syncthreads();
#pragma unroll 4
    for (int i = 0; i < 16; ++i) {
        const int k = i * 4 + (tid >> 6), n = tid & 63;
        float v = 0.f;
        if (n0 + n < N) v = src[(size_t)(k0 + k) * N + n0 + n];
        t[n * 68 + k] = f2bf(v);
    }
    __syncthreads();
#pragma unroll
    for (int i = 0; i < 4; ++i) {
        const int n = i * 16 + (tid >> 4), kq = (tid & 15) * 4;
        const int ng = n0 + n;
        int nd = ng;
        if (mode == 1) nd = 32 * (ng >> 4) + (ng & 15);
        else if (mode == 2) nd = 32 * (ng >> 4) + 16 + (ng & 15);
        uint2 v;
        v.x = (unsigned)t[n * 68 + kq] | ((unsigned)t[n * 68 + kq + 1] << 16);
        v.y = (unsigned)t[n * 68 + kq + 2] | ((unsigned)t[n * 68 + kq + 3] << 16);
        *(uint2*)(dst + (size_t)nd * K + k0 + kq) = v;
    }
}
DEVINL void ph_convw(const P& p, int l, char* smem) {
    const int TIDX_ = tid_(); const int BIDX_ = bid_(); char* const WS_ = wsl_(p.ws); (void)TIDX_; (void)BIDX_; (void)WS_;
    u16* win = (u16*)(WS_ + OFF_WIN); u16* wout = (u16*)(WS_ + OFF_WOUT);
    for (int u = BIDX_; u < 896 + 256; u += gridDim.x) {
        if (u < 896) conv_tile(p.w_in + (size_t)l * 1024 * INP, INP, 1024, win, (u / 56) * 64, (u % 56) * 64, 0, smem);
        else { const int v = u - 896; conv_tile(p.w_out + (size_t)l * 1024 * 1024, 1024, 1024, wout, (v / 16) * 64, (v % 16) * 64, 0, smem); }
    }
}
DEVINL void ph_convexp(const P& p, int l, char* smem) {
    const int TIDX_ = tid_(); const int BIDX_ = bid_(); char* const WS_ = wsl_(p.ws); (void)TIDX_; (void)BIDX_; (void)WS_;
    u16* wgu = (u16*)(WS_ + OFF_WGU); u16* wdn = (u16*)(WS_ + OFF_WDN);
    for (int u = BIDX_; u < 32 * 384; u += gridDim.x) {
        const int e = u / 384, v = u % 384;
        const size_t le = (size_t)l * 32 + e;
        if (v < 128) conv_tile(p.egate + le * 1024 * 512, 512, 1024, wgu + (size_t)e * 1024 * 1024, (v / 8) * 64, (v % 8) * 64, 1, smem);
        else if (v < 256) { const int w = v - 128; conv_tile(p.eup + le * 1024 * 512, 512, 1024, wgu + (size_t)e * 1024 * 1024, (w / 8) * 64, (w % 8) * 64, 2, smem); }
        else { const int w = v - 256; conv_tile(p.edown + le * 512 * 1024, 1024, 512, wdn + (size_t)e * 1024 * 512, (w / 16) * 64, (w % 16) * 64, 0, smem); }
    }
}

DEVINL void ph_xm0(const P& p) {
    const int TIDX_ = tid_(); const int BIDX_ = bid_(); char* const WS_ = wsl_(p.ws); (void)TIDX_; (void)BIDX_; (void)WS_;
    const float* modv = (const float*)(WS_ + OFF_MOD);
    u16* hm = (u16*)(WS_ + OFF_HM);
    for (size_t i = (size_t)BIDX_ * 256 + TIDX_; i < (size_t)T * 256; i += (size_t)gridDim.x * 256) {
        const int row = (int)(i >> 8), c4 = (int)(i & 255) * 4;
        const float* src = row < CTXROWS ? p.ctx + (size_t)row * 1024 : p.x + (size_t)(row - CTXROWS) * 1024;
        const float* mv = modv + row_sel(row) * 6144;
        const float4 v = *(const float4*)(src + c4);
        const float4 sh = *(const float4*)(mv + c4), sc = *(const float4*)(mv + 1024 + c4);
        uint2 o;
        o.x = (unsigned)f2bf(v.x * (1.f + sc.x) + sh.x) | ((unsigned)f2bf(v.y * (1.f + sc.y) + sh.y) << 16);
        o.y = (unsigned)f2bf(v.z * (1.f + sc.z) + sh.z) | ((unsigned)f2bf(v.w * (1.f + sc.w) + sh.w) << 16);
        *(uint2*)(hm + (size_t)row * 1024 + c4) = o;
    }
}

DEVINL void ph_inproj(const P& p, char* smem) {
    const int TIDX_ = tid_(); const int BIDX_ = bid_(); char* const WS_ = wsl_(p.ws); (void)TIDX_; (void)BIDX_; (void)WS_;
    const u16* hm = (const u16*)(WS_ + OFF_HM);
    const u16* win = (const u16*)(WS_ + OFF_WIN);
    u16* pqk = (u16*)(WS_ + OFF_PQK); u16* vtl = (u16*)(WS_ + OFF_VTL); u16* vtc = (u16*)(WS_ + OFF_VTC);
    u16* pb = (u16*)(WS_ + OFF_PB); u16* pc = (u16*)(WS_ + OFF_PC);
    for (int u = BIDX_; u < 260 * 28; u += gridDim.x) {
        const int mt = u / 28, nt = u % 28;
        const u16* A = hm + (size_t)mt * 128 * 1024;
        gemm128([&](int r) { return A + (size_t)r * 1024; }, win + (size_t)nt * 128 * 1024, 1024, 1024, smem,
                [&](int m, int n, f32x4 a) {
                    const int R = mt * 128 + m, N = nt * 128 + n;
                    if (N >= INP) return;
                    const u16 h0 = f2bf(a[0]), h1 = f2bf(a[1]), h2 = f2bf(a[2]), h3 = f2bf(a[3]);
                    if (N < 1024) {
                        u16* q = pqk + (size_t)R * 1024 + N; q[0] = h0; q[1024] = h1; q[2048] = h2; q[3072] = h3;
                    } else if (N < 1536) {
                        const int hh = (N - 1024) >> 6, d = (N - 1024) & 63;
                        uint2 v; v.x = (unsigned)h0 | ((unsigned)h1 << 16); v.y = (unsigned)h2 | ((unsigned)h3 << 16);
                        if (R < CTXROWS) { const int b = R >> 8, t = R & 255; *(uint2*)(vtc + ((size_t)((b * 8 + hh) * 64 + d)) * 256 + t) = v; }
                        else { const int R2 = R - CTXROWS, b = R2 >> 14, t = R2 & 16383; *(uint2*)(vtl + ((size_t)((b * 8 + hh) * 64 + d)) * 16384 + t) = v; }
                    } else if (N < 2496) {
                        u16* q = pb + (size_t)R * 960 + (N - 1536); q[0] = h0; q[960] = h1; q[1920] = h2; q[2880] = h3;
                    } else {
                        u16* q = pc + (size_t)R * 1040 + (N - 2496); q[0] = h0; q[1040] = h1; q[2080] = h2; q[3120] = h3;
                    }
                });
    }
}

constexpr size_t RWREC = 12288;
constexpr size_t RW_A1 = 0, RW_A4 = 2048, RW_A3 = 4096, RW_MKA = 8192, RW_TT = 8704, RW_MY = 9216, RW_V = 10240;
constexpr size_t OFF_RWOP = OFF_X1;
constexpr size_t OFF_RWWG = OFF_RWOP + (size_t)8 * 1040 * RWREC;
constexpr size_t OFF_YRWB = OFF_RWWG + (size_t)8 * 260 * 64 * 4;
constexpr size_t OFF_BONUS = OFF_YRWB + (size_t)T * 256 * 2;
static_assert(OFF_BONUS + (size_t)T * 4 * 4 <= OFF_HM, "rw operand store must fit the X1 region");

DEVINL float rw_mix(const u16* __restrict__ pb, const float* __restrict__ mup, const float* __restrict__ mun, int row, int t, int seqlen, int col) {
    const float cu = bf2f(pb[(size_t)row * 960 + col]);
    const float pr = t > 0 ? bf2f(pb[(size_t)(row - 1) * 960 + col]) : 0.f;
    const float nx = t + 1 < seqlen ? bf2f(pb[(size_t)(row + 1) * 960 + col]) : 0.f;
    return cu + mup[col] * (pr - cu) + mun[col] * (nx - cu);
}

DEVINL void ph_rwprep(const P& p, int l, int d, char* smem) {
    const int TIDX_ = tid_(); const int BIDX_ = bid_(); char* const WS_ = wsl_(p.ws);
    const int tid = TIDX_, lane = tid & 63, w = tid >> 6, fr = lane & 15, fq = lane >> 4;
    const u16* pb = (const u16*)(WS_ + OFF_PB);
    char* rwop = WS_ + OFF_RWOP;
    float* rwwg = (float*)(WS_ + OFF_RWWG);
    float* bonus = (float*)(WS_ + OFF_BONUS);
    u16* gate = (u16*)(WS_ + OFF_GATE);
    const float* mup = p.mu_prev + l * 960; const float* mun = p.mu_next + l * 960;
    u16* lwdh = (u16*)smem;
    u16* ladh = lwdh + 2048;
    u16* abuf = ladh + 2048;
    float* Lb = (float*)(smem + 16384);
    u16* SV = (u16*)(smem + 32768);
    float* tot = (float*)(smem + 32768);
    const u16* w2t = (const u16*)(WS_ + OFF_LORA);
    const u16* a2t = w2t + 2 * 2 * 256 * 32;
    const u16* g2t = a2t + 2 * 2 * 256 * 32;
    const int z = d;
    for (int u = BIDX_; u < NUNIT_CH; u += gridDim.x) {
        int b, gi, row0, seqlen, gscan;
        if (u < 8) { b = u >> 2; gi = u & 3; row0 = b * 256 + gi * 64; seqlen = 256; gscan = d ? 3 - gi : gi; }
        else { b = (u - 8) >> 8; gi = (u - 8) & 255; row0 = CTXROWS + b * LAT + gi * 64; seqlen = LAT; gscan = 4 + (d ? 255 - gi : gi); }
        const int t0 = gi * 64;
        __syncthreads();
#pragma unroll 1
        for (int i = 0; i < 8; ++i) {
            const int idx = tid + 256 * i, j = idx >> 5, cc = idx & 31;
            lwdh[idx] = f2bf(tanhf(rw_mix(pb, mup, mun, row0 + j, t0 + j, seqlen, 768 + z * 32 + cc)));
            ladh[idx] = f2bf(rw_mix(pb, mup, mun, row0 + j, t0 + j, seqlen, 832 + z * 32 + cc));
        }
        if (d == 0) {
            u16* lgd = (u16*)Lb;
#pragma unroll 1
            for (int i = 0; i < 16; ++i) {
                const int idx = tid + 256 * i, j = idx >> 6, cc = idx & 63;
                lgd[idx] = f2bf(sigmoidf_(rw_mix(pb, mup, mun, row0 + j, t0 + j, seqlen, 896 + cc)));
            }
            __syncthreads();
#pragma unroll 1
            for (int nt = 0; nt < 4; ++nt) {
                const u16* bp = g2t + ((size_t)l * 256 + 64 * w + 16 * nt + fr) * 64 + 8 * fq;
                const bf16x8 b0 = *(const bf16x8*)bp, b1 = *(const bf16x8*)(bp + 32);
#pragma unroll
                for (int mt = 0; mt < 4; ++mt) {
                    const bf16x8 x0 = *(const bf16x8*)(lgd + (16 * mt + fr) * 64 + 8 * fq), x1 = *(const bf16x8*)(lgd + (16 * mt + fr) * 64 + 32 + 8 * fq);
                    f32x4 acc = f32x4{0.f, 0.f, 0.f, 0.f};
                    acc = __builtin_amdgcn_mfma_f32_16x16x32_bf16(x0, b0, acc, 0, 0, 0);
                    acc = __builtin_amdgcn_mfma_f32_16x16x32_bf16(x1, b1, acc, 0, 0, 0);
#pragma unroll
                    for (int r = 0; r < 4; ++r) gate[(size_t)(row0 + 16 * mt + 4 * fq + r) * 256 + 64 * w + 16 * nt + fr] = f2bf(acc[r]);
                }
            }
        }
#pragma unroll 1
        for (int h = 0; h < 4; ++h) {
            const int bh = b * 4 + h;
            const int ch = h * 64 + lane;
            __syncthreads();
            {
                const bf16x8 xw = *(const bf16x8*)(lwdh + (16 * w + fr) * 32 + 8 * fq);
                const bf16x8 xa = *(const bf16x8*)(ladh + (16 * w + fr) * 32 + 8 * fq);
#pragma unroll 1
                for (int kt = 0; kt < 4; ++kt) {
                    const int key = 16 * kt + fr;
                    const size_t wrow = ((size_t)(l * 2 + z) * 256 + h * 64 + key) * 32 + 8 * fq;
                    const bf16x8 bw = *(const bf16x8*)(w2t + wrow), ba = *(const bf16x8*)(a2t + wrow);
                    f32x4 ae = f32x4{0.f, 0.f, 0.f, 0.f}, aa = f32x4{0.f, 0.f, 0.f, 0.f};
                    ae = __builtin_amdgcn_mfma_f32_16x16x32_bf16(xw, bw, ae, 0, 0, 0);
                    aa = __builtin_amdgcn_mfma_f32_16x16x32_bf16(xa, ba, aa, 0, 0, 0);
                    const float w0 = p.rw_w0[(l * 2 + z) * 256 + h * 64 + key], a0 = p.rw_a0[(l * 2 + z) * 256 + h * 64 + key];
#pragma unroll
                    for (int r = 0; r < 4; ++r) {
                        const int tok = 16 * w + 4 * fq + r;
                        const int s = d ? 63 - tok : tok;
                        Lb[s * 64 + key] = 0.60653065971263342f * sigmoidf_(ae[r] + w0);
                        abuf[tok * 64 + key] = f2bf(sigmoidf_(aa[r] + a0));
                    }
                }
            }
            __syncthreads();
            {
                float pre[16]; float run = 0.f;
#pragma unroll
                for (int i = 0; i < 16; ++i) { run += Lb[(16 * w + i) * 64 + lane]; pre[i] = run; }
                tot[w * 64 + lane] = run;
                __syncthreads();
                float offs = 0.f;
#pragma unroll
                for (int ww = 0; ww < 3; ++ww) offs += (ww < w) ? tot[ww * 64 + lane] : 0.f;
#pragma unroll
                for (int i = 0; i < 16; ++i) Lb[(16 * w + i) * 64 + lane] = -(offs + pre[i]);
            }
            __syncthreads();
            {
                const float kkw = p.rw_kk[l * 256 + ch], ka = p.rw_ka[l * 256 + ch], rk = p.rw_rk[l * 256 + ch];
#pragma unroll 1
                for (int i = 0; i < 16; ++i) {
                    const int j = w + 4 * i, row = row0 + j, tt = t0 + j;
                    const float rr = rw_mix(pb, mup, mun, row, tt, seqlen, ch);
                    const float kr = rw_mix(pb, mup, mun, row, tt, seqlen, 256 + ch);
                    const float a = bf2f(abuf[j * 64 + lane]);
                    const float kkv = kr * kkw;
                    const float ss = wsum(kkv * kkv);
                    const float kkn = kkv / fmaxf(sqrtf(ss), 1e-12f);
                    const int s = d ? 63 - j : j;
                    const float Lt = Lb[s * 64 + lane];
                    const float Lp = s > 0 ? Lb[(s - 1) * 64 + lane] : 0.f;
                    const float einv = expf(-Lt);
                    const int c = s >> 4, ts = s & 15;
                    u16* sv = SV + (size_t)(c * 4) * 1024 + ts * 64 + lane;
                    sv[0] = f2bf(-kkn * expf(Lp));
                    sv[1024] = f2bf(rr * expf(Lt));
                    sv[2048] = f2bf(kkn * a * einv);
                    sv[3072] = f2bf(kr * (1.f + (a - 1.f) * ka) * einv);
                    if (d == 0) { const float bs = wsum(rr * kr * rk); if (lane == 0) bonus[(size_t)row * 4 + h] = bs; }
                }
                if (w == 0) rwwg[((size_t)bh * 260 + gscan) * 64 + lane] = expf(Lb[63 * 64 + lane]);
            }
            __syncthreads();
            {
                char* rec = rwop + ((size_t)bh * 1040 + (size_t)gscan * 4 + w) * RWREC;
                const u16* Av = SV + (size_t)(w * 4) * 1024; const u16* Rv = Av + 1024; const u16* Bv = Av + 2048; const u16* Kv = Av + 3072;
                bf16x8 fa[2], frr[2], fb[2], fk[2];
#pragma unroll
                for (int ks = 0; ks < 2; ++ks) {
                    fa[ks] = *(const bf16x8*)(Av + fr * 64 + ks * 32 + fq * 8);
                    frr[ks] = *(const bf16x8*)(Rv + fr * 64 + ks * 32 + fq * 8);
                    fb[ks] = *(const bf16x8*)(Bv + fr * 64 + ks * 32 + fq * 8);
                    fk[ks] = *(const bf16x8*)(Kv + fr * 64 + ks * 32 + fq * 8);
                }
                f32x4 mka = f32x4{0.f, 0.f, 0.f, 0.f}, mba = mka, mkr = mka, mbr = mka;
#pragma unroll
                for (int ks = 0; ks < 2; ++ks) {
                    mka = __builtin_amdgcn_mfma_f32_16x16x32_bf16(fa[ks], fk[ks], mka, 0, 0, 0);
                    mba = __builtin_amdgcn_mfma_f32_16x16x32_bf16(fa[ks], fb[ks], mba, 0, 0, 0);
                    mkr = __builtin_amdgcn_mfma_f32_16x16x32_bf16(frr[ks], fk[ks], mkr, 0, 0, 0);
                    mbr = __builtin_amdgcn_mfma_f32_16x16x32_bf16(frr[ks], fb[ks], mbr, 0, 0, 0);
                }
                float* Ns = Lb + w * 256;
                u16* rmka = (u16*)(rec + RW_MKA); u16* rmy = (u16*)(rec + RW_MY); u16* rtt = (u16*)(rec + RW_TT);
                const int i_ = fr;
#pragma unroll
                for (int r = 0; r < 4; ++r) {
                    const int t_ = 4 * fq + r;
                    const int lp = (i_ >> 2) * 16 + t_;
                    rmka[lp * 4 + (i_ & 3)] = f2bf(i_ < t_ ? mka[r] : 0.f);
                    rmy[lp * 8 + (i_ & 3)] = f2bf(i_ <= t_ ? mbr[r] : 0.f);
                    rmy[lp * 8 + 4 + (i_ & 3)] = f2bf(i_ <= t_ ? mkr[r] : 0.f);
                    Ns[t_ * 16 + i_] = i_ < t_ ? mba[r] : 0.f;
                }
                if (lane < 16) {
                    float Tr[16];
#pragma unroll
                    for (int t_ = 0; t_ < 16; ++t_) {
                        float acc = (lane == t_) ? 1.f : 0.f;
#pragma unroll
                        for (int ii = 0; ii < t_; ++ii) acc += Tr[ii] * Ns[t_ * 16 + ii];
                        Tr[t_] = acc;
                        rtt[((lane >> 2) * 16 + t_) * 4 + (lane & 3)] = f2bf(acc);
                    }
                }
#pragma unroll
                for (int ks = 0; ks < 2; ++ks) {
                    uint4 o;
                    const uint2 lo = *(const uint2*)(Av + fr * 64 + 32 * ks + 4 * fq), hi = *(const uint2*)(Av + fr * 64 + 32 * ks + 16 + 4 * fq);
                    o.x = lo.x; o.y = lo.y; o.z = hi.x; o.w = hi.y;
                    *(uint4*)(rec + RW_A1 + (ks * 64 + lane) * 16) = o;
                    const uint2 lo2 = *(const uint2*)(Rv + fr * 64 + 32 * ks + 4 * fq), hi2 = *(const uint2*)(Rv + fr * 64 + 32 * ks + 16 + 4 * fq);
                    o.x = lo2.x; o.y = lo2.y; o.z = hi2.x; o.w = hi2.y;
                    *(uint4*)(rec + RW_A4 + (ks * 64 + lane) * 16) = o;
                }
#pragma unroll
                for (int m = 0; m < 4; ++m) {
                    unsigned e[8];
#pragma unroll
                    for (int j = 0; j < 4; ++j) { e[j] = Bv[(4 * fq + j) * 64 + 16 * m + fr]; e[4 + j] = Kv[(4 * fq + j) * 64 + 16 * m + fr]; }
                    uint4 o; o.x = e[0] | (e[1] << 16); o.y = e[2] | (e[3] << 16); o.z = e[4] | (e[5] << 16); o.w = e[6] | (e[7] << 16);
                    *(uint4*)(rec + RW_A3 + (m * 64 + lane) * 16) = o;
                }
#pragma unroll 1
                for (int q = 0; q < 4; ++q) {
                    unsigned e[4];
#pragma unroll
                    for (int j = 0; j < 4; ++j) {
                        const int s = 16 * w + 4 * fq + j; const int jt = d ? 63 - s : s;
                        e[j] = f2bf(rw_mix(pb, mup, mun, row0 + jt, t0 + jt, seqlen, 512 + h * 64 + 16 * q + fr));
                    }
                    uint2 o; o.x = e[0] | (e[1] << 16); o.y = e[2] | (e[3] << 16);
                    *(uint2*)(rec + RW_V + (q * 64 + lane) * 8) = o;
                }
            }
        }
    }
}

constexpr int RWSLOT = 12544;
DEVINL void ph_rwscan(const P& p, int l, int d, int bid, int nb, char* smem) {
    const int TIDX_ = tid_(); char* const WS_ = wsl_(p.ws);
    const int tid = TIDX_, lane = tid & 63, q = tid >> 6, fr = lane & 15, fq = lane >> 4;
    const char* rwop = WS_ + OFF_RWOP;
    const float* rwwg = (const float*)(WS_ + OFF_RWWG);
    u16* yf = (u16*)(WS_ + OFF_Y);
    u16* yb = (u16*)(WS_ + OFF_YRWB);
    (void)l;
    for (int bh = bid; bh < 8; bh += nb) {
        const int b = bh >> 2, h = bh & 3;
        f32x4 z[4];
#pragma unroll
        for (int m = 0; m < 4; ++m) z[m] = f32x4{0.f, 0.f, 0.f, 0.f};
        const char* rec0 = rwop + (size_t)bh * 1040 * RWREC;
        const float* wg0 = rwwg + (size_t)bh * 260 * 64;
        auto issue = [&](int c, int sl) {
            const int cc = c < 1040 ? c : 1039;
            char* slot = smem + sl * RWSLOT;
            const char* rec = rec0 + (size_t)cc * RWREC;
#pragma unroll
            for (int i = 0; i < 3; ++i) glds16(rec + (tid + 256 * i) * 16, slot + (tid + 256 * i) * 16);
            glds4((const char*)(wg0 + (size_t)(cc >> 2) * 64) + lane * 4, slot + 12288 + lane * 4);
        };
        auto asfrag = [](uint4 v) { union { uint4 u; bf16x8 f; } x; x.u = v; return x.f; };
        auto pack2 = [](float lo, float hi) { return (unsigned)f2bf(lo) | ((unsigned)f2bf(hi) << 16); };
        const unsigned b128 = lds_addr(smem) + lane * 16, b64 = lds_addr(smem) + lane * 8, bv = lds_addr(smem) + (q * 64 + lane) * 8, bg = lds_addr(smem) + 16 * fq;
        __syncthreads();
        issue(0, 0); issue(1, 1); issue(2, 2); issue(3, 3);
#pragma unroll 1
        for (int c5 = 0; c5 < 1040; c5 += 5) {
          auto body = [&](auto SJ) {
            constexpr int sj = decltype(SJ)::value;
            const int c = c5 + sj;
            asm volatile("s_waitcnt vmcnt(12)" ::: "memory");
            __builtin_amdgcn_s_barrier();
            issue(c + 4, (sj + 4) % 5);
            constexpr int SB = sj * RWSLOT;
            u32x4 r_a10, r_a11, r_a40, r_a41, r_a30, r_a31, r_a32, r_a33, r_my, g0, g1, g2, g3;
            u32x2 mka, tt, vcur;
            asm volatile(
                "ds_read_b128 %0, %16 offset:%20+0\n\t"
                "ds_read_b128 %1, %16 offset:%20+1024\n\t"
                "ds_read_b128 %2, %16 offset:%20+2048\n\t"
                "ds_read_b128 %3, %16 offset:%20+3072\n\t"
                "ds_read_b128 %4, %16 offset:%20+4096\n\t"
                "ds_read_b128 %5, %16 offset:%20+5120\n\t"
                "ds_read_b128 %6, %16 offset:%20+6144\n\t"
                "ds_read_b128 %7, %16 offset:%20+7168\n\t"
                "ds_read_b128 %8, %16 offset:%20+9216\n\t"
                "ds_read_b64 %9, %17 offset:%20+8192\n\t"
                "ds_read_b64 %10, %17 offset:%20+8704\n\t"
                "ds_read_b64 %11, %18 offset:%20+10240\n\t"
                "ds_read_b128 %12, %19 offset:%20+12288\n\t"
                "ds_read_b128 %13, %19 offset:%20+12352\n\t"
                "ds_read_b128 %14, %19 offset:%20+12416\n\t"
                "ds_read_b128 %15, %19 offset:%20+12480\n\t"
                "s_waitcnt lgkmcnt(0)"
                : "=&v"(r_a10), "=&v"(r_a11), "=&v"(r_a40), "=&v"(r_a41), "=&v"(r_a30), "=&v"(r_a31), "=&v"(r_a32), "=&v"(r_a33), "=&v"(r_my),
                  "=&v"(mka), "=&v"(tt), "=&v"(vcur), "=&v"(g0), "=&v"(g1), "=&v"(g2), "=&v"(g3)
                : "v"(b128), "v"(b64), "v"(bv), "v"(bg), "n"(SB)
                : "memory");
            auto asfrag4 = [](u32x4 v) { union { u32x4 u; bf16x8 f; } x; x.u = v; return x.f; };
            const bf16x8 A1_0 = asfrag4(r_a10), A1_1 = asfrag4(r_a11), A4_0 = asfrag4(r_a40), A4_1 = asfrag4(r_a41);
            const bf16x8 A3_0 = asfrag4(r_a30), A3_1 = asfrag4(r_a31), A3_2 = asfrag4(r_a32), A3_3 = asfrag4(r_a33), MY = asfrag4(r_my);
            const bf16x8 MKA = asfrag(make_uint4(mka.x, mka.y, 0u, 0u)), TT = asfrag(make_uint4(tt.x, tt.y, 0u, 0u));
            const bf16x8 VB = asfrag(make_uint4(vcur.x, vcur.y, 0u, 0u));
            const bf16x8 ZB0 = asfrag(make_uint4(pack2(z[0][0], z[0][1]), pack2(z[0][2], z[0][3]), pack2(z[1][0], z[1][1]), pack2(z[1][2], z[1][3])));
            const bf16x8 ZB1 = asfrag(make_uint4(pack2(z[2][0], z[2][1]), pack2(z[2][2], z[2][3]), pack2(z[3][0], z[3][1]), pack2(z[3][2], z[3][3])));
            f32x4 X = f32x4{0.f, 0.f, 0.f, 0.f};
            X = __builtin_amdgcn_mfma_f32_16x16x32_bf16(MKA, VB, X, 0, 0, 0);
            X = __builtin_amdgcn_mfma_f32_16x16x32_bf16(A1_0, ZB0, X, 0, 0, 0);
            X = __builtin_amdgcn_mfma_f32_16x16x32_bf16(A1_1, ZB1, X, 0, 0, 0);
            f32x4 Y = f32x4{0.f, 0.f, 0.f, 0.f};
            Y = __builtin_amdgcn_mfma_f32_16x16x32_bf16(A4_0, ZB0, Y, 0, 0, 0);
            Y = __builtin_amdgcn_mfma_f32_16x16x32_bf16(A4_1, ZB1, Y, 0, 0, 0);
            const bf16x8 XB = asfrag(make_uint4(pack2(X[0], X[1]), pack2(X[2], X[3]), 0u, 0u));
            f32x4 U = f32x4{0.f, 0.f, 0.f, 0.f};
            U = __builtin_amdgcn_mfma_f32_16x16x32_bf16(TT, XB, U, 0, 0, 0);
            const bf16x8 UV = asfrag(make_uint4(pack2(U[0], U[1]), pack2(U[2], U[3]), vcur.x, vcur.y));
            z[0] = __builtin_amdgcn_mfma_f32_16x16x32_bf16(A3_0, UV, z[0], 0, 0, 0);
            z[1] = __builtin_amdgcn_mfma_f32_16x16x32_bf16(A3_1, UV, z[1], 0, 0, 0);
            z[2] = __builtin_amdgcn_mfma_f32_16x16x32_bf16(A3_2, UV, z[2], 0, 0, 0);
            z[3] = __builtin_amdgcn_mfma_f32_16x16x32_bf16(A3_3, UV, z[3], 0, 0, 0);
            Y = __builtin_amdgcn_mfma_f32_16x16x32_bf16(MY, UV, Y, 0, 0, 0);
            if ((c & 3) == 3) {
                z[0][0] *= __uint_as_float(g0.x); z[0][1] *= __uint_as_float(g0.y); z[0][2] *= __uint_as_float(g0.z); z[0][3] *= __uint_as_float(g0.w);
                z[1][0] *= __uint_as_float(g1.x); z[1][1] *= __uint_as_float(g1.y); z[1][2] *= __uint_as_float(g1.z); z[1][3] *= __uint_as_float(g1.w);
                z[2][0] *= __uint_as_float(g2.x); z[2][1] *= __uint_as_float(g2.y); z[2][2] *= __uint_as_float(g2.z); z[2][3] *= __uint_as_float(g2.w);
                z[3][0] *= __uint_as_float(g3.x); z[3][1] *= __uint_as_float(g3.y); z[3][2] *= __uint_as_float(g3.z); z[3][3] *= __uint_as_float(g3.w);
            }
            {
                const bool isctx = c < 16;
                const int cc = isctx ? c : c - 16;
                const int n = isctx ? LCTX : LAT;
                const int rowbase = isctx ? b * LCTX : CTXROWS + b * LAT;
#pragma unroll
                for (int r = 0; r < 4; ++r) {
                    const int s = cc * 16 + 4 * fq + r;
                    const int t = d ? n - 1 - s : s;
                    const u16 o = f2bf(Y[r]);
                    u16* dst = d == 0 ? yf + (size_t)(rowbase + t) * 1024 + 512 + h * 64 + 16 * q + fr : yb + (size_t)(rowbase + t) * 256 + h * 64 + 16 * q + fr;
                    *dst = o;
                }
            }
          };
          body(std::integral_constant<int, 0>{}); body(std::integral_constant<int, 1>{}); body(std::integral_constant<int, 2>{});
          body(std::integral_constant<int, 3>{}); body(std::integral_constant<int, 4>{});
        }
        asm volatile("s_waitcnt vmcnt(0)" ::: "memory");
        __syncthreads();
    }
}

DEVINL void ph_rwout(const P& p, int l) {
    const int TIDX_ = tid_(); const int BIDX_ = bid_(); char* const WS_ = wsl_(p.ws);
    const int tid = TIDX_, h = tid >> 6;
    const u16* pb = (const u16*)(WS_ + OFF_PB);
    const u16* yb = (const u16*)(WS_ + OFF_YRWB);
    const u16* gate = (const u16*)(WS_ + OFF_GATE);
    const float* bonus = (const float*)(WS_ + OFF_BONUS);
    u16* y = (u16*)(WS_ + OFF_Y);
    const float* mup = p.mu_prev + l * 960; const float* mun = p.mu_next + l * 960;
    const float lw = p.rw_lnw[l * 256 + tid], lb = p.rw_lnb[l * 256 + tid];
    const int rstart = (l == 0) ? 0 : CTXROWS;
    for (int row = rstart + BIDX_; row < T; row += gridDim.x) {
        int t, seqlen;
        if (row < CTXROWS) { t = row & 255; seqlen = LCTX; } else { t = (row - CTXROWS) & (LAT - 1); seqlen = LAT; }
        const float yv = bf2f(y[(size_t)row * 1024 + 512 + tid]) + bf2f(yb[(size_t)row * 256 + tid]);
        const float v = rw_mix(pb, mup, mun, row, t, seqlen, 512 + tid);
        const float mu = wsum(yv) * (1.f / 64.f);
        const float dl = yv - mu;
        const float var = wsum(dl * dl) * (1.f / 64.f);
        const float o = (dl * rsqrtf(var + 64e-5f) * lw + lb + bonus[(size_t)row * 4 + h] * v) * bf2f(gate[(size_t)row * 256 + tid]);
        y[(size_t)row * 1024 + 512 + tid] = f2bf(o);
    }
}
DEVINL void ph_prepM(const P& p, int l, char* smem) {
    const int TIDX_ = tid_(); const int BIDX_ = bid_(); char* const WS_ = wsl_(p.ws); (void)TIDX_; (void)BIDX_; (void)WS_;
    const int tid = TIDX_, lane = tid & 63, wid = tid >> 6;
    const u16* pb = (const u16*)(WS_ + OFF_PB);
    const u16* pc = (const u16*)(WS_ + OFF_PC);
    u16* rwf = (u16*)(WS_ + OFF_X1);
    u16* gate = (u16*)(WS_ + OFF_GATE);
    u16* mlf = (u16*)(WS_ + OFF_MLF);
    float* mlg = (float*)(WS_ + OFF_MLG);
    float* mls = (float*)(WS_ + OFF_MLS);
    float* nst = (float*)(WS_ + OFF_NST);
    float* cst = (float*)(WS_ + OFF_HM);
    const float* rope = (const float*)(WS_ + OFF_ROPE);
    const float* mup = p.mu_prev + l * 960; const float* mun = p.mu_next + l * 960;
    for (int u = BIDX_; u < NUNIT_CH; u += gridDim.x) {
        int b, ch, row0, seqlen; bool isctx;
        if (u < 8) { isctx = true; b = u >> 2; ch = u & 3; row0 = b * 256 + ch * 64; seqlen = 256; }
        else { isctx = false; b = (u - 8) >> 8; ch = (u - 8) & 255; row0 = CTXROWS + b * LAT + ch * 64; seqlen = LAT; }
        const int t0 = ch * 64;
        const int tc = isctx ? ch : 4 + ch;
        __syncthreads();
        u16* kl = (u16*)smem;
        u16* vl = kl + 4096;
        float* wsl = (float*)(vl + 4096);
        float* lil = wsl + 512;
        {
            const float* cw = p.ml_cw + (size_t)l * 3 * 512;
            const float wq0 = cw[tid], wq1 = cw[512 + tid], wq2 = cw[1024 + tid], bq = p.ml_cb[l * 512 + tid];
            const float wk0 = cw[256 + tid], wk1 = cw[512 + 256 + tid], wk2 = cw[1024 + 256 + tid], bk = p.ml_cb[l * 512 + 256 + tid];
            float pq = 0, pk = 0, cq, ck;
            if (t0 > 0) { const u16* r = pc + (size_t)(row0 - 1) * 1040; pq = bf2f(r[tid]); pk = bf2f(r[256 + tid]); }
            { const u16* r = pc + (size_t)row0 * 1040; cq = bf2f(r[tid]); ck = bf2f(r[256 + tid]); }
            const int i16 = lane & 15; const bool second = (lane & 16) != 0; const int half = lane >> 5;
#pragma unroll 1
            for (int j = 0; j < 64; ++j) {
                float nq = 0, nk = 0;
                if (t0 + j + 1 < seqlen) { const u16* r = pc + (size_t)(row0 + j + 1) * 1040; nq = bf2f(r[tid]); nk = bf2f(r[256 + tid]); }
                float vq = siluf_(wq0 * pq + wq1 * cq + wq2 * nq + bq);
                float vk = siluf_(wk0 * pk + wk1 * ck + wk2 * nk + bk);
                if (!isctx) {
                    const int t = t0 + j;
                    const int pos = half == 0 ? (t >> 6) : (t & 63);
                    const float cs = half == 0 ? rope[pos * 16 + i16] : rope[8192 + pos * 16 + i16];
                    const float sn = half == 0 ? rope[4096 + pos * 16 + i16] : rope[9216 + pos * 16 + i16];
                    const float oq = __shfl_xor(vq, 16), ok = __shfl_xor(vk, 16);
                    vq = second ? (oq * sn + vq * cs) : (vq * cs - oq * sn);
                    vk = second ? (ok * sn + vk * cs) : (vk * cs - ok * sn);
                }
                mlf[(size_t)(row0 + j) * 512 + tid] = f2bf(vq);
                mlf[(size_t)(row0 + j) * 512 + 256 + tid] = f2bf(vk * 0.125f);
                pq = cq; pk = ck; cq = nq; ck = nk;
            }
            const int j = tid >> 2, q4 = tid & 3;
#pragma unroll
            for (int i = 0; i < 4; ++i) {
                const int idx = q4 * 4 + i;
                const float g = bf2f(pc[(size_t)(row0 + j) * 1040 + 1024 + idx]);
                float v;
                if (idx < 8) v = g + p.ml_ib[l * 8 + idx];
                else { const float xx = g + p.ml_fb[l * 8 + idx - 8]; v = fminf(xx, 0.f) - log1pf(__expf(-fabsf(xx))); }
                lil[j * 16 + idx] = v;
                mlg[(size_t)(row0 + j) * 16 + idx] = v;
            }
        }
        __syncthreads();
        if (tid < 8) {
            const int d = tid >> 2, h = tid & 3;
            float bacc = 0.f;
#pragma unroll 1
            for (int jj = 0; jj < 64; ++jj) { const int tok = d ? 63 - jj : jj; bacc += lil[tok * 16 + 8 + d * 4 + h]; wsl[tid * 64 + tok] = bacc; }
            const float Bs = bacc;
            float G = -3.0e38f;
#pragma unroll 1
            for (int tok = 0; tok < 64; ++tok) { const float g = Bs - wsl[tid * 64 + tok] + lil[tok * 16 + d * 4 + h]; G = fmaxf(G, g); }
#pragma unroll 1
            for (int tok = 0; tok < 64; ++tok) { const float g = Bs - wsl[tid * 64 + tok] + lil[tok * 16 + d * 4 + h]; wsl[tid * 64 + tok] = expf(g - G); }
            const int bhd = (b * 4 + h) * 2 + d;
            mls[(bhd * NTC + tc) * 2 + 0] = G; mls[(bhd * NTC + tc) * 2 + 1] = Bs;
        }
#pragma unroll 1
        for (int h = 0; h < 4; ++h) {
            __syncthreads();
            for (int i = tid; i < 64 * 16; i += 256) {
                const int tok = i >> 4, c4 = (i & 15) * 4;
                *(uint2*)(kl + tok * 64 + c4) = *(const uint2*)(mlf + (size_t)(row0 + tok) * 512 + 256 + h * 64 + c4);
                *(uint2*)(vl + tok * 64 + c4) = *(const uint2*)(pc + (size_t)(row0 + tok) * 1040 + 512 + h * 64 + c4);
            }
            __syncthreads();
            const int dk4 = (tid >> 4) * 4, dv4 = (tid & 15) * 4;
            float a0[4][4], a1[4][4], n0[4], n1[4];
#pragma unroll
            for (int a = 0; a < 4; ++a) { n0[a] = 0.f; n1[a] = 0.f;
#pragma unroll
                for (int c = 0; c < 4; ++c) { a0[a][c] = 0.f; a1[a][c] = 0.f; } }
#pragma unroll 2
            for (int j = 0; j < 64; ++j) {
                const uint2 kk = *(const uint2*)(kl + j * 64 + dk4);
                const uint2 vv = *(const uint2*)(vl + j * 64 + dv4);
                const float w0 = wsl[h * 64 + j], w1 = wsl[(4 + h) * 64 + j];
                const float kf[4] = {bf2f((u16)(kk.x & 0xFFFF)), bf2f((u16)(kk.x >> 16)), bf2f((u16)(kk.y & 0xFFFF)), bf2f((u16)(kk.y >> 16))};
                const float vf[4] = {bf2f((u16)(vv.x & 0xFFFF)), bf2f((u16)(vv.x >> 16)), bf2f((u16)(vv.y & 0xFFFF)), bf2f((u16)(vv.y >> 16))};
#pragma unroll
                for (int a = 0; a < 4; ++a) {
                    const float k0 = kf[a] * w0, k1 = kf[a] * w1;
                    n0[a] += k0; n1[a] += k1;
#pragma unroll
                    for (int c = 0; c < 4; ++c) { a0[a][c] += k0 * vf[c]; a1[a][c] += k1 * vf[c]; }
                }
            }
            const int bh0 = ((b * 4 + h) * 2 + 0) * NTC + tc, bh1 = ((b * 4 + h) * 2 + 1) * NTC + tc;
#pragma unroll
            for (int a = 0; a < 4; ++a) {
                *(float4*)(cst + (size_t)bh0 * 4096 + (dk4 + a) * 64 + dv4) = make_float4(a0[a][0], a0[a][1], a0[a][2], a0[a][3]);
                *(float4*)(cst + (size_t)bh1 * 4096 + (dk4 + a) * 64 + dv4) = make_float4(a1[a][0], a1[a][1], a1[a][2], a1[a][3]);
                if ((tid & 15) == 0) { nst[(size_t)bh0 * 64 + dk4 + a] = n0[a]; nst[(size_t)bh1 * 64 + dk4 + a] = n1[a]; }
            }
        }
    }
}

DEVINL void ph_mlB(const P& p, int bid, int nb) {
    const int TIDX_ = tid_(); const int BIDX_ = bid_(); char* const WS_ = wsl_(p.ws); (void)TIDX_; (void)BIDX_; (void)WS_;
    const int tid = TIDX_;
    float* mls = (float*)(WS_ + OFF_MLS);
    float* mst = (float*)(WS_ + OFF_MST);
    float* nst = (float*)(WS_ + OFF_NST);
    float* cst = (float*)(WS_ + OFF_HM);
    for (int u = bid; u < 64; u += nb) {
        const int bhd = u >> 2, q = u & 3, d = bhd & 1;
        float zz = 0.f; asm volatile("" : "+v"(zz));
        float4 C = make_float4(zz, zz, zz, zz);
        float nn = zz, m = zz;
        auto tcof = [&](int cs) { return cs < 4 ? (d ? 3 - cs : cs) : 4 + (d ? 255 - (cs - 4) : cs - 4); };
        float4 Unext = *(const float4*)(cst + ((size_t)bhd * NTC + tcof(0)) * 4096 + q * 1024 + tid * 4);
        for (int cs = 0; cs < NTC; ++cs) {
            const int tc = tcof(cs);
            const float4 U = Unext;
            float* cp = cst + ((size_t)bhd * NTC + tc) * 4096 + q * 1024 + tid * 4;
            if (cs + 1 < NTC) Unext = *(const float4*)(cst + ((size_t)bhd * NTC + tcof(cs + 1)) * 4096 + q * 1024 + tid * 4);
            const float G = mls[(bhd * NTC + tc) * 2 + 0], Bs = mls[(bhd * NTC + tc) * 2 + 1];
            float nU = 0.f;
            if (q == 0 && tid < 64) nU = nst[((size_t)bhd * NTC + tc) * 64 + tid];
            *(float4*)cp = C;
            if (q == 0 && tid < 64) nst[((size_t)bhd * NTC + tc) * 64 + tid] = nn;
            if (q == 0 && tid == 0) mst[bhd * NTC + tc] = m;
            const float ml = fmaxf(Bs + m, G);
            const float dC = expf(Bs + m - ml), dU = expf(G - ml);
            C.x = dC * C.x + dU * U.x; C.y = dC * C.y + dU * U.y; C.z = dC * C.z + dU * U.z; C.w = dC * C.w + dU * U.w;
            nn = dC * nn + dU * nU;
            m = ml;
        }
    }
}

DEVINL void ph_na(const P& p, int l, char* smem, int bid, int nb) {
    const int TIDX_ = tid_(); const int BIDX_ = bid_(); char* const WS_ = wsl_(p.ws); (void)TIDX_; (void)BIDX_; (void)WS_;
    const int tid = TIDX_, lane = tid & 63, w = tid >> 6, fr = lane & 15, g = lane >> 4;
    const u16* pqk = (const u16*)(WS_ + OFF_PQK);
    const u16* vtl = (const u16*)(WS_ + OFF_VTL);
    const u16* vtc = (const u16*)(WS_ + OFF_VTC);
    u16* y = (u16*)(WS_ + OFF_Y);
    float* rpbl = (float*)smem;
    const int nunit = 4096 + (l == 0 ? 64 : 0);
    for (int u = bid; u < nunit; u += nb) {
        const bool isctx = u >= 4096;
        int b, h, r = 0, qg = 0;
        if (!isctx) { b = u >> 11; h = (u >> 8) & 7; r = u & 255; }
        else { const int v = u - 4096; b = v >> 5; h = (v >> 2) & 7; qg = v & 3; }
        __syncthreads();
        if (!isctx) for (int i = tid; i < 465; i += 256) rpbl[i] = p.na_rpb[((size_t)l * 8 + h) * 465 + i];
        __syncthreads();
        const int c = 16 * w + fr;
        const int qrow = isctx ? b * LCTX + qg * 64 + c : CTXROWS + b * LAT + r * 64 + c;
        bf16x8 qf[2];
        qf[0] = *(const bf16x8*)(pqk + (size_t)qrow * 1024 + h * 64 + 8 * g);
        qf[1] = *(const bf16x8*)(pqk + (size_t)qrow * 1024 + h * 64 + 32 + 8 * g);
        f32x4 O[4];
#pragma unroll
        for (int i = 0; i < 4; ++i) O[i] = f32x4{0.f, 0.f, 0.f, 0.f};
        float mrun = -1.0e30f, lrun = 0.f;
        auto chunk = [&](const u16* kbase0, const u16* kbase1, const u16* vb, int vstride, const float* bias0, const float* bias1, bool lo0, bool lo1, int kc0, int cs) {
            bf16x8 k00 = *(const bf16x8*)(kbase0 + 8 * g), k01 = *(const bf16x8*)(kbase0 + 32 + 8 * g);
            bf16x8 k10 = *(const bf16x8*)(kbase1 + 8 * g), k11 = *(const bf16x8*)(kbase1 + 32 + 8 * g);
            uint2 vlo[4], vhi[4];
#pragma unroll
            for (int dt = 0; dt < 4; ++dt) { vlo[dt] = *(const uint2*)(vb + (size_t)dt * 16 * vstride); vhi[dt] = *(const uint2*)(vb + (size_t)dt * 16 * vstride + 16); }
            f32x4 s0 = f32x4{0.f, 0.f, 0.f, 0.f}, s1 = f32x4{0.f, 0.f, 0.f, 0.f};
            s0 = __builtin_amdgcn_mfma_f32_16x16x32_bf16(k00, qf[0], s0, 0, 0, 0);
            s0 = __builtin_amdgcn_mfma_f32_16x16x32_bf16(k01, qf[1], s0, 0, 0, 0);
            s1 = __builtin_amdgcn_mfma_f32_16x16x32_bf16(k10, qf[0], s1, 0, 0, 0);
            s1 = __builtin_amdgcn_mfma_f32_16x16x32_bf16(k11, qf[1], s1, 0, 0, 0);
            float sv[8];
#pragma unroll
            for (int j = 0; j < 4; ++j) {
                float a = s0[j] * 0.125f, bb = s1[j] * 0.125f;
                if (lo0) {
                    const int k0c = kc0 + 4 * g + j, k1c = k0c + 16;
                    a = (k0c >= cs && k0c <= cs + 15) ? a + bias0[k0c] : -1.0e30f;
                    bb = (k1c >= cs && k1c <= cs + 15) ? bb + bias0[k1c] : -1.0e30f;
                }
                sv[j] = a; sv[4 + j] = bb;
            }
            (void)bias1; (void)lo1;
            float mx = sv[0];
#pragma unroll
            for (int j = 1; j < 8; ++j) mx = fmaxf(mx, sv[j]);
            mx = fmaxf(mx, __shfl_xor(mx, 16)); mx = fmaxf(mx, __shfl_xor(mx, 32));
            const float mnew = fmaxf(mrun, mx);
            const float sc = __expf(mrun - mnew);
            mrun = mnew;
            float ps = 0.f; bf16x8 pf;
#pragma unroll
            for (int j = 0; j < 8; ++j) { const float pv = __expf(sv[j] - mnew); ps += pv; pf[j] = (short)f2bf(pv); }
            lrun = lrun * sc + ps;
#pragma unroll
            for (int dt = 0; dt < 4; ++dt) {
                O[dt][0] *= sc; O[dt][1] *= sc; O[dt][2] *= sc; O[dt][3] *= sc;
                bf16x8 vf;
                vf[0] = (short)(vlo[dt].x & 0xFFFF); vf[1] = (short)(vlo[dt].x >> 16); vf[2] = (short)(vlo[dt].y & 0xFFFF); vf[3] = (short)(vlo[dt].y >> 16);
                vf[4] = (short)(vhi[dt].x & 0xFFFF); vf[5] = (short)(vhi[dt].x >> 16); vf[6] = (short)(vhi[dt].y & 0xFFFF); vf[7] = (short)(vhi[dt].y >> 16);
                O[dt] = __builtin_amdgcn_mfma_f32_16x16x32_bf16(vf, pf, O[dt], 0, 0, 0);
            }
        };
        if (!isctx) {
            const int rs = min(max(r - 4, 0), 248);
            const int cb = (w == 0) ? 0 : (w == 1) ? 8 : (w == 2) ? 24 : 32;
            const int cs = min(max(c - 8, 0), 48);
            for (int i = 0; i < 8; ++i) {
                const int krow = rs + i;
                const size_t tokb = (size_t)CTXROWS + (size_t)b * LAT + krow * 64 + cb;
                const u16* kb0 = pqk + (tokb + fr) * 1024 + 512 + h * 64;
                const u16* kb1 = pqk + (tokb + 16 + fr) * 1024 + 512 + h * 64;
                const u16* vb = vtl + ((size_t)((b * 8 + h) * 64 + fr)) * LAT + krow * 64 + cb + 4 * g;
                const float* bias0 = rpbl + (krow - r + 7) * 31 - c + 15;
                chunk(kb0, kb1, vb, LAT, bias0, bias0, true, true, cb, cs);
            }
        }
        for (int cc = 0; cc < 8; ++cc) {
            const size_t tokb = (size_t)b * LCTX + cc * 32;
            const u16* kb0 = pqk + (tokb + fr) * 1024 + 512 + h * 64;
            const u16* kb1 = pqk + (tokb + 16 + fr) * 1024 + 512 + h * 64;
            const u16* vb = vtc + ((size_t)((b * 8 + h) * 64 + fr)) * LCTX + cc * 32 + 4 * g;
            chunk(kb0, kb1, vb, LCTX, nullptr, nullptr, false, false, 0, 0);
        }
        float lt = lrun; lt += __shfl_xor(lt, 16); lt += __shfl_xor(lt, 32);
        const float inv = 1.f / lt;
#pragma unroll
        for (int dt = 0; dt < 4; ++dt) {
            uint2 o;
            o.x = (unsigned)f2bf(O[dt][0] * inv) | ((unsigned)f2bf(O[dt][1] * inv) << 16);
            o.y = (unsigned)f2bf(O[dt][2] * inv) | ((unsigned)f2bf(O[dt][3] * inv) << 16);
            *(uint2*)(y + (size_t)qrow * 1024 + h * 64 + dt * 16 + 4 * g) = o;
        }
    }
}

DEVINL void ph_mlC(const P& p, int l, char* smem, int bid, int nb) {
    const int TIDX_ = tid_(); const int BIDX_ = bid_(); char* const WS_ = wsl_(p.ws); (void)TIDX_; (void)BIDX_; (void)WS_;
    const int tid = TIDX_;
    const u16* mlf = (const u16*)(WS_ + OFF_MLF);
    const u16* pc = (const u16*)(WS_ + OFF_PC);
    const float* mlg = (const float*)(WS_ + OFF_MLG);
    const float* mst = (const float*)(WS_ + OFF_MST);
    const float* nst = (const float*)(WS_ + OFF_NST);
    const float* cst = (const float*)(WS_ + OFF_HM);
    u16* y = (u16*)(WS_ + OFF_Y);
    u16* ql = (u16*)smem;
    u16* kl = ql + 4096;
    u16* vl = kl + 4096;
    float* Cl = (float*)(vl + 4096);
    float* Sl = Cl + 4096;
    float* btl = Sl + 4096;
    float* lil = btl + 64;
    float* nl = lil + 64;
    const int t = tid >> 2, q4 = tid & 3;
    for (int u = bid; u < 2 * NTC; u += nb) {
        const int b = u / NTC, tc = u % NTC;
        if (tc < 4 && l != 0) continue;
        const int row0 = tc < 4 ? b * LCTX + tc * 64 : CTXROWS + b * LAT + (tc - 4) * 64;
        for (int h = 0; h < 4; ++h) {
            float hs[16];
#pragma unroll
            for (int i = 0; i < 16; ++i) hs[i] = 0.f;
            __syncthreads();
            for (int i = tid; i < 64 * 16; i += 256) {
                const int tok = i >> 4, c4 = (i & 15) * 4;
                *(uint2*)(ql + tok * 64 + c4) = *(const uint2*)(mlf + (size_t)(row0 + tok) * 512 + h * 64 + c4);
                *(uint2*)(kl + tok * 64 + c4) = *(const uint2*)(mlf + (size_t)(row0 + tok) * 512 + 256 + h * 64 + c4);
                *(uint2*)(vl + tok * 64 + c4) = *(const uint2*)(pc + (size_t)(row0 + tok) * 1040 + 512 + h * 64 + c4);
            }
            for (int d = 0; d < 2; ++d) {
                const int bhd = (b * 4 + h) * 2 + d;
                __syncthreads();
                for (int i = tid; i < 1024; i += 256) *(float4*)(Cl + i * 4) = *(const float4*)(cst + ((size_t)bhd * NTC + tc) * 4096 + i * 4);
                if (tid < 64) { nl[tid] = nst[((size_t)bhd * NTC + tc) * 64 + tid]; lil[tid] = mlg[(size_t)(row0 + tid) * 16 + d * 4 + h]; }
                if (tid == 64) {
                    float bacc = 0.f;
#pragma unroll 1
                    for (int jj = 0; jj < 64; ++jj) { const int tok = d ? 63 - jj : jj; bacc += mlg[(size_t)(row0 + tok) * 16 + 8 + d * 4 + h]; btl[tok] = bacc; }
                }
                __syncthreads();
                const float m0 = mst[bhd * NTC + tc];
                float sc[16];
#pragma unroll
                for (int i = 0; i < 16; ++i) sc[i] = 0.f;
                for (int dk = 0; dk < 64; dk += 4) {
                    const uint2 qq = *(const uint2*)(ql + t * 64 + dk);
                    const float q0 = bf2f((u16)(qq.x & 0xFFFF)), q1 = bf2f((u16)(qq.x >> 16)), q2 = bf2f((u16)(qq.y & 0xFFFF)), q3 = bf2f((u16)(qq.y >> 16));
#pragma unroll
                    for (int i = 0; i < 16; ++i) {
                        const uint2 kk = *(const uint2*)(kl + (q4 * 16 + i) * 64 + dk);
                        sc[i] += q0 * bf2f((u16)(kk.x & 0xFFFF)) + q1 * bf2f((u16)(kk.x >> 16)) + q2 * bf2f((u16)(kk.y & 0xFFFF)) + q3 * bf2f((u16)(kk.y >> 16));
                    }
                }
                const float bt = btl[t];
                float ld[16]; float mx = -3.0e38f;
#pragma unroll
                for (int i = 0; i < 16; ++i) {
                    const int s = q4 * 16 + i;
                    const bool ok = d ? (s >= t) : (s <= t);
                    ld[i] = ok ? (bt - btl[s] + lil[s]) : -3.0e38f;
                    mx = fmaxf(mx, ld[i]);
                }
                mx = fmaxf(mx, __shfl_xor(mx, 1)); mx = fmaxf(mx, __shfl_xor(mx, 2));
                const float mt = fmaxf(bt + m0, mx);
                float rsum = 0.f;
#pragma unroll
                for (int i = 0; i < 16; ++i) {
                    const int s = q4 * 16 + i;
                    const bool ok = d ? (s >= t) : (s <= t);
                    const float dw = ok ? expf(ld[i] - mt) * sc[i] : 0.f;
                    rsum += dw;
                    Sl[t * 64 + s] = dw;
                }
                rsum += __shfl_xor(rsum, 1); rsum += __shfl_xor(rsum, 2);
                const float inter = expf(bt + m0 - mt);
                float qn = 0.f;
                for (int dk = q4 * 16; dk < q4 * 16 + 16; ++dk) qn += bf2f(ql[t * 64 + dk]) * nl[dk];
                qn += __shfl_xor(qn, 1); qn += __shfl_xor(qn, 2);
                const float den = rsum + inter * qn;
                __syncthreads();
                float num[16];
#pragma unroll
                for (int i = 0; i < 16; ++i) num[i] = 0.f;
                for (int s = 0; s < 64; ++s) {
                    const float dw = Sl[t * 64 + s];
                    const uint4 va = *(const uint4*)(vl + s * 64 + q4 * 16);
                    const uint4 vb2 = *(const uint4*)(vl + s * 64 + q4 * 16 + 8);
                    const unsigned vv[8] = {va.x, va.y, va.z, va.w, vb2.x, vb2.y, vb2.z, vb2.w};
#pragma unroll
                    for (int i = 0; i < 8; ++i) { num[2 * i] += dw * bf2f((u16)(vv[i] & 0xFFFF)); num[2 * i + 1] += dw * bf2f((u16)(vv[i] >> 16)); }
                }
                for (int dk = 0; dk < 64; ++dk) {
                    const float qv = bf2f(ql[t * 64 + dk]) * inter;
#pragma unroll
                    for (int i = 0; i < 16; i += 4) {
                        const float4 cv = *(const float4*)(Cl + dk * 64 + q4 * 16 + i);
                        num[i] += qv * cv.x; num[i + 1] += qv * cv.y; num[i + 2] += qv * cv.z; num[i + 3] += qv * cv.w;
                    }
                }
                const float dn = 1.f / fmaxf(fabsf(den), expf(-mt));
#pragma unroll
                for (int i = 0; i < 16; ++i) hs[i] += num[i] * dn;
            }
            float s1 = 0.f;
#pragma unroll
            for (int i = 0; i < 16; ++i) s1 += hs[i];
            s1 += __shfl_xor(s1, 1); s1 += __shfl_xor(s1, 2);
            const float mu = s1 * (1.f / 64.f);
            float s2 = 0.f;
#pragma unroll
            for (int i = 0; i < 16; ++i) { const float dlt = hs[i] - mu; s2 += dlt * dlt; }
            s2 += __shfl_xor(s2, 1); s2 += __shfl_xor(s2, 2);
            const float rstd = rsqrtf(s2 * (1.f / 64.f) + 1e-6f);
            const int row = row0 + t;
#pragma unroll
            for (int i = 0; i < 16; i += 2) {
                const int cc = h * 64 + q4 * 16 + i;
                const float o0 = bf2f(pc[(size_t)row * 1040 + 768 + cc]), o1 = bf2f(pc[(size_t)row * 1040 + 768 + cc + 1]);
                const float y0 = (hs[i] - mu) * rstd * p.ml_nw[l * 256 + cc] * sigmoidf_(o0);
                const float y1 = (hs[i + 1] - mu) * rstd * p.ml_nw[l * 256 + cc + 1] * sigmoidf_(o1);
                *(unsigned*)(y + (size_t)row * 1024 + 768 + cc) = (unsigned)f2bf(y0) | ((unsigned)f2bf(y1) << 16);
            }
        }
    }
}

DEVINL void ph_outproj(const P& p, int l, char* smem) {
    const int TIDX_ = tid_(); const int BIDX_ = bid_(); char* const WS_ = wsl_(p.ws); (void)TIDX_; (void)BIDX_; (void)WS_;
    const u16* y = (const u16*)(WS_ + OFF_Y);
    const u16* wout = (const u16*)(WS_ + OFF_WOUT);
    const float* modv = (const float*)(WS_ + OFF_MOD) + (size_t)l * 3 * 6144;
    const float* x2c = (const float*)(WS_ + OFF_X2CTX);
    float* x1 = (float*)(WS_ + OFF_X1);
    const int mt0 = (l == 0) ? 0 : 4;
    const int ntile = (260 - mt0) * 8;
    for (int u = BIDX_; u < ntile; u += gridDim.x) {
        const int mt = mt0 + u / 8, nt = u % 8;
        const u16* A = y + (size_t)mt * 128 * 1024;
        const int R0 = mt * 128;
        const float* xin;
        if (l == 0) xin = R0 < CTXROWS ? p.ctx + (size_t)R0 * 1024 : p.x + (size_t)(R0 - CTXROWS) * 1024;
        else xin = R0 < CTXROWS ? x2c + (size_t)R0 * 1024 : p.out + (size_t)(R0 - CTXROWS) * 1024;
        const float* g1 = modv + row_sel(R0) * 6144 + 2048;
        gemm128([&](int r) { return A + (size_t)r * 1024; }, wout + (size_t)nt * 128 * 1024, 1024, 1024, smem,
                [&](int m, int n, f32x4 a) {
                    const int N = nt * 128 + n;
                    const float gg = g1[N];
#pragma unroll
                    for (int j = 0; j < 4; ++j) x1[(size_t)(R0 + m + j) * 1024 + N] = ALPHA * xin[(size_t)(m + j) * 1024 + N] + gg * a[j];
                });
    }
}

DEVINL void ph_ln1(const P& p, int l) {
    const int TIDX_ = tid_(); const int BIDX_ = bid_(); char* const WS_ = wsl_(p.ws); (void)TIDX_; (void)BIDX_; (void)WS_;
    const int lane = TIDX_ & 63, wid = TIDX_ >> 6;
    const float* modv = (const float*)(WS_ + OFF_MOD) + (size_t)l * 3 * 6144;
    float* x1 = (float*)(WS_ + OFF_X1);
    u16* hm = (u16*)(WS_ + OFF_HM);
    const int rstart = (l == 0) ? 0 : CTXROWS;
    for (int row = rstart + BIDX_ * 4 + wid; row < T; row += gridDim.x * 4) {
        float4 v[4];
        float s = 0.f;
#pragma unroll
        for (int i = 0; i < 4; ++i) { v[i] = *(const float4*)(x1 + (size_t)row * 1024 + i * 256 + lane * 4); s += v[i].x + v[i].y + v[i].z + v[i].w; }
        const float mu = wsum(s) * (1.f / 1024.f);
        float q = 0.f;
#pragma unroll
        for (int i = 0; i < 4; ++i) { v[i].x -= mu; v[i].y -= mu; v[i].z -= mu; v[i].w -= mu; q += v[i].x * v[i].x + v[i].y * v[i].y + v[i].z * v[i].z + v[i].w * v[i].w; }
        const float rstd = rsqrtf(wsum(q) * (1.f / 1024.f) + 1e-5f);
        const float* mv = modv + row_sel(row) * 6144;
#pragma unroll
        for (int i = 0; i < 4; ++i) {
            const int c = i * 256 + lane * 4;
            const float4 g = *(const float4*)(p.ln1g + l * 1024 + c), bb = *(const float4*)(p.ln1b + l * 1024 + c);
            const float4 sh = *(const float4*)(mv + 3072 + c), sc = *(const float4*)(mv + 4096 + c);
            float4 o;
            o.x = v[i].x * rstd * g.x + bb.x; o.y = v[i].y * rstd * g.y + bb.y; o.z = v[i].z * rstd * g.z + bb.z; o.w = v[i].w * rstd * g.w + bb.w;
            *(float4*)(x1 + (size_t)row * 1024 + c) = o;
            uint2 hh;
            hh.x = (unsigned)f2bf(o.x * (1.f + sc.x) + sh.x) | ((unsigned)f2bf(o.y * (1.f + sc.y) + sh.y) << 16);
            hh.y = (unsigned)f2bf(o.z * (1.f + sc.z) + sh.z) | ((unsigned)f2bf(o.w * (1.f + sc.w) + sh.w) << 16);
            *(uint2*)(hm + (size_t)row * 1024 + c) = hh;
        }
    }
}

DEVINL void ph_router(const P& p, int l, char* smem) {
    const int TIDX_ = tid_(); const int BIDX_ = bid_(); char* const WS_ = wsl_(p.ws); (void)TIDX_; (void)BIDX_; (void)WS_;
    const u16* hm = (const u16*)(WS_ + OFF_HM);
    const u16* wr = (const u16*)(WS_ + OFF_WR) + (size_t)l * 128 * 1024;
    float* lg = (float*)(WS_ + OFF_LOGITS);
    const int mt0 = (l == 0) ? 0 : 4;
    for (int u = BIDX_; u < 260 - mt0; u += gridDim.x) {
        const int mt = mt0 + u;
        const u16* A = hm + (size_t)mt * 128 * 1024;
        gemm128([&](int r) { return A + (size_t)r * 1024; }, wr, 1024, 1024, smem,
                [&](int m, int n, f32x4 a) {
                    if (n < 36) {
#pragma unroll
                        for (int j = 0; j < 4; ++j) lg[(size_t)(mt * 128 + m + j) * 64 + n] = a[j];
                    }
                });
    }
}

DEVINL void ph_route1(const P& p, int l, char* smem) {
    const int TIDX_ = tid_(); const int BIDX_ = bid_(); char* const WS_ = wsl_(p.ws); (void)TIDX_; (void)BIDX_; (void)WS_;
    const int tid = TIDX_;
    const float* lg = (const float*)(WS_ + OFF_LOGITS);
    int* toke = (int*)(WS_ + OFF_TOKE); float* tokw = (float*)(WS_ + OFF_TOKW);
    int* cnt = (int*)(WS_ + CTL_CNT) + l * 32;
    int* hist = (int*)smem;
    __syncthreads();
    if (tid < 32) hist[tid] = 0;
    __syncthreads();
    const int rstart = (l == 0) ? 0 : CTXROWS;
    for (int row = rstart + BIDX_ * 256 + tid; row < T; row += gridDim.x * 256) {
        const float* q = lg + (size_t)row * 64;
        float gl[4]; int gs = 0; float gm = -3.0e38f;
#pragma unroll
        for (int i = 0; i < 4; ++i) { gl[i] = q[i] + p.rgb[l * 4 + i]; if (gl[i] > gm) { gm = gl[i]; gs = i; } }
        float se = 0.f;
#pragma unroll
        for (int i = 0; i < 4; ++i) se += expf(gl[i] - gm);
        const float gw = 1.f / se;
        float v1 = -3.0e38f, v2 = -3.0e38f; int i1 = 0, i2 = 0;
#pragma unroll
        for (int i = 0; i < 8; ++i) {
            const float e = q[4 + gs * 8 + i] + p.reb[l * 32 + gs * 8 + i];
            if (e > v1) { v2 = v1; i2 = i1; v1 = e; i1 = i; }
            else if (e > v2) { v2 = e; i2 = i; }
        }
        const float e2 = expf(v2 - v1);
        const float w1 = gw / (1.f + e2), w2 = gw * e2 / (1.f + e2);
        const int ea = gs * 8 + i1, eb = gs * 8 + i2;
        toke[row * 2] = ea; toke[row * 2 + 1] = eb; tokw[row * 2] = w1; tokw[row * 2 + 1] = w2;
        atomicAdd(&hist[ea], 1); atomicAdd(&hist[eb], 1);
    }
    __syncthreads();
    if (tid < 32 && hist[tid] > 0) atomicAdd(&cnt[tid], hist[tid]);
}

DEVINL void ph_route2(const P& p, int l, char* smem) {
    const int TIDX_ = tid_(); const int BIDX_ = bid_(); char* const WS_ = wsl_(p.ws); (void)TIDX_; (void)BIDX_; (void)WS_;
    const int tid = TIDX_;
    const int* toke = (const int*)(WS_ + OFF_TOKE);
    int* toks = (int*)(WS_ + OFF_TOKS);
    int* slottok = (int*)(WS_ + OFF_SLOTTOK);
    const int* cnt = (const int*)(WS_ + CTL_CNT) + l * 32;
    int* cur = (int*)(WS_ + CTL_CUR) + l * 32;
    int* tiles = (int*)(WS_ + OFF_TILES);
    int* off = (int*)smem;
    int* hist = off + 64;
    int* base = hist + 32;
    __syncthreads();
    if (tid == 0) { int a = 0; for (int e = 0; e < 32; ++e) { off[e] = a; a += (cnt[e] + 127) & ~127; } off[32] = a; }
    if (tid < 32) hist[tid] = 0;
    __syncthreads();
    if (BIDX_ == 0) {
        if (tid == 0) {
            int nt = 0;
            for (int e = 0; e < 32; ++e) for (int s = off[e]; s < off[e + 1]; s += 128) { tiles[64 + nt * 2] = e; tiles[64 + nt * 2 + 1] = s; ++nt; }
            tiles[40] = nt;
        }
        for (int e = 0; e < 32; ++e) for (int s = off[e] + cnt[e] + tid; s < off[e + 1]; s += 256) slottok[s] = (l == 0) ? 0 : CTXROWS;
    }
    const int rstart = (l == 0) ? 0 : CTXROWS;
    for (int a0 = rstart * 2 + BIDX_ * 256; a0 < T * 2; a0 += gridDim.x * 256) {
        const int a = a0 + tid;
        int e = -1, lpos = 0;
        if (a < T * 2) { e = toke[a]; lpos = atomicAdd(&hist[e], 1); }
        __syncthreads();
        if (tid < 32) { base[tid] = hist[tid] > 0 ? atomicAdd(&cur[tid], hist[tid]) : 0; }
        __syncthreads();
        if (e >= 0) { const int s = off[e] + base[e] + lpos; toks[a] = s; slottok[s] = a >> 1; }
        __syncthreads();
        if (tid < 32) hist[tid] = 0;
        __syncthreads();
    }
}

DEVINL void ph_gateup(const P& p, char* smem) {
    const int TIDX_ = tid_(); const int BIDX_ = bid_(); char* const WS_ = wsl_(p.ws); (void)TIDX_; (void)BIDX_; (void)WS_;
    const int tid = TIDX_, lane = tid & 63, wid = tid >> 6, wr = wid >> 1, wc = wid & 1, fr = lane & 15, fq = lane >> 4;
    const u16* hm = (const u16*)(WS_ + OFF_HM);
    const u16* wgu = (const u16*)(WS_ + OFF_WGU);
    const int* tiles = (const int*)(WS_ + OFF_TILES);
    const int* slottok = (const int*)(WS_ + OFF_SLOTTOK);
    u16* act = (u16*)(WS_ + OFF_ACT);
    const int ntile = tiles[40] * 8;
    for (int u = BIDX_; u < ntile; u += gridDim.x) {
        const int ti = u >> 3, nt = u & 7;
        const int e = tiles[64 + ti * 2], s0 = tiles[64 + ti * 2 + 1];
        f32x4 acc[4][4];
        gemm128_acc([&](int r) { return hm + (size_t)slottok[s0 + r] * 1024; }, wgu + ((size_t)e * 1024 + nt * 128) * 1024, 1024, 1024, smem, acc);
#pragma unroll
        for (int m = 0; m < 4; ++m)
#pragma unroll
            for (int n = 0; n < 4; n += 2) {
                const int jcol = (nt * 128 + wc * 64 + n * 16) / 2 + fr;
                const int srow = s0 + wr * 64 + m * 16 + fq * 4;
#pragma unroll
                for (int j = 0; j < 4; ++j) {
                    const float gte = acc[m][n][j], up = acc[m][n + 1][j];
                    act[(size_t)(srow + j) * 512 + jcol] = f2bf(gte / (1.f + __expf(-gte)) * up);
                }
            }
    }
}

DEVINL void ph_down(const P& p, char* smem) {
    const int TIDX_ = tid_(); const int BIDX_ = bid_(); char* const WS_ = wsl_(p.ws); (void)TIDX_; (void)BIDX_; (void)WS_;
    const u16* act = (const u16*)(WS_ + OFF_ACT);
    const u16* wdn = (const u16*)(WS_ + OFF_WDN);
    const int* tiles = (const int*)(WS_ + OFF_TILES);
    u16* so = (u16*)(WS_ + OFF_SLOTOUT);
    const int ntile = tiles[40] * 8;
    for (int u = BIDX_; u < ntile; u += gridDim.x) {
        const int ti = u >> 3, nt = u & 7;
        const int e = tiles[64 + ti * 2], s0 = tiles[64 + ti * 2 + 1];
        const u16* A = act + (size_t)s0 * 512;
        gemm128([&](int r) { return A + (size_t)r * 512; }, wdn + ((size_t)e * 1024 + nt * 128) * 512, 512, 512, smem,
                [&](int m, int n, f32x4 a) {
                    u16* q = so + (size_t)(s0 + m) * 1024 + nt * 128 + n;
                    q[0] = f2bf(a[0]); q[1024] = f2bf(a[1]); q[2048] = f2bf(a[2]); q[3072] = f2bf(a[3]);
                });
    }
}

DEVINL void ph_ln2(const P& p, int l) {
    const int TIDX_ = tid_(); const int BIDX_ = bid_(); char* const WS_ = wsl_(p.ws); (void)TIDX_; (void)BIDX_; (void)WS_;
    const int lane = TIDX_ & 63, wid = TIDX_ >> 6;
    const float* modv = (const float*)(WS_ + OFF_MOD) + (size_t)l * 3 * 6144;
    const float* modn = (const float*)(WS_ + OFF_MOD) + (size_t)(l + 1) * 3 * 6144;
    const float* x1 = (const float*)(WS_ + OFF_X1);
    const u16* so = (const u16*)(WS_ + OFF_SLOTOUT);
    const int* toks = (const int*)(WS_ + OFF_TOKS);
    const float* tokw = (const float*)(WS_ + OFF_TOKW);
    float* x2c = (float*)(WS_ + OFF_X2CTX);
    u16* hm = (u16*)(WS_ + OFF_HM);
    const int rstart = (l == 0) ? 0 : CTXROWS;
    for (int row = rstart + BIDX_ * 4 + wid; row < T; row += gridDim.x * 4) {
        const int sa = toks[row * 2], sb = toks[row * 2 + 1];
        const float wa = tokw[row * 2], wb = tokw[row * 2 + 1];
        const float* mv = modv + row_sel(row) * 6144;
        float4 v[4];
        float s = 0.f;
#pragma unroll
        for (int i = 0; i < 4; ++i) {
            const int c = i * 256 + lane * 4;
            const float4 xv = *(const float4*)(x1 + (size_t)row * 1024 + c);
            const uint2 ua = *(const uint2*)(so + (size_t)sa * 1024 + c), ub = *(const uint2*)(so + (size_t)sb * 1024 + c);
            const float4 g2 = *(const float4*)(mv + 5120 + c);
            const float f0 = wa * bf2f((u16)(ua.x & 0xFFFF)) + wb * bf2f((u16)(ub.x & 0xFFFF));
            const float f1 = wa * bf2f((u16)(ua.x >> 16)) + wb * bf2f((u16)(ub.x >> 16));
            const float f2 = wa * bf2f((u16)(ua.y & 0xFFFF)) + wb * bf2f((u16)(ub.y & 0xFFFF));
            const float f3 = wa * bf2f((u16)(ua.y >> 16)) + wb * bf2f((u16)(ub.y >> 16));
            v[i].x = ALPHA * xv.x + g2.x * f0; v[i].y = ALPHA * xv.y + g2.y * f1; v[i].z = ALPHA * xv.z + g2.z * f2; v[i].w = ALPHA * xv.w + g2.w * f3;
            s += v[i].x + v[i].y + v[i].z + v[i].w;
        }
        const float mu = wsum(s) * (1.f / 1024.f);
        float q = 0.f;
#pragma unroll
        for (int i = 0; i < 4; ++i) { v[i].x -= mu; v[i].y -= mu; v[i].z -= mu; v[i].w -= mu; q += v[i].x * v[i].x + v[i].y * v[i].y + v[i].z * v[i].z + v[i].w * v[i].w; }
        const float rstd = rsqrtf(wsum(q) * (1.f / 1024.f) + 1e-5f);
        float* dst = row < CTXROWS ? x2c + (size_t)row * 1024 : p.out + (size_t)(row - CTXROWS) * 1024;
        const float* mn = modn + row_sel(row) * 6144;
#pragma unroll
        for (int i = 0; i < 4; ++i) {
            const int c = i * 256 + lane * 4;
            const float4 g = *(const float4*)(p.ln2g + l * 1024 + c), bb = *(const float4*)(p.ln2b + l * 1024 + c);
            float4 o;
            o.x = v[i].x * rstd * g.x + bb.x; o.y = v[i].y * rstd * g.y + bb.y; o.z = v[i].z * rstd * g.z + bb.z; o.w = v[i].w * rstd * g.w + bb.w;
            *(float4*)(dst + c) = o;
            if (l == 0) {
                const float4 sh = *(const float4*)(mn + c), sc = *(const float4*)(mn + 1024 + c);
                uint2 hh;
                hh.x = (unsigned)f2bf(o.x * (1.f + sc.x) + sh.x) | ((unsigned)f2bf(o.y * (1.f + sc.y) + sh.y) << 16);
                hh.y = (unsigned)f2bf(o.z * (1.f + sc.z) + sh.z) | ((unsigned)f2bf(o.w * (1.f + sc.w) + sh.w) << 16);
                *(uint2*)(hm + (size_t)row * 1024 + c) = hh;
            }
        }
    }
}

DEVINL void gbar(XcdBarrier b) {
    unsigned x = b.x; GAS unsigned* q = (GAS unsigned*)b.bar;
    asm volatile("" : "+s"(x), "+s"(q));
    b.x = x; b.bar = (unsigned*)q;
    xcd_barrier(b);
}
#ifndef PROBE
#define PROBE 0
#endif
__global__ void __launch_bounds__(256, 2) k_mega(P p) {
    __shared__ __attribute__((aligned(16))) char smem[65536 + 16];
    if (threadIdx.x == 0) *(uint4*)(smem + 65536) = make_uint4(0u, 0u, 0u, 0u);
    __syncthreads();
    XcdBarrier bar = xcd_barrier_post((unsigned*)p.ws, (volatile LAS unsigned*)(smem + 65536));
    const int bid = blockIdx.x, nb = gridDim.x;
    ph_prolog(p, smem);
    ph_convw(p, 0, smem);
    gbar(bar);
    ph_xm0(p);
    gbar(bar);
#pragma unroll 1
    for (int l = 0; l < NLAYER; ++l) {
        ph_inproj(p, smem);
        gbar(bar);
        for (int rp = 0; rp < (PROBE == 3 ? 2 : 1); ++rp) ph_rwprep(p, l, 0, smem);
        for (int rp = 0; rp < (PROBE == 4 ? 2 : 1); ++rp) ph_prepM(p, l, smem);
        gbar(bar);
        if (bid < 8) { for (int rp = 0; rp < (PROBE == 5 ? 2 : 1); ++rp) ph_rwscan(p, l, 0, bid, 8, smem); }
        else { ph_mlB(p, bid - 8, nb - 8); for (int rp = 0; rp < (PROBE == 1 ? 2 : 1); ++rp) ph_na(p, l, smem, bid - 8, nb - 8); }
        gbar(bar);
        for (int rp = 0; rp < (PROBE == 3 ? 2 : 1); ++rp) ph_rwprep(p, l, 1, smem);
        gbar(bar);
        if (bid < 8) { for (int rp = 0; rp < (PROBE == 5 ? 2 : 1); ++rp) ph_rwscan(p, l, 1, bid, 8, smem); }
        else { for (int rp = 0; rp < (PROBE == 2 ? 2 : 1); ++rp) ph_mlC(p, l, smem, bid - 8, nb - 8); }
        gbar(bar);
        ph_rwout(p, l);
        gbar(bar);
        ph_outproj(p, l, smem);
        ph_convexp(p, l, smem);
        gbar(bar);
        ph_ln1(p, l);
        gbar(bar);
        ph_router(p, l, smem);
        gbar(bar);
        ph_route1(p, l, smem);
        gbar(bar);
        ph_route2(p, l, smem);
        gbar(bar);
        ph_gateup(p, smem);
        gbar(bar);
        ph_down(p, smem);
        gbar(bar);
        ph_ln2(p, l);
        if (l + 1 < NLAYER) ph_convw(p, l + 1, smem);
        gbar(bar);
    }
}

extern "C" void kernel_launch(void* const* d_in, const int* in_sizes, int n_in, void* d_out, int out_size, void* d_ws, size_t ws_size,
                              hipStream_t stream) {
    if (n_in != 37 || ws_size < WS_NEED) { fprintf(stderr, "kernel_launch: n_in %d ws %zu need %zu\n", n_in, ws_size, (size_t)WS_NEED); return; }
    static int grid = 0;
    if (!grid) {
        int dev = 0, cus = 0, per_cu = 0;
        (void)hipGetDevice(&dev);
        (void)hipDeviceGetAttribute(&cus, hipDeviceAttributeMultiprocessorCount, dev);
        (void)hipOccupancyMaxActiveBlocksPerMultiprocessor(&per_cu, (const void*)k_mega, 256, 0);
        if (per_cu < 1) per_cu = 1;
        grid = cus * (per_cu < 2 ? per_cu : 2);
    }
    P p{};
    const float** pp = (const float**)&p;
    for (int i = 0; i < 37; ++i) pp[i] = (const float*)d_in[i];
    p.out = (float*)d_out; p.ws = (char*)d_ws;
    (void)hipMemsetAsync(d_ws, 0, CTL_BYTES, stream);
    k_mega<<<dim3(grid), dim3(256), 0, stream>>>(p);
}
```

```cpp
#include <hip/hip_runtime.h>
#include <hip/hip_bf16.h>
#include <stdint.h>
#include <stdio.h>
#include <type_traits>

#define DEVINL __device__ __forceinline__
typedef unsigned short u16;
using bf16x8 = __attribute__((ext_vector_type(8))) short;
using f32x4 = __attribute__((ext_vector_type(4))) float;

constexpr int D = 1024, LAT = 16384, LCTX = 256, T = 33280, CTXROWS = 512;
constexpr int INP = 3536;
constexpr int NLAYER = 2;
constexpr float ALPHA = 1.41421356237309515f;
constexpr int NUNIT_CH = 520;
constexpr int NTC = 260;
constexpr int MAXSLOT = 70656;

constexpr size_t al(size_t x) { return (x + 255) & ~(size_t)255; }
constexpr size_t CTL_CNT = 16384;
constexpr size_t CTL_CUR = CTL_CNT + 256;
constexpr size_t CTL_BYTES = 32768;
constexpr size_t OFF_MOD = CTL_BYTES;
constexpr size_t OFF_ROPE = OFF_MOD + al(2 * 3 * 6144 * 4);
constexpr size_t OFF_WR = OFF_ROPE + al(10240 * 4);
constexpr size_t OFF_LORA = OFF_WR + al(2 * 128 * 1024 * 2);
constexpr size_t OFF_TILES = OFF_LORA + al(3 * 65536);
constexpr size_t OFF_TOKE = OFF_TILES + al((64 + 2048) * 4);
constexpr size_t OFF_TOKW = OFF_TOKE + al((size_t)T * 2 * 4);
constexpr size_t OFF_TOKS = OFF_TOKW + al((size_t)T * 2 * 4);
constexpr size_t OFF_SLOTTOK = OFF_TOKS + al((size_t)T * 2 * 4);
constexpr size_t OFF_X2CTX = OFF_SLOTTOK + al((size_t)MAXSLOT * 4);
constexpr size_t OFF_WIN = OFF_X2CTX + al((size_t)512 * 1024 * 4);
constexpr size_t OFF_WOUT = OFF_WIN + al((size_t)3584 * 1024 * 2);
constexpr size_t OFF_X1 = OFF_WOUT + al((size_t)1024 * 1024 * 2);
constexpr size_t OFF_HM = OFF_X1 + al((size_t)T * 1024 * 4);
constexpr size_t OFF_P = OFF_HM + al((size_t)T * 1024 * 2);
constexpr size_t OFF_PQK = OFF_P;
constexpr size_t OFF_VTL = OFF_PQK + (size_t)T * 1024 * 2;
constexpr size_t OFF_VTC = OFF_VTL + (size_t)2 * 8 * 64 * 16384 * 2;
constexpr size_t OFF_PB = OFF_VTC + (size_t)2 * 8 * 64 * 256 * 2;
constexpr size_t OFF_PC = OFF_PB + (size_t)T * 960 * 2;
constexpr size_t OFF_Y = OFF_PC + (size_t)T * 1040 * 2;
constexpr size_t OFF_MLF = OFF_Y + (size_t)T * 1024 * 2;
constexpr size_t OFF_GATE = OFF_MLF + (size_t)T * 512 * 2;
constexpr size_t OFF_MLG = OFF_GATE + (size_t)T * 256 * 2;
constexpr size_t OFF_MLS = OFF_MLG + (size_t)T * 16 * 4;
constexpr size_t OFF_MST = OFF_MLS + al(16 * 260 * 2 * 4);
constexpr size_t OFF_NST = OFF_MST + al(16 * 260 * 4);
constexpr size_t OFF_END1 = OFF_NST + al(16 * 260 * 64 * 4);
constexpr size_t OFF_WGU = OFF_P;
constexpr size_t OFF_WDN = OFF_WGU + (size_t)32 * 1024 * 1024 * 2;
constexpr size_t OFF_ACT = OFF_WDN + (size_t)32 * 1024 * 512 * 2;
constexpr size_t OFF_SLOTOUT = OFF_ACT + (size_t)MAXSLOT * 512 * 2;
constexpr size_t OFF_LOGITS = OFF_SLOTOUT + (size_t)MAXSLOT * 1024 * 2;
constexpr size_t OFF_END2 = OFF_LOGITS + (size_t)T * 64 * 4;
constexpr size_t WS_NEED = OFF_END1 > OFF_END2 ? OFF_END1 : OFF_END2;
static_assert(OFF_WDN <= OFF_Y, "Wexp must not overlap y");
static_assert(OFF_LOGITS >= OFF_MLF, "logits placement");

struct P {
    const float *x, *c, *ctx, *c_ctx, *w_mod, *b_mod, *w_in, *na_rpb, *mu_prev, *mu_next, *rw_w0, *rw_w2, *rw_a0, *rw_a2,
        *rw_g2, *rw_kk, *rw_ka, *rw_rk, *rw_lnw, *rw_lnb, *ml_cw, *ml_cb, *ml_ib, *ml_fb, *ml_nw, *w_out, *ln1g, *ln1b,
        *rgw, *rgb, *rew, *reb, *egate, *eup, *edown, *ln2g, *ln2b;
    float* out;
    char* ws;
};

#define XB_TMO      128
#define XB_XCNT(j)  (256  + 64 * (j))
#define XB_XSUB(j)  (1280 + 64 * (j))
#define XB_XGEN(j)  (2304 + 64 * (j))
#define XB_TOP      3328
#define XB_TOPGEN   3392
#define XCD_BAR_WORDS 3456
#define XB_SPIN_CAP (1u << 18)
#define LAS __attribute__((address_space(3)))

__device__ __forceinline__ unsigned xb_ld(unsigned* p)              { return __hip_atomic_load(p, __ATOMIC_RELAXED, __HIP_MEMORY_SCOPE_AGENT); }
__device__ __forceinline__ unsigned xb_add(unsigned* p, unsigned v) { return __hip_atomic_fetch_add(p, v, __ATOMIC_RELAXED, __HIP_MEMORY_SCOPE_AGENT); }
__device__ __forceinline__ unsigned xb_xcc_id() { return (unsigned)__builtin_amdgcn_s_getreg((3 << 11) | 20) & 0xFu; }
#define XB_SPIN(cond, bar) do { unsigned _sp = 0; while (cond) { __builtin_amdgcn_s_sleep(1); \
    if ((++_sp & 255u) == 0u) { if (xb_ld(&(bar)[XB_TMO])) break; if (_sp > XB_SPIN_CAP) { atomicAdd(&(bar)[XB_TMO], 1u); break; } } } } while (0)

struct XcdBarrier {
    unsigned* bar; unsigned x;
    volatile LAS unsigned* st;
};

__device__ __forceinline__ XcdBarrier xcd_barrier_post(unsigned* bar, volatile LAS unsigned* st) {
    XcdBarrier b; b.bar = bar; b.x = xb_xcc_id(); b.st = st;
    if (threadIdx.x == 0) (void)xb_add(&bar[XB_XCNT(b.x)], 1u);
    return b;
}
__device__ __forceinline__ void xcd_barrier_complete(unsigned* bar, unsigned x, unsigned& nloc, unsigned& nx) {
    const unsigned G = gridDim.x * gridDim.y * gridDim.z;
    unsigned sum, cnt, mine, sp = 0u;
    for (;;) {
        sum = 0u; cnt = 0u; mine = 0u;
#pragma unroll
        for (unsigned j = 0; j < 16; ++j) { const unsigned c = xb_ld(&bar[XB_XCNT(j)]); sum += c; cnt += (c > 0u) ? 1u : 0u; mine = (j == x) ? c : mine; }
        if (sum == G) break;
        __builtin_amdgcn_s_sleep(1);
        if ((++sp & 255u) == 0u) { if (xb_ld(&bar[XB_TMO])) break; if (sp > XB_SPIN_CAP) { atomicAdd(&bar[XB_TMO], 1u); break; } }
    }
    nloc = mine > 0u ? mine : 1u; nx = cnt > 0u ? cnt : 1u;
}

__device__ __forceinline__ void xcd_barrier(const XcdBarrier& b) {
    asm volatile("s_waitcnt vmcnt(0)" ::: "memory");
    __syncthreads();
    if (threadIdx.x == 0) {
        unsigned* bar = b.bar;
        __builtin_amdgcn_s_waitcnt(0);
        unsigned nloc = b.st[0], nx = b.st[1];
        if (nloc == 0u) { xcd_barrier_complete(bar, b.x, nloc, nx); b.st[0] = nloc; b.st[1] = nx; }
        const unsigned old = xb_add(&bar[XB_XSUB(b.x)], 1u);
        const unsigned gen = old / nloc;
        if (old + 1u == (gen + 1u) * nloc) {
            __builtin_amdgcn_fence(__ATOMIC_RELEASE, "agent");
            asm volatile("s_waitcnt vmcnt(0)" ::: "memory");
            const unsigned og = xb_add(&bar[XB_TOP], 1u);
            const unsigned tg = og / nx;
            if (og + 1u == (tg + 1u) * nx) xb_add(&bar[XB_TOPGEN], 1u);
            else XB_SPIN(xb_ld(&bar[XB_TOPGEN]) == tg, bar);
            __builtin_amdgcn_fence(__ATOMIC_ACQUIRE, "agent");
            xb_add(&bar[XB_XGEN(b.x)], 1u);
            asm volatile("s_waitcnt vmcnt(0)" ::: "memory");
        } else {
            XB_SPIN(xb_ld(&bar[XB_XGEN(b.x)]) == gen, bar);
            __builtin_amdgcn_fence(__ATOMIC_ACQUIRE, "agent");
            asm volatile("s_waitcnt vmcnt(0)" ::: "memory");
        }
    }
    __syncthreads();
}


DEVINL int tid_() { int t = threadIdx.x; asm volatile("" : "+v"(t)); return t; }
DEVINL int bid_() { int b = blockIdx.x; asm volatile("" : "+s"(b)); return b; }
#define GAS __attribute__((address_space(1)))
DEVINL char* wsl_(char* w) { GAS char* g = (GAS char*)w; asm volatile("" : "+s"(g)); return (char*)g; }
template <class Tp> DEVINL const Tp* gl_(const Tp* q) { const GAS Tp* g = (const GAS Tp*)q; asm volatile("" : "+s"(g)); return (const Tp*)g; }
typedef float f32x2_t __attribute__((ext_vector_type(2)));
typedef __bf16 bf16x2_t __attribute__((ext_vector_type(2)));
DEVINL unsigned pk2bf(float lo, float hi) { f32x2_t f = {lo, hi}; bf16x2_t b = __builtin_convertvector(f, bf16x2_t); return __builtin_bit_cast(unsigned, b); }
DEVINL u16 f2bf(float f) { return (u16)(pk2bf(f, f) & 0xFFFFu); }
DEVINL float bf2f(u16 h) { return __uint_as_float(((unsigned)h) << 16); }
DEVINL float wsum(float v) { for (int o = 32; o > 0; o >>= 1) v += __shfl_xor(v, o); return v; }
DEVINL float sigmoidf_(float x) { return 1.f / (1.f + __expf(-x)); }
DEVINL float siluf_(float x) { return x / (1.f + __expf(-x)); }
DEVINL float softplusf_(float x) { return fmaxf(x, 0.f) + log1pf(__expf(-fabsf(x))); }
DEVINL int row_sel(int row) { return row < CTXROWS ? 2 : ((row - CTXROWS) >> 14); }
template <int CTRL, int RM>
DEVINL float dpp_f(float v) { return __int_as_float(__builtin_amdgcn_update_dpp(0, __float_as_int(v), CTRL, RM, 0xF, false)); }
DEVINL float wave_sum_dpp(float v) {
    v += dpp_f<0xB1, 0xF>(v);
    v += dpp_f<0x4E, 0xF>(v);
    v += dpp_f<0x141, 0xF>(v);
    v += dpp_f<0x140, 0xF>(v);
    v += dpp_f<0x142, 0xA>(v);
    v += dpp_f<0x143, 0xC>(v);
    return __int_as_float(__builtin_amdgcn_readlane(__float_as_int(v), 63));
}
DEVINL unsigned lds_addr(const void* p) { return (unsigned)(size_t)(const __attribute__((address_space(3))) char*)p; }
using u32x4 = __attribute__((ext_vector_type(4))) unsigned;
using u32x2 = __attribute__((ext_vector_type(2))) unsigned;
template <int OFF> DEVINL u32x4 lds_rd128(unsigned a) { u32x4 v; asm volatile("ds_read_b128 %0, %1 offset:%2" : "=v"(v) : "v"(a), "n"(OFF)); return v; }
template <int OFF> DEVINL u32x2 lds_rd64(unsigned a) { u32x2 v; asm volatile("ds_read_b64 %0, %1 offset:%2" : "=v"(v) : "v"(a), "n"(OFF)); return v; }
DEVINL void glds4(const void* g, void* l) {
    __builtin_amdgcn_global_load_lds((const __attribute__((address_space(1))) void*)g, (__attribute__((address_space(3))) void*)l, 4, 0, 0);
}
DEVINL void glds16(const void* g, void* l) {
    __builtin_amdgcn_global_load_lds((const __attribute__((address_space(1))) void*)g, (__attribute__((address_space(3))) void*)l, 16, 0, 0);
}

template <class RowA>
DEVINL void gemm128_acc(RowA rowA, const u16* __restrict__ Bt, int ldb, int K, char* smem, f32x4 (&acc)[4][4]) {
    const int tid = tid_(), lane = tid & 63, wid = tid >> 6, wr = wid >> 1, wc = wid & 1, fr = lane & 15, fq = lane >> 4;
#pragma unroll
    for (int m = 0; m < 4; ++m)
#pragma unroll
        for (int n = 0; n < 4; ++n) acc[m][n] = f32x4{0.f, 0.f, 0.f, 0.f};
    const u16* aS0 = rowA(tid >> 2) + (tid & 3) * 8;
    const u16* aS1 = rowA((tid >> 2) + 64) + (tid & 3) * 8;
    const u16* bS0 = Bt + (size_t)(tid >> 2) * ldb + (tid & 3) * 8;
    const u16* bS1 = Bt + (size_t)((tid >> 2) + 64) * ldb + (tid & 3) * 8;
    const int nt = K >> 5;
    __syncthreads();
    {
        char* SA = smem; char* SB = smem + 8192;
        glds16(aS0, SA + tid * 16); glds16(aS1, SA + tid * 16 + 4096);
        glds16(bS0, SB + tid * 16); glds16(bS1, SB + tid * 16 + 4096);
    }
    for (int t = 0; t < nt; ++t) {
        asm volatile("s_waitcnt vmcnt(0)" ::: "memory");
        __builtin_amdgcn_s_barrier();
        if (t + 1 < nt) {
            char* SA = smem + ((t + 1) & 1) * 16384; char* SB = SA + 8192;
            const int ko = (t + 1) * 32;
            glds16(aS0 + ko, SA + tid * 16); glds16(aS1 + ko, SA + tid * 16 + 4096);
            glds16(bS0 + ko, SB + tid * 16); glds16(bS1 + ko, SB + tid * 16 + 4096);
        }
        const char* SA = smem + (t & 1) * 16384; const char* SB = SA + 8192;
        bf16x8 af[4], bfr[4];
#pragma unroll
        for (int m = 0; m < 4; ++m) af[m] = *(const bf16x8*)(SA + (wr * 64 + m * 16 + fr) * 64 + fq * 16);
#pragma unroll
        for (int n = 0; n < 4; ++n) bfr[n] = *(const bf16x8*)(SB + (wc * 64 + n * 16 + fr) * 64 + fq * 16);
#pragma unroll
        for (int m = 0; m < 4; ++m)
#pragma unroll
            for (int n = 0; n < 4; ++n) acc[m][n] = __builtin_amdgcn_mfma_f32_16x16x32_bf16(af[m], bfr[n], acc[m][n], 0, 0, 0);
    }
}
template <class RowA, class Epi>
DEVINL void gemm128(RowA rowA, const u16* __restrict__ Bt, int ldb, int K, char* smem, Epi epi) {
    const int tid = tid_(), lane = tid & 63, wid = tid >> 6, wr = wid >> 1, wc = wid & 1, fr = lane & 15, fq = lane >> 4;
    f32x4 acc[4][4];
    gemm128_acc(rowA, Bt, ldb, K, smem, acc);
#pragma unroll
    for (int m = 0; m < 4; ++m)
#pragma unroll
        for (int n = 0; n < 4; ++n) epi(wr * 64 + m * 16 + fq * 4, wc * 64 + n * 16 + fr, acc[m][n]);
}

DEVINL void ph_prolog(const P& p, char* smem) {
    const int TIDX_ = tid_(); const int BIDX_ = bid_(); char* const WS_ = wsl_(p.ws); (void)TIDX_; (void)BIDX_; (void)WS_;
    const int tid = TIDX_;
    float* modv = (float*)(WS_ + OFF_MOD);
    float* sil = (float*)smem;
    float* red = sil + 3072;
    bool ready = false;
    for (int u = BIDX_; u < 192; u += gridDim.x) {
        if (!ready) {
            for (int i = tid; i < 3072; i += 256) { int v = i >> 10, k = i & 1023; float cv = v < 2 ? p.c[v * 1024 + k] : p.c_ctx[k]; sil[i] = cv / (1.f + expf(-cv)); }
            ready = true;
        }
        __syncthreads();
        const int l = u / 96, cg = u % 96;
        const float* W = p.w_mod + (size_t)l * 1024 * 6144 + cg * 64;
        const int c4 = (tid & 15) * 4, rg = tid >> 4;
        float a0[4] = {0, 0, 0, 0}, a1[4] = {0, 0, 0, 0}, a2[4] = {0, 0, 0, 0};
#pragma unroll 4
        for (int i = 0; i < 64; ++i) {
            const int k = rg + 16 * i;
            const float4 w = *(const float4*)(W + (size_t)k * 6144 + c4);
            const float s0 = sil[k], s1 = sil[1024 + k], s2 = sil[2048 + k];
            a0[0] += s0 * w.x; a0[1] += s0 * w.y; a0[2] += s0 * w.z; a0[3] += s0 * w.w;
            a1[0] += s1 * w.x; a1[1] += s1 * w.y; a1[2] += s1 * w.z; a1[3] += s1 * w.w;
            a2[0] += s2 * w.x; a2[1] += s2 * w.y; a2[2] += s2 * w.z; a2[3] += s2 * w.w;
        }
#pragma unroll
        for (int j = 0; j < 4; ++j) { red[(rg * 3 + 0) * 64 + c4 + j] = a0[j]; red[(rg * 3 + 1) * 64 + c4 + j] = a1[j]; red[(rg * 3 + 2) * 64 + c4 + j] = a2[j]; }
        __syncthreads();
        if (tid < 192) {
            const int v = tid >> 6, cc = tid & 63;
            float s = 0.f;
            for (int r = 0; r < 16; ++r) s += red[(r * 3 + v) * 64 + cc];
            const int col = cg * 64 + cc;
            modv[(l * 3 + v) * 6144 + col] = s + p.b_mod[l * 6144 + col];
        }
        __syncthreads();
    }
    float* rope = (float*)(WS_ + OFF_ROPE);
    for (int i = BIDX_ * 256 + tid; i < 320 * 16; i += gridDim.x * 256) {
        const int pos = (i < 4096) ? (i >> 4) : ((i - 4096) >> 4);
        const int f = i & 15;
        const float inv = powf(10000.0f, -(float)f / 16.0f);
        const float ang = (float)pos * inv;
        const double TWO_PI = 6.283185307179586476925;
        double a = (double)ang;
        a -= TWO_PI * rint(a / TWO_PI);
        const float cr = (float)cos(a), sr = (float)sin(a);
        if (i < 4096) { rope[i] = cr; rope[4096 + i] = sr; }
        else { rope[8192 + (i - 4096)] = cr; rope[8192 + 1024 + (i - 4096)] = sr; }
    }
    {
        u16* w2t = (u16*)(WS_ + OFF_LORA); u16* a2t = w2t + 2 * 2 * 256 * 32; u16* g2t = a2t + 2 * 2 * 256 * 32;
        for (int i = BIDX_ * 256 + tid; i < 2 * 2 * 256 * 32; i += gridDim.x * 256) {
            const int lz = i >> 13, c = (i >> 5) & 255, r = i & 31;
            w2t[i] = f2bf(p.rw_w2[((size_t)lz * 32 + r) * 256 + c]);
            a2t[i] = f2bf(p.rw_a2[((size_t)lz * 32 + r) * 256 + c]);
        }
        for (int i = BIDX_ * 256 + tid; i < 2 * 256 * 64; i += gridDim.x * 256) {
            const int l = i >> 14, c = (i >> 6) & 255, r = i & 63;
            g2t[i] = f2bf(p.rw_g2[((size_t)l * 64 + r) * 256 + c]);
        }
    }
    u16* wr = (u16*)(WS_ + OFF_WR);
    for (int i = BIDX_ * 256 + tid; i < 2 * 128 * 1024; i += gridDim.x * 256) {
        const int l = i >> 17, n = (i >> 10) & 127, k = i & 1023;
        float v = 0.f;
        if (n < 4) v = p.rgw[((size_t)l * 1024 + k) * 4 + n];
        else if (n < 36) v = p.rew[((size_t)l * 1024 + k) * 32 + (n - 4)];
        wr[i] = f2bf(v);
    }
}

DEVINL void conv_tile(const float* __restrict__ src, int N, int K, u16* __restrict__ dst, int k0, int n0, int mode, char* smem) {
    unsigned* t = (unsigned*)smem;
    const int tid = tid_();
    const int n4 = (tid & 15) * 4;
    const bool ok = n0 + n4 < N;
    float4 va[2], vb[2];
    __syncthreads();
#pragma unroll
    for (int i = 0; i < 2; ++i) {
        const int kp = i * 16 + (tid >> 4);
        const float* s0 = src + (size_t)(k0 + 2 * kp) * N + n0 + n4;
        va[i] = ok ? *(const float4*)s0 : make_float4(0.f, 0.f, 0.f, 0.f);
        vb[i] = ok ? *(const float4*)(s0 + N) : make_float4(0.f, 0.f, 0.f, 0.f);
    }
#pragma unroll
    for (int i = 0; i < 2; ++i) {
        const int kp = i * 16 + (tid >> 4);
        t[(n4 + 0) * 33 + kp] = pk2bf(va[i].x, vb[i].x);
        t[(n4 + 1) * 33 + kp] = pk2bf(va[i].y, vb[i].y);
        t[(n4 + 2) * 33 + kp] = pk2bf(va[i].z, vb[i].z);
        t[(n4 + 3) * 33 + kp] = pk2bf(va[i].w, vb[i].w);
    }
    __syncthreads();
    {
        const int n = tid >> 2, w0 = (tid & 3) * 8;
        const int ng = n0 + n;
        int nd = ng;
        if (mode == 1) nd = 32 * (ng >> 4) + (ng & 15);
        else if (mode == 2) nd = 32 * (ng >> 4) + 16 + (ng & 15);
        uint4 o0, o1;
        o0.x = t[n * 33 + w0 + 0]; o0.y = t[n * 33 + w0 + 1]; o0.z = t[n * 33 + w0 + 2]; o0.w = t[n * 33 + w0 + 3];
        o1.x = t[n * 33 + w0 + 4]; o1.y = t[n * 33 + w0 + 5]; o1.z = t[n * 33 + w0 + 6]; o1.w = t[n * 33 + w0 + 7];
        u16* q = dst + (size_t)nd * K + k0 + w0 * 2;
        *(uint4*)q = o0; *(uint4*)(q + 8) = o1;
    }
}
DEVINL void ph_convw(const P& p, int l, char* smem) {
    const int TIDX_ = tid_(); const int BIDX_ = bid_(); char* const WS_ = wsl_(p.ws); (void)TIDX_; (void)BIDX_; (void)WS_;
    u16* win = (u16*)(WS_ + OFF_WIN); u16* wout = (u16*)(WS_ + OFF_WOUT);
    for (int u = BIDX_; u < 896 + 256; u += gridDim.x) {
        if (u < 896) conv_tile(p.w_in + (size_t)l * 1024 * INP, INP, 1024, win, (u / 56) * 64, (u % 56) * 64, 0, smem);
        else { const int v = u - 896; conv_tile(p.w_out + (size_t)l * 1024 * 1024, 1024, 1024, wout, (v / 16) * 64, (v % 16) * 64, 0, smem); }
    }
}
DEVINL void ph_convexp(const P& p, int l, char* smem, int bid, int nb) {
    const int TIDX_ = tid_(); const int BIDX_ = bid_(); char* const WS_ = wsl_(p.ws); (void)TIDX_; (void)BIDX_; (void)WS_;
    u16* wgu = (u16*)(WS_ + OFF_WGU); u16* wdn = (u16*)(WS_ + OFF_WDN);
    for (int u = bid; u < 32 * 384; u += nb) {
        const int e = u / 384, v = u % 384;
        const size_t le = (size_t)l * 32 + e;
        if (v < 128) conv_tile(p.egate + le * 1024 * 512, 512, 1024, wgu + (size_t)e * 1024 * 1024, (v / 8) * 64, (v % 8) * 64, 1, smem);
        else if (v < 256) { const int w = v - 128; conv_tile(p.eup + le * 1024 * 512, 512, 1024, wgu + (size_t)e * 1024 * 1024, (w / 8) * 64, (w % 8) * 64, 2, smem); }
        else { const int w = v - 256; conv_tile(p.edown + le * 512 * 1024, 1024, 512, wdn + (size_t)e * 1024 * 512, (w / 16) * 64, (w % 16) * 64, 0, smem); }
    }
}

DEVINL void ph_xm0(const P& p) {
    const int TIDX_ = tid_(); const int BIDX_ = bid_(); char* const WS_ = wsl_(p.ws); (void)TIDX_; (void)BIDX_; (void)WS_;
    const float* modv = (const float*)(WS_ + OFF_MOD);
    u16* hm = (u16*)(WS_ + OFF_HM);
    for (size_t i = (size_t)BIDX_ * 256 + TIDX_; i < (size_t)T * 256; i += (size_t)gridDim.x * 256) {
        const int row = (int)(i >> 8), c4 = (int)(i & 255) * 4;
        const float* src = row < CTXROWS ? p.ctx + (size_t)row * 1024 : p.x + (size_t)(row - CTXROWS) * 1024;
        const float* mv = modv + row_sel(row) * 6144;
        const float4 v = *(const float4*)(src + c4);
        const float4 sh = *(const float4*)(mv + c4), sc = *(const float4*)(mv + 1024 + c4);
        uint2 o;
        o.x = (unsigned)f2bf(v.x * (1.f + sc.x) + sh.x) | ((unsigned)f2bf(v.y * (1.f + sc.y) + sh.y) << 16);
        o.y = (unsigned)f2bf(v.z * (1.f + sc.z) + sh.z) | ((unsigned)f2bf(v.w * (1.f + sc.w) + sh.w) << 16);
        *(uint2*)(hm + (size_t)row * 1024 + c4) = o;
    }
}

DEVINL void ph_inproj(const P& p, char* smem) {
    const int TIDX_ = tid_(); const int BIDX_ = bid_(); char* const WS_ = wsl_(p.ws); (void)TIDX_; (void)BIDX_; (void)WS_;
    const u16* hm = (const u16*)(WS_ + OFF_HM);
    const u16* win = (const u16*)(WS_ + OFF_WIN);
    u16* pqk = (u16*)(WS_ + OFF_PQK); u16* vtl = (u16*)(WS_ + OFF_VTL); u16* vtc = (u16*)(WS_ + OFF_VTC);
    u16* pb = (u16*)(WS_ + OFF_PB); u16* pc = (u16*)(WS_ + OFF_PC);
    for (int u = BIDX_; u < 260 * 28; u += gridDim.x) {
        const int mt = u / 28, nt = u % 28;
        const u16* A = hm + (size_t)mt * 128 * 1024;
        gemm128([&](int r) { return A + (size_t)r * 1024; }, win + (size_t)nt * 128 * 1024, 1024, 1024, smem,
                [&](int m, int n, f32x4 a) {
                    const int R = mt * 128 + m, N = nt * 128 + n;
                    if (N >= INP) return;
                    const u16 h0 = f2bf(a[0]), h1 = f2bf(a[1]), h2 = f2bf(a[2]), h3 = f2bf(a[3]);
                    if (N < 1024) {
                        u16* q = pqk + (size_t)R * 1024 + N; q[0] = h0; q[1024] = h1; q[2048] = h2; q[3072] = h3;
                    } else if (N < 1536) {
                        const int hh = (N - 1024) >> 6, d = (N - 1024) & 63;
                        uint2 v; v.x = (unsigned)h0 | ((unsigned)h1 << 16); v.y = (unsigned)h2 | ((unsigned)h3 << 16);
                        if (R < CTXROWS) { const int b = R >> 8, t = R & 255; *(uint2*)(vtc + ((size_t)((b * 8 + hh) * 64 + d)) * 256 + t) = v; }
                        else { const int R2 = R - CTXROWS, b = R2 >> 14, t = R2 & 16383; *(uint2*)(vtl + ((size_t)((b * 8 + hh) * 64 + d)) * 16384 + t) = v; }
                    } else if (N < 2496) {
                        u16* q = pb + (size_t)R * 960 + (N - 1536); q[0] = h0; q[960] = h1; q[1920] = h2; q[2880] = h3;
                    } else {
                        u16* q = pc + (size_t)R * 1040 + (N - 2496); q[0] = h0; q[1040] = h1; q[2080] = h2; q[3120] = h3;
                    }
                });
    }
}

constexpr size_t RWREC = 12288;
constexpr size_t RW_A1 = 0, RW_A4 = 2048, RW_A3 = 4096, RW_MKA = 8192, RW_TT = 8704, RW_MY = 9216, RW_V = 10240;
constexpr size_t OFF_RWOP = OFF_X1;
constexpr size_t OFF_RWWG = OFF_RWOP + (size_t)8 * 1040 * RWREC;
constexpr size_t OFF_YRWB = OFF_RWWG + (size_t)8 * 260 * 64 * 4;
constexpr size_t OFF_BONUS = OFF_YRWB + (size_t)T * 256 * 2;
static_assert(OFF_BONUS + (size_t)T * 4 * 4 <= OFF_HM, "rw operand store must fit the X1 region");

DEVINL float rw_mix(const u16* __restrict__ pb, const float* __restrict__ mup, const float* __restrict__ mun, int row, int t, int seqlen, int col) {
    const float cu = bf2f(pb[(size_t)row * 960 + col]);
    const float pr = t > 0 ? bf2f(pb[(size_t)(row - 1) * 960 + col]) : 0.f;
    const float nx = t + 1 < seqlen ? bf2f(pb[(size_t)(row + 1) * 960 + col]) : 0.f;
    return cu + mup[col] * (pr - cu) + mun[col] * (nx - cu);
}

DEVINL void ph_rwprep(const P& p, int l, int d, char* smem) {
    const int TIDX_ = tid_(); const int BIDX_ = bid_(); char* const WS_ = wsl_(p.ws);
    const int tid = TIDX_, lane = tid & 63, w = tid >> 6, fr = lane & 15, fq = lane >> 4;
    const u16* pb = (const u16*)(WS_ + OFF_PB);
    char* rwop = WS_ + OFF_RWOP;
    float* rwwg = (float*)(WS_ + OFF_RWWG);
    float* bonus = (float*)(WS_ + OFF_BONUS);
    u16* gate = (u16*)(WS_ + OFF_GATE);
    const float* mup = p.mu_prev + l * 960; const float* mun = p.mu_next + l * 960;
    u16* lwdh = (u16*)smem;
    u16* ladh = lwdh + 2048;
    u16* abuf = ladh + 2048;
    float* Lb = (float*)(smem + 16384);
    u16* SV = (u16*)(smem + 32768);
    float* tot = (float*)(smem + 32768);
    const u16* w2t = (const u16*)(WS_ + OFF_LORA);
    const u16* a2t = w2t + 2 * 2 * 256 * 32;
    const u16* g2t = a2t + 2 * 2 * 256 * 32;
    const int z = d;
    for (int uh = BIDX_; uh < NUNIT_CH * 4; uh += gridDim.x) {
        const int u = uh >> 2, h = uh & 3;
        int b, gi, row0, seqlen, gscan;
        if (u < 8) { b = u >> 2; gi = u & 3; row0 = b * 256 + gi * 64; seqlen = 256; gscan = d ? 3 - gi : gi; }
        else { b = (u - 8) >> 8; gi = (u - 8) & 255; row0 = CTXROWS + b * LAT + gi * 64; seqlen = LAT; gscan = 4 + (d ? 255 - gi : gi); }
        const int t0 = gi * 64;
        __syncthreads();
#pragma unroll 1
        for (int i = 0; i < 8; ++i) {
            const int idx = tid + 256 * i, j = idx >> 5, cc = idx & 31;
            lwdh[idx] = f2bf(tanhf(rw_mix(pb, mup, mun, row0 + j, t0 + j, seqlen, 768 + z * 32 + cc)));
            ladh[idx] = f2bf(rw_mix(pb, mup, mun, row0 + j, t0 + j, seqlen, 832 + z * 32 + cc));
        }
        if (d == 0) {
            u16* lgd = (u16*)Lb;
#pragma unroll 1
            for (int i = 0; i < 16; ++i) {
                const int idx = tid + 256 * i, j = idx >> 6, cc = idx & 63;
                lgd[idx] = f2bf(sigmoidf_(rw_mix(pb, mup, mun, row0 + j, t0 + j, seqlen, 896 + cc)));
            }
            __syncthreads();
            const bf16x8 x0 = *(const bf16x8*)(lgd + (16 * w + fr) * 64 + 8 * fq), x1 = *(const bf16x8*)(lgd + (16 * w + fr) * 64 + 32 + 8 * fq);
#pragma unroll
            for (int nt = 0; nt < 4; ++nt) {
                const u16* bp = g2t + ((size_t)l * 256 + 64 * h + 16 * nt + fr) * 64 + 8 * fq;
                const bf16x8 b0 = *(const bf16x8*)bp, b1 = *(const bf16x8*)(bp + 32);
                f32x4 acc = f32x4{0.f, 0.f, 0.f, 0.f};
                acc = __builtin_amdgcn_mfma_f32_16x16x32_bf16(x0, b0, acc, 0, 0, 0);
                acc = __builtin_amdgcn_mfma_f32_16x16x32_bf16(x1, b1, acc, 0, 0, 0);
#pragma unroll
                for (int r = 0; r < 4; ++r) gate[(size_t)(row0 + 16 * w + 4 * fq + r) * 256 + 64 * h + 16 * nt + fr] = f2bf(acc[r]);
            }
        }
        {
            const int bh = b * 4 + h;
            const int ch = h * 64 + lane;
            __syncthreads();
            {
                const bf16x8 xw = *(const bf16x8*)(lwdh + (16 * w + fr) * 32 + 8 * fq);
                const bf16x8 xa = *(const bf16x8*)(ladh + (16 * w + fr) * 32 + 8 * fq);
#pragma unroll 1
                for (int kt = 0; kt < 4; ++kt) {
                    const int key = 16 * kt + fr;
                    const size_t wrow = ((size_t)(l * 2 + z) * 256 + h * 64 + key) * 32 + 8 * fq;
                    const bf16x8 bw = *(const bf16x8*)(w2t + wrow), ba = *(const bf16x8*)(a2t + wrow);
                    f32x4 ae = f32x4{0.f, 0.f, 0.f, 0.f}, aa = f32x4{0.f, 0.f, 0.f, 0.f};
                    ae = __builtin_amdgcn_mfma_f32_16x16x32_bf16(xw, bw, ae, 0, 0, 0);
                    aa = __builtin_amdgcn_mfma_f32_16x16x32_bf16(xa, ba, aa, 0, 0, 0);
                    const float w0 = p.rw_w0[(l * 2 + z) * 256 + h * 64 + key], a0 = p.rw_a0[(l * 2 + z) * 256 + h * 64 + key];
#pragma unroll
                    for (int r = 0; r < 4; ++r) {
                        const int tok = 16 * w + 4 * fq + r;
                        const int s = d ? 63 - tok : tok;
                        Lb[s * 64 + key] = 0.60653065971263342f * sigmoidf_(ae[r] + w0);
                        abuf[tok * 64 + key] = f2bf(sigmoidf_(aa[r] + a0));
                    }
                }
            }
            __syncthreads();
            {
                float pre[16]; float run = 0.f;
#pragma unroll
                for (int i = 0; i < 16; ++i) { run += Lb[(16 * w + i) * 64 + lane]; pre[i] = run; }
                tot[w * 64 + lane] = run;
                __syncthreads();
                float offs = 0.f;
#pragma unroll
                for (int ww = 0; ww < 3; ++ww) offs += (ww < w) ? tot[ww * 64 + lane] : 0.f;
#pragma unroll
                for (int i = 0; i < 16; ++i) Lb[(16 * w + i) * 64 + lane] = -(offs + pre[i]);
            }
            __syncthreads();
            {
                const float kkw = p.rw_kk[l * 256 + ch], ka = p.rw_ka[l * 256 + ch], rk = p.rw_rk[l * 256 + ch];
#pragma unroll 1
                for (int i = 0; i < 16; ++i) {
                    const int j = w + 4 * i, row = row0 + j, tt = t0 + j;
                    const float rr = rw_mix(pb, mup, mun, row, tt, seqlen, ch);
                    const float kr = rw_mix(pb, mup, mun, row, tt, seqlen, 256 + ch);
                    const float a = bf2f(abuf[j * 64 + lane]);
                    const float kkv = kr * kkw;
                    const float ss = wsum(kkv * kkv);
                    const float kkn = kkv / fmaxf(sqrtf(ss), 1e-12f);
                    const int s = d ? 63 - j : j;
                    const float Lt = Lb[s * 64 + lane];
                    const float Lp = s > 0 ? Lb[(s - 1) * 64 + lane] : 0.f;
                    const float einv = expf(-Lt);
                    const int c = s >> 4, ts = s & 15;
                    u16* sv = SV + (size_t)(c * 4) * 1024 + ts * 64 + lane;
                    sv[0] = f2bf(-kkn * expf(Lp));
                    sv[1024] = f2bf(rr * expf(Lt));
                    sv[2048] = f2bf(kkn * a * einv);
                    sv[3072] = f2bf(kr * (1.f + (a - 1.f) * ka) * einv);
                    if (d == 0) { const float bs = wsum(rr * kr * rk); if (lane == 0) bonus[(size_t)row * 4 + h] = bs; }
                }
                if (w == 0) rwwg[((size_t)bh * 260 + gscan) * 64 + lane] = expf(Lb[63 * 64 + lane]);
            }
            __syncthreads();
            {
                char* rec = rwop + ((size_t)bh * 1040 + (size_t)gscan * 4 + w) * RWREC;
                const u16* Av = SV + (size_t)(w * 4) * 1024; const u16* Rv = Av + 1024; const u16* Bv = Av + 2048; const u16* Kv = Av + 3072;
                bf16x8 fa[2], frr[2], fb[2], fk[2];
#pragma unroll
                for (int ks = 0; ks < 2; ++ks) {
                    fa[ks] = *(const bf16x8*)(Av + fr * 64 + ks * 32 + fq * 8);
                    frr[ks] = *(const bf16x8*)(Rv + fr * 64 + ks * 32 + fq * 8);
                    fb[ks] = *(const bf16x8*)(Bv + fr * 64 + ks * 32 + fq * 8);
                    fk[ks] = *(const bf16x8*)(Kv + fr * 64 + ks * 32 + fq * 8);
                }
                f32x4 mka = f32x4{0.f, 0.f, 0.f, 0.f}, mba = mka, mkr = mka, mbr = mka;
#pragma unroll
                for (int ks = 0; ks < 2; ++ks) {
                    mka = __builtin_amdgcn_mfma_f32_16x16x32_bf16(fa[ks], fk[ks], mka, 0, 0, 0);
                    mba = __builtin_amdgcn_mfma_f32_16x16x32_bf16(fa[ks], fb[ks], mba, 0, 0, 0);
                    mkr = __builtin_amdgcn_mfma_f32_16x16x32_bf16(frr[ks], fk[ks], mkr, 0, 0, 0);
                    mbr = __builtin_amdgcn_mfma_f32_16x16x32_bf16(frr[ks], fb[ks], mbr, 0, 0, 0);
                }
                float* Ns = Lb + w * 256;
                u16* rmka = (u16*)(rec + RW_MKA); u16* rmy = (u16*)(rec + RW_MY); u16* rtt = (u16*)(rec + RW_TT);
                const int i_ = fr;
#pragma unroll
                for (int r = 0; r < 4; ++r) {
                    const int t_ = 4 * fq + r;
                    const int lp = (i_ >> 2) * 16 + t_;
                    rmka[lp * 4 + (i_ & 3)] = f2bf(i_ < t_ ? mka[r] : 0.f);
                    rmy[lp * 8 + (i_ & 3)] = f2bf(i_ <= t_ ? mbr[r] : 0.f);
                    rmy[lp * 8 + 4 + (i_ & 3)] = f2bf(i_ <= t_ ? mkr[r] : 0.f);
                    Ns[t_ * 16 + i_] = i_ < t_ ? mba[r] : 0.f;
                }
                if (lane < 16) {
                    float Tr[16];
#pragma unroll
                    for (int t_ = 0; t_ < 16; ++t_) {
                        float acc = (lane == t_) ? 1.f : 0.f;
#pragma unroll
                        for (int ii = 0; ii < t_; ++ii) acc += Tr[ii] * Ns[t_ * 16 + ii];
                        Tr[t_] = acc;
                        rtt[((lane >> 2) * 16 + t_) * 4 + (lane & 3)] = f2bf(acc);
                    }
                }
#pragma unroll
                for (int ks = 0; ks < 2; ++ks) {
                    uint4 o;
                    const uint2 lo = *(const uint2*)(Av + fr * 64 + 32 * ks + 4 * fq), hi = *(const uint2*)(Av + fr * 64 + 32 * ks + 16 + 4 * fq);
                    o.x = lo.x; o.y = lo.y; o.z = hi.x; o.w = hi.y;
                    *(uint4*)(rec + RW_A1 + (ks * 64 + lane) * 16) = o;
                    const uint2 lo2 = *(const uint2*)(Rv + fr * 64 + 32 * ks + 4 * fq), hi2 = *(const uint2*)(Rv + fr * 64 + 32 * ks + 16 + 4 * fq);
                    o.x = lo2.x; o.y = lo2.y; o.z = hi2.x; o.w = hi2.y;
                    *(uint4*)(rec + RW_A4 + (ks * 64 + lane) * 16) = o;
                }
#pragma unroll
                for (int m = 0; m < 4; ++m) {
                    unsigned e[8];
#pragma unroll
                    for (int j = 0; j < 4; ++j) { e[j] = Bv[(4 * fq + j) * 64 + 16 * m + fr]; e[4 + j] = Kv[(4 * fq + j) * 64 + 16 * m + fr]; }
                    uint4 o; o.x = e[0] | (e[1] << 16); o.y = e[2] | (e[3] << 16); o.z = e[4] | (e[5] << 16); o.w = e[6] | (e[7] << 16);
                    *(uint4*)(rec + RW_A3 + (m * 64 + lane) * 16) = o;
                }
#pragma unroll 1
                for (int q = 0; q < 4; ++q) {
                    unsigned e[4];
#pragma unroll
                    for (int j = 0; j < 4; ++j) {
                        const int s = 16 * w + 4 * fq + j; const int jt = d ? 63 - s : s;
                        e[j] = f2bf(rw_mix(pb, mup, mun, row0 + jt, t0 + jt, seqlen, 512 + h * 64 + 16 * q + fr));
                    }
                    uint2 o; o.x = e[0] | (e[1] << 16); o.y = e[2] | (e[3] << 16);
                    *(uint2*)(rec + RW_V + (q * 64 + lane) * 8) = o;
                }
            }
        }
    }
}

constexpr int RWSLOT = 12544;
DEVINL void ph_rwscan(const P& p, int l, int d, int bid, int nb, char* smem) {
    const int TIDX_ = tid_(); char* const WS_ = wsl_(p.ws);
    const int tid = TIDX_, lane = tid & 63, q = tid >> 6, fr = lane & 15, fq = lane >> 4;
    const char* rwop = WS_ + OFF_RWOP;
    const float* rwwg = (const float*)(WS_ + OFF_RWWG);
    u16* yf = (u16*)(WS_ + OFF_Y);
    u16* yb = (u16*)(WS_ + OFF_YRWB);
    (void)l;
    for (int bh = bid; bh < 8; bh += nb) {
        const int b = bh >> 2, h = bh & 3;
        f32x4 z[4];
#pragma unroll
        for (int m = 0; m < 4; ++m) z[m] = f32x4{0.f, 0.f, 0.f, 0.f};
        const char* rec0 = rwop + (size_t)bh * 1040 * RWREC;
        const float* wg0 = rwwg + (size_t)bh * 260 * 64;
        auto issue = [&](int c, int sl) {
            const int cc = c < 1040 ? c : 1039;
            char* slot = smem + sl * RWSLOT;
            const char* rec = rec0 + (size_t)cc * RWREC;
#pragma unroll
            for (int i = 0; i < 3; ++i) glds16(rec + (tid + 256 * i) * 16, slot + (tid + 256 * i) * 16);
            glds4((const char*)(wg0 + (size_t)(cc >> 2) * 64) + lane * 4, slot + 12288 + lane * 4);
        };
        auto asfrag = [](uint4 v) { union { uint4 u; bf16x8 f; } x; x.u = v; return x.f; };
        auto pack2 = [](float lo, float hi) { return pk2bf(lo, hi); };
        const unsigned b128 = lds_addr(smem) + lane * 16, b64 = lds_addr(smem) + lane * 8, bv = lds_addr(smem) + (q * 64 + lane) * 8, bg = lds_addr(smem) + 16 * fq;
        __syncthreads();
        issue(0, 0); issue(1, 1); issue(2, 2); issue(3, 3);
#pragma unroll 1
        for (int c5 = 0; c5 < 1040; c5 += 5) {
          auto body = [&](auto SJ) {
            constexpr int sj = decltype(SJ)::value;
            const int c = c5 + sj;
            asm volatile("s_waitcnt vmcnt(12)" ::: "memory");
            __builtin_amdgcn_s_barrier();
            issue(c + 4, (sj + 4) % 5);
            constexpr int SB = sj * RWSLOT;
            u32x4 r_a10, r_a11, r_a40, r_a41, r_a30, r_a31, r_a32, r_a33, r_my, g0, g1, g2, g3;
            u32x2 mka, tt, vcur;
            asm volatile(
                "ds_read_b128 %0, %16 offset:%20+0\n\t"
                "ds_read_b128 %1, %16 offset:%20+1024\n\t"
                "ds_read_b128 %2, %16 offset:%20+2048\n\t"
                "ds_read_b128 %3, %16 offset:%20+3072\n\t"
                "ds_read_b128 %4, %16 offset:%20+4096\n\t"
                "ds_read_b128 %5, %16 offset:%20+5120\n\t"
                "ds_read_b128 %6, %16 offset:%20+6144\n\t"
                "ds_read_b128 %7, %16 offset:%20+7168\n\t"
                "ds_read_b128 %8, %16 offset:%20+9216\n\t"
                "ds_read_b64 %9, %17 offset:%20+8192\n\t"
                "ds_read_b64 %10, %17 offset:%20+8704\n\t"
                "ds_read_b64 %11, %18 offset:%20+10240\n\t"
                "ds_read_b128 %12, %19 offset:%20+12288\n\t"
                "ds_read_b128 %13, %19 offset:%20+12352\n\t"
                "ds_read_b128 %14, %19 offset:%20+12416\n\t"
                "ds_read_b128 %15, %19 offset:%20+12480\n\t"
                "s_waitcnt lgkmcnt(0)"
                : "=&v"(r_a10), "=&v"(r_a11), "=&v"(r_a40), "=&v"(r_a41), "=&v"(r_a30), "=&v"(r_a31), "=&v"(r_a32), "=&v"(r_a33), "=&v"(r_my),
                  "=&v"(mka), "=&v"(tt), "=&v"(vcur), "=&v"(g0), "=&v"(g1), "=&v"(g2), "=&v"(g3)
                : "v"(b128), "v"(b64), "v"(bv), "v"(bg), "n"(SB)
                : "memory");
            auto asfrag4 = [](u32x4 v) { union { u32x4 u; bf16x8 f; } x; x.u = v; return x.f; };
            const bf16x8 A1_0 = asfrag4(r_a10), A1_1 = asfrag4(r_a11), A4_0 = asfrag4(r_a40), A4_1 = asfrag4(r_a41);
            const bf16x8 A3_0 = asfrag4(r_a30), A3_1 = asfrag4(r_a31), A3_2 = asfrag4(r_a32), A3_3 = asfrag4(r_a33), MY = asfrag4(r_my);
            const bf16x8 MKA = asfrag(make_uint4(mka.x, mka.y, 0u, 0u)), TT = asfrag(make_uint4(tt.x, tt.y, 0u, 0u));
            const bf16x8 VB = asfrag(make_uint4(vcur.x, vcur.y, 0u, 0u));
            const bf16x8 ZB0 = asfrag(make_uint4(pack2(z[0][0], z[0][1]), pack2(z[0][2], z[0][3]), pack2(z[1][0], z[1][1]), pack2(z[1][2], z[1][3])));
            const bf16x8 ZB1 = asfrag(make_uint4(pack2(z[2][0], z[2][1]), pack2(z[2][2], z[2][3]), pack2(z[3][0], z[3][1]), pack2(z[3][2], z[3][3])));
            f32x4 X = f32x4{0.f, 0.f, 0.f, 0.f};
            X = __builtin_amdgcn_mfma_f32_16x16x32_bf16(MKA, VB, X, 0, 0, 0);
            X = __builtin_amdgcn_mfma_f32_16x16x32_bf16(A1_0, ZB0, X, 0, 0, 0);
            X = __builtin_amdgcn_mfma_f32_16x16x32_bf16(A1_1, ZB1, X, 0, 0, 0);
            f32x4 Y = f32x4{0.f, 0.f, 0.f, 0.f};
            Y = __builtin_amdgcn_mfma_f32_16x16x32_bf16(A4_0, ZB0, Y, 0, 0, 0);
            Y = __builtin_amdgcn_mfma_f32_16x16x32_bf16(A4_1, ZB1, Y, 0, 0, 0);
            const bf16x8 XB = asfrag(make_uint4(pack2(X[0], X[1]), pack2(X[2], X[3]), 0u, 0u));
            f32x4 U = f32x4{0.f, 0.f, 0.f, 0.f};
            U = __builtin_amdgcn_mfma_f32_16x16x32_bf16(TT, XB, U, 0, 0, 0);
            const bf16x8 UV = asfrag(make_uint4(pack2(U[0], U[1]), pack2(U[2], U[3]), vcur.x, vcur.y));
            z[0] = __builtin_amdgcn_mfma_f32_16x16x32_bf16(A3_0, UV, z[0], 0, 0, 0);
            z[1] = __builtin_amdgcn_mfma_f32_16x16x32_bf16(A3_1, UV, z[1], 0, 0, 0);
            z[2] = __builtin_amdgcn_mfma_f32_16x16x32_bf16(A3_2, UV, z[2], 0, 0, 0);
            z[3] = __builtin_amdgcn_mfma_f32_16x16x32_bf16(A3_3, UV, z[3], 0, 0, 0);
            Y = __builtin_amdgcn_mfma_f32_16x16x32_bf16(MY, UV, Y, 0, 0, 0);
            if ((c & 3) == 3) {
                z[0][0] *= __uint_as_float(g0.x); z[0][1] *= __uint_as_float(g0.y); z[0][2] *= __uint_as_float(g0.z); z[0][3] *= __uint_as_float(g0.w);
                z[1][0] *= __uint_as_float(g1.x); z[1][1] *= __uint_as_float(g1.y); z[1][2] *= __uint_as_float(g1.z); z[1][3] *= __uint_as_float(g1.w);
                z[2][0] *= __uint_as_float(g2.x); z[2][1] *= __uint_as_float(g2.y); z[2][2] *= __uint_as_float(g2.z); z[2][3] *= __uint_as_float(g2.w);
                z[3][0] *= __uint_as_float(g3.x); z[3][1] *= __uint_as_float(g3.y); z[3][2] *= __uint_as_float(g3.z); z[3][3] *= __uint_as_float(g3.w);
            }
            {
                const bool isctx = c < 16;
                const int cc = isctx ? c : c - 16;
                const int n = isctx ? LCTX : LAT;
                const int rowbase = isctx ? b * LCTX : CTXROWS + b * LAT;
                const unsigned y01 = pk2bf(Y[0], Y[1]), y23 = pk2bf(Y[2], Y[3]);
#pragma unroll
                for (int r = 0; r < 4; ++r) {
                    const int s = cc * 16 + 4 * fq + r;
                    const int t = d ? n - 1 - s : s;
                    const u16 o = (u16)(((r < 2 ? y01 : y23) >> ((r & 1) * 16)) & 0xFFFFu);
                    u16* dst = d == 0 ? yf + (size_t)(rowbase + t) * 1024 + 512 + h * 64 + 16 * q + fr : yb + (size_t)(rowbase + t) * 256 + h * 64 + 16 * q + fr;
                    *dst = o;
                }
            }
          };
          body(std::integral_constant<int, 0>{}); body(std::integral_constant<int, 1>{}); body(std::integral_constant<int, 2>{});
          body(std::integral_constant<int, 3>{}); body(std::integral_constant<int, 4>{});
        }
        asm volatile("s_waitcnt vmcnt(0)" ::: "memory");
        __syncthreads();
    }
}

DEVINL void ph_rwout(const P& p, int l) {
    const int TIDX_ = tid_(); const int BIDX_ = bid_(); char* const WS_ = wsl_(p.ws);
    const int tid = TIDX_, h = tid >> 6;
    const u16* pb = (const u16*)(WS_ + OFF_PB);
    const u16* yb = (const u16*)(WS_ + OFF_YRWB);
    const u16* gate = (const u16*)(WS_ + OFF_GATE);
    const float* bonus = (const float*)(WS_ + OFF_BONUS);
    u16* y = (u16*)(WS_ + OFF_Y);
    const float* mup = p.mu_prev + l * 960; const float* mun = p.mu_next + l * 960;
    const float lw = p.rw_lnw[l * 256 + tid], lb = p.rw_lnb[l * 256 + tid];
    const int rstart = (l == 0) ? 0 : CTXROWS;
    for (int row = rstart + BIDX_; row < T; row += gridDim.x) {
        int t, seqlen;
        if (row < CTXROWS) { t = row & 255; seqlen = LCTX; } else { t = (row - CTXROWS) & (LAT - 1); seqlen = LAT; }
        const float yv = bf2f(y[(size_t)row * 1024 + 512 + tid]) + bf2f(yb[(size_t)row * 256 + tid]);
        const float v = rw_mix(pb, mup, mun, row, t, seqlen, 512 + tid);
        const float mu = wsum(yv) * (1.f / 64.f);
        const float dl = yv - mu;
        const float var = wsum(dl * dl) * (1.f / 64.f);
        const float o = (dl * rsqrtf(var + 64e-5f) * lw + lb + bonus[(size_t)row * 4 + h] * v) * bf2f(gate[(size_t)row * 256 + tid]);
        y[(size_t)row * 1024 + 512 + tid] = f2bf(o);
    }
}
DEVINL void ph_prepM(const P& p, int l, char* smem) {
    const int TIDX_ = tid_(); const int BIDX_ = bid_(); char* const WS_ = wsl_(p.ws);
    const int tid = TIDX_, lane = tid & 63, wid = tid >> 6;
    const u16* pc = (const u16*)(WS_ + OFF_PC);
    u16* mlf = (u16*)(WS_ + OFF_MLF);
    float* mlg = (float*)(WS_ + OFF_MLG);
    float* mls = (float*)(WS_ + OFF_MLS);
    float* nst = (float*)(WS_ + OFF_NST);
    float* cst = (float*)(WS_ + OFF_HM);
    const float* rope = (const float*)(WS_ + OFF_ROPE);
    u16* kl = (u16*)smem;
    u16* vl = kl + 4096;
    float* wsl = (float*)(vl + 4096);
    float* lil = wsl + 128;
    for (int uh = BIDX_; uh < NUNIT_CH * 4; uh += gridDim.x) {
        const int u = uh >> 2, h = uh & 3;
        int b, ch, row0, seqlen; bool isctx;
        if (u < 8) { isctx = true; b = u >> 2; ch = u & 3; row0 = b * 256 + ch * 64; seqlen = 256; }
        else { isctx = false; b = (u - 8) >> 8; ch = (u - 8) & 255; row0 = CTXROWS + b * LAT + ch * 64; seqlen = LAT; }
        const int t0 = ch * 64;
        const int tc = isctx ? ch : 4 + ch;
        __syncthreads();
        {
            const bool isk = wid >= 2;
            const int cch = (isk ? 256 : 0) + h * 64 + lane;
            const float* cw = p.ml_cw + (size_t)l * 3 * 512;
            const float w0 = cw[cch], w1 = cw[512 + cch], w2 = cw[1024 + cch], bb = p.ml_cb[l * 512 + cch];
            const int jb = (wid & 1) * 32;
            const int i16 = lane & 15; const bool second = (lane & 16) != 0; const int half = lane >> 5;
            float pv = (t0 + jb > 0) ? bf2f(pc[(size_t)(row0 + jb - 1) * 1040 + cch]) : 0.f;
            float cv = bf2f(pc[(size_t)(row0 + jb) * 1040 + cch]);
#pragma unroll 4
            for (int jj = 0; jj < 32; ++jj) {
                const int j = jb + jj;
                const float nv = (t0 + j + 1 < seqlen) ? bf2f(pc[(size_t)(row0 + j + 1) * 1040 + cch]) : 0.f;
                float val = siluf_(w0 * pv + w1 * cv + w2 * nv + bb);
                if (!isctx) {
                    const int t = t0 + j;
                    const int pos = half == 0 ? (t >> 6) : (t & 63);
                    const float cs = half == 0 ? rope[pos * 16 + i16] : rope[8192 + pos * 16 + i16];
                    const float sn = half == 0 ? rope[4096 + pos * 16 + i16] : rope[9216 + pos * 16 + i16];
                    const float ov = __shfl_xor(val, 16);
                    val = second ? (ov * sn + val * cs) : (val * cs - ov * sn);
                }
                if (isk) { const u16 kb = f2bf(val * 0.125f); mlf[(size_t)(row0 + j) * 512 + 256 + h * 64 + lane] = kb; kl[j * 64 + lane] = kb; }
                else mlf[(size_t)(row0 + j) * 512 + h * 64 + lane] = f2bf(val);
                pv = cv; cv = nv;
            }
            {
                const int j = tid >> 2, wh = tid & 3;
                const int idx = (wh < 2) ? (wh * 4 + h) : (8 + (wh - 2) * 4 + h);
                const float g = bf2f(pc[(size_t)(row0 + j) * 1040 + 1024 + idx]);
                float v;
                if (wh < 2) v = g + p.ml_ib[l * 8 + idx];
                else { const float xx = g + p.ml_fb[l * 8 + idx - 8]; v = fminf(xx, 0.f) - log1pf(__expf(-fabsf(xx))); }
                lil[j * 4 + wh] = v;
                mlg[(size_t)(row0 + j) * 16 + idx] = v;
            }
            for (int i = tid; i < 64 * 16; i += 256) {
                const int tok = i >> 4, c4 = (i & 15) * 4;
                *(uint2*)(vl + tok * 64 + c4) = *(const uint2*)(pc + (size_t)(row0 + tok) * 1040 + 512 + h * 64 + c4);
            }
        }
        __syncthreads();
        if (tid < 2) {
            const int d = tid;
            float bacc = 0.f;
#pragma unroll 1
            for (int jj = 0; jj < 64; ++jj) { const int tok = d ? 63 - jj : jj; bacc += lil[tok * 4 + 2 + d]; wsl[d * 64 + tok] = bacc; }
            const float Bs = bacc;
            float G = -3.0e38f;
#pragma unroll 1
            for (int tok = 0; tok < 64; ++tok) { const float g = Bs - wsl[d * 64 + tok] + lil[tok * 4 + d]; G = fmaxf(G, g); }
#pragma unroll 1
            for (int tok = 0; tok < 64; ++tok) { const float g = Bs - wsl[d * 64 + tok] + lil[tok * 4 + d]; wsl[d * 64 + tok] = expf(g - G); }
            const int bhd = (b * 4 + h) * 2 + d;
            mls[(bhd * NTC + tc) * 2 + 0] = G; mls[(bhd * NTC + tc) * 2 + 1] = Bs;
        }
        __syncthreads();
        {
            const int dk4 = (tid >> 4) * 4, dv4 = (tid & 15) * 4;
            float a0[4][4], a1[4][4], n0[4], n1[4];
#pragma unroll
            for (int a = 0; a < 4; ++a) { n0[a] = 0.f; n1[a] = 0.f;
#pragma unroll
                for (int c = 0; c < 4; ++c) { a0[a][c] = 0.f; a1[a][c] = 0.f; } }
#pragma unroll 2
            for (int j = 0; j < 64; ++j) {
                const uint2 kk = *(const uint2*)(kl + j * 64 + dk4);
                const uint2 vv = *(const uint2*)(vl + j * 64 + dv4);
                const float w0 = wsl[j], w1 = wsl[64 + j];
                const float kf[4] = {bf2f((u16)(kk.x & 0xFFFF)), bf2f((u16)(kk.x >> 16)), bf2f((u16)(kk.y & 0xFFFF)), bf2f((u16)(kk.y >> 16))};
                const float vf[4] = {bf2f((u16)(vv.x & 0xFFFF)), bf2f((u16)(vv.x >> 16)), bf2f((u16)(vv.y & 0xFFFF)), bf2f((u16)(vv.y >> 16))};
#pragma unroll
                for (int a = 0; a < 4; ++a) {
                    const float k0 = kf[a] * w0, k1 = kf[a] * w1;
                    n0[a] += k0; n1[a] += k1;
#pragma unroll
                    for (int c = 0; c < 4; ++c) { a0[a][c] += k0 * vf[c]; a1[a][c] += k1 * vf[c]; }
                }
            }
            const int bh0 = ((b * 4 + h) * 2 + 0) * NTC + tc, bh1 = ((b * 4 + h) * 2 + 1) * NTC + tc;
#pragma unroll
            for (int a = 0; a < 4; ++a) {
                *(float4*)(cst + (size_t)bh0 * 4096 + (dk4 + a) * 64 + dv4) = make_float4(a0[a][0], a0[a][1], a0[a][2], a0[a][3]);
                *(float4*)(cst + (size_t)bh1 * 4096 + (dk4 + a) * 64 + dv4) = make_float4(a1[a][0], a1[a][1], a1[a][2], a1[a][3]);
                if ((tid & 15) == 0) { nst[(size_t)bh0 * 64 + dk4 + a] = n0[a]; nst[(size_t)bh1 * 64 + dk4 + a] = n1[a]; }
            }
        }
    }
}

DEVINL void ph_mlB(const P& p, int bid, int nb, char* smem) {
    const int TIDX_ = tid_(); char* const WS_ = wsl_(p.ws);
    const int tid = TIDX_;
    const float* mls = (const float*)(WS_ + OFF_MLS);
    float* mst = (float*)(WS_ + OFF_MST);
    float* nst = (float*)(WS_ + OFF_NST);
    float* cst = (float*)(WS_ + OFF_HM);
    float* gb = (float*)smem;
    float* dcu = gb + 1024;
    for (int u = bid; u < 64; u += nb) {
        const int bhd = u >> 2, q = u & 3, d = bhd & 1;
        auto tcof = [&](int cs) { return cs < 4 ? (d ? 3 - cs : cs) : 4 + (d ? 255 - (cs - 4) : cs - 4); };
        __syncthreads();
        for (int cs = tid; cs < NTC; cs += 256) { const int tc = tcof(cs); gb[cs * 2] = mls[(bhd * NTC + tc) * 2]; gb[cs * 2 + 1] = mls[(bhd * NTC + tc) * 2 + 1]; }
        __syncthreads();
        if (tid == 0) {
            float m = 0.f;
#pragma unroll 1
            for (int cs = 0; cs < NTC; ++cs) {
                const float G = gb[cs * 2], Bs = gb[cs * 2 + 1];
                if (q == 0) mst[bhd * NTC + tcof(cs)] = m;
                const float ml = fmaxf(Bs + m, G);
                dcu[cs * 2] = __expf(Bs + m - ml); dcu[cs * 2 + 1] = __expf(G - ml);
                m = ml;
            }
        }
        __syncthreads();
        float zz = 0.f; asm volatile("" : "+v"(zz));
        float4 C = make_float4(zz, zz, zz, zz);
        float nn = zz;
        const bool don = (q == 0) && (tid < 64);
        float* cbase = cst + (size_t)bhd * NTC * 4096 + q * 1024 + tid * 4;
        float* nbase = nst + (size_t)bhd * NTC * 64 + tid;
        float4 Ub[8]; float Nb[8];
#pragma unroll
        for (int i = 0; i < 8; ++i) { Ub[i] = *(const float4*)(cbase + (size_t)tcof(i) * 4096); Nb[i] = don ? nbase[(size_t)tcof(i) * 64] : 0.f; }
#pragma unroll 1
        for (int cs0 = 0; cs0 < NTC; cs0 += 8) {
#pragma unroll
            for (int i = 0; i < 8; ++i) {
                const int cs = cs0 + i;
                if (cs < NTC) {
                    const float4 U = Ub[i]; const float nU = Nb[i];
                    const int tc = tcof(cs);
                    if (cs + 8 < NTC) { Ub[i] = *(const float4*)(cbase + (size_t)tcof(cs + 8) * 4096); Nb[i] = don ? nbase[(size_t)tcof(cs + 8) * 64] : 0.f; }
                    *(float4*)(cbase + (size_t)tc * 4096) = C;
                    if (don) nbase[(size_t)tc * 64] = nn;
                    const float dC = dcu[cs * 2], dU = dcu[cs * 2 + 1];
                    C.x = dC * C.x + dU * U.x; C.y = dC * C.y + dU * U.y; C.z = dC * C.z + dU * U.z; C.w = dC * C.w + dU * U.w;
                    nn = dC * nn + dU * nU;
                }
            }
        }
    }
}

DEVINL void ph_na(const P& p, int l, char* smem, int bid, int nb) {
    const int TIDX_ = tid_(); const int BIDX_ = bid_(); char* const WS_ = wsl_(p.ws); (void)TIDX_; (void)BIDX_; (void)WS_;
    const int tid = TIDX_, lane = tid & 63, w = tid >> 6, fr = lane & 15, g = lane >> 4;
    const u16* pqk = (const u16*)(WS_ + OFF_PQK);
    const u16* vtl = (const u16*)(WS_ + OFF_VTL);
    const u16* vtc = (const u16*)(WS_ + OFF_VTC);
    u16* y = (u16*)(WS_ + OFF_Y);
    float* rpbl = (float*)smem;
    const int nunit = 4096 + (l == 0 ? 64 : 0);
    for (int u = bid; u < nunit; u += nb) {
        const bool isctx = u >= 4096;
        int b, h, r = 0, qg = 0;
        if (!isctx) { b = u >> 11; h = (u >> 8) & 7; r = u & 255; }
        else { const int v = u - 4096; b = v >> 5; h = (v >> 2) & 7; qg = v & 3; }
        __syncthreads();
        if (!isctx) for (int i = tid; i < 465; i += 256) rpbl[i] = p.na_rpb[((size_t)l * 8 + h) * 465 + i];
        __syncthreads();
        const int c = 16 * w + fr;
        const int qrow = isctx ? b * LCTX + qg * 64 + c : CTXROWS + b * LAT + r * 64 + c;
        bf16x8 qf[2];
        qf[0] = *(const bf16x8*)(pqk + (size_t)qrow * 1024 + h * 64 + 8 * g);
        qf[1] = *(const bf16x8*)(pqk + (size_t)qrow * 1024 + h * 64 + 32 + 8 * g);
        f32x4 O[4];
#pragma unroll
        for (int i = 0; i < 4; ++i) O[i] = f32x4{0.f, 0.f, 0.f, 0.f};
        float mrun = -1.0e30f, lrun = 0.f;
        auto chunk = [&](const u16* kbase0, const u16* kbase1, const u16* vb, int vstride, const float* bias0, const float* bias1, bool lo0, bool lo1, int kc0, int cs) {
            bf16x8 k00 = *(const bf16x8*)(kbase0 + 8 * g), k01 = *(const bf16x8*)(kbase0 + 32 + 8 * g);
            bf16x8 k10 = *(const bf16x8*)(kbase1 + 8 * g), k11 = *(const bf16x8*)(kbase1 + 32 + 8 * g);
            uint2 vlo[4], vhi[4];
#pragma unroll
            for (int dt = 0; dt < 4; ++dt) { vlo[dt] = *(const uint2*)(vb + (size_t)dt * 16 * vstride); vhi[dt] = *(const uint2*)(vb + (size_t)dt * 16 * vstride + 16); }
            f32x4 s0 = f32x4{0.f, 0.f, 0.f, 0.f}, s1 = f32x4{0.f, 0.f, 0.f, 0.f};
            s0 = __builtin_amdgcn_mfma_f32_16x16x32_bf16(k00, qf[0], s0, 0, 0, 0);
            s0 = __builtin_amdgcn_mfma_f32_16x16x32_bf16(k01, qf[1], s0, 0, 0, 0);
            s1 = __builtin_amdgcn_mfma_f32_16x16x32_bf16(k10, qf[0], s1, 0, 0, 0);
            s1 = __builtin_amdgcn_mfma_f32_16x16x32_bf16(k11, qf[1], s1, 0, 0, 0);
            float sv[8];
#pragma unroll
            for (int j = 0; j < 4; ++j) {
                float a = s0[j] * 0.125f, bb = s1[j] * 0.125f;
                if (lo0) {
                    const int k0c = kc0 + 4 * g + j, k1c = k0c + 16;
                    a = (k0c >= cs && k0c <= cs + 15) ? a + bias0[k0c] : -1.0e30f;
                    bb = (k1c >= cs && k1c <= cs + 15) ? bb + bias0[k1c] : -1.0e30f;
                }
                sv[j] = a; sv[4 + j] = bb;
            }
            (void)bias1; (void)lo1;
            float mx = sv[0];
#pragma unroll
            for (int j = 1; j < 8; ++j) mx = fmaxf(mx, sv[j]);
            mx = fmaxf(mx, __shfl_xor(mx, 16)); mx = fmaxf(mx, __shfl_xor(mx, 32));
            const float mnew = fmaxf(mrun, mx);
            const float sc = __expf(mrun - mnew);
            mrun = mnew;
            float ps = 0.f; bf16x8 pf;
#pragma unroll
            for (int j = 0; j < 8; ++j) { const float pv = __expf(sv[j] - mnew); ps += pv; pf[j] = (short)f2bf(pv); }
            lrun = lrun * sc + ps;
#pragma unroll
            for (int dt = 0; dt < 4; ++dt) {
                O[dt][0] *= sc; O[dt][1] *= sc; O[dt][2] *= sc; O[dt][3] *= sc;
                bf16x8 vf;
                vf[0] = (short)(vlo[dt].x & 0xFFFF); vf[1] = (short)(vlo[dt].x >> 16); vf[2] = (short)(vlo[dt].y & 0xFFFF); vf[3] = (short)(vlo[dt].y >> 16);
                vf[4] = (short)(vhi[dt].x & 0xFFFF); vf[5] = (short)(vhi[dt].x >> 16); vf[6] = (short)(vhi[dt].y & 0xFFFF); vf[7] = (short)(vhi[dt].y >> 16);
                O[dt] = __builtin_amdgcn_mfma_f32_16x16x32_bf16(vf, pf, O[dt], 0, 0, 0);
            }
        };
        if (!isctx) {
            const int rs = min(max(r - 4, 0), 248);
            const int cb = (w == 0) ? 0 : (w == 1) ? 8 : (w == 2) ? 24 : 32;
            const int cs = min(max(c - 8, 0), 48);
            for (int i = 0; i < 8; ++i) {
                const int krow = rs + i;
                const size_t tokb = (size_t)CTXROWS + (size_t)b * LAT + krow * 64 + cb;
                const u16* kb0 = pqk + (tokb + fr) * 1024 + 512 + h * 64;
                const u16* kb1 = pqk + (tokb + 16 + fr) * 1024 + 512 + h * 64;
                const u16* vb = vtl + ((size_t)((b * 8 + h) * 64 + fr)) * LAT + krow * 64 + cb + 4 * g;
                const float* bias0 = rpbl + (krow - r + 7) * 31 - c + 15;
                chunk(kb0, kb1, vb, LAT, bias0, bias0, true, true, cb, cs);
            }
        }
        for (int cc = 0; cc < 8; ++cc) {
            const size_t tokb = (size_t)b * LCTX + cc * 32;
            const u16* kb0 = pqk + (tokb + fr) * 1024 + 512 + h * 64;
            const u16* kb1 = pqk + (tokb + 16 + fr) * 1024 + 512 + h * 64;
            const u16* vb = vtc + ((size_t)((b * 8 + h) * 64 + fr)) * LCTX + cc * 32 + 4 * g;
            chunk(kb0, kb1, vb, LCTX, nullptr, nullptr, false, false, 0, 0);
        }
        float lt = lrun; lt += __shfl_xor(lt, 16); lt += __shfl_xor(lt, 32);
        const float inv = 1.f / lt;
#pragma unroll
        for (int dt = 0; dt < 4; ++dt) {
            uint2 o;
            o.x = (unsigned)f2bf(O[dt][0] * inv) | ((unsigned)f2bf(O[dt][1] * inv) << 16);
            o.y = (unsigned)f2bf(O[dt][2] * inv) | ((unsigned)f2bf(O[dt][3] * inv) << 16);
            *(uint2*)(y + (size_t)qrow * 1024 + h * 64 + dt * 16 + 4 * g) = o;
        }
    }
}

DEVINL void ph_mlC(const P& p, int l, char* smem, int bid, int nb) {
    const int TIDX_ = tid_(); const int BIDX_ = bid_(); char* const WS_ = wsl_(p.ws); (void)TIDX_; (void)BIDX_; (void)WS_;
    const int tid = TIDX_;
    const u16* mlf = (const u16*)(WS_ + OFF_MLF);
    const u16* pc = (const u16*)(WS_ + OFF_PC);
    const float* mlg = (const float*)(WS_ + OFF_MLG);
    const float* mst = (const float*)(WS_ + OFF_MST);
    const float* nst = (const float*)(WS_ + OFF_NST);
    const float* cst = (const float*)(WS_ + OFF_HM);
    u16* y = (u16*)(WS_ + OFF_Y);
    u16* ql = (u16*)smem;
    u16* kl = ql + 4096;
    u16* vl = kl + 4096;
    float* Cl = (float*)(vl + 4096);
    float* Sl = Cl + 4096;
    float* btl = Sl + 4096;
    float* lil = btl + 64;
    float* nl = lil + 64;
    const int t = tid >> 2, q4 = tid & 3;
    for (int uh = bid; uh < 2 * NTC * 4; uh += nb) {
        const int u = uh >> 2, h = uh & 3;
        const int b = u / NTC, tc = u % NTC;
        if (tc < 4 && l != 0) continue;
        const int row0 = tc < 4 ? b * LCTX + tc * 64 : CTXROWS + b * LAT + (tc - 4) * 64;
        {
            float hs[16];
#pragma unroll
            for (int i = 0; i < 16; ++i) hs[i] = 0.f;
            __syncthreads();
            for (int i = tid; i < 64 * 16; i += 256) {
                const int tok = i >> 4, c4 = (i & 15) * 4;
                *(uint2*)(ql + tok * 64 + c4) = *(const uint2*)(mlf + (size_t)(row0 + tok) * 512 + h * 64 + c4);
                *(uint2*)(kl + tok * 64 + c4) = *(const uint2*)(mlf + (size_t)(row0 + tok) * 512 + 256 + h * 64 + c4);
                *(uint2*)(vl + tok * 64 + c4) = *(const uint2*)(pc + (size_t)(row0 + tok) * 1040 + 512 + h * 64 + c4);
            }
            for (int d = 0; d < 2; ++d) {
                const int bhd = (b * 4 + h) * 2 + d;
                __syncthreads();
                for (int i = tid; i < 1024; i += 256) *(float4*)(Cl + i * 4) = *(const float4*)(cst + ((size_t)bhd * NTC + tc) * 4096 + i * 4);
                if (tid < 64) { nl[tid] = nst[((size_t)bhd * NTC + tc) * 64 + tid]; lil[tid] = mlg[(size_t)(row0 + tid) * 16 + d * 4 + h]; }
                if (tid == 64) {
                    float bacc = 0.f;
#pragma unroll 1
                    for (int jj = 0; jj < 64; ++jj) { const int tok = d ? 63 - jj : jj; bacc += mlg[(size_t)(row0 + tok) * 16 + 8 + d * 4 + h]; btl[tok] = bacc; }
                }
                __syncthreads();
                const float m0 = mst[bhd * NTC + tc];
                float sc[16];
#pragma unroll
                for (int i = 0; i < 16; ++i) sc[i] = 0.f;
                for (int dk = 0; dk < 64; dk += 4) {
                    const uint2 qq = *(const uint2*)(ql + t * 64 + dk);
                    const float q0 = bf2f((u16)(qq.x & 0xFFFF)), q1 = bf2f((u16)(qq.x >> 16)), q2 = bf2f((u16)(qq.y & 0xFFFF)), q3 = bf2f((u16)(qq.y >> 16));
#pragma unroll
                    for (int i = 0; i < 16; ++i) {
                        const uint2 kk = *(const uint2*)(kl + (q4 * 16 + i) * 64 + dk);
                        sc[i] += q0 * bf2f((u16)(kk.x & 0xFFFF)) + q1 * bf2f((u16)(kk.x >> 16)) + q2 * bf2f((u16)(kk.y & 0xFFFF)) + q3 * bf2f((u16)(kk.y >> 16));
                    }
                }
                const float bt = btl[t];
                float ld[16]; float mx = -3.0e38f;
#pragma unroll
                for (int i = 0; i < 16; ++i) {
                    const int s = q4 * 16 + i;
                    const bool ok = d ? (s >= t) : (s <= t);
                    ld[i] = ok ? (bt - btl[s] + lil[s]) : -3.0e38f;
                    mx = fmaxf(mx, ld[i]);
                }
                mx = fmaxf(mx, __shfl_xor(mx, 1)); mx = fmaxf(mx, __shfl_xor(mx, 2));
                const float mt = fmaxf(bt + m0, mx);
                float rsum = 0.f;
#pragma unroll
                for (int i = 0; i < 16; ++i) {
                    const int s = q4 * 16 + i;
                    const bool ok = d ? (s >= t) : (s <= t);
                    const float dw = ok ? expf(ld[i] - mt) * sc[i] : 0.f;
                    rsum += dw;
                    Sl[t * 64 + s] = dw;
                }
                rsum += __shfl_xor(rsum, 1); rsum += __shfl_xor(rsum, 2);
                const float inter = expf(bt + m0 - mt);
                float qn = 0.f;
                for (int dk = q4 * 16; dk < q4 * 16 + 16; ++dk) qn += bf2f(ql[t * 64 + dk]) * nl[dk];
                qn += __shfl_xor(qn, 1); qn += __shfl_xor(qn, 2);
                const float den = rsum + inter * qn;
                __syncthreads();
                float num[16];
#pragma unroll
                for (int i = 0; i < 16; ++i) num[i] = 0.f;
                for (int s = 0; s < 64; ++s) {
                    const float dw = Sl[t * 64 + s];
                    const uint4 va = *(const uint4*)(vl + s * 64 + q4 * 16);
                    const uint4 vb2 = *(const uint4*)(vl + s * 64 + q4 * 16 + 8);
                    const unsigned vv[8] = {va.x, va.y, va.z, va.w, vb2.x, vb2.y, vb2.z, vb2.w};
#pragma unroll
                    for (int i = 0; i < 8; ++i) { num[2 * i] += dw * bf2f((u16)(vv[i] & 0xFFFF)); num[2 * i + 1] += dw * bf2f((u16)(vv[i] >> 16)); }
                }
                for (int dk = 0; dk < 64; ++dk) {
                    const float qv = bf2f(ql[t * 64 + dk]) * inter;
#pragma unroll
                    for (int i = 0; i < 16; i += 4) {
                        const float4 cv = *(const float4*)(Cl + dk * 64 + q4 * 16 + i);
                        num[i] += qv * cv.x; num[i + 1] += qv * cv.y; num[i + 2] += qv * cv.z; num[i + 3] += qv * cv.w;
                    }
                }
                const float dn = 1.f / fmaxf(fabsf(den), expf(-mt));
#pragma unroll
                for (int i = 0; i < 16; ++i) hs[i] += num[i] * dn;
            }
            float s1 = 0.f;
#pragma unroll
            for (int i = 0; i < 16; ++i) s1 += hs[i];
            s1 += __shfl_xor(s1, 1); s1 += __shfl_xor(s1, 2);
            const float mu = s1 * (1.f / 64.f);
            float s2 = 0.f;
#pragma unroll
            for (int i = 0; i < 16; ++i) { const float dlt = hs[i] - mu; s2 += dlt * dlt; }
            s2 += __shfl_xor(s2, 1); s2 += __shfl_xor(s2, 2);
            const float rstd = rsqrtf(s2 * (1.f / 64.f) + 1e-6f);
            const int row = row0 + t;
#pragma unroll
            for (int i = 0; i < 16; i += 2) {
                const int cc = h * 64 + q4 * 16 + i;
                const float o0 = bf2f(pc[(size_t)row * 1040 + 768 + cc]), o1 = bf2f(pc[(size_t)row * 1040 + 768 + cc + 1]);
                const float y0 = (hs[i] - mu) * rstd * p.ml_nw[l * 256 + cc] * sigmoidf_(o0);
                const float y1 = (hs[i + 1] - mu) * rstd * p.ml_nw[l * 256 + cc + 1] * sigmoidf_(o1);
                *(unsigned*)(y + (size_t)row * 1024 + 768 + cc) = (unsigned)f2bf(y0) | ((unsigned)f2bf(y1) << 16);
            }
        }
    }
}

DEVINL void ph_outproj(const P& p, int l, char* smem) {
    const int TIDX_ = tid_(); const int BIDX_ = bid_(); char* const WS_ = wsl_(p.ws); (void)TIDX_; (void)BIDX_; (void)WS_;
    const u16* y = (const u16*)(WS_ + OFF_Y);
    const u16* wout = (const u16*)(WS_ + OFF_WOUT);
    const float* modv = (const float*)(WS_ + OFF_MOD) + (size_t)l * 3 * 6144;
    const float* x2c = (const float*)(WS_ + OFF_X2CTX);
    float* x1 = (float*)(WS_ + OFF_X1);
    const int mt0 = (l == 0) ? 0 : 4;
    const int ntile = (260 - mt0) * 8;
    for (int u = BIDX_; u < ntile; u += gridDim.x) {
        const int mt = mt0 + u / 8, nt = u % 8;
        const u16* A = y + (size_t)mt * 128 * 1024;
        const int R0 = mt * 128;
        const float* xin;
        if (l == 0) xin = R0 < CTXROWS ? p.ctx + (size_t)R0 * 1024 : p.x + (size_t)(R0 - CTXROWS) * 1024;
        else xin = R0 < CTXROWS ? x2c + (size_t)R0 * 1024 : p.out + (size_t)(R0 - CTXROWS) * 1024;
        const float* g1 = modv + row_sel(R0) * 6144 + 2048;
        gemm128([&](int r) { return A + (size_t)r * 1024; }, wout + (size_t)nt * 128 * 1024, 1024, 1024, smem,
                [&](int m, int n, f32x4 a) {
                    const int N = nt * 128 + n;
                    const float gg = g1[N];
#pragma unroll
                    for (int j = 0; j < 4; ++j) x1[(size_t)(R0 + m + j) * 1024 + N] = ALPHA * xin[(size_t)(m + j) * 1024 + N] + gg * a[j];
                });
    }
}

DEVINL void ph_ln1(const P& p, int l) {
    const int TIDX_ = tid_(); const int BIDX_ = bid_(); char* const WS_ = wsl_(p.ws); (void)TIDX_; (void)BIDX_; (void)WS_;
    const int lane = TIDX_ & 63, wid = TIDX_ >> 6;
    const float* modv = (const float*)(WS_ + OFF_MOD) + (size_t)l * 3 * 6144;
    float* x1 = (float*)(WS_ + OFF_X1);
    u16* hm = (u16*)(WS_ + OFF_HM);
    const int rstart = (l == 0) ? 0 : CTXROWS;
    for (int row = rstart + BIDX_ * 4 + wid; row < T; row += gridDim.x * 4) {
        float4 v[4];
        float s = 0.f;
#pragma unroll
        for (int i = 0; i < 4; ++i) { v[i] = *(const float4*)(x1 + (size_t)row * 1024 + i * 256 + lane * 4); s += v[i].x + v[i].y + v[i].z + v[i].w; }
        const float mu = wsum(s) * (1.f / 1024.f);
        float q = 0.f;
#pragma unroll
        for (int i = 0; i < 4; ++i) { v[i].x -= mu; v[i].y -= mu; v[i].z -= mu; v[i].w -= mu; q += v[i].x * v[i].x + v[i].y * v[i].y + v[i].z * v[i].z + v[i].w * v[i].w; }
        const float rstd = rsqrtf(wsum(q) * (1.f / 1024.f) + 1e-5f);
        const float* mv = modv + row_sel(row) * 6144;
#pragma unroll
        for (int i = 0; i < 4; ++i) {
            const int c = i * 256 + lane * 4;
            const float4 g = *(const float4*)(p.ln1g + l * 1024 + c), bb = *(const float4*)(p.ln1b + l * 1024 + c);
            const float4 sh = *(const float4*)(mv + 3072 + c), sc = *(const float4*)(mv + 4096 + c);
            float4 o;
            o.x = v[i].x * rstd * g.x + bb.x; o.y = v[i].y * rstd * g.y + bb.y; o.z = v[i].z * rstd * g.z + bb.z; o.w = v[i].w * rstd * g.w + bb.w;
            *(float4*)(x1 + (size_t)row * 1024 + c) = o;
            uint2 hh;
            hh.x = (unsigned)f2bf(o.x * (1.f + sc.x) + sh.x) | ((unsigned)f2bf(o.y * (1.f + sc.y) + sh.y) << 16);
            hh.y = (unsigned)f2bf(o.z * (1.f + sc.z) + sh.z) | ((unsigned)f2bf(o.w * (1.f + sc.w) + sh.w) << 16);
            *(uint2*)(hm + (size_t)row * 1024 + c) = hh;
        }
    }
}

DEVINL void ph_router(const P& p, int l, char* smem) {
    const int TIDX_ = tid_(); const int BIDX_ = bid_(); char* const WS_ = wsl_(p.ws); (void)TIDX_; (void)BIDX_; (void)WS_;
    const u16* hm = (const u16*)(WS_ + OFF_HM);
    const u16* wr = (const u16*)(WS_ + OFF_WR) + (size_t)l * 128 * 1024;
    float* lg = (float*)(WS_ + OFF_LOGITS);
    const int mt0 = (l == 0) ? 0 : 4;
    for (int u = BIDX_; u < 260 - mt0; u += gridDim.x) {
        const int mt = mt0 + u;
        const u16* A = hm + (size_t)mt * 128 * 1024;
        gemm128([&](int r) { return A + (size_t)r * 1024; }, wr, 1024, 1024, smem,
                [&](int m, int n, f32x4 a) {
                    if (n < 36) {
#pragma unroll
                        for (int j = 0; j < 4; ++j) lg[(size_t)(mt * 128 + m + j) * 64 + n] = a[j];
                    }
                });
    }
}

DEVINL void ph_route1(const P& p, int l, char* smem) {
    const int TIDX_ = tid_(); const int BIDX_ = bid_(); char* const WS_ = wsl_(p.ws); (void)TIDX_; (void)BIDX_; (void)WS_;
    const int tid = TIDX_;
    const float* lg = (const float*)(WS_ + OFF_LOGITS);
    int* toke = (int*)(WS_ + OFF_TOKE); float* tokw = (float*)(WS_ + OFF_TOKW);
    int* cnt = (int*)(WS_ + CTL_CNT) + l * 32;
    int* hist = (int*)smem;
    __syncthreads();
    if (tid < 32) hist[tid] = 0;
    __syncthreads();
    const int rstart = (l == 0) ? 0 : CTXROWS;
    for (int row = rstart + BIDX_ * 256 + tid; row < T; row += gridDim.x * 256) {
        const float* q = lg + (size_t)row * 64;
        float gl[4]; int gs = 0; float gm = -3.0e38f;
#pragma unroll
        for (int i = 0; i < 4; ++i) { gl[i] = q[i] + p.rgb[l * 4 + i]; if (gl[i] > gm) { gm = gl[i]; gs = i; } }
        float se = 0.f;
#pragma unroll
        for (int i = 0; i < 4; ++i) se += expf(gl[i] - gm);
        const float gw = 1.f / se;
        float v1 = -3.0e38f, v2 = -3.0e38f; int i1 = 0, i2 = 0;
#pragma unroll
        for (int i = 0; i < 8; ++i) {
            const float e = q[4 + gs * 8 + i] + p.reb[l * 32 + gs * 8 + i];
            if (e > v1) { v2 = v1; i2 = i1; v1 = e; i1 = i; }
            else if (e > v2) { v2 = e; i2 = i; }
        }
        const float e2 = expf(v2 - v1);
        const float w1 = gw / (1.f + e2), w2 = gw * e2 / (1.f + e2);
        const int ea = gs * 8 + i1, eb = gs * 8 + i2;
        toke[row * 2] = ea; toke[row * 2 + 1] = eb; tokw[row * 2] = w1; tokw[row * 2 + 1] = w2;
        atomicAdd(&hist[ea], 1); atomicAdd(&hist[eb], 1);
    }
    __syncthreads();
    if (tid < 32 && hist[tid] > 0) atomicAdd(&cnt[tid], hist[tid]);
}

DEVINL void ph_route2(const P& p, int l, char* smem) {
    const int TIDX_ = tid_(); const int BIDX_ = bid_(); char* const WS_ = wsl_(p.ws); (void)TIDX_; (void)BIDX_; (void)WS_;
    const int tid = TIDX_;
    const int* toke = (const int*)(WS_ + OFF_TOKE);
    int* toks = (int*)(WS_ + OFF_TOKS);
    int* slottok = (int*)(WS_ + OFF_SLOTTOK);
    const int* cnt = (const int*)(WS_ + CTL_CNT) + l * 32;
    int* cur = (int*)(WS_ + CTL_CUR) + l * 32;
    int* tiles = (int*)(WS_ + OFF_TILES);
    int* off = (int*)smem;
    int* hist = off + 64;
    int* base = hist + 32;
    __syncthreads();
    if (tid == 0) { int a = 0; for (int e = 0; e < 32; ++e) { off[e] = a; a += (cnt[e] + 127) & ~127; } off[32] = a; }
    if (tid < 32) hist[tid] = 0;
    __syncthreads();
    if (BIDX_ == 0) {
        if (tid == 0) {
            int nt = 0;
            for (int e = 0; e < 32; ++e) for (int s = off[e]; s < off[e + 1]; s += 128) { tiles[64 + nt * 2] = e; tiles[64 + nt * 2 + 1] = s; ++nt; }
            tiles[40] = nt;
        }
        for (int e = 0; e < 32; ++e) for (int s = off[e] + cnt[e] + tid; s < off[e + 1]; s += 256) slottok[s] = (l == 0) ? 0 : CTXROWS;
    }
    const int rstart = (l == 0) ? 0 : CTXROWS;
    for (int a0 = rstart * 2 + BIDX_ * 256; a0 < T * 2; a0 += gridDim.x * 256) {
        const int a = a0 + tid;
        int e = -1, lpos = 0;
        if (a < T * 2) { e = toke[a]; lpos = atomicAdd(&hist[e], 1); }
        __syncthreads();
        if (tid < 32) { base[tid] = hist[tid] > 0 ? atomicAdd(&cur[tid], hist[tid]) : 0; }
        __syncthreads();
        if (e >= 0) { const int s = off[e] + base[e] + lpos; toks[a] = s; slottok[s] = a >> 1; }
        __syncthreads();
        if (tid < 32) hist[tid] = 0;
        __syncthreads();
    }
}

DEVINL void ph_gateup(const P& p, char* smem) {
    const int TIDX_ = tid_(); const int BIDX_ = bid_(); char* const WS_ = wsl_(p.ws); (void)TIDX_; (void)BIDX_; (void)WS_;
    const int tid = TIDX_, lane = tid & 63, wid = tid >> 6, wr = wid >> 1, wc = wid & 1, fr = lane & 15, fq = lane >> 4;
    const u16* hm = (const u16*)(WS_ + OFF_HM);
    const u16* wgu = (const u16*)(WS_ + OFF_WGU);
    const int* tiles = (const int*)(WS_ + OFF_TILES);
    const int* slottok = (const int*)(WS_ + OFF_SLOTTOK);
    u16* act = (u16*)(WS_ + OFF_ACT);
    const int ntile = tiles[40] * 8;
    for (int u = BIDX_; u < ntile; u += gridDim.x) {
        const int ti = u >> 3, nt = u & 7;
        const int e = tiles[64 + ti * 2], s0 = tiles[64 + ti * 2 + 1];
        f32x4 acc[4][4];
        gemm128_acc([&](int r) { return hm + (size_t)slottok[s0 + r] * 1024; }, wgu + ((size_t)e * 1024 + nt * 128) * 1024, 1024, 1024, smem, acc);
#pragma unroll
        for (int m = 0; m < 4; ++m)
#pragma unroll
            for (int n = 0; n < 4; n += 2) {
                const int jcol = (nt * 128 + wc * 64 + n * 16) / 2 + fr;
                const int srow = s0 + wr * 64 + m * 16 + fq * 4;
#pragma unroll
                for (int j = 0; j < 4; ++j) {
                    const float gte = acc[m][n][j], up = acc[m][n + 1][j];
                    act[(size_t)(srow + j) * 512 + jcol] = f2bf(gte / (1.f + __expf(-gte)) * up);
                }
            }
    }
}

DEVINL void ph_down(const P& p, char* smem) {
    const int TIDX_ = tid_(); const int BIDX_ = bid_(); char* const WS_ = wsl_(p.ws); (void)TIDX_; (void)BIDX_; (void)WS_;
    const u16* act = (const u16*)(WS_ + OFF_ACT);
    const u16* wdn = (const u16*)(WS_ + OFF_WDN);
    const int* tiles = (const int*)(WS_ + OFF_TILES);
    u16* so = (u16*)(WS_ + OFF_SLOTOUT);
    const int ntile = tiles[40] * 8;
    for (int u = BIDX_; u < ntile; u += gridDim.x) {
        const int ti = u >> 3, nt = u & 7;
        const int e = tiles[64 + ti * 2], s0 = tiles[64 + ti * 2 + 1];
        const u16* A = act + (size_t)s0 * 512;
        gemm128([&](int r) { return A + (size_t)r * 512; }, wdn + ((size_t)e * 1024 + nt * 128) * 512, 512, 512, smem,
                [&](int m, int n, f32x4 a) {
                    u16* q = so + (size_t)(s0 + m) * 1024 + nt * 128 + n;
                    q[0] = f2bf(a[0]); q[1024] = f2bf(a[1]); q[2048] = f2bf(a[2]); q[3072] = f2bf(a[3]);
                });
    }
}

DEVINL void ph_ln2(const P& p, int l) {
    const int TIDX_ = tid_(); const int BIDX_ = bid_(); char* const WS_ = wsl_(p.ws); (void)TIDX_; (void)BIDX_; (void)WS_;
    const int lane = TIDX_ & 63, wid = TIDX_ >> 6;
    const float* modv = (const float*)(WS_ + OFF_MOD) + (size_t)l * 3 * 6144;
    const float* modn = (const float*)(WS_ + OFF_MOD) + (size_t)(l + 1) * 3 * 6144;
    const float* x1 = (const float*)(WS_ + OFF_X1);
    const u16* so = (const u16*)(WS_ + OFF_SLOTOUT);
    const int* toks = (const int*)(WS_ + OFF_TOKS);
    const float* tokw = (const float*)(WS_ + OFF_TOKW);
    float* x2c = (float*)(WS_ + OFF_X2CTX);
    u16* hm = (u16*)(WS_ + OFF_HM);
    const int rstart = (l == 0) ? 0 : CTXROWS;
    for (int row = rstart + BIDX_ * 4 + wid; row < T; row += gridDim.x * 4) {
        const int sa = toks[row * 2], sb = toks[row * 2 + 1];
        const float wa = tokw[row * 2], wb = tokw[row * 2 + 1];
        const float* mv = modv + row_sel(row) * 6144;
        float4 v[4];
        float s = 0.f;
#pragma unroll
        for (int i = 0; i < 4; ++i) {
            const int c = i * 256 + lane * 4;
            const float4 xv = *(const float4*)(x1 + (size_t)row * 1024 + c);
            const uint2 ua = *(const uint2*)(so + (size_t)sa * 1024 + c), ub = *(const uint2*)(so + (size_t)sb * 1024 + c);
            const float4 g2 = *(const float4*)(mv + 5120 + c);
            const float f0 = wa * bf2f((u16)(ua.x & 0xFFFF)) + wb * bf2f((u16)(ub.x & 0xFFFF));
            const float f1 = wa * bf2f((u16)(ua.x >> 16)) + wb * bf2f((u16)(ub.x >> 16));
            const float f2 = wa * bf2f((u16)(ua.y & 0xFFFF)) + wb * bf2f((u16)(ub.y & 0xFFFF));
            const float f3 = wa * bf2f((u16)(ua.y >> 16)) + wb * bf2f((u16)(ub.y >> 16));
            v[i].x = ALPHA * xv.x + g2.x * f0; v[i].y = ALPHA * xv.y + g2.y * f1; v[i].z = ALPHA * xv.z + g2.z * f2; v[i].w = ALPHA * xv.w + g2.w * f3;
            s += v[i].x + v[i].y + v[i].z + v[i].w;
        }
        const float mu = wsum(s) * (1.f / 1024.f);
        float q = 0.f;
#pragma unroll
        for (int i = 0; i < 4; ++i) { v[i].x -= mu; v[i].y -= mu; v[i].z -= mu; v[i].w -= mu; q += v[i].x * v[i].x + v[i].y * v[i].y + v[i].z * v[i].z + v[i].w * v[i].w; }
        const float rstd = rsqrtf(wsum(q) * (1.f / 1024.f) + 1e-5f);
        float* dst = row < CTXROWS ? x2c + (size_t)row * 1024 : p.out + (size_t)(row - CTXROWS) * 1024;
        const float* mn = modn + row_sel(row) * 6144;
#pragma unroll
        for (int i = 0; i < 4; ++i) {
            const int c = i * 256 + lane * 4;
            const float4 g = *(const float4*)(p.ln2g + l * 1024 + c), bb = *(const float4*)(p.ln2b + l * 1024 + c);
            float4 o;
            o.x = v[i].x * rstd * g.x + bb.x; o.y = v[i].y * rstd * g.y + bb.y; o.z = v[i].z * rstd * g.z + bb.z; o.w = v[i].w * rstd * g.w + bb.w;
            *(float4*)(dst + c) = o;
            if (l == 0) {
                const float4 sh = *(const float4*)(mn + c), sc = *(const float4*)(mn + 1024 + c);
                uint2 hh;
                hh.x = (unsigned)f2bf(o.x * (1.f + sc.x) + sh.x) | ((unsigned)f2bf(o.y * (1.f + sc.y) + sh.y) << 16);
                hh.y = (unsigned)f2bf(o.z * (1.f + sc.z) + sh.z) | ((unsigned)f2bf(o.w * (1.f + sc.w) + sh.w) << 16);
                *(uint2*)(hm + (size_t)row * 1024 + c) = hh;
            }
        }
    }
}

DEVINL void gbar(XcdBarrier b) {
    unsigned x = b.x; GAS unsigned* q = (GAS unsigned*)b.bar;
    asm volatile("" : "+s"(x), "+s"(q));
    b.x = x; b.bar = (unsigned*)q;
    xcd_barrier(b);
}
#ifndef PROBE
#define PROBE 0
#endif
#ifndef TPROBE
#define TPROBE 0
#endif
__global__ void __launch_bounds__(256, 2) k_mega(P p) {
    __shared__ __attribute__((aligned(16))) char smem[65536 + 16 + 16];
    if (threadIdx.x == 0) *(uint4*)(smem + 65536) = make_uint4(0u, 0u, 0u, 0u);
    __syncthreads();
    XcdBarrier bar = xcd_barrier_post((unsigned*)p.ws, (volatile LAS unsigned*)(smem + 65536));
    const int bid = blockIdx.x, nb = gridDim.x;
#if TPROBE
    unsigned long long tp_acc = 0, tp_last = wall_clock64();
#define TP(g) do { const unsigned long long _n = wall_clock64(); if ((g) == TPROBE) tp_acc += _n - tp_last; tp_last = _n; } while (0)
#else
#define TP(g) do { } while (0)
#endif
    ph_prolog(p, smem);
    ph_convw(p, 0, smem);
    gbar(bar);
    TP(1);
    ph_xm0(p);
    gbar(bar);
    TP(1);
#pragma unroll 1
    for (int l = 0; l < NLAYER; ++l) {
        ph_inproj(p, smem);
        gbar(bar);
    TP(2);
        for (int rp = 0; rp < (PROBE == 3 ? 2 : 1); ++rp) ph_rwprep(p, l, 0, smem);
        for (int rp = 0; rp < (PROBE == 4 ? 2 : 1); ++rp) ph_prepM(p, l, smem);
        gbar(bar);
    TP(3);
        if (bid < 8) { for (int rp = 0; rp < (PROBE == 5 ? 2 : 1); ++rp) ph_rwscan(p, l, 0, bid, 8, smem); }
        else { ph_mlB(p, bid - 8, nb - 8, smem); for (int rp = 0; rp < (PROBE == 1 ? 2 : 1); ++rp) ph_na(p, l, smem, bid - 8, nb - 8); }
        gbar(bar);
    TP(4);
        for (int rp = 0; rp < (PROBE == 3 ? 2 : 1); ++rp) ph_rwprep(p, l, 1, smem);
        gbar(bar);
    TP(5);
        if (bid < 8) { for (int rp = 0; rp < (PROBE == 5 ? 2 : 1); ++rp) ph_rwscan(p, l, 1, bid, 8, smem); }
        else { for (int rp = 0; rp < (PROBE == 2 ? 2 : 1); ++rp) ph_mlC(p, l, smem, bid - 8, nb - 8); ph_convexp(p, l, smem, bid - 8, nb - 8); }
        gbar(bar);
    TP(6);
        ph_rwout(p, l);
        gbar(bar);
    TP(7);
        ph_outproj(p, l, smem);
        gbar(bar);
    TP(8);
        ph_ln1(p, l);
        gbar(bar);
    TP(9);
        ph_router(p, l, smem);
        gbar(bar);
    TP(9);
        ph_route1(p, l, smem);
        gbar(bar);
    TP(9);
        ph_route2(p, l, smem);
        gbar(bar);
    TP(9);
        ph_gateup(p, smem);
        gbar(bar);
    TP(10);
        ph_down(p, smem);
        gbar(bar);
    TP(11);
        ph_ln2(p, l);
        if (l + 1 < NLAYER) ph_convw(p, l + 1, smem);
        gbar(bar);
    TP(12);
    }
#if TPROBE
    if (bid == 0 && threadIdx.x == 0) { const unsigned long long t_end = wall_clock64() + tp_acc; while (wall_clock64() < t_end) __builtin_amdgcn_s_sleep(8); }
    __syncthreads();
    gbar(bar);
#endif
}


extern "C" void kernel_launch(void* const* d_in, const int* in_sizes, int n_in, void* d_out, int out_size, void* d_ws, size_t ws_size,
                              hipStream_t stream) {
    if (n_in != 37 || ws_size < WS_NEED) { fprintf(stderr, "kernel_launch: n_in %d ws %zu need %zu\n", n_in, ws_size, (size_t)WS_NEED); return; }
    static int grid = 0;
    if (!grid) {
        int dev = 0, cus = 0, per_cu = 0;
        (void)hipGetDevice(&dev);
        (void)hipDeviceGetAttribute(&cus, hipDeviceAttributeMultiprocessorCount, dev);
        (void)hipOccupancyMaxActiveBlocksPerMultiprocessor(&per_cu, (const void*)k_mega, 256, 0);
        if (per_cu < 1) per_cu = 1;
        grid = cus * (per_cu < 2 ? per_cu : 2);
    }
    P p{};
    const float** pp = (const float**)&p;
    for (int i = 0; i < 37; ++i) pp[i] = (const float*)d_in[i];
    p.out = (float*)d_out; p.ws = (char*)d_ws;
    (void)hipMemsetAsync(d_ws, 0, CTL_BYTES, stream);
    k_mega<<<dim3(grid), dim3(256), 0, stream>>>(p);
}
```

```cpp
#include <hip/hip_runtime.h>
#include <hip/hip_bf16.h>
#include <stdint.h>
#include <stdio.h>
#include <type_traits>

#define DEVINL __device__ __forceinline__
typedef unsigned short u16;
using bf16x8 = __attribute__((ext_vector_type(8))) short;
using f32x4 = __attribute__((ext_vector_type(4))) float;

constexpr int D = 1024, LAT = 16384, LCTX = 256, T = 33280, CTXROWS = 512;
constexpr int INP = 3536;
constexpr int NLAYER = 2;
constexpr float ALPHA = 1.41421356237309515f;
constexpr int NUNIT_CH = 520;
constexpr int NTC = 260;
constexpr int MAXSLOT = 70656;

constexpr size_t al(size_t x) { return (x + 255) & ~(size_t)255; }
constexpr size_t CTL_CNT = 16384;
constexpr size_t CTL_CUR = CTL_CNT + 256;
constexpr size_t CTL_CUKEY = 20480;
constexpr size_t CTL_BYTES = 32768;
constexpr size_t OFF_MOD = CTL_BYTES;
constexpr size_t OFF_ROPE = OFF_MOD + al(2 * 3 * 6144 * 4);
constexpr size_t OFF_WR = OFF_ROPE + al(10240 * 4);
constexpr size_t OFF_LORA = OFF_WR + al(2 * 128 * 1024 * 2);
constexpr size_t OFF_TILES = OFF_LORA + al(3 * 65536);
constexpr size_t OFF_TOKE = OFF_TILES + al((64 + 2048) * 4);
constexpr size_t OFF_TOKW = OFF_TOKE + al((size_t)T * 2 * 4);
constexpr size_t OFF_TOKS = OFF_TOKW + al((size_t)T * 2 * 4);
constexpr size_t OFF_SLOTTOK = OFF_TOKS + al((size_t)T * 2 * 4);
constexpr size_t OFF_X2CTX = OFF_SLOTTOK + al((size_t)MAXSLOT * 4);
constexpr size_t OFF_WIN = OFF_X2CTX + al((size_t)512 * 1024 * 4);
constexpr size_t OFF_WOUT = OFF_WIN + al((size_t)3584 * 1024 * 2);
constexpr size_t OFF_X1 = OFF_WOUT + al((size_t)1024 * 1024 * 2);
constexpr size_t OFF_HM = OFF_X1 + al((size_t)T * 1024 * 4);
constexpr size_t OFF_P = OFF_HM + al((size_t)T * 1024 * 2);
constexpr size_t OFF_PQK = OFF_P;
constexpr size_t OFF_VTL = OFF_PQK + (size_t)T * 1024 * 2;
constexpr size_t OFF_VTC = OFF_VTL + (size_t)2 * 8 * 64 * 16384 * 2;
constexpr size_t OFF_PB = OFF_VTC + (size_t)2 * 8 * 64 * 256 * 2;
constexpr size_t OFF_PC = OFF_PB + (size_t)T * 960 * 2;
constexpr size_t OFF_Y = OFF_PC + (size_t)T * 1040 * 2;
constexpr size_t OFF_MLF = OFF_Y + (size_t)T * 1024 * 2;
constexpr size_t OFF_GATE = OFF_MLF + (size_t)T * 512 * 2;
constexpr size_t OFF_MLG = OFF_GATE + (size_t)T * 256 * 2;
constexpr size_t OFF_MLS = OFF_MLG + (size_t)T * 16 * 4;
constexpr size_t OFF_MST = OFF_MLS + al(16 * 260 * 2 * 4);
constexpr size_t OFF_NST = OFF_MST + al(16 * 260 * 4);
constexpr size_t OFF_CST2 = OFF_NST + al(16 * 260 * 64 * 4);
constexpr size_t OFF_NST2 = OFF_CST2 + (size_t)16 * 260 * 4096 * 2;
constexpr size_t OFF_END1 = OFF_NST2 + al(16 * 260 * 64 * 4);
constexpr size_t OFF_WGU = OFF_P;
constexpr size_t OFF_WDN = OFF_WGU + (size_t)32 * 1024 * 1024 * 2;
constexpr size_t OFF_ACT = OFF_WDN + (size_t)32 * 1024 * 512 * 2;
constexpr size_t OFF_SLOTOUT = OFF_ACT + (size_t)MAXSLOT * 512 * 2;
constexpr size_t OFF_LOGITS = OFF_SLOTOUT + (size_t)MAXSLOT * 1024 * 2;
constexpr size_t OFF_END2 = OFF_LOGITS + (size_t)T * 64 * 4;
constexpr size_t WS_NEED = OFF_END1 > OFF_END2 ? OFF_END1 : OFF_END2;
static_assert(OFF_WDN <= OFF_Y, "Wexp must not overlap y");
static_assert(OFF_LOGITS >= OFF_MLF, "logits placement");

struct P {
    const float *x, *c, *ctx, *c_ctx, *w_mod, *b_mod, *w_in, *na_rpb, *mu_prev, *mu_next, *rw_w0, *rw_w2, *rw_a0, *rw_a2,
        *rw_g2, *rw_kk, *rw_ka, *rw_rk, *rw_lnw, *rw_lnb, *ml_cw, *ml_cb, *ml_ib, *ml_fb, *ml_nw, *w_out, *ln1g, *ln1b,
        *rgw, *rgb, *rew, *reb, *egate, *eup, *edown, *ln2g, *ln2b;
    float* out;
    char* ws;
};

#define XB_TMO      128
#define XB_XCNT(j)  (256  + 64 * (j))
#define XB_XSUB(j)  (1280 + 64 * (j))
#define XB_XGEN(j)  (2304 + 64 * (j))
#define XB_TOP      3328
#define XB_TOPGEN   3392
#define XCD_BAR_WORDS 3456
#define XB_SPIN_CAP (1u << 18)
#define LAS __attribute__((address_space(3)))

__device__ __forceinline__ unsigned xb_ld(unsigned* p)              { return __hip_atomic_load(p, __ATOMIC_RELAXED, __HIP_MEMORY_SCOPE_AGENT); }
__device__ __forceinline__ unsigned xb_add(unsigned* p, unsigned v) { return __hip_atomic_fetch_add(p, v, __ATOMIC_RELAXED, __HIP_MEMORY_SCOPE_AGENT); }
__device__ __forceinline__ unsigned xb_xcc_id() { return (unsigned)__builtin_amdgcn_s_getreg((3 << 11) | 20) & 0xFu; }
#define XB_SPIN(cond, bar) do { unsigned _sp = 0; while (cond) { __builtin_amdgcn_s_sleep(1); \
    if ((++_sp & 255u) == 0u) { if (xb_ld(&(bar)[XB_TMO])) break; if (_sp > XB_SPIN_CAP) { atomicAdd(&(bar)[XB_TMO], 1u); break; } } } } while (0)

struct XcdBarrier {
    unsigned* bar; unsigned x;
    volatile LAS unsigned* st;
};

__device__ __forceinline__ XcdBarrier xcd_barrier_post(unsigned* bar, volatile LAS unsigned* st) {
    XcdBarrier b; b.bar = bar; b.x = xb_xcc_id(); b.st = st;
    if (threadIdx.x == 0) (void)xb_add(&bar[XB_XCNT(b.x)], 1u);
    return b;
}
__device__ __forceinline__ void xcd_barrier_complete(unsigned* bar, unsigned x, unsigned& nloc, unsigned& nx) {
    const unsigned G = gridDim.x * gridDim.y * gridDim.z;
    unsigned sum, cnt, mine, sp = 0u;
    for (;;) {
        sum = 0u; cnt = 0u; mine = 0u;
#pragma unroll
        for (unsigned j = 0; j < 16; ++j) { const unsigned c = xb_ld(&bar[XB_XCNT(j)]); sum += c; cnt += (c > 0u) ? 1u : 0u; mine = (j == x) ? c : mine; }
        if (sum == G) break;
        __builtin_amdgcn_s_sleep(1);
        if ((++sp & 255u) == 0u) { if (xb_ld(&bar[XB_TMO])) break; if (sp > XB_SPIN_CAP) { atomicAdd(&bar[XB_TMO], 1u); break; } }
    }
    nloc = mine > 0u ? mine : 1u; nx = cnt > 0u ? cnt : 1u;
}

__device__ __forceinline__ void xcd_barrier(const XcdBarrier& b) {
    asm volatile("s_waitcnt vmcnt(0)" ::: "memory");
    __syncthreads();
    if (threadIdx.x == 0) {
        unsigned* bar = b.bar;
        __builtin_amdgcn_s_waitcnt(0);
        unsigned nloc = b.st[0], nx = b.st[1];
        if (nloc == 0u) { xcd_barrier_complete(bar, b.x, nloc, nx); b.st[0] = nloc; b.st[1] = nx; }
        const unsigned old = xb_add(&bar[XB_XSUB(b.x)], 1u);
        const unsigned gen = old / nloc;
        if (old + 1u == (gen + 1u) * nloc) {
            __builtin_amdgcn_fence(__ATOMIC_RELEASE, "agent");
            asm volatile("s_waitcnt vmcnt(0)" ::: "memory");
            const unsigned og = xb_add(&bar[XB_TOP], 1u);
            const unsigned tg = og / nx;
            if (og + 1u == (tg + 1u) * nx) xb_add(&bar[XB_TOPGEN], 1u);
            else XB_SPIN(xb_ld(&bar[XB_TOPGEN]) == tg, bar);
            __builtin_amdgcn_fence(__ATOMIC_ACQUIRE, "agent");
            xb_add(&bar[XB_XGEN(b.x)], 1u);
            asm volatile("s_waitcnt vmcnt(0)" ::: "memory");
        } else {
            XB_SPIN(xb_ld(&bar[XB_XGEN(b.x)]) == gen, bar);
            __builtin_amdgcn_fence(__ATOMIC_ACQUIRE, "agent");
            asm volatile("s_waitcnt vmcnt(0)" ::: "memory");
        }
    }
    __syncthreads();
}


DEVINL int tid_() { int t = threadIdx.x; asm volatile("" : "+v"(t)); return t; }
DEVINL int bid_() { int b = blockIdx.x; asm volatile("" : "+s"(b)); return b; }
#define GAS __attribute__((address_space(1)))
DEVINL char* wsl_(char* w) { GAS char* g = (GAS char*)w; asm volatile("" : "+s"(g)); return (char*)g; }
template <class Tp> DEVINL const Tp* gl_(const Tp* q) { const GAS Tp* g = (const GAS Tp*)q; asm volatile("" : "+s"(g)); return (const Tp*)g; }
typedef float f32x2_t __attribute__((ext_vector_type(2)));
typedef __bf16 bf16x2_t __attribute__((ext_vector_type(2)));
DEVINL unsigned pk2bf(float lo, float hi) { f32x2_t f = {lo, hi}; bf16x2_t b = __builtin_convertvector(f, bf16x2_t); return __builtin_bit_cast(unsigned, b); }
DEVINL u16 f2bf(float f) { return (u16)(pk2bf(f, f) & 0xFFFFu); }
DEVINL float bf2f(u16 h) { return __uint_as_float(((unsigned)h) << 16); }
DEVINL float wsum(float v) { for (int o = 32; o > 0; o >>= 1) v += __shfl_xor(v, o); return v; }
DEVINL float sigmoidf_(float x) { return 1.f / (1.f + __expf(-x)); }
DEVINL float siluf_(float x) { return x / (1.f + __expf(-x)); }
DEVINL float softplusf_(float x) { return fmaxf(x, 0.f) + log1pf(__expf(-fabsf(x))); }
DEVINL int row_sel(int row) { return row < CTXROWS ? 2 : ((row - CTXROWS) >> 14); }
template <int CTRL, int RM>
DEVINL float dpp_f(float v) { return __int_as_float(__builtin_amdgcn_update_dpp(0, __float_as_int(v), CTRL, RM, 0xF, false)); }
DEVINL float wave_sum_dpp(float v) {
    v += dpp_f<0xB1, 0xF>(v);
    v += dpp_f<0x4E, 0xF>(v);
    v += dpp_f<0x141, 0xF>(v);
    v += dpp_f<0x140, 0xF>(v);
    v += dpp_f<0x142, 0xA>(v);
    v += dpp_f<0x143, 0xC>(v);
    return __int_as_float(__builtin_amdgcn_readlane(__float_as_int(v), 63));
}
DEVINL unsigned lds_addr(const void* p) { return (unsigned)(size_t)(const __attribute__((address_space(3))) char*)p; }
using u32x4 = __attribute__((ext_vector_type(4))) unsigned;
using u32x2 = __attribute__((ext_vector_type(2))) unsigned;
template <int OFF> DEVINL u32x4 lds_rd128(unsigned a) { u32x4 v; asm volatile("ds_read_b128 %0, %1 offset:%2" : "=v"(v) : "v"(a), "n"(OFF)); return v; }
template <int OFF> DEVINL u32x2 lds_rd64(unsigned a) { u32x2 v; asm volatile("ds_read_b64 %0, %1 offset:%2" : "=v"(v) : "v"(a), "n"(OFF)); return v; }
DEVINL void glds4(const void* g, void* l) {
    __builtin_amdgcn_global_load_lds((const __attribute__((address_space(1))) void*)g, (__attribute__((address_space(3))) void*)l, 4, 0, 0);
}
DEVINL void glds16(const void* g, void* l) {
    __builtin_amdgcn_global_load_lds((const __attribute__((address_space(1))) void*)g, (__attribute__((address_space(3))) void*)l, 16, 0, 0);
}

template <class RowA>
DEVINL void gemm128_acc(RowA rowA, const u16* __restrict__ Bt, int ldb, int K, char* smem, f32x4 (&acc)[4][4]) {
    const int tid = tid_(), lane = tid & 63, wid = tid >> 6, wr = wid >> 1, wc = wid & 1, fr = lane & 15, fq = lane >> 4;
#pragma unroll
    for (int m = 0; m < 4; ++m)
#pragma unroll
        for (int n = 0; n < 4; ++n) acc[m][n] = f32x4{0.f, 0.f, 0.f, 0.f};
    const u16* aS0 = rowA(tid >> 2) + (tid & 3) * 8;
    const u16* aS1 = rowA((tid >> 2) + 64) + (tid & 3) * 8;
    const u16* bS0 = Bt + (size_t)(tid >> 2) * ldb + (tid & 3) * 8;
    const u16* bS1 = Bt + (size_t)((tid >> 2) + 64) * ldb + (tid & 3) * 8;
    const int nt = K >> 5;
    __syncthreads();
    {
        char* SA = smem; char* SB = smem + 8192;
        glds16(aS0, SA + tid * 16); glds16(aS1, SA + tid * 16 + 4096);
        glds16(bS0, SB + tid * 16); glds16(bS1, SB + tid * 16 + 4096);
    }
    for (int t = 0; t < nt; ++t) {
        asm volatile("s_waitcnt vmcnt(0)" ::: "memory");
        __builtin_amdgcn_s_barrier();
        if (t + 1 < nt) {
            char* SA = smem + ((t + 1) & 1) * 16384; char* SB = SA + 8192;
            const int ko = (t + 1) * 32;
            glds16(aS0 + ko, SA + tid * 16); glds16(aS1 + ko, SA + tid * 16 + 4096);
            glds16(bS0 + ko, SB + tid * 16); glds16(bS1 + ko, SB + tid * 16 + 4096);
        }
        const char* SA = smem + (t & 1) * 16384; const char* SB = SA + 8192;
        bf16x8 af[4], bfr[4];
#pragma unroll
        for (int m = 0; m < 4; ++m) af[m] = *(const bf16x8*)(SA + (wr * 64 + m * 16 + fr) * 64 + fq * 16);
#pragma unroll
        for (int n = 0; n < 4; ++n) bfr[n] = *(const bf16x8*)(SB + (wc * 64 + n * 16 + fr) * 64 + fq * 16);
#pragma unroll
        for (int m = 0; m < 4; ++m)
#pragma unroll
            for (int n = 0; n < 4; ++n) acc[m][n] = __builtin_amdgcn_mfma_f32_16x16x32_bf16(af[m], bfr[n], acc[m][n], 0, 0, 0);
    }
}
template <class RowA, class Epi>
DEVINL void gemm128(RowA rowA, const u16* __restrict__ Bt, int ldb, int K, char* smem, Epi epi) {
    const int tid = tid_(), lane = tid & 63, wid = tid >> 6, wr = wid >> 1, wc = wid & 1, fr = lane & 15, fq = lane >> 4;
    f32x4 acc[4][4];
    gemm128_acc(rowA, Bt, ldb, K, smem, acc);
#pragma unroll
    for (int m = 0; m < 4; ++m)
#pragma unroll
        for (int n = 0; n < 4; ++n) epi(wr * 64 + m * 16 + fq * 4, wc * 64 + n * 16 + fr, acc[m][n]);
}

DEVINL void ph_prolog(const P& p, char* smem) {
    const int TIDX_ = tid_(); const int BIDX_ = bid_(); char* const WS_ = wsl_(p.ws); (void)TIDX_; (void)BIDX_; (void)WS_;
    const int tid = TIDX_;
    float* modv = (float*)(WS_ + OFF_MOD);
    float* sil = (float*)smem;
    float* red = sil + 3072;
    bool ready = false;
    for (int u = BIDX_; u < 192; u += gridDim.x) {
        if (!ready) {
            for (int i = tid; i < 3072; i += 256) { int v = i >> 10, k = i & 1023; float cv = v < 2 ? p.c[v * 1024 + k] : p.c_ctx[k]; sil[i] = cv / (1.f + expf(-cv)); }
            ready = true;
        }
        __syncthreads();
        const int l = u / 96, cg = u % 96;
        const float* W = p.w_mod + (size_t)l * 1024 * 6144 + cg * 64;
        const int c4 = (tid & 15) * 4, rg = tid >> 4;
        float a0[4] = {0, 0, 0, 0}, a1[4] = {0, 0, 0, 0}, a2[4] = {0, 0, 0, 0};
#pragma unroll 4
        for (int i = 0; i < 64; ++i) {
            const int k = rg + 16 * i;
            const float4 w = *(const float4*)(W + (size_t)k * 6144 + c4);
            const float s0 = sil[k], s1 = sil[1024 + k], s2 = sil[2048 + k];
            a0[0] += s0 * w.x; a0[1] += s0 * w.y; a0[2] += s0 * w.z; a0[3] += s0 * w.w;
            a1[0] += s1 * w.x; a1[1] += s1 * w.y; a1[2] += s1 * w.z; a1[3] += s1 * w.w;
            a2[0] += s2 * w.x; a2[1] += s2 * w.y; a2[2] += s2 * w.z; a2[3] += s2 * w.w;
        }
#pragma unroll
        for (int j = 0; j < 4; ++j) { red[(rg * 3 + 0) * 64 + c4 + j] = a0[j]; red[(rg * 3 + 1) * 64 + c4 + j] = a1[j]; red[(rg * 3 + 2) * 64 + c4 + j] = a2[j]; }
        __syncthreads();
        if (tid < 192) {
            const int v = tid >> 6, cc = tid & 63;
            float s = 0.f;
            for (int r = 0; r < 16; ++r) s += red[(r * 3 + v) * 64 + cc];
            const int col = cg * 64 + cc;
            modv[(l * 3 + v) * 6144 + col] = s + p.b_mod[l * 6144 + col];
        }
        __syncthreads();
    }
    float* rope = (float*)(WS_ + OFF_ROPE);
    for (int i = BIDX_ * 256 + tid; i < 320 * 16; i += gridDim.x * 256) {
        const int pos = (i < 4096) ? (i >> 4) : ((i - 4096) >> 4);
        const int f = i & 15;
        const float inv = powf(10000.0f, -(float)f / 16.0f);
        const float ang = (float)pos * inv;
        const double TWO_PI = 6.283185307179586476925;
        double a = (double)ang;
        a -= TWO_PI * rint(a / TWO_PI);
        const float cr = (float)cos(a), sr = (float)sin(a);
        if (i < 4096) { rope[i] = cr; rope[4096 + i] = sr; }
        else { rope[8192 + (i - 4096)] = cr; rope[8192 + 1024 + (i - 4096)] = sr; }
    }
    {
        u16* w2t = (u16*)(WS_ + OFF_LORA); u16* a2t = w2t + 2 * 2 * 256 * 32; u16* g2t = a2t + 2 * 2 * 256 * 32;
        for (int i = BIDX_ * 256 + tid; i < 2 * 2 * 256 * 32; i += gridDim.x * 256) {
            const int lz = i >> 13, c = (i >> 5) & 255, r = i & 31;
            w2t[i] = f2bf(p.rw_w2[((size_t)lz * 32 + r) * 256 + c]);
            a2t[i] = f2bf(p.rw_a2[((size_t)lz * 32 + r) * 256 + c]);
        }
        for (int i = BIDX_ * 256 + tid; i < 2 * 256 * 64; i += gridDim.x * 256) {
            const int l = i >> 14, c = (i >> 6) & 255, r = i & 63;
            g2t[i] = f2bf(p.rw_g2[((size_t)l * 64 + r) * 256 + c]);
        }
    }
    u16* wr = (u16*)(WS_ + OFF_WR);
    for (int i = BIDX_ * 256 + tid; i < 2 * 128 * 1024; i += gridDim.x * 256) {
        const int l = i >> 17, n = (i >> 10) & 127, k = i & 1023;
        float v = 0.f;
        if (n < 4) v = p.rgw[((size_t)l * 1024 + k) * 4 + n];
        else if (n < 36) v = p.rew[((size_t)l * 1024 + k) * 32 + (n - 4)];
        wr[i] = f2bf(v);
    }
}

DEVINL void conv_tile(const float* __restrict__ src, int N, int K, u16* __restrict__ dst, int k0, int n0, int mode, char* smem) {
    unsigned* t = (unsigned*)smem;
    const int tid = tid_();
    const int n4 = (tid & 15) * 4;
    const bool ok = n0 + n4 < N;
    float4 va[2], vb[2];
    __syncthreads();
#pragma unroll
    for (int i = 0; i < 2; ++i) {
        const int kp = i * 16 + (tid >> 4);
        const float* s0 = src + (size_t)(k0 + 2 * kp) * N + n0 + n4;
        va[i] = ok ? *(const float4*)s0 : make_float4(0.f, 0.f, 0.f, 0.f);
        vb[i] = ok ? *(const float4*)(s0 + N) : make_float4(0.f, 0.f, 0.f, 0.f);
    }
#pragma unroll
    for (int i = 0; i < 2; ++i) {
        const int kp = i * 16 + (tid >> 4);
        t[(n4 + 0) * 33 + kp] = pk2bf(va[i].x, vb[i].x);
        t[(n4 + 1) * 33 + kp] = pk2bf(va[i].y, vb[i].y);
        t[(n4 + 2) * 33 + kp] = pk2bf(va[i].z, vb[i].z);
        t[(n4 + 3) * 33 + kp] = pk2bf(va[i].w, vb[i].w);
    }
    __syncthreads();
    {
        const int n = tid >> 2, w0 = (tid & 3) * 8;
        const int ng = n0 + n;
        int nd = ng;
        if (mode == 1) nd = 32 * (ng >> 4) + (ng & 15);
        else if (mode == 2) nd = 32 * (ng >> 4) + 16 + (ng & 15);
        uint4 o0, o1;
        o0.x = t[n * 33 + w0 + 0]; o0.y = t[n * 33 + w0 + 1]; o0.z = t[n * 33 + w0 + 2]; o0.w = t[n * 33 + w0 + 3];
        o1.x = t[n * 33 + w0 + 4]; o1.y = t[n * 33 + w0 + 5]; o1.z = t[n * 33 + w0 + 6]; o1.w = t[n * 33 + w0 + 7];
        u16* q = dst + (size_t)nd * K + k0 + w0 * 2;
        *(uint4*)q = o0; *(uint4*)(q + 8) = o1;
    }
}
DEVINL void ph_convw(const P& p, int l, char* smem) {
    const int TIDX_ = tid_(); const int BIDX_ = bid_(); char* const WS_ = wsl_(p.ws); (void)TIDX_; (void)BIDX_; (void)WS_;
    u16* win = (u16*)(WS_ + OFF_WIN); u16* wout = (u16*)(WS_ + OFF_WOUT);
    for (int u = BIDX_; u < 896 + 256; u += gridDim.x) {
        if (u < 896) conv_tile(p.w_in + (size_t)l * 1024 * INP, INP, 1024, win, (u / 56) * 64, (u % 56) * 64, 0, smem);
        else { const int v = u - 896; conv_tile(p.w_out + (size_t)l * 1024 * 1024, 1024, 1024, wout, (v / 16) * 64, (v % 16) * 64, 0, smem); }
    }
}
DEVINL void ph_convexp(const P& p, int l, char* smem, int bid, int nb) {
    const int TIDX_ = tid_(); const int BIDX_ = bid_(); char* const WS_ = wsl_(p.ws); (void)TIDX_; (void)BIDX_; (void)WS_;
    u16* wgu = (u16*)(WS_ + OFF_WGU); u16* wdn = (u16*)(WS_ + OFF_WDN);
    for (int u = bid; u < 32 * 384; u += nb) {
        const int e = u / 384, v = u % 384;
        const size_t le = (size_t)l * 32 + e;
        if (v < 128) conv_tile(p.egate + le * 1024 * 512, 512, 1024, wgu + (size_t)e * 1024 * 1024, (v / 8) * 64, (v % 8) * 64, 1, smem);
        else if (v < 256) { const int w = v - 128; conv_tile(p.eup + le * 1024 * 512, 512, 1024, wgu + (size_t)e * 1024 * 1024, (w / 8) * 64, (w % 8) * 64, 2, smem); }
        else { const int w = v - 256; conv_tile(p.edown + le * 512 * 1024, 1024, 512, wdn + (size_t)e * 1024 * 512, (w / 16) * 64, (w % 16) * 64, 0, smem); }
    }
}

DEVINL void ph_xm0(const P& p) {
    const int TIDX_ = tid_(); const int BIDX_ = bid_(); char* const WS_ = wsl_(p.ws); (void)TIDX_; (void)BIDX_; (void)WS_;
    const float* modv = (const float*)(WS_ + OFF_MOD);
    u16* hm = (u16*)(WS_ + OFF_HM);
    for (size_t i = (size_t)BIDX_ * 256 + TIDX_; i < (size_t)T * 256; i += (size_t)gridDim.x * 256) {
        const int row = (int)(i >> 8), c4 = (int)(i & 255) * 4;
        const float* src = row < CTXROWS ? p.ctx + (size_t)row * 1024 : p.x + (size_t)(row - CTXROWS) * 1024;
        const float* mv = modv + row_sel(row) * 6144;
        const float4 v = *(const float4*)(src + c4);
        const float4 sh = *(const float4*)(mv + c4), sc = *(const float4*)(mv + 1024 + c4);
        uint2 o;
        o.x = (unsigned)f2bf(v.x * (1.f + sc.x) + sh.x) | ((unsigned)f2bf(v.y * (1.f + sc.y) + sh.y) << 16);
        o.y = (unsigned)f2bf(v.z * (1.f + sc.z) + sh.z) | ((unsigned)f2bf(v.w * (1.f + sc.w) + sh.w) << 16);
        *(uint2*)(hm + (size_t)row * 1024 + c4) = o;
    }
}

DEVINL void ph_inproj(const P& p, char* smem) {
    const int TIDX_ = tid_(); const int BIDX_ = bid_(); char* const WS_ = wsl_(p.ws); (void)TIDX_; (void)BIDX_; (void)WS_;
    const u16* hm = (const u16*)(WS_ + OFF_HM);
    const u16* win = (const u16*)(WS_ + OFF_WIN);
    u16* pqk = (u16*)(WS_ + OFF_PQK); u16* vtl = (u16*)(WS_ + OFF_VTL); u16* vtc = (u16*)(WS_ + OFF_VTC);
    u16* pb = (u16*)(WS_ + OFF_PB); u16* pc = (u16*)(WS_ + OFF_PC);
    for (int u = BIDX_; u < 260 * 28; u += gridDim.x) {
        const int mt = u / 28, nt = u % 28;
        const u16* A = hm + (size_t)mt * 128 * 1024;
        gemm128([&](int r) { return A + (size_t)r * 1024; }, win + (size_t)nt * 128 * 1024, 1024, 1024, smem,
                [&](int m, int n, f32x4 a) {
                    const int R = mt * 128 + m, N = nt * 128 + n;
                    if (N >= INP) return;
                    const u16 h0 = f2bf(a[0]), h1 = f2bf(a[1]), h2 = f2bf(a[2]), h3 = f2bf(a[3]);
                    if (N < 1024) {
                        u16* q = pqk + (size_t)R * 1024 + N; q[0] = h0; q[1024] = h1; q[2048] = h2; q[3072] = h3;
                    } else if (N < 1536) {
                        const int hh = (N - 1024) >> 6, d = (N - 1024) & 63;
                        uint2 v; v.x = (unsigned)h0 | ((unsigned)h1 << 16); v.y = (unsigned)h2 | ((unsigned)h3 << 16);
                        if (R < CTXROWS) { const int b = R >> 8, t = R & 255; *(uint2*)(vtc + ((size_t)((b * 8 + hh) * 64 + d)) * 256 + t) = v; }
                        else { const int R2 = R - CTXROWS, b = R2 >> 14, t = R2 & 16383; *(uint2*)(vtl + ((size_t)((b * 8 + hh) * 64 + d)) * 16384 + t) = v; }
                    } else if (N < 2496) {
                        u16* q = pb + (size_t)R * 960 + (N - 1536); q[0] = h0; q[960] = h1; q[1920] = h2; q[2880] = h3;
                    } else {
                        u16* q = pc + (size_t)R * 1040 + (N - 2496); q[0] = h0; q[1040] = h1; q[2080] = h2; q[3120] = h3;
                    }
                });
    }
}

constexpr size_t RWREC = 12288;
constexpr size_t RW_A1 = 0, RW_A4 = 2048, RW_A3 = 4096, RW_MKA = 8192, RW_TT = 8704, RW_MY = 9216, RW_V = 10240;
constexpr size_t OFF_RWOP = OFF_X1;
constexpr size_t OFF_RWWG = OFF_RWOP + (size_t)8 * 1040 * RWREC;
constexpr size_t OFF_YRWB = OFF_RWWG + (size_t)8 * 260 * 64 * 4;
constexpr size_t OFF_BONUS = OFF_YRWB + (size_t)T * 256 * 2;
static_assert(OFF_BONUS + (size_t)T * 4 * 4 <= OFF_HM, "rw operand store must fit the X1 region");

DEVINL float rw_mix(const u16* __restrict__ pb, const float* __restrict__ mup, const float* __restrict__ mun, int row, int t, int seqlen, int col) {
    const float cu = bf2f(pb[(size_t)row * 960 + col]);
    const float pr = t > 0 ? bf2f(pb[(size_t)(row - 1) * 960 + col]) : 0.f;
    const float nx = t + 1 < seqlen ? bf2f(pb[(size_t)(row + 1) * 960 + col]) : 0.f;
    return cu + mup[col] * (pr - cu) + mun[col] * (nx - cu);
}

DEVINL void ph_rwprep(const P& p, int l, int d, char* smem, int bid, int nb) {
    const int TIDX_ = tid_(); const int BIDX_ = bid_(); char* const WS_ = wsl_(p.ws);
    const int tid = TIDX_, lane = tid & 63, w = tid >> 6, fr = lane & 15, fq = lane >> 4;
    const u16* pb = (const u16*)(WS_ + OFF_PB);
    char* rwop = WS_ + OFF_RWOP;
    float* rwwg = (float*)(WS_ + OFF_RWWG);
    float* bonus = (float*)(WS_ + OFF_BONUS);
    u16* gate = (u16*)(WS_ + OFF_GATE);
    const float* mup = p.mu_prev + l * 960; const float* mun = p.mu_next + l * 960;
    u16* lwdh = (u16*)smem;
    u16* ladh = lwdh + 2048;
    u16* abuf = ladh + 2048;
    float* Lb = (float*)(smem + 16384);
    u16* SV = (u16*)(smem + 32768);
    float* tot = (float*)(smem + 32768);
    const u16* w2t = (const u16*)(WS_ + OFF_LORA);
    const u16* a2t = w2t + 2 * 2 * 256 * 32;
    const u16* g2t = a2t + 2 * 2 * 256 * 32;
    const int z = d;
    for (int uh = bid; uh < NUNIT_CH * 4; uh += nb) {
        const int u = uh >> 2, h = uh & 3;
        int b, gi, row0, seqlen, gscan;
        if (u < 8) { b = u >> 2; gi = u & 3; row0 = b * 256 + gi * 64; seqlen = 256; gscan = d ? 3 - gi : gi; }
        else { b = (u - 8) >> 8; gi = (u - 8) & 255; row0 = CTXROWS + b * LAT + gi * 64; seqlen = LAT; gscan = 4 + (d ? 255 - gi : gi); }
        const int t0 = gi * 64;
        __syncthreads();
#pragma unroll 1
        for (int i = 0; i < 8; ++i) {
            const int idx = tid + 256 * i, j = idx >> 5, cc = idx & 31;
            lwdh[idx] = f2bf(tanhf(rw_mix(pb, mup, mun, row0 + j, t0 + j, seqlen, 768 + z * 32 + cc)));
            ladh[idx] = f2bf(rw_mix(pb, mup, mun, row0 + j, t0 + j, seqlen, 832 + z * 32 + cc));
        }
        if (d == 0) {
            u16* lgd = (u16*)Lb;
#pragma unroll 1
            for (int i = 0; i < 16; ++i) {
                const int idx = tid + 256 * i, j = idx >> 6, cc = idx & 63;
                lgd[idx] = f2bf(sigmoidf_(rw_mix(pb, mup, mun, row0 + j, t0 + j, seqlen, 896 + cc)));
            }
            __syncthreads();
            const bf16x8 x0 = *(const bf16x8*)(lgd + (16 * w + fr) * 64 + 8 * fq), x1 = *(const bf16x8*)(lgd + (16 * w + fr) * 64 + 32 + 8 * fq);
#pragma unroll
            for (int nt = 0; nt < 4; ++nt) {
                const u16* bp = g2t + ((size_t)l * 256 + 64 * h + 16 * nt + fr) * 64 + 8 * fq;
                const bf16x8 b0 = *(const bf16x8*)bp, b1 = *(const bf16x8*)(bp + 32);
                f32x4 acc = f32x4{0.f, 0.f, 0.f, 0.f};
                acc = __builtin_amdgcn_mfma_f32_16x16x32_bf16(x0, b0, acc, 0, 0, 0);
                acc = __builtin_amdgcn_mfma_f32_16x16x32_bf16(x1, b1, acc, 0, 0, 0);
#pragma unroll
                for (int r = 0; r < 4; ++r) gate[(size_t)(row0 + 16 * w + 4 * fq + r) * 256 + 64 * h + 16 * nt + fr] = f2bf(acc[r]);
            }
        }
        {
            const int bh = b * 4 + h;
            const int ch = h * 64 + lane;
            __syncthreads();
            {
                const bf16x8 xw = *(const bf16x8*)(lwdh + (16 * w + fr) * 32 + 8 * fq);
                const bf16x8 xa = *(const bf16x8*)(ladh + (16 * w + fr) * 32 + 8 * fq);
#pragma unroll 1
                for (int kt = 0; kt < 4; ++kt) {
                    const int key = 16 * kt + fr;
                    const size_t wrow = ((size_t)(l * 2 + z) * 256 + h * 64 + key) * 32 + 8 * fq;
                    const bf16x8 bw = *(const bf16x8*)(w2t + wrow), ba = *(const bf16x8*)(a2t + wrow);
                    f32x4 ae = f32x4{0.f, 0.f, 0.f, 0.f}, aa = f32x4{0.f, 0.f, 0.f, 0.f};
                    ae = __builtin_amdgcn_mfma_f32_16x16x32_bf16(xw, bw, ae, 0, 0, 0);
                    aa = __builtin_amdgcn_mfma_f32_16x16x32_bf16(xa, ba, aa, 0, 0, 0);
                    const float w0 = p.rw_w0[(l * 2 + z) * 256 + h * 64 + key], a0 = p.rw_a0[(l * 2 + z) * 256 + h * 64 + key];
#pragma unroll
                    for (int r = 0; r < 4; ++r) {
                        const int tok = 16 * w + 4 * fq + r;
                        const int s = d ? 63 - tok : tok;
                        Lb[s * 64 + key] = 0.60653065971263342f * sigmoidf_(ae[r] + w0);
                        abuf[tok * 64 + key] = f2bf(sigmoidf_(aa[r] + a0));
                    }
                }
            }
            __syncthreads();
            {
                float pre[16]; float run = 0.f;
#pragma unroll
                for (int i = 0; i < 16; ++i) { run += Lb[(16 * w + i) * 64 + lane]; pre[i] = run; }
                tot[w * 64 + lane] = run;
                __syncthreads();
                float offs = 0.f;
#pragma unroll
                for (int ww = 0; ww < 3; ++ww) offs += (ww < w) ? tot[ww * 64 + lane] : 0.f;
#pragma unroll
                for (int i = 0; i < 16; ++i) Lb[(16 * w + i) * 64 + lane] = -(offs + pre[i]);
            }
            __syncthreads();
            {
                const float kkw = p.rw_kk[l * 256 + ch], ka = p.rw_ka[l * 256 + ch], rk = p.rw_rk[l * 256 + ch];
#pragma unroll 1
                for (int i = 0; i < 16; ++i) {
                    const int j = w + 4 * i, row = row0 + j, tt = t0 + j;
                    const float rr = rw_mix(pb, mup, mun, row, tt, seqlen, ch);
                    const float kr = rw_mix(pb, mup, mun, row, tt, seqlen, 256 + ch);
                    const float a = bf2f(abuf[j * 64 + lane]);
                    const float kkv = kr * kkw;
                    const float ss = wsum(kkv * kkv);
                    const float kkn = kkv / fmaxf(sqrtf(ss), 1e-12f);
                    const int s = d ? 63 - j : j;
                    const float Lt = Lb[s * 64 + lane];
                    const float Lp = s > 0 ? Lb[(s - 1) * 64 + lane] : 0.f;
                    const float einv = __expf(-Lt);
                    const int c = s >> 4, ts = s & 15;
                    u16* sv = SV + (size_t)(c * 4) * 1024 + ts * 64 + lane;
                    sv[0] = f2bf(-kkn * __expf(Lp));
                    sv[1024] = f2bf(rr * __expf(Lt));
                    sv[2048] = f2bf(kkn * a * einv);
                    sv[3072] = f2bf(kr * (1.f + (a - 1.f) * ka) * einv);
                    if (d == 0) { const float bs = wsum(rr * kr * rk); if (lane == 0) bonus[(size_t)row * 4 + h] = bs; }
                }
                if (w == 0) rwwg[((size_t)bh * 260 + gscan) * 64 + lane] = __expf(Lb[63 * 64 + lane]);
            }
            __syncthreads();
            {
                char* rec = rwop + ((size_t)bh * 1040 + (size_t)gscan * 4 + w) * RWREC;
                const u16* Av = SV + (size_t)(w * 4) * 1024; const u16* Rv = Av + 1024; const u16* Bv = Av + 2048; const u16* Kv = Av + 3072;
                bf16x8 fa[2], frr[2], fb[2], fk[2];
#pragma unroll
                for (int ks = 0; ks < 2; ++ks) {
                    fa[ks] = *(const bf16x8*)(Av + fr * 64 + ks * 32 + fq * 8);
                    frr[ks] = *(const bf16x8*)(Rv + fr * 64 + ks * 32 + fq * 8);
                    fb[ks] = *(const bf16x8*)(Bv + fr * 64 + ks * 32 + fq * 8);
                    fk[ks] = *(const bf16x8*)(Kv + fr * 64 + ks * 32 + fq * 8);
                }
                f32x4 mka = f32x4{0.f, 0.f, 0.f, 0.f}, mba = mka, mkr = mka, mbr = mka;
#pragma unroll
                for (int ks = 0; ks < 2; ++ks) {
                    mka = __builtin_amdgcn_mfma_f32_16x16x32_bf16(fa[ks], fk[ks], mka, 0, 0, 0);
                    mba = __builtin_amdgcn_mfma_f32_16x16x32_bf16(fa[ks], fb[ks], mba, 0, 0, 0);
                    mkr = __builtin_amdgcn_mfma_f32_16x16x32_bf16(frr[ks], fk[ks], mkr, 0, 0, 0);
                    mbr = __builtin_amdgcn_mfma_f32_16x16x32_bf16(frr[ks], fb[ks], mbr, 0, 0, 0);
                }
                float* Ns = Lb + w * 256;
                u16* rmka = (u16*)(rec + RW_MKA); u16* rmy = (u16*)(rec + RW_MY); u16* rtt = (u16*)(rec + RW_TT);
                const int i_ = fr;
#pragma unroll
                for (int r = 0; r < 4; ++r) {
                    const int t_ = 4 * fq + r;
                    const int lp = (i_ >> 2) * 16 + t_;
                    rmka[lp * 4 + (i_ & 3)] = f2bf(i_ < t_ ? mka[r] : 0.f);
                    rmy[lp * 8 + (i_ & 3)] = f2bf(i_ <= t_ ? mbr[r] : 0.f);
                    rmy[lp * 8 + 4 + (i_ & 3)] = f2bf(i_ <= t_ ? mkr[r] : 0.f);
                    Ns[t_ * 16 + i_] = i_ < t_ ? mba[r] : 0.f;
                }
                if (lane < 16) {
                    float Tr[16];
#pragma unroll
                    for (int t_ = 0; t_ < 16; ++t_) {
                        float acc = (lane == t_) ? 1.f : 0.f;
#pragma unroll
                        for (int ii = 0; ii < t_; ++ii) acc += Tr[ii] * Ns[t_ * 16 + ii];
                        Tr[t_] = acc;
                        rtt[((lane >> 2) * 16 + t_) * 4 + (lane & 3)] = f2bf(acc);
                    }
                }
#pragma unroll
                for (int ks = 0; ks < 2; ++ks) {
                    uint4 o;
                    const uint2 lo = *(const uint2*)(Av + fr * 64 + 32 * ks + 4 * fq), hi = *(const uint2*)(Av + fr * 64 + 32 * ks + 16 + 4 * fq);
                    o.x = lo.x; o.y = lo.y; o.z = hi.x; o.w = hi.y;
                    *(uint4*)(rec + RW_A1 + (ks * 64 + lane) * 16) = o;
                    const uint2 lo2 = *(const uint2*)(Rv + fr * 64 + 32 * ks + 4 * fq), hi2 = *(const uint2*)(Rv + fr * 64 + 32 * ks + 16 + 4 * fq);
                    o.x = lo2.x; o.y = lo2.y; o.z = hi2.x; o.w = hi2.y;
                    *(uint4*)(rec + RW_A4 + (ks * 64 + lane) * 16) = o;
                }
#pragma unroll
                for (int m = 0; m < 4; ++m) {
                    unsigned e[8];
#pragma unroll
                    for (int j = 0; j < 4; ++j) { e[j] = Bv[(4 * fq + j) * 64 + 16 * m + fr]; e[4 + j] = Kv[(4 * fq + j) * 64 + 16 * m + fr]; }
                    uint4 o; o.x = e[0] | (e[1] << 16); o.y = e[2] | (e[3] << 16); o.z = e[4] | (e[5] << 16); o.w = e[6] | (e[7] << 16);
                    *(uint4*)(rec + RW_A3 + (m * 64 + lane) * 16) = o;
                }
#pragma unroll 1
                for (int q = 0; q < 4; ++q) {
                    unsigned e[4];
#pragma unroll
                    for (int j = 0; j < 4; ++j) {
                        const int s = 16 * w + 4 * fq + j; const int jt = d ? 63 - s : s;
                        e[j] = f2bf(rw_mix(pb, mup, mun, row0 + jt, t0 + jt, seqlen, 512 + h * 64 + 16 * q + fr));
                    }
                    uint2 o; o.x = e[0] | (e[1] << 16); o.y = e[2] | (e[3] << 16);
                    *(uint2*)(rec + RW_V + (q * 64 + lane) * 8) = o;
                }
            }
        }
    }
}

constexpr int RWSLOT = 12544;
DEVINL void ph_rwscan(const P& p, int l, int d, int bid, int nb, char* smem) {
    const int TIDX_ = tid_(); char* const WS_ = wsl_(p.ws);
    const int tid = TIDX_, lane = tid & 63, q = tid >> 6, fr = lane & 15, fq = lane >> 4;
    const char* rwop = WS_ + OFF_RWOP;
    const float* rwwg = (const float*)(WS_ + OFF_RWWG);
    u16* yf = (u16*)(WS_ + OFF_Y);
    u16* yb = (u16*)(WS_ + OFF_YRWB);
    (void)l;
    for (int bh = bid; bh < 8; bh += nb) {
        const int b = bh >> 2, h = bh & 3;
        f32x4 z[4];
#pragma unroll
        for (int m = 0; m < 4; ++m) z[m] = f32x4{0.f, 0.f, 0.f, 0.f};
        const char* rec0 = rwop + (size_t)bh * 1040 * RWREC;
        const float* wg0 = rwwg + (size_t)bh * 260 * 64;
        auto issue = [&](int c, int sl) {
            const int cc = c < 1040 ? c : 1039;
            char* slot = smem + sl * RWSLOT;
            const char* rec = rec0 + (size_t)cc * RWREC;
#pragma unroll
            for (int i = 0; i < 3; ++i) glds16(rec + (tid + 256 * i) * 16, slot + (tid + 256 * i) * 16);
            glds4((const char*)(wg0 + (size_t)(cc >> 2) * 64) + lane * 4, slot + 12288 + lane * 4);
        };
        auto asfrag = [](uint4 v) { union { uint4 u; bf16x8 f; } x; x.u = v; return x.f; };
        auto pack2 = [](float lo, float hi) { return pk2bf(lo, hi); };
        const unsigned b128 = lds_addr(smem) + lane * 16, b64 = lds_addr(smem) + lane * 8, bv = lds_addr(smem) + (q * 64 + lane) * 8, bg = lds_addr(smem) + 16 * fq;
        __syncthreads();
        __builtin_amdgcn_s_setprio(3);
        issue(0, 0); issue(1, 1); issue(2, 2); issue(3, 3);
#pragma unroll 1
        for (int c5 = 0; c5 < 1040; c5 += 5) {
          auto body = [&](auto SJ) {
            constexpr int sj = decltype(SJ)::value;
            const int c = c5 + sj;
            asm volatile("s_waitcnt vmcnt(12)" ::: "memory");
            __builtin_amdgcn_s_barrier();
            issue(c + 4, (sj + 4) % 5);
            constexpr int SB = sj * RWSLOT;
            u32x4 r_a10, r_a11, r_a40, r_a41, r_a30, r_a31, r_a32, r_a33, r_my, g0, g1, g2, g3;
            u32x2 mka, tt, vcur;
            asm volatile(
                "ds_read_b128 %0, %16 offset:%20+0\n\t"
                "ds_read_b128 %1, %16 offset:%20+1024\n\t"
                "ds_read_b128 %2, %16 offset:%20+2048\n\t"
                "ds_read_b128 %3, %16 offset:%20+3072\n\t"
                "ds_read_b128 %4, %16 offset:%20+4096\n\t"
                "ds_read_b128 %5, %16 offset:%20+5120\n\t"
                "ds_read_b128 %6, %16 offset:%20+6144\n\t"
                "ds_read_b128 %7, %16 offset:%20+7168\n\t"
                "ds_read_b128 %8, %16 offset:%20+9216\n\t"
                "ds_read_b64 %9, %17 offset:%20+8192\n\t"
                "ds_read_b64 %10, %17 offset:%20+8704\n\t"
                "ds_read_b64 %11, %18 offset:%20+10240\n\t"
                "ds_read_b128 %12, %19 offset:%20+12288\n\t"
                "ds_read_b128 %13, %19 offset:%20+12352\n\t"
                "ds_read_b128 %14, %19 offset:%20+12416\n\t"
                "ds_read_b128 %15, %19 offset:%20+12480\n\t"
                "s_waitcnt lgkmcnt(0)"
                : "=&v"(r_a10), "=&v"(r_a11), "=&v"(r_a40), "=&v"(r_a41), "=&v"(r_a30), "=&v"(r_a31), "=&v"(r_a32), "=&v"(r_a33), "=&v"(r_my),
                  "=&v"(mka), "=&v"(tt), "=&v"(vcur), "=&v"(g0), "=&v"(g1), "=&v"(g2), "=&v"(g3)
                : "v"(b128), "v"(b64), "v"(bv), "v"(bg), "n"(SB)
                : "memory");
            auto asfrag4 = [](u32x4 v) { union { u32x4 u; bf16x8 f; } x; x.u = v; return x.f; };
            const bf16x8 A1_0 = asfrag4(r_a10), A1_1 = asfrag4(r_a11), A4_0 = asfrag4(r_a40), A4_1 = asfrag4(r_a41);
            const bf16x8 A3_0 = asfrag4(r_a30), A3_1 = asfrag4(r_a31), A3_2 = asfrag4(r_a32), A3_3 = asfrag4(r_a33), MY = asfrag4(r_my);
            const bf16x8 MKA = asfrag(make_uint4(mka.x, mka.y, 0u, 0u)), TT = asfrag(make_uint4(tt.x, tt.y, 0u, 0u));
            const bf16x8 VB = asfrag(make_uint4(vcur.x, vcur.y, 0u, 0u));
            const bf16x8 ZB0 = asfrag(make_uint4(pack2(z[0][0], z[0][1]), pack2(z[0][2], z[0][3]), pack2(z[1][0], z[1][1]), pack2(z[1][2], z[1][3])));
            const bf16x8 ZB1 = asfrag(make_uint4(pack2(z[2][0], z[2][1]), pack2(z[2][2], z[2][3]), pack2(z[3][0], z[3][1]), pack2(z[3][2], z[3][3])));
            f32x4 X = f32x4{0.f, 0.f, 0.f, 0.f};
            X = __builtin_amdgcn_mfma_f32_16x16x32_bf16(MKA, VB, X, 0, 0, 0);
            X = __builtin_amdgcn_mfma_f32_16x16x32_bf16(A1_0, ZB0, X, 0, 0, 0);
            X = __builtin_amdgcn_mfma_f32_16x16x32_bf16(A1_1, ZB1, X, 0, 0, 0);
            f32x4 Y = f32x4{0.f, 0.f, 0.f, 0.f};
            Y = __builtin_amdgcn_mfma_f32_16x16x32_bf16(A4_0, ZB0, Y, 0, 0, 0);
            Y = __builtin_amdgcn_mfma_f32_16x16x32_bf16(A4_1, ZB1, Y, 0, 0, 0);
            const bf16x8 XB = asfrag(make_uint4(pack2(X[0], X[1]), pack2(X[2], X[3]), 0u, 0u));
            f32x4 U = f32x4{0.f, 0.f, 0.f, 0.f};
            U = __builtin_amdgcn_mfma_f32_16x16x32_bf16(TT, XB, U, 0, 0, 0);
            const bf16x8 UV = asfrag(make_uint4(pack2(U[0], U[1]), pack2(U[2], U[3]), vcur.x, vcur.y));
            z[0] = __builtin_amdgcn_mfma_f32_16x16x32_bf16(A3_0, UV, z[0], 0, 0, 0);
            z[1] = __builtin_amdgcn_mfma_f32_16x16x32_bf16(A3_1, UV, z[1], 0, 0, 0);
            z[2] = __builtin_amdgcn_mfma_f32_16x16x32_bf16(A3_2, UV, z[2], 0, 0, 0);
            z[3] = __builtin_amdgcn_mfma_f32_16x16x32_bf16(A3_3, UV, z[3], 0, 0, 0);
            Y = __builtin_amdgcn_mfma_f32_16x16x32_bf16(MY, UV, Y, 0, 0, 0);
            if ((c & 3) == 3) {
                z[0][0] *= __uint_as_float(g0.x); z[0][1] *= __uint_as_float(g0.y); z[0][2] *= __uint_as_float(g0.z); z[0][3] *= __uint_as_float(g0.w);
                z[1][0] *= __uint_as_float(g1.x); z[1][1] *= __uint_as_float(g1.y); z[1][2] *= __uint_as_float(g1.z); z[1][3] *= __uint_as_float(g1.w);
                z[2][0] *= __uint_as_float(g2.x); z[2][1] *= __uint_as_float(g2.y); z[2][2] *= __uint_as_float(g2.z); z[2][3] *= __uint_as_float(g2.w);
                z[3][0] *= __uint_as_float(g3.x); z[3][1] *= __uint_as_float(g3.y); z[3][2] *= __uint_as_float(g3.z); z[3][3] *= __uint_as_float(g3.w);
            }
            {
                const bool isctx = c < 16;
                const int cc = isctx ? c : c - 16;
                const int n = isctx ? LCTX : LAT;
                const int rowbase = isctx ? b * LCTX : CTXROWS + b * LAT;
                const unsigned y01 = pk2bf(Y[0], Y[1]), y23 = pk2bf(Y[2], Y[3]);
#pragma unroll
                for (int r = 0; r < 4; ++r) {
                    const int s = cc * 16 + 4 * fq + r;
                    const int t = d ? n - 1 - s : s;
                    const u16 o = (u16)(((r < 2 ? y01 : y23) >> ((r & 1) * 16)) & 0xFFFFu);
                    u16* dst = d == 0 ? yf + (size_t)(rowbase + t) * 1024 + 512 + h * 64 + 16 * q + fr : yb + (size_t)(rowbase + t) * 256 + h * 64 + 16 * q + fr;
                    *dst = o;
                }
            }
          };
          body(std::integral_constant<int, 0>{}); body(std::integral_constant<int, 1>{}); body(std::integral_constant<int, 2>{});
          body(std::integral_constant<int, 3>{}); body(std::integral_constant<int, 4>{});
        }
        asm volatile("s_waitcnt vmcnt(0)" ::: "memory");
        __builtin_amdgcn_s_setprio(0);
        __syncthreads();
    }
}

DEVINL void ph_rwout(const P& p, int l) {
    const int TIDX_ = tid_(); const int BIDX_ = bid_(); char* const WS_ = wsl_(p.ws);
    const int tid = TIDX_, h = tid >> 6;
    const u16* pb = (const u16*)(WS_ + OFF_PB);
    const u16* yb = (const u16*)(WS_ + OFF_YRWB);
    const u16* gate = (const u16*)(WS_ + OFF_GATE);
    const float* bonus = (const float*)(WS_ + OFF_BONUS);
    u16* y = (u16*)(WS_ + OFF_Y);
    const float* mup = p.mu_prev + l * 960; const float* mun = p.mu_next + l * 960;
    const float lw = p.rw_lnw[l * 256 + tid], lb = p.rw_lnb[l * 256 + tid];
    const int rstart = (l == 0) ? 0 : CTXROWS;
    for (int row = rstart + BIDX_; row < T; row += gridDim.x) {
        int t, seqlen;
        if (row < CTXROWS) { t = row & 255; seqlen = LCTX; } else { t = (row - CTXROWS) & (LAT - 1); seqlen = LAT; }
        const float yv = bf2f(y[(size_t)row * 1024 + 512 + tid]) + bf2f(yb[(size_t)row * 256 + tid]);
        const float v = rw_mix(pb, mup, mun, row, t, seqlen, 512 + tid);
        const float mu = wsum(yv) * (1.f / 64.f);
        const float dl = yv - mu;
        const float var = wsum(dl * dl) * (1.f / 64.f);
        const float o = (dl * rsqrtf(var + 64e-5f) * lw + lb + bonus[(size_t)row * 4 + h] * v) * bf2f(gate[(size_t)row * 256 + tid]);
        y[(size_t)row * 1024 + 512 + tid] = f2bf(o);
    }
}
DEVINL void ph_prepM(const P& p, int l, char* smem, int bid, int nb) {
    const int TIDX_ = tid_(); const int BIDX_ = bid_(); char* const WS_ = wsl_(p.ws);
    const int tid = TIDX_, lane = tid & 63, wid = tid >> 6;
    const u16* pc = (const u16*)(WS_ + OFF_PC);
    u16* mlf = (u16*)(WS_ + OFF_MLF);
    float* mlg = (float*)(WS_ + OFF_MLG);
    float* mls = (float*)(WS_ + OFF_MLS);
    float* nst = (float*)(WS_ + OFF_NST);
    float* cst = (float*)(WS_ + OFF_HM);
    const float* rope = (const float*)(WS_ + OFF_ROPE);
    u16* kl = (u16*)smem;
    u16* vl = kl + 4096;
    float* wsl = (float*)(vl + 4096);
    float* lil = wsl + 128;
    for (int uh = bid; uh < NUNIT_CH * 4; uh += nb) {
        const int u = uh >> 2, h = uh & 3;
        int b, ch, row0, seqlen; bool isctx;
        if (u < 8) { isctx = true; b = u >> 2; ch = u & 3; row0 = b * 256 + ch * 64; seqlen = 256; }
        else { isctx = false; b = (u - 8) >> 8; ch = (u - 8) & 255; row0 = CTXROWS + b * LAT + ch * 64; seqlen = LAT; }
        const int t0 = ch * 64;
        const int tc = isctx ? ch : 4 + ch;
        __syncthreads();
        {
            const bool isk = wid >= 2;
            const int cch = (isk ? 256 : 0) + h * 64 + lane;
            const float* cw = p.ml_cw + (size_t)l * 3 * 512;
            const float w0 = cw[cch], w1 = cw[512 + cch], w2 = cw[1024 + cch], bb = p.ml_cb[l * 512 + cch];
            const int jb = (wid & 1) * 32;
            const int i16 = lane & 15; const bool second = (lane & 16) != 0; const int half = lane >> 5;
            float pv = (t0 + jb > 0) ? bf2f(pc[(size_t)(row0 + jb - 1) * 1040 + cch]) : 0.f;
            float cv = bf2f(pc[(size_t)(row0 + jb) * 1040 + cch]);
#pragma unroll 4
            for (int jj = 0; jj < 32; ++jj) {
                const int j = jb + jj;
                const float nv = (t0 + j + 1 < seqlen) ? bf2f(pc[(size_t)(row0 + j + 1) * 1040 + cch]) : 0.f;
                float val = siluf_(w0 * pv + w1 * cv + w2 * nv + bb);
                if (!isctx) {
                    const int t = t0 + j;
                    const int pos = half == 0 ? (t >> 6) : (t & 63);
                    const float cs = half == 0 ? rope[pos * 16 + i16] : rope[8192 + pos * 16 + i16];
                    const float sn = half == 0 ? rope[4096 + pos * 16 + i16] : rope[9216 + pos * 16 + i16];
                    const float ov = __shfl_xor(val, 16);
                    val = second ? (ov * sn + val * cs) : (val * cs - ov * sn);
                }
                if (isk) { const u16 kb = f2bf(val * 0.125f); mlf[(size_t)(row0 + j) * 512 + 256 + h * 64 + lane] = kb; kl[j * 64 + lane] = kb; }
                else mlf[(size_t)(row0 + j) * 512 + h * 64 + lane] = f2bf(val);
                pv = cv; cv = nv;
            }
            {
                const int j = tid >> 2, wh = tid & 3;
                const int idx = (wh < 2) ? (wh * 4 + h) : (8 + (wh - 2) * 4 + h);
                const float g = bf2f(pc[(size_t)(row0 + j) * 1040 + 1024 + idx]);
                float v;
                if (wh < 2) v = g + p.ml_ib[l * 8 + idx];
                else { const float xx = g + p.ml_fb[l * 8 + idx - 8]; v = fminf(xx, 0.f) - log1pf(__expf(-fabsf(xx))); }
                lil[j * 4 + wh] = v;
                mlg[(size_t)(row0 + j) * 16 + idx] = v;
            }
            for (int i = tid; i < 64 * 16; i += 256) {
                const int tok = i >> 4, c4 = (i & 15) * 4;
                *(uint2*)(vl + tok * 64 + c4) = *(const uint2*)(pc + (size_t)(row0 + tok) * 1040 + 512 + h * 64 + c4);
            }
        }
        __syncthreads();
        if (tid < 2) {
            const int d = tid;
            float bacc = 0.f;
#pragma unroll 1
            for (int jj = 0; jj < 64; ++jj) { const int tok = d ? 63 - jj : jj; bacc += lil[tok * 4 + 2 + d]; wsl[d * 64 + tok] = bacc; }
            const float Bs = bacc;
            float G = -3.0e38f;
#pragma unroll 1
            for (int tok = 0; tok < 64; ++tok) { const float g = Bs - wsl[d * 64 + tok] + lil[tok * 4 + d]; G = fmaxf(G, g); }
#pragma unroll 1
            for (int tok = 0; tok < 64; ++tok) { const float g = Bs - wsl[d * 64 + tok] + lil[tok * 4 + d]; wsl[d * 64 + tok] = expf(g - G); }
            const int bhd = (b * 4 + h) * 2 + d;
            mls[(bhd * NTC + tc) * 2 + 0] = G; mls[(bhd * NTC + tc) * 2 + 1] = Bs;
        }
        __syncthreads();
        {
            const int dk4 = (tid >> 4) * 4, dv4 = (tid & 15) * 4;
            float a0[4][4], a1[4][4], n0[4], n1[4];
#pragma unroll
            for (int a = 0; a < 4; ++a) { n0[a] = 0.f; n1[a] = 0.f;
#pragma unroll
                for (int c = 0; c < 4; ++c) { a0[a][c] = 0.f; a1[a][c] = 0.f; } }
#pragma unroll 2
            for (int j = 0; j < 64; ++j) {
                const uint2 kk = *(const uint2*)(kl + j * 64 + dk4);
                const uint2 vv = *(const uint2*)(vl + j * 64 + dv4);
                const float w0 = wsl[j], w1 = wsl[64 + j];
                const float kf[4] = {bf2f((u16)(kk.x & 0xFFFF)), bf2f((u16)(kk.x >> 16)), bf2f((u16)(kk.y & 0xFFFF)), bf2f((u16)(kk.y >> 16))};
                const float vf[4] = {bf2f((u16)(vv.x & 0xFFFF)), bf2f((u16)(vv.x >> 16)), bf2f((u16)(vv.y & 0xFFFF)), bf2f((u16)(vv.y >> 16))};
#pragma unroll
                for (int a = 0; a < 4; ++a) {
                    const float k0 = kf[a] * w0, k1 = kf[a] * w1;
                    n0[a] += k0; n1[a] += k1;
#pragma unroll
                    for (int c = 0; c < 4; ++c) { a0[a][c] += k0 * vf[c]; a1[a][c] += k1 * vf[c]; }
                }
            }
            const int bh0 = ((b * 4 + h) * 2 + 0) * NTC + tc, bh1 = ((b * 4 + h) * 2 + 1) * NTC + tc;
#pragma unroll
            for (int a = 0; a < 4; ++a) {
                *(float4*)(cst + (size_t)bh0 * 4096 + (dk4 + a) * 64 + dv4) = make_float4(a0[a][0], a0[a][1], a0[a][2], a0[a][3]);
                *(float4*)(cst + (size_t)bh1 * 4096 + (dk4 + a) * 64 + dv4) = make_float4(a1[a][0], a1[a][1], a1[a][2], a1[a][3]);
                if ((tid & 15) == 0) { nst[(size_t)bh0 * 64 + dk4 + a] = n0[a]; nst[(size_t)bh1 * 64 + dk4 + a] = n1[a]; }
            }
        }
    }
}

DEVINL void ph_mlB(const P& p, int bid, int nb, char* smem) {
    const int TIDX_ = tid_(); char* const WS_ = wsl_(p.ws);
    const int tid = TIDX_;
    const float* mls = (const float*)(WS_ + OFF_MLS);
    float* mst = (float*)(WS_ + OFF_MST);
    float* nst = (float*)(WS_ + OFF_NST);
    const float* cst = (const float*)(WS_ + OFF_HM);
    u16* cst2 = (u16*)(WS_ + OFF_CST2);
    float* nst2 = (float*)(WS_ + OFF_NST2);
    float* gb = (float*)smem;
    float* dcu = gb + 1024;
    for (int u = bid; u < 64; u += nb) {
        const int bhd = u >> 2, q = u & 3, d = bhd & 1;
        auto tcof = [&](int cs) { return cs < 4 ? (d ? 3 - cs : cs) : 4 + (d ? 255 - (cs - 4) : cs - 4); };
        __syncthreads();
        for (int cs = tid; cs < NTC; cs += 256) { const int tc = tcof(cs); gb[cs * 2] = mls[(bhd * NTC + tc) * 2]; gb[cs * 2 + 1] = mls[(bhd * NTC + tc) * 2 + 1]; }
        __syncthreads();
        if (tid == 0) {
            float m = 0.f;
#pragma unroll 1
            for (int cs = 0; cs < NTC; ++cs) {
                const float G = gb[cs * 2], Bs = gb[cs * 2 + 1];
                if (q == 0) mst[bhd * NTC + tcof(cs)] = m;
                const float ml = fmaxf(Bs + m, G);
                dcu[cs * 2] = __expf(Bs + m - ml); dcu[cs * 2 + 1] = __expf(G - ml);
                m = ml;
            }
        }
        __syncthreads();
        float zz = 0.f; asm volatile("" : "+v"(zz));
        float4 C = make_float4(zz, zz, zz, zz);
        float nn = zz;
        const bool don = (q == 0) && (tid < 64);
        const float* cbase = cst + (size_t)bhd * NTC * 4096 + q * 1024 + tid * 4;
        const float* nbase = nst + (size_t)bhd * NTC * 64 + tid;
        u16* obase = cst2 + (size_t)bhd * NTC * 4096 + q * 1024 + tid * 4;
        float* onbase = nst2 + (size_t)bhd * NTC * 64 + tid;
        float4 Ub[8]; float Nb[8];
#pragma unroll
        for (int i = 0; i < 8; ++i) { Ub[i] = *(const float4*)(cbase + (size_t)tcof(i) * 4096); Nb[i] = don ? nbase[(size_t)tcof(i) * 64] : 0.f; }
#pragma unroll 1
        for (int cs0 = 0; cs0 < NTC; cs0 += 8) {
#pragma unroll
            for (int i = 0; i < 8; ++i) {
                const int cs = cs0 + i;
                if (cs < NTC) {
                    const float4 U = Ub[i]; const float nU = Nb[i];
                    const int tc = tcof(cs);
                    if (cs + 8 < NTC) { Ub[i] = *(const float4*)(cbase + (size_t)tcof(cs + 8) * 4096); Nb[i] = don ? nbase[(size_t)tcof(cs + 8) * 64] : 0.f; }
                    { uint2 o; o.x = pk2bf(C.x, C.y); o.y = pk2bf(C.z, C.w); *(uint2*)(obase + (size_t)tc * 4096) = o; }
                    if (don) onbase[(size_t)tc * 64] = nn;
                    const float dC = dcu[cs * 2], dU = dcu[cs * 2 + 1];
                    C.x = dC * C.x + dU * U.x; C.y = dC * C.y + dU * U.y; C.z = dC * C.z + dU * U.z; C.w = dC * C.w + dU * U.w;
                    nn = dC * nn + dU * nU;
                }
            }
        }
    }
}

DEVINL void ph_na(const P& p, int l, char* smem, int bid, int nb) {
    const int TIDX_ = tid_(); const int BIDX_ = bid_(); char* const WS_ = wsl_(p.ws); (void)TIDX_; (void)BIDX_; (void)WS_;
    const int tid = TIDX_, lane = tid & 63, w = tid >> 6, fr = lane & 15, g = lane >> 4;
    const u16* pqk = (const u16*)(WS_ + OFF_PQK);
    const u16* vtl = (const u16*)(WS_ + OFF_VTL);
    const u16* vtc = (const u16*)(WS_ + OFF_VTC);
    u16* y = (u16*)(WS_ + OFF_Y);
    float* rpbl = (float*)smem;
    const int nunit = 4096 + (l == 0 ? 64 : 0);
    for (int u = bid; u < nunit; u += nb) {
        const bool isctx = u >= 4096;
        int b, h, r = 0, qg = 0;
        if (!isctx) { b = u >> 11; h = (u >> 8) & 7; r = u & 255; }
        else { const int v = u - 4096; b = v >> 5; h = (v >> 2) & 7; qg = v & 3; }
        __syncthreads();
        if (!isctx) for (int i = tid; i < 465; i += 256) rpbl[i] = p.na_rpb[((size_t)l * 8 + h) * 465 + i];
        __syncthreads();
        const int c = 16 * w + fr;
        const int qrow = isctx ? b * LCTX + qg * 64 + c : CTXROWS + b * LAT + r * 64 + c;
        bf16x8 qf[2];
        qf[0] = *(const bf16x8*)(pqk + (size_t)qrow * 1024 + h * 64 + 8 * g);
        qf[1] = *(const bf16x8*)(pqk + (size_t)qrow * 1024 + h * 64 + 32 + 8 * g);
        f32x4 O[4];
#pragma unroll
        for (int i = 0; i < 4; ++i) O[i] = f32x4{0.f, 0.f, 0.f, 0.f};
        float mrun = -1.0e30f, lrun = 0.f;
        auto chunk = [&](const u16* kbase0, const u16* kbase1, const u16* vb, int vstride, const float* bias0, const float* bias1, bool lo0, bool lo1, int kc0, int cs) {
            bf16x8 k00 = *(const bf16x8*)(kbase0 + 8 * g), k01 = *(const bf16x8*)(kbase0 + 32 + 8 * g);
            bf16x8 k10 = *(const bf16x8*)(kbase1 + 8 * g), k11 = *(const bf16x8*)(kbase1 + 32 + 8 * g);
            uint2 vlo[4], vhi[4];
#pragma unroll
            for (int dt = 0; dt < 4; ++dt) { vlo[dt] = *(const uint2*)(vb + (size_t)dt * 16 * vstride); vhi[dt] = *(const uint2*)(vb + (size_t)dt * 16 * vstride + 16); }
            f32x4 s0 = f32x4{0.f, 0.f, 0.f, 0.f}, s1 = f32x4{0.f, 0.f, 0.f, 0.f};
            s0 = __builtin_amdgcn_mfma_f32_16x16x32_bf16(k00, qf[0], s0, 0, 0, 0);
            s0 = __builtin_amdgcn_mfma_f32_16x16x32_bf16(k01, qf[1], s0, 0, 0, 0);
            s1 = __builtin_amdgcn_mfma_f32_16x16x32_bf16(k10, qf[0], s1, 0, 0, 0);
            s1 = __builtin_amdgcn_mfma_f32_16x16x32_bf16(k11, qf[1], s1, 0, 0, 0);
            float sv[8];
#pragma unroll
            for (int j = 0; j < 4; ++j) {
                float a = s0[j] * 0.125f, bb = s1[j] * 0.125f;
                if (lo0) {
                    const int k0c = kc0 + 4 * g + j, k1c = k0c + 16;
                    a = (k0c >= cs && k0c <= cs + 15) ? a + bias0[k0c] : -1.0e30f;
                    bb = (k1c >= cs && k1c <= cs + 15) ? bb + bias0[k1c] : -1.0e30f;
                }
                sv[j] = a; sv[4 + j] = bb;
            }
            (void)bias1; (void)lo1;
            float mx = sv[0];
#pragma unroll
            for (int j = 1; j < 8; ++j) mx = fmaxf(mx, sv[j]);
            mx = fmaxf(mx, __shfl_xor(mx, 16)); mx = fmaxf(mx, __shfl_xor(mx, 32));
            const float mnew = fmaxf(mrun, mx);
            const float sc = __expf(mrun - mnew);
            mrun = mnew;
            float ps = 0.f; bf16x8 pf;
#pragma unroll
            for (int j = 0; j < 8; ++j) { const float pv = __expf(sv[j] - mnew); ps += pv; pf[j] = (short)f2bf(pv); }
            lrun = lrun * sc + ps;
#pragma unroll
            for (int dt = 0; dt < 4; ++dt) {
                O[dt][0] *= sc; O[dt][1] *= sc; O[dt][2] *= sc; O[dt][3] *= sc;
                bf16x8 vf;
                vf[0] = (short)(vlo[dt].x & 0xFFFF); vf[1] = (short)(vlo[dt].x >> 16); vf[2] = (short)(vlo[dt].y & 0xFFFF); vf[3] = (short)(vlo[dt].y >> 16);
                vf[4] = (short)(vhi[dt].x & 0xFFFF); vf[5] = (short)(vhi[dt].x >> 16); vf[6] = (short)(vhi[dt].y & 0xFFFF); vf[7] = (short)(vhi[dt].y >> 16);
                O[dt] = __builtin_amdgcn_mfma_f32_16x16x32_bf16(vf, pf, O[dt], 0, 0, 0);
            }
        };
        if (!isctx) {
            const int rs = min(max(r - 4, 0), 248);
            const int cb = (w == 0) ? 0 : (w == 1) ? 8 : (w == 2) ? 24 : 32;
            const int cs = min(max(c - 8, 0), 48);
            for (int i = 0; i < 8; ++i) {
                const int krow = rs + i;
                const size_t tokb = (size_t)CTXROWS + (size_t)b * LAT + krow * 64 + cb;
                const u16* kb0 = pqk + (tokb + fr) * 1024 + 512 + h * 64;
                const u16* kb1 = pqk + (tokb + 16 + fr) * 1024 + 512 + h * 64;
                const u16* vb = vtl + ((size_t)((b * 8 + h) * 64 + fr)) * LAT + krow * 64 + cb + 4 * g;
                const float* bias0 = rpbl + (krow - r + 7) * 31 - c + 15;
                chunk(kb0, kb1, vb, LAT, bias0, bias0, true, true, cb, cs);
            }
        }
        for (int cc = 0; cc < 8; ++cc) {
            const size_t tokb = (size_t)b * LCTX + cc * 32;
            const u16* kb0 = pqk + (tokb + fr) * 1024 + 512 + h * 64;
            const u16* kb1 = pqk + (tokb + 16 + fr) * 1024 + 512 + h * 64;
            const u16* vb = vtc + ((size_t)((b * 8 + h) * 64 + fr)) * LCTX + cc * 32 + 4 * g;
            chunk(kb0, kb1, vb, LCTX, nullptr, nullptr, false, false, 0, 0);
        }
        float lt = lrun; lt += __shfl_xor(lt, 16); lt += __shfl_xor(lt, 32);
        const float inv = 1.f / lt;
#pragma unroll
        for (int dt = 0; dt < 4; ++dt) {
            uint2 o;
            o.x = (unsigned)f2bf(O[dt][0] * inv) | ((unsigned)f2bf(O[dt][1] * inv) << 16);
            o.y = (unsigned)f2bf(O[dt][2] * inv) | ((unsigned)f2bf(O[dt][3] * inv) << 16);
            *(uint2*)(y + (size_t)qrow * 1024 + h * 64 + dt * 16 + 4 * g) = o;
        }
    }
}

DEVINL void ph_mlC(const P& p, int l, char* smem, int bid, int nb) {
    const int TIDX_ = tid_(); const int BIDX_ = bid_(); char* const WS_ = wsl_(p.ws); (void)TIDX_; (void)BIDX_; (void)WS_;
    const int tid = TIDX_;
    const u16* mlf = (const u16*)(WS_ + OFF_MLF);
    const u16* pc = (const u16*)(WS_ + OFF_PC);
    const float* mlg = (const float*)(WS_ + OFF_MLG);
    const float* mst = (const float*)(WS_ + OFF_MST);
    const float* nst = (const float*)(WS_ + OFF_NST2);
    const u16* cst = (const u16*)(WS_ + OFF_CST2);
    u16* y = (u16*)(WS_ + OFF_Y);
    u16* ql = (u16*)smem;
    u16* kl = ql + 4096;
    u16* vl = kl + 4096;
    float* Cl = (float*)(vl + 4096);
    float* Sl = Cl + 4096;
    float* btl = Sl + 4096;
    float* lil = btl + 64;
    float* nl = lil + 64;
    const int t = tid >> 2, q4 = tid & 3;
    for (int uh = bid; uh < 2 * NTC * 4; uh += nb) {
        const int u = uh >> 2, h = uh & 3;
        const int b = u / NTC, tc = u % NTC;
        if (tc < 4 && l != 0) continue;
        const int row0 = tc < 4 ? b * LCTX + tc * 64 : CTXROWS + b * LAT + (tc - 4) * 64;
        {
            float hs[16];
#pragma unroll
            for (int i = 0; i < 16; ++i) hs[i] = 0.f;
            __syncthreads();
            for (int i = tid; i < 64 * 16; i += 256) {
                const int tok = i >> 4, c4 = (i & 15) * 4;
                *(uint2*)(ql + tok * 64 + c4) = *(const uint2*)(mlf + (size_t)(row0 + tok) * 512 + h * 64 + c4);
                *(uint2*)(kl + tok * 64 + c4) = *(const uint2*)(mlf + (size_t)(row0 + tok) * 512 + 256 + h * 64 + c4);
                *(uint2*)(vl + tok * 64 + c4) = *(const uint2*)(pc + (size_t)(row0 + tok) * 1040 + 512 + h * 64 + c4);
            }
            for (int d = 0; d < 2; ++d) {
                const int bhd = (b * 4 + h) * 2 + d;
                __syncthreads();
                for (int i = tid; i < 1024; i += 256) { const uint2 cv = *(const uint2*)(cst + ((size_t)bhd * NTC + tc) * 4096 + i * 4); *(float4*)(Cl + i * 4) = make_float4(bf2f((u16)(cv.x & 0xFFFF)), bf2f((u16)(cv.x >> 16)), bf2f((u16)(cv.y & 0xFFFF)), bf2f((u16)(cv.y >> 16))); }
                if (tid < 64) { nl[tid] = nst[((size_t)bhd * NTC + tc) * 64 + tid]; lil[tid] = mlg[(size_t)(row0 + tid) * 16 + d * 4 + h]; }
                if (tid == 64) {
                    float bacc = 0.f;
#pragma unroll 1
                    for (int jj = 0; jj < 64; ++jj) { const int tok = d ? 63 - jj : jj; bacc += mlg[(size_t)(row0 + tok) * 16 + 8 + d * 4 + h]; btl[tok] = bacc; }
                }
                __syncthreads();
                const float m0 = mst[bhd * NTC + tc];
                float sc[16];
#pragma unroll
                for (int i = 0; i < 16; ++i) sc[i] = 0.f;
                for (int dk = 0; dk < 64; dk += 4) {
                    const uint2 qq = *(const uint2*)(ql + t * 64 + dk);
                    const float q0 = bf2f((u16)(qq.x & 0xFFFF)), q1 = bf2f((u16)(qq.x >> 16)), q2 = bf2f((u16)(qq.y & 0xFFFF)), q3 = bf2f((u16)(qq.y >> 16));
#pragma unroll
                    for (int i = 0; i < 16; ++i) {
                        const uint2 kk = *(const uint2*)(kl + (q4 * 16 + i) * 64 + dk);
                        sc[i] += q0 * bf2f((u16)(kk.x & 0xFFFF)) + q1 * bf2f((u16)(kk.x >> 16)) + q2 * bf2f((u16)(kk.y & 0xFFFF)) + q3 * bf2f((u16)(kk.y >> 16));
                    }
                }
                const float bt = btl[t];
                float ld[16]; float mx = -3.0e38f;
#pragma unroll
                for (int i = 0; i < 16; ++i) {
                    const int s = q4 * 16 + i;
                    const bool ok = d ? (s >= t) : (s <= t);
                    ld[i] = ok ? (bt - btl[s] + lil[s]) : -3.0e38f;
                    mx = fmaxf(mx, ld[i]);
                }
                mx = fmaxf(mx, __shfl_xor(mx, 1)); mx = fmaxf(mx, __shfl_xor(mx, 2));
                const float mt = fmaxf(bt + m0, mx);
                float rsum = 0.f;
#pragma unroll
                for (int i = 0; i < 16; ++i) {
                    const int s = q4 * 16 + i;
                    const bool ok = d ? (s >= t) : (s <= t);
                    const float dw = ok ? expf(ld[i] - mt) * sc[i] : 0.f;
                    rsum += dw;
                    Sl[t * 64 + s] = dw;
                }
                rsum += __shfl_xor(rsum, 1); rsum += __shfl_xor(rsum, 2);
                const float inter = expf(bt + m0 - mt);
                float qn = 0.f;
                for (int dk = q4 * 16; dk < q4 * 16 + 16; ++dk) qn += bf2f(ql[t * 64 + dk]) * nl[dk];
                qn += __shfl_xor(qn, 1); qn += __shfl_xor(qn, 2);
                const float den = rsum + inter * qn;
                __syncthreads();
                float num[16];
#pragma unroll
                for (int i = 0; i < 16; ++i) num[i] = 0.f;
                for (int s = 0; s < 64; ++s) {
                    const float dw = Sl[t * 64 + s];
                    const uint4 va = *(const uint4*)(vl + s * 64 + q4 * 16);
                    const uint4 vb2 = *(const uint4*)(vl + s * 64 + q4 * 16 + 8);
                    const unsigned vv[8] = {va.x, va.y, va.z, va.w, vb2.x, vb2.y, vb2.z, vb2.w};
#pragma unroll
                    for (int i = 0; i < 8; ++i) { num[2 * i] += dw * bf2f((u16)(vv[i] & 0xFFFF)); num[2 * i + 1] += dw * bf2f((u16)(vv[i] >> 16)); }
                }
                for (int dk = 0; dk < 64; ++dk) {
                    const float qv = bf2f(ql[t * 64 + dk]) * inter;
#pragma unroll
                    for (int i = 0; i < 16; i += 4) {
                        const float4 cv = *(const float4*)(Cl + dk * 64 + q4 * 16 + i);
                        num[i] += qv * cv.x; num[i + 1] += qv * cv.y; num[i + 2] += qv * cv.z; num[i + 3] += qv * cv.w;
                    }
                }
                const float dn = 1.f / fmaxf(fabsf(den), expf(-mt));
#pragma unroll
                for (int i = 0; i < 16; ++i) hs[i] += num[i] * dn;
            }
            float s1 = 0.f;
#pragma unroll
            for (int i = 0; i < 16; ++i) s1 += hs[i];
            s1 += __shfl_xor(s1, 1); s1 += __shfl_xor(s1, 2);
            const float mu = s1 * (1.f / 64.f);
            float s2 = 0.f;
#pragma unroll
            for (int i = 0; i < 16; ++i) { const float dlt = hs[i] - mu; s2 += dlt * dlt; }
            s2 += __shfl_xor(s2, 1); s2 += __shfl_xor(s2, 2);
            const float rstd = rsqrtf(s2 * (1.f / 64.f) + 1e-6f);
            const int row = row0 + t;
#pragma unroll
            for (int i = 0; i < 16; i += 2) {
                const int cc = h * 64 + q4 * 16 + i;
                const float o0 = bf2f(pc[(size_t)row * 1040 + 768 + cc]), o1 = bf2f(pc[(size_t)row * 1040 + 768 + cc + 1]);
                const float y0 = (hs[i] - mu) * rstd * p.ml_nw[l * 256 + cc] * sigmoidf_(o0);
                const float y1 = (hs[i + 1] - mu) * rstd * p.ml_nw[l * 256 + cc + 1] * sigmoidf_(o1);
                *(unsigned*)(y + (size_t)row * 1024 + 768 + cc) = (unsigned)f2bf(y0) | ((unsigned)f2bf(y1) << 16);
            }
        }
    }
}

DEVINL void ph_outproj(const P& p, int l, char* smem) {
    const int TIDX_ = tid_(); const int BIDX_ = bid_(); char* const WS_ = wsl_(p.ws); (void)TIDX_; (void)BIDX_; (void)WS_;
    const u16* y = (const u16*)(WS_ + OFF_Y);
    const u16* wout = (const u16*)(WS_ + OFF_WOUT);
    const float* modv = (const float*)(WS_ + OFF_MOD) + (size_t)l * 3 * 6144;
    const float* x2c = (const float*)(WS_ + OFF_X2CTX);
    float* x1 = (float*)(WS_ + OFF_X1);
    const int mt0 = (l == 0) ? 0 : 4;
    const int ntile = (260 - mt0) * 8;
    for (int u = BIDX_; u < ntile; u += gridDim.x) {
        const int mt = mt0 + u / 8, nt = u % 8;
        const u16* A = y + (size_t)mt * 128 * 1024;
        const int R0 = mt * 128;
        const float* xin;
        if (l == 0) xin = R0 < CTXROWS ? p.ctx + (size_t)R0 * 1024 : p.x + (size_t)(R0 - CTXROWS) * 1024;
        else xin = R0 < CTXROWS ? x2c + (size_t)R0 * 1024 : p.out + (size_t)(R0 - CTXROWS) * 1024;
        const float* g1 = modv + row_sel(R0) * 6144 + 2048;
        gemm128([&](int r) { return A + (size_t)r * 1024; }, wout + (size_t)nt * 128 * 1024, 1024, 1024, smem,
                [&](int m, int n, f32x4 a) {
                    const int N = nt * 128 + n;
                    const float gg = g1[N];
#pragma unroll
                    for (int j = 0; j < 4; ++j) x1[(size_t)(R0 + m + j) * 1024 + N] = ALPHA * xin[(size_t)(m + j) * 1024 + N] + gg * a[j];
                });
    }
}

DEVINL void ph_ln1(const P& p, int l) {
    const int TIDX_ = tid_(); const int BIDX_ = bid_(); char* const WS_ = wsl_(p.ws); (void)TIDX_; (void)BIDX_; (void)WS_;
    const int lane = TIDX_ & 63, wid = TIDX_ >> 6;
    const float* modv = (const float*)(WS_ + OFF_MOD) + (size_t)l * 3 * 6144;
    float* x1 = (float*)(WS_ + OFF_X1);
    u16* hm = (u16*)(WS_ + OFF_HM);
    const int rstart = (l == 0) ? 0 : CTXROWS;
    for (int row = rstart + BIDX_ * 4 + wid; row < T; row += gridDim.x * 4) {
        float4 v[4];
        float s = 0.f;
#pragma unroll
        for (int i = 0; i < 4; ++i) { v[i] = *(const float4*)(x1 + (size_t)row * 1024 + i * 256 + lane * 4); s += v[i].x + v[i].y + v[i].z + v[i].w; }
        const float mu = wsum(s) * (1.f / 1024.f);
        float q = 0.f;
#pragma unroll
        for (int i = 0; i < 4; ++i) { v[i].x -= mu; v[i].y -= mu; v[i].z -= mu; v[i].w -= mu; q += v[i].x * v[i].x + v[i].y * v[i].y + v[i].z * v[i].z + v[i].w * v[i].w; }
        const float rstd = rsqrtf(wsum(q) * (1.f / 1024.f) + 1e-5f);
        const float* mv = modv + row_sel(row) * 6144;
#pragma unroll
        for (int i = 0; i < 4; ++i) {
            const int c = i * 256 + lane * 4;
            const float4 g = *(const float4*)(p.ln1g + l * 1024 + c), bb = *(const float4*)(p.ln1b + l * 1024 + c);
            const float4 sh = *(const float4*)(mv + 3072 + c), sc = *(const float4*)(mv + 4096 + c);
            float4 o;
            o.x = v[i].x * rstd * g.x + bb.x; o.y = v[i].y * rstd * g.y + bb.y; o.z = v[i].z * rstd * g.z + bb.z; o.w = v[i].w * rstd * g.w + bb.w;
            *(float4*)(x1 + (size_t)row * 1024 + c) = o;
            uint2 hh;
            hh.x = (unsigned)f2bf(o.x * (1.f + sc.x) + sh.x) | ((unsigned)f2bf(o.y * (1.f + sc.y) + sh.y) << 16);
            hh.y = (unsigned)f2bf(o.z * (1.f + sc.z) + sh.z) | ((unsigned)f2bf(o.w * (1.f + sc.w) + sh.w) << 16);
            *(uint2*)(hm + (size_t)row * 1024 + c) = hh;
        }
    }
}

DEVINL void ph_router(const P& p, int l, char* smem) {
    const int TIDX_ = tid_(); const int BIDX_ = bid_(); char* const WS_ = wsl_(p.ws); (void)TIDX_; (void)BIDX_; (void)WS_;
    const u16* hm = (const u16*)(WS_ + OFF_HM);
    const u16* wr = (const u16*)(WS_ + OFF_WR) + (size_t)l * 128 * 1024;
    float* lg = (float*)(WS_ + OFF_LOGITS);
    const int mt0 = (l == 0) ? 0 : 4;
    for (int u = BIDX_; u < 260 - mt0; u += gridDim.x) {
        const int mt = mt0 + u;
        const u16* A = hm + (size_t)mt * 128 * 1024;
        gemm128([&](int r) { return A + (size_t)r * 1024; }, wr, 1024, 1024, smem,
                [&](int m, int n, f32x4 a) {
                    if (n < 36) {
#pragma unroll
                        for (int j = 0; j < 4; ++j) lg[(size_t)(mt * 128 + m + j) * 64 + n] = a[j];
                    }
                });
    }
}

DEVINL void ph_route1(const P& p, int l, char* smem) {
    const int TIDX_ = tid_(); const int BIDX_ = bid_(); char* const WS_ = wsl_(p.ws); (void)TIDX_; (void)BIDX_; (void)WS_;
    const int tid = TIDX_;
    const float* lg = (const float*)(WS_ + OFF_LOGITS);
    int* toke = (int*)(WS_ + OFF_TOKE); float* tokw = (float*)(WS_ + OFF_TOKW);
    int* cnt = (int*)(WS_ + CTL_CNT) + l * 32;
    int* hist = (int*)smem;
    __syncthreads();
    if (tid < 32) hist[tid] = 0;
    __syncthreads();
    const int rstart = (l == 0) ? 0 : CTXROWS;
    for (int row = rstart + BIDX_ * 256 + tid; row < T; row += gridDim.x * 256) {
        const float* q = lg + (size_t)row * 64;
        float gl[4]; int gs = 0; float gm = -3.0e38f;
#pragma unroll
        for (int i = 0; i < 4; ++i) { gl[i] = q[i] + p.rgb[l * 4 + i]; if (gl[i] > gm) { gm = gl[i]; gs = i; } }
        float se = 0.f;
#pragma unroll
        for (int i = 0; i < 4; ++i) se += expf(gl[i] - gm);
        const float gw = 1.f / se;
        float v1 = -3.0e38f, v2 = -3.0e38f; int i1 = 0, i2 = 0;
#pragma unroll
        for (int i = 0; i < 8; ++i) {
            const float e = q[4 + gs * 8 + i] + p.reb[l * 32 + gs * 8 + i];
            if (e > v1) { v2 = v1; i2 = i1; v1 = e; i1 = i; }
            else if (e > v2) { v2 = e; i2 = i; }
        }
        const float e2 = expf(v2 - v1);
        const float w1 = gw / (1.f + e2), w2 = gw * e2 / (1.f + e2);
        const int ea = gs * 8 + i1, eb = gs * 8 + i2;
        toke[row * 2] = ea; toke[row * 2 + 1] = eb; tokw[row * 2] = w1; tokw[row * 2 + 1] = w2;
        atomicAdd(&hist[ea], 1); atomicAdd(&hist[eb], 1);
    }
    __syncthreads();
    if (tid < 32 && hist[tid] > 0) atomicAdd(&cnt[tid], hist[tid]);
}

DEVINL void ph_route2(const P& p, int l, char* smem) {
    const int TIDX_ = tid_(); const int BIDX_ = bid_(); char* const WS_ = wsl_(p.ws); (void)TIDX_; (void)BIDX_; (void)WS_;
    const int tid = TIDX_;
    const int* toke = (const int*)(WS_ + OFF_TOKE);
    int* toks = (int*)(WS_ + OFF_TOKS);
    int* slottok = (int*)(WS_ + OFF_SLOTTOK);
    const int* cnt = (const int*)(WS_ + CTL_CNT) + l * 32;
    int* cur = (int*)(WS_ + CTL_CUR) + l * 32;
    int* tiles = (int*)(WS_ + OFF_TILES);
    int* off = (int*)smem;
    int* hist = off + 64;
    int* base = hist + 32;
    __syncthreads();
    if (tid == 0) { int a = 0; for (int e = 0; e < 32; ++e) { off[e] = a; a += (cnt[e] + 127) & ~127; } off[32] = a; }
    if (tid < 32) hist[tid] = 0;
    __syncthreads();
    if (BIDX_ == 0) {
        if (tid == 0) {
            int nt = 0;
            for (int e = 0; e < 32; ++e) for (int s = off[e]; s < off[e + 1]; s += 128) { tiles[64 + nt * 2] = e; tiles[64 + nt * 2 + 1] = s; ++nt; }
            tiles[40] = nt;
        }
        for (int e = 0; e < 32; ++e) for (int s = off[e] + cnt[e] + tid; s < off[e + 1]; s += 256) slottok[s] = (l == 0) ? 0 : CTXROWS;
    }
    const int rstart = (l == 0) ? 0 : CTXROWS;
    for (int a0 = rstart * 2 + BIDX_ * 256; a0 < T * 2; a0 += gridDim.x * 256) {
        const int a = a0 + tid;
        int e = -1, lpos = 0;
        if (a < T * 2) { e = toke[a]; lpos = atomicAdd(&hist[e], 1); }
        __syncthreads();
        if (tid < 32) { base[tid] = hist[tid] > 0 ? atomicAdd(&cur[tid], hist[tid]) : 0; }
        __syncthreads();
        if (e >= 0) { const int s = off[e] + base[e] + lpos; toks[a] = s; slottok[s] = a >> 1; }
        __syncthreads();
        if (tid < 32) hist[tid] = 0;
        __syncthreads();
    }
}

DEVINL void ph_gateup(const P& p, char* smem) {
    const int TIDX_ = tid_(); const int BIDX_ = bid_(); char* const WS_ = wsl_(p.ws); (void)TIDX_; (void)BIDX_; (void)WS_;
    const int tid = TIDX_, lane = tid & 63, wid = tid >> 6, wr = wid >> 1, wc = wid & 1, fr = lane & 15, fq = lane >> 4;
    const u16* hm = (const u16*)(WS_ + OFF_HM);
    const u16* wgu = (const u16*)(WS_ + OFF_WGU);
    const int* tiles = (const int*)(WS_ + OFF_TILES);
    const int* slottok = (const int*)(WS_ + OFF_SLOTTOK);
    u16* act = (u16*)(WS_ + OFF_ACT);
    const int ntile = tiles[40] * 8;
    for (int u = BIDX_; u < ntile; u += gridDim.x) {
        const int ti = u >> 3, nt = u & 7;
        const int e = tiles[64 + ti * 2], s0 = tiles[64 + ti * 2 + 1];
        f32x4 acc[4][4];
        gemm128_acc([&](int r) { return hm + (size_t)slottok[s0 + r] * 1024; }, wgu + ((size_t)e * 1024 + nt * 128) * 1024, 1024, 1024, smem, acc);
#pragma unroll
        for (int m = 0; m < 4; ++m)
#pragma unroll
            for (int n = 0; n < 4; n += 2) {
                const int jcol = (nt * 128 + wc * 64 + n * 16) / 2 + fr;
                const int srow = s0 + wr * 64 + m * 16 + fq * 4;
#pragma unroll
                for (int j = 0; j < 4; ++j) {
                    const float gte = acc[m][n][j], up = acc[m][n + 1][j];
                    act[(size_t)(srow + j) * 512 + jcol] = f2bf(gte / (1.f + __expf(-gte)) * up);
                }
            }
    }
}

DEVINL void ph_down(const P& p, char* smem) {
    const int TIDX_ = tid_(); const int BIDX_ = bid_(); char* const WS_ = wsl_(p.ws); (void)TIDX_; (void)BIDX_; (void)WS_;
    const u16* act = (const u16*)(WS_ + OFF_ACT);
    const u16* wdn = (const u16*)(WS_ + OFF_WDN);
    const int* tiles = (const int*)(WS_ + OFF_TILES);
    u16* so = (u16*)(WS_ + OFF_SLOTOUT);
    const int ntile = tiles[40] * 8;
    for (int u = BIDX_; u < ntile; u += gridDim.x) {
        const int ti = u >> 3, nt = u & 7;
        const int e = tiles[64 + ti * 2], s0 = tiles[64 + ti * 2 + 1];
        const u16* A = act + (size_t)s0 * 512;
        gemm128([&](int r) { return A + (size_t)r * 512; }, wdn + ((size_t)e * 1024 + nt * 128) * 512, 512, 512, smem,
                [&](int m, int n, f32x4 a) {
                    u16* q = so + (size_t)(s0 + m) * 1024 + nt * 128 + n;
                    q[0] = f2bf(a[0]); q[1024] = f2bf(a[1]); q[2048] = f2bf(a[2]); q[3072] = f2bf(a[3]);
                });
    }
}

DEVINL void ph_ln2(const P& p, int l) {
    const int TIDX_ = tid_(); const int BIDX_ = bid_(); char* const WS_ = wsl_(p.ws); (void)TIDX_; (void)BIDX_; (void)WS_;
    const int lane = TIDX_ & 63, wid = TIDX_ >> 6;
    const float* modv = (const float*)(WS_ + OFF_MOD) + (size_t)l * 3 * 6144;
    const float* modn = (const float*)(WS_ + OFF_MOD) + (size_t)(l + 1) * 3 * 6144;
    const float* x1 = (const float*)(WS_ + OFF_X1);
    const u16* so = (const u16*)(WS_ + OFF_SLOTOUT);
    const int* toks = (const int*)(WS_ + OFF_TOKS);
    const float* tokw = (const float*)(WS_ + OFF_TOKW);
    float* x2c = (float*)(WS_ + OFF_X2CTX);
    u16* hm = (u16*)(WS_ + OFF_HM);
    const int rstart = (l == 0) ? 0 : CTXROWS;
    for (int row = rstart + BIDX_ * 4 + wid; row < T; row += gridDim.x * 4) {
        const int sa = toks[row * 2], sb = toks[row * 2 + 1];
        const float wa = tokw[row * 2], wb = tokw[row * 2 + 1];
        const float* mv = modv + row_sel(row) * 6144;
        float4 v[4];
        float s = 0.f;
#pragma unroll
        for (int i = 0; i < 4; ++i) {
            const int c = i * 256 + lane * 4;
            const float4 xv = *(const float4*)(x1 + (size_t)row * 1024 + c);
            const uint2 ua = *(const uint2*)(so + (size_t)sa * 1024 + c), ub = *(const uint2*)(so + (size_t)sb * 1024 + c);
            const float4 g2 = *(const float4*)(mv + 5120 + c);
            const float f0 = wa * bf2f((u16)(ua.x & 0xFFFF)) + wb * bf2f((u16)(ub.x & 0xFFFF));
            const float f1 = wa * bf2f((u16)(ua.x >> 16)) + wb * bf2f((u16)(ub.x >> 16));
            const float f2 = wa * bf2f((u16)(ua.y & 0xFFFF)) + wb * bf2f((u16)(ub.y & 0xFFFF));
            const float f3 = wa * bf2f((u16)(ua.y >> 16)) + wb * bf2f((u16)(ub.y >> 16));
            v[i].x = ALPHA * xv.x + g2.x * f0; v[i].y = ALPHA * xv.y + g2.y * f1; v[i].z = ALPHA * xv.z + g2.z * f2; v[i].w = ALPHA * xv.w + g2.w * f3;
            s += v[i].x + v[i].y + v[i].z + v[i].w;
        }
        const float mu = wsum(s) * (1.f / 1024.f);
        float q = 0.f;
#pragma unroll
        for (int i = 0; i < 4; ++i) { v[i].x -= mu; v[i].y -= mu; v[i].z -= mu; v[i].w -= mu; q += v[i].x * v[i].x + v[i].y * v[i].y + v[i].z * v[i].z + v[i].w * v[i].w; }
        const float rstd = rsqrtf(wsum(q) * (1.f / 1024.f) + 1e-5f);
        float* dst = row < CTXROWS ? x2c + (size_t)row * 1024 : p.out + (size_t)(row - CTXROWS) * 1024;
        const float* mn = modn + row_sel(row) * 6144;
#pragma unroll
        for (int i = 0; i < 4; ++i) {
            const int c = i * 256 + lane * 4;
            const float4 g = *(const float4*)(p.ln2g + l * 1024 + c), bb = *(const float4*)(p.ln2b + l * 1024 + c);
            float4 o;
            o.x = v[i].x * rstd * g.x + bb.x; o.y = v[i].y * rstd * g.y + bb.y; o.z = v[i].z * rstd * g.z + bb.z; o.w = v[i].w * rstd * g.w + bb.w;
            *(float4*)(dst + c) = o;
            if (l == 0) {
                const float4 sh = *(const float4*)(mn + c), sc = *(const float4*)(mn + 1024 + c);
                uint2 hh;
                hh.x = (unsigned)f2bf(o.x * (1.f + sc.x) + sh.x) | ((unsigned)f2bf(o.y * (1.f + sc.y) + sh.y) << 16);
                hh.y = (unsigned)f2bf(o.z * (1.f + sc.z) + sh.z) | ((unsigned)f2bf(o.w * (1.f + sc.w) + sh.w) << 16);
                *(uint2*)(hm + (size_t)row * 1024 + c) = hh;
            }
        }
    }
}

DEVINL void gbar(XcdBarrier b) {
    unsigned x = b.x; GAS unsigned* q = (GAS unsigned*)b.bar;
    asm volatile("" : "+s"(x), "+s"(q));
    b.x = x; b.bar = (unsigned*)q;
    xcd_barrier(b);
}
#ifndef PROBE
#define PROBE 0
#endif
#ifndef TPROBE
#define TPROBE 0
#endif
__global__ void __launch_bounds__(256, 2) k_mega(P p) {
    __shared__ __attribute__((aligned(16))) char smem[65536 + 16 + 16];
    if (threadIdx.x == 0) *(uint4*)(smem + 65536) = make_uint4(0u, 0u, 0u, 0u);
    __syncthreads();
    XcdBarrier bar = xcd_barrier_post((unsigned*)p.ws, (volatile LAS unsigned*)(smem + 65536));
    const int bid = blockIdx.x, nb = gridDim.x;
#if TPROBE
    unsigned long long tp_acc = 0, tp_last = wall_clock64();
#define TP(g) do { const unsigned long long _n = wall_clock64(); if ((g) == TPROBE) tp_acc += _n - tp_last; tp_last = _n; } while (0)
#else
#define TP(g) do { } while (0)
#endif
    if (threadIdx.x == 0) {
        const unsigned key = ((unsigned)__builtin_amdgcn_s_getreg((3 << 11) | 20) << 8) | ((unsigned)__builtin_amdgcn_s_getreg((7 << 11) | (8 << 6) | 4) & 0xFFu);
        ((unsigned*)(p.ws + CTL_CUKEY))[blockIdx.x] = key | 0x80000000u;
    }
    ph_prolog(p, smem);
    ph_convw(p, 0, smem);
    gbar(bar);
    TP(1);
    ph_xm0(p);
    gbar(bar);
    TP(1);
    bool quiet; int wrank, nwork;
    {
        const unsigned* keys = (const unsigned*)(p.ws + CTL_CUKEY);
        int* cnt = (int*)smem;
        if (threadIdx.x < 2) cnt[threadIdx.x] = 0;
        __syncthreads();
        for (int i = 8 + threadIdx.x; i < nb; i += 256) {
            const unsigned k = keys[i];
            bool qq = false;
            for (int j = 0; j < 8 && j < nb; ++j) qq = qq || (keys[j] == k);
            if (qq) { atomicAdd(&cnt[1], 1); if (i < bid) atomicAdd(&cnt[0], 1); }
        }
        __syncthreads();
        const int below = cnt[0], total = cnt[1];
        bool me = false;
        if (bid >= 8) { const unsigned k = keys[bid]; for (int j = 0; j < 8 && j < nb; ++j) me = me || (keys[j] == k); }
        __syncthreads();
        if (total > 16) { quiet = false; wrank = bid - 8; nwork = nb - 8; }
        else { quiet = me; wrank = bid - 8 - below; nwork = nb - 8 - total; }
    }
#pragma unroll 1
    for (int l = 0; l < NLAYER; ++l) {
        ph_inproj(p, smem);
        gbar(bar);
    TP(2);
        ph_rwprep(p, l, 0, smem, bid, nb);
        gbar(bar);
    TP(3);
        if (bid < 8) ph_rwscan(p, l, 0, bid, 8, smem);
        else if (!quiet) { ph_prepM(p, l, smem, wrank, nwork); ph_na(p, l, smem, wrank, nwork); }
        gbar(bar);
    TP(4);
        ph_mlB(p, bid, nb, smem);
        gbar(bar);
        ph_rwprep(p, l, 1, smem, bid, nb);
        gbar(bar);
    TP(5);
        if (bid < 8) ph_rwscan(p, l, 1, bid, 8, smem);
        else if (!quiet) { ph_mlC(p, l, smem, wrank, nwork); ph_convexp(p, l, smem, wrank, nwork); }
        gbar(bar);
    TP(6);
        ph_rwout(p, l);
        gbar(bar);
    TP(7);
        ph_outproj(p, l, smem);
        gbar(bar);
    TP(8);
        ph_ln1(p, l);
        gbar(bar);
    TP(9);
        ph_router(p, l, smem);
        gbar(bar);
    TP(9);
        ph_route1(p, l, smem);
        gbar(bar);
    TP(9);
        ph_route2(p, l, smem);
        gbar(bar);
    TP(9);
        ph_gateup(p, smem);
        gbar(bar);
    TP(10);
        ph_down(p, smem);
        gbar(bar);
    TP(11);
        ph_ln2(p, l);
        if (l + 1 < NLAYER) ph_convw(p, l + 1, smem);
        gbar(bar);
    TP(12);
    }
#if TPROBE
    if (bid == 0 && threadIdx.x == 0) { const unsigned long long t_end = wall_clock64() + tp_acc; while (wall_clock64() < t_end) __builtin_amdgcn_s_sleep(8); }
    __syncthreads();
    gbar(bar);
#endif
}


extern "C" void kernel_launch(void* const* d_in, const int* in_sizes, int n_in, void* d_out, int out_size, void* d_ws, size_t ws_size,
                              hipStream_t stream) {
    if (n_in != 37 || ws_size < WS_NEED) { fprintf(stderr, "kernel_launch: n_in %d ws %zu need %zu\n", n_in, ws_size, (size_t)WS_NEED); return; }
    static int grid = 0;
    if (!grid) {
        int dev = 0, cus = 0, per_cu = 0;
        (void)hipGetDevice(&dev);
        (void)hipDeviceGetAttribute(&cus, hipDeviceAttributeMultiprocessorCount, dev);
        (void)hipOccupancyMaxActiveBlocksPerMultiprocessor(&per_cu, (const void*)k_mega, 256, 0);
        if (per_cu < 1) per_cu = 1;
        grid = cus * (per_cu < 2 ? per_cu : 2);
    }
    P p{};
    const float** pp = (const float**)&p;
    for (int i = 0; i < 37; ++i) pp[i] = (const float*)d_in[i];
    p.out = (float*)d_out; p.ws = (char*)d_ws;
    (void)hipMemsetAsync(d_ws, 0, CTL_BYTES, stream);
    k_mega<<<dim3(grid), dim3(256), 0, stream>>>(p);
}
```

```cpp
#include <hip/hip_runtime.h>
#include <hip/hip_bf16.h>
#include <stdint.h>
#include <stdio.h>
#include <type_traits>

#define DEVINL __device__ __forceinline__
typedef unsigned short u16;
using bf16x8 = __attribute__((ext_vector_type(8))) short;
using f32x4 = __attribute__((ext_vector_type(4))) float;

constexpr int D = 1024, LAT = 16384, LCTX = 256, T = 33280, CTXROWS = 512;
constexpr int INP = 3536;
constexpr int NLAYER = 2;
constexpr float ALPHA = 1.41421356237309515f;
constexpr int NUNIT_CH = 520;
constexpr int NTC = 260;
constexpr int MAXSLOT = 70656;

constexpr size_t al(size_t x) { return (x + 255) & ~(size_t)255; }
constexpr size_t CTL_CNT = 16384;
constexpr size_t CTL_CUR = CTL_CNT + 256;
constexpr size_t CTL_CUKEY = 20480;
constexpr size_t CTL_BYTES = 32768;
constexpr size_t OFF_MOD = CTL_BYTES;
constexpr size_t OFF_ROPE = OFF_MOD + al(2 * 3 * 6144 * 4);
constexpr size_t OFF_WR = OFF_ROPE + al(10240 * 4);
constexpr size_t OFF_LORA = OFF_WR + al(2 * 128 * 1024 * 2);
constexpr size_t OFF_TILES = OFF_LORA + al(3 * 65536);
constexpr size_t OFF_TOKE = OFF_TILES + al((64 + 2048) * 4);
constexpr size_t OFF_TOKW = OFF_TOKE + al((size_t)T * 2 * 4);
constexpr size_t OFF_TOKS = OFF_TOKW + al((size_t)T * 2 * 4);
constexpr size_t OFF_SLOTTOK = OFF_TOKS + al((size_t)T * 2 * 4);
constexpr size_t OFF_X2CTX = OFF_SLOTTOK + al((size_t)MAXSLOT * 4);
constexpr size_t OFF_WIN = OFF_X2CTX + al((size_t)512 * 1024 * 4);
constexpr size_t OFF_WOUT = OFF_WIN + al((size_t)3584 * 1024 * 2);
constexpr size_t OFF_X1 = OFF_WOUT + al((size_t)1024 * 1024 * 2);
constexpr size_t OFF_HM = OFF_X1 + al((size_t)T * 1024 * 4);
constexpr size_t OFF_P = OFF_HM + al((size_t)T * 1024 * 2);
constexpr size_t OFF_PQK = OFF_P;
constexpr size_t OFF_VTL = OFF_PQK + (size_t)T * 1024 * 2;
constexpr size_t OFF_VTC = OFF_VTL + (size_t)2 * 8 * 64 * 16384 * 2;
constexpr size_t OFF_PB = OFF_VTC + (size_t)2 * 8 * 64 * 256 * 2;
constexpr size_t OFF_PC = OFF_PB + (size_t)T * 960 * 2;
constexpr size_t OFF_Y = OFF_PC + (size_t)T * 1040 * 2;
constexpr size_t OFF_MLF = OFF_Y + (size_t)T * 1024 * 2;
constexpr size_t OFF_GATE = OFF_MLF + (size_t)T * 512 * 2;
constexpr size_t OFF_MLG = OFF_GATE + (size_t)T * 256 * 2;
constexpr size_t OFF_MLS = OFF_MLG + (size_t)T * 16 * 4;
constexpr size_t OFF_MST = OFF_MLS + al(16 * 260 * 2 * 4);
constexpr size_t OFF_NST = OFF_MST + al(16 * 260 * 4);
constexpr size_t OFF_CST2 = OFF_NST + al(16 * 260 * 64 * 4);
constexpr size_t OFF_NST2 = OFF_CST2 + (size_t)16 * 260 * 4096 * 2;
constexpr size_t OFF_END1 = OFF_NST2 + al(16 * 260 * 64 * 4);
constexpr size_t OFF_WGU = OFF_P;
constexpr size_t OFF_WDN = OFF_WGU + (size_t)32 * 1024 * 1024 * 2;
constexpr size_t OFF_ACT = OFF_WDN + (size_t)32 * 1024 * 512 * 2;
constexpr size_t OFF_SLOTOUT = OFF_ACT + (size_t)MAXSLOT * 512 * 2;
constexpr size_t OFF_LOGITS = OFF_SLOTOUT + (size_t)MAXSLOT * 1024 * 2;
constexpr size_t OFF_END2 = OFF_LOGITS + (size_t)T * 64 * 4;
constexpr size_t WS_NEED = OFF_END1 > OFF_END2 ? OFF_END1 : OFF_END2;
static_assert(OFF_WDN <= OFF_Y, "Wexp must not overlap y");
static_assert(OFF_LOGITS >= OFF_MLF, "logits placement");

struct P {
    const float *x, *c, *ctx, *c_ctx, *w_mod, *b_mod, *w_in, *na_rpb, *mu_prev, *mu_next, *rw_w0, *rw_w2, *rw_a0, *rw_a2,
        *rw_g2, *rw_kk, *rw_ka, *rw_rk, *rw_lnw, *rw_lnb, *ml_cw, *ml_cb, *ml_ib, *ml_fb, *ml_nw, *w_out, *ln1g, *ln1b,
        *rgw, *rgb, *rew, *reb, *egate, *eup, *edown, *ln2g, *ln2b;
    float* out;
    char* ws;
};

#define XB_TMO      128
#define XB_XCNT(j)  (256  + 64 * (j))
#define XB_XSUB(j)  (1280 + 64 * (j))
#define XB_XGEN(j)  (2304 + 64 * (j))
#define XB_TOP      3328
#define XB_TOPGEN   3392
#define XCD_BAR_WORDS 3456
#define XB_SPIN_CAP (1u << 18)
#define LAS __attribute__((address_space(3)))

__device__ __forceinline__ unsigned xb_ld(unsigned* p)              { return __hip_atomic_load(p, __ATOMIC_RELAXED, __HIP_MEMORY_SCOPE_AGENT); }
__device__ __forceinline__ unsigned xb_add(unsigned* p, unsigned v) { return __hip_atomic_fetch_add(p, v, __ATOMIC_RELAXED, __HIP_MEMORY_SCOPE_AGENT); }
__device__ __forceinline__ unsigned xb_xcc_id() { return (unsigned)__builtin_amdgcn_s_getreg((3 << 11) | 20) & 0xFu; }
#define XB_SPIN(cond, bar) do { unsigned _sp = 0; while (cond) { __builtin_amdgcn_s_sleep(1); \
    if ((++_sp & 255u) == 0u) { if (xb_ld(&(bar)[XB_TMO])) break; if (_sp > XB_SPIN_CAP) { atomicAdd(&(bar)[XB_TMO], 1u); break; } } } } while (0)

struct XcdBarrier {
    unsigned* bar; unsigned x;
    volatile LAS unsigned* st;
};

__device__ __forceinline__ XcdBarrier xcd_barrier_post(unsigned* bar, volatile LAS unsigned* st) {
    XcdBarrier b; b.bar = bar; b.x = xb_xcc_id(); b.st = st;
    if (threadIdx.x == 0) (void)xb_add(&bar[XB_XCNT(b.x)], 1u);
    return b;
}
__device__ __forceinline__ void xcd_barrier_complete(unsigned* bar, unsigned x, unsigned& nloc, unsigned& nx) {
    const unsigned G = gridDim.x * gridDim.y * gridDim.z;
    unsigned sum, cnt, mine, sp = 0u;
    for (;;) {
        sum = 0u; cnt = 0u; mine = 0u;
#pragma unroll
        for (unsigned j = 0; j < 16; ++j) { const unsigned c = xb_ld(&bar[XB_XCNT(j)]); sum += c; cnt += (c > 0u) ? 1u : 0u; mine = (j == x) ? c : mine; }
        if (sum == G) break;
        __builtin_amdgcn_s_sleep(1);
        if ((++sp & 255u) == 0u) { if (xb_ld(&bar[XB_TMO])) break; if (sp > XB_SPIN_CAP) { atomicAdd(&bar[XB_TMO], 1u); break; } }
    }
    nloc = mine > 0u ? mine : 1u; nx = cnt > 0u ? cnt : 1u;
}

__device__ __forceinline__ void xcd_barrier(const XcdBarrier& b) {
    asm volatile("s_waitcnt vmcnt(0)" ::: "memory");
    __syncthreads();
    if (threadIdx.x == 0) {
        unsigned* bar = b.bar;
        __builtin_amdgcn_s_waitcnt(0);
        unsigned nloc = b.st[0], nx = b.st[1];
        if (nloc == 0u) { xcd_barrier_complete(bar, b.x, nloc, nx); b.st[0] = nloc; b.st[1] = nx; }
        const unsigned old = xb_add(&bar[XB_XSUB(b.x)], 1u);
        const unsigned gen = old / nloc;
        if (old + 1u == (gen + 1u) * nloc) {
            __builtin_amdgcn_fence(__ATOMIC_RELEASE, "agent");
            asm volatile("s_waitcnt vmcnt(0)" ::: "memory");
            const unsigned og = xb_add(&bar[XB_TOP], 1u);
            const unsigned tg = og / nx;
            if (og + 1u == (tg + 1u) * nx) xb_add(&bar[XB_TOPGEN], 1u);
            else XB_SPIN(xb_ld(&bar[XB_TOPGEN]) == tg, bar);
            __builtin_amdgcn_fence(__ATOMIC_ACQUIRE, "agent");
            xb_add(&bar[XB_XGEN(b.x)], 1u);
            asm volatile("s_waitcnt vmcnt(0)" ::: "memory");
        } else {
            XB_SPIN(xb_ld(&bar[XB_XGEN(b.x)]) == gen, bar);
            __builtin_amdgcn_fence(__ATOMIC_ACQUIRE, "agent");
            asm volatile("s_waitcnt vmcnt(0)" ::: "memory");
        }
    }
    __syncthreads();
}


DEVINL int tid_() { int t = threadIdx.x; asm volatile("" : "+v"(t)); return t; }
DEVINL int bid_() { int b = blockIdx.x; asm volatile("" : "+s"(b)); return b; }
#define GAS __attribute__((address_space(1)))
DEVINL char* wsl_(char* w) { GAS char* g = (GAS char*)w; asm volatile("" : "+s"(g)); return (char*)g; }
template <class Tp> DEVINL const Tp* gl_(const Tp* q) { const GAS Tp* g = (const GAS Tp*)q; asm volatile("" : "+s"(g)); return (const Tp*)g; }
typedef float f32x2_t __attribute__((ext_vector_type(2)));
typedef __bf16 bf16x2_t __attribute__((ext_vector_type(2)));
DEVINL unsigned pk2bf(float lo, float hi) { f32x2_t f = {lo, hi}; bf16x2_t b = __builtin_convertvector(f, bf16x2_t); return __builtin_bit_cast(unsigned, b); }
DEVINL u16 f2bf(float f) { return (u16)(pk2bf(f, f) & 0xFFFFu); }
DEVINL float bf2f(u16 h) { return __uint_as_float(((unsigned)h) << 16); }
DEVINL float wsum(float v) { for (int o = 32; o > 0; o >>= 1) v += __shfl_xor(v, o); return v; }
DEVINL float sigmoidf_(float x) { return 1.f / (1.f + __expf(-x)); }
DEVINL float siluf_(float x) { return x / (1.f + __expf(-x)); }
DEVINL float softplusf_(float x) { return fmaxf(x, 0.f) + log1pf(__expf(-fabsf(x))); }
DEVINL int row_sel(int row) { return row < CTXROWS ? 2 : ((row - CTXROWS) >> 14); }
template <int CTRL, int RM>
DEVINL float dpp_f(float v) { return __int_as_float(__builtin_amdgcn_update_dpp(0, __float_as_int(v), CTRL, RM, 0xF, false)); }
DEVINL float wave_sum_dpp(float v) {
    v += dpp_f<0xB1, 0xF>(v);
    v += dpp_f<0x4E, 0xF>(v);
    v += dpp_f<0x141, 0xF>(v);
    v += dpp_f<0x140, 0xF>(v);
    v += dpp_f<0x142, 0xA>(v);
    v += dpp_f<0x143, 0xC>(v);
    return __int_as_float(__builtin_amdgcn_readlane(__float_as_int(v), 63));
}
DEVINL unsigned lds_addr(const void* p) { return (unsigned)(size_t)(const __attribute__((address_space(3))) char*)p; }
using u32x4 = __attribute__((ext_vector_type(4))) unsigned;
using u32x2 = __attribute__((ext_vector_type(2))) unsigned;
template <int OFF> DEVINL u32x4 lds_rd128(unsigned a) { u32x4 v; asm volatile("ds_read_b128 %0, %1 offset:%2" : "=v"(v) : "v"(a), "n"(OFF)); return v; }
template <int OFF> DEVINL u32x2 lds_rd64(unsigned a) { u32x2 v; asm volatile("ds_read_b64 %0, %1 offset:%2" : "=v"(v) : "v"(a), "n"(OFF)); return v; }
DEVINL void glds4(const void* g, void* l) {
    __builtin_amdgcn_global_load_lds((const __attribute__((address_space(1))) void*)g, (__attribute__((address_space(3))) void*)l, 4, 0, 0);
}
DEVINL void glds16nt(const void* g, void* l) {
    __builtin_amdgcn_global_load_lds((const __attribute__((address_space(1))) void*)g, (__attribute__((address_space(3))) void*)l, 16, 0, 2);
}
DEVINL void glds16(const void* g, void* l) {
    __builtin_amdgcn_global_load_lds((const __attribute__((address_space(1))) void*)g, (__attribute__((address_space(3))) void*)l, 16, 0, 0);
}

template <class RowA>
DEVINL void gemm128_acc(RowA rowA, const u16* __restrict__ Bt, int ldb, int K, char* smem, f32x4 (&acc)[4][4]) {
    const int tid = tid_(), lane = tid & 63, wid = tid >> 6, wr = wid >> 1, wc = wid & 1, fr = lane & 15, fq = lane >> 4;
#pragma unroll
    for (int m = 0; m < 4; ++m)
#pragma unroll
        for (int n = 0; n < 4; ++n) acc[m][n] = f32x4{0.f, 0.f, 0.f, 0.f};
    const int sc = ((tid & 7) ^ ((tid >> 3) & 7)) * 8;
    const u16* aS[4]; const u16* bS[4];
#pragma unroll
    for (int i = 0; i < 4; ++i) { const int r = (tid >> 3) + 32 * i; aS[i] = rowA(r) + sc; bS[i] = Bt + (size_t)r * ldb + sc; }
    const int nt = K >> 6;
    __syncthreads();
#pragma unroll
    for (int i = 0; i < 4; ++i) { glds16(aS[i], smem + (tid + 256 * i) * 16); glds16(bS[i], smem + 16384 + (tid + 256 * i) * 16); }
    for (int t = 0; t < nt; ++t) {
        asm volatile("s_waitcnt vmcnt(0)" ::: "memory");
        __builtin_amdgcn_s_barrier();
        if (t + 1 < nt) {
            char* SA = smem + ((t + 1) & 1) * 32768;
            const int ko = (t + 1) * 64;
#pragma unroll
            for (int i = 0; i < 4; ++i) { glds16(aS[i] + ko, SA + (tid + 256 * i) * 16); glds16(bS[i] + ko, SA + 16384 + (tid + 256 * i) * 16); }
        }
        const char* SA = smem + (t & 1) * 32768; const char* SB = SA + 16384;
#pragma unroll
        for (int ks = 0; ks < 2; ++ks) {
            const int pos = ((ks * 4 + fq) ^ (fr & 7)) * 16;
            bf16x8 af[4], bfr[4];
#pragma unroll
            for (int m = 0; m < 4; ++m) af[m] = *(const bf16x8*)(SA + (wr * 64 + m * 16 + fr) * 128 + pos);
#pragma unroll
            for (int n = 0; n < 4; ++n) bfr[n] = *(const bf16x8*)(SB + (wc * 64 + n * 16 + fr) * 128 + pos);
#pragma unroll
            for (int m = 0; m < 4; ++m)
#pragma unroll
                for (int n = 0; n < 4; ++n) acc[m][n] = __builtin_amdgcn_mfma_f32_16x16x32_bf16(af[m], bfr[n], acc[m][n], 0, 0, 0);
        }
    }
}
template <class RowA, class Epi>
DEVINL void gemm128(RowA rowA, const u16* __restrict__ Bt, int ldb, int K, char* smem, Epi epi) {
    const int tid = tid_(), lane = tid & 63, wid = tid >> 6, wr = wid >> 1, wc = wid & 1, fr = lane & 15, fq = lane >> 4;
    f32x4 acc[4][4];
    gemm128_acc(rowA, Bt, ldb, K, smem, acc);
#pragma unroll
    for (int m = 0; m < 4; ++m)
#pragma unroll
        for (int n = 0; n < 4; ++n) epi(wr * 64 + m * 16 + fq * 4, wc * 64 + n * 16 + fr, acc[m][n]);
}

DEVINL void ph_prolog(const P& p, char* smem) {
    const int TIDX_ = tid_(); const int BIDX_ = bid_(); char* const WS_ = wsl_(p.ws); (void)TIDX_; (void)BIDX_; (void)WS_;
    const int tid = TIDX_;
    float* modv = (float*)(WS_ + OFF_MOD);
    float* sil = (float*)smem;
    float* red = sil + 3072;
    bool ready = false;
    for (int u = BIDX_; u < 192; u += gridDim.x) {
        if (!ready) {
            for (int i = tid; i < 3072; i += 256) { int v = i >> 10, k = i & 1023; float cv = v < 2 ? p.c[v * 1024 + k] : p.c_ctx[k]; sil[i] = cv / (1.f + expf(-cv)); }
            ready = true;
        }
        __syncthreads();
        const int l = u / 96, cg = u % 96;
        const float* W = p.w_mod + (size_t)l * 1024 * 6144 + cg * 64;
        const int c4 = (tid & 15) * 4, rg = tid >> 4;
        float a0[4] = {0, 0, 0, 0}, a1[4] = {0, 0, 0, 0}, a2[4] = {0, 0, 0, 0};
#pragma unroll 4
        for (int i = 0; i < 64; ++i) {
            const int k = rg + 16 * i;
            const float4 w = *(const float4*)(W + (size_t)k * 6144 + c4);
            const float s0 = sil[k], s1 = sil[1024 + k], s2 = sil[2048 + k];
            a0[0] += s0 * w.x; a0[1] += s0 * w.y; a0[2] += s0 * w.z; a0[3] += s0 * w.w;
            a1[0] += s1 * w.x; a1[1] += s1 * w.y; a1[2] += s1 * w.z; a1[3] += s1 * w.w;
            a2[0] += s2 * w.x; a2[1] += s2 * w.y; a2[2] += s2 * w.z; a2[3] += s2 * w.w;
        }
#pragma unroll
        for (int j = 0; j < 4; ++j) { red[(rg * 3 + 0) * 64 + c4 + j] = a0[j]; red[(rg * 3 + 1) * 64 + c4 + j] = a1[j]; red[(rg * 3 + 2) * 64 + c4 + j] = a2[j]; }
        __syncthreads();
        if (tid < 192) {
            const int v = tid >> 6, cc = tid & 63;
            float s = 0.f;
            for (int r = 0; r < 16; ++r) s += red[(r * 3 + v) * 64 + cc];
            const int col = cg * 64 + cc;
            modv[(l * 3 + v) * 6144 + col] = s + p.b_mod[l * 6144 + col];
        }
        __syncthreads();
    }
    float* rope = (float*)(WS_ + OFF_ROPE);
    for (int i = BIDX_ * 256 + tid; i < 320 * 16; i += gridDim.x * 256) {
        const int pos = (i < 4096) ? (i >> 4) : ((i - 4096) >> 4);
        const int f = i & 15;
        const float inv = powf(10000.0f, -(float)f / 16.0f);
        const float ang = (float)pos * inv;
        const double TWO_PI = 6.283185307179586476925;
        double a = (double)ang;
        a -= TWO_PI * rint(a / TWO_PI);
        const float cr = (float)cos(a), sr = (float)sin(a);
        if (i < 4096) { rope[i] = cr; rope[4096 + i] = sr; }
        else { rope[8192 + (i - 4096)] = cr; rope[8192 + 1024 + (i - 4096)] = sr; }
    }
    {
        u16* w2t = (u16*)(WS_ + OFF_LORA); u16* a2t = w2t + 2 * 2 * 256 * 32; u16* g2t = a2t + 2 * 2 * 256 * 32;
        for (int i = BIDX_ * 256 + tid; i < 2 * 2 * 256 * 32; i += gridDim.x * 256) {
            const int lz = i >> 13, c = (i >> 5) & 255, r = i & 31;
            w2t[i] = f2bf(p.rw_w2[((size_t)lz * 32 + r) * 256 + c]);
            a2t[i] = f2bf(p.rw_a2[((size_t)lz * 32 + r) * 256 + c]);
        }
        for (int i = BIDX_ * 256 + tid; i < 2 * 256 * 64; i += gridDim.x * 256) {
            const int l = i >> 14, c = (i >> 6) & 255, r = i & 63;
            g2t[i] = f2bf(p.rw_g2[((size_t)l * 64 + r) * 256 + c]);
        }
    }
    u16* wr = (u16*)(WS_ + OFF_WR);
    for (int i = BIDX_ * 256 + tid; i < 2 * 128 * 1024; i += gridDim.x * 256) {
        const int l = i >> 17, n = (i >> 10) & 127, k = i & 1023;
        float v = 0.f;
        if (n < 4) v = p.rgw[((size_t)l * 1024 + k) * 4 + n];
        else if (n < 36) v = p.rew[((size_t)l * 1024 + k) * 32 + (n - 4)];
        wr[i] = f2bf(v);
    }
}

DEVINL void conv_tile(const float* __restrict__ src, int N, int K, u16* __restrict__ dst, int k0, int n0, int mode, char* smem) {
    unsigned* t = (unsigned*)smem;
    const int tid = tid_();
    const int n4 = (tid & 15) * 4;
    const bool ok = n0 + n4 < N;
    float4 va[2], vb[2];
    __syncthreads();
#pragma unroll
    for (int i = 0; i < 2; ++i) {
        const int kp = i * 16 + (tid >> 4);
        const float* s0 = src + (size_t)(k0 + 2 * kp) * N + n0 + n4;
        va[i] = ok ? *(const float4*)s0 : make_float4(0.f, 0.f, 0.f, 0.f);
        vb[i] = ok ? *(const float4*)(s0 + N) : make_float4(0.f, 0.f, 0.f, 0.f);
    }
#pragma unroll
    for (int i = 0; i < 2; ++i) {
        const int kp = i * 16 + (tid >> 4);
        t[(n4 + 0) * 33 + kp] = pk2bf(va[i].x, vb[i].x);
        t[(n4 + 1) * 33 + kp] = pk2bf(va[i].y, vb[i].y);
        t[(n4 + 2) * 33 + kp] = pk2bf(va[i].z, vb[i].z);
        t[(n4 + 3) * 33 + kp] = pk2bf(va[i].w, vb[i].w);
    }
    __syncthreads();
    {
        const int n = tid >> 2, w0 = (tid & 3) * 8;
        const int ng = n0 + n;
        int nd = ng;
        if (mode == 1) nd = 32 * (ng >> 4) + (ng & 15);
        else if (mode == 2) nd = 32 * (ng >> 4) + 16 + (ng & 15);
        uint4 o0, o1;
        o0.x = t[n * 33 + w0 + 0]; o0.y = t[n * 33 + w0 + 1]; o0.z = t[n * 33 + w0 + 2]; o0.w = t[n * 33 + w0 + 3];
        o1.x = t[n * 33 + w0 + 4]; o1.y = t[n * 33 + w0 + 5]; o1.z = t[n * 33 + w0 + 6]; o1.w = t[n * 33 + w0 + 7];
        u16* q = dst + (size_t)nd * K + k0 + w0 * 2;
        *(uint4*)q = o0; *(uint4*)(q + 8) = o1;
    }
}
DEVINL void ph_convw(const P& p, int l, char* smem) {
    const int TIDX_ = tid_(); const int BIDX_ = bid_(); char* const WS_ = wsl_(p.ws); (void)TIDX_; (void)BIDX_; (void)WS_;
    u16* win = (u16*)(WS_ + OFF_WIN); u16* wout = (u16*)(WS_ + OFF_WOUT);
    for (int u = BIDX_; u < 896 + 256; u += gridDim.x) {
        if (u < 896) conv_tile(p.w_in + (size_t)l * 1024 * INP, INP, 1024, win, (u / 56) * 64, (u % 56) * 64, 0, smem);
        else { const int v = u - 896; conv_tile(p.w_out + (size_t)l * 1024 * 1024, 1024, 1024, wout, (v / 16) * 64, (v % 16) * 64, 0, smem); }
    }
}
DEVINL void ph_convexp(const P& p, int l, char* smem, int bid, int nb) {
    const int TIDX_ = tid_(); const int BIDX_ = bid_(); char* const WS_ = wsl_(p.ws); (void)TIDX_; (void)BIDX_; (void)WS_;
    u16* wgu = (u16*)(WS_ + OFF_WGU); u16* wdn = (u16*)(WS_ + OFF_WDN);
    for (int u = bid; u < 32 * 384; u += nb) {
        const int e = u / 384, v = u % 384;
        const size_t le = (size_t)l * 32 + e;
        if (v < 128) conv_tile(p.egate + le * 1024 * 512, 512, 1024, wgu + (size_t)e * 1024 * 1024, (v / 8) * 64, (v % 8) * 64, 1, smem);
        else if (v < 256) { const int w = v - 128; conv_tile(p.eup + le * 1024 * 512, 512, 1024, wgu + (size_t)e * 1024 * 1024, (w / 8) * 64, (w % 8) * 64, 2, smem); }
        else { const int w = v - 256; conv_tile(p.edown + le * 512 * 1024, 1024, 512, wdn + (size_t)e * 1024 * 512, (w / 16) * 64, (w % 16) * 64, 0, smem); }
    }
}

DEVINL void ph_xm0(const P& p) {
    const int TIDX_ = tid_(); const int BIDX_ = bid_(); char* const WS_ = wsl_(p.ws); (void)TIDX_; (void)BIDX_; (void)WS_;
    const float* modv = (const float*)(WS_ + OFF_MOD);
    u16* hm = (u16*)(WS_ + OFF_HM);
    for (size_t i = (size_t)BIDX_ * 256 + TIDX_; i < (size_t)T * 256; i += (size_t)gridDim.x * 256) {
        const int row = (int)(i >> 8), c4 = (int)(i & 255) * 4;
        const float* src = row < CTXROWS ? p.ctx + (size_t)row * 1024 : p.x + (size_t)(row - CTXROWS) * 1024;
        const float* mv = modv + row_sel(row) * 6144;
        const float4 v = *(const float4*)(src + c4);
        const float4 sh = *(const float4*)(mv + c4), sc = *(const float4*)(mv + 1024 + c4);
        uint2 o;
        o.x = (unsigned)f2bf(v.x * (1.f + sc.x) + sh.x) | ((unsigned)f2bf(v.y * (1.f + sc.y) + sh.y) << 16);
        o.y = (unsigned)f2bf(v.z * (1.f + sc.z) + sh.z) | ((unsigned)f2bf(v.w * (1.f + sc.w) + sh.w) << 16);
        *(uint2*)(hm + (size_t)row * 1024 + c4) = o;
    }
}

DEVINL void ph_inproj(const P& p, char* smem) {
    const int TIDX_ = tid_(); const int BIDX_ = bid_(); char* const WS_ = wsl_(p.ws); (void)TIDX_; (void)BIDX_; (void)WS_;
    const u16* hm = (const u16*)(WS_ + OFF_HM);
    const u16* win = (const u16*)(WS_ + OFF_WIN);
    u16* pqk = (u16*)(WS_ + OFF_PQK); u16* vtl = (u16*)(WS_ + OFF_VTL); u16* vtc = (u16*)(WS_ + OFF_VTC);
    u16* pb = (u16*)(WS_ + OFF_PB); u16* pc = (u16*)(WS_ + OFF_PC);
    for (int u = BIDX_; u < 260 * 28; u += gridDim.x) {
        const int mt = u / 28, nt = u % 28;
        const u16* A = hm + (size_t)mt * 128 * 1024;
        gemm128([&](int r) { return A + (size_t)r * 1024; }, win + (size_t)nt * 128 * 1024, 1024, 1024, smem,
                [&](int m, int n, f32x4 a) {
                    const int R = mt * 128 + m, N = nt * 128 + n;
                    if (N >= INP) return;
                    const u16 h0 = f2bf(a[0]), h1 = f2bf(a[1]), h2 = f2bf(a[2]), h3 = f2bf(a[3]);
                    if (N < 1024) {
                        u16* q = pqk + (size_t)R * 1024 + N; q[0] = h0; q[1024] = h1; q[2048] = h2; q[3072] = h3;
                    } else if (N < 1536) {
                        const int hh = (N - 1024) >> 6, d = (N - 1024) & 63;
                        uint2 v; v.x = (unsigned)h0 | ((unsigned)h1 << 16); v.y = (unsigned)h2 | ((unsigned)h3 << 16);
                        if (R < CTXROWS) { const int b = R >> 8, t = R & 255; *(uint2*)(vtc + ((size_t)((b * 8 + hh) * 64 + d)) * 256 + t) = v; }
                        else { const int R2 = R - CTXROWS, b = R2 >> 14, t = R2 & 16383; *(uint2*)(vtl + ((size_t)((b * 8 + hh) * 64 + d)) * 16384 + t) = v; }
                    } else if (N < 2496) {
                        u16* q = pb + (size_t)R * 960 + (N - 1536); q[0] = h0; q[960] = h1; q[1920] = h2; q[2880] = h3;
                    } else {
                        u16* q = pc + (size_t)R * 1040 + (N - 2496); q[0] = h0; q[1040] = h1; q[2080] = h2; q[3120] = h3;
                    }
                });
    }
}

constexpr size_t RWREC = 12288;
constexpr size_t RW_A1 = 0, RW_A4 = 2048, RW_A3 = 4096, RW_MKA = 8192, RW_TT = 8704, RW_MY = 9216, RW_V = 10240;
constexpr size_t OFF_RWOP = OFF_X1;
constexpr size_t OFF_RWWG = OFF_RWOP + (size_t)8 * 1040 * RWREC;
constexpr size_t OFF_YRWB = OFF_RWWG + (size_t)8 * 260 * 64 * 4;
constexpr size_t OFF_BONUS = OFF_YRWB + (size_t)T * 256 * 2;
static_assert(OFF_BONUS + (size_t)T * 4 * 4 <= OFF_HM, "rw operand store must fit the X1 region");

DEVINL float rw_mix(const u16* __restrict__ pb, const float* __restrict__ mup, const float* __restrict__ mun, int row, int t, int seqlen, int col) {
    const float cu = bf2f(pb[(size_t)row * 960 + col]);
    const float pr = t > 0 ? bf2f(pb[(size_t)(row - 1) * 960 + col]) : 0.f;
    const float nx = t + 1 < seqlen ? bf2f(pb[(size_t)(row + 1) * 960 + col]) : 0.f;
    return cu + mup[col] * (pr - cu) + mun[col] * (nx - cu);
}

DEVINL void rw_mix8(const u16* __restrict__ pb, const float* __restrict__ mup, const float* __restrict__ mun, int row, int t, int seqlen, int col0, float (&o)[8]) {
    const bool hp = t > 0, hn = t + 1 < seqlen;
    const u32x4 c = *(const u32x4*)(pb + (size_t)row * 960 + col0);
    u32x4 pv = *(const u32x4*)(pb + (size_t)(hp ? row - 1 : row) * 960 + col0);
    u32x4 nx = *(const u32x4*)(pb + (size_t)(hn ? row + 1 : row) * 960 + col0);
    const unsigned mpv = hp ? 0xFFFFFFFFu : 0u, mnx = hn ? 0xFFFFFFFFu : 0u;
    const f32x4 mp0 = *(const f32x4*)(mup + col0), mp1 = *(const f32x4*)(mup + col0 + 4), mn0 = *(const f32x4*)(mun + col0), mn1 = *(const f32x4*)(mun + col0 + 4);
#pragma unroll
    for (int i = 0; i < 4; ++i) {
        const unsigned cw = c[i], pw = pv[i] & mpv, nw = nx[i] & mnx;
        const float c0 = __uint_as_float(cw << 16), c1 = __uint_as_float(cw & 0xFFFF0000u);
        const float p0 = __uint_as_float(pw << 16), p1 = __uint_as_float(pw & 0xFFFF0000u);
        const float n0 = __uint_as_float(nw << 16), n1 = __uint_as_float(nw & 0xFFFF0000u);
        const float ma = (i < 2) ? mp0[2 * i] : mp1[2 * i - 4], mb = (i < 2) ? mp0[2 * i + 1] : mp1[2 * i - 3];
        const float na = (i < 2) ? mn0[2 * i] : mn1[2 * i - 4], nb = (i < 2) ? mn0[2 * i + 1] : mn1[2 * i - 3];
        o[2 * i] = c0 + ma * (p0 - c0) + na * (n0 - c0);
        o[2 * i + 1] = c1 + mb * (p1 - c1) + nb * (n1 - c1);
    }
}
DEVINL uint4 pack8bf(const float (&v)[8]) { return make_uint4(pk2bf(v[0], v[1]), pk2bf(v[2], v[3]), pk2bf(v[4], v[5]), pk2bf(v[6], v[7])); }

DEVINL void ph_rwprep(const P& p, int l, int d, char* smem, int bid, int nb) {
    const int TIDX_ = tid_(); const int BIDX_ = bid_(); char* const WS_ = wsl_(p.ws);
    const int tid = TIDX_, lane = tid & 63, w = tid >> 6, fr = lane & 15, fq = lane >> 4;
    const u16* pb = (const u16*)(WS_ + OFF_PB);
    char* rwop = WS_ + OFF_RWOP;
    float* rwwg = (float*)(WS_ + OFF_RWWG);
    float* bonus = (float*)(WS_ + OFF_BONUS);
    u16* gate = (u16*)(WS_ + OFF_GATE);
    const float* mup = p.mu_prev + l * 960; const float* mun = p.mu_next + l * 960;
    u16* lwdh = (u16*)smem;
    u16* ladh = lwdh + 2048;
    u16* abuf = ladh + 2048;
    float* Lb = (float*)(smem + 16384);
    u16* SV = (u16*)(smem + 32768);
    float* tot = (float*)(smem + 32768);
    const u16* w2t = (const u16*)(WS_ + OFF_LORA);
    const u16* a2t = w2t + 2 * 2 * 256 * 32;
    const u16* g2t = a2t + 2 * 2 * 256 * 32;
    const int z = d;
    for (int uh = bid; uh < NUNIT_CH * 4; uh += nb) {
        const int u = uh >> 2, h = uh & 3;
        int b, gi, row0, seqlen, gscan;
        if (u < 8) { b = u >> 2; gi = u & 3; row0 = b * 256 + gi * 64; seqlen = 256; gscan = d ? 3 - gi : gi; }
        else { b = (u - 8) >> 8; gi = (u - 8) & 255; row0 = CTXROWS + b * LAT + gi * 64; seqlen = LAT; gscan = 4 + (d ? 255 - gi : gi); }
        const int t0 = gi * 64;
        __syncthreads();
        {
            const int j = tid >> 2, cq = tid & 3;
            float v[8];
            rw_mix8(pb, mup, mun, row0 + j, t0 + j, seqlen, 768 + z * 32 + 8 * cq, v);
#pragma unroll
            for (int i = 0; i < 8; ++i) v[i] = tanhf(v[i]);
            *(uint4*)(lwdh + j * 32 + 8 * cq) = pack8bf(v);
            rw_mix8(pb, mup, mun, row0 + j, t0 + j, seqlen, 832 + z * 32 + 8 * cq, v);
            *(uint4*)(ladh + j * 32 + 8 * cq) = pack8bf(v);
        }
        if (d == 0) {
            u16* lgd = (u16*)Lb;
            {
                const int j = tid >> 2, cq = tid & 3;
#pragma unroll
                for (int hh = 0; hh < 2; ++hh) {
                    float v[8];
                    rw_mix8(pb, mup, mun, row0 + j, t0 + j, seqlen, 896 + 16 * cq + 8 * hh, v);
#pragma unroll
                    for (int i = 0; i < 8; ++i) v[i] = sigmoidf_(v[i]);
                    *(uint4*)(lgd + j * 64 + 16 * cq + 8 * hh) = pack8bf(v);
                }
            }
            __syncthreads();
            const bf16x8 x0 = *(const bf16x8*)(lgd + (16 * w + fr) * 64 + 8 * fq), x1 = *(const bf16x8*)(lgd + (16 * w + fr) * 64 + 32 + 8 * fq);
#pragma unroll
            for (int nt = 0; nt < 4; ++nt) {
                const u16* bp = g2t + ((size_t)l * 256 + 64 * h + 16 * nt + fr) * 64 + 8 * fq;
                const bf16x8 b0 = *(const bf16x8*)bp, b1 = *(const bf16x8*)(bp + 32);
                f32x4 acc = f32x4{0.f, 0.f, 0.f, 0.f};
                acc = __builtin_amdgcn_mfma_f32_16x16x32_bf16(x0, b0, acc, 0, 0, 0);
                acc = __builtin_amdgcn_mfma_f32_16x16x32_bf16(x1, b1, acc, 0, 0, 0);
#pragma unroll
                for (int r = 0; r < 4; ++r) gate[(size_t)(row0 + 16 * w + 4 * fq + r) * 256 + 64 * h + 16 * nt + fr] = f2bf(acc[r]);
            }
        }
        {
            const int bh = b * 4 + h;
            const int ch = h * 64 + lane;
            __syncthreads();
            {
                const bf16x8 xw = *(const bf16x8*)(lwdh + (16 * w + fr) * 32 + 8 * fq);
                const bf16x8 xa = *(const bf16x8*)(ladh + (16 * w + fr) * 32 + 8 * fq);
#pragma unroll 1
                for (int kt = 0; kt < 4; ++kt) {
                    const int key = 16 * kt + fr;
                    const size_t wrow = ((size_t)(l * 2 + z) * 256 + h * 64 + key) * 32 + 8 * fq;
                    const bf16x8 bw = *(const bf16x8*)(w2t + wrow), ba = *(const bf16x8*)(a2t + wrow);
                    f32x4 ae = f32x4{0.f, 0.f, 0.f, 0.f}, aa = f32x4{0.f, 0.f, 0.f, 0.f};
                    ae = __builtin_amdgcn_mfma_f32_16x16x32_bf16(xw, bw, ae, 0, 0, 0);
                    aa = __builtin_amdgcn_mfma_f32_16x16x32_bf16(xa, ba, aa, 0, 0, 0);
                    const float w0 = p.rw_w0[(l * 2 + z) * 256 + h * 64 + key], a0 = p.rw_a0[(l * 2 + z) * 256 + h * 64 + key];
#pragma unroll
                    for (int r = 0; r < 4; ++r) {
                        const int tok = 16 * w + 4 * fq + r;
                        const int s = d ? 63 - tok : tok;
                        Lb[s * 64 + key] = 0.60653065971263342f * sigmoidf_(ae[r] + w0);
                        abuf[tok * 64 + key] = f2bf(sigmoidf_(aa[r] + a0));
                    }
                }
            }
            __syncthreads();
            {
                float pre[16]; float run = 0.f;
#pragma unroll
                for (int i = 0; i < 16; ++i) { run += Lb[(16 * w + i) * 64 + lane]; pre[i] = run; }
                tot[w * 64 + lane] = run;
                __syncthreads();
                float offs = 0.f;
#pragma unroll
                for (int ww = 0; ww < 3; ++ww) offs += (ww < w) ? tot[ww * 64 + lane] : 0.f;
#pragma unroll
                for (int i = 0; i < 16; ++i) Lb[(16 * w + i) * 64 + lane] = -(offs + pre[i]);
            }
            __syncthreads();
            {
                const int j = tid >> 2, kq = tid & 3, row = row0 + j, tt = t0 + j;
                const int c0 = h * 64 + 16 * kq;
                float kr[16];
                { float t8[8];
                  rw_mix8(pb, mup, mun, row, tt, seqlen, 256 + c0, t8);
#pragma unroll
                  for (int i = 0; i < 8; ++i) kr[i] = t8[i];
                  rw_mix8(pb, mup, mun, row, tt, seqlen, 256 + c0 + 8, t8);
#pragma unroll
                  for (int i = 0; i < 8; ++i) kr[8 + i] = t8[i]; }
                float ss = 0.f;
#pragma unroll
                for (int i = 0; i < 16; ++i) { const float kv = kr[i] * p.rw_kk[l * 256 + c0 + i]; ss += kv * kv; }
                ss += __shfl_xor(ss, 1); ss += __shfl_xor(ss, 2);
                const float inorm = 1.f / fmaxf(sqrtf(ss), 1e-12f);
                const int sidx = d ? 63 - j : j;
                const int cch = sidx >> 4, ts = sidx & 15;
                u16* sv = SV + (size_t)(cch * 4) * 1024 + ts * 64 + 16 * kq;
                float bs = 0.f;
#pragma unroll 1
                for (int hh = 0; hh < 2; ++hh) {
                    const int cb = c0 + 8 * hh;
                    float rr[8], av[8], oa[8], orr[8], ob[8], ok[8];
                    rw_mix8(pb, mup, mun, row, tt, seqlen, cb, rr);
                    { const uint4 a0 = *(const uint4*)(abuf + j * 64 + 16 * kq + 8 * hh);
                      const unsigned aw[4] = {a0.x, a0.y, a0.z, a0.w};
#pragma unroll
                      for (int i = 0; i < 4; ++i) { av[2 * i] = __uint_as_float(aw[i] << 16); av[2 * i + 1] = __uint_as_float(aw[i] & 0xFFFF0000u); } }
#pragma unroll
                    for (int i4 = 0; i4 < 2; ++i4) {
                        const float4 Lt4 = *(const float4*)(Lb + sidx * 64 + 16 * kq + 8 * hh + 4 * i4);
                        const float4 Lp4 = sidx > 0 ? *(const float4*)(Lb + (sidx - 1) * 64 + 16 * kq + 8 * hh + 4 * i4) : make_float4(0.f, 0.f, 0.f, 0.f);
                        const float Lt[4] = {Lt4.x, Lt4.y, Lt4.z, Lt4.w}, Lp[4] = {Lp4.x, Lp4.y, Lp4.z, Lp4.w};
#pragma unroll
                        for (int ii = 0; ii < 4; ++ii) {
                            const int i = 4 * i4 + ii;
                            const float kraw = hh ? kr[8 + i] : kr[i];
                            const float kkn = kraw * p.rw_kk[l * 256 + cb + i] * inorm, a = av[i];
                            const float et = __expf(Lt[ii]), einv = __builtin_amdgcn_rcpf(et);
                            oa[i] = -kkn * __expf(Lp[ii]);
                            orr[i] = rr[i] * et;
                            ob[i] = kkn * a * einv;
                            ok[i] = kraw * (1.f + (a - 1.f) * p.rw_ka[l * 256 + cb + i]) * einv;
                            bs += rr[i] * kraw * p.rw_rk[l * 256 + cb + i];
                            if (sidx == 63) rwwg[((size_t)bh * 260 + gscan) * 64 + 16 * kq + 8 * hh + i] = et;
                        }
                    }
                    *(uint4*)(sv + 8 * hh) = pack8bf(oa);
                    *(uint4*)(sv + 1024 + 8 * hh) = pack8bf(orr);
                    *(uint4*)(sv + 2048 + 8 * hh) = pack8bf(ob);
                    *(uint4*)(sv + 3072 + 8 * hh) = pack8bf(ok);
                    rw_mix8(pb, mup, mun, row, tt, seqlen, 512 + cb, rr);
                    *(uint4*)(abuf + j * 64 + 16 * kq + 8 * hh) = pack8bf(rr);
                }
                if (d == 0) { bs += __shfl_xor(bs, 1); bs += __shfl_xor(bs, 2); if (kq == 0) bonus[(size_t)row * 4 + h] = bs; }
            }
            __syncthreads();
            {
                char* rec = rwop + ((size_t)bh * 1040 + (size_t)gscan * 4 + w) * RWREC;
                const u16* Av = SV + (size_t)(w * 4) * 1024; const u16* Rv = Av + 1024; const u16* Bv = Av + 2048; const u16* Kv = Av + 3072;
                bf16x8 fa[2], frr[2], fb[2], fk[2];
#pragma unroll
                for (int ks = 0; ks < 2; ++ks) {
                    fa[ks] = *(const bf16x8*)(Av + fr * 64 + ks * 32 + fq * 8);
                    frr[ks] = *(const bf16x8*)(Rv + fr * 64 + ks * 32 + fq * 8);
                    fb[ks] = *(const bf16x8*)(Bv + fr * 64 + ks * 32 + fq * 8);
                    fk[ks] = *(const bf16x8*)(Kv + fr * 64 + ks * 32 + fq * 8);
                }
                f32x4 mka = f32x4{0.f, 0.f, 0.f, 0.f}, mba = mka, mkr = mka, mbr = mka;
#pragma unroll
                for (int ks = 0; ks < 2; ++ks) {
                    mka = __builtin_amdgcn_mfma_f32_16x16x32_bf16(fa[ks], fk[ks], mka, 0, 0, 0);
                    mba = __builtin_amdgcn_mfma_f32_16x16x32_bf16(fa[ks], fb[ks], mba, 0, 0, 0);
                    mkr = __builtin_amdgcn_mfma_f32_16x16x32_bf16(frr[ks], fk[ks], mkr, 0, 0, 0);
                    mbr = __builtin_amdgcn_mfma_f32_16x16x32_bf16(frr[ks], fb[ks], mbr, 0, 0, 0);
                }
                float* Ns = Lb + w * 256;
                u16* rmka = (u16*)(rec + RW_MKA); u16* rmy = (u16*)(rec + RW_MY); u16* rtt = (u16*)(rec + RW_TT);
                const int i_ = fr;
#pragma unroll
                for (int r = 0; r < 4; ++r) {
                    const int t_ = 4 * fq + r;
                    const int lp = (i_ >> 2) * 16 + t_;
                    rmka[lp * 4 + (i_ & 3)] = f2bf(i_ < t_ ? mka[r] : 0.f);
                    rmy[lp * 8 + (i_ & 3)] = f2bf(i_ <= t_ ? mbr[r] : 0.f);
                    rmy[lp * 8 + 4 + (i_ & 3)] = f2bf(i_ <= t_ ? mkr[r] : 0.f);
                    Ns[t_ * 16 + i_] = i_ < t_ ? mba[r] : 0.f;
                }
                if (lane < 16) {
                    float Tr[16];
#pragma unroll
                    for (int t_ = 0; t_ < 16; ++t_) {
                        float acc = (lane == t_) ? 1.f : 0.f;
#pragma unroll
                        for (int ii = 0; ii < t_; ++ii) acc += Tr[ii] * Ns[t_ * 16 + ii];
                        Tr[t_] = acc;
                        rtt[((lane >> 2) * 16 + t_) * 4 + (lane & 3)] = f2bf(acc);
                    }
                }
#pragma unroll
                for (int ks = 0; ks < 2; ++ks) {
                    uint4 o;
                    const uint2 lo = *(const uint2*)(Av + fr * 64 + 32 * ks + 4 * fq), hi = *(const uint2*)(Av + fr * 64 + 32 * ks + 16 + 4 * fq);
                    o.x = lo.x; o.y = lo.y; o.z = hi.x; o.w = hi.y;
                    *(uint4*)(rec + RW_A1 + (ks * 64 + lane) * 16) = o;
                    const uint2 lo2 = *(const uint2*)(Rv + fr * 64 + 32 * ks + 4 * fq), hi2 = *(const uint2*)(Rv + fr * 64 + 32 * ks + 16 + 4 * fq);
                    o.x = lo2.x; o.y = lo2.y; o.z = hi2.x; o.w = hi2.y;
                    *(uint4*)(rec + RW_A4 + (ks * 64 + lane) * 16) = o;
                }
#pragma unroll
                for (int m = 0; m < 4; ++m) {
                    unsigned e[8];
#pragma unroll
                    for (int j = 0; j < 4; ++j) { e[j] = Bv[(4 * fq + j) * 64 + 16 * m + fr]; e[4 + j] = Kv[(4 * fq + j) * 64 + 16 * m + fr]; }
                    uint4 o; o.x = e[0] | (e[1] << 16); o.y = e[2] | (e[3] << 16); o.z = e[4] | (e[5] << 16); o.w = e[6] | (e[7] << 16);
                    *(uint4*)(rec + RW_A3 + (m * 64 + lane) * 16) = o;
                }
#pragma unroll
                for (int q = 0; q < 4; ++q) {
                    unsigned e[4];
#pragma unroll
                    for (int j = 0; j < 4; ++j) {
                        const int s = 16 * w + 4 * fq + j; const int jt = d ? 63 - s : s;
                        e[j] = abuf[jt * 64 + 16 * q + fr];
                    }
                    uint2 o; o.x = e[0] | (e[1] << 16); o.y = e[2] | (e[3] << 16);
                    *(uint2*)(rec + RW_V + (q * 64 + lane) * 8) = o;
                }
            }
        }
    }
}

constexpr int RWSLOT = 12544;
DEVINL void ph_rwscan(const P& p, int l, int d, int bid, int nb, char* smem) {
    const int TIDX_ = tid_(); char* const WS_ = wsl_(p.ws);
    const int tid = TIDX_, lane = tid & 63, q = tid >> 6, fr = lane & 15, fq = lane >> 4;
    const char* rwop = WS_ + OFF_RWOP;
    const float* rwwg = (const float*)(WS_ + OFF_RWWG);
    u16* yf = (u16*)(WS_ + OFF_Y);
    u16* yb = (u16*)(WS_ + OFF_YRWB);
    (void)l;
    for (int bh = bid; bh < 8; bh += nb) {
        const int b = bh >> 2, h = bh & 3;
        f32x4 z[4];
#pragma unroll
        for (int m = 0; m < 4; ++m) z[m] = f32x4{0.f, 0.f, 0.f, 0.f};
        const char* rec0 = rwop + (size_t)bh * 1040 * RWREC;
        const float* wg0 = rwwg + (size_t)bh * 260 * 64;
        auto issue = [&](int c, int sl) {
            const int cc = c < 1040 ? c : 1039;
            char* slot = smem + sl * RWSLOT;
            const char* rec = rec0 + (size_t)cc * RWREC;
#pragma unroll
            for (int i = 0; i < 3; ++i) glds16(rec + (tid + 256 * i) * 16, slot + (tid + 256 * i) * 16);
            glds4((const char*)(wg0 + (size_t)(cc >> 2) * 64) + lane * 4, slot + 12288 + lane * 4);
        };
        auto asfrag = [](uint4 v) { union { uint4 u; bf16x8 f; } x; x.u = v; return x.f; };
        auto pack2 = [](float lo, float hi) { return pk2bf(lo, hi); };
        const unsigned b128 = lds_addr(smem) + lane * 16, b64 = lds_addr(smem) + lane * 8, bv = lds_addr(smem) + (q * 64 + lane) * 8, bg = lds_addr(smem) + 16 * fq;
        __syncthreads();
        __builtin_amdgcn_s_setprio(3);
        issue(0, 0); issue(1, 1); issue(2, 2); issue(3, 3);
#pragma unroll 1
        for (int c5 = 0; c5 < 1040; c5 += 5) {
          auto body = [&](auto SJ) {
            constexpr int sj = decltype(SJ)::value;
            const int c = c5 + sj;
            asm volatile("s_waitcnt vmcnt(12)" ::: "memory");
            __builtin_amdgcn_s_barrier();
            issue(c + 4, (sj + 4) % 5);
            constexpr int SB = sj * RWSLOT;
            u32x4 r_a10, r_a11, r_a40, r_a41, r_a30, r_a31, r_a32, r_a33, r_my, g0, g1, g2, g3;
            u32x2 mka, tt, vcur;
            asm volatile(
                "ds_read_b128 %0, %16 offset:%20+0\n\t"
                "ds_read_b128 %1, %16 offset:%20+1024\n\t"
                "ds_read_b128 %2, %16 offset:%20+2048\n\t"
                "ds_read_b128 %3, %16 offset:%20+3072\n\t"
                "ds_read_b128 %4, %16 offset:%20+4096\n\t"
                "ds_read_b128 %5, %16 offset:%20+5120\n\t"
                "ds_read_b128 %6, %16 offset:%20+6144\n\t"
                "ds_read_b128 %7, %16 offset:%20+7168\n\t"
                "ds_read_b128 %8, %16 offset:%20+9216\n\t"
                "ds_read_b64 %9, %17 offset:%20+8192\n\t"
                "ds_read_b64 %10, %17 offset:%20+8704\n\t"
                "ds_read_b64 %11, %18 offset:%20+10240\n\t"
                "ds_read_b128 %12, %19 offset:%20+12288\n\t"
                "ds_read_b128 %13, %19 offset:%20+12352\n\t"
                "ds_read_b128 %14, %19 offset:%20+12416\n\t"
                "ds_read_b128 %15, %19 offset:%20+12480\n\t"
                "s_waitcnt lgkmcnt(0)"
                : "=&v"(r_a10), "=&v"(r_a11), "=&v"(r_a40), "=&v"(r_a41), "=&v"(r_a30), "=&v"(r_a31), "=&v"(r_a32), "=&v"(r_a33), "=&v"(r_my),
                  "=&v"(mka), "=&v"(tt), "=&v"(vcur), "=&v"(g0), "=&v"(g1), "=&v"(g2), "=&v"(g3)
                : "v"(b128), "v"(b64), "v"(bv), "v"(bg), "n"(SB)
                : "memory");
            auto asfrag4 = [](u32x4 v) { union { u32x4 u; bf16x8 f; } x; x.u = v; return x.f; };
            const bf16x8 A1_0 = asfrag4(r_a10), A1_1 = asfrag4(r_a11), A4_0 = asfrag4(r_a40), A4_1 = asfrag4(r_a41);
            const bf16x8 A3_0 = asfrag4(r_a30), A3_1 = asfrag4(r_a31), A3_2 = asfrag4(r_a32), A3_3 = asfrag4(r_a33), MY = asfrag4(r_my);
            const bf16x8 MKA = asfrag(make_uint4(mka.x, mka.y, 0u, 0u)), TT = asfrag(make_uint4(tt.x, tt.y, 0u, 0u));
            const bf16x8 VB = asfrag(make_uint4(vcur.x, vcur.y, 0u, 0u));
            const bf16x8 ZB0 = asfrag(make_uint4(pack2(z[0][0], z[0][1]), pack2(z[0][2], z[0][3]), pack2(z[1][0], z[1][1]), pack2(z[1][2], z[1][3])));
            const bf16x8 ZB1 = asfrag(make_uint4(pack2(z[2][0], z[2][1]), pack2(z[2][2], z[2][3]), pack2(z[3][0], z[3][1]), pack2(z[3][2], z[3][3])));
            f32x4 X = f32x4{0.f, 0.f, 0.f, 0.f};
            X = __builtin_amdgcn_mfma_f32_16x16x32_bf16(MKA, VB, X, 0, 0, 0);
            X = __builtin_amdgcn_mfma_f32_16x16x32_bf16(A1_0, ZB0, X, 0, 0, 0);
            X = __builtin_amdgcn_mfma_f32_16x16x32_bf16(A1_1, ZB1, X, 0, 0, 0);
            f32x4 Y = f32x4{0.f, 0.f, 0.f, 0.f};
            Y = __builtin_amdgcn_mfma_f32_16x16x32_bf16(A4_0, ZB0, Y, 0, 0, 0);
            Y = __builtin_amdgcn_mfma_f32_16x16x32_bf16(A4_1, ZB1, Y, 0, 0, 0);
            const bf16x8 XB = asfrag(make_uint4(pack2(X[0], X[1]), pack2(X[2], X[3]), 0u, 0u));
            f32x4 U = f32x4{0.f, 0.f, 0.f, 0.f};
            U = __builtin_amdgcn_mfma_f32_16x16x32_bf16(TT, XB, U, 0, 0, 0);
            const bf16x8 UV = asfrag(make_uint4(pack2(U[0], U[1]), pack2(U[2], U[3]), vcur.x, vcur.y));
            z[0] = __builtin_amdgcn_mfma_f32_16x16x32_bf16(A3_0, UV, z[0], 0, 0, 0);
            z[1] = __builtin_amdgcn_mfma_f32_16x16x32_bf16(A3_1, UV, z[1], 0, 0, 0);
            z[2] = __builtin_amdgcn_mfma_f32_16x16x32_bf16(A3_2, UV, z[2], 0, 0, 0);
            z[3] = __builtin_amdgcn_mfma_f32_16x16x32_bf16(A3_3, UV, z[3], 0, 0, 0);
            Y = __builtin_amdgcn_mfma_f32_16x16x32_bf16(MY, UV, Y, 0, 0, 0);
            if ((c & 3) == 3) {
                z[0][0] *= __uint_as_float(g0.x); z[0][1] *= __uint_as_float(g0.y); z[0][2] *= __uint_as_float(g0.z); z[0][3] *= __uint_as_float(g0.w);
                z[1][0] *= __uint_as_float(g1.x); z[1][1] *= __uint_as_float(g1.y); z[1][2] *= __uint_as_float(g1.z); z[1][3] *= __uint_as_float(g1.w);
                z[2][0] *= __uint_as_float(g2.x); z[2][1] *= __uint_as_float(g2.y); z[2][2] *= __uint_as_float(g2.z); z[2][3] *= __uint_as_float(g2.w);
                z[3][0] *= __uint_as_float(g3.x); z[3][1] *= __uint_as_float(g3.y); z[3][2] *= __uint_as_float(g3.z); z[3][3] *= __uint_as_float(g3.w);
            }
            {
                const bool isctx = c < 16;
                const int cc = isctx ? c : c - 16;
                const int n = isctx ? LCTX : LAT;
                const int rowbase = isctx ? b * LCTX : CTXROWS + b * LAT;
                const unsigned y01 = pk2bf(Y[0], Y[1]), y23 = pk2bf(Y[2], Y[3]);
#pragma unroll
                for (int r = 0; r < 4; ++r) {
                    const int s = cc * 16 + 4 * fq + r;
                    const int t = d ? n - 1 - s : s;
                    const u16 o = (u16)(((r < 2 ? y01 : y23) >> ((r & 1) * 16)) & 0xFFFFu);
                    u16* dst = d == 0 ? yf + (size_t)(rowbase + t) * 1024 + 512 + h * 64 + 16 * q + fr : yb + (size_t)(rowbase + t) * 256 + h * 64 + 16 * q + fr;
                    *dst = o;
                }
            }
          };
          body(std::integral_constant<int, 0>{}); body(std::integral_constant<int, 1>{}); body(std::integral_constant<int, 2>{});
          body(std::integral_constant<int, 3>{}); body(std::integral_constant<int, 4>{});
        }
        asm volatile("s_waitcnt vmcnt(0)" ::: "memory");
        __builtin_amdgcn_s_setprio(0);
        __syncthreads();
    }
}

DEVINL void ph_rwout(const P& p, int l) {
    const int TIDX_ = tid_(); const int BIDX_ = bid_(); char* const WS_ = wsl_(p.ws);
    const int tid = TIDX_, h = tid >> 6;
    const u16* pb = (const u16*)(WS_ + OFF_PB);
    const u16* yb = (const u16*)(WS_ + OFF_YRWB);
    const u16* gate = (const u16*)(WS_ + OFF_GATE);
    const float* bonus = (const float*)(WS_ + OFF_BONUS);
    u16* y = (u16*)(WS_ + OFF_Y);
    const float* mup = p.mu_prev + l * 960; const float* mun = p.mu_next + l * 960;
    const float lw = p.rw_lnw[l * 256 + tid], lb = p.rw_lnb[l * 256 + tid];
    const int rstart = (l == 0) ? 0 : CTXROWS;
    for (int row = rstart + BIDX_; row < T; row += gridDim.x) {
        int t, seqlen;
        if (row < CTXROWS) { t = row & 255; seqlen = LCTX; } else { t = (row - CTXROWS) & (LAT - 1); seqlen = LAT; }
        const float yv = bf2f(y[(size_t)row * 1024 + 512 + tid]) + bf2f(yb[(size_t)row * 256 + tid]);
        const float v = rw_mix(pb, mup, mun, row, t, seqlen, 512 + tid);
        const float mu = wsum(yv) * (1.f / 64.f);
        const float dl = yv - mu;
        const float var = wsum(dl * dl) * (1.f / 64.f);
        const float o = (dl * rsqrtf(var + 64e-5f) * lw + lb + bonus[(size_t)row * 4 + h] * v) * bf2f(gate[(size_t)row * 256 + tid]);
        y[(size_t)row * 1024 + 512 + tid] = f2bf(o);
    }
}
DEVINL void ph_prepM(const P& p, int l, char* smem, int bid, int nb) {
    const int TIDX_ = tid_(); const int BIDX_ = bid_(); char* const WS_ = wsl_(p.ws);
    const int tid = TIDX_, lane = tid & 63, wid = tid >> 6;
    const u16* pc = (const u16*)(WS_ + OFF_PC);
    u16* mlf = (u16*)(WS_ + OFF_MLF);
    float* mlg = (float*)(WS_ + OFF_MLG);
    float* mls = (float*)(WS_ + OFF_MLS);
    float* nst = (float*)(WS_ + OFF_NST);
    float* cst = (float*)(WS_ + OFF_HM);
    const float* rope = (const float*)(WS_ + OFF_ROPE);
    u16* kl = (u16*)smem;
    u16* vl = kl + 4096;
    float* wsl = (float*)(vl + 4096);
    float* lil = wsl + 128;
    for (int uh = bid; uh < NUNIT_CH * 4; uh += nb) {
        const int u = uh >> 2, h = uh & 3;
        int b, ch, row0, seqlen; bool isctx;
        if (u < 8) { isctx = true; b = u >> 2; ch = u & 3; row0 = b * 256 + ch * 64; seqlen = 256; }
        else { isctx = false; b = (u - 8) >> 8; ch = (u - 8) & 255; row0 = CTXROWS + b * LAT + ch * 64; seqlen = LAT; }
        const int t0 = ch * 64;
        const int tc = isctx ? ch : 4 + ch;
        __syncthreads();
        {
            const bool isk = wid >= 2;
            const int cch = (isk ? 256 : 0) + h * 64 + lane;
            const float* cw = p.ml_cw + (size_t)l * 3 * 512;
            const float w0 = cw[cch], w1 = cw[512 + cch], w2 = cw[1024 + cch], bb = p.ml_cb[l * 512 + cch];
            const int jb = (wid & 1) * 32;
            const int i16 = lane & 15; const bool second = (lane & 16) != 0; const int half = lane >> 5;
            float pv = (t0 + jb > 0) ? bf2f(pc[(size_t)(row0 + jb - 1) * 1040 + cch]) : 0.f;
            float cv = bf2f(pc[(size_t)(row0 + jb) * 1040 + cch]);
#pragma unroll 4
            for (int jj = 0; jj < 32; ++jj) {
                const int j = jb + jj;
                const float nv = (t0 + j + 1 < seqlen) ? bf2f(pc[(size_t)(row0 + j + 1) * 1040 + cch]) : 0.f;
                float val = siluf_(w0 * pv + w1 * cv + w2 * nv + bb);
                if (!isctx) {
                    const int t = t0 + j;
                    const int pos = half == 0 ? (t >> 6) : (t & 63);
                    const float cs = half == 0 ? rope[pos * 16 + i16] : rope[8192 + pos * 16 + i16];
                    const float sn = half == 0 ? rope[4096 + pos * 16 + i16] : rope[9216 + pos * 16 + i16];
                    const float ov = __shfl_xor(val, 16);
                    val = second ? (ov * sn + val * cs) : (val * cs - ov * sn);
                }
                if (isk) { const u16 kb = f2bf(val * 0.125f); mlf[(size_t)(row0 + j) * 512 + 256 + h * 64 + lane] = kb; kl[j * 64 + lane] = kb; }
                else mlf[(size_t)(row0 + j) * 512 + h * 64 + lane] = f2bf(val);
                pv = cv; cv = nv;
            }
            {
                const int j = tid >> 2, wh = tid & 3;
                const int idx = (wh < 2) ? (wh * 4 + h) : (8 + (wh - 2) * 4 + h);
                const float g = bf2f(pc[(size_t)(row0 + j) * 1040 + 1024 + idx]);
                float v;
                if (wh < 2) v = g + p.ml_ib[l * 8 + idx];
                else { const float xx = g + p.ml_fb[l * 8 + idx - 8]; v = fminf(xx, 0.f) - log1pf(__expf(-fabsf(xx))); }
                lil[j * 4 + wh] = v;
                mlg[(size_t)(row0 + j) * 16 + idx] = v;
            }
            for (int i = tid; i < 64 * 16; i += 256) {
                const int tok = i >> 4, c4 = (i & 15) * 4;
                *(uint2*)(vl + tok * 64 + c4) = *(const uint2*)(pc + (size_t)(row0 + tok) * 1040 + 512 + h * 64 + c4);
            }
        }
        __syncthreads();
        if (tid < 2) {
            const int d = tid;
            float bacc = 0.f;
#pragma unroll 1
            for (int jj = 0; jj < 64; ++jj) { const int tok = d ? 63 - jj : jj; bacc += lil[tok * 4 + 2 + d]; wsl[d * 64 + tok] = bacc; }
            const float Bs = bacc;
            float G = -3.0e38f;
#pragma unroll 1
            for (int tok = 0; tok < 64; ++tok) { const float g = Bs - wsl[d * 64 + tok] + lil[tok * 4 + d]; G = fmaxf(G, g); }
#pragma unroll 1
            for (int tok = 0; tok < 64; ++tok) { const float g = Bs - wsl[d * 64 + tok] + lil[tok * 4 + d]; wsl[d * 64 + tok] = expf(g - G); }
            const int bhd = (b * 4 + h) * 2 + d;
            mls[(bhd * NTC + tc) * 2 + 0] = G; mls[(bhd * NTC + tc) * 2 + 1] = Bs;
        }
        __syncthreads();
        {
            const int dk4 = (tid >> 4) * 4, dv4 = (tid & 15) * 4;
            float a0[4][4], a1[4][4], n0[4], n1[4];
#pragma unroll
            for (int a = 0; a < 4; ++a) { n0[a] = 0.f; n1[a] = 0.f;
#pragma unroll
                for (int c = 0; c < 4; ++c) { a0[a][c] = 0.f; a1[a][c] = 0.f; } }
#pragma unroll 2
            for (int j = 0; j < 64; ++j) {
                const uint2 kk = *(const uint2*)(kl + j * 64 + dk4);
                const uint2 vv = *(const uint2*)(vl + j * 64 + dv4);
                const float w0 = wsl[j], w1 = wsl[64 + j];
                const float kf[4] = {bf2f((u16)(kk.x & 0xFFFF)), bf2f((u16)(kk.x >> 16)), bf2f((u16)(kk.y & 0xFFFF)), bf2f((u16)(kk.y >> 16))};
                const float vf[4] = {bf2f((u16)(vv.x & 0xFFFF)), bf2f((u16)(vv.x >> 16)), bf2f((u16)(vv.y & 0xFFFF)), bf2f((u16)(vv.y >> 16))};
#pragma unroll
                for (int a = 0; a < 4; ++a) {
                    const float k0 = kf[a] * w0, k1 = kf[a] * w1;
                    n0[a] += k0; n1[a] += k1;
#pragma unroll
                    for (int c = 0; c < 4; ++c) { a0[a][c] += k0 * vf[c]; a1[a][c] += k1 * vf[c]; }
                }
            }
            const int bh0 = ((b * 4 + h) * 2 + 0) * NTC + tc, bh1 = ((b * 4 + h) * 2 + 1) * NTC + tc;
#pragma unroll
            for (int a = 0; a < 4; ++a) {
                *(float4*)(cst + (size_t)bh0 * 4096 + (dk4 + a) * 64 + dv4) = make_float4(a0[a][0], a0[a][1], a0[a][2], a0[a][3]);
                *(float4*)(cst + (size_t)bh1 * 4096 + (dk4 + a) * 64 + dv4) = make_float4(a1[a][0], a1[a][1], a1[a][2], a1[a][3]);
                if ((tid & 15) == 0) { nst[(size_t)bh0 * 64 + dk4 + a] = n0[a]; nst[(size_t)bh1 * 64 + dk4 + a] = n1[a]; }
            }
        }
    }
}

DEVINL void ph_mlB(const P& p, int bid, int nb, char* smem) {
    const int TIDX_ = tid_(); char* const WS_ = wsl_(p.ws);
    const int tid = TIDX_;
    const float* mls = (const float*)(WS_ + OFF_MLS);
    float* mst = (float*)(WS_ + OFF_MST);
    float* nst = (float*)(WS_ + OFF_NST);
    const float* cst = (const float*)(WS_ + OFF_HM);
    u16* cst2 = (u16*)(WS_ + OFF_CST2);
    float* nst2 = (float*)(WS_ + OFF_NST2);
    float* gb = (float*)smem;
    float* dcu = gb + 1024;
    for (int u = bid; u < 64; u += nb) {
        const int bhd = u >> 2, q = u & 3, d = bhd & 1;
        auto tcof = [&](int cs) { return cs < 4 ? (d ? 3 - cs : cs) : 4 + (d ? 255 - (cs - 4) : cs - 4); };
        __syncthreads();
        for (int cs = tid; cs < NTC; cs += 256) { const int tc = tcof(cs); gb[cs * 2] = mls[(bhd * NTC + tc) * 2]; gb[cs * 2 + 1] = mls[(bhd * NTC + tc) * 2 + 1]; }
        __syncthreads();
        if (tid == 0) {
            float m = 0.f;
#pragma unroll 1
            for (int cs = 0; cs < NTC; ++cs) {
                const float G = gb[cs * 2], Bs = gb[cs * 2 + 1];
                if (q == 0) mst[bhd * NTC + tcof(cs)] = m;
                const float ml = fmaxf(Bs + m, G);
                dcu[cs * 2] = __expf(Bs + m - ml); dcu[cs * 2 + 1] = __expf(G - ml);
                m = ml;
            }
        }
        __syncthreads();
        float zz = 0.f; asm volatile("" : "+v"(zz));
        float4 C = make_float4(zz, zz, zz, zz);
        float nn = zz;
        const bool don = (q == 0) && (tid < 64);
        const float* cbase = cst + (size_t)bhd * NTC * 4096 + q * 1024 + tid * 4;
        const float* nbase = nst + (size_t)bhd * NTC * 64 + tid;
        u16* obase = cst2 + (size_t)bhd * NTC * 4096 + q * 1024 + tid * 4;
        float* onbase = nst2 + (size_t)bhd * NTC * 64 + tid;
        float4 Ub[8]; float Nb[8];
#pragma unroll
        for (int i = 0; i < 8; ++i) { Ub[i] = *(const float4*)(cbase + (size_t)tcof(i) * 4096); Nb[i] = don ? nbase[(size_t)tcof(i) * 64] : 0.f; }
#pragma unroll 1
        for (int cs0 = 0; cs0 < NTC; cs0 += 8) {
#pragma unroll
            for (int i = 0; i < 8; ++i) {
                const int cs = cs0 + i;
                if (cs < NTC) {
                    const float4 U = Ub[i]; const float nU = Nb[i];
                    const int tc = tcof(cs);
                    if (cs + 8 < NTC) { Ub[i] = *(const float4*)(cbase + (size_t)tcof(cs + 8) * 4096); Nb[i] = don ? nbase[(size_t)tcof(cs + 8) * 64] : 0.f; }
                    { uint2 o; o.x = pk2bf(C.x, C.y); o.y = pk2bf(C.z, C.w); *(uint2*)(obase + (size_t)tc * 4096) = o; }
                    if (don) onbase[(size_t)tc * 64] = nn;
                    const float dC = dcu[cs * 2], dU = dcu[cs * 2 + 1];
                    C.x = dC * C.x + dU * U.x; C.y = dC * C.y + dU * U.y; C.z = dC * C.z + dU * U.z; C.w = dC * C.w + dU * U.w;
                    nn = dC * nn + dU * nU;
                }
            }
        }
    }
}

DEVINL void ph_na(const P& p, int l, char* smem, int bid, int nb) {
    const int TIDX_ = tid_(); const int BIDX_ = bid_(); char* const WS_ = wsl_(p.ws); (void)TIDX_; (void)BIDX_; (void)WS_;
    const int tid = TIDX_, lane = tid & 63, w = tid >> 6, fr = lane & 15, g = lane >> 4;
    const u16* pqk = (const u16*)(WS_ + OFF_PQK);
    const u16* vtl = (const u16*)(WS_ + OFF_VTL);
    const u16* vtc = (const u16*)(WS_ + OFF_VTC);
    u16* y = (u16*)(WS_ + OFF_Y);
    float* rpbl = (float*)smem;
    const int nunit = 4096 + (l == 0 ? 64 : 0);
    for (int u = bid; u < nunit; u += nb) {
        const bool isctx = u >= 4096;
        int b, h, r = 0, qg = 0;
        if (!isctx) { b = u >> 11; h = (u >> 8) & 7; r = u & 255; }
        else { const int v = u - 4096; b = v >> 5; h = (v >> 2) & 7; qg = v & 3; }
        __syncthreads();
        if (!isctx) for (int i = tid; i < 465; i += 256) rpbl[i] = p.na_rpb[((size_t)l * 8 + h) * 465 + i];
        __syncthreads();
        const int c = 16 * w + fr;
        const int qrow = isctx ? b * LCTX + qg * 64 + c : CTXROWS + b * LAT + r * 64 + c;
        bf16x8 qf[2];
        qf[0] = *(const bf16x8*)(pqk + (size_t)qrow * 1024 + h * 64 + 8 * g);
        qf[1] = *(const bf16x8*)(pqk + (size_t)qrow * 1024 + h * 64 + 32 + 8 * g);
        f32x4 O[4];
#pragma unroll
        for (int i = 0; i < 4; ++i) O[i] = f32x4{0.f, 0.f, 0.f, 0.f};
        float mrun = -1.0e30f, lrun = 0.f;
        auto chunk = [&](const u16* kbase0, const u16* kbase1, const u16* vb, int vstride, const float* bias0, const float* bias1, bool lo0, bool lo1, int kc0, int cs) {
            bf16x8 k00 = *(const bf16x8*)(kbase0 + 8 * g), k01 = *(const bf16x8*)(kbase0 + 32 + 8 * g);
            bf16x8 k10 = *(const bf16x8*)(kbase1 + 8 * g), k11 = *(const bf16x8*)(kbase1 + 32 + 8 * g);
            uint2 vlo[4], vhi[4];
#pragma unroll
            for (int dt = 0; dt < 4; ++dt) { vlo[dt] = *(const uint2*)(vb + (size_t)dt * 16 * vstride); vhi[dt] = *(const uint2*)(vb + (size_t)dt * 16 * vstride + 16); }
            f32x4 s0 = f32x4{0.f, 0.f, 0.f, 0.f}, s1 = f32x4{0.f, 0.f, 0.f, 0.f};
            s0 = __builtin_amdgcn_mfma_f32_16x16x32_bf16(k00, qf[0], s0, 0, 0, 0);
            s0 = __builtin_amdgcn_mfma_f32_16x16x32_bf16(k01, qf[1], s0, 0, 0, 0);
            s1 = __builtin_amdgcn_mfma_f32_16x16x32_bf16(k10, qf[0], s1, 0, 0, 0);
            s1 = __builtin_amdgcn_mfma_f32_16x16x32_bf16(k11, qf[1], s1, 0, 0, 0);
            float sv[8];
#pragma unroll
            for (int j = 0; j < 4; ++j) {
                float a = s0[j] * 0.125f, bb = s1[j] * 0.125f;
                if (lo0) {
                    const int k0c = kc0 + 4 * g + j, k1c = k0c + 16;
                    a = (k0c >= cs && k0c <= cs + 15) ? a + bias0[k0c] : -1.0e30f;
                    bb = (k1c >= cs && k1c <= cs + 15) ? bb + bias0[k1c] : -1.0e30f;
                }
                sv[j] = a; sv[4 + j] = bb;
            }
            (void)bias1; (void)lo1;
            float mx = sv[0];
#pragma unroll
            for (int j = 1; j < 8; ++j) mx = fmaxf(mx, sv[j]);
            mx = fmaxf(mx, __shfl_xor(mx, 16)); mx = fmaxf(mx, __shfl_xor(mx, 32));
            const float mnew = fmaxf(mrun, mx);
            const float sc = __expf(mrun - mnew);
            mrun = mnew;
            float ps = 0.f; bf16x8 pf;
#pragma unroll
            for (int j = 0; j < 8; ++j) { const float pv = __expf(sv[j] - mnew); ps += pv; pf[j] = (short)f2bf(pv); }
            lrun = lrun * sc + ps;
#pragma unroll
            for (int dt = 0; dt < 4; ++dt) {
                O[dt][0] *= sc; O[dt][1] *= sc; O[dt][2] *= sc; O[dt][3] *= sc;
                bf16x8 vf;
                vf[0] = (short)(vlo[dt].x & 0xFFFF); vf[1] = (short)(vlo[dt].x >> 16); vf[2] = (short)(vlo[dt].y & 0xFFFF); vf[3] = (short)(vlo[dt].y >> 16);
                vf[4] = (short)(vhi[dt].x & 0xFFFF); vf[5] = (short)(vhi[dt].x >> 16); vf[6] = (short)(vhi[dt].y & 0xFFFF); vf[7] = (short)(vhi[dt].y >> 16);
                O[dt] = __builtin_amdgcn_mfma_f32_16x16x32_bf16(vf, pf, O[dt], 0, 0, 0);
            }
        };
        if (!isctx) {
            const int rs = min(max(r - 4, 0), 248);
            const int cb = (w == 0) ? 0 : (w == 1) ? 8 : (w == 2) ? 24 : 32;
            const int cs = min(max(c - 8, 0), 48);
            for (int i = 0; i < 8; ++i) {
                const int krow = rs + i;
                const size_t tokb = (size_t)CTXROWS + (size_t)b * LAT + krow * 64 + cb;
                const u16* kb0 = pqk + (tokb + fr) * 1024 + 512 + h * 64;
                const u16* kb1 = pqk + (tokb + 16 + fr) * 1024 + 512 + h * 64;
                const u16* vb = vtl + ((size_t)((b * 8 + h) * 64 + fr)) * LAT + krow * 64 + cb + 4 * g;
                const float* bias0 = rpbl + (krow - r + 7) * 31 - c + 15;
                chunk(kb0, kb1, vb, LAT, bias0, bias0, true, true, cb, cs);
            }
        }
        for (int cc = 0; cc < 8; ++cc) {
            const size_t tokb = (size_t)b * LCTX + cc * 32;
            const u16* kb0 = pqk + (tokb + fr) * 1024 + 512 + h * 64;
            const u16* kb1 = pqk + (tokb + 16 + fr) * 1024 + 512 + h * 64;
            const u16* vb = vtc + ((size_t)((b * 8 + h) * 64 + fr)) * LCTX + cc * 32 + 4 * g;
            chunk(kb0, kb1, vb, LCTX, nullptr, nullptr, false, false, 0, 0);
        }
        float lt = lrun; lt += __shfl_xor(lt, 16); lt += __shfl_xor(lt, 32);
        const float inv = 1.f / lt;
#pragma unroll
        for (int dt = 0; dt < 4; ++dt) {
            uint2 o;
            o.x = (unsigned)f2bf(O[dt][0] * inv) | ((unsigned)f2bf(O[dt][1] * inv) << 16);
            o.y = (unsigned)f2bf(O[dt][2] * inv) | ((unsigned)f2bf(O[dt][3] * inv) << 16);
            *(uint2*)(y + (size_t)qrow * 1024 + h * 64 + dt * 16 + 4 * g) = o;
        }
    }
}

DEVINL void ph_mlC(const P& p, int l, char* smem, int bid, int nb) {
    const int TIDX_ = tid_(); const int BIDX_ = bid_(); char* const WS_ = wsl_(p.ws); (void)TIDX_; (void)BIDX_; (void)WS_;
    const int tid = TIDX_;
    const u16* mlf = (const u16*)(WS_ + OFF_MLF);
    const u16* pc = (const u16*)(WS_ + OFF_PC);
    const float* mlg = (const float*)(WS_ + OFF_MLG);
    const float* mst = (const float*)(WS_ + OFF_MST);
    const float* nst = (const float*)(WS_ + OFF_NST2);
    const u16* cst = (const u16*)(WS_ + OFF_CST2);
    u16* y = (u16*)(WS_ + OFF_Y);
    u16* ql = (u16*)smem;
    u16* kl = ql + 4096;
    u16* vl = kl + 4096;
    float* Cl = (float*)(vl + 4096);
    float* Sl = Cl + 4096;
    float* btl = Sl + 4096;
    float* lil = btl + 64;
    float* nl = lil + 64;
    const int t = tid >> 2, q4 = tid & 3;
    for (int uh = bid; uh < 2 * NTC * 4; uh += nb) {
        const int u = uh >> 2, h = uh & 3;
        const int b = u / NTC, tc = u % NTC;
        if (tc < 4 && l != 0) continue;
        const int row0 = tc < 4 ? b * LCTX + tc * 64 : CTXROWS + b * LAT + (tc - 4) * 64;
        {
            float hs[16];
#pragma unroll
            for (int i = 0; i < 16; ++i) hs[i] = 0.f;
            __syncthreads();
            for (int i = tid; i < 64 * 16; i += 256) {
                const int tok = i >> 4, c4 = (i & 15) * 4;
                *(uint2*)(ql + tok * 64 + c4) = *(const uint2*)(mlf + (size_t)(row0 + tok) * 512 + h * 64 + c4);
                *(uint2*)(kl + tok * 64 + c4) = *(const uint2*)(mlf + (size_t)(row0 + tok) * 512 + 256 + h * 64 + c4);
                *(uint2*)(vl + tok * 64 + c4) = *(const uint2*)(pc + (size_t)(row0 + tok) * 1040 + 512 + h * 64 + c4);
            }
            for (int d = 0; d < 2; ++d) {
                const int bhd = (b * 4 + h) * 2 + d;
                __syncthreads();
                for (int i = tid; i < 1024; i += 256) { const uint2 cv = *(const uint2*)(cst + ((size_t)bhd * NTC + tc) * 4096 + i * 4); *(float4*)(Cl + i * 4) = make_float4(bf2f((u16)(cv.x & 0xFFFF)), bf2f((u16)(cv.x >> 16)), bf2f((u16)(cv.y & 0xFFFF)), bf2f((u16)(cv.y >> 16))); }
                if (tid < 64) { nl[tid] = nst[((size_t)bhd * NTC + tc) * 64 + tid]; lil[tid] = mlg[(size_t)(row0 + tid) * 16 + d * 4 + h]; }
                if (tid == 64) {
                    float bacc = 0.f;
#pragma unroll 1
                    for (int jj = 0; jj < 64; ++jj) { const int tok = d ? 63 - jj : jj; bacc += mlg[(size_t)(row0 + tok) * 16 + 8 + d * 4 + h]; btl[tok] = bacc; }
                }
                __syncthreads();
                const float m0 = mst[bhd * NTC + tc];
                float sc[16];
#pragma unroll
                for (int i = 0; i < 16; ++i) sc[i] = 0.f;
                for (int dk = 0; dk < 64; dk += 4) {
                    const uint2 qq = *(const uint2*)(ql + t * 64 + dk);
                    const float q0 = bf2f((u16)(qq.x & 0xFFFF)), q1 = bf2f((u16)(qq.x >> 16)), q2 = bf2f((u16)(qq.y & 0xFFFF)), q3 = bf2f((u16)(qq.y >> 16));
#pragma unroll
                    for (int i = 0; i < 16; ++i) {
                        const uint2 kk = *(const uint2*)(kl + (q4 * 16 + i) * 64 + dk);
                        sc[i] += q0 * bf2f((u16)(kk.x & 0xFFFF)) + q1 * bf2f((u16)(kk.x >> 16)) + q2 * bf2f((u16)(kk.y & 0xFFFF)) + q3 * bf2f((u16)(kk.y >> 16));
                    }
                }
                const float bt = btl[t];
                float ld[16]; float mx = -3.0e38f;
#pragma unroll
                for (int i = 0; i < 16; ++i) {
                    const int s = q4 * 16 + i;
                    const bool ok = d ? (s >= t) : (s <= t);
                    ld[i] = ok ? (bt - btl[s] + lil[s]) : -3.0e38f;
                    mx = fmaxf(mx, ld[i]);
                }
                mx = fmaxf(mx, __shfl_xor(mx, 1)); mx = fmaxf(mx, __shfl_xor(mx, 2));
                const float mt = fmaxf(bt + m0, mx);
                float rsum = 0.f;
#pragma unroll
                for (int i = 0; i < 16; ++i) {
                    const int s = q4 * 16 + i;
                    const bool ok = d ? (s >= t) : (s <= t);
                    const float dw = ok ? expf(ld[i] - mt) * sc[i] : 0.f;
                    rsum += dw;
                    Sl[t * 64 + s] = dw;
                }
                rsum += __shfl_xor(rsum, 1); rsum += __shfl_xor(rsum, 2);
                const float inter = expf(bt + m0 - mt);
                float qn = 0.f;
                for (int dk = q4 * 16; dk < q4 * 16 + 16; ++dk) qn += bf2f(ql[t * 64 + dk]) * nl[dk];
                qn += __shfl_xor(qn, 1); qn += __shfl_xor(qn, 2);
                const float den = rsum + inter * qn;
                __syncthreads();
                float num[16];
#pragma unroll
                for (int i = 0; i < 16; ++i) num[i] = 0.f;
                for (int s = 0; s < 64; ++s) {
                    const float dw = Sl[t * 64 + s];
                    const uint4 va = *(const uint4*)(vl + s * 64 + q4 * 16);
                    const uint4 vb2 = *(const uint4*)(vl + s * 64 + q4 * 16 + 8);
                    const unsigned vv[8] = {va.x, va.y, va.z, va.w, vb2.x, vb2.y, vb2.z, vb2.w};
#pragma unroll
                    for (int i = 0; i < 8; ++i) { num[2 * i] += dw * bf2f((u16)(vv[i] & 0xFFFF)); num[2 * i + 1] += dw * bf2f((u16)(vv[i] >> 16)); }
                }
                for (int dk = 0; dk < 64; ++dk) {
                    const float qv = bf2f(ql[t * 64 + dk]) * inter;
#pragma unroll
                    for (int i = 0; i < 16; i += 4) {
                        const float4 cv = *(const float4*)(Cl + dk * 64 + q4 * 16 + i);
                        num[i] += qv * cv.x; num[i + 1] += qv * cv.y; num[i + 2] += qv * cv.z; num[i + 3] += qv * cv.w;
                    }
                }
                const float dn = 1.f / fmaxf(fabsf(den), expf(-mt));
#pragma unroll
                for (int i = 0; i < 16; ++i) hs[i] += num[i] * dn;
            }
            float s1 = 0.f;
#pragma unroll
            for (int i = 0; i < 16; ++i) s1 += hs[i];
            s1 += __shfl_xor(s1, 1); s1 += __shfl_xor(s1, 2);
            const float mu = s1 * (1.f / 64.f);
            float s2 = 0.f;
#pragma unroll
            for (int i = 0; i < 16; ++i) { const float dlt = hs[i] - mu; s2 += dlt * dlt; }
            s2 += __shfl_xor(s2, 1); s2 += __shfl_xor(s2, 2);
            const float rstd = rsqrtf(s2 * (1.f / 64.f) + 1e-6f);
            const int row = row0 + t;
#pragma unroll
            for (int i = 0; i < 16; i += 2) {
                const int cc = h * 64 + q4 * 16 + i;
                const float o0 = bf2f(pc[(size_t)row * 1040 + 768 + cc]), o1 = bf2f(pc[(size_t)row * 1040 + 768 + cc + 1]);
                const float y0 = (hs[i] - mu) * rstd * p.ml_nw[l * 256 + cc] * sigmoidf_(o0);
                const float y1 = (hs[i + 1] - mu) * rstd * p.ml_nw[l * 256 + cc + 1] * sigmoidf_(o1);
                *(unsigned*)(y + (size_t)row * 1024 + 768 + cc) = (unsigned)f2bf(y0) | ((unsigned)f2bf(y1) << 16);
            }
        }
    }
}

DEVINL void ph_outproj(const P& p, int l, char* smem) {
    const int TIDX_ = tid_(); const int BIDX_ = bid_(); char* const WS_ = wsl_(p.ws); (void)TIDX_; (void)BIDX_; (void)WS_;
    const u16* y = (const u16*)(WS_ + OFF_Y);
    const u16* wout = (const u16*)(WS_ + OFF_WOUT);
    const float* modv = (const float*)(WS_ + OFF_MOD) + (size_t)l * 3 * 6144;
    const float* x2c = (const float*)(WS_ + OFF_X2CTX);
    float* x1 = (float*)(WS_ + OFF_X1);
    const int mt0 = (l == 0) ? 0 : 4;
    const int ntile = (260 - mt0) * 8;
    for (int u = BIDX_; u < ntile; u += gridDim.x) {
        const int mt = mt0 + u / 8, nt = u % 8;
        const u16* A = y + (size_t)mt * 128 * 1024;
        const int R0 = mt * 128;
        const float* xin;
        if (l == 0) xin = R0 < CTXROWS ? p.ctx + (size_t)R0 * 1024 : p.x + (size_t)(R0 - CTXROWS) * 1024;
        else xin = R0 < CTXROWS ? x2c + (size_t)R0 * 1024 : p.out + (size_t)(R0 - CTXROWS) * 1024;
        const float* g1 = modv + row_sel(R0) * 6144 + 2048;
        gemm128([&](int r) { return A + (size_t)r * 1024; }, wout + (size_t)nt * 128 * 1024, 1024, 1024, smem,
                [&](int m, int n, f32x4 a) {
                    const int N = nt * 128 + n;
                    const float gg = g1[N];
#pragma unroll
                    for (int j = 0; j < 4; ++j) x1[(size_t)(R0 + m + j) * 1024 + N] = ALPHA * xin[(size_t)(m + j) * 1024 + N] + gg * a[j];
                });
    }
}

DEVINL void ph_ln1(const P& p, int l) {
    const int TIDX_ = tid_(); const int BIDX_ = bid_(); char* const WS_ = wsl_(p.ws); (void)TIDX_; (void)BIDX_; (void)WS_;
    const int lane = TIDX_ & 63, wid = TIDX_ >> 6;
    const float* modv = (const float*)(WS_ + OFF_MOD) + (size_t)l * 3 * 6144;
    float* x1 = (float*)(WS_ + OFF_X1);
    u16* hm = (u16*)(WS_ + OFF_HM);
    const int rstart = (l == 0) ? 0 : CTXROWS;
    for (int row = rstart + BIDX_ * 4 + wid; row < T; row += gridDim.x * 4) {
        float4 v[4];
        float s = 0.f;
#pragma unroll
        for (int i = 0; i < 4; ++i) { v[i] = *(const float4*)(x1 + (size_t)row * 1024 + i * 256 + lane * 4); s += v[i].x + v[i].y + v[i].z + v[i].w; }
        const float mu = wsum(s) * (1.f / 1024.f);
        float q = 0.f;
#pragma unroll
        for (int i = 0; i < 4; ++i) { v[i].x -= mu; v[i].y -= mu; v[i].z -= mu; v[i].w -= mu; q += v[i].x * v[i].x + v[i].y * v[i].y + v[i].z * v[i].z + v[i].w * v[i].w; }
        const float rstd = rsqrtf(wsum(q) * (1.f / 1024.f) + 1e-5f);
        const float* mv = modv + row_sel(row) * 6144;
#pragma unroll
        for (int i = 0; i < 4; ++i) {
            const int c = i * 256 + lane * 4;
            const float4 g = *(const float4*)(p.ln1g + l * 1024 + c), bb = *(const float4*)(p.ln1b + l * 1024 + c);
            const float4 sh = *(const float4*)(mv + 3072 + c), sc = *(const float4*)(mv + 4096 + c);
            float4 o;
            o.x = v[i].x * rstd * g.x + bb.x; o.y = v[i].y * rstd * g.y + bb.y; o.z = v[i].z * rstd * g.z + bb.z; o.w = v[i].w * rstd * g.w + bb.w;
            *(float4*)(x1 + (size_t)row * 1024 + c) = o;
            uint2 hh;
            hh.x = (unsigned)f2bf(o.x * (1.f + sc.x) + sh.x) | ((unsigned)f2bf(o.y * (1.f + sc.y) + sh.y) << 16);
            hh.y = (unsigned)f2bf(o.z * (1.f + sc.z) + sh.z) | ((unsigned)f2bf(o.w * (1.f + sc.w) + sh.w) << 16);
            *(uint2*)(hm + (size_t)row * 1024 + c) = hh;
        }
    }
}

DEVINL void ph_router(const P& p, int l, char* smem) {
    const int TIDX_ = tid_(); const int BIDX_ = bid_(); char* const WS_ = wsl_(p.ws); (void)TIDX_; (void)BIDX_; (void)WS_;
    const u16* hm = (const u16*)(WS_ + OFF_HM);
    const u16* wr = (const u16*)(WS_ + OFF_WR) + (size_t)l * 128 * 1024;
    float* lg = (float*)(WS_ + OFF_LOGITS);
    const int mt0 = (l == 0) ? 0 : 4;
    for (int u = BIDX_; u < 260 - mt0; u += gridDim.x) {
        const int mt = mt0 + u;
        const u16* A = hm + (size_t)mt * 128 * 1024;
        gemm128([&](int r) { return A + (size_t)r * 1024; }, wr, 1024, 1024, smem,
                [&](int m, int n, f32x4 a) {
                    if (n < 36) {
#pragma unroll
                        for (int j = 0; j < 4; ++j) lg[(size_t)(mt * 128 + m + j) * 64 + n] = a[j];
                    }
                });
    }
}

DEVINL void ph_route1(const P& p, int l, char* smem) {
    const int TIDX_ = tid_(); const int BIDX_ = bid_(); char* const WS_ = wsl_(p.ws); (void)TIDX_; (void)BIDX_; (void)WS_;
    const int tid = TIDX_;
    const float* lg = (const float*)(WS_ + OFF_LOGITS);
    int* toke = (int*)(WS_ + OFF_TOKE); float* tokw = (float*)(WS_ + OFF_TOKW);
    int* cnt = (int*)(WS_ + CTL_CNT) + l * 32;
    int* hist = (int*)smem;
    __syncthreads();
    if (tid < 32) hist[tid] = 0;
    __syncthreads();
    const int rstart = (l == 0) ? 0 : CTXROWS;
    for (int row = rstart + BIDX_ * 256 + tid; row < T; row += gridDim.x * 256) {
        const float* q = lg + (size_t)row * 64;
        float gl[4]; int gs = 0; float gm = -3.0e38f;
#pragma unroll
        for (int i = 0; i < 4; ++i) { gl[i] = q[i] + p.rgb[l * 4 + i]; if (gl[i] > gm) { gm = gl[i]; gs = i; } }
        float se = 0.f;
#pragma unroll
        for (int i = 0; i < 4; ++i) se += expf(gl[i] - gm);
        const float gw = 1.f / se;
        float v1 = -3.0e38f, v2 = -3.0e38f; int i1 = 0, i2 = 0;
#pragma unroll
        for (int i = 0; i < 8; ++i) {
            const float e = q[4 + gs * 8 + i] + p.reb[l * 32 + gs * 8 + i];
            if (e > v1) { v2 = v1; i2 = i1; v1 = e; i1 = i; }
            else if (e > v2) { v2 = e; i2 = i; }
        }
        const float e2 = expf(v2 - v1);
        const float w1 = gw / (1.f + e2), w2 = gw * e2 / (1.f + e2);
        const int ea = gs * 8 + i1, eb = gs * 8 + i2;
        toke[row * 2] = ea; toke[row * 2 + 1] = eb; tokw[row * 2] = w1; tokw[row * 2 + 1] = w2;
        atomicAdd(&hist[ea], 1); atomicAdd(&hist[eb], 1);
    }
    __syncthreads();
    if (tid < 32 && hist[tid] > 0) atomicAdd(&cnt[tid], hist[tid]);
}

DEVINL void ph_route2(const P& p, int l, char* smem) {
    const int TIDX_ = tid_(); const int BIDX_ = bid_(); char* const WS_ = wsl_(p.ws); (void)TIDX_; (void)BIDX_; (void)WS_;
    const int tid = TIDX_;
    const int* toke = (const int*)(WS_ + OFF_TOKE);
    int* toks = (int*)(WS_ + OFF_TOKS);
    int* slottok = (int*)(WS_ + OFF_SLOTTOK);
    const int* cnt = (const int*)(WS_ + CTL_CNT) + l * 32;
    int* cur = (int*)(WS_ + CTL_CUR) + l * 32;
    int* tiles = (int*)(WS_ + OFF_TILES);
    int* off = (int*)smem;
    int* hist = off + 64;
    int* base = hist + 32;
    __syncthreads();
    if (tid == 0) { int a = 0; for (int e = 0; e < 32; ++e) { off[e] = a; a += (cnt[e] + 127) & ~127; } off[32] = a; }
    if (tid < 32) hist[tid] = 0;
    __syncthreads();
    if (BIDX_ == 0) {
        if (tid == 0) {
            int nt = 0;
            for (int e = 0; e < 32; ++e) for (int s = off[e]; s < off[e + 1]; s += 128) { tiles[64 + nt * 2] = e; tiles[64 + nt * 2 + 1] = s; ++nt; }
            tiles[40] = nt;
        }
        for (int e = 0; e < 32; ++e) for (int s = off[e] + cnt[e] + tid; s < off[e + 1]; s += 256) slottok[s] = (l == 0) ? 0 : CTXROWS;
    }
    const int rstart = (l == 0) ? 0 : CTXROWS;
    for (int a0 = rstart * 2 + BIDX_ * 256; a0 < T * 2; a0 += gridDim.x * 256) {
        const int a = a0 + tid;
        int e = -1, lpos = 0;
        if (a < T * 2) { e = toke[a]; lpos = atomicAdd(&hist[e], 1); }
        __syncthreads();
        if (tid < 32) { base[tid] = hist[tid] > 0 ? atomicAdd(&cur[tid], hist[tid]) : 0; }
        __syncthreads();
        if (e >= 0) { const int s = off[e] + base[e] + lpos; toks[a] = s; slottok[s] = a >> 1; }
        __syncthreads();
        if (tid < 32) hist[tid] = 0;
        __syncthreads();
    }
}

DEVINL void ph_gateup(const P& p, char* smem) {
    const int TIDX_ = tid_(); const int BIDX_ = bid_(); char* const WS_ = wsl_(p.ws); (void)TIDX_; (void)BIDX_; (void)WS_;
    const int tid = TIDX_, lane = tid & 63, wid = tid >> 6, wr = wid >> 1, wc = wid & 1, fr = lane & 15, fq = lane >> 4;
    const u16* hm = (const u16*)(WS_ + OFF_HM);
    const u16* wgu = (const u16*)(WS_ + OFF_WGU);
    const int* tiles = (const int*)(WS_ + OFF_TILES);
    const int* slottok = (const int*)(WS_ + OFF_SLOTTOK);
    u16* act = (u16*)(WS_ + OFF_ACT);
    const int ntile = tiles[40] * 8;
    for (int u = BIDX_; u < ntile; u += gridDim.x) {
        const int ti = u >> 3, nt = u & 7;
        const int e = tiles[64 + ti * 2], s0 = tiles[64 + ti * 2 + 1];
        f32x4 acc[4][4];
        gemm128_acc([&](int r) { return hm + (size_t)slottok[s0 + r] * 1024; }, wgu + ((size_t)e * 1024 + nt * 128) * 1024, 1024, 1024, smem, acc);
#pragma unroll
        for (int m = 0; m < 4; ++m)
#pragma unroll
            for (int n = 0; n < 4; n += 2) {
                const int jcol = (nt * 128 + wc * 64 + n * 16) / 2 + fr;
                const int srow = s0 + wr * 64 + m * 16 + fq * 4;
#pragma unroll
                for (int j = 0; j < 4; ++j) {
                    const float gte = acc[m][n][j], up = acc[m][n + 1][j];
                    act[(size_t)(srow + j) * 512 + jcol] = f2bf(gte / (1.f + __expf(-gte)) * up);
                }
            }
    }
}

DEVINL void ph_down(const P& p, char* smem) {
    const int TIDX_ = tid_(); const int BIDX_ = bid_(); char* const WS_ = wsl_(p.ws); (void)TIDX_; (void)BIDX_; (void)WS_;
    const u16* act = (const u16*)(WS_ + OFF_ACT);
    const u16* wdn = (const u16*)(WS_ + OFF_WDN);
    const int* tiles = (const int*)(WS_ + OFF_TILES);
    u16* so = (u16*)(WS_ + OFF_SLOTOUT);
    const int ntile = tiles[40] * 8;
    for (int u = BIDX_; u < ntile; u += gridDim.x) {
        const int ti = u >> 3, nt = u & 7;
        const int e = tiles[64 + ti * 2], s0 = tiles[64 + ti * 2 + 1];
        const u16* A = act + (size_t)s0 * 512;
        gemm128([&](int r) { return A + (size_t)r * 512; }, wdn + ((size_t)e * 1024 + nt * 128) * 512, 512, 512, smem,
                [&](int m, int n, f32x4 a) {
                    u16* q = so + (size_t)(s0 + m) * 1024 + nt * 128 + n;
                    q[0] = f2bf(a[0]); q[1024] = f2bf(a[1]); q[2048] = f2bf(a[2]); q[3072] = f2bf(a[3]);
                });
    }
}

DEVINL void ph_ln2(const P& p, int l) {
    const int TIDX_ = tid_(); const int BIDX_ = bid_(); char* const WS_ = wsl_(p.ws); (void)TIDX_; (void)BIDX_; (void)WS_;
    const int lane = TIDX_ & 63, wid = TIDX_ >> 6;
    const float* modv = (const float*)(WS_ + OFF_MOD) + (size_t)l * 3 * 6144;
    const float* modn = (const float*)(WS_ + OFF_MOD) + (size_t)(l + 1) * 3 * 6144;
    const float* x1 = (const float*)(WS_ + OFF_X1);
    const u16* so = (const u16*)(WS_ + OFF_SLOTOUT);
    const int* toks = (const int*)(WS_ + OFF_TOKS);
    const float* tokw = (const float*)(WS_ + OFF_TOKW);
    float* x2c = (float*)(WS_ + OFF_X2CTX);
    u16* hm = (u16*)(WS_ + OFF_HM);
    const int rstart = (l == 0) ? 0 : CTXROWS;
    for (int row = rstart + BIDX_ * 4 + wid; row < T; row += gridDim.x * 4) {
        const int sa = toks[row * 2], sb = toks[row * 2 + 1];
        const float wa = tokw[row * 2], wb = tokw[row * 2 + 1];
        const float* mv = modv + row_sel(row) * 6144;
        float4 v[4];
        float s = 0.f;
#pragma unroll
        for (int i = 0; i < 4; ++i) {
            const int c = i * 256 + lane * 4;
            const float4 xv = *(const float4*)(x1 + (size_t)row * 1024 + c);
            const uint2 ua = *(const uint2*)(so + (size_t)sa * 1024 + c), ub = *(const uint2*)(so + (size_t)sb * 1024 + c);
            const float4 g2 = *(const float4*)(mv + 5120 + c);
            const float f0 = wa * bf2f((u16)(ua.x & 0xFFFF)) + wb * bf2f((u16)(ub.x & 0xFFFF));
            const float f1 = wa * bf2f((u16)(ua.x >> 16)) + wb * bf2f((u16)(ub.x >> 16));
            const float f2 = wa * bf2f((u16)(ua.y & 0xFFFF)) + wb * bf2f((u16)(ub.y & 0xFFFF));
            const float f3 = wa * bf2f((u16)(ua.y >> 16)) + wb * bf2f((u16)(ub.y >> 16));
            v[i].x = ALPHA * xv.x + g2.x * f0; v[i].y = ALPHA * xv.y + g2.y * f1; v[i].z = ALPHA * xv.z + g2.z * f2; v[i].w = ALPHA * xv.w + g2.w * f3;
            s += v[i].x + v[i].y + v[i].z + v[i].w;
        }
        const float mu = wsum(s) * (1.f / 1024.f);
        float q = 0.f;
#pragma unroll
        for (int i = 0; i < 4; ++i) { v[i].x -= mu; v[i].y -= mu; v[i].z -= mu; v[i].w -= mu; q += v[i].x * v[i].x + v[i].y * v[i].y + v[i].z * v[i].z + v[i].w * v[i].w; }
        const float rstd = rsqrtf(wsum(q) * (1.f / 1024.f) + 1e-5f);
        float* dst = row < CTXROWS ? x2c + (size_t)row * 1024 : p.out + (size_t)(row - CTXROWS) * 1024;
        const float* mn = modn + row_sel(row) * 6144;
#pragma unroll
        for (int i = 0; i < 4; ++i) {
            const int c = i * 256 + lane * 4;
            const float4 g = *(const float4*)(p.ln2g + l * 1024 + c), bb = *(const float4*)(p.ln2b + l * 1024 + c);
            float4 o;
            o.x = v[i].x * rstd * g.x + bb.x; o.y = v[i].y * rstd * g.y + bb.y; o.z = v[i].z * rstd * g.z + bb.z; o.w = v[i].w * rstd * g.w + bb.w;
            *(float4*)(dst + c) = o;
            if (l == 0) {
                const float4 sh = *(const float4*)(mn + c), sc = *(const float4*)(mn + 1024 + c);
                uint2 hh;
                hh.x = (unsigned)f2bf(o.x * (1.f + sc.x) + sh.x) | ((unsigned)f2bf(o.y * (1.f + sc.y) + sh.y) << 16);
                hh.y = (unsigned)f2bf(o.z * (1.f + sc.z) + sh.z) | ((unsigned)f2bf(o.w * (1.f + sc.w) + sh.w) << 16);
                *(uint2*)(hm + (size_t)row * 1024 + c) = hh;
            }
        }
    }
}

DEVINL void gbar(XcdBarrier b) {
    unsigned x = b.x; GAS unsigned* q = (GAS unsigned*)b.bar;
    asm volatile("" : "+s"(x), "+s"(q));
    b.x = x; b.bar = (unsigned*)q;
    xcd_barrier(b);
}
#ifndef PROBE
#define PROBE 0
#endif
#ifndef TPROBE
#define TPROBE 0
#endif
__global__ void __launch_bounds__(256, 2) k_mega(P p) {
    __shared__ __attribute__((aligned(16))) char smem[65536 + 16 + 16];
    if (threadIdx.x == 0) *(uint4*)(smem + 65536) = make_uint4(0u, 0u, 0u, 0u);
    __syncthreads();
    XcdBarrier bar = xcd_barrier_post((unsigned*)p.ws, (volatile LAS unsigned*)(smem + 65536));
    const int bid = blockIdx.x, nb = gridDim.x;
#if TPROBE
    unsigned long long tp_acc = 0, tp_last = wall_clock64();
#define TP(g) do { const unsigned long long _n = wall_clock64(); if ((g) == TPROBE) tp_acc += _n - tp_last; tp_last = _n; } while (0)
#else
#define TP(g) do { } while (0)
#endif
    if (threadIdx.x == 0) {
        const unsigned key = ((unsigned)__builtin_amdgcn_s_getreg((3 << 11) | 20) << 8) | ((unsigned)__builtin_amdgcn_s_getreg((7 << 11) | (8 << 6) | 4) & 0xFFu);
        ((unsigned*)(p.ws + CTL_CUKEY))[blockIdx.x] = key | 0x80000000u;
    }
    ph_prolog(p, smem);
    ph_convw(p, 0, smem);
    gbar(bar);
    TP(1);
    ph_xm0(p);
    gbar(bar);
    TP(1);
    bool quiet; int wrank, nwork;
    {
        const unsigned* keys = (const unsigned*)(p.ws + CTL_CUKEY);
        int* cnt = (int*)smem;
        if (threadIdx.x < 2) cnt[threadIdx.x] = 0;
        __syncthreads();
        for (int i = 8 + threadIdx.x; i < nb; i += 256) {
            const unsigned k = keys[i];
            bool qq = false;
            for (int j = 0; j < 8 && j < nb; ++j) qq = qq || (keys[j] == k);
            if (qq) { atomicAdd(&cnt[1], 1); if (i < bid) atomicAdd(&cnt[0], 1); }
        }
        __syncthreads();
        const int below = cnt[0], total = cnt[1];
        bool me = false;
        if (bid >= 8) { const unsigned k = keys[bid]; for (int j = 0; j < 8 && j < nb; ++j) me = me || (keys[j] == k); }
        __syncthreads();
        if (total > 16) { quiet = false; wrank = bid - 8; nwork = nb - 8; }
        else { quiet = me; wrank = bid - 8 - below; nwork = nb - 8 - total; }
    }
#pragma unroll 1
    for (int l = 0; l < NLAYER; ++l) {
        ph_inproj(p, smem);
        gbar(bar);
    TP(2);
        ph_rwprep(p, l, 0, smem, bid, nb);
        gbar(bar);
    TP(3);
        if (bid < 8) ph_rwscan(p, l, 0, bid, 8, smem);
        else if (!quiet) { ph_prepM(p, l, smem, wrank, nwork); ph_na(p, l, smem, wrank, nwork); }
        gbar(bar);
    TP(4);
        ph_mlB(p, bid, nb, smem);
        gbar(bar);
        ph_rwprep(p, l, 1, smem, bid, nb);
        gbar(bar);
    TP(5);
        if (bid < 8) ph_rwscan(p, l, 1, bid, 8, smem);
        else if (!quiet) { ph_mlC(p, l, smem, wrank, nwork); ph_convexp(p, l, smem, wrank, nwork); }
        gbar(bar);
    TP(6);
        ph_rwout(p, l);
        gbar(bar);
    TP(7);
        ph_outproj(p, l, smem);
        gbar(bar);
    TP(8);
        ph_ln1(p, l);
        gbar(bar);
    TP(9);
        ph_router(p, l, smem);
        gbar(bar);
    TP(9);
        ph_route1(p, l, smem);
        gbar(bar);
    TP(9);
        ph_route2(p, l, smem);
        gbar(bar);
    TP(9);
        ph_gateup(p, smem);
        gbar(bar);
    TP(10);
        ph_down(p, smem);
        gbar(bar);
    TP(11);
        ph_ln2(p, l);
        if (l + 1 < NLAYER) ph_convw(p, l + 1, smem);
        gbar(bar);
    TP(12);
    }
#if TPROBE
    if (bid == 0 && threadIdx.x == 0) { const unsigned long long t_end = wall_clock64() + tp_acc; while (wall_clock64() < t_end) __builtin_amdgcn_s_sleep(8); }
    __syncthreads();
    gbar(bar);
#endif
}


extern "C" void kernel_launch(void* const* d_in, const int* in_sizes, int n_in, void* d_out, int out_size, void* d_ws, size_t ws_size,
                              hipStream_t stream) {
    if (n_in != 37 || ws_size < WS_NEED) { fprintf(stderr, "kernel_launch: n_in %d ws %zu need %zu\n", n_in, ws_size, (size_t)WS_NEED); return; }
    static int grid = 0;
    if (!grid) {
        int dev = 0, cus = 0, per_cu = 0;
        (void)hipGetDevice(&dev);
        (void)hipDeviceGetAttribute(&cus, hipDeviceAttributeMultiprocessorCount, dev);
        (void)hipOccupancyMaxActiveBlocksPerMultiprocessor(&per_cu, (const void*)k_mega, 256, 0);
        if (per_cu < 1) per_cu = 1;
        grid = cus * (per_cu < 2 ? per_cu : 2);
    }
    P p{};
    const float** pp = (const float**)&p;
    for (int i = 0; i < 37; ++i) pp[i] = (const float*)d_in[i];
    p.out = (float*)d_out; p.ws = (char*)d_ws;
    (void)hipMemsetAsync(d_ws, 0, CTL_BYTES, stream);
    k_mega<<<dim3(grid), dim3(256), 0, stream>>>(p);
}
```

```cpp
#include <hip/hip_runtime.h>
#include <hip/hip_bf16.h>
#include <stdint.h>
#include <stdio.h>
#include <type_traits>

#define DEVINL __device__ __forceinline__
typedef unsigned short u16;
using bf16x8 = __attribute__((ext_vector_type(8))) short;
using f32x4 = __attribute__((ext_vector_type(4))) float;

constexpr int D = 1024, LAT = 16384, LCTX = 256, T = 33280, CTXROWS = 512;
constexpr int INP = 3536;
constexpr int NLAYER = 2;
constexpr float ALPHA = 1.41421356237309515f;
constexpr int NUNIT_CH = 520;
constexpr int NTC = 260;
constexpr int MAXSLOT = 70656;
constexpr int SMEM_BYTES = 81920;

constexpr size_t al(size_t x) { return (x + 255) & ~(size_t)255; }
constexpr size_t CTL_CNT = 16384;
constexpr size_t CTL_CUR = CTL_CNT + 256;
constexpr size_t CTL_CUKEY = 20480;
constexpr size_t CTL_BYTES = 32768;
constexpr size_t OFF_MOD = CTL_BYTES;
constexpr size_t OFF_ROPE = OFF_MOD + al(2 * 3 * 6144 * 4);
constexpr size_t OFF_WR = OFF_ROPE + al(10240 * 4);
constexpr size_t OFF_LORA = OFF_WR + al(2 * 128 * 1024 * 2);
constexpr size_t OFF_TILES = OFF_LORA + al(3 * 65536);
constexpr size_t OFF_TOKE = OFF_TILES + al((64 + 2048) * 4);
constexpr size_t OFF_TOKW = OFF_TOKE + al((size_t)T * 2 * 4);
constexpr size_t OFF_TOKS = OFF_TOKW + al((size_t)T * 2 * 4);
constexpr size_t OFF_SLOTTOK = OFF_TOKS + al((size_t)T * 2 * 4);
constexpr size_t OFF_X2CTX = OFF_SLOTTOK + al((size_t)MAXSLOT * 4);
constexpr size_t OFF_WIN = OFF_X2CTX + al((size_t)512 * 1024 * 4);
constexpr size_t OFF_WOUT = OFF_WIN + al((size_t)3584 * 1024 * 2);
constexpr size_t OFF_X1 = OFF_WOUT + al((size_t)1024 * 1024 * 2);
constexpr size_t OFF_HM = OFF_X1 + al((size_t)T * 1024 * 4);
constexpr size_t OFF_P = OFF_HM + al((size_t)T * 1024 * 2);
constexpr size_t OFF_PQK = OFF_P;
constexpr size_t OFF_VTL = OFF_PQK + (size_t)T * 1024 * 2;
constexpr size_t OFF_VTC = OFF_VTL + (size_t)2 * 8 * 64 * 16384 * 2;
constexpr size_t OFF_PB = OFF_VTC + (size_t)2 * 8 * 64 * 256 * 2;
constexpr size_t OFF_PC = OFF_PB + (size_t)T * 960 * 2;
constexpr size_t OFF_Y = OFF_PC + (size_t)T * 1040 * 2;
constexpr size_t OFF_MLF = OFF_Y + (size_t)T * 1024 * 2;
constexpr size_t OFF_GATE = OFF_MLF + (size_t)T * 512 * 2;
constexpr size_t OFF_MLG = OFF_GATE + (size_t)T * 256 * 2;
constexpr size_t OFF_MLS = OFF_MLG + (size_t)T * 16 * 4;
constexpr size_t OFF_MST = OFF_MLS + al(16 * 260 * 2 * 4);
constexpr size_t OFF_NST = OFF_MST + al(16 * 260 * 4);
constexpr size_t OFF_CST2 = OFF_NST + al(16 * 260 * 64 * 4);
constexpr size_t OFF_NST2 = OFF_CST2 + (size_t)16 * 260 * 4096 * 2;
constexpr size_t OFF_END1 = OFF_NST2 + al(16 * 260 * 64 * 4);
constexpr size_t OFF_WGU = OFF_P;
constexpr size_t OFF_WDN = OFF_WGU + (size_t)32 * 1024 * 1024 * 2;
constexpr size_t OFF_ACT = OFF_WDN + (size_t)32 * 1024 * 512 * 2;
constexpr size_t OFF_SLOTOUT = OFF_ACT + (size_t)MAXSLOT * 512 * 2;
constexpr size_t OFF_LOGITS = OFF_SLOTOUT + (size_t)MAXSLOT * 1024 * 2;
constexpr size_t OFF_END2 = OFF_LOGITS + (size_t)T * 64 * 4;
constexpr size_t WS_NEED = OFF_END1 > OFF_END2 ? OFF_END1 : OFF_END2;
static_assert(OFF_WDN <= OFF_Y, "Wexp must not overlap y");
static_assert(OFF_LOGITS >= OFF_MLF, "logits placement");

struct P {
    const float *x, *c, *ctx, *c_ctx, *w_mod, *b_mod, *w_in, *na_rpb, *mu_prev, *mu_next, *rw_w0, *rw_w2, *rw_a0, *rw_a2,
        *rw_g2, *rw_kk, *rw_ka, *rw_rk, *rw_lnw, *rw_lnb, *ml_cw, *ml_cb, *ml_ib, *ml_fb, *ml_nw, *w_out, *ln1g, *ln1b,
        *rgw, *rgb, *rew, *reb, *egate, *eup, *edown, *ln2g, *ln2b;
    float* out;
    char* ws;
};

#define XB_TMO      128
#define XB_XCNT(j)  (256  + 64 * (j))
#define XB_XSUB(j)  (1280 + 64 * (j))
#define XB_XGEN(j)  (2304 + 64 * (j))
#define XB_TOP      3328
#define XB_TOPGEN   3392
#define XCD_BAR_WORDS 3456
#define XB_SPIN_CAP (1u << 18)
#define LAS __attribute__((address_space(3)))

__device__ __forceinline__ unsigned xb_ld(unsigned* p)              { return __hip_atomic_load(p, __ATOMIC_RELAXED, __HIP_MEMORY_SCOPE_AGENT); }
__device__ __forceinline__ unsigned xb_add(unsigned* p, unsigned v) { return __hip_atomic_fetch_add(p, v, __ATOMIC_RELAXED, __HIP_MEMORY_SCOPE_AGENT); }
__device__ __forceinline__ unsigned xb_xcc_id() { return (unsigned)__builtin_amdgcn_s_getreg((3 << 11) | 20) & 0xFu; }
#define XB_SPIN(cond, bar) do { unsigned _sp = 0; while (cond) { __builtin_amdgcn_s_sleep(1); \
    if ((++_sp & 255u) == 0u) { if (xb_ld(&(bar)[XB_TMO])) break; if (_sp > XB_SPIN_CAP) { atomicAdd(&(bar)[XB_TMO], 1u); break; } } } } while (0)

struct XcdBarrier {
    unsigned* bar; unsigned x;
    volatile LAS unsigned* st;
};

__device__ __forceinline__ XcdBarrier xcd_barrier_post(unsigned* bar, volatile LAS unsigned* st) {
    XcdBarrier b; b.bar = bar; b.x = xb_xcc_id(); b.st = st;
    if (threadIdx.x == 0) (void)xb_add(&bar[XB_XCNT(b.x)], 1u);
    return b;
}
__device__ __forceinline__ void xcd_barrier_complete(unsigned* bar, unsigned x, unsigned& nloc, unsigned& nx) {
    const unsigned G = gridDim.x * gridDim.y * gridDim.z;
    unsigned sum, cnt, mine, sp = 0u;
    for (;;) {
        sum = 0u; cnt = 0u; mine = 0u;
#pragma unroll
        for (unsigned j = 0; j < 16; ++j) { const unsigned c = xb_ld(&bar[XB_XCNT(j)]); sum += c; cnt += (c > 0u) ? 1u : 0u; mine = (j == x) ? c : mine; }
        if (sum == G) break;
        __builtin_amdgcn_s_sleep(1);
        if ((++sp & 255u) == 0u) { if (xb_ld(&bar[XB_TMO])) break; if (sp > XB_SPIN_CAP) { atomicAdd(&bar[XB_TMO], 1u); break; } }
    }
    nloc = mine > 0u ? mine : 1u; nx = cnt > 0u ? cnt : 1u;
}

__device__ __forceinline__ void xcd_barrier(const XcdBarrier& b) {
    asm volatile("s_waitcnt vmcnt(0)" ::: "memory");
    __syncthreads();
    if (threadIdx.x == 0) {
        unsigned* bar = b.bar;
        __builtin_amdgcn_s_waitcnt(0);
        unsigned nloc = b.st[0], nx = b.st[1];
        if (nloc == 0u) { xcd_barrier_complete(bar, b.x, nloc, nx); b.st[0] = nloc; b.st[1] = nx; }
        const unsigned old = xb_add(&bar[XB_XSUB(b.x)], 1u);
        const unsigned gen = old / nloc;
        if (old + 1u == (gen + 1u) * nloc) {
            __builtin_amdgcn_fence(__ATOMIC_RELEASE, "agent");
            asm volatile("s_waitcnt vmcnt(0)" ::: "memory");
            const unsigned og = xb_add(&bar[XB_TOP], 1u);
            const unsigned tg = og / nx;
            if (og + 1u == (tg + 1u) * nx) xb_add(&bar[XB_TOPGEN], 1u);
            else XB_SPIN(xb_ld(&bar[XB_TOPGEN]) == tg, bar);
            __builtin_amdgcn_fence(__ATOMIC_ACQUIRE, "agent");
            xb_add(&bar[XB_XGEN(b.x)], 1u);
            asm volatile("s_waitcnt vmcnt(0)" ::: "memory");
        } else {
            XB_SPIN(xb_ld(&bar[XB_XGEN(b.x)]) == gen, bar);
            __builtin_amdgcn_fence(__ATOMIC_ACQUIRE, "agent");
            asm volatile("s_waitcnt vmcnt(0)" ::: "memory");
        }
    }
    __syncthreads();
}


DEVINL int tid_() { int t = threadIdx.x; asm volatile("" : "+v"(t)); return t; }
DEVINL int bid_() { int b = blockIdx.x; asm volatile("" : "+s"(b)); return b; }
#define GAS __attribute__((address_space(1)))
DEVINL char* wsl_(char* w) { GAS char* g = (GAS char*)w; asm volatile("" : "+s"(g)); return (char*)g; }
template <class Tp> DEVINL const Tp* gl_(const Tp* q) { const GAS Tp* g = (const GAS Tp*)q; asm volatile("" : "+s"(g)); return (const Tp*)g; }
typedef float f32x2_t __attribute__((ext_vector_type(2)));
typedef __bf16 bf16x2_t __attribute__((ext_vector_type(2)));
DEVINL unsigned pk2bf(float lo, float hi) { f32x2_t f = {lo, hi}; bf16x2_t b = __builtin_convertvector(f, bf16x2_t); return __builtin_bit_cast(unsigned, b); }
DEVINL u16 f2bf(float f) { return (u16)(pk2bf(f, f) & 0xFFFFu); }
DEVINL float bf2f(u16 h) { return __uint_as_float(((unsigned)h) << 16); }
DEVINL float wsum(float v) { for (int o = 32; o > 0; o >>= 1) v += __shfl_xor(v, o); return v; }
DEVINL float sigmoidf_(float x) { return 1.f / (1.f + __expf(-x)); }
DEVINL float siluf_(float x) { return x / (1.f + __expf(-x)); }
DEVINL float softplusf_(float x) { return fmaxf(x, 0.f) + log1pf(__expf(-fabsf(x))); }
DEVINL int row_sel(int row) { return row < CTXROWS ? 2 : ((row - CTXROWS) >> 14); }
template <int CTRL, int RM>
DEVINL float dpp_f(float v) { return __int_as_float(__builtin_amdgcn_update_dpp(0, __float_as_int(v), CTRL, RM, 0xF, false)); }
DEVINL float wave_sum_dpp(float v) {
    v += dpp_f<0xB1, 0xF>(v);
    v += dpp_f<0x4E, 0xF>(v);
    v += dpp_f<0x141, 0xF>(v);
    v += dpp_f<0x140, 0xF>(v);
    v += dpp_f<0x142, 0xA>(v);
    v += dpp_f<0x143, 0xC>(v);
    return __int_as_float(__builtin_amdgcn_readlane(__float_as_int(v), 63));
}
DEVINL unsigned lds_addr(const void* p) { return (unsigned)(size_t)(const __attribute__((address_space(3))) char*)p; }
using u32x4 = __attribute__((ext_vector_type(4))) unsigned;
using u32x2 = __attribute__((ext_vector_type(2))) unsigned;
template <int OFF> DEVINL u32x4 lds_rd128(unsigned a) { u32x4 v; asm volatile("ds_read_b128 %0, %1 offset:%2" : "=v"(v) : "v"(a), "n"(OFF)); return v; }
template <int OFF> DEVINL u32x2 lds_rd64(unsigned a) { u32x2 v; asm volatile("ds_read_b64 %0, %1 offset:%2" : "=v"(v) : "v"(a), "n"(OFF)); return v; }
DEVINL void glds4(const void* g, void* l) {
    __builtin_amdgcn_global_load_lds((const __attribute__((address_space(1))) void*)g, (__attribute__((address_space(3))) void*)l, 4, 0, 0);
}
DEVINL void glds16nt(const void* g, void* l) {
    __builtin_amdgcn_global_load_lds((const __attribute__((address_space(1))) void*)g, (__attribute__((address_space(3))) void*)l, 16, 0, 2);
}
DEVINL void glds16(const void* g, void* l) {
    __builtin_amdgcn_global_load_lds((const __attribute__((address_space(1))) void*)g, (__attribute__((address_space(3))) void*)l, 16, 0, 0);
}

template <class RowA>
DEVINL void gemm128_acc(RowA rowA, const u16* __restrict__ Bt, int ldb, int K, char* smem, f32x4 (&acc)[4][4]) {
    const int tid = tid_(), lane = tid & 63, wid = tid >> 6, wr = wid >> 1, wc = wid & 1, fr = lane & 15, fq = lane >> 4;
#pragma unroll
    for (int m = 0; m < 4; ++m)
#pragma unroll
        for (int n = 0; n < 4; ++n) acc[m][n] = f32x4{0.f, 0.f, 0.f, 0.f};
    const int sc = ((tid & 7) ^ ((tid >> 3) & 7)) * 8;
    const u16* aS[4]; const u16* bS[4];
#pragma unroll
    for (int i = 0; i < 4; ++i) { const int r = (tid >> 3) + 32 * i; aS[i] = rowA(r) + sc; bS[i] = Bt + (size_t)r * ldb + sc; }
    const int nt = K >> 6;
    __syncthreads();
#pragma unroll
    for (int i = 0; i < 4; ++i) { glds16(aS[i], smem + (tid + 256 * i) * 16); glds16(bS[i], smem + 16384 + (tid + 256 * i) * 16); }
    for (int t = 0; t < nt; ++t) {
        asm volatile("s_waitcnt vmcnt(0)" ::: "memory");
        __builtin_amdgcn_s_barrier();
        if (t + 1 < nt) {
            char* SA = smem + ((t + 1) & 1) * 32768;
            const int ko = (t + 1) * 64;
#pragma unroll
            for (int i = 0; i < 4; ++i) { glds16(aS[i] + ko, SA + (tid + 256 * i) * 16); glds16(bS[i] + ko, SA + 16384 + (tid + 256 * i) * 16); }
        }
        const char* SA = smem + (t & 1) * 32768; const char* SB = SA + 16384;
#pragma unroll
        for (int ks = 0; ks < 2; ++ks) {
            const int pos = ((ks * 4 + fq) ^ (fr & 7)) * 16;
            bf16x8 af[4], bfr[4];
#pragma unroll
            for (int m = 0; m < 4; ++m) af[m] = *(const bf16x8*)(SA + (wr * 64 + m * 16 + fr) * 128 + pos);
#pragma unroll
            for (int n = 0; n < 4; ++n) bfr[n] = *(const bf16x8*)(SB + (wc * 64 + n * 16 + fr) * 128 + pos);
#pragma unroll
            for (int m = 0; m < 4; ++m)
#pragma unroll
                for (int n = 0; n < 4; ++n) acc[m][n] = __builtin_amdgcn_mfma_f32_16x16x32_bf16(af[m], bfr[n], acc[m][n], 0, 0, 0);
        }
    }
}
template <class RowA, class Epi>
DEVINL void gemm128(RowA rowA, const u16* __restrict__ Bt, int ldb, int K, char* smem, Epi epi) {
    const int tid = tid_(), lane = tid & 63, wid = tid >> 6, wr = wid >> 1, wc = wid & 1, fr = lane & 15, fq = lane >> 4;
    f32x4 acc[4][4];
    gemm128_acc(rowA, Bt, ldb, K, smem, acc);
#pragma unroll
    for (int m = 0; m < 4; ++m)
#pragma unroll
        for (int n = 0; n < 4; ++n) epi(wr * 64 + m * 16 + fq * 4, wc * 64 + n * 16 + fr, acc[m][n]);
}

DEVINL void ph_prolog(const P& p, char* smem) {
    const int TIDX_ = tid_(); const int BIDX_ = bid_(); char* const WS_ = wsl_(p.ws); (void)TIDX_; (void)BIDX_; (void)WS_;
    const int tid = TIDX_;
    float* modv = (float*)(WS_ + OFF_MOD);
    float* sil = (float*)smem;
    float* red = sil + 3072;
    bool ready = false;
    for (int u = BIDX_; u < 192; u += gridDim.x) {
        if (!ready) {
            for (int i = tid; i < 3072; i += 256) { int v = i >> 10, k = i & 1023; float cv = v < 2 ? p.c[v * 1024 + k] : p.c_ctx[k]; sil[i] = cv / (1.f + expf(-cv)); }
            ready = true;
        }
        __syncthreads();
        const int l = u / 96, cg = u % 96;
        const float* W = p.w_mod + (size_t)l * 1024 * 6144 + cg * 64;
        const int c4 = (tid & 15) * 4, rg = tid >> 4;
        float a0[4] = {0, 0, 0, 0}, a1[4] = {0, 0, 0, 0}, a2[4] = {0, 0, 0, 0};
#pragma unroll 4
        for (int i = 0; i < 64; ++i) {
            const int k = rg + 16 * i;
            const float4 w = *(const float4*)(W + (size_t)k * 6144 + c4);
            const float s0 = sil[k], s1 = sil[1024 + k], s2 = sil[2048 + k];
            a0[0] += s0 * w.x; a0[1] += s0 * w.y; a0[2] += s0 * w.z; a0[3] += s0 * w.w;
            a1[0] += s1 * w.x; a1[1] += s1 * w.y; a1[2] += s1 * w.z; a1[3] += s1 * w.w;
            a2[0] += s2 * w.x; a2[1] += s2 * w.y; a2[2] += s2 * w.z; a2[3] += s2 * w.w;
        }
#pragma unroll
        for (int j = 0; j < 4; ++j) { red[(rg * 3 + 0) * 64 + c4 + j] = a0[j]; red[(rg * 3 + 1) * 64 + c4 + j] = a1[j]; red[(rg * 3 + 2) * 64 + c4 + j] = a2[j]; }
        __syncthreads();
        if (tid < 192) {
            const int v = tid >> 6, cc = tid & 63;
            float s = 0.f;
            for (int r = 0; r < 16; ++r) s += red[(r * 3 + v) * 64 + cc];
            const int col = cg * 64 + cc;
            modv[(l * 3 + v) * 6144 + col] = s + p.b_mod[l * 6144 + col];
        }
        __syncthreads();
    }
    float* rope = (float*)(WS_ + OFF_ROPE);
    for (int i = BIDX_ * 256 + tid; i < 320 * 16; i += gridDim.x * 256) {
        const int pos = (i < 4096) ? (i >> 4) : ((i - 4096) >> 4);
        const int f = i & 15;
        const float inv = powf(10000.0f, -(float)f / 16.0f);
        const float ang = (float)pos * inv;
        const double TWO_PI = 6.283185307179586476925;
        double a = (double)ang;
        a -= TWO_PI * rint(a / TWO_PI);
        const float cr = (float)cos(a), sr = (float)sin(a);
        if (i < 4096) { rope[i] = cr; rope[4096 + i] = sr; }
        else { rope[8192 + (i - 4096)] = cr; rope[8192 + 1024 + (i - 4096)] = sr; }
    }
    {
        u16* w2t = (u16*)(WS_ + OFF_LORA); u16* a2t = w2t + 2 * 2 * 256 * 32; u16* g2t = a2t + 2 * 2 * 256 * 32;
        for (int i = BIDX_ * 256 + tid; i < 2 * 2 * 256 * 32; i += gridDim.x * 256) {
            const int lz = i >> 13, c = (i >> 5) & 255, r = i & 31;
            w2t[i] = f2bf(p.rw_w2[((size_t)lz * 32 + r) * 256 + c]);
            a2t[i] = f2bf(p.rw_a2[((size_t)lz * 32 + r) * 256 + c]);
        }
        for (int i = BIDX_ * 256 + tid; i < 2 * 256 * 64; i += gridDim.x * 256) {
            const int l = i >> 14, c = (i >> 6) & 255, r = i & 63;
            g2t[i] = f2bf(p.rw_g2[((size_t)l * 64 + r) * 256 + c]);
        }
    }
    u16* wr = (u16*)(WS_ + OFF_WR);
    for (int i = BIDX_ * 256 + tid; i < 2 * 128 * 1024; i += gridDim.x * 256) {
        const int l = i >> 17, n = (i >> 10) & 127, k = i & 1023;
        float v = 0.f;
        if (n < 4) v = p.rgw[((size_t)l * 1024 + k) * 4 + n];
        else if (n < 36) v = p.rew[((size_t)l * 1024 + k) * 32 + (n - 4)];
        wr[i] = f2bf(v);
    }
}

DEVINL void conv_tile(const float* __restrict__ src, int N, int K, u16* __restrict__ dst, int k0, int n0, int mode, char* smem) {
    unsigned* t = (unsigned*)smem;
    const int tid = tid_();
    const int n4 = (tid & 15) * 4;
    const bool ok = n0 + n4 < N;
    float4 va[2], vb[2];
    __syncthreads();
#pragma unroll
    for (int i = 0; i < 2; ++i) {
        const int kp = i * 16 + (tid >> 4);
        const float* s0 = src + (size_t)(k0 + 2 * kp) * N + n0 + n4;
        va[i] = ok ? *(const float4*)s0 : make_float4(0.f, 0.f, 0.f, 0.f);
        vb[i] = ok ? *(const float4*)(s0 + N) : make_float4(0.f, 0.f, 0.f, 0.f);
    }
#pragma unroll
    for (int i = 0; i < 2; ++i) {
        const int kp = i * 16 + (tid >> 4);
        t[(n4 + 0) * 33 + kp] = pk2bf(va[i].x, vb[i].x);
        t[(n4 + 1) * 33 + kp] = pk2bf(va[i].y, vb[i].y);
        t[(n4 + 2) * 33 + kp] = pk2bf(va[i].z, vb[i].z);
        t[(n4 + 3) * 33 + kp] = pk2bf(va[i].w, vb[i].w);
    }
    __syncthreads();
    {
        const int n = tid >> 2, w0 = (tid & 3) * 8;
        const int ng = n0 + n;
        int nd = ng;
        if (mode == 1) nd = 32 * (ng >> 4) + (ng & 15);
        else if (mode == 2) nd = 32 * (ng >> 4) + 16 + (ng & 15);
        uint4 o0, o1;
        o0.x = t[n * 33 + w0 + 0]; o0.y = t[n * 33 + w0 + 1]; o0.z = t[n * 33 + w0 + 2]; o0.w = t[n * 33 + w0 + 3];
        o1.x = t[n * 33 + w0 + 4]; o1.y = t[n * 33 + w0 + 5]; o1.z = t[n * 33 + w0 + 6]; o1.w = t[n * 33 + w0 + 7];
        u16* q = dst + (size_t)nd * K + k0 + w0 * 2;
        *(uint4*)q = o0; *(uint4*)(q + 8) = o1;
    }
}
DEVINL void ph_convw(const P& p, int l, char* smem) {
    const int TIDX_ = tid_(); const int BIDX_ = bid_(); char* const WS_ = wsl_(p.ws); (void)TIDX_; (void)BIDX_; (void)WS_;
    u16* win = (u16*)(WS_ + OFF_WIN); u16* wout = (u16*)(WS_ + OFF_WOUT);
    for (int u = BIDX_; u < 896 + 256; u += gridDim.x) {
        if (u < 896) conv_tile(p.w_in + (size_t)l * 1024 * INP, INP, 1024, win, (u / 56) * 64, (u % 56) * 64, 0, smem);
        else { const int v = u - 896; conv_tile(p.w_out + (size_t)l * 1024 * 1024, 1024, 1024, wout, (v / 16) * 64, (v % 16) * 64, 0, smem); }
    }
}
DEVINL void ph_convexp(const P& p, int l, char* smem, int bid, int nb) {
    const int TIDX_ = tid_(); const int BIDX_ = bid_(); char* const WS_ = wsl_(p.ws); (void)TIDX_; (void)BIDX_; (void)WS_;
    u16* wgu = (u16*)(WS_ + OFF_WGU); u16* wdn = (u16*)(WS_ + OFF_WDN);
    for (int u = bid; u < 32 * 384; u += nb) {
        const int e = u / 384, v = u % 384;
        const size_t le = (size_t)l * 32 + e;
        if (v < 128) conv_tile(p.egate + le * 1024 * 512, 512, 1024, wgu + (size_t)e * 1024 * 1024, (v / 8) * 64, (v % 8) * 64, 1, smem);
        else if (v < 256) { const int w = v - 128; conv_tile(p.eup + le * 1024 * 512, 512, 1024, wgu + (size_t)e * 1024 * 1024, (w / 8) * 64, (w % 8) * 64, 2, smem); }
        else { const int w = v - 256; conv_tile(p.edown + le * 512 * 1024, 1024, 512, wdn + (size_t)e * 1024 * 512, (w / 16) * 64, (w % 16) * 64, 0, smem); }
    }
}

DEVINL void ph_xm0(const P& p) {
    const int TIDX_ = tid_(); const int BIDX_ = bid_(); char* const WS_ = wsl_(p.ws); (void)TIDX_; (void)BIDX_; (void)WS_;
    const float* modv = (const float*)(WS_ + OFF_MOD);
    u16* hm = (u16*)(WS_ + OFF_HM);
    for (size_t i = (size_t)BIDX_ * 256 + TIDX_; i < (size_t)T * 256; i += (size_t)gridDim.x * 256) {
        const int row = (int)(i >> 8), c4 = (int)(i & 255) * 4;
        const float* src = row < CTXROWS ? p.ctx + (size_t)row * 1024 : p.x + (size_t)(row - CTXROWS) * 1024;
        const float* mv = modv + row_sel(row) * 6144;
        const float4 v = *(const float4*)(src + c4);
        const float4 sh = *(const float4*)(mv + c4), sc = *(const float4*)(mv + 1024 + c4);
        uint2 o;
        o.x = (unsigned)f2bf(v.x * (1.f + sc.x) + sh.x) | ((unsigned)f2bf(v.y * (1.f + sc.y) + sh.y) << 16);
        o.y = (unsigned)f2bf(v.z * (1.f + sc.z) + sh.z) | ((unsigned)f2bf(v.w * (1.f + sc.w) + sh.w) << 16);
        *(uint2*)(hm + (size_t)row * 1024 + c4) = o;
    }
}

DEVINL void ph_inproj(const P& p, char* smem) {
    const int TIDX_ = tid_(); const int BIDX_ = bid_(); char* const WS_ = wsl_(p.ws); (void)TIDX_; (void)BIDX_; (void)WS_;
    const u16* hm = (const u16*)(WS_ + OFF_HM);
    const u16* win = (const u16*)(WS_ + OFF_WIN);
    u16* pqk = (u16*)(WS_ + OFF_PQK); u16* vtl = (u16*)(WS_ + OFF_VTL); u16* vtc = (u16*)(WS_ + OFF_VTC);
    u16* pb = (u16*)(WS_ + OFF_PB); u16* pc = (u16*)(WS_ + OFF_PC);
    for (int u = BIDX_; u < 260 * 28; u += gridDim.x) {
        const int mt = u / 28, nt = u % 28;
        const u16* A = hm + (size_t)mt * 128 * 1024;
        gemm128([&](int r) { return A + (size_t)r * 1024; }, win + (size_t)nt * 128 * 1024, 1024, 1024, smem,
                [&](int m, int n, f32x4 a) {
                    const int R = mt * 128 + m, N = nt * 128 + n;
                    if (N >= INP) return;
                    const u16 h0 = f2bf(a[0]), h1 = f2bf(a[1]), h2 = f2bf(a[2]), h3 = f2bf(a[3]);
                    if (N < 1024) {
                        u16* q = pqk + (size_t)R * 1024 + N; q[0] = h0; q[1024] = h1; q[2048] = h2; q[3072] = h3;
                    } else if (N < 1536) {
                        const int hh = (N - 1024) >> 6, d = (N - 1024) & 63;
                        uint2 v; v.x = (unsigned)h0 | ((unsigned)h1 << 16); v.y = (unsigned)h2 | ((unsigned)h3 << 16);
                        if (R < CTXROWS) { const int b = R >> 8, t = R & 255; *(uint2*)(vtc + ((size_t)((b * 8 + hh) * 64 + d)) * 256 + t) = v; }
                        else { const int R2 = R - CTXROWS, b = R2 >> 14, t = R2 & 16383; *(uint2*)(vtl + ((size_t)((b * 8 + hh) * 64 + d)) * 16384 + t) = v; }
                    } else if (N < 2496) {
                        u16* q = pb + (size_t)R * 960 + (N - 1536); q[0] = h0; q[960] = h1; q[1920] = h2; q[2880] = h3;
                    } else {
                        u16* q = pc + (size_t)R * 1040 + (N - 2496); q[0] = h0; q[1040] = h1; q[2080] = h2; q[3120] = h3;
                    }
                });
    }
}

constexpr size_t RWREC = 12288;
constexpr size_t RW_A1 = 0, RW_A4 = 2048, RW_A3 = 4096, RW_MKA = 8192, RW_TT = 8704, RW_MY = 9216, RW_V = 10240;
constexpr size_t OFF_RWOP = OFF_X1;
constexpr size_t OFF_RWWG = OFF_RWOP + (size_t)8 * 1040 * RWREC;
constexpr size_t OFF_YRWB = OFF_RWWG + (size_t)8 * 260 * 64 * 4;
constexpr size_t OFF_BONUS = OFF_YRWB + (size_t)T * 256 * 2;
static_assert(OFF_BONUS + (size_t)T * 4 * 4 <= OFF_HM, "rw operand store must fit the X1 region");

DEVINL float rw_mix(const u16* __restrict__ pb, const float* __restrict__ mup, const float* __restrict__ mun, int row, int t, int seqlen, int col) {
    const float cu = bf2f(pb[(size_t)row * 960 + col]);
    const float pr = t > 0 ? bf2f(pb[(size_t)(row - 1) * 960 + col]) : 0.f;
    const float nx = t + 1 < seqlen ? bf2f(pb[(size_t)(row + 1) * 960 + col]) : 0.f;
    return cu + mup[col] * (pr - cu) + mun[col] * (nx - cu);
}

DEVINL void rw_mix8(const u16* __restrict__ pb, const float* __restrict__ mup, const float* __restrict__ mun, int row, int t, int seqlen, int col0, float (&o)[8]) {
    const bool hp = t > 0, hn = t + 1 < seqlen;
    const u32x4 c = *(const u32x4*)(pb + (size_t)row * 960 + col0);
    u32x4 pv = *(const u32x4*)(pb + (size_t)(hp ? row - 1 : row) * 960 + col0);
    u32x4 nx = *(const u32x4*)(pb + (size_t)(hn ? row + 1 : row) * 960 + col0);
    const unsigned mpv = hp ? 0xFFFFFFFFu : 0u, mnx = hn ? 0xFFFFFFFFu : 0u;
    const f32x4 mp0 = *(const f32x4*)(mup + col0), mp1 = *(const f32x4*)(mup + col0 + 4), mn0 = *(const f32x4*)(mun + col0), mn1 = *(const f32x4*)(mun + col0 + 4);
#pragma unroll
    for (int i = 0; i < 4; ++i) {
        const unsigned cw = c[i], pw = pv[i] & mpv, nw = nx[i] & mnx;
        const float c0 = __uint_as_float(cw << 16), c1 = __uint_as_float(cw & 0xFFFF0000u);
        const float p0 = __uint_as_float(pw << 16), p1 = __uint_as_float(pw & 0xFFFF0000u);
        const float n0 = __uint_as_float(nw << 16), n1 = __uint_as_float(nw & 0xFFFF0000u);
        const float ma = (i < 2) ? mp0[2 * i] : mp1[2 * i - 4], mb = (i < 2) ? mp0[2 * i + 1] : mp1[2 * i - 3];
        const float na = (i < 2) ? mn0[2 * i] : mn1[2 * i - 4], nb = (i < 2) ? mn0[2 * i + 1] : mn1[2 * i - 3];
        o[2 * i] = c0 + ma * (p0 - c0) + na * (n0 - c0);
        o[2 * i + 1] = c1 + mb * (p1 - c1) + nb * (n1 - c1);
    }
}
DEVINL uint4 pack8bf(const float (&v)[8]) { return make_uint4(pk2bf(v[0], v[1]), pk2bf(v[2], v[3]), pk2bf(v[4], v[5]), pk2bf(v[6], v[7])); }

DEVINL void ph_rwprep(const P& p, int l, int d, char* smem, int bid, int nb) {
    const int TIDX_ = tid_(); const int BIDX_ = bid_(); char* const WS_ = wsl_(p.ws);
    const int tid = TIDX_, lane = tid & 63, w = tid >> 6, fr = lane & 15, fq = lane >> 4;
    const u16* pb = (const u16*)(WS_ + OFF_PB);
    char* rwop = WS_ + OFF_RWOP;
    float* rwwg = (float*)(WS_ + OFF_RWWG);
    float* bonus = (float*)(WS_ + OFF_BONUS);
    u16* gate = (u16*)(WS_ + OFF_GATE);
    const float* mup = p.mu_prev + l * 960; const float* mun = p.mu_next + l * 960;
    u16* lwdh = (u16*)smem;
    u16* ladh = lwdh + 2048;
    u16* abuf = ladh + 2048;
    float* Lb = (float*)(smem + 16384);
    u16* SV = (u16*)(smem + 32768);
    float* tot = (float*)(smem + 32768);
    const u16* w2t = (const u16*)(WS_ + OFF_LORA);
    const u16* a2t = w2t + 2 * 2 * 256 * 32;
    const u16* g2t = a2t + 2 * 2 * 256 * 32;
    const int z = d;
    for (int uh = bid; uh < NUNIT_CH * 4; uh += nb) {
        const int u = uh >> 2, h = uh & 3;
        int b, gi, row0, seqlen, gscan;
        if (u < 8) { b = u >> 2; gi = u & 3; row0 = b * 256 + gi * 64; seqlen = 256; gscan = d ? 3 - gi : gi; }
        else { b = (u - 8) >> 8; gi = (u - 8) & 255; row0 = CTXROWS + b * LAT + gi * 64; seqlen = LAT; gscan = 4 + (d ? 255 - gi : gi); }
        const int t0 = gi * 64;
        __syncthreads();
        {
            const int j = tid >> 2, cq = tid & 3;
            float v[8];
            rw_mix8(pb, mup, mun, row0 + j, t0 + j, seqlen, 768 + z * 32 + 8 * cq, v);
#pragma unroll
            for (int i = 0; i < 8; ++i) v[i] = tanhf(v[i]);
            *(uint4*)(lwdh + j * 32 + 8 * cq) = pack8bf(v);
            rw_mix8(pb, mup, mun, row0 + j, t0 + j, seqlen, 832 + z * 32 + 8 * cq, v);
            *(uint4*)(ladh + j * 32 + 8 * cq) = pack8bf(v);
        }
        if (d == 0) {
            u16* lgd = (u16*)Lb;
            {
                const int j = tid >> 2, cq = tid & 3;
#pragma unroll
                for (int hh = 0; hh < 2; ++hh) {
                    float v[8];
                    rw_mix8(pb, mup, mun, row0 + j, t0 + j, seqlen, 896 + 16 * cq + 8 * hh, v);
#pragma unroll
                    for (int i = 0; i < 8; ++i) v[i] = sigmoidf_(v[i]);
                    *(uint4*)(lgd + j * 64 + 16 * cq + 8 * hh) = pack8bf(v);
                }
            }
            __syncthreads();
            const bf16x8 x0 = *(const bf16x8*)(lgd + (16 * w + fr) * 64 + 8 * fq), x1 = *(const bf16x8*)(lgd + (16 * w + fr) * 64 + 32 + 8 * fq);
#pragma unroll
            for (int nt = 0; nt < 4; ++nt) {
                const u16* bp = g2t + ((size_t)l * 256 + 64 * h + 16 * nt + fr) * 64 + 8 * fq;
                const bf16x8 b0 = *(const bf16x8*)bp, b1 = *(const bf16x8*)(bp + 32);
                f32x4 acc = f32x4{0.f, 0.f, 0.f, 0.f};
                acc = __builtin_amdgcn_mfma_f32_16x16x32_bf16(x0, b0, acc, 0, 0, 0);
                acc = __builtin_amdgcn_mfma_f32_16x16x32_bf16(x1, b1, acc, 0, 0, 0);
#pragma unroll
                for (int r = 0; r < 4; ++r) gate[(size_t)(row0 + 16 * w + 4 * fq + r) * 256 + 64 * h + 16 * nt + fr] = f2bf(acc[r]);
            }
        }
        {
            const int bh = b * 4 + h;
            const int ch = h * 64 + lane;
            __syncthreads();
            {
                const bf16x8 xw = *(const bf16x8*)(lwdh + (16 * w + fr) * 32 + 8 * fq);
                const bf16x8 xa = *(const bf16x8*)(ladh + (16 * w + fr) * 32 + 8 * fq);
#pragma unroll 1
                for (int kt = 0; kt < 4; ++kt) {
                    const int key = 16 * kt + fr;
                    const size_t wrow = ((size_t)(l * 2 + z) * 256 + h * 64 + key) * 32 + 8 * fq;
                    const bf16x8 bw = *(const bf16x8*)(w2t + wrow), ba = *(const bf16x8*)(a2t + wrow);
                    f32x4 ae = f32x4{0.f, 0.f, 0.f, 0.f}, aa = f32x4{0.f, 0.f, 0.f, 0.f};
                    ae = __builtin_amdgcn_mfma_f32_16x16x32_bf16(xw, bw, ae, 0, 0, 0);
                    aa = __builtin_amdgcn_mfma_f32_16x16x32_bf16(xa, ba, aa, 0, 0, 0);
                    const float w0 = p.rw_w0[(l * 2 + z) * 256 + h * 64 + key], a0 = p.rw_a0[(l * 2 + z) * 256 + h * 64 + key];
#pragma unroll
                    for (int r = 0; r < 4; ++r) {
                        const int tok = 16 * w + 4 * fq + r;
                        const int s = d ? 63 - tok : tok;
                        Lb[s * 64 + key] = 0.60653065971263342f * sigmoidf_(ae[r] + w0);
                        abuf[tok * 64 + key] = f2bf(sigmoidf_(aa[r] + a0));
                    }
                }
            }
            __syncthreads();
            {
                float pre[16]; float run = 0.f;
#pragma unroll
                for (int i = 0; i < 16; ++i) { run += Lb[(16 * w + i) * 64 + lane]; pre[i] = run; }
                tot[w * 64 + lane] = run;
                __syncthreads();
                float offs = 0.f;
#pragma unroll
                for (int ww = 0; ww < 3; ++ww) offs += (ww < w) ? tot[ww * 64 + lane] : 0.f;
#pragma unroll
                for (int i = 0; i < 16; ++i) Lb[(16 * w + i) * 64 + lane] = -(offs + pre[i]);
            }
            __syncthreads();
            {
                const int j = tid >> 2, kq = tid & 3, row = row0 + j, tt = t0 + j;
                const int c0 = h * 64 + 16 * kq;
                float kr[16];
                { float t8[8];
                  rw_mix8(pb, mup, mun, row, tt, seqlen, 256 + c0, t8);
#pragma unroll
                  for (int i = 0; i < 8; ++i) kr[i] = t8[i];
                  rw_mix8(pb, mup, mun, row, tt, seqlen, 256 + c0 + 8, t8);
#pragma unroll
                  for (int i = 0; i < 8; ++i) kr[8 + i] = t8[i]; }
                float ss = 0.f;
#pragma unroll
                for (int i = 0; i < 16; ++i) { const float kv = kr[i] * p.rw_kk[l * 256 + c0 + i]; ss += kv * kv; }
                ss += __shfl_xor(ss, 1); ss += __shfl_xor(ss, 2);
                const float inorm = 1.f / fmaxf(sqrtf(ss), 1e-12f);
                const int sidx = d ? 63 - j : j;
                const int cch = sidx >> 4, ts = sidx & 15;
                u16* sv = SV + (size_t)(cch * 4) * 1024 + ts * 64 + 16 * kq;
                float bs = 0.f;
#pragma unroll 1
                for (int hh = 0; hh < 2; ++hh) {
                    const int cb = c0 + 8 * hh;
                    float rr[8], av[8], oa[8], orr[8], ob[8], ok[8];
                    rw_mix8(pb, mup, mun, row, tt, seqlen, cb, rr);
                    { const uint4 a0 = *(const uint4*)(abuf + j * 64 + 16 * kq + 8 * hh);
                      const unsigned aw[4] = {a0.x, a0.y, a0.z, a0.w};
#pragma unroll
                      for (int i = 0; i < 4; ++i) { av[2 * i] = __uint_as_float(aw[i] << 16); av[2 * i + 1] = __uint_as_float(aw[i] & 0xFFFF0000u); } }
#pragma unroll
                    for (int i4 = 0; i4 < 2; ++i4) {
                        const float4 Lt4 = *(const float4*)(Lb + sidx * 64 + 16 * kq + 8 * hh + 4 * i4);
                        const float4 Lp4 = sidx > 0 ? *(const float4*)(Lb + (sidx - 1) * 64 + 16 * kq + 8 * hh + 4 * i4) : make_float4(0.f, 0.f, 0.f, 0.f);
                        const float Lt[4] = {Lt4.x, Lt4.y, Lt4.z, Lt4.w}, Lp[4] = {Lp4.x, Lp4.y, Lp4.z, Lp4.w};
#pragma unroll
                        for (int ii = 0; ii < 4; ++ii) {
                            const int i = 4 * i4 + ii;
                            const float kraw = hh ? kr[8 + i] : kr[i];
                            const float kkn = kraw * p.rw_kk[l * 256 + cb + i] * inorm, a = av[i];
                            const float et = __expf(Lt[ii]), einv = __builtin_amdgcn_rcpf(et);
                            oa[i] = -kkn * __expf(Lp[ii]);
                            orr[i] = rr[i] * et;
                            ob[i] = kkn * a * einv;
                            ok[i] = kraw * (1.f + (a - 1.f) * p.rw_ka[l * 256 + cb + i]) * einv;
                            bs += rr[i] * kraw * p.rw_rk[l * 256 + cb + i];
                            if (sidx == 63) rwwg[((size_t)bh * 260 + gscan) * 64 + 16 * kq + 8 * hh + i] = et;
                        }
                    }
                    *(uint4*)(sv + 8 * hh) = pack8bf(oa);
                    *(uint4*)(sv + 1024 + 8 * hh) = pack8bf(orr);
                    *(uint4*)(sv + 2048 + 8 * hh) = pack8bf(ob);
                    *(uint4*)(sv + 3072 + 8 * hh) = pack8bf(ok);
                    rw_mix8(pb, mup, mun, row, tt, seqlen, 512 + cb, rr);
                    *(uint4*)(abuf + j * 64 + 16 * kq + 8 * hh) = pack8bf(rr);
                }
                if (d == 0) { bs += __shfl_xor(bs, 1); bs += __shfl_xor(bs, 2); if (kq == 0) bonus[(size_t)row * 4 + h] = bs; }
            }
            __syncthreads();
            {
                char* rec = rwop + ((size_t)bh * 1040 + (size_t)gscan * 4 + w) * RWREC;
                const u16* Av = SV + (size_t)(w * 4) * 1024; const u16* Rv = Av + 1024; const u16* Bv = Av + 2048; const u16* Kv = Av + 3072;
                bf16x8 fa[2], frr[2], fb[2], fk[2];
#pragma unroll
                for (int ks = 0; ks < 2; ++ks) {
                    fa[ks] = *(const bf16x8*)(Av + fr * 64 + ks * 32 + fq * 8);
                    frr[ks] = *(const bf16x8*)(Rv + fr * 64 + ks * 32 + fq * 8);
                    fb[ks] = *(const bf16x8*)(Bv + fr * 64 + ks * 32 + fq * 8);
                    fk[ks] = *(const bf16x8*)(Kv + fr * 64 + ks * 32 + fq * 8);
                }
                f32x4 mka = f32x4{0.f, 0.f, 0.f, 0.f}, mba = mka, mkr = mka, mbr = mka;
#pragma unroll
                for (int ks = 0; ks < 2; ++ks) {
                    mka = __builtin_amdgcn_mfma_f32_16x16x32_bf16(fa[ks], fk[ks], mka, 0, 0, 0);
                    mba = __builtin_amdgcn_mfma_f32_16x16x32_bf16(fa[ks], fb[ks], mba, 0, 0, 0);
                    mkr = __builtin_amdgcn_mfma_f32_16x16x32_bf16(frr[ks], fk[ks], mkr, 0, 0, 0);
                    mbr = __builtin_amdgcn_mfma_f32_16x16x32_bf16(frr[ks], fb[ks], mbr, 0, 0, 0);
                }
                float* Ns = Lb + w * 256;
                u16* rmka = (u16*)(rec + RW_MKA); u16* rmy = (u16*)(rec + RW_MY); u16* rtt = (u16*)(rec + RW_TT);
                const int i_ = fr;
#pragma unroll
                for (int r = 0; r < 4; ++r) {
                    const int t_ = 4 * fq + r;
                    const int lp = (i_ >> 2) * 16 + t_;
                    rmka[lp * 4 + (i_ & 3)] = f2bf(i_ < t_ ? mka[r] : 0.f);
                    rmy[lp * 8 + (i_ & 3)] = f2bf(i_ <= t_ ? mbr[r] : 0.f);
                    rmy[lp * 8 + 4 + (i_ & 3)] = f2bf(i_ <= t_ ? mkr[r] : 0.f);
                    Ns[t_ * 16 + i_] = i_ < t_ ? mba[r] : 0.f;
                }
                if (lane < 16) {
                    float Tr[16];
#pragma unroll
                    for (int t_ = 0; t_ < 16; ++t_) {
                        float acc = (lane == t_) ? 1.f : 0.f;
#pragma unroll
                        for (int ii = 0; ii < t_; ++ii) acc += Tr[ii] * Ns[t_ * 16 + ii];
                        Tr[t_] = acc;
                        rtt[((lane >> 2) * 16 + t_) * 4 + (lane & 3)] = f2bf(acc);
                    }
                }
#pragma unroll
                for (int ks = 0; ks < 2; ++ks) {
                    uint4 o;
                    const uint2 lo = *(const uint2*)(Av + fr * 64 + 32 * ks + 4 * fq), hi = *(const uint2*)(Av + fr * 64 + 32 * ks + 16 + 4 * fq);
                    o.x = lo.x; o.y = lo.y; o.z = hi.x; o.w = hi.y;
                    *(uint4*)(rec + RW_A1 + (ks * 64 + lane) * 16) = o;
                    const uint2 lo2 = *(const uint2*)(Rv + fr * 64 + 32 * ks + 4 * fq), hi2 = *(const uint2*)(Rv + fr * 64 + 32 * ks + 16 + 4 * fq);
                    o.x = lo2.x; o.y = lo2.y; o.z = hi2.x; o.w = hi2.y;
                    *(uint4*)(rec + RW_A4 + (ks * 64 + lane) * 16) = o;
                }
#pragma unroll
                for (int m = 0; m < 4; ++m) {
                    unsigned e[8];
#pragma unroll
                    for (int j = 0; j < 4; ++j) { e[j] = Bv[(4 * fq + j) * 64 + 16 * m + fr]; e[4 + j] = Kv[(4 * fq + j) * 64 + 16 * m + fr]; }
                    uint4 o; o.x = e[0] | (e[1] << 16); o.y = e[2] | (e[3] << 16); o.z = e[4] | (e[5] << 16); o.w = e[6] | (e[7] << 16);
                    *(uint4*)(rec + RW_A3 + (m * 64 + lane) * 16) = o;
                }
#pragma unroll
                for (int q = 0; q < 4; ++q) {
                    unsigned e[4];
#pragma unroll
                    for (int j = 0; j < 4; ++j) {
                        const int s = 16 * w + 4 * fq + j; const int jt = d ? 63 - s : s;
                        e[j] = abuf[jt * 64 + 16 * q + fr];
                    }
                    uint2 o; o.x = e[0] | (e[1] << 16); o.y = e[2] | (e[3] << 16);
                    *(uint2*)(rec + RW_V + (q * 64 + lane) * 8) = o;
                }
            }
        }
    }
}

constexpr int RWSLOT = 12544;
DEVINL void ph_rwscan(const P& p, int l, int d, int bid, int nb, char* smem) {
    const int TIDX_ = tid_(); char* const WS_ = wsl_(p.ws);
    const int tid = TIDX_, lane = tid & 63, q = tid >> 6, fr = lane & 15, fq = lane >> 4;
    const char* rwop = WS_ + OFF_RWOP;
    const float* rwwg = (const float*)(WS_ + OFF_RWWG);
    u16* yf = (u16*)(WS_ + OFF_Y);
    u16* yb = (u16*)(WS_ + OFF_YRWB);
    (void)l;
    for (int bh = bid; bh < 8; bh += nb) {
        const int b = bh >> 2, h = bh & 3;
        f32x4 z[4];
#pragma unroll
        for (int m = 0; m < 4; ++m) z[m] = f32x4{0.f, 0.f, 0.f, 0.f};
        const char* rec0 = rwop + (size_t)bh * 1040 * RWREC;
        const float* wg0 = rwwg + (size_t)bh * 260 * 64;
        auto issue = [&](int c, int sl) {
            const int cc = c < 1040 ? c : 1039;
            char* slot = smem + sl * RWSLOT;
            const char* rec = rec0 + (size_t)cc * RWREC;
#pragma unroll
            for (int i = 0; i < 3; ++i) glds16(rec + (tid + 256 * i) * 16, slot + (tid + 256 * i) * 16);
            glds4((const char*)(wg0 + (size_t)(cc >> 2) * 64) + lane * 4, slot + 12288 + lane * 4);
        };
        auto asfrag = [](uint4 v) { union { uint4 u; bf16x8 f; } x; x.u = v; return x.f; };
        auto pack2 = [](float lo, float hi) { return pk2bf(lo, hi); };
        const unsigned b128 = lds_addr(smem) + lane * 16, b64 = lds_addr(smem) + lane * 8, bv = lds_addr(smem) + (q * 64 + lane) * 8, bg = lds_addr(smem) + 16 * fq;
        __syncthreads();
        __builtin_amdgcn_s_setprio(3);
        issue(0, 0); issue(1, 1); issue(2, 2); issue(3, 3); issue(4, 4);
#pragma unroll 1
        for (int c5 = 0; c5 < 1044; c5 += 6) {
          auto body = [&](auto SJ) {
            constexpr int sj = decltype(SJ)::value;
            const int c = c5 + sj;
            asm volatile("s_waitcnt vmcnt(16)" ::: "memory");
            __builtin_amdgcn_s_barrier();
            issue(c + 5, (sj + 5) % 6);
            if (c < 1040) {
            constexpr int SB = (sj % 3) * RWSLOT;
            constexpr unsigned SH = (sj / 3) * 3 * RWSLOT;
            u32x4 r_a10, r_a11, r_a40, r_a41, r_a30, r_a31, r_a32, r_a33, r_my, g0, g1, g2, g3;
            u32x2 mka, tt, vcur;
            asm volatile(
                "ds_read_b64 %0, %4 offset:%6+8192\n\t"
                "ds_read_b64 %1, %5 offset:%6+10240\n\t"
                "ds_read_b128 %2, %7 offset:%6+0\n\t"
                "ds_read_b128 %3, %7 offset:%6+1024\n\t"
                "s_waitcnt lgkmcnt(0)"
                : "=&v"(mka), "=&v"(vcur), "=&v"(r_a10), "=&v"(r_a11)
                : "v"(b64 + SH), "v"(bv + SH), "n"(SB), "v"(b128 + SH)
                : "memory");
            auto asfrag4 = [](u32x4 v) { union { u32x4 u; bf16x8 f; } x; x.u = v; return x.f; };
            const bf16x8 A1_0 = asfrag4(r_a10), A1_1 = asfrag4(r_a11);
            const bf16x8 MKA = asfrag(make_uint4(mka.x, mka.y, 0u, 0u));
            const bf16x8 VB = asfrag(make_uint4(vcur.x, vcur.y, 0u, 0u));
            const bf16x8 ZB0 = asfrag(make_uint4(pack2(z[0][0], z[0][1]), pack2(z[0][2], z[0][3]), pack2(z[1][0], z[1][1]), pack2(z[1][2], z[1][3])));
            const bf16x8 ZB1 = asfrag(make_uint4(pack2(z[2][0], z[2][1]), pack2(z[2][2], z[2][3]), pack2(z[3][0], z[3][1]), pack2(z[3][2], z[3][3])));
            f32x4 X = f32x4{0.f, 0.f, 0.f, 0.f};
            X = __builtin_amdgcn_mfma_f32_16x16x32_bf16(MKA, VB, X, 0, 0, 0);
            X = __builtin_amdgcn_mfma_f32_16x16x32_bf16(A1_0, ZB0, X, 0, 0, 0);
            X = __builtin_amdgcn_mfma_f32_16x16x32_bf16(A1_1, ZB1, X, 0, 0, 0);
            asm volatile(
                "ds_read_b64 %0, %13 offset:%15+8704\n\t"
                "ds_read_b128 %1, %12 offset:%15+2048\n\t"
                "ds_read_b128 %2, %12 offset:%15+3072\n\t"
                "ds_read_b128 %3, %12 offset:%15+4096\n\t"
                "ds_read_b128 %4, %12 offset:%15+5120\n\t"
                "ds_read_b128 %5, %12 offset:%15+6144\n\t"
                "ds_read_b128 %6, %12 offset:%15+7168\n\t"
                "ds_read_b128 %7, %12 offset:%15+9216\n\t"
                "ds_read_b128 %8, %14 offset:%15+12288\n\t"
                "ds_read_b128 %9, %14 offset:%15+12352\n\t"
                "ds_read_b128 %10, %14 offset:%15+12416\n\t"
                "ds_read_b128 %11, %14 offset:%15+12480\n\t"
                "s_waitcnt lgkmcnt(0)"
                : "=&v"(tt), "=&v"(r_a40), "=&v"(r_a41), "=&v"(r_a30), "=&v"(r_a31), "=&v"(r_a32), "=&v"(r_a33), "=&v"(r_my),
                  "=&v"(g0), "=&v"(g1), "=&v"(g2), "=&v"(g3)
                : "v"(b128 + SH), "v"(b64 + SH), "v"(bg + SH), "n"(SB)
                : "memory");
            const bf16x8 A4_0 = asfrag4(r_a40), A4_1 = asfrag4(r_a41);
            const bf16x8 A3_0 = asfrag4(r_a30), A3_1 = asfrag4(r_a31), A3_2 = asfrag4(r_a32), A3_3 = asfrag4(r_a33), MY = asfrag4(r_my);
            const bf16x8 TT = asfrag(make_uint4(tt.x, tt.y, 0u, 0u));
            f32x4 Y = f32x4{0.f, 0.f, 0.f, 0.f};
            Y = __builtin_amdgcn_mfma_f32_16x16x32_bf16(A4_0, ZB0, Y, 0, 0, 0);
            Y = __builtin_amdgcn_mfma_f32_16x16x32_bf16(A4_1, ZB1, Y, 0, 0, 0);
            const bf16x8 XB = asfrag(make_uint4(pack2(X[0], X[1]), pack2(X[2], X[3]), 0u, 0u));
            f32x4 U = f32x4{0.f, 0.f, 0.f, 0.f};
            U = __builtin_amdgcn_mfma_f32_16x16x32_bf16(TT, XB, U, 0, 0, 0);
            const bf16x8 UV = asfrag(make_uint4(pack2(U[0], U[1]), pack2(U[2], U[3]), vcur.x, vcur.y));
            z[0] = __builtin_amdgcn_mfma_f32_16x16x32_bf16(A3_0, UV, z[0], 0, 0, 0);
            z[1] = __builtin_amdgcn_mfma_f32_16x16x32_bf16(A3_1, UV, z[1], 0, 0, 0);
            z[2] = __builtin_amdgcn_mfma_f32_16x16x32_bf16(A3_2, UV, z[2], 0, 0, 0);
            z[3] = __builtin_amdgcn_mfma_f32_16x16x32_bf16(A3_3, UV, z[3], 0, 0, 0);
            Y = __builtin_amdgcn_mfma_f32_16x16x32_bf16(MY, UV, Y, 0, 0, 0);
            if ((c & 3) == 3) {
                z[0][0] *= __uint_as_float(g0.x); z[0][1] *= __uint_as_float(g0.y); z[0][2] *= __uint_as_float(g0.z); z[0][3] *= __uint_as_float(g0.w);
                z[1][0] *= __uint_as_float(g1.x); z[1][1] *= __uint_as_float(g1.y); z[1][2] *= __uint_as_float(g1.z); z[1][3] *= __uint_as_float(g1.w);
                z[2][0] *= __uint_as_float(g2.x); z[2][1] *= __uint_as_float(g2.y); z[2][2] *= __uint_as_float(g2.z); z[2][3] *= __uint_as_float(g2.w);
                z[3][0] *= __uint_as_float(g3.x); z[3][1] *= __uint_as_float(g3.y); z[3][2] *= __uint_as_float(g3.z); z[3][3] *= __uint_as_float(g3.w);
            }
            {
                const bool isctx = c < 16;
                const int cc = isctx ? c : c - 16;
                const int n = isctx ? LCTX : LAT;
                const int rowbase = isctx ? b * LCTX : CTXROWS + b * LAT;
                const unsigned y01 = pk2bf(Y[0], Y[1]), y23 = pk2bf(Y[2], Y[3]);
#pragma unroll
                for (int r = 0; r < 4; ++r) {
                    const int s = cc * 16 + 4 * fq + r;
                    const int t = d ? n - 1 - s : s;
                    const u16 o = (u16)(((r < 2 ? y01 : y23) >> ((r & 1) * 16)) & 0xFFFFu);
                    u16* dst = d == 0 ? yf + (size_t)(rowbase + t) * 1024 + 512 + h * 64 + 16 * q + fr : yb + (size_t)(rowbase + t) * 256 + h * 64 + 16 * q + fr;
                    *dst = o;
                }
            }
            }
          };
          body(std::integral_constant<int, 0>{}); body(std::integral_constant<int, 1>{}); body(std::integral_constant<int, 2>{});
          body(std::integral_constant<int, 3>{}); body(std::integral_constant<int, 4>{}); body(std::integral_constant<int, 5>{});
        }
        asm volatile("s_waitcnt vmcnt(0)" ::: "memory");
        __builtin_amdgcn_s_setprio(0);
        __syncthreads();
    }
}

DEVINL void ph_rwout(const P& p, int l) {
    const int TIDX_ = tid_(); const int BIDX_ = bid_(); char* const WS_ = wsl_(p.ws);
    const int tid = TIDX_, h = tid >> 6;
    const u16* pb = (const u16*)(WS_ + OFF_PB);
    const u16* yb = (const u16*)(WS_ + OFF_YRWB);
    const u16* gate = (const u16*)(WS_ + OFF_GATE);
    const float* bonus = (const float*)(WS_ + OFF_BONUS);
    u16* y = (u16*)(WS_ + OFF_Y);
    const float* mup = p.mu_prev + l * 960; const float* mun = p.mu_next + l * 960;
    const float lw = p.rw_lnw[l * 256 + tid], lb = p.rw_lnb[l * 256 + tid];
    const int rstart = (l == 0) ? 0 : CTXROWS;
    for (int row = rstart + BIDX_; row < T; row += gridDim.x) {
        int t, seqlen;
        if (row < CTXROWS) { t = row & 255; seqlen = LCTX; } else { t = (row - CTXROWS) & (LAT - 1); seqlen = LAT; }
        const float yv = bf2f(y[(size_t)row * 1024 + 512 + tid]) + bf2f(yb[(size_t)row * 256 + tid]);
        const float v = rw_mix(pb, mup, mun, row, t, seqlen, 512 + tid);
        const float mu = wsum(yv) * (1.f / 64.f);
        const float dl = yv - mu;
        const float var = wsum(dl * dl) * (1.f / 64.f);
        const float o = (dl * rsqrtf(var + 64e-5f) * lw + lb + bonus[(size_t)row * 4 + h] * v) * bf2f(gate[(size_t)row * 256 + tid]);
        y[(size_t)row * 1024 + 512 + tid] = f2bf(o);
    }
}
DEVINL void ph_prepM(const P& p, int l, char* smem, int bid, int nb) {
    const int TIDX_ = tid_(); const int BIDX_ = bid_(); char* const WS_ = wsl_(p.ws);
    const int tid = TIDX_, lane = tid & 63, wid = tid >> 6;
    const u16* pc = (const u16*)(WS_ + OFF_PC);
    u16* mlf = (u16*)(WS_ + OFF_MLF);
    float* mlg = (float*)(WS_ + OFF_MLG);
    float* mls = (float*)(WS_ + OFF_MLS);
    float* nst = (float*)(WS_ + OFF_NST);
    float* cst = (float*)(WS_ + OFF_HM);
    const float* rope = (const float*)(WS_ + OFF_ROPE);
    u16* kl = (u16*)smem;
    u16* vl = kl + 4096;
    float* wsl = (float*)(vl + 4096);
    float* lil = wsl + 128;
    for (int uh = bid; uh < NUNIT_CH * 4; uh += nb) {
        const int u = uh >> 2, h = uh & 3;
        int b, ch, row0, seqlen; bool isctx;
        if (u < 8) { isctx = true; b = u >> 2; ch = u & 3; row0 = b * 256 + ch * 64; seqlen = 256; }
        else { isctx = false; b = (u - 8) >> 8; ch = (u - 8) & 255; row0 = CTXROWS + b * LAT + ch * 64; seqlen = LAT; }
        const int t0 = ch * 64;
        const int tc = isctx ? ch : 4 + ch;
        __syncthreads();
        {
            const bool isk = wid >= 2;
            const int cch = (isk ? 256 : 0) + h * 64 + lane;
            const float* cw = p.ml_cw + (size_t)l * 3 * 512;
            const float w0 = cw[cch], w1 = cw[512 + cch], w2 = cw[1024 + cch], bb = p.ml_cb[l * 512 + cch];
            const int jb = (wid & 1) * 32;
            const int i16 = lane & 15; const bool second = (lane & 16) != 0; const int half = lane >> 5;
            float pv = (t0 + jb > 0) ? bf2f(pc[(size_t)(row0 + jb - 1) * 1040 + cch]) : 0.f;
            float cv = bf2f(pc[(size_t)(row0 + jb) * 1040 + cch]);
#pragma unroll 4
            for (int jj = 0; jj < 32; ++jj) {
                const int j = jb + jj;
                const float nv = (t0 + j + 1 < seqlen) ? bf2f(pc[(size_t)(row0 + j + 1) * 1040 + cch]) : 0.f;
                float val = siluf_(w0 * pv + w1 * cv + w2 * nv + bb);
                if (!isctx) {
                    const int t = t0 + j;
                    const int pos = half == 0 ? (t >> 6) : (t & 63);
                    const float cs = half == 0 ? rope[pos * 16 + i16] : rope[8192 + pos * 16 + i16];
                    const float sn = half == 0 ? rope[4096 + pos * 16 + i16] : rope[9216 + pos * 16 + i16];
                    const float ov = __shfl_xor(val, 16);
                    val = second ? (ov * sn + val * cs) : (val * cs - ov * sn);
                }
                if (isk) { const u16 kb = f2bf(val * 0.125f); mlf[(size_t)(row0 + j) * 512 + 256 + h * 64 + lane] = kb; kl[j * 64 + lane] = kb; }
                else mlf[(size_t)(row0 + j) * 512 + h * 64 + lane] = f2bf(val);
                pv = cv; cv = nv;
            }
            {
                const int j = tid >> 2, wh = tid & 3;
                const int idx = (wh < 2) ? (wh * 4 + h) : (8 + (wh - 2) * 4 + h);
                const float g = bf2f(pc[(size_t)(row0 + j) * 1040 + 1024 + idx]);
                float v;
                if (wh < 2) v = g + p.ml_ib[l * 8 + idx];
                else { const float xx = g + p.ml_fb[l * 8 + idx - 8]; v = fminf(xx, 0.f) - log1pf(__expf(-fabsf(xx))); }
                lil[j * 4 + wh] = v;
                mlg[(size_t)(row0 + j) * 16 + idx] = v;
            }
            for (int i = tid; i < 64 * 16; i += 256) {
                const int tok = i >> 4, c4 = (i & 15) * 4;
                *(uint2*)(vl + tok * 64 + c4) = *(const uint2*)(pc + (size_t)(row0 + tok) * 1040 + 512 + h * 64 + c4);
            }
        }
        __syncthreads();
        if (tid < 2) {
            const int d = tid;
            float bacc = 0.f;
#pragma unroll 1
            for (int jj = 0; jj < 64; ++jj) { const int tok = d ? 63 - jj : jj; bacc += lil[tok * 4 + 2 + d]; wsl[d * 64 + tok] = bacc; }
            const float Bs = bacc;
            float G = -3.0e38f;
#pragma unroll 1
            for (int tok = 0; tok < 64; ++tok) { const float g = Bs - wsl[d * 64 + tok] + lil[tok * 4 + d]; G = fmaxf(G, g); }
#pragma unroll 1
            for (int tok = 0; tok < 64; ++tok) { const float g = Bs - wsl[d * 64 + tok] + lil[tok * 4 + d]; wsl[d * 64 + tok] = expf(g - G); }
            const int bhd = (b * 4 + h) * 2 + d;
            mls[(bhd * NTC + tc) * 2 + 0] = G; mls[(bhd * NTC + tc) * 2 + 1] = Bs;
        }
        __syncthreads();
        {
            const int dk4 = (tid >> 4) * 4, dv4 = (tid & 15) * 4;
            float a0[4][4], a1[4][4], n0[4], n1[4];
#pragma unroll
            for (int a = 0; a < 4; ++a) { n0[a] = 0.f; n1[a] = 0.f;
#pragma unroll
                for (int c = 0; c < 4; ++c) { a0[a][c] = 0.f; a1[a][c] = 0.f; } }
#pragma unroll 2
            for (int j = 0; j < 64; ++j) {
                const uint2 kk = *(const uint2*)(kl + j * 64 + dk4);
                const uint2 vv = *(const uint2*)(vl + j * 64 + dv4);
                const float w0 = wsl[j], w1 = wsl[64 + j];
                const float kf[4] = {bf2f((u16)(kk.x & 0xFFFF)), bf2f((u16)(kk.x >> 16)), bf2f((u16)(kk.y & 0xFFFF)), bf2f((u16)(kk.y >> 16))};
                const float vf[4] = {bf2f((u16)(vv.x & 0xFFFF)), bf2f((u16)(vv.x >> 16)), bf2f((u16)(vv.y & 0xFFFF)), bf2f((u16)(vv.y >> 16))};
#pragma unroll
                for (int a = 0; a < 4; ++a) {
                    const float k0 = kf[a] * w0, k1 = kf[a] * w1;
                    n0[a] += k0; n1[a] += k1;
#pragma unroll
                    for (int c = 0; c < 4; ++c) { a0[a][c] += k0 * vf[c]; a1[a][c] += k1 * vf[c]; }
                }
            }
            const int bh0 = ((b * 4 + h) * 2 + 0) * NTC + tc, bh1 = ((b * 4 + h) * 2 + 1) * NTC + tc;
#pragma unroll
            for (int a = 0; a < 4; ++a) {
                *(float4*)(cst + (size_t)bh0 * 4096 + (dk4 + a) * 64 + dv4) = make_float4(a0[a][0], a0[a][1], a0[a][2], a0[a][3]);
                *(float4*)(cst + (size_t)bh1 * 4096 + (dk4 + a) * 64 + dv4) = make_float4(a1[a][0], a1[a][1], a1[a][2], a1[a][3]);
                if ((tid & 15) == 0) { nst[(size_t)bh0 * 64 + dk4 + a] = n0[a]; nst[(size_t)bh1 * 64 + dk4 + a] = n1[a]; }
            }
        }
    }
}

DEVINL void ph_mlB(const P& p, int bid, int nb, char* smem) {
    const int TIDX_ = tid_(); char* const WS_ = wsl_(p.ws);
    const int tid = TIDX_;
    const float* mls = (const float*)(WS_ + OFF_MLS);
    float* mst = (float*)(WS_ + OFF_MST);
    float* nst = (float*)(WS_ + OFF_NST);
    const float* cst = (const float*)(WS_ + OFF_HM);
    u16* cst2 = (u16*)(WS_ + OFF_CST2);
    float* nst2 = (float*)(WS_ + OFF_NST2);
    float* gb = (float*)smem;
    float* dcu = gb + 1024;
    for (int u = bid; u < 64; u += nb) {
        const int bhd = u >> 2, q = u & 3, d = bhd & 1;
        auto tcof = [&](int cs) { return cs < 4 ? (d ? 3 - cs : cs) : 4 + (d ? 255 - (cs - 4) : cs - 4); };
        __syncthreads();
        for (int cs = tid; cs < NTC; cs += 256) { const int tc = tcof(cs); gb[cs * 2] = mls[(bhd * NTC + tc) * 2]; gb[cs * 2 + 1] = mls[(bhd * NTC + tc) * 2 + 1]; }
        __syncthreads();
        if (tid == 0) {
            float m = 0.f;
#pragma unroll 1
            for (int cs = 0; cs < NTC; ++cs) {
                const float G = gb[cs * 2], Bs = gb[cs * 2 + 1];
                if (q == 0) mst[bhd * NTC + tcof(cs)] = m;
                const float ml = fmaxf(Bs + m, G);
                dcu[cs * 2] = __expf(Bs + m - ml); dcu[cs * 2 + 1] = __expf(G - ml);
                m = ml;
            }
        }
        __syncthreads();
        float zz = 0.f; asm volatile("" : "+v"(zz));
        float4 C = make_float4(zz, zz, zz, zz);
        float nn = zz;
        const bool don = (q == 0) && (tid < 64);
        const float* cbase = cst + (size_t)bhd * NTC * 4096 + q * 1024 + tid * 4;
        const float* nbase = nst + (size_t)bhd * NTC * 64 + tid;
        u16* obase = cst2 + (size_t)bhd * NTC * 4096 + q * 1024 + tid * 4;
        float* onbase = nst2 + (size_t)bhd * NTC * 64 + tid;
        float4 Ub[8]; float Nb[8];
#pragma unroll
        for (int i = 0; i < 8; ++i) { Ub[i] = *(const float4*)(cbase + (size_t)tcof(i) * 4096); Nb[i] = don ? nbase[(size_t)tcof(i) * 64] : 0.f; }
#pragma unroll 1
        for (int cs0 = 0; cs0 < NTC; cs0 += 8) {
#pragma unroll
            for (int i = 0; i < 8; ++i) {
                const int cs = cs0 + i;
                if (cs < NTC) {
                    const float4 U = Ub[i]; const float nU = Nb[i];
                    const int tc = tcof(cs);
                    if (cs + 8 < NTC) { Ub[i] = *(const float4*)(cbase + (size_t)tcof(cs + 8) * 4096); Nb[i] = don ? nbase[(size_t)tcof(cs + 8) * 64] : 0.f; }
                    { uint2 o; o.x = pk2bf(C.x, C.y); o.y = pk2bf(C.z, C.w); *(uint2*)(obase + (size_t)tc * 4096) = o; }
                    if (don) onbase[(size_t)tc * 64] = nn;
                    const float dC = dcu[cs * 2], dU = dcu[cs * 2 + 1];
                    C.x = dC * C.x + dU * U.x; C.y = dC * C.y + dU * U.y; C.z = dC * C.z + dU * U.z; C.w = dC * C.w + dU * U.w;
                    nn = dC * nn + dU * nU;
                }
            }
        }
    }
}

DEVINL void ph_na(const P& p, int l, char* smem, int bid, int nb) {
    const int TIDX_ = tid_(); char* const WS_ = wsl_(p.ws);
    const int tid = TIDX_, lane = tid & 63, w = tid >> 6, fr = lane & 15, g = lane >> 4;
    const u16* pqk = (const u16*)(WS_ + OFF_PQK);
    const u16* vtl = (const u16*)(WS_ + OFF_VTL);
    const u16* vtc = (const u16*)(WS_ + OFF_VTC);
    u16* y = (u16*)(WS_ + OFF_Y);
    float* rpbl = (float*)(smem + 49152);
    const int nunit = 4096 + (l == 0 ? 64 : 0);
    const unsigned lbase = lds_addr(smem);
    const int lrow0 = tid >> 3, lrow1 = lrow0 + 32, lsc = ((tid & 7) ^ (lrow0 & 7)) * 8;
    for (int u = bid; u < nunit; u += nb) {
        const bool isctx = u >= 4096;
        int b, h, r = 0, qg = 0;
        if (!isctx) { b = u >> 11; h = (u >> 8) & 7; r = u & 255; }
        else { const int v = u - 4096; b = v >> 5; h = (v >> 2) & 7; qg = v & 3; }
        const int rs = min(max(r - 4, 0), 248);
        const int nwin = isctx ? 0 : 8, nst = nwin + 4;
        auto issue = [&](int st) {
            char* slot = smem + (st % 3) * 16384;
            const u16* ksrc; const u16* vsrc; size_t vstride;
            if (st < nwin) {
                const size_t tok0 = (size_t)CTXROWS + (size_t)b * LAT + (size_t)(rs + st) * 64;
                ksrc = pqk + tok0 * 1024 + 512 + h * 64;
                vsrc = vtl + (size_t)((b * 8 + h) * 64) * LAT + (size_t)(rs + st) * 64; vstride = LAT;
            } else {
                const size_t tok0 = (size_t)b * LCTX + (size_t)(st - nwin) * 64;
                ksrc = pqk + tok0 * 1024 + 512 + h * 64;
                vsrc = vtc + (size_t)((b * 8 + h) * 64) * LCTX + (size_t)(st - nwin) * 64; vstride = LCTX;
            }
            glds16(ksrc + (size_t)lrow0 * 1024 + lsc, slot + tid * 16);
            glds16(ksrc + (size_t)lrow1 * 1024 + lsc, slot + 4096 + tid * 16);
            glds16(vsrc + (size_t)lrow0 * vstride + lsc, slot + 8192 + tid * 16);
            glds16(vsrc + (size_t)lrow1 * vstride + lsc, slot + 8192 + 4096 + tid * 16);
        };
        __syncthreads();
        issue(0); issue(1);
        if (!isctx) for (int i = tid; i < 465; i += 256) rpbl[i] = p.na_rpb[((size_t)l * 8 + h) * 465 + i];
        asm volatile("s_waitcnt lgkmcnt(0)" ::: "memory");
        const int c = 16 * w + fr;
        const int qrow = isctx ? b * LCTX + qg * 64 + c : CTXROWS + b * LAT + r * 64 + c;
        bf16x8 qf[2];
        qf[0] = *(const bf16x8*)(pqk + (size_t)qrow * 1024 + h * 64 + 8 * g);
        qf[1] = *(const bf16x8*)(pqk + (size_t)qrow * 1024 + h * 64 + 32 + 8 * g);
        f32x4 O[4];
#pragma unroll
        for (int i = 0; i < 4; ++i) O[i] = f32x4{0.f, 0.f, 0.f, 0.f};
        float mrun = -1.0e30f, lrun = 0.f;
        const int cb = (w == 0) ? 0 : (w == 1) ? 8 : (w == 2) ? 24 : 32;
        const int cs = min(max(c - 8, 0), 48);
        auto chunk = [&](unsigned sl, int kb, const float* bias0, bool local) {
            const int key0 = kb + fr, key1 = kb + 16 + fr;
            const unsigned ka0 = sl + key0 * 128, ka1 = sl + key1 * 128;
            const unsigned k00a = ka0 + ((g ^ (key0 & 7)) << 4), k01a = ka0 + (((4 + g) ^ (key0 & 7)) << 4);
            const unsigned k10a = ka1 + ((g ^ (key1 & 7)) << 4), k11a = ka1 + (((4 + g) ^ (key1 & 7)) << 4);
            const int q0 = (kb >> 2) + g, q1 = q0 + 4;
            const unsigned vbase = sl + 8192 + fr * 128;
            const unsigned vo0 = ((((q0 >> 1) ^ (fr & 7)) << 4) + ((q0 & 1) << 3)), vo1 = ((((q1 >> 1) ^ (fr & 7)) << 4) + ((q1 & 1) << 3));
            u32x4 k00, k01, k10, k11; u32x2 vlo0, vhi0, vlo1, vhi1, vlo2, vhi2, vlo3, vhi3;
            asm volatile(
                "ds_read_b128 %0, %12\n\t"
                "ds_read_b128 %1, %13\n\t"
                "ds_read_b128 %2, %14\n\t"
                "ds_read_b128 %3, %15\n\t"
                "ds_read_b64 %4, %16\n\t"
                "ds_read_b64 %5, %17\n\t"
                "ds_read_b64 %6, %16 offset:2048\n\t"
                "ds_read_b64 %7, %17 offset:2048\n\t"
                "ds_read_b64 %8, %16 offset:4096\n\t"
                "ds_read_b64 %9, %17 offset:4096\n\t"
                "ds_read_b64 %10, %16 offset:6144\n\t"
                "ds_read_b64 %11, %17 offset:6144\n\t"
                "s_waitcnt lgkmcnt(0)"
                : "=&v"(k00), "=&v"(k01), "=&v"(k10), "=&v"(k11), "=&v"(vlo0), "=&v"(vhi0), "=&v"(vlo1), "=&v"(vhi1),
                  "=&v"(vlo2), "=&v"(vhi2), "=&v"(vlo3), "=&v"(vhi3)
                : "v"(k00a), "v"(k01a), "v"(k10a), "v"(k11a), "v"(vbase + vo0), "v"(vbase + vo1)
                : "memory");
            auto asf = [](u32x4 v) { union { u32x4 u; bf16x8 f; } x; x.u = v; return x.f; };
            f32x4 s0 = f32x4{0.f, 0.f, 0.f, 0.f}, s1 = f32x4{0.f, 0.f, 0.f, 0.f};
            s0 = __builtin_amdgcn_mfma_f32_16x16x32_bf16(asf(k00), qf[0], s0, 0, 0, 0);
            s0 = __builtin_amdgcn_mfma_f32_16x16x32_bf16(asf(k01), qf[1], s0, 0, 0, 0);
            s1 = __builtin_amdgcn_mfma_f32_16x16x32_bf16(asf(k10), qf[0], s1, 0, 0, 0);
            s1 = __builtin_amdgcn_mfma_f32_16x16x32_bf16(asf(k11), qf[1], s1, 0, 0, 0);
            float sv[8];
#pragma unroll
            for (int j = 0; j < 4; ++j) {
                float a = s0[j] * 0.125f, bb = s1[j] * 0.125f;
                if (local) {
                    const int k0c = kb + 4 * g + j, k1c = k0c + 16;
                    a = (k0c >= cs && k0c <= cs + 15) ? a + bias0[k0c] : -1.0e30f;
                    bb = (k1c >= cs && k1c <= cs + 15) ? bb + bias0[k1c] : -1.0e30f;
                }
                sv[j] = a; sv[4 + j] = bb;
            }
            float mx = sv[0];
#pragma unroll
            for (int j = 1; j < 8; ++j) mx = fmaxf(mx, sv[j]);
            mx = fmaxf(mx, __shfl_xor(mx, 16)); mx = fmaxf(mx, __shfl_xor(mx, 32));
            const float mnew = fmaxf(mrun, mx);
            const float sc = __expf(mrun - mnew);
            mrun = mnew;
            float ps = 0.f; float pv[8];
#pragma unroll
            for (int j = 0; j < 8; ++j) { pv[j] = __expf(sv[j] - mnew); ps += pv[j]; }
            lrun = lrun * sc + ps;
            union { u32x4 u; bf16x8 f; } pf; pf.u = u32x4{pk2bf(pv[0], pv[1]), pk2bf(pv[2], pv[3]), pk2bf(pv[4], pv[5]), pk2bf(pv[6], pv[7])};
            const u32x2 vl[4] = {vlo0, vlo1, vlo2, vlo3}, vh[4] = {vhi0, vhi1, vhi2, vhi3};
#pragma unroll
            for (int dt = 0; dt < 4; ++dt) {
                O[dt][0] *= sc; O[dt][1] *= sc; O[dt][2] *= sc; O[dt][3] *= sc;
                union { u32x4 u; bf16x8 f; } vf; vf.u = u32x4{vl[dt].x, vl[dt].y, vh[dt].x, vh[dt].y};
                O[dt] = __builtin_amdgcn_mfma_f32_16x16x32_bf16(vf.f, pf.f, O[dt], 0, 0, 0);
            }
        };
#pragma unroll 1
        for (int st = 0; st < nst; ++st) {
            if (st + 1 < nst) asm volatile("s_waitcnt vmcnt(4)" ::: "memory"); else asm volatile("s_waitcnt vmcnt(0)" ::: "memory");
            __builtin_amdgcn_s_barrier();
            if (st + 2 < nst) issue(st + 2);
            const unsigned sl = lbase + (st % 3) * 16384;
            if (st < nwin) {
                const int krow = rs + st;
                chunk(sl, cb, rpbl + (krow - r + 7) * 31 - c + 15, true);
            } else {
                chunk(sl, 0, nullptr, false);
                chunk(sl, 32, nullptr, false);
            }
        }
        float lt = lrun; lt += __shfl_xor(lt, 16); lt += __shfl_xor(lt, 32);
        const float inv = 1.f / lt;
#pragma unroll
        for (int dt = 0; dt < 4; ++dt) {
            uint2 o;
            o.x = pk2bf(O[dt][0] * inv, O[dt][1] * inv);
            o.y = pk2bf(O[dt][2] * inv, O[dt][3] * inv);
            *(uint2*)(y + (size_t)qrow * 1024 + h * 64 + dt * 16 + 4 * g) = o;
        }
    }
    asm volatile("s_waitcnt vmcnt(0)" ::: "memory");
    __syncthreads();
}

DEVINL void ph_mlC(const P& p, int l, char* smem, int bid, int nb) {
    const int TIDX_ = tid_(); const int BIDX_ = bid_(); char* const WS_ = wsl_(p.ws); (void)TIDX_; (void)BIDX_; (void)WS_;
    const int tid = TIDX_;
    const u16* mlf = (const u16*)(WS_ + OFF_MLF);
    const u16* pc = (const u16*)(WS_ + OFF_PC);
    const float* mlg = (const float*)(WS_ + OFF_MLG);
    const float* mst = (const float*)(WS_ + OFF_MST);
    const float* nst = (const float*)(WS_ + OFF_NST2);
    const u16* cst = (const u16*)(WS_ + OFF_CST2);
    u16* y = (u16*)(WS_ + OFF_Y);
    u16* ql = (u16*)smem;
    u16* kl = ql + 4096;
    u16* vl = kl + 4096;
    float* Cl = (float*)(vl + 4096);
    float* Sl = Cl + 4096;
    float* btl = Sl + 4096;
    float* lil = btl + 64;
    float* nl = lil + 64;
    const int t = tid >> 2, q4 = tid & 3;
    for (int uh = bid; uh < 2 * NTC * 4; uh += nb) {
        const int u = uh >> 2, h = uh & 3;
        const int b = u / NTC, tc = u % NTC;
        if (tc < 4 && l != 0) continue;
        const int row0 = tc < 4 ? b * LCTX + tc * 64 : CTXROWS + b * LAT + (tc - 4) * 64;
        {
            float hs[16];
#pragma unroll
            for (int i = 0; i < 16; ++i) hs[i] = 0.f;
            __syncthreads();
            for (int i = tid; i < 64 * 16; i += 256) {
                const int tok = i >> 4, c4 = (i & 15) * 4;
                *(uint2*)(ql + tok * 64 + c4) = *(const uint2*)(mlf + (size_t)(row0 + tok) * 512 + h * 64 + c4);
                *(uint2*)(kl + tok * 64 + c4) = *(const uint2*)(mlf + (size_t)(row0 + tok) * 512 + 256 + h * 64 + c4);
                *(uint2*)(vl + tok * 64 + c4) = *(const uint2*)(pc + (size_t)(row0 + tok) * 1040 + 512 + h * 64 + c4);
            }
            for (int d = 0; d < 2; ++d) {
                const int bhd = (b * 4 + h) * 2 + d;
                __syncthreads();
                for (int i = tid; i < 1024; i += 256) { const uint2 cv = *(const uint2*)(cst + ((size_t)bhd * NTC + tc) * 4096 + i * 4); *(float4*)(Cl + i * 4) = make_float4(bf2f((u16)(cv.x & 0xFFFF)), bf2f((u16)(cv.x >> 16)), bf2f((u16)(cv.y & 0xFFFF)), bf2f((u16)(cv.y >> 16))); }
                if (tid < 64) { nl[tid] = nst[((size_t)bhd * NTC + tc) * 64 + tid]; lil[tid] = mlg[(size_t)(row0 + tid) * 16 + d * 4 + h]; }
                if (tid == 64) {
                    float bacc = 0.f;
#pragma unroll 1
                    for (int jj = 0; jj < 64; ++jj) { const int tok = d ? 63 - jj : jj; bacc += mlg[(size_t)(row0 + tok) * 16 + 8 + d * 4 + h]; btl[tok] = bacc; }
                }
                __syncthreads();
                const float m0 = mst[bhd * NTC + tc];
                float sc[16];
#pragma unroll
                for (int i = 0; i < 16; ++i) sc[i] = 0.f;
                for (int dk = 0; dk < 64; dk += 4) {
                    const uint2 qq = *(const uint2*)(ql + t * 64 + dk);
                    const float q0 = bf2f((u16)(qq.x & 0xFFFF)), q1 = bf2f((u16)(qq.x >> 16)), q2 = bf2f((u16)(qq.y & 0xFFFF)), q3 = bf2f((u16)(qq.y >> 16));
#pragma unroll
                    for (int i = 0; i < 16; ++i) {
                        const uint2 kk = *(const uint2*)(kl + (q4 * 16 + i) * 64 + dk);
                        sc[i] += q0 * bf2f((u16)(kk.x & 0xFFFF)) + q1 * bf2f((u16)(kk.x >> 16)) + q2 * bf2f((u16)(kk.y & 0xFFFF)) + q3 * bf2f((u16)(kk.y >> 16));
                    }
                }
                const float bt = btl[t];
                float ld[16]; float mx = -3.0e38f;
#pragma unroll
                for (int i = 0; i < 16; ++i) {
                    const int s = q4 * 16 + i;
                    const bool ok = d ? (s >= t) : (s <= t);
                    ld[i] = ok ? (bt - btl[s] + lil[s]) : -3.0e38f;
                    mx = fmaxf(mx, ld[i]);
                }
                mx = fmaxf(mx, __shfl_xor(mx, 1)); mx = fmaxf(mx, __shfl_xor(mx, 2));
                const float mt = fmaxf(bt + m0, mx);
                float rsum = 0.f;
#pragma unroll
                for (int i = 0; i < 16; ++i) {
                    const int s = q4 * 16 + i;
                    const bool ok = d ? (s >= t) : (s <= t);
                    const float dw = ok ? expf(ld[i] - mt) * sc[i] : 0.f;
                    rsum += dw;
                    Sl[t * 64 + s] = dw;
                }
                rsum += __shfl_xor(rsum, 1); rsum += __shfl_xor(rsum, 2);
                const float inter = expf(bt + m0 - mt);
                float qn = 0.f;
                for (int dk = q4 * 16; dk < q4 * 16 + 16; ++dk) qn += bf2f(ql[t * 64 + dk]) * nl[dk];
                qn += __shfl_xor(qn, 1); qn += __shfl_xor(qn, 2);
                const float den = rsum + inter * qn;
                __syncthreads();
                float num[16];
#pragma unroll
                for (int i = 0; i < 16; ++i) num[i] = 0.f;
                for (int s = 0; s < 64; ++s) {
                    const float dw = Sl[t * 64 + s];
                    const uint4 va = *(const uint4*)(vl + s * 64 + q4 * 16);
                    const uint4 vb2 = *(const uint4*)(vl + s * 64 + q4 * 16 + 8);
                    const unsigned vv[8] = {va.x, va.y, va.z, va.w, vb2.x, vb2.y, vb2.z, vb2.w};
#pragma unroll
                    for (int i = 0; i < 8; ++i) { num[2 * i] += dw * bf2f((u16)(vv[i] & 0xFFFF)); num[2 * i + 1] += dw * bf2f((u16)(vv[i] >> 16)); }
                }
                for (int dk = 0; dk < 64; ++dk) {
                    const float qv = bf2f(ql[t * 64 + dk]) * inter;
#pragma unroll
                    for (int i = 0; i < 16; i += 4) {
                        const float4 cv = *(const float4*)(Cl + dk * 64 + q4 * 16 + i);
                        num[i] += qv * cv.x; num[i + 1] += qv * cv.y; num[i + 2] += qv * cv.z; num[i + 3] += qv * cv.w;
                    }
                }
                const float dn = 1.f / fmaxf(fabsf(den), expf(-mt));
#pragma unroll
                for (int i = 0; i < 16; ++i) hs[i] += num[i] * dn;
            }
            float s1 = 0.f;
#pragma unroll
            for (int i = 0; i < 16; ++i) s1 += hs[i];
            s1 += __shfl_xor(s1, 1); s1 += __shfl_xor(s1, 2);
            const float mu = s1 * (1.f / 64.f);
            float s2 = 0.f;
#pragma unroll
            for (int i = 0; i < 16; ++i) { const float dlt = hs[i] - mu; s2 += dlt * dlt; }
            s2 += __shfl_xor(s2, 1); s2 += __shfl_xor(s2, 2);
            const float rstd = rsqrtf(s2 * (1.f / 64.f) + 1e-6f);
            const int row = row0 + t;
#pragma unroll
            for (int i = 0; i < 16; i += 2) {
                const int cc = h * 64 + q4 * 16 + i;
                const float o0 = bf2f(pc[(size_t)row * 1040 + 768 + cc]), o1 = bf2f(pc[(size_t)row * 1040 + 768 + cc + 1]);
                const float y0 = (hs[i] - mu) * rstd * p.ml_nw[l * 256 + cc] * sigmoidf_(o0);
                const float y1 = (hs[i + 1] - mu) * rstd * p.ml_nw[l * 256 + cc + 1] * sigmoidf_(o1);
                *(unsigned*)(y + (size_t)row * 1024 + 768 + cc) = (unsigned)f2bf(y0) | ((unsigned)f2bf(y1) << 16);
            }
        }
    }
}

DEVINL void ph_outproj(const P& p, int l, char* smem) {
    const int TIDX_ = tid_(); const int BIDX_ = bid_(); char* const WS_ = wsl_(p.ws); (void)TIDX_; (void)BIDX_; (void)WS_;
    const u16* y = (const u16*)(WS_ + OFF_Y);
    const u16* wout = (const u16*)(WS_ + OFF_WOUT);
    const float* modv = (const float*)(WS_ + OFF_MOD) + (size_t)l * 3 * 6144;
    const float* x2c = (const float*)(WS_ + OFF_X2CTX);
    float* x1 = (float*)(WS_ + OFF_X1);
    const int mt0 = (l == 0) ? 0 : 4;
    const int ntile = (260 - mt0) * 8;
    for (int u = BIDX_; u < ntile; u += gridDim.x) {
        const int mt = mt0 + u / 8, nt = u % 8;
        const u16* A = y + (size_t)mt * 128 * 1024;
        const int R0 = mt * 128;
        const float* xin;
        if (l == 0) xin = R0 < CTXROWS ? p.ctx + (size_t)R0 * 1024 : p.x + (size_t)(R0 - CTXROWS) * 1024;
        else xin = R0 < CTXROWS ? x2c + (size_t)R0 * 1024 : p.out + (size_t)(R0 - CTXROWS) * 1024;
        const float* g1 = modv + row_sel(R0) * 6144 + 2048;
        gemm128([&](int r) { return A + (size_t)r * 1024; }, wout + (size_t)nt * 128 * 1024, 1024, 1024, smem,
                [&](int m, int n, f32x4 a) {
                    const int N = nt * 128 + n;
                    const float gg = g1[N];
#pragma unroll
                    for (int j = 0; j < 4; ++j) x1[(size_t)(R0 + m + j) * 1024 + N] = ALPHA * xin[(size_t)(m + j) * 1024 + N] + gg * a[j];
                });
    }
}

DEVINL void ph_ln1(const P& p, int l) {
    const int TIDX_ = tid_(); const int BIDX_ = bid_(); char* const WS_ = wsl_(p.ws); (void)TIDX_; (void)BIDX_; (void)WS_;
    const int lane = TIDX_ & 63, wid = TIDX_ >> 6;
    const float* modv = (const float*)(WS_ + OFF_MOD) + (size_t)l * 3 * 6144;
    float* x1 = (float*)(WS_ + OFF_X1);
    u16* hm = (u16*)(WS_ + OFF_HM);
    const int rstart = (l == 0) ? 0 : CTXROWS;
    for (int row = rstart + BIDX_ * 4 + wid; row < T; row += gridDim.x * 4) {
        float4 v[4];
        float s = 0.f;
#pragma unroll
        for (int i = 0; i < 4; ++i) { v[i] = *(const float4*)(x1 + (size_t)row * 1024 + i * 256 + lane * 4); s += v[i].x + v[i].y + v[i].z + v[i].w; }
        const float mu = wsum(s) * (1.f / 1024.f);
        float q = 0.f;
#pragma unroll
        for (int i = 0; i < 4; ++i) { v[i].x -= mu; v[i].y -= mu; v[i].z -= mu; v[i].w -= mu; q += v[i].x * v[i].x + v[i].y * v[i].y + v[i].z * v[i].z + v[i].w * v[i].w; }
        const float rstd = rsqrtf(wsum(q) * (1.f / 1024.f) + 1e-5f);
        const float* mv = modv + row_sel(row) * 6144;
#pragma unroll
        for (int i = 0; i < 4; ++i) {
            const int c = i * 256 + lane * 4;
            const float4 g = *(const float4*)(p.ln1g + l * 1024 + c), bb = *(const float4*)(p.ln1b + l * 1024 + c);
            const float4 sh = *(const float4*)(mv + 3072 + c), sc = *(const float4*)(mv + 4096 + c);
            float4 o;
            o.x = v[i].x * rstd * g.x + bb.x; o.y = v[i].y * rstd * g.y + bb.y; o.z = v[i].z * rstd * g.z + bb.z; o.w = v[i].w * rstd * g.w + bb.w;
            *(float4*)(x1 + (size_t)row * 1024 + c) = o;
            uint2 hh;
            hh.x = (unsigned)f2bf(o.x * (1.f + sc.x) + sh.x) | ((unsigned)f2bf(o.y * (1.f + sc.y) + sh.y) << 16);
            hh.y = (unsigned)f2bf(o.z * (1.f + sc.z) + sh.z) | ((unsigned)f2bf(o.w * (1.f + sc.w) + sh.w) << 16);
            *(uint2*)(hm + (size_t)row * 1024 + c) = hh;
        }
    }
}

DEVINL void ph_router(const P& p, int l, char* smem) {
    const int TIDX_ = tid_(); const int BIDX_ = bid_(); char* const WS_ = wsl_(p.ws); (void)TIDX_; (void)BIDX_; (void)WS_;
    const u16* hm = (const u16*)(WS_ + OFF_HM);
    const u16* wr = (const u16*)(WS_ + OFF_WR) + (size_t)l * 128 * 1024;
    float* lg = (float*)(WS_ + OFF_LOGITS);
    const int mt0 = (l == 0) ? 0 : 4;
    for (int u = BIDX_; u < 260 - mt0; u += gridDim.x) {
        const int mt = mt0 + u;
        const u16* A = hm + (size_t)mt * 128 * 1024;
        gemm128([&](int r) { return A + (size_t)r * 1024; }, wr, 1024, 1024, smem,
                [&](int m, int n, f32x4 a) {
                    if (n < 36) {
#pragma unroll
                        for (int j = 0; j < 4; ++j) lg[(size_t)(mt * 128 + m + j) * 64 + n] = a[j];
                    }
                });
    }
}

DEVINL void ph_route1(const P& p, int l, char* smem) {
    const int TIDX_ = tid_(); const int BIDX_ = bid_(); char* const WS_ = wsl_(p.ws); (void)TIDX_; (void)BIDX_; (void)WS_;
    const int tid = TIDX_;
    const float* lg = (const float*)(WS_ + OFF_LOGITS);
    int* toke = (int*)(WS_ + OFF_TOKE); float* tokw = (float*)(WS_ + OFF_TOKW);
    int* cnt = (int*)(WS_ + CTL_CNT) + l * 32;
    int* hist = (int*)smem;
    __syncthreads();
    if (tid < 32) hist[tid] = 0;
    __syncthreads();
    const int rstart = (l == 0) ? 0 : CTXROWS;
    for (int row = rstart + BIDX_ * 256 + tid; row < T; row += gridDim.x * 256) {
        const float* q = lg + (size_t)row * 64;
        float gl[4]; int gs = 0; float gm = -3.0e38f;
#pragma unroll
        for (int i = 0; i < 4; ++i) { gl[i] = q[i] + p.rgb[l * 4 + i]; if (gl[i] > gm) { gm = gl[i]; gs = i; } }
        float se = 0.f;
#pragma unroll
        for (int i = 0; i < 4; ++i) se += expf(gl[i] - gm);
        const float gw = 1.f / se;
        float v1 = -3.0e38f, v2 = -3.0e38f; int i1 = 0, i2 = 0;
#pragma unroll
        for (int i = 0; i < 8; ++i) {
            const float e = q[4 + gs * 8 + i] + p.reb[l * 32 + gs * 8 + i];
            if (e > v1) { v2 = v1; i2 = i1; v1 = e; i1 = i; }
            else if (e > v2) { v2 = e; i2 = i; }
        }
        const float e2 = expf(v2 - v1);
        const float w1 = gw / (1.f + e2), w2 = gw * e2 / (1.f + e2);
        const int ea = gs * 8 + i1, eb = gs * 8 + i2;
        toke[row * 2] = ea; toke[row * 2 + 1] = eb; tokw[row * 2] = w1; tokw[row * 2 + 1] = w2;
        atomicAdd(&hist[ea], 1); atomicAdd(&hist[eb], 1);
    }
    __syncthreads();
    if (tid < 32 && hist[tid] > 0) atomicAdd(&cnt[tid], hist[tid]);
}

DEVINL void ph_route2(const P& p, int l, char* smem) {
    const int TIDX_ = tid_(); const int BIDX_ = bid_(); char* const WS_ = wsl_(p.ws); (void)TIDX_; (void)BIDX_; (void)WS_;
    const int tid = TIDX_;
    const int* toke = (const int*)(WS_ + OFF_TOKE);
    int* toks = (int*)(WS_ + OFF_TOKS);
    int* slottok = (int*)(WS_ + OFF_SLOTTOK);
    const int* cnt = (const int*)(WS_ + CTL_CNT) + l * 32;
    int* cur = (int*)(WS_ + CTL_CUR) + l * 32;
    int* tiles = (int*)(WS_ + OFF_TILES);
    int* off = (int*)smem;
    int* hist = off + 64;
    int* base = hist + 32;
    __syncthreads();
    if (tid == 0) { int a = 0; for (int e = 0; e < 32; ++e) { off[e] = a; a += (cnt[e] + 127) & ~127; } off[32] = a; }
    if (tid < 32) hist[tid] = 0;
    __syncthreads();
    if (BIDX_ == 0) {
        if (tid == 0) {
            int nt = 0;
            for (int e = 0; e < 32; ++e) for (int s = off[e]; s < off[e + 1]; s += 128) { tiles[64 + nt * 2] = e; tiles[64 + nt * 2 + 1] = s; ++nt; }
            tiles[40] = nt;
        }
        for (int e = 0; e < 32; ++e) for (int s = off[e] + cnt[e] + tid; s < off[e + 1]; s += 256) slottok[s] = (l == 0) ? 0 : CTXROWS;
    }
    const int rstart = (l == 0) ? 0 : CTXROWS;
    for (int a0 = rstart * 2 + BIDX_ * 256; a0 < T * 2; a0 += gridDim.x * 256) {
        const int a = a0 + tid;
        int e = -1, lpos = 0;
        if (a < T * 2) { e = toke[a]; lpos = atomicAdd(&hist[e], 1); }
        __syncthreads();
        if (tid < 32) { base[tid] = hist[tid] > 0 ? atomicAdd(&cur[tid], hist[tid]) : 0; }
        __syncthreads();
        if (e >= 0) { const int s = off[e] + base[e] + lpos; toks[a] = s; slottok[s] = a >> 1; }
        __syncthreads();
        if (tid < 32) hist[tid] = 0;
        __syncthreads();
    }
}

DEVINL void ph_gateup(const P& p, char* smem) {
    const int TIDX_ = tid_(); const int BIDX_ = bid_(); char* const WS_ = wsl_(p.ws); (void)TIDX_; (void)BIDX_; (void)WS_;
    const int tid = TIDX_, lane = tid & 63, wid = tid >> 6, wr = wid >> 1, wc = wid & 1, fr = lane & 15, fq = lane >> 4;
    const u16* hm = (const u16*)(WS_ + OFF_HM);
    const u16* wgu = (const u16*)(WS_ + OFF_WGU);
    const int* tiles = (const int*)(WS_ + OFF_TILES);
    const int* slottok = (const int*)(WS_ + OFF_SLOTTOK);
    u16* act = (u16*)(WS_ + OFF_ACT);
    const int ntile = tiles[40] * 8;
    for (int u = BIDX_; u < ntile; u += gridDim.x) {
        const int ti = u >> 3, nt = u & 7;
        const int e = tiles[64 + ti * 2], s0 = tiles[64 + ti * 2 + 1];
        f32x4 acc[4][4];
        gemm128_acc([&](int r) { return hm + (size_t)slottok[s0 + r] * 1024; }, wgu + ((size_t)e * 1024 + nt * 128) * 1024, 1024, 1024, smem, acc);
#pragma unroll
        for (int m = 0; m < 4; ++m)
#pragma unroll
            for (int n = 0; n < 4; n += 2) {
                const int jcol = (nt * 128 + wc * 64 + n * 16) / 2 + fr;
                const int srow = s0 + wr * 64 + m * 16 + fq * 4;
#pragma unroll
                for (int j = 0; j < 4; ++j) {
                    const float gte = acc[m][n][j], up = acc[m][n + 1][j];
                    act[(size_t)(srow + j) * 512 + jcol] = f2bf(gte / (1.f + __expf(-gte)) * up);
                }
            }
    }
}

DEVINL void ph_down(const P& p, char* smem) {
    const int TIDX_ = tid_(); const int BIDX_ = bid_(); char* const WS_ = wsl_(p.ws); (void)TIDX_; (void)BIDX_; (void)WS_;
    const u16* act = (const u16*)(WS_ + OFF_ACT);
    const u16* wdn = (const u16*)(WS_ + OFF_WDN);
    const int* tiles = (const int*)(WS_ + OFF_TILES);
    u16* so = (u16*)(WS_ + OFF_SLOTOUT);
    const int ntile = tiles[40] * 8;
    for (int u = BIDX_; u < ntile; u += gridDim.x) {
        const int ti = u >> 3, nt = u & 7;
        const int e = tiles[64 + ti * 2], s0 = tiles[64 + ti * 2 + 1];
        const u16* A = act + (size_t)s0 * 512;
        gemm128([&](int r) { return A + (size_t)r * 512; }, wdn + ((size_t)e * 1024 + nt * 128) * 512, 512, 512, smem,
                [&](int m, int n, f32x4 a) {
                    u16* q = so + (size_t)(s0 + m) * 1024 + nt * 128 + n;
                    q[0] = f2bf(a[0]); q[1024] = f2bf(a[1]); q[2048] = f2bf(a[2]); q[3072] = f2bf(a[3]);
                });
    }
}

DEVINL void ph_ln2(const P& p, int l) {
    const int TIDX_ = tid_(); const int BIDX_ = bid_(); char* const WS_ = wsl_(p.ws); (void)TIDX_; (void)BIDX_; (void)WS_;
    const int lane = TIDX_ & 63, wid = TIDX_ >> 6;
    const float* modv = (const float*)(WS_ + OFF_MOD) + (size_t)l * 3 * 6144;
    const float* modn = (const float*)(WS_ + OFF_MOD) + (size_t)(l + 1) * 3 * 6144;
    const float* x1 = (const float*)(WS_ + OFF_X1);
    const u16* so = (const u16*)(WS_ + OFF_SLOTOUT);
    const int* toks = (const int*)(WS_ + OFF_TOKS);
    const float* tokw = (const float*)(WS_ + OFF_TOKW);
    float* x2c = (float*)(WS_ + OFF_X2CTX);
    u16* hm = (u16*)(WS_ + OFF_HM);
    const int rstart = (l == 0) ? 0 : CTXROWS;
    for (int row = rstart + BIDX_ * 4 + wid; row < T; row += gridDim.x * 4) {
        const int sa = toks[row * 2], sb = toks[row * 2 + 1];
        const float wa = tokw[row * 2], wb = tokw[row * 2 + 1];
        const float* mv = modv + row_sel(row) * 6144;
        float4 v[4];
        float s = 0.f;
#pragma unroll
        for (int i = 0; i < 4; ++i) {
            const int c = i * 256 + lane * 4;
            const float4 xv = *(const float4*)(x1 + (size_t)row * 1024 + c);
            const uint2 ua = *(const uint2*)(so + (size_t)sa * 1024 + c), ub = *(const uint2*)(so + (size_t)sb * 1024 + c);
            const float4 g2 = *(const float4*)(mv + 5120 + c);
            const float f0 = wa * bf2f((u16)(ua.x & 0xFFFF)) + wb * bf2f((u16)(ub.x & 0xFFFF));
            const float f1 = wa * bf2f((u16)(ua.x >> 16)) + wb * bf2f((u16)(ub.x >> 16));
            const float f2 = wa * bf2f((u16)(ua.y & 0xFFFF)) + wb * bf2f((u16)(ub.y & 0xFFFF));
            const float f3 = wa * bf2f((u16)(ua.y >> 16)) + wb * bf2f((u16)(ub.y >> 16));
            v[i].x = ALPHA * xv.x + g2.x * f0; v[i].y = ALPHA * xv.y + g2.y * f1; v[i].z = ALPHA * xv.z + g2.z * f2; v[i].w = ALPHA * xv.w + g2.w * f3;
            s += v[i].x + v[i].y + v[i].z + v[i].w;
        }
        const float mu = wsum(s) * (1.f / 1024.f);
        float q = 0.f;
#pragma unroll
        for (int i = 0; i < 4; ++i) { v[i].x -= mu; v[i].y -= mu; v[i].z -= mu; v[i].w -= mu; q += v[i].x * v[i].x + v[i].y * v[i].y + v[i].z * v[i].z + v[i].w * v[i].w; }
        const float rstd = rsqrtf(wsum(q) * (1.f / 1024.f) + 1e-5f);
        float* dst = row < CTXROWS ? x2c + (size_t)row * 1024 : p.out + (size_t)(row - CTXROWS) * 1024;
        const float* mn = modn + row_sel(row) * 6144;
#pragma unroll
        for (int i = 0; i < 4; ++i) {
            const int c = i * 256 + lane * 4;
            const float4 g = *(const float4*)(p.ln2g + l * 1024 + c), bb = *(const float4*)(p.ln2b + l * 1024 + c);
            float4 o;
            o.x = v[i].x * rstd * g.x + bb.x; o.y = v[i].y * rstd * g.y + bb.y; o.z = v[i].z * rstd * g.z + bb.z; o.w = v[i].w * rstd * g.w + bb.w;
            *(float4*)(dst + c) = o;
            if (l == 0) {
                const float4 sh = *(const float4*)(mn + c), sc = *(const float4*)(mn + 1024 + c);
                uint2 hh;
                hh.x = (unsigned)f2bf(o.x * (1.f + sc.x) + sh.x) | ((unsigned)f2bf(o.y * (1.f + sc.y) + sh.y) << 16);
                hh.y = (unsigned)f2bf(o.z * (1.f + sc.z) + sh.z) | ((unsigned)f2bf(o.w * (1.f + sc.w) + sh.w) << 16);
                *(uint2*)(hm + (size_t)row * 1024 + c) = hh;
            }
        }
    }
}

DEVINL void gbar(XcdBarrier b) {
    unsigned x = b.x; GAS unsigned* q = (GAS unsigned*)b.bar;
    asm volatile("" : "+s"(x), "+s"(q));
    b.x = x; b.bar = (unsigned*)q;
    xcd_barrier(b);
}
#ifndef PROBE
#define PROBE 0
#endif
#ifndef TPROBE
#define TPROBE 0
#endif
__global__ void __launch_bounds__(256, 2) k_mega(P p) {
    __shared__ __attribute__((aligned(16))) char smem[SMEM_BYTES];
    if (threadIdx.x == 0) *(uint4*)(smem + SMEM_BYTES - 16) = make_uint4(0u, 0u, 0u, 0u);
    __syncthreads();
    XcdBarrier bar = xcd_barrier_post((unsigned*)p.ws, (volatile LAS unsigned*)(smem + SMEM_BYTES - 16));
    const int bid = blockIdx.x, nb = gridDim.x;
#if TPROBE
    unsigned long long tp_acc = 0, tp_last = wall_clock64();
#define TP(g) do { const unsigned long long _n = wall_clock64(); if ((g) == TPROBE) tp_acc += _n - tp_last; tp_last = _n; } while (0)
#else
#define TP(g) do { } while (0)
#endif
    if (threadIdx.x == 0) {
        const unsigned key = ((unsigned)__builtin_amdgcn_s_getreg((3 << 11) | 20) << 8) | ((unsigned)__builtin_amdgcn_s_getreg((7 << 11) | (8 << 6) | 4) & 0xFFu);
        ((unsigned*)(p.ws + CTL_CUKEY))[blockIdx.x] = key | 0x80000000u;
    }
    ph_prolog(p, smem);
    ph_convw(p, 0, smem);
    gbar(bar);
    TP(1);
    ph_xm0(p);
    gbar(bar);
    TP(1);
    bool quiet; int wrank, nwork;
    {
        const unsigned* keys = (const unsigned*)(p.ws + CTL_CUKEY);
        int* cnt = (int*)smem;
        if (threadIdx.x < 2) cnt[threadIdx.x] = 0;
        __syncthreads();
        for (int i = 8 + threadIdx.x; i < nb; i += 256) {
            const unsigned k = keys[i];
            bool qq = false;
            for (int j = 0; j < 8 && j < nb; ++j) qq = qq || (keys[j] == k);
            if (qq) { atomicAdd(&cnt[1], 1); if (i < bid) atomicAdd(&cnt[0], 1); }
        }
        __syncthreads();
        const int below = cnt[0], total = cnt[1];
        bool me = false;
        if (bid >= 8) { const unsigned k = keys[bid]; for (int j = 0; j < 8 && j < nb; ++j) me = me || (keys[j] == k); }
        __syncthreads();
        if (total > 16) { quiet = false; wrank = bid - 8; nwork = nb - 8; }
        else { quiet = me; wrank = bid - 8 - below; nwork = nb - 8 - total; }
    }
#pragma unroll 1
    for (int l = 0; l < NLAYER; ++l) {
        ph_inproj(p, smem);
        gbar(bar);
    TP(2);
        ph_rwprep(p, l, 0, smem, bid, nb);
        gbar(bar);
    TP(3);
        if (bid < 8) ph_rwscan(p, l, 0, bid, 8, smem);
        else if (!quiet) { ph_prepM(p, l, smem, wrank, nwork); ph_na(p, l, smem, wrank, nwork); }
        gbar(bar);
    TP(4);
        ph_mlB(p, bid, nb, smem);
        gbar(bar);
        ph_rwprep(p, l, 1, smem, bid, nb);
        gbar(bar);
    TP(5);
        if (bid < 8) ph_rwscan(p, l, 1, bid, 8, smem);
        else if (!quiet) { ph_mlC(p, l, smem, wrank, nwork); ph_convexp(p, l, smem, wrank, nwork); }
        gbar(bar);
    TP(6);
        ph_rwout(p, l);
        gbar(bar);
    TP(7);
        ph_outproj(p, l, smem);
        gbar(bar);
    TP(8);
        ph_ln1(p, l);
        gbar(bar);
    TP(9);
        ph_router(p, l, smem);
        gbar(bar);
    TP(9);
        ph_route1(p, l, smem);
        gbar(bar);
    TP(9);
        ph_route2(p, l, smem);
        gbar(bar);
    TP(9);
        ph_gateup(p, smem);
        gbar(bar);
    TP(10);
        ph_down(p, smem);
        gbar(bar);
    TP(11);
        ph_ln2(p, l);
        if (l + 1 < NLAYER) ph_convw(p, l + 1, smem);
        gbar(bar);
    TP(12);
    }
#if TPROBE
    if (bid == 0 && threadIdx.x == 0) { const unsigned long long t_end = wall_clock64() + tp_acc; while (wall_clock64() < t_end) __builtin_amdgcn_s_sleep(8); }
    __syncthreads();
    gbar(bar);
#endif
}


extern "C" void kernel_launch(void* const* d_in, const int* in_sizes, int n_in, void* d_out, int out_size, void* d_ws, size_t ws_size,
                              hipStream_t stream) {
    if (n_in != 37 || ws_size < WS_NEED) { fprintf(stderr, "kernel_launch: n_in %d ws %zu need %zu\n", n_in, ws_size, (size_t)WS_NEED); return; }
    static int grid = 0;
    if (!grid) {
        int dev = 0, cus = 0, per_cu = 0;
        (void)hipGetDevice(&dev);
        (void)hipDeviceGetAttribute(&cus, hipDeviceAttributeMultiprocessorCount, dev);
        (void)hipOccupancyMaxActiveBlocksPerMultiprocessor(&per_cu, (const void*)k_mega, 256, 0);
        if (per_cu < 1) per_cu = 1;
        grid = cus * (per_cu < 2 ? per_cu : 2);
    }
    P p{};
    const float** pp = (const float**)&p;
    for (int i = 0; i < 37; ++i) pp[i] = (const float*)d_in[i];
    p.out = (float*)d_out; p.ws = (char*)d_ws;
    (void)hipMemsetAsync(d_ws, 0, CTL_BYTES, stream);
    k_mega<<<dim3(grid), dim3(256), 0, stream>>>(p);
}
```

```cpp
#include <hip/hip_runtime.h>
#include <hip/hip_bf16.h>
#include <stdint.h>
#include <stdio.h>
#include <type_traits>

#define DEVINL __device__ __forceinline__
typedef unsigned short u16;
using bf16x8 = __attribute__((ext_vector_type(8))) short;
using f32x4 = __attribute__((ext_vector_type(4))) float;

constexpr int D = 1024, LAT = 16384, LCTX = 256, T = 33280, CTXROWS = 512;
constexpr int INP = 3536;
constexpr int NLAYER = 2;
constexpr float ALPHA = 1.41421356237309515f;
constexpr int NUNIT_CH = 520;
constexpr int NTC = 260;
constexpr int MAXSLOT = 70656;
constexpr int SMEM_BYTES = 81920;

constexpr size_t al(size_t x) { return (x + 255) & ~(size_t)255; }
constexpr size_t CTL_CNT = 16384;
constexpr size_t CTL_CUR = CTL_CNT + 256;
constexpr size_t CTL_CUKEY = 20480;
constexpr size_t CTL_PROG = 24576;
constexpr size_t CTL_BYTES = 32768;
constexpr size_t OFF_MOD = CTL_BYTES;
constexpr size_t OFF_ROPE = OFF_MOD + al(2 * 3 * 6144 * 4);
constexpr size_t OFF_WR = OFF_ROPE + al(10240 * 4);
constexpr size_t OFF_LORA = OFF_WR + al(2 * 128 * 1024 * 2);
constexpr size_t OFF_TILES = OFF_LORA + al(3 * 65536);
constexpr size_t OFF_TOKE = OFF_TILES + al((64 + 2048) * 4);
constexpr size_t OFF_TOKW = OFF_TOKE + al((size_t)T * 2 * 4);
constexpr size_t OFF_TOKS = OFF_TOKW + al((size_t)T * 2 * 4);
constexpr size_t OFF_SLOTTOK = OFF_TOKS + al((size_t)T * 2 * 4);
constexpr size_t OFF_X2CTX = OFF_SLOTTOK + al((size_t)MAXSLOT * 4);
constexpr size_t OFF_WIN = OFF_X2CTX + al((size_t)512 * 1024 * 4);
constexpr size_t OFF_WOUT = OFF_WIN + al((size_t)3584 * 1024 * 2);
constexpr size_t OFF_X1 = OFF_WOUT + al((size_t)1024 * 1024 * 2);
constexpr size_t OFF_HM = OFF_X1 + al((size_t)T * 1024 * 4);
constexpr size_t OFF_P = OFF_HM + al((size_t)T * 1024 * 2);
constexpr size_t OFF_PQK = OFF_P;
constexpr size_t OFF_VTL = OFF_PQK + (size_t)T * 1024 * 2;
constexpr size_t OFF_VTC = OFF_VTL + (size_t)2 * 8 * 64 * 16384 * 2;
constexpr size_t OFF_PB = OFF_VTC + (size_t)2 * 8 * 64 * 256 * 2;
constexpr size_t OFF_PC = OFF_PB + (size_t)T * 960 * 2;
constexpr size_t OFF_Y = OFF_PC + (size_t)T * 1040 * 2;
constexpr size_t OFF_MLF = OFF_Y + (size_t)T * 1024 * 2;
constexpr size_t OFF_GATE = OFF_MLF + (size_t)T * 512 * 2;
constexpr size_t OFF_MLG = OFF_GATE + (size_t)T * 256 * 2;
constexpr size_t OFF_MLS = OFF_MLG + (size_t)T * 16 * 4;
constexpr size_t OFF_MST = OFF_MLS + al(16 * 260 * 2 * 4);
constexpr size_t OFF_NST = OFF_MST + al(16 * 260 * 4);
constexpr size_t OFF_CST2 = OFF_NST + al(16 * 260 * 64 * 4);
constexpr size_t OFF_NST2 = OFF_CST2 + (size_t)16 * 260 * 4096 * 2;
constexpr size_t OFF_END1 = OFF_NST2 + al(16 * 260 * 64 * 4);
constexpr size_t OFF_WGU = OFF_P;
constexpr size_t OFF_WDN = OFF_WGU + (size_t)32 * 1024 * 1024 * 2;
constexpr size_t OFF_ACT = OFF_WDN + (size_t)32 * 1024 * 512 * 2;
constexpr size_t OFF_SLOTOUT = OFF_ACT + (size_t)MAXSLOT * 512 * 2;
constexpr size_t OFF_LOGITS = OFF_SLOTOUT + (size_t)MAXSLOT * 1024 * 2;
constexpr size_t OFF_END2 = OFF_LOGITS + (size_t)T * 64 * 4;
constexpr size_t WS_NEED = OFF_END1 > OFF_END2 ? OFF_END1 : OFF_END2;
static_assert(OFF_WDN <= OFF_Y, "Wexp must not overlap y");
static_assert(OFF_LOGITS >= OFF_MLF, "logits placement");

struct P {
    const float *x, *c, *ctx, *c_ctx, *w_mod, *b_mod, *w_in, *na_rpb, *mu_prev, *mu_next, *rw_w0, *rw_w2, *rw_a0, *rw_a2,
        *rw_g2, *rw_kk, *rw_ka, *rw_rk, *rw_lnw, *rw_lnb, *ml_cw, *ml_cb, *ml_ib, *ml_fb, *ml_nw, *w_out, *ln1g, *ln1b,
        *rgw, *rgb, *rew, *reb, *egate, *eup, *edown, *ln2g, *ln2b;
    float* out;
    char* ws;
};

#define XB_TMO      128
#define XB_XCNT(j)  (256  + 64 * (j))
#define XB_XSUB(j)  (1280 + 64 * (j))
#define XB_XGEN(j)  (2304 + 64 * (j))
#define XB_TOP      3328
#define XB_TOPGEN   3392
#define XCD_BAR_WORDS 3456
#define XB_SPIN_CAP (1u << 18)
#define LAS __attribute__((address_space(3)))

__device__ __forceinline__ unsigned xb_ld(unsigned* p)              { return __hip_atomic_load(p, __ATOMIC_RELAXED, __HIP_MEMORY_SCOPE_AGENT); }
__device__ __forceinline__ unsigned xb_add(unsigned* p, unsigned v) { return __hip_atomic_fetch_add(p, v, __ATOMIC_RELAXED, __HIP_MEMORY_SCOPE_AGENT); }
__device__ __forceinline__ unsigned xb_xcc_id() { return (unsigned)__builtin_amdgcn_s_getreg((3 << 11) | 20) & 0xFu; }
#define XB_SPIN(cond, bar) do { unsigned _sp = 0; while (cond) { __builtin_amdgcn_s_sleep(1); \
    if ((++_sp & 255u) == 0u) { if (xb_ld(&(bar)[XB_TMO])) break; if (_sp > XB_SPIN_CAP) { atomicAdd(&(bar)[XB_TMO], 1u); break; } } } } while (0)

struct XcdBarrier {
    unsigned* bar; unsigned x;
    volatile LAS unsigned* st;
};

__device__ __forceinline__ XcdBarrier xcd_barrier_post(unsigned* bar, volatile LAS unsigned* st) {
    XcdBarrier b; b.bar = bar; b.x = xb_xcc_id(); b.st = st;
    if (threadIdx.x == 0) (void)xb_add(&bar[XB_XCNT(b.x)], 1u);
    return b;
}
__device__ __forceinline__ void xcd_barrier_complete(unsigned* bar, unsigned x, unsigned& nloc, unsigned& nx) {
    const unsigned G = gridDim.x * gridDim.y * gridDim.z;
    unsigned sum, cnt, mine, sp = 0u;
    for (;;) {
        sum = 0u; cnt = 0u; mine = 0u;
#pragma unroll
        for (unsigned j = 0; j < 16; ++j) { const unsigned c = xb_ld(&bar[XB_XCNT(j)]); sum += c; cnt += (c > 0u) ? 1u : 0u; mine = (j == x) ? c : mine; }
        if (sum == G) break;
        __builtin_amdgcn_s_sleep(1);
        if ((++sp & 255u) == 0u) { if (xb_ld(&bar[XB_TMO])) break; if (sp > XB_SPIN_CAP) { atomicAdd(&bar[XB_TMO], 1u); break; } }
    }
    nloc = mine > 0u ? mine : 1u; nx = cnt > 0u ? cnt : 1u;
}

__device__ __forceinline__ void xcd_barrier(const XcdBarrier& b) {
    asm volatile("s_waitcnt vmcnt(0)" ::: "memory");
    __syncthreads();
    if (threadIdx.x == 0) {
        unsigned* bar = b.bar;
        __builtin_amdgcn_s_waitcnt(0);
        unsigned nloc = b.st[0], nx = b.st[1];
        if (nloc == 0u) { xcd_barrier_complete(bar, b.x, nloc, nx); b.st[0] = nloc; b.st[1] = nx; }
        const unsigned old = xb_add(&bar[XB_XSUB(b.x)], 1u);
        const unsigned gen = old / nloc;
        if (old + 1u == (gen + 1u) * nloc) {
            __builtin_amdgcn_fence(__ATOMIC_RELEASE, "agent");
            asm volatile("s_waitcnt vmcnt(0)" ::: "memory");
            const unsigned og = xb_add(&bar[XB_TOP], 1u);
            const unsigned tg = og / nx;
            if (og + 1u == (tg + 1u) * nx) xb_add(&bar[XB_TOPGEN], 1u);
            else XB_SPIN(xb_ld(&bar[XB_TOPGEN]) == tg, bar);
            __builtin_amdgcn_fence(__ATOMIC_ACQUIRE, "agent");
            xb_add(&bar[XB_XGEN(b.x)], 1u);
            asm volatile("s_waitcnt vmcnt(0)" ::: "memory");
        } else {
            XB_SPIN(xb_ld(&bar[XB_XGEN(b.x)]) == gen, bar);
            __builtin_amdgcn_fence(__ATOMIC_ACQUIRE, "agent");
            asm volatile("s_waitcnt vmcnt(0)" ::: "memory");
        }
    }
    __syncthreads();
}


DEVINL int tid_() { int t = threadIdx.x; asm volatile("" : "+v"(t)); return t; }
DEVINL int bid_() { int b = blockIdx.x; asm volatile("" : "+s"(b)); return b; }
#define GAS __attribute__((address_space(1)))
DEVINL char* wsl_(char* w) { GAS char* g = (GAS char*)w; asm volatile("" : "+s"(g)); return (char*)g; }
template <class Tp> DEVINL const Tp* gl_(const Tp* q) { const GAS Tp* g = (const GAS Tp*)q; asm volatile("" : "+s"(g)); return (const Tp*)g; }
typedef float f32x2_t __attribute__((ext_vector_type(2)));
typedef __bf16 bf16x2_t __attribute__((ext_vector_type(2)));
DEVINL unsigned pk2bf(float lo, float hi) { f32x2_t f = {lo, hi}; bf16x2_t b = __builtin_convertvector(f, bf16x2_t); return __builtin_bit_cast(unsigned, b); }
DEVINL u16 f2bf(float f) { return (u16)(pk2bf(f, f) & 0xFFFFu); }
DEVINL float bf2f(u16 h) { return __uint_as_float(((unsigned)h) << 16); }
DEVINL float wsum(float v) { for (int o = 32; o > 0; o >>= 1) v += __shfl_xor(v, o); return v; }
DEVINL float sigmoidf_(float x) { return 1.f / (1.f + __expf(-x)); }
DEVINL float siluf_(float x) { return x / (1.f + __expf(-x)); }
DEVINL float softplusf_(float x) { return fmaxf(x, 0.f) + log1pf(__expf(-fabsf(x))); }
DEVINL int row_sel(int row) { return row < CTXROWS ? 2 : ((row - CTXROWS) >> 14); }
template <int CTRL, int RM>
DEVINL float dpp_f(float v) { return __int_as_float(__builtin_amdgcn_update_dpp(0, __float_as_int(v), CTRL, RM, 0xF, false)); }
DEVINL float wave_sum_dpp(float v) {
    v += dpp_f<0xB1, 0xF>(v);
    v += dpp_f<0x4E, 0xF>(v);
    v += dpp_f<0x141, 0xF>(v);
    v += dpp_f<0x140, 0xF>(v);
    v += dpp_f<0x142, 0xA>(v);
    v += dpp_f<0x143, 0xC>(v);
    return __int_as_float(__builtin_amdgcn_readlane(__float_as_int(v), 63));
}
DEVINL unsigned lds_addr(const void* p) { return (unsigned)(size_t)(const __attribute__((address_space(3))) char*)p; }
using u32x4 = __attribute__((ext_vector_type(4))) unsigned;
using u32x2 = __attribute__((ext_vector_type(2))) unsigned;
template <int OFF> DEVINL u32x4 lds_rd128(unsigned a) { u32x4 v; asm volatile("ds_read_b128 %0, %1 offset:%2" : "=v"(v) : "v"(a), "n"(OFF)); return v; }
template <int OFF> DEVINL u32x2 lds_rd64(unsigned a) { u32x2 v; asm volatile("ds_read_b64 %0, %1 offset:%2" : "=v"(v) : "v"(a), "n"(OFF)); return v; }
DEVINL void glds4(const void* g, void* l) {
    __builtin_amdgcn_global_load_lds((const __attribute__((address_space(1))) void*)g, (__attribute__((address_space(3))) void*)l, 4, 0, 0);
}
DEVINL void glds16nt(const void* g, void* l) {
    __builtin_amdgcn_global_load_lds((const __attribute__((address_space(1))) void*)g, (__attribute__((address_space(3))) void*)l, 16, 0, 2);
}
DEVINL void glds16(const void* g, void* l) {
    __builtin_amdgcn_global_load_lds((const __attribute__((address_space(1))) void*)g, (__attribute__((address_space(3))) void*)l, 16, 0, 0);
}

template <class RowA>
DEVINL void gemm128_acc(RowA rowA, const u16* __restrict__ Bt, int ldb, int K, char* smem, f32x4 (&acc)[4][4]) {
    const int tid = tid_(), lane = tid & 63, wid = tid >> 6, wr = wid >> 1, wc = wid & 1, fr = lane & 15, fq = lane >> 4;
#pragma unroll
    for (int m = 0; m < 4; ++m)
#pragma unroll
        for (int n = 0; n < 4; ++n) acc[m][n] = f32x4{0.f, 0.f, 0.f, 0.f};
    const int sc = ((tid & 7) ^ ((tid >> 3) & 7)) * 8;
    const u16* aS[4]; const u16* bS[4];
#pragma unroll
    for (int i = 0; i < 4; ++i) { const int r = (tid >> 3) + 32 * i; aS[i] = rowA(r) + sc; bS[i] = Bt + (size_t)r * ldb + sc; }
    const int nt = K >> 6;
    __syncthreads();
#pragma unroll
    for (int i = 0; i < 4; ++i) { glds16(aS[i], smem + (tid + 256 * i) * 16); glds16(bS[i], smem + 16384 + (tid + 256 * i) * 16); }
    for (int t = 0; t < nt; ++t) {
        asm volatile("s_waitcnt vmcnt(0)" ::: "memory");
        __builtin_amdgcn_s_barrier();
        if (t + 1 < nt) {
            char* SA = smem + ((t + 1) & 1) * 32768;
            const int ko = (t + 1) * 64;
#pragma unroll
            for (int i = 0; i < 4; ++i) { glds16(aS[i] + ko, SA + (tid + 256 * i) * 16); glds16(bS[i] + ko, SA + 16384 + (tid + 256 * i) * 16); }
        }
        const char* SA = smem + (t & 1) * 32768; const char* SB = SA + 16384;
#pragma unroll
        for (int ks = 0; ks < 2; ++ks) {
            const int pos = ((ks * 4 + fq) ^ (fr & 7)) * 16;
            bf16x8 af[4], bfr[4];
#pragma unroll
            for (int m = 0; m < 4; ++m) af[m] = *(const bf16x8*)(SA + (wr * 64 + m * 16 + fr) * 128 + pos);
#pragma unroll
            for (int n = 0; n < 4; ++n) bfr[n] = *(const bf16x8*)(SB + (wc * 64 + n * 16 + fr) * 128 + pos);
#pragma unroll
            for (int m = 0; m < 4; ++m)
#pragma unroll
                for (int n = 0; n < 4; ++n) acc[m][n] = __builtin_amdgcn_mfma_f32_16x16x32_bf16(af[m], bfr[n], acc[m][n], 0, 0, 0);
        }
    }
}
template <class RowA, class Epi>
DEVINL void gemm128(RowA rowA, const u16* __restrict__ Bt, int ldb, int K, char* smem, Epi epi) {
    const int tid = tid_(), lane = tid & 63, wid = tid >> 6, wr = wid >> 1, wc = wid & 1, fr = lane & 15, fq = lane >> 4;
    f32x4 acc[4][4];
    gemm128_acc(rowA, Bt, ldb, K, smem, acc);
#pragma unroll
    for (int m = 0; m < 4; ++m)
#pragma unroll
        for (int n = 0; n < 4; ++n) epi(wr * 64 + m * 16 + fq * 4, wc * 64 + n * 16 + fr, acc[m][n]);
}

template <class Emit>
DEVINL void stage_tile_bf16(const f32x4 (&acc)[4][4], char* smem, Emit emit) {
    const int tid = tid_(), lane = tid & 63, wid = tid >> 6, wr = wid >> 1, wc = wid & 1, fr = lane & 15, fq = lane >> 4;
    u16* t = (u16*)smem;
    __syncthreads();
#pragma unroll
    for (int m = 0; m < 4; ++m)
#pragma unroll
        for (int n = 0; n < 4; ++n) {
            const int r0 = wr * 64 + m * 16 + fq * 4, c = wc * 64 + n * 16 + fr;
            const unsigned p01 = pk2bf(acc[m][n][0], acc[m][n][1]), p23 = pk2bf(acc[m][n][2], acc[m][n][3]);
            t[(r0 + 0) * 136 + c] = (u16)(p01 & 0xFFFFu); t[(r0 + 1) * 136 + c] = (u16)(p01 >> 16);
            t[(r0 + 2) * 136 + c] = (u16)(p23 & 0xFFFFu); t[(r0 + 3) * 136 + c] = (u16)(p23 >> 16);
        }
    __syncthreads();
#pragma unroll
    for (int i = 0; i < 8; ++i) {
        const int ci = tid + 256 * i, row = ci >> 4, c8 = (ci & 15) * 8;
        emit(row, c8, *(const uint4*)(t + row * 136 + c8));
    }
}

template <class Emit>
DEVINL void stage_tile_f32(const f32x4 (&acc)[4][4], char* smem, Emit emit) {
    const int tid = tid_(), lane = tid & 63, wid = tid >> 6, wr = wid >> 1, wc = wid & 1, fr = lane & 15, fq = lane >> 4;
    float* t = (float*)smem;
    __syncthreads();
#pragma unroll
    for (int m = 0; m < 4; ++m)
#pragma unroll
        for (int n = 0; n < 4; ++n) {
            const int r0 = wr * 64 + m * 16 + fq * 4, c = wc * 64 + n * 16 + fr;
#pragma unroll
            for (int j = 0; j < 4; ++j) t[(r0 + j) * 132 + c] = acc[m][n][j];
        }
    __syncthreads();
#pragma unroll 4
    for (int i = 0; i < 16; ++i) {
        const int ci = tid + 256 * i, row = ci >> 5, c4 = (ci & 31) * 4;
        emit(row, c4, *(const float4*)(t + row * 132 + c4));
    }
}

DEVINL void ph_prolog(const P& p, char* smem) {
    const int TIDX_ = tid_(); const int BIDX_ = bid_(); char* const WS_ = wsl_(p.ws); (void)TIDX_; (void)BIDX_; (void)WS_;
    const int tid = TIDX_;
    float* modv = (float*)(WS_ + OFF_MOD);
    float* sil = (float*)smem;
    float* red = sil + 3072;
    bool ready = false;
    for (int u = BIDX_; u < 192; u += gridDim.x) {
        if (!ready) {
            for (int i = tid; i < 3072; i += 256) { int v = i >> 10, k = i & 1023; float cv = v < 2 ? p.c[v * 1024 + k] : p.c_ctx[k]; sil[i] = cv / (1.f + expf(-cv)); }
            ready = true;
        }
        __syncthreads();
        const int l = u / 96, cg = u % 96;
        const float* W = p.w_mod + (size_t)l * 1024 * 6144 + cg * 64;
        const int c4 = (tid & 15) * 4, rg = tid >> 4;
        float a0[4] = {0, 0, 0, 0}, a1[4] = {0, 0, 0, 0}, a2[4] = {0, 0, 0, 0};
#pragma unroll 4
        for (int i = 0; i < 64; ++i) {
            const int k = rg + 16 * i;
            const float4 w = *(const float4*)(W + (size_t)k * 6144 + c4);
            const float s0 = sil[k], s1 = sil[1024 + k], s2 = sil[2048 + k];
            a0[0] += s0 * w.x; a0[1] += s0 * w.y; a0[2] += s0 * w.z; a0[3] += s0 * w.w;
            a1[0] += s1 * w.x; a1[1] += s1 * w.y; a1[2] += s1 * w.z; a1[3] += s1 * w.w;
            a2[0] += s2 * w.x; a2[1] += s2 * w.y; a2[2] += s2 * w.z; a2[3] += s2 * w.w;
        }
#pragma unroll
        for (int j = 0; j < 4; ++j) { red[(rg * 3 + 0) * 64 + c4 + j] = a0[j]; red[(rg * 3 + 1) * 64 + c4 + j] = a1[j]; red[(rg * 3 + 2) * 64 + c4 + j] = a2[j]; }
        __syncthreads();
        if (tid < 192) {
            const int v = tid >> 6, cc = tid & 63;
            float s = 0.f;
            for (int r = 0; r < 16; ++r) s += red[(r * 3 + v) * 64 + cc];
            const int col = cg * 64 + cc;
            modv[(l * 3 + v) * 6144 + col] = s + p.b_mod[l * 6144 + col];
        }
        __syncthreads();
    }
    float* rope = (float*)(WS_ + OFF_ROPE);
    for (int i = BIDX_ * 256 + tid; i < 320 * 16; i += gridDim.x * 256) {
        const int pos = (i < 4096) ? (i >> 4) : ((i - 4096) >> 4);
        const int f = i & 15;
        const float inv = powf(10000.0f, -(float)f / 16.0f);
        const float ang = (float)pos * inv;
        const double TWO_PI = 6.283185307179586476925;
        double a = (double)ang;
        a -= TWO_PI * rint(a / TWO_PI);
        const float cr = (float)cos(a), sr = (float)sin(a);
        if (i < 4096) { rope[i] = cr; rope[4096 + i] = sr; }
        else { rope[8192 + (i - 4096)] = cr; rope[8192 + 1024 + (i - 4096)] = sr; }
    }
    {
        u16* w2t = (u16*)(WS_ + OFF_LORA); u16* a2t = w2t + 2 * 2 * 256 * 32; u16* g2t = a2t + 2 * 2 * 256 * 32;
        for (int i = BIDX_ * 256 + tid; i < 2 * 2 * 256 * 32; i += gridDim.x * 256) {
            const int lz = i >> 13, c = (i >> 5) & 255, r = i & 31;
            w2t[i] = f2bf(p.rw_w2[((size_t)lz * 32 + r) * 256 + c]);
            a2t[i] = f2bf(p.rw_a2[((size_t)lz * 32 + r) * 256 + c]);
        }
        for (int i = BIDX_ * 256 + tid; i < 2 * 256 * 64; i += gridDim.x * 256) {
            const int l = i >> 14, c = (i >> 6) & 255, r = i & 63;
            g2t[i] = f2bf(p.rw_g2[((size_t)l * 64 + r) * 256 + c]);
        }
    }
    u16* wr = (u16*)(WS_ + OFF_WR);
    for (int i = BIDX_ * 256 + tid; i < 2 * 128 * 1024; i += gridDim.x * 256) {
        const int l = i >> 17, n = (i >> 10) & 127, k = i & 1023;
        float v = 0.f;
        if (n < 4) v = p.rgw[((size_t)l * 1024 + k) * 4 + n];
        else if (n < 36) v = p.rew[((size_t)l * 1024 + k) * 32 + (n - 4)];
        wr[i] = f2bf(v);
    }
}

DEVINL void conv_tile(const float* __restrict__ src, int N, int K, u16* __restrict__ dst, int k0, int n0, int mode, char* smem) {
    unsigned* t = (unsigned*)smem;
    const int tid = tid_();
    const int n4 = (tid & 15) * 4;
    const bool ok = n0 + n4 < N;
    float4 va[2], vb[2];
    __syncthreads();
#pragma unroll
    for (int i = 0; i < 2; ++i) {
        const int kp = i * 16 + (tid >> 4);
        const float* s0 = src + (size_t)(k0 + 2 * kp) * N + n0 + n4;
        va[i] = ok ? *(const float4*)s0 : make_float4(0.f, 0.f, 0.f, 0.f);
        vb[i] = ok ? *(const float4*)(s0 + N) : make_float4(0.f, 0.f, 0.f, 0.f);
    }
#pragma unroll
    for (int i = 0; i < 2; ++i) {
        const int kp = i * 16 + (tid >> 4);
        t[(n4 + 0) * 33 + kp] = pk2bf(va[i].x, vb[i].x);
        t[(n4 + 1) * 33 + kp] = pk2bf(va[i].y, vb[i].y);
        t[(n4 + 2) * 33 + kp] = pk2bf(va[i].z, vb[i].z);
        t[(n4 + 3) * 33 + kp] = pk2bf(va[i].w, vb[i].w);
    }
    __syncthreads();
    {
        const int n = tid >> 2, w0 = (tid & 3) * 8;
        const int ng = n0 + n;
        int nd = ng;
        if (mode == 1) nd = 32 * (ng >> 4) + (ng & 15);
        else if (mode == 2) nd = 32 * (ng >> 4) + 16 + (ng & 15);
        uint4 o0, o1;
        o0.x = t[n * 33 + w0 + 0]; o0.y = t[n * 33 + w0 + 1]; o0.z = t[n * 33 + w0 + 2]; o0.w = t[n * 33 + w0 + 3];
        o1.x = t[n * 33 + w0 + 4]; o1.y = t[n * 33 + w0 + 5]; o1.z = t[n * 33 + w0 + 6]; o1.w = t[n * 33 + w0 + 7];
        u16* q = dst + (size_t)nd * K + k0 + w0 * 2;
        *(uint4*)q = o0; *(uint4*)(q + 8) = o1;
    }
}
DEVINL void ph_convw(const P& p, int l, char* smem) {
    const int TIDX_ = tid_(); const int BIDX_ = bid_(); char* const WS_ = wsl_(p.ws); (void)TIDX_; (void)BIDX_; (void)WS_;
    u16* win = (u16*)(WS_ + OFF_WIN); u16* wout = (u16*)(WS_ + OFF_WOUT);
    for (int u = BIDX_; u < 896 + 256; u += gridDim.x) {
        if (u < 896) conv_tile(p.w_in + (size_t)l * 1024 * INP, INP, 1024, win, (u / 56) * 64, (u % 56) * 64, 0, smem);
        else { const int v = u - 896; conv_tile(p.w_out + (size_t)l * 1024 * 1024, 1024, 1024, wout, (v / 16) * 64, (v % 16) * 64, 0, smem); }
    }
}
DEVINL void ph_convexp(const P& p, int l, char* smem, int bid, int nb) {
    const int TIDX_ = tid_(); const int BIDX_ = bid_(); char* const WS_ = wsl_(p.ws); (void)TIDX_; (void)BIDX_; (void)WS_;
    u16* wgu = (u16*)(WS_ + OFF_WGU); u16* wdn = (u16*)(WS_ + OFF_WDN);
    for (int u = bid; u < 32 * 384; u += nb) {
        const int e = u / 384, v = u % 384;
        const size_t le = (size_t)l * 32 + e;
        if (v < 128) conv_tile(p.egate + le * 1024 * 512, 512, 1024, wgu + (size_t)e * 1024 * 1024, (v / 8) * 64, (v % 8) * 64, 1, smem);
        else if (v < 256) { const int w = v - 128; conv_tile(p.eup + le * 1024 * 512, 512, 1024, wgu + (size_t)e * 1024 * 1024, (w / 8) * 64, (w % 8) * 64, 2, smem); }
        else { const int w = v - 256; conv_tile(p.edown + le * 512 * 1024, 1024, 512, wdn + (size_t)e * 1024 * 512, (w / 16) * 64, (w % 16) * 64, 0, smem); }
    }
}

DEVINL void ph_xm0(const P& p) {
    const int TIDX_ = tid_(); const int BIDX_ = bid_(); char* const WS_ = wsl_(p.ws); (void)TIDX_; (void)BIDX_; (void)WS_;
    const float* modv = (const float*)(WS_ + OFF_MOD);
    u16* hm = (u16*)(WS_ + OFF_HM);
    for (size_t i = (size_t)BIDX_ * 256 + TIDX_; i < (size_t)T * 256; i += (size_t)gridDim.x * 256) {
        const int row = (int)(i >> 8), c4 = (int)(i & 255) * 4;
        const float* src = row < CTXROWS ? p.ctx + (size_t)row * 1024 : p.x + (size_t)(row - CTXROWS) * 1024;
        const float* mv = modv + row_sel(row) * 6144;
        const float4 v = *(const float4*)(src + c4);
        const float4 sh = *(const float4*)(mv + c4), sc = *(const float4*)(mv + 1024 + c4);
        uint2 o;
        o.x = (unsigned)f2bf(v.x * (1.f + sc.x) + sh.x) | ((unsigned)f2bf(v.y * (1.f + sc.y) + sh.y) << 16);
        o.y = (unsigned)f2bf(v.z * (1.f + sc.z) + sh.z) | ((unsigned)f2bf(v.w * (1.f + sc.w) + sh.w) << 16);
        *(uint2*)(hm + (size_t)row * 1024 + c4) = o;
    }
}

DEVINL void ph_inproj(const P& p, char* smem) {
    const int TIDX_ = tid_(); const int BIDX_ = bid_(); char* const WS_ = wsl_(p.ws); (void)TIDX_; (void)BIDX_; (void)WS_;
    const u16* hm = (const u16*)(WS_ + OFF_HM);
    const u16* win = (const u16*)(WS_ + OFF_WIN);
    u16* pqk = (u16*)(WS_ + OFF_PQK); u16* vtl = (u16*)(WS_ + OFF_VTL); u16* vtc = (u16*)(WS_ + OFF_VTC);
    u16* pb = (u16*)(WS_ + OFF_PB); u16* pc = (u16*)(WS_ + OFF_PC);
    for (int u = BIDX_; u < 260 * 28; u += gridDim.x) {
        const int mt = u / 28, nt = u % 28;
        const u16* A = hm + (size_t)mt * 128 * 1024;
        f32x4 acc[4][4];
        gemm128_acc([&](int r) { return A + (size_t)r * 1024; }, win + (size_t)nt * 128 * 1024, 1024, 1024, smem, acc);
        if (nt >= 8 && nt < 12) {
            const int tid = tid_(), lane = tid & 63, wid = tid >> 6, wr = wid >> 1, wc = wid & 1, fr = lane & 15, fq = lane >> 4;
#pragma unroll
            for (int m = 0; m < 4; ++m)
#pragma unroll
                for (int n = 0; n < 4; ++n) {
                    const int R = mt * 128 + wr * 64 + m * 16 + fq * 4, N = nt * 128 + wc * 64 + n * 16 + fr;
                    const int hh = (N - 1024) >> 6, d = (N - 1024) & 63;
                    uint2 v; v.x = pk2bf(acc[m][n][0], acc[m][n][1]); v.y = pk2bf(acc[m][n][2], acc[m][n][3]);
                    if (R < CTXROWS) { const int b = R >> 8, t = R & 255; *(uint2*)(vtc + ((size_t)((b * 8 + hh) * 64 + d)) * 256 + t) = v; }
                    else { const int R2 = R - CTXROWS, b = R2 >> 14, t = R2 & 16383; *(uint2*)(vtl + ((size_t)((b * 8 + hh) * 64 + d)) * 16384 + t) = v; }
                }
        } else {
            stage_tile_bf16(acc, smem, [&](int row, int c8, uint4 v) {
                const int R = mt * 128 + row, N = nt * 128 + c8;
                if (N >= INP) return;
                if (N < 1024) *(uint4*)(pqk + (size_t)R * 1024 + N) = v;
                else if (N < 2496) *(uint4*)(pb + (size_t)R * 960 + (N - 1536)) = v;
                else *(uint4*)(pc + (size_t)R * 1040 + (N - 2496)) = v;
            });
        }
    }
}

constexpr size_t RWREC = 12288;
constexpr size_t RW_A1 = 0, RW_A4 = 2048, RW_A3 = 4096, RW_MKA = 8192, RW_TT = 8704, RW_MY = 9216, RW_V = 10240;
constexpr size_t OFF_RWOP = OFF_X1;
constexpr size_t OFF_RWWG = OFF_RWOP + (size_t)8 * 1040 * RWREC;
constexpr size_t OFF_YRWB = OFF_RWWG + (size_t)8 * 260 * 64 * 4;
constexpr size_t OFF_BONUS = OFF_YRWB + (size_t)T * 256 * 2;
static_assert(OFF_BONUS + (size_t)T * 4 * 4 <= OFF_HM, "rw operand store must fit the X1 region");

DEVINL float rw_mix(const u16* __restrict__ pb, const float* __restrict__ mup, const float* __restrict__ mun, int row, int t, int seqlen, int col) {
    const float cu = bf2f(pb[(size_t)row * 960 + col]);
    const float pr = t > 0 ? bf2f(pb[(size_t)(row - 1) * 960 + col]) : 0.f;
    const float nx = t + 1 < seqlen ? bf2f(pb[(size_t)(row + 1) * 960 + col]) : 0.f;
    return cu + mup[col] * (pr - cu) + mun[col] * (nx - cu);
}

DEVINL void rw_mix8(const u16* __restrict__ pb, const float* __restrict__ mup, const float* __restrict__ mun, int row, int t, int seqlen, int col0, float (&o)[8]) {
    const bool hp = t > 0, hn = t + 1 < seqlen;
    const u32x4 c = *(const u32x4*)(pb + (size_t)row * 960 + col0);
    u32x4 pv = *(const u32x4*)(pb + (size_t)(hp ? row - 1 : row) * 960 + col0);
    u32x4 nx = *(const u32x4*)(pb + (size_t)(hn ? row + 1 : row) * 960 + col0);
    const unsigned mpv = hp ? 0xFFFFFFFFu : 0u, mnx = hn ? 0xFFFFFFFFu : 0u;
    const f32x4 mp0 = *(const f32x4*)(mup + col0), mp1 = *(const f32x4*)(mup + col0 + 4), mn0 = *(const f32x4*)(mun + col0), mn1 = *(const f32x4*)(mun + col0 + 4);
#pragma unroll
    for (int i = 0; i < 4; ++i) {
        const unsigned cw = c[i], pw = pv[i] & mpv, nw = nx[i] & mnx;
        const float c0 = __uint_as_float(cw << 16), c1 = __uint_as_float(cw & 0xFFFF0000u);
        const float p0 = __uint_as_float(pw << 16), p1 = __uint_as_float(pw & 0xFFFF0000u);
        const float n0 = __uint_as_float(nw << 16), n1 = __uint_as_float(nw & 0xFFFF0000u);
        const float ma = (i < 2) ? mp0[2 * i] : mp1[2 * i - 4], mb = (i < 2) ? mp0[2 * i + 1] : mp1[2 * i - 3];
        const float na = (i < 2) ? mn0[2 * i] : mn1[2 * i - 4], nb = (i < 2) ? mn0[2 * i + 1] : mn1[2 * i - 3];
        o[2 * i] = c0 + ma * (p0 - c0) + na * (n0 - c0);
        o[2 * i + 1] = c1 + mb * (p1 - c1) + nb * (n1 - c1);
    }
}
DEVINL uint4 pack8bf(const float (&v)[8]) { return make_uint4(pk2bf(v[0], v[1]), pk2bf(v[2], v[3]), pk2bf(v[4], v[5]), pk2bf(v[6], v[7])); }

DEVINL void ph_rwprep(const P& p, int l, int d, char* smem, int bid, int nb) {
    const int TIDX_ = tid_(); const int BIDX_ = bid_(); char* const WS_ = wsl_(p.ws);
    const int tid = TIDX_, lane = tid & 63, w = tid >> 6, fr = lane & 15, fq = lane >> 4;
    const u16* pb = (const u16*)(WS_ + OFF_PB);
    char* rwop = WS_ + OFF_RWOP;
    float* rwwg = (float*)(WS_ + OFF_RWWG);
    float* bonus = (float*)(WS_ + OFF_BONUS);
    u16* gate = (u16*)(WS_ + OFF_GATE);
    const float* mup = p.mu_prev + l * 960; const float* mun = p.mu_next + l * 960;
    u16* lwdh = (u16*)smem;
    u16* ladh = lwdh + 2048;
    u16* abuf = ladh + 2048;
    float* Lb = (float*)(smem + 16384);
    u16* SV = (u16*)(smem + 32768);
    float* tot = (float*)(smem + 32768);
    const u16* w2t = (const u16*)(WS_ + OFF_LORA);
    const u16* a2t = w2t + 2 * 2 * 256 * 32;
    const u16* g2t = a2t + 2 * 2 * 256 * 32;
    const int z = d;
    for (int uh = bid; uh < NUNIT_CH * 4; uh += nb) {
        const int u = uh >> 2, h = uh & 3;
        int b, gi, row0, seqlen, gscan;
        if (u < 8) { b = u >> 2; gi = u & 3; row0 = b * 256 + gi * 64; seqlen = 256; gscan = d ? 3 - gi : gi; }
        else { b = (u - 8) >> 8; gi = (u - 8) & 255; row0 = CTXROWS + b * LAT + gi * 64; seqlen = LAT; gscan = 4 + (d ? 255 - gi : gi); }
        const int t0 = gi * 64;
        __syncthreads();
        {
            const int j = tid >> 2, cq = tid & 3;
            float v[8];
            rw_mix8(pb, mup, mun, row0 + j, t0 + j, seqlen, 768 + z * 32 + 8 * cq, v);
#pragma unroll
            for (int i = 0; i < 8; ++i) v[i] = tanhf(v[i]);
            *(uint4*)(lwdh + j * 32 + 8 * cq) = pack8bf(v);
            rw_mix8(pb, mup, mun, row0 + j, t0 + j, seqlen, 832 + z * 32 + 8 * cq, v);
            *(uint4*)(ladh + j * 32 + 8 * cq) = pack8bf(v);
        }
        if (d == 0) {
            u16* lgd = (u16*)Lb;
            {
                const int j = tid >> 2, cq = tid & 3;
#pragma unroll
                for (int hh = 0; hh < 2; ++hh) {
                    float v[8];
                    rw_mix8(pb, mup, mun, row0 + j, t0 + j, seqlen, 896 + 16 * cq + 8 * hh, v);
#pragma unroll
                    for (int i = 0; i < 8; ++i) v[i] = sigmoidf_(v[i]);
                    *(uint4*)(lgd + j * 64 + 16 * cq + 8 * hh) = pack8bf(v);
                }
            }
            __syncthreads();
            const bf16x8 x0 = *(const bf16x8*)(lgd + (16 * w + fr) * 64 + 8 * fq), x1 = *(const bf16x8*)(lgd + (16 * w + fr) * 64 + 32 + 8 * fq);
#pragma unroll
            for (int nt = 0; nt < 4; ++nt) {
                const u16* bp = g2t + ((size_t)l * 256 + 64 * h + 16 * nt + fr) * 64 + 8 * fq;
                const bf16x8 b0 = *(const bf16x8*)bp, b1 = *(const bf16x8*)(bp + 32);
                f32x4 acc = f32x4{0.f, 0.f, 0.f, 0.f};
                acc = __builtin_amdgcn_mfma_f32_16x16x32_bf16(x0, b0, acc, 0, 0, 0);
                acc = __builtin_amdgcn_mfma_f32_16x16x32_bf16(x1, b1, acc, 0, 0, 0);
#pragma unroll
                for (int r = 0; r < 4; ++r) gate[(size_t)(row0 + 16 * w + 4 * fq + r) * 256 + 64 * h + 16 * nt + fr] = f2bf(acc[r]);
            }
        }
        {
            const int bh = b * 4 + h;
            const int ch = h * 64 + lane;
            __syncthreads();
            {
                const bf16x8 xw = *(const bf16x8*)(lwdh + (16 * w + fr) * 32 + 8 * fq);
                const bf16x8 xa = *(const bf16x8*)(ladh + (16 * w + fr) * 32 + 8 * fq);
#pragma unroll 1
                for (int kt = 0; kt < 4; ++kt) {
                    const int key = 16 * kt + fr;
                    const size_t wrow = ((size_t)(l * 2 + z) * 256 + h * 64 + key) * 32 + 8 * fq;
                    const bf16x8 bw = *(const bf16x8*)(w2t + wrow), ba = *(const bf16x8*)(a2t + wrow);
                    f32x4 ae = f32x4{0.f, 0.f, 0.f, 0.f}, aa = f32x4{0.f, 0.f, 0.f, 0.f};
                    ae = __builtin_amdgcn_mfma_f32_16x16x32_bf16(xw, bw, ae, 0, 0, 0);
                    aa = __builtin_amdgcn_mfma_f32_16x16x32_bf16(xa, ba, aa, 0, 0, 0);
                    const float w0 = p.rw_w0[(l * 2 + z) * 256 + h * 64 + key], a0 = p.rw_a0[(l * 2 + z) * 256 + h * 64 + key];
#pragma unroll
                    for (int r = 0; r < 4; ++r) {
                        const int tok = 16 * w + 4 * fq + r;
                        const int s = d ? 63 - tok : tok;
                        Lb[s * 64 + key] = 0.60653065971263342f * sigmoidf_(ae[r] + w0);
                        abuf[tok * 64 + key] = f2bf(sigmoidf_(aa[r] + a0));
                    }
                }
            }
            __syncthreads();
            {
                float pre[16]; float run = 0.f;
#pragma unroll
                for (int i = 0; i < 16; ++i) { run += Lb[(16 * w + i) * 64 + lane]; pre[i] = run; }
                tot[w * 64 + lane] = run;
                __syncthreads();
                float offs = 0.f;
#pragma unroll
                for (int ww = 0; ww < 3; ++ww) offs += (ww < w) ? tot[ww * 64 + lane] : 0.f;
#pragma unroll
                for (int i = 0; i < 16; ++i) Lb[(16 * w + i) * 64 + lane] = -(offs + pre[i]);
            }
            __syncthreads();
            {
                const int j = tid >> 2, kq = tid & 3, row = row0 + j, tt = t0 + j;
                const int c0 = h * 64 + 16 * kq;
                float kr[16];
                { float t8[8];
                  rw_mix8(pb, mup, mun, row, tt, seqlen, 256 + c0, t8);
#pragma unroll
                  for (int i = 0; i < 8; ++i) kr[i] = t8[i];
                  rw_mix8(pb, mup, mun, row, tt, seqlen, 256 + c0 + 8, t8);
#pragma unroll
                  for (int i = 0; i < 8; ++i) kr[8 + i] = t8[i]; }
                float ss = 0.f;
#pragma unroll
                for (int i = 0; i < 16; ++i) { const float kv = kr[i] * p.rw_kk[l * 256 + c0 + i]; ss += kv * kv; }
                ss += __shfl_xor(ss, 1); ss += __shfl_xor(ss, 2);
                const float inorm = 1.f / fmaxf(sqrtf(ss), 1e-12f);
                const int sidx = d ? 63 - j : j;
                const int cch = sidx >> 4, ts = sidx & 15;
                u16* sv = SV + (size_t)(cch * 4) * 1024 + ts * 64 + 16 * kq;
                float bs = 0.f;
#pragma unroll 1
                for (int hh = 0; hh < 2; ++hh) {
                    const int cb = c0 + 8 * hh;
                    float rr[8], av[8], oa[8], orr[8], ob[8], ok[8];
                    rw_mix8(pb, mup, mun, row, tt, seqlen, cb, rr);
                    { const uint4 a0 = *(const uint4*)(abuf + j * 64 + 16 * kq + 8 * hh);
                      const unsigned aw[4] = {a0.x, a0.y, a0.z, a0.w};
#pragma unroll
                      for (int i = 0; i < 4; ++i) { av[2 * i] = __uint_as_float(aw[i] << 16); av[2 * i + 1] = __uint_as_float(aw[i] & 0xFFFF0000u); } }
#pragma unroll
                    for (int i4 = 0; i4 < 2; ++i4) {
                        const float4 Lt4 = *(const float4*)(Lb + sidx * 64 + 16 * kq + 8 * hh + 4 * i4);
                        const float4 Lp4 = sidx > 0 ? *(const float4*)(Lb + (sidx - 1) * 64 + 16 * kq + 8 * hh + 4 * i4) : make_float4(0.f, 0.f, 0.f, 0.f);
                        const float Lt[4] = {Lt4.x, Lt4.y, Lt4.z, Lt4.w}, Lp[4] = {Lp4.x, Lp4.y, Lp4.z, Lp4.w};
#pragma unroll
                        for (int ii = 0; ii < 4; ++ii) {
                            const int i = 4 * i4 + ii;
                            const float kraw = hh ? kr[8 + i] : kr[i];
                            const float kkn = kraw * p.rw_kk[l * 256 + cb + i] * inorm, a = av[i];
                            const float et = __expf(Lt[ii]), einv = __builtin_amdgcn_rcpf(et);
                            oa[i] = -kkn * __expf(Lp[ii]);
                            orr[i] = rr[i] * et;
                            ob[i] = kkn * a * einv;
                            ok[i] = kraw * (1.f + (a - 1.f) * p.rw_ka[l * 256 + cb + i]) * einv;
                            bs += rr[i] * kraw * p.rw_rk[l * 256 + cb + i];
                            if (sidx == 63) rwwg[((size_t)bh * 260 + gscan) * 64 + 16 * kq + 8 * hh + i] = et;
                        }
                    }
                    *(uint4*)(sv + 8 * hh) = pack8bf(oa);
                    *(uint4*)(sv + 1024 + 8 * hh) = pack8bf(orr);
                    *(uint4*)(sv + 2048 + 8 * hh) = pack8bf(ob);
                    *(uint4*)(sv + 3072 + 8 * hh) = pack8bf(ok);
                    rw_mix8(pb, mup, mun, row, tt, seqlen, 512 + cb, rr);
                    *(uint4*)(abuf + j * 64 + 16 * kq + 8 * hh) = pack8bf(rr);
                }
                if (d == 0) { bs += __shfl_xor(bs, 1); bs += __shfl_xor(bs, 2); if (kq == 0) bonus[(size_t)row * 4 + h] = bs; }
            }
            __syncthreads();
            {
                char* rec = rwop + ((size_t)bh * 1040 + (size_t)gscan * 4 + w) * RWREC;
                const u16* Av = SV + (size_t)(w * 4) * 1024; const u16* Rv = Av + 1024; const u16* Bv = Av + 2048; const u16* Kv = Av + 3072;
                bf16x8 fa[2], frr[2], fb[2], fk[2];
#pragma unroll
                for (int ks = 0; ks < 2; ++ks) {
                    fa[ks] = *(const bf16x8*)(Av + fr * 64 + ks * 32 + fq * 8);
                    frr[ks] = *(const bf16x8*)(Rv + fr * 64 + ks * 32 + fq * 8);
                    fb[ks] = *(const bf16x8*)(Bv + fr * 64 + ks * 32 + fq * 8);
                    fk[ks] = *(const bf16x8*)(Kv + fr * 64 + ks * 32 + fq * 8);
                }
                f32x4 mka = f32x4{0.f, 0.f, 0.f, 0.f}, mba = mka, mkr = mka, mbr = mka;
#pragma unroll
                for (int ks = 0; ks < 2; ++ks) {
                    mka = __builtin_amdgcn_mfma_f32_16x16x32_bf16(fa[ks], fk[ks], mka, 0, 0, 0);
                    mba = __builtin_amdgcn_mfma_f32_16x16x32_bf16(fa[ks], fb[ks], mba, 0, 0, 0);
                    mkr = __builtin_amdgcn_mfma_f32_16x16x32_bf16(frr[ks], fk[ks], mkr, 0, 0, 0);
                    mbr = __builtin_amdgcn_mfma_f32_16x16x32_bf16(frr[ks], fb[ks], mbr, 0, 0, 0);
                }
                float* Ns = Lb + w * 256;
                float* Ts = Lb + 1024 + w * 256;
                u16* rmka = (u16*)(rec + RW_MKA); u16* rmy = (u16*)(rec + RW_MY);
                const int i_ = fr;
#pragma unroll
                for (int r = 0; r < 4; ++r) {
                    const int t_ = 4 * fq + r;
                    const int lp = (i_ >> 2) * 16 + t_;
                    mka[r] = i_ < t_ ? mka[r] : 0.f;
                    rmy[lp * 8 + (i_ & 3)] = f2bf(i_ <= t_ ? mbr[r] : 0.f);
                    rmy[lp * 8 + 4 + (i_ & 3)] = f2bf(i_ <= t_ ? mkr[r] : 0.f);
                    Ns[t_ * 16 + i_] = i_ < t_ ? mba[r] : 0.f;
                }
                if (lane < 16) {
                    float Tr[16];
#pragma unroll
                    for (int ii = 0; ii < 16; ++ii) Tr[ii] = 0.f;
#pragma unroll 1
                    for (int t_ = 0; t_ < 16; ++t_) {
                        float acc = (lane == t_) ? 1.f : 0.f;
#pragma unroll
                        for (int i4 = 0; i4 < 4; ++i4) {
                            const float4 nv = *(const float4*)(Ns + t_ * 16 + 4 * i4);
                            acc += Tr[4 * i4] * nv.x + Tr[4 * i4 + 1] * nv.y + Tr[4 * i4 + 2] * nv.z + Tr[4 * i4 + 3] * nv.w;
                        }
#pragma unroll
                        for (int ii = 0; ii < 16; ++ii) Tr[ii] = (ii == t_) ? acc : Tr[ii];
                        Ts[lane * 16 + t_] = acc;
                    }
                }
                bf16x8 TTf;
                {
                    const float t0v = Ts[(4 * fq + 0) * 16 + fr], t1v = Ts[(4 * fq + 1) * 16 + fr], t2v = Ts[(4 * fq + 2) * 16 + fr], t3v = Ts[(4 * fq + 3) * 16 + fr];
                    union { u32x4 u; bf16x8 f; } x; x.u = u32x4{pk2bf(t0v, t1v), pk2bf(t2v, t3v), 0u, 0u}; TTf = x.f;
                }
                {
                    union { u32x4 u; bf16x8 f; } mb; mb.u = u32x4{pk2bf(mka[0], mka[1]), pk2bf(mka[2], mka[3]), 0u, 0u};
                    f32x4 mk2 = f32x4{0.f, 0.f, 0.f, 0.f};
                    mk2 = __builtin_amdgcn_mfma_f32_16x16x32_bf16(TTf, mb.f, mk2, 0, 0, 0);
#pragma unroll
                    for (int r = 0; r < 4; ++r) { const int t_ = 4 * fq + r; rmka[((i_ >> 2) * 16 + t_) * 4 + (i_ & 3)] = f2bf(mk2[r]); }
                }
                {
                    f32x4 ap[4];
#pragma unroll
                    for (int m = 0; m < 4; ++m) {
                        union { u32x4 u; bf16x8 f; } ag;
                        ag.u = u32x4{(unsigned)Av[(4 * fq + 0) * 64 + 16 * m + fr] | ((unsigned)Av[(4 * fq + 1) * 64 + 16 * m + fr] << 16),
                                     (unsigned)Av[(4 * fq + 2) * 64 + 16 * m + fr] | ((unsigned)Av[(4 * fq + 3) * 64 + 16 * m + fr] << 16), 0u, 0u};
                        ap[m] = f32x4{0.f, 0.f, 0.f, 0.f};
                        ap[m] = __builtin_amdgcn_mfma_f32_16x16x32_bf16(ag.f, TTf, ap[m], 0, 0, 0);
                    }
#pragma unroll
                    for (int ks = 0; ks < 2; ++ks) {
                        uint4 o;
                        o.x = pk2bf(ap[2 * ks][0], ap[2 * ks][1]); o.y = pk2bf(ap[2 * ks][2], ap[2 * ks][3]);
                        o.z = pk2bf(ap[2 * ks + 1][0], ap[2 * ks + 1][1]); o.w = pk2bf(ap[2 * ks + 1][2], ap[2 * ks + 1][3]);
                        *(uint4*)(rec + RW_A1 + (ks * 64 + lane) * 16) = o;
                    }
                }
#pragma unroll
                for (int ks = 0; ks < 2; ++ks) {
                    uint4 o;
                    const uint2 lo2 = *(const uint2*)(Rv + fr * 64 + 32 * ks + 4 * fq), hi2 = *(const uint2*)(Rv + fr * 64 + 32 * ks + 16 + 4 * fq);
                    o.x = lo2.x; o.y = lo2.y; o.z = hi2.x; o.w = hi2.y;
                    *(uint4*)(rec + RW_A4 + (ks * 64 + lane) * 16) = o;
                }
#pragma unroll
                for (int m = 0; m < 4; ++m) {
                    unsigned e[8];
#pragma unroll
                    for (int j = 0; j < 4; ++j) { e[j] = Bv[(4 * fq + j) * 64 + 16 * m + fr]; e[4 + j] = Kv[(4 * fq + j) * 64 + 16 * m + fr]; }
                    uint4 o; o.x = e[0] | (e[1] << 16); o.y = e[2] | (e[3] << 16); o.z = e[4] | (e[5] << 16); o.w = e[6] | (e[7] << 16);
                    *(uint4*)(rec + RW_A3 + (m * 64 + lane) * 16) = o;
                }
#pragma unroll
                for (int q = 0; q < 4; ++q) {
                    unsigned e[4];
#pragma unroll
                    for (int j = 0; j < 4; ++j) {
                        const int s = 16 * w + 4 * fq + j; const int jt = d ? 63 - s : s;
                        e[j] = abuf[jt * 64 + 16 * q + fr];
                    }
                    uint2 o; o.x = e[0] | (e[1] << 16); o.y = e[2] | (e[3] << 16);
                    *(uint2*)(rec + RW_V + (q * 64 + lane) * 8) = o;
                }
            }
        }
    }
}

constexpr int RWSLOT = 12544;
DEVINL void ph_rwscan(const P& p, int l, int d, int bid, int nb, char* smem) {
    const int TIDX_ = tid_(); char* const WS_ = wsl_(p.ws);
    const int tid = TIDX_, lane = tid & 63, q = tid >> 6, fr = lane & 15, fq = lane >> 4;
    const char* rwop = WS_ + OFF_RWOP;
    const float* rwwg = (const float*)(WS_ + OFF_RWWG);
    u16* yf = (u16*)(WS_ + OFF_Y);
    u16* yb = (u16*)(WS_ + OFF_YRWB);
    (void)l;
    for (int bh = bid; bh < 8; bh += nb) {
        const int b = bh >> 2, h = bh & 3;
        f32x4 z[4];
#pragma unroll
        for (int m = 0; m < 4; ++m) z[m] = f32x4{0.f, 0.f, 0.f, 0.f};
        const char* rec0 = rwop + (size_t)bh * 1040 * RWREC;
        const float* wg0 = rwwg + (size_t)bh * 260 * 64;
        constexpr int RD = 6;
        u32x4 rb[RD][3]; float rwgA = 0.f, rwgB = 0.f;
        auto ldrec = [&](int c, auto I) {
            constexpr int i = decltype(I)::value;
            const int cc = c < 1040 ? c : 1039;
            const char* rec = rec0 + (size_t)cc * RWREC;
#pragma unroll
            for (int k = 0; k < 3; ++k) rb[i][k] = *(const u32x4*)(rec + (tid + 256 * k) * 16);
        };
        auto strec = [&](auto I, int slotidx) {
            constexpr int i = decltype(I)::value;
            char* slot = smem + slotidx * RWSLOT;
#pragma unroll
            for (int k = 0; k < 3; ++k) *(u32x4*)(slot + (tid + 256 * k) * 16) = rb[i][k];
        };
        auto asfrag = [](uint4 v) { union { uint4 u; bf16x8 f; } x; x.u = v; return x.f; };
        auto pack2 = [](float lo, float hi) { return pk2bf(lo, hi); };
        const unsigned b128 = lds_addr(smem) + lane * 16, b64 = lds_addr(smem) + lane * 8, bv = lds_addr(smem) + (q * 64 + lane) * 8, bg = lds_addr(smem) + 16 * fq;
        __syncthreads();
        __builtin_amdgcn_s_setprio(3);
#define IC(n) std::integral_constant<int, n>{}
        auto flush_y = [&](int cprev, int par) {
            if (tid < 128) {
                const bool isctx = cprev < 16;
                const int cc = isctx ? cprev : cprev - 16;
                const int n = isctx ? LCTX : LAT;
                const int rowbase = isctx ? b * LCTX : CTXROWS + b * LAT;
                const int ts = tid >> 3, c8 = (tid & 7) * 8;
                const int sidx = cc * 16 + ts;
                const int t = d ? n - 1 - sidx : sidx;
                const u32x4 v = *(const u32x4*)(smem + 4 * RWSLOT + par * 2048 + (ts * 64 + c8) * 2);
                u16* dst = d == 0 ? yf + (size_t)(rowbase + t) * 1024 + 512 + h * 64 + c8 : yb + (size_t)(rowbase + t) * 256 + h * 64 + c8;
                *(u32x4*)dst = v;
            }
        };
        u32x4 f4[2][6]; u32x2 f2[2][2];
#define RD_ISSUE(par, SBC) asm volatile( \
                "ds_read_b64 %6, %9 offset:%11+8192\n\t" \
                "ds_read_b64 %7, %10 offset:%11+10240\n\t" \
                "ds_read_b128 %0, %8 offset:%11+0\n\t" \
                "ds_read_b128 %1, %8 offset:%11+1024\n\t" \
                "ds_read_b128 %2, %8 offset:%11+4096\n\t" \
                "ds_read_b128 %3, %8 offset:%11+5120\n\t" \
                "ds_read_b128 %4, %8 offset:%11+6144\n\t" \
                "ds_read_b128 %5, %8 offset:%11+7168" \
                : "=&v"(f4[par][0]), "=&v"(f4[par][1]), "=&v"(f4[par][2]), "=&v"(f4[par][3]), "=&v"(f4[par][4]), "=&v"(f4[par][5]), \
                  "=&v"(f2[par][0]), "=&v"(f2[par][1]) \
                : "v"(b128), "v"(b64), "v"(bv), "n"(SBC) \
                : "memory")
#define RD_WAIT(par) asm volatile("s_waitcnt lgkmcnt(0)" \
                : "+v"(f4[par][0]), "+v"(f4[par][1]), "+v"(f4[par][2]), "+v"(f4[par][3]), "+v"(f4[par][4]), "+v"(f4[par][5]), \
                  "+v"(f2[par][0]), "+v"(f2[par][1]) \
                :: "memory")
        ldrec(0, IC(0)); ldrec(1, IC(1)); ldrec(2, IC(2)); ldrec(3, IC(3)); ldrec(4, IC(4)); ldrec(5, IC(5));
        strec(IC(0), 0); ldrec(RD, IC(0));
        strec(IC(1), 1); ldrec(RD + 1, IC(1));
        rwgA = wg0[lane]; rwgB = wg0[64 + lane];
        asm volatile("s_waitcnt lgkmcnt(0)" ::: "memory");
        __builtin_amdgcn_s_barrier();
        RD_ISSUE(0, 0); RD_WAIT(0);
#pragma unroll 1
        for (int c5 = 0; c5 < 1044; c5 += 12) {
          auto body = [&](auto SJ) {
            constexpr int sj = decltype(SJ)::value;
            constexpr int par = sj & 1;
            const int c = c5 + sj;
            asm volatile("s_waitcnt lgkmcnt(0)" ::: "memory");
            __builtin_amdgcn_s_barrier();
            RD_ISSUE(par ^ 1, ((sj + 1) % 4) * RWSLOT);
            if (c > 0 && c <= 1040) flush_y(c - 1, par ^ 1);
            strec(IC((sj + 2) % 6), (sj + 2) % 4);
            ldrec(c + 2 + RD, IC((sj + 2) % 6));
            if ((sj & 3) == 1) {
                const bool even = (((c >> 2) & 1) == 0);
                if (q == 0) *(float*)(smem + ((sj + 2) % 4) * RWSLOT + 12288 + lane * 4) = even ? rwgA : rwgB;
                const int gn = (c >> 2) + 2;
                const float nv = wg0[(size_t)(gn < 260 ? gn : 259) * 64 + lane];
                if (even) rwgA = nv; else rwgB = nv;
            }
            if (c < 1040) {
            constexpr int SB = (sj % 4) * RWSLOT;
            auto asfrag4 = [](u32x4 v) { union { u32x4 u; bf16x8 f; } x; x.u = v; return x.f; };
            const bf16x8 A1_0 = asfrag4(f4[par][0]), A1_1 = asfrag4(f4[par][1]);
            const bf16x8 A3_0 = asfrag4(f4[par][2]), A3_1 = asfrag4(f4[par][3]), A3_2 = asfrag4(f4[par][4]), A3_3 = asfrag4(f4[par][5]);
            const u32x2 mka = f2[par][0], vcur = f2[par][1];
            const bf16x8 MKA = asfrag(make_uint4(mka.x, mka.y, 0u, 0u));
            const bf16x8 VB = asfrag(make_uint4(vcur.x, vcur.y, 0u, 0u));
            const bf16x8 ZB0 = asfrag(make_uint4(pack2(z[0][0], z[0][1]), pack2(z[0][2], z[0][3]), pack2(z[1][0], z[1][1]), pack2(z[1][2], z[1][3])));
            const bf16x8 ZB1 = asfrag(make_uint4(pack2(z[2][0], z[2][1]), pack2(z[2][2], z[2][3]), pack2(z[3][0], z[3][1]), pack2(z[3][2], z[3][3])));
            f32x4 Ua = f32x4{0.f, 0.f, 0.f, 0.f}, Ub = f32x4{0.f, 0.f, 0.f, 0.f};
            Ua = __builtin_amdgcn_mfma_f32_16x16x32_bf16(MKA, VB, Ua, 0, 0, 0);
            Ub = __builtin_amdgcn_mfma_f32_16x16x32_bf16(A1_1, ZB1, Ub, 0, 0, 0);
            Ua = __builtin_amdgcn_mfma_f32_16x16x32_bf16(A1_0, ZB0, Ua, 0, 0, 0);
            u32x4 r_a40, r_a41, r_my;
            asm volatile(
                "ds_read_b128 %0, %3 offset:%4+2048\n\t"
                "ds_read_b128 %1, %3 offset:%4+3072\n\t"
                "ds_read_b128 %2, %3 offset:%4+9216\n\t"
                "s_waitcnt lgkmcnt(0)"
                : "=&v"(r_a40), "=&v"(r_a41), "=&v"(r_my) : "v"(b128), "n"(SB) : "memory");
            const bf16x8 A4_0 = asfrag4(r_a40), A4_1 = asfrag4(r_a41), MY = asfrag4(r_my);
            f32x4 Y = f32x4{0.f, 0.f, 0.f, 0.f};
            Y = __builtin_amdgcn_mfma_f32_16x16x32_bf16(A4_0, ZB0, Y, 0, 0, 0);
            Y = __builtin_amdgcn_mfma_f32_16x16x32_bf16(A4_1, ZB1, Y, 0, 0, 0);
            const f32x4 U = Ua + Ub;
            const bf16x8 UV = asfrag(make_uint4(pack2(U[0], U[1]), pack2(U[2], U[3]), vcur.x, vcur.y));
            z[0] = __builtin_amdgcn_mfma_f32_16x16x32_bf16(A3_0, UV, z[0], 0, 0, 0);
            z[1] = __builtin_amdgcn_mfma_f32_16x16x32_bf16(A3_1, UV, z[1], 0, 0, 0);
            z[2] = __builtin_amdgcn_mfma_f32_16x16x32_bf16(A3_2, UV, z[2], 0, 0, 0);
            z[3] = __builtin_amdgcn_mfma_f32_16x16x32_bf16(A3_3, UV, z[3], 0, 0, 0);
            Y = __builtin_amdgcn_mfma_f32_16x16x32_bf16(MY, UV, Y, 0, 0, 0);
            asm volatile("s_waitcnt lgkmcnt(0)" ::: "memory");
            if ((c & 3) == 3) {
                u32x4 g0, g1, g2, g3;
                asm volatile(
                    "ds_read_b128 %0, %4 offset:%5+12288\n\t"
                    "ds_read_b128 %1, %4 offset:%5+12352\n\t"
                    "ds_read_b128 %2, %4 offset:%5+12416\n\t"
                    "ds_read_b128 %3, %4 offset:%5+12480\n\t"
                    "s_waitcnt lgkmcnt(0)"
                    : "=&v"(g0), "=&v"(g1), "=&v"(g2), "=&v"(g3) : "v"(bg), "n"(SB) : "memory");
                z[0][0] *= __uint_as_float(g0.x); z[0][1] *= __uint_as_float(g0.y); z[0][2] *= __uint_as_float(g0.z); z[0][3] *= __uint_as_float(g0.w);
                z[1][0] *= __uint_as_float(g1.x); z[1][1] *= __uint_as_float(g1.y); z[1][2] *= __uint_as_float(g1.z); z[1][3] *= __uint_as_float(g1.w);
                z[2][0] *= __uint_as_float(g2.x); z[2][1] *= __uint_as_float(g2.y); z[2][2] *= __uint_as_float(g2.z); z[2][3] *= __uint_as_float(g2.w);
                z[3][0] *= __uint_as_float(g3.x); z[3][1] *= __uint_as_float(g3.y); z[3][2] *= __uint_as_float(g3.z); z[3][3] *= __uint_as_float(g3.w);
            }
            {
                u16* yl = (u16*)(smem + 4 * RWSLOT + par * 2048);
                const unsigned y01 = pk2bf(Y[0], Y[1]), y23 = pk2bf(Y[2], Y[3]);
                yl[(4 * fq + 0) * 64 + 16 * q + fr] = (u16)(y01 & 0xFFFFu);
                yl[(4 * fq + 1) * 64 + 16 * q + fr] = (u16)(y01 >> 16);
                yl[(4 * fq + 2) * 64 + 16 * q + fr] = (u16)(y23 & 0xFFFFu);
                yl[(4 * fq + 3) * 64 + 16 * q + fr] = (u16)(y23 >> 16);
            }
            }
            RD_WAIT(par ^ 1);
          };
          body(IC(0)); body(IC(1)); body(IC(2)); body(IC(3)); body(IC(4)); body(IC(5)); body(IC(6)); body(IC(7)); body(IC(8)); body(IC(9)); body(IC(10)); body(IC(11));
        }
        asm volatile("s_waitcnt vmcnt(0)" ::: "memory");
        __builtin_amdgcn_s_setprio(0);
        __syncthreads();
    }
}

DEVINL void ph_rwout(const P& p, int l) {
    const int TIDX_ = tid_(); const int BIDX_ = bid_(); char* const WS_ = wsl_(p.ws);
    const int tid = TIDX_, h = tid >> 6;
    const u16* pb = (const u16*)(WS_ + OFF_PB);
    const u16* yb = (const u16*)(WS_ + OFF_YRWB);
    const u16* gate = (const u16*)(WS_ + OFF_GATE);
    const float* bonus = (const float*)(WS_ + OFF_BONUS);
    u16* y = (u16*)(WS_ + OFF_Y);
    const float* mup = p.mu_prev + l * 960; const float* mun = p.mu_next + l * 960;
    const float lw = p.rw_lnw[l * 256 + tid], lb = p.rw_lnb[l * 256 + tid];
    const int rstart = (l == 0) ? 0 : CTXROWS;
    for (int row = rstart + BIDX_; row < T; row += gridDim.x) {
        int t, seqlen;
        if (row < CTXROWS) { t = row & 255; seqlen = LCTX; } else { t = (row - CTXROWS) & (LAT - 1); seqlen = LAT; }
        const float yv = bf2f(y[(size_t)row * 1024 + 512 + tid]) + bf2f(yb[(size_t)row * 256 + tid]);
        const float v = rw_mix(pb, mup, mun, row, t, seqlen, 512 + tid);
        const float mu = wsum(yv) * (1.f / 64.f);
        const float dl = yv - mu;
        const float var = wsum(dl * dl) * (1.f / 64.f);
        const float o = (dl * rsqrtf(var + 64e-5f) * lw + lb + bonus[(size_t)row * 4 + h] * v) * bf2f(gate[(size_t)row * 256 + tid]);
        y[(size_t)row * 1024 + 512 + tid] = f2bf(o);
    }
}
DEVINL void ph_prepM(const P& p, int l, char* smem, int bid, int nb) {
    const int TIDX_ = tid_(); const int BIDX_ = bid_(); char* const WS_ = wsl_(p.ws);
    const int tid = TIDX_, lane = tid & 63, wid = tid >> 6;
    const u16* pc = (const u16*)(WS_ + OFF_PC);
    u16* mlf = (u16*)(WS_ + OFF_MLF);
    float* mlg = (float*)(WS_ + OFF_MLG);
    float* mls = (float*)(WS_ + OFF_MLS);
    float* nst = (float*)(WS_ + OFF_NST);
    float* cst = (float*)(WS_ + OFF_HM);
    const float* rope = (const float*)(WS_ + OFF_ROPE);
    u16* kl = (u16*)smem;
    u16* vl = kl + 4096;
    float* wsl = (float*)(vl + 4096);
    float* lil = wsl + 128;
    for (int uh = bid; uh < NUNIT_CH * 4; uh += nb) {
        const int u = uh >> 2, h = uh & 3;
        int b, ch, row0, seqlen; bool isctx;
        if (u < 8) { isctx = true; b = u >> 2; ch = u & 3; row0 = b * 256 + ch * 64; seqlen = 256; }
        else { isctx = false; b = (u - 8) >> 8; ch = (u - 8) & 255; row0 = CTXROWS + b * LAT + ch * 64; seqlen = LAT; }
        const int t0 = ch * 64;
        const int tc = isctx ? ch : 4 + ch;
        __syncthreads();
        {
            const bool isk = wid >= 2;
            const int cch = (isk ? 256 : 0) + h * 64 + lane;
            const float* cw = p.ml_cw + (size_t)l * 3 * 512;
            const float w0 = cw[cch], w1 = cw[512 + cch], w2 = cw[1024 + cch], bb = p.ml_cb[l * 512 + cch];
            const int jb = (wid & 1) * 32;
            const int i16 = lane & 15; const bool second = (lane & 16) != 0; const int half = lane >> 5;
            float pv = (t0 + jb > 0) ? bf2f(pc[(size_t)(row0 + jb - 1) * 1040 + cch]) : 0.f;
            float cv = bf2f(pc[(size_t)(row0 + jb) * 1040 + cch]);
#pragma unroll 4
            for (int jj = 0; jj < 32; ++jj) {
                const int j = jb + jj;
                const float nv = (t0 + j + 1 < seqlen) ? bf2f(pc[(size_t)(row0 + j + 1) * 1040 + cch]) : 0.f;
                float val = siluf_(w0 * pv + w1 * cv + w2 * nv + bb);
                if (!isctx) {
                    const int t = t0 + j;
                    const int pos = half == 0 ? (t >> 6) : (t & 63);
                    const float cs = half == 0 ? rope[pos * 16 + i16] : rope[8192 + pos * 16 + i16];
                    const float sn = half == 0 ? rope[4096 + pos * 16 + i16] : rope[9216 + pos * 16 + i16];
                    const float ov = __shfl_xor(val, 16);
                    val = second ? (ov * sn + val * cs) : (val * cs - ov * sn);
                }
                if (isk) { const u16 kb = f2bf(val * 0.125f); mlf[(size_t)(row0 + j) * 512 + 256 + h * 64 + lane] = kb; kl[j * 64 + lane] = kb; }
                else mlf[(size_t)(row0 + j) * 512 + h * 64 + lane] = f2bf(val);
                pv = cv; cv = nv;
            }
            {
                const int j = tid >> 2, wh = tid & 3;
                const int idx = (wh < 2) ? (wh * 4 + h) : (8 + (wh - 2) * 4 + h);
                const float g = bf2f(pc[(size_t)(row0 + j) * 1040 + 1024 + idx]);
                float v;
                if (wh < 2) v = g + p.ml_ib[l * 8 + idx];
                else { const float xx = g + p.ml_fb[l * 8 + idx - 8]; v = fminf(xx, 0.f) - log1pf(__expf(-fabsf(xx))); }
                lil[j * 4 + wh] = v;
                mlg[(size_t)(row0 + j) * 16 + idx] = v;
            }
            for (int i = tid; i < 64 * 16; i += 256) {
                const int tok = i >> 4, c4 = (i & 15) * 4;
                *(uint2*)(vl + tok * 64 + c4) = *(const uint2*)(pc + (size_t)(row0 + tok) * 1040 + 512 + h * 64 + c4);
            }
        }
        __syncthreads();
        if (tid < 2) {
            const int d = tid;
            float bacc = 0.f;
#pragma unroll 1
            for (int jj = 0; jj < 64; ++jj) { const int tok = d ? 63 - jj : jj; bacc += lil[tok * 4 + 2 + d]; wsl[d * 64 + tok] = bacc; }
            const float Bs = bacc;
            float G = -3.0e38f;
#pragma unroll 1
            for (int tok = 0; tok < 64; ++tok) { const float g = Bs - wsl[d * 64 + tok] + lil[tok * 4 + d]; G = fmaxf(G, g); }
#pragma unroll 1
            for (int tok = 0; tok < 64; ++tok) { const float g = Bs - wsl[d * 64 + tok] + lil[tok * 4 + d]; wsl[d * 64 + tok] = expf(g - G); }
            const int bhd = (b * 4 + h) * 2 + d;
            mls[(bhd * NTC + tc) * 2 + 0] = G; mls[(bhd * NTC + tc) * 2 + 1] = Bs;
        }
        __syncthreads();
        {
            const int dk4 = (tid >> 4) * 4, dv4 = (tid & 15) * 4;
            float a0[4][4], a1[4][4], n0[4], n1[4];
#pragma unroll
            for (int a = 0; a < 4; ++a) { n0[a] = 0.f; n1[a] = 0.f;
#pragma unroll
                for (int c = 0; c < 4; ++c) { a0[a][c] = 0.f; a1[a][c] = 0.f; } }
#pragma unroll 2
            for (int j = 0; j < 64; ++j) {
                const uint2 kk = *(const uint2*)(kl + j * 64 + dk4);
                const uint2 vv = *(const uint2*)(vl + j * 64 + dv4);
                const float w0 = wsl[j], w1 = wsl[64 + j];
                const float kf[4] = {bf2f((u16)(kk.x & 0xFFFF)), bf2f((u16)(kk.x >> 16)), bf2f((u16)(kk.y & 0xFFFF)), bf2f((u16)(kk.y >> 16))};
                const float vf[4] = {bf2f((u16)(vv.x & 0xFFFF)), bf2f((u16)(vv.x >> 16)), bf2f((u16)(vv.y & 0xFFFF)), bf2f((u16)(vv.y >> 16))};
#pragma unroll
                for (int a = 0; a < 4; ++a) {
                    const float k0 = kf[a] * w0, k1 = kf[a] * w1;
                    n0[a] += k0; n1[a] += k1;
#pragma unroll
                    for (int c = 0; c < 4; ++c) { a0[a][c] += k0 * vf[c]; a1[a][c] += k1 * vf[c]; }
                }
            }
            const int bh0 = ((b * 4 + h) * 2 + 0) * NTC + tc, bh1 = ((b * 4 + h) * 2 + 1) * NTC + tc;
#pragma unroll
            for (int a = 0; a < 4; ++a) {
                *(float4*)(cst + (size_t)bh0 * 4096 + (dk4 + a) * 64 + dv4) = make_float4(a0[a][0], a0[a][1], a0[a][2], a0[a][3]);
                *(float4*)(cst + (size_t)bh1 * 4096 + (dk4 + a) * 64 + dv4) = make_float4(a1[a][0], a1[a][1], a1[a][2], a1[a][3]);
                if ((tid & 15) == 0) { nst[(size_t)bh0 * 64 + dk4 + a] = n0[a]; nst[(size_t)bh1 * 64 + dk4 + a] = n1[a]; }
            }
        }
    }
}

DEVINL void ph_mlB(const P& p, int bid, int nb, char* smem) {
    const int TIDX_ = tid_(); char* const WS_ = wsl_(p.ws);
    const int tid = TIDX_;
    const float* mls = (const float*)(WS_ + OFF_MLS);
    float* mst = (float*)(WS_ + OFF_MST);
    float* nst = (float*)(WS_ + OFF_NST);
    const float* cst = (const float*)(WS_ + OFF_HM);
    u16* cst2 = (u16*)(WS_ + OFF_CST2);
    float* nst2 = (float*)(WS_ + OFF_NST2);
    float* gb = (float*)smem;
    float* dcu = gb + 1024;
    for (int u = bid; u < 64; u += nb) {
        const int bhd = u >> 2, q = u & 3, d = bhd & 1;
        auto tcof = [&](int cs) { return cs < 4 ? (d ? 3 - cs : cs) : 4 + (d ? 255 - (cs - 4) : cs - 4); };
        __syncthreads();
        for (int cs = tid; cs < NTC; cs += 256) { const int tc = tcof(cs); gb[cs * 2] = mls[(bhd * NTC + tc) * 2]; gb[cs * 2 + 1] = mls[(bhd * NTC + tc) * 2 + 1]; }
        __syncthreads();
        if (tid == 0) {
            float m = 0.f;
#pragma unroll 1
            for (int cs = 0; cs < NTC; ++cs) {
                const float G = gb[cs * 2], Bs = gb[cs * 2 + 1];
                if (q == 0) mst[bhd * NTC + tcof(cs)] = m;
                const float ml = fmaxf(Bs + m, G);
                dcu[cs * 2] = __expf(Bs + m - ml); dcu[cs * 2 + 1] = __expf(G - ml);
                m = ml;
            }
        }
        __syncthreads();
        float zz = 0.f; asm volatile("" : "+v"(zz));
        float4 C = make_float4(zz, zz, zz, zz);
        float nn = zz;
        const bool don = (q == 0) && (tid < 64);
        const float* cbase = cst + (size_t)bhd * NTC * 4096 + q * 1024 + tid * 4;
        const float* nbase = nst + (size_t)bhd * NTC * 64 + tid;
        u16* obase = cst2 + (size_t)bhd * NTC * 4096 + q * 1024 + tid * 4;
        float* onbase = nst2 + (size_t)bhd * NTC * 64 + tid;
        float4 Ub[8]; float Nb[8];
#pragma unroll
        for (int i = 0; i < 8; ++i) { Ub[i] = *(const float4*)(cbase + (size_t)tcof(i) * 4096); Nb[i] = don ? nbase[(size_t)tcof(i) * 64] : 0.f; }
#pragma unroll 1
        for (int cs0 = 0; cs0 < NTC; cs0 += 8) {
#pragma unroll
            for (int i = 0; i < 8; ++i) {
                const int cs = cs0 + i;
                if (cs < NTC) {
                    const float4 U = Ub[i]; const float nU = Nb[i];
                    const int tc = tcof(cs);
                    if (cs + 8 < NTC) { Ub[i] = *(const float4*)(cbase + (size_t)tcof(cs + 8) * 4096); Nb[i] = don ? nbase[(size_t)tcof(cs + 8) * 64] : 0.f; }
                    { uint2 o; o.x = pk2bf(C.x, C.y); o.y = pk2bf(C.z, C.w); *(uint2*)(obase + (size_t)tc * 4096) = o; }
                    if (don) onbase[(size_t)tc * 64] = nn;
                    const float dC = dcu[cs * 2], dU = dcu[cs * 2 + 1];
                    C.x = dC * C.x + dU * U.x; C.y = dC * C.y + dU * U.y; C.z = dC * C.z + dU * U.z; C.w = dC * C.w + dU * U.w;
                    nn = dC * nn + dU * nU;
                }
            }
        }
    }
}

DEVINL void ph_na(const P& p, int l, char* smem, int bid, int nb) {
    const int TIDX_ = tid_(); char* const WS_ = wsl_(p.ws);
    const int tid = TIDX_, lane = tid & 63, w = tid >> 6, fr = lane & 15, g = lane >> 4;
    const u16* pqk = (const u16*)(WS_ + OFF_PQK);
    const u16* vtl = (const u16*)(WS_ + OFF_VTL);
    const u16* vtc = (const u16*)(WS_ + OFF_VTC);
    u16* y = (u16*)(WS_ + OFF_Y);
    float* rpbl = (float*)(smem + 49152);
    const int nunit = 4096 + (l == 0 ? 64 : 0);
    const unsigned lbase = lds_addr(smem);
    const int lrow0 = tid >> 3, lrow1 = lrow0 + 32, lsc = ((tid & 7) ^ (lrow0 & 7)) * 8;
    for (int u = bid; u < nunit; u += nb) {
        const bool isctx = u >= 4096;
        int b, h, r = 0, qg = 0;
        if (!isctx) { b = u >> 11; h = (u >> 8) & 7; r = u & 255; }
        else { const int v = u - 4096; b = v >> 5; h = (v >> 2) & 7; qg = v & 3; }
        const int rs = min(max(r - 4, 0), 248);
        const int nwin = isctx ? 0 : 8, nst = nwin + 4;
        auto issue = [&](int st) {
            char* slot = smem + (st % 3) * 16384;
            const u16* ksrc; const u16* vsrc; size_t vstride;
            if (st < nwin) {
                const size_t tok0 = (size_t)CTXROWS + (size_t)b * LAT + (size_t)(rs + st) * 64;
                ksrc = pqk + tok0 * 1024 + 512 + h * 64;
                vsrc = vtl + (size_t)((b * 8 + h) * 64) * LAT + (size_t)(rs + st) * 64; vstride = LAT;
            } else {
                const size_t tok0 = (size_t)b * LCTX + (size_t)(st - nwin) * 64;
                ksrc = pqk + tok0 * 1024 + 512 + h * 64;
                vsrc = vtc + (size_t)((b * 8 + h) * 64) * LCTX + (size_t)(st - nwin) * 64; vstride = LCTX;
            }
            glds16(ksrc + (size_t)lrow0 * 1024 + lsc, slot + tid * 16);
            glds16(ksrc + (size_t)lrow1 * 1024 + lsc, slot + 4096 + tid * 16);
            glds16(vsrc + (size_t)lrow0 * vstride + lsc, slot + 8192 + tid * 16);
            glds16(vsrc + (size_t)lrow1 * vstride + lsc, slot + 8192 + 4096 + tid * 16);
        };
        __syncthreads();
        issue(0); issue(1);
        if (!isctx) for (int i = tid; i < 465; i += 256) rpbl[i] = p.na_rpb[((size_t)l * 8 + h) * 465 + i];
        asm volatile("s_waitcnt lgkmcnt(0)" ::: "memory");
        const int c = 16 * w + fr;
        const int qrow = isctx ? b * LCTX + qg * 64 + c : CTXROWS + b * LAT + r * 64 + c;
        bf16x8 qf[2];
        qf[0] = *(const bf16x8*)(pqk + (size_t)qrow * 1024 + h * 64 + 8 * g);
        qf[1] = *(const bf16x8*)(pqk + (size_t)qrow * 1024 + h * 64 + 32 + 8 * g);
        f32x4 O[4];
#pragma unroll
        for (int i = 0; i < 4; ++i) O[i] = f32x4{0.f, 0.f, 0.f, 0.f};
        float mrun = -1.0e30f, lrun = 0.f;
        const int cb = (w == 0) ? 0 : (w == 1) ? 8 : (w == 2) ? 24 : 32;
        const int cs = min(max(c - 8, 0), 48);
        auto chunk = [&](unsigned sl, int kb, const float* bias0, bool local) {
            const int key0 = kb + fr, key1 = kb + 16 + fr;
            const unsigned ka0 = sl + key0 * 128, ka1 = sl + key1 * 128;
            const unsigned k00a = ka0 + ((g ^ (key0 & 7)) << 4), k01a = ka0 + (((4 + g) ^ (key0 & 7)) << 4);
            const unsigned k10a = ka1 + ((g ^ (key1 & 7)) << 4), k11a = ka1 + (((4 + g) ^ (key1 & 7)) << 4);
            const int q0 = (kb >> 2) + g, q1 = q0 + 4;
            const unsigned vbase = sl + 8192 + fr * 128;
            const unsigned vo0 = ((((q0 >> 1) ^ (fr & 7)) << 4) + ((q0 & 1) << 3)), vo1 = ((((q1 >> 1) ^ (fr & 7)) << 4) + ((q1 & 1) << 3));
            u32x4 k00, k01, k10, k11; u32x2 vlo0, vhi0, vlo1, vhi1, vlo2, vhi2, vlo3, vhi3;
            asm volatile(
                "ds_read_b128 %0, %12\n\t"
                "ds_read_b128 %1, %13\n\t"
                "ds_read_b128 %2, %14\n\t"
                "ds_read_b128 %3, %15\n\t"
                "ds_read_b64 %4, %16\n\t"
                "ds_read_b64 %5, %17\n\t"
                "ds_read_b64 %6, %16 offset:2048\n\t"
                "ds_read_b64 %7, %17 offset:2048\n\t"
                "ds_read_b64 %8, %16 offset:4096\n\t"
                "ds_read_b64 %9, %17 offset:4096\n\t"
                "ds_read_b64 %10, %16 offset:6144\n\t"
                "ds_read_b64 %11, %17 offset:6144\n\t"
                "s_waitcnt lgkmcnt(0)"
                : "=&v"(k00), "=&v"(k01), "=&v"(k10), "=&v"(k11), "=&v"(vlo0), "=&v"(vhi0), "=&v"(vlo1), "=&v"(vhi1),
                  "=&v"(vlo2), "=&v"(vhi2), "=&v"(vlo3), "=&v"(vhi3)
                : "v"(k00a), "v"(k01a), "v"(k10a), "v"(k11a), "v"(vbase + vo0), "v"(vbase + vo1)
                : "memory");
            auto asf = [](u32x4 v) { union { u32x4 u; bf16x8 f; } x; x.u = v; return x.f; };
            f32x4 s0 = f32x4{0.f, 0.f, 0.f, 0.f}, s1 = f32x4{0.f, 0.f, 0.f, 0.f};
            s0 = __builtin_amdgcn_mfma_f32_16x16x32_bf16(asf(k00), qf[0], s0, 0, 0, 0);
            s0 = __builtin_amdgcn_mfma_f32_16x16x32_bf16(asf(k01), qf[1], s0, 0, 0, 0);
            s1 = __builtin_amdgcn_mfma_f32_16x16x32_bf16(asf(k10), qf[0], s1, 0, 0, 0);
            s1 = __builtin_amdgcn_mfma_f32_16x16x32_bf16(asf(k11), qf[1], s1, 0, 0, 0);
            float sv[8];
#pragma unroll
            for (int j = 0; j < 4; ++j) {
                float a = s0[j] * 0.125f, bb = s1[j] * 0.125f;
                if (local) {
                    const int k0c = kb + 4 * g + j, k1c = k0c + 16;
                    a = (k0c >= cs && k0c <= cs + 15) ? a + bias0[k0c] : -1.0e30f;
                    bb = (k1c >= cs && k1c <= cs + 15) ? bb + bias0[k1c] : -1.0e30f;
                }
                sv[j] = a; sv[4 + j] = bb;
            }
            float mx = sv[0];
#pragma unroll
            for (int j = 1; j < 8; ++j) mx = fmaxf(mx, sv[j]);
            mx = fmaxf(mx, __shfl_xor(mx, 16)); mx = fmaxf(mx, __shfl_xor(mx, 32));
            const float mnew = fmaxf(mrun, mx);
            const float sc = __expf(mrun - mnew);
            mrun = mnew;
            float ps = 0.f; float pv[8];
#pragma unroll
            for (int j = 0; j < 8; ++j) { pv[j] = __expf(sv[j] - mnew); ps += pv[j]; }
            lrun = lrun * sc + ps;
            union { u32x4 u; bf16x8 f; } pf; pf.u = u32x4{pk2bf(pv[0], pv[1]), pk2bf(pv[2], pv[3]), pk2bf(pv[4], pv[5]), pk2bf(pv[6], pv[7])};
            const u32x2 vl[4] = {vlo0, vlo1, vlo2, vlo3}, vh[4] = {vhi0, vhi1, vhi2, vhi3};
#pragma unroll
            for (int dt = 0; dt < 4; ++dt) {
                O[dt][0] *= sc; O[dt][1] *= sc; O[dt][2] *= sc; O[dt][3] *= sc;
                union { u32x4 u; bf16x8 f; } vf; vf.u = u32x4{vl[dt].x, vl[dt].y, vh[dt].x, vh[dt].y};
                O[dt] = __builtin_amdgcn_mfma_f32_16x16x32_bf16(vf.f, pf.f, O[dt], 0, 0, 0);
            }
        };
#pragma unroll 1
        for (int st = 0; st < nst; ++st) {
            if (st + 1 < nst) asm volatile("s_waitcnt vmcnt(4)" ::: "memory"); else asm volatile("s_waitcnt vmcnt(0)" ::: "memory");
            __builtin_amdgcn_s_barrier();
            if (st + 2 < nst) issue(st + 2);
            const unsigned sl = lbase + (st % 3) * 16384;
            if (st < nwin) {
                const int krow = rs + st;
                chunk(sl, cb, rpbl + (krow - r + 7) * 31 - c + 15, true);
            } else {
                chunk(sl, 0, nullptr, false);
                chunk(sl, 32, nullptr, false);
            }
        }
        float lt = lrun; lt += __shfl_xor(lt, 16); lt += __shfl_xor(lt, 32);
        const float inv = 1.f / lt;
#pragma unroll
        for (int dt = 0; dt < 4; ++dt) {
            uint2 o;
            o.x = pk2bf(O[dt][0] * inv, O[dt][1] * inv);
            o.y = pk2bf(O[dt][2] * inv, O[dt][3] * inv);
            *(uint2*)(y + (size_t)qrow * 1024 + h * 64 + dt * 16 + 4 * g) = o;
        }
    }
    asm volatile("s_waitcnt vmcnt(0)" ::: "memory");
    __syncthreads();
}

DEVINL void ph_mlC(const P& p, int l, char* smem, int bid, int nb) {
    const int TIDX_ = tid_(); const int BIDX_ = bid_(); char* const WS_ = wsl_(p.ws); (void)TIDX_; (void)BIDX_; (void)WS_;
    const int tid = TIDX_;
    const u16* mlf = (const u16*)(WS_ + OFF_MLF);
    const u16* pc = (const u16*)(WS_ + OFF_PC);
    const float* mlg = (const float*)(WS_ + OFF_MLG);
    const float* mst = (const float*)(WS_ + OFF_MST);
    const float* nst = (const float*)(WS_ + OFF_NST2);
    const u16* cst = (const u16*)(WS_ + OFF_CST2);
    u16* y = (u16*)(WS_ + OFF_Y);
    u16* ql = (u16*)smem;
    u16* kl = ql + 4096;
    u16* vl = kl + 4096;
    float* Cl = (float*)(vl + 4096);
    float* Sl = Cl + 4096;
    float* btl = Sl + 4096;
    float* lil = btl + 64;
    float* nl = lil + 64;
    const int t = tid >> 2, q4 = tid & 3;
    for (int uh = bid; uh < 2 * NTC * 4; uh += nb) {
        const int u = uh >> 2, h = uh & 3;
        const int b = u / NTC, tc = u % NTC;
        if (tc < 4 && l != 0) continue;
        const int row0 = tc < 4 ? b * LCTX + tc * 64 : CTXROWS + b * LAT + (tc - 4) * 64;
        {
            float hs[16];
#pragma unroll
            for (int i = 0; i < 16; ++i) hs[i] = 0.f;
            __syncthreads();
            for (int i = tid; i < 64 * 16; i += 256) {
                const int tok = i >> 4, c4 = (i & 15) * 4;
                *(uint2*)(ql + tok * 64 + c4) = *(const uint2*)(mlf + (size_t)(row0 + tok) * 512 + h * 64 + c4);
                *(uint2*)(kl + tok * 64 + c4) = *(const uint2*)(mlf + (size_t)(row0 + tok) * 512 + 256 + h * 64 + c4);
                *(uint2*)(vl + tok * 64 + c4) = *(const uint2*)(pc + (size_t)(row0 + tok) * 1040 + 512 + h * 64 + c4);
            }
            for (int d = 0; d < 2; ++d) {
                const int bhd = (b * 4 + h) * 2 + d;
                __syncthreads();
                for (int i = tid; i < 1024; i += 256) { const uint2 cv = *(const uint2*)(cst + ((size_t)bhd * NTC + tc) * 4096 + i * 4); *(float4*)(Cl + i * 4) = make_float4(bf2f((u16)(cv.x & 0xFFFF)), bf2f((u16)(cv.x >> 16)), bf2f((u16)(cv.y & 0xFFFF)), bf2f((u16)(cv.y >> 16))); }
                if (tid < 64) { nl[tid] = nst[((size_t)bhd * NTC + tc) * 64 + tid]; lil[tid] = mlg[(size_t)(row0 + tid) * 16 + d * 4 + h]; }
                if (tid == 64) {
                    float bacc = 0.f;
#pragma unroll 1
                    for (int jj = 0; jj < 64; ++jj) { const int tok = d ? 63 - jj : jj; bacc += mlg[(size_t)(row0 + tok) * 16 + 8 + d * 4 + h]; btl[tok] = bacc; }
                }
                __syncthreads();
                const float m0 = mst[bhd * NTC + tc];
                float sc[16];
#pragma unroll
                for (int i = 0; i < 16; ++i) sc[i] = 0.f;
                for (int dk = 0; dk < 64; dk += 4) {
                    const uint2 qq = *(const uint2*)(ql + t * 64 + dk);
                    const float q0 = bf2f((u16)(qq.x & 0xFFFF)), q1 = bf2f((u16)(qq.x >> 16)), q2 = bf2f((u16)(qq.y & 0xFFFF)), q3 = bf2f((u16)(qq.y >> 16));
#pragma unroll
                    for (int i = 0; i < 16; ++i) {
                        const uint2 kk = *(const uint2*)(kl + (q4 * 16 + i) * 64 + dk);
                        sc[i] += q0 * bf2f((u16)(kk.x & 0xFFFF)) + q1 * bf2f((u16)(kk.x >> 16)) + q2 * bf2f((u16)(kk.y & 0xFFFF)) + q3 * bf2f((u16)(kk.y >> 16));
                    }
                }
                const float bt = btl[t];
                float ld[16]; float mx = -3.0e38f;
#pragma unroll
                for (int i = 0; i < 16; ++i) {
                    const int s = q4 * 16 + i;
                    const bool ok = d ? (s >= t) : (s <= t);
                    ld[i] = ok ? (bt - btl[s] + lil[s]) : -3.0e38f;
                    mx = fmaxf(mx, ld[i]);
                }
                mx = fmaxf(mx, __shfl_xor(mx, 1)); mx = fmaxf(mx, __shfl_xor(mx, 2));
                const float mt = fmaxf(bt + m0, mx);
                float rsum = 0.f;
#pragma unroll
                for (int i = 0; i < 16; ++i) {
                    const int s = q4 * 16 + i;
                    const bool ok = d ? (s >= t) : (s <= t);
                    const float dw = ok ? expf(ld[i] - mt) * sc[i] : 0.f;
                    rsum += dw;
                    Sl[t * 64 + s] = dw;
                }
                rsum += __shfl_xor(rsum, 1); rsum += __shfl_xor(rsum, 2);
                const float inter = expf(bt + m0 - mt);
                float qn = 0.f;
                for (int dk = q4 * 16; dk < q4 * 16 + 16; ++dk) qn += bf2f(ql[t * 64 + dk]) * nl[dk];
                qn += __shfl_xor(qn, 1); qn += __shfl_xor(qn, 2);
                const float den = rsum + inter * qn;
                __syncthreads();
                float num[16];
#pragma unroll
                for (int i = 0; i < 16; ++i) num[i] = 0.f;
                for (int s = 0; s < 64; ++s) {
                    const float dw = Sl[t * 64 + s];
                    const uint4 va = *(const uint4*)(vl + s * 64 + q4 * 16);
                    const uint4 vb2 = *(const uint4*)(vl + s * 64 + q4 * 16 + 8);
                    const unsigned vv[8] = {va.x, va.y, va.z, va.w, vb2.x, vb2.y, vb2.z, vb2.w};
#pragma unroll
                    for (int i = 0; i < 8; ++i) { num[2 * i] += dw * bf2f((u16)(vv[i] & 0xFFFF)); num[2 * i + 1] += dw * bf2f((u16)(vv[i] >> 16)); }
                }
                for (int dk = 0; dk < 64; ++dk) {
                    const float qv = bf2f(ql[t * 64 + dk]) * inter;
#pragma unroll
                    for (int i = 0; i < 16; i += 4) {
                        const float4 cv = *(const float4*)(Cl + dk * 64 + q4 * 16 + i);
                        num[i] += qv * cv.x; num[i + 1] += qv * cv.y; num[i + 2] += qv * cv.z; num[i + 3] += qv * cv.w;
                    }
                }
                const float dn = 1.f / fmaxf(fabsf(den), expf(-mt));
#pragma unroll
                for (int i = 0; i < 16; ++i) hs[i] += num[i] * dn;
            }
            float s1 = 0.f;
#pragma unroll
            for (int i = 0; i < 16; ++i) s1 += hs[i];
            s1 += __shfl_xor(s1, 1); s1 += __shfl_xor(s1, 2);
            const float mu = s1 * (1.f / 64.f);
            float s2 = 0.f;
#pragma unroll
            for (int i = 0; i < 16; ++i) { const float dlt = hs[i] - mu; s2 += dlt * dlt; }
            s2 += __shfl_xor(s2, 1); s2 += __shfl_xor(s2, 2);
            const float rstd = rsqrtf(s2 * (1.f / 64.f) + 1e-6f);
            const int row = row0 + t;
#pragma unroll
            for (int i = 0; i < 16; i += 2) {
                const int cc = h * 64 + q4 * 16 + i;
                const float o0 = bf2f(pc[(size_t)row * 1040 + 768 + cc]), o1 = bf2f(pc[(size_t)row * 1040 + 768 + cc + 1]);
                const float y0 = (hs[i] - mu) * rstd * p.ml_nw[l * 256 + cc] * sigmoidf_(o0);
                const float y1 = (hs[i + 1] - mu) * rstd * p.ml_nw[l * 256 + cc + 1] * sigmoidf_(o1);
                *(unsigned*)(y + (size_t)row * 1024 + 768 + cc) = (unsigned)f2bf(y0) | ((unsigned)f2bf(y1) << 16);
            }
        }
    }
}

DEVINL void ph_outproj(const P& p, int l, char* smem) {
    const int TIDX_ = tid_(); const int BIDX_ = bid_(); char* const WS_ = wsl_(p.ws); (void)TIDX_; (void)BIDX_; (void)WS_;
    const u16* y = (const u16*)(WS_ + OFF_Y);
    const u16* wout = (const u16*)(WS_ + OFF_WOUT);
    const float* modv = (const float*)(WS_ + OFF_MOD) + (size_t)l * 3 * 6144;
    const float* x2c = (const float*)(WS_ + OFF_X2CTX);
    float* x1 = (float*)(WS_ + OFF_X1);
    const int mt0 = (l == 0) ? 0 : 4;
    const int ntile = (260 - mt0) * 8;
    for (int u = BIDX_; u < ntile; u += gridDim.x) {
        const int mt = mt0 + u / 8, nt = u % 8;
        const u16* A = y + (size_t)mt * 128 * 1024;
        const int R0 = mt * 128;
        const float* xin;
        if (l == 0) xin = R0 < CTXROWS ? p.ctx + (size_t)R0 * 1024 : p.x + (size_t)(R0 - CTXROWS) * 1024;
        else xin = R0 < CTXROWS ? x2c + (size_t)R0 * 1024 : p.out + (size_t)(R0 - CTXROWS) * 1024;
        const float* g1 = modv + row_sel(R0) * 6144 + 2048;
        f32x4 acc[4][4];
        gemm128_acc([&](int r) { return A + (size_t)r * 1024; }, wout + (size_t)nt * 128 * 1024, 1024, 1024, smem, acc);
        stage_tile_f32(acc, smem, [&](int row, int c4, float4 a) {
            const int N = nt * 128 + c4;
            const float4 gg = *(const float4*)(g1 + N);
            const float4 xv = *(const float4*)(xin + (size_t)row * 1024 + N);
            float4 o;
            o.x = ALPHA * xv.x + gg.x * a.x; o.y = ALPHA * xv.y + gg.y * a.y; o.z = ALPHA * xv.z + gg.z * a.z; o.w = ALPHA * xv.w + gg.w * a.w;
            *(float4*)(x1 + (size_t)(R0 + row) * 1024 + N) = o;
        });
    }
}

DEVINL void ph_ln1(const P& p, int l) {
    const int TIDX_ = tid_(); const int BIDX_ = bid_(); char* const WS_ = wsl_(p.ws); (void)TIDX_; (void)BIDX_; (void)WS_;
    const int lane = TIDX_ & 63, wid = TIDX_ >> 6;
    const float* modv = (const float*)(WS_ + OFF_MOD) + (size_t)l * 3 * 6144;
    float* x1 = (float*)(WS_ + OFF_X1);
    u16* hm = (u16*)(WS_ + OFF_HM);
    const int rstart = (l == 0) ? 0 : CTXROWS;
    for (int row = rstart + BIDX_ * 4 + wid; row < T; row += gridDim.x * 4) {
        float4 v[4];
        float s = 0.f;
#pragma unroll
        for (int i = 0; i < 4; ++i) { v[i] = *(const float4*)(x1 + (size_t)row * 1024 + i * 256 + lane * 4); s += v[i].x + v[i].y + v[i].z + v[i].w; }
        const float mu = wsum(s) * (1.f / 1024.f);
        float q = 0.f;
#pragma unroll
        for (int i = 0; i < 4; ++i) { v[i].x -= mu; v[i].y -= mu; v[i].z -= mu; v[i].w -= mu; q += v[i].x * v[i].x + v[i].y * v[i].y + v[i].z * v[i].z + v[i].w * v[i].w; }
        const float rstd = rsqrtf(wsum(q) * (1.f / 1024.f) + 1e-5f);
        const float* mv = modv + row_sel(row) * 6144;
#pragma unroll
        for (int i = 0; i < 4; ++i) {
            const int c = i * 256 + lane * 4;
            const float4 g = *(const float4*)(p.ln1g + l * 1024 + c), bb = *(const float4*)(p.ln1b + l * 1024 + c);
            const float4 sh = *(const float4*)(mv + 3072 + c), sc = *(const float4*)(mv + 4096 + c);
            float4 o;
            o.x = v[i].x * rstd * g.x + bb.x; o.y = v[i].y * rstd * g.y + bb.y; o.z = v[i].z * rstd * g.z + bb.z; o.w = v[i].w * rstd * g.w + bb.w;
            *(float4*)(x1 + (size_t)row * 1024 + c) = o;
            uint2 hh;
            hh.x = (unsigned)f2bf(o.x * (1.f + sc.x) + sh.x) | ((unsigned)f2bf(o.y * (1.f + sc.y) + sh.y) << 16);
            hh.y = (unsigned)f2bf(o.z * (1.f + sc.z) + sh.z) | ((unsigned)f2bf(o.w * (1.f + sc.w) + sh.w) << 16);
            *(uint2*)(hm + (size_t)row * 1024 + c) = hh;
        }
    }
}

DEVINL void ph_router(const P& p, int l, char* smem) {
    const int TIDX_ = tid_(); const int BIDX_ = bid_(); char* const WS_ = wsl_(p.ws); (void)TIDX_; (void)BIDX_; (void)WS_;
    const u16* hm = (const u16*)(WS_ + OFF_HM);
    const u16* wr = (const u16*)(WS_ + OFF_WR) + (size_t)l * 128 * 1024;
    float* lg = (float*)(WS_ + OFF_LOGITS);
    const int mt0 = (l == 0) ? 0 : 4;
    for (int u = BIDX_; u < 260 - mt0; u += gridDim.x) {
        const int mt = mt0 + u;
        const u16* A = hm + (size_t)mt * 128 * 1024;
        gemm128([&](int r) { return A + (size_t)r * 1024; }, wr, 1024, 1024, smem,
                [&](int m, int n, f32x4 a) {
                    if (n < 36) {
#pragma unroll
                        for (int j = 0; j < 4; ++j) lg[(size_t)(mt * 128 + m + j) * 64 + n] = a[j];
                    }
                });
    }
}

DEVINL void ph_route1(const P& p, int l, char* smem) {
    const int TIDX_ = tid_(); const int BIDX_ = bid_(); char* const WS_ = wsl_(p.ws); (void)TIDX_; (void)BIDX_; (void)WS_;
    const int tid = TIDX_;
    const float* lg = (const float*)(WS_ + OFF_LOGITS);
    int* toke = (int*)(WS_ + OFF_TOKE); float* tokw = (float*)(WS_ + OFF_TOKW);
    int* cnt = (int*)(WS_ + CTL_CNT) + l * 32;
    int* hist = (int*)smem;
    __syncthreads();
    if (tid < 32) hist[tid] = 0;
    __syncthreads();
    const int rstart = (l == 0) ? 0 : CTXROWS;
    for (int row = rstart + BIDX_ * 256 + tid; row < T; row += gridDim.x * 256) {
        const float* q = lg + (size_t)row * 64;
        float gl[4]; int gs = 0; float gm = -3.0e38f;
#pragma unroll
        for (int i = 0; i < 4; ++i) { gl[i] = q[i] + p.rgb[l * 4 + i]; if (gl[i] > gm) { gm = gl[i]; gs = i; } }
        float se = 0.f;
#pragma unroll
        for (int i = 0; i < 4; ++i) se += expf(gl[i] - gm);
        const float gw = 1.f / se;
        float v1 = -3.0e38f, v2 = -3.0e38f; int i1 = 0, i2 = 0;
#pragma unroll
        for (int i = 0; i < 8; ++i) {
            const float e = q[4 + gs * 8 + i] + p.reb[l * 32 + gs * 8 + i];
            if (e > v1) { v2 = v1; i2 = i1; v1 = e; i1 = i; }
            else if (e > v2) { v2 = e; i2 = i; }
        }
        const float e2 = expf(v2 - v1);
        const float w1 = gw / (1.f + e2), w2 = gw * e2 / (1.f + e2);
        const int ea = gs * 8 + i1, eb = gs * 8 + i2;
        toke[row * 2] = ea; toke[row * 2 + 1] = eb; tokw[row * 2] = w1; tokw[row * 2 + 1] = w2;
        atomicAdd(&hist[ea], 1); atomicAdd(&hist[eb], 1);
    }
    __syncthreads();
    if (tid < 32 && hist[tid] > 0) atomicAdd(&cnt[tid], hist[tid]);
}

DEVINL void ph_route2(const P& p, int l, char* smem) {
    const int TIDX_ = tid_(); const int BIDX_ = bid_(); char* const WS_ = wsl_(p.ws); (void)TIDX_; (void)BIDX_; (void)WS_;
    const int tid = TIDX_;
    const int* toke = (const int*)(WS_ + OFF_TOKE);
    int* toks = (int*)(WS_ + OFF_TOKS);
    int* slottok = (int*)(WS_ + OFF_SLOTTOK);
    const int* cnt = (const int*)(WS_ + CTL_CNT) + l * 32;
    int* cur = (int*)(WS_ + CTL_CUR) + l * 32;
    int* tiles = (int*)(WS_ + OFF_TILES);
    int* off = (int*)smem;
    int* hist = off + 64;
    int* base = hist + 32;
    __syncthreads();
    if (tid == 0) { int a = 0; for (int e = 0; e < 32; ++e) { off[e] = a; a += (cnt[e] + 127) & ~127; } off[32] = a; }
    if (tid < 32) hist[tid] = 0;
    __syncthreads();
    if (BIDX_ == 0) {
        if (tid == 0) {
            int nt = 0;
#pragma clang loop vectorize(disable) unroll(disable)
            for (int e = 0; e < 32; ++e) {
#pragma clang loop vectorize(disable) unroll(disable)
                for (int s = off[e]; s < off[e + 1]; s += 128) { tiles[64 + nt * 2] = e; tiles[64 + nt * 2 + 1] = s; ++nt; }
            }
            tiles[40] = nt;
        }
#pragma clang loop vectorize(disable) unroll(disable)
        for (int e = 0; e < 32; ++e) {
#pragma clang loop vectorize(disable) unroll(disable)
            for (int s = off[e] + cnt[e] + tid; s < off[e + 1]; s += 256) slottok[s] = (l == 0) ? 0 : CTXROWS;
        }
    }
    const int rstart = (l == 0) ? 0 : CTXROWS;
    for (int a0 = rstart * 2 + BIDX_ * 256; a0 < T * 2; a0 += gridDim.x * 256) {
        const int a = a0 + tid;
        int e = -1, lpos = 0;
        if (a < T * 2) { e = toke[a]; lpos = atomicAdd(&hist[e], 1); }
        __syncthreads();
        if (tid < 32) { base[tid] = hist[tid] > 0 ? atomicAdd(&cur[tid], hist[tid]) : 0; }
        __syncthreads();
        if (e >= 0) { const int s = off[e] + base[e] + lpos; toks[a] = s; slottok[s] = a >> 1; }
        __syncthreads();
        if (tid < 32) hist[tid] = 0;
        __syncthreads();
    }
}

DEVINL void ph_gateup(const P& p, char* smem) {
    const int TIDX_ = tid_(); const int BIDX_ = bid_(); char* const WS_ = wsl_(p.ws); (void)TIDX_; (void)BIDX_; (void)WS_;
    const int tid = TIDX_, lane = tid & 63, wid = tid >> 6, wr = wid >> 1, wc = wid & 1, fr = lane & 15, fq = lane >> 4;
    const u16* hm = (const u16*)(WS_ + OFF_HM);
    const u16* wgu = (const u16*)(WS_ + OFF_WGU);
    const int* tiles = (const int*)(WS_ + OFF_TILES);
    const int* slottok = (const int*)(WS_ + OFF_SLOTTOK);
    u16* act = (u16*)(WS_ + OFF_ACT);
    const int ntile = tiles[40] * 8;
    for (int u = BIDX_; u < ntile; u += gridDim.x) {
        const int ti = u >> 3, nt = u & 7;
        const int e = tiles[64 + ti * 2], s0 = tiles[64 + ti * 2 + 1];
        f32x4 acc[4][4];
        gemm128_acc([&](int r) { return hm + (size_t)slottok[s0 + r] * 1024; }, wgu + ((size_t)e * 1024 + nt * 128) * 1024, 1024, 1024, smem, acc);
        {
            u16* t = (u16*)smem;
            __syncthreads();
#pragma unroll
            for (int m = 0; m < 4; ++m)
#pragma unroll
                for (int n = 0; n < 4; n += 2) {
                    const int jc = (wc * 64 + n * 16) / 2 + fr;
                    const int r0 = wr * 64 + m * 16 + fq * 4;
                    float av[4];
#pragma unroll
                    for (int j = 0; j < 4; ++j) { const float gte = acc[m][n][j], up = acc[m][n + 1][j]; av[j] = gte / (1.f + __expf(-gte)) * up; }
                    const unsigned p01 = pk2bf(av[0], av[1]), p23 = pk2bf(av[2], av[3]);
                    t[(r0 + 0) * 72 + jc] = (u16)(p01 & 0xFFFFu); t[(r0 + 1) * 72 + jc] = (u16)(p01 >> 16);
                    t[(r0 + 2) * 72 + jc] = (u16)(p23 & 0xFFFFu); t[(r0 + 3) * 72 + jc] = (u16)(p23 >> 16);
                }
            __syncthreads();
#pragma unroll
            for (int i = 0; i < 4; ++i) {
                const int ci = tid + 256 * i, row = ci >> 3, c8 = (ci & 7) * 8;
                *(uint4*)(act + (size_t)(s0 + row) * 512 + nt * 64 + c8) = *(const uint4*)(t + row * 72 + c8);
            }
        }
    }
}

DEVINL void ph_down(const P& p, char* smem) {
    const int TIDX_ = tid_(); const int BIDX_ = bid_(); char* const WS_ = wsl_(p.ws); (void)TIDX_; (void)BIDX_; (void)WS_;
    const u16* act = (const u16*)(WS_ + OFF_ACT);
    const u16* wdn = (const u16*)(WS_ + OFF_WDN);
    const int* tiles = (const int*)(WS_ + OFF_TILES);
    u16* so = (u16*)(WS_ + OFF_SLOTOUT);
    const int ntile = tiles[40] * 8;
    for (int u = BIDX_; u < ntile; u += gridDim.x) {
        const int ti = u >> 3, nt = u & 7;
        const int e = tiles[64 + ti * 2], s0 = tiles[64 + ti * 2 + 1];
        const u16* A = act + (size_t)s0 * 512;
        f32x4 acc[4][4];
        gemm128_acc([&](int r) { return A + (size_t)r * 512; }, wdn + ((size_t)e * 1024 + nt * 128) * 512, 512, 512, smem, acc);
        stage_tile_bf16(acc, smem, [&](int row, int c8, uint4 v) { *(uint4*)(so + (size_t)(s0 + row) * 1024 + nt * 128 + c8) = v; });
    }
}

DEVINL void ph_ln2(const P& p, int l) {
    const int TIDX_ = tid_(); const int BIDX_ = bid_(); char* const WS_ = wsl_(p.ws); (void)TIDX_; (void)BIDX_; (void)WS_;
    const int lane = TIDX_ & 63, wid = TIDX_ >> 6;
    const float* modv = (const float*)(WS_ + OFF_MOD) + (size_t)l * 3 * 6144;
    const float* modn = (const float*)(WS_ + OFF_MOD) + (size_t)(l + 1) * 3 * 6144;
    const float* x1 = (const float*)(WS_ + OFF_X1);
    const u16* so = (const u16*)(WS_ + OFF_SLOTOUT);
    const int* toks = (const int*)(WS_ + OFF_TOKS);
    const float* tokw = (const float*)(WS_ + OFF_TOKW);
    float* x2c = (float*)(WS_ + OFF_X2CTX);
    u16* hm = (u16*)(WS_ + OFF_HM);
    const int rstart = (l == 0) ? 0 : CTXROWS;
    for (int row = rstart + BIDX_ * 4 + wid; row < T; row += gridDim.x * 4) {
        const int sa = toks[row * 2], sb = toks[row * 2 + 1];
        const float wa = tokw[row * 2], wb = tokw[row * 2 + 1];
        const float* mv = modv + row_sel(row) * 6144;
        float4 v[4];
        float s = 0.f;
#pragma unroll
        for (int i = 0; i < 4; ++i) {
            const int c = i * 256 + lane * 4;
            const float4 xv = *(const float4*)(x1 + (size_t)row * 1024 + c);
            const uint2 ua = *(const uint2*)(so + (size_t)sa * 1024 + c), ub = *(const uint2*)(so + (size_t)sb * 1024 + c);
            const float4 g2 = *(const float4*)(mv + 5120 + c);
            const float f0 = wa * bf2f((u16)(ua.x & 0xFFFF)) + wb * bf2f((u16)(ub.x & 0xFFFF));
            const float f1 = wa * bf2f((u16)(ua.x >> 16)) + wb * bf2f((u16)(ub.x >> 16));
            const float f2 = wa * bf2f((u16)(ua.y & 0xFFFF)) + wb * bf2f((u16)(ub.y & 0xFFFF));
            const float f3 = wa * bf2f((u16)(ua.y >> 16)) + wb * bf2f((u16)(ub.y >> 16));
            v[i].x = ALPHA * xv.x + g2.x * f0; v[i].y = ALPHA * xv.y + g2.y * f1; v[i].z = ALPHA * xv.z + g2.z * f2; v[i].w = ALPHA * xv.w + g2.w * f3;
            s += v[i].x + v[i].y + v[i].z + v[i].w;
        }
        const float mu = wsum(s) * (1.f / 1024.f);
        float q = 0.f;
#pragma unroll
        for (int i = 0; i < 4; ++i) { v[i].x -= mu; v[i].y -= mu; v[i].z -= mu; v[i].w -= mu; q += v[i].x * v[i].x + v[i].y * v[i].y + v[i].z * v[i].z + v[i].w * v[i].w; }
        const float rstd = rsqrtf(wsum(q) * (1.f / 1024.f) + 1e-5f);
        float* dst = row < CTXROWS ? x2c + (size_t)row * 1024 : p.out + (size_t)(row - CTXROWS) * 1024;
        const float* mn = modn + row_sel(row) * 6144;
#pragma unroll
        for (int i = 0; i < 4; ++i) {
            const int c = i * 256 + lane * 4;
            const float4 g = *(const float4*)(p.ln2g + l * 1024 + c), bb = *(const float4*)(p.ln2b + l * 1024 + c);
            float4 o;
            o.x = v[i].x * rstd * g.x + bb.x; o.y = v[i].y * rstd * g.y + bb.y; o.z = v[i].z * rstd * g.z + bb.z; o.w = v[i].w * rstd * g.w + bb.w;
            *(float4*)(dst + c) = o;
            if (l == 0) {
                const float4 sh = *(const float4*)(mn + c), sc = *(const float4*)(mn + 1024 + c);
                uint2 hh;
                hh.x = (unsigned)f2bf(o.x * (1.f + sc.x) + sh.x) | ((unsigned)f2bf(o.y * (1.f + sc.y) + sh.y) << 16);
                hh.y = (unsigned)f2bf(o.z * (1.f + sc.z) + sh.z) | ((unsigned)f2bf(o.w * (1.f + sc.w) + sh.w) << 16);
                *(uint2*)(hm + (size_t)row * 1024 + c) = hh;
            }
        }
    }
}

DEVINL void gbar(XcdBarrier b) {
    unsigned x = b.x; GAS unsigned* q = (GAS unsigned*)b.bar;
    asm volatile("" : "+s"(x), "+s"(q));
    b.x = x; b.bar = (unsigned*)q;
    xcd_barrier(b);
}
#ifndef PROBE
#define PROBE 0
#endif
#ifndef TPROBE
#define TPROBE 0
#endif
__global__ void __launch_bounds__(256, 2) k_mega(P p) {
    __shared__ __attribute__((aligned(16))) char smem[SMEM_BYTES];
    if (threadIdx.x == 0) *(uint4*)(smem + SMEM_BYTES - 16) = make_uint4(0u, 0u, 0u, 0u);
    __syncthreads();
    XcdBarrier bar = xcd_barrier_post((unsigned*)p.ws, (volatile LAS unsigned*)(smem + SMEM_BYTES - 16));
    const int bid = blockIdx.x, nb = gridDim.x;
#if TPROBE
    unsigned long long tp_acc = 0, tp_last = wall_clock64();
#define TP(g) do { const unsigned long long _n = wall_clock64(); if ((g) == TPROBE) tp_acc += _n - tp_last; tp_last = _n; } while (0)
#else
#define TP(g) do { } while (0)
#endif
    if (threadIdx.x == 0) {
        const unsigned key = ((unsigned)__builtin_amdgcn_s_getreg((3 << 11) | 20) << 8) | ((unsigned)__builtin_amdgcn_s_getreg((7 << 11) | (8 << 6) | 4) & 0xFFu);
        ((unsigned*)(p.ws + CTL_CUKEY))[blockIdx.x] = key | 0x80000000u;
    }
    ph_prolog(p, smem);
    ph_convw(p, 0, smem);
    gbar(bar);
    TP(1);
    ph_xm0(p);
    gbar(bar);
    TP(1);
    bool quiet; int wrank, nwork, mate_of = -1;
    {
        const unsigned* keys = (const unsigned*)(p.ws + CTL_CUKEY);
        int* cnt = (int*)smem;
        if (threadIdx.x < 2) cnt[threadIdx.x] = 0;
        __syncthreads();
        for (int i = 8 + threadIdx.x; i < nb; i += 256) {
            const unsigned k = keys[i];
            bool qq = false;
            for (int j = 0; j < 8 && j < nb; ++j) qq = qq || (keys[j] == k);
            if (qq) { atomicAdd(&cnt[1], 1); if (i < bid) atomicAdd(&cnt[0], 1); }
        }
        __syncthreads();
        const int below = cnt[0], total = cnt[1];
        bool me = false;
        if (bid >= 8) { const unsigned k = keys[bid]; for (int j = 7; j >= 0; --j) if (j < nb && keys[j] == k) { me = true; mate_of = j; } }
        __syncthreads();
        if (total > 16) { quiet = false; wrank = bid - 8; nwork = nb - 8; mate_of = -1; }
        else { quiet = me; wrank = bid - 8 - below; nwork = nb - 8 - total; }
    }
#pragma unroll 1
    for (int l = 0; l < NLAYER; ++l) {
        ph_inproj(p, smem);
        gbar(bar);
    TP(2);
        ph_rwprep(p, l, 0, smem, bid, nb);
        gbar(bar);
    TP(3);
        if (bid < 8) ph_rwscan(p, l, 0, bid, 8, smem);
        else if (!quiet) { ph_prepM(p, l, smem, wrank, nwork); ph_na(p, l, smem, wrank, nwork); }
        gbar(bar);
    TP(4);
        ph_mlB(p, bid, nb, smem);
        gbar(bar);
        ph_rwprep(p, l, 1, smem, bid, nb);
        gbar(bar);
    TP(5);
        if (bid < 8) ph_rwscan(p, l, 1, bid, 8, smem);
        else if (!quiet) { ph_mlC(p, l, smem, wrank, nwork); ph_convexp(p, l, smem, wrank, nwork); }
        gbar(bar);
    TP(6);
        ph_rwout(p, l);
        gbar(bar);
    TP(7);
        ph_outproj(p, l, smem);
        gbar(bar);
    TP(8);
        ph_ln1(p, l);
        gbar(bar);
    TP(9);
        ph_router(p, l, smem);
        gbar(bar);
    TP(9);
        ph_route1(p, l, smem);
        gbar(bar);
    TP(9);
        ph_route2(p, l, smem);
        gbar(bar);
    TP(9);
        ph_gateup(p, smem);
        gbar(bar);
    TP(10);
        ph_down(p, smem);
        gbar(bar);
    TP(11);
        ph_ln2(p, l);
        if (l + 1 < NLAYER) ph_convw(p, l + 1, smem);
        gbar(bar);
    TP(12);
    }
#if TPROBE
    if (bid == 0 && threadIdx.x == 0) { const unsigned long long t_end = wall_clock64() + tp_acc; while (wall_clock64() < t_end) __builtin_amdgcn_s_sleep(8); }
    __syncthreads();
    gbar(bar);
#endif
}


extern "C" void kernel_launch(void* const* d_in, const int* in_sizes, int n_in, void* d_out, int out_size, void* d_ws, size_t ws_size,
                              hipStream_t stream) {
    if (n_in != 37 || ws_size < WS_NEED) { fprintf(stderr, "kernel_launch: n_in %d ws %zu need %zu\n", n_in, ws_size, (size_t)WS_NEED); return; }
    static int grid = 0;
    if (!grid) {
        int dev = 0, cus = 0, per_cu = 0;
        (void)hipGetDevice(&dev);
        (void)hipDeviceGetAttribute(&cus, hipDeviceAttributeMultiprocessorCount, dev);
        (void)hipOccupancyMaxActiveBlocksPerMultiprocessor(&per_cu, (const void*)k_mega, 256, 0);
        if (per_cu < 1) per_cu = 1;
        grid = cus * (per_cu < 2 ? per_cu : 2);
    }
    P p{};
    const float** pp = (const float**)&p;
    for (int i = 0; i < 37; ++i) pp[i] = (const float*)d_in[i];
    p.out = (float*)d_out; p.ws = (char*)d_ws;
    (void)hipMemsetAsync(d_ws, 0, CTL_BYTES, stream);
    k_mega<<<dim3(grid), dim3(256), 0, stream>>>(p);
}
```

```cpp
#include <hip/hip_runtime.h>
#include <hip/hip_bf16.h>
#include <stdint.h>
#include <stdio.h>
#include <type_traits>

#define DEVINL __device__ __forceinline__
typedef unsigned short u16;
using bf16x8 = __attribute__((ext_vector_type(8))) short;
using f32x4 = __attribute__((ext_vector_type(4))) float;

constexpr int D = 1024, LAT = 16384, LCTX = 256, T = 33280, CTXROWS = 512;
constexpr int INP = 3536;
constexpr int NLAYER = 2;
constexpr float ALPHA = 1.41421356237309515f;
constexpr int NUNIT_CH = 520;
constexpr int NTC = 260;
constexpr int MAXSLOT = 70656;
constexpr int SMEM_BYTES = 81920;

constexpr size_t al(size_t x) { return (x + 255) & ~(size_t)255; }
constexpr size_t CTL_CNT = 16384;
constexpr size_t CTL_CUR = CTL_CNT + 256;
constexpr size_t CTL_CUKEY = 20480;
constexpr size_t CTL_PROG = 24576;
constexpr size_t CTL_BYTES = 32768;
constexpr size_t OFF_MOD = CTL_BYTES;
constexpr size_t OFF_ROPE = OFF_MOD + al(2 * 3 * 6144 * 4);
constexpr size_t OFF_WR = OFF_ROPE + al(10240 * 4);
constexpr size_t OFF_LORA = OFF_WR + al(2 * 128 * 1024 * 2);
constexpr size_t OFF_TILES = OFF_LORA + al(3 * 65536);
constexpr size_t OFF_TOKE = OFF_TILES + al((64 + 2048) * 4);
constexpr size_t OFF_TOKW = OFF_TOKE + al((size_t)T * 2 * 4);
constexpr size_t OFF_TOKS = OFF_TOKW + al((size_t)T * 2 * 4);
constexpr size_t OFF_SLOTTOK = OFF_TOKS + al((size_t)T * 2 * 4);
constexpr size_t OFF_X2CTX = OFF_SLOTTOK + al((size_t)MAXSLOT * 4);
constexpr size_t OFF_ZST = OFF_X2CTX + al((size_t)512 * 1024 * 4);
constexpr size_t OFF_WIN = OFF_ZST + al((size_t)16 * 4 * 64 * 16 * 4);
constexpr size_t OFF_WOUT = OFF_WIN + al((size_t)3584 * 1024 * 2);
constexpr size_t OFF_X1 = OFF_WOUT + al((size_t)1024 * 1024 * 2);
constexpr size_t OFF_HM = OFF_X1 + al((size_t)T * 1024 * 4);
constexpr size_t OFF_P = OFF_HM + al((size_t)T * 1024 * 2);
constexpr size_t OFF_PQK = OFF_P;
constexpr size_t OFF_VTL = OFF_PQK + (size_t)T * 1024 * 2;
constexpr size_t OFF_VTC = OFF_VTL + (size_t)2 * 8 * 64 * 16384 * 2;
constexpr size_t OFF_PB = OFF_VTC + (size_t)2 * 8 * 64 * 256 * 2;
constexpr size_t OFF_PC = OFF_PB + (size_t)T * 960 * 2;
constexpr size_t OFF_Y = OFF_PC + (size_t)T * 1040 * 2;
constexpr size_t OFF_MLF = OFF_Y + (size_t)T * 1024 * 2;
constexpr size_t OFF_GATE = OFF_MLF + (size_t)T * 512 * 2;
constexpr size_t OFF_MLG = OFF_GATE + (size_t)T * 256 * 2;
constexpr size_t OFF_MLS = OFF_MLG + (size_t)T * 16 * 4;
constexpr size_t OFF_MST = OFF_MLS + al(16 * 260 * 2 * 4);
constexpr size_t OFF_NST = OFF_MST + al(16 * 260 * 4);
constexpr size_t OFF_CST2 = OFF_NST + al(16 * 260 * 64 * 4);
constexpr size_t OFF_NST2 = OFF_CST2 + (size_t)16 * 260 * 4096 * 2;
constexpr size_t OFF_END1 = OFF_NST2 + al(16 * 260 * 64 * 4);
constexpr size_t OFF_WGU = OFF_P;
constexpr size_t OFF_WDN = OFF_WGU + (size_t)32 * 1024 * 1024 * 2;
constexpr size_t OFF_ACT = OFF_WDN + (size_t)32 * 1024 * 512 * 2;
constexpr size_t OFF_SLOTOUT = OFF_ACT + (size_t)MAXSLOT * 512 * 2;
constexpr size_t OFF_LOGITS = OFF_SLOTOUT + (size_t)MAXSLOT * 1024 * 2;
constexpr size_t OFF_END2 = OFF_LOGITS + (size_t)T * 64 * 4;
constexpr size_t WS_NEED = OFF_END1 > OFF_END2 ? OFF_END1 : OFF_END2;
static_assert(OFF_WDN <= OFF_Y, "Wexp must not overlap y");
static_assert(OFF_LOGITS >= OFF_MLF, "logits placement");

struct P {
    const float *x, *c, *ctx, *c_ctx, *w_mod, *b_mod, *w_in, *na_rpb, *mu_prev, *mu_next, *rw_w0, *rw_w2, *rw_a0, *rw_a2,
        *rw_g2, *rw_kk, *rw_ka, *rw_rk, *rw_lnw, *rw_lnb, *ml_cw, *ml_cb, *ml_ib, *ml_fb, *ml_nw, *w_out, *ln1g, *ln1b,
        *rgw, *rgb, *rew, *reb, *egate, *eup, *edown, *ln2g, *ln2b;
    float* out;
    char* ws;
};

#define XB_TMO      128
#define XB_XCNT(j)  (256  + 64 * (j))
#define XB_XSUB(j)  (1280 + 64 * (j))
#define XB_XGEN(j)  (2304 + 64 * (j))
#define XB_TOP      3328
#define XB_TOPGEN   3392
#define XCD_BAR_WORDS 3456
#define XB_SPIN_CAP (1u << 18)
#define LAS __attribute__((address_space(3)))

__device__ __forceinline__ unsigned xb_ld(unsigned* p)              { return __hip_atomic_load(p, __ATOMIC_RELAXED, __HIP_MEMORY_SCOPE_AGENT); }
__device__ __forceinline__ unsigned xb_add(unsigned* p, unsigned v) { return __hip_atomic_fetch_add(p, v, __ATOMIC_RELAXED, __HIP_MEMORY_SCOPE_AGENT); }
__device__ __forceinline__ unsigned xb_xcc_id() { return (unsigned)__builtin_amdgcn_s_getreg((3 << 11) | 20) & 0xFu; }
#define XB_SPIN(cond, bar) do { unsigned _sp = 0; while (cond) { __builtin_amdgcn_s_sleep(1); \
    if ((++_sp & 255u) == 0u) { if (xb_ld(&(bar)[XB_TMO])) break; if (_sp > XB_SPIN_CAP) { atomicAdd(&(bar)[XB_TMO], 1u); break; } } } } while (0)

struct XcdBarrier {
    unsigned* bar; unsigned x;
    volatile LAS unsigned* st;
};

__device__ __forceinline__ XcdBarrier xcd_barrier_post(unsigned* bar, volatile LAS unsigned* st) {
    XcdBarrier b; b.bar = bar; b.x = xb_xcc_id(); b.st = st;
    if (threadIdx.x == 0) (void)xb_add(&bar[XB_XCNT(b.x)], 1u);
    return b;
}
__device__ __forceinline__ void xcd_barrier_complete(unsigned* bar, unsigned x, unsigned& nloc, unsigned& nx) {
    const unsigned G = gridDim.x * gridDim.y * gridDim.z;
    unsigned sum, cnt, mine, sp = 0u;
    for (;;) {
        sum = 0u; cnt = 0u; mine = 0u;
#pragma unroll
        for (unsigned j = 0; j < 16; ++j) { const unsigned c = xb_ld(&bar[XB_XCNT(j)]); sum += c; cnt += (c > 0u) ? 1u : 0u; mine = (j == x) ? c : mine; }
        if (sum == G) break;
        __builtin_amdgcn_s_sleep(1);
        if ((++sp & 255u) == 0u) { if (xb_ld(&bar[XB_TMO])) break; if (sp > XB_SPIN_CAP) { atomicAdd(&bar[XB_TMO], 1u); break; } }
    }
    nloc = mine > 0u ? mine : 1u; nx = cnt > 0u ? cnt : 1u;
}

__device__ __forceinline__ void xcd_barrier(const XcdBarrier& b) {
    asm volatile("s_waitcnt vmcnt(0)" ::: "memory");
    __syncthreads();
    if (threadIdx.x == 0) {
        unsigned* bar = b.bar;
        __builtin_amdgcn_s_waitcnt(0);
        unsigned nloc = b.st[0], nx = b.st[1];
        if (nloc == 0u) { xcd_barrier_complete(bar, b.x, nloc, nx); b.st[0] = nloc; b.st[1] = nx; }
        const unsigned old = xb_add(&bar[XB_XSUB(b.x)], 1u);
        const unsigned gen = old / nloc;
        if (old + 1u == (gen + 1u) * nloc) {
            __builtin_amdgcn_fence(__ATOMIC_RELEASE, "agent");
            asm volatile("s_waitcnt vmcnt(0)" ::: "memory");
            const unsigned og = xb_add(&bar[XB_TOP], 1u);
            const unsigned tg = og / nx;
            if (og + 1u == (tg + 1u) * nx) xb_add(&bar[XB_TOPGEN], 1u);
            else XB_SPIN(xb_ld(&bar[XB_TOPGEN]) == tg, bar);
            __builtin_amdgcn_fence(__ATOMIC_ACQUIRE, "agent");
            xb_add(&bar[XB_XGEN(b.x)], 1u);
            asm volatile("s_waitcnt vmcnt(0)" ::: "memory");
        } else {
            XB_SPIN(xb_ld(&bar[XB_XGEN(b.x)]) == gen, bar);
            __builtin_amdgcn_fence(__ATOMIC_ACQUIRE, "agent");
            asm volatile("s_waitcnt vmcnt(0)" ::: "memory");
        }
    }
    __syncthreads();
}


DEVINL int tid_() { int t = threadIdx.x; asm volatile("" : "+v"(t)); return t; }
DEVINL int bid_() { int b = blockIdx.x; asm volatile("" : "+s"(b)); return b; }
#define GAS __attribute__((address_space(1)))
DEVINL char* wsl_(char* w) { GAS char* g = (GAS char*)w; asm volatile("" : "+s"(g)); return (char*)g; }
template <class Tp> DEVINL const Tp* gl_(const Tp* q) { const GAS Tp* g = (const GAS Tp*)q; asm volatile("" : "+s"(g)); return (const Tp*)g; }
typedef float f32x2_t __attribute__((ext_vector_type(2)));
typedef __bf16 bf16x2_t __attribute__((ext_vector_type(2)));
DEVINL unsigned pk2bf(float lo, float hi) { f32x2_t f = {lo, hi}; bf16x2_t b = __builtin_convertvector(f, bf16x2_t); return __builtin_bit_cast(unsigned, b); }
DEVINL u16 f2bf(float f) { return (u16)(pk2bf(f, f) & 0xFFFFu); }
DEVINL float bf2f(u16 h) { return __uint_as_float(((unsigned)h) << 16); }
DEVINL float wsum(float v) { for (int o = 32; o > 0; o >>= 1) v += __shfl_xor(v, o); return v; }
DEVINL float sigmoidf_(float x) { return 1.f / (1.f + __expf(-x)); }
DEVINL float siluf_(float x) { return x / (1.f + __expf(-x)); }
DEVINL float softplusf_(float x) { return fmaxf(x, 0.f) + log1pf(__expf(-fabsf(x))); }
DEVINL int row_sel(int row) { return row < CTXROWS ? 2 : ((row - CTXROWS) >> 14); }
template <int CTRL, int RM>
DEVINL float dpp_f(float v) { return __int_as_float(__builtin_amdgcn_update_dpp(0, __float_as_int(v), CTRL, RM, 0xF, false)); }
DEVINL float wave_sum_dpp(float v) {
    v += dpp_f<0xB1, 0xF>(v);
    v += dpp_f<0x4E, 0xF>(v);
    v += dpp_f<0x141, 0xF>(v);
    v += dpp_f<0x140, 0xF>(v);
    v += dpp_f<0x142, 0xA>(v);
    v += dpp_f<0x143, 0xC>(v);
    return __int_as_float(__builtin_amdgcn_readlane(__float_as_int(v), 63));
}
DEVINL unsigned lds_addr(const void* p) { return (unsigned)(size_t)(const __attribute__((address_space(3))) char*)p; }
using u32x4 = __attribute__((ext_vector_type(4))) unsigned;
using u32x2 = __attribute__((ext_vector_type(2))) unsigned;
template <int OFF> DEVINL u32x4 lds_rd128(unsigned a) { u32x4 v; asm volatile("ds_read_b128 %0, %1 offset:%2" : "=v"(v) : "v"(a), "n"(OFF)); return v; }
template <int OFF> DEVINL u32x2 lds_rd64(unsigned a) { u32x2 v; asm volatile("ds_read_b64 %0, %1 offset:%2" : "=v"(v) : "v"(a), "n"(OFF)); return v; }
DEVINL void glds4(const void* g, void* l) {
    __builtin_amdgcn_global_load_lds((const __attribute__((address_space(1))) void*)g, (__attribute__((address_space(3))) void*)l, 4, 0, 0);
}
DEVINL void glds16nt(const void* g, void* l) {
    __builtin_amdgcn_global_load_lds((const __attribute__((address_space(1))) void*)g, (__attribute__((address_space(3))) void*)l, 16, 0, 2);
}
DEVINL void glds16(const void* g, void* l) {
    __builtin_amdgcn_global_load_lds((const __attribute__((address_space(1))) void*)g, (__attribute__((address_space(3))) void*)l, 16, 0, 0);
}

template <class RowA>
DEVINL void gemm128_acc(RowA rowA, const u16* __restrict__ Bt, int ldb, int K, char* smem, f32x4 (&acc)[4][4]) {
    const int tid = tid_(), lane = tid & 63, wid = tid >> 6, wr = wid >> 1, wc = wid & 1, fr = lane & 15, fq = lane >> 4;
#pragma unroll
    for (int m = 0; m < 4; ++m)
#pragma unroll
        for (int n = 0; n < 4; ++n) acc[m][n] = f32x4{0.f, 0.f, 0.f, 0.f};
    const int sc = ((tid & 7) ^ ((tid >> 3) & 7)) * 8;
    const u16* aS[4]; const u16* bS[4];
#pragma unroll
    for (int i = 0; i < 4; ++i) { const int r = (tid >> 3) + 32 * i; aS[i] = rowA(r) + sc; bS[i] = Bt + (size_t)r * ldb + sc; }
    const int nt = K >> 6;
    __syncthreads();
#pragma unroll
    for (int i = 0; i < 4; ++i) { glds16(aS[i], smem + (tid + 256 * i) * 16); glds16(bS[i], smem + 16384 + (tid + 256 * i) * 16); }
    for (int t = 0; t < nt; ++t) {
        asm volatile("s_waitcnt vmcnt(0)" ::: "memory");
        __builtin_amdgcn_s_barrier();
        if (t + 1 < nt) {
            char* SA = smem + ((t + 1) & 1) * 32768;
            const int ko = (t + 1) * 64;
#pragma unroll
            for (int i = 0; i < 4; ++i) { glds16(aS[i] + ko, SA + (tid + 256 * i) * 16); glds16(bS[i] + ko, SA + 16384 + (tid + 256 * i) * 16); }
        }
        const char* SA = smem + (t & 1) * 32768; const char* SB = SA + 16384;
#pragma unroll
        for (int ks = 0; ks < 2; ++ks) {
            const int pos = ((ks * 4 + fq) ^ (fr & 7)) * 16;
            bf16x8 af[4], bfr[4];
#pragma unroll
            for (int m = 0; m < 4; ++m) af[m] = *(const bf16x8*)(SA + (wr * 64 + m * 16 + fr) * 128 + pos);
#pragma unroll
            for (int n = 0; n < 4; ++n) bfr[n] = *(const bf16x8*)(SB + (wc * 64 + n * 16 + fr) * 128 + pos);
#pragma unroll
            for (int m = 0; m < 4; ++m)
#pragma unroll
                for (int n = 0; n < 4; ++n) acc[m][n] = __builtin_amdgcn_mfma_f32_16x16x32_bf16(af[m], bfr[n], acc[m][n], 0, 0, 0);
        }
    }
}
template <class RowA, class Epi>
DEVINL void gemm128(RowA rowA, const u16* __restrict__ Bt, int ldb, int K, char* smem, Epi epi) {
    const int tid = tid_(), lane = tid & 63, wid = tid >> 6, wr = wid >> 1, wc = wid & 1, fr = lane & 15, fq = lane >> 4;
    f32x4 acc[4][4];
    gemm128_acc(rowA, Bt, ldb, K, smem, acc);
#pragma unroll
    for (int m = 0; m < 4; ++m)
#pragma unroll
        for (int n = 0; n < 4; ++n) epi(wr * 64 + m * 16 + fq * 4, wc * 64 + n * 16 + fr, acc[m][n]);
}

template <class Emit>
DEVINL void stage_tile_bf16(const f32x4 (&acc)[4][4], char* smem, Emit emit) {
    const int tid = tid_(), lane = tid & 63, wid = tid >> 6, wr = wid >> 1, wc = wid & 1, fr = lane & 15, fq = lane >> 4;
    u16* t = (u16*)smem;
    __syncthreads();
#pragma unroll
    for (int m = 0; m < 4; ++m)
#pragma unroll
        for (int n = 0; n < 4; ++n) {
            const int r0 = wr * 64 + m * 16 + fq * 4, c = wc * 64 + n * 16 + fr;
            const unsigned p01 = pk2bf(acc[m][n][0], acc[m][n][1]), p23 = pk2bf(acc[m][n][2], acc[m][n][3]);
            t[(r0 + 0) * 136 + c] = (u16)(p01 & 0xFFFFu); t[(r0 + 1) * 136 + c] = (u16)(p01 >> 16);
            t[(r0 + 2) * 136 + c] = (u16)(p23 & 0xFFFFu); t[(r0 + 3) * 136 + c] = (u16)(p23 >> 16);
        }
    __syncthreads();
#pragma unroll
    for (int i = 0; i < 8; ++i) {
        const int ci = tid + 256 * i, row = ci >> 4, c8 = (ci & 15) * 8;
        emit(row, c8, *(const uint4*)(t + row * 136 + c8));
    }
}

template <class Emit>
DEVINL void stage_tile_f32(const f32x4 (&acc)[4][4], char* smem, Emit emit) {
    const int tid = tid_(), lane = tid & 63, wid = tid >> 6, wr = wid >> 1, wc = wid & 1, fr = lane & 15, fq = lane >> 4;
    float* t = (float*)smem;
    __syncthreads();
#pragma unroll
    for (int m = 0; m < 4; ++m)
#pragma unroll
        for (int n = 0; n < 4; ++n) {
            const int r0 = wr * 64 + m * 16 + fq * 4, c = wc * 64 + n * 16 + fr;
#pragma unroll
            for (int j = 0; j < 4; ++j) t[(r0 + j) * 132 + c] = acc[m][n][j];
        }
    __syncthreads();
#pragma unroll 4
    for (int i = 0; i < 16; ++i) {
        const int ci = tid + 256 * i, row = ci >> 5, c4 = (ci & 31) * 4;
        emit(row, c4, *(const float4*)(t + row * 132 + c4));
    }
}

DEVINL void ph_prolog(const P& p, char* smem) {
    const int TIDX_ = tid_(); const int BIDX_ = bid_(); char* const WS_ = wsl_(p.ws); (void)TIDX_; (void)BIDX_; (void)WS_;
    const int tid = TIDX_;
    float* modv = (float*)(WS_ + OFF_MOD);
    float* sil = (float*)smem;
    float* red = sil + 3072;
    bool ready = false;
    for (int u = BIDX_; u < 192; u += gridDim.x) {
        if (!ready) {
            for (int i = tid; i < 3072; i += 256) { int v = i >> 10, k = i & 1023; float cv = v < 2 ? p.c[v * 1024 + k] : p.c_ctx[k]; sil[i] = cv / (1.f + expf(-cv)); }
            ready = true;
        }
        __syncthreads();
        const int l = u / 96, cg = u % 96;
        const float* W = p.w_mod + (size_t)l * 1024 * 6144 + cg * 64;
        const int c4 = (tid & 15) * 4, rg = tid >> 4;
        float a0[4] = {0, 0, 0, 0}, a1[4] = {0, 0, 0, 0}, a2[4] = {0, 0, 0, 0};
#pragma unroll 4
        for (int i = 0; i < 64; ++i) {
            const int k = rg + 16 * i;
            const float4 w = *(const float4*)(W + (size_t)k * 6144 + c4);
            const float s0 = sil[k], s1 = sil[1024 + k], s2 = sil[2048 + k];
            a0[0] += s0 * w.x; a0[1] += s0 * w.y; a0[2] += s0 * w.z; a0[3] += s0 * w.w;
            a1[0] += s1 * w.x; a1[1] += s1 * w.y; a1[2] += s1 * w.z; a1[3] += s1 * w.w;
            a2[0] += s2 * w.x; a2[1] += s2 * w.y; a2[2] += s2 * w.z; a2[3] += s2 * w.w;
        }
#pragma unroll
        for (int j = 0; j < 4; ++j) { red[(rg * 3 + 0) * 64 + c4 + j] = a0[j]; red[(rg * 3 + 1) * 64 + c4 + j] = a1[j]; red[(rg * 3 + 2) * 64 + c4 + j] = a2[j]; }
        __syncthreads();
        if (tid < 192) {
            const int v = tid >> 6, cc = tid & 63;
            float s = 0.f;
            for (int r = 0; r < 16; ++r) s += red[(r * 3 + v) * 64 + cc];
            const int col = cg * 64 + cc;
            modv[(l * 3 + v) * 6144 + col] = s + p.b_mod[l * 6144 + col];
        }
        __syncthreads();
    }
    float* rope = (float*)(WS_ + OFF_ROPE);
    for (int i = BIDX_ * 256 + tid; i < 320 * 16; i += gridDim.x * 256) {
        const int pos = (i < 4096) ? (i >> 4) : ((i - 4096) >> 4);
        const int f = i & 15;
        const float inv = powf(10000.0f, -(float)f / 16.0f);
        const float ang = (float)pos * inv;
        const double TWO_PI = 6.283185307179586476925;
        double a = (double)ang;
        a -= TWO_PI * rint(a / TWO_PI);
        const float cr = (float)cos(a), sr = (float)sin(a);
        if (i < 4096) { rope[i] = cr; rope[4096 + i] = sr; }
        else { rope[8192 + (i - 4096)] = cr; rope[8192 + 1024 + (i - 4096)] = sr; }
    }
    {
        u16* w2t = (u16*)(WS_ + OFF_LORA); u16* a2t = w2t + 2 * 2 * 256 * 32; u16* g2t = a2t + 2 * 2 * 256 * 32;
        for (int i = BIDX_ * 256 + tid; i < 2 * 2 * 256 * 32; i += gridDim.x * 256) {
            const int lz = i >> 13, c = (i >> 5) & 255, r = i & 31;
            w2t[i] = f2bf(p.rw_w2[((size_t)lz * 32 + r) * 256 + c]);
            a2t[i] = f2bf(p.rw_a2[((size_t)lz * 32 + r) * 256 + c]);
        }
        for (int i = BIDX_ * 256 + tid; i < 2 * 256 * 64; i += gridDim.x * 256) {
            const int l = i >> 14, c = (i >> 6) & 255, r = i & 63;
            g2t[i] = f2bf(p.rw_g2[((size_t)l * 64 + r) * 256 + c]);
        }
    }
    u16* wr = (u16*)(WS_ + OFF_WR);
    for (int i = BIDX_ * 256 + tid; i < 2 * 128 * 1024; i += gridDim.x * 256) {
        const int l = i >> 17, n = (i >> 10) & 127, k = i & 1023;
        float v = 0.f;
        if (n < 4) v = p.rgw[((size_t)l * 1024 + k) * 4 + n];
        else if (n < 36) v = p.rew[((size_t)l * 1024 + k) * 32 + (n - 4)];
        wr[i] = f2bf(v);
    }
}

DEVINL void conv_tile(const float* __restrict__ src, int N, int K, u16* __restrict__ dst, int k0, int n0, int mode, char* smem) {
    unsigned* t = (unsigned*)smem;
    const int tid = tid_();
    const int n4 = (tid & 15) * 4;
    const bool ok = n0 + n4 < N;
    float4 va[2], vb[2];
    __syncthreads();
#pragma unroll
    for (int i = 0; i < 2; ++i) {
        const int kp = i * 16 + (tid >> 4);
        const float* s0 = src + (size_t)(k0 + 2 * kp) * N + n0 + n4;
        va[i] = ok ? *(const float4*)s0 : make_float4(0.f, 0.f, 0.f, 0.f);
        vb[i] = ok ? *(const float4*)(s0 + N) : make_float4(0.f, 0.f, 0.f, 0.f);
    }
#pragma unroll
    for (int i = 0; i < 2; ++i) {
        const int kp = i * 16 + (tid >> 4);
        t[(n4 + 0) * 33 + kp] = pk2bf(va[i].x, vb[i].x);
        t[(n4 + 1) * 33 + kp] = pk2bf(va[i].y, vb[i].y);
        t[(n4 + 2) * 33 + kp] = pk2bf(va[i].z, vb[i].z);
        t[(n4 + 3) * 33 + kp] = pk2bf(va[i].w, vb[i].w);
    }
    __syncthreads();
    {
        const int n = tid >> 2, w0 = (tid & 3) * 8;
        const int ng = n0 + n;
        int nd = ng;
        if (mode == 1) nd = 32 * (ng >> 4) + (ng & 15);
        else if (mode == 2) nd = 32 * (ng >> 4) + 16 + (ng & 15);
        uint4 o0, o1;
        o0.x = t[n * 33 + w0 + 0]; o0.y = t[n * 33 + w0 + 1]; o0.z = t[n * 33 + w0 + 2]; o0.w = t[n * 33 + w0 + 3];
        o1.x = t[n * 33 + w0 + 4]; o1.y = t[n * 33 + w0 + 5]; o1.z = t[n * 33 + w0 + 6]; o1.w = t[n * 33 + w0 + 7];
        u16* q = dst + (size_t)nd * K + k0 + w0 * 2;
        *(uint4*)q = o0; *(uint4*)(q + 8) = o1;
    }
}
DEVINL void ph_convw(const P& p, int l, char* smem) {
    const int TIDX_ = tid_(); const int BIDX_ = bid_(); char* const WS_ = wsl_(p.ws); (void)TIDX_; (void)BIDX_; (void)WS_;
    u16* win = (u16*)(WS_ + OFF_WIN); u16* wout = (u16*)(WS_ + OFF_WOUT);
    for (int u = BIDX_; u < 896 + 256; u += gridDim.x) {
        if (u < 896) conv_tile(p.w_in + (size_t)l * 1024 * INP, INP, 1024, win, (u / 56) * 64, (u % 56) * 64, 0, smem);
        else { const int v = u - 896; conv_tile(p.w_out + (size_t)l * 1024 * 1024, 1024, 1024, wout, (v / 16) * 64, (v % 16) * 64, 0, smem); }
    }
}
DEVINL void ph_convexp(const P& p, int l, char* smem, int bid, int nb) {
    const int TIDX_ = tid_(); const int BIDX_ = bid_(); char* const WS_ = wsl_(p.ws); (void)TIDX_; (void)BIDX_; (void)WS_;
    u16* wgu = (u16*)(WS_ + OFF_WGU); u16* wdn = (u16*)(WS_ + OFF_WDN);
    for (int u = bid; u < 32 * 384; u += nb) {
        const int e = u / 384, v = u % 384;
        const size_t le = (size_t)l * 32 + e;
        if (v < 128) conv_tile(p.egate + le * 1024 * 512, 512, 1024, wgu + (size_t)e * 1024 * 1024, (v / 8) * 64, (v % 8) * 64, 1, smem);
        else if (v < 256) { const int w = v - 128; conv_tile(p.eup + le * 1024 * 512, 512, 1024, wgu + (size_t)e * 1024 * 1024, (w / 8) * 64, (w % 8) * 64, 2, smem); }
        else { const int w = v - 256; conv_tile(p.edown + le * 512 * 1024, 1024, 512, wdn + (size_t)e * 1024 * 512, (w / 16) * 64, (w % 16) * 64, 0, smem); }
    }
}

DEVINL void ph_xm0(const P& p) {
    const int TIDX_ = tid_(); const int BIDX_ = bid_(); char* const WS_ = wsl_(p.ws); (void)TIDX_; (void)BIDX_; (void)WS_;
    const float* modv = (const float*)(WS_ + OFF_MOD);
    u16* hm = (u16*)(WS_ + OFF_HM);
    for (size_t i = (size_t)BIDX_ * 256 + TIDX_; i < (size_t)T * 256; i += (size_t)gridDim.x * 256) {
        const int row = (int)(i >> 8), c4 = (int)(i & 255) * 4;
        const float* src = row < CTXROWS ? p.ctx + (size_t)row * 1024 : p.x + (size_t)(row - CTXROWS) * 1024;
        const float* mv = modv + row_sel(row) * 6144;
        const float4 v = *(const float4*)(src + c4);
        const float4 sh = *(const float4*)(mv + c4), sc = *(const float4*)(mv + 1024 + c4);
        uint2 o;
        o.x = (unsigned)f2bf(v.x * (1.f + sc.x) + sh.x) | ((unsigned)f2bf(v.y * (1.f + sc.y) + sh.y) << 16);
        o.y = (unsigned)f2bf(v.z * (1.f + sc.z) + sh.z) | ((unsigned)f2bf(v.w * (1.f + sc.w) + sh.w) << 16);
        *(uint2*)(hm + (size_t)row * 1024 + c4) = o;
    }
}

DEVINL void ph_inproj(const P& p, char* smem) {
    const int TIDX_ = tid_(); const int BIDX_ = bid_(); char* const WS_ = wsl_(p.ws); (void)TIDX_; (void)BIDX_; (void)WS_;
    const u16* hm = (const u16*)(WS_ + OFF_HM);
    const u16* win = (const u16*)(WS_ + OFF_WIN);
    u16* pqk = (u16*)(WS_ + OFF_PQK); u16* vtl = (u16*)(WS_ + OFF_VTL); u16* vtc = (u16*)(WS_ + OFF_VTC);
    u16* pb = (u16*)(WS_ + OFF_PB); u16* pc = (u16*)(WS_ + OFF_PC);
    for (int u = BIDX_; u < 260 * 28; u += gridDim.x) {
        const int mt = u / 28, nt = u % 28;
        const u16* A = hm + (size_t)mt * 128 * 1024;
        f32x4 acc[4][4];
        gemm128_acc([&](int r) { return A + (size_t)r * 1024; }, win + (size_t)nt * 128 * 1024, 1024, 1024, smem, acc);
        if (nt >= 8 && nt < 12) {
            const int tid = tid_(), lane = tid & 63, wid = tid >> 6, wr = wid >> 1, wc = wid & 1, fr = lane & 15, fq = lane >> 4;
#pragma unroll
            for (int m = 0; m < 4; ++m)
#pragma unroll
                for (int n = 0; n < 4; ++n) {
                    const int R = mt * 128 + wr * 64 + m * 16 + fq * 4, N = nt * 128 + wc * 64 + n * 16 + fr;
                    const int hh = (N - 1024) >> 6, d = (N - 1024) & 63;
                    uint2 v; v.x = pk2bf(acc[m][n][0], acc[m][n][1]); v.y = pk2bf(acc[m][n][2], acc[m][n][3]);
                    if (R < CTXROWS) { const int b = R >> 8, t = R & 255; *(uint2*)(vtc + ((size_t)((b * 8 + hh) * 64 + d)) * 256 + t) = v; }
                    else { const int R2 = R - CTXROWS, b = R2 >> 14, t = R2 & 16383; *(uint2*)(vtl + ((size_t)((b * 8 + hh) * 64 + d)) * 16384 + t) = v; }
                }
        } else {
            stage_tile_bf16(acc, smem, [&](int row, int c8, uint4 v) {
                const int R = mt * 128 + row, N = nt * 128 + c8;
                if (N >= INP) return;
                if (N < 1024) *(uint4*)(pqk + (size_t)R * 1024 + N) = v;
                else if (N < 2496) *(uint4*)(pb + (size_t)R * 960 + (N - 1536)) = v;
                else *(uint4*)(pc + (size_t)R * 1040 + (N - 2496)) = v;
            });
        }
    }
}

constexpr size_t RWREC = 12288;
constexpr size_t RW_A1 = 0, RW_A4 = 2048, RW_A3 = 4096, RW_MKA = 8192, RW_TT = 8704, RW_MY = 9216, RW_V = 10240;
constexpr size_t OFF_RWOP = OFF_X1;
constexpr size_t OFF_RWWG = OFF_RWOP + (size_t)16 * 520 * RWREC;
constexpr size_t OFF_YRWB = OFF_RWWG + (size_t)16 * 130 * 64 * 4;
constexpr size_t OFF_BONUS = OFF_YRWB + (size_t)T * 256 * 2;
static_assert(OFF_BONUS + (size_t)T * 4 * 4 <= OFF_HM, "rw operand store must fit the X1 region");

DEVINL float rw_mix(const u16* __restrict__ pb, const float* __restrict__ mup, const float* __restrict__ mun, int row, int t, int seqlen, int col) {
    const float cu = bf2f(pb[(size_t)row * 960 + col]);
    const float pr = t > 0 ? bf2f(pb[(size_t)(row - 1) * 960 + col]) : 0.f;
    const float nx = t + 1 < seqlen ? bf2f(pb[(size_t)(row + 1) * 960 + col]) : 0.f;
    return cu + mup[col] * (pr - cu) + mun[col] * (nx - cu);
}

DEVINL void rw_mix8(const u16* __restrict__ pb, const float* __restrict__ mup, const float* __restrict__ mun, int row, int t, int seqlen, int col0, float (&o)[8]) {
    const bool hp = t > 0, hn = t + 1 < seqlen;
    const u32x4 c = *(const u32x4*)(pb + (size_t)row * 960 + col0);
    u32x4 pv = *(const u32x4*)(pb + (size_t)(hp ? row - 1 : row) * 960 + col0);
    u32x4 nx = *(const u32x4*)(pb + (size_t)(hn ? row + 1 : row) * 960 + col0);
    const unsigned mpv = hp ? 0xFFFFFFFFu : 0u, mnx = hn ? 0xFFFFFFFFu : 0u;
    const f32x4 mp0 = *(const f32x4*)(mup + col0), mp1 = *(const f32x4*)(mup + col0 + 4), mn0 = *(const f32x4*)(mun + col0), mn1 = *(const f32x4*)(mun + col0 + 4);
#pragma unroll
    for (int i = 0; i < 4; ++i) {
        const unsigned cw = c[i], pw = pv[i] & mpv, nw = nx[i] & mnx;
        const float c0 = __uint_as_float(cw << 16), c1 = __uint_as_float(cw & 0xFFFF0000u);
        const float p0 = __uint_as_float(pw << 16), p1 = __uint_as_float(pw & 0xFFFF0000u);
        const float n0 = __uint_as_float(nw << 16), n1 = __uint_as_float(nw & 0xFFFF0000u);
        const float ma = (i < 2) ? mp0[2 * i] : mp1[2 * i - 4], mb = (i < 2) ? mp0[2 * i + 1] : mp1[2 * i - 3];
        const float na = (i < 2) ? mn0[2 * i] : mn1[2 * i - 4], nb = (i < 2) ? mn0[2 * i + 1] : mn1[2 * i - 3];
        o[2 * i] = c0 + ma * (p0 - c0) + na * (n0 - c0);
        o[2 * i + 1] = c1 + mb * (p1 - c1) + nb * (n1 - c1);
    }
}
DEVINL uint4 pack8bf(const float (&v)[8]) { return make_uint4(pk2bf(v[0], v[1]), pk2bf(v[2], v[3]), pk2bf(v[4], v[5]), pk2bf(v[6], v[7])); }

DEVINL void ph_rwprep(const P& p, int l, int half, char* smem, int bid, int nb) {
    const int TIDX_ = tid_(); const int BIDX_ = bid_(); char* const WS_ = wsl_(p.ws);
    const int tid = TIDX_, lane = tid & 63, w = tid >> 6, fr = lane & 15, fq = lane >> 4;
    const u16* pb = (const u16*)(WS_ + OFF_PB);
    char* rwop = WS_ + OFF_RWOP;
    float* rwwg = (float*)(WS_ + OFF_RWWG);
    float* bonus = (float*)(WS_ + OFF_BONUS);
    u16* gate = (u16*)(WS_ + OFF_GATE);
    const float* mup = p.mu_prev + l * 960; const float* mun = p.mu_next + l * 960;
    u16* lwdh = (u16*)smem;
    u16* ladh = lwdh + 2048;
    u16* abuf = ladh + 2048;
    float* Lb = (float*)(smem + 16384);
    u16* SV = (u16*)(smem + 32768);
    float* tot = (float*)(smem + 32768);
    const u16* w2t = (const u16*)(WS_ + OFF_LORA);
    const u16* a2t = w2t + 2 * 2 * 256 * 32;
    const u16* g2t = a2t + 2 * 2 * 256 * 32;
    for (int uh = bid; uh < 2 * 2 * 130 * 4; uh += nb) {
        const int h = uh & 3, rest = uh >> 2;
        const int d = rest / 260, b = (rest % 260) / 130, gl = rest % 130;
        const int z = d;
        const int gscan = half * 130 + gl;
        int gi, row0, seqlen;
        if (gscan < 4) { gi = d ? 3 - gscan : gscan; row0 = b * 256 + gi * 64; seqlen = 256; }
        else { gi = d ? 255 - (gscan - 4) : gscan - 4; row0 = CTXROWS + b * LAT + gi * 64; seqlen = LAT; }
        const int t0 = gi * 64;
        __syncthreads();
        {
            const int j = tid >> 2, cq = tid & 3;
            float v[8];
            rw_mix8(pb, mup, mun, row0 + j, t0 + j, seqlen, 768 + z * 32 + 8 * cq, v);
#pragma unroll
            for (int i = 0; i < 8; ++i) v[i] = tanhf(v[i]);
            *(uint4*)(lwdh + j * 32 + 8 * cq) = pack8bf(v);
            rw_mix8(pb, mup, mun, row0 + j, t0 + j, seqlen, 832 + z * 32 + 8 * cq, v);
            *(uint4*)(ladh + j * 32 + 8 * cq) = pack8bf(v);
        }
        if (d == 0) {
            u16* lgd = (u16*)Lb;
            {
                const int j = tid >> 2, cq = tid & 3;
#pragma unroll
                for (int hh = 0; hh < 2; ++hh) {
                    float v[8];
                    rw_mix8(pb, mup, mun, row0 + j, t0 + j, seqlen, 896 + 16 * cq + 8 * hh, v);
#pragma unroll
                    for (int i = 0; i < 8; ++i) v[i] = sigmoidf_(v[i]);
                    *(uint4*)(lgd + j * 64 + 16 * cq + 8 * hh) = pack8bf(v);
                }
            }
            __syncthreads();
            const bf16x8 x0 = *(const bf16x8*)(lgd + (16 * w + fr) * 64 + 8 * fq), x1 = *(const bf16x8*)(lgd + (16 * w + fr) * 64 + 32 + 8 * fq);
#pragma unroll
            for (int nt = 0; nt < 4; ++nt) {
                const u16* bp = g2t + ((size_t)l * 256 + 64 * h + 16 * nt + fr) * 64 + 8 * fq;
                const bf16x8 b0 = *(const bf16x8*)bp, b1 = *(const bf16x8*)(bp + 32);
                f32x4 acc = f32x4{0.f, 0.f, 0.f, 0.f};
                acc = __builtin_amdgcn_mfma_f32_16x16x32_bf16(x0, b0, acc, 0, 0, 0);
                acc = __builtin_amdgcn_mfma_f32_16x16x32_bf16(x1, b1, acc, 0, 0, 0);
#pragma unroll
                for (int r = 0; r < 4; ++r) gate[(size_t)(row0 + 16 * w + 4 * fq + r) * 256 + 64 * h + 16 * nt + fr] = f2bf(acc[r]);
            }
        }
        {
            const int bh = b * 4 + h;
            const int ch = h * 64 + lane;
            __syncthreads();
            {
                const bf16x8 xw = *(const bf16x8*)(lwdh + (16 * w + fr) * 32 + 8 * fq);
                const bf16x8 xa = *(const bf16x8*)(ladh + (16 * w + fr) * 32 + 8 * fq);
#pragma unroll 1
                for (int kt = 0; kt < 4; ++kt) {
                    const int key = 16 * kt + fr;
                    const size_t wrow = ((size_t)(l * 2 + z) * 256 + h * 64 + key) * 32 + 8 * fq;
                    const bf16x8 bw = *(const bf16x8*)(w2t + wrow), ba = *(const bf16x8*)(a2t + wrow);
                    f32x4 ae = f32x4{0.f, 0.f, 0.f, 0.f}, aa = f32x4{0.f, 0.f, 0.f, 0.f};
                    ae = __builtin_amdgcn_mfma_f32_16x16x32_bf16(xw, bw, ae, 0, 0, 0);
                    aa = __builtin_amdgcn_mfma_f32_16x16x32_bf16(xa, ba, aa, 0, 0, 0);
                    const float w0 = p.rw_w0[(l * 2 + z) * 256 + h * 64 + key], a0 = p.rw_a0[(l * 2 + z) * 256 + h * 64 + key];
#pragma unroll
                    for (int r = 0; r < 4; ++r) {
                        const int tok = 16 * w + 4 * fq + r;
                        const int s = d ? 63 - tok : tok;
                        Lb[s * 64 + key] = 0.60653065971263342f * sigmoidf_(ae[r] + w0);
                        abuf[tok * 64 + key] = f2bf(sigmoidf_(aa[r] + a0));
                    }
                }
            }
            __syncthreads();
            {
                float pre[16]; float run = 0.f;
#pragma unroll
                for (int i = 0; i < 16; ++i) { run += Lb[(16 * w + i) * 64 + lane]; pre[i] = run; }
                tot[w * 64 + lane] = run;
                __syncthreads();
                float offs = 0.f;
#pragma unroll
                for (int ww = 0; ww < 3; ++ww) offs += (ww < w) ? tot[ww * 64 + lane] : 0.f;
#pragma unroll
                for (int i = 0; i < 16; ++i) Lb[(16 * w + i) * 64 + lane] = -(offs + pre[i]);
            }
            __syncthreads();
            {
                const int j = tid >> 2, kq = tid & 3, row = row0 + j, tt = t0 + j;
                const int c0 = h * 64 + 16 * kq;
                float kr[16];
                { float t8[8];
                  rw_mix8(pb, mup, mun, row, tt, seqlen, 256 + c0, t8);
#pragma unroll
                  for (int i = 0; i < 8; ++i) kr[i] = t8[i];
                  rw_mix8(pb, mup, mun, row, tt, seqlen, 256 + c0 + 8, t8);
#pragma unroll
                  for (int i = 0; i < 8; ++i) kr[8 + i] = t8[i]; }
                float ss = 0.f;
#pragma unroll
                for (int i = 0; i < 16; ++i) { const float kv = kr[i] * p.rw_kk[l * 256 + c0 + i]; ss += kv * kv; }
                ss += __shfl_xor(ss, 1); ss += __shfl_xor(ss, 2);
                const float inorm = 1.f / fmaxf(sqrtf(ss), 1e-12f);
                const int sidx = d ? 63 - j : j;
                const int cch = sidx >> 4, ts = sidx & 15;
                u16* sv = SV + (size_t)(cch * 4) * 1024 + ts * 64 + 16 * kq;
                float bs = 0.f;
#pragma unroll 1
                for (int hh = 0; hh < 2; ++hh) {
                    const int cb = c0 + 8 * hh;
                    float rr[8], av[8], oa[8], orr[8], ob[8], ok[8];
                    rw_mix8(pb, mup, mun, row, tt, seqlen, cb, rr);
                    { const uint4 a0 = *(const uint4*)(abuf + j * 64 + 16 * kq + 8 * hh);
                      const unsigned aw[4] = {a0.x, a0.y, a0.z, a0.w};
#pragma unroll
                      for (int i = 0; i < 4; ++i) { av[2 * i] = __uint_as_float(aw[i] << 16); av[2 * i + 1] = __uint_as_float(aw[i] & 0xFFFF0000u); } }
#pragma unroll
                    for (int i4 = 0; i4 < 2; ++i4) {
                        const float4 Lt4 = *(const float4*)(Lb + sidx * 64 + 16 * kq + 8 * hh + 4 * i4);
                        const float4 Lp4 = sidx > 0 ? *(const float4*)(Lb + (sidx - 1) * 64 + 16 * kq + 8 * hh + 4 * i4) : make_float4(0.f, 0.f, 0.f, 0.f);
                        const float Lt[4] = {Lt4.x, Lt4.y, Lt4.z, Lt4.w}, Lp[4] = {Lp4.x, Lp4.y, Lp4.z, Lp4.w};
#pragma unroll
                        for (int ii = 0; ii < 4; ++ii) {
                            const int i = 4 * i4 + ii;
                            const float kraw = hh ? kr[8 + i] : kr[i];
                            const float kkn = kraw * p.rw_kk[l * 256 + cb + i] * inorm, a = av[i];
                            const float et = __expf(Lt[ii]), einv = __builtin_amdgcn_rcpf(et);
                            oa[i] = -kkn * __expf(Lp[ii]);
                            orr[i] = rr[i] * et;
                            ob[i] = kkn * a * einv;
                            ok[i] = kraw * (1.f + (a - 1.f) * p.rw_ka[l * 256 + cb + i]) * einv;
                            bs += rr[i] * kraw * p.rw_rk[l * 256 + cb + i];
                            if (sidx == 63) rwwg[((size_t)(d * 8 + bh) * 130 + gl) * 64 + 16 * kq + 8 * hh + i] = et;
                        }
                    }
                    *(uint4*)(sv + 8 * hh) = pack8bf(oa);
                    *(uint4*)(sv + 1024 + 8 * hh) = pack8bf(orr);
                    *(uint4*)(sv + 2048 + 8 * hh) = pack8bf(ob);
                    *(uint4*)(sv + 3072 + 8 * hh) = pack8bf(ok);
                    rw_mix8(pb, mup, mun, row, tt, seqlen, 512 + cb, rr);
                    *(uint4*)(abuf + j * 64 + 16 * kq + 8 * hh) = pack8bf(rr);
                }
                if (d == 0) { bs += __shfl_xor(bs, 1); bs += __shfl_xor(bs, 2); if (kq == 0) bonus[(size_t)row * 4 + h] = bs; }
            }
            __syncthreads();
            {
                char* rec = rwop + ((size_t)(d * 8 + bh) * 520 + (size_t)gl * 4 + w) * RWREC;
                const u16* Av = SV + (size_t)(w * 4) * 1024; const u16* Rv = Av + 1024; const u16* Bv = Av + 2048; const u16* Kv = Av + 3072;
                bf16x8 fa[2], frr[2], fb[2], fk[2];
#pragma unroll
                for (int ks = 0; ks < 2; ++ks) {
                    fa[ks] = *(const bf16x8*)(Av + fr * 64 + ks * 32 + fq * 8);
                    frr[ks] = *(const bf16x8*)(Rv + fr * 64 + ks * 32 + fq * 8);
                    fb[ks] = *(const bf16x8*)(Bv + fr * 64 + ks * 32 + fq * 8);
                    fk[ks] = *(const bf16x8*)(Kv + fr * 64 + ks * 32 + fq * 8);
                }
                f32x4 mka = f32x4{0.f, 0.f, 0.f, 0.f}, mba = mka, mkr = mka, mbr = mka;
#pragma unroll
                for (int ks = 0; ks < 2; ++ks) {
                    mka = __builtin_amdgcn_mfma_f32_16x16x32_bf16(fa[ks], fk[ks], mka, 0, 0, 0);
                    mba = __builtin_amdgcn_mfma_f32_16x16x32_bf16(fa[ks], fb[ks], mba, 0, 0, 0);
                    mkr = __builtin_amdgcn_mfma_f32_16x16x32_bf16(frr[ks], fk[ks], mkr, 0, 0, 0);
                    mbr = __builtin_amdgcn_mfma_f32_16x16x32_bf16(frr[ks], fb[ks], mbr, 0, 0, 0);
                }
                float* Ns = Lb + w * 256;
                float* Ts = Lb + 1024 + w * 256;
                u16* rmka = (u16*)(rec + RW_MKA); u16* rmy = (u16*)(rec + RW_MY);
                const int i_ = fr;
#pragma unroll
                for (int r = 0; r < 4; ++r) {
                    const int t_ = 4 * fq + r;
                    const int lp = (i_ >> 2) * 16 + t_;
                    mka[r] = i_ < t_ ? mka[r] : 0.f;
                    rmy[lp * 8 + (i_ & 3)] = f2bf(i_ <= t_ ? mbr[r] : 0.f);
                    rmy[lp * 8 + 4 + (i_ & 3)] = f2bf(i_ <= t_ ? mkr[r] : 0.f);
                    Ns[t_ * 16 + i_] = i_ < t_ ? mba[r] : 0.f;
                }
                if (lane < 16) {
                    float Tr[16];
#pragma unroll
                    for (int ii = 0; ii < 16; ++ii) Tr[ii] = 0.f;
#pragma unroll 1
                    for (int t_ = 0; t_ < 16; ++t_) {
                        float acc = (lane == t_) ? 1.f : 0.f;
#pragma unroll
                        for (int i4 = 0; i4 < 4; ++i4) {
                            const float4 nv = *(const float4*)(Ns + t_ * 16 + 4 * i4);
                            acc += Tr[4 * i4] * nv.x + Tr[4 * i4 + 1] * nv.y + Tr[4 * i4 + 2] * nv.z + Tr[4 * i4 + 3] * nv.w;
                        }
#pragma unroll
                        for (int ii = 0; ii < 16; ++ii) Tr[ii] = (ii == t_) ? acc : Tr[ii];
                        Ts[lane * 16 + t_] = acc;
                    }
                }
                bf16x8 TTf;
                {
                    const float t0v = Ts[(4 * fq + 0) * 16 + fr], t1v = Ts[(4 * fq + 1) * 16 + fr], t2v = Ts[(4 * fq + 2) * 16 + fr], t3v = Ts[(4 * fq + 3) * 16 + fr];
                    union { u32x4 u; bf16x8 f; } x; x.u = u32x4{pk2bf(t0v, t1v), pk2bf(t2v, t3v), 0u, 0u}; TTf = x.f;
                }
                {
                    union { u32x4 u; bf16x8 f; } mb; mb.u = u32x4{pk2bf(mka[0], mka[1]), pk2bf(mka[2], mka[3]), 0u, 0u};
                    f32x4 mk2 = f32x4{0.f, 0.f, 0.f, 0.f};
                    mk2 = __builtin_amdgcn_mfma_f32_16x16x32_bf16(TTf, mb.f, mk2, 0, 0, 0);
#pragma unroll
                    for (int r = 0; r < 4; ++r) { const int t_ = 4 * fq + r; rmka[((i_ >> 2) * 16 + t_) * 4 + (i_ & 3)] = f2bf(mk2[r]); }
                }
                {
                    f32x4 ap[4];
#pragma unroll
                    for (int m = 0; m < 4; ++m) {
                        union { u32x4 u; bf16x8 f; } ag;
                        ag.u = u32x4{(unsigned)Av[(4 * fq + 0) * 64 + 16 * m + fr] | ((unsigned)Av[(4 * fq + 1) * 64 + 16 * m + fr] << 16),
                                     (unsigned)Av[(4 * fq + 2) * 64 + 16 * m + fr] | ((unsigned)Av[(4 * fq + 3) * 64 + 16 * m + fr] << 16), 0u, 0u};
                        ap[m] = f32x4{0.f, 0.f, 0.f, 0.f};
                        ap[m] = __builtin_amdgcn_mfma_f32_16x16x32_bf16(ag.f, TTf, ap[m], 0, 0, 0);
                    }
#pragma unroll
                    for (int ks = 0; ks < 2; ++ks) {
                        uint4 o;
                        o.x = pk2bf(ap[2 * ks][0], ap[2 * ks][1]); o.y = pk2bf(ap[2 * ks][2], ap[2 * ks][3]);
                        o.z = pk2bf(ap[2 * ks + 1][0], ap[2 * ks + 1][1]); o.w = pk2bf(ap[2 * ks + 1][2], ap[2 * ks + 1][3]);
                        *(uint4*)(rec + RW_A1 + (ks * 64 + lane) * 16) = o;
                    }
                }
#pragma unroll
                for (int ks = 0; ks < 2; ++ks) {
                    uint4 o;
                    const uint2 lo2 = *(const uint2*)(Rv + fr * 64 + 32 * ks + 4 * fq), hi2 = *(const uint2*)(Rv + fr * 64 + 32 * ks + 16 + 4 * fq);
                    o.x = lo2.x; o.y = lo2.y; o.z = hi2.x; o.w = hi2.y;
                    *(uint4*)(rec + RW_A4 + (ks * 64 + lane) * 16) = o;
                }
#pragma unroll
                for (int m = 0; m < 4; ++m) {
                    unsigned e[8];
#pragma unroll
                    for (int j = 0; j < 4; ++j) { e[j] = Bv[(4 * fq + j) * 64 + 16 * m + fr]; e[4 + j] = Kv[(4 * fq + j) * 64 + 16 * m + fr]; }
                    uint4 o; o.x = e[0] | (e[1] << 16); o.y = e[2] | (e[3] << 16); o.z = e[4] | (e[5] << 16); o.w = e[6] | (e[7] << 16);
                    *(uint4*)(rec + RW_A3 + (m * 64 + lane) * 16) = o;
                }
#pragma unroll
                for (int q = 0; q < 4; ++q) {
                    unsigned e[4];
#pragma unroll
                    for (int j = 0; j < 4; ++j) {
                        const int s = 16 * w + 4 * fq + j; const int jt = d ? 63 - s : s;
                        e[j] = abuf[jt * 64 + 16 * q + fr];
                    }
                    uint2 o; o.x = e[0] | (e[1] << 16); o.y = e[2] | (e[3] << 16);
                    *(uint2*)(rec + RW_V + (q * 64 + lane) * 8) = o;
                }
            }
        }
    }
}

constexpr int RWSLOT = 12544;
DEVINL void ph_rwscan(const P& p, int l, int half, int bid, int nb, char* smem) {
    const int TIDX_ = tid_(); char* const WS_ = wsl_(p.ws);
    const int tid = TIDX_, lane = tid & 63, q = tid >> 6, fr = lane & 15, fq = lane >> 4;
    const char* rwop = WS_ + OFF_RWOP;
    const float* rwwg = (const float*)(WS_ + OFF_RWWG);
    u16* yf = (u16*)(WS_ + OFF_Y);
    u16* yb = (u16*)(WS_ + OFF_YRWB);
    (void)l;
    float* zst = (float*)(WS_ + OFF_ZST);
    for (int dbh = bid; dbh < 16; dbh += nb) {
        const int d = dbh >> 3, bh = dbh & 7, b = bh >> 2, h = bh & 3;
        f32x4 z[4];
        float* zp = zst + ((size_t)(dbh * 4 + q) * 64 + lane) * 16;
#pragma unroll
        for (int m = 0; m < 4; ++m) {
            if (half == 0) z[m] = f32x4{0.f, 0.f, 0.f, 0.f};
            else { const float4 t4 = *(const float4*)(zp + 4 * m); z[m] = f32x4{t4.x, t4.y, t4.z, t4.w}; }
        }
        const int cbase = half * 520;
        const char* rec0 = rwop + (size_t)dbh * 520 * RWREC;
        const float* wg0 = rwwg + (size_t)dbh * 130 * 64;
        constexpr int RD = 6;
        u32x4 rb[RD][3]; float rwgA = 0.f, rwgB = 0.f;
        auto ldrec = [&](int c, auto I) {
            constexpr int i = decltype(I)::value;
            const int cc = c < 520 ? c : 519;
            const char* rec = rec0 + (size_t)cc * RWREC;
#pragma unroll
            for (int k = 0; k < 3; ++k) rb[i][k] = *(const u32x4*)(rec + (tid + 256 * k) * 16);
        };
        auto strec = [&](auto I, int slotidx) {
            constexpr int i = decltype(I)::value;
            char* slot = smem + slotidx * RWSLOT;
#pragma unroll
            for (int k = 0; k < 3; ++k) *(u32x4*)(slot + (tid + 256 * k) * 16) = rb[i][k];
        };
        auto asfrag = [](uint4 v) { union { uint4 u; bf16x8 f; } x; x.u = v; return x.f; };
        auto pack2 = [](float lo, float hi) { return pk2bf(lo, hi); };
        const unsigned b128 = lds_addr(smem) + lane * 16, b64 = lds_addr(smem) + lane * 8, bv = lds_addr(smem) + (q * 64 + lane) * 8, bg = lds_addr(smem) + 16 * fq;
        __syncthreads();
        __builtin_amdgcn_s_setprio(3);
#define IC(n) std::integral_constant<int, n>{}
        auto flush_y = [&](int cprev, int par) {
            if (tid < 128) {
                const int cg = cbase + cprev;
                const bool isctx = cg < 16;
                const int cc = isctx ? cg : cg - 16;
                const int n = isctx ? LCTX : LAT;
                const int rowbase = isctx ? b * LCTX : CTXROWS + b * LAT;
                const int ts = tid >> 3, c8 = (tid & 7) * 8;
                const int sidx = cc * 16 + ts;
                const int t = d ? n - 1 - sidx : sidx;
                const u32x4 v = *(const u32x4*)(smem + 4 * RWSLOT + par * 2048 + (ts * 64 + c8) * 2);
                u16* dst = d == 0 ? yf + (size_t)(rowbase + t) * 1024 + 512 + h * 64 + c8 : yb + (size_t)(rowbase + t) * 256 + h * 64 + c8;
                *(u32x4*)dst = v;
            }
        };
        u32x4 f4[2][6]; u32x2 f2[2][2];
#define RD_ISSUE(par, SBC) asm volatile( \
                "ds_read_b64 %6, %9 offset:%11+8192\n\t" \
                "ds_read_b64 %7, %10 offset:%11+10240\n\t" \
                "ds_read_b128 %0, %8 offset:%11+0\n\t" \
                "ds_read_b128 %1, %8 offset:%11+1024\n\t" \
                "ds_read_b128 %2, %8 offset:%11+4096\n\t" \
                "ds_read_b128 %3, %8 offset:%11+5120\n\t" \
                "ds_read_b128 %4, %8 offset:%11+6144\n\t" \
                "ds_read_b128 %5, %8 offset:%11+7168" \
                : "=&v"(f4[par][0]), "=&v"(f4[par][1]), "=&v"(f4[par][2]), "=&v"(f4[par][3]), "=&v"(f4[par][4]), "=&v"(f4[par][5]), \
                  "=&v"(f2[par][0]), "=&v"(f2[par][1]) \
                : "v"(b128), "v"(b64), "v"(bv), "n"(SBC) \
                : "memory")
#define RD_WAIT(par) asm volatile("s_waitcnt lgkmcnt(0)" \
                : "+v"(f4[par][0]), "+v"(f4[par][1]), "+v"(f4[par][2]), "+v"(f4[par][3]), "+v"(f4[par][4]), "+v"(f4[par][5]), \
                  "+v"(f2[par][0]), "+v"(f2[par][1]) \
                :: "memory")
        ldrec(0, IC(0)); ldrec(1, IC(1)); ldrec(2, IC(2)); ldrec(3, IC(3)); ldrec(4, IC(4)); ldrec(5, IC(5));
        strec(IC(0), 0); ldrec(RD, IC(0));
        strec(IC(1), 1); ldrec(RD + 1, IC(1));
        rwgA = wg0[lane]; rwgB = wg0[64 + lane];
        asm volatile("s_waitcnt lgkmcnt(0)" ::: "memory");
        __builtin_amdgcn_s_barrier();
        RD_ISSUE(0, 0); RD_WAIT(0);
#pragma unroll 1
        for (int c5 = 0; c5 < 528; c5 += 12) {
          auto body = [&](auto SJ) {
            constexpr int sj = decltype(SJ)::value;
            constexpr int par = sj & 1;
            const int c = c5 + sj;
            asm volatile("s_waitcnt lgkmcnt(0)" ::: "memory");
            __builtin_amdgcn_s_barrier();
            RD_ISSUE(par ^ 1, ((sj + 1) % 4) * RWSLOT);
            if (c > 0 && c <= 520) flush_y(c - 1, par ^ 1);
            strec(IC((sj + 2) % 6), (sj + 2) % 4);
            ldrec(c + 2 + RD, IC((sj + 2) % 6));
            if ((sj & 3) == 1) {
                const bool even = (((c >> 2) & 1) == 0);
                if (q == 0) *(float*)(smem + ((sj + 2) % 4) * RWSLOT + 12288 + lane * 4) = even ? rwgA : rwgB;
                const int gn = (c >> 2) + 2;
                const float nv = wg0[(size_t)(gn < 130 ? gn : 129) * 64 + lane];
                if (even) rwgA = nv; else rwgB = nv;
            }
            if (c < 520) {
            constexpr int SB = (sj % 4) * RWSLOT;
            auto asfrag4 = [](u32x4 v) { union { u32x4 u; bf16x8 f; } x; x.u = v; return x.f; };
            const bf16x8 A1_0 = asfrag4(f4[par][0]), A1_1 = asfrag4(f4[par][1]);
            const bf16x8 A3_0 = asfrag4(f4[par][2]), A3_1 = asfrag4(f4[par][3]), A3_2 = asfrag4(f4[par][4]), A3_3 = asfrag4(f4[par][5]);
            const u32x2 mka = f2[par][0], vcur = f2[par][1];
            const bf16x8 MKA = asfrag(make_uint4(mka.x, mka.y, 0u, 0u));
            const bf16x8 VB = asfrag(make_uint4(vcur.x, vcur.y, 0u, 0u));
            const bf16x8 ZB0 = asfrag(make_uint4(pack2(z[0][0], z[0][1]), pack2(z[0][2], z[0][3]), pack2(z[1][0], z[1][1]), pack2(z[1][2], z[1][3])));
            const bf16x8 ZB1 = asfrag(make_uint4(pack2(z[2][0], z[2][1]), pack2(z[2][2], z[2][3]), pack2(z[3][0], z[3][1]), pack2(z[3][2], z[3][3])));
            f32x4 Ua = f32x4{0.f, 0.f, 0.f, 0.f}, Ub = f32x4{0.f, 0.f, 0.f, 0.f};
            Ua = __builtin_amdgcn_mfma_f32_16x16x32_bf16(MKA, VB, Ua, 0, 0, 0);
            Ub = __builtin_amdgcn_mfma_f32_16x16x32_bf16(A1_1, ZB1, Ub, 0, 0, 0);
            Ua = __builtin_amdgcn_mfma_f32_16x16x32_bf16(A1_0, ZB0, Ua, 0, 0, 0);
            u32x4 r_a40, r_a41, r_my;
            asm volatile(
                "ds_read_b128 %0, %3 offset:%4+2048\n\t"
                "ds_read_b128 %1, %3 offset:%4+3072\n\t"
                "ds_read_b128 %2, %3 offset:%4+9216\n\t"
                "s_waitcnt lgkmcnt(0)"
                : "=&v"(r_a40), "=&v"(r_a41), "=&v"(r_my) : "v"(b128), "n"(SB) : "memory");
            const bf16x8 A4_0 = asfrag4(r_a40), A4_1 = asfrag4(r_a41), MY = asfrag4(r_my);
            f32x4 Y = f32x4{0.f, 0.f, 0.f, 0.f};
            Y = __builtin_amdgcn_mfma_f32_16x16x32_bf16(A4_0, ZB0, Y, 0, 0, 0);
            Y = __builtin_amdgcn_mfma_f32_16x16x32_bf16(A4_1, ZB1, Y, 0, 0, 0);
            const f32x4 U = Ua + Ub;
            const bf16x8 UV = asfrag(make_uint4(pack2(U[0], U[1]), pack2(U[2], U[3]), vcur.x, vcur.y));
            z[0] = __builtin_amdgcn_mfma_f32_16x16x32_bf16(A3_0, UV, z[0], 0, 0, 0);
            z[1] = __builtin_amdgcn_mfma_f32_16x16x32_bf16(A3_1, UV, z[1], 0, 0, 0);
            z[2] = __builtin_amdgcn_mfma_f32_16x16x32_bf16(A3_2, UV, z[2], 0, 0, 0);
            z[3] = __builtin_amdgcn_mfma_f32_16x16x32_bf16(A3_3, UV, z[3], 0, 0, 0);
            Y = __builtin_amdgcn_mfma_f32_16x16x32_bf16(MY, UV, Y, 0, 0, 0);
            asm volatile("s_waitcnt lgkmcnt(0)" ::: "memory");
            if ((c & 3) == 3) {
                u32x4 g0, g1, g2, g3;
                asm volatile(
                    "ds_read_b128 %0, %4 offset:%5+12288\n\t"
                    "ds_read_b128 %1, %4 offset:%5+12352\n\t"
                    "ds_read_b128 %2, %4 offset:%5+12416\n\t"
                    "ds_read_b128 %3, %4 offset:%5+12480\n\t"
                    "s_waitcnt lgkmcnt(0)"
                    : "=&v"(g0), "=&v"(g1), "=&v"(g2), "=&v"(g3) : "v"(bg), "n"(SB) : "memory");
                z[0][0] *= __uint_as_float(g0.x); z[0][1] *= __uint_as_float(g0.y); z[0][2] *= __uint_as_float(g0.z); z[0][3] *= __uint_as_float(g0.w);
                z[1][0] *= __uint_as_float(g1.x); z[1][1] *= __uint_as_float(g1.y); z[1][2] *= __uint_as_float(g1.z); z[1][3] *= __uint_as_float(g1.w);
                z[2][0] *= __uint_as_float(g2.x); z[2][1] *= __uint_as_float(g2.y); z[2][2] *= __uint_as_float(g2.z); z[2][3] *= __uint_as_float(g2.w);
                z[3][0] *= __uint_as_float(g3.x); z[3][1] *= __uint_as_float(g3.y); z[3][2] *= __uint_as_float(g3.z); z[3][3] *= __uint_as_float(g3.w);
            }
            {
                u16* yl = (u16*)(smem + 4 * RWSLOT + par * 2048);
                const unsigned y01 = pk2bf(Y[0], Y[1]), y23 = pk2bf(Y[2], Y[3]);
                yl[(4 * fq + 0) * 64 + 16 * q + fr] = (u16)(y01 & 0xFFFFu);
                yl[(4 * fq + 1) * 64 + 16 * q + fr] = (u16)(y01 >> 16);
                yl[(4 * fq + 2) * 64 + 16 * q + fr] = (u16)(y23 & 0xFFFFu);
                yl[(4 * fq + 3) * 64 + 16 * q + fr] = (u16)(y23 >> 16);
            }
            }
            RD_WAIT(par ^ 1);
          };
          body(IC(0)); body(IC(1)); body(IC(2)); body(IC(3)); body(IC(4)); body(IC(5)); body(IC(6)); body(IC(7)); body(IC(8)); body(IC(9)); body(IC(10)); body(IC(11));
        }
#pragma unroll
        for (int m = 0; m < 4; ++m) *(float4*)(zp + 4 * m) = make_float4(z[m][0], z[m][1], z[m][2], z[m][3]);
        asm volatile("s_waitcnt vmcnt(0)" ::: "memory");
        __builtin_amdgcn_s_setprio(0);
        __syncthreads();
    }
}

DEVINL void ph_rwout(const P& p, int l) {
    const int TIDX_ = tid_(); const int BIDX_ = bid_(); char* const WS_ = wsl_(p.ws);
    const int tid = TIDX_, h = tid >> 6;
    const u16* pb = (const u16*)(WS_ + OFF_PB);
    const u16* yb = (const u16*)(WS_ + OFF_YRWB);
    const u16* gate = (const u16*)(WS_ + OFF_GATE);
    const float* bonus = (const float*)(WS_ + OFF_BONUS);
    u16* y = (u16*)(WS_ + OFF_Y);
    const float* mup = p.mu_prev + l * 960; const float* mun = p.mu_next + l * 960;
    const float lw = p.rw_lnw[l * 256 + tid], lb = p.rw_lnb[l * 256 + tid];
    const int rstart = (l == 0) ? 0 : CTXROWS;
    for (int row = rstart + BIDX_; row < T; row += gridDim.x) {
        int t, seqlen;
        if (row < CTXROWS) { t = row & 255; seqlen = LCTX; } else { t = (row - CTXROWS) & (LAT - 1); seqlen = LAT; }
        const float yv = bf2f(y[(size_t)row * 1024 + 512 + tid]) + bf2f(yb[(size_t)row * 256 + tid]);
        const float v = rw_mix(pb, mup, mun, row, t, seqlen, 512 + tid);
        const float mu = wsum(yv) * (1.f / 64.f);
        const float dl = yv - mu;
        const float var = wsum(dl * dl) * (1.f / 64.f);
        const float o = (dl * rsqrtf(var + 64e-5f) * lw + lb + bonus[(size_t)row * 4 + h] * v) * bf2f(gate[(size_t)row * 256 + tid]);
        y[(size_t)row * 1024 + 512 + tid] = f2bf(o);
    }
}
DEVINL void ph_prepM(const P& p, int l, char* smem, int bid, int nb) {
    const int TIDX_ = tid_(); const int BIDX_ = bid_(); char* const WS_ = wsl_(p.ws);
    const int tid = TIDX_, lane = tid & 63, wid = tid >> 6;
    const u16* pc = (const u16*)(WS_ + OFF_PC);
    u16* mlf = (u16*)(WS_ + OFF_MLF);
    float* mlg = (float*)(WS_ + OFF_MLG);
    float* mls = (float*)(WS_ + OFF_MLS);
    float* nst = (float*)(WS_ + OFF_NST);
    float* cst = (float*)(WS_ + OFF_HM);
    const float* rope = (const float*)(WS_ + OFF_ROPE);
    u16* kl = (u16*)smem;
    u16* vl = kl + 4096;
    float* wsl = (float*)(vl + 4096);
    float* lil = wsl + 128;
    for (int uh = bid; uh < NUNIT_CH * 4; uh += nb) {
        const int u = uh >> 2, h = uh & 3;
        int b, ch, row0, seqlen; bool isctx;
        if (u < 8) { isctx = true; b = u >> 2; ch = u & 3; row0 = b * 256 + ch * 64; seqlen = 256; }
        else { isctx = false; b = (u - 8) >> 8; ch = (u - 8) & 255; row0 = CTXROWS + b * LAT + ch * 64; seqlen = LAT; }
        const int t0 = ch * 64;
        const int tc = isctx ? ch : 4 + ch;
        __syncthreads();
        {
            const bool isk = wid >= 2;
            const int cch = (isk ? 256 : 0) + h * 64 + lane;
            const float* cw = p.ml_cw + (size_t)l * 3 * 512;
            const float w0 = cw[cch], w1 = cw[512 + cch], w2 = cw[1024 + cch], bb = p.ml_cb[l * 512 + cch];
            const int jb = (wid & 1) * 32;
            const int i16 = lane & 15; const bool second = (lane & 16) != 0; const int half = lane >> 5;
            float pv = (t0 + jb > 0) ? bf2f(pc[(size_t)(row0 + jb - 1) * 1040 + cch]) : 0.f;
            float cv = bf2f(pc[(size_t)(row0 + jb) * 1040 + cch]);
#pragma unroll 4
            for (int jj = 0; jj < 32; ++jj) {
                const int j = jb + jj;
                const float nv = (t0 + j + 1 < seqlen) ? bf2f(pc[(size_t)(row0 + j + 1) * 1040 + cch]) : 0.f;
                float val = siluf_(w0 * pv + w1 * cv + w2 * nv + bb);
                if (!isctx) {
                    const int t = t0 + j;
                    const int pos = half == 0 ? (t >> 6) : (t & 63);
                    const float cs = half == 0 ? rope[pos * 16 + i16] : rope[8192 + pos * 16 + i16];
                    const float sn = half == 0 ? rope[4096 + pos * 16 + i16] : rope[9216 + pos * 16 + i16];
                    const float ov = __shfl_xor(val, 16);
                    val = second ? (ov * sn + val * cs) : (val * cs - ov * sn);
                }
                if (isk) { const u16 kb = f2bf(val * 0.125f); mlf[(size_t)(row0 + j) * 512 + 256 + h * 64 + lane] = kb; kl[j * 64 + lane] = kb; }
                else mlf[(size_t)(row0 + j) * 512 + h * 64 + lane] = f2bf(val);
                pv = cv; cv = nv;
            }
            {
                const int j = tid >> 2, wh = tid & 3;
                const int idx = (wh < 2) ? (wh * 4 + h) : (8 + (wh - 2) * 4 + h);
                const float g = bf2f(pc[(size_t)(row0 + j) * 1040 + 1024 + idx]);
                float v;
                if (wh < 2) v = g + p.ml_ib[l * 8 + idx];
                else { const float xx = g + p.ml_fb[l * 8 + idx - 8]; v = fminf(xx, 0.f) - log1pf(__expf(-fabsf(xx))); }
                lil[j * 4 + wh] = v;
                mlg[(size_t)(row0 + j) * 16 + idx] = v;
            }
            for (int i = tid; i < 64 * 16; i += 256) {
                const int tok = i >> 4, c4 = (i & 15) * 4;
                *(uint2*)(vl + tok * 64 + c4) = *(const uint2*)(pc + (size_t)(row0 + tok) * 1040 + 512 + h * 64 + c4);
            }
        }
        __syncthreads();
        if (tid < 2) {
            const int d = tid;
            float bacc = 0.f;
#pragma unroll 1
            for (int jj = 0; jj < 64; ++jj) { const int tok = d ? 63 - jj : jj; bacc += lil[tok * 4 + 2 + d]; wsl[d * 64 + tok] = bacc; }
            const float Bs = bacc;
            float G = -3.0e38f;
#pragma unroll 1
            for (int tok = 0; tok < 64; ++tok) { const float g = Bs - wsl[d * 64 + tok] + lil[tok * 4 + d]; G = fmaxf(G, g); }
#pragma unroll 1
            for (int tok = 0; tok < 64; ++tok) { const float g = Bs - wsl[d * 64 + tok] + lil[tok * 4 + d]; wsl[d * 64 + tok] = expf(g - G); }
            const int bhd = (b * 4 + h) * 2 + d;
            mls[(bhd * NTC + tc) * 2 + 0] = G; mls[(bhd * NTC + tc) * 2 + 1] = Bs;
        }
        __syncthreads();
        {
            const int dk4 = (tid >> 4) * 4, dv4 = (tid & 15) * 4;
            float a0[4][4], a1[4][4], n0[4], n1[4];
#pragma unroll
            for (int a = 0; a < 4; ++a) { n0[a] = 0.f; n1[a] = 0.f;
#pragma unroll
                for (int c = 0; c < 4; ++c) { a0[a][c] = 0.f; a1[a][c] = 0.f; } }
#pragma unroll 2
            for (int j = 0; j < 64; ++j) {
                const uint2 kk = *(const uint2*)(kl + j * 64 + dk4);
                const uint2 vv = *(const uint2*)(vl + j * 64 + dv4);
                const float w0 = wsl[j], w1 = wsl[64 + j];
                const float kf[4] = {bf2f((u16)(kk.x & 0xFFFF)), bf2f((u16)(kk.x >> 16)), bf2f((u16)(kk.y & 0xFFFF)), bf2f((u16)(kk.y >> 16))};
                const float vf[4] = {bf2f((u16)(vv.x & 0xFFFF)), bf2f((u16)(vv.x >> 16)), bf2f((u16)(vv.y & 0xFFFF)), bf2f((u16)(vv.y >> 16))};
#pragma unroll
                for (int a = 0; a < 4; ++a) {
                    const float k0 = kf[a] * w0, k1 = kf[a] * w1;
                    n0[a] += k0; n1[a] += k1;
#pragma unroll
                    for (int c = 0; c < 4; ++c) { a0[a][c] += k0 * vf[c]; a1[a][c] += k1 * vf[c]; }
                }
            }
            const int bh0 = ((b * 4 + h) * 2 + 0) * NTC + tc, bh1 = ((b * 4 + h) * 2 + 1) * NTC + tc;
#pragma unroll
            for (int c = 0; c < 4; ++c) {
                *(float4*)(cst + (size_t)bh0 * 4096 + (dv4 + c) * 64 + dk4) = make_float4(a0[0][c], a0[1][c], a0[2][c], a0[3][c]);
                *(float4*)(cst + (size_t)bh1 * 4096 + (dv4 + c) * 64 + dk4) = make_float4(a1[0][c], a1[1][c], a1[2][c], a1[3][c]);
            }
#pragma unroll
            for (int a = 0; a < 4; ++a)
                if ((tid & 15) == 0) { nst[(size_t)bh0 * 64 + dk4 + a] = n0[a]; nst[(size_t)bh1 * 64 + dk4 + a] = n1[a]; }
        }
    }
}

DEVINL void ph_mlB(const P& p, int bid, int nb, char* smem) {
    const int TIDX_ = tid_(); char* const WS_ = wsl_(p.ws);
    const int tid = TIDX_;
    const float* mls = (const float*)(WS_ + OFF_MLS);
    float* mst = (float*)(WS_ + OFF_MST);
    float* nst = (float*)(WS_ + OFF_NST);
    const float* cst = (const float*)(WS_ + OFF_HM);
    u16* cst2 = (u16*)(WS_ + OFF_CST2);
    float* nst2 = (float*)(WS_ + OFF_NST2);
    float* gb = (float*)smem;
    float* dcu = gb + 1024;
    for (int u = bid; u < 64; u += nb) {
        const int bhd = u >> 2, q = u & 3, d = bhd & 1;
        auto tcof = [&](int cs) { return cs < 4 ? (d ? 3 - cs : cs) : 4 + (d ? 255 - (cs - 4) : cs - 4); };
        __syncthreads();
        for (int cs = tid; cs < NTC; cs += 256) { const int tc = tcof(cs); gb[cs * 2] = mls[(bhd * NTC + tc) * 2]; gb[cs * 2 + 1] = mls[(bhd * NTC + tc) * 2 + 1]; }
        __syncthreads();
        if (tid == 0) {
            float m = 0.f;
#pragma unroll 1
            for (int cs = 0; cs < NTC; ++cs) {
                const float G = gb[cs * 2], Bs = gb[cs * 2 + 1];
                if (q == 0) mst[bhd * NTC + tcof(cs)] = m;
                const float ml = fmaxf(Bs + m, G);
                dcu[cs * 2] = __expf(Bs + m - ml); dcu[cs * 2 + 1] = __expf(G - ml);
                m = ml;
            }
        }
        __syncthreads();
        float zz = 0.f; asm volatile("" : "+v"(zz));
        float4 C = make_float4(zz, zz, zz, zz);
        float nn = zz;
        const bool don = (q == 0) && (tid < 64);
        const float* cbase = cst + (size_t)bhd * NTC * 4096 + q * 1024 + tid * 4;
        const float* nbase = nst + (size_t)bhd * NTC * 64 + tid;
        u16* obase = cst2 + (size_t)bhd * NTC * 4096 + q * 1024 + tid * 4;
        float* onbase = nst2 + (size_t)bhd * NTC * 64 + tid;
        float4 Ub[8]; float Nb[8];
#pragma unroll
        for (int i = 0; i < 8; ++i) { Ub[i] = *(const float4*)(cbase + (size_t)tcof(i) * 4096); Nb[i] = don ? nbase[(size_t)tcof(i) * 64] : 0.f; }
#pragma unroll 1
        for (int cs0 = 0; cs0 < NTC; cs0 += 8) {
#pragma unroll
            for (int i = 0; i < 8; ++i) {
                const int cs = cs0 + i;
                if (cs < NTC) {
                    const float4 U = Ub[i]; const float nU = Nb[i];
                    const int tc = tcof(cs);
                    if (cs + 8 < NTC) { Ub[i] = *(const float4*)(cbase + (size_t)tcof(cs + 8) * 4096); Nb[i] = don ? nbase[(size_t)tcof(cs + 8) * 64] : 0.f; }
                    { uint2 o; o.x = pk2bf(C.x, C.y); o.y = pk2bf(C.z, C.w); *(uint2*)(obase + (size_t)tc * 4096) = o; }
                    if (don) onbase[(size_t)tc * 64] = nn;
                    const float dC = dcu[cs * 2], dU = dcu[cs * 2 + 1];
                    C.x = dC * C.x + dU * U.x; C.y = dC * C.y + dU * U.y; C.z = dC * C.z + dU * U.z; C.w = dC * C.w + dU * U.w;
                    nn = dC * nn + dU * nU;
                }
            }
        }
    }
}

DEVINL void ph_na(const P& p, int l, char* smem, int bid, int nb) {
    const int TIDX_ = tid_(); char* const WS_ = wsl_(p.ws);
    const int tid = TIDX_, lane = tid & 63, w = tid >> 6, fr = lane & 15, g = lane >> 4;
    const u16* pqk = (const u16*)(WS_ + OFF_PQK);
    const u16* vtl = (const u16*)(WS_ + OFF_VTL);
    const u16* vtc = (const u16*)(WS_ + OFF_VTC);
    u16* y = (u16*)(WS_ + OFF_Y);
    float* rpbl = (float*)(smem + 49152);
    const int nunit = 4096 + (l == 0 ? 64 : 0);
    const unsigned lbase = lds_addr(smem);
    const int lrow0 = tid >> 3, lrow1 = lrow0 + 32, lsc = ((tid & 7) ^ (lrow0 & 7)) * 8;
    for (int u = bid; u < nunit; u += nb) {
        const bool isctx = u >= 4096;
        int b, h, r = 0, qg = 0;
        if (!isctx) { b = u >> 11; h = (u >> 8) & 7; r = u & 255; }
        else { const int v = u - 4096; b = v >> 5; h = (v >> 2) & 7; qg = v & 3; }
        const int rs = min(max(r - 4, 0), 248);
        const int nwin = isctx ? 0 : 8, nst = nwin + 4;
        auto issue = [&](int st) {
            char* slot = smem + (st % 3) * 16384;
            const u16* ksrc; const u16* vsrc; size_t vstride;
            if (st < nwin) {
                const size_t tok0 = (size_t)CTXROWS + (size_t)b * LAT + (size_t)(rs + st) * 64;
                ksrc = pqk + tok0 * 1024 + 512 + h * 64;
                vsrc = vtl + (size_t)((b * 8 + h) * 64) * LAT + (size_t)(rs + st) * 64; vstride = LAT;
            } else {
                const size_t tok0 = (size_t)b * LCTX + (size_t)(st - nwin) * 64;
                ksrc = pqk + tok0 * 1024 + 512 + h * 64;
                vsrc = vtc + (size_t)((b * 8 + h) * 64) * LCTX + (size_t)(st - nwin) * 64; vstride = LCTX;
            }
            glds16(ksrc + (size_t)lrow0 * 1024 + lsc, slot + tid * 16);
            glds16(ksrc + (size_t)lrow1 * 1024 + lsc, slot + 4096 + tid * 16);
            glds16(vsrc + (size_t)lrow0 * vstride + lsc, slot + 8192 + tid * 16);
            glds16(vsrc + (size_t)lrow1 * vstride + lsc, slot + 8192 + 4096 + tid * 16);
        };
        __syncthreads();
        issue(0); issue(1);
        if (!isctx) for (int i = tid; i < 465; i += 256) rpbl[i] = p.na_rpb[((size_t)l * 8 + h) * 465 + i];
        asm volatile("s_waitcnt lgkmcnt(0)" ::: "memory");
        const int c = 16 * w + fr;
        const int qrow = isctx ? b * LCTX + qg * 64 + c : CTXROWS + b * LAT + r * 64 + c;
        bf16x8 qf[2];
        qf[0] = *(const bf16x8*)(pqk + (size_t)qrow * 1024 + h * 64 + 8 * g);
        qf[1] = *(const bf16x8*)(pqk + (size_t)qrow * 1024 + h * 64 + 32 + 8 * g);
        f32x4 O[4];
#pragma unroll
        for (int i = 0; i < 4; ++i) O[i] = f32x4{0.f, 0.f, 0.f, 0.f};
        float mrun = -1.0e30f, lrun = 0.f;
        const int cb = (w == 0) ? 0 : (w == 1) ? 8 : (w == 2) ? 24 : 32;
        const int cs = min(max(c - 8, 0), 48);
        auto chunk = [&](unsigned sl, int kb, const float* bias0, bool local) {
            const int key0 = kb + fr, key1 = kb + 16 + fr;
            const unsigned ka0 = sl + key0 * 128, ka1 = sl + key1 * 128;
            const unsigned k00a = ka0 + ((g ^ (key0 & 7)) << 4), k01a = ka0 + (((4 + g) ^ (key0 & 7)) << 4);
            const unsigned k10a = ka1 + ((g ^ (key1 & 7)) << 4), k11a = ka1 + (((4 + g) ^ (key1 & 7)) << 4);
            const int q0 = (kb >> 2) + g, q1 = q0 + 4;
            const unsigned vbase = sl + 8192 + fr * 128;
            const unsigned vo0 = ((((q0 >> 1) ^ (fr & 7)) << 4) + ((q0 & 1) << 3)), vo1 = ((((q1 >> 1) ^ (fr & 7)) << 4) + ((q1 & 1) << 3));
            u32x4 k00, k01, k10, k11; u32x2 vlo0, vhi0, vlo1, vhi1, vlo2, vhi2, vlo3, vhi3;
            asm volatile(
                "ds_read_b128 %0, %12\n\t"
                "ds_read_b128 %1, %13\n\t"
                "ds_read_b128 %2, %14\n\t"
                "ds_read_b128 %3, %15\n\t"
                "ds_read_b64 %4, %16\n\t"
                "ds_read_b64 %5, %17\n\t"
                "ds_read_b64 %6, %16 offset:2048\n\t"
                "ds_read_b64 %7, %17 offset:2048\n\t"
                "ds_read_b64 %8, %16 offset:4096\n\t"
                "ds_read_b64 %9, %17 offset:4096\n\t"
                "ds_read_b64 %10, %16 offset:6144\n\t"
                "ds_read_b64 %11, %17 offset:6144\n\t"
                "s_waitcnt lgkmcnt(0)"
                : "=&v"(k00), "=&v"(k01), "=&v"(k10), "=&v"(k11), "=&v"(vlo0), "=&v"(vhi0), "=&v"(vlo1), "=&v"(vhi1),
                  "=&v"(vlo2), "=&v"(vhi2), "=&v"(vlo3), "=&v"(vhi3)
                : "v"(k00a), "v"(k01a), "v"(k10a), "v"(k11a), "v"(vbase + vo0), "v"(vbase + vo1)
                : "memory");
            auto asf = [](u32x4 v) { union { u32x4 u; bf16x8 f; } x; x.u = v; return x.f; };
            f32x4 s0 = f32x4{0.f, 0.f, 0.f, 0.f}, s1 = f32x4{0.f, 0.f, 0.f, 0.f};
            s0 = __builtin_amdgcn_mfma_f32_16x16x32_bf16(asf(k00), qf[0], s0, 0, 0, 0);
            s0 = __builtin_amdgcn_mfma_f32_16x16x32_bf16(asf(k01), qf[1], s0, 0, 0, 0);
            s1 = __builtin_amdgcn_mfma_f32_16x16x32_bf16(asf(k10), qf[0], s1, 0, 0, 0);
            s1 = __builtin_amdgcn_mfma_f32_16x16x32_bf16(asf(k11), qf[1], s1, 0, 0, 0);
            float sv[8];
#pragma unroll
            for (int j = 0; j < 4; ++j) {
                float a = s0[j] * 0.125f, bb = s1[j] * 0.125f;
                if (local) {
                    const int k0c = kb + 4 * g + j, k1c = k0c + 16;
                    a = (k0c >= cs && k0c <= cs + 15) ? a + bias0[k0c] : -1.0e30f;
                    bb = (k1c >= cs && k1c <= cs + 15) ? bb + bias0[k1c] : -1.0e30f;
                }
                sv[j] = a; sv[4 + j] = bb;
            }
            float mx = sv[0];
#pragma unroll
            for (int j = 1; j < 8; ++j) mx = fmaxf(mx, sv[j]);
            mx = fmaxf(mx, __shfl_xor(mx, 16)); mx = fmaxf(mx, __shfl_xor(mx, 32));
            const float mnew = fmaxf(mrun, mx);
            const float sc = __expf(mrun - mnew);
            mrun = mnew;
            float ps = 0.f; float pv[8];
#pragma unroll
            for (int j = 0; j < 8; ++j) { pv[j] = __expf(sv[j] - mnew); ps += pv[j]; }
            lrun = lrun * sc + ps;
            union { u32x4 u; bf16x8 f; } pf; pf.u = u32x4{pk2bf(pv[0], pv[1]), pk2bf(pv[2], pv[3]), pk2bf(pv[4], pv[5]), pk2bf(pv[6], pv[7])};
            const u32x2 vl[4] = {vlo0, vlo1, vlo2, vlo3}, vh[4] = {vhi0, vhi1, vhi2, vhi3};
#pragma unroll
            for (int dt = 0; dt < 4; ++dt) {
                O[dt][0] *= sc; O[dt][1] *= sc; O[dt][2] *= sc; O[dt][3] *= sc;
                union { u32x4 u; bf16x8 f; } vf; vf.u = u32x4{vl[dt].x, vl[dt].y, vh[dt].x, vh[dt].y};
                O[dt] = __builtin_amdgcn_mfma_f32_16x16x32_bf16(vf.f, pf.f, O[dt], 0, 0, 0);
            }
        };
#pragma unroll 1
        for (int st = 0; st < nst; ++st) {
            if (st + 1 < nst) asm volatile("s_waitcnt vmcnt(4)" ::: "memory"); else asm volatile("s_waitcnt vmcnt(0)" ::: "memory");
            __builtin_amdgcn_s_barrier();
            if (st + 2 < nst) issue(st + 2);
            const unsigned sl = lbase + (st % 3) * 16384;
            if (st < nwin) {
                const int krow = rs + st;
                chunk(sl, cb, rpbl + (krow - r + 7) * 31 - c + 15, true);
            } else {
                chunk(sl, 0, nullptr, false);
                chunk(sl, 32, nullptr, false);
            }
        }
        float lt = lrun; lt += __shfl_xor(lt, 16); lt += __shfl_xor(lt, 32);
        const float inv = 1.f / lt;
#pragma unroll
        for (int dt = 0; dt < 4; ++dt) {
            uint2 o;
            o.x = pk2bf(O[dt][0] * inv, O[dt][1] * inv);
            o.y = pk2bf(O[dt][2] * inv, O[dt][3] * inv);
            *(uint2*)(y + (size_t)qrow * 1024 + h * 64 + dt * 16 + 4 * g) = o;
        }
    }
    asm volatile("s_waitcnt vmcnt(0)" ::: "memory");
    __syncthreads();
}

DEVINL void ph_mlC(const P& p, int l, char* smem, int bid, int nb) {
    const int TIDX_ = tid_(); char* const WS_ = wsl_(p.ws);
    const int tid = TIDX_, lane = tid & 63, w = tid >> 6, fr = lane & 15, g = lane >> 4;
    const u16* mlf = (const u16*)(WS_ + OFF_MLF);
    const u16* pc = (const u16*)(WS_ + OFF_PC);
    const float* mlg = (const float*)(WS_ + OFF_MLG);
    const float* mst = (const float*)(WS_ + OFF_MST);
    const float* nst = (const float*)(WS_ + OFF_NST2);
    const u16* cst = (const u16*)(WS_ + OFF_CST2);
    u16* y = (u16*)(WS_ + OFF_Y);
    u16* vt = (u16*)smem;
    float* btl = (float*)(smem + 9216);
    float* lil = btl + 128;
    float* nl = lil + 128;
    for (int uh = bid; uh < 2 * NTC * 4; uh += nb) {
        const int u = uh >> 2, h = uh & 3;
        const int b = u / NTC, tc = u % NTC;
        if (tc < 4 && l != 0) continue;
        const int row0 = tc < 4 ? b * LCTX + tc * 64 : CTXROWS + b * LAT + (tc - 4) * 64;
        __syncthreads();
        for (int i = tid; i < 64 * 8; i += 256) {
            const int tok = i >> 3, d8 = (i & 7) * 8;
            const uint4 vv = *(const uint4*)(pc + (size_t)(row0 + tok) * 1040 + 512 + h * 64 + d8);
            const unsigned wv[4] = {vv.x, vv.y, vv.z, vv.w};
#pragma unroll
            for (int k = 0; k < 4; ++k) { vt[(d8 + 2 * k) * 72 + tok] = (u16)(wv[k] & 0xFFFFu); vt[(d8 + 2 * k + 1) * 72 + tok] = (u16)(wv[k] >> 16); }
        }
        if (tid < 128) {
            const int d = tid >> 6, tok = tid & 63;
            lil[d * 64 + tok] = mlg[(size_t)(row0 + tok) * 16 + d * 4 + h];
            nl[d * 64 + tok] = nst[((size_t)((b * 4 + h) * 2 + d) * NTC + tc) * 64 + tok];
        }
        if (tid == 128 || tid == 192) {
            const int d = (tid - 128) >> 6;
            float bacc = 0.f;
#pragma unroll 1
            for (int jj = 0; jj < 64; ++jj) { const int tok = d ? 63 - jj : jj; bacc += mlg[(size_t)(row0 + tok) * 16 + 8 + d * 4 + h]; btl[d * 64 + tok] = bacc; }
        }
        const int t = 16 * w + fr;
        bf16x8 qf[2];
        qf[0] = *(const bf16x8*)(mlf + (size_t)(row0 + t) * 512 + h * 64 + 8 * g);
        qf[1] = *(const bf16x8*)(mlf + (size_t)(row0 + t) * 512 + h * 64 + 32 + 8 * g);
        f32x4 S[4];
#pragma unroll
        for (int st = 0; st < 4; ++st) {
            const u16* kp = mlf + (size_t)(row0 + 16 * st + fr) * 512 + 256 + h * 64 + 8 * g;
            const bf16x8 k0 = *(const bf16x8*)kp, k1 = *(const bf16x8*)(kp + 32);
            S[st] = f32x4{0.f, 0.f, 0.f, 0.f};
            S[st] = __builtin_amdgcn_mfma_f32_16x16x32_bf16(k0, qf[0], S[st], 0, 0, 0);
            S[st] = __builtin_amdgcn_mfma_f32_16x16x32_bf16(k1, qf[1], S[st], 0, 0, 0);
        }
        __syncthreads();
        f32x4 hs[4];
#pragma unroll
        for (int i = 0; i < 4; ++i) hs[i] = f32x4{0.f, 0.f, 0.f, 0.f};
#pragma unroll 1
        for (int d = 0; d < 2; ++d) {
            const int bhd = (b * 4 + h) * 2 + d;
            const float m0 = mst[bhd * NTC + tc];
            const float bt = btl[d * 64 + t];
            float ld[16]; float mx = -3.0e38f;
#pragma unroll
            for (int st = 0; st < 4; ++st) {
                const float4 b4 = *(const float4*)(btl + d * 64 + 16 * st + 4 * g), l4 = *(const float4*)(lil + d * 64 + 16 * st + 4 * g);
                const float bs[4] = {b4.x, b4.y, b4.z, b4.w}, ls[4] = {l4.x, l4.y, l4.z, l4.w};
#pragma unroll
                for (int r = 0; r < 4; ++r) {
                    const int s = 16 * st + 4 * g + r;
                    const bool ok = d ? (s >= t) : (s <= t);
                    ld[4 * st + r] = ok ? (bt - bs[r] + ls[r]) : -3.0e38f;
                    mx = fmaxf(mx, ld[4 * st + r]);
                }
            }
            mx = fmaxf(mx, __shfl_xor(mx, 16)); mx = fmaxf(mx, __shfl_xor(mx, 32));
            const float mt = fmaxf(bt + m0, mx);
            float rsum = 0.f; float dw[16];
#pragma unroll
            for (int i = 0; i < 16; ++i) { dw[i] = (ld[i] > -1.0e38f) ? __expf(ld[i] - mt) * S[i >> 2][i & 3] : 0.f; rsum += dw[i]; }
            rsum += __shfl_xor(rsum, 16); rsum += __shfl_xor(rsum, 32);
            const float inter = __expf(bt + m0 - mt);
            float qn = 0.f;
#pragma unroll
            for (int j = 0; j < 8; ++j) {
                qn += bf2f((u16)qf[0][j]) * nl[d * 64 + 8 * g + j] + bf2f((u16)qf[1][j]) * nl[d * 64 + 32 + 8 * g + j];
            }
            qn += __shfl_xor(qn, 16); qn += __shfl_xor(qn, 32);
            const float den = rsum + inter * qn;
            const float dn = 1.f / fmaxf(fabsf(den), __expf(-mt));
            union { u32x4 u; bf16x8 f; } pf[2];
#pragma unroll
            for (int ks = 0; ks < 2; ++ks) pf[ks].u = u32x4{pk2bf(dw[8 * ks], dw[8 * ks + 1]), pk2bf(dw[8 * ks + 2], dw[8 * ks + 3]), pk2bf(dw[8 * ks + 4], dw[8 * ks + 5]), pk2bf(dw[8 * ks + 6], dw[8 * ks + 7])};
            const u16* cb = cst + ((size_t)bhd * NTC + tc) * 4096;
#pragma unroll
            for (int dvt = 0; dvt < 4; ++dvt) {
                f32x4 num = f32x4{0.f, 0.f, 0.f, 0.f}, qc = f32x4{0.f, 0.f, 0.f, 0.f};
#pragma unroll
                for (int ks = 0; ks < 2; ++ks) {
                    const uint2 lo = *(const uint2*)(vt + (16 * dvt + fr) * 72 + 32 * ks + 4 * g), hi = *(const uint2*)(vt + (16 * dvt + fr) * 72 + 32 * ks + 16 + 4 * g);
                    union { u32x4 u; bf16x8 f; } vf; vf.u = u32x4{lo.x, lo.y, hi.x, hi.y};
                    num = __builtin_amdgcn_mfma_f32_16x16x32_bf16(vf.f, pf[ks].f, num, 0, 0, 0);
                    const bf16x8 cf = *(const bf16x8*)(cb + (16 * dvt + fr) * 64 + 32 * ks + 8 * g);
                    qc = __builtin_amdgcn_mfma_f32_16x16x32_bf16(cf, qf[ks], qc, 0, 0, 0);
                }
#pragma unroll
                for (int r = 0; r < 4; ++r) hs[dvt][r] += (num[r] + inter * qc[r]) * dn;
            }
        }
        float s1 = 0.f;
#pragma unroll
        for (int i = 0; i < 4; ++i) s1 += hs[i][0] + hs[i][1] + hs[i][2] + hs[i][3];
        s1 += __shfl_xor(s1, 16); s1 += __shfl_xor(s1, 32);
        const float mu = s1 * (1.f / 64.f);
        float s2 = 0.f;
#pragma unroll
        for (int i = 0; i < 4; ++i)
#pragma unroll
            for (int r = 0; r < 4; ++r) { const float dl = hs[i][r] - mu; s2 += dl * dl; }
        s2 += __shfl_xor(s2, 16); s2 += __shfl_xor(s2, 32);
        const float rstd = rsqrtf(s2 * (1.f / 64.f) + 1e-6f);
        const int row = row0 + t;
#pragma unroll
        for (int dvt = 0; dvt < 4; ++dvt) {
            const int cc = h * 64 + 16 * dvt + 4 * g;
            const uint2 ov = *(const uint2*)(pc + (size_t)row * 1040 + 768 + cc);
            const float4 nw = *(const float4*)(p.ml_nw + l * 256 + cc);
            const float o0 = bf2f((u16)(ov.x & 0xFFFF)), o1 = bf2f((u16)(ov.x >> 16)), o2 = bf2f((u16)(ov.y & 0xFFFF)), o3 = bf2f((u16)(ov.y >> 16));
            uint2 out;
            out.x = pk2bf((hs[dvt][0] - mu) * rstd * nw.x * sigmoidf_(o0), (hs[dvt][1] - mu) * rstd * nw.y * sigmoidf_(o1));
            out.y = pk2bf((hs[dvt][2] - mu) * rstd * nw.z * sigmoidf_(o2), (hs[dvt][3] - mu) * rstd * nw.w * sigmoidf_(o3));
            *(uint2*)(y + (size_t)row * 1024 + 768 + cc) = out;
        }
    }
}

DEVINL void ph_outproj(const P& p, int l, char* smem) {
    const int TIDX_ = tid_(); const int BIDX_ = bid_(); char* const WS_ = wsl_(p.ws); (void)TIDX_; (void)BIDX_; (void)WS_;
    const u16* y = (const u16*)(WS_ + OFF_Y);
    const u16* wout = (const u16*)(WS_ + OFF_WOUT);
    const float* modv = (const float*)(WS_ + OFF_MOD) + (size_t)l * 3 * 6144;
    const float* x2c = (const float*)(WS_ + OFF_X2CTX);
    float* x1 = (float*)(WS_ + OFF_X1);
    const int mt0 = (l == 0) ? 0 : 4;
    const int ntile = (260 - mt0) * 8;
    for (int u = BIDX_; u < ntile; u += gridDim.x) {
        const int mt = mt0 + u / 8, nt = u % 8;
        const u16* A = y + (size_t)mt * 128 * 1024;
        const int R0 = mt * 128;
        const float* xin;
        if (l == 0) xin = R0 < CTXROWS ? p.ctx + (size_t)R0 * 1024 : p.x + (size_t)(R0 - CTXROWS) * 1024;
        else xin = R0 < CTXROWS ? x2c + (size_t)R0 * 1024 : p.out + (size_t)(R0 - CTXROWS) * 1024;
        const float* g1 = modv + row_sel(R0) * 6144 + 2048;
        f32x4 acc[4][4];
        gemm128_acc([&](int r) { return A + (size_t)r * 1024; }, wout + (size_t)nt * 128 * 1024, 1024, 1024, smem, acc);
        stage_tile_f32(acc, smem, [&](int row, int c4, float4 a) {
            const int N = nt * 128 + c4;
            const float4 gg = *(const float4*)(g1 + N);
            const float4 xv = *(const float4*)(xin + (size_t)row * 1024 + N);
            float4 o;
            o.x = ALPHA * xv.x + gg.x * a.x; o.y = ALPHA * xv.y + gg.y * a.y; o.z = ALPHA * xv.z + gg.z * a.z; o.w = ALPHA * xv.w + gg.w * a.w;
            *(float4*)(x1 + (size_t)(R0 + row) * 1024 + N) = o;
        });
    }
}

DEVINL void ph_ln1(const P& p, int l) {
    const int TIDX_ = tid_(); const int BIDX_ = bid_(); char* const WS_ = wsl_(p.ws); (void)TIDX_; (void)BIDX_; (void)WS_;
    const int lane = TIDX_ & 63, wid = TIDX_ >> 6;
    const float* modv = (const float*)(WS_ + OFF_MOD) + (size_t)l * 3 * 6144;
    float* x1 = (float*)(WS_ + OFF_X1);
    u16* hm = (u16*)(WS_ + OFF_HM);
    const int rstart = (l == 0) ? 0 : CTXROWS;
    for (int row = rstart + BIDX_ * 4 + wid; row < T; row += gridDim.x * 4) {
        float4 v[4];
        float s = 0.f;
#pragma unroll
        for (int i = 0; i < 4; ++i) { v[i] = *(const float4*)(x1 + (size_t)row * 1024 + i * 256 + lane * 4); s += v[i].x + v[i].y + v[i].z + v[i].w; }
        const float mu = wsum(s) * (1.f / 1024.f);
        float q = 0.f;
#pragma unroll
        for (int i = 0; i < 4; ++i) { v[i].x -= mu; v[i].y -= mu; v[i].z -= mu; v[i].w -= mu; q += v[i].x * v[i].x + v[i].y * v[i].y + v[i].z * v[i].z + v[i].w * v[i].w; }
        const float rstd = rsqrtf(wsum(q) * (1.f / 1024.f) + 1e-5f);
        const float* mv = modv + row_sel(row) * 6144;
#pragma unroll
        for (int i = 0; i < 4; ++i) {
            const int c = i * 256 + lane * 4;
            const float4 g = *(const float4*)(p.ln1g + l * 1024 + c), bb = *(const float4*)(p.ln1b + l * 1024 + c);
            const float4 sh = *(const float4*)(mv + 3072 + c), sc = *(const float4*)(mv + 4096 + c);
            float4 o;
            o.x = v[i].x * rstd * g.x + bb.x; o.y = v[i].y * rstd * g.y + bb.y; o.z = v[i].z * rstd * g.z + bb.z; o.w = v[i].w * rstd * g.w + bb.w;
            *(float4*)(x1 + (size_t)row * 1024 + c) = o;
            uint2 hh;
            hh.x = (unsigned)f2bf(o.x * (1.f + sc.x) + sh.x) | ((unsigned)f2bf(o.y * (1.f + sc.y) + sh.y) << 16);
            hh.y = (unsigned)f2bf(o.z * (1.f + sc.z) + sh.z) | ((unsigned)f2bf(o.w * (1.f + sc.w) + sh.w) << 16);
            *(uint2*)(hm + (size_t)row * 1024 + c) = hh;
        }
    }
}

DEVINL void ph_router(const P& p, int l, char* smem) {
    const int TIDX_ = tid_(); const int BIDX_ = bid_(); char* const WS_ = wsl_(p.ws); (void)TIDX_; (void)BIDX_; (void)WS_;
    const u16* hm = (const u16*)(WS_ + OFF_HM);
    const u16* wr = (const u16*)(WS_ + OFF_WR) + (size_t)l * 128 * 1024;
    float* lg = (float*)(WS_ + OFF_LOGITS);
    const int mt0 = (l == 0) ? 0 : 4;
    for (int u = BIDX_; u < 260 - mt0; u += gridDim.x) {
        const int mt = mt0 + u;
        const u16* A = hm + (size_t)mt * 128 * 1024;
        gemm128([&](int r) { return A + (size_t)r * 1024; }, wr, 1024, 1024, smem,
                [&](int m, int n, f32x4 a) {
                    if (n < 36) {
#pragma unroll
                        for (int j = 0; j < 4; ++j) lg[(size_t)(mt * 128 + m + j) * 64 + n] = a[j];
                    }
                });
    }
}

DEVINL void ph_route1(const P& p, int l, char* smem) {
    const int TIDX_ = tid_(); const int BIDX_ = bid_(); char* const WS_ = wsl_(p.ws); (void)TIDX_; (void)BIDX_; (void)WS_;
    const int tid = TIDX_;
    const float* lg = (const float*)(WS_ + OFF_LOGITS);
    int* toke = (int*)(WS_ + OFF_TOKE); float* tokw = (float*)(WS_ + OFF_TOKW);
    int* cnt = (int*)(WS_ + CTL_CNT) + l * 32;
    int* hist = (int*)smem;
    __syncthreads();
    if (tid < 32) hist[tid] = 0;
    __syncthreads();
    const int rstart = (l == 0) ? 0 : CTXROWS;
    for (int row = rstart + BIDX_ * 256 + tid; row < T; row += gridDim.x * 256) {
        const float* q = lg + (size_t)row * 64;
        float gl[4]; int gs = 0; float gm = -3.0e38f;
#pragma unroll
        for (int i = 0; i < 4; ++i) { gl[i] = q[i] + p.rgb[l * 4 + i]; if (gl[i] > gm) { gm = gl[i]; gs = i; } }
        float se = 0.f;
#pragma unroll
        for (int i = 0; i < 4; ++i) se += expf(gl[i] - gm);
        const float gw = 1.f / se;
        float v1 = -3.0e38f, v2 = -3.0e38f; int i1 = 0, i2 = 0;
#pragma unroll
        for (int i = 0; i < 8; ++i) {
            const float e = q[4 + gs * 8 + i] + p.reb[l * 32 + gs * 8 + i];
            if (e > v1) { v2 = v1; i2 = i1; v1 = e; i1 = i; }
            else if (e > v2) { v2 = e; i2 = i; }
        }
        const float e2 = expf(v2 - v1);
        const float w1 = gw / (1.f + e2), w2 = gw * e2 / (1.f + e2);
        const int ea = gs * 8 + i1, eb = gs * 8 + i2;
        toke[row * 2] = ea; toke[row * 2 + 1] = eb; tokw[row * 2] = w1; tokw[row * 2 + 1] = w2;
        atomicAdd(&hist[ea], 1); atomicAdd(&hist[eb], 1);
    }
    __syncthreads();
    if (tid < 32 && hist[tid] > 0) atomicAdd(&cnt[tid], hist[tid]);
}

DEVINL void ph_route2(const P& p, int l, char* smem) {
    const int TIDX_ = tid_(); const int BIDX_ = bid_(); char* const WS_ = wsl_(p.ws); (void)TIDX_; (void)BIDX_; (void)WS_;
    const int tid = TIDX_;
    const int* toke = (const int*)(WS_ + OFF_TOKE);
    int* toks = (int*)(WS_ + OFF_TOKS);
    int* slottok = (int*)(WS_ + OFF_SLOTTOK);
    const int* cnt = (const int*)(WS_ + CTL_CNT) + l * 32;
    int* cur = (int*)(WS_ + CTL_CUR) + l * 32;
    int* tiles = (int*)(WS_ + OFF_TILES);
    int* off = (int*)smem;
    int* hist = off + 64;
    int* base = hist + 32;
    __syncthreads();
    if (tid == 0) { int a = 0; for (int e = 0; e < 32; ++e) { off[e] = a; a += (cnt[e] + 127) & ~127; } off[32] = a; }
    if (tid < 32) hist[tid] = 0;
    __syncthreads();
    if (BIDX_ == 0) {
        if (tid == 0) {
            int nt = 0;
#pragma clang loop vectorize(disable) unroll(disable)
            for (int e = 0; e < 32; ++e) {
#pragma clang loop vectorize(disable) unroll(disable)
                for (int s = off[e]; s < off[e + 1]; s += 128) { tiles[64 + nt * 2] = e; tiles[64 + nt * 2 + 1] = s; ++nt; }
            }
            tiles[40] = nt;
        }
#pragma clang loop vectorize(disable) unroll(disable)
        for (int e = 0; e < 32; ++e) {
#pragma clang loop vectorize(disable) unroll(disable)
            for (int s = off[e] + cnt[e] + tid; s < off[e + 1]; s += 256) slottok[s] = (l == 0) ? 0 : CTXROWS;
        }
    }
    const int rstart = (l == 0) ? 0 : CTXROWS;
    for (int a0 = rstart * 2 + BIDX_ * 256; a0 < T * 2; a0 += gridDim.x * 256) {
        const int a = a0 + tid;
        int e = -1, lpos = 0;
        if (a < T * 2) { e = toke[a]; lpos = atomicAdd(&hist[e], 1); }
        __syncthreads();
        if (tid < 32) { base[tid] = hist[tid] > 0 ? atomicAdd(&cur[tid], hist[tid]) : 0; }
        __syncthreads();
        if (e >= 0) { const int s = off[e] + base[e] + lpos; toks[a] = s; slottok[s] = a >> 1; }
        __syncthreads();
        if (tid < 32) hist[tid] = 0;
        __syncthreads();
    }
}

DEVINL void ph_gateup(const P& p, char* smem) {
    const int TIDX_ = tid_(); const int BIDX_ = bid_(); char* const WS_ = wsl_(p.ws); (void)TIDX_; (void)BIDX_; (void)WS_;
    const int tid = TIDX_, lane = tid & 63, wid = tid >> 6, wr = wid >> 1, wc = wid & 1, fr = lane & 15, fq = lane >> 4;
    const u16* hm = (const u16*)(WS_ + OFF_HM);
    const u16* wgu = (const u16*)(WS_ + OFF_WGU);
    const int* tiles = (const int*)(WS_ + OFF_TILES);
    const int* slottok = (const int*)(WS_ + OFF_SLOTTOK);
    u16* act = (u16*)(WS_ + OFF_ACT);
    const int ntile = tiles[40] * 8;
    for (int u = BIDX_; u < ntile; u += gridDim.x) {
        const int ti = u >> 3, nt = u & 7;
        const int e = tiles[64 + ti * 2], s0 = tiles[64 + ti * 2 + 1];
        f32x4 acc[4][4];
        gemm128_acc([&](int r) { return hm + (size_t)slottok[s0 + r] * 1024; }, wgu + ((size_t)e * 1024 + nt * 128) * 1024, 1024, 1024, smem, acc);
        {
            u16* t = (u16*)smem;
            __syncthreads();
#pragma unroll
            for (int m = 0; m < 4; ++m)
#pragma unroll
                for (int n = 0; n < 4; n += 2) {
                    const int jc = (wc * 64 + n * 16) / 2 + fr;
                    const int r0 = wr * 64 + m * 16 + fq * 4;
                    float av[4];
#pragma unroll
                    for (int j = 0; j < 4; ++j) { const float gte = acc[m][n][j], up = acc[m][n + 1][j]; av[j] = gte / (1.f + __expf(-gte)) * up; }
                    const unsigned p01 = pk2bf(av[0], av[1]), p23 = pk2bf(av[2], av[3]);
                    t[(r0 + 0) * 72 + jc] = (u16)(p01 & 0xFFFFu); t[(r0 + 1) * 72 + jc] = (u16)(p01 >> 16);
                    t[(r0 + 2) * 72 + jc] = (u16)(p23 & 0xFFFFu); t[(r0 + 3) * 72 + jc] = (u16)(p23 >> 16);
                }
            __syncthreads();
#pragma unroll
            for (int i = 0; i < 4; ++i) {
                const int ci = tid + 256 * i, row = ci >> 3, c8 = (ci & 7) * 8;
                *(uint4*)(act + (size_t)(s0 + row) * 512 + nt * 64 + c8) = *(const uint4*)(t + row * 72 + c8);
            }
        }
    }
}

DEVINL void ph_down(const P& p, char* smem) {
    const int TIDX_ = tid_(); const int BIDX_ = bid_(); char* const WS_ = wsl_(p.ws); (void)TIDX_; (void)BIDX_; (void)WS_;
    const u16* act = (const u16*)(WS_ + OFF_ACT);
    const u16* wdn = (const u16*)(WS_ + OFF_WDN);
    const int* tiles = (const int*)(WS_ + OFF_TILES);
    u16* so = (u16*)(WS_ + OFF_SLOTOUT);
    const int ntile = tiles[40] * 8;
    for (int u = BIDX_; u < ntile; u += gridDim.x) {
        const int ti = u >> 3, nt = u & 7;
        const int e = tiles[64 + ti * 2], s0 = tiles[64 + ti * 2 + 1];
        const u16* A = act + (size_t)s0 * 512;
        f32x4 acc[4][4];
        gemm128_acc([&](int r) { return A + (size_t)r * 512; }, wdn + ((size_t)e * 1024 + nt * 128) * 512, 512, 512, smem, acc);
        stage_tile_bf16(acc, smem, [&](int row, int c8, uint4 v) { *(uint4*)(so + (size_t)(s0 + row) * 1024 + nt * 128 + c8) = v; });
    }
}

DEVINL void ph_ln2(const P& p, int l) {
    const int TIDX_ = tid_(); const int BIDX_ = bid_(); char* const WS_ = wsl_(p.ws); (void)TIDX_; (void)BIDX_; (void)WS_;
    const int lane = TIDX_ & 63, wid = TIDX_ >> 6;
    const float* modv = (const float*)(WS_ + OFF_MOD) + (size_t)l * 3 * 6144;
    const float* modn = (const float*)(WS_ + OFF_MOD) + (size_t)(l + 1) * 3 * 6144;
    const float* x1 = (const float*)(WS_ + OFF_X1);
    const u16* so = (const u16*)(WS_ + OFF_SLOTOUT);
    const int* toks = (const int*)(WS_ + OFF_TOKS);
    const float* tokw = (const float*)(WS_ + OFF_TOKW);
    float* x2c = (float*)(WS_ + OFF_X2CTX);
    u16* hm = (u16*)(WS_ + OFF_HM);
    const int rstart = (l == 0) ? 0 : CTXROWS;
    for (int row = rstart + BIDX_ * 4 + wid; row < T; row += gridDim.x * 4) {
        const int sa = toks[row * 2], sb = toks[row * 2 + 1];
        const float wa = tokw[row * 2], wb = tokw[row * 2 + 1];
        const float* mv = modv + row_sel(row) * 6144;
        float4 v[4];
        float s = 0.f;
#pragma unroll
        for (int i = 0; i < 4; ++i) {
            const int c = i * 256 + lane * 4;
            const float4 xv = *(const float4*)(x1 + (size_t)row * 1024 + c);
            const uint2 ua = *(const uint2*)(so + (size_t)sa * 1024 + c), ub = *(const uint2*)(so + (size_t)sb * 1024 + c);
            const float4 g2 = *(const float4*)(mv + 5120 + c);
            const float f0 = wa * bf2f((u16)(ua.x & 0xFFFF)) + wb * bf2f((u16)(ub.x & 0xFFFF));
            const float f1 = wa * bf2f((u16)(ua.x >> 16)) + wb * bf2f((u16)(ub.x >> 16));
            const float f2 = wa * bf2f((u16)(ua.y & 0xFFFF)) + wb * bf2f((u16)(ub.y & 0xFFFF));
            const float f3 = wa * bf2f((u16)(ua.y >> 16)) + wb * bf2f((u16)(ub.y >> 16));
            v[i].x = ALPHA * xv.x + g2.x * f0; v[i].y = ALPHA * xv.y + g2.y * f1; v[i].z = ALPHA * xv.z + g2.z * f2; v[i].w = ALPHA * xv.w + g2.w * f3;
            s += v[i].x + v[i].y + v[i].z + v[i].w;
        }
        const float mu = wsum(s) * (1.f / 1024.f);
        float q = 0.f;
#pragma unroll
        for (int i = 0; i < 4; ++i) { v[i].x -= mu; v[i].y -= mu; v[i].z -= mu; v[i].w -= mu; q += v[i].x * v[i].x + v[i].y * v[i].y + v[i].z * v[i].z + v[i].w * v[i].w; }
        const float rstd = rsqrtf(wsum(q) * (1.f / 1024.f) + 1e-5f);
        float* dst = row < CTXROWS ? x2c + (size_t)row * 1024 : p.out + (size_t)(row - CTXROWS) * 1024;
        const float* mn = modn + row_sel(row) * 6144;
#pragma unroll
        for (int i = 0; i < 4; ++i) {
            const int c = i * 256 + lane * 4;
            const float4 g = *(const float4*)(p.ln2g + l * 1024 + c), bb = *(const float4*)(p.ln2b + l * 1024 + c);
            float4 o;
            o.x = v[i].x * rstd * g.x + bb.x; o.y = v[i].y * rstd * g.y + bb.y; o.z = v[i].z * rstd * g.z + bb.z; o.w = v[i].w * rstd * g.w + bb.w;
            *(float4*)(dst + c) = o;
            if (l == 0) {
                const float4 sh = *(const float4*)(mn + c), sc = *(const float4*)(mn + 1024 + c);
                uint2 hh;
                hh.x = (unsigned)f2bf(o.x * (1.f + sc.x) + sh.x) | ((unsigned)f2bf(o.y * (1.f + sc.y) + sh.y) << 16);
                hh.y = (unsigned)f2bf(o.z * (1.f + sc.z) + sh.z) | ((unsigned)f2bf(o.w * (1.f + sc.w) + sh.w) << 16);
                *(uint2*)(hm + (size_t)row * 1024 + c) = hh;
            }
        }
    }
}

DEVINL void gbar(XcdBarrier b) {
    unsigned x = b.x; GAS unsigned* q = (GAS unsigned*)b.bar;
    asm volatile("" : "+s"(x), "+s"(q));
    b.x = x; b.bar = (unsigned*)q;
    xcd_barrier(b);
}
#ifndef PROBE
#define PROBE 0
#endif
#ifndef TPROBE
#define TPROBE 0
#endif
__global__ void __launch_bounds__(256, 2) k_mega(P p) {
    __shared__ __attribute__((aligned(16))) char smem[SMEM_BYTES];
    if (threadIdx.x == 0) *(uint4*)(smem + SMEM_BYTES - 16) = make_uint4(0u, 0u, 0u, 0u);
    __syncthreads();
    XcdBarrier bar = xcd_barrier_post((unsigned*)p.ws, (volatile LAS unsigned*)(smem + SMEM_BYTES - 16));
    const int bid = blockIdx.x, nb = gridDim.x;
#if TPROBE
    unsigned long long tp_acc = 0, tp_last = wall_clock64();
#define TP(g) do { const unsigned long long _n = wall_clock64(); if ((g) == TPROBE) tp_acc += _n - tp_last; tp_last = _n; } while (0)
#else
#define TP(g) do { } while (0)
#endif
    if (threadIdx.x == 0) {
        const unsigned key = ((unsigned)__builtin_amdgcn_s_getreg((3 << 11) | 20) << 8) | ((unsigned)__builtin_amdgcn_s_getreg((7 << 11) | (8 << 6) | 4) & 0xFFu);
        ((unsigned*)(p.ws + CTL_CUKEY))[blockIdx.x] = key | 0x80000000u;
    }
    ph_prolog(p, smem);
    ph_convw(p, 0, smem);
    gbar(bar);
    TP(1);
    ph_xm0(p);
    gbar(bar);
    TP(1);
    constexpr int NSCAN = 16;
    bool quiet; int wrank, nwork, mate_of = -1;
    {
        const unsigned* keys = (const unsigned*)(p.ws + CTL_CUKEY);
        int* cnt = (int*)smem;
        if (threadIdx.x < 2) cnt[threadIdx.x] = 0;
        __syncthreads();
        for (int i = NSCAN + threadIdx.x; i < nb; i += 256) {
            const unsigned k = keys[i];
            bool qq = false;
            for (int j = 0; j < NSCAN && j < nb; ++j) qq = qq || (keys[j] == k);
            if (qq) { atomicAdd(&cnt[1], 1); if (i < bid) atomicAdd(&cnt[0], 1); }
        }
        __syncthreads();
        const int below = cnt[0], total = cnt[1];
        bool me = false;
        if (bid >= NSCAN) { const unsigned k = keys[bid]; for (int j = NSCAN - 1; j >= 0; --j) if (j < nb && keys[j] == k) { me = true; mate_of = j; } }
        __syncthreads();
        if (total > 2 * NSCAN) { quiet = false; wrank = bid - NSCAN; nwork = nb - NSCAN; mate_of = -1; }
        else { quiet = me; wrank = bid - NSCAN - below; nwork = nb - NSCAN - total; }
    }
#pragma unroll 1
    for (int l = 0; l < NLAYER; ++l) {
        ph_inproj(p, smem);
        gbar(bar);
    TP(2);
        ph_rwprep(p, l, 0, smem, bid, nb);
        ph_prepM(p, l, smem, bid, nb);
        gbar(bar);
    TP(3);
        if (bid < NSCAN) ph_rwscan(p, l, 0, bid, NSCAN, smem);
        else if (!quiet) { ph_mlB(p, wrank, nwork, smem); ph_na(p, l, smem, wrank, nwork); }
        gbar(bar);
    TP(4);
        ph_rwprep(p, l, 1, smem, bid, nb);
        gbar(bar);
    TP(5);
        if (bid < NSCAN) ph_rwscan(p, l, 1, bid, NSCAN, smem);
        else if (!quiet) { ph_mlC(p, l, smem, wrank, nwork); ph_convexp(p, l, smem, wrank, nwork); }
        gbar(bar);
    TP(6);
        ph_rwout(p, l);
        gbar(bar);
    TP(7);
        ph_outproj(p, l, smem);
        gbar(bar);
    TP(8);
        ph_ln1(p, l);
        gbar(bar);
    TP(9);
        ph_router(p, l, smem);
        gbar(bar);
    TP(9);
        ph_route1(p, l, smem);
        gbar(bar);
    TP(9);
        ph_route2(p, l, smem);
        gbar(bar);
    TP(9);
        ph_gateup(p, smem);
        gbar(bar);
    TP(10);
        ph_down(p, smem);
        gbar(bar);
    TP(11);
        ph_ln2(p, l);
        if (l + 1 < NLAYER) ph_convw(p, l + 1, smem);
        gbar(bar);
    TP(12);
    }
#if TPROBE
    if (bid == 0 && threadIdx.x == 0) { const unsigned long long t_end = wall_clock64() + tp_acc; while (wall_clock64() < t_end) __builtin_amdgcn_s_sleep(8); }
    __syncthreads();
    gbar(bar);
#endif
}


extern "C" void kernel_launch(void* const* d_in, const int* in_sizes, int n_in, void* d_out, int out_size, void* d_ws, size_t ws_size,
                              hipStream_t stream) {
    if (n_in != 37 || ws_size < WS_NEED) { fprintf(stderr, "kernel_launch: n_in %d ws %zu need %zu\n", n_in, ws_size, (size_t)WS_NEED); return; }
    static int grid = 0;
    if (!grid) {
        int dev = 0, cus = 0, per_cu = 0;
        (void)hipGetDevice(&dev);
        (void)hipDeviceGetAttribute(&cus, hipDeviceAttributeMultiprocessorCount, dev);
        (void)hipOccupancyMaxActiveBlocksPerMultiprocessor(&per_cu, (const void*)k_mega, 256, 0);
        if (per_cu < 1) per_cu = 1;
        grid = cus * (per_cu < 2 ? per_cu : 2);
    }
    P p{};
    const float** pp = (const float**)&p;
    for (int i = 0; i < 37; ++i) pp[i] = (const float*)d_in[i];
    p.out = (float*)d_out; p.ws = (char*)d_ws;
    (void)hipMemsetAsync(d_ws, 0, CTL_BYTES, stream);
    k_mega<<<dim3(grid), dim3(256), 0, stream>>>(p);
}
```

```cpp
#include <hip/hip_runtime.h>
#include <hip/hip_bf16.h>
#include <stdint.h>
#include <stdio.h>
#include <type_traits>

#define DEVINL __device__ __forceinline__
typedef unsigned short u16;
using bf16x8 = __attribute__((ext_vector_type(8))) short;
using f32x4 = __attribute__((ext_vector_type(4))) float;

constexpr int D = 1024, LAT = 16384, LCTX = 256, T = 33280, CTXROWS = 512;
constexpr int INP = 3536;
constexpr int NLAYER = 2;
constexpr float ALPHA = 1.41421356237309515f;
constexpr int NUNIT_CH = 520;
constexpr int NTC = 260;
constexpr int MAXSLOT = 70656;
constexpr int SMEM_BYTES = 81920;

constexpr size_t al(size_t x) { return (x + 255) & ~(size_t)255; }
constexpr size_t CTL_CNT = 16384;
constexpr size_t CTL_CUR = CTL_CNT + 256;
constexpr size_t CTL_CUKEY = 20480;
constexpr size_t CTL_PROG = 24576;
constexpr size_t CTL_BYTES = 32768;
constexpr size_t OFF_MOD = CTL_BYTES;
constexpr size_t OFF_ROPE = OFF_MOD + al(2 * 3 * 6144 * 4);
constexpr size_t OFF_WR = OFF_ROPE + al(10240 * 4);
constexpr size_t OFF_LORA = OFF_WR + al(2 * 128 * 1024 * 2);
constexpr size_t OFF_TILES = OFF_LORA + al(3 * 65536);
constexpr size_t OFF_TOKE = OFF_TILES + al((64 + 2048) * 4);
constexpr size_t OFF_TOKW = OFF_TOKE + al((size_t)T * 2 * 4);
constexpr size_t OFF_TOKS = OFF_TOKW + al((size_t)T * 2 * 4);
constexpr size_t OFF_SLOTTOK = OFF_TOKS + al((size_t)T * 2 * 4);
constexpr size_t OFF_X2CTX = OFF_SLOTTOK + al((size_t)MAXSLOT * 4);
constexpr size_t OFF_ZST = OFF_X2CTX + al((size_t)512 * 1024 * 4);
constexpr size_t OFF_WIN = OFF_ZST + al((size_t)16 * 4 * 64 * 16 * 4);
constexpr size_t OFF_WOUT = OFF_WIN + al((size_t)3584 * 1024 * 2);
constexpr size_t OFF_X1 = OFF_WOUT + al((size_t)1024 * 1024 * 2);
constexpr size_t OFF_HM = OFF_X1 + al((size_t)T * 1024 * 4);
constexpr size_t OFF_P = OFF_HM + al((size_t)T * 1024 * 2);
constexpr size_t OFF_PQK = OFF_P;
constexpr size_t OFF_VTL = OFF_PQK + (size_t)T * 1024 * 2;
constexpr size_t OFF_VTC = OFF_VTL + (size_t)2 * 8 * 64 * 16384 * 2;
constexpr size_t OFF_PB = OFF_VTC + (size_t)2 * 8 * 64 * 256 * 2;
constexpr size_t OFF_PC = OFF_PB + (size_t)T * 960 * 2;
constexpr size_t OFF_Y = OFF_PC + (size_t)T * 1040 * 2;
constexpr size_t OFF_MLF = OFF_Y + (size_t)T * 1024 * 2;
constexpr size_t OFF_GATE = OFF_MLF + (size_t)T * 512 * 2;
constexpr size_t OFF_MLG = OFF_GATE + (size_t)T * 256 * 2;
constexpr size_t OFF_MLS = OFF_MLG + (size_t)T * 16 * 4;
constexpr size_t OFF_MST = OFF_MLS + al(16 * 260 * 2 * 4);
constexpr size_t OFF_NST = OFF_MST + al(16 * 260 * 4);
constexpr size_t OFF_CST2 = OFF_NST + al(16 * 260 * 64 * 4);
constexpr size_t OFF_NST2 = OFF_CST2 + (size_t)16 * 260 * 4096 * 2;
constexpr size_t OFF_END1 = OFF_NST2 + al(16 * 260 * 64 * 4);
constexpr size_t OFF_WGU = OFF_P;
constexpr size_t OFF_WDN = OFF_WGU + (size_t)32 * 1024 * 1024 * 2;
constexpr size_t OFF_ACT = OFF_WDN + (size_t)32 * 1024 * 512 * 2;
constexpr size_t OFF_SLOTOUT = OFF_ACT + (size_t)MAXSLOT * 512 * 2;
constexpr size_t OFF_LOGITS = OFF_SLOTOUT + (size_t)MAXSLOT * 1024 * 2;
constexpr size_t OFF_END2 = OFF_LOGITS + (size_t)T * 64 * 4;
constexpr size_t WS_NEED = OFF_END1 > OFF_END2 ? OFF_END1 : OFF_END2;
static_assert(OFF_WDN <= OFF_Y, "Wexp must not overlap y");
static_assert(OFF_LOGITS >= OFF_MLF, "logits placement");

struct P {
    const float *x, *c, *ctx, *c_ctx, *w_mod, *b_mod, *w_in, *na_rpb, *mu_prev, *mu_next, *rw_w0, *rw_w2, *rw_a0, *rw_a2,
        *rw_g2, *rw_kk, *rw_ka, *rw_rk, *rw_lnw, *rw_lnb, *ml_cw, *ml_cb, *ml_ib, *ml_fb, *ml_nw, *w_out, *ln1g, *ln1b,
        *rgw, *rgb, *rew, *reb, *egate, *eup, *edown, *ln2g, *ln2b;
    float* out;
    char* ws;
};

#define XB_TMO      128
#define XB_XCNT(j)  (256  + 64 * (j))
#define XB_XSUB(j)  (1280 + 64 * (j))
#define XB_XGEN(j)  (2304 + 64 * (j))
#define XB_TOP      3328
#define XB_TOPGEN   3392
#define XCD_BAR_WORDS 3456
#define XB_SPIN_CAP (1u << 18)
#define LAS __attribute__((address_space(3)))

__device__ __forceinline__ unsigned xb_ld(unsigned* p)              { return __hip_atomic_load(p, __ATOMIC_RELAXED, __HIP_MEMORY_SCOPE_AGENT); }
__device__ __forceinline__ unsigned xb_add(unsigned* p, unsigned v) { return __hip_atomic_fetch_add(p, v, __ATOMIC_RELAXED, __HIP_MEMORY_SCOPE_AGENT); }
__device__ __forceinline__ unsigned xb_xcc_id() { return (unsigned)__builtin_amdgcn_s_getreg((3 << 11) | 20) & 0xFu; }
#define XB_SPIN(cond, bar) do { unsigned _sp = 0; while (cond) { __builtin_amdgcn_s_sleep(1); \
    if ((++_sp & 255u) == 0u) { if (xb_ld(&(bar)[XB_TMO])) break; if (_sp > XB_SPIN_CAP) { atomicAdd(&(bar)[XB_TMO], 1u); break; } } } } while (0)

struct XcdBarrier {
    unsigned* bar; unsigned x;
    volatile LAS unsigned* st;
};

__device__ __forceinline__ XcdBarrier xcd_barrier_post(unsigned* bar, volatile LAS unsigned* st) {
    XcdBarrier b; b.bar = bar; b.x = xb_xcc_id(); b.st = st;
    if (threadIdx.x == 0) (void)xb_add(&bar[XB_XCNT(b.x)], 1u);
    return b;
}
__device__ __forceinline__ void xcd_barrier_complete(unsigned* bar, unsigned x, unsigned& nloc, unsigned& nx) {
    const unsigned G = gridDim.x * gridDim.y * gridDim.z;
    unsigned sum, cnt, mine, sp = 0u;
    for (;;) {
        sum = 0u; cnt = 0u; mine = 0u;
#pragma unroll
        for (unsigned j = 0; j < 16; ++j) { const unsigned c = xb_ld(&bar[XB_XCNT(j)]); sum += c; cnt += (c > 0u) ? 1u : 0u; mine = (j == x) ? c : mine; }
        if (sum == G) break;
        __builtin_amdgcn_s_sleep(1);
        if ((++sp & 255u) == 0u) { if (xb_ld(&bar[XB_TMO])) break; if (sp > XB_SPIN_CAP) { atomicAdd(&bar[XB_TMO], 1u); break; } }
    }
    nloc = mine > 0u ? mine : 1u; nx = cnt > 0u ? cnt : 1u;
}

__device__ __forceinline__ void xcd_barrier(const XcdBarrier& b) {
    asm volatile("s_waitcnt vmcnt(0)" ::: "memory");
    __syncthreads();
    if (threadIdx.x == 0) {
        unsigned* bar = b.bar;
        __builtin_amdgcn_s_waitcnt(0);
        unsigned nloc = b.st[0], nx = b.st[1];
        if (nloc == 0u) { xcd_barrier_complete(bar, b.x, nloc, nx); b.st[0] = nloc; b.st[1] = nx; }
        const unsigned old = xb_add(&bar[XB_XSUB(b.x)], 1u);
        const unsigned gen = old / nloc;
        if (old + 1u == (gen + 1u) * nloc) {
            __builtin_amdgcn_fence(__ATOMIC_RELEASE, "agent");
            asm volatile("s_waitcnt vmcnt(0)" ::: "memory");
            const unsigned og = xb_add(&bar[XB_TOP], 1u);
            const unsigned tg = og / nx;
            if (og + 1u == (tg + 1u) * nx) xb_add(&bar[XB_TOPGEN], 1u);
            else XB_SPIN(xb_ld(&bar[XB_TOPGEN]) == tg, bar);
            __builtin_amdgcn_fence(__ATOMIC_ACQUIRE, "agent");
            xb_add(&bar[XB_XGEN(b.x)], 1u);
            asm volatile("s_waitcnt vmcnt(0)" ::: "memory");
        } else {
            XB_SPIN(xb_ld(&bar[XB_XGEN(b.x)]) == gen, bar);
            __builtin_amdgcn_fence(__ATOMIC_ACQUIRE, "agent");
            asm volatile("s_waitcnt vmcnt(0)" ::: "memory");
        }
    }
    __syncthreads();
}


DEVINL int tid_() { int t = threadIdx.x; asm volatile("" : "+v"(t)); return t; }
DEVINL int bid_() { int b = blockIdx.x; asm volatile("" : "+s"(b)); return b; }
#define GAS __attribute__((address_space(1)))
DEVINL char* wsl_(char* w) { GAS char* g = (GAS char*)w; asm volatile("" : "+s"(g)); return (char*)g; }
template <class Tp> DEVINL const Tp* gl_(const Tp* q) { const GAS Tp* g = (const GAS Tp*)q; asm volatile("" : "+s"(g)); return (const Tp*)g; }
typedef float f32x2_t __attribute__((ext_vector_type(2)));
typedef __bf16 bf16x2_t __attribute__((ext_vector_type(2)));
DEVINL unsigned pk2bf(float lo, float hi) { f32x2_t f = {lo, hi}; bf16x2_t b = __builtin_convertvector(f, bf16x2_t); return __builtin_bit_cast(unsigned, b); }
DEVINL u16 f2bf(float f) { return (u16)(pk2bf(f, f) & 0xFFFFu); }
DEVINL float bf2f(u16 h) { return __uint_as_float(((unsigned)h) << 16); }
DEVINL float wsum(float v) { for (int o = 32; o > 0; o >>= 1) v += __shfl_xor(v, o); return v; }
DEVINL float sigmoidf_(float x) { return 1.f / (1.f + __expf(-x)); }
DEVINL float siluf_(float x) { return x / (1.f + __expf(-x)); }
DEVINL float softplusf_(float x) { return fmaxf(x, 0.f) + log1pf(__expf(-fabsf(x))); }
DEVINL int row_sel(int row) { return row < CTXROWS ? 2 : ((row - CTXROWS) >> 14); }
template <int CTRL, int RM>
DEVINL float dpp_f(float v) { return __int_as_float(__builtin_amdgcn_update_dpp(0, __float_as_int(v), CTRL, RM, 0xF, false)); }
DEVINL float wave_sum_dpp(float v) {
    v += dpp_f<0xB1, 0xF>(v);
    v += dpp_f<0x4E, 0xF>(v);
    v += dpp_f<0x141, 0xF>(v);
    v += dpp_f<0x140, 0xF>(v);
    v += dpp_f<0x142, 0xA>(v);
    v += dpp_f<0x143, 0xC>(v);
    return __int_as_float(__builtin_amdgcn_readlane(__float_as_int(v), 63));
}
DEVINL unsigned lds_addr(const void* p) { return (unsigned)(size_t)(const __attribute__((address_space(3))) char*)p; }
using u32x4 = __attribute__((ext_vector_type(4))) unsigned;
using u32x2 = __attribute__((ext_vector_type(2))) unsigned;
template <int OFF> DEVINL u32x4 lds_rd128(unsigned a) { u32x4 v; asm volatile("ds_read_b128 %0, %1 offset:%2" : "=v"(v) : "v"(a), "n"(OFF)); return v; }
template <int OFF> DEVINL u32x2 lds_rd64(unsigned a) { u32x2 v; asm volatile("ds_read_b64 %0, %1 offset:%2" : "=v"(v) : "v"(a), "n"(OFF)); return v; }
DEVINL void glds4(const void* g, void* l) {
    __builtin_amdgcn_global_load_lds((const __attribute__((address_space(1))) void*)g, (__attribute__((address_space(3))) void*)l, 4, 0, 0);
}
DEVINL void glds16nt(const void* g, void* l) {
    __builtin_amdgcn_global_load_lds((const __attribute__((address_space(1))) void*)g, (__attribute__((address_space(3))) void*)l, 16, 0, 2);
}
DEVINL void glds16(const void* g, void* l) {
    __builtin_amdgcn_global_load_lds((const __attribute__((address_space(1))) void*)g, (__attribute__((address_space(3))) void*)l, 16, 0, 0);
}

template <class RowA>
DEVINL void gemm128_acc(RowA rowA, const u16* __restrict__ Bt, int ldb, int K, char* smem, f32x4 (&acc)[4][4]) {
    const int tid = tid_(), lane = tid & 63, wid = tid >> 6, wr = wid >> 1, wc = wid & 1, fr = lane & 15, fq = lane >> 4;
#pragma unroll
    for (int m = 0; m < 4; ++m)
#pragma unroll
        for (int n = 0; n < 4; ++n) acc[m][n] = f32x4{0.f, 0.f, 0.f, 0.f};
    const int sc = ((tid & 7) ^ ((tid >> 3) & 7)) * 8;
    const u16* aS[4]; const u16* bS[4];
#pragma unroll
    for (int i = 0; i < 4; ++i) { const int r = (tid >> 3) + 32 * i; aS[i] = rowA(r) + sc; bS[i] = Bt + (size_t)r * ldb + sc; }
    const int nt = K >> 6;
    __syncthreads();
#pragma unroll
    for (int i = 0; i < 4; ++i) { glds16(aS[i], smem + (tid + 256 * i) * 16); glds16(bS[i], smem + 16384 + (tid + 256 * i) * 16); }
    for (int t = 0; t < nt; ++t) {
        asm volatile("s_waitcnt vmcnt(0)" ::: "memory");
        __builtin_amdgcn_s_barrier();
        if (t + 1 < nt) {
            char* SA = smem + ((t + 1) & 1) * 32768;
            const int ko = (t + 1) * 64;
#pragma unroll
            for (int i = 0; i < 4; ++i) { glds16(aS[i] + ko, SA + (tid + 256 * i) * 16); glds16(bS[i] + ko, SA + 16384 + (tid + 256 * i) * 16); }
        }
        const char* SA = smem + (t & 1) * 32768; const char* SB = SA + 16384;
#pragma unroll
        for (int ks = 0; ks < 2; ++ks) {
            const int pos = ((ks * 4 + fq) ^ (fr & 7)) * 16;
            bf16x8 af[4], bfr[4];
#pragma unroll
            for (int m = 0; m < 4; ++m) af[m] = *(const bf16x8*)(SA + (wr * 64 + m * 16 + fr) * 128 + pos);
#pragma unroll
            for (int n = 0; n < 4; ++n) bfr[n] = *(const bf16x8*)(SB + (wc * 64 + n * 16 + fr) * 128 + pos);
#pragma unroll
            for (int m = 0; m < 4; ++m)
#pragma unroll
                for (int n = 0; n < 4; ++n) acc[m][n] = __builtin_amdgcn_mfma_f32_16x16x32_bf16(af[m], bfr[n], acc[m][n], 0, 0, 0);
        }
    }
}
template <class RowA, class Epi>
DEVINL void gemm128(RowA rowA, const u16* __restrict__ Bt, int ldb, int K, char* smem, Epi epi) {
    const int tid = tid_(), lane = tid & 63, wid = tid >> 6, wr = wid >> 1, wc = wid & 1, fr = lane & 15, fq = lane >> 4;
    f32x4 acc[4][4];
    gemm128_acc(rowA, Bt, ldb, K, smem, acc);
#pragma unroll
    for (int m = 0; m < 4; ++m)
#pragma unroll
        for (int n = 0; n < 4; ++n) epi(wr * 64 + m * 16 + fq * 4, wc * 64 + n * 16 + fr, acc[m][n]);
}

template <class Emit>
DEVINL void stage_tile_bf16(const f32x4 (&acc)[4][4], char* smem, Emit emit) {
    const int tid = tid_(), lane = tid & 63, wid = tid >> 6, wr = wid >> 1, wc = wid & 1, fr = lane & 15, fq = lane >> 4;
    u16* t = (u16*)smem;
    __syncthreads();
#pragma unroll
    for (int m = 0; m < 4; ++m)
#pragma unroll
        for (int n = 0; n < 4; ++n) {
            const int r0 = wr * 64 + m * 16 + fq * 4, c = wc * 64 + n * 16 + fr;
            const unsigned p01 = pk2bf(acc[m][n][0], acc[m][n][1]), p23 = pk2bf(acc[m][n][2], acc[m][n][3]);
            t[(r0 + 0) * 136 + c] = (u16)(p01 & 0xFFFFu); t[(r0 + 1) * 136 + c] = (u16)(p01 >> 16);
            t[(r0 + 2) * 136 + c] = (u16)(p23 & 0xFFFFu); t[(r0 + 3) * 136 + c] = (u16)(p23 >> 16);
        }
    __syncthreads();
#pragma unroll
    for (int i = 0; i < 8; ++i) {
        const int ci = tid + 256 * i, row = ci >> 4, c8 = (ci & 15) * 8;
        emit(row, c8, *(const uint4*)(t + row * 136 + c8));
    }
}

template <class Emit>
DEVINL void stage_tile_f32(const f32x4 (&acc)[4][4], char* smem, Emit emit) {
    const int tid = tid_(), lane = tid & 63, wid = tid >> 6, wr = wid >> 1, wc = wid & 1, fr = lane & 15, fq = lane >> 4;
    float* t = (float*)smem;
    __syncthreads();
#pragma unroll
    for (int m = 0; m < 4; ++m)
#pragma unroll
        for (int n = 0; n < 4; ++n) {
            const int r0 = wr * 64 + m * 16 + fq * 4, c = wc * 64 + n * 16 + fr;
#pragma unroll
            for (int j = 0; j < 4; ++j) t[(r0 + j) * 132 + c] = acc[m][n][j];
        }
    __syncthreads();
#pragma unroll 4
    for (int i = 0; i < 16; ++i) {
        const int ci = tid + 256 * i, row = ci >> 5, c4 = (ci & 31) * 4;
        emit(row, c4, *(const float4*)(t + row * 132 + c4));
    }
}

DEVINL void ph_prolog(const P& p, char* smem) {
    const int TIDX_ = tid_(); const int BIDX_ = bid_(); char* const WS_ = wsl_(p.ws); (void)TIDX_; (void)BIDX_; (void)WS_;
    const int tid = TIDX_;
    float* modv = (float*)(WS_ + OFF_MOD);
    float* sil = (float*)smem;
    float* red = sil + 3072;
    bool ready = false;
    for (int u = BIDX_; u < 192; u += gridDim.x) {
        if (!ready) {
            for (int i = tid; i < 3072; i += 256) { int v = i >> 10, k = i & 1023; float cv = v < 2 ? p.c[v * 1024 + k] : p.c_ctx[k]; sil[i] = cv / (1.f + expf(-cv)); }
            ready = true;
        }
        __syncthreads();
        const int l = u / 96, cg = u % 96;
        const float* W = p.w_mod + (size_t)l * 1024 * 6144 + cg * 64;
        const int c4 = (tid & 15) * 4, rg = tid >> 4;
        float a0[4] = {0, 0, 0, 0}, a1[4] = {0, 0, 0, 0}, a2[4] = {0, 0, 0, 0};
#pragma unroll 4
        for (int i = 0; i < 64; ++i) {
            const int k = rg + 16 * i;
            const float4 w = *(const float4*)(W + (size_t)k * 6144 + c4);
            const float s0 = sil[k], s1 = sil[1024 + k], s2 = sil[2048 + k];
            a0[0] += s0 * w.x; a0[1] += s0 * w.y; a0[2] += s0 * w.z; a0[3] += s0 * w.w;
            a1[0] += s1 * w.x; a1[1] += s1 * w.y; a1[2] += s1 * w.z; a1[3] += s1 * w.w;
            a2[0] += s2 * w.x; a2[1] += s2 * w.y; a2[2] += s2 * w.z; a2[3] += s2 * w.w;
        }
#pragma unroll
        for (int j = 0; j < 4; ++j) { red[(rg * 3 + 0) * 64 + c4 + j] = a0[j]; red[(rg * 3 + 1) * 64 + c4 + j] = a1[j]; red[(rg * 3 + 2) * 64 + c4 + j] = a2[j]; }
        __syncthreads();
        if (tid < 192) {
            const int v = tid >> 6, cc = tid & 63;
            float s = 0.f;
            for (int r = 0; r < 16; ++r) s += red[(r * 3 + v) * 64 + cc];
            const int col = cg * 64 + cc;
            modv[(l * 3 + v) * 6144 + col] = s + p.b_mod[l * 6144 + col];
        }
        __syncthreads();
    }
    float* rope = (float*)(WS_ + OFF_ROPE);
    for (int i = BIDX_ * 256 + tid; i < 320 * 16; i += gridDim.x * 256) {
        const int pos = (i < 4096) ? (i >> 4) : ((i - 4096) >> 4);
        const int f = i & 15;
        const float inv = powf(10000.0f, -(float)f / 16.0f);
        const float ang = (float)pos * inv;
        const double TWO_PI = 6.283185307179586476925;
        double a = (double)ang;
        a -= TWO_PI * rint(a / TWO_PI);
        const float cr = (float)cos(a), sr = (float)sin(a);
        if (i < 4096) { rope[i] = cr; rope[4096 + i] = sr; }
        else { rope[8192 + (i - 4096)] = cr; rope[8192 + 1024 + (i - 4096)] = sr; }
    }
    {
        u16* w2t = (u16*)(WS_ + OFF_LORA); u16* a2t = w2t + 2 * 2 * 256 * 32; u16* g2t = a2t + 2 * 2 * 256 * 32;
        for (int i = BIDX_ * 256 + tid; i < 2 * 2 * 256 * 32; i += gridDim.x * 256) {
            const int lz = i >> 13, c = (i >> 5) & 255, r = i & 31;
            w2t[i] = f2bf(p.rw_w2[((size_t)lz * 32 + r) * 256 + c]);
            a2t[i] = f2bf(p.rw_a2[((size_t)lz * 32 + r) * 256 + c]);
        }
        for (int i = BIDX_ * 256 + tid; i < 2 * 256 * 64; i += gridDim.x * 256) {
            const int l = i >> 14, c = (i >> 6) & 255, r = i & 63;
            g2t[i] = f2bf(p.rw_g2[((size_t)l * 64 + r) * 256 + c]);
        }
    }
    u16* wr = (u16*)(WS_ + OFF_WR);
    for (int i = BIDX_ * 256 + tid; i < 2 * 128 * 1024; i += gridDim.x * 256) {
        const int l = i >> 17, n = (i >> 10) & 127, k = i & 1023;
        float v = 0.f;
        if (n < 4) v = p.rgw[((size_t)l * 1024 + k) * 4 + n];
        else if (n < 36) v = p.rew[((size_t)l * 1024 + k) * 32 + (n - 4)];
        wr[i] = f2bf(v);
    }
}

DEVINL void conv_tile(const float* __restrict__ src, int N, int K, u16* __restrict__ dst, int k0, int n0, int mode, char* smem) {
    unsigned* t = (unsigned*)smem;
    const int tid = tid_();
    const int n4 = (tid & 15) * 4;
    const bool ok = n0 + n4 < N;
    float4 va[2], vb[2];
    __syncthreads();
#pragma unroll
    for (int i = 0; i < 2; ++i) {
        const int kp = i * 16 + (tid >> 4);
        const float* s0 = src + (size_t)(k0 + 2 * kp) * N + n0 + n4;
        va[i] = ok ? *(const float4*)s0 : make_float4(0.f, 0.f, 0.f, 0.f);
        vb[i] = ok ? *(const float4*)(s0 + N) : make_float4(0.f, 0.f, 0.f, 0.f);
    }
#pragma unroll
    for (int i = 0; i < 2; ++i) {
        const int kp = i * 16 + (tid >> 4);
        t[(n4 + 0) * 33 + kp] = pk2bf(va[i].x, vb[i].x);
        t[(n4 + 1) * 33 + kp] = pk2bf(va[i].y, vb[i].y);
        t[(n4 + 2) * 33 + kp] = pk2bf(va[i].z, vb[i].z);
        t[(n4 + 3) * 33 + kp] = pk2bf(va[i].w, vb[i].w);
    }
    __syncthreads();
    {
        const int n = tid >> 2, w0 = (tid & 3) * 8;
        const int ng = n0 + n;
        int nd = ng;
        if (mode == 1) nd = 32 * (ng >> 4) + (ng & 15);
        else if (mode == 2) nd = 32 * (ng >> 4) + 16 + (ng & 15);
        uint4 o0, o1;
        o0.x = t[n * 33 + w0 + 0]; o0.y = t[n * 33 + w0 + 1]; o0.z = t[n * 33 + w0 + 2]; o0.w = t[n * 33 + w0 + 3];
        o1.x = t[n * 33 + w0 + 4]; o1.y = t[n * 33 + w0 + 5]; o1.z = t[n * 33 + w0 + 6]; o1.w = t[n * 33 + w0 + 7];
        u16* q = dst + (size_t)nd * K + k0 + w0 * 2;
        *(uint4*)q = o0; *(uint4*)(q + 8) = o1;
    }
}
DEVINL void ph_convw(const P& p, int l, char* smem) {
    const int TIDX_ = tid_(); const int BIDX_ = bid_(); char* const WS_ = wsl_(p.ws); (void)TIDX_; (void)BIDX_; (void)WS_;
    u16* win = (u16*)(WS_ + OFF_WIN); u16* wout = (u16*)(WS_ + OFF_WOUT);
    for (int u = BIDX_; u < 896 + 256; u += gridDim.x) {
        if (u < 896) conv_tile(p.w_in + (size_t)l * 1024 * INP, INP, 1024, win, (u / 56) * 64, (u % 56) * 64, 0, smem);
        else { const int v = u - 896; conv_tile(p.w_out + (size_t)l * 1024 * 1024, 1024, 1024, wout, (v / 16) * 64, (v % 16) * 64, 0, smem); }
    }
}
DEVINL void ph_convexp(const P& p, int l, char* smem, int bid, int nb) {
    const int TIDX_ = tid_(); const int BIDX_ = bid_(); char* const WS_ = wsl_(p.ws); (void)TIDX_; (void)BIDX_; (void)WS_;
    u16* wgu = (u16*)(WS_ + OFF_WGU); u16* wdn = (u16*)(WS_ + OFF_WDN);
    for (int u = bid; u < 32 * 384; u += nb) {
        const int e = u / 384, v = u % 384;
        const size_t le = (size_t)l * 32 + e;
        if (v < 128) conv_tile(p.egate + le * 1024 * 512, 512, 1024, wgu + (size_t)e * 1024 * 1024, (v / 8) * 64, (v % 8) * 64, 1, smem);
        else if (v < 256) { const int w = v - 128; conv_tile(p.eup + le * 1024 * 512, 512, 1024, wgu + (size_t)e * 1024 * 1024, (w / 8) * 64, (w % 8) * 64, 2, smem); }
        else { const int w = v - 256; conv_tile(p.edown + le * 512 * 1024, 1024, 512, wdn + (size_t)e * 1024 * 512, (w / 16) * 64, (w % 16) * 64, 0, smem); }
    }
}

DEVINL void ph_xm0(const P& p) {
    const int TIDX_ = tid_(); const int BIDX_ = bid_(); char* const WS_ = wsl_(p.ws); (void)TIDX_; (void)BIDX_; (void)WS_;
    const float* modv = (const float*)(WS_ + OFF_MOD);
    u16* hm = (u16*)(WS_ + OFF_HM);
    for (size_t i = (size_t)BIDX_ * 256 + TIDX_; i < (size_t)T * 256; i += (size_t)gridDim.x * 256) {
        const int row = (int)(i >> 8), c4 = (int)(i & 255) * 4;
        const float* src = row < CTXROWS ? p.ctx + (size_t)row * 1024 : p.x + (size_t)(row - CTXROWS) * 1024;
        const float* mv = modv + row_sel(row) * 6144;
        const float4 v = *(const float4*)(src + c4);
        const float4 sh = *(const float4*)(mv + c4), sc = *(const float4*)(mv + 1024 + c4);
        uint2 o;
        o.x = (unsigned)f2bf(v.x * (1.f + sc.x) + sh.x) | ((unsigned)f2bf(v.y * (1.f + sc.y) + sh.y) << 16);
        o.y = (unsigned)f2bf(v.z * (1.f + sc.z) + sh.z) | ((unsigned)f2bf(v.w * (1.f + sc.w) + sh.w) << 16);
        *(uint2*)(hm + (size_t)row * 1024 + c4) = o;
    }
}

DEVINL void ph_inproj(const P& p, char* smem) {
    const int TIDX_ = tid_(); const int BIDX_ = bid_(); char* const WS_ = wsl_(p.ws); (void)TIDX_; (void)BIDX_; (void)WS_;
    const u16* hm = (const u16*)(WS_ + OFF_HM);
    const u16* win = (const u16*)(WS_ + OFF_WIN);
    u16* pqk = (u16*)(WS_ + OFF_PQK); u16* vtl = (u16*)(WS_ + OFF_VTL); u16* vtc = (u16*)(WS_ + OFF_VTC);
    u16* pb = (u16*)(WS_ + OFF_PB); u16* pc = (u16*)(WS_ + OFF_PC);
    for (int u = BIDX_; u < 260 * 28; u += gridDim.x) {
        const int mt = u / 28, nt = u % 28;
        const u16* A = hm + (size_t)mt * 128 * 1024;
        f32x4 acc[4][4];
        gemm128_acc([&](int r) { return A + (size_t)r * 1024; }, win + (size_t)nt * 128 * 1024, 1024, 1024, smem, acc);
        if (nt >= 8 && nt < 12) {
            const int tid = tid_(), lane = tid & 63, wid = tid >> 6, wr = wid >> 1, wc = wid & 1, fr = lane & 15, fq = lane >> 4;
#pragma unroll
            for (int m = 0; m < 4; ++m)
#pragma unroll
                for (int n = 0; n < 4; ++n) {
                    const int R = mt * 128 + wr * 64 + m * 16 + fq * 4, N = nt * 128 + wc * 64 + n * 16 + fr;
                    const int hh = (N - 1024) >> 6, d = (N - 1024) & 63;
                    uint2 v; v.x = pk2bf(acc[m][n][0], acc[m][n][1]); v.y = pk2bf(acc[m][n][2], acc[m][n][3]);
                    if (R < CTXROWS) { const int b = R >> 8, t = R & 255; *(uint2*)(vtc + ((size_t)((b * 8 + hh) * 64 + d)) * 256 + t) = v; }
                    else { const int R2 = R - CTXROWS, b = R2 >> 14, t = R2 & 16383; *(uint2*)(vtl + ((size_t)((b * 8 + hh) * 64 + d)) * 16384 + t) = v; }
                }
        } else {
            stage_tile_bf16(acc, smem, [&](int row, int c8, uint4 v) {
                const int R = mt * 128 + row, N = nt * 128 + c8;
                if (N >= INP) return;
                if (N < 1024) *(uint4*)(pqk + (size_t)R * 1024 + N) = v;
                else if (N < 2496) *(uint4*)(pb + (size_t)R * 960 + (N - 1536)) = v;
                else *(uint4*)(pc + (size_t)R * 1040 + (N - 2496)) = v;
            });
        }
    }
}

constexpr size_t RWREC = 12288;
constexpr size_t RW_A1 = 0, RW_A4 = 2048, RW_A3 = 4096, RW_MKA = 8192, RW_TT = 8704, RW_MY = 9216, RW_V = 10240;
constexpr size_t OFF_RWOP = OFF_X1;
constexpr size_t OFF_RWWG = OFF_RWOP + (size_t)16 * 520 * RWREC;
constexpr size_t OFF_YRWB = OFF_RWWG + (size_t)16 * 130 * 64 * 4;
constexpr size_t OFF_BONUS = OFF_YRWB + (size_t)T * 256 * 2;
static_assert(OFF_BONUS + (size_t)T * 4 * 4 <= OFF_HM, "rw operand store must fit the X1 region");

DEVINL float rw_mix(const u16* __restrict__ pb, const float* __restrict__ mup, const float* __restrict__ mun, int row, int t, int seqlen, int col) {
    const float cu = bf2f(pb[(size_t)row * 960 + col]);
    const float pr = t > 0 ? bf2f(pb[(size_t)(row - 1) * 960 + col]) : 0.f;
    const float nx = t + 1 < seqlen ? bf2f(pb[(size_t)(row + 1) * 960 + col]) : 0.f;
    return cu + mup[col] * (pr - cu) + mun[col] * (nx - cu);
}

DEVINL void rw_mix8(const u16* __restrict__ pb, const float* __restrict__ mup, const float* __restrict__ mun, int row, int t, int seqlen, int col0, float (&o)[8]) {
    const bool hp = t > 0, hn = t + 1 < seqlen;
    const u32x4 c = *(const u32x4*)(pb + (size_t)row * 960 + col0);
    u32x4 pv = *(const u32x4*)(pb + (size_t)(hp ? row - 1 : row) * 960 + col0);
    u32x4 nx = *(const u32x4*)(pb + (size_t)(hn ? row + 1 : row) * 960 + col0);
    const unsigned mpv = hp ? 0xFFFFFFFFu : 0u, mnx = hn ? 0xFFFFFFFFu : 0u;
    const f32x4 mp0 = *(const f32x4*)(mup + col0), mp1 = *(const f32x4*)(mup + col0 + 4), mn0 = *(const f32x4*)(mun + col0), mn1 = *(const f32x4*)(mun + col0 + 4);
#pragma unroll
    for (int i = 0; i < 4; ++i) {
        const unsigned cw = c[i], pw = pv[i] & mpv, nw = nx[i] & mnx;
        const float c0 = __uint_as_float(cw << 16), c1 = __uint_as_float(cw & 0xFFFF0000u);
        const float p0 = __uint_as_float(pw << 16), p1 = __uint_as_float(pw & 0xFFFF0000u);
        const float n0 = __uint_as_float(nw << 16), n1 = __uint_as_float(nw & 0xFFFF0000u);
        const float ma = (i < 2) ? mp0[2 * i] : mp1[2 * i - 4], mb = (i < 2) ? mp0[2 * i + 1] : mp1[2 * i - 3];
        const float na = (i < 2) ? mn0[2 * i] : mn1[2 * i - 4], nb = (i < 2) ? mn0[2 * i + 1] : mn1[2 * i - 3];
        o[2 * i] = c0 + ma * (p0 - c0) + na * (n0 - c0);
        o[2 * i + 1] = c1 + mb * (p1 - c1) + nb * (n1 - c1);
    }
}
DEVINL uint4 pack8bf(const float (&v)[8]) { return make_uint4(pk2bf(v[0], v[1]), pk2bf(v[2], v[3]), pk2bf(v[4], v[5]), pk2bf(v[6], v[7])); }

DEVINL void ph_rwprep(const P& p, int l, int half, char* smem, int bid, int nb) {
    const int TIDX_ = tid_(); const int BIDX_ = bid_(); char* const WS_ = wsl_(p.ws);
    const int tid = TIDX_, lane = tid & 63, w = tid >> 6, fr = lane & 15, fq = lane >> 4;
    const u16* pb = (const u16*)(WS_ + OFF_PB);
    char* rwop = WS_ + OFF_RWOP;
    float* rwwg = (float*)(WS_ + OFF_RWWG);
    float* bonus = (float*)(WS_ + OFF_BONUS);
    u16* gate = (u16*)(WS_ + OFF_GATE);
    const float* mup = p.mu_prev + l * 960; const float* mun = p.mu_next + l * 960;
    u16* lwdh = (u16*)smem;
    u16* ladh = lwdh + 2048;
    u16* abuf = ladh + 2048;
    float* Lb = (float*)(smem + 16384);
    u16* SV = (u16*)(smem + 32768);
    float* tot = (float*)(smem + 32768);
    const u16* w2t = (const u16*)(WS_ + OFF_LORA);
    const u16* a2t = w2t + 2 * 2 * 256 * 32;
    const u16* g2t = a2t + 2 * 2 * 256 * 32;
    for (int uh = bid; uh < 2 * 2 * 130 * 4; uh += nb) {
        const int h = uh & 3, rest = uh >> 2;
        const int d = rest / 260, b = (rest % 260) / 130, gl = rest % 130;
        const int z = d;
        const int gscan = half * 130 + gl;
        int gi, row0, seqlen;
        if (gscan < 4) { gi = d ? 3 - gscan : gscan; row0 = b * 256 + gi * 64; seqlen = 256; }
        else { gi = d ? 255 - (gscan - 4) : gscan - 4; row0 = CTXROWS + b * LAT + gi * 64; seqlen = LAT; }
        const int t0 = gi * 64;
        __syncthreads();
        {
            const int j = tid >> 2, cq = tid & 3;
            float v[8];
            rw_mix8(pb, mup, mun, row0 + j, t0 + j, seqlen, 768 + z * 32 + 8 * cq, v);
#pragma unroll
            for (int i = 0; i < 8; ++i) v[i] = tanhf(v[i]);
            *(uint4*)(lwdh + j * 32 + 8 * cq) = pack8bf(v);
            rw_mix8(pb, mup, mun, row0 + j, t0 + j, seqlen, 832 + z * 32 + 8 * cq, v);
            *(uint4*)(ladh + j * 32 + 8 * cq) = pack8bf(v);
        }
        if (d == 0) {
            u16* lgd = (u16*)Lb;
            {
                const int j = tid >> 2, cq = tid & 3;
#pragma unroll
                for (int hh = 0; hh < 2; ++hh) {
                    float v[8];
                    rw_mix8(pb, mup, mun, row0 + j, t0 + j, seqlen, 896 + 16 * cq + 8 * hh, v);
#pragma unroll
                    for (int i = 0; i < 8; ++i) v[i] = sigmoidf_(v[i]);
                    *(uint4*)(lgd + j * 64 + 16 * cq + 8 * hh) = pack8bf(v);
                }
            }
            __syncthreads();
            const bf16x8 x0 = *(const bf16x8*)(lgd + (16 * w + fr) * 64 + 8 * fq), x1 = *(const bf16x8*)(lgd + (16 * w + fr) * 64 + 32 + 8 * fq);
#pragma unroll
            for (int nt = 0; nt < 4; ++nt) {
                const u16* bp = g2t + ((size_t)l * 256 + 64 * h + 16 * nt + fr) * 64 + 8 * fq;
                const bf16x8 b0 = *(const bf16x8*)bp, b1 = *(const bf16x8*)(bp + 32);
                f32x4 acc = f32x4{0.f, 0.f, 0.f, 0.f};
                acc = __builtin_amdgcn_mfma_f32_16x16x32_bf16(x0, b0, acc, 0, 0, 0);
                acc = __builtin_amdgcn_mfma_f32_16x16x32_bf16(x1, b1, acc, 0, 0, 0);
#pragma unroll
                for (int r = 0; r < 4; ++r) gate[(size_t)(row0 + 16 * w + 4 * fq + r) * 256 + 64 * h + 16 * nt + fr] = f2bf(acc[r]);
            }
        }
        {
            const int bh = b * 4 + h;
            const int ch = h * 64 + lane;
            __syncthreads();
            {
                const bf16x8 xw = *(const bf16x8*)(lwdh + (16 * w + fr) * 32 + 8 * fq);
                const bf16x8 xa = *(const bf16x8*)(ladh + (16 * w + fr) * 32 + 8 * fq);
#pragma unroll 1
                for (int kt = 0; kt < 4; ++kt) {
                    const int key = 16 * kt + fr;
                    const size_t wrow = ((size_t)(l * 2 + z) * 256 + h * 64 + key) * 32 + 8 * fq;
                    const bf16x8 bw = *(const bf16x8*)(w2t + wrow), ba = *(const bf16x8*)(a2t + wrow);
                    f32x4 ae = f32x4{0.f, 0.f, 0.f, 0.f}, aa = f32x4{0.f, 0.f, 0.f, 0.f};
                    ae = __builtin_amdgcn_mfma_f32_16x16x32_bf16(xw, bw, ae, 0, 0, 0);
                    aa = __builtin_amdgcn_mfma_f32_16x16x32_bf16(xa, ba, aa, 0, 0, 0);
                    const float w0 = p.rw_w0[(l * 2 + z) * 256 + h * 64 + key], a0 = p.rw_a0[(l * 2 + z) * 256 + h * 64 + key];
#pragma unroll
                    for (int r = 0; r < 4; ++r) {
                        const int tok = 16 * w + 4 * fq + r;
                        const int s = d ? 63 - tok : tok;
                        Lb[s * 64 + key] = 0.60653065971263342f * sigmoidf_(ae[r] + w0);
                        abuf[tok * 64 + key] = f2bf(sigmoidf_(aa[r] + a0));
                    }
                }
            }
            __syncthreads();
            {
                float pre[16]; float run = 0.f;
#pragma unroll
                for (int i = 0; i < 16; ++i) { run += Lb[(16 * w + i) * 64 + lane]; pre[i] = run; }
                tot[w * 64 + lane] = run;
                __syncthreads();
                float offs = 0.f;
#pragma unroll
                for (int ww = 0; ww < 3; ++ww) offs += (ww < w) ? tot[ww * 64 + lane] : 0.f;
#pragma unroll
                for (int i = 0; i < 16; ++i) Lb[(16 * w + i) * 64 + lane] = -(offs + pre[i]);
            }
            __syncthreads();
            {
                const int j = tid >> 2, kq = tid & 3, row = row0 + j, tt = t0 + j;
                const int c0 = h * 64 + 16 * kq;
                float kr[16];
                { float t8[8];
                  rw_mix8(pb, mup, mun, row, tt, seqlen, 256 + c0, t8);
#pragma unroll
                  for (int i = 0; i < 8; ++i) kr[i] = t8[i];
                  rw_mix8(pb, mup, mun, row, tt, seqlen, 256 + c0 + 8, t8);
#pragma unroll
                  for (int i = 0; i < 8; ++i) kr[8 + i] = t8[i]; }
                float ss = 0.f;
#pragma unroll
                for (int i = 0; i < 16; ++i) { const float kv = kr[i] * p.rw_kk[l * 256 + c0 + i]; ss += kv * kv; }
                ss += __shfl_xor(ss, 1); ss += __shfl_xor(ss, 2);
                const float inorm = 1.f / fmaxf(sqrtf(ss), 1e-12f);
                const int sidx = d ? 63 - j : j;
                const int cch = sidx >> 4, ts = sidx & 15;
                u16* sv = SV + (size_t)(cch * 4) * 1024 + ts * 64 + 16 * kq;
                float bs = 0.f;
#pragma unroll 1
                for (int hh = 0; hh < 2; ++hh) {
                    const int cb = c0 + 8 * hh;
                    float rr[8], av[8], oa[8], orr[8], ob[8], ok[8];
                    rw_mix8(pb, mup, mun, row, tt, seqlen, cb, rr);
                    { const uint4 a0 = *(const uint4*)(abuf + j * 64 + 16 * kq + 8 * hh);
                      const unsigned aw[4] = {a0.x, a0.y, a0.z, a0.w};
#pragma unroll
                      for (int i = 0; i < 4; ++i) { av[2 * i] = __uint_as_float(aw[i] << 16); av[2 * i + 1] = __uint_as_float(aw[i] & 0xFFFF0000u); } }
#pragma unroll
                    for (int i4 = 0; i4 < 2; ++i4) {
                        const float4 Lt4 = *(const float4*)(Lb + sidx * 64 + 16 * kq + 8 * hh + 4 * i4);
                        const float4 Lp4 = sidx > 0 ? *(const float4*)(Lb + (sidx - 1) * 64 + 16 * kq + 8 * hh + 4 * i4) : make_float4(0.f, 0.f, 0.f, 0.f);
                        const float Lt[4] = {Lt4.x, Lt4.y, Lt4.z, Lt4.w}, Lp[4] = {Lp4.x, Lp4.y, Lp4.z, Lp4.w};
#pragma unroll
                        for (int ii = 0; ii < 4; ++ii) {
                            const int i = 4 * i4 + ii;
                            const float kraw = hh ? kr[8 + i] : kr[i];
                            const float kkn = kraw * p.rw_kk[l * 256 + cb + i] * inorm, a = av[i];
                            const float et = __expf(Lt[ii]), einv = __builtin_amdgcn_rcpf(et);
                            oa[i] = -kkn * __expf(Lp[ii]);
                            orr[i] = rr[i] * et;
                            ob[i] = kkn * a * einv;
                            ok[i] = kraw * (1.f + (a - 1.f) * p.rw_ka[l * 256 + cb + i]) * einv;
                            bs += rr[i] * kraw * p.rw_rk[l * 256 + cb + i];
                            if (sidx == 63) rwwg[((size_t)(d * 8 + bh) * 130 + gl) * 64 + 16 * kq + 8 * hh + i] = et;
                        }
                    }
                    *(uint4*)(sv + 8 * hh) = pack8bf(oa);
                    *(uint4*)(sv + 1024 + 8 * hh) = pack8bf(orr);
                    *(uint4*)(sv + 2048 + 8 * hh) = pack8bf(ob);
                    *(uint4*)(sv + 3072 + 8 * hh) = pack8bf(ok);
                    rw_mix8(pb, mup, mun, row, tt, seqlen, 512 + cb, rr);
                    *(uint4*)(abuf + j * 64 + 16 * kq + 8 * hh) = pack8bf(rr);
                }
                if (d == 0) { bs += __shfl_xor(bs, 1); bs += __shfl_xor(bs, 2); if (kq == 0) bonus[(size_t)row * 4 + h] = bs; }
            }
            __syncthreads();
            {
                char* rec = rwop + ((size_t)(d * 8 + bh) * 520 + (size_t)gl * 4 + w) * RWREC;
                const u16* Av = SV + (size_t)(w * 4) * 1024; const u16* Rv = Av + 1024; const u16* Bv = Av + 2048; const u16* Kv = Av + 3072;
                bf16x8 fa[2], frr[2], fb[2], fk[2];
#pragma unroll
                for (int ks = 0; ks < 2; ++ks) {
                    fa[ks] = *(const bf16x8*)(Av + fr * 64 + ks * 32 + fq * 8);
                    frr[ks] = *(const bf16x8*)(Rv + fr * 64 + ks * 32 + fq * 8);
                    fb[ks] = *(const bf16x8*)(Bv + fr * 64 + ks * 32 + fq * 8);
                    fk[ks] = *(const bf16x8*)(Kv + fr * 64 + ks * 32 + fq * 8);
                }
                f32x4 mka = f32x4{0.f, 0.f, 0.f, 0.f}, mba = mka, mkr = mka, mbr = mka;
#pragma unroll
                for (int ks = 0; ks < 2; ++ks) {
                    mka = __builtin_amdgcn_mfma_f32_16x16x32_bf16(fa[ks], fk[ks], mka, 0, 0, 0);
                    mba = __builtin_amdgcn_mfma_f32_16x16x32_bf16(fa[ks], fb[ks], mba, 0, 0, 0);
                    mkr = __builtin_amdgcn_mfma_f32_16x16x32_bf16(frr[ks], fk[ks], mkr, 0, 0, 0);
                    mbr = __builtin_amdgcn_mfma_f32_16x16x32_bf16(frr[ks], fb[ks], mbr, 0, 0, 0);
                }
                float* Ns = Lb + w * 256;
                float* Ts = Lb + 1024 + w * 256;
                u16* rmka = (u16*)(rec + RW_MKA); u16* rmy = (u16*)(rec + RW_MY);
                const int i_ = fr;
#pragma unroll
                for (int r = 0; r < 4; ++r) {
                    const int t_ = 4 * fq + r;
                    const int lp = (i_ >> 2) * 16 + t_;
                    mka[r] = i_ < t_ ? mka[r] : 0.f;
                    rmy[lp * 8 + (i_ & 3)] = f2bf(i_ <= t_ ? mbr[r] : 0.f);
                    rmy[lp * 8 + 4 + (i_ & 3)] = f2bf(i_ <= t_ ? mkr[r] : 0.f);
                    Ns[t_ * 16 + i_] = i_ < t_ ? mba[r] : 0.f;
                }
                if (lane < 16) {
                    float Tr[16];
#pragma unroll
                    for (int ii = 0; ii < 16; ++ii) Tr[ii] = 0.f;
#pragma unroll 1
                    for (int t_ = 0; t_ < 16; ++t_) {
                        float acc = (lane == t_) ? 1.f : 0.f;
#pragma unroll
                        for (int i4 = 0; i4 < 4; ++i4) {
                            const float4 nv = *(const float4*)(Ns + t_ * 16 + 4 * i4);
                            acc += Tr[4 * i4] * nv.x + Tr[4 * i4 + 1] * nv.y + Tr[4 * i4 + 2] * nv.z + Tr[4 * i4 + 3] * nv.w;
                        }
#pragma unroll
                        for (int ii = 0; ii < 16; ++ii) Tr[ii] = (ii == t_) ? acc : Tr[ii];
                        Ts[lane * 16 + t_] = acc;
                    }
                }
                bf16x8 TTf;
                {
                    const float t0v = Ts[(4 * fq + 0) * 16 + fr], t1v = Ts[(4 * fq + 1) * 16 + fr], t2v = Ts[(4 * fq + 2) * 16 + fr], t3v = Ts[(4 * fq + 3) * 16 + fr];
                    union { u32x4 u; bf16x8 f; } x; x.u = u32x4{pk2bf(t0v, t1v), pk2bf(t2v, t3v), 0u, 0u}; TTf = x.f;
                }
                {
                    union { u32x4 u; bf16x8 f; } mb; mb.u = u32x4{pk2bf(mka[0], mka[1]), pk2bf(mka[2], mka[3]), 0u, 0u};
                    f32x4 mk2 = f32x4{0.f, 0.f, 0.f, 0.f};
                    mk2 = __builtin_amdgcn_mfma_f32_16x16x32_bf16(TTf, mb.f, mk2, 0, 0, 0);
#pragma unroll
                    for (int r = 0; r < 4; ++r) { const int t_ = 4 * fq + r; rmka[((i_ >> 2) * 16 + t_) * 4 + (i_ & 3)] = f2bf(mk2[r]); }
                }
                {
                    f32x4 ap[4];
#pragma unroll
                    for (int m = 0; m < 4; ++m) {
                        union { u32x4 u; bf16x8 f; } ag;
                        ag.u = u32x4{(unsigned)Av[(4 * fq + 0) * 64 + 16 * m + fr] | ((unsigned)Av[(4 * fq + 1) * 64 + 16 * m + fr] << 16),
                                     (unsigned)Av[(4 * fq + 2) * 64 + 16 * m + fr] | ((unsigned)Av[(4 * fq + 3) * 64 + 16 * m + fr] << 16), 0u, 0u};
                        ap[m] = f32x4{0.f, 0.f, 0.f, 0.f};
                        ap[m] = __builtin_amdgcn_mfma_f32_16x16x32_bf16(ag.f, TTf, ap[m], 0, 0, 0);
                    }
#pragma unroll
                    for (int ks = 0; ks < 2; ++ks) {
                        uint4 o;
                        o.x = pk2bf(ap[2 * ks][0], ap[2 * ks][1]); o.y = pk2bf(ap[2 * ks][2], ap[2 * ks][3]);
                        o.z = pk2bf(ap[2 * ks + 1][0], ap[2 * ks + 1][1]); o.w = pk2bf(ap[2 * ks + 1][2], ap[2 * ks + 1][3]);
                        *(uint4*)(rec + RW_A1 + (ks * 64 + lane) * 16) = o;
                    }
                }
#pragma unroll
                for (int ks = 0; ks < 2; ++ks) {
                    uint4 o;
                    const uint2 lo2 = *(const uint2*)(Rv + fr * 64 + 32 * ks + 4 * fq), hi2 = *(const uint2*)(Rv + fr * 64 + 32 * ks + 16 + 4 * fq);
                    o.x = lo2.x; o.y = lo2.y; o.z = hi2.x; o.w = hi2.y;
                    *(uint4*)(rec + RW_A4 + (ks * 64 + lane) * 16) = o;
                }
#pragma unroll
                for (int m = 0; m < 4; ++m) {
                    unsigned e[8];
#pragma unroll
                    for (int j = 0; j < 4; ++j) { e[j] = Bv[(4 * fq + j) * 64 + 16 * m + fr]; e[4 + j] = Kv[(4 * fq + j) * 64 + 16 * m + fr]; }
                    uint4 o; o.x = e[0] | (e[1] << 16); o.y = e[2] | (e[3] << 16); o.z = e[4] | (e[5] << 16); o.w = e[6] | (e[7] << 16);
                    *(uint4*)(rec + RW_A3 + (m * 64 + lane) * 16) = o;
                }
#pragma unroll
                for (int q = 0; q < 4; ++q) {
                    unsigned e[4];
#pragma unroll
                    for (int j = 0; j < 4; ++j) {
                        const int s = 16 * w + 4 * fq + j; const int jt = d ? 63 - s : s;
                        e[j] = abuf[jt * 64 + 16 * q + fr];
                    }
                    uint2 o; o.x = e[0] | (e[1] << 16); o.y = e[2] | (e[3] << 16);
                    *(uint2*)(rec + RW_V + (q * 64 + lane) * 8) = o;
                }
            }
        }
    }
}

constexpr int RWSLOT = 12544;
DEVINL void ph_rwscan(const P& p, int l, int half, int bid, int nb, char* smem) {
    const int TIDX_ = tid_(); char* const WS_ = wsl_(p.ws);
    const int tid = TIDX_, lane = tid & 63, q = tid >> 6, fr = lane & 15, fq = lane >> 4;
    const char* rwop = WS_ + OFF_RWOP;
    const float* rwwg = (const float*)(WS_ + OFF_RWWG);
    u16* yf = (u16*)(WS_ + OFF_Y);
    u16* yb = (u16*)(WS_ + OFF_YRWB);
    (void)l;
    float* zst = (float*)(WS_ + OFF_ZST);
    for (int dbh = bid; dbh < 16; dbh += nb) {
        const int d = dbh >> 3, bh = dbh & 7, b = bh >> 2, h = bh & 3;
        f32x4 z[4];
        float* zp = zst + ((size_t)(dbh * 4 + q) * 64 + lane) * 16;
#pragma unroll
        for (int m = 0; m < 4; ++m) {
            if (half == 0) z[m] = f32x4{0.f, 0.f, 0.f, 0.f};
            else { const float4 t4 = *(const float4*)(zp + 4 * m); z[m] = f32x4{t4.x, t4.y, t4.z, t4.w}; }
        }
        const int cbase = half * 520;
        const char* rec0 = rwop + (size_t)dbh * 520 * RWREC;
        const float* wg0 = rwwg + (size_t)dbh * 130 * 64;
        constexpr int RD = 6;
        u32x4 rb[RD][3]; float rwgA = 0.f, rwgB = 0.f;
        auto ldrec = [&](int c, auto I) {
            constexpr int i = decltype(I)::value;
            const int cc = c < 520 ? c : 519;
            const char* rec = rec0 + (size_t)cc * RWREC;
#pragma unroll
            for (int k = 0; k < 3; ++k) rb[i][k] = *(const u32x4*)(rec + (tid + 256 * k) * 16);
        };
        auto strec = [&](auto I, int slotidx) {
            constexpr int i = decltype(I)::value;
            char* slot = smem + slotidx * RWSLOT;
#pragma unroll
            for (int k = 0; k < 3; ++k) *(u32x4*)(slot + (tid + 256 * k) * 16) = rb[i][k];
        };
        auto asfrag = [](uint4 v) { union { uint4 u; bf16x8 f; } x; x.u = v; return x.f; };
        auto pack2 = [](float lo, float hi) { return pk2bf(lo, hi); };
        const unsigned b128 = lds_addr(smem) + lane * 16, b64 = lds_addr(smem) + lane * 8, bv = lds_addr(smem) + (q * 64 + lane) * 8, bg = lds_addr(smem) + 16 * fq;
        __syncthreads();
        __builtin_amdgcn_s_setprio(3);
#define IC(n) std::integral_constant<int, n>{}
        auto flush_y = [&](int cprev, int par) {
            if (tid < 128) {
                const int cg = cbase + cprev;
                const bool isctx = cg < 16;
                const int cc = isctx ? cg : cg - 16;
                const int n = isctx ? LCTX : LAT;
                const int rowbase = isctx ? b * LCTX : CTXROWS + b * LAT;
                const int ts = tid >> 3, c8 = (tid & 7) * 8;
                const int sidx = cc * 16 + ts;
                const int t = d ? n - 1 - sidx : sidx;
                const u32x4 v = *(const u32x4*)(smem + 4 * RWSLOT + par * 2048 + (ts * 64 + c8) * 2);
                u16* dst = d == 0 ? yf + (size_t)(rowbase + t) * 1024 + 512 + h * 64 + c8 : yb + (size_t)(rowbase + t) * 256 + h * 64 + c8;
                *(u32x4*)dst = v;
            }
        };
        u32x4 f4[2][6]; u32x2 f2[2][2];
#define RD_ISSUE(par, SBC) asm volatile( \
                "ds_read_b64 %6, %9 offset:%11+8192\n\t" \
                "ds_read_b64 %7, %10 offset:%11+10240\n\t" \
                "ds_read_b128 %0, %8 offset:%11+0\n\t" \
                "ds_read_b128 %1, %8 offset:%11+1024\n\t" \
                "ds_read_b128 %2, %8 offset:%11+4096\n\t" \
                "ds_read_b128 %3, %8 offset:%11+5120\n\t" \
                "ds_read_b128 %4, %8 offset:%11+6144\n\t" \
                "ds_read_b128 %5, %8 offset:%11+7168" \
                : "=&v"(f4[par][0]), "=&v"(f4[par][1]), "=&v"(f4[par][2]), "=&v"(f4[par][3]), "=&v"(f4[par][4]), "=&v"(f4[par][5]), \
                  "=&v"(f2[par][0]), "=&v"(f2[par][1]) \
                : "v"(b128), "v"(b64), "v"(bv), "n"(SBC) \
                : "memory")
#define RD_WAIT(par) asm volatile("s_waitcnt lgkmcnt(0)" \
                : "+v"(f4[par][0]), "+v"(f4[par][1]), "+v"(f4[par][2]), "+v"(f4[par][3]), "+v"(f4[par][4]), "+v"(f4[par][5]), \
                  "+v"(f2[par][0]), "+v"(f2[par][1]) \
                :: "memory")
        ldrec(0, IC(0)); ldrec(1, IC(1)); ldrec(2, IC(2)); ldrec(3, IC(3)); ldrec(4, IC(4)); ldrec(5, IC(5));
        strec(IC(0), 0); ldrec(RD, IC(0));
        strec(IC(1), 1); ldrec(RD + 1, IC(1));
        rwgA = wg0[lane]; rwgB = wg0[64 + lane];
        asm volatile("s_waitcnt lgkmcnt(0)" ::: "memory");
        __builtin_amdgcn_s_barrier();
        RD_ISSUE(0, 0); RD_WAIT(0);
#pragma unroll 1
        for (int c5 = 0; c5 < 528; c5 += 12) {
          auto body = [&](auto SJ) {
            constexpr int sj = decltype(SJ)::value;
            constexpr int par = sj & 1;
            const int c = c5 + sj;
            asm volatile("s_waitcnt lgkmcnt(0)" ::: "memory");
            __builtin_amdgcn_s_barrier();
            RD_ISSUE(par ^ 1, ((sj + 1) % 4) * RWSLOT);
            if (c > 0 && c <= 520) flush_y(c - 1, par ^ 1);
            strec(IC((sj + 2) % 6), (sj + 2) % 4);
            ldrec(c + 2 + RD, IC((sj + 2) % 6));
            if ((sj & 3) == 1) {
                const bool even = (((c >> 2) & 1) == 0);
                if (q == 0) *(float*)(smem + ((sj + 2) % 4) * RWSLOT + 12288 + lane * 4) = even ? rwgA : rwgB;
                const int gn = (c >> 2) + 2;
                const float nv = wg0[(size_t)(gn < 130 ? gn : 129) * 64 + lane];
                if (even) rwgA = nv; else rwgB = nv;
            }
            if (c < 520) {
            constexpr int SB = (sj % 4) * RWSLOT;
            auto asfrag4 = [](u32x4 v) { union { u32x4 u; bf16x8 f; } x; x.u = v; return x.f; };
            const bf16x8 A1_0 = asfrag4(f4[par][0]), A1_1 = asfrag4(f4[par][1]);
            const bf16x8 A3_0 = asfrag4(f4[par][2]), A3_1 = asfrag4(f4[par][3]), A3_2 = asfrag4(f4[par][4]), A3_3 = asfrag4(f4[par][5]);
            const u32x2 mka = f2[par][0], vcur = f2[par][1];
            const bf16x8 MKA = asfrag(make_uint4(mka.x, mka.y, 0u, 0u));
            const bf16x8 VB = asfrag(make_uint4(vcur.x, vcur.y, 0u, 0u));
            const bf16x8 ZB0 = asfrag(make_uint4(pack2(z[0][0], z[0][1]), pack2(z[0][2], z[0][3]), pack2(z[1][0], z[1][1]), pack2(z[1][2], z[1][3])));
            const bf16x8 ZB1 = asfrag(make_uint4(pack2(z[2][0], z[2][1]), pack2(z[2][2], z[2][3]), pack2(z[3][0], z[3][1]), pack2(z[3][2], z[3][3])));
            f32x4 Ua = f32x4{0.f, 0.f, 0.f, 0.f}, Ub = f32x4{0.f, 0.f, 0.f, 0.f};
            Ua = __builtin_amdgcn_mfma_f32_16x16x32_bf16(MKA, VB, Ua, 0, 0, 0);
            Ub = __builtin_amdgcn_mfma_f32_16x16x32_bf16(A1_1, ZB1, Ub, 0, 0, 0);
            Ua = __builtin_amdgcn_mfma_f32_16x16x32_bf16(A1_0, ZB0, Ua, 0, 0, 0);
            u32x4 r_a40, r_a41, r_my;
            asm volatile(
                "ds_read_b128 %0, %3 offset:%4+2048\n\t"
                "ds_read_b128 %1, %3 offset:%4+3072\n\t"
                "ds_read_b128 %2, %3 offset:%4+9216\n\t"
                "s_waitcnt lgkmcnt(0)"
                : "=&v"(r_a40), "=&v"(r_a41), "=&v"(r_my) : "v"(b128), "n"(SB) : "memory");
            const bf16x8 A4_0 = asfrag4(r_a40), A4_1 = asfrag4(r_a41), MY = asfrag4(r_my);
            f32x4 Y = f32x4{0.f, 0.f, 0.f, 0.f};
            Y = __builtin_amdgcn_mfma_f32_16x16x32_bf16(A4_0, ZB0, Y, 0, 0, 0);
            Y = __builtin_amdgcn_mfma_f32_16x16x32_bf16(A4_1, ZB1, Y, 0, 0, 0);
            const f32x4 U = Ua + Ub;
            const bf16x8 UV = asfrag(make_uint4(pack2(U[0], U[1]), pack2(U[2], U[3]), vcur.x, vcur.y));
            z[0] = __builtin_amdgcn_mfma_f32_16x16x32_bf16(A3_0, UV, z[0], 0, 0, 0);
            z[1] = __builtin_amdgcn_mfma_f32_16x16x32_bf16(A3_1, UV, z[1], 0, 0, 0);
            z[2] = __builtin_amdgcn_mfma_f32_16x16x32_bf16(A3_2, UV, z[2], 0, 0, 0);
            z[3] = __builtin_amdgcn_mfma_f32_16x16x32_bf16(A3_3, UV, z[3], 0, 0, 0);
            Y = __builtin_amdgcn_mfma_f32_16x16x32_bf16(MY, UV, Y, 0, 0, 0);
            asm volatile("s_waitcnt lgkmcnt(0)" ::: "memory");
            if ((c & 3) == 3) {
                u32x4 g0, g1, g2, g3;
                asm volatile(
                    "ds_read_b128 %0, %4 offset:%5+12288\n\t"
                    "ds_read_b128 %1, %4 offset:%5+12352\n\t"
                    "ds_read_b128 %2, %4 offset:%5+12416\n\t"
                    "ds_read_b128 %3, %4 offset:%5+12480\n\t"
                    "s_waitcnt lgkmcnt(0)"
                    : "=&v"(g0), "=&v"(g1), "=&v"(g2), "=&v"(g3) : "v"(bg), "n"(SB) : "memory");
                z[0][0] *= __uint_as_float(g0.x); z[0][1] *= __uint_as_float(g0.y); z[0][2] *= __uint_as_float(g0.z); z[0][3] *= __uint_as_float(g0.w);
                z[1][0] *= __uint_as_float(g1.x); z[1][1] *= __uint_as_float(g1.y); z[1][2] *= __uint_as_float(g1.z); z[1][3] *= __uint_as_float(g1.w);
                z[2][0] *= __uint_as_float(g2.x); z[2][1] *= __uint_as_float(g2.y); z[2][2] *= __uint_as_float(g2.z); z[2][3] *= __uint_as_float(g2.w);
                z[3][0] *= __uint_as_float(g3.x); z[3][1] *= __uint_as_float(g3.y); z[3][2] *= __uint_as_float(g3.z); z[3][3] *= __uint_as_float(g3.w);
            }
            {
                u16* yl = (u16*)(smem + 4 * RWSLOT + par * 2048);
                const unsigned y01 = pk2bf(Y[0], Y[1]), y23 = pk2bf(Y[2], Y[3]);
                yl[(4 * fq + 0) * 64 + 16 * q + fr] = (u16)(y01 & 0xFFFFu);
                yl[(4 * fq + 1) * 64 + 16 * q + fr] = (u16)(y01 >> 16);
                yl[(4 * fq + 2) * 64 + 16 * q + fr] = (u16)(y23 & 0xFFFFu);
                yl[(4 * fq + 3) * 64 + 16 * q + fr] = (u16)(y23 >> 16);
            }
            }
            RD_WAIT(par ^ 1);
          };
          body(IC(0)); body(IC(1)); body(IC(2)); body(IC(3)); body(IC(4)); body(IC(5)); body(IC(6)); body(IC(7)); body(IC(8)); body(IC(9)); body(IC(10)); body(IC(11));
        }
#pragma unroll
        for (int m = 0; m < 4; ++m) *(float4*)(zp + 4 * m) = make_float4(z[m][0], z[m][1], z[m][2], z[m][3]);
        asm volatile("s_waitcnt vmcnt(0)" ::: "memory");
        __builtin_amdgcn_s_setprio(0);
        __syncthreads();
    }
}

DEVINL void ph_rwout(const P& p, int l) {
    const int TIDX_ = tid_(); const int BIDX_ = bid_(); char* const WS_ = wsl_(p.ws);
    const int tid = TIDX_, h = tid >> 6;
    const u16* pb = (const u16*)(WS_ + OFF_PB);
    const u16* yb = (const u16*)(WS_ + OFF_YRWB);
    const u16* gate = (const u16*)(WS_ + OFF_GATE);
    const float* bonus = (const float*)(WS_ + OFF_BONUS);
    u16* y = (u16*)(WS_ + OFF_Y);
    const float* mup = p.mu_prev + l * 960; const float* mun = p.mu_next + l * 960;
    const float lw = p.rw_lnw[l * 256 + tid], lb = p.rw_lnb[l * 256 + tid];
    const int rstart = (l == 0) ? 0 : CTXROWS;
    for (int row = rstart + BIDX_; row < T; row += gridDim.x) {
        int t, seqlen;
        if (row < CTXROWS) { t = row & 255; seqlen = LCTX; } else { t = (row - CTXROWS) & (LAT - 1); seqlen = LAT; }
        const float yv = bf2f(y[(size_t)row * 1024 + 512 + tid]) + bf2f(yb[(size_t)row * 256 + tid]);
        const float v = rw_mix(pb, mup, mun, row, t, seqlen, 512 + tid);
        const float mu = wsum(yv) * (1.f / 64.f);
        const float dl = yv - mu;
        const float var = wsum(dl * dl) * (1.f / 64.f);
        const float o = (dl * rsqrtf(var + 64e-5f) * lw + lb + bonus[(size_t)row * 4 + h] * v) * bf2f(gate[(size_t)row * 256 + tid]);
        y[(size_t)row * 1024 + 512 + tid] = f2bf(o);
    }
}
DEVINL void ph_prepM(const P& p, int l, char* smem, int bid, int nb) {
    const int TIDX_ = tid_(); const int BIDX_ = bid_(); char* const WS_ = wsl_(p.ws);
    const int tid = TIDX_, lane = tid & 63, wid = tid >> 6;
    const u16* pc = (const u16*)(WS_ + OFF_PC);
    u16* mlf = (u16*)(WS_ + OFF_MLF);
    float* mlg = (float*)(WS_ + OFF_MLG);
    float* mls = (float*)(WS_ + OFF_MLS);
    float* nst = (float*)(WS_ + OFF_NST);
    float* cst = (float*)(WS_ + OFF_HM);
    const float* rope = (const float*)(WS_ + OFF_ROPE);
    u16* kT = (u16*)smem;
    u16* vT = kT + 64 * 72;
    float* wsl = (float*)(vT + 64 * 72);
    float* lil = wsl + 128;
    for (int uh = bid; uh < NUNIT_CH * 4; uh += nb) {
        const int u = uh >> 2, h = uh & 3;
        int b, ch, row0, seqlen; bool isctx;
        if (u < 8) { isctx = true; b = u >> 2; ch = u & 3; row0 = b * 256 + ch * 64; seqlen = 256; }
        else { isctx = false; b = (u - 8) >> 8; ch = (u - 8) & 255; row0 = CTXROWS + b * LAT + ch * 64; seqlen = LAT; }
        const int t0 = ch * 64;
        const int tc = isctx ? ch : 4 + ch;
        __syncthreads();
        {
            const bool isk = wid >= 2;
            const int cch = (isk ? 256 : 0) + h * 64 + lane;
            const float* cw = p.ml_cw + (size_t)l * 3 * 512;
            const float w0 = cw[cch], w1 = cw[512 + cch], w2 = cw[1024 + cch], bb = p.ml_cb[l * 512 + cch];
            const int jb = (wid & 1) * 32;
            const int i16 = lane & 15; const bool second = (lane & 16) != 0; const int half = lane >> 5;
            float pv = (t0 + jb > 0) ? bf2f(pc[(size_t)(row0 + jb - 1) * 1040 + cch]) : 0.f;
            float cv = bf2f(pc[(size_t)(row0 + jb) * 1040 + cch]);
#pragma unroll 4
            for (int jj = 0; jj < 32; ++jj) {
                const int j = jb + jj;
                const float nv = (t0 + j + 1 < seqlen) ? bf2f(pc[(size_t)(row0 + j + 1) * 1040 + cch]) : 0.f;
                float val = siluf_(w0 * pv + w1 * cv + w2 * nv + bb);
                if (!isctx) {
                    const int t = t0 + j;
                    const int pos = half == 0 ? (t >> 6) : (t & 63);
                    const float cs = half == 0 ? rope[pos * 16 + i16] : rope[8192 + pos * 16 + i16];
                    const float sn = half == 0 ? rope[4096 + pos * 16 + i16] : rope[9216 + pos * 16 + i16];
                    const float ov = __shfl_xor(val, 16);
                    val = second ? (ov * sn + val * cs) : (val * cs - ov * sn);
                }
                if (isk) { const u16 kb = f2bf(val * 0.125f); mlf[(size_t)(row0 + j) * 512 + 256 + h * 64 + lane] = kb; kT[lane * 72 + j] = kb; }
                else mlf[(size_t)(row0 + j) * 512 + h * 64 + lane] = f2bf(val);
                pv = cv; cv = nv;
            }
            {
                const int j = tid >> 2, wh = tid & 3;
                const int idx = (wh < 2) ? (wh * 4 + h) : (8 + (wh - 2) * 4 + h);
                const float g = bf2f(pc[(size_t)(row0 + j) * 1040 + 1024 + idx]);
                float v;
                if (wh < 2) v = g + p.ml_ib[l * 8 + idx];
                else { const float xx = g + p.ml_fb[l * 8 + idx - 8]; v = fminf(xx, 0.f) - log1pf(__expf(-fabsf(xx))); }
                lil[j * 4 + wh] = v;
                if (wh < 2) mlg[(size_t)(row0 + j) * 16 + idx] = v;
            }
            for (int i = tid; i < 64 * 8; i += 256) {
                const int tok = i >> 3, d8 = (i & 7) * 8;
                const uint4 vv = *(const uint4*)(pc + (size_t)(row0 + tok) * 1040 + 512 + h * 64 + d8);
                const unsigned wv[4] = {vv.x, vv.y, vv.z, vv.w};
#pragma unroll
                for (int k = 0; k < 4; ++k) { vT[(d8 + 2 * k) * 72 + tok] = (u16)(wv[k] & 0xFFFFu); vT[(d8 + 2 * k + 1) * 72 + tok] = (u16)(wv[k] >> 16); }
            }
        }
        __syncthreads();
        if (wid < 2) {
            const int d = wid, tok = d ? 63 - lane : lane;
            float bsum = lil[tok * 4 + 2 + d];
#pragma unroll
            for (int off = 1; off < 64; off <<= 1) { const float o = __shfl_up(bsum, off); if (lane >= off) bsum += o; }
            const float Bs = __shfl(bsum, 63);
            const float gl = Bs - bsum + lil[tok * 4 + d];
            float G = gl;
#pragma unroll
            for (int off = 32; off > 0; off >>= 1) G = fmaxf(G, __shfl_xor(G, off));
            wsl[d * 64 + tok] = __expf(gl - G);
            mlg[(size_t)(row0 + tok) * 16 + 8 + d * 4 + h] = bsum;
            if (lane == 0) { const int bhd = (b * 4 + h) * 2 + d; mls[(bhd * NTC + tc) * 2 + 0] = G; mls[(bhd * NTC + tc) * 2 + 1] = Bs; }
        }
        __syncthreads();
        {
            const int fr = lane & 15, g = lane >> 4;
            const int bh0 = ((b * 4 + h) * 2 + 0) * NTC + tc, bh1 = ((b * 4 + h) * 2 + 1) * NTC + tc;
            bf16x8 va[2];
            va[0] = *(const bf16x8*)(vT + (16 * wid + fr) * 72 + 8 * g);
            va[1] = *(const bf16x8*)(vT + (16 * wid + fr) * 72 + 32 + 8 * g);
#pragma unroll 1
            for (int dkt = 0; dkt < 4; ++dkt) {
                f32x4 u0 = f32x4{0.f, 0.f, 0.f, 0.f}, u1 = f32x4{0.f, 0.f, 0.f, 0.f};
#pragma unroll
                for (int ks = 0; ks < 2; ++ks) {
                    const uint4 kv = *(const uint4*)(kT + (16 * dkt + fr) * 72 + 32 * ks + 8 * g);
                    const float4 wa0 = *(const float4*)(wsl + 32 * ks + 8 * g), wa1 = *(const float4*)(wsl + 32 * ks + 8 * g + 4);
                    const float4 wb0 = *(const float4*)(wsl + 64 + 32 * ks + 8 * g), wb1 = *(const float4*)(wsl + 64 + 32 * ks + 8 * g + 4);
                    const unsigned kw[4] = {kv.x, kv.y, kv.z, kv.w};
                    const float w0[8] = {wa0.x, wa0.y, wa0.z, wa0.w, wa1.x, wa1.y, wa1.z, wa1.w}, w1[8] = {wb0.x, wb0.y, wb0.z, wb0.w, wb1.x, wb1.y, wb1.z, wb1.w};
                    union { u32x4 u; bf16x8 f; } b0, b1;
#pragma unroll
                    for (int i = 0; i < 4; ++i) {
                        const float ka = __uint_as_float(kw[i] << 16), kb = __uint_as_float(kw[i] & 0xFFFF0000u);
                        b0.u[i] = pk2bf(ka * w0[2 * i], kb * w0[2 * i + 1]);
                        b1.u[i] = pk2bf(ka * w1[2 * i], kb * w1[2 * i + 1]);
                    }
                    u0 = __builtin_amdgcn_mfma_f32_16x16x32_bf16(va[ks], b0.f, u0, 0, 0, 0);
                    u1 = __builtin_amdgcn_mfma_f32_16x16x32_bf16(va[ks], b1.f, u1, 0, 0, 0);
                }
#pragma unroll
                for (int r = 0; r < 4; ++r) {
                    cst[(size_t)bh0 * 4096 + (16 * wid + 4 * g + r) * 64 + 16 * dkt + fr] = u0[r];
                    cst[(size_t)bh1 * 4096 + (16 * wid + 4 * g + r) * 64 + 16 * dkt + fr] = u1[r];
                }
            }
            if (tid < 128) {
                const int d = tid >> 6, dk = tid & 63;
                float acc = 0.f;
#pragma unroll 8
                for (int j = 0; j < 64; ++j) acc += bf2f(kT[dk * 72 + j]) * wsl[d * 64 + j];
                nst[(size_t)(d ? bh1 : bh0) * 64 + dk] = acc;
            }
        }
    }
}

DEVINL void ph_mlB(const P& p, int bid, int nb, char* smem) {
    const int TIDX_ = tid_(); char* const WS_ = wsl_(p.ws);
    const int tid = TIDX_;
    const float* mls = (const float*)(WS_ + OFF_MLS);
    float* mst = (float*)(WS_ + OFF_MST);
    float* nst = (float*)(WS_ + OFF_NST);
    const float* cst = (const float*)(WS_ + OFF_HM);
    u16* cst2 = (u16*)(WS_ + OFF_CST2);
    float* nst2 = (float*)(WS_ + OFF_NST2);
    float* gb = (float*)smem;
    float* dcu = gb + 1024;
    for (int u = bid; u < 64; u += nb) {
        const int bhd = u >> 2, q = u & 3, d = bhd & 1;
        auto tcof = [&](int cs) { return cs < 4 ? (d ? 3 - cs : cs) : 4 + (d ? 255 - (cs - 4) : cs - 4); };
        __syncthreads();
        for (int cs = tid; cs < NTC; cs += 256) { const int tc = tcof(cs); gb[cs * 2] = mls[(bhd * NTC + tc) * 2]; gb[cs * 2 + 1] = mls[(bhd * NTC + tc) * 2 + 1]; }
        __syncthreads();
        if (tid == 0) {
            float m = 0.f;
#pragma unroll 1
            for (int cs = 0; cs < NTC; ++cs) {
                const float G = gb[cs * 2], Bs = gb[cs * 2 + 1];
                if (q == 0) mst[bhd * NTC + tcof(cs)] = m;
                const float ml = fmaxf(Bs + m, G);
                dcu[cs * 2] = __expf(Bs + m - ml); dcu[cs * 2 + 1] = __expf(G - ml);
                m = ml;
            }
        }
        __syncthreads();
        float zz = 0.f; asm volatile("" : "+v"(zz));
        float4 C = make_float4(zz, zz, zz, zz);
        float nn = zz;
        const bool don = (q == 0) && (tid < 64);
        const float* cbase = cst + (size_t)bhd * NTC * 4096 + q * 1024 + tid * 4;
        const float* nbase = nst + (size_t)bhd * NTC * 64 + tid;
        u16* obase = cst2 + (size_t)bhd * NTC * 4096 + q * 1024 + tid * 4;
        float* onbase = nst2 + (size_t)bhd * NTC * 64 + tid;
        float4 Ub[8]; float Nb[8];
#pragma unroll
        for (int i = 0; i < 8; ++i) { Ub[i] = *(const float4*)(cbase + (size_t)tcof(i) * 4096); Nb[i] = don ? nbase[(size_t)tcof(i) * 64] : 0.f; }
#pragma unroll 1
        for (int cs0 = 0; cs0 < NTC; cs0 += 8) {
#pragma unroll
            for (int i = 0; i < 8; ++i) {
                const int cs = cs0 + i;
                if (cs < NTC) {
                    const float4 U = Ub[i]; const float nU = Nb[i];
                    const int tc = tcof(cs);
                    if (cs + 8 < NTC) { Ub[i] = *(const float4*)(cbase + (size_t)tcof(cs + 8) * 4096); Nb[i] = don ? nbase[(size_t)tcof(cs + 8) * 64] : 0.f; }
                    { uint2 o; o.x = pk2bf(C.x, C.y); o.y = pk2bf(C.z, C.w); *(uint2*)(obase + (size_t)tc * 4096) = o; }
                    if (don) onbase[(size_t)tc * 64] = nn;
                    const float dC = dcu[cs * 2], dU = dcu[cs * 2 + 1];
                    C.x = dC * C.x + dU * U.x; C.y = dC * C.y + dU * U.y; C.z = dC * C.z + dU * U.z; C.w = dC * C.w + dU * U.w;
                    nn = dC * nn + dU * nU;
                }
            }
        }
    }
}

DEVINL void ph_na(const P& p, int l, char* smem, int bid, int nb) {
    const int TIDX_ = tid_(); char* const WS_ = wsl_(p.ws);
    const int tid = TIDX_, lane = tid & 63, w = tid >> 6, fr = lane & 15, g = lane >> 4;
    const u16* pqk = (const u16*)(WS_ + OFF_PQK);
    const u16* vtl = (const u16*)(WS_ + OFF_VTL);
    const u16* vtc = (const u16*)(WS_ + OFF_VTC);
    u16* y = (u16*)(WS_ + OFF_Y);
    float* rpbl = (float*)(smem + 49152);
    const int nunit = 4096 + (l == 0 ? 64 : 0);
    const unsigned lbase = lds_addr(smem);
    const int lrow0 = tid >> 3, lrow1 = lrow0 + 32, lsc = ((tid & 7) ^ (lrow0 & 7)) * 8;
    for (int u = bid; u < nunit; u += nb) {
        const bool isctx = u >= 4096;
        int b, h, r = 0, qg = 0;
        if (!isctx) { b = u >> 11; h = (u >> 8) & 7; r = u & 255; }
        else { const int v = u - 4096; b = v >> 5; h = (v >> 2) & 7; qg = v & 3; }
        const int rs = min(max(r - 4, 0), 248);
        const int nwin = isctx ? 0 : 8, nst = nwin + 4;
        auto issue = [&](int st) {
            char* slot = smem + (st % 3) * 16384;
            const u16* ksrc; const u16* vsrc; size_t vstride;
            if (st < nwin) {
                const size_t tok0 = (size_t)CTXROWS + (size_t)b * LAT + (size_t)(rs + st) * 64;
                ksrc = pqk + tok0 * 1024 + 512 + h * 64;
                vsrc = vtl + (size_t)((b * 8 + h) * 64) * LAT + (size_t)(rs + st) * 64; vstride = LAT;
            } else {
                const size_t tok0 = (size_t)b * LCTX + (size_t)(st - nwin) * 64;
                ksrc = pqk + tok0 * 1024 + 512 + h * 64;
                vsrc = vtc + (size_t)((b * 8 + h) * 64) * LCTX + (size_t)(st - nwin) * 64; vstride = LCTX;
            }
            glds16(ksrc + (size_t)lrow0 * 1024 + lsc, slot + tid * 16);
            glds16(ksrc + (size_t)lrow1 * 1024 + lsc, slot + 4096 + tid * 16);
            glds16(vsrc + (size_t)lrow0 * vstride + lsc, slot + 8192 + tid * 16);
            glds16(vsrc + (size_t)lrow1 * vstride + lsc, slot + 8192 + 4096 + tid * 16);
        };
        __syncthreads();
        issue(0); issue(1);
        if (!isctx) for (int i = tid; i < 465; i += 256) rpbl[i] = p.na_rpb[((size_t)l * 8 + h) * 465 + i];
        asm volatile("s_waitcnt lgkmcnt(0)" ::: "memory");
        const int c = 16 * w + fr;
        const int qrow = isctx ? b * LCTX + qg * 64 + c : CTXROWS + b * LAT + r * 64 + c;
        bf16x8 qf[2];
        qf[0] = *(const bf16x8*)(pqk + (size_t)qrow * 1024 + h * 64 + 8 * g);
        qf[1] = *(const bf16x8*)(pqk + (size_t)qrow * 1024 + h * 64 + 32 + 8 * g);
        f32x4 O[4];
#pragma unroll
        for (int i = 0; i < 4; ++i) O[i] = f32x4{0.f, 0.f, 0.f, 0.f};
        float mrun = -1.0e30f, lrun = 0.f;
        const int cb = (w == 0) ? 0 : (w == 1) ? 8 : (w == 2) ? 24 : 32;
        const int cs = min(max(c - 8, 0), 48);
        auto chunk = [&](unsigned sl, int kb, const float* bias0, bool local) {
            const int key0 = kb + fr, key1 = kb + 16 + fr;
            const unsigned ka0 = sl + key0 * 128, ka1 = sl + key1 * 128;
            const unsigned k00a = ka0 + ((g ^ (key0 & 7)) << 4), k01a = ka0 + (((4 + g) ^ (key0 & 7)) << 4);
            const unsigned k10a = ka1 + ((g ^ (key1 & 7)) << 4), k11a = ka1 + (((4 + g) ^ (key1 & 7)) << 4);
            const int q0 = (kb >> 2) + g, q1 = q0 + 4;
            const unsigned vbase = sl + 8192 + fr * 128;
            const unsigned vo0 = ((((q0 >> 1) ^ (fr & 7)) << 4) + ((q0 & 1) << 3)), vo1 = ((((q1 >> 1) ^ (fr & 7)) << 4) + ((q1 & 1) << 3));
            u32x4 k00, k01, k10, k11; u32x2 vlo0, vhi0, vlo1, vhi1, vlo2, vhi2, vlo3, vhi3;
            asm volatile(
                "ds_read_b128 %0, %12\n\t"
                "ds_read_b128 %1, %13\n\t"
                "ds_read_b128 %2, %14\n\t"
                "ds_read_b128 %3, %15\n\t"
                "ds_read_b64 %4, %16\n\t"
                "ds_read_b64 %5, %17\n\t"
                "ds_read_b64 %6, %16 offset:2048\n\t"
                "ds_read_b64 %7, %17 offset:2048\n\t"
                "ds_read_b64 %8, %16 offset:4096\n\t"
                "ds_read_b64 %9, %17 offset:4096\n\t"
                "ds_read_b64 %10, %16 offset:6144\n\t"
                "ds_read_b64 %11, %17 offset:6144\n\t"
                "s_waitcnt lgkmcnt(0)"
                : "=&v"(k00), "=&v"(k01), "=&v"(k10), "=&v"(k11), "=&v"(vlo0), "=&v"(vhi0), "=&v"(vlo1), "=&v"(vhi1),
                  "=&v"(vlo2), "=&v"(vhi2), "=&v"(vlo3), "=&v"(vhi3)
                : "v"(k00a), "v"(k01a), "v"(k10a), "v"(k11a), "v"(vbase + vo0), "v"(vbase + vo1)
                : "memory");
            auto asf = [](u32x4 v) { union { u32x4 u; bf16x8 f; } x; x.u = v; return x.f; };
            f32x4 s0 = f32x4{0.f, 0.f, 0.f, 0.f}, s1 = f32x4{0.f, 0.f, 0.f, 0.f};
            s0 = __builtin_amdgcn_mfma_f32_16x16x32_bf16(asf(k00), qf[0], s0, 0, 0, 0);
            s0 = __builtin_amdgcn_mfma_f32_16x16x32_bf16(asf(k01), qf[1], s0, 0, 0, 0);
            s1 = __builtin_amdgcn_mfma_f32_16x16x32_bf16(asf(k10), qf[0], s1, 0, 0, 0);
            s1 = __builtin_amdgcn_mfma_f32_16x16x32_bf16(asf(k11), qf[1], s1, 0, 0, 0);
            float sv[8];
#pragma unroll
            for (int j = 0; j < 4; ++j) {
                float a = s0[j] * 0.125f, bb = s1[j] * 0.125f;
                if (local) {
                    const int k0c = kb + 4 * g + j, k1c = k0c + 16;
                    a = (k0c >= cs && k0c <= cs + 15) ? a + bias0[k0c] : -1.0e30f;
                    bb = (k1c >= cs && k1c <= cs + 15) ? bb + bias0[k1c] : -1.0e30f;
                }
                sv[j] = a; sv[4 + j] = bb;
            }
            float mx = sv[0];
#pragma unroll
            for (int j = 1; j < 8; ++j) mx = fmaxf(mx, sv[j]);
            mx = fmaxf(mx, __shfl_xor(mx, 16)); mx = fmaxf(mx, __shfl_xor(mx, 32));
            const float mnew = fmaxf(mrun, mx);
            const float sc = __expf(mrun - mnew);
            mrun = mnew;
            float ps = 0.f; float pv[8];
#pragma unroll
            for (int j = 0; j < 8; ++j) { pv[j] = __expf(sv[j] - mnew); ps += pv[j]; }
            lrun = lrun * sc + ps;
            union { u32x4 u; bf16x8 f; } pf; pf.u = u32x4{pk2bf(pv[0], pv[1]), pk2bf(pv[2], pv[3]), pk2bf(pv[4], pv[5]), pk2bf(pv[6], pv[7])};
            const u32x2 vl[4] = {vlo0, vlo1, vlo2, vlo3}, vh[4] = {vhi0, vhi1, vhi2, vhi3};
#pragma unroll
            for (int dt = 0; dt < 4; ++dt) {
                O[dt][0] *= sc; O[dt][1] *= sc; O[dt][2] *= sc; O[dt][3] *= sc;
                union { u32x4 u; bf16x8 f; } vf; vf.u = u32x4{vl[dt].x, vl[dt].y, vh[dt].x, vh[dt].y};
                O[dt] = __builtin_amdgcn_mfma_f32_16x16x32_bf16(vf.f, pf.f, O[dt], 0, 0, 0);
            }
        };
#pragma unroll 1
        for (int st = 0; st < nst; ++st) {
            if (st + 1 < nst) asm volatile("s_waitcnt vmcnt(4)" ::: "memory"); else asm volatile("s_waitcnt vmcnt(0)" ::: "memory");
            __builtin_amdgcn_s_barrier();
            if (st + 2 < nst) issue(st + 2);
            const unsigned sl = lbase + (st % 3) * 16384;
            if (st < nwin) {
                const int krow = rs + st;
                chunk(sl, cb, rpbl + (krow - r + 7) * 31 - c + 15, true);
            } else {
                chunk(sl, 0, nullptr, false);
                chunk(sl, 32, nullptr, false);
            }
        }
        float lt = lrun; lt += __shfl_xor(lt, 16); lt += __shfl_xor(lt, 32);
        const float inv = 1.f / lt;
#pragma unroll
        for (int dt = 0; dt < 4; ++dt) {
            uint2 o;
            o.x = pk2bf(O[dt][0] * inv, O[dt][1] * inv);
            o.y = pk2bf(O[dt][2] * inv, O[dt][3] * inv);
            *(uint2*)(y + (size_t)qrow * 1024 + h * 64 + dt * 16 + 4 * g) = o;
        }
    }
    asm volatile("s_waitcnt vmcnt(0)" ::: "memory");
    __syncthreads();
}

DEVINL void ph_mlC(const P& p, int l, char* smem, int bid, int nb) {
    const int TIDX_ = tid_(); char* const WS_ = wsl_(p.ws);
    const int tid = TIDX_, lane = tid & 63, w = tid >> 6, fr = lane & 15, g = lane >> 4;
    const u16* mlf = (const u16*)(WS_ + OFF_MLF);
    const u16* pc = (const u16*)(WS_ + OFF_PC);
    const float* mlg = (const float*)(WS_ + OFF_MLG);
    const float* mst = (const float*)(WS_ + OFF_MST);
    const float* nst = (const float*)(WS_ + OFF_NST2);
    const u16* cst = (const u16*)(WS_ + OFF_CST2);
    u16* y = (u16*)(WS_ + OFF_Y);
    u16* vt = (u16*)smem;
    float* btl = (float*)(smem + 9216);
    float* lil = btl + 128;
    float* nl = lil + 128;
    for (int uh = bid; uh < 2 * NTC * 4; uh += nb) {
        const int u = uh >> 2, h = uh & 3;
        const int b = u / NTC, tc = u % NTC;
        if (tc < 4 && l != 0) continue;
        const int row0 = tc < 4 ? b * LCTX + tc * 64 : CTXROWS + b * LAT + (tc - 4) * 64;
        __syncthreads();
        for (int i = tid; i < 64 * 8; i += 256) {
            const int tok = i >> 3, d8 = (i & 7) * 8;
            const uint4 vv = *(const uint4*)(pc + (size_t)(row0 + tok) * 1040 + 512 + h * 64 + d8);
            const unsigned wv[4] = {vv.x, vv.y, vv.z, vv.w};
#pragma unroll
            for (int k = 0; k < 4; ++k) { vt[(d8 + 2 * k) * 72 + tok] = (u16)(wv[k] & 0xFFFFu); vt[(d8 + 2 * k + 1) * 72 + tok] = (u16)(wv[k] >> 16); }
        }
        if (tid < 128) {
            const int d = tid >> 6, tok = tid & 63;
            lil[d * 64 + tok] = mlg[(size_t)(row0 + tok) * 16 + d * 4 + h];
            nl[d * 64 + tok] = nst[((size_t)((b * 4 + h) * 2 + d) * NTC + tc) * 64 + tok];
        }
        else { const int d = (tid - 128) >> 6, tok = tid & 63; btl[d * 64 + tok] = mlg[(size_t)(row0 + tok) * 16 + 8 + d * 4 + h]; }
        const int t = 16 * w + fr;
        bf16x8 qf[2];
        qf[0] = *(const bf16x8*)(mlf + (size_t)(row0 + t) * 512 + h * 64 + 8 * g);
        qf[1] = *(const bf16x8*)(mlf + (size_t)(row0 + t) * 512 + h * 64 + 32 + 8 * g);
        f32x4 S[4];
#pragma unroll
        for (int st = 0; st < 4; ++st) {
            const u16* kp = mlf + (size_t)(row0 + 16 * st + fr) * 512 + 256 + h * 64 + 8 * g;
            const bf16x8 k0 = *(const bf16x8*)kp, k1 = *(const bf16x8*)(kp + 32);
            S[st] = f32x4{0.f, 0.f, 0.f, 0.f};
            S[st] = __builtin_amdgcn_mfma_f32_16x16x32_bf16(k0, qf[0], S[st], 0, 0, 0);
            S[st] = __builtin_amdgcn_mfma_f32_16x16x32_bf16(k1, qf[1], S[st], 0, 0, 0);
        }
        __syncthreads();
        f32x4 hs[4];
#pragma unroll
        for (int i = 0; i < 4; ++i) hs[i] = f32x4{0.f, 0.f, 0.f, 0.f};
#pragma unroll 1
        for (int d = 0; d < 2; ++d) {
            const int bhd = (b * 4 + h) * 2 + d;
            const float m0 = mst[bhd * NTC + tc];
            const float bt = btl[d * 64 + t];
            float ld[16]; float mx = -3.0e38f;
#pragma unroll
            for (int st = 0; st < 4; ++st) {
                const float4 b4 = *(const float4*)(btl + d * 64 + 16 * st + 4 * g), l4 = *(const float4*)(lil + d * 64 + 16 * st + 4 * g);
                const float bs[4] = {b4.x, b4.y, b4.z, b4.w}, ls[4] = {l4.x, l4.y, l4.z, l4.w};
#pragma unroll
                for (int r = 0; r < 4; ++r) {
                    const int s = 16 * st + 4 * g + r;
                    const bool ok = d ? (s >= t) : (s <= t);
                    ld[4 * st + r] = ok ? (bt - bs[r] + ls[r]) : -3.0e38f;
                    mx = fmaxf(mx, ld[4 * st + r]);
                }
            }
            mx = fmaxf(mx, __shfl_xor(mx, 16)); mx = fmaxf(mx, __shfl_xor(mx, 32));
            const float mt = fmaxf(bt + m0, mx);
            float rsum = 0.f; float dw[16];
#pragma unroll
            for (int i = 0; i < 16; ++i) { dw[i] = (ld[i] > -1.0e38f) ? __expf(ld[i] - mt) * S[i >> 2][i & 3] : 0.f; rsum += dw[i]; }
            rsum += __shfl_xor(rsum, 16); rsum += __shfl_xor(rsum, 32);
            const float inter = __expf(bt + m0 - mt);
            float qn = 0.f;
#pragma unroll
            for (int j = 0; j < 8; ++j) {
                qn += bf2f((u16)qf[0][j]) * nl[d * 64 + 8 * g + j] + bf2f((u16)qf[1][j]) * nl[d * 64 + 32 + 8 * g + j];
            }
            qn += __shfl_xor(qn, 16); qn += __shfl_xor(qn, 32);
            const float den = rsum + inter * qn;
            const float dn = 1.f / fmaxf(fabsf(den), __expf(-mt));
            union { u32x4 u; bf16x8 f; } pf[2];
#pragma unroll
            for (int ks = 0; ks < 2; ++ks) pf[ks].u = u32x4{pk2bf(dw[8 * ks], dw[8 * ks + 1]), pk2bf(dw[8 * ks + 2], dw[8 * ks + 3]), pk2bf(dw[8 * ks + 4], dw[8 * ks + 5]), pk2bf(dw[8 * ks + 6], dw[8 * ks + 7])};
            const u16* cb = cst + ((size_t)bhd * NTC + tc) * 4096;
#pragma unroll
            for (int dvt = 0; dvt < 4; ++dvt) {
                f32x4 num = f32x4{0.f, 0.f, 0.f, 0.f}, qc = f32x4{0.f, 0.f, 0.f, 0.f};
#pragma unroll
                for (int ks = 0; ks < 2; ++ks) {
                    const uint2 lo = *(const uint2*)(vt + (16 * dvt + fr) * 72 + 32 * ks + 4 * g), hi = *(const uint2*)(vt + (16 * dvt + fr) * 72 + 32 * ks + 16 + 4 * g);
                    union { u32x4 u; bf16x8 f; } vf; vf.u = u32x4{lo.x, lo.y, hi.x, hi.y};
                    num = __builtin_amdgcn_mfma_f32_16x16x32_bf16(vf.f, pf[ks].f, num, 0, 0, 0);
                    const bf16x8 cf = *(const bf16x8*)(cb + (16 * dvt + fr) * 64 + 32 * ks + 8 * g);
                    qc = __builtin_amdgcn_mfma_f32_16x16x32_bf16(cf, qf[ks], qc, 0, 0, 0);
                }
#pragma unroll
                for (int r = 0; r < 4; ++r) hs[dvt][r] += (num[r] + inter * qc[r]) * dn;
            }
        }
        float s1 = 0.f;
#pragma unroll
        for (int i = 0; i < 4; ++i) s1 += hs[i][0] + hs[i][1] + hs[i][2] + hs[i][3];
        s1 += __shfl_xor(s1, 16); s1 += __shfl_xor(s1, 32);
        const float mu = s1 * (1.f / 64.f);
        float s2 = 0.f;
#pragma unroll
        for (int i = 0; i < 4; ++i)
#pragma unroll
            for (int r = 0; r < 4; ++r) { const float dl = hs[i][r] - mu; s2 += dl * dl; }
        s2 += __shfl_xor(s2, 16); s2 += __shfl_xor(s2, 32);
        const float rstd = rsqrtf(s2 * (1.f / 64.f) + 1e-6f);
        const int row = row0 + t;
#pragma unroll
        for (int dvt = 0; dvt < 4; ++dvt) {
            const int cc = h * 64 + 16 * dvt + 4 * g;
            const uint2 ov = *(const uint2*)(pc + (size_t)row * 1040 + 768 + cc);
            const float4 nw = *(const float4*)(p.ml_nw + l * 256 + cc);
            const float o0 = bf2f((u16)(ov.x & 0xFFFF)), o1 = bf2f((u16)(ov.x >> 16)), o2 = bf2f((u16)(ov.y & 0xFFFF)), o3 = bf2f((u16)(ov.y >> 16));
            uint2 out;
            out.x = pk2bf((hs[dvt][0] - mu) * rstd * nw.x * sigmoidf_(o0), (hs[dvt][1] - mu) * rstd * nw.y * sigmoidf_(o1));
            out.y = pk2bf((hs[dvt][2] - mu) * rstd * nw.z * sigmoidf_(o2), (hs[dvt][3] - mu) * rstd * nw.w * sigmoidf_(o3));
            *(uint2*)(y + (size_t)row * 1024 + 768 + cc) = out;
        }
    }
}

DEVINL void ph_outproj(const P& p, int l, char* smem) {
    const int TIDX_ = tid_(); const int BIDX_ = bid_(); char* const WS_ = wsl_(p.ws); (void)TIDX_; (void)BIDX_; (void)WS_;
    const u16* y = (const u16*)(WS_ + OFF_Y);
    const u16* wout = (const u16*)(WS_ + OFF_WOUT);
    const float* modv = (const float*)(WS_ + OFF_MOD) + (size_t)l * 3 * 6144;
    const float* x2c = (const float*)(WS_ + OFF_X2CTX);
    float* x1 = (float*)(WS_ + OFF_X1);
    const int mt0 = (l == 0) ? 0 : 4;
    const int ntile = (260 - mt0) * 8;
    for (int u = BIDX_; u < ntile; u += gridDim.x) {
        const int mt = mt0 + u / 8, nt = u % 8;
        const u16* A = y + (size_t)mt * 128 * 1024;
        const int R0 = mt * 128;
        const float* xin;
        if (l == 0) xin = R0 < CTXROWS ? p.ctx + (size_t)R0 * 1024 : p.x + (size_t)(R0 - CTXROWS) * 1024;
        else xin = R0 < CTXROWS ? x2c + (size_t)R0 * 1024 : p.out + (size_t)(R0 - CTXROWS) * 1024;
        const float* g1 = modv + row_sel(R0) * 6144 + 2048;
        f32x4 acc[4][4];
        gemm128_acc([&](int r) { return A + (size_t)r * 1024; }, wout + (size_t)nt * 128 * 1024, 1024, 1024, smem, acc);
        stage_tile_f32(acc, smem, [&](int row, int c4, float4 a) {
            const int N = nt * 128 + c4;
            const float4 gg = *(const float4*)(g1 + N);
            const float4 xv = *(const float4*)(xin + (size_t)row * 1024 + N);
            float4 o;
            o.x = ALPHA * xv.x + gg.x * a.x; o.y = ALPHA * xv.y + gg.y * a.y; o.z = ALPHA * xv.z + gg.z * a.z; o.w = ALPHA * xv.w + gg.w * a.w;
            *(float4*)(x1 + (size_t)(R0 + row) * 1024 + N) = o;
        });
    }
}

DEVINL void ph_ln1(const P& p, int l) {
    const int TIDX_ = tid_(); const int BIDX_ = bid_(); char* const WS_ = wsl_(p.ws); (void)TIDX_; (void)BIDX_; (void)WS_;
    const int lane = TIDX_ & 63, wid = TIDX_ >> 6;
    const float* modv = (const float*)(WS_ + OFF_MOD) + (size_t)l * 3 * 6144;
    float* x1 = (float*)(WS_ + OFF_X1);
    u16* hm = (u16*)(WS_ + OFF_HM);
    const int rstart = (l == 0) ? 0 : CTXROWS;
    for (int row = rstart + BIDX_ * 4 + wid; row < T; row += gridDim.x * 4) {
        float4 v[4];
        float s = 0.f;
#pragma unroll
        for (int i = 0; i < 4; ++i) { v[i] = *(const float4*)(x1 + (size_t)row * 1024 + i * 256 + lane * 4); s += v[i].x + v[i].y + v[i].z + v[i].w; }
        const float mu = wsum(s) * (1.f / 1024.f);
        float q = 0.f;
#pragma unroll
        for (int i = 0; i < 4; ++i) { v[i].x -= mu; v[i].y -= mu; v[i].z -= mu; v[i].w -= mu; q += v[i].x * v[i].x + v[i].y * v[i].y + v[i].z * v[i].z + v[i].w * v[i].w; }
        const float rstd = rsqrtf(wsum(q) * (1.f / 1024.f) + 1e-5f);
        const float* mv = modv + row_sel(row) * 6144;
#pragma unroll
        for (int i = 0; i < 4; ++i) {
            const int c = i * 256 + lane * 4;
            const float4 g = *(const float4*)(p.ln1g + l * 1024 + c), bb = *(const float4*)(p.ln1b + l * 1024 + c);
            const float4 sh = *(const float4*)(mv + 3072 + c), sc = *(const float4*)(mv + 4096 + c);
            float4 o;
            o.x = v[i].x * rstd * g.x + bb.x; o.y = v[i].y * rstd * g.y + bb.y; o.z = v[i].z * rstd * g.z + bb.z; o.w = v[i].w * rstd * g.w + bb.w;
            *(float4*)(x1 + (size_t)row * 1024 + c) = o;
            uint2 hh;
            hh.x = (unsigned)f2bf(o.x * (1.f + sc.x) + sh.x) | ((unsigned)f2bf(o.y * (1.f + sc.y) + sh.y) << 16);
            hh.y = (unsigned)f2bf(o.z * (1.f + sc.z) + sh.z) | ((unsigned)f2bf(o.w * (1.f + sc.w) + sh.w) << 16);
            *(uint2*)(hm + (size_t)row * 1024 + c) = hh;
        }
    }
}

DEVINL void ph_router(const P& p, int l, char* smem) {
    const int TIDX_ = tid_(); const int BIDX_ = bid_(); char* const WS_ = wsl_(p.ws); (void)TIDX_; (void)BIDX_; (void)WS_;
    const u16* hm = (const u16*)(WS_ + OFF_HM);
    const u16* wr = (const u16*)(WS_ + OFF_WR) + (size_t)l * 128 * 1024;
    float* lg = (float*)(WS_ + OFF_LOGITS);
    const int mt0 = (l == 0) ? 0 : 4;
    for (int u = BIDX_; u < 260 - mt0; u += gridDim.x) {
        const int mt = mt0 + u;
        const u16* A = hm + (size_t)mt * 128 * 1024;
        gemm128([&](int r) { return A + (size_t)r * 1024; }, wr, 1024, 1024, smem,
                [&](int m, int n, f32x4 a) {
                    if (n < 36) {
#pragma unroll
                        for (int j = 0; j < 4; ++j) lg[(size_t)(mt * 128 + m + j) * 64 + n] = a[j];
                    }
                });
    }
}

DEVINL void ph_route1(const P& p, int l, char* smem) {
    const int TIDX_ = tid_(); const int BIDX_ = bid_(); char* const WS_ = wsl_(p.ws); (void)TIDX_; (void)BIDX_; (void)WS_;
    const int tid = TIDX_;
    const float* lg = (const float*)(WS_ + OFF_LOGITS);
    int* toke = (int*)(WS_ + OFF_TOKE); float* tokw = (float*)(WS_ + OFF_TOKW);
    int* cnt = (int*)(WS_ + CTL_CNT) + l * 32;
    int* hist = (int*)smem;
    __syncthreads();
    if (tid < 32) hist[tid] = 0;
    __syncthreads();
    const int rstart = (l == 0) ? 0 : CTXROWS;
    for (int row = rstart + BIDX_ * 256 + tid; row < T; row += gridDim.x * 256) {
        const float* q = lg + (size_t)row * 64;
        float gl[4]; int gs = 0; float gm = -3.0e38f;
#pragma unroll
        for (int i = 0; i < 4; ++i) { gl[i] = q[i] + p.rgb[l * 4 + i]; if (gl[i] > gm) { gm = gl[i]; gs = i; } }
        float se = 0.f;
#pragma unroll
        for (int i = 0; i < 4; ++i) se += expf(gl[i] - gm);
        const float gw = 1.f / se;
        float v1 = -3.0e38f, v2 = -3.0e38f; int i1 = 0, i2 = 0;
#pragma unroll
        for (int i = 0; i < 8; ++i) {
            const float e = q[4 + gs * 8 + i] + p.reb[l * 32 + gs * 8 + i];
            if (e > v1) { v2 = v1; i2 = i1; v1 = e; i1 = i; }
            else if (e > v2) { v2 = e; i2 = i; }
        }
        const float e2 = expf(v2 - v1);
        const float w1 = gw / (1.f + e2), w2 = gw * e2 / (1.f + e2);
        const int ea = gs * 8 + i1, eb = gs * 8 + i2;
        toke[row * 2] = ea; toke[row * 2 + 1] = eb; tokw[row * 2] = w1; tokw[row * 2 + 1] = w2;
        atomicAdd(&hist[ea], 1); atomicAdd(&hist[eb], 1);
    }
    __syncthreads();
    if (tid < 32 && hist[tid] > 0) atomicAdd(&cnt[tid], hist[tid]);
}

DEVINL void ph_route2(const P& p, int l, char* smem) {
    const int TIDX_ = tid_(); const int BIDX_ = bid_(); char* const WS_ = wsl_(p.ws); (void)TIDX_; (void)BIDX_; (void)WS_;
    const int tid = TIDX_;
    const int* toke = (const int*)(WS_ + OFF_TOKE);
    int* toks = (int*)(WS_ + OFF_TOKS);
    int* slottok = (int*)(WS_ + OFF_SLOTTOK);
    const int* cnt = (const int*)(WS_ + CTL_CNT) + l * 32;
    int* cur = (int*)(WS_ + CTL_CUR) + l * 32;
    int* tiles = (int*)(WS_ + OFF_TILES);
    int* off = (int*)smem;
    int* hist = off + 64;
    int* base = hist + 32;
    __syncthreads();
    if (tid == 0) { int a = 0; for (int e = 0; e < 32; ++e) { off[e] = a; a += (cnt[e] + 127) & ~127; } off[32] = a; }
    if (tid < 32) hist[tid] = 0;
    __syncthreads();
    if (BIDX_ == 0) {
        if (tid == 0) {
            int nt = 0;
#pragma clang loop vectorize(disable) unroll(disable)
            for (int e = 0; e < 32; ++e) {
#pragma clang loop vectorize(disable) unroll(disable)
                for (int s = off[e]; s < off[e + 1]; s += 128) { tiles[64 + nt * 2] = e; tiles[64 + nt * 2 + 1] = s; ++nt; }
            }
            tiles[40] = nt;
        }
#pragma clang loop vectorize(disable) unroll(disable)
        for (int e = 0; e < 32; ++e) {
#pragma clang loop vectorize(disable) unroll(disable)
            for (int s = off[e] + cnt[e] + tid; s < off[e + 1]; s += 256) slottok[s] = (l == 0) ? 0 : CTXROWS;
        }
    }
    const int rstart = (l == 0) ? 0 : CTXROWS;
    for (int a0 = rstart * 2 + BIDX_ * 256; a0 < T * 2; a0 += gridDim.x * 256) {
        const int a = a0 + tid;
        int e = -1, lpos = 0;
        if (a < T * 2) { e = toke[a]; lpos = atomicAdd(&hist[e], 1); }
        __syncthreads();
        if (tid < 32) { base[tid] = hist[tid] > 0 ? atomicAdd(&cur[tid], hist[tid]) : 0; }
        __syncthreads();
        if (e >= 0) { const int s = off[e] + base[e] + lpos; toks[a] = s; slottok[s] = a >> 1; }
        __syncthreads();
        if (tid < 32) hist[tid] = 0;
        __syncthreads();
    }
}

DEVINL void ph_gateup(const P& p, char* smem) {
    const int TIDX_ = tid_(); const int BIDX_ = bid_(); char* const WS_ = wsl_(p.ws); (void)TIDX_; (void)BIDX_; (void)WS_;
    const int tid = TIDX_, lane = tid & 63, wid = tid >> 6, wr = wid >> 1, wc = wid & 1, fr = lane & 15, fq = lane >> 4;
    const u16* hm = (const u16*)(WS_ + OFF_HM);
    const u16* wgu = (const u16*)(WS_ + OFF_WGU);
    const int* tiles = (const int*)(WS_ + OFF_TILES);
    const int* slottok = (const int*)(WS_ + OFF_SLOTTOK);
    u16* act = (u16*)(WS_ + OFF_ACT);
    const int ntile = tiles[40] * 8;
    for (int u = BIDX_; u < ntile; u += gridDim.x) {
        const int ti = u >> 3, nt = u & 7;
        const int e = tiles[64 + ti * 2], s0 = tiles[64 + ti * 2 + 1];
        f32x4 acc[4][4];
        gemm128_acc([&](int r) { return hm + (size_t)slottok[s0 + r] * 1024; }, wgu + ((size_t)e * 1024 + nt * 128) * 1024, 1024, 1024, smem, acc);
        {
            u16* t = (u16*)smem;
            __syncthreads();
#pragma unroll
            for (int m = 0; m < 4; ++m)
#pragma unroll
                for (int n = 0; n < 4; n += 2) {
                    const int jc = (wc * 64 + n * 16) / 2 + fr;
                    const int r0 = wr * 64 + m * 16 + fq * 4;
                    float av[4];
#pragma unroll
                    for (int j = 0; j < 4; ++j) { const float gte = acc[m][n][j], up = acc[m][n + 1][j]; av[j] = gte / (1.f + __expf(-gte)) * up; }
                    const unsigned p01 = pk2bf(av[0], av[1]), p23 = pk2bf(av[2], av[3]);
                    t[(r0 + 0) * 72 + jc] = (u16)(p01 & 0xFFFFu); t[(r0 + 1) * 72 + jc] = (u16)(p01 >> 16);
                    t[(r0 + 2) * 72 + jc] = (u16)(p23 & 0xFFFFu); t[(r0 + 3) * 72 + jc] = (u16)(p23 >> 16);
                }
            __syncthreads();
#pragma unroll
            for (int i = 0; i < 4; ++i) {
                const int ci = tid + 256 * i, row = ci >> 3, c8 = (ci & 7) * 8;
                *(uint4*)(act + (size_t)(s0 + row) * 512 + nt * 64 + c8) = *(const uint4*)(t + row * 72 + c8);
            }
        }
    }
}

DEVINL void ph_down(const P& p, char* smem) {
    const int TIDX_ = tid_(); const int BIDX_ = bid_(); char* const WS_ = wsl_(p.ws); (void)TIDX_; (void)BIDX_; (void)WS_;
    const u16* act = (const u16*)(WS_ + OFF_ACT);
    const u16* wdn = (const u16*)(WS_ + OFF_WDN);
    const int* tiles = (const int*)(WS_ + OFF_TILES);
    u16* so = (u16*)(WS_ + OFF_SLOTOUT);
    const int ntile = tiles[40] * 8;
    for (int u = BIDX_; u < ntile; u += gridDim.x) {
        const int ti = u >> 3, nt = u & 7;
        const int e = tiles[64 + ti * 2], s0 = tiles[64 + ti * 2 + 1];
        const u16* A = act + (size_t)s0 * 512;
        f32x4 acc[4][4];
        gemm128_acc([&](int r) { return A + (size_t)r * 512; }, wdn + ((size_t)e * 1024 + nt * 128) * 512, 512, 512, smem, acc);
        stage_tile_bf16(acc, smem, [&](int row, int c8, uint4 v) { *(uint4*)(so + (size_t)(s0 + row) * 1024 + nt * 128 + c8) = v; });
    }
}

DEVINL void ph_ln2(const P& p, int l) {
    const int TIDX_ = tid_(); const int BIDX_ = bid_(); char* const WS_ = wsl_(p.ws); (void)TIDX_; (void)BIDX_; (void)WS_;
    const int lane = TIDX_ & 63, wid = TIDX_ >> 6;
    const float* modv = (const float*)(WS_ + OFF_MOD) + (size_t)l * 3 * 6144;
    const float* modn = (const float*)(WS_ + OFF_MOD) + (size_t)(l + 1) * 3 * 6144;
    const float* x1 = (const float*)(WS_ + OFF_X1);
    const u16* so = (const u16*)(WS_ + OFF_SLOTOUT);
    const int* toks = (const int*)(WS_ + OFF_TOKS);
    const float* tokw = (const float*)(WS_ + OFF_TOKW);
    float* x2c = (float*)(WS_ + OFF_X2CTX);
    u16* hm = (u16*)(WS_ + OFF_HM);
    const int rstart = (l == 0) ? 0 : CTXROWS;
    for (int row = rstart + BIDX_ * 4 + wid; row < T; row += gridDim.x * 4) {
        const int sa = toks[row * 2], sb = toks[row * 2 + 1];
        const float wa = tokw[row * 2], wb = tokw[row * 2 + 1];
        const float* mv = modv + row_sel(row) * 6144;
        float4 v[4];
        float s = 0.f;
#pragma unroll
        for (int i = 0; i < 4; ++i) {
            const int c = i * 256 + lane * 4;
            const float4 xv = *(const float4*)(x1 + (size_t)row * 1024 + c);
            const uint2 ua = *(const uint2*)(so + (size_t)sa * 1024 + c), ub = *(const uint2*)(so + (size_t)sb * 1024 + c);
            const float4 g2 = *(const float4*)(mv + 5120 + c);
            const float f0 = wa * bf2f((u16)(ua.x & 0xFFFF)) + wb * bf2f((u16)(ub.x & 0xFFFF));
            const float f1 = wa * bf2f((u16)(ua.x >> 16)) + wb * bf2f((u16)(ub.x >> 16));
            const float f2 = wa * bf2f((u16)(ua.y & 0xFFFF)) + wb * bf2f((u16)(ub.y & 0xFFFF));
            const float f3 = wa * bf2f((u16)(ua.y >> 16)) + wb * bf2f((u16)(ub.y >> 16));
            v[i].x = ALPHA * xv.x + g2.x * f0; v[i].y = ALPHA * xv.y + g2.y * f1; v[i].z = ALPHA * xv.z + g2.z * f2; v[i].w = ALPHA * xv.w + g2.w * f3;
            s += v[i].x + v[i].y + v[i].z + v[i].w;
        }
        const float mu = wsum(s) * (1.f / 1024.f);
        float q = 0.f;
#pragma unroll
        for (int i = 0; i < 4; ++i) { v[i].x -= mu; v[i].y -= mu; v[i].z -= mu; v[i].w -= mu; q += v[i].x * v[i].x + v[i].y * v[i].y + v[i].z * v[i].z + v[i].w * v[i].w; }
        const float rstd = rsqrtf(wsum(q) * (1.f / 1024.f) + 1e-5f);
        float* dst = row < CTXROWS ? x2c + (size_t)row * 1024 : p.out + (size_t)(row - CTXROWS) * 1024;
        const float* mn = modn + row_sel(row) * 6144;
#pragma unroll
        for (int i = 0; i < 4; ++i) {
            const int c = i * 256 + lane * 4;
            const float4 g = *(const float4*)(p.ln2g + l * 1024 + c), bb = *(const float4*)(p.ln2b + l * 1024 + c);
            float4 o;
            o.x = v[i].x * rstd * g.x + bb.x; o.y = v[i].y * rstd * g.y + bb.y; o.z = v[i].z * rstd * g.z + bb.z; o.w = v[i].w * rstd * g.w + bb.w;
            *(float4*)(dst + c) = o;
            if (l == 0) {
                const float4 sh = *(const float4*)(mn + c), sc = *(const float4*)(mn + 1024 + c);
                uint2 hh;
                hh.x = (unsigned)f2bf(o.x * (1.f + sc.x) + sh.x) | ((unsigned)f2bf(o.y * (1.f + sc.y) + sh.y) << 16);
                hh.y = (unsigned)f2bf(o.z * (1.f + sc.z) + sh.z) | ((unsigned)f2bf(o.w * (1.f + sc.w) + sh.w) << 16);
                *(uint2*)(hm + (size_t)row * 1024 + c) = hh;
            }
        }
    }
}

DEVINL void gbar(XcdBarrier b) {
    unsigned x = b.x; GAS unsigned* q = (GAS unsigned*)b.bar;
    asm volatile("" : "+s"(x), "+s"(q));
    b.x = x; b.bar = (unsigned*)q;
    xcd_barrier(b);
}
#ifndef PROBE
#define PROBE 0
#endif
#ifndef TPROBE
#define TPROBE 0
#endif
__global__ void __launch_bounds__(256, 2) k_mega(P p) {
    __shared__ __attribute__((aligned(16))) char smem[SMEM_BYTES];
    if (threadIdx.x == 0) *(uint4*)(smem + SMEM_BYTES - 16) = make_uint4(0u, 0u, 0u, 0u);
    __syncthreads();
    XcdBarrier bar = xcd_barrier_post((unsigned*)p.ws, (volatile LAS unsigned*)(smem + SMEM_BYTES - 16));
    const int bid = blockIdx.x, nb = gridDim.x;
#if TPROBE
    unsigned long long tp_acc = 0, tp_last = wall_clock64();
#define TP(g) do { const unsigned long long _n = wall_clock64(); if ((g) == TPROBE) tp_acc += _n - tp_last; tp_last = _n; } while (0)
#else
#define TP(g) do { } while (0)
#endif
    if (threadIdx.x == 0) {
        const unsigned key = ((unsigned)__builtin_amdgcn_s_getreg((3 << 11) | 20) << 8) | ((unsigned)__builtin_amdgcn_s_getreg((7 << 11) | (8 << 6) | 4) & 0xFFu);
        ((unsigned*)(p.ws + CTL_CUKEY))[blockIdx.x] = key | 0x80000000u;
    }
    ph_prolog(p, smem);
    ph_convw(p, 0, smem);
    gbar(bar);
    TP(1);
    ph_xm0(p);
    gbar(bar);
    TP(1);
    constexpr int NSCAN = 16;
    bool quiet; int wrank, nwork, mate_of = -1;
    {
        const unsigned* keys = (const unsigned*)(p.ws + CTL_CUKEY);
        int* cnt = (int*)smem;
        if (threadIdx.x < 2) cnt[threadIdx.x] = 0;
        __syncthreads();
        for (int i = NSCAN + threadIdx.x; i < nb; i += 256) {
            const unsigned k = keys[i];
            bool qq = false;
            for (int j = 0; j < NSCAN && j < nb; ++j) qq = qq || (keys[j] == k);
            if (qq) { atomicAdd(&cnt[1], 1); if (i < bid) atomicAdd(&cnt[0], 1); }
        }
        __syncthreads();
        const int below = cnt[0], total = cnt[1];
        bool me = false;
        if (bid >= NSCAN) { const unsigned k = keys[bid]; for (int j = NSCAN - 1; j >= 0; --j) if (j < nb && keys[j] == k) { me = true; mate_of = j; } }
        __syncthreads();
        if (total > 2 * NSCAN) { quiet = false; wrank = bid - NSCAN; nwork = nb - NSCAN; mate_of = -1; }
        else { quiet = me; wrank = bid - NSCAN - below; nwork = nb - NSCAN - total; }
    }
#pragma unroll 1
    for (int l = 0; l < NLAYER; ++l) {
        ph_inproj(p, smem);
        gbar(bar);
    TP(2);
        ph_rwprep(p, l, 0, smem, bid, nb);
        ph_prepM(p, l, smem, bid, nb);
        gbar(bar);
    TP(3);
        if (bid < NSCAN) ph_rwscan(p, l, 0, bid, NSCAN, smem);
        else if (!quiet) { if (nwork > 128) { if (wrank < 64) ph_mlB(p, wrank, 64, smem); else ph_na(p, l, smem, wrank - 64, nwork - 64); } else { ph_mlB(p, wrank, nwork, smem); ph_na(p, l, smem, wrank, nwork); } }
        gbar(bar);
    TP(4);
        ph_rwprep(p, l, 1, smem, bid, nb);
        gbar(bar);
    TP(5);
        if (bid < NSCAN) ph_rwscan(p, l, 1, bid, NSCAN, smem);
        else if (!quiet) { ph_mlC(p, l, smem, wrank, nwork); ph_convexp(p, l, smem, wrank, nwork); }
        gbar(bar);
    TP(6);
        ph_rwout(p, l);
        gbar(bar);
    TP(7);
        ph_outproj(p, l, smem);
        gbar(bar);
    TP(8);
        ph_ln1(p, l);
        gbar(bar);
    TP(9);
        ph_router(p, l, smem);
        gbar(bar);
    TP(9);
        ph_route1(p, l, smem);
        gbar(bar);
    TP(9);
        ph_route2(p, l, smem);
        gbar(bar);
    TP(9);
        ph_gateup(p, smem);
        gbar(bar);
    TP(10);
        ph_down(p, smem);
        gbar(bar);
    TP(11);
        ph_ln2(p, l);
        if (l + 1 < NLAYER) ph_convw(p, l + 1, smem);
        gbar(bar);
    TP(12);
    }
#if TPROBE
    if (bid == 0 && threadIdx.x == 0) { const unsigned long long t_end = wall_clock64() + tp_acc; while (wall_clock64() < t_end) __builtin_amdgcn_s_sleep(8); }
    __syncthreads();
    gbar(bar);
#endif
}


extern "C" void kernel_launch(void* const* d_in, const int* in_sizes, int n_in, void* d_out, int out_size, void* d_ws, size_t ws_size,
                              hipStream_t stream) {
    if (n_in != 37 || ws_size < WS_NEED) { fprintf(stderr, "kernel_launch: n_in %d ws %zu need %zu\n", n_in, ws_size, (size_t)WS_NEED); return; }
    static int grid = 0;
    if (!grid) {
        int dev = 0, cus = 0, per_cu = 0;
        (void)hipGetDevice(&dev);
        (void)hipDeviceGetAttribute(&cus, hipDeviceAttributeMultiprocessorCount, dev);
        (void)hipOccupancyMaxActiveBlocksPerMultiprocessor(&per_cu, (const void*)k_mega, 256, 0);
        if (per_cu < 1) per_cu = 1;
        grid = cus * (per_cu < 2 ? per_cu : 2);
    }
    P p{};
    const float** pp = (const float**)&p;
    for (int i = 0; i < 37; ++i) pp[i] = (const float*)d_in[i];
    p.out = (float*)d_out; p.ws = (char*)d_ws;
    (void)hipMemsetAsync(d_ws, 0, CTL_BYTES, stream);
    k_mega<<<dim3(grid), dim3(256), 0, stream>>>(p);
}
```

```cpp
#include <hip/hip_runtime.h>
#include <hip/hip_bf16.h>
#include <stdint.h>
#include <stdio.h>
#include <type_traits>

#define DEVINL __device__ __forceinline__
typedef unsigned short u16;
using bf16x8 = __attribute__((ext_vector_type(8))) short;
using f32x4 = __attribute__((ext_vector_type(4))) float;

constexpr int D = 1024, LAT = 16384, LCTX = 256, T = 33280, CTXROWS = 512;
constexpr int INP = 3536;
constexpr int NLAYER = 2;
constexpr float ALPHA = 1.41421356237309515f;
constexpr int NUNIT_CH = 520;
constexpr int NTC = 260;
constexpr int MAXSLOT = 70656;
constexpr int SMEM_BYTES = 81920;

constexpr size_t al(size_t x) { return (x + 255) & ~(size_t)255; }
constexpr size_t CTL_CNT = 16384;
constexpr size_t CTL_CUR = CTL_CNT + 256;
constexpr size_t CTL_CUKEY = 20480;
constexpr size_t CTL_PROG = 24576;
constexpr size_t CTL_BYTES = 32768;
constexpr size_t OFF_MOD = CTL_BYTES;
constexpr size_t OFF_ROPE = OFF_MOD + al(2 * 3 * 6144 * 4);
constexpr size_t OFF_WR = OFF_ROPE + al(10240 * 4);
constexpr size_t OFF_LORA = OFF_WR + al(2 * 128 * 1024 * 2);
constexpr size_t OFF_TILES = OFF_LORA + al(3 * 65536);
constexpr size_t OFF_TOKE = OFF_TILES + al((64 + 2048) * 4);
constexpr size_t OFF_TOKW = OFF_TOKE + al((size_t)T * 2 * 4);
constexpr size_t OFF_TOKS = OFF_TOKW + al((size_t)T * 2 * 4);
constexpr size_t OFF_SLOTTOK = OFF_TOKS + al((size_t)T * 2 * 4);
constexpr size_t OFF_X2CTX = OFF_SLOTTOK + al((size_t)MAXSLOT * 4);
constexpr size_t OFF_ZST = OFF_X2CTX + al((size_t)512 * 1024 * 4);
constexpr size_t OFF_WIN = OFF_ZST + al((size_t)16 * 4 * 64 * 16 * 4);
constexpr size_t OFF_WOUT = OFF_WIN + al((size_t)3584 * 1024 * 2);
constexpr size_t OFF_X1 = OFF_WOUT + al((size_t)1024 * 1024 * 2);
constexpr size_t OFF_HM = OFF_X1 + al((size_t)T * 1024 * 4);
constexpr size_t OFF_P = OFF_HM + al((size_t)T * 1024 * 2);
constexpr size_t OFF_PQK = OFF_P;
constexpr size_t OFF_VTL = OFF_PQK + (size_t)T * 1024 * 2;
constexpr size_t OFF_VTC = OFF_VTL + (size_t)2 * 8 * 64 * 16384 * 2;
constexpr size_t OFF_PB = OFF_VTC + (size_t)2 * 8 * 64 * 256 * 2;
constexpr size_t OFF_PC = OFF_PB + (size_t)T * 960 * 2;
constexpr size_t OFF_Y = OFF_PC + (size_t)T * 1040 * 2;
constexpr size_t OFF_MLF = OFF_Y + (size_t)T * 1024 * 2;
constexpr size_t OFF_GATE = OFF_MLF + (size_t)T * 512 * 2;
constexpr size_t OFF_MLG = OFF_GATE + (size_t)T * 256 * 2;
constexpr size_t OFF_MLS = OFF_MLG + (size_t)T * 16 * 4;
constexpr size_t OFF_MST = OFF_MLS + al(16 * 260 * 2 * 4);
constexpr size_t OFF_NST = OFF_MST + al(16 * 260 * 4);
constexpr size_t OFF_CST2 = OFF_NST + al(16 * 260 * 64 * 4);
constexpr size_t OFF_NST2 = OFF_CST2 + (size_t)16 * 260 * 4096 * 2;
constexpr size_t OFF_END1 = OFF_NST2 + al(16 * 260 * 64 * 4);
constexpr size_t OFF_WGU = OFF_P;
constexpr size_t OFF_WDN = OFF_WGU + (size_t)32 * 1024 * 1024 * 2;
constexpr size_t OFF_ACT = OFF_WDN + (size_t)32 * 1024 * 512 * 2;
constexpr size_t OFF_SLOTOUT = OFF_ACT + (size_t)MAXSLOT * 512 * 2;
constexpr size_t OFF_LOGITS = OFF_SLOTOUT + (size_t)MAXSLOT * 1024 * 2;
constexpr size_t OFF_END2 = OFF_LOGITS + (size_t)T * 64 * 4;
constexpr size_t WS_NEED = OFF_END1 > OFF_END2 ? OFF_END1 : OFF_END2;
static_assert(OFF_WDN <= OFF_Y, "Wexp must not overlap y");
static_assert(OFF_LOGITS >= OFF_MLF, "logits placement");

struct P {
    const float *x, *c, *ctx, *c_ctx, *w_mod, *b_mod, *w_in, *na_rpb, *mu_prev, *mu_next, *rw_w0, *rw_w2, *rw_a0, *rw_a2,
        *rw_g2, *rw_kk, *rw_ka, *rw_rk, *rw_lnw, *rw_lnb, *ml_cw, *ml_cb, *ml_ib, *ml_fb, *ml_nw, *w_out, *ln1g, *ln1b,
        *rgw, *rgb, *rew, *reb, *egate, *eup, *edown, *ln2g, *ln2b;
    float* out;
    char* ws;
};

#define XB_TMO      128
#define XB_XCNT(j)  (256  + 64 * (j))
#define XB_XSUB(j)  (1280 + 64 * (j))
#define XB_XGEN(j)  (2304 + 64 * (j))
#define XB_TOP      3328
#define XB_TOPGEN   3392
#define XCD_BAR_WORDS 3456
#define XB_SPIN_CAP (1u << 18)
#define LAS __attribute__((address_space(3)))

__device__ __forceinline__ unsigned xb_ld(unsigned* p)              { return __hip_atomic_load(p, __ATOMIC_RELAXED, __HIP_MEMORY_SCOPE_AGENT); }
__device__ __forceinline__ unsigned xb_add(unsigned* p, unsigned v) { return __hip_atomic_fetch_add(p, v, __ATOMIC_RELAXED, __HIP_MEMORY_SCOPE_AGENT); }
__device__ __forceinline__ unsigned xb_xcc_id() { return (unsigned)__builtin_amdgcn_s_getreg((3 << 11) | 20) & 0xFu; }
#define XB_SPIN(cond, bar) do { unsigned _sp = 0; while (cond) { __builtin_amdgcn_s_sleep(1); \
    if ((++_sp & 255u) == 0u) { if (xb_ld(&(bar)[XB_TMO])) break; if (_sp > XB_SPIN_CAP) { atomicAdd(&(bar)[XB_TMO], 1u); break; } } } } while (0)

struct XcdBarrier {
    unsigned* bar; unsigned x;
    volatile LAS unsigned* st;
};

__device__ __forceinline__ XcdBarrier xcd_barrier_post(unsigned* bar, volatile LAS unsigned* st) {
    XcdBarrier b; b.bar = bar; b.x = xb_xcc_id(); b.st = st;
    if (threadIdx.x == 0) (void)xb_add(&bar[XB_XCNT(b.x)], 1u);
    return b;
}
__device__ __forceinline__ void xcd_barrier_complete(unsigned* bar, unsigned x, unsigned& nloc, unsigned& nx) {
    const unsigned G = gridDim.x * gridDim.y * gridDim.z;
    unsigned sum, cnt, mine, sp = 0u;
    for (;;) {
        sum = 0u; cnt = 0u; mine = 0u;
#pragma unroll
        for (unsigned j = 0; j < 16; ++j) { const unsigned c = xb_ld(&bar[XB_XCNT(j)]); sum += c; cnt += (c > 0u) ? 1u : 0u; mine = (j == x) ? c : mine; }
        if (sum == G) break;
        __builtin_amdgcn_s_sleep(1);
        if ((++sp & 255u) == 0u) { if (xb_ld(&bar[XB_TMO])) break; if (sp > XB_SPIN_CAP) { atomicAdd(&bar[XB_TMO], 1u); break; } }
    }
    nloc = mine > 0u ? mine : 1u; nx = cnt > 0u ? cnt : 1u;
}

__device__ __forceinline__ void xcd_barrier(const XcdBarrier& b) {
    asm volatile("s_waitcnt vmcnt(0)" ::: "memory");
    __syncthreads();
    if (threadIdx.x == 0) {
        unsigned* bar = b.bar;
        __builtin_amdgcn_s_waitcnt(0);
        unsigned nloc = b.st[0], nx = b.st[1];
        if (nloc == 0u) { xcd_barrier_complete(bar, b.x, nloc, nx); b.st[0] = nloc; b.st[1] = nx; }
        const unsigned old = xb_add(&bar[XB_XSUB(b.x)], 1u);
        const unsigned gen = old / nloc;
        if (old + 1u == (gen + 1u) * nloc) {
            __builtin_amdgcn_fence(__ATOMIC_RELEASE, "agent");
            asm volatile("s_waitcnt vmcnt(0)" ::: "memory");
            const unsigned og = xb_add(&bar[XB_TOP], 1u);
            const unsigned tg = og / nx;
            if (og + 1u == (tg + 1u) * nx) xb_add(&bar[XB_TOPGEN], 1u);
            else XB_SPIN(xb_ld(&bar[XB_TOPGEN]) == tg, bar);
            __builtin_amdgcn_fence(__ATOMIC_ACQUIRE, "agent");
            xb_add(&bar[XB_XGEN(b.x)], 1u);
            asm volatile("s_waitcnt vmcnt(0)" ::: "memory");
        } else {
            XB_SPIN(xb_ld(&bar[XB_XGEN(b.x)]) == gen, bar);
            __builtin_amdgcn_fence(__ATOMIC_ACQUIRE, "agent");
            asm volatile("s_waitcnt vmcnt(0)" ::: "memory");
        }
    }
    __syncthreads();
}


DEVINL int tid_() { int t = threadIdx.x; asm volatile("" : "+v"(t)); return t; }
DEVINL int bid_() { int b = blockIdx.x; asm volatile("" : "+s"(b)); return b; }
#define GAS __attribute__((address_space(1)))
DEVINL char* wsl_(char* w) { GAS char* g = (GAS char*)w; asm volatile("" : "+s"(g)); return (char*)g; }
template <class Tp> DEVINL const Tp* gl_(const Tp* q) { const GAS Tp* g = (const GAS Tp*)q; asm volatile("" : "+s"(g)); return (const Tp*)g; }
typedef float f32x2_t __attribute__((ext_vector_type(2)));
typedef __bf16 bf16x2_t __attribute__((ext_vector_type(2)));
DEVINL unsigned pk2bf(float lo, float hi) { f32x2_t f = {lo, hi}; bf16x2_t b = __builtin_convertvector(f, bf16x2_t); return __builtin_bit_cast(unsigned, b); }
DEVINL u16 f2bf(float f) { return (u16)(pk2bf(f, f) & 0xFFFFu); }
DEVINL float bf2f(u16 h) { return __uint_as_float(((unsigned)h) << 16); }
DEVINL float wsum(float v) { for (int o = 32; o > 0; o >>= 1) v += __shfl_xor(v, o); return v; }
DEVINL float sigmoidf_(float x) { return 1.f / (1.f + __expf(-x)); }
DEVINL float siluf_(float x) { return x / (1.f + __expf(-x)); }
DEVINL float softplusf_(float x) { return fmaxf(x, 0.f) + log1pf(__expf(-fabsf(x))); }
DEVINL int row_sel(int row) { return row < CTXROWS ? 2 : ((row - CTXROWS) >> 14); }
template <int CTRL, int RM>
DEVINL float dpp_f(float v) { return __int_as_float(__builtin_amdgcn_update_dpp(0, __float_as_int(v), CTRL, RM, 0xF, false)); }
DEVINL float wave_sum_dpp(float v) {
    v += dpp_f<0xB1, 0xF>(v);
    v += dpp_f<0x4E, 0xF>(v);
    v += dpp_f<0x141, 0xF>(v);
    v += dpp_f<0x140, 0xF>(v);
    v += dpp_f<0x142, 0xA>(v);
    v += dpp_f<0x143, 0xC>(v);
    return __int_as_float(__builtin_amdgcn_readlane(__float_as_int(v), 63));
}
DEVINL unsigned lds_addr(const void* p) { return (unsigned)(size_t)(const __attribute__((address_space(3))) char*)p; }
using u32x4 = __attribute__((ext_vector_type(4))) unsigned;
using u32x2 = __attribute__((ext_vector_type(2))) unsigned;
template <int OFF> DEVINL u32x4 lds_rd128(unsigned a) { u32x4 v; asm volatile("ds_read_b128 %0, %1 offset:%2" : "=v"(v) : "v"(a), "n"(OFF)); return v; }
template <int OFF> DEVINL u32x2 lds_rd64(unsigned a) { u32x2 v; asm volatile("ds_read_b64 %0, %1 offset:%2" : "=v"(v) : "v"(a), "n"(OFF)); return v; }
DEVINL void glds4(const void* g, void* l) {
    __builtin_amdgcn_global_load_lds((const __attribute__((address_space(1))) void*)g, (__attribute__((address_space(3))) void*)l, 4, 0, 0);
}
DEVINL void glds16nt(const void* g, void* l) {
    __builtin_amdgcn_global_load_lds((const __attribute__((address_space(1))) void*)g, (__attribute__((address_space(3))) void*)l, 16, 0, 2);
}
DEVINL void glds16(const void* g, void* l) {
    __builtin_amdgcn_global_load_lds((const __attribute__((address_space(1))) void*)g, (__attribute__((address_space(3))) void*)l, 16, 0, 0);
}

template <class RowA>
DEVINL void gemm128_acc(RowA rowA, const u16* __restrict__ Bt, int ldb, int K, char* smem, f32x4 (&acc)[4][4]) {
    const int tid = tid_(), lane = tid & 63, wid = tid >> 6, wr = wid >> 1, wc = wid & 1, fr = lane & 15, fq = lane >> 4;
#pragma unroll
    for (int m = 0; m < 4; ++m)
#pragma unroll
        for (int n = 0; n < 4; ++n) acc[m][n] = f32x4{0.f, 0.f, 0.f, 0.f};
    const int sc = ((tid & 7) ^ ((tid >> 3) & 7)) * 8;
    const u16* aS[4]; const u16* bS[4];
#pragma unroll
    for (int i = 0; i < 4; ++i) { const int r = (tid >> 3) + 32 * i; aS[i] = rowA(r) + sc; bS[i] = Bt + (size_t)r * ldb + sc; }
    const int nt = K >> 6;
    __syncthreads();
#pragma unroll
    for (int i = 0; i < 4; ++i) { glds16(aS[i], smem + (tid + 256 * i) * 16); glds16(bS[i], smem + 16384 + (tid + 256 * i) * 16); }
    for (int t = 0; t < nt; ++t) {
        asm volatile("s_waitcnt vmcnt(0)" ::: "memory");
        __builtin_amdgcn_s_barrier();
        if (t + 1 < nt) {
            char* SA = smem + ((t + 1) & 1) * 32768;
            const int ko = (t + 1) * 64;
#pragma unroll
            for (int i = 0; i < 4; ++i) { glds16(aS[i] + ko, SA + (tid + 256 * i) * 16); glds16(bS[i] + ko, SA + 16384 + (tid + 256 * i) * 16); }
        }
        const char* SA = smem + (t & 1) * 32768; const char* SB = SA + 16384;
#pragma unroll
        for (int ks = 0; ks < 2; ++ks) {
            const int pos = ((ks * 4 + fq) ^ (fr & 7)) * 16;
            bf16x8 af[4], bfr[4];
#pragma unroll
            for (int m = 0; m < 4; ++m) af[m] = *(const bf16x8*)(SA + (wr * 64 + m * 16 + fr) * 128 + pos);
#pragma unroll
            for (int n = 0; n < 4; ++n) bfr[n] = *(const bf16x8*)(SB + (wc * 64 + n * 16 + fr) * 128 + pos);
#pragma unroll
            for (int m = 0; m < 4; ++m)
#pragma unroll
                for (int n = 0; n < 4; ++n) acc[m][n] = __builtin_amdgcn_mfma_f32_16x16x32_bf16(af[m], bfr[n], acc[m][n], 0, 0, 0);
        }
    }
}
template <class RowA, class Epi>
DEVINL void gemm128(RowA rowA, const u16* __restrict__ Bt, int ldb, int K, char* smem, Epi epi) {
    const int tid = tid_(), lane = tid & 63, wid = tid >> 6, wr = wid >> 1, wc = wid & 1, fr = lane & 15, fq = lane >> 4;
    f32x4 acc[4][4];
    gemm128_acc(rowA, Bt, ldb, K, smem, acc);
#pragma unroll
    for (int m = 0; m < 4; ++m)
#pragma unroll
        for (int n = 0; n < 4; ++n) epi(wr * 64 + m * 16 + fq * 4, wc * 64 + n * 16 + fr, acc[m][n]);
}

template <class Emit>
DEVINL void stage_tile_bf16(const f32x4 (&acc)[4][4], char* smem, Emit emit) {
    const int tid = tid_(), lane = tid & 63, wid = tid >> 6, wr = wid >> 1, wc = wid & 1, fr = lane & 15, fq = lane >> 4;
    u16* t = (u16*)smem;
    __syncthreads();
#pragma unroll
    for (int m = 0; m < 4; ++m)
#pragma unroll
        for (int n = 0; n < 4; ++n) {
            const int r0 = wr * 64 + m * 16 + fq * 4, c = wc * 64 + n * 16 + fr;
            const unsigned p01 = pk2bf(acc[m][n][0], acc[m][n][1]), p23 = pk2bf(acc[m][n][2], acc[m][n][3]);
            t[(r0 + 0) * 136 + c] = (u16)(p01 & 0xFFFFu); t[(r0 + 1) * 136 + c] = (u16)(p01 >> 16);
            t[(r0 + 2) * 136 + c] = (u16)(p23 & 0xFFFFu); t[(r0 + 3) * 136 + c] = (u16)(p23 >> 16);
        }
    __syncthreads();
#pragma unroll
    for (int i = 0; i < 8; ++i) {
        const int ci = tid + 256 * i, row = ci >> 4, c8 = (ci & 15) * 8;
        emit(row, c8, *(const uint4*)(t + row * 136 + c8));
    }
}

template <class Emit>
DEVINL void stage_tile_f32(const f32x4 (&acc)[4][4], char* smem, Emit emit) {
    const int tid = tid_(), lane = tid & 63, wid = tid >> 6, wr = wid >> 1, wc = wid & 1, fr = lane & 15, fq = lane >> 4;
    float* t = (float*)smem;
    __syncthreads();
#pragma unroll
    for (int m = 0; m < 4; ++m)
#pragma unroll
        for (int n = 0; n < 4; ++n) {
            const int r0 = wr * 64 + m * 16 + fq * 4, c = wc * 64 + n * 16 + fr;
#pragma unroll
            for (int j = 0; j < 4; ++j) t[(r0 + j) * 132 + c] = acc[m][n][j];
        }
    __syncthreads();
#pragma unroll 4
    for (int i = 0; i < 16; ++i) {
        const int ci = tid + 256 * i, row = ci >> 5, c4 = (ci & 31) * 4;
        emit(row, c4, *(const float4*)(t + row * 132 + c4));
    }
}

DEVINL void ph_prolog(const P& p, char* smem) {
    const int TIDX_ = tid_(); const int BIDX_ = bid_(); char* const WS_ = wsl_(p.ws); (void)TIDX_; (void)BIDX_; (void)WS_;
    const int tid = TIDX_;
    float* modv = (float*)(WS_ + OFF_MOD);
    float* sil = (float*)smem;
    float* red = sil + 3072;
    bool ready = false;
    for (int u = BIDX_; u < 192; u += gridDim.x) {
        if (!ready) {
            for (int i = tid; i < 3072; i += 256) { int v = i >> 10, k = i & 1023; float cv = v < 2 ? p.c[v * 1024 + k] : p.c_ctx[k]; sil[i] = cv / (1.f + expf(-cv)); }
            ready = true;
        }
        __syncthreads();
        const int l = u / 96, cg = u % 96;
        const float* W = p.w_mod + (size_t)l * 1024 * 6144 + cg * 64;
        const int c4 = (tid & 15) * 4, rg = tid >> 4;
        float a0[4] = {0, 0, 0, 0}, a1[4] = {0, 0, 0, 0}, a2[4] = {0, 0, 0, 0};
#pragma unroll 4
        for (int i = 0; i < 64; ++i) {
            const int k = rg + 16 * i;
            const float4 w = *(const float4*)(W + (size_t)k * 6144 + c4);
            const float s0 = sil[k], s1 = sil[1024 + k], s2 = sil[2048 + k];
            a0[0] += s0 * w.x; a0[1] += s0 * w.y; a0[2] += s0 * w.z; a0[3] += s0 * w.w;
            a1[0] += s1 * w.x; a1[1] += s1 * w.y; a1[2] += s1 * w.z; a1[3] += s1 * w.w;
            a2[0] += s2 * w.x; a2[1] += s2 * w.y; a2[2] += s2 * w.z; a2[3] += s2 * w.w;
        }
#pragma unroll
        for (int j = 0; j < 4; ++j) { red[(rg * 3 + 0) * 64 + c4 + j] = a0[j]; red[(rg * 3 + 1) * 64 + c4 + j] = a1[j]; red[(rg * 3 + 2) * 64 + c4 + j] = a2[j]; }
        __syncthreads();
        if (tid < 192) {
            const int v = tid >> 6, cc = tid & 63;
            float s = 0.f;
            for (int r = 0; r < 16; ++r) s += red[(r * 3 + v) * 64 + cc];
            const int col = cg * 64 + cc;
            modv[(l * 3 + v) * 6144 + col] = s + p.b_mod[l * 6144 + col];
        }
        __syncthreads();
    }
    float* rope = (float*)(WS_ + OFF_ROPE);
    for (int i = BIDX_ * 256 + tid; i < 320 * 16; i += gridDim.x * 256) {
        const int pos = (i < 4096) ? (i >> 4) : ((i - 4096) >> 4);
        const int f = i & 15;
        const float inv = powf(10000.0f, -(float)f / 16.0f);
        const float ang = (float)pos * inv;
        const double TWO_PI = 6.283185307179586476925;
        double a = (double)ang;
        a -= TWO_PI * rint(a / TWO_PI);
        const float cr = (float)cos(a), sr = (float)sin(a);
        if (i < 4096) { rope[i] = cr; rope[4096 + i] = sr; }
        else { rope[8192 + (i - 4096)] = cr; rope[8192 + 1024 + (i - 4096)] = sr; }
    }
    {
        u16* w2t = (u16*)(WS_ + OFF_LORA); u16* a2t = w2t + 2 * 2 * 256 * 32; u16* g2t = a2t + 2 * 2 * 256 * 32;
        for (int i = BIDX_ * 256 + tid; i < 2 * 2 * 256 * 32; i += gridDim.x * 256) {
            const int lz = i >> 13, c = (i >> 5) & 255, r = i & 31;
            w2t[i] = f2bf(p.rw_w2[((size_t)lz * 32 + r) * 256 + c]);
            a2t[i] = f2bf(p.rw_a2[((size_t)lz * 32 + r) * 256 + c]);
        }
        for (int i = BIDX_ * 256 + tid; i < 2 * 256 * 64; i += gridDim.x * 256) {
            const int l = i >> 14, c = (i >> 6) & 255, r = i & 63;
            g2t[i] = f2bf(p.rw_g2[((size_t)l * 64 + r) * 256 + c]);
        }
    }
    u16* wr = (u16*)(WS_ + OFF_WR);
    for (int i = BIDX_ * 256 + tid; i < 2 * 128 * 1024; i += gridDim.x * 256) {
        const int l = i >> 17, n = (i >> 10) & 127, k = i & 1023;
        float v = 0.f;
        if (n < 4) v = p.rgw[((size_t)l * 1024 + k) * 4 + n];
        else if (n < 36) v = p.rew[((size_t)l * 1024 + k) * 32 + (n - 4)];
        wr[i] = f2bf(v);
    }
}

DEVINL void conv_tile(const float* __restrict__ src, int N, int K, u16* __restrict__ dst, int k0, int n0, int mode, char* smem) {
    unsigned* t = (unsigned*)smem;
    const int tid = tid_();
    const int n4 = (tid & 15) * 4;
    const bool ok = n0 + n4 < N;
    float4 va[2], vb[2];
    __syncthreads();
#pragma unroll
    for (int i = 0; i < 2; ++i) {
        const int kp = i * 16 + (tid >> 4);
        const float* s0 = src + (size_t)(k0 + 2 * kp) * N + n0 + n4;
        va[i] = ok ? *(const float4*)s0 : make_float4(0.f, 0.f, 0.f, 0.f);
        vb[i] = ok ? *(const float4*)(s0 + N) : make_float4(0.f, 0.f, 0.f, 0.f);
    }
#pragma unroll
    for (int i = 0; i < 2; ++i) {
        const int kp = i * 16 + (tid >> 4);
        t[(n4 + 0) * 33 + kp] = pk2bf(va[i].x, vb[i].x);
        t[(n4 + 1) * 33 + kp] = pk2bf(va[i].y, vb[i].y);
        t[(n4 + 2) * 33 + kp] = pk2bf(va[i].z, vb[i].z);
        t[(n4 + 3) * 33 + kp] = pk2bf(va[i].w, vb[i].w);
    }
    __syncthreads();
    {
        const int n = tid >> 2, w0 = (tid & 3) * 8;
        const int ng = n0 + n;
        int nd = ng;
        if (mode == 1) nd = 32 * (ng >> 4) + (ng & 15);
        else if (mode == 2) nd = 32 * (ng >> 4) + 16 + (ng & 15);
        uint4 o0, o1;
        o0.x = t[n * 33 + w0 + 0]; o0.y = t[n * 33 + w0 + 1]; o0.z = t[n * 33 + w0 + 2]; o0.w = t[n * 33 + w0 + 3];
        o1.x = t[n * 33 + w0 + 4]; o1.y = t[n * 33 + w0 + 5]; o1.z = t[n * 33 + w0 + 6]; o1.w = t[n * 33 + w0 + 7];
        u16* q = dst + (size_t)nd * K + k0 + w0 * 2;
        *(uint4*)q = o0; *(uint4*)(q + 8) = o1;
    }
}
DEVINL void ph_convw(const P& p, int l, char* smem) {
    const int TIDX_ = tid_(); const int BIDX_ = bid_(); char* const WS_ = wsl_(p.ws); (void)TIDX_; (void)BIDX_; (void)WS_;
    u16* win = (u16*)(WS_ + OFF_WIN); u16* wout = (u16*)(WS_ + OFF_WOUT);
    for (int u = BIDX_; u < 896 + 256; u += gridDim.x) {
        if (u < 896) conv_tile(p.w_in + (size_t)l * 1024 * INP, INP, 1024, win, (u / 56) * 64, (u % 56) * 64, 0, smem);
        else { const int v = u - 896; conv_tile(p.w_out + (size_t)l * 1024 * 1024, 1024, 1024, wout, (v / 16) * 64, (v % 16) * 64, 0, smem); }
    }
}
DEVINL void ph_convexp(const P& p, int l, char* smem, int bid, int nb) {
    const int TIDX_ = tid_(); const int BIDX_ = bid_(); char* const WS_ = wsl_(p.ws); (void)TIDX_; (void)BIDX_; (void)WS_;
    u16* wgu = (u16*)(WS_ + OFF_WGU); u16* wdn = (u16*)(WS_ + OFF_WDN);
    for (int u = bid; u < 32 * 384; u += nb) {
        const int e = u / 384, v = u % 384;
        const size_t le = (size_t)l * 32 + e;
        if (v < 128) conv_tile(p.egate + le * 1024 * 512, 512, 1024, wgu + (size_t)e * 1024 * 1024, (v / 8) * 64, (v % 8) * 64, 1, smem);
        else if (v < 256) { const int w = v - 128; conv_tile(p.eup + le * 1024 * 512, 512, 1024, wgu + (size_t)e * 1024 * 1024, (w / 8) * 64, (w % 8) * 64, 2, smem); }
        else { const int w = v - 256; conv_tile(p.edown + le * 512 * 1024, 1024, 512, wdn + (size_t)e * 1024 * 512, (w / 16) * 64, (w % 16) * 64, 0, smem); }
    }
}

DEVINL void ph_xm0(const P& p) {
    const int TIDX_ = tid_(); const int BIDX_ = bid_(); char* const WS_ = wsl_(p.ws); (void)TIDX_; (void)BIDX_; (void)WS_;
    const float* modv = (const float*)(WS_ + OFF_MOD);
    u16* hm = (u16*)(WS_ + OFF_HM);
    for (size_t i = (size_t)BIDX_ * 256 + TIDX_; i < (size_t)T * 256; i += (size_t)gridDim.x * 256) {
        const int row = (int)(i >> 8), c4 = (int)(i & 255) * 4;
        const float* src = row < CTXROWS ? p.ctx + (size_t)row * 1024 : p.x + (size_t)(row - CTXROWS) * 1024;
        const float* mv = modv + row_sel(row) * 6144;
        const float4 v = *(const float4*)(src + c4);
        const float4 sh = *(const float4*)(mv + c4), sc = *(const float4*)(mv + 1024 + c4);
        uint2 o;
        o.x = (unsigned)f2bf(v.x * (1.f + sc.x) + sh.x) | ((unsigned)f2bf(v.y * (1.f + sc.y) + sh.y) << 16);
        o.y = (unsigned)f2bf(v.z * (1.f + sc.z) + sh.z) | ((unsigned)f2bf(v.w * (1.f + sc.w) + sh.w) << 16);
        *(uint2*)(hm + (size_t)row * 1024 + c4) = o;
    }
}

DEVINL void ph_inproj(const P& p, char* smem) {
    const int TIDX_ = tid_(); const int BIDX_ = bid_(); char* const WS_ = wsl_(p.ws); (void)TIDX_; (void)BIDX_; (void)WS_;
    const u16* hm = (const u16*)(WS_ + OFF_HM);
    const u16* win = (const u16*)(WS_ + OFF_WIN);
    u16* pqk = (u16*)(WS_ + OFF_PQK); u16* vtl = (u16*)(WS_ + OFF_VTL); u16* vtc = (u16*)(WS_ + OFF_VTC);
    u16* pb = (u16*)(WS_ + OFF_PB); u16* pc = (u16*)(WS_ + OFF_PC);
    for (int u = BIDX_; u < 260 * 28; u += gridDim.x) {
        const int mt = u / 28, nt = u % 28;
        const u16* A = hm + (size_t)mt * 128 * 1024;
        f32x4 acc[4][4];
        gemm128_acc([&](int r) { return A + (size_t)r * 1024; }, win + (size_t)nt * 128 * 1024, 1024, 1024, smem, acc);
        if (nt >= 8 && nt < 12) {
            const int tid = tid_(), lane = tid & 63, wid = tid >> 6, wr = wid >> 1, wc = wid & 1, fr = lane & 15, fq = lane >> 4;
#pragma unroll
            for (int m = 0; m < 4; ++m)
#pragma unroll
                for (int n = 0; n < 4; ++n) {
                    const int R = mt * 128 + wr * 64 + m * 16 + fq * 4, N = nt * 128 + wc * 64 + n * 16 + fr;
                    const int hh = (N - 1024) >> 6, d = (N - 1024) & 63;
                    uint2 v; v.x = pk2bf(acc[m][n][0], acc[m][n][1]); v.y = pk2bf(acc[m][n][2], acc[m][n][3]);
                    if (R < CTXROWS) { const int b = R >> 8, t = R & 255; *(uint2*)(vtc + ((size_t)((b * 8 + hh) * 64 + d)) * 256 + t) = v; }
                    else { const int R2 = R - CTXROWS, b = R2 >> 14, t = R2 & 16383; *(uint2*)(vtl + ((size_t)((b * 8 + hh) * 64 + d)) * 16384 + t) = v; }
                }
        } else {
            stage_tile_bf16(acc, smem, [&](int row, int c8, uint4 v) {
                const int R = mt * 128 + row, N = nt * 128 + c8;
                if (N >= INP) return;
                if (N < 1024) *(uint4*)(pqk + (size_t)R * 1024 + N) = v;
                else if (N < 2496) *(uint4*)(pb + (size_t)R * 960 + (N - 1536)) = v;
                else *(uint4*)(pc + (size_t)R * 1040 + (N - 2496)) = v;
            });
        }
    }
}

constexpr size_t RWREC = 12288;
constexpr size_t RW_A1 = 0, RW_A4 = 2048, RW_A3 = 4096, RW_MKA = 8192, RW_TT = 8704, RW_MY = 9216, RW_V = 10240;
constexpr size_t OFF_RWOP = OFF_X1;
constexpr size_t OFF_RWWG = OFF_RWOP + (size_t)16 * 520 * RWREC;
constexpr size_t OFF_YRWB = OFF_RWWG + (size_t)16 * 130 * 64 * 4;
constexpr size_t OFF_BONUS = OFF_YRWB + (size_t)T * 256 * 2;
static_assert(OFF_BONUS + (size_t)T * 4 * 4 <= OFF_HM, "rw operand store must fit the X1 region");

DEVINL float rw_mix(const u16* __restrict__ pb, const float* __restrict__ mup, const float* __restrict__ mun, int row, int t, int seqlen, int col) {
    const float cu = bf2f(pb[(size_t)row * 960 + col]);
    const float pr = t > 0 ? bf2f(pb[(size_t)(row - 1) * 960 + col]) : 0.f;
    const float nx = t + 1 < seqlen ? bf2f(pb[(size_t)(row + 1) * 960 + col]) : 0.f;
    return cu + mup[col] * (pr - cu) + mun[col] * (nx - cu);
}

DEVINL void rw_mix8(const u16* __restrict__ pb, const float* __restrict__ mup, const float* __restrict__ mun, int row, int t, int seqlen, int col0, float (&o)[8]) {
    const bool hp = t > 0, hn = t + 1 < seqlen;
    const u32x4 c = *(const u32x4*)(pb + (size_t)row * 960 + col0);
    u32x4 pv = *(const u32x4*)(pb + (size_t)(hp ? row - 1 : row) * 960 + col0);
    u32x4 nx = *(const u32x4*)(pb + (size_t)(hn ? row + 1 : row) * 960 + col0);
    const unsigned mpv = hp ? 0xFFFFFFFFu : 0u, mnx = hn ? 0xFFFFFFFFu : 0u;
    const f32x4 mp0 = *(const f32x4*)(mup + col0), mp1 = *(const f32x4*)(mup + col0 + 4), mn0 = *(const f32x4*)(mun + col0), mn1 = *(const f32x4*)(mun + col0 + 4);
#pragma unroll
    for (int i = 0; i < 4; ++i) {
        const unsigned cw = c[i], pw = pv[i] & mpv, nw = nx[i] & mnx;
        const float c0 = __uint_as_float(cw << 16), c1 = __uint_as_float(cw & 0xFFFF0000u);
        const float p0 = __uint_as_float(pw << 16), p1 = __uint_as_float(pw & 0xFFFF0000u);
        const float n0 = __uint_as_float(nw << 16), n1 = __uint_as_float(nw & 0xFFFF0000u);
        const float ma = (i < 2) ? mp0[2 * i] : mp1[2 * i - 4], mb = (i < 2) ? mp0[2 * i + 1] : mp1[2 * i - 3];
        const float na = (i < 2) ? mn0[2 * i] : mn1[2 * i - 4], nb = (i < 2) ? mn0[2 * i + 1] : mn1[2 * i - 3];
        o[2 * i] = c0 + ma * (p0 - c0) + na * (n0 - c0);
        o[2 * i + 1] = c1 + mb * (p1 - c1) + nb * (n1 - c1);
    }
}
DEVINL uint4 pack8bf(const float (&v)[8]) { return make_uint4(pk2bf(v[0], v[1]), pk2bf(v[2], v[3]), pk2bf(v[4], v[5]), pk2bf(v[6], v[7])); }

DEVINL void ph_rwprep(const P& p, int l, int half, char* smem, int bid, int nb) {
    const int TIDX_ = tid_(); const int BIDX_ = bid_(); char* const WS_ = wsl_(p.ws);
    const int tid = TIDX_, lane = tid & 63, w = tid >> 6, fr = lane & 15, fq = lane >> 4;
    const u16* pb = (const u16*)(WS_ + OFF_PB);
    char* rwop = WS_ + OFF_RWOP;
    float* rwwg = (float*)(WS_ + OFF_RWWG);
    float* bonus = (float*)(WS_ + OFF_BONUS);
    u16* gate = (u16*)(WS_ + OFF_GATE);
    const float* mup = p.mu_prev + l * 960; const float* mun = p.mu_next + l * 960;
    u16* lwdh = (u16*)smem;
    u16* ladh = lwdh + 2048;
    u16* abuf = ladh + 2048;
    float* Lb = (float*)(smem + 16384);
    u16* SV = (u16*)(smem + 32768);
    float* tot = (float*)(smem + 32768);
    const u16* w2t = (const u16*)(WS_ + OFF_LORA);
    const u16* a2t = w2t + 2 * 2 * 256 * 32;
    const u16* g2t = a2t + 2 * 2 * 256 * 32;
    for (int uh = bid; uh < 2 * 2 * 130 * 4; uh += nb) {
        const int h = uh & 3, rest = uh >> 2;
        const int d = rest / 260, b = (rest % 260) / 130, gl = rest % 130;
        const int z = d;
        const int gscan = half * 130 + gl;
        int gi, row0, seqlen;
        if (gscan < 4) { gi = d ? 3 - gscan : gscan; row0 = b * 256 + gi * 64; seqlen = 256; }
        else { gi = d ? 255 - (gscan - 4) : gscan - 4; row0 = CTXROWS + b * LAT + gi * 64; seqlen = LAT; }
        const int t0 = gi * 64;
        __syncthreads();
        {
            const int j = tid >> 2, cq = tid & 3;
            float v[8];
            rw_mix8(pb, mup, mun, row0 + j, t0 + j, seqlen, 768 + z * 32 + 8 * cq, v);
#pragma unroll
            for (int i = 0; i < 8; ++i) v[i] = tanhf(v[i]);
            *(uint4*)(lwdh + j * 32 + 8 * cq) = pack8bf(v);
            rw_mix8(pb, mup, mun, row0 + j, t0 + j, seqlen, 832 + z * 32 + 8 * cq, v);
            *(uint4*)(ladh + j * 32 + 8 * cq) = pack8bf(v);
        }
        if (d == 0) {
            u16* lgd = (u16*)Lb;
            {
                const int j = tid >> 2, cq = tid & 3;
#pragma unroll
                for (int hh = 0; hh < 2; ++hh) {
                    float v[8];
                    rw_mix8(pb, mup, mun, row0 + j, t0 + j, seqlen, 896 + 16 * cq + 8 * hh, v);
#pragma unroll
                    for (int i = 0; i < 8; ++i) v[i] = sigmoidf_(v[i]);
                    *(uint4*)(lgd + j * 64 + 16 * cq + 8 * hh) = pack8bf(v);
                }
            }
            __syncthreads();
            const bf16x8 x0 = *(const bf16x8*)(lgd + (16 * w + fr) * 64 + 8 * fq), x1 = *(const bf16x8*)(lgd + (16 * w + fr) * 64 + 32 + 8 * fq);
#pragma unroll
            for (int nt = 0; nt < 4; ++nt) {
                const u16* bp = g2t + ((size_t)l * 256 + 64 * h + 16 * nt + fr) * 64 + 8 * fq;
                const bf16x8 b0 = *(const bf16x8*)bp, b1 = *(const bf16x8*)(bp + 32);
                f32x4 acc = f32x4{0.f, 0.f, 0.f, 0.f};
                acc = __builtin_amdgcn_mfma_f32_16x16x32_bf16(x0, b0, acc, 0, 0, 0);
                acc = __builtin_amdgcn_mfma_f32_16x16x32_bf16(x1, b1, acc, 0, 0, 0);
#pragma unroll
                for (int r = 0; r < 4; ++r) gate[(size_t)(row0 + 16 * w + 4 * fq + r) * 256 + 64 * h + 16 * nt + fr] = f2bf(acc[r]);
            }
        }
        {
            const int bh = b * 4 + h;
            const int ch = h * 64 + lane;
            __syncthreads();
            {
                const bf16x8 xw = *(const bf16x8*)(lwdh + (16 * w + fr) * 32 + 8 * fq);
                const bf16x8 xa = *(const bf16x8*)(ladh + (16 * w + fr) * 32 + 8 * fq);
#pragma unroll 1
                for (int kt = 0; kt < 4; ++kt) {
                    const int key = 16 * kt + fr;
                    const size_t wrow = ((size_t)(l * 2 + z) * 256 + h * 64 + key) * 32 + 8 * fq;
                    const bf16x8 bw = *(const bf16x8*)(w2t + wrow), ba = *(const bf16x8*)(a2t + wrow);
                    f32x4 ae = f32x4{0.f, 0.f, 0.f, 0.f}, aa = f32x4{0.f, 0.f, 0.f, 0.f};
                    ae = __builtin_amdgcn_mfma_f32_16x16x32_bf16(xw, bw, ae, 0, 0, 0);
                    aa = __builtin_amdgcn_mfma_f32_16x16x32_bf16(xa, ba, aa, 0, 0, 0);
                    const float w0 = p.rw_w0[(l * 2 + z) * 256 + h * 64 + key], a0 = p.rw_a0[(l * 2 + z) * 256 + h * 64 + key];
#pragma unroll
                    for (int r = 0; r < 4; ++r) {
                        const int tok = 16 * w + 4 * fq + r;
                        const int s = d ? 63 - tok : tok;
                        Lb[s * 64 + key] = 0.60653065971263342f * sigmoidf_(ae[r] + w0);
                        abuf[tok * 64 + key] = f2bf(sigmoidf_(aa[r] + a0));
                    }
                }
            }
            __syncthreads();
            {
                float pre[16]; float run = 0.f;
#pragma unroll
                for (int i = 0; i < 16; ++i) { run += Lb[(16 * w + i) * 64 + lane]; pre[i] = run; }
                tot[w * 64 + lane] = run;
                __syncthreads();
                float offs = 0.f;
#pragma unroll
                for (int ww = 0; ww < 3; ++ww) offs += (ww < w) ? tot[ww * 64 + lane] : 0.f;
#pragma unroll
                for (int i = 0; i < 16; ++i) Lb[(16 * w + i) * 64 + lane] = -(offs + pre[i]);
            }
            __syncthreads();
            {
                const int j = tid >> 2, kq = tid & 3, row = row0 + j, tt = t0 + j;
                const int c0 = h * 64 + 16 * kq;
                float kr[16];
                { float t8[8];
                  rw_mix8(pb, mup, mun, row, tt, seqlen, 256 + c0, t8);
#pragma unroll
                  for (int i = 0; i < 8; ++i) kr[i] = t8[i];
                  rw_mix8(pb, mup, mun, row, tt, seqlen, 256 + c0 + 8, t8);
#pragma unroll
                  for (int i = 0; i < 8; ++i) kr[8 + i] = t8[i]; }
                float ss = 0.f;
#pragma unroll
                for (int i = 0; i < 16; ++i) { const float kv = kr[i] * p.rw_kk[l * 256 + c0 + i]; ss += kv * kv; }
                ss += __shfl_xor(ss, 1); ss += __shfl_xor(ss, 2);
                const float inorm = 1.f / fmaxf(sqrtf(ss), 1e-12f);
                const int sidx = d ? 63 - j : j;
                const int cch = sidx >> 4, ts = sidx & 15;
                u16* sv = SV + (size_t)(cch * 4) * 1024 + ts * 64 + 16 * kq;
                float bs = 0.f;
#pragma unroll 1
                for (int hh = 0; hh < 2; ++hh) {
                    const int cb = c0 + 8 * hh;
                    float rr[8], av[8], oa[8], orr[8], ob[8], ok[8];
                    rw_mix8(pb, mup, mun, row, tt, seqlen, cb, rr);
                    { const uint4 a0 = *(const uint4*)(abuf + j * 64 + 16 * kq + 8 * hh);
                      const unsigned aw[4] = {a0.x, a0.y, a0.z, a0.w};
#pragma unroll
                      for (int i = 0; i < 4; ++i) { av[2 * i] = __uint_as_float(aw[i] << 16); av[2 * i + 1] = __uint_as_float(aw[i] & 0xFFFF0000u); } }
#pragma unroll
                    for (int i4 = 0; i4 < 2; ++i4) {
                        const float4 Lt4 = *(const float4*)(Lb + sidx * 64 + 16 * kq + 8 * hh + 4 * i4);
                        const float4 Lp4 = sidx > 0 ? *(const float4*)(Lb + (sidx - 1) * 64 + 16 * kq + 8 * hh + 4 * i4) : make_float4(0.f, 0.f, 0.f, 0.f);
                        const float Lt[4] = {Lt4.x, Lt4.y, Lt4.z, Lt4.w}, Lp[4] = {Lp4.x, Lp4.y, Lp4.z, Lp4.w};
#pragma unroll
                        for (int ii = 0; ii < 4; ++ii) {
                            const int i = 4 * i4 + ii;
                            const float kraw = hh ? kr[8 + i] : kr[i];
                            const float kkn = kraw * p.rw_kk[l * 256 + cb + i] * inorm, a = av[i];
                            const float et = __expf(Lt[ii]), einv = __builtin_amdgcn_rcpf(et);
                            oa[i] = -kkn * __expf(Lp[ii]);
                            orr[i] = rr[i] * et;
                            ob[i] = kkn * a * einv;
                            ok[i] = kraw * (1.f + (a - 1.f) * p.rw_ka[l * 256 + cb + i]) * einv;
                            bs += rr[i] * kraw * p.rw_rk[l * 256 + cb + i];
                            if (sidx == 63) rwwg[((size_t)(d * 8 + bh) * 130 + gl) * 64 + 16 * kq + 8 * hh + i] = et;
                        }
                    }
                    *(uint4*)(sv + 8 * hh) = pack8bf(oa);
                    *(uint4*)(sv + 1024 + 8 * hh) = pack8bf(orr);
                    *(uint4*)(sv + 2048 + 8 * hh) = pack8bf(ob);
                    *(uint4*)(sv + 3072 + 8 * hh) = pack8bf(ok);
                    rw_mix8(pb, mup, mun, row, tt, seqlen, 512 + cb, rr);
                    *(uint4*)(abuf + j * 64 + 16 * kq + 8 * hh) = pack8bf(rr);
                }
                if (d == 0) { bs += __shfl_xor(bs, 1); bs += __shfl_xor(bs, 2); if (kq == 0) bonus[(size_t)row * 4 + h] = bs; }
            }
            __syncthreads();
            {
                char* rec = rwop + ((size_t)(d * 8 + bh) * 520 + (size_t)gl * 4 + w) * RWREC;
                const u16* Av = SV + (size_t)(w * 4) * 1024; const u16* Rv = Av + 1024; const u16* Bv = Av + 2048; const u16* Kv = Av + 3072;
                bf16x8 fa[2], frr[2], fb[2], fk[2];
#pragma unroll
                for (int ks = 0; ks < 2; ++ks) {
                    fa[ks] = *(const bf16x8*)(Av + fr * 64 + ks * 32 + fq * 8);
                    frr[ks] = *(const bf16x8*)(Rv + fr * 64 + ks * 32 + fq * 8);
                    fb[ks] = *(const bf16x8*)(Bv + fr * 64 + ks * 32 + fq * 8);
                    fk[ks] = *(const bf16x8*)(Kv + fr * 64 + ks * 32 + fq * 8);
                }
                f32x4 mka = f32x4{0.f, 0.f, 0.f, 0.f}, mba = mka, mkr = mka, mbr = mka;
#pragma unroll
                for (int ks = 0; ks < 2; ++ks) {
                    mka = __builtin_amdgcn_mfma_f32_16x16x32_bf16(fa[ks], fk[ks], mka, 0, 0, 0);
                    mba = __builtin_amdgcn_mfma_f32_16x16x32_bf16(fa[ks], fb[ks], mba, 0, 0, 0);
                    mkr = __builtin_amdgcn_mfma_f32_16x16x32_bf16(frr[ks], fk[ks], mkr, 0, 0, 0);
                    mbr = __builtin_amdgcn_mfma_f32_16x16x32_bf16(frr[ks], fb[ks], mbr, 0, 0, 0);
                }
                float* Ns = Lb + w * 256;
                float* Ts = Lb + 1024 + w * 256;
                u16* rmka = (u16*)(rec + RW_MKA); u16* rmy = (u16*)(rec + RW_MY);
                const int i_ = fr;
#pragma unroll
                for (int r = 0; r < 4; ++r) {
                    const int t_ = 4 * fq + r;
                    const int lp = (i_ >> 2) * 16 + t_;
                    mka[r] = i_ < t_ ? mka[r] : 0.f;
                    rmy[lp * 8 + (i_ & 3)] = f2bf(i_ <= t_ ? mbr[r] : 0.f);
                    rmy[lp * 8 + 4 + (i_ & 3)] = f2bf(i_ <= t_ ? mkr[r] : 0.f);
                    Ns[t_ * 16 + i_] = i_ < t_ ? mba[r] : 0.f;
                }
                if (lane < 16) {
                    float Tr[16];
#pragma unroll
                    for (int ii = 0; ii < 16; ++ii) Tr[ii] = 0.f;
#pragma unroll 1
                    for (int t_ = 0; t_ < 16; ++t_) {
                        float acc = (lane == t_) ? 1.f : 0.f;
#pragma unroll
                        for (int i4 = 0; i4 < 4; ++i4) {
                            const float4 nv = *(const float4*)(Ns + t_ * 16 + 4 * i4);
                            acc += Tr[4 * i4] * nv.x + Tr[4 * i4 + 1] * nv.y + Tr[4 * i4 + 2] * nv.z + Tr[4 * i4 + 3] * nv.w;
                        }
#pragma unroll
                        for (int ii = 0; ii < 16; ++ii) Tr[ii] = (ii == t_) ? acc : Tr[ii];
                        Ts[lane * 16 + t_] = acc;
                    }
                }
                bf16x8 TTf;
                {
                    const float t0v = Ts[(4 * fq + 0) * 16 + fr], t1v = Ts[(4 * fq + 1) * 16 + fr], t2v = Ts[(4 * fq + 2) * 16 + fr], t3v = Ts[(4 * fq + 3) * 16 + fr];
                    union { u32x4 u; bf16x8 f; } x; x.u = u32x4{pk2bf(t0v, t1v), pk2bf(t2v, t3v), 0u, 0u}; TTf = x.f;
                }
                {
                    union { u32x4 u; bf16x8 f; } mb; mb.u = u32x4{pk2bf(mka[0], mka[1]), pk2bf(mka[2], mka[3]), 0u, 0u};
                    f32x4 mk2 = f32x4{0.f, 0.f, 0.f, 0.f};
                    mk2 = __builtin_amdgcn_mfma_f32_16x16x32_bf16(TTf, mb.f, mk2, 0, 0, 0);
#pragma unroll
                    for (int r = 0; r < 4; ++r) { const int t_ = 4 * fq + r; rmka[((i_ >> 2) * 16 + t_) * 4 + (i_ & 3)] = f2bf(mk2[r]); }
                }
                {
                    f32x4 ap[4];
#pragma unroll
                    for (int m = 0; m < 4; ++m) {
                        union { u32x4 u; bf16x8 f; } ag;
                        ag.u = u32x4{(unsigned)Av[(4 * fq + 0) * 64 + 16 * m + fr] | ((unsigned)Av[(4 * fq + 1) * 64 + 16 * m + fr] << 16),
                                     (unsigned)Av[(4 * fq + 2) * 64 + 16 * m + fr] | ((unsigned)Av[(4 * fq + 3) * 64 + 16 * m + fr] << 16), 0u, 0u};
                        ap[m] = f32x4{0.f, 0.f, 0.f, 0.f};
                        ap[m] = __builtin_amdgcn_mfma_f32_16x16x32_bf16(ag.f, TTf, ap[m], 0, 0, 0);
                    }
#pragma unroll
                    for (int ks = 0; ks < 2; ++ks) {
                        uint4 o;
                        o.x = pk2bf(ap[2 * ks][0], ap[2 * ks][1]); o.y = pk2bf(ap[2 * ks][2], ap[2 * ks][3]);
                        o.z = pk2bf(ap[2 * ks + 1][0], ap[2 * ks + 1][1]); o.w = pk2bf(ap[2 * ks + 1][2], ap[2 * ks + 1][3]);
                        *(uint4*)(rec + RW_A1 + (ks * 64 + lane) * 16) = o;
                    }
                }
#pragma unroll
                for (int ks = 0; ks < 2; ++ks) {
                    uint4 o;
                    const uint2 lo2 = *(const uint2*)(Rv + fr * 64 + 32 * ks + 4 * fq), hi2 = *(const uint2*)(Rv + fr * 64 + 32 * ks + 16 + 4 * fq);
                    o.x = lo2.x; o.y = lo2.y; o.z = hi2.x; o.w = hi2.y;
                    *(uint4*)(rec + RW_A4 + (ks * 64 + lane) * 16) = o;
                }
#pragma unroll
                for (int m = 0; m < 4; ++m) {
                    unsigned e[8];
#pragma unroll
                    for (int j = 0; j < 4; ++j) { e[j] = Bv[(4 * fq + j) * 64 + 16 * m + fr]; e[4 + j] = Kv[(4 * fq + j) * 64 + 16 * m + fr]; }
                    uint4 o; o.x = e[0] | (e[1] << 16); o.y = e[2] | (e[3] << 16); o.z = e[4] | (e[5] << 16); o.w = e[6] | (e[7] << 16);
                    *(uint4*)(rec + RW_A3 + (m * 64 + lane) * 16) = o;
                }
#pragma unroll
                for (int q = 0; q < 4; ++q) {
                    unsigned e[4];
#pragma unroll
                    for (int j = 0; j < 4; ++j) {
                        const int s = 16 * w + 4 * fq + j; const int jt = d ? 63 - s : s;
                        e[j] = abuf[jt * 64 + 16 * q + fr];
                    }
                    uint2 o; o.x = e[0] | (e[1] << 16); o.y = e[2] | (e[3] << 16);
                    *(uint2*)(rec + RW_V + (q * 64 + lane) * 8) = o;
                }
            }
        }
    }
}

constexpr int RWSLOT = 12544;
DEVINL void ph_rwscan(const P& p, int l, int half, int bid, int nb, char* smem) {
    const int TIDX_ = tid_(); char* const WS_ = wsl_(p.ws);
    const int tid = TIDX_, lane = tid & 63, q = tid >> 6, fr = lane & 15, fq = lane >> 4;
    const char* rwop = WS_ + OFF_RWOP;
    const float* rwwg = (const float*)(WS_ + OFF_RWWG);
    u16* yf = (u16*)(WS_ + OFF_Y);
    u16* yb = (u16*)(WS_ + OFF_YRWB);
    (void)l;
    float* zst = (float*)(WS_ + OFF_ZST);
    for (int dbh = bid; dbh < 16; dbh += nb) {
        const int d = dbh >> 3, bh = dbh & 7, b = bh >> 2, h = bh & 3;
        f32x4 z[4];
        float* zp = zst + ((size_t)(dbh * 4 + q) * 64 + lane) * 16;
#pragma unroll
        for (int m = 0; m < 4; ++m) {
            if (half == 0) z[m] = f32x4{0.f, 0.f, 0.f, 0.f};
            else { const float4 t4 = *(const float4*)(zp + 4 * m); z[m] = f32x4{t4.x, t4.y, t4.z, t4.w}; }
        }
        const int cbase = half * 520;
        const char* rec0 = rwop + (size_t)dbh * 520 * RWREC;
        const float* wg0 = rwwg + (size_t)dbh * 130 * 64;
        constexpr int RD = 6;
        u32x4 rb[RD][3]; float rwgA = 0.f, rwgB = 0.f;
        auto ldrec = [&](int c, auto I) {
            constexpr int i = decltype(I)::value;
            const int cc = c < 520 ? c : 519;
            const char* rec = rec0 + (size_t)cc * RWREC;
#pragma unroll
            for (int k = 0; k < 3; ++k) rb[i][k] = *(const u32x4*)(rec + (tid + 256 * k) * 16);
        };
        auto strec = [&](auto I, int slotidx) {
            constexpr int i = decltype(I)::value;
            char* slot = smem + slotidx * RWSLOT;
#pragma unroll
            for (int k = 0; k < 3; ++k) *(u32x4*)(slot + (tid + 256 * k) * 16) = rb[i][k];
        };
        auto asfrag = [](uint4 v) { union { uint4 u; bf16x8 f; } x; x.u = v; return x.f; };
        auto pack2 = [](float lo, float hi) { return pk2bf(lo, hi); };
        const unsigned b128 = lds_addr(smem) + lane * 16, b64 = lds_addr(smem) + lane * 8, bv = lds_addr(smem) + (q * 64 + lane) * 8, bg = lds_addr(smem) + 16 * fq;
        __syncthreads();
        __builtin_amdgcn_s_setprio(3);
#define IC(n) std::integral_constant<int, n>{}
        auto flush_y = [&](int cprev, int par) {
            if (tid < 128) {
                const int cg = cbase + cprev;
                const bool isctx = cg < 16;
                const int cc = isctx ? cg : cg - 16;
                const int n = isctx ? LCTX : LAT;
                const int rowbase = isctx ? b * LCTX : CTXROWS + b * LAT;
                const int ts = tid >> 3, c8 = (tid & 7) * 8;
                const int sidx = cc * 16 + ts;
                const int t = d ? n - 1 - sidx : sidx;
                const u32x4 v = *(const u32x4*)(smem + 4 * RWSLOT + par * 2048 + (ts * 64 + c8) * 2);
                u16* dst = d == 0 ? yf + (size_t)(rowbase + t) * 1024 + 512 + h * 64 + c8 : yb + (size_t)(rowbase + t) * 256 + h * 64 + c8;
                *(u32x4*)dst = v;
            }
        };
        u32x4 f4[2][6]; u32x2 f2[2][2];
#define RD_ISSUE(par, SBC) asm volatile( \
                "ds_read_b64 %6, %9 offset:%11+8192\n\t" \
                "ds_read_b64 %7, %10 offset:%11+10240\n\t" \
                "ds_read_b128 %0, %8 offset:%11+0\n\t" \
                "ds_read_b128 %1, %8 offset:%11+1024\n\t" \
                "ds_read_b128 %2, %8 offset:%11+4096\n\t" \
                "ds_read_b128 %3, %8 offset:%11+5120\n\t" \
                "ds_read_b128 %4, %8 offset:%11+6144\n\t" \
                "ds_read_b128 %5, %8 offset:%11+7168" \
                : "=&v"(f4[par][0]), "=&v"(f4[par][1]), "=&v"(f4[par][2]), "=&v"(f4[par][3]), "=&v"(f4[par][4]), "=&v"(f4[par][5]), \
                  "=&v"(f2[par][0]), "=&v"(f2[par][1]) \
                : "v"(b128), "v"(b64), "v"(bv), "n"(SBC) \
                : "memory")
#define RD_WAIT(par) asm volatile("s_waitcnt lgkmcnt(0)" \
                : "+v"(f4[par][0]), "+v"(f4[par][1]), "+v"(f4[par][2]), "+v"(f4[par][3]), "+v"(f4[par][4]), "+v"(f4[par][5]), \
                  "+v"(f2[par][0]), "+v"(f2[par][1]) \
                :: "memory")
        ldrec(0, IC(0)); ldrec(1, IC(1)); ldrec(2, IC(2)); ldrec(3, IC(3)); ldrec(4, IC(4)); ldrec(5, IC(5));
        strec(IC(0), 0); ldrec(RD, IC(0));
        strec(IC(1), 1); ldrec(RD + 1, IC(1));
        rwgA = wg0[lane]; rwgB = wg0[64 + lane];
        asm volatile("s_waitcnt lgkmcnt(0)" ::: "memory");
        __builtin_amdgcn_s_barrier();
        RD_ISSUE(0, 0); RD_WAIT(0);
#pragma unroll 1
        for (int c5 = 0; c5 < 528; c5 += 12) {
          auto body = [&](auto SJ) {
            constexpr int sj = decltype(SJ)::value;
            constexpr int par = sj & 1;
            const int c = c5 + sj;
            asm volatile("s_waitcnt lgkmcnt(0)" ::: "memory");
            __builtin_amdgcn_s_barrier();
            RD_ISSUE(par ^ 1, ((sj + 1) % 4) * RWSLOT);
            if (c > 0 && c <= 520) flush_y(c - 1, par ^ 1);
            strec(IC((sj + 2) % 6), (sj + 2) % 4);
            ldrec(c + 2 + RD, IC((sj + 2) % 6));
            if ((sj & 3) == 1) {
                const bool even = (((c >> 2) & 1) == 0);
                if (q == 0) *(float*)(smem + ((sj + 2) % 4) * RWSLOT + 12288 + lane * 4) = even ? rwgA : rwgB;
                const int gn = (c >> 2) + 2;
                const float nv = wg0[(size_t)(gn < 130 ? gn : 129) * 64 + lane];
                if (even) rwgA = nv; else rwgB = nv;
            }
            if (c < 520) {
            constexpr int SB = (sj % 4) * RWSLOT;
            auto asfrag4 = [](u32x4 v) { union { u32x4 u; bf16x8 f; } x; x.u = v; return x.f; };
            const bf16x8 A1_0 = asfrag4(f4[par][0]), A1_1 = asfrag4(f4[par][1]);
            const bf16x8 A3_0 = asfrag4(f4[par][2]), A3_1 = asfrag4(f4[par][3]), A3_2 = asfrag4(f4[par][4]), A3_3 = asfrag4(f4[par][5]);
            const u32x2 mka = f2[par][0], vcur = f2[par][1];
            const bf16x8 MKA = asfrag(make_uint4(mka.x, mka.y, 0u, 0u));
            const bf16x8 VB = asfrag(make_uint4(vcur.x, vcur.y, 0u, 0u));
            const bf16x8 ZB0 = asfrag(make_uint4(pack2(z[0][0], z[0][1]), pack2(z[0][2], z[0][3]), pack2(z[1][0], z[1][1]), pack2(z[1][2], z[1][3])));
            const bf16x8 ZB1 = asfrag(make_uint4(pack2(z[2][0], z[2][1]), pack2(z[2][2], z[2][3]), pack2(z[3][0], z[3][1]), pack2(z[3][2], z[3][3])));
            f32x4 Ua = f32x4{0.f, 0.f, 0.f, 0.f}, Ub = f32x4{0.f, 0.f, 0.f, 0.f};
            Ua = __builtin_amdgcn_mfma_f32_16x16x32_bf16(MKA, VB, Ua, 0, 0, 0);
            Ub = __builtin_amdgcn_mfma_f32_16x16x32_bf16(A1_1, ZB1, Ub, 0, 0, 0);
            Ua = __builtin_amdgcn_mfma_f32_16x16x32_bf16(A1_0, ZB0, Ua, 0, 0, 0);
            u32x4 r_a40, r_a41, r_my;
            asm volatile(
                "ds_read_b128 %0, %3 offset:%4+2048\n\t"
                "ds_read_b128 %1, %3 offset:%4+3072\n\t"
                "ds_read_b128 %2, %3 offset:%4+9216\n\t"
                "s_waitcnt lgkmcnt(0)"
                : "=&v"(r_a40), "=&v"(r_a41), "=&v"(r_my) : "v"(b128), "n"(SB) : "memory");
            const bf16x8 A4_0 = asfrag4(r_a40), A4_1 = asfrag4(r_a41), MY = asfrag4(r_my);
            f32x4 Y = f32x4{0.f, 0.f, 0.f, 0.f};
            Y = __builtin_amdgcn_mfma_f32_16x16x32_bf16(A4_0, ZB0, Y, 0, 0, 0);
            Y = __builtin_amdgcn_mfma_f32_16x16x32_bf16(A4_1, ZB1, Y, 0, 0, 0);
            const f32x4 U = Ua + Ub;
            const bf16x8 UV = asfrag(make_uint4(pack2(U[0], U[1]), pack2(U[2], U[3]), vcur.x, vcur.y));
            z[0] = __builtin_amdgcn_mfma_f32_16x16x32_bf16(A3_0, UV, z[0], 0, 0, 0);
            z[1] = __builtin_amdgcn_mfma_f32_16x16x32_bf16(A3_1, UV, z[1], 0, 0, 0);
            z[2] = __builtin_amdgcn_mfma_f32_16x16x32_bf16(A3_2, UV, z[2], 0, 0, 0);
            z[3] = __builtin_amdgcn_mfma_f32_16x16x32_bf16(A3_3, UV, z[3], 0, 0, 0);
            Y = __builtin_amdgcn_mfma_f32_16x16x32_bf16(MY, UV, Y, 0, 0, 0);
            asm volatile("s_waitcnt lgkmcnt(0)" ::: "memory");
            if ((c & 3) == 3) {
                u32x4 g0, g1, g2, g3;
                asm volatile(
                    "ds_read_b128 %0, %4 offset:%5+12288\n\t"
                    "ds_read_b128 %1, %4 offset:%5+12352\n\t"
                    "ds_read_b128 %2, %4 offset:%5+12416\n\t"
                    "ds_read_b128 %3, %4 offset:%5+12480\n\t"
                    "s_waitcnt lgkmcnt(0)"
                    : "=&v"(g0), "=&v"(g1), "=&v"(g2), "=&v"(g3) : "v"(bg), "n"(SB) : "memory");
                z[0][0] *= __uint_as_float(g0.x); z[0][1] *= __uint_as_float(g0.y); z[0][2] *= __uint_as_float(g0.z); z[0][3] *= __uint_as_float(g0.w);
                z[1][0] *= __uint_as_float(g1.x); z[1][1] *= __uint_as_float(g1.y); z[1][2] *= __uint_as_float(g1.z); z[1][3] *= __uint_as_float(g1.w);
                z[2][0] *= __uint_as_float(g2.x); z[2][1] *= __uint_as_float(g2.y); z[2][2] *= __uint_as_float(g2.z); z[2][3] *= __uint_as_float(g2.w);
                z[3][0] *= __uint_as_float(g3.x); z[3][1] *= __uint_as_float(g3.y); z[3][2] *= __uint_as_float(g3.z); z[3][3] *= __uint_as_float(g3.w);
            }
            {
                u16* yl = (u16*)(smem + 4 * RWSLOT + par * 2048);
                const unsigned y01 = pk2bf(Y[0], Y[1]), y23 = pk2bf(Y[2], Y[3]);
                yl[(4 * fq + 0) * 64 + 16 * q + fr] = (u16)(y01 & 0xFFFFu);
                yl[(4 * fq + 1) * 64 + 16 * q + fr] = (u16)(y01 >> 16);
                yl[(4 * fq + 2) * 64 + 16 * q + fr] = (u16)(y23 & 0xFFFFu);
                yl[(4 * fq + 3) * 64 + 16 * q + fr] = (u16)(y23 >> 16);
            }
            }
            RD_WAIT(par ^ 1);
          };
          body(IC(0)); body(IC(1)); body(IC(2)); body(IC(3)); body(IC(4)); body(IC(5)); body(IC(6)); body(IC(7)); body(IC(8)); body(IC(9)); body(IC(10)); body(IC(11));
        }
#pragma unroll
        for (int m = 0; m < 4; ++m) *(float4*)(zp + 4 * m) = make_float4(z[m][0], z[m][1], z[m][2], z[m][3]);
        asm volatile("s_waitcnt vmcnt(0)" ::: "memory");
        __builtin_amdgcn_s_setprio(0);
        __syncthreads();
    }
}

DEVINL void ph_rwout(const P& p, int l) {
    const int TIDX_ = tid_(); const int BIDX_ = bid_(); char* const WS_ = wsl_(p.ws);
    const int tid = TIDX_;
    const u16* pb = (const u16*)(WS_ + OFF_PB);
    const u16* yb = (const u16*)(WS_ + OFF_YRWB);
    const u16* gate = (const u16*)(WS_ + OFF_GATE);
    const float* bonus = (const float*)(WS_ + OFF_BONUS);
    u16* y = (u16*)(WS_ + OFF_Y);
    const float* mup = p.mu_prev + l * 960; const float* mun = p.mu_next + l * 960;
    const int c8 = (tid & 31) * 8, h = (tid & 31) >> 3;
    float lw[8], lb[8];
#pragma unroll
    for (int i = 0; i < 8; ++i) { lw[i] = p.rw_lnw[l * 256 + c8 + i]; lb[i] = p.rw_lnb[l * 256 + c8 + i]; }
    const int rstart = (l == 0) ? 0 : CTXROWS;
    for (int row = rstart + BIDX_ * 8 + (tid >> 5); row < T; row += gridDim.x * 8) {
        int t, seqlen;
        if (row < CTXROWS) { t = row & 255; seqlen = LCTX; } else { t = (row - CTXROWS) & (LAT - 1); seqlen = LAT; }
        const uint4 yfv = *(const uint4*)(y + (size_t)row * 1024 + 512 + c8), ybv = *(const uint4*)(yb + (size_t)row * 256 + c8);
        const uint4 gv = *(const uint4*)(gate + (size_t)row * 256 + c8);
        float v[8];
        rw_mix8(pb, mup, mun, row, t, seqlen, 512 + c8, v);
        const unsigned fw[4] = {yfv.x, yfv.y, yfv.z, yfv.w}, bw[4] = {ybv.x, ybv.y, ybv.z, ybv.w}, gw[4] = {gv.x, gv.y, gv.z, gv.w};
        float yv[8], gt[8]; float s1 = 0.f;
#pragma unroll
        for (int i = 0; i < 4; ++i) {
            yv[2 * i] = __uint_as_float(fw[i] << 16) + __uint_as_float(bw[i] << 16);
            yv[2 * i + 1] = __uint_as_float(fw[i] & 0xFFFF0000u) + __uint_as_float(bw[i] & 0xFFFF0000u);
            gt[2 * i] = __uint_as_float(gw[i] << 16); gt[2 * i + 1] = __uint_as_float(gw[i] & 0xFFFF0000u);
            s1 += yv[2 * i] + yv[2 * i + 1];
        }
        s1 += __shfl_xor(s1, 1); s1 += __shfl_xor(s1, 2); s1 += __shfl_xor(s1, 4);
        const float mu = s1 * (1.f / 64.f);
        float s2 = 0.f;
#pragma unroll
        for (int i = 0; i < 8; ++i) { const float dl = yv[i] - mu; s2 += dl * dl; }
        s2 += __shfl_xor(s2, 1); s2 += __shfl_xor(s2, 2); s2 += __shfl_xor(s2, 4);
        const float rstd = rsqrtf(s2 * (1.f / 64.f) + 64e-5f);
        const float bn = bonus[(size_t)row * 4 + h];
        float o[8];
#pragma unroll
        for (int i = 0; i < 8; ++i) o[i] = ((yv[i] - mu) * rstd * lw[i] + lb[i] + bn * v[i]) * gt[i];
        *(uint4*)(y + (size_t)row * 1024 + 512 + c8) = pack8bf(o);
    }
}
DEVINL void ph_prepM(const P& p, int l, char* smem, int bid, int nb) {
    const int TIDX_ = tid_(); const int BIDX_ = bid_(); char* const WS_ = wsl_(p.ws);
    const int tid = TIDX_, lane = tid & 63, wid = tid >> 6;
    const u16* pc = (const u16*)(WS_ + OFF_PC);
    u16* mlf = (u16*)(WS_ + OFF_MLF);
    float* mlg = (float*)(WS_ + OFF_MLG);
    float* mls = (float*)(WS_ + OFF_MLS);
    float* nst = (float*)(WS_ + OFF_NST);
    float* cst = (float*)(WS_ + OFF_HM);
    const float* rope = (const float*)(WS_ + OFF_ROPE);
    u16* kT = (u16*)smem;
    u16* vT = kT + 64 * 72;
    float* wsl = (float*)(vT + 64 * 72);
    float* lil = wsl + 128;
    for (int uh = bid; uh < NUNIT_CH * 4; uh += nb) {
        const int u = uh >> 2, h = uh & 3;
        int b, ch, row0, seqlen; bool isctx;
        if (u < 8) { isctx = true; b = u >> 2; ch = u & 3; row0 = b * 256 + ch * 64; seqlen = 256; }
        else { isctx = false; b = (u - 8) >> 8; ch = (u - 8) & 255; row0 = CTXROWS + b * LAT + ch * 64; seqlen = LAT; }
        const int t0 = ch * 64;
        const int tc = isctx ? ch : 4 + ch;
        __syncthreads();
        {
            const bool isk = wid >= 2;
            const int cch = (isk ? 256 : 0) + h * 64 + lane;
            const float* cw = p.ml_cw + (size_t)l * 3 * 512;
            const float w0 = cw[cch], w1 = cw[512 + cch], w2 = cw[1024 + cch], bb = p.ml_cb[l * 512 + cch];
            const int jb = (wid & 1) * 32;
            const int i16 = lane & 15; const bool second = (lane & 16) != 0; const int half = lane >> 5;
            float pv = (t0 + jb > 0) ? bf2f(pc[(size_t)(row0 + jb - 1) * 1040 + cch]) : 0.f;
            float cv = bf2f(pc[(size_t)(row0 + jb) * 1040 + cch]);
#pragma unroll 4
            for (int jj = 0; jj < 32; ++jj) {
                const int j = jb + jj;
                const float nv = (t0 + j + 1 < seqlen) ? bf2f(pc[(size_t)(row0 + j + 1) * 1040 + cch]) : 0.f;
                float val = siluf_(w0 * pv + w1 * cv + w2 * nv + bb);
                if (!isctx) {
                    const int t = t0 + j;
                    const int pos = half == 0 ? (t >> 6) : (t & 63);
                    const float cs = half == 0 ? rope[pos * 16 + i16] : rope[8192 + pos * 16 + i16];
                    const float sn = half == 0 ? rope[4096 + pos * 16 + i16] : rope[9216 + pos * 16 + i16];
                    const float ov = __shfl_xor(val, 16);
                    val = second ? (ov * sn + val * cs) : (val * cs - ov * sn);
                }
                if (isk) { const u16 kb = f2bf(val * 0.125f); mlf[(size_t)(row0 + j) * 512 + 256 + h * 64 + lane] = kb; kT[lane * 72 + j] = kb; }
                else mlf[(size_t)(row0 + j) * 512 + h * 64 + lane] = f2bf(val);
                pv = cv; cv = nv;
            }
            {
                const int j = tid >> 2, wh = tid & 3;
                const int idx = (wh < 2) ? (wh * 4 + h) : (8 + (wh - 2) * 4 + h);
                const float g = bf2f(pc[(size_t)(row0 + j) * 1040 + 1024 + idx]);
                float v;
                if (wh < 2) v = g + p.ml_ib[l * 8 + idx];
                else { const float xx = g + p.ml_fb[l * 8 + idx - 8]; v = fminf(xx, 0.f) - log1pf(__expf(-fabsf(xx))); }
                lil[j * 4 + wh] = v;
                if (wh < 2) mlg[(size_t)(row0 + j) * 16 + idx] = v;
            }
            for (int i = tid; i < 64 * 8; i += 256) {
                const int tok = i >> 3, d8 = (i & 7) * 8;
                const uint4 vv = *(const uint4*)(pc + (size_t)(row0 + tok) * 1040 + 512 + h * 64 + d8);
                const unsigned wv[4] = {vv.x, vv.y, vv.z, vv.w};
#pragma unroll
                for (int k = 0; k < 4; ++k) { vT[(d8 + 2 * k) * 72 + tok] = (u16)(wv[k] & 0xFFFFu); vT[(d8 + 2 * k + 1) * 72 + tok] = (u16)(wv[k] >> 16); }
            }
        }
        __syncthreads();
        if (wid < 2) {
            const int d = wid, tok = d ? 63 - lane : lane;
            float bsum = lil[tok * 4 + 2 + d];
#pragma unroll
            for (int off = 1; off < 64; off <<= 1) { const float o = __shfl_up(bsum, off); if (lane >= off) bsum += o; }
            const float Bs = __shfl(bsum, 63);
            const float gl = Bs - bsum + lil[tok * 4 + d];
            float G = gl;
#pragma unroll
            for (int off = 32; off > 0; off >>= 1) G = fmaxf(G, __shfl_xor(G, off));
            wsl[d * 64 + tok] = __expf(gl - G);
            mlg[(size_t)(row0 + tok) * 16 + 8 + d * 4 + h] = bsum;
            if (lane == 0) { const int bhd = (b * 4 + h) * 2 + d; mls[(bhd * NTC + tc) * 2 + 0] = G; mls[(bhd * NTC + tc) * 2 + 1] = Bs; }
        }
        __syncthreads();
        {
            const int fr = lane & 15, g = lane >> 4;
            const int bh0 = ((b * 4 + h) * 2 + 0) * NTC + tc, bh1 = ((b * 4 + h) * 2 + 1) * NTC + tc;
            bf16x8 va[2];
            va[0] = *(const bf16x8*)(vT + (16 * wid + fr) * 72 + 8 * g);
            va[1] = *(const bf16x8*)(vT + (16 * wid + fr) * 72 + 32 + 8 * g);
#pragma unroll 1
            for (int dkt = 0; dkt < 4; ++dkt) {
                f32x4 u0 = f32x4{0.f, 0.f, 0.f, 0.f}, u1 = f32x4{0.f, 0.f, 0.f, 0.f};
#pragma unroll
                for (int ks = 0; ks < 2; ++ks) {
                    const uint4 kv = *(const uint4*)(kT + (16 * dkt + fr) * 72 + 32 * ks + 8 * g);
                    const float4 wa0 = *(const float4*)(wsl + 32 * ks + 8 * g), wa1 = *(const float4*)(wsl + 32 * ks + 8 * g + 4);
                    const float4 wb0 = *(const float4*)(wsl + 64 + 32 * ks + 8 * g), wb1 = *(const float4*)(wsl + 64 + 32 * ks + 8 * g + 4);
                    const unsigned kw[4] = {kv.x, kv.y, kv.z, kv.w};
                    const float w0[8] = {wa0.x, wa0.y, wa0.z, wa0.w, wa1.x, wa1.y, wa1.z, wa1.w}, w1[8] = {wb0.x, wb0.y, wb0.z, wb0.w, wb1.x, wb1.y, wb1.z, wb1.w};
                    union { u32x4 u; bf16x8 f; } b0, b1;
#pragma unroll
                    for (int i = 0; i < 4; ++i) {
                        const float ka = __uint_as_float(kw[i] << 16), kb = __uint_as_float(kw[i] & 0xFFFF0000u);
                        b0.u[i] = pk2bf(ka * w0[2 * i], kb * w0[2 * i + 1]);
                        b1.u[i] = pk2bf(ka * w1[2 * i], kb * w1[2 * i + 1]);
                    }
                    u0 = __builtin_amdgcn_mfma_f32_16x16x32_bf16(va[ks], b0.f, u0, 0, 0, 0);
                    u1 = __builtin_amdgcn_mfma_f32_16x16x32_bf16(va[ks], b1.f, u1, 0, 0, 0);
                }
#pragma unroll
                for (int r = 0; r < 4; ++r) {
                    cst[(size_t)bh0 * 4096 + (16 * wid + 4 * g + r) * 64 + 16 * dkt + fr] = u0[r];
                    cst[(size_t)bh1 * 4096 + (16 * wid + 4 * g + r) * 64 + 16 * dkt + fr] = u1[r];
                }
            }
            if (tid < 128) {
                const int d = tid >> 6, dk = tid & 63;
                float acc = 0.f;
#pragma unroll 8
                for (int j = 0; j < 64; ++j) acc += bf2f(kT[dk * 72 + j]) * wsl[d * 64 + j];
                nst[(size_t)(d ? bh1 : bh0) * 64 + dk] = acc;
            }
        }
    }
}

DEVINL void ph_mlB(const P& p, int bid, int nb, char* smem) {
    const int TIDX_ = tid_(); char* const WS_ = wsl_(p.ws);
    const int tid = TIDX_;
    const float* mls = (const float*)(WS_ + OFF_MLS);
    float* mst = (float*)(WS_ + OFF_MST);
    float* nst = (float*)(WS_ + OFF_NST);
    const float* cst = (const float*)(WS_ + OFF_HM);
    u16* cst2 = (u16*)(WS_ + OFF_CST2);
    float* nst2 = (float*)(WS_ + OFF_NST2);
    float* gb = (float*)smem;
    float* dcu = gb + 1024;
    for (int u = bid; u < 64; u += nb) {
        const int bhd = u >> 2, q = u & 3, d = bhd & 1;
        auto tcof = [&](int cs) { return cs < 4 ? (d ? 3 - cs : cs) : 4 + (d ? 255 - (cs - 4) : cs - 4); };
        __syncthreads();
        for (int cs = tid; cs < NTC; cs += 256) { const int tc = tcof(cs); gb[cs * 2] = mls[(bhd * NTC + tc) * 2]; gb[cs * 2 + 1] = mls[(bhd * NTC + tc) * 2 + 1]; }
        __syncthreads();
        if (tid == 0) {
            float m = 0.f;
#pragma unroll 1
            for (int cs = 0; cs < NTC; ++cs) {
                const float G = gb[cs * 2], Bs = gb[cs * 2 + 1];
                if (q == 0) mst[bhd * NTC + tcof(cs)] = m;
                const float ml = fmaxf(Bs + m, G);
                dcu[cs * 2] = __expf(Bs + m - ml); dcu[cs * 2 + 1] = __expf(G - ml);
                m = ml;
            }
        }
        __syncthreads();
        float zz = 0.f; asm volatile("" : "+v"(zz));
        float4 C = make_float4(zz, zz, zz, zz);
        float nn = zz;
        const bool don = (q == 0) && (tid < 64);
        const float* cbase = cst + (size_t)bhd * NTC * 4096 + q * 1024 + tid * 4;
        const float* nbase = nst + (size_t)bhd * NTC * 64 + tid;
        u16* obase = cst2 + (size_t)bhd * NTC * 4096 + q * 1024 + tid * 4;
        float* onbase = nst2 + (size_t)bhd * NTC * 64 + tid;
        float4 Ub[8]; float Nb[8];
#pragma unroll
        for (int i = 0; i < 8; ++i) { Ub[i] = *(const float4*)(cbase + (size_t)tcof(i) * 4096); Nb[i] = don ? nbase[(size_t)tcof(i) * 64] : 0.f; }
#pragma unroll 1
        for (int cs0 = 0; cs0 < NTC; cs0 += 8) {
#pragma unroll
            for (int i = 0; i < 8; ++i) {
                const int cs = cs0 + i;
                if (cs < NTC) {
                    const float4 U = Ub[i]; const float nU = Nb[i];
                    const int tc = tcof(cs);
                    if (cs + 8 < NTC) { Ub[i] = *(const float4*)(cbase + (size_t)tcof(cs + 8) * 4096); Nb[i] = don ? nbase[(size_t)tcof(cs + 8) * 64] : 0.f; }
                    { uint2 o; o.x = pk2bf(C.x, C.y); o.y = pk2bf(C.z, C.w); *(uint2*)(obase + (size_t)tc * 4096) = o; }
                    if (don) onbase[(size_t)tc * 64] = nn;
                    const float dC = dcu[cs * 2], dU = dcu[cs * 2 + 1];
                    C.x = dC * C.x + dU * U.x; C.y = dC * C.y + dU * U.y; C.z = dC * C.z + dU * U.z; C.w = dC * C.w + dU * U.w;
                    nn = dC * nn + dU * nU;
                }
            }
        }
    }
}

DEVINL void ph_na(const P& p, int l, char* smem, int bid, int nb) {
    const int TIDX_ = tid_(); char* const WS_ = wsl_(p.ws);
    const int tid = TIDX_, lane = tid & 63, w = tid >> 6, fr = lane & 15, g = lane >> 4;
    const u16* pqk = (const u16*)(WS_ + OFF_PQK);
    const u16* vtl = (const u16*)(WS_ + OFF_VTL);
    const u16* vtc = (const u16*)(WS_ + OFF_VTC);
    u16* y = (u16*)(WS_ + OFF_Y);
    float* rpbl = (float*)(smem + 49152);
    const int nunit = 4096 + (l == 0 ? 64 : 0);
    const unsigned lbase = lds_addr(smem);
    const int lrow0 = tid >> 3, lrow1 = lrow0 + 32, lsc = ((tid & 7) ^ (lrow0 & 7)) * 8;
    for (int u = bid; u < nunit; u += nb) {
        const bool isctx = u >= 4096;
        int b, h, r = 0, qg = 0;
        if (!isctx) { b = u >> 11; h = (u >> 8) & 7; r = u & 255; }
        else { const int v = u - 4096; b = v >> 5; h = (v >> 2) & 7; qg = v & 3; }
        const int rs = min(max(r - 4, 0), 248);
        const int nwin = isctx ? 0 : 8, nst = nwin + 4;
        auto issue = [&](int st) {
            char* slot = smem + (st % 3) * 16384;
            const u16* ksrc; const u16* vsrc; size_t vstride;
            if (st < nwin) {
                const size_t tok0 = (size_t)CTXROWS + (size_t)b * LAT + (size_t)(rs + st) * 64;
                ksrc = pqk + tok0 * 1024 + 512 + h * 64;
                vsrc = vtl + (size_t)((b * 8 + h) * 64) * LAT + (size_t)(rs + st) * 64; vstride = LAT;
            } else {
                const size_t tok0 = (size_t)b * LCTX + (size_t)(st - nwin) * 64;
                ksrc = pqk + tok0 * 1024 + 512 + h * 64;
                vsrc = vtc + (size_t)((b * 8 + h) * 64) * LCTX + (size_t)(st - nwin) * 64; vstride = LCTX;
            }
            glds16(ksrc + (size_t)lrow0 * 1024 + lsc, slot + tid * 16);
            glds16(ksrc + (size_t)lrow1 * 1024 + lsc, slot + 4096 + tid * 16);
            glds16(vsrc + (size_t)lrow0 * vstride + lsc, slot + 8192 + tid * 16);
            glds16(vsrc + (size_t)lrow1 * vstride + lsc, slot + 8192 + 4096 + tid * 16);
        };
        __syncthreads();
        issue(0); issue(1);
        if (!isctx) for (int i = tid; i < 465; i += 256) rpbl[i] = p.na_rpb[((size_t)l * 8 + h) * 465 + i];
        asm volatile("s_waitcnt lgkmcnt(0)" ::: "memory");
        const int c = 16 * w + fr;
        const int qrow = isctx ? b * LCTX + qg * 64 + c : CTXROWS + b * LAT + r * 64 + c;
        bf16x8 qf[2];
        qf[0] = *(const bf16x8*)(pqk + (size_t)qrow * 1024 + h * 64 + 8 * g);
        qf[1] = *(const bf16x8*)(pqk + (size_t)qrow * 1024 + h * 64 + 32 + 8 * g);
        f32x4 O[4];
#pragma unroll
        for (int i = 0; i < 4; ++i) O[i] = f32x4{0.f, 0.f, 0.f, 0.f};
        float mrun = -1.0e30f, lrun = 0.f;
        const int cb = (w == 0) ? 0 : (w == 1) ? 8 : (w == 2) ? 24 : 32;
        const int cs = min(max(c - 8, 0), 48);
        auto chunk = [&](unsigned sl, int kb, const float* bias0, bool local) {
            const int key0 = kb + fr, key1 = kb + 16 + fr;
            const unsigned ka0 = sl + key0 * 128, ka1 = sl + key1 * 128;
            const unsigned k00a = ka0 + ((g ^ (key0 & 7)) << 4), k01a = ka0 + (((4 + g) ^ (key0 & 7)) << 4);
            const unsigned k10a = ka1 + ((g ^ (key1 & 7)) << 4), k11a = ka1 + (((4 + g) ^ (key1 & 7)) << 4);
            const int q0 = (kb >> 2) + g, q1 = q0 + 4;
            const unsigned vbase = sl + 8192 + fr * 128;
            const unsigned vo0 = ((((q0 >> 1) ^ (fr & 7)) << 4) + ((q0 & 1) << 3)), vo1 = ((((q1 >> 1) ^ (fr & 7)) << 4) + ((q1 & 1) << 3));
            u32x4 k00, k01, k10, k11; u32x2 vlo0, vhi0, vlo1, vhi1, vlo2, vhi2, vlo3, vhi3;
            asm volatile(
                "ds_read_b128 %0, %12\n\t"
                "ds_read_b128 %1, %13\n\t"
                "ds_read_b128 %2, %14\n\t"
                "ds_read_b128 %3, %15\n\t"
                "ds_read_b64 %4, %16\n\t"
                "ds_read_b64 %5, %17\n\t"
                "ds_read_b64 %6, %16 offset:2048\n\t"
                "ds_read_b64 %7, %17 offset:2048\n\t"
                "ds_read_b64 %8, %16 offset:4096\n\t"
                "ds_read_b64 %9, %17 offset:4096\n\t"
                "ds_read_b64 %10, %16 offset:6144\n\t"
                "ds_read_b64 %11, %17 offset:6144\n\t"
                "s_waitcnt lgkmcnt(0)"
                : "=&v"(k00), "=&v"(k01), "=&v"(k10), "=&v"(k11), "=&v"(vlo0), "=&v"(vhi0), "=&v"(vlo1), "=&v"(vhi1),
                  "=&v"(vlo2), "=&v"(vhi2), "=&v"(vlo3), "=&v"(vhi3)
                : "v"(k00a), "v"(k01a), "v"(k10a), "v"(k11a), "v"(vbase + vo0), "v"(vbase + vo1)
                : "memory");
            auto asf = [](u32x4 v) { union { u32x4 u; bf16x8 f; } x; x.u = v; return x.f; };
            f32x4 s0 = f32x4{0.f, 0.f, 0.f, 0.f}, s1 = f32x4{0.f, 0.f, 0.f, 0.f};
            s0 = __builtin_amdgcn_mfma_f32_16x16x32_bf16(asf(k00), qf[0], s0, 0, 0, 0);
            s0 = __builtin_amdgcn_mfma_f32_16x16x32_bf16(asf(k01), qf[1], s0, 0, 0, 0);
            s1 = __builtin_amdgcn_mfma_f32_16x16x32_bf16(asf(k10), qf[0], s1, 0, 0, 0);
            s1 = __builtin_amdgcn_mfma_f32_16x16x32_bf16(asf(k11), qf[1], s1, 0, 0, 0);
            float sv[8];
#pragma unroll
            for (int j = 0; j < 4; ++j) {
                float a = s0[j] * 0.125f, bb = s1[j] * 0.125f;
                if (local) {
                    const int k0c = kb + 4 * g + j, k1c = k0c + 16;
                    a = (k0c >= cs && k0c <= cs + 15) ? a + bias0[k0c] : -1.0e30f;
                    bb = (k1c >= cs && k1c <= cs + 15) ? bb + bias0[k1c] : -1.0e30f;
                }
                sv[j] = a; sv[4 + j] = bb;
            }
            float mx = sv[0];
#pragma unroll
            for (int j = 1; j < 8; ++j) mx = fmaxf(mx, sv[j]);
            mx = fmaxf(mx, __shfl_xor(mx, 16)); mx = fmaxf(mx, __shfl_xor(mx, 32));
            const float mnew = fmaxf(mrun, mx);
            const float sc = __expf(mrun - mnew);
            mrun = mnew;
            float ps = 0.f; float pv[8];
#pragma unroll
            for (int j = 0; j < 8; ++j) { pv[j] = __expf(sv[j] - mnew); ps += pv[j]; }
            lrun = lrun * sc + ps;
            union { u32x4 u; bf16x8 f; } pf; pf.u = u32x4{pk2bf(pv[0], pv[1]), pk2bf(pv[2], pv[3]), pk2bf(pv[4], pv[5]), pk2bf(pv[6], pv[7])};
            const u32x2 vl[4] = {vlo0, vlo1, vlo2, vlo3}, vh[4] = {vhi0, vhi1, vhi2, vhi3};
#pragma unroll
            for (int dt = 0; dt < 4; ++dt) {
                O[dt][0] *= sc; O[dt][1] *= sc; O[dt][2] *= sc; O[dt][3] *= sc;
                union { u32x4 u; bf16x8 f; } vf; vf.u = u32x4{vl[dt].x, vl[dt].y, vh[dt].x, vh[dt].y};
                O[dt] = __builtin_amdgcn_mfma_f32_16x16x32_bf16(vf.f, pf.f, O[dt], 0, 0, 0);
            }
        };
#pragma unroll 1
        for (int st = 0; st < nst; ++st) {
            if (st + 1 < nst) asm volatile("s_waitcnt vmcnt(4)" ::: "memory"); else asm volatile("s_waitcnt vmcnt(0)" ::: "memory");
            __builtin_amdgcn_s_barrier();
            if (st + 2 < nst) issue(st + 2);
            const unsigned sl = lbase + (st % 3) * 16384;
            if (st < nwin) {
                const int krow = rs + st;
                chunk(sl, cb, rpbl + (krow - r + 7) * 31 - c + 15, true);
            } else {
                chunk(sl, 0, nullptr, false);
                chunk(sl, 32, nullptr, false);
            }
        }
        float lt = lrun; lt += __shfl_xor(lt, 16); lt += __shfl_xor(lt, 32);
        const float inv = 1.f / lt;
#pragma unroll
        for (int dt = 0; dt < 4; ++dt) {
            uint2 o;
            o.x = pk2bf(O[dt][0] * inv, O[dt][1] * inv);
            o.y = pk2bf(O[dt][2] * inv, O[dt][3] * inv);
            *(uint2*)(y + (size_t)qrow * 1024 + h * 64 + dt * 16 + 4 * g) = o;
        }
    }
    asm volatile("s_waitcnt vmcnt(0)" ::: "memory");
    __syncthreads();
}

DEVINL void ph_mlC(const P& p, int l, char* smem, int bid, int nb) {
    const int TIDX_ = tid_(); char* const WS_ = wsl_(p.ws);
    const int tid = TIDX_, lane = tid & 63, w = tid >> 6, fr = lane & 15, g = lane >> 4;
    const u16* mlf = (const u16*)(WS_ + OFF_MLF);
    const u16* pc = (const u16*)(WS_ + OFF_PC);
    const float* mlg = (const float*)(WS_ + OFF_MLG);
    const float* mst = (const float*)(WS_ + OFF_MST);
    const float* nst = (const float*)(WS_ + OFF_NST2);
    const u16* cst = (const u16*)(WS_ + OFF_CST2);
    u16* y = (u16*)(WS_ + OFF_Y);
    u16* vt = (u16*)smem;
    float* btl = (float*)(smem + 9216);
    float* lil = btl + 128;
    float* nl = lil + 128;
    for (int uh = bid; uh < 2 * NTC * 4; uh += nb) {
        const int u = uh >> 2, h = uh & 3;
        const int b = u / NTC, tc = u % NTC;
        if (tc < 4 && l != 0) continue;
        const int row0 = tc < 4 ? b * LCTX + tc * 64 : CTXROWS + b * LAT + (tc - 4) * 64;
        __syncthreads();
        for (int i = tid; i < 64 * 8; i += 256) {
            const int tok = i >> 3, d8 = (i & 7) * 8;
            const uint4 vv = *(const uint4*)(pc + (size_t)(row0 + tok) * 1040 + 512 + h * 64 + d8);
            const unsigned wv[4] = {vv.x, vv.y, vv.z, vv.w};
#pragma unroll
            for (int k = 0; k < 4; ++k) { vt[(d8 + 2 * k) * 72 + tok] = (u16)(wv[k] & 0xFFFFu); vt[(d8 + 2 * k + 1) * 72 + tok] = (u16)(wv[k] >> 16); }
        }
        if (tid < 128) {
            const int d = tid >> 6, tok = tid & 63;
            lil[d * 64 + tok] = mlg[(size_t)(row0 + tok) * 16 + d * 4 + h];
            nl[d * 64 + tok] = nst[((size_t)((b * 4 + h) * 2 + d) * NTC + tc) * 64 + tok];
        }
        else { const int d = (tid - 128) >> 6, tok = tid & 63; btl[d * 64 + tok] = mlg[(size_t)(row0 + tok) * 16 + 8 + d * 4 + h]; }
        const int t = 16 * w + fr;
        bf16x8 qf[2];
        qf[0] = *(const bf16x8*)(mlf + (size_t)(row0 + t) * 512 + h * 64 + 8 * g);
        qf[1] = *(const bf16x8*)(mlf + (size_t)(row0 + t) * 512 + h * 64 + 32 + 8 * g);
        f32x4 S[4];
#pragma unroll
        for (int st = 0; st < 4; ++st) {
            const u16* kp = mlf + (size_t)(row0 + 16 * st + fr) * 512 + 256 + h * 64 + 8 * g;
            const bf16x8 k0 = *(const bf16x8*)kp, k1 = *(const bf16x8*)(kp + 32);
            S[st] = f32x4{0.f, 0.f, 0.f, 0.f};
            S[st] = __builtin_amdgcn_mfma_f32_16x16x32_bf16(k0, qf[0], S[st], 0, 0, 0);
            S[st] = __builtin_amdgcn_mfma_f32_16x16x32_bf16(k1, qf[1], S[st], 0, 0, 0);
        }
        __syncthreads();
        f32x4 hs[4];
#pragma unroll
        for (int i = 0; i < 4; ++i) hs[i] = f32x4{0.f, 0.f, 0.f, 0.f};
#pragma unroll 1
        for (int d = 0; d < 2; ++d) {
            const int bhd = (b * 4 + h) * 2 + d;
            const float m0 = mst[bhd * NTC + tc];
            const float bt = btl[d * 64 + t];
            float ld[16]; float mx = -3.0e38f;
#pragma unroll
            for (int st = 0; st < 4; ++st) {
                const float4 b4 = *(const float4*)(btl + d * 64 + 16 * st + 4 * g), l4 = *(const float4*)(lil + d * 64 + 16 * st + 4 * g);
                const float bs[4] = {b4.x, b4.y, b4.z, b4.w}, ls[4] = {l4.x, l4.y, l4.z, l4.w};
#pragma unroll
                for (int r = 0; r < 4; ++r) {
                    const int s = 16 * st + 4 * g + r;
                    const bool ok = d ? (s >= t) : (s <= t);
                    ld[4 * st + r] = ok ? (bt - bs[r] + ls[r]) : -3.0e38f;
                    mx = fmaxf(mx, ld[4 * st + r]);
                }
            }
            mx = fmaxf(mx, __shfl_xor(mx, 16)); mx = fmaxf(mx, __shfl_xor(mx, 32));
            const float mt = fmaxf(bt + m0, mx);
            float rsum = 0.f; float dw[16];
#pragma unroll
            for (int i = 0; i < 16; ++i) { dw[i] = (ld[i] > -1.0e38f) ? __expf(ld[i] - mt) * S[i >> 2][i & 3] : 0.f; rsum += dw[i]; }
            rsum += __shfl_xor(rsum, 16); rsum += __shfl_xor(rsum, 32);
            const float inter = __expf(bt + m0 - mt);
            float qn = 0.f;
#pragma unroll
            for (int j = 0; j < 8; ++j) {
                qn += bf2f((u16)qf[0][j]) * nl[d * 64 + 8 * g + j] + bf2f((u16)qf[1][j]) * nl[d * 64 + 32 + 8 * g + j];
            }
            qn += __shfl_xor(qn, 16); qn += __shfl_xor(qn, 32);
            const float den = rsum + inter * qn;
            const float dn = 1.f / fmaxf(fabsf(den), __expf(-mt));
            union { u32x4 u; bf16x8 f; } pf[2];
#pragma unroll
            for (int ks = 0; ks < 2; ++ks) pf[ks].u = u32x4{pk2bf(dw[8 * ks], dw[8 * ks + 1]), pk2bf(dw[8 * ks + 2], dw[8 * ks + 3]), pk2bf(dw[8 * ks + 4], dw[8 * ks + 5]), pk2bf(dw[8 * ks + 6], dw[8 * ks + 7])};
            const u16* cb = cst + ((size_t)bhd * NTC + tc) * 4096;
#pragma unroll
            for (int dvt = 0; dvt < 4; ++dvt) {
                f32x4 num = f32x4{0.f, 0.f, 0.f, 0.f}, qc = f32x4{0.f, 0.f, 0.f, 0.f};
#pragma unroll
                for (int ks = 0; ks < 2; ++ks) {
                    const uint2 lo = *(const uint2*)(vt + (16 * dvt + fr) * 72 + 32 * ks + 4 * g), hi = *(const uint2*)(vt + (16 * dvt + fr) * 72 + 32 * ks + 16 + 4 * g);
                    union { u32x4 u; bf16x8 f; } vf; vf.u = u32x4{lo.x, lo.y, hi.x, hi.y};
                    num = __builtin_amdgcn_mfma_f32_16x16x32_bf16(vf.f, pf[ks].f, num, 0, 0, 0);
                    const bf16x8 cf = *(const bf16x8*)(cb + (16 * dvt + fr) * 64 + 32 * ks + 8 * g);
                    qc = __builtin_amdgcn_mfma_f32_16x16x32_bf16(cf, qf[ks], qc, 0, 0, 0);
                }
#pragma unroll
                for (int r = 0; r < 4; ++r) hs[dvt][r] += (num[r] + inter * qc[r]) * dn;
            }
        }
        float s1 = 0.f;
#pragma unroll
        for (int i = 0; i < 4; ++i) s1 += hs[i][0] + hs[i][1] + hs[i][2] + hs[i][3];
        s1 += __shfl_xor(s1, 16); s1 += __shfl_xor(s1, 32);
        const float mu = s1 * (1.f / 64.f);
        float s2 = 0.f;
#pragma unroll
        for (int i = 0; i < 4; ++i)
#pragma unroll
            for (int r = 0; r < 4; ++r) { const float dl = hs[i][r] - mu; s2 += dl * dl; }
        s2 += __shfl_xor(s2, 16); s2 += __shfl_xor(s2, 32);
        const float rstd = rsqrtf(s2 * (1.f / 64.f) + 1e-6f);
        const int row = row0 + t;
#pragma unroll
        for (int dvt = 0; dvt < 4; ++dvt) {
            const int cc = h * 64 + 16 * dvt + 4 * g;
            const uint2 ov = *(const uint2*)(pc + (size_t)row * 1040 + 768 + cc);
            const float4 nw = *(const float4*)(p.ml_nw + l * 256 + cc);
            const float o0 = bf2f((u16)(ov.x & 0xFFFF)), o1 = bf2f((u16)(ov.x >> 16)), o2 = bf2f((u16)(ov.y & 0xFFFF)), o3 = bf2f((u16)(ov.y >> 16));
            uint2 out;
            out.x = pk2bf((hs[dvt][0] - mu) * rstd * nw.x * sigmoidf_(o0), (hs[dvt][1] - mu) * rstd * nw.y * sigmoidf_(o1));
            out.y = pk2bf((hs[dvt][2] - mu) * rstd * nw.z * sigmoidf_(o2), (hs[dvt][3] - mu) * rstd * nw.w * sigmoidf_(o3));
            *(uint2*)(y + (size_t)row * 1024 + 768 + cc) = out;
        }
    }
}

DEVINL void ph_outproj(const P& p, int l, char* smem) {
    const int TIDX_ = tid_(); const int BIDX_ = bid_(); char* const WS_ = wsl_(p.ws); (void)TIDX_; (void)BIDX_; (void)WS_;
    const u16* y = (const u16*)(WS_ + OFF_Y);
    const u16* wout = (const u16*)(WS_ + OFF_WOUT);
    const float* modv = (const float*)(WS_ + OFF_MOD) + (size_t)l * 3 * 6144;
    const float* x2c = (const float*)(WS_ + OFF_X2CTX);
    float* x1 = (float*)(WS_ + OFF_X1);
    const int mt0 = (l == 0) ? 0 : 4;
    const int ntile = (260 - mt0) * 8;
    for (int u = BIDX_; u < ntile; u += gridDim.x) {
        const int mt = mt0 + u / 8, nt = u % 8;
        const u16* A = y + (size_t)mt * 128 * 1024;
        const int R0 = mt * 128;
        const float* xin;
        if (l == 0) xin = R0 < CTXROWS ? p.ctx + (size_t)R0 * 1024 : p.x + (size_t)(R0 - CTXROWS) * 1024;
        else xin = R0 < CTXROWS ? x2c + (size_t)R0 * 1024 : p.out + (size_t)(R0 - CTXROWS) * 1024;
        const float* g1 = modv + row_sel(R0) * 6144 + 2048;
        f32x4 acc[4][4];
        gemm128_acc([&](int r) { return A + (size_t)r * 1024; }, wout + (size_t)nt * 128 * 1024, 1024, 1024, smem, acc);
        stage_tile_f32(acc, smem, [&](int row, int c4, float4 a) {
            const int N = nt * 128 + c4;
            const float4 gg = *(const float4*)(g1 + N);
            const float4 xv = *(const float4*)(xin + (size_t)row * 1024 + N);
            float4 o;
            o.x = ALPHA * xv.x + gg.x * a.x; o.y = ALPHA * xv.y + gg.y * a.y; o.z = ALPHA * xv.z + gg.z * a.z; o.w = ALPHA * xv.w + gg.w * a.w;
            *(float4*)(x1 + (size_t)(R0 + row) * 1024 + N) = o;
        });
    }
}

DEVINL void ph_ln1(const P& p, int l) {
    const int TIDX_ = tid_(); const int BIDX_ = bid_(); char* const WS_ = wsl_(p.ws); (void)TIDX_; (void)BIDX_; (void)WS_;
    const int lane = TIDX_ & 63, wid = TIDX_ >> 6;
    const float* modv = (const float*)(WS_ + OFF_MOD) + (size_t)l * 3 * 6144;
    float* x1 = (float*)(WS_ + OFF_X1);
    u16* hm = (u16*)(WS_ + OFF_HM);
    const int rstart = (l == 0) ? 0 : CTXROWS;
    for (int row = rstart + BIDX_ * 4 + wid; row < T; row += gridDim.x * 4) {
        float4 v[4];
        float s = 0.f;
#pragma unroll
        for (int i = 0; i < 4; ++i) { v[i] = *(const float4*)(x1 + (size_t)row * 1024 + i * 256 + lane * 4); s += v[i].x + v[i].y + v[i].z + v[i].w; }
        const float mu = wsum(s) * (1.f / 1024.f);
        float q = 0.f;
#pragma unroll
        for (int i = 0; i < 4; ++i) { v[i].x -= mu; v[i].y -= mu; v[i].z -= mu; v[i].w -= mu; q += v[i].x * v[i].x + v[i].y * v[i].y + v[i].z * v[i].z + v[i].w * v[i].w; }
        const float rstd = rsqrtf(wsum(q) * (1.f / 1024.f) + 1e-5f);
        const float* mv = modv + row_sel(row) * 6144;
#pragma unroll
        for (int i = 0; i < 4; ++i) {
            const int c = i * 256 + lane * 4;
            const float4 g = *(const float4*)(p.ln1g + l * 1024 + c), bb = *(const float4*)(p.ln1b + l * 1024 + c);
            const float4 sh = *(const float4*)(mv + 3072 + c), sc = *(const float4*)(mv + 4096 + c);
            float4 o;
            o.x = v[i].x * rstd * g.x + bb.x; o.y = v[i].y * rstd * g.y + bb.y; o.z = v[i].z * rstd * g.z + bb.z; o.w = v[i].w * rstd * g.w + bb.w;
            *(float4*)(x1 + (size_t)row * 1024 + c) = o;
            uint2 hh;
            hh.x = (unsigned)f2bf(o.x * (1.f + sc.x) + sh.x) | ((unsigned)f2bf(o.y * (1.f + sc.y) + sh.y) << 16);
            hh.y = (unsigned)f2bf(o.z * (1.f + sc.z) + sh.z) | ((unsigned)f2bf(o.w * (1.f + sc.w) + sh.w) << 16);
            *(uint2*)(hm + (size_t)row * 1024 + c) = hh;
        }
    }
}

DEVINL void ph_router(const P& p, int l, char* smem) {
    const int TIDX_ = tid_(); const int BIDX_ = bid_(); char* const WS_ = wsl_(p.ws); (void)TIDX_; (void)BIDX_; (void)WS_;
    const u16* hm = (const u16*)(WS_ + OFF_HM);
    const u16* wr = (const u16*)(WS_ + OFF_WR) + (size_t)l * 128 * 1024;
    float* lg = (float*)(WS_ + OFF_LOGITS);
    const int mt0 = (l == 0) ? 0 : 4;
    for (int u = BIDX_; u < 260 - mt0; u += gridDim.x) {
        const int mt = mt0 + u;
        const u16* A = hm + (size_t)mt * 128 * 1024;
        gemm128([&](int r) { return A + (size_t)r * 1024; }, wr, 1024, 1024, smem,
                [&](int m, int n, f32x4 a) {
                    if (n < 36) {
#pragma unroll
                        for (int j = 0; j < 4; ++j) lg[(size_t)(mt * 128 + m + j) * 64 + n] = a[j];
                    }
                });
    }
}

DEVINL void ph_route1(const P& p, int l, char* smem) {
    const int TIDX_ = tid_(); const int BIDX_ = bid_(); char* const WS_ = wsl_(p.ws); (void)TIDX_; (void)BIDX_; (void)WS_;
    const int tid = TIDX_;
    const float* lg = (const float*)(WS_ + OFF_LOGITS);
    int* toke = (int*)(WS_ + OFF_TOKE); float* tokw = (float*)(WS_ + OFF_TOKW);
    int* cnt = (int*)(WS_ + CTL_CNT) + l * 32;
    int* hist = (int*)smem;
    __syncthreads();
    if (tid < 32) hist[tid] = 0;
    __syncthreads();
    const int rstart = (l == 0) ? 0 : CTXROWS;
    for (int row = rstart + BIDX_ * 256 + tid; row < T; row += gridDim.x * 256) {
        const float* q = lg + (size_t)row * 64;
        float gl[4]; int gs = 0; float gm = -3.0e38f;
#pragma unroll
        for (int i = 0; i < 4; ++i) { gl[i] = q[i] + p.rgb[l * 4 + i]; if (gl[i] > gm) { gm = gl[i]; gs = i; } }
        float se = 0.f;
#pragma unroll
        for (int i = 0; i < 4; ++i) se += expf(gl[i] - gm);
        const float gw = 1.f / se;
        float v1 = -3.0e38f, v2 = -3.0e38f; int i1 = 0, i2 = 0;
#pragma unroll
        for (int i = 0; i < 8; ++i) {
            const float e = q[4 + gs * 8 + i] + p.reb[l * 32 + gs * 8 + i];
            if (e > v1) { v2 = v1; i2 = i1; v1 = e; i1 = i; }
            else if (e > v2) { v2 = e; i2 = i; }
        }
        const float e2 = expf(v2 - v1);
        const float w1 = gw / (1.f + e2), w2 = gw * e2 / (1.f + e2);
        const int ea = gs * 8 + i1, eb = gs * 8 + i2;
        toke[row * 2] = ea; toke[row * 2 + 1] = eb; tokw[row * 2] = w1; tokw[row * 2 + 1] = w2;
        atomicAdd(&hist[ea], 1); atomicAdd(&hist[eb], 1);
    }
    __syncthreads();
    if (tid < 32 && hist[tid] > 0) atomicAdd(&cnt[tid], hist[tid]);
}

DEVINL void ph_route2(const P& p, int l, char* smem) {
    const int TIDX_ = tid_(); const int BIDX_ = bid_(); char* const WS_ = wsl_(p.ws); (void)TIDX_; (void)BIDX_; (void)WS_;
    const int tid = TIDX_;
    const int* toke = (const int*)(WS_ + OFF_TOKE);
    int* toks = (int*)(WS_ + OFF_TOKS);
    int* slottok = (int*)(WS_ + OFF_SLOTTOK);
    const int* cnt = (const int*)(WS_ + CTL_CNT) + l * 32;
    int* cur = (int*)(WS_ + CTL_CUR) + l * 32;
    int* tiles = (int*)(WS_ + OFF_TILES);
    int* off = (int*)smem;
    int* hist = off + 64;
    int* base = hist + 32;
    __syncthreads();
    if (tid == 0) { int a = 0; for (int e = 0; e < 32; ++e) { off[e] = a; a += (cnt[e] + 127) & ~127; } off[32] = a; }
    if (tid < 32) hist[tid] = 0;
    __syncthreads();
    if (BIDX_ == 0) {
        if (tid == 0) {
            int nt = 0;
#pragma clang loop vectorize(disable) unroll(disable)
            for (int e = 0; e < 32; ++e) {
#pragma clang loop vectorize(disable) unroll(disable)
                for (int s = off[e]; s < off[e + 1]; s += 128) { tiles[64 + nt * 2] = e; tiles[64 + nt * 2 + 1] = s; ++nt; }
            }
            tiles[40] = nt;
        }
#pragma clang loop vectorize(disable) unroll(disable)
        for (int e = 0; e < 32; ++e) {
#pragma clang loop vectorize(disable) unroll(disable)
            for (int s = off[e] + cnt[e] + tid; s < off[e + 1]; s += 256) slottok[s] = (l == 0) ? 0 : CTXROWS;
        }
    }
    const int rstart = (l == 0) ? 0 : CTXROWS;
    for (int a0 = rstart * 2 + BIDX_ * 256; a0 < T * 2; a0 += gridDim.x * 256) {
        const int a = a0 + tid;
        int e = -1, lpos = 0;
        if (a < T * 2) { e = toke[a]; lpos = atomicAdd(&hist[e], 1); }
        __syncthreads();
        if (tid < 32) { base[tid] = hist[tid] > 0 ? atomicAdd(&cur[tid], hist[tid]) : 0; }
        __syncthreads();
        if (e >= 0) { const int s = off[e] + base[e] + lpos; toks[a] = s; slottok[s] = a >> 1; }
        __syncthreads();
        if (tid < 32) hist[tid] = 0;
        __syncthreads();
    }
}

DEVINL void ph_gateup(const P& p, char* smem) {
    const int TIDX_ = tid_(); const int BIDX_ = bid_(); char* const WS_ = wsl_(p.ws); (void)TIDX_; (void)BIDX_; (void)WS_;
    const int tid = TIDX_, lane = tid & 63, wid = tid >> 6, wr = wid >> 1, wc = wid & 1, fr = lane & 15, fq = lane >> 4;
    const u16* hm = (const u16*)(WS_ + OFF_HM);
    const u16* wgu = (const u16*)(WS_ + OFF_WGU);
    const int* tiles = (const int*)(WS_ + OFF_TILES);
    const int* slottok = (const int*)(WS_ + OFF_SLOTTOK);
    u16* act = (u16*)(WS_ + OFF_ACT);
    const int ntile = tiles[40] * 8;
    for (int u = BIDX_; u < ntile; u += gridDim.x) {
        const int ti = u >> 3, nt = u & 7;
        const int e = tiles[64 + ti * 2], s0 = tiles[64 + ti * 2 + 1];
        f32x4 acc[4][4];
        gemm128_acc([&](int r) { return hm + (size_t)slottok[s0 + r] * 1024; }, wgu + ((size_t)e * 1024 + nt * 128) * 1024, 1024, 1024, smem, acc);
        {
            u16* t = (u16*)smem;
            __syncthreads();
#pragma unroll
            for (int m = 0; m < 4; ++m)
#pragma unroll
                for (int n = 0; n < 4; n += 2) {
                    const int jc = (wc * 64 + n * 16) / 2 + fr;
                    const int r0 = wr * 64 + m * 16 + fq * 4;
                    float av[4];
#pragma unroll
                    for (int j = 0; j < 4; ++j) { const float gte = acc[m][n][j], up = acc[m][n + 1][j]; av[j] = gte / (1.f + __expf(-gte)) * up; }
                    const unsigned p01 = pk2bf(av[0], av[1]), p23 = pk2bf(av[2], av[3]);
                    t[(r0 + 0) * 72 + jc] = (u16)(p01 & 0xFFFFu); t[(r0 + 1) * 72 + jc] = (u16)(p01 >> 16);
                    t[(r0 + 2) * 72 + jc] = (u16)(p23 & 0xFFFFu); t[(r0 + 3) * 72 + jc] = (u16)(p23 >> 16);
                }
            __syncthreads();
#pragma unroll
            for (int i = 0; i < 4; ++i) {
                const int ci = tid + 256 * i, row = ci >> 3, c8 = (ci & 7) * 8;
                *(uint4*)(act + (size_t)(s0 + row) * 512 + nt * 64 + c8) = *(const uint4*)(t + row * 72 + c8);
            }
        }
    }
}

DEVINL void ph_down(const P& p, char* smem) {
    const int TIDX_ = tid_(); const int BIDX_ = bid_(); char* const WS_ = wsl_(p.ws); (void)TIDX_; (void)BIDX_; (void)WS_;
    const u16* act = (const u16*)(WS_ + OFF_ACT);
    const u16* wdn = (const u16*)(WS_ + OFF_WDN);
    const int* tiles = (const int*)(WS_ + OFF_TILES);
    u16* so = (u16*)(WS_ + OFF_SLOTOUT);
    const int ntile = tiles[40] * 8;
    for (int u = BIDX_; u < ntile; u += gridDim.x) {
        const int ti = u >> 3, nt = u & 7;
        const int e = tiles[64 + ti * 2], s0 = tiles[64 + ti * 2 + 1];
        const u16* A = act + (size_t)s0 * 512;
        f32x4 acc[4][4];
        gemm128_acc([&](int r) { return A + (size_t)r * 512; }, wdn + ((size_t)e * 1024 + nt * 128) * 512, 512, 512, smem, acc);
        stage_tile_bf16(acc, smem, [&](int row, int c8, uint4 v) { *(uint4*)(so + (size_t)(s0 + row) * 1024 + nt * 128 + c8) = v; });
    }
}

DEVINL void ph_ln2(const P& p, int l) {
    const int TIDX_ = tid_(); const int BIDX_ = bid_(); char* const WS_ = wsl_(p.ws); (void)TIDX_; (void)BIDX_; (void)WS_;
    const int lane = TIDX_ & 63, wid = TIDX_ >> 6;
    const float* modv = (const float*)(WS_ + OFF_MOD) + (size_t)l * 3 * 6144;
    const float* modn = (const float*)(WS_ + OFF_MOD) + (size_t)(l + 1) * 3 * 6144;
    const float* x1 = (const float*)(WS_ + OFF_X1);
    const u16* so = (const u16*)(WS_ + OFF_SLOTOUT);
    const int* toks = (const int*)(WS_ + OFF_TOKS);
    const float* tokw = (const float*)(WS_ + OFF_TOKW);
    float* x2c = (float*)(WS_ + OFF_X2CTX);
    u16* hm = (u16*)(WS_ + OFF_HM);
    const int rstart = (l == 0) ? 0 : CTXROWS;
    for (int row = rstart + BIDX_ * 4 + wid; row < T; row += gridDim.x * 4) {
        const int sa = toks[row * 2], sb = toks[row * 2 + 1];
        const float wa = tokw[row * 2], wb = tokw[row * 2 + 1];
        const float* mv = modv + row_sel(row) * 6144;
        float4 v[4];
        float s = 0.f;
#pragma unroll
        for (int i = 0; i < 4; ++i) {
            const int c = i * 256 + lane * 4;
            const float4 xv = *(const float4*)(x1 + (size_t)row * 1024 + c);
            const uint2 ua = *(const uint2*)(so + (size_t)sa * 1024 + c), ub = *(const uint2*)(so + (size_t)sb * 1024 + c);
            const float4 g2 = *(const float4*)(mv + 5120 + c);
            const float f0 = wa * bf2f((u16)(ua.x & 0xFFFF)) + wb * bf2f((u16)(ub.x & 0xFFFF));
            const float f1 = wa * bf2f((u16)(ua.x >> 16)) + wb * bf2f((u16)(ub.x >> 16));
            const float f2 = wa * bf2f((u16)(ua.y & 0xFFFF)) + wb * bf2f((u16)(ub.y & 0xFFFF));
            const float f3 = wa * bf2f((u16)(ua.y >> 16)) + wb * bf2f((u16)(ub.y >> 16));
            v[i].x = ALPHA * xv.x + g2.x * f0; v[i].y = ALPHA * xv.y + g2.y * f1; v[i].z = ALPHA * xv.z + g2.z * f2; v[i].w = ALPHA * xv.w + g2.w * f3;
            s += v[i].x + v[i].y + v[i].z + v[i].w;
        }
        const float mu = wsum(s) * (1.f / 1024.f);
        float q = 0.f;
#pragma unroll
        for (int i = 0; i < 4; ++i) { v[i].x -= mu; v[i].y -= mu; v[i].z -= mu; v[i].w -= mu; q += v[i].x * v[i].x + v[i].y * v[i].y + v[i].z * v[i].z + v[i].w * v[i].w; }
        const float rstd = rsqrtf(wsum(q) * (1.f / 1024.f) + 1e-5f);
        float* dst = row < CTXROWS ? x2c + (size_t)row * 1024 : p.out + (size_t)(row - CTXROWS) * 1024;
        const float* mn = modn + row_sel(row) * 6144;
#pragma unroll
        for (int i = 0; i < 4; ++i) {
            const int c = i * 256 + lane * 4;
            const float4 g = *(const float4*)(p.ln2g + l * 1024 + c), bb = *(const float4*)(p.ln2b + l * 1024 + c);
            float4 o;
            o.x = v[i].x * rstd * g.x + bb.x; o.y = v[i].y * rstd * g.y + bb.y; o.z = v[i].z * rstd * g.z + bb.z; o.w = v[i].w * rstd * g.w + bb.w;
            *(float4*)(dst + c) = o;
            if (l == 0) {
                const float4 sh = *(const float4*)(mn + c), sc = *(const float4*)(mn + 1024 + c);
                uint2 hh;
                hh.x = (unsigned)f2bf(o.x * (1.f + sc.x) + sh.x) | ((unsigned)f2bf(o.y * (1.f + sc.y) + sh.y) << 16);
                hh.y = (unsigned)f2bf(o.z * (1.f + sc.z) + sh.z) | ((unsigned)f2bf(o.w * (1.f + sc.w) + sh.w) << 16);
                *(uint2*)(hm + (size_t)row * 1024 + c) = hh;
            }
        }
    }
}

DEVINL void gbar(XcdBarrier b) {
    unsigned x = b.x; GAS unsigned* q = (GAS unsigned*)b.bar;
    asm volatile("" : "+s"(x), "+s"(q));
    b.x = x; b.bar = (unsigned*)q;
    xcd_barrier(b);
}
#ifndef PROBE
#define PROBE 0
#endif
#ifndef TPROBE
#define TPROBE 0
#endif
__global__ void __launch_bounds__(256, 2) k_mega(P p) {
    __shared__ __attribute__((aligned(16))) char smem[SMEM_BYTES];
    if (threadIdx.x == 0) *(uint4*)(smem + SMEM_BYTES - 16) = make_uint4(0u, 0u, 0u, 0u);
    __syncthreads();
    XcdBarrier bar = xcd_barrier_post((unsigned*)p.ws, (volatile LAS unsigned*)(smem + SMEM_BYTES - 16));
    const int bid = blockIdx.x, nb = gridDim.x;
#if TPROBE
    unsigned long long tp_acc = 0, tp_last = wall_clock64();
#define TP(g) do { const unsigned long long _n = wall_clock64(); if ((g) == TPROBE) tp_acc += _n - tp_last; tp_last = _n; } while (0)
#else
#define TP(g) do { } while (0)
#endif
    if (threadIdx.x == 0) {
        const unsigned key = ((unsigned)__builtin_amdgcn_s_getreg((3 << 11) | 20) << 8) | ((unsigned)__builtin_amdgcn_s_getreg((7 << 11) | (8 << 6) | 4) & 0xFFu);
        ((unsigned*)(p.ws + CTL_CUKEY))[blockIdx.x] = key | 0x80000000u;
    }
    ph_prolog(p, smem);
    ph_convw(p, 0, smem);
    gbar(bar);
    TP(1);
    ph_xm0(p);
    gbar(bar);
    TP(1);
    constexpr int NSCAN = 16;
    bool quiet; int wrank, nwork, mate_of = -1;
    {
        const unsigned* keys = (const unsigned*)(p.ws + CTL_CUKEY);
        int* cnt = (int*)smem;
        if (threadIdx.x < 2) cnt[threadIdx.x] = 0;
        __syncthreads();
        for (int i = NSCAN + threadIdx.x; i < nb; i += 256) {
            const unsigned k = keys[i];
            bool qq = false;
            for (int j = 0; j < NSCAN && j < nb; ++j) qq = qq || (keys[j] == k);
            if (qq) { atomicAdd(&cnt[1], 1); if (i < bid) atomicAdd(&cnt[0], 1); }
        }
        __syncthreads();
        const int below = cnt[0], total = cnt[1];
        bool me = false;
        if (bid >= NSCAN) { const unsigned k = keys[bid]; for (int j = NSCAN - 1; j >= 0; --j) if (j < nb && keys[j] == k) { me = true; mate_of = j; } }
        __syncthreads();
        if (total > 2 * NSCAN) { quiet = false; wrank = bid - NSCAN; nwork = nb - NSCAN; mate_of = -1; }
        else { quiet = me; wrank = bid - NSCAN - below; nwork = nb - NSCAN - total; }
    }
#pragma unroll 1
    for (int l = 0; l < NLAYER; ++l) {
        ph_inproj(p, smem);
        gbar(bar);
    TP(2);
        ph_rwprep(p, l, 0, smem, bid, nb);
        ph_prepM(p, l, smem, bid, nb);
        gbar(bar);
    TP(3);
        if (bid < NSCAN) ph_rwscan(p, l, 0, bid, NSCAN, smem);
        else if (!quiet) { if (nwork > 128) { if (wrank < 64) ph_mlB(p, wrank, 64, smem); else ph_na(p, l, smem, wrank - 64, nwork - 64); } else { ph_mlB(p, wrank, nwork, smem); ph_na(p, l, smem, wrank, nwork); } }
        gbar(bar);
    TP(4);
        ph_rwprep(p, l, 1, smem, bid, nb);
        gbar(bar);
    TP(5);
        if (bid < NSCAN) ph_rwscan(p, l, 1, bid, NSCAN, smem);
        else if (!quiet) { ph_mlC(p, l, smem, wrank, nwork); ph_convexp(p, l, smem, wrank, nwork); }
        gbar(bar);
    TP(6);
        ph_rwout(p, l);
        gbar(bar);
    TP(7);
        ph_outproj(p, l, smem);
        gbar(bar);
    TP(8);
        ph_ln1(p, l);
        gbar(bar);
    TP(9);
        ph_router(p, l, smem);
        gbar(bar);
    TP(9);
        ph_route1(p, l, smem);
        gbar(bar);
    TP(9);
        ph_route2(p, l, smem);
        gbar(bar);
    TP(9);
        ph_gateup(p, smem);
        gbar(bar);
    TP(10);
        ph_down(p, smem);
        gbar(bar);
    TP(11);
        ph_ln2(p, l);
        if (l + 1 < NLAYER) ph_convw(p, l + 1, smem);
        gbar(bar);
    TP(12);
    }
#if TPROBE
    if (bid == 0 && threadIdx.x == 0) { const unsigned long long t_end = wall_clock64() + tp_acc; while (wall_clock64() < t_end) __builtin_amdgcn_s_sleep(8); }
    __syncthreads();
    gbar(bar);
#endif
}


extern "C" void kernel_launch(void* const* d_in, const int* in_sizes, int n_in, void* d_out, int out_size, void* d_ws, size_t ws_size,
                              hipStream_t stream) {
    if (n_in != 37 || ws_size < WS_NEED) { fprintf(stderr, "kernel_launch: n_in %d ws %zu need %zu\n", n_in, ws_size, (size_t)WS_NEED); return; }
    static int grid = 0;
    if (!grid) {
        int dev = 0, cus = 0, per_cu = 0;
        (void)hipGetDevice(&dev);
        (void)hipDeviceGetAttribute(&cus, hipDeviceAttributeMultiprocessorCount, dev);
        (void)hipOccupancyMaxActiveBlocksPerMultiprocessor(&per_cu, (const void*)k_mega, 256, 0);
        if (per_cu < 1) per_cu = 1;
        grid = cus * (per_cu < 2 ? per_cu : 2);
    }
    P p{};
    const float** pp = (const float**)&p;
    for (int i = 0; i < 37; ++i) pp[i] = (const float*)d_in[i];
    p.out = (float*)d_out; p.ws = (char*)d_ws;
    (void)hipMemsetAsync(d_ws, 0, CTL_BYTES, stream);
    k_mega<<<dim3(grid), dim3(256), 0, stream>>>(p);
}
```

```cpp
#include <hip/hip_runtime.h>
#include <hip/hip_bf16.h>
#include <stdint.h>
#include <stdio.h>
#include <type_traits>

#define DEVINL __device__ __forceinline__
typedef unsigned short u16;
using bf16x8 = __attribute__((ext_vector_type(8))) short;
using f32x4 = __attribute__((ext_vector_type(4))) float;

constexpr int D = 1024, LAT = 16384, LCTX = 256, T = 33280, CTXROWS = 512;
constexpr int INP = 3536;
constexpr int NLAYER = 2;
constexpr float ALPHA = 1.41421356237309515f;
constexpr int NUNIT_CH = 520;
constexpr int NTC = 260;
constexpr int MAXSLOT = 70656;
constexpr int SMEM_BYTES = 81920;

constexpr size_t al(size_t x) { return (x + 255) & ~(size_t)255; }
constexpr size_t CTL_CNT = 16384;
constexpr size_t CTL_CUR = CTL_CNT + 256;
constexpr size_t CTL_CUKEY = 20480;
constexpr size_t CTL_PROG = 24576;
constexpr size_t CTL_BYTES = 32768;
constexpr size_t OFF_MOD = CTL_BYTES;
constexpr size_t OFF_ROPE = OFF_MOD + al(2 * 3 * 6144 * 4);
constexpr size_t OFF_WR = OFF_ROPE + al(10240 * 4);
constexpr size_t OFF_LORA = OFF_WR + al(2 * 128 * 1024 * 2);
constexpr size_t OFF_TILES = OFF_LORA + al(3 * 65536);
constexpr size_t OFF_TOKE = OFF_TILES + al((64 + 2048) * 4);
constexpr size_t OFF_TOKW = OFF_TOKE + al((size_t)T * 2 * 4);
constexpr size_t OFF_TOKS = OFF_TOKW + al((size_t)T * 2 * 4);
constexpr size_t OFF_SLOTTOK = OFF_TOKS + al((size_t)T * 2 * 4);
constexpr size_t OFF_X2CTX = OFF_SLOTTOK + al((size_t)MAXSLOT * 4);
constexpr size_t OFF_ZST = OFF_X2CTX + al((size_t)512 * 1024 * 4);
constexpr size_t OFF_WIN = OFF_ZST + al((size_t)16 * 4 * 64 * 16 * 4);
constexpr size_t OFF_WOUT = OFF_WIN + al((size_t)3584 * 1024 * 2);
constexpr size_t OFF_X1 = OFF_WOUT + al((size_t)1024 * 1024 * 2);
constexpr size_t OFF_HM = OFF_X1 + al((size_t)T * 1024 * 4);
constexpr size_t OFF_P = OFF_HM + al((size_t)T * 1024 * 2);
constexpr size_t OFF_PQK = OFF_P;
constexpr size_t OFF_VTL = OFF_PQK + (size_t)T * 1024 * 2;
constexpr size_t OFF_VTC = OFF_VTL + (size_t)2 * 8 * 64 * 16384 * 2;
constexpr size_t OFF_PB = OFF_VTC + (size_t)2 * 8 * 64 * 256 * 2;
constexpr size_t OFF_PC = OFF_PB + (size_t)T * 960 * 2;
constexpr size_t OFF_Y = OFF_PC + (size_t)T * 1040 * 2;
constexpr size_t OFF_MLF = OFF_Y + (size_t)T * 1024 * 2;
constexpr size_t OFF_GATE = OFF_MLF + (size_t)T * 512 * 2;
constexpr size_t OFF_MLG = OFF_GATE + (size_t)T * 256 * 2;
constexpr size_t OFF_MLS = OFF_MLG + (size_t)T * 16 * 4;
constexpr size_t OFF_MST = OFF_MLS + al(16 * 260 * 2 * 4);
constexpr size_t OFF_NST = OFF_MST + al(16 * 260 * 4);
constexpr size_t OFF_CST2 = OFF_NST + al(16 * 260 * 64 * 4);
constexpr size_t OFF_NST2 = OFF_CST2 + (size_t)16 * 260 * 4096 * 2;
constexpr size_t OFF_END1 = OFF_NST2 + al(16 * 260 * 64 * 4);
constexpr size_t OFF_WGU = OFF_P;
constexpr size_t OFF_WDN = OFF_WGU + (size_t)32 * 1024 * 1024 * 2;
constexpr size_t OFF_ACT = OFF_WDN + (size_t)32 * 1024 * 512 * 2;
constexpr size_t OFF_SLOTOUT = OFF_ACT + (size_t)MAXSLOT * 512 * 2;
constexpr size_t OFF_LOGITS = OFF_SLOTOUT + (size_t)MAXSLOT * 1024 * 2;
constexpr size_t OFF_END2 = OFF_LOGITS + (size_t)T * 64 * 4;
constexpr size_t WS_NEED = OFF_END1 > OFF_END2 ? OFF_END1 : OFF_END2;
static_assert(OFF_WDN <= OFF_Y, "Wexp must not overlap y");
static_assert(OFF_LOGITS >= OFF_MLF, "logits placement");

struct P {
    const float *x, *c, *ctx, *c_ctx, *w_mod, *b_mod, *w_in, *na_rpb, *mu_prev, *mu_next, *rw_w0, *rw_w2, *rw_a0, *rw_a2,
        *rw_g2, *rw_kk, *rw_ka, *rw_rk, *rw_lnw, *rw_lnb, *ml_cw, *ml_cb, *ml_ib, *ml_fb, *ml_nw, *w_out, *ln1g, *ln1b,
        *rgw, *rgb, *rew, *reb, *egate, *eup, *edown, *ln2g, *ln2b;
    float* out;
    char* ws;
};

#define XB_TMO      128
#define XB_XCNT(j)  (256  + 64 * (j))
#define XB_XSUB(j)  (1280 + 64 * (j))
#define XB_XGEN(j)  (2304 + 64 * (j))
#define XB_TOP      3328
#define XB_TOPGEN   3392
#define XCD_BAR_WORDS 3456
#define XB_SPIN_CAP (1u << 18)
#define LAS __attribute__((address_space(3)))

__device__ __forceinline__ unsigned xb_ld(unsigned* p)              { return __hip_atomic_load(p, __ATOMIC_RELAXED, __HIP_MEMORY_SCOPE_AGENT); }
__device__ __forceinline__ unsigned xb_add(unsigned* p, unsigned v) { return __hip_atomic_fetch_add(p, v, __ATOMIC_RELAXED, __HIP_MEMORY_SCOPE_AGENT); }
__device__ __forceinline__ unsigned xb_xcc_id() { return (unsigned)__builtin_amdgcn_s_getreg((3 << 11) | 20) & 0xFu; }
#define XB_SPIN(cond, bar) do { unsigned _sp = 0; while (cond) { __builtin_amdgcn_s_sleep(1); \
    if ((++_sp & 255u) == 0u) { if (xb_ld(&(bar)[XB_TMO])) break; if (_sp > XB_SPIN_CAP) { atomicAdd(&(bar)[XB_TMO], 1u); break; } } } } while (0)

struct XcdBarrier {
    unsigned* bar; unsigned x;
    volatile LAS unsigned* st;
};

__device__ __forceinline__ XcdBarrier xcd_barrier_post(unsigned* bar, volatile LAS unsigned* st) {
    XcdBarrier b; b.bar = bar; b.x = xb_xcc_id(); b.st = st;
    if (threadIdx.x == 0) (void)xb_add(&bar[XB_XCNT(b.x)], 1u);
    return b;
}
__device__ __forceinline__ void xcd_barrier_complete(unsigned* bar, unsigned x, unsigned& nloc, unsigned& nx) {
    const unsigned G = gridDim.x * gridDim.y * gridDim.z;
    unsigned sum, cnt, mine, sp = 0u;
    for (;;) {
        sum = 0u; cnt = 0u; mine = 0u;
#pragma unroll
        for (unsigned j = 0; j < 16; ++j) { const unsigned c = xb_ld(&bar[XB_XCNT(j)]); sum += c; cnt += (c > 0u) ? 1u : 0u; mine = (j == x) ? c : mine; }
        if (sum == G) break;
        __builtin_amdgcn_s_sleep(1);
        if ((++sp & 255u) == 0u) { if (xb_ld(&bar[XB_TMO])) break; if (sp > XB_SPIN_CAP) { atomicAdd(&bar[XB_TMO], 1u); break; } }
    }
    nloc = mine > 0u ? mine : 1u; nx = cnt > 0u ? cnt : 1u;
}

__device__ __forceinline__ void xcd_barrier(const XcdBarrier& b) {
    asm volatile("s_waitcnt vmcnt(0)" ::: "memory");
    __syncthreads();
    if (threadIdx.x == 0) {
        unsigned* bar = b.bar;
        __builtin_amdgcn_s_waitcnt(0);
        unsigned nloc = b.st[0], nx = b.st[1];
        if (nloc == 0u) { xcd_barrier_complete(bar, b.x, nloc, nx); b.st[0] = nloc; b.st[1] = nx; }
        const unsigned old = xb_add(&bar[XB_XSUB(b.x)], 1u);
        const unsigned gen = old / nloc;
        if (old + 1u == (gen + 1u) * nloc) {
            __builtin_amdgcn_fence(__ATOMIC_RELEASE, "agent");
            asm volatile("s_waitcnt vmcnt(0)" ::: "memory");
            const unsigned og = xb_add(&bar[XB_TOP], 1u);
            const unsigned tg = og / nx;
            if (og + 1u == (tg + 1u) * nx) xb_add(&bar[XB_TOPGEN], 1u);
            else XB_SPIN(xb_ld(&bar[XB_TOPGEN]) == tg, bar);
            __builtin_amdgcn_fence(__ATOMIC_ACQUIRE, "agent");
            xb_add(&bar[XB_XGEN(b.x)], 1u);
            asm volatile("s_waitcnt vmcnt(0)" ::: "memory");
        } else {
            XB_SPIN(xb_ld(&bar[XB_XGEN(b.x)]) == gen, bar);
            __builtin_amdgcn_fence(__ATOMIC_ACQUIRE, "agent");
            asm volatile("s_waitcnt vmcnt(0)" ::: "memory");
        }
    }
    __syncthreads();
}


DEVINL int tid_() { int t = threadIdx.x; asm volatile("" : "+v"(t)); return t; }
DEVINL int bid_() { int b = blockIdx.x; asm volatile("" : "+s"(b)); return b; }
#define GAS __attribute__((address_space(1)))
DEVINL char* wsl_(char* w) { GAS char* g = (GAS char*)w; asm volatile("" : "+s"(g)); return (char*)g; }
template <class Tp> DEVINL const Tp* gl_(const Tp* q) { const GAS Tp* g = (const GAS Tp*)q; asm volatile("" : "+s"(g)); return (const Tp*)g; }
typedef float f32x2_t __attribute__((ext_vector_type(2)));
typedef __bf16 bf16x2_t __attribute__((ext_vector_type(2)));
DEVINL unsigned pk2bf(float lo, float hi) { f32x2_t f = {lo, hi}; bf16x2_t b = __builtin_convertvector(f, bf16x2_t); return __builtin_bit_cast(unsigned, b); }
DEVINL u16 f2bf(float f) { return (u16)(pk2bf(f, f) & 0xFFFFu); }
DEVINL float bf2f(u16 h) { return __uint_as_float(((unsigned)h) << 16); }
DEVINL float wsum(float v) { for (int o = 32; o > 0; o >>= 1) v += __shfl_xor(v, o); return v; }
DEVINL float sigmoidf_(float x) { return 1.f / (1.f + __expf(-x)); }
DEVINL float siluf_(float x) { return x / (1.f + __expf(-x)); }
DEVINL float softplusf_(float x) { return fmaxf(x, 0.f) + log1pf(__expf(-fabsf(x))); }
DEVINL int row_sel(int row) { return row < CTXROWS ? 2 : ((row - CTXROWS) >> 14); }
template <int CTRL, int RM>
DEVINL float dpp_f(float v) { return __int_as_float(__builtin_amdgcn_update_dpp(0, __float_as_int(v), CTRL, RM, 0xF, false)); }
DEVINL float wave_sum_dpp(float v) {
    v += dpp_f<0xB1, 0xF>(v);
    v += dpp_f<0x4E, 0xF>(v);
    v += dpp_f<0x141, 0xF>(v);
    v += dpp_f<0x140, 0xF>(v);
    v += dpp_f<0x142, 0xA>(v);
    v += dpp_f<0x143, 0xC>(v);
    return __int_as_float(__builtin_amdgcn_readlane(__float_as_int(v), 63));
}
DEVINL unsigned lds_addr(const void* p) { return (unsigned)(size_t)(const __attribute__((address_space(3))) char*)p; }
using u32x4 = __attribute__((ext_vector_type(4))) unsigned;
using u32x2 = __attribute__((ext_vector_type(2))) unsigned;
template <int OFF> DEVINL u32x4 lds_rd128(unsigned a) { u32x4 v; asm volatile("ds_read_b128 %0, %1 offset:%2" : "=v"(v) : "v"(a), "n"(OFF)); return v; }
template <int OFF> DEVINL u32x2 lds_rd64(unsigned a) { u32x2 v; asm volatile("ds_read_b64 %0, %1 offset:%2" : "=v"(v) : "v"(a), "n"(OFF)); return v; }
DEVINL void glds4(const void* g, void* l) {
    __builtin_amdgcn_global_load_lds((const __attribute__((address_space(1))) void*)g, (__attribute__((address_space(3))) void*)l, 4, 0, 0);
}
DEVINL void glds16nt(const void* g, void* l) {
    __builtin_amdgcn_global_load_lds((const __attribute__((address_space(1))) void*)g, (__attribute__((address_space(3))) void*)l, 16, 0, 2);
}
DEVINL void glds16(const void* g, void* l) {
    __builtin_amdgcn_global_load_lds((const __attribute__((address_space(1))) void*)g, (__attribute__((address_space(3))) void*)l, 16, 0, 0);
}

#define XCD_WALK(total_, bid_v, nb_v) \
    const bool xw_8 = (((nb_v) & 7) == 0); \
    const int xw_per = xw_8 ? (((((total_) + 7) >> 3) + 7) & ~7) : (total_); \
    const int xw_base = xw_8 ? ((bid_v) & 7) * xw_per : 0; \
    const int xw_lo = xw_base + (xw_8 ? ((bid_v) >> 3) : (bid_v)); \
    const int xw_hi = min((int)(total_), xw_base + xw_per); \
    const int xw_st = xw_8 ? ((nb_v) >> 3) : (nb_v)

template <class RowA>
DEVINL void gemm128_acc(RowA rowA, const u16* __restrict__ Bt, int ldb, int K, char* smem, f32x4 (&acc)[4][4]) {
    const int tid = tid_(), lane = tid & 63, wid = tid >> 6, wr = wid >> 1, wc = wid & 1, fr = lane & 15, fq = lane >> 4;
#pragma unroll
    for (int m = 0; m < 4; ++m)
#pragma unroll
        for (int n = 0; n < 4; ++n) acc[m][n] = f32x4{0.f, 0.f, 0.f, 0.f};
    const int sc = ((tid & 7) ^ ((tid >> 3) & 7)) * 8;
    const u16* aS[4]; const u16* bS[4];
#pragma unroll
    for (int i = 0; i < 4; ++i) { const int r = (tid >> 3) + 32 * i; aS[i] = rowA(r) + sc; bS[i] = Bt + (size_t)r * ldb + sc; }
    const int nt = K >> 6;
    __syncthreads();
#pragma unroll
    for (int i = 0; i < 4; ++i) { glds16(aS[i], smem + (tid + 256 * i) * 16); glds16(bS[i], smem + 16384 + (tid + 256 * i) * 16); }
    for (int t = 0; t < nt; ++t) {
        asm volatile("s_waitcnt vmcnt(0)" ::: "memory");
        __builtin_amdgcn_s_barrier();
        if (t + 1 < nt) {
            char* SA = smem + ((t + 1) & 1) * 32768;
            const int ko = (t + 1) * 64;
#pragma unroll
            for (int i = 0; i < 4; ++i) { glds16(aS[i] + ko, SA + (tid + 256 * i) * 16); glds16(bS[i] + ko, SA + 16384 + (tid + 256 * i) * 16); }
        }
        const char* SA = smem + (t & 1) * 32768; const char* SB = SA + 16384;
#pragma unroll
        for (int ks = 0; ks < 2; ++ks) {
            const int pos = ((ks * 4 + fq) ^ (fr & 7)) * 16;
            bf16x8 af[4], bfr[4];
#pragma unroll
            for (int m = 0; m < 4; ++m) af[m] = *(const bf16x8*)(SA + (wr * 64 + m * 16 + fr) * 128 + pos);
#pragma unroll
            for (int n = 0; n < 4; ++n) bfr[n] = *(const bf16x8*)(SB + (wc * 64 + n * 16 + fr) * 128 + pos);
#pragma unroll
            for (int m = 0; m < 4; ++m)
#pragma unroll
                for (int n = 0; n < 4; ++n) acc[m][n] = __builtin_amdgcn_mfma_f32_16x16x32_bf16(af[m], bfr[n], acc[m][n], 0, 0, 0);
        }
    }
}
template <class RowA, class Epi>
DEVINL void gemm128(RowA rowA, const u16* __restrict__ Bt, int ldb, int K, char* smem, Epi epi) {
    const int tid = tid_(), lane = tid & 63, wid = tid >> 6, wr = wid >> 1, wc = wid & 1, fr = lane & 15, fq = lane >> 4;
    f32x4 acc[4][4];
    gemm128_acc(rowA, Bt, ldb, K, smem, acc);
#pragma unroll
    for (int m = 0; m < 4; ++m)
#pragma unroll
        for (int n = 0; n < 4; ++n) epi(wr * 64 + m * 16 + fq * 4, wc * 64 + n * 16 + fr, acc[m][n]);
}

template <class Emit>
DEVINL void stage_tile_bf16(const f32x4 (&acc)[4][4], char* smem, Emit emit) {
    const int tid = tid_(), lane = tid & 63, wid = tid >> 6, wr = wid >> 1, wc = wid & 1, fr = lane & 15, fq = lane >> 4;
    u16* t = (u16*)smem;
    __syncthreads();
#pragma unroll
    for (int m = 0; m < 4; ++m)
#pragma unroll
        for (int n = 0; n < 4; ++n) {
            const int r0 = wr * 64 + m * 16 + fq * 4, c = wc * 64 + n * 16 + fr;
            const unsigned p01 = pk2bf(acc[m][n][0], acc[m][n][1]), p23 = pk2bf(acc[m][n][2], acc[m][n][3]);
            t[(r0 + 0) * 136 + c] = (u16)(p01 & 0xFFFFu); t[(r0 + 1) * 136 + c] = (u16)(p01 >> 16);
            t[(r0 + 2) * 136 + c] = (u16)(p23 & 0xFFFFu); t[(r0 + 3) * 136 + c] = (u16)(p23 >> 16);
        }
    __syncthreads();
#pragma unroll
    for (int i = 0; i < 8; ++i) {
        const int ci = tid + 256 * i, row = ci >> 4, c8 = (ci & 15) * 8;
        emit(row, c8, *(const uint4*)(t + row * 136 + c8));
    }
}

template <class Emit>
DEVINL void stage_tile_f32(const f32x4 (&acc)[4][4], char* smem, Emit emit) {
    const int tid = tid_(), lane = tid & 63, wid = tid >> 6, wr = wid >> 1, wc = wid & 1, fr = lane & 15, fq = lane >> 4;
    float* t = (float*)smem;
    __syncthreads();
#pragma unroll
    for (int m = 0; m < 4; ++m)
#pragma unroll
        for (int n = 0; n < 4; ++n) {
            const int r0 = wr * 64 + m * 16 + fq * 4, c = wc * 64 + n * 16 + fr;
#pragma unroll
            for (int j = 0; j < 4; ++j) t[(r0 + j) * 132 + c] = acc[m][n][j];
        }
    __syncthreads();
#pragma unroll 4
    for (int i = 0; i < 16; ++i) {
        const int ci = tid + 256 * i, row = ci >> 5, c4 = (ci & 31) * 4;
        emit(row, c4, *(const float4*)(t + row * 132 + c4));
    }
}

DEVINL void ph_prolog(const P& p, char* smem) {
    const int TIDX_ = tid_(); const int BIDX_ = bid_(); char* const WS_ = wsl_(p.ws); (void)TIDX_; (void)BIDX_; (void)WS_;
    const int tid = TIDX_;
    float* modv = (float*)(WS_ + OFF_MOD);
    float* sil = (float*)smem;
    float* red = sil + 3072;
    bool ready = false;
    for (int u = BIDX_; u < 192; u += gridDim.x) {
        if (!ready) {
            for (int i = tid; i < 3072; i += 256) { int v = i >> 10, k = i & 1023; float cv = v < 2 ? p.c[v * 1024 + k] : p.c_ctx[k]; sil[i] = cv / (1.f + expf(-cv)); }
            ready = true;
        }
        __syncthreads();
        const int l = u / 96, cg = u % 96;
        const float* W = p.w_mod + (size_t)l * 1024 * 6144 + cg * 64;
        const int c4 = (tid & 15) * 4, rg = tid >> 4;
        float a0[4] = {0, 0, 0, 0}, a1[4] = {0, 0, 0, 0}, a2[4] = {0, 0, 0, 0};
#pragma unroll 4
        for (int i = 0; i < 64; ++i) {
            const int k = rg + 16 * i;
            const float4 w = *(const float4*)(W + (size_t)k * 6144 + c4);
            const float s0 = sil[k], s1 = sil[1024 + k], s2 = sil[2048 + k];
            a0[0] += s0 * w.x; a0[1] += s0 * w.y; a0[2] += s0 * w.z; a0[3] += s0 * w.w;
            a1[0] += s1 * w.x; a1[1] += s1 * w.y; a1[2] += s1 * w.z; a1[3] += s1 * w.w;
            a2[0] += s2 * w.x; a2[1] += s2 * w.y; a2[2] += s2 * w.z; a2[3] += s2 * w.w;
        }
#pragma unroll
        for (int j = 0; j < 4; ++j) { red[(rg * 3 + 0) * 64 + c4 + j] = a0[j]; red[(rg * 3 + 1) * 64 + c4 + j] = a1[j]; red[(rg * 3 + 2) * 64 + c4 + j] = a2[j]; }
        __syncthreads();
        if (tid < 192) {
            const int v = tid >> 6, cc = tid & 63;
            float s = 0.f;
            for (int r = 0; r < 16; ++r) s += red[(r * 3 + v) * 64 + cc];
            const int col = cg * 64 + cc;
            modv[(l * 3 + v) * 6144 + col] = s + p.b_mod[l * 6144 + col];
        }
        __syncthreads();
    }
    float* rope = (float*)(WS_ + OFF_ROPE);
    for (int i = BIDX_ * 256 + tid; i < 320 * 16; i += gridDim.x * 256) {
        const int pos = (i < 4096) ? (i >> 4) : ((i - 4096) >> 4);
        const int f = i & 15;
        const float inv = powf(10000.0f, -(float)f / 16.0f);
        const float ang = (float)pos * inv;
        const double TWO_PI = 6.283185307179586476925;
        double a = (double)ang;
        a -= TWO_PI * rint(a / TWO_PI);
        const float cr = (float)cos(a), sr = (float)sin(a);
        if (i < 4096) { rope[i] = cr; rope[4096 + i] = sr; }
        else { rope[8192 + (i - 4096)] = cr; rope[8192 + 1024 + (i - 4096)] = sr; }
    }
    {
        u16* w2t = (u16*)(WS_ + OFF_LORA); u16* a2t = w2t + 2 * 2 * 256 * 32; u16* g2t = a2t + 2 * 2 * 256 * 32;
        for (int i = BIDX_ * 256 + tid; i < 2 * 2 * 256 * 32; i += gridDim.x * 256) {
            const int lz = i >> 13, c = (i >> 5) & 255, r = i & 31;
            w2t[i] = f2bf(p.rw_w2[((size_t)lz * 32 + r) * 256 + c]);
            a2t[i] = f2bf(p.rw_a2[((size_t)lz * 32 + r) * 256 + c]);
        }
        for (int i = BIDX_ * 256 + tid; i < 2 * 256 * 64; i += gridDim.x * 256) {
            const int l = i >> 14, c = (i >> 6) & 255, r = i & 63;
            g2t[i] = f2bf(p.rw_g2[((size_t)l * 64 + r) * 256 + c]);
        }
    }
    u16* wr = (u16*)(WS_ + OFF_WR);
    for (int i = BIDX_ * 256 + tid; i < 2 * 128 * 1024; i += gridDim.x * 256) {
        const int l = i >> 17, n = (i >> 10) & 127, k = i & 1023;
        float v = 0.f;
        if (n < 4) v = p.rgw[((size_t)l * 1024 + k) * 4 + n];
        else if (n < 36) v = p.rew[((size_t)l * 1024 + k) * 32 + (n - 4)];
        wr[i] = f2bf(v);
    }
}

DEVINL void conv_tile(const float* __restrict__ src, int N, int K, u16* __restrict__ dst, int k0, int n0, int mode, char* smem) {
    unsigned* t = (unsigned*)smem;
    const int tid = tid_();
    const int n4 = (tid & 15) * 4;
    const bool ok = n0 + n4 < N;
    float4 va[2], vb[2];
    __syncthreads();
#pragma unroll
    for (int i = 0; i < 2; ++i) {
        const int kp = i * 16 + (tid >> 4);
        const float* s0 = src + (size_t)(k0 + 2 * kp) * N + n0 + n4;
        va[i] = ok ? *(const float4*)s0 : make_float4(0.f, 0.f, 0.f, 0.f);
        vb[i] = ok ? *(const float4*)(s0 + N) : make_float4(0.f, 0.f, 0.f, 0.f);
    }
#pragma unroll
    for (int i = 0; i < 2; ++i) {
        const int kp = i * 16 + (tid >> 4);
        t[(n4 + 0) * 33 + kp] = pk2bf(va[i].x, vb[i].x);
        t[(n4 + 1) * 33 + kp] = pk2bf(va[i].y, vb[i].y);
        t[(n4 + 2) * 33 + kp] = pk2bf(va[i].z, vb[i].z);
        t[(n4 + 3) * 33 + kp] = pk2bf(va[i].w, vb[i].w);
    }
    __syncthreads();
    {
        const int n = tid >> 2, w0 = (tid & 3) * 8;
        const int ng = n0 + n;
        int nd = ng;
        if (mode == 1) nd = 32 * (ng >> 4) + (ng & 15);
        else if (mode == 2) nd = 32 * (ng >> 4) + 16 + (ng & 15);
        uint4 o0, o1;
        o0.x = t[n * 33 + w0 + 0]; o0.y = t[n * 33 + w0 + 1]; o0.z = t[n * 33 + w0 + 2]; o0.w = t[n * 33 + w0 + 3];
        o1.x = t[n * 33 + w0 + 4]; o1.y = t[n * 33 + w0 + 5]; o1.z = t[n * 33 + w0 + 6]; o1.w = t[n * 33 + w0 + 7];
        u16* q = dst + (size_t)nd * K + k0 + w0 * 2;
        *(uint4*)q = o0; *(uint4*)(q + 8) = o1;
    }
}
DEVINL void ph_convw(const P& p, int l, char* smem) {
    const int TIDX_ = tid_(); const int BIDX_ = bid_(); char* const WS_ = wsl_(p.ws); (void)TIDX_; (void)BIDX_; (void)WS_;
    u16* win = (u16*)(WS_ + OFF_WIN); u16* wout = (u16*)(WS_ + OFF_WOUT);
    for (int u = BIDX_; u < 896 + 256; u += gridDim.x) {
        if (u < 896) conv_tile(p.w_in + (size_t)l * 1024 * INP, INP, 1024, win, (u / 56) * 64, (u % 56) * 64, 0, smem);
        else { const int v = u - 896; conv_tile(p.w_out + (size_t)l * 1024 * 1024, 1024, 1024, wout, (v / 16) * 64, (v % 16) * 64, 0, smem); }
    }
}
DEVINL void ph_convexp(const P& p, int l, char* smem, int bid, int nb) {
    const int TIDX_ = tid_(); const int BIDX_ = bid_(); char* const WS_ = wsl_(p.ws); (void)TIDX_; (void)BIDX_; (void)WS_;
    u16* wgu = (u16*)(WS_ + OFF_WGU); u16* wdn = (u16*)(WS_ + OFF_WDN);
    for (int u = bid; u < 32 * 384; u += nb) {
        const int e = u / 384, v = u % 384;
        const size_t le = (size_t)l * 32 + e;
        if (v < 128) conv_tile(p.egate + le * 1024 * 512, 512, 1024, wgu + (size_t)e * 1024 * 1024, (v / 8) * 64, (v % 8) * 64, 1, smem);
        else if (v < 256) { const int w = v - 128; conv_tile(p.eup + le * 1024 * 512, 512, 1024, wgu + (size_t)e * 1024 * 1024, (w / 8) * 64, (w % 8) * 64, 2, smem); }
        else { const int w = v - 256; conv_tile(p.edown + le * 512 * 1024, 1024, 512, wdn + (size_t)e * 1024 * 512, (w / 16) * 64, (w % 16) * 64, 0, smem); }
    }
}

DEVINL void ph_xm0(const P& p) {
    const int TIDX_ = tid_(); const int BIDX_ = bid_(); char* const WS_ = wsl_(p.ws); (void)TIDX_; (void)BIDX_; (void)WS_;
    const float* modv = (const float*)(WS_ + OFF_MOD);
    u16* hm = (u16*)(WS_ + OFF_HM);
    for (size_t i = (size_t)BIDX_ * 256 + TIDX_; i < (size_t)T * 256; i += (size_t)gridDim.x * 256) {
        const int row = (int)(i >> 8), c4 = (int)(i & 255) * 4;
        const float* src = row < CTXROWS ? p.ctx + (size_t)row * 1024 : p.x + (size_t)(row - CTXROWS) * 1024;
        const float* mv = modv + row_sel(row) * 6144;
        const float4 v = *(const float4*)(src + c4);
        const float4 sh = *(const float4*)(mv + c4), sc = *(const float4*)(mv + 1024 + c4);
        uint2 o;
        o.x = (unsigned)f2bf(v.x * (1.f + sc.x) + sh.x) | ((unsigned)f2bf(v.y * (1.f + sc.y) + sh.y) << 16);
        o.y = (unsigned)f2bf(v.z * (1.f + sc.z) + sh.z) | ((unsigned)f2bf(v.w * (1.f + sc.w) + sh.w) << 16);
        *(uint2*)(hm + (size_t)row * 1024 + c4) = o;
    }
}

DEVINL void ph_inproj(const P& p, char* smem) {
    const int TIDX_ = tid_(); const int BIDX_ = bid_(); char* const WS_ = wsl_(p.ws); (void)TIDX_; (void)BIDX_; (void)WS_;
    const u16* hm = (const u16*)(WS_ + OFF_HM);
    const u16* win = (const u16*)(WS_ + OFF_WIN);
    u16* pqk = (u16*)(WS_ + OFF_PQK); u16* vtl = (u16*)(WS_ + OFF_VTL); u16* vtc = (u16*)(WS_ + OFF_VTC);
    u16* pb = (u16*)(WS_ + OFF_PB); u16* pc = (u16*)(WS_ + OFF_PC);
    XCD_WALK(260 * 28, BIDX_, (int)gridDim.x);
    for (int o = xw_lo; o < xw_hi; o += xw_st) {
        const int g = o / 224, w = o % 224;
        const int mt = g < 32 ? g * 8 + (w & 7) : 256 + (w & 3), nt = g < 32 ? (w >> 3) : (w >> 2);
        const u16* A = hm + (size_t)mt * 128 * 1024;
        f32x4 acc[4][4];
        gemm128_acc([&](int r) { return A + (size_t)r * 1024; }, win + (size_t)nt * 128 * 1024, 1024, 1024, smem, acc);
        if (nt >= 8 && nt < 12) {
            const int tid = tid_(), lane = tid & 63, wid = tid >> 6, wr = wid >> 1, wc = wid & 1, fr = lane & 15, fq = lane >> 4;
#pragma unroll
            for (int m = 0; m < 4; ++m)
#pragma unroll
                for (int n = 0; n < 4; ++n) {
                    const int R = mt * 128 + wr * 64 + m * 16 + fq * 4, N = nt * 128 + wc * 64 + n * 16 + fr;
                    const int hh = (N - 1024) >> 6, d = (N - 1024) & 63;
                    uint2 v; v.x = pk2bf(acc[m][n][0], acc[m][n][1]); v.y = pk2bf(acc[m][n][2], acc[m][n][3]);
                    if (R < CTXROWS) { const int b = R >> 8, t = R & 255; *(uint2*)(vtc + ((size_t)((b * 8 + hh) * 64 + d)) * 256 + t) = v; }
                    else { const int R2 = R - CTXROWS, b = R2 >> 14, t = R2 & 16383; *(uint2*)(vtl + ((size_t)((b * 8 + hh) * 64 + d)) * 16384 + t) = v; }
                }
        } else {
            stage_tile_bf16(acc, smem, [&](int row, int c8, uint4 v) {
                const int R = mt * 128 + row, N = nt * 128 + c8;
                if (N >= INP) return;
                if (N < 1024) *(uint4*)(pqk + (size_t)R * 1024 + N) = v;
                else if (N < 2496) *(uint4*)(pb + (size_t)R * 960 + (N - 1536)) = v;
                else *(uint4*)(pc + (size_t)R * 1040 + (N - 2496)) = v;
            });
        }
    }
}

constexpr size_t RWREC = 12288;
constexpr size_t RW_A1 = 0, RW_A4 = 2048, RW_A3 = 4096, RW_MKA = 8192, RW_TT = 8704, RW_MY = 9216, RW_V = 10240;
constexpr size_t OFF_RWOP = OFF_X1;
constexpr size_t OFF_RWWG = OFF_RWOP + (size_t)16 * 520 * RWREC;
constexpr size_t OFF_YRWB = OFF_RWWG + (size_t)16 * 130 * 64 * 4;
constexpr size_t OFF_BONUS = OFF_YRWB + (size_t)T * 256 * 2;
static_assert(OFF_BONUS + (size_t)T * 4 * 4 <= OFF_HM, "rw operand store must fit the X1 region");

DEVINL float rw_mix(const u16* __restrict__ pb, const float* __restrict__ mup, const float* __restrict__ mun, int row, int t, int seqlen, int col) {
    const float cu = bf2f(pb[(size_t)row * 960 + col]);
    const float pr = t > 0 ? bf2f(pb[(size_t)(row - 1) * 960 + col]) : 0.f;
    const float nx = t + 1 < seqlen ? bf2f(pb[(size_t)(row + 1) * 960 + col]) : 0.f;
    return cu + mup[col] * (pr - cu) + mun[col] * (nx - cu);
}

DEVINL void rw_mix8(const u16* __restrict__ pb, const float* __restrict__ mup, const float* __restrict__ mun, int row, int t, int seqlen, int col0, float (&o)[8]) {
    const bool hp = t > 0, hn = t + 1 < seqlen;
    const u32x4 c = *(const u32x4*)(pb + (size_t)row * 960 + col0);
    u32x4 pv = *(const u32x4*)(pb + (size_t)(hp ? row - 1 : row) * 960 + col0);
    u32x4 nx = *(const u32x4*)(pb + (size_t)(hn ? row + 1 : row) * 960 + col0);
    const unsigned mpv = hp ? 0xFFFFFFFFu : 0u, mnx = hn ? 0xFFFFFFFFu : 0u;
    const f32x4 mp0 = *(const f32x4*)(mup + col0), mp1 = *(const f32x4*)(mup + col0 + 4), mn0 = *(const f32x4*)(mun + col0), mn1 = *(const f32x4*)(mun + col0 + 4);
#pragma unroll
    for (int i = 0; i < 4; ++i) {
        const unsigned cw = c[i], pw = pv[i] & mpv, nw = nx[i] & mnx;
        const float c0 = __uint_as_float(cw << 16), c1 = __uint_as_float(cw & 0xFFFF0000u);
        const float p0 = __uint_as_float(pw << 16), p1 = __uint_as_float(pw & 0xFFFF0000u);
        const float n0 = __uint_as_float(nw << 16), n1 = __uint_as_float(nw & 0xFFFF0000u);
        const float ma = (i < 2) ? mp0[2 * i] : mp1[2 * i - 4], mb = (i < 2) ? mp0[2 * i + 1] : mp1[2 * i - 3];
        const float na = (i < 2) ? mn0[2 * i] : mn1[2 * i - 4], nb = (i < 2) ? mn0[2 * i + 1] : mn1[2 * i - 3];
        o[2 * i] = c0 + ma * (p0 - c0) + na * (n0 - c0);
        o[2 * i + 1] = c1 + mb * (p1 - c1) + nb * (n1 - c1);
    }
}
DEVINL uint4 pack8bf(const float (&v)[8]) { return make_uint4(pk2bf(v[0], v[1]), pk2bf(v[2], v[3]), pk2bf(v[4], v[5]), pk2bf(v[6], v[7])); }

DEVINL void ph_rwprep(const P& p, int l, int half, char* smem, int bid, int nb) {
    const int TIDX_ = tid_(); const int BIDX_ = bid_(); char* const WS_ = wsl_(p.ws);
    const int tid = TIDX_, lane = tid & 63, w = tid >> 6, fr = lane & 15, fq = lane >> 4;
    const u16* pb = (const u16*)(WS_ + OFF_PB);
    char* rwop = WS_ + OFF_RWOP;
    float* rwwg = (float*)(WS_ + OFF_RWWG);
    float* bonus = (float*)(WS_ + OFF_BONUS);
    u16* gate = (u16*)(WS_ + OFF_GATE);
    const float* mup = p.mu_prev + l * 960; const float* mun = p.mu_next + l * 960;
    u16* lwdh = (u16*)smem;
    u16* ladh = lwdh + 2048;
    u16* abuf = ladh + 2048;
    float* Lb = (float*)(smem + 16384);
    u16* SV = (u16*)(smem + 32768);
    float* tot = (float*)(smem + 32768);
    const u16* w2t = (const u16*)(WS_ + OFF_LORA);
    const u16* a2t = w2t + 2 * 2 * 256 * 32;
    const u16* g2t = a2t + 2 * 2 * 256 * 32;
    for (int uh = bid; uh < 2 * 2 * 130 * 4; uh += nb) {
        const int h = uh & 3, rest = uh >> 2;
        const int d = rest / 260, b = (rest % 260) / 130, gl = rest % 130;
        const int z = d;
        const int gscan = half * 130 + gl;
        int gi, row0, seqlen;
        if (gscan < 4) { gi = d ? 3 - gscan : gscan; row0 = b * 256 + gi * 64; seqlen = 256; }
        else { gi = d ? 255 - (gscan - 4) : gscan - 4; row0 = CTXROWS + b * LAT + gi * 64; seqlen = LAT; }
        const int t0 = gi * 64;
        __syncthreads();
        {
            const int j = tid >> 2, cq = tid & 3;
            float v[8];
            rw_mix8(pb, mup, mun, row0 + j, t0 + j, seqlen, 768 + z * 32 + 8 * cq, v);
#pragma unroll
            for (int i = 0; i < 8; ++i) v[i] = tanhf(v[i]);
            *(uint4*)(lwdh + j * 32 + 8 * cq) = pack8bf(v);
            rw_mix8(pb, mup, mun, row0 + j, t0 + j, seqlen, 832 + z * 32 + 8 * cq, v);
            *(uint4*)(ladh + j * 32 + 8 * cq) = pack8bf(v);
        }
        if (d == 0) {
            u16* lgd = (u16*)Lb;
            {
                const int j = tid >> 2, cq = tid & 3;
#pragma unroll
                for (int hh = 0; hh < 2; ++hh) {
                    float v[8];
                    rw_mix8(pb, mup, mun, row0 + j, t0 + j, seqlen, 896 + 16 * cq + 8 * hh, v);
#pragma unroll
                    for (int i = 0; i < 8; ++i) v[i] = sigmoidf_(v[i]);
                    *(uint4*)(lgd + j * 64 + 16 * cq + 8 * hh) = pack8bf(v);
                }
            }
            __syncthreads();
            const bf16x8 x0 = *(const bf16x8*)(lgd + (16 * w + fr) * 64 + 8 * fq), x1 = *(const bf16x8*)(lgd + (16 * w + fr) * 64 + 32 + 8 * fq);
#pragma unroll
            for (int nt = 0; nt < 4; ++nt) {
                const u16* bp = g2t + ((size_t)l * 256 + 64 * h + 16 * nt + fr) * 64 + 8 * fq;
                const bf16x8 b0 = *(const bf16x8*)bp, b1 = *(const bf16x8*)(bp + 32);
                f32x4 acc = f32x4{0.f, 0.f, 0.f, 0.f};
                acc = __builtin_amdgcn_mfma_f32_16x16x32_bf16(x0, b0, acc, 0, 0, 0);
                acc = __builtin_amdgcn_mfma_f32_16x16x32_bf16(x1, b1, acc, 0, 0, 0);
#pragma unroll
                for (int r = 0; r < 4; ++r) gate[(size_t)(row0 + 16 * w + 4 * fq + r) * 256 + 64 * h + 16 * nt + fr] = f2bf(acc[r]);
            }
        }
        {
            const int bh = b * 4 + h;
            const int ch = h * 64 + lane;
            __syncthreads();
            {
                const bf16x8 xw = *(const bf16x8*)(lwdh + (16 * w + fr) * 32 + 8 * fq);
                const bf16x8 xa = *(const bf16x8*)(ladh + (16 * w + fr) * 32 + 8 * fq);
#pragma unroll 1
                for (int kt = 0; kt < 4; ++kt) {
                    const int key = 16 * kt + fr;
                    const size_t wrow = ((size_t)(l * 2 + z) * 256 + h * 64 + key) * 32 + 8 * fq;
                    const bf16x8 bw = *(const bf16x8*)(w2t + wrow), ba = *(const bf16x8*)(a2t + wrow);
                    f32x4 ae = f32x4{0.f, 0.f, 0.f, 0.f}, aa = f32x4{0.f, 0.f, 0.f, 0.f};
                    ae = __builtin_amdgcn_mfma_f32_16x16x32_bf16(xw, bw, ae, 0, 0, 0);
                    aa = __builtin_amdgcn_mfma_f32_16x16x32_bf16(xa, ba, aa, 0, 0, 0);
                    const float w0 = p.rw_w0[(l * 2 + z) * 256 + h * 64 + key], a0 = p.rw_a0[(l * 2 + z) * 256 + h * 64 + key];
#pragma unroll
                    for (int r = 0; r < 4; ++r) {
                        const int tok = 16 * w + 4 * fq + r;
                        const int s = d ? 63 - tok : tok;
                        Lb[s * 64 + key] = 0.60653065971263342f * sigmoidf_(ae[r] + w0);
                        abuf[tok * 64 + key] = f2bf(sigmoidf_(aa[r] + a0));
                    }
                }
            }
            __syncthreads();
            {
                float pre[16]; float run = 0.f;
#pragma unroll
                for (int i = 0; i < 16; ++i) { run += Lb[(16 * w + i) * 64 + lane]; pre[i] = run; }
                tot[w * 64 + lane] = run;
                __syncthreads();
                float offs = 0.f;
#pragma unroll
                for (int ww = 0; ww < 3; ++ww) offs += (ww < w) ? tot[ww * 64 + lane] : 0.f;
#pragma unroll
                for (int i = 0; i < 16; ++i) Lb[(16 * w + i) * 64 + lane] = -(offs + pre[i]);
            }
            __syncthreads();
            {
                const int j = tid >> 2, kq = tid & 3, row = row0 + j, tt = t0 + j;
                const int c0 = h * 64 + 16 * kq;
                float kr[16];
                { float t8[8];
                  rw_mix8(pb, mup, mun, row, tt, seqlen, 256 + c0, t8);
#pragma unroll
                  for (int i = 0; i < 8; ++i) kr[i] = t8[i];
                  rw_mix8(pb, mup, mun, row, tt, seqlen, 256 + c0 + 8, t8);
#pragma unroll
                  for (int i = 0; i < 8; ++i) kr[8 + i] = t8[i]; }
                float ss = 0.f;
#pragma unroll
                for (int i = 0; i < 16; ++i) { const float kv = kr[i] * p.rw_kk[l * 256 + c0 + i]; ss += kv * kv; }
                ss += __shfl_xor(ss, 1); ss += __shfl_xor(ss, 2);
                const float inorm = 1.f / fmaxf(sqrtf(ss), 1e-12f);
                const int sidx = d ? 63 - j : j;
                const int cch = sidx >> 4, ts = sidx & 15;
                u16* sv = SV + (size_t)(cch * 4) * 1024 + ts * 64 + 16 * kq;
                float bs = 0.f;
#pragma unroll 1
                for (int hh = 0; hh < 2; ++hh) {
                    const int cb = c0 + 8 * hh;
                    float rr[8], av[8], oa[8], orr[8], ob[8], ok[8];
                    rw_mix8(pb, mup, mun, row, tt, seqlen, cb, rr);
                    { const uint4 a0 = *(const uint4*)(abuf + j * 64 + 16 * kq + 8 * hh);
                      const unsigned aw[4] = {a0.x, a0.y, a0.z, a0.w};
#pragma unroll
                      for (int i = 0; i < 4; ++i) { av[2 * i] = __uint_as_float(aw[i] << 16); av[2 * i + 1] = __uint_as_float(aw[i] & 0xFFFF0000u); } }
#pragma unroll
                    for (int i4 = 0; i4 < 2; ++i4) {
                        const float4 Lt4 = *(const float4*)(Lb + sidx * 64 + 16 * kq + 8 * hh + 4 * i4);
                        const float4 Lp4 = sidx > 0 ? *(const float4*)(Lb + (sidx - 1) * 64 + 16 * kq + 8 * hh + 4 * i4) : make_float4(0.f, 0.f, 0.f, 0.f);
                        const float Lt[4] = {Lt4.x, Lt4.y, Lt4.z, Lt4.w}, Lp[4] = {Lp4.x, Lp4.y, Lp4.z, Lp4.w};
#pragma unroll
                        for (int ii = 0; ii < 4; ++ii) {
                            const int i = 4 * i4 + ii;
                            const float kraw = hh ? kr[8 + i] : kr[i];
                            const float kkn = kraw * p.rw_kk[l * 256 + cb + i] * inorm, a = av[i];
                            const float et = __expf(Lt[ii]), einv = __builtin_amdgcn_rcpf(et);
                            oa[i] = -kkn * __expf(Lp[ii]);
                            orr[i] = rr[i] * et;
                            ob[i] = kkn * a * einv;
                            ok[i] = kraw * (1.f + (a - 1.f) * p.rw_ka[l * 256 + cb + i]) * einv;
                            bs += rr[i] * kraw * p.rw_rk[l * 256 + cb + i];
                            if (sidx == 63) rwwg[((size_t)(d * 8 + bh) * 130 + gl) * 64 + 16 * kq + 8 * hh + i] = et;
                        }
                    }
                    *(uint4*)(sv + 8 * hh) = pack8bf(oa);
                    *(uint4*)(sv + 1024 + 8 * hh) = pack8bf(orr);
                    *(uint4*)(sv + 2048 + 8 * hh) = pack8bf(ob);
                    *(uint4*)(sv + 3072 + 8 * hh) = pack8bf(ok);
                    rw_mix8(pb, mup, mun, row, tt, seqlen, 512 + cb, rr);
                    *(uint4*)(abuf + j * 64 + 16 * kq + 8 * hh) = pack8bf(rr);
                }
                if (d == 0) { bs += __shfl_xor(bs, 1); bs += __shfl_xor(bs, 2); if (kq == 0) bonus[(size_t)row * 4 + h] = bs; }
            }
            __syncthreads();
            {
                char* rec = rwop + ((size_t)(d * 8 + bh) * 520 + (size_t)gl * 4 + w) * RWREC;
                const u16* Av = SV + (size_t)(w * 4) * 1024; const u16* Rv = Av + 1024; const u16* Bv = Av + 2048; const u16* Kv = Av + 3072;
                bf16x8 fa[2], frr[2], fb[2], fk[2];
#pragma unroll
                for (int ks = 0; ks < 2; ++ks) {
                    fa[ks] = *(const bf16x8*)(Av + fr * 64 + ks * 32 + fq * 8);
                    frr[ks] = *(const bf16x8*)(Rv + fr * 64 + ks * 32 + fq * 8);
                    fb[ks] = *(const bf16x8*)(Bv + fr * 64 + ks * 32 + fq * 8);
                    fk[ks] = *(const bf16x8*)(Kv + fr * 64 + ks * 32 + fq * 8);
                }
                f32x4 mka = f32x4{0.f, 0.f, 0.f, 0.f}, mba = mka, mkr = mka, mbr = mka;
#pragma unroll
                for (int ks = 0; ks < 2; ++ks) {
                    mka = __builtin_amdgcn_mfma_f32_16x16x32_bf16(fa[ks], fk[ks], mka, 0, 0, 0);
                    mba = __builtin_amdgcn_mfma_f32_16x16x32_bf16(fa[ks], fb[ks], mba, 0, 0, 0);
                    mkr = __builtin_amdgcn_mfma_f32_16x16x32_bf16(frr[ks], fk[ks], mkr, 0, 0, 0);
                    mbr = __builtin_amdgcn_mfma_f32_16x16x32_bf16(frr[ks], fb[ks], mbr, 0, 0, 0);
                }
                float* Ns = Lb + w * 256;
                float* Ts = Lb + 1024 + w * 256;
                u16* rmka = (u16*)(rec + RW_MKA); u16* rmy = (u16*)(rec + RW_MY);
                const int i_ = fr;
#pragma unroll
                for (int r = 0; r < 4; ++r) {
                    const int t_ = 4 * fq + r;
                    const int lp = (i_ >> 2) * 16 + t_;
                    mka[r] = i_ < t_ ? mka[r] : 0.f;
                    rmy[lp * 8 + (i_ & 3)] = f2bf(i_ <= t_ ? mbr[r] : 0.f);
                    rmy[lp * 8 + 4 + (i_ & 3)] = f2bf(i_ <= t_ ? mkr[r] : 0.f);
                    Ns[t_ * 16 + i_] = i_ < t_ ? mba[r] : 0.f;
                }
                if (lane < 16) {
                    float Tr[16];
#pragma unroll
                    for (int ii = 0; ii < 16; ++ii) Tr[ii] = 0.f;
#pragma unroll 1
                    for (int t_ = 0; t_ < 16; ++t_) {
                        float acc = (lane == t_) ? 1.f : 0.f;
#pragma unroll
                        for (int i4 = 0; i4 < 4; ++i4) {
                            const float4 nv = *(const float4*)(Ns + t_ * 16 + 4 * i4);
                            acc += Tr[4 * i4] * nv.x + Tr[4 * i4 + 1] * nv.y + Tr[4 * i4 + 2] * nv.z + Tr[4 * i4 + 3] * nv.w;
                        }
#pragma unroll
                        for (int ii = 0; ii < 16; ++ii) Tr[ii] = (ii == t_) ? acc : Tr[ii];
                        Ts[lane * 16 + t_] = acc;
                    }
                }
                bf16x8 TTf;
                {
                    const float t0v = Ts[(4 * fq + 0) * 16 + fr], t1v = Ts[(4 * fq + 1) * 16 + fr], t2v = Ts[(4 * fq + 2) * 16 + fr], t3v = Ts[(4 * fq + 3) * 16 + fr];
                    union { u32x4 u; bf16x8 f; } x; x.u = u32x4{pk2bf(t0v, t1v), pk2bf(t2v, t3v), 0u, 0u}; TTf = x.f;
                }
                {
                    union { u32x4 u; bf16x8 f; } mb; mb.u = u32x4{pk2bf(mka[0], mka[1]), pk2bf(mka[2], mka[3]), 0u, 0u};
                    f32x4 mk2 = f32x4{0.f, 0.f, 0.f, 0.f};
                    mk2 = __builtin_amdgcn_mfma_f32_16x16x32_bf16(TTf, mb.f, mk2, 0, 0, 0);
#pragma unroll
                    for (int r = 0; r < 4; ++r) { const int t_ = 4 * fq + r; rmka[((i_ >> 2) * 16 + t_) * 4 + (i_ & 3)] = f2bf(mk2[r]); }
                }
                {
                    f32x4 ap[4];
#pragma unroll
                    for (int m = 0; m < 4; ++m) {
                        union { u32x4 u; bf16x8 f; } ag;
                        ag.u = u32x4{(unsigned)Av[(4 * fq + 0) * 64 + 16 * m + fr] | ((unsigned)Av[(4 * fq + 1) * 64 + 16 * m + fr] << 16),
                                     (unsigned)Av[(4 * fq + 2) * 64 + 16 * m + fr] | ((unsigned)Av[(4 * fq + 3) * 64 + 16 * m + fr] << 16), 0u, 0u};
                        ap[m] = f32x4{0.f, 0.f, 0.f, 0.f};
                        ap[m] = __builtin_amdgcn_mfma_f32_16x16x32_bf16(ag.f, TTf, ap[m], 0, 0, 0);
                    }
#pragma unroll
                    for (int ks = 0; ks < 2; ++ks) {
                        uint4 o;
                        o.x = pk2bf(ap[2 * ks][0], ap[2 * ks][1]); o.y = pk2bf(ap[2 * ks][2], ap[2 * ks][3]);
                        o.z = pk2bf(ap[2 * ks + 1][0], ap[2 * ks + 1][1]); o.w = pk2bf(ap[2 * ks + 1][2], ap[2 * ks + 1][3]);
                        *(uint4*)(rec + RW_A1 + (ks * 64 + lane) * 16) = o;
                    }
                }
#pragma unroll
                for (int ks = 0; ks < 2; ++ks) {
                    uint4 o;
                    const uint2 lo2 = *(const uint2*)(Rv + fr * 64 + 32 * ks + 4 * fq), hi2 = *(const uint2*)(Rv + fr * 64 + 32 * ks + 16 + 4 * fq);
                    o.x = lo2.x; o.y = lo2.y; o.z = hi2.x; o.w = hi2.y;
                    *(uint4*)(rec + RW_A4 + (ks * 64 + lane) * 16) = o;
                }
#pragma unroll
                for (int m = 0; m < 4; ++m) {
                    unsigned e[8];
#pragma unroll
                    for (int j = 0; j < 4; ++j) { e[j] = Bv[(4 * fq + j) * 64 + 16 * m + fr]; e[4 + j] = Kv[(4 * fq + j) * 64 + 16 * m + fr]; }
                    uint4 o; o.x = e[0] | (e[1] << 16); o.y = e[2] | (e[3] << 16); o.z = e[4] | (e[5] << 16); o.w = e[6] | (e[7] << 16);
                    *(uint4*)(rec + RW_A3 + (m * 64 + lane) * 16) = o;
                }
#pragma unroll
                for (int q = 0; q < 4; ++q) {
                    unsigned e[4];
#pragma unroll
                    for (int j = 0; j < 4; ++j) {
                        const int s = 16 * w + 4 * fq + j; const int jt = d ? 63 - s : s;
                        e[j] = abuf[jt * 64 + 16 * q + fr];
                    }
                    uint2 o; o.x = e[0] | (e[1] << 16); o.y = e[2] | (e[3] << 16);
                    *(uint2*)(rec + RW_V + (q * 64 + lane) * 8) = o;
                }
            }
        }
    }
}

constexpr int RWSLOT = 12544;
DEVINL void ph_rwscan(const P& p, int l, int half, int bid, int nb, char* smem) {
    const int TIDX_ = tid_(); char* const WS_ = wsl_(p.ws);
    const int tid = TIDX_, lane = tid & 63, q = tid >> 6, fr = lane & 15, fq = lane >> 4;
    const char* rwop = WS_ + OFF_RWOP;
    const float* rwwg = (const float*)(WS_ + OFF_RWWG);
    u16* yf = (u16*)(WS_ + OFF_Y);
    u16* yb = (u16*)(WS_ + OFF_YRWB);
    (void)l;
    float* zst = (float*)(WS_ + OFF_ZST);
    for (int dbh = bid; dbh < 16; dbh += nb) {
        const int d = dbh >> 3, bh = dbh & 7, b = bh >> 2, h = bh & 3;
        f32x4 z[4];
        float* zp = zst + ((size_t)(dbh * 4 + q) * 64 + lane) * 16;
#pragma unroll
        for (int m = 0; m < 4; ++m) {
            if (half == 0) z[m] = f32x4{0.f, 0.f, 0.f, 0.f};
            else { const float4 t4 = *(const float4*)(zp + 4 * m); z[m] = f32x4{t4.x, t4.y, t4.z, t4.w}; }
        }
        const int cbase = half * 520;
        const char* rec0 = rwop + (size_t)dbh * 520 * RWREC;
        const float* wg0 = rwwg + (size_t)dbh * 130 * 64;
        constexpr int RD = 6;
        u32x4 rb[RD][3]; float rwgA = 0.f, rwgB = 0.f;
        auto ldrec = [&](int c, auto I) {
            constexpr int i = decltype(I)::value;
            const int cc = c < 520 ? c : 519;
            const char* rec = rec0 + (size_t)cc * RWREC;
#pragma unroll
            for (int k = 0; k < 3; ++k) rb[i][k] = *(const u32x4*)(rec + (tid + 256 * k) * 16);
        };
        auto strec = [&](auto I, int slotidx) {
            constexpr int i = decltype(I)::value;
            char* slot = smem + slotidx * RWSLOT;
#pragma unroll
            for (int k = 0; k < 3; ++k) *(u32x4*)(slot + (tid + 256 * k) * 16) = rb[i][k];
        };
        auto asfrag = [](uint4 v) { union { uint4 u; bf16x8 f; } x; x.u = v; return x.f; };
        auto pack2 = [](float lo, float hi) { return pk2bf(lo, hi); };
        const unsigned b128 = lds_addr(smem) + lane * 16, b64 = lds_addr(smem) + lane * 8, bv = lds_addr(smem) + (q * 64 + lane) * 8, bg = lds_addr(smem) + 16 * fq;
        __syncthreads();
        __builtin_amdgcn_s_setprio(3);
#define IC(n) std::integral_constant<int, n>{}
        auto flush_y = [&](int cprev, int par) {
            if (tid < 128) {
                const int cg = cbase + cprev;
                const bool isctx = cg < 16;
                const int cc = isctx ? cg : cg - 16;
                const int n = isctx ? LCTX : LAT;
                const int rowbase = isctx ? b * LCTX : CTXROWS + b * LAT;
                const int ts = tid >> 3, c8 = (tid & 7) * 8;
                const int sidx = cc * 16 + ts;
                const int t = d ? n - 1 - sidx : sidx;
                const u32x4 v = *(const u32x4*)(smem + 4 * RWSLOT + par * 2048 + (ts * 64 + c8) * 2);
                u16* dst = d == 0 ? yf + (size_t)(rowbase + t) * 1024 + 512 + h * 64 + c8 : yb + (size_t)(rowbase + t) * 256 + h * 64 + c8;
                *(u32x4*)dst = v;
            }
        };
        u32x4 f4[2][6]; u32x2 f2[2][2];
#define RD_ISSUE(par, SBC) asm volatile( \
                "ds_read_b64 %6, %9 offset:%11+8192\n\t" \
                "ds_read_b64 %7, %10 offset:%11+10240\n\t" \
                "ds_read_b128 %0, %8 offset:%11+0\n\t" \
                "ds_read_b128 %1, %8 offset:%11+1024\n\t" \
                "ds_read_b128 %2, %8 offset:%11+4096\n\t" \
                "ds_read_b128 %3, %8 offset:%11+5120\n\t" \
                "ds_read_b128 %4, %8 offset:%11+6144\n\t" \
                "ds_read_b128 %5, %8 offset:%11+7168" \
                : "=&v"(f4[par][0]), "=&v"(f4[par][1]), "=&v"(f4[par][2]), "=&v"(f4[par][3]), "=&v"(f4[par][4]), "=&v"(f4[par][5]), \
                  "=&v"(f2[par][0]), "=&v"(f2[par][1]) \
                : "v"(b128), "v"(b64), "v"(bv), "n"(SBC) \
                : "memory")
#define RD_WAIT(par) asm volatile("s_waitcnt lgkmcnt(0)" \
                : "+v"(f4[par][0]), "+v"(f4[par][1]), "+v"(f4[par][2]), "+v"(f4[par][3]), "+v"(f4[par][4]), "+v"(f4[par][5]), \
                  "+v"(f2[par][0]), "+v"(f2[par][1]) \
                :: "memory")
        ldrec(0, IC(0)); ldrec(1, IC(1)); ldrec(2, IC(2)); ldrec(3, IC(3)); ldrec(4, IC(4)); ldrec(5, IC(5));
        strec(IC(0), 0); ldrec(RD, IC(0));
        strec(IC(1), 1); ldrec(RD + 1, IC(1));
        rwgA = wg0[lane]; rwgB = wg0[64 + lane];
        asm volatile("s_waitcnt lgkmcnt(0)" ::: "memory");
        __builtin_amdgcn_s_barrier();
        RD_ISSUE(0, 0); RD_WAIT(0);
#pragma unroll 1
        for (int c5 = 0; c5 < 528; c5 += 12) {
          auto body = [&](auto SJ) {
            constexpr int sj = decltype(SJ)::value;
            constexpr int par = sj & 1;
            const int c = c5 + sj;
            asm volatile("s_waitcnt lgkmcnt(0)" ::: "memory");
            __builtin_amdgcn_s_barrier();
            RD_ISSUE(par ^ 1, ((sj + 1) % 4) * RWSLOT);
            if (c > 0 && c <= 520) flush_y(c - 1, par ^ 1);
            strec(IC((sj + 2) % 6), (sj + 2) % 4);
            ldrec(c + 2 + RD, IC((sj + 2) % 6));
            if ((sj & 3) == 1) {
                const bool even = (((c >> 2) & 1) == 0);
                if (q == 0) *(float*)(smem + ((sj + 2) % 4) * RWSLOT + 12288 + lane * 4) = even ? rwgA : rwgB;
                const int gn = (c >> 2) + 2;
                const float nv = wg0[(size_t)(gn < 130 ? gn : 129) * 64 + lane];
                if (even) rwgA = nv; else rwgB = nv;
            }
            if (c < 520) {
            constexpr int SB = (sj % 4) * RWSLOT;
            auto asfrag4 = [](u32x4 v) { union { u32x4 u; bf16x8 f; } x; x.u = v; return x.f; };
            const bf16x8 A1_0 = asfrag4(f4[par][0]), A1_1 = asfrag4(f4[par][1]);
            const bf16x8 A3_0 = asfrag4(f4[par][2]), A3_1 = asfrag4(f4[par][3]), A3_2 = asfrag4(f4[par][4]), A3_3 = asfrag4(f4[par][5]);
            const u32x2 mka = f2[par][0], vcur = f2[par][1];
            const bf16x8 MKA = asfrag(make_uint4(mka.x, mka.y, 0u, 0u));
            const bf16x8 VB = asfrag(make_uint4(vcur.x, vcur.y, 0u, 0u));
            const bf16x8 ZB0 = asfrag(make_uint4(pack2(z[0][0], z[0][1]), pack2(z[0][2], z[0][3]), pack2(z[1][0], z[1][1]), pack2(z[1][2], z[1][3])));
            const bf16x8 ZB1 = asfrag(make_uint4(pack2(z[2][0], z[2][1]), pack2(z[2][2], z[2][3]), pack2(z[3][0], z[3][1]), pack2(z[3][2], z[3][3])));
            f32x4 Ua = f32x4{0.f, 0.f, 0.f, 0.f}, Ub = f32x4{0.f, 0.f, 0.f, 0.f};
            Ua = __builtin_amdgcn_mfma_f32_16x16x32_bf16(MKA, VB, Ua, 0, 0, 0);
            Ub = __builtin_amdgcn_mfma_f32_16x16x32_bf16(A1_1, ZB1, Ub, 0, 0, 0);
            Ua = __builtin_amdgcn_mfma_f32_16x16x32_bf16(A1_0, ZB0, Ua, 0, 0, 0);
            u32x4 r_a40, r_a41, r_my;
            asm volatile(
                "ds_read_b128 %0, %3 offset:%4+2048\n\t"
                "ds_read_b128 %1, %3 offset:%4+3072\n\t"
                "ds_read_b128 %2, %3 offset:%4+9216\n\t"
                "s_waitcnt lgkmcnt(0)"
                : "=&v"(r_a40), "=&v"(r_a41), "=&v"(r_my) : "v"(b128), "n"(SB) : "memory");
            const bf16x8 A4_0 = asfrag4(r_a40), A4_1 = asfrag4(r_a41), MY = asfrag4(r_my);
            f32x4 Y = f32x4{0.f, 0.f, 0.f, 0.f};
            Y = __builtin_amdgcn_mfma_f32_16x16x32_bf16(A4_0, ZB0, Y, 0, 0, 0);
            Y = __builtin_amdgcn_mfma_f32_16x16x32_bf16(A4_1, ZB1, Y, 0, 0, 0);
            const f32x4 U = Ua + Ub;
            const bf16x8 UV = asfrag(make_uint4(pack2(U[0], U[1]), pack2(U[2], U[3]), vcur.x, vcur.y));
            z[0] = __builtin_amdgcn_mfma_f32_16x16x32_bf16(A3_0, UV, z[0], 0, 0, 0);
            z[1] = __builtin_amdgcn_mfma_f32_16x16x32_bf16(A3_1, UV, z[1], 0, 0, 0);
            z[2] = __builtin_amdgcn_mfma_f32_16x16x32_bf16(A3_2, UV, z[2], 0, 0, 0);
            z[3] = __builtin_amdgcn_mfma_f32_16x16x32_bf16(A3_3, UV, z[3], 0, 0, 0);
            Y = __builtin_amdgcn_mfma_f32_16x16x32_bf16(MY, UV, Y, 0, 0, 0);
            asm volatile("s_waitcnt lgkmcnt(0)" ::: "memory");
            if ((c & 3) == 3) {
                u32x4 g0, g1, g2, g3;
                asm volatile(
                    "ds_read_b128 %0, %4 offset:%5+12288\n\t"
                    "ds_read_b128 %1, %4 offset:%5+12352\n\t"
                    "ds_read_b128 %2, %4 offset:%5+12416\n\t"
                    "ds_read_b128 %3, %4 offset:%5+12480\n\t"
                    "s_waitcnt lgkmcnt(0)"
                    : "=&v"(g0), "=&v"(g1), "=&v"(g2), "=&v"(g3) : "v"(bg), "n"(SB) : "memory");
                z[0][0] *= __uint_as_float(g0.x); z[0][1] *= __uint_as_float(g0.y); z[0][2] *= __uint_as_float(g0.z); z[0][3] *= __uint_as_float(g0.w);
                z[1][0] *= __uint_as_float(g1.x); z[1][1] *= __uint_as_float(g1.y); z[1][2] *= __uint_as_float(g1.z); z[1][3] *= __uint_as_float(g1.w);
                z[2][0] *= __uint_as_float(g2.x); z[2][1] *= __uint_as_float(g2.y); z[2][2] *= __uint_as_float(g2.z); z[2][3] *= __uint_as_float(g2.w);
                z[3][0] *= __uint_as_float(g3.x); z[3][1] *= __uint_as_float(g3.y); z[3][2] *= __uint_as_float(g3.z); z[3][3] *= __uint_as_float(g3.w);
            }
            {
                u16* yl = (u16*)(smem + 4 * RWSLOT + par * 2048);
                const unsigned y01 = pk2bf(Y[0], Y[1]), y23 = pk2bf(Y[2], Y[3]);
                yl[(4 * fq + 0) * 64 + 16 * q + fr] = (u16)(y01 & 0xFFFFu);
                yl[(4 * fq + 1) * 64 + 16 * q + fr] = (u16)(y01 >> 16);
                yl[(4 * fq + 2) * 64 + 16 * q + fr] = (u16)(y23 & 0xFFFFu);
                yl[(4 * fq + 3) * 64 + 16 * q + fr] = (u16)(y23 >> 16);
            }
            }
            RD_WAIT(par ^ 1);
          };
          body(IC(0)); body(IC(1)); body(IC(2)); body(IC(3)); body(IC(4)); body(IC(5)); body(IC(6)); body(IC(7)); body(IC(8)); body(IC(9)); body(IC(10)); body(IC(11));
        }
#pragma unroll
        for (int m = 0; m < 4; ++m) *(float4*)(zp + 4 * m) = make_float4(z[m][0], z[m][1], z[m][2], z[m][3]);
        asm volatile("s_waitcnt vmcnt(0)" ::: "memory");
        __builtin_amdgcn_s_setprio(0);
        __syncthreads();
    }
}

DEVINL void ph_rwout(const P& p, int l) {
    const int TIDX_ = tid_(); const int BIDX_ = bid_(); char* const WS_ = wsl_(p.ws);
    const int tid = TIDX_;
    const u16* pb = (const u16*)(WS_ + OFF_PB);
    const u16* yb = (const u16*)(WS_ + OFF_YRWB);
    const u16* gate = (const u16*)(WS_ + OFF_GATE);
    const float* bonus = (const float*)(WS_ + OFF_BONUS);
    u16* y = (u16*)(WS_ + OFF_Y);
    const float* mup = p.mu_prev + l * 960; const float* mun = p.mu_next + l * 960;
    const int c8 = (tid & 31) * 8, h = (tid & 31) >> 3;
    float lw[8], lb[8];
#pragma unroll
    for (int i = 0; i < 8; ++i) { lw[i] = p.rw_lnw[l * 256 + c8 + i]; lb[i] = p.rw_lnb[l * 256 + c8 + i]; }
    const int rstart = (l == 0) ? 0 : CTXROWS;
    for (int row = rstart + BIDX_ * 8 + (tid >> 5); row < T; row += gridDim.x * 8) {
        int t, seqlen;
        if (row < CTXROWS) { t = row & 255; seqlen = LCTX; } else { t = (row - CTXROWS) & (LAT - 1); seqlen = LAT; }
        const uint4 yfv = *(const uint4*)(y + (size_t)row * 1024 + 512 + c8), ybv = *(const uint4*)(yb + (size_t)row * 256 + c8);
        const uint4 gv = *(const uint4*)(gate + (size_t)row * 256 + c8);
        float v[8];
        rw_mix8(pb, mup, mun, row, t, seqlen, 512 + c8, v);
        const unsigned fw[4] = {yfv.x, yfv.y, yfv.z, yfv.w}, bw[4] = {ybv.x, ybv.y, ybv.z, ybv.w}, gw[4] = {gv.x, gv.y, gv.z, gv.w};
        float yv[8], gt[8]; float s1 = 0.f;
#pragma unroll
        for (int i = 0; i < 4; ++i) {
            yv[2 * i] = __uint_as_float(fw[i] << 16) + __uint_as_float(bw[i] << 16);
            yv[2 * i + 1] = __uint_as_float(fw[i] & 0xFFFF0000u) + __uint_as_float(bw[i] & 0xFFFF0000u);
            gt[2 * i] = __uint_as_float(gw[i] << 16); gt[2 * i + 1] = __uint_as_float(gw[i] & 0xFFFF0000u);
            s1 += yv[2 * i] + yv[2 * i + 1];
        }
        s1 += __shfl_xor(s1, 1); s1 += __shfl_xor(s1, 2); s1 += __shfl_xor(s1, 4);
        const float mu = s1 * (1.f / 64.f);
        float s2 = 0.f;
#pragma unroll
        for (int i = 0; i < 8; ++i) { const float dl = yv[i] - mu; s2 += dl * dl; }
        s2 += __shfl_xor(s2, 1); s2 += __shfl_xor(s2, 2); s2 += __shfl_xor(s2, 4);
        const float rstd = rsqrtf(s2 * (1.f / 64.f) + 64e-5f);
        const float bn = bonus[(size_t)row * 4 + h];
        float o[8];
#pragma unroll
        for (int i = 0; i < 8; ++i) o[i] = ((yv[i] - mu) * rstd * lw[i] + lb[i] + bn * v[i]) * gt[i];
        *(uint4*)(y + (size_t)row * 1024 + 512 + c8) = pack8bf(o);
    }
}
DEVINL void ph_prepM(const P& p, int l, char* smem, int bid, int nb) {
    const int TIDX_ = tid_(); const int BIDX_ = bid_(); char* const WS_ = wsl_(p.ws);
    const int tid = TIDX_, lane = tid & 63, wid = tid >> 6;
    const u16* pc = (const u16*)(WS_ + OFF_PC);
    u16* mlf = (u16*)(WS_ + OFF_MLF);
    float* mlg = (float*)(WS_ + OFF_MLG);
    float* mls = (float*)(WS_ + OFF_MLS);
    float* nst = (float*)(WS_ + OFF_NST);
    float* cst = (float*)(WS_ + OFF_HM);
    const float* rope = (const float*)(WS_ + OFF_ROPE);
    u16* kT = (u16*)smem;
    u16* vT = kT + 64 * 72;
    float* wsl = (float*)(vT + 64 * 72);
    float* lil = wsl + 128;
    for (int uh = bid; uh < NUNIT_CH * 4; uh += nb) {
        const int u = uh >> 2, h = uh & 3;
        int b, ch, row0, seqlen; bool isctx;
        if (u < 8) { isctx = true; b = u >> 2; ch = u & 3; row0 = b * 256 + ch * 64; seqlen = 256; }
        else { isctx = false; b = (u - 8) >> 8; ch = (u - 8) & 255; row0 = CTXROWS + b * LAT + ch * 64; seqlen = LAT; }
        const int t0 = ch * 64;
        const int tc = isctx ? ch : 4 + ch;
        __syncthreads();
        {
            const bool isk = wid >= 2;
            const int cch = (isk ? 256 : 0) + h * 64 + lane;
            const float* cw = p.ml_cw + (size_t)l * 3 * 512;
            const float w0 = cw[cch], w1 = cw[512 + cch], w2 = cw[1024 + cch], bb = p.ml_cb[l * 512 + cch];
            const int jb = (wid & 1) * 32;
            const int i16 = lane & 15; const bool second = (lane & 16) != 0; const int half = lane >> 5;
            float pv = (t0 + jb > 0) ? bf2f(pc[(size_t)(row0 + jb - 1) * 1040 + cch]) : 0.f;
            float cv = bf2f(pc[(size_t)(row0 + jb) * 1040 + cch]);
#pragma unroll 4
            for (int jj = 0; jj < 32; ++jj) {
                const int j = jb + jj;
                const float nv = (t0 + j + 1 < seqlen) ? bf2f(pc[(size_t)(row0 + j + 1) * 1040 + cch]) : 0.f;
                float val = siluf_(w0 * pv + w1 * cv + w2 * nv + bb);
                if (!isctx) {
                    const int t = t0 + j;
                    const int pos = half == 0 ? (t >> 6) : (t & 63);
                    const float cs = half == 0 ? rope[pos * 16 + i16] : rope[8192 + pos * 16 + i16];
                    const float sn = half == 0 ? rope[4096 + pos * 16 + i16] : rope[9216 + pos * 16 + i16];
                    const float ov = __shfl_xor(val, 16);
                    val = second ? (ov * sn + val * cs) : (val * cs - ov * sn);
                }
                if (isk) { const u16 kb = f2bf(val * 0.125f); mlf[(size_t)(row0 + j) * 512 + 256 + h * 64 + lane] = kb; kT[lane * 72 + j] = kb; }
                else mlf[(size_t)(row0 + j) * 512 + h * 64 + lane] = f2bf(val);
                pv = cv; cv = nv;
            }
            {
                const int j = tid >> 2, wh = tid & 3;
                const int idx = (wh < 2) ? (wh * 4 + h) : (8 + (wh - 2) * 4 + h);
                const float g = bf2f(pc[(size_t)(row0 + j) * 1040 + 1024 + idx]);
                float v;
                if (wh < 2) v = g + p.ml_ib[l * 8 + idx];
                else { const float xx = g + p.ml_fb[l * 8 + idx - 8]; v = fminf(xx, 0.f) - log1pf(__expf(-fabsf(xx))); }
                lil[j * 4 + wh] = v;
                if (wh < 2) mlg[(size_t)(row0 + j) * 16 + idx] = v;
            }
            for (int i = tid; i < 64 * 8; i += 256) {
                const int tok = i >> 3, d8 = (i & 7) * 8;
                const uint4 vv = *(const uint4*)(pc + (size_t)(row0 + tok) * 1040 + 512 + h * 64 + d8);
                const unsigned wv[4] = {vv.x, vv.y, vv.z, vv.w};
#pragma unroll
                for (int k = 0; k < 4; ++k) { vT[(d8 + 2 * k) * 72 + tok] = (u16)(wv[k] & 0xFFFFu); vT[(d8 + 2 * k + 1) * 72 + tok] = (u16)(wv[k] >> 16); }
            }
        }
        __syncthreads();
        if (wid < 2) {
            const int d = wid, tok = d ? 63 - lane : lane;
            float bsum = lil[tok * 4 + 2 + d];
#pragma unroll
            for (int off = 1; off < 64; off <<= 1) { const float o = __shfl_up(bsum, off); if (lane >= off) bsum += o; }
            const float Bs = __shfl(bsum, 63);
            const float gl = Bs - bsum + lil[tok * 4 + d];
            float G = gl;
#pragma unroll
            for (int off = 32; off > 0; off >>= 1) G = fmaxf(G, __shfl_xor(G, off));
            wsl[d * 64 + tok] = __expf(gl - G);
            mlg[(size_t)(row0 + tok) * 16 + 8 + d * 4 + h] = bsum;
            if (lane == 0) { const int bhd = (b * 4 + h) * 2 + d; mls[(bhd * NTC + tc) * 2 + 0] = G; mls[(bhd * NTC + tc) * 2 + 1] = Bs; }
        }
        __syncthreads();
        {
            const int fr = lane & 15, g = lane >> 4;
            const int bh0 = ((b * 4 + h) * 2 + 0) * NTC + tc, bh1 = ((b * 4 + h) * 2 + 1) * NTC + tc;
            bf16x8 va[2];
            va[0] = *(const bf16x8*)(vT + (16 * wid + fr) * 72 + 8 * g);
            va[1] = *(const bf16x8*)(vT + (16 * wid + fr) * 72 + 32 + 8 * g);
#pragma unroll 1
            for (int dkt = 0; dkt < 4; ++dkt) {
                f32x4 u0 = f32x4{0.f, 0.f, 0.f, 0.f}, u1 = f32x4{0.f, 0.f, 0.f, 0.f};
#pragma unroll
                for (int ks = 0; ks < 2; ++ks) {
                    const uint4 kv = *(const uint4*)(kT + (16 * dkt + fr) * 72 + 32 * ks + 8 * g);
                    const float4 wa0 = *(const float4*)(wsl + 32 * ks + 8 * g), wa1 = *(const float4*)(wsl + 32 * ks + 8 * g + 4);
                    const float4 wb0 = *(const float4*)(wsl + 64 + 32 * ks + 8 * g), wb1 = *(const float4*)(wsl + 64 + 32 * ks + 8 * g + 4);
                    const unsigned kw[4] = {kv.x, kv.y, kv.z, kv.w};
                    const float w0[8] = {wa0.x, wa0.y, wa0.z, wa0.w, wa1.x, wa1.y, wa1.z, wa1.w}, w1[8] = {wb0.x, wb0.y, wb0.z, wb0.w, wb1.x, wb1.y, wb1.z, wb1.w};
                    union { u32x4 u; bf16x8 f; } b0, b1;
#pragma unroll
                    for (int i = 0; i < 4; ++i) {
                        const float ka = __uint_as_float(kw[i] << 16), kb = __uint_as_float(kw[i] & 0xFFFF0000u);
                        b0.u[i] = pk2bf(ka * w0[2 * i], kb * w0[2 * i + 1]);
                        b1.u[i] = pk2bf(ka * w1[2 * i], kb * w1[2 * i + 1]);
                    }
                    u0 = __builtin_amdgcn_mfma_f32_16x16x32_bf16(va[ks], b0.f, u0, 0, 0, 0);
                    u1 = __builtin_amdgcn_mfma_f32_16x16x32_bf16(va[ks], b1.f, u1, 0, 0, 0);
                }
#pragma unroll
                for (int r = 0; r < 4; ++r) {
                    cst[(size_t)bh0 * 4096 + (16 * wid + 4 * g + r) * 64 + 16 * dkt + fr] = u0[r];
                    cst[(size_t)bh1 * 4096 + (16 * wid + 4 * g + r) * 64 + 16 * dkt + fr] = u1[r];
                }
            }
            if (tid < 128) {
                const int d = tid >> 6, dk = tid & 63;
                float acc = 0.f;
#pragma unroll 8
                for (int j = 0; j < 64; ++j) acc += bf2f(kT[dk * 72 + j]) * wsl[d * 64 + j];
                nst[(size_t)(d ? bh1 : bh0) * 64 + dk] = acc;
            }
        }
    }
}

DEVINL void ph_mlB(const P& p, int bid, int nb, char* smem) {
    const int TIDX_ = tid_(); char* const WS_ = wsl_(p.ws);
    const int tid = TIDX_;
    const float* mls = (const float*)(WS_ + OFF_MLS);
    float* mst = (float*)(WS_ + OFF_MST);
    float* nst = (float*)(WS_ + OFF_NST);
    const float* cst = (const float*)(WS_ + OFF_HM);
    u16* cst2 = (u16*)(WS_ + OFF_CST2);
    float* nst2 = (float*)(WS_ + OFF_NST2);
    float* gb = (float*)smem;
    float* dcu = gb + 1024;
    for (int u = bid; u < 64; u += nb) {
        const int bhd = u >> 2, q = u & 3, d = bhd & 1;
        auto tcof = [&](int cs) { return cs < 4 ? (d ? 3 - cs : cs) : 4 + (d ? 255 - (cs - 4) : cs - 4); };
        __syncthreads();
        for (int cs = tid; cs < NTC; cs += 256) { const int tc = tcof(cs); gb[cs * 2] = mls[(bhd * NTC + tc) * 2]; gb[cs * 2 + 1] = mls[(bhd * NTC + tc) * 2 + 1]; }
        __syncthreads();
        if (tid == 0) {
            float m = 0.f;
#pragma unroll 1
            for (int cs = 0; cs < NTC; ++cs) {
                const float G = gb[cs * 2], Bs = gb[cs * 2 + 1];
                if (q == 0) mst[bhd * NTC + tcof(cs)] = m;
                const float ml = fmaxf(Bs + m, G);
                dcu[cs * 2] = __expf(Bs + m - ml); dcu[cs * 2 + 1] = __expf(G - ml);
                m = ml;
            }
        }
        __syncthreads();
        float zz = 0.f; asm volatile("" : "+v"(zz));
        float4 C = make_float4(zz, zz, zz, zz);
        float nn = zz;
        const bool don = (q == 0) && (tid < 64);
        const float* cbase = cst + (size_t)bhd * NTC * 4096 + q * 1024 + tid * 4;
        const float* nbase = nst + (size_t)bhd * NTC * 64 + tid;
        u16* obase = cst2 + (size_t)bhd * NTC * 4096 + q * 1024 + tid * 4;
        float* onbase = nst2 + (size_t)bhd * NTC * 64 + tid;
        float4 Ub[8]; float Nb[8];
#pragma unroll
        for (int i = 0; i < 8; ++i) { Ub[i] = *(const float4*)(cbase + (size_t)tcof(i) * 4096); Nb[i] = don ? nbase[(size_t)tcof(i) * 64] : 0.f; }
#pragma unroll 1
        for (int cs0 = 0; cs0 < NTC; cs0 += 8) {
#pragma unroll
            for (int i = 0; i < 8; ++i) {
                const int cs = cs0 + i;
                if (cs < NTC) {
                    const float4 U = Ub[i]; const float nU = Nb[i];
                    const int tc = tcof(cs);
                    if (cs + 8 < NTC) { Ub[i] = *(const float4*)(cbase + (size_t)tcof(cs + 8) * 4096); Nb[i] = don ? nbase[(size_t)tcof(cs + 8) * 64] : 0.f; }
                    { uint2 o; o.x = pk2bf(C.x, C.y); o.y = pk2bf(C.z, C.w); *(uint2*)(obase + (size_t)tc * 4096) = o; }
                    if (don) onbase[(size_t)tc * 64] = nn;
                    const float dC = dcu[cs * 2], dU = dcu[cs * 2 + 1];
                    C.x = dC * C.x + dU * U.x; C.y = dC * C.y + dU * U.y; C.z = dC * C.z + dU * U.z; C.w = dC * C.w + dU * U.w;
                    nn = dC * nn + dU * nU;
                }
            }
        }
    }
}

DEVINL void ph_na(const P& p, int l, char* smem, int bid, int nb) {
    const int TIDX_ = tid_(); char* const WS_ = wsl_(p.ws);
    const int tid = TIDX_, lane = tid & 63, w = tid >> 6, fr = lane & 15, g = lane >> 4;
    const u16* pqk = (const u16*)(WS_ + OFF_PQK);
    const u16* vtl = (const u16*)(WS_ + OFF_VTL);
    const u16* vtc = (const u16*)(WS_ + OFF_VTC);
    u16* y = (u16*)(WS_ + OFF_Y);
    float* rpbl = (float*)(smem + 49152);
    const int nunit = 4096 + (l == 0 ? 64 : 0);
    const unsigned lbase = lds_addr(smem);
    const int lrow0 = tid >> 3, lrow1 = lrow0 + 32, lsc = ((tid & 7) ^ (lrow0 & 7)) * 8;
    for (int u = bid; u < nunit; u += nb) {
        const bool isctx = u >= 4096;
        int b, h, r = 0, qg = 0;
        if (!isctx) { b = u >> 11; h = (u >> 8) & 7; r = u & 255; }
        else { const int v = u - 4096; b = v >> 5; h = (v >> 2) & 7; qg = v & 3; }
        const int rs = min(max(r - 4, 0), 248);
        const int nwin = isctx ? 0 : 8, nst = nwin + 4;
        auto issue = [&](int st) {
            char* slot = smem + (st % 3) * 16384;
            const u16* ksrc; const u16* vsrc; size_t vstride;
            if (st < nwin) {
                const size_t tok0 = (size_t)CTXROWS + (size_t)b * LAT + (size_t)(rs + st) * 64;
                ksrc = pqk + tok0 * 1024 + 512 + h * 64;
                vsrc = vtl + (size_t)((b * 8 + h) * 64) * LAT + (size_t)(rs + st) * 64; vstride = LAT;
            } else {
                const size_t tok0 = (size_t)b * LCTX + (size_t)(st - nwin) * 64;
                ksrc = pqk + tok0 * 1024 + 512 + h * 64;
                vsrc = vtc + (size_t)((b * 8 + h) * 64) * LCTX + (size_t)(st - nwin) * 64; vstride = LCTX;
            }
            glds16(ksrc + (size_t)lrow0 * 1024 + lsc, slot + tid * 16);
            glds16(ksrc + (size_t)lrow1 * 1024 + lsc, slot + 4096 + tid * 16);
            glds16(vsrc + (size_t)lrow0 * vstride + lsc, slot + 8192 + tid * 16);
            glds16(vsrc + (size_t)lrow1 * vstride + lsc, slot + 8192 + 4096 + tid * 16);
        };
        __syncthreads();
        issue(0); issue(1);
        if (!isctx) for (int i = tid; i < 465; i += 256) rpbl[i] = p.na_rpb[((size_t)l * 8 + h) * 465 + i];
        asm volatile("s_waitcnt lgkmcnt(0)" ::: "memory");
        const int c = 16 * w + fr;
        const int qrow = isctx ? b * LCTX + qg * 64 + c : CTXROWS + b * LAT + r * 64 + c;
        bf16x8 qf[2];
        qf[0] = *(const bf16x8*)(pqk + (size_t)qrow * 1024 + h * 64 + 8 * g);
        qf[1] = *(const bf16x8*)(pqk + (size_t)qrow * 1024 + h * 64 + 32 + 8 * g);
        f32x4 O[4];
#pragma unroll
        for (int i = 0; i < 4; ++i) O[i] = f32x4{0.f, 0.f, 0.f, 0.f};
        float mrun = -1.0e30f, lrun = 0.f;
        const int cb = (w == 0) ? 0 : (w == 1) ? 8 : (w == 2) ? 24 : 32;
        const int cs = min(max(c - 8, 0), 48);
        auto chunk = [&](unsigned sl, int kb, const float* bias0, bool local) {
            const int key0 = kb + fr, key1 = kb + 16 + fr;
            const unsigned ka0 = sl + key0 * 128, ka1 = sl + key1 * 128;
            const unsigned k00a = ka0 + ((g ^ (key0 & 7)) << 4), k01a = ka0 + (((4 + g) ^ (key0 & 7)) << 4);
            const unsigned k10a = ka1 + ((g ^ (key1 & 7)) << 4), k11a = ka1 + (((4 + g) ^ (key1 & 7)) << 4);
            const int q0 = (kb >> 2) + g, q1 = q0 + 4;
            const unsigned vbase = sl + 8192 + fr * 128;
            const unsigned vo0 = ((((q0 >> 1) ^ (fr & 7)) << 4) + ((q0 & 1) << 3)), vo1 = ((((q1 >> 1) ^ (fr & 7)) << 4) + ((q1 & 1) << 3));
            u32x4 k00, k01, k10, k11; u32x2 vlo0, vhi0, vlo1, vhi1, vlo2, vhi2, vlo3, vhi3;
            asm volatile(
                "ds_read_b128 %0, %12\n\t"
                "ds_read_b128 %1, %13\n\t"
                "ds_read_b128 %2, %14\n\t"
                "ds_read_b128 %3, %15\n\t"
                "ds_read_b64 %4, %16\n\t"
                "ds_read_b64 %5, %17\n\t"
                "ds_read_b64 %6, %16 offset:2048\n\t"
                "ds_read_b64 %7, %17 offset:2048\n\t"
                "ds_read_b64 %8, %16 offset:4096\n\t"
                "ds_read_b64 %9, %17 offset:4096\n\t"
                "ds_read_b64 %10, %16 offset:6144\n\t"
                "ds_read_b64 %11, %17 offset:6144\n\t"
                "s_waitcnt lgkmcnt(0)"
                : "=&v"(k00), "=&v"(k01), "=&v"(k10), "=&v"(k11), "=&v"(vlo0), "=&v"(vhi0), "=&v"(vlo1), "=&v"(vhi1),
                  "=&v"(vlo2), "=&v"(vhi2), "=&v"(vlo3), "=&v"(vhi3)
                : "v"(k00a), "v"(k01a), "v"(k10a), "v"(k11a), "v"(vbase + vo0), "v"(vbase + vo1)
                : "memory");
            auto asf = [](u32x4 v) { union { u32x4 u; bf16x8 f; } x; x.u = v; return x.f; };
            f32x4 s0 = f32x4{0.f, 0.f, 0.f, 0.f}, s1 = f32x4{0.f, 0.f, 0.f, 0.f};
            s0 = __builtin_amdgcn_mfma_f32_16x16x32_bf16(asf(k00), qf[0], s0, 0, 0, 0);
            s0 = __builtin_amdgcn_mfma_f32_16x16x32_bf16(asf(k01), qf[1], s0, 0, 0, 0);
            s1 = __builtin_amdgcn_mfma_f32_16x16x32_bf16(asf(k10), qf[0], s1, 0, 0, 0);
            s1 = __builtin_amdgcn_mfma_f32_16x16x32_bf16(asf(k11), qf[1], s1, 0, 0, 0);
            float sv[8];
#pragma unroll
            for (int j = 0; j < 4; ++j) {
                float a = s0[j] * 0.125f, bb = s1[j] * 0.125f;
                if (local) {
                    const int k0c = kb + 4 * g + j, k1c = k0c + 16;
                    a = (k0c >= cs && k0c <= cs + 15) ? a + bias0[k0c] : -1.0e30f;
                    bb = (k1c >= cs && k1c <= cs + 15) ? bb + bias0[k1c] : -1.0e30f;
                }
                sv[j] = a; sv[4 + j] = bb;
            }
            float mx = sv[0];
#pragma unroll
            for (int j = 1; j < 8; ++j) mx = fmaxf(mx, sv[j]);
            mx = fmaxf(mx, __shfl_xor(mx, 16)); mx = fmaxf(mx, __shfl_xor(mx, 32));
            const float mnew = fmaxf(mrun, mx);
            const float sc = __expf(mrun - mnew);
            mrun = mnew;
            float ps = 0.f; float pv[8];
#pragma unroll
            for (int j = 0; j < 8; ++j) { pv[j] = __expf(sv[j] - mnew); ps += pv[j]; }
            lrun = lrun * sc + ps;
            union { u32x4 u; bf16x8 f; } pf; pf.u = u32x4{pk2bf(pv[0], pv[1]), pk2bf(pv[2], pv[3]), pk2bf(pv[4], pv[5]), pk2bf(pv[6], pv[7])};
            const u32x2 vl[4] = {vlo0, vlo1, vlo2, vlo3}, vh[4] = {vhi0, vhi1, vhi2, vhi3};
#pragma unroll
            for (int dt = 0; dt < 4; ++dt) {
                O[dt][0] *= sc; O[dt][1] *= sc; O[dt][2] *= sc; O[dt][3] *= sc;
                union { u32x4 u; bf16x8 f; } vf; vf.u = u32x4{vl[dt].x, vl[dt].y, vh[dt].x, vh[dt].y};
                O[dt] = __builtin_amdgcn_mfma_f32_16x16x32_bf16(vf.f, pf.f, O[dt], 0, 0, 0);
            }
        };
#pragma unroll 1
        for (int st = 0; st < nst; ++st) {
            if (st + 1 < nst) asm volatile("s_waitcnt vmcnt(4)" ::: "memory"); else asm volatile("s_waitcnt vmcnt(0)" ::: "memory");
            __builtin_amdgcn_s_barrier();
            if (st + 2 < nst) issue(st + 2);
            const unsigned sl = lbase + (st % 3) * 16384;
            if (st < nwin) {
                const int krow = rs + st;
                chunk(sl, cb, rpbl + (krow - r + 7) * 31 - c + 15, true);
            } else {
                chunk(sl, 0, nullptr, false);
                chunk(sl, 32, nullptr, false);
            }
        }
        float lt = lrun; lt += __shfl_xor(lt, 16); lt += __shfl_xor(lt, 32);
        const float inv = 1.f / lt;
#pragma unroll
        for (int dt = 0; dt < 4; ++dt) {
            uint2 o;
            o.x = pk2bf(O[dt][0] * inv, O[dt][1] * inv);
            o.y = pk2bf(O[dt][2] * inv, O[dt][3] * inv);
            *(uint2*)(y + (size_t)qrow * 1024 + h * 64 + dt * 16 + 4 * g) = o;
        }
    }
    asm volatile("s_waitcnt vmcnt(0)" ::: "memory");
    __syncthreads();
}

DEVINL void ph_mlC(const P& p, int l, char* smem, int bid, int nb) {
    const int TIDX_ = tid_(); char* const WS_ = wsl_(p.ws);
    const int tid = TIDX_, lane = tid & 63, w = tid >> 6, fr = lane & 15, g = lane >> 4;
    const u16* mlf = (const u16*)(WS_ + OFF_MLF);
    const u16* pc = (const u16*)(WS_ + OFF_PC);
    const float* mlg = (const float*)(WS_ + OFF_MLG);
    const float* mst = (const float*)(WS_ + OFF_MST);
    const float* nst = (const float*)(WS_ + OFF_NST2);
    const u16* cst = (const u16*)(WS_ + OFF_CST2);
    u16* y = (u16*)(WS_ + OFF_Y);
    u16* vt = (u16*)smem;
    float* btl = (float*)(smem + 9216);
    float* lil = btl + 128;
    float* nl = lil + 128;
    for (int uh = bid; uh < 2 * NTC * 4; uh += nb) {
        const int u = uh >> 2, h = uh & 3;
        const int b = u / NTC, tc = u % NTC;
        if (tc < 4 && l != 0) continue;
        const int row0 = tc < 4 ? b * LCTX + tc * 64 : CTXROWS + b * LAT + (tc - 4) * 64;
        __syncthreads();
        for (int i = tid; i < 64 * 8; i += 256) {
            const int tok = i >> 3, d8 = (i & 7) * 8;
            const uint4 vv = *(const uint4*)(pc + (size_t)(row0 + tok) * 1040 + 512 + h * 64 + d8);
            const unsigned wv[4] = {vv.x, vv.y, vv.z, vv.w};
#pragma unroll
            for (int k = 0; k < 4; ++k) { vt[(d8 + 2 * k) * 72 + tok] = (u16)(wv[k] & 0xFFFFu); vt[(d8 + 2 * k + 1) * 72 + tok] = (u16)(wv[k] >> 16); }
        }
        if (tid < 128) {
            const int d = tid >> 6, tok = tid & 63;
            lil[d * 64 + tok] = mlg[(size_t)(row0 + tok) * 16 + d * 4 + h];
            nl[d * 64 + tok] = nst[((size_t)((b * 4 + h) * 2 + d) * NTC + tc) * 64 + tok];
        }
        else { const int d = (tid - 128) >> 6, tok = tid & 63; btl[d * 64 + tok] = mlg[(size_t)(row0 + tok) * 16 + 8 + d * 4 + h]; }
        const int t = 16 * w + fr;
        bf16x8 qf[2];
        qf[0] = *(const bf16x8*)(mlf + (size_t)(row0 + t) * 512 + h * 64 + 8 * g);
        qf[1] = *(const bf16x8*)(mlf + (size_t)(row0 + t) * 512 + h * 64 + 32 + 8 * g);
        f32x4 S[4];
#pragma unroll
        for (int st = 0; st < 4; ++st) {
            const u16* kp = mlf + (size_t)(row0 + 16 * st + fr) * 512 + 256 + h * 64 + 8 * g;
            const bf16x8 k0 = *(const bf16x8*)kp, k1 = *(const bf16x8*)(kp + 32);
            S[st] = f32x4{0.f, 0.f, 0.f, 0.f};
            S[st] = __builtin_amdgcn_mfma_f32_16x16x32_bf16(k0, qf[0], S[st], 0, 0, 0);
            S[st] = __builtin_amdgcn_mfma_f32_16x16x32_bf16(k1, qf[1], S[st], 0, 0, 0);
        }
        __syncthreads();
        f32x4 hs[4];
#pragma unroll
        for (int i = 0; i < 4; ++i) hs[i] = f32x4{0.f, 0.f, 0.f, 0.f};
#pragma unroll 1
        for (int d = 0; d < 2; ++d) {
            const int bhd = (b * 4 + h) * 2 + d;
            const float m0 = mst[bhd * NTC + tc];
            const float bt = btl[d * 64 + t];
            float ld[16]; float mx = -3.0e38f;
#pragma unroll
            for (int st = 0; st < 4; ++st) {
                const float4 b4 = *(const float4*)(btl + d * 64 + 16 * st + 4 * g), l4 = *(const float4*)(lil + d * 64 + 16 * st + 4 * g);
                const float bs[4] = {b4.x, b4.y, b4.z, b4.w}, ls[4] = {l4.x, l4.y, l4.z, l4.w};
#pragma unroll
                for (int r = 0; r < 4; ++r) {
                    const int s = 16 * st + 4 * g + r;
                    const bool ok = d ? (s >= t) : (s <= t);
                    ld[4 * st + r] = ok ? (bt - bs[r] + ls[r]) : -3.0e38f;
                    mx = fmaxf(mx, ld[4 * st + r]);
                }
            }
            mx = fmaxf(mx, __shfl_xor(mx, 16)); mx = fmaxf(mx, __shfl_xor(mx, 32));
            const float mt = fmaxf(bt + m0, mx);
            float rsum = 0.f; float dw[16];
#pragma unroll
            for (int i = 0; i < 16; ++i) { dw[i] = (ld[i] > -1.0e38f) ? __expf(ld[i] - mt) * S[i >> 2][i & 3] : 0.f; rsum += dw[i]; }
            rsum += __shfl_xor(rsum, 16); rsum += __shfl_xor(rsum, 32);
            const float inter = __expf(bt + m0 - mt);
            float qn = 0.f;
#pragma unroll
            for (int j = 0; j < 8; ++j) {
                qn += bf2f((u16)qf[0][j]) * nl[d * 64 + 8 * g + j] + bf2f((u16)qf[1][j]) * nl[d * 64 + 32 + 8 * g + j];
            }
            qn += __shfl_xor(qn, 16); qn += __shfl_xor(qn, 32);
            const float den = rsum + inter * qn;
            const float dn = 1.f / fmaxf(fabsf(den), __expf(-mt));
            union { u32x4 u; bf16x8 f; } pf[2];
#pragma unroll
            for (int ks = 0; ks < 2; ++ks) pf[ks].u = u32x4{pk2bf(dw[8 * ks], dw[8 * ks + 1]), pk2bf(dw[8 * ks + 2], dw[8 * ks + 3]), pk2bf(dw[8 * ks + 4], dw[8 * ks + 5]), pk2bf(dw[8 * ks + 6], dw[8 * ks + 7])};
            const u16* cb = cst + ((size_t)bhd * NTC + tc) * 4096;
#pragma unroll
            for (int dvt = 0; dvt < 4; ++dvt) {
                f32x4 num = f32x4{0.f, 0.f, 0.f, 0.f}, qc = f32x4{0.f, 0.f, 0.f, 0.f};
#pragma unroll
                for (int ks = 0; ks < 2; ++ks) {
                    const uint2 lo = *(const uint2*)(vt + (16 * dvt + fr) * 72 + 32 * ks + 4 * g), hi = *(const uint2*)(vt + (16 * dvt + fr) * 72 + 32 * ks + 16 + 4 * g);
                    union { u32x4 u; bf16x8 f; } vf; vf.u = u32x4{lo.x, lo.y, hi.x, hi.y};
                    num = __builtin_amdgcn_mfma_f32_16x16x32_bf16(vf.f, pf[ks].f, num, 0, 0, 0);
                    const bf16x8 cf = *(const bf16x8*)(cb + (16 * dvt + fr) * 64 + 32 * ks + 8 * g);
                    qc = __builtin_amdgcn_mfma_f32_16x16x32_bf16(cf, qf[ks], qc, 0, 0, 0);
                }
#pragma unroll
                for (int r = 0; r < 4; ++r) hs[dvt][r] += (num[r] + inter * qc[r]) * dn;
            }
        }
        float s1 = 0.f;
#pragma unroll
        for (int i = 0; i < 4; ++i) s1 += hs[i][0] + hs[i][1] + hs[i][2] + hs[i][3];
        s1 += __shfl_xor(s1, 16); s1 += __shfl_xor(s1, 32);
        const float mu = s1 * (1.f / 64.f);
        float s2 = 0.f;
#pragma unroll
        for (int i = 0; i < 4; ++i)
#pragma unroll
            for (int r = 0; r < 4; ++r) { const float dl = hs[i][r] - mu; s2 += dl * dl; }
        s2 += __shfl_xor(s2, 16); s2 += __shfl_xor(s2, 32);
        const float rstd = rsqrtf(s2 * (1.f / 64.f) + 1e-6f);
        const int row = row0 + t;
#pragma unroll
        for (int dvt = 0; dvt < 4; ++dvt) {
            const int cc = h * 64 + 16 * dvt + 4 * g;
            const uint2 ov = *(const uint2*)(pc + (size_t)row * 1040 + 768 + cc);
            const float4 nw = *(const float4*)(p.ml_nw + l * 256 + cc);
            const float o0 = bf2f((u16)(ov.x & 0xFFFF)), o1 = bf2f((u16)(ov.x >> 16)), o2 = bf2f((u16)(ov.y & 0xFFFF)), o3 = bf2f((u16)(ov.y >> 16));
            uint2 out;
            out.x = pk2bf((hs[dvt][0] - mu) * rstd * nw.x * sigmoidf_(o0), (hs[dvt][1] - mu) * rstd * nw.y * sigmoidf_(o1));
            out.y = pk2bf((hs[dvt][2] - mu) * rstd * nw.z * sigmoidf_(o2), (hs[dvt][3] - mu) * rstd * nw.w * sigmoidf_(o3));
            *(uint2*)(y + (size_t)row * 1024 + 768 + cc) = out;
        }
    }
}

DEVINL void ph_outproj(const P& p, int l, char* smem) {
    const int TIDX_ = tid_(); const int BIDX_ = bid_(); char* const WS_ = wsl_(p.ws); (void)TIDX_; (void)BIDX_; (void)WS_;
    const u16* y = (const u16*)(WS_ + OFF_Y);
    const u16* wout = (const u16*)(WS_ + OFF_WOUT);
    const float* modv = (const float*)(WS_ + OFF_MOD) + (size_t)l * 3 * 6144;
    const float* x2c = (const float*)(WS_ + OFF_X2CTX);
    float* x1 = (float*)(WS_ + OFF_X1);
    const int mt0 = (l == 0) ? 0 : 4;
    const int ntile = (260 - mt0) * 8;
    XCD_WALK(ntile, BIDX_, (int)gridDim.x);
    for (int u = xw_lo; u < xw_hi; u += xw_st) {
        const int mt = mt0 + u / 8, nt = u % 8;
        const u16* A = y + (size_t)mt * 128 * 1024;
        const int R0 = mt * 128;
        const float* xin;
        if (l == 0) xin = R0 < CTXROWS ? p.ctx + (size_t)R0 * 1024 : p.x + (size_t)(R0 - CTXROWS) * 1024;
        else xin = R0 < CTXROWS ? x2c + (size_t)R0 * 1024 : p.out + (size_t)(R0 - CTXROWS) * 1024;
        const float* g1 = modv + row_sel(R0) * 6144 + 2048;
        f32x4 acc[4][4];
        gemm128_acc([&](int r) { return A + (size_t)r * 1024; }, wout + (size_t)nt * 128 * 1024, 1024, 1024, smem, acc);
        stage_tile_f32(acc, smem, [&](int row, int c4, float4 a) {
            const int N = nt * 128 + c4;
            const float4 gg = *(const float4*)(g1 + N);
            const float4 xv = *(const float4*)(xin + (size_t)row * 1024 + N);
            float4 o;
            o.x = ALPHA * xv.x + gg.x * a.x; o.y = ALPHA * xv.y + gg.y * a.y; o.z = ALPHA * xv.z + gg.z * a.z; o.w = ALPHA * xv.w + gg.w * a.w;
            *(float4*)(x1 + (size_t)(R0 + row) * 1024 + N) = o;
        });
    }
}

DEVINL void ph_ln1(const P& p, int l) {
    const int TIDX_ = tid_(); const int BIDX_ = bid_(); char* const WS_ = wsl_(p.ws); (void)TIDX_; (void)BIDX_; (void)WS_;
    const int lane = TIDX_ & 63, wid = TIDX_ >> 6;
    const float* modv = (const float*)(WS_ + OFF_MOD) + (size_t)l * 3 * 6144;
    float* x1 = (float*)(WS_ + OFF_X1);
    u16* hm = (u16*)(WS_ + OFF_HM);
    const int rstart = (l == 0) ? 0 : CTXROWS;
    for (int row = rstart + BIDX_ * 4 + wid; row < T; row += gridDim.x * 4) {
        float4 v[4];
        float s = 0.f;
#pragma unroll
        for (int i = 0; i < 4; ++i) { v[i] = *(const float4*)(x1 + (size_t)row * 1024 + i * 256 + lane * 4); s += v[i].x + v[i].y + v[i].z + v[i].w; }
        const float mu = wsum(s) * (1.f / 1024.f);
        float q = 0.f;
#pragma unroll
        for (int i = 0; i < 4; ++i) { v[i].x -= mu; v[i].y -= mu; v[i].z -= mu; v[i].w -= mu; q += v[i].x * v[i].x + v[i].y * v[i].y + v[i].z * v[i].z + v[i].w * v[i].w; }
        const float rstd = rsqrtf(wsum(q) * (1.f / 1024.f) + 1e-5f);
        const float* mv = modv + row_sel(row) * 6144;
#pragma unroll
        for (int i = 0; i < 4; ++i) {
            const int c = i * 256 + lane * 4;
            const float4 g = *(const float4*)(p.ln1g + l * 1024 + c), bb = *(const float4*)(p.ln1b + l * 1024 + c);
            const float4 sh = *(const float4*)(mv + 3072 + c), sc = *(const float4*)(mv + 4096 + c);
            float4 o;
            o.x = v[i].x * rstd * g.x + bb.x; o.y = v[i].y * rstd * g.y + bb.y; o.z = v[i].z * rstd * g.z + bb.z; o.w = v[i].w * rstd * g.w + bb.w;
            *(float4*)(x1 + (size_t)row * 1024 + c) = o;
            uint2 hh;
            hh.x = (unsigned)f2bf(o.x * (1.f + sc.x) + sh.x) | ((unsigned)f2bf(o.y * (1.f + sc.y) + sh.y) << 16);
            hh.y = (unsigned)f2bf(o.z * (1.f + sc.z) + sh.z) | ((unsigned)f2bf(o.w * (1.f + sc.w) + sh.w) << 16);
            *(uint2*)(hm + (size_t)row * 1024 + c) = hh;
        }
    }
}

DEVINL void ph_router(const P& p, int l, char* smem) {
    const int TIDX_ = tid_(); const int BIDX_ = bid_(); char* const WS_ = wsl_(p.ws); (void)TIDX_; (void)BIDX_; (void)WS_;
    const u16* hm = (const u16*)(WS_ + OFF_HM);
    const u16* wr = (const u16*)(WS_ + OFF_WR) + (size_t)l * 128 * 1024;
    float* lg = (float*)(WS_ + OFF_LOGITS);
    const int mt0 = (l == 0) ? 0 : 4;
    for (int u = BIDX_; u < 260 - mt0; u += gridDim.x) {
        const int mt = mt0 + u;
        const u16* A = hm + (size_t)mt * 128 * 1024;
        gemm128([&](int r) { return A + (size_t)r * 1024; }, wr, 1024, 1024, smem,
                [&](int m, int n, f32x4 a) {
                    if (n < 36) {
#pragma unroll
                        for (int j = 0; j < 4; ++j) lg[(size_t)(mt * 128 + m + j) * 64 + n] = a[j];
                    }
                });
    }
}

DEVINL void ph_route1(const P& p, int l, char* smem) {
    const int TIDX_ = tid_(); const int BIDX_ = bid_(); char* const WS_ = wsl_(p.ws); (void)TIDX_; (void)BIDX_; (void)WS_;
    const int tid = TIDX_;
    const float* lg = (const float*)(WS_ + OFF_LOGITS);
    int* toke = (int*)(WS_ + OFF_TOKE); float* tokw = (float*)(WS_ + OFF_TOKW);
    int* cnt = (int*)(WS_ + CTL_CNT) + l * 32;
    int* hist = (int*)smem;
    __syncthreads();
    if (tid < 32) hist[tid] = 0;
    __syncthreads();
    const int rstart = (l == 0) ? 0 : CTXROWS;
    for (int row = rstart + BIDX_ * 256 + tid; row < T; row += gridDim.x * 256) {
        const float* q = lg + (size_t)row * 64;
        float gl[4]; int gs = 0; float gm = -3.0e38f;
#pragma unroll
        for (int i = 0; i < 4; ++i) { gl[i] = q[i] + p.rgb[l * 4 + i]; if (gl[i] > gm) { gm = gl[i]; gs = i; } }
        float se = 0.f;
#pragma unroll
        for (int i = 0; i < 4; ++i) se += expf(gl[i] - gm);
        const float gw = 1.f / se;
        float v1 = -3.0e38f, v2 = -3.0e38f; int i1 = 0, i2 = 0;
#pragma unroll
        for (int i = 0; i < 8; ++i) {
            const float e = q[4 + gs * 8 + i] + p.reb[l * 32 + gs * 8 + i];
            if (e > v1) { v2 = v1; i2 = i1; v1 = e; i1 = i; }
            else if (e > v2) { v2 = e; i2 = i; }
        }
        const float e2 = expf(v2 - v1);
        const float w1 = gw / (1.f + e2), w2 = gw * e2 / (1.f + e2);
        const int ea = gs * 8 + i1, eb = gs * 8 + i2;
        toke[row * 2] = ea; toke[row * 2 + 1] = eb; tokw[row * 2] = w1; tokw[row * 2 + 1] = w2;
        atomicAdd(&hist[ea], 1); atomicAdd(&hist[eb], 1);
    }
    __syncthreads();
    if (tid < 32 && hist[tid] > 0) atomicAdd(&cnt[tid], hist[tid]);
}

DEVINL void ph_route2(const P& p, int l, char* smem) {
    const int TIDX_ = tid_(); const int BIDX_ = bid_(); char* const WS_ = wsl_(p.ws); (void)TIDX_; (void)BIDX_; (void)WS_;
    const int tid = TIDX_;
    const int* toke = (const int*)(WS_ + OFF_TOKE);
    int* toks = (int*)(WS_ + OFF_TOKS);
    int* slottok = (int*)(WS_ + OFF_SLOTTOK);
    const int* cnt = (const int*)(WS_ + CTL_CNT) + l * 32;
    int* cur = (int*)(WS_ + CTL_CUR) + l * 32;
    int* tiles = (int*)(WS_ + OFF_TILES);
    int* off = (int*)smem;
    int* hist = off + 64;
    int* base = hist + 32;
    __syncthreads();
    if (tid == 0) { int a = 0; for (int e = 0; e < 32; ++e) { off[e] = a; a += (cnt[e] + 127) & ~127; } off[32] = a; }
    if (tid < 32) hist[tid] = 0;
    __syncthreads();
    if (BIDX_ == 0) {
        if (tid == 0) {
            int nt = 0;
#pragma clang loop vectorize(disable) unroll(disable)
            for (int e = 0; e < 32; ++e) {
#pragma clang loop vectorize(disable) unroll(disable)
                for (int s = off[e]; s < off[e + 1]; s += 128) { tiles[64 + nt * 2] = e; tiles[64 + nt * 2 + 1] = s; ++nt; }
            }
            tiles[40] = nt;
        }
#pragma clang loop vectorize(disable) unroll(disable)
        for (int e = 0; e < 32; ++e) {
#pragma clang loop vectorize(disable) unroll(disable)
            for (int s = off[e] + cnt[e] + tid; s < off[e + 1]; s += 256) slottok[s] = (l == 0) ? 0 : CTXROWS;
        }
    }
    const int rstart = (l == 0) ? 0 : CTXROWS;
    for (int a0 = rstart * 2 + BIDX_ * 256; a0 < T * 2; a0 += gridDim.x * 256) {
        const int a = a0 + tid;
        int e = -1, lpos = 0;
        if (a < T * 2) { e = toke[a]; lpos = atomicAdd(&hist[e], 1); }
        __syncthreads();
        if (tid < 32) { base[tid] = hist[tid] > 0 ? atomicAdd(&cur[tid], hist[tid]) : 0; }
        __syncthreads();
        if (e >= 0) { const int s = off[e] + base[e] + lpos; toks[a] = s; slottok[s] = a >> 1; }
        __syncthreads();
        if (tid < 32) hist[tid] = 0;
        __syncthreads();
    }
}

DEVINL void ph_gateup(const P& p, char* smem) {
    const int TIDX_ = tid_(); const int BIDX_ = bid_(); char* const WS_ = wsl_(p.ws); (void)TIDX_; (void)BIDX_; (void)WS_;
    const int tid = TIDX_, lane = tid & 63, wid = tid >> 6, wr = wid >> 1, wc = wid & 1, fr = lane & 15, fq = lane >> 4;
    const u16* hm = (const u16*)(WS_ + OFF_HM);
    const u16* wgu = (const u16*)(WS_ + OFF_WGU);
    const int* tiles = (const int*)(WS_ + OFF_TILES);
    const int* slottok = (const int*)(WS_ + OFF_SLOTTOK);
    u16* act = (u16*)(WS_ + OFF_ACT);
    const int ntile = tiles[40] * 8;
    XCD_WALK(ntile, BIDX_, (int)gridDim.x);
    for (int u = xw_lo; u < xw_hi; u += xw_st) {
        const int ti = u >> 3, nt = u & 7;
        const int e = tiles[64 + ti * 2], s0 = tiles[64 + ti * 2 + 1];
        f32x4 acc[4][4];
        gemm128_acc([&](int r) { return hm + (size_t)slottok[s0 + r] * 1024; }, wgu + ((size_t)e * 1024 + nt * 128) * 1024, 1024, 1024, smem, acc);
        {
            u16* t = (u16*)smem;
            __syncthreads();
#pragma unroll
            for (int m = 0; m < 4; ++m)
#pragma unroll
                for (int n = 0; n < 4; n += 2) {
                    const int jc = (wc * 64 + n * 16) / 2 + fr;
                    const int r0 = wr * 64 + m * 16 + fq * 4;
                    float av[4];
#pragma unroll
                    for (int j = 0; j < 4; ++j) { const float gte = acc[m][n][j], up = acc[m][n + 1][j]; av[j] = gte / (1.f + __expf(-gte)) * up; }
                    const unsigned p01 = pk2bf(av[0], av[1]), p23 = pk2bf(av[2], av[3]);
                    t[(r0 + 0) * 72 + jc] = (u16)(p01 & 0xFFFFu); t[(r0 + 1) * 72 + jc] = (u16)(p01 >> 16);
                    t[(r0 + 2) * 72 + jc] = (u16)(p23 & 0xFFFFu); t[(r0 + 3) * 72 + jc] = (u16)(p23 >> 16);
                }
            __syncthreads();
#pragma unroll
            for (int i = 0; i < 4; ++i) {
                const int ci = tid + 256 * i, row = ci >> 3, c8 = (ci & 7) * 8;
                *(uint4*)(act + (size_t)(s0 + row) * 512 + nt * 64 + c8) = *(const uint4*)(t + row * 72 + c8);
            }
        }
    }
}

DEVINL void ph_down(const P& p, char* smem) {
    const int TIDX_ = tid_(); const int BIDX_ = bid_(); char* const WS_ = wsl_(p.ws); (void)TIDX_; (void)BIDX_; (void)WS_;
    const u16* act = (const u16*)(WS_ + OFF_ACT);
    const u16* wdn = (const u16*)(WS_ + OFF_WDN);
    const int* tiles = (const int*)(WS_ + OFF_TILES);
    u16* so = (u16*)(WS_ + OFF_SLOTOUT);
    const int ntile = tiles[40] * 8;
    XCD_WALK(ntile, BIDX_, (int)gridDim.x);
    for (int u = xw_lo; u < xw_hi; u += xw_st) {
        const int ti = u >> 3, nt = u & 7;
        const int e = tiles[64 + ti * 2], s0 = tiles[64 + ti * 2 + 1];
        const u16* A = act + (size_t)s0 * 512;
        f32x4 acc[4][4];
        gemm128_acc([&](int r) { return A + (size_t)r * 512; }, wdn + ((size_t)e * 1024 + nt * 128) * 512, 512, 512, smem, acc);
        stage_tile_bf16(acc, smem, [&](int row, int c8, uint4 v) { *(uint4*)(so + (size_t)(s0 + row) * 1024 + nt * 128 + c8) = v; });
    }
}

DEVINL void ph_ln2(const P& p, int l) {
    const int TIDX_ = tid_(); const int BIDX_ = bid_(); char* const WS_ = wsl_(p.ws); (void)TIDX_; (void)BIDX_; (void)WS_;
    const int lane = TIDX_ & 63, wid = TIDX_ >> 6;
    const float* modv = (const float*)(WS_ + OFF_MOD) + (size_t)l * 3 * 6144;
    const float* modn = (const float*)(WS_ + OFF_MOD) + (size_t)(l + 1) * 3 * 6144;
    const float* x1 = (const float*)(WS_ + OFF_X1);
    const u16* so = (const u16*)(WS_ + OFF_SLOTOUT);
    const int* toks = (const int*)(WS_ + OFF_TOKS);
    const float* tokw = (const float*)(WS_ + OFF_TOKW);
    float* x2c = (float*)(WS_ + OFF_X2CTX);
    u16* hm = (u16*)(WS_ + OFF_HM);
    const int rstart = (l == 0) ? 0 : CTXROWS;
    for (int row = rstart + BIDX_ * 4 + wid; row < T; row += gridDim.x * 4) {
        const int sa = toks[row * 2], sb = toks[row * 2 + 1];
        const float wa = tokw[row * 2], wb = tokw[row * 2 + 1];
        const float* mv = modv + row_sel(row) * 6144;
        float4 v[4];
        float s = 0.f;
#pragma unroll
        for (int i = 0; i < 4; ++i) {
            const int c = i * 256 + lane * 4;
            const float4 xv = *(const float4*)(x1 + (size_t)row * 1024 + c);
            const uint2 ua = *(const uint2*)(so + (size_t)sa * 1024 + c), ub = *(const uint2*)(so + (size_t)sb * 1024 + c);
            const float4 g2 = *(const float4*)(mv + 5120 + c);
            const float f0 = wa * bf2f((u16)(ua.x & 0xFFFF)) + wb * bf2f((u16)(ub.x & 0xFFFF));
            const float f1 = wa * bf2f((u16)(ua.x >> 16)) + wb * bf2f((u16)(ub.x >> 16));
            const float f2 = wa * bf2f((u16)(ua.y & 0xFFFF)) + wb * bf2f((u16)(ub.y & 0xFFFF));
            const float f3 = wa * bf2f((u16)(ua.y >> 16)) + wb * bf2f((u16)(ub.y >> 16));
            v[i].x = ALPHA * xv.x + g2.x * f0; v[i].y = ALPHA * xv.y + g2.y * f1; v[i].z = ALPHA * xv.z + g2.z * f2; v[i].w = ALPHA * xv.w + g2.w * f3;
            s += v[i].x + v[i].y + v[i].z + v[i].w;
        }
        const float mu = wsum(s) * (1.f / 1024.f);
        float q = 0.f;
#pragma unroll
        for (int i = 0; i < 4; ++i) { v[i].x -= mu; v[i].y -= mu; v[i].z -= mu; v[i].w -= mu; q += v[i].x * v[i].x + v[i].y * v[i].y + v[i].z * v[i].z + v[i].w * v[i].w; }
        const float rstd = rsqrtf(wsum(q) * (1.f / 1024.f) + 1e-5f);
        float* dst = row < CTXROWS ? x2c + (size_t)row * 1024 : p.out + (size_t)(row - CTXROWS) * 1024;
        const float* mn = modn + row_sel(row) * 6144;
#pragma unroll
        for (int i = 0; i < 4; ++i) {
            const int c = i * 256 + lane * 4;
            const float4 g = *(const float4*)(p.ln2g + l * 1024 + c), bb = *(const float4*)(p.ln2b + l * 1024 + c);
            float4 o;
            o.x = v[i].x * rstd * g.x + bb.x; o.y = v[i].y * rstd * g.y + bb.y; o.z = v[i].z * rstd * g.z + bb.z; o.w = v[i].w * rstd * g.w + bb.w;
            *(float4*)(dst + c) = o;
            if (l == 0) {
                const float4 sh = *(const float4*)(mn + c), sc = *(const float4*)(mn + 1024 + c);
                uint2 hh;
                hh.x = (unsigned)f2bf(o.x * (1.f + sc.x) + sh.x) | ((unsigned)f2bf(o.y * (1.f + sc.y) + sh.y) << 16);
                hh.y = (unsigned)f2bf(o.z * (1.f + sc.z) + sh.z) | ((unsigned)f2bf(o.w * (1.f + sc.w) + sh.w) << 16);
                *(uint2*)(hm + (size_t)row * 1024 + c) = hh;
            }
        }
    }
}

DEVINL void gbar(XcdBarrier b) {
    unsigned x = b.x; GAS unsigned* q = (GAS unsigned*)b.bar;
    asm volatile("" : "+s"(x), "+s"(q));
    b.x = x; b.bar = (unsigned*)q;
    xcd_barrier(b);
}
#ifndef PROBE
#define PROBE 0
#endif
#ifndef TPROBE
#define TPROBE 0
#endif
__global__ void __launch_bounds__(256, 2) k_mega(P p) {
    __shared__ __attribute__((aligned(16))) char smem[SMEM_BYTES];
    if (threadIdx.x == 0) *(uint4*)(smem + SMEM_BYTES - 16) = make_uint4(0u, 0u, 0u, 0u);
    __syncthreads();
    XcdBarrier bar = xcd_barrier_post((unsigned*)p.ws, (volatile LAS unsigned*)(smem + SMEM_BYTES - 16));
    const int bid = blockIdx.x, nb = gridDim.x;
#if TPROBE
    unsigned long long tp_acc = 0, tp_last = wall_clock64();
#define TP(g) do { const unsigned long long _n = wall_clock64(); if ((g) == TPROBE) tp_acc += _n - tp_last; tp_last = _n; } while (0)
#else
#define TP(g) do { } while (0)
#endif
    if (threadIdx.x == 0) {
        const unsigned key = ((unsigned)__builtin_amdgcn_s_getreg((3 << 11) | 20) << 8) | ((unsigned)__builtin_amdgcn_s_getreg((7 << 11) | (8 << 6) | 4) & 0xFFu);
        ((unsigned*)(p.ws + CTL_CUKEY))[blockIdx.x] = key | 0x80000000u;
    }
    ph_prolog(p, smem);
    ph_convw(p, 0, smem);
    gbar(bar);
    TP(1);
    ph_xm0(p);
    gbar(bar);
    TP(1);
    constexpr int NSCAN = 16;
    bool quiet; int wrank, nwork, mate_of = -1;
    {
        const unsigned* keys = (const unsigned*)(p.ws + CTL_CUKEY);
        int* cnt = (int*)smem;
        if (threadIdx.x < 2) cnt[threadIdx.x] = 0;
        __syncthreads();
        for (int i = NSCAN + threadIdx.x; i < nb; i += 256) {
            const unsigned k = keys[i];
            bool qq = false;
            for (int j = 0; j < NSCAN && j < nb; ++j) qq = qq || (keys[j] == k);
            if (qq) { atomicAdd(&cnt[1], 1); if (i < bid) atomicAdd(&cnt[0], 1); }
        }
        __syncthreads();
        const int below = cnt[0], total = cnt[1];
        bool me = false;
        if (bid >= NSCAN) { const unsigned k = keys[bid]; for (int j = NSCAN - 1; j >= 0; --j) if (j < nb && keys[j] == k) { me = true; mate_of = j; } }
        __syncthreads();
        if (total > 2 * NSCAN) { quiet = false; wrank = bid - NSCAN; nwork = nb - NSCAN; mate_of = -1; }
        else { quiet = me; wrank = bid - NSCAN - below; nwork = nb - NSCAN - total; }
    }
#pragma unroll 1
    for (int l = 0; l < NLAYER; ++l) {
        ph_inproj(p, smem);
        gbar(bar);
    TP(2);
        ph_rwprep(p, l, 0, smem, bid, nb);
        ph_prepM(p, l, smem, bid, nb);
        gbar(bar);
    TP(3);
        if (bid < NSCAN) ph_rwscan(p, l, 0, bid, NSCAN, smem);
        else if (!quiet) { if (nwork > 128) { if (wrank < 64) ph_mlB(p, wrank, 64, smem); else ph_na(p, l, smem, wrank - 64, nwork - 64); } else { ph_mlB(p, wrank, nwork, smem); ph_na(p, l, smem, wrank, nwork); } }
        gbar(bar);
    TP(4);
        ph_rwprep(p, l, 1, smem, bid, nb);
        gbar(bar);
    TP(5);
        if (bid < NSCAN) ph_rwscan(p, l, 1, bid, NSCAN, smem);
        else if (!quiet) { ph_mlC(p, l, smem, wrank, nwork); ph_convexp(p, l, smem, wrank, nwork); }
        gbar(bar);
    TP(6);
        ph_rwout(p, l);
        gbar(bar);
    TP(7);
        ph_outproj(p, l, smem);
        gbar(bar);
    TP(8);
        ph_ln1(p, l);
        gbar(bar);
    TP(9);
        ph_router(p, l, smem);
        gbar(bar);
    TP(9);
        ph_route1(p, l, smem);
        gbar(bar);
    TP(9);
        ph_route2(p, l, smem);
        gbar(bar);
    TP(9);
        ph_gateup(p, smem);
        gbar(bar);
    TP(10);
        ph_down(p, smem);
        gbar(bar);
    TP(11);
        ph_ln2(p, l);
        if (l + 1 < NLAYER) ph_convw(p, l + 1, smem);
        gbar(bar);
    TP(12);
    }
#if TPROBE
    if (bid == 0 && threadIdx.x == 0) { const unsigned long long t_end = wall_clock64() + tp_acc; while (wall_clock64() < t_end) __builtin_amdgcn_s_sleep(8); }
    __syncthreads();
    gbar(bar);
#endif
}


extern "C" void kernel_launch(void* const* d_in, const int* in_sizes, int n_in, void* d_out, int out_size, void* d_ws, size_t ws_size,
                              hipStream_t stream) {
    if (n_in != 37 || ws_size < WS_NEED) { fprintf(stderr, "kernel_launch: n_in %d ws %zu need %zu\n", n_in, ws_size, (size_t)WS_NEED); return; }
    static int grid = 0;
    if (!grid) {
        int dev = 0, cus = 0, per_cu = 0;
        (void)hipGetDevice(&dev);
        (void)hipDeviceGetAttribute(&cus, hipDeviceAttributeMultiprocessorCount, dev);
        (void)hipOccupancyMaxActiveBlocksPerMultiprocessor(&per_cu, (const void*)k_mega, 256, 0);
        if (per_cu < 1) per_cu = 1;
        grid = cus * (per_cu < 2 ? per_cu : 2);
    }
    P p{};
    const float** pp = (const float**)&p;
    for (int i = 0; i < 37; ++i) pp[i] = (const float*)d_in[i];
    p.out = (float*)d_out; p.ws = (char*)d_ws;
    (void)hipMemsetAsync(d_ws, 0, CTL_BYTES, stream);
    k_mega<<<dim3(grid), dim3(256), 0, stream>>>(p);
}
```

```cpp
#include <hip/hip_runtime.h>
#include <hip/hip_bf16.h>
#include <stdint.h>
#include <stdio.h>
#include <type_traits>

#define DEVINL __device__ __forceinline__
typedef unsigned short u16;
using bf16x8 = __attribute__((ext_vector_type(8))) short;
using f32x4 = __attribute__((ext_vector_type(4))) float;

constexpr int D = 1024, LAT = 16384, LCTX = 256, T = 33280, CTXROWS = 512;
constexpr int INP = 3536;
constexpr int NLAYER = 2;
constexpr float ALPHA = 1.41421356237309515f;
constexpr int NUNIT_CH = 520;
constexpr int NTC = 260;
constexpr int MAXSLOT = 70656;
constexpr int SMEM_BYTES = 81920;

constexpr size_t al(size_t x) { return (x + 255) & ~(size_t)255; }
constexpr size_t CTL_CNT = 16384;
constexpr size_t CTL_CUR = CTL_CNT + 256;
constexpr size_t CTL_CUKEY = 20480;
constexpr size_t CTL_PROG = 24576;
constexpr size_t CTL_BYTES = 32768;
constexpr size_t OFF_MOD = CTL_BYTES;
constexpr size_t OFF_ROPE = OFF_MOD + al(2 * 3 * 6144 * 4);
constexpr size_t OFF_WR = OFF_ROPE + al(10240 * 4);
constexpr size_t OFF_LORA = OFF_WR + al(2 * 128 * 1024 * 2);
constexpr size_t OFF_TILES = OFF_LORA + al(3 * 65536);
constexpr size_t OFF_TOKE = OFF_TILES + al((64 + 2048) * 4);
constexpr size_t OFF_TOKW = OFF_TOKE + al((size_t)T * 2 * 4);
constexpr size_t OFF_TOKS = OFF_TOKW + al((size_t)T * 2 * 4);
constexpr size_t OFF_SLOTTOK = OFF_TOKS + al((size_t)T * 2 * 4);
constexpr size_t OFF_X2CTX = OFF_SLOTTOK + al((size_t)MAXSLOT * 4);
constexpr size_t OFF_ZST = OFF_X2CTX + al((size_t)512 * 1024 * 4);
constexpr size_t OFF_WIN = OFF_ZST + al((size_t)16 * 4 * 64 * 16 * 4);
constexpr size_t OFF_WOUT = OFF_WIN + al((size_t)3584 * 1024 * 2);
constexpr size_t OFF_X1 = OFF_WOUT + al((size_t)1024 * 1024 * 2);
constexpr size_t OFF_HM = OFF_X1 + al((size_t)T * 1024 * 4);
constexpr size_t OFF_P = OFF_HM + al((size_t)T * 1024 * 2);
constexpr size_t OFF_PQK = OFF_P;
constexpr size_t OFF_VTL = OFF_PQK + (size_t)T * 1024 * 2;
constexpr size_t OFF_VTC = OFF_VTL + (size_t)2 * 8 * 64 * 16384 * 2;
constexpr size_t OFF_PB = OFF_VTC + (size_t)2 * 8 * 64 * 256 * 2;
constexpr size_t OFF_PC = OFF_PB + (size_t)T * 960 * 2;
constexpr size_t OFF_Y = OFF_PC + (size_t)T * 1040 * 2;
constexpr size_t OFF_MLF = OFF_Y + (size_t)T * 1024 * 2;
constexpr size_t OFF_GATE = OFF_MLF + (size_t)T * 512 * 2;
constexpr size_t OFF_MLG = OFF_GATE + (size_t)T * 256 * 2;
constexpr size_t OFF_MLS = OFF_MLG + (size_t)T * 16 * 4;
constexpr size_t OFF_MST = OFF_MLS + al(16 * 260 * 2 * 4);
constexpr size_t OFF_NST = OFF_MST + al(16 * 260 * 4);
constexpr size_t OFF_CST2 = OFF_NST + al(16 * 260 * 64 * 4);
constexpr size_t OFF_NST2 = OFF_CST2 + (size_t)16 * 260 * 4096 * 2;
constexpr size_t OFF_END1 = OFF_NST2 + al(16 * 260 * 64 * 4);
constexpr size_t OFF_WGU = OFF_P;
constexpr size_t OFF_WDN = OFF_WGU + (size_t)32 * 1024 * 1024 * 2;
constexpr size_t OFF_ACT = OFF_WDN + (size_t)32 * 1024 * 512 * 2;
constexpr size_t OFF_SLOTOUT = OFF_ACT + (size_t)MAXSLOT * 512 * 2;
constexpr size_t OFF_LOGITS = OFF_SLOTOUT + (size_t)MAXSLOT * 1024 * 2;
constexpr size_t OFF_END2 = OFF_LOGITS + (size_t)T * 64 * 4;
constexpr size_t WS_NEED = OFF_END1 > OFF_END2 ? OFF_END1 : OFF_END2;
static_assert(OFF_WDN <= OFF_Y, "Wexp must not overlap y");
static_assert(OFF_LOGITS >= OFF_MLF, "logits placement");

struct P {
    const float *x, *c, *ctx, *c_ctx, *w_mod, *b_mod, *w_in, *na_rpb, *mu_prev, *mu_next, *rw_w0, *rw_w2, *rw_a0, *rw_a2,
        *rw_g2, *rw_kk, *rw_ka, *rw_rk, *rw_lnw, *rw_lnb, *ml_cw, *ml_cb, *ml_ib, *ml_fb, *ml_nw, *w_out, *ln1g, *ln1b,
        *rgw, *rgb, *rew, *reb, *egate, *eup, *edown, *ln2g, *ln2b;
    float* out;
    char* ws;
};

#define XB_TMO      128
#define XB_XCNT(j)  (256  + 64 * (j))
#define XB_XSUB(j)  (1280 + 64 * (j))
#define XB_XGEN(j)  (2304 + 64 * (j))
#define XB_TOP      3328
#define XB_TOPGEN   3392
#define XCD_BAR_WORDS 3456
#define XB_SPIN_CAP (1u << 18)
#define LAS __attribute__((address_space(3)))

__device__ __forceinline__ unsigned xb_ld(unsigned* p)              { return __hip_atomic_load(p, __ATOMIC_RELAXED, __HIP_MEMORY_SCOPE_AGENT); }
__device__ __forceinline__ unsigned xb_add(unsigned* p, unsigned v) { return __hip_atomic_fetch_add(p, v, __ATOMIC_RELAXED, __HIP_MEMORY_SCOPE_AGENT); }
__device__ __forceinline__ unsigned xb_xcc_id() { return (unsigned)__builtin_amdgcn_s_getreg((3 << 11) | 20) & 0xFu; }
#define XB_SPIN(cond, bar) do { unsigned _sp = 0; while (cond) { __builtin_amdgcn_s_sleep(1); \
    if ((++_sp & 255u) == 0u) { if (xb_ld(&(bar)[XB_TMO])) break; if (_sp > XB_SPIN_CAP) { atomicAdd(&(bar)[XB_TMO], 1u); break; } } } } while (0)

struct XcdBarrier {
    unsigned* bar; unsigned x;
    volatile LAS unsigned* st;
};

__device__ __forceinline__ XcdBarrier xcd_barrier_post(unsigned* bar, volatile LAS unsigned* st) {
    XcdBarrier b; b.bar = bar; b.x = xb_xcc_id(); b.st = st;
    if (threadIdx.x == 0) (void)xb_add(&bar[XB_XCNT(b.x)], 1u);
    return b;
}
__device__ __forceinline__ void xcd_barrier_complete(unsigned* bar, unsigned x, unsigned& nloc, unsigned& nx) {
    const unsigned G = gridDim.x * gridDim.y * gridDim.z;
    unsigned sum, cnt, mine, sp = 0u;
    for (;;) {
        sum = 0u; cnt = 0u; mine = 0u;
#pragma unroll
        for (unsigned j = 0; j < 16; ++j) { const unsigned c = xb_ld(&bar[XB_XCNT(j)]); sum += c; cnt += (c > 0u) ? 1u : 0u; mine = (j == x) ? c : mine; }
        if (sum == G) break;
        __builtin_amdgcn_s_sleep(1);
        if ((++sp & 255u) == 0u) { if (xb_ld(&bar[XB_TMO])) break; if (sp > XB_SPIN_CAP) { atomicAdd(&bar[XB_TMO], 1u); break; } }
    }
    nloc = mine > 0u ? mine : 1u; nx = cnt > 0u ? cnt : 1u;
}

__device__ __forceinline__ void xcd_barrier(const XcdBarrier& b) {
    asm volatile("s_waitcnt vmcnt(0)" ::: "memory");
    __syncthreads();
    if (threadIdx.x == 0) {
        unsigned* bar = b.bar;
        __builtin_amdgcn_s_waitcnt(0);
        unsigned nloc = b.st[0], nx = b.st[1];
        if (nloc == 0u) { xcd_barrier_complete(bar, b.x, nloc, nx); b.st[0] = nloc; b.st[1] = nx; }
        const unsigned old = xb_add(&bar[XB_XSUB(b.x)], 1u);
        const unsigned gen = old / nloc;
        if (old + 1u == (gen + 1u) * nloc) {
            __builtin_amdgcn_fence(__ATOMIC_RELEASE, "agent");
            asm volatile("s_waitcnt vmcnt(0)" ::: "memory");
            const unsigned og = xb_add(&bar[XB_TOP], 1u);
            const unsigned tg = og / nx;
            if (og + 1u == (tg + 1u) * nx) xb_add(&bar[XB_TOPGEN], 1u);
            else XB_SPIN(xb_ld(&bar[XB_TOPGEN]) == tg, bar);
            __builtin_amdgcn_fence(__ATOMIC_ACQUIRE, "agent");
            xb_add(&bar[XB_XGEN(b.x)], 1u);
            asm volatile("s_waitcnt vmcnt(0)" ::: "memory");
        } else {
            XB_SPIN(xb_ld(&bar[XB_XGEN(b.x)]) == gen, bar);
            __builtin_amdgcn_fence(__ATOMIC_ACQUIRE, "agent");
            asm volatile("s_waitcnt vmcnt(0)" ::: "memory");
        }
    }
    __syncthreads();
}


DEVINL int tid_() { int t = threadIdx.x; asm volatile("" : "+v"(t)); return t; }
DEVINL int bid_() { int b = blockIdx.x; asm volatile("" : "+s"(b)); return b; }
#define GAS __attribute__((address_space(1)))
DEVINL char* wsl_(char* w) { GAS char* g = (GAS char*)w; asm volatile("" : "+s"(g)); return (char*)g; }
template <class Tp> DEVINL const Tp* gl_(const Tp* q) { const GAS Tp* g = (const GAS Tp*)q; asm volatile("" : "+s"(g)); return (const Tp*)g; }
typedef float f32x2_t __attribute__((ext_vector_type(2)));
typedef __bf16 bf16x2_t __attribute__((ext_vector_type(2)));
DEVINL unsigned pk2bf(float lo, float hi) { f32x2_t f = {lo, hi}; bf16x2_t b = __builtin_convertvector(f, bf16x2_t); return __builtin_bit_cast(unsigned, b); }
DEVINL u16 f2bf(float f) { return (u16)(pk2bf(f, f) & 0xFFFFu); }
DEVINL float bf2f(u16 h) { return __uint_as_float(((unsigned)h) << 16); }
DEVINL float wsum(float v) { for (int o = 32; o > 0; o >>= 1) v += __shfl_xor(v, o); return v; }
DEVINL float sigmoidf_(float x) { return 1.f / (1.f + __expf(-x)); }
DEVINL float siluf_(float x) { return x / (1.f + __expf(-x)); }
DEVINL float softplusf_(float x) { return fmaxf(x, 0.f) + log1pf(__expf(-fabsf(x))); }
DEVINL int row_sel(int row) { return row < CTXROWS ? 2 : ((row - CTXROWS) >> 14); }
template <int CTRL, int RM>
DEVINL float dpp_f(float v) { return __int_as_float(__builtin_amdgcn_update_dpp(0, __float_as_int(v), CTRL, RM, 0xF, false)); }
DEVINL float wave_sum_dpp(float v) {
    v += dpp_f<0xB1, 0xF>(v);
    v += dpp_f<0x4E, 0xF>(v);
    v += dpp_f<0x141, 0xF>(v);
    v += dpp_f<0x140, 0xF>(v);
    v += dpp_f<0x142, 0xA>(v);
    v += dpp_f<0x143, 0xC>(v);
    return __int_as_float(__builtin_amdgcn_readlane(__float_as_int(v), 63));
}
DEVINL unsigned lds_addr(const void* p) { return (unsigned)(size_t)(const __attribute__((address_space(3))) char*)p; }
using u32x4 = __attribute__((ext_vector_type(4))) unsigned;
using u32x2 = __attribute__((ext_vector_type(2))) unsigned;
template <int OFF> DEVINL u32x4 lds_rd128(unsigned a) { u32x4 v; asm volatile("ds_read_b128 %0, %1 offset:%2" : "=v"(v) : "v"(a), "n"(OFF)); return v; }
template <int OFF> DEVINL u32x2 lds_rd64(unsigned a) { u32x2 v; asm volatile("ds_read_b64 %0, %1 offset:%2" : "=v"(v) : "v"(a), "n"(OFF)); return v; }
DEVINL void glds4(const void* g, void* l) {
    __builtin_amdgcn_global_load_lds((const __attribute__((address_space(1))) void*)g, (__attribute__((address_space(3))) void*)l, 4, 0, 0);
}
DEVINL void glds16nt(const void* g, void* l) {
    __builtin_amdgcn_global_load_lds((const __attribute__((address_space(1))) void*)g, (__attribute__((address_space(3))) void*)l, 16, 0, 2);
}
DEVINL void glds16(const void* g, void* l) {
    __builtin_amdgcn_global_load_lds((const __attribute__((address_space(1))) void*)g, (__attribute__((address_space(3))) void*)l, 16, 0, 0);
}

#define XCD_WALK(total_, bid_v, nb_v) \
    const bool xw_8 = (((nb_v) & 7) == 0); \
    const int xw_per = xw_8 ? (((((total_) + 7) >> 3) + 7) & ~7) : (total_); \
    const int xw_base = xw_8 ? ((bid_v) & 7) * xw_per : 0; \
    const int xw_lo = xw_base + (xw_8 ? ((bid_v) >> 3) : (bid_v)); \
    const int xw_hi = min((int)(total_), xw_base + xw_per); \
    const int xw_st = xw_8 ? ((nb_v) >> 3) : (nb_v)

template <class RowA>
DEVINL void gemm128_acc(RowA rowA, const u16* __restrict__ Bt, int ldb, int K, char* smem, f32x4 (&acc)[4][4]) {
    const int tid = tid_(), lane = tid & 63, wid = tid >> 6, wr = wid >> 1, wc = wid & 1, fr = lane & 15, fq = lane >> 4;
#pragma unroll
    for (int m = 0; m < 4; ++m)
#pragma unroll
        for (int n = 0; n < 4; ++n) acc[m][n] = f32x4{0.f, 0.f, 0.f, 0.f};
    const int sc = ((tid & 7) ^ ((tid >> 3) & 7)) * 8;
    const u16* aS[4]; const u16* bS[4];
#pragma unroll
    for (int i = 0; i < 4; ++i) { const int r = (tid >> 3) + 32 * i; aS[i] = rowA(r) + sc; bS[i] = Bt + (size_t)r * ldb + sc; }
    const int nt = K >> 6;
    __syncthreads();
#pragma unroll
    for (int i = 0; i < 4; ++i) { glds16(aS[i], smem + (tid + 256 * i) * 16); glds16(bS[i], smem + 16384 + (tid + 256 * i) * 16); }
    for (int t = 0; t < nt; ++t) {
        asm volatile("s_waitcnt vmcnt(0)" ::: "memory");
        __builtin_amdgcn_s_barrier();
        if (t + 1 < nt) {
            char* SA = smem + ((t + 1) & 1) * 32768;
            const int ko = (t + 1) * 64;
#pragma unroll
            for (int i = 0; i < 4; ++i) { glds16(aS[i] + ko, SA + (tid + 256 * i) * 16); glds16(bS[i] + ko, SA + 16384 + (tid + 256 * i) * 16); }
        }
        const char* SA = smem + (t & 1) * 32768; const char* SB = SA + 16384;
#pragma unroll
        for (int ks = 0; ks < 2; ++ks) {
            const int pos = ((ks * 4 + fq) ^ (fr & 7)) * 16;
            bf16x8 af[4], bfr[4];
#pragma unroll
            for (int m = 0; m < 4; ++m) af[m] = *(const bf16x8*)(SA + (wr * 64 + m * 16 + fr) * 128 + pos);
#pragma unroll
            for (int n = 0; n < 4; ++n) bfr[n] = *(const bf16x8*)(SB + (wc * 64 + n * 16 + fr) * 128 + pos);
#pragma unroll
            for (int m = 0; m < 4; ++m)
#pragma unroll
                for (int n = 0; n < 4; ++n) acc[m][n] = __builtin_amdgcn_mfma_f32_16x16x32_bf16(af[m], bfr[n], acc[m][n], 0, 0, 0);
        }
    }
}
template <class RowA, class Epi>
DEVINL void gemm128(RowA rowA, const u16* __restrict__ Bt, int ldb, int K, char* smem, Epi epi) {
    const int tid = tid_(), lane = tid & 63, wid = tid >> 6, wr = wid >> 1, wc = wid & 1, fr = lane & 15, fq = lane >> 4;
    f32x4 acc[4][4];
    gemm128_acc(rowA, Bt, ldb, K, smem, acc);
#pragma unroll
    for (int m = 0; m < 4; ++m)
#pragma unroll
        for (int n = 0; n < 4; ++n) epi(wr * 64 + m * 16 + fq * 4, wc * 64 + n * 16 + fr, acc[m][n]);
}

template <class Emit>
DEVINL void stage_tile_bf16(const f32x4 (&acc)[4][4], char* smem, Emit emit) {
    const int tid = tid_(), lane = tid & 63, wid = tid >> 6, wr = wid >> 1, wc = wid & 1, fr = lane & 15, fq = lane >> 4;
    u16* t = (u16*)smem;
    __syncthreads();
#pragma unroll
    for (int m = 0; m < 4; ++m)
#pragma unroll
        for (int n = 0; n < 4; ++n) {
            const int r0 = wr * 64 + m * 16 + fq * 4, c = wc * 64 + n * 16 + fr;
            const unsigned p01 = pk2bf(acc[m][n][0], acc[m][n][1]), p23 = pk2bf(acc[m][n][2], acc[m][n][3]);
            t[(r0 + 0) * 136 + c] = (u16)(p01 & 0xFFFFu); t[(r0 + 1) * 136 + c] = (u16)(p01 >> 16);
            t[(r0 + 2) * 136 + c] = (u16)(p23 & 0xFFFFu); t[(r0 + 3) * 136 + c] = (u16)(p23 >> 16);
        }
    __syncthreads();
#pragma unroll
    for (int i = 0; i < 8; ++i) {
        const int ci = tid + 256 * i, row = ci >> 4, c8 = (ci & 15) * 8;
        emit(row, c8, *(const uint4*)(t + row * 136 + c8));
    }
}

template <class Emit>
DEVINL void stage_tile_f32(const f32x4 (&acc)[4][4], char* smem, Emit emit) {
    const int tid = tid_(), lane = tid & 63, wid = tid >> 6, wr = wid >> 1, wc = wid & 1, fr = lane & 15, fq = lane >> 4;
    float* t = (float*)smem;
    __syncthreads();
#pragma unroll
    for (int m = 0; m < 4; ++m)
#pragma unroll
        for (int n = 0; n < 4; ++n) {
            const int r0 = wr * 64 + m * 16 + fq * 4, c = wc * 64 + n * 16 + fr;
#pragma unroll
            for (int j = 0; j < 4; ++j) t[(r0 + j) * 132 + c] = acc[m][n][j];
        }
    __syncthreads();
#pragma unroll 4
    for (int i = 0; i < 16; ++i) {
        const int ci = tid + 256 * i, row = ci >> 5, c4 = (ci & 31) * 4;
        emit(row, c4, *(const float4*)(t + row * 132 + c4));
    }
}

DEVINL void ph_prolog(const P& p, char* smem) {
    const int TIDX_ = tid_(); const int BIDX_ = bid_(); char* const WS_ = wsl_(p.ws); (void)TIDX_; (void)BIDX_; (void)WS_;
    const int tid = TIDX_;
    float* modv = (float*)(WS_ + OFF_MOD);
    float* sil = (float*)smem;
    float* red = sil + 3072;
    bool ready = false;
    for (int u = BIDX_; u < 192; u += gridDim.x) {
        if (!ready) {
            for (int i = tid; i < 3072; i += 256) { int v = i >> 10, k = i & 1023; float cv = v < 2 ? p.c[v * 1024 + k] : p.c_ctx[k]; sil[i] = cv / (1.f + expf(-cv)); }
            ready = true;
        }
        __syncthreads();
        const int l = u / 96, cg = u % 96;
        const float* W = p.w_mod + (size_t)l * 1024 * 6144 + cg * 64;
        const int c4 = (tid & 15) * 4, rg = tid >> 4;
        float a0[4] = {0, 0, 0, 0}, a1[4] = {0, 0, 0, 0}, a2[4] = {0, 0, 0, 0};
#pragma unroll 4
        for (int i = 0; i < 64; ++i) {
            const int k = rg + 16 * i;
            const float4 w = *(const float4*)(W + (size_t)k * 6144 + c4);
            const float s0 = sil[k], s1 = sil[1024 + k], s2 = sil[2048 + k];
            a0[0] += s0 * w.x; a0[1] += s0 * w.y; a0[2] += s0 * w.z; a0[3] += s0 * w.w;
            a1[0] += s1 * w.x; a1[1] += s1 * w.y; a1[2] += s1 * w.z; a1[3] += s1 * w.w;
            a2[0] += s2 * w.x; a2[1] += s2 * w.y; a2[2] += s2 * w.z; a2[3] += s2 * w.w;
        }
#pragma unroll
        for (int j = 0; j < 4; ++j) { red[(rg * 3 + 0) * 64 + c4 + j] = a0[j]; red[(rg * 3 + 1) * 64 + c4 + j] = a1[j]; red[(rg * 3 + 2) * 64 + c4 + j] = a2[j]; }
        __syncthreads();
        if (tid < 192) {
            const int v = tid >> 6, cc = tid & 63;
            float s = 0.f;
            for (int r = 0; r < 16; ++r) s += red[(r * 3 + v) * 64 + cc];
            const int col = cg * 64 + cc;
            modv[(l * 3 + v) * 6144 + col] = s + p.b_mod[l * 6144 + col];
        }
        __syncthreads();
    }
    float* rope = (float*)(WS_ + OFF_ROPE);
    for (int i = BIDX_ * 256 + tid; i < 320 * 16; i += gridDim.x * 256) {
        const int pos = (i < 4096) ? (i >> 4) : ((i - 4096) >> 4);
        const int f = i & 15;
        const float inv = powf(10000.0f, -(float)f / 16.0f);
        const float ang = (float)pos * inv;
        const double TWO_PI = 6.283185307179586476925;
        double a = (double)ang;
        a -= TWO_PI * rint(a / TWO_PI);
        const float cr = (float)cos(a), sr = (float)sin(a);
        if (i < 4096) { rope[i] = cr; rope[4096 + i] = sr; }
        else { rope[8192 + (i - 4096)] = cr; rope[8192 + 1024 + (i - 4096)] = sr; }
    }
    {
        u16* w2t = (u16*)(WS_ + OFF_LORA); u16* a2t = w2t + 2 * 2 * 256 * 32; u16* g2t = a2t + 2 * 2 * 256 * 32;
        for (int i = BIDX_ * 256 + tid; i < 2 * 2 * 256 * 32; i += gridDim.x * 256) {
            const int lz = i >> 13, c = (i >> 5) & 255, r = i & 31;
            w2t[i] = f2bf(p.rw_w2[((size_t)lz * 32 + r) * 256 + c]);
            a2t[i] = f2bf(p.rw_a2[((size_t)lz * 32 + r) * 256 + c]);
        }
        for (int i = BIDX_ * 256 + tid; i < 2 * 256 * 64; i += gridDim.x * 256) {
            const int l = i >> 14, c = (i >> 6) & 255, r = i & 63;
            g2t[i] = f2bf(p.rw_g2[((size_t)l * 64 + r) * 256 + c]);
        }
    }
    u16* wr = (u16*)(WS_ + OFF_WR);
    for (int i = BIDX_ * 256 + tid; i < 2 * 128 * 1024; i += gridDim.x * 256) {
        const int l = i >> 17, n = (i >> 10) & 127, k = i & 1023;
        float v = 0.f;
        if (n < 4) v = p.rgw[((size_t)l * 1024 + k) * 4 + n];
        else if (n < 36) v = p.rew[((size_t)l * 1024 + k) * 32 + (n - 4)];
        wr[i] = f2bf(v);
    }
}

DEVINL void conv_tile(const float* __restrict__ src, int N, int K, u16* __restrict__ dst, int k0, int n0, int mode, char* smem) {
    unsigned* t = (unsigned*)smem;
    const int tid = tid_();
    const int n4 = (tid & 15) * 4;
    const bool ok = n0 + n4 < N;
    float4 va[2], vb[2];
    __syncthreads();
#pragma unroll
    for (int i = 0; i < 2; ++i) {
        const int kp = i * 16 + (tid >> 4);
        const float* s0 = src + (size_t)(k0 + 2 * kp) * N + n0 + n4;
        va[i] = ok ? *(const float4*)s0 : make_float4(0.f, 0.f, 0.f, 0.f);
        vb[i] = ok ? *(const float4*)(s0 + N) : make_float4(0.f, 0.f, 0.f, 0.f);
    }
#pragma unroll
    for (int i = 0; i < 2; ++i) {
        const int kp = i * 16 + (tid >> 4);
        t[(n4 + 0) * 33 + kp] = pk2bf(va[i].x, vb[i].x);
        t[(n4 + 1) * 33 + kp] = pk2bf(va[i].y, vb[i].y);
        t[(n4 + 2) * 33 + kp] = pk2bf(va[i].z, vb[i].z);
        t[(n4 + 3) * 33 + kp] = pk2bf(va[i].w, vb[i].w);
    }
    __syncthreads();
    {
        const int n = tid >> 2, w0 = (tid & 3) * 8;
        const int ng = n0 + n;
        int nd = ng;
        if (mode == 1) nd = 32 * (ng >> 4) + (ng & 15);
        else if (mode == 2) nd = 32 * (ng >> 4) + 16 + (ng & 15);
        uint4 o0, o1;
        o0.x = t[n * 33 + w0 + 0]; o0.y = t[n * 33 + w0 + 1]; o0.z = t[n * 33 + w0 + 2]; o0.w = t[n * 33 + w0 + 3];
        o1.x = t[n * 33 + w0 + 4]; o1.y = t[n * 33 + w0 + 5]; o1.z = t[n * 33 + w0 + 6]; o1.w = t[n * 33 + w0 + 7];
        u16* q = dst + (size_t)nd * K + k0 + w0 * 2;
        *(uint4*)q = o0; *(uint4*)(q + 8) = o1;
    }
}
DEVINL void ph_convw(const P& p, int l, char* smem) {
    const int TIDX_ = tid_(); const int BIDX_ = bid_(); char* const WS_ = wsl_(p.ws); (void)TIDX_; (void)BIDX_; (void)WS_;
    u16* win = (u16*)(WS_ + OFF_WIN); u16* wout = (u16*)(WS_ + OFF_WOUT);
    for (int u = BIDX_; u < 896 + 256; u += gridDim.x) {
        if (u < 896) conv_tile(p.w_in + (size_t)l * 1024 * INP, INP, 1024, win, (u / 56) * 64, (u % 56) * 64, 0, smem);
        else { const int v = u - 896; conv_tile(p.w_out + (size_t)l * 1024 * 1024, 1024, 1024, wout, (v / 16) * 64, (v % 16) * 64, 0, smem); }
    }
}
DEVINL void ph_convexp(const P& p, int l, char* smem, int bid, int nb) {
    const int TIDX_ = tid_(); const int BIDX_ = bid_(); char* const WS_ = wsl_(p.ws); (void)TIDX_; (void)BIDX_; (void)WS_;
    u16* wgu = (u16*)(WS_ + OFF_WGU); u16* wdn = (u16*)(WS_ + OFF_WDN);
    for (int u = bid; u < 32 * 384; u += nb) {
        const int e = u / 384, v = u % 384;
        const size_t le = (size_t)l * 32 + e;
        if (v < 128) conv_tile(p.egate + le * 1024 * 512, 512, 1024, wgu + (size_t)e * 1024 * 1024, (v / 8) * 64, (v % 8) * 64, 1, smem);
        else if (v < 256) { const int w = v - 128; conv_tile(p.eup + le * 1024 * 512, 512, 1024, wgu + (size_t)e * 1024 * 1024, (w / 8) * 64, (w % 8) * 64, 2, smem); }
        else { const int w = v - 256; conv_tile(p.edown + le * 512 * 1024, 1024, 512, wdn + (size_t)e * 1024 * 512, (w / 16) * 64, (w % 16) * 64, 0, smem); }
    }
}

DEVINL void ph_xm0(const P& p) {
    const int TIDX_ = tid_(); const int BIDX_ = bid_(); char* const WS_ = wsl_(p.ws); (void)TIDX_; (void)BIDX_; (void)WS_;
    const float* modv = (const float*)(WS_ + OFF_MOD);
    u16* hm = (u16*)(WS_ + OFF_HM);
    for (size_t i = (size_t)BIDX_ * 256 + TIDX_; i < (size_t)T * 256; i += (size_t)gridDim.x * 256) {
        const int row = (int)(i >> 8), c4 = (int)(i & 255) * 4;
        const float* src = row < CTXROWS ? p.ctx + (size_t)row * 1024 : p.x + (size_t)(row - CTXROWS) * 1024;
        const float* mv = modv + row_sel(row) * 6144;
        const float4 v = *(const float4*)(src + c4);
        const float4 sh = *(const float4*)(mv + c4), sc = *(const float4*)(mv + 1024 + c4);
        uint2 o;
        o.x = (unsigned)f2bf(v.x * (1.f + sc.x) + sh.x) | ((unsigned)f2bf(v.y * (1.f + sc.y) + sh.y) << 16);
        o.y = (unsigned)f2bf(v.z * (1.f + sc.z) + sh.z) | ((unsigned)f2bf(v.w * (1.f + sc.w) + sh.w) << 16);
        *(uint2*)(hm + (size_t)row * 1024 + c4) = o;
    }
}

DEVINL void ph_inproj(const P& p, char* smem) {
    const int TIDX_ = tid_(); const int BIDX_ = bid_(); char* const WS_ = wsl_(p.ws); (void)TIDX_; (void)BIDX_; (void)WS_;
    const u16* hm = (const u16*)(WS_ + OFF_HM);
    const u16* win = (const u16*)(WS_ + OFF_WIN);
    u16* pqk = (u16*)(WS_ + OFF_PQK); u16* vtl = (u16*)(WS_ + OFF_VTL); u16* vtc = (u16*)(WS_ + OFF_VTC);
    u16* pb = (u16*)(WS_ + OFF_PB); u16* pc = (u16*)(WS_ + OFF_PC);
    XCD_WALK(260 * 28, BIDX_, (int)gridDim.x);
    for (int o = xw_lo; o < xw_hi; o += xw_st) {
        const int g = o / 224, w = o % 224;
        const int mt = g < 32 ? g * 8 + (w & 7) : 256 + (w & 3), nt = g < 32 ? (w >> 3) : (w >> 2);
        const u16* A = hm + (size_t)mt * 128 * 1024;
        f32x4 acc[4][4];
        gemm128_acc([&](int r) { return A + (size_t)r * 1024; }, win + (size_t)nt * 128 * 1024, 1024, 1024, smem, acc);
        if (nt >= 8 && nt < 12) {
            const int tid = tid_(), lane = tid & 63, wid = tid >> 6, wr = wid >> 1, wc = wid & 1, fr = lane & 15, fq = lane >> 4;
#pragma unroll
            for (int m = 0; m < 4; ++m)
#pragma unroll
                for (int n = 0; n < 4; ++n) {
                    const int R = mt * 128 + wr * 64 + m * 16 + fq * 4, N = nt * 128 + wc * 64 + n * 16 + fr;
                    const int hh = (N - 1024) >> 6, d = (N - 1024) & 63;
                    uint2 v; v.x = pk2bf(acc[m][n][0], acc[m][n][1]); v.y = pk2bf(acc[m][n][2], acc[m][n][3]);
                    if (R < CTXROWS) { const int b = R >> 8, t = R & 255; *(uint2*)(vtc + ((size_t)((b * 8 + hh) * 64 + d)) * 256 + t) = v; }
                    else { const int R2 = R - CTXROWS, b = R2 >> 14, t = R2 & 16383; *(uint2*)(vtl + ((size_t)((b * 8 + hh) * 64 + d)) * 16384 + t) = v; }
                }
        } else {
            stage_tile_bf16(acc, smem, [&](int row, int c8, uint4 v) {
                const int R = mt * 128 + row, N = nt * 128 + c8;
                if (N >= INP) return;
                if (N < 1024) *(uint4*)(pqk + (size_t)R * 1024 + N) = v;
                else if (N < 2496) *(uint4*)(pb + (size_t)R * 960 + (N - 1536)) = v;
                else *(uint4*)(pc + (size_t)R * 1040 + (N - 2496)) = v;
            });
        }
    }
}

constexpr size_t RWREC = 12288;
constexpr size_t RW_A1 = 0, RW_A4 = 2048, RW_A3 = 4096, RW_MKA = 8192, RW_TT = 8704, RW_MY = 9216, RW_V = 10240;
constexpr size_t OFF_RWOP = OFF_X1;
constexpr size_t OFF_RWWG = OFF_RWOP + (size_t)16 * 520 * RWREC;
constexpr size_t OFF_YRWB = OFF_RWWG + (size_t)16 * 130 * 64 * 4;
constexpr size_t OFF_BONUS = OFF_YRWB + (size_t)T * 256 * 2;
static_assert(OFF_BONUS + (size_t)T * 4 * 4 <= OFF_HM, "rw operand store must fit the X1 region");

DEVINL float rw_mix(const u16* __restrict__ pb, const float* __restrict__ mup, const float* __restrict__ mun, int row, int t, int seqlen, int col) {
    const float cu = bf2f(pb[(size_t)row * 960 + col]);
    const float pr = t > 0 ? bf2f(pb[(size_t)(row - 1) * 960 + col]) : 0.f;
    const float nx = t + 1 < seqlen ? bf2f(pb[(size_t)(row + 1) * 960 + col]) : 0.f;
    return cu + mup[col] * (pr - cu) + mun[col] * (nx - cu);
}

DEVINL void rw_mix8(const u16* __restrict__ pb, const float* __restrict__ mup, const float* __restrict__ mun, int row, int t, int seqlen, int col0, float (&o)[8]) {
    const bool hp = t > 0, hn = t + 1 < seqlen;
    const u32x4 c = *(const u32x4*)(pb + (size_t)row * 960 + col0);
    u32x4 pv = *(const u32x4*)(pb + (size_t)(hp ? row - 1 : row) * 960 + col0);
    u32x4 nx = *(const u32x4*)(pb + (size_t)(hn ? row + 1 : row) * 960 + col0);
    const unsigned mpv = hp ? 0xFFFFFFFFu : 0u, mnx = hn ? 0xFFFFFFFFu : 0u;
    const f32x4 mp0 = *(const f32x4*)(mup + col0), mp1 = *(const f32x4*)(mup + col0 + 4), mn0 = *(const f32x4*)(mun + col0), mn1 = *(const f32x4*)(mun + col0 + 4);
#pragma unroll
    for (int i = 0; i < 4; ++i) {
        const unsigned cw = c[i], pw = pv[i] & mpv, nw = nx[i] & mnx;
        const float c0 = __uint_as_float(cw << 16), c1 = __uint_as_float(cw & 0xFFFF0000u);
        const float p0 = __uint_as_float(pw << 16), p1 = __uint_as_float(pw & 0xFFFF0000u);
        const float n0 = __uint_as_float(nw << 16), n1 = __uint_as_float(nw & 0xFFFF0000u);
        const float ma = (i < 2) ? mp0[2 * i] : mp1[2 * i - 4], mb = (i < 2) ? mp0[2 * i + 1] : mp1[2 * i - 3];
        const float na = (i < 2) ? mn0[2 * i] : mn1[2 * i - 4], nb = (i < 2) ? mn0[2 * i + 1] : mn1[2 * i - 3];
        o[2 * i] = c0 + ma * (p0 - c0) + na * (n0 - c0);
        o[2 * i + 1] = c1 + mb * (p1 - c1) + nb * (n1 - c1);
    }
}
DEVINL uint4 pack8bf(const float (&v)[8]) { return make_uint4(pk2bf(v[0], v[1]), pk2bf(v[2], v[3]), pk2bf(v[4], v[5]), pk2bf(v[6], v[7])); }

DEVINL void ph_rwprep(const P& p, int l, int half, char* smem, int bid, int nb) {
    const int TIDX_ = tid_(); const int BIDX_ = bid_(); char* const WS_ = wsl_(p.ws);
    const int tid = TIDX_, lane = tid & 63, w = tid >> 6, fr = lane & 15, fq = lane >> 4;
    const u16* pb = (const u16*)(WS_ + OFF_PB);
    char* rwop = WS_ + OFF_RWOP;
    float* rwwg = (float*)(WS_ + OFF_RWWG);
    float* bonus = (float*)(WS_ + OFF_BONUS);
    u16* gate = (u16*)(WS_ + OFF_GATE);
    const float* mup = p.mu_prev + l * 960; const float* mun = p.mu_next + l * 960;
    u16* lwdh = (u16*)smem;
    u16* ladh = lwdh + 2048;
    u16* abuf = ladh + 2048;
    float* Lb = (float*)(smem + 16384);
    u16* SV = (u16*)(smem + 32768);
    float* tot = (float*)(smem + 32768);
    const u16* w2t = (const u16*)(WS_ + OFF_LORA);
    const u16* a2t = w2t + 2 * 2 * 256 * 32;
    const u16* g2t = a2t + 2 * 2 * 256 * 32;
    for (int uh = bid; uh < 2 * 2 * 130 * 4; uh += nb) {
        const int h = uh & 3, rest = uh >> 2;
        const int d = rest / 260, b = (rest % 260) / 130, gl = rest % 130;
        const int z = d;
        const int gscan = half * 130 + gl;
        int gi, row0, seqlen;
        if (gscan < 4) { gi = d ? 3 - gscan : gscan; row0 = b * 256 + gi * 64; seqlen = 256; }
        else { gi = d ? 255 - (gscan - 4) : gscan - 4; row0 = CTXROWS + b * LAT + gi * 64; seqlen = LAT; }
        const int t0 = gi * 64;
        __syncthreads();
        {
            const int j = tid >> 2, cq = tid & 3;
            float v[8];
            rw_mix8(pb, mup, mun, row0 + j, t0 + j, seqlen, 768 + z * 32 + 8 * cq, v);
#pragma unroll
            for (int i = 0; i < 8; ++i) v[i] = tanhf(v[i]);
            *(uint4*)(lwdh + j * 32 + 8 * cq) = pack8bf(v);
            rw_mix8(pb, mup, mun, row0 + j, t0 + j, seqlen, 832 + z * 32 + 8 * cq, v);
            *(uint4*)(ladh + j * 32 + 8 * cq) = pack8bf(v);
        }
        if (d == 0) {
            u16* lgd = (u16*)Lb;
            {
                const int j = tid >> 2, cq = tid & 3;
#pragma unroll
                for (int hh = 0; hh < 2; ++hh) {
                    float v[8];
                    rw_mix8(pb, mup, mun, row0 + j, t0 + j, seqlen, 896 + 16 * cq + 8 * hh, v);
#pragma unroll
                    for (int i = 0; i < 8; ++i) v[i] = sigmoidf_(v[i]);
                    *(uint4*)(lgd + j * 64 + 16 * cq + 8 * hh) = pack8bf(v);
                }
            }
            __syncthreads();
            const bf16x8 x0 = *(const bf16x8*)(lgd + (16 * w + fr) * 64 + 8 * fq), x1 = *(const bf16x8*)(lgd + (16 * w + fr) * 64 + 32 + 8 * fq);
#pragma unroll
            for (int nt = 0; nt < 4; ++nt) {
                const u16* bp = g2t + ((size_t)l * 256 + 64 * h + 16 * nt + fr) * 64 + 8 * fq;
                const bf16x8 b0 = *(const bf16x8*)bp, b1 = *(const bf16x8*)(bp + 32);
                f32x4 acc = f32x4{0.f, 0.f, 0.f, 0.f};
                acc = __builtin_amdgcn_mfma_f32_16x16x32_bf16(x0, b0, acc, 0, 0, 0);
                acc = __builtin_amdgcn_mfma_f32_16x16x32_bf16(x1, b1, acc, 0, 0, 0);
#pragma unroll
                for (int r = 0; r < 4; ++r) gate[(size_t)(row0 + 16 * w + 4 * fq + r) * 256 + 64 * h + 16 * nt + fr] = f2bf(acc[r]);
            }
        }
        {
            const int bh = b * 4 + h;
            const int ch = h * 64 + lane;
            __syncthreads();
            {
                const bf16x8 xw = *(const bf16x8*)(lwdh + (16 * w + fr) * 32 + 8 * fq);
                const bf16x8 xa = *(const bf16x8*)(ladh + (16 * w + fr) * 32 + 8 * fq);
#pragma unroll 1
                for (int kt = 0; kt < 4; ++kt) {
                    const int key = 16 * kt + fr;
                    const size_t wrow = ((size_t)(l * 2 + z) * 256 + h * 64 + key) * 32 + 8 * fq;
                    const bf16x8 bw = *(const bf16x8*)(w2t + wrow), ba = *(const bf16x8*)(a2t + wrow);
                    f32x4 ae = f32x4{0.f, 0.f, 0.f, 0.f}, aa = f32x4{0.f, 0.f, 0.f, 0.f};
                    ae = __builtin_amdgcn_mfma_f32_16x16x32_bf16(xw, bw, ae, 0, 0, 0);
                    aa = __builtin_amdgcn_mfma_f32_16x16x32_bf16(xa, ba, aa, 0, 0, 0);
                    const float w0 = p.rw_w0[(l * 2 + z) * 256 + h * 64 + key], a0 = p.rw_a0[(l * 2 + z) * 256 + h * 64 + key];
#pragma unroll
                    for (int r = 0; r < 4; ++r) {
                        const int tok = 16 * w + 4 * fq + r;
                        const int s = d ? 63 - tok : tok;
                        Lb[s * 64 + key] = 0.60653065971263342f * sigmoidf_(ae[r] + w0);
                        abuf[tok * 64 + key] = f2bf(sigmoidf_(aa[r] + a0));
                    }
                }
            }
            __syncthreads();
            {
                float pre[16]; float run = 0.f;
#pragma unroll
                for (int i = 0; i < 16; ++i) { run += Lb[(16 * w + i) * 64 + lane]; pre[i] = run; }
                tot[w * 64 + lane] = run;
                __syncthreads();
                float offs = 0.f;
#pragma unroll
                for (int ww = 0; ww < 3; ++ww) offs += (ww < w) ? tot[ww * 64 + lane] : 0.f;
#pragma unroll
                for (int i = 0; i < 16; ++i) Lb[(16 * w + i) * 64 + lane] = -(offs + pre[i]);
            }
            __syncthreads();
            {
                const int j = tid >> 2, kq = tid & 3, row = row0 + j, tt = t0 + j;
                const int c0 = h * 64 + 16 * kq;
                float kr[16];
                { float t8[8];
                  rw_mix8(pb, mup, mun, row, tt, seqlen, 256 + c0, t8);
#pragma unroll
                  for (int i = 0; i < 8; ++i) kr[i] = t8[i];
                  rw_mix8(pb, mup, mun, row, tt, seqlen, 256 + c0 + 8, t8);
#pragma unroll
                  for (int i = 0; i < 8; ++i) kr[8 + i] = t8[i]; }
                float ss = 0.f;
#pragma unroll
                for (int i = 0; i < 16; ++i) { const float kv = kr[i] * p.rw_kk[l * 256 + c0 + i]; ss += kv * kv; }
                ss += __shfl_xor(ss, 1); ss += __shfl_xor(ss, 2);
                const float inorm = 1.f / fmaxf(sqrtf(ss), 1e-12f);
                const int sidx = d ? 63 - j : j;
                const int cch = sidx >> 4, ts = sidx & 15;
                u16* sv = SV + (size_t)(cch * 4) * 1024 + ts * 64 + 16 * kq;
                float bs = 0.f;
#pragma unroll 1
                for (int hh = 0; hh < 2; ++hh) {
                    const int cb = c0 + 8 * hh;
                    float rr[8], av[8], oa[8], orr[8], ob[8], ok[8];
                    rw_mix8(pb, mup, mun, row, tt, seqlen, cb, rr);
                    { const uint4 a0 = *(const uint4*)(abuf + j * 64 + 16 * kq + 8 * hh);
                      const unsigned aw[4] = {a0.x, a0.y, a0.z, a0.w};
#pragma unroll
                      for (int i = 0; i < 4; ++i) { av[2 * i] = __uint_as_float(aw[i] << 16); av[2 * i + 1] = __uint_as_float(aw[i] & 0xFFFF0000u); } }
#pragma unroll
                    for (int i4 = 0; i4 < 2; ++i4) {
                        const float4 Lt4 = *(const float4*)(Lb + sidx * 64 + 16 * kq + 8 * hh + 4 * i4);
                        const float4 Lp4 = sidx > 0 ? *(const float4*)(Lb + (sidx - 1) * 64 + 16 * kq + 8 * hh + 4 * i4) : make_float4(0.f, 0.f, 0.f, 0.f);
                        const float Lt[4] = {Lt4.x, Lt4.y, Lt4.z, Lt4.w}, Lp[4] = {Lp4.x, Lp4.y, Lp4.z, Lp4.w};
#pragma unroll
                        for (int ii = 0; ii < 4; ++ii) {
                            const int i = 4 * i4 + ii;
                            const float kraw = hh ? kr[8 + i] : kr[i];
                            const float kkn = kraw * p.rw_kk[l * 256 + cb + i] * inorm, a = av[i];
                            const float et = __expf(Lt[ii]), einv = __builtin_amdgcn_rcpf(et);
                            oa[i] = -kkn * __expf(Lp[ii]);
                            orr[i] = rr[i] * et;
                            ob[i] = kkn * a * einv;
                            ok[i] = kraw * (1.f + (a - 1.f) * p.rw_ka[l * 256 + cb + i]) * einv;
                            bs += rr[i] * kraw * p.rw_rk[l * 256 + cb + i];
                            if (sidx == 63) rwwg[((size_t)(d * 8 + bh) * 130 + gl) * 64 + 16 * kq + 8 * hh + i] = et;
                        }
                    }
                    *(uint4*)(sv + 8 * hh) = pack8bf(oa);
                    *(uint4*)(sv + 1024 + 8 * hh) = pack8bf(orr);
                    *(uint4*)(sv + 2048 + 8 * hh) = pack8bf(ob);
                    *(uint4*)(sv + 3072 + 8 * hh) = pack8bf(ok);
                    rw_mix8(pb, mup, mun, row, tt, seqlen, 512 + cb, rr);
                    *(uint4*)(abuf + j * 64 + 16 * kq + 8 * hh) = pack8bf(rr);
                }
                if (d == 0) { bs += __shfl_xor(bs, 1); bs += __shfl_xor(bs, 2); if (kq == 0) bonus[(size_t)row * 4 + h] = bs; }
            }
            __syncthreads();
            {
                char* rec = rwop + ((size_t)(d * 8 + bh) * 520 + (size_t)gl * 4 + w) * RWREC;
                const u16* Av = SV + (size_t)(w * 4) * 1024; const u16* Rv = Av + 1024; const u16* Bv = Av + 2048; const u16* Kv = Av + 3072;
                bf16x8 fa[2], frr[2], fb[2], fk[2];
#pragma unroll
                for (int ks = 0; ks < 2; ++ks) {
                    fa[ks] = *(const bf16x8*)(Av + fr * 64 + ks * 32 + fq * 8);
                    frr[ks] = *(const bf16x8*)(Rv + fr * 64 + ks * 32 + fq * 8);
                    fb[ks] = *(const bf16x8*)(Bv + fr * 64 + ks * 32 + fq * 8);
                    fk[ks] = *(const bf16x8*)(Kv + fr * 64 + ks * 32 + fq * 8);
                }
                f32x4 mka = f32x4{0.f, 0.f, 0.f, 0.f}, mba = mka, mkr = mka, mbr = mka;
#pragma unroll
                for (int ks = 0; ks < 2; ++ks) {
                    mka = __builtin_amdgcn_mfma_f32_16x16x32_bf16(fa[ks], fk[ks], mka, 0, 0, 0);
                    mba = __builtin_amdgcn_mfma_f32_16x16x32_bf16(fa[ks], fb[ks], mba, 0, 0, 0);
                    mkr = __builtin_amdgcn_mfma_f32_16x16x32_bf16(frr[ks], fk[ks], mkr, 0, 0, 0);
                    mbr = __builtin_amdgcn_mfma_f32_16x16x32_bf16(frr[ks], fb[ks], mbr, 0, 0, 0);
                }
                float* Ns = Lb + w * 256;
                float* Ts = Lb + 1024 + w * 256;
                u16* rmka = (u16*)(rec + RW_MKA); u16* rmy = (u16*)(rec + RW_MY);
                const int i_ = fr;
#pragma unroll
                for (int r = 0; r < 4; ++r) {
                    const int t_ = 4 * fq + r;
                    const int lp = (i_ >> 2) * 16 + t_;
                    mka[r] = i_ < t_ ? mka[r] : 0.f;
                    rmy[lp * 8 + (i_ & 3)] = f2bf(i_ <= t_ ? mbr[r] : 0.f);
                    rmy[lp * 8 + 4 + (i_ & 3)] = f2bf(i_ <= t_ ? mkr[r] : 0.f);
                    Ns[t_ * 16 + i_] = i_ < t_ ? mba[r] : 0.f;
                }
                if (lane < 16) {
                    float Tr[16];
#pragma unroll
                    for (int ii = 0; ii < 16; ++ii) Tr[ii] = 0.f;
#pragma unroll 1
                    for (int t_ = 0; t_ < 16; ++t_) {
                        float acc = (lane == t_) ? 1.f : 0.f;
#pragma unroll
                        for (int i4 = 0; i4 < 4; ++i4) {
                            const float4 nv = *(const float4*)(Ns + t_ * 16 + 4 * i4);
                            acc += Tr[4 * i4] * nv.x + Tr[4 * i4 + 1] * nv.y + Tr[4 * i4 + 2] * nv.z + Tr[4 * i4 + 3] * nv.w;
                        }
#pragma unroll
                        for (int ii = 0; ii < 16; ++ii) Tr[ii] = (ii == t_) ? acc : Tr[ii];
                        Ts[lane * 16 + t_] = acc;
                    }
                }
                bf16x8 TTf;
                {
                    const float t0v = Ts[(4 * fq + 0) * 16 + fr], t1v = Ts[(4 * fq + 1) * 16 + fr], t2v = Ts[(4 * fq + 2) * 16 + fr], t3v = Ts[(4 * fq + 3) * 16 + fr];
                    union { u32x4 u; bf16x8 f; } x; x.u = u32x4{pk2bf(t0v, t1v), pk2bf(t2v, t3v), 0u, 0u}; TTf = x.f;
                }
                {
                    union { u32x4 u; bf16x8 f; } mb; mb.u = u32x4{pk2bf(mka[0], mka[1]), pk2bf(mka[2], mka[3]), 0u, 0u};
                    f32x4 mk2 = f32x4{0.f, 0.f, 0.f, 0.f};
                    mk2 = __builtin_amdgcn_mfma_f32_16x16x32_bf16(TTf, mb.f, mk2, 0, 0, 0);
#pragma unroll
                    for (int r = 0; r < 4; ++r) { const int t_ = 4 * fq + r; rmka[((i_ >> 2) * 16 + t_) * 4 + (i_ & 3)] = f2bf(mk2[r]); }
                }
                {
                    f32x4 ap[4];
#pragma unroll
                    for (int m = 0; m < 4; ++m) {
                        union { u32x4 u; bf16x8 f; } ag;
                        ag.u = u32x4{(unsigned)Av[(4 * fq + 0) * 64 + 16 * m + fr] | ((unsigned)Av[(4 * fq + 1) * 64 + 16 * m + fr] << 16),
                                     (unsigned)Av[(4 * fq + 2) * 64 + 16 * m + fr] | ((unsigned)Av[(4 * fq + 3) * 64 + 16 * m + fr] << 16), 0u, 0u};
                        ap[m] = f32x4{0.f, 0.f, 0.f, 0.f};
                        ap[m] = __builtin_amdgcn_mfma_f32_16x16x32_bf16(ag.f, TTf, ap[m], 0, 0, 0);
                    }
#pragma unroll
                    for (int ks = 0; ks < 2; ++ks) {
                        uint4 o;
                        o.x = pk2bf(ap[2 * ks][0], ap[2 * ks][1]); o.y = pk2bf(ap[2 * ks][2], ap[2 * ks][3]);
                        o.z = pk2bf(ap[2 * ks + 1][0], ap[2 * ks + 1][1]); o.w = pk2bf(ap[2 * ks + 1][2], ap[2 * ks + 1][3]);
                        *(uint4*)(rec + RW_A1 + (ks * 64 + lane) * 16) = o;
                    }
                }
#pragma unroll
                for (int ks = 0; ks < 2; ++ks) {
                    uint4 o;
                    const uint2 lo2 = *(const uint2*)(Rv + fr * 64 + 32 * ks + 4 * fq), hi2 = *(const uint2*)(Rv + fr * 64 + 32 * ks + 16 + 4 * fq);
                    o.x = lo2.x; o.y = lo2.y; o.z = hi2.x; o.w = hi2.y;
                    *(uint4*)(rec + RW_A4 + (ks * 64 + lane) * 16) = o;
                }
#pragma unroll
                for (int m = 0; m < 4; ++m) {
                    unsigned e[8];
#pragma unroll
                    for (int j = 0; j < 4; ++j) { e[j] = Bv[(4 * fq + j) * 64 + 16 * m + fr]; e[4 + j] = Kv[(4 * fq + j) * 64 + 16 * m + fr]; }
                    uint4 o; o.x = e[0] | (e[1] << 16); o.y = e[2] | (e[3] << 16); o.z = e[4] | (e[5] << 16); o.w = e[6] | (e[7] << 16);
                    *(uint4*)(rec + RW_A3 + (m * 64 + lane) * 16) = o;
                }
#pragma unroll
                for (int q = 0; q < 4; ++q) {
                    unsigned e[4];
#pragma unroll
                    for (int j = 0; j < 4; ++j) {
                        const int s = 16 * w + 4 * fq + j; const int jt = d ? 63 - s : s;
                        e[j] = abuf[jt * 64 + 16 * q + fr];
                    }
                    uint2 o; o.x = e[0] | (e[1] << 16); o.y = e[2] | (e[3] << 16);
                    *(uint2*)(rec + RW_V + (q * 64 + lane) * 8) = o;
                }
            }
        }
    }
}

constexpr int RWSLOT = 12544;
DEVINL void ph_rwscan(const P& p, int l, int half, int bid, int nb, char* smem) {
    const int TIDX_ = tid_(); char* const WS_ = wsl_(p.ws);
    const int tid = TIDX_, lane = tid & 63, q = tid >> 6, fr = lane & 15, fq = lane >> 4;
    const char* rwop = WS_ + OFF_RWOP;
    const float* rwwg = (const float*)(WS_ + OFF_RWWG);
    u16* yf = (u16*)(WS_ + OFF_Y);
    u16* yb = (u16*)(WS_ + OFF_YRWB);
    (void)l;
    float* zst = (float*)(WS_ + OFF_ZST);
    for (int dbh = bid; dbh < 16; dbh += nb) {
        const int d = dbh >> 3, bh = dbh & 7, b = bh >> 2, h = bh & 3;
        f32x4 z[4];
        float* zp = zst + ((size_t)(dbh * 4 + q) * 64 + lane) * 16;
#pragma unroll
        for (int m = 0; m < 4; ++m) {
            if (half == 0) z[m] = f32x4{0.f, 0.f, 0.f, 0.f};
            else { const float4 t4 = *(const float4*)(zp + 4 * m); z[m] = f32x4{t4.x, t4.y, t4.z, t4.w}; }
        }
        const int cbase = half * 520;
        const char* rec0 = rwop + (size_t)dbh * 520 * RWREC;
        const float* wg0 = rwwg + (size_t)dbh * 130 * 64;
        constexpr int RD = 6;
        u32x4 rb[RD][3]; float rwgA = 0.f, rwgB = 0.f;
        auto ldrec = [&](int c, auto I) {
            constexpr int i = decltype(I)::value;
            const int cc = c < 520 ? c : 519;
            const char* rec = rec0 + (size_t)cc * RWREC;
#pragma unroll
            for (int k = 0; k < 3; ++k) rb[i][k] = *(const u32x4*)(rec + (tid + 256 * k) * 16);
        };
        auto strec = [&](auto I, int slotidx) {
            constexpr int i = decltype(I)::value;
            char* slot = smem + slotidx * RWSLOT;
#pragma unroll
            for (int k = 0; k < 3; ++k) *(u32x4*)(slot + (tid + 256 * k) * 16) = rb[i][k];
        };
        auto asfrag = [](uint4 v) { union { uint4 u; bf16x8 f; } x; x.u = v; return x.f; };
        auto pack2 = [](float lo, float hi) { return pk2bf(lo, hi); };
        const unsigned b128 = lds_addr(smem) + lane * 16, b64 = lds_addr(smem) + lane * 8, bv = lds_addr(smem) + (q * 64 + lane) * 8, bg = lds_addr(smem) + 16 * fq;
        __syncthreads();
        __builtin_amdgcn_s_setprio(3);
#define IC(n) std::integral_constant<int, n>{}
        auto flush_y = [&](int cprev, int par) {
            if (tid < 128) {
                const int cg = cbase + cprev;
                const bool isctx = cg < 16;
                const int cc = isctx ? cg : cg - 16;
                const int n = isctx ? LCTX : LAT;
                const int rowbase = isctx ? b * LCTX : CTXROWS + b * LAT;
                const int ts = tid >> 3, c8 = (tid & 7) * 8;
                const int sidx = cc * 16 + ts;
                const int t = d ? n - 1 - sidx : sidx;
                const u32x4 v = *(const u32x4*)(smem + 4 * RWSLOT + par * 2048 + (ts * 64 + c8) * 2);
                u16* dst = d == 0 ? yf + (size_t)(rowbase + t) * 1024 + 512 + h * 64 + c8 : yb + (size_t)(rowbase + t) * 256 + h * 64 + c8;
                *(u32x4*)dst = v;
            }
        };
        u32x4 f4[2][6]; u32x2 f2[2][2];
#define RD_ISSUE(par, SBC) asm volatile( \
                "ds_read_b64 %6, %9 offset:%11+8192\n\t" \
                "ds_read_b64 %7, %10 offset:%11+10240\n\t" \
                "ds_read_b128 %0, %8 offset:%11+0\n\t" \
                "ds_read_b128 %1, %8 offset:%11+1024\n\t" \
                "ds_read_b128 %2, %8 offset:%11+4096\n\t" \
                "ds_read_b128 %3, %8 offset:%11+5120\n\t" \
                "ds_read_b128 %4, %8 offset:%11+6144\n\t" \
                "ds_read_b128 %5, %8 offset:%11+7168" \
                : "=&v"(f4[par][0]), "=&v"(f4[par][1]), "=&v"(f4[par][2]), "=&v"(f4[par][3]), "=&v"(f4[par][4]), "=&v"(f4[par][5]), \
                  "=&v"(f2[par][0]), "=&v"(f2[par][1]) \
                : "v"(b128), "v"(b64), "v"(bv), "n"(SBC) \
                : "memory")
#define RD_WAIT(par) asm volatile("s_waitcnt lgkmcnt(0)" \
                : "+v"(f4[par][0]), "+v"(f4[par][1]), "+v"(f4[par][2]), "+v"(f4[par][3]), "+v"(f4[par][4]), "+v"(f4[par][5]), \
                  "+v"(f2[par][0]), "+v"(f2[par][1]) \
                :: "memory")
        ldrec(0, IC(0)); ldrec(1, IC(1)); ldrec(2, IC(2)); ldrec(3, IC(3)); ldrec(4, IC(4)); ldrec(5, IC(5));
        strec(IC(0), 0); ldrec(RD, IC(0));
        strec(IC(1), 1); ldrec(RD + 1, IC(1));
        rwgA = wg0[lane]; rwgB = wg0[64 + lane];
        asm volatile("s_waitcnt lgkmcnt(0)" ::: "memory");
        __builtin_amdgcn_s_barrier();
        RD_ISSUE(0, 0); RD_WAIT(0);
#pragma unroll 1
        for (int c5 = 0; c5 < 528; c5 += 12) {
          auto body = [&](auto SJ) {
            constexpr int sj = decltype(SJ)::value;
            constexpr int par = sj & 1;
            const int c = c5 + sj;
            asm volatile("s_waitcnt lgkmcnt(0)" ::: "memory");
            __builtin_amdgcn_s_barrier();
            RD_ISSUE(par ^ 1, ((sj + 1) % 4) * RWSLOT);
            if (c > 0 && c <= 520) flush_y(c - 1, par ^ 1);
            strec(IC((sj + 2) % 6), (sj + 2) % 4);
            ldrec(c + 2 + RD, IC((sj + 2) % 6));
            if ((sj & 3) == 1) {
                const bool even = (((c >> 2) & 1) == 0);
                if (q == 0) *(float*)(smem + ((sj + 2) % 4) * RWSLOT + 12288 + lane * 4) = even ? rwgA : rwgB;
                const int gn = (c >> 2) + 2;
                const float nv = wg0[(size_t)(gn < 130 ? gn : 129) * 64 + lane];
                if (even) rwgA = nv; else rwgB = nv;
            }
            if (c < 520) {
            constexpr int SB = (sj % 4) * RWSLOT;
            auto asfrag4 = [](u32x4 v) { union { u32x4 u; bf16x8 f; } x; x.u = v; return x.f; };
            const bf16x8 A1_0 = asfrag4(f4[par][0]), A1_1 = asfrag4(f4[par][1]);
            const bf16x8 A3_0 = asfrag4(f4[par][2]), A3_1 = asfrag4(f4[par][3]), A3_2 = asfrag4(f4[par][4]), A3_3 = asfrag4(f4[par][5]);
            const u32x2 mka = f2[par][0], vcur = f2[par][1];
            const bf16x8 MKA = asfrag(make_uint4(mka.x, mka.y, 0u, 0u));
            const bf16x8 VB = asfrag(make_uint4(vcur.x, vcur.y, 0u, 0u));
            const bf16x8 ZB0 = asfrag(make_uint4(pack2(z[0][0], z[0][1]), pack2(z[0][2], z[0][3]), pack2(z[1][0], z[1][1]), pack2(z[1][2], z[1][3])));
            const bf16x8 ZB1 = asfrag(make_uint4(pack2(z[2][0], z[2][1]), pack2(z[2][2], z[2][3]), pack2(z[3][0], z[3][1]), pack2(z[3][2], z[3][3])));
            f32x4 Ua = f32x4{0.f, 0.f, 0.f, 0.f}, Ub = f32x4{0.f, 0.f, 0.f, 0.f};
            Ua = __builtin_amdgcn_mfma_f32_16x16x32_bf16(MKA, VB, Ua, 0, 0, 0);
            Ub = __builtin_amdgcn_mfma_f32_16x16x32_bf16(A1_1, ZB1, Ub, 0, 0, 0);
            Ua = __builtin_amdgcn_mfma_f32_16x16x32_bf16(A1_0, ZB0, Ua, 0, 0, 0);
            u32x4 r_a40, r_a41, r_my;
            asm volatile(
                "ds_read_b128 %0, %3 offset:%4+2048\n\t"
                "ds_read_b128 %1, %3 offset:%4+3072\n\t"
                "ds_read_b128 %2, %3 offset:%4+9216\n\t"
                "s_waitcnt lgkmcnt(0)"
                : "=&v"(r_a40), "=&v"(r_a41), "=&v"(r_my) : "v"(b128), "n"(SB) : "memory");
            const bf16x8 A4_0 = asfrag4(r_a40), A4_1 = asfrag4(r_a41), MY = asfrag4(r_my);
            f32x4 Y = f32x4{0.f, 0.f, 0.f, 0.f};
            Y = __builtin_amdgcn_mfma_f32_16x16x32_bf16(A4_0, ZB0, Y, 0, 0, 0);
            Y = __builtin_amdgcn_mfma_f32_16x16x32_bf16(A4_1, ZB1, Y, 0, 0, 0);
            const f32x4 U = Ua + Ub;
            const bf16x8 UV = asfrag(make_uint4(pack2(U[0], U[1]), pack2(U[2], U[3]), vcur.x, vcur.y));
            z[0] = __builtin_amdgcn_mfma_f32_16x16x32_bf16(A3_0, UV, z[0], 0, 0, 0);
            z[1] = __builtin_amdgcn_mfma_f32_16x16x32_bf16(A3_1, UV, z[1], 0, 0, 0);
            z[2] = __builtin_amdgcn_mfma_f32_16x16x32_bf16(A3_2, UV, z[2], 0, 0, 0);
            z[3] = __builtin_amdgcn_mfma_f32_16x16x32_bf16(A3_3, UV, z[3], 0, 0, 0);
            Y = __builtin_amdgcn_mfma_f32_16x16x32_bf16(MY, UV, Y, 0, 0, 0);
            asm volatile("s_waitcnt lgkmcnt(0)" ::: "memory");
            if ((c & 3) == 3) {
                u32x4 g0, g1, g2, g3;
                asm volatile(
                    "ds_read_b128 %0, %4 offset:%5+12288\n\t"
                    "ds_read_b128 %1, %4 offset:%5+12352\n\t"
                    "ds_read_b128 %2, %4 offset:%5+12416\n\t"
                    "ds_read_b128 %3, %4 offset:%5+12480\n\t"
                    "s_waitcnt lgkmcnt(0)"
                    : "=&v"(g0), "=&v"(g1), "=&v"(g2), "=&v"(g3) : "v"(bg), "n"(SB) : "memory");
                z[0][0] *= __uint_as_float(g0.x); z[0][1] *= __uint_as_float(g0.y); z[0][2] *= __uint_as_float(g0.z); z[0][3] *= __uint_as_float(g0.w);
                z[1][0] *= __uint_as_float(g1.x); z[1][1] *= __uint_as_float(g1.y); z[1][2] *= __uint_as_float(g1.z); z[1][3] *= __uint_as_float(g1.w);
                z[2][0] *= __uint_as_float(g2.x); z[2][1] *= __uint_as_float(g2.y); z[2][2] *= __uint_as_float(g2.z); z[2][3] *= __uint_as_float(g2.w);
                z[3][0] *= __uint_as_float(g3.x); z[3][1] *= __uint_as_float(g3.y); z[3][2] *= __uint_as_float(g3.z); z[3][3] *= __uint_as_float(g3.w);
            }
            {
                u16* yl = (u16*)(smem + 4 * RWSLOT + par * 2048);
                const unsigned y01 = pk2bf(Y[0], Y[1]), y23 = pk2bf(Y[2], Y[3]);
                yl[(4 * fq + 0) * 64 + 16 * q + fr] = (u16)(y01 & 0xFFFFu);
                yl[(4 * fq + 1) * 64 + 16 * q + fr] = (u16)(y01 >> 16);
                yl[(4 * fq + 2) * 64 + 16 * q + fr] = (u16)(y23 & 0xFFFFu);
                yl[(4 * fq + 3) * 64 + 16 * q + fr] = (u16)(y23 >> 16);
            }
            }
            RD_WAIT(par ^ 1);
          };
          body(IC(0)); body(IC(1)); body(IC(2)); body(IC(3)); body(IC(4)); body(IC(5)); body(IC(6)); body(IC(7)); body(IC(8)); body(IC(9)); body(IC(10)); body(IC(11));
        }
#pragma unroll
        for (int m = 0; m < 4; ++m) *(float4*)(zp + 4 * m) = make_float4(z[m][0], z[m][1], z[m][2], z[m][3]);
        asm volatile("s_waitcnt vmcnt(0)" ::: "memory");
        __builtin_amdgcn_s_setprio(0);
        __syncthreads();
    }
}

DEVINL void ph_rwout(const P& p, int l) {
    const int TIDX_ = tid_(); const int BIDX_ = bid_(); char* const WS_ = wsl_(p.ws);
    const int tid = TIDX_;
    const u16* pb = (const u16*)(WS_ + OFF_PB);
    const u16* yb = (const u16*)(WS_ + OFF_YRWB);
    const u16* gate = (const u16*)(WS_ + OFF_GATE);
    const float* bonus = (const float*)(WS_ + OFF_BONUS);
    u16* y = (u16*)(WS_ + OFF_Y);
    const float* mup = p.mu_prev + l * 960; const float* mun = p.mu_next + l * 960;
    const int c8 = (tid & 31) * 8, h = (tid & 31) >> 3;
    float lw[8], lb[8];
#pragma unroll
    for (int i = 0; i < 8; ++i) { lw[i] = p.rw_lnw[l * 256 + c8 + i]; lb[i] = p.rw_lnb[l * 256 + c8 + i]; }
    const int rstart = (l == 0) ? 0 : CTXROWS;
    for (int row = rstart + BIDX_ * 8 + (tid >> 5); row < T; row += gridDim.x * 8) {
        int t, seqlen;
        if (row < CTXROWS) { t = row & 255; seqlen = LCTX; } else { t = (row - CTXROWS) & (LAT - 1); seqlen = LAT; }
        const uint4 yfv = *(const uint4*)(y + (size_t)row * 1024 + 512 + c8), ybv = *(const uint4*)(yb + (size_t)row * 256 + c8);
        const uint4 gv = *(const uint4*)(gate + (size_t)row * 256 + c8);
        float v[8];
        rw_mix8(pb, mup, mun, row, t, seqlen, 512 + c8, v);
        const unsigned fw[4] = {yfv.x, yfv.y, yfv.z, yfv.w}, bw[4] = {ybv.x, ybv.y, ybv.z, ybv.w}, gw[4] = {gv.x, gv.y, gv.z, gv.w};
        float yv[8], gt[8]; float s1 = 0.f;
#pragma unroll
        for (int i = 0; i < 4; ++i) {
            yv[2 * i] = __uint_as_float(fw[i] << 16) + __uint_as_float(bw[i] << 16);
            yv[2 * i + 1] = __uint_as_float(fw[i] & 0xFFFF0000u) + __uint_as_float(bw[i] & 0xFFFF0000u);
            gt[2 * i] = __uint_as_float(gw[i] << 16); gt[2 * i + 1] = __uint_as_float(gw[i] & 0xFFFF0000u);
            s1 += yv[2 * i] + yv[2 * i + 1];
        }
        s1 += __shfl_xor(s1, 1); s1 += __shfl_xor(s1, 2); s1 += __shfl_xor(s1, 4);
        const float mu = s1 * (1.f / 64.f);
        float s2 = 0.f;
#pragma unroll
        for (int i = 0; i < 8; ++i) { const float dl = yv[i] - mu; s2 += dl * dl; }
        s2 += __shfl_xor(s2, 1); s2 += __shfl_xor(s2, 2); s2 += __shfl_xor(s2, 4);
        const float rstd = rsqrtf(s2 * (1.f / 64.f) + 64e-5f);
        const float bn = bonus[(size_t)row * 4 + h];
        float o[8];
#pragma unroll
        for (int i = 0; i < 8; ++i) o[i] = ((yv[i] - mu) * rstd * lw[i] + lb[i] + bn * v[i]) * gt[i];
        *(uint4*)(y + (size_t)row * 1024 + 512 + c8) = pack8bf(o);
    }
}
DEVINL void ph_prepM(const P& p, int l, char* smem, int bid, int nb) {
    const int TIDX_ = tid_(); const int BIDX_ = bid_(); char* const WS_ = wsl_(p.ws);
    const int tid = TIDX_, lane = tid & 63, wid = tid >> 6;
    const u16* pc = (const u16*)(WS_ + OFF_PC);
    u16* mlf = (u16*)(WS_ + OFF_MLF);
    float* mlg = (float*)(WS_ + OFF_MLG);
    float* mls = (float*)(WS_ + OFF_MLS);
    float* nst = (float*)(WS_ + OFF_NST);
    float* cst = (float*)(WS_ + OFF_HM);
    const float* rope = (const float*)(WS_ + OFF_ROPE);
    u16* kT = (u16*)smem;
    u16* vT = kT + 64 * 72;
    float* wsl = (float*)(vT + 64 * 72);
    float* lil = wsl + 128;
    for (int uh = bid; uh < NUNIT_CH * 4; uh += nb) {
        const int u = uh >> 2, h = uh & 3;
        int b, ch, row0, seqlen; bool isctx;
        if (u < 8) { isctx = true; b = u >> 2; ch = u & 3; row0 = b * 256 + ch * 64; seqlen = 256; }
        else { isctx = false; b = (u - 8) >> 8; ch = (u - 8) & 255; row0 = CTXROWS + b * LAT + ch * 64; seqlen = LAT; }
        const int t0 = ch * 64;
        const int tc = isctx ? ch : 4 + ch;
        __syncthreads();
        {
            const bool isk = wid >= 2;
            const int cch = (isk ? 256 : 0) + h * 64 + lane;
            const float* cw = p.ml_cw + (size_t)l * 3 * 512;
            const float w0 = cw[cch], w1 = cw[512 + cch], w2 = cw[1024 + cch], bb = p.ml_cb[l * 512 + cch];
            const int jb = (wid & 1) * 32;
            const int i16 = lane & 15; const bool second = (lane & 16) != 0; const int half = lane >> 5;
            float pv = (t0 + jb > 0) ? bf2f(pc[(size_t)(row0 + jb - 1) * 1040 + cch]) : 0.f;
            float cv = bf2f(pc[(size_t)(row0 + jb) * 1040 + cch]);
#pragma unroll 4
            for (int jj = 0; jj < 32; ++jj) {
                const int j = jb + jj;
                const float nv = (t0 + j + 1 < seqlen) ? bf2f(pc[(size_t)(row0 + j + 1) * 1040 + cch]) : 0.f;
                float val = siluf_(w0 * pv + w1 * cv + w2 * nv + bb);
                if (!isctx) {
                    const int t = t0 + j;
                    const int pos = half == 0 ? (t >> 6) : (t & 63);
                    const float cs = half == 0 ? rope[pos * 16 + i16] : rope[8192 + pos * 16 + i16];
                    const float sn = half == 0 ? rope[4096 + pos * 16 + i16] : rope[9216 + pos * 16 + i16];
                    const float ov = __shfl_xor(val, 16);
                    val = second ? (ov * sn + val * cs) : (val * cs - ov * sn);
                }
                if (isk) { const u16 kb = f2bf(val * 0.125f); mlf[(size_t)(row0 + j) * 512 + 256 + h * 64 + lane] = kb; kT[lane * 72 + j] = kb; }
                else mlf[(size_t)(row0 + j) * 512 + h * 64 + lane] = f2bf(val);
                pv = cv; cv = nv;
            }
            {
                const int j = tid >> 2, wh = tid & 3;
                const int idx = (wh < 2) ? (wh * 4 + h) : (8 + (wh - 2) * 4 + h);
                const float g = bf2f(pc[(size_t)(row0 + j) * 1040 + 1024 + idx]);
                float v;
                if (wh < 2) v = g + p.ml_ib[l * 8 + idx];
                else { const float xx = g + p.ml_fb[l * 8 + idx - 8]; v = fminf(xx, 0.f) - log1pf(__expf(-fabsf(xx))); }
                lil[j * 4 + wh] = v;
                if (wh < 2) mlg[(size_t)(row0 + j) * 16 + idx] = v;
            }
            for (int i = tid; i < 64 * 8; i += 256) {
                const int tok = i >> 3, d8 = (i & 7) * 8;
                const uint4 vv = *(const uint4*)(pc + (size_t)(row0 + tok) * 1040 + 512 + h * 64 + d8);
                const unsigned wv[4] = {vv.x, vv.y, vv.z, vv.w};
#pragma unroll
                for (int k = 0; k < 4; ++k) { vT[(d8 + 2 * k) * 72 + tok] = (u16)(wv[k] & 0xFFFFu); vT[(d8 + 2 * k + 1) * 72 + tok] = (u16)(wv[k] >> 16); }
            }
        }
        __syncthreads();
        if (wid < 2) {
            const int d = wid, tok = d ? 63 - lane : lane;
            float bsum = lil[tok * 4 + 2 + d];
#pragma unroll
            for (int off = 1; off < 64; off <<= 1) { const float o = __shfl_up(bsum, off); if (lane >= off) bsum += o; }
            const float Bs = __shfl(bsum, 63);
            const float gl = Bs - bsum + lil[tok * 4 + d];
            float G = gl;
#pragma unroll
            for (int off = 32; off > 0; off >>= 1) G = fmaxf(G, __shfl_xor(G, off));
            wsl[d * 64 + tok] = __expf(gl - G);
            mlg[(size_t)(row0 + tok) * 16 + 8 + d * 4 + h] = bsum;
            if (lane == 0) { const int bhd = (b * 4 + h) * 2 + d; mls[(bhd * NTC + tc) * 2 + 0] = G; mls[(bhd * NTC + tc) * 2 + 1] = Bs; }
        }
        __syncthreads();
        {
            const int fr = lane & 15, g = lane >> 4;
            const int bh0 = ((b * 4 + h) * 2 + 0) * NTC + tc, bh1 = ((b * 4 + h) * 2 + 1) * NTC + tc;
            bf16x8 va[2];
            va[0] = *(const bf16x8*)(vT + (16 * wid + fr) * 72 + 8 * g);
            va[1] = *(const bf16x8*)(vT + (16 * wid + fr) * 72 + 32 + 8 * g);
#pragma unroll 1
            for (int dkt = 0; dkt < 4; ++dkt) {
                f32x4 u0 = f32x4{0.f, 0.f, 0.f, 0.f}, u1 = f32x4{0.f, 0.f, 0.f, 0.f};
#pragma unroll
                for (int ks = 0; ks < 2; ++ks) {
                    const uint4 kv = *(const uint4*)(kT + (16 * dkt + fr) * 72 + 32 * ks + 8 * g);
                    const float4 wa0 = *(const float4*)(wsl + 32 * ks + 8 * g), wa1 = *(const float4*)(wsl + 32 * ks + 8 * g + 4);
                    const float4 wb0 = *(const float4*)(wsl + 64 + 32 * ks + 8 * g), wb1 = *(const float4*)(wsl + 64 + 32 * ks + 8 * g + 4);
                    const unsigned kw[4] = {kv.x, kv.y, kv.z, kv.w};
                    const float w0[8] = {wa0.x, wa0.y, wa0.z, wa0.w, wa1.x, wa1.y, wa1.z, wa1.w}, w1[8] = {wb0.x, wb0.y, wb0.z, wb0.w, wb1.x, wb1.y, wb1.z, wb1.w};
                    union { u32x4 u; bf16x8 f; } b0, b1;
#pragma unroll
                    for (int i = 0; i < 4; ++i) {
                        const float ka = __uint_as_float(kw[i] << 16), kb = __uint_as_float(kw[i] & 0xFFFF0000u);
                        b0.u[i] = pk2bf(ka * w0[2 * i], kb * w0[2 * i + 1]);
                        b1.u[i] = pk2bf(ka * w1[2 * i], kb * w1[2 * i + 1]);
                    }
                    u0 = __builtin_amdgcn_mfma_f32_16x16x32_bf16(va[ks], b0.f, u0, 0, 0, 0);
                    u1 = __builtin_amdgcn_mfma_f32_16x16x32_bf16(va[ks], b1.f, u1, 0, 0, 0);
                }
#pragma unroll
                for (int r = 0; r < 4; ++r) {
                    cst[(size_t)bh0 * 4096 + (16 * wid + 4 * g + r) * 64 + 16 * dkt + fr] = u0[r];
                    cst[(size_t)bh1 * 4096 + (16 * wid + 4 * g + r) * 64 + 16 * dkt + fr] = u1[r];
                }
            }
            if (tid < 128) {
                const int d = tid >> 6, dk = tid & 63;
                float acc = 0.f;
#pragma unroll 8
                for (int j = 0; j < 64; ++j) acc += bf2f(kT[dk * 72 + j]) * wsl[d * 64 + j];
                nst[(size_t)(d ? bh1 : bh0) * 64 + dk] = acc;
            }
        }
    }
}

DEVINL void ph_mlB(const P& p, int bid, int nb, char* smem) {
    const int TIDX_ = tid_(); char* const WS_ = wsl_(p.ws);
    const int tid = TIDX_;
    const float* mls = (const float*)(WS_ + OFF_MLS);
    float* mst = (float*)(WS_ + OFF_MST);
    float* nst = (float*)(WS_ + OFF_NST);
    const float* cst = (const float*)(WS_ + OFF_HM);
    u16* cst2 = (u16*)(WS_ + OFF_CST2);
    float* nst2 = (float*)(WS_ + OFF_NST2);
    float* gb = (float*)smem;
    float* dcu = gb + 1024;
    for (int u = bid; u < 64; u += nb) {
        const int bhd = u >> 2, q = u & 3, d = bhd & 1;
        auto tcof = [&](int cs) { return cs < 4 ? (d ? 3 - cs : cs) : 4 + (d ? 255 - (cs - 4) : cs - 4); };
        __syncthreads();
        for (int cs = tid; cs < NTC; cs += 256) { const int tc = tcof(cs); gb[cs * 2] = mls[(bhd * NTC + tc) * 2]; gb[cs * 2 + 1] = mls[(bhd * NTC + tc) * 2 + 1]; }
        __syncthreads();
        if (tid == 0) {
            float m = 0.f;
#pragma unroll 1
            for (int cs = 0; cs < NTC; ++cs) {
                const float G = gb[cs * 2], Bs = gb[cs * 2 + 1];
                if (q == 0) mst[bhd * NTC + tcof(cs)] = m;
                const float ml = fmaxf(Bs + m, G);
                dcu[cs * 2] = __expf(Bs + m - ml); dcu[cs * 2 + 1] = __expf(G - ml);
                m = ml;
            }
        }
        __syncthreads();
        float zz = 0.f; asm volatile("" : "+v"(zz));
        float4 C = make_float4(zz, zz, zz, zz);
        float nn = zz;
        const bool don = (q == 0) && (tid < 64);
        const float* cbase = cst + (size_t)bhd * NTC * 4096 + q * 1024 + tid * 4;
        const float* nbase = nst + (size_t)bhd * NTC * 64 + tid;
        u16* obase = cst2 + (size_t)bhd * NTC * 4096 + q * 1024 + tid * 4;
        float* onbase = nst2 + (size_t)bhd * NTC * 64 + tid;
        float4 Ub[8]; float Nb[8];
#pragma unroll
        for (int i = 0; i < 8; ++i) { Ub[i] = *(const float4*)(cbase + (size_t)tcof(i) * 4096); Nb[i] = don ? nbase[(size_t)tcof(i) * 64] : 0.f; }
#pragma unroll 1
        for (int cs0 = 0; cs0 < NTC; cs0 += 8) {
#pragma unroll
            for (int i = 0; i < 8; ++i) {
                const int cs = cs0 + i;
                if (cs < NTC) {
                    const float4 U = Ub[i]; const float nU = Nb[i];
                    const int tc = tcof(cs);
                    if (cs + 8 < NTC) { Ub[i] = *(const float4*)(cbase + (size_t)tcof(cs + 8) * 4096); Nb[i] = don ? nbase[(size_t)tcof(cs + 8) * 64] : 0.f; }
                    { uint2 o; o.x = pk2bf(C.x, C.y); o.y = pk2bf(C.z, C.w); *(uint2*)(obase + (size_t)tc * 4096) = o; }
                    if (don) onbase[(size_t)tc * 64] = nn;
                    const float dC = dcu[cs * 2], dU = dcu[cs * 2 + 1];
                    C.x = dC * C.x + dU * U.x; C.y = dC * C.y + dU * U.y; C.z = dC * C.z + dU * U.z; C.w = dC * C.w + dU * U.w;
                    nn = dC * nn + dU * nU;
                }
            }
        }
    }
}

DEVINL void ph_na(const P& p, int l, char* smem, int bid, int nb) {
    const int TIDX_ = tid_(); char* const WS_ = wsl_(p.ws);
    const int tid = TIDX_, lane = tid & 63, w = tid >> 6, fr = lane & 15, g = lane >> 4;
    const u16* pqk = (const u16*)(WS_ + OFF_PQK);
    const u16* vtl = (const u16*)(WS_ + OFF_VTL);
    const u16* vtc = (const u16*)(WS_ + OFF_VTC);
    u16* y = (u16*)(WS_ + OFF_Y);
    float* rpbl = (float*)(smem + 49152);
    const int nunit = 4096 + (l == 0 ? 64 : 0);
    const unsigned lbase = lds_addr(smem);
    const int lrow0 = tid >> 3, lrow1 = lrow0 + 32, lsc = ((tid & 7) ^ (lrow0 & 7)) * 8;
    for (int u = bid; u < nunit; u += nb) {
        const bool isctx = u >= 4096;
        int b, h, r = 0, qg = 0;
        if (!isctx) { b = u >> 11; h = (u >> 8) & 7; r = u & 255; }
        else { const int v = u - 4096; b = v >> 5; h = (v >> 2) & 7; qg = v & 3; }
        const int rs = min(max(r - 4, 0), 248);
        const int nwin = isctx ? 0 : 8, nst = nwin + 4;
        auto issue = [&](int st) {
            char* slot = smem + (st % 3) * 16384;
            const u16* ksrc; const u16* vsrc; size_t vstride;
            if (st < nwin) {
                const size_t tok0 = (size_t)CTXROWS + (size_t)b * LAT + (size_t)(rs + st) * 64;
                ksrc = pqk + tok0 * 1024 + 512 + h * 64;
                vsrc = vtl + (size_t)((b * 8 + h) * 64) * LAT + (size_t)(rs + st) * 64; vstride = LAT;
            } else {
                const size_t tok0 = (size_t)b * LCTX + (size_t)(st - nwin) * 64;
                ksrc = pqk + tok0 * 1024 + 512 + h * 64;
                vsrc = vtc + (size_t)((b * 8 + h) * 64) * LCTX + (size_t)(st - nwin) * 64; vstride = LCTX;
            }
            glds16(ksrc + (size_t)lrow0 * 1024 + lsc, slot + tid * 16);
            glds16(ksrc + (size_t)lrow1 * 1024 + lsc, slot + 4096 + tid * 16);
            glds16(vsrc + (size_t)lrow0 * vstride + lsc, slot + 8192 + tid * 16);
            glds16(vsrc + (size_t)lrow1 * vstride + lsc, slot + 8192 + 4096 + tid * 16);
        };
        __syncthreads();
        issue(0); issue(1);
        if (!isctx) for (int i = tid; i < 465; i += 256) rpbl[i] = p.na_rpb[((size_t)l * 8 + h) * 465 + i];
        asm volatile("s_waitcnt lgkmcnt(0)" ::: "memory");
        const int c = 16 * w + fr;
        const int qrow = isctx ? b * LCTX + qg * 64 + c : CTXROWS + b * LAT + r * 64 + c;
        bf16x8 qf[2];
        qf[0] = *(const bf16x8*)(pqk + (size_t)qrow * 1024 + h * 64 + 8 * g);
        qf[1] = *(const bf16x8*)(pqk + (size_t)qrow * 1024 + h * 64 + 32 + 8 * g);
        f32x4 O[4];
#pragma unroll
        for (int i = 0; i < 4; ++i) O[i] = f32x4{0.f, 0.f, 0.f, 0.f};
        float mrun = -1.0e30f, lrun = 0.f;
        const int cb = (w == 0) ? 0 : (w == 1) ? 8 : (w == 2) ? 24 : 32;
        const int cs = min(max(c - 8, 0), 48);
        auto chunk = [&](unsigned sl, int kb, const float* bias0, bool local) {
            const int key0 = kb + fr, key1 = kb + 16 + fr;
            const unsigned ka0 = sl + key0 * 128, ka1 = sl + key1 * 128;
            const unsigned k00a = ka0 + ((g ^ (key0 & 7)) << 4), k01a = ka0 + (((4 + g) ^ (key0 & 7)) << 4);
            const unsigned k10a = ka1 + ((g ^ (key1 & 7)) << 4), k11a = ka1 + (((4 + g) ^ (key1 & 7)) << 4);
            const int q0 = (kb >> 2) + g, q1 = q0 + 4;
            const unsigned vbase = sl + 8192 + fr * 128;
            const unsigned vo0 = ((((q0 >> 1) ^ (fr & 7)) << 4) + ((q0 & 1) << 3)), vo1 = ((((q1 >> 1) ^ (fr & 7)) << 4) + ((q1 & 1) << 3));
            u32x4 k00, k01, k10, k11; u32x2 vlo0, vhi0, vlo1, vhi1, vlo2, vhi2, vlo3, vhi3;
            asm volatile(
                "ds_read_b128 %0, %12\n\t"
                "ds_read_b128 %1, %13\n\t"
                "ds_read_b128 %2, %14\n\t"
                "ds_read_b128 %3, %15\n\t"
                "ds_read_b64 %4, %16\n\t"
                "ds_read_b64 %5, %17\n\t"
                "ds_read_b64 %6, %16 offset:2048\n\t"
                "ds_read_b64 %7, %17 offset:2048\n\t"
                "ds_read_b64 %8, %16 offset:4096\n\t"
                "ds_read_b64 %9, %17 offset:4096\n\t"
                "ds_read_b64 %10, %16 offset:6144\n\t"
                "ds_read_b64 %11, %17 offset:6144\n\t"
                "s_waitcnt lgkmcnt(0)"
                : "=&v"(k00), "=&v"(k01), "=&v"(k10), "=&v"(k11), "=&v"(vlo0), "=&v"(vhi0), "=&v"(vlo1), "=&v"(vhi1),
                  "=&v"(vlo2), "=&v"(vhi2), "=&v"(vlo3), "=&v"(vhi3)
                : "v"(k00a), "v"(k01a), "v"(k10a), "v"(k11a), "v"(vbase + vo0), "v"(vbase + vo1)
                : "memory");
            auto asf = [](u32x4 v) { union { u32x4 u; bf16x8 f; } x; x.u = v; return x.f; };
            f32x4 s0 = f32x4{0.f, 0.f, 0.f, 0.f}, s1 = f32x4{0.f, 0.f, 0.f, 0.f};
            s0 = __builtin_amdgcn_mfma_f32_16x16x32_bf16(asf(k00), qf[0], s0, 0, 0, 0);
            s0 = __builtin_amdgcn_mfma_f32_16x16x32_bf16(asf(k01), qf[1], s0, 0, 0, 0);
            s1 = __builtin_amdgcn_mfma_f32_16x16x32_bf16(asf(k10), qf[0], s1, 0, 0, 0);
            s1 = __builtin_amdgcn_mfma_f32_16x16x32_bf16(asf(k11), qf[1], s1, 0, 0, 0);
            float sv[8];
#pragma unroll
            for (int j = 0; j < 4; ++j) {
                float a = s0[j] * 0.125f, bb = s1[j] * 0.125f;
                if (local) {
                    const int k0c = kb + 4 * g + j, k1c = k0c + 16;
                    a = (k0c >= cs && k0c <= cs + 15) ? a + bias0[k0c] : -1.0e30f;
                    bb = (k1c >= cs && k1c <= cs + 15) ? bb + bias0[k1c] : -1.0e30f;
                }
                sv[j] = a; sv[4 + j] = bb;
            }
            float mx = sv[0];
#pragma unroll
            for (int j = 1; j < 8; ++j) mx = fmaxf(mx, sv[j]);
            mx = fmaxf(mx, __shfl_xor(mx, 16)); mx = fmaxf(mx, __shfl_xor(mx, 32));
            const float mnew = fmaxf(mrun, mx);
            const float sc = __expf(mrun - mnew);
            mrun = mnew;
            float ps = 0.f; float pv[8];
#pragma unroll
            for (int j = 0; j < 8; ++j) { pv[j] = __expf(sv[j] - mnew); ps += pv[j]; }
            lrun = lrun * sc + ps;
            union { u32x4 u; bf16x8 f; } pf; pf.u = u32x4{pk2bf(pv[0], pv[1]), pk2bf(pv[2], pv[3]), pk2bf(pv[4], pv[5]), pk2bf(pv[6], pv[7])};
            const u32x2 vl[4] = {vlo0, vlo1, vlo2, vlo3}, vh[4] = {vhi0, vhi1, vhi2, vhi3};
#pragma unroll
            for (int dt = 0; dt < 4; ++dt) {
                O[dt][0] *= sc; O[dt][1] *= sc; O[dt][2] *= sc; O[dt][3] *= sc;
                union { u32x4 u; bf16x8 f; } vf; vf.u = u32x4{vl[dt].x, vl[dt].y, vh[dt].x, vh[dt].y};
                O[dt] = __builtin_amdgcn_mfma_f32_16x16x32_bf16(vf.f, pf.f, O[dt], 0, 0, 0);
            }
        };
#pragma unroll 1
        for (int st = 0; st < nst; ++st) {
            if (st + 1 < nst) asm volatile("s_waitcnt vmcnt(4)" ::: "memory"); else asm volatile("s_waitcnt vmcnt(0)" ::: "memory");
            __builtin_amdgcn_s_barrier();
            if (st + 2 < nst) issue(st + 2);
            const unsigned sl = lbase + (st % 3) * 16384;
            if (st < nwin) {
                const int krow = rs + st;
                chunk(sl, cb, rpbl + (krow - r + 7) * 31 - c + 15, true);
            } else {
                chunk(sl, 0, nullptr, false);
                chunk(sl, 32, nullptr, false);
            }
        }
        float lt = lrun; lt += __shfl_xor(lt, 16); lt += __shfl_xor(lt, 32);
        const float inv = 1.f / lt;
#pragma unroll
        for (int dt = 0; dt < 4; ++dt) {
            uint2 o;
            o.x = pk2bf(O[dt][0] * inv, O[dt][1] * inv);
            o.y = pk2bf(O[dt][2] * inv, O[dt][3] * inv);
            *(uint2*)(y + (size_t)qrow * 1024 + h * 64 + dt * 16 + 4 * g) = o;
        }
    }
    asm volatile("s_waitcnt vmcnt(0)" ::: "memory");
    __syncthreads();
}

DEVINL void ph_mlC(const P& p, int l, char* smem, int bid, int nb) {
    const int TIDX_ = tid_(); char* const WS_ = wsl_(p.ws);
    const int tid = TIDX_, lane = tid & 63, w = tid >> 6, fr = lane & 15, g = lane >> 4;
    const u16* mlf = (const u16*)(WS_ + OFF_MLF);
    const u16* pc = (const u16*)(WS_ + OFF_PC);
    const float* mlg = (const float*)(WS_ + OFF_MLG);
    const float* mst = (const float*)(WS_ + OFF_MST);
    const float* nst = (const float*)(WS_ + OFF_NST2);
    const u16* cst = (const u16*)(WS_ + OFF_CST2);
    u16* y = (u16*)(WS_ + OFF_Y);
    u16* vt = (u16*)smem;
    float* btl = (float*)(smem + 9216);
    float* lil = btl + 128;
    float* nl = lil + 128;
    for (int uh = bid; uh < 2 * NTC * 4; uh += nb) {
        const int u = uh >> 2, h = uh & 3;
        const int b = u / NTC, tc = u % NTC;
        if (tc < 4 && l != 0) continue;
        const int row0 = tc < 4 ? b * LCTX + tc * 64 : CTXROWS + b * LAT + (tc - 4) * 64;
        __syncthreads();
        for (int i = tid; i < 64 * 8; i += 256) {
            const int tok = i >> 3, d8 = (i & 7) * 8;
            const uint4 vv = *(const uint4*)(pc + (size_t)(row0 + tok) * 1040 + 512 + h * 64 + d8);
            const unsigned wv[4] = {vv.x, vv.y, vv.z, vv.w};
#pragma unroll
            for (int k = 0; k < 4; ++k) { vt[(d8 + 2 * k) * 72 + tok] = (u16)(wv[k] & 0xFFFFu); vt[(d8 + 2 * k + 1) * 72 + tok] = (u16)(wv[k] >> 16); }
        }
        if (tid < 128) {
            const int d = tid >> 6, tok = tid & 63;
            lil[d * 64 + tok] = mlg[(size_t)(row0 + tok) * 16 + d * 4 + h];
            nl[d * 64 + tok] = nst[((size_t)((b * 4 + h) * 2 + d) * NTC + tc) * 64 + tok];
        }
        else { const int d = (tid - 128) >> 6, tok = tid & 63; btl[d * 64 + tok] = mlg[(size_t)(row0 + tok) * 16 + 8 + d * 4 + h]; }
        const int t = 16 * w + fr;
        bf16x8 qf[2];
        qf[0] = *(const bf16x8*)(mlf + (size_t)(row0 + t) * 512 + h * 64 + 8 * g);
        qf[1] = *(const bf16x8*)(mlf + (size_t)(row0 + t) * 512 + h * 64 + 32 + 8 * g);
        f32x4 S[4];
#pragma unroll
        for (int st = 0; st < 4; ++st) {
            const u16* kp = mlf + (size_t)(row0 + 16 * st + fr) * 512 + 256 + h * 64 + 8 * g;
            const bf16x8 k0 = *(const bf16x8*)kp, k1 = *(const bf16x8*)(kp + 32);
            S[st] = f32x4{0.f, 0.f, 0.f, 0.f};
            S[st] = __builtin_amdgcn_mfma_f32_16x16x32_bf16(k0, qf[0], S[st], 0, 0, 0);
            S[st] = __builtin_amdgcn_mfma_f32_16x16x32_bf16(k1, qf[1], S[st], 0, 0, 0);
        }
        __syncthreads();
        f32x4 hs[4];
#pragma unroll
        for (int i = 0; i < 4; ++i) hs[i] = f32x4{0.f, 0.f, 0.f, 0.f};
#pragma unroll 1
        for (int d = 0; d < 2; ++d) {
            const int bhd = (b * 4 + h) * 2 + d;
            const float m0 = mst[bhd * NTC + tc];
            const float bt = btl[d * 64 + t];
            float ld[16]; float mx = -3.0e38f;
#pragma unroll
            for (int st = 0; st < 4; ++st) {
                const float4 b4 = *(const float4*)(btl + d * 64 + 16 * st + 4 * g), l4 = *(const float4*)(lil + d * 64 + 16 * st + 4 * g);
                const float bs[4] = {b4.x, b4.y, b4.z, b4.w}, ls[4] = {l4.x, l4.y, l4.z, l4.w};
#pragma unroll
                for (int r = 0; r < 4; ++r) {
                    const int s = 16 * st + 4 * g + r;
                    const bool ok = d ? (s >= t) : (s <= t);
                    ld[4 * st + r] = ok ? (bt - bs[r] + ls[r]) : -3.0e38f;
                    mx = fmaxf(mx, ld[4 * st + r]);
                }
            }
            mx = fmaxf(mx, __shfl_xor(mx, 16)); mx = fmaxf(mx, __shfl_xor(mx, 32));
            const float mt = fmaxf(bt + m0, mx);
            float rsum = 0.f; float dw[16];
#pragma unroll
            for (int i = 0; i < 16; ++i) { dw[i] = (ld[i] > -1.0e38f) ? __expf(ld[i] - mt) * S[i >> 2][i & 3] : 0.f; rsum += dw[i]; }
            rsum += __shfl_xor(rsum, 16); rsum += __shfl_xor(rsum, 32);
            const float inter = __expf(bt + m0 - mt);
            float qn = 0.f;
#pragma unroll
            for (int j = 0; j < 8; ++j) {
                qn += bf2f((u16)qf[0][j]) * nl[d * 64 + 8 * g + j] + bf2f((u16)qf[1][j]) * nl[d * 64 + 32 + 8 * g + j];
            }
            qn += __shfl_xor(qn, 16); qn += __shfl_xor(qn, 32);
            const float den = rsum + inter * qn;
            const float dn = 1.f / fmaxf(fabsf(den), __expf(-mt));
            union { u32x4 u; bf16x8 f; } pf[2];
#pragma unroll
            for (int ks = 0; ks < 2; ++ks) pf[ks].u = u32x4{pk2bf(dw[8 * ks], dw[8 * ks + 1]), pk2bf(dw[8 * ks + 2], dw[8 * ks + 3]), pk2bf(dw[8 * ks + 4], dw[8 * ks + 5]), pk2bf(dw[8 * ks + 6], dw[8 * ks + 7])};
            const u16* cb = cst + ((size_t)bhd * NTC + tc) * 4096;
#pragma unroll
            for (int dvt = 0; dvt < 4; ++dvt) {
                f32x4 num = f32x4{0.f, 0.f, 0.f, 0.f}, qc = f32x4{0.f, 0.f, 0.f, 0.f};
#pragma unroll
                for (int ks = 0; ks < 2; ++ks) {
                    const uint2 lo = *(const uint2*)(vt + (16 * dvt + fr) * 72 + 32 * ks + 4 * g), hi = *(const uint2*)(vt + (16 * dvt + fr) * 72 + 32 * ks + 16 + 4 * g);
                    union { u32x4 u; bf16x8 f; } vf; vf.u = u32x4{lo.x, lo.y, hi.x, hi.y};
                    num = __builtin_amdgcn_mfma_f32_16x16x32_bf16(vf.f, pf[ks].f, num, 0, 0, 0);
                    const bf16x8 cf = *(const bf16x8*)(cb + (16 * dvt + fr) * 64 + 32 * ks + 8 * g);
                    qc = __builtin_amdgcn_mfma_f32_16x16x32_bf16(cf, qf[ks], qc, 0, 0, 0);
                }
#pragma unroll
                for (int r = 0; r < 4; ++r) hs[dvt][r] += (num[r] + inter * qc[r]) * dn;
            }
        }
        float s1 = 0.f;
#pragma unroll
        for (int i = 0; i < 4; ++i) s1 += hs[i][0] + hs[i][1] + hs[i][2] + hs[i][3];
        s1 += __shfl_xor(s1, 16); s1 += __shfl_xor(s1, 32);
        const float mu = s1 * (1.f / 64.f);
        float s2 = 0.f;
#pragma unroll
        for (int i = 0; i < 4; ++i)
#pragma unroll
            for (int r = 0; r < 4; ++r) { const float dl = hs[i][r] - mu; s2 += dl * dl; }
        s2 += __shfl_xor(s2, 16); s2 += __shfl_xor(s2, 32);
        const float rstd = rsqrtf(s2 * (1.f / 64.f) + 1e-6f);
        const int row = row0 + t;
#pragma unroll
        for (int dvt = 0; dvt < 4; ++dvt) {
            const int cc = h * 64 + 16 * dvt + 4 * g;
            const uint2 ov = *(const uint2*)(pc + (size_t)row * 1040 + 768 + cc);
            const float4 nw = *(const float4*)(p.ml_nw + l * 256 + cc);
            const float o0 = bf2f((u16)(ov.x & 0xFFFF)), o1 = bf2f((u16)(ov.x >> 16)), o2 = bf2f((u16)(ov.y & 0xFFFF)), o3 = bf2f((u16)(ov.y >> 16));
            uint2 out;
            out.x = pk2bf((hs[dvt][0] - mu) * rstd * nw.x * sigmoidf_(o0), (hs[dvt][1] - mu) * rstd * nw.y * sigmoidf_(o1));
            out.y = pk2bf((hs[dvt][2] - mu) * rstd * nw.z * sigmoidf_(o2), (hs[dvt][3] - mu) * rstd * nw.w * sigmoidf_(o3));
            *(uint2*)(y + (size_t)row * 1024 + 768 + cc) = out;
        }
    }
}

DEVINL void ph_outproj(const P& p, int l, char* smem) {
    const int TIDX_ = tid_(); const int BIDX_ = bid_(); char* const WS_ = wsl_(p.ws); (void)TIDX_; (void)BIDX_; (void)WS_;
    const u16* y = (const u16*)(WS_ + OFF_Y);
    const u16* wout = (const u16*)(WS_ + OFF_WOUT);
    const float* modv = (const float*)(WS_ + OFF_MOD) + (size_t)l * 3 * 6144;
    const float* x2c = (const float*)(WS_ + OFF_X2CTX);
    float* x1 = (float*)(WS_ + OFF_X1);
    const int mt0 = (l == 0) ? 0 : 4;
    const int ntile = (260 - mt0) * 8;
    XCD_WALK(ntile, BIDX_, (int)gridDim.x);
    for (int u = xw_lo; u < xw_hi; u += xw_st) {
        const int mt = mt0 + u / 8, nt = u % 8;
        const u16* A = y + (size_t)mt * 128 * 1024;
        const int R0 = mt * 128;
        const float* xin;
        if (l == 0) xin = R0 < CTXROWS ? p.ctx + (size_t)R0 * 1024 : p.x + (size_t)(R0 - CTXROWS) * 1024;
        else xin = R0 < CTXROWS ? x2c + (size_t)R0 * 1024 : p.out + (size_t)(R0 - CTXROWS) * 1024;
        const float* g1 = modv + row_sel(R0) * 6144 + 2048;
        f32x4 acc[4][4];
        gemm128_acc([&](int r) { return A + (size_t)r * 1024; }, wout + (size_t)nt * 128 * 1024, 1024, 1024, smem, acc);
        stage_tile_f32(acc, smem, [&](int row, int c4, float4 a) {
            const int N = nt * 128 + c4;
            const float4 gg = *(const float4*)(g1 + N);
            const float4 xv = *(const float4*)(xin + (size_t)row * 1024 + N);
            float4 o;
            o.x = ALPHA * xv.x + gg.x * a.x; o.y = ALPHA * xv.y + gg.y * a.y; o.z = ALPHA * xv.z + gg.z * a.z; o.w = ALPHA * xv.w + gg.w * a.w;
            *(float4*)(x1 + (size_t)(R0 + row) * 1024 + N) = o;
        });
    }
}

DEVINL void ph_ln1(const P& p, int l) {
    const int TIDX_ = tid_(); const int BIDX_ = bid_(); char* const WS_ = wsl_(p.ws); (void)TIDX_; (void)BIDX_; (void)WS_;
    const int lane = TIDX_ & 63, wid = TIDX_ >> 6;
    const float* modv = (const float*)(WS_ + OFF_MOD) + (size_t)l * 3 * 6144;
    float* x1 = (float*)(WS_ + OFF_X1);
    u16* hm = (u16*)(WS_ + OFF_HM);
    const int rstart = (l == 0) ? 0 : CTXROWS;
    const int rstride = (int)gridDim.x * 4;
#pragma unroll 1
    for (int row0 = rstart + BIDX_ * 4 + wid; row0 < T; row0 += 2 * rstride) {
        int rowv[2]; rowv[0] = row0; rowv[1] = row0 + rstride;
        const bool has1 = rowv[1] < T;
        if (!has1) rowv[1] = row0;
        float4 v[2][4];
        float s[2] = {0.f, 0.f};
#pragma unroll
        for (int r = 0; r < 2; ++r)
#pragma unroll
            for (int i = 0; i < 4; ++i) { v[r][i] = *(const float4*)(x1 + (size_t)rowv[r] * 1024 + i * 256 + lane * 4); s[r] += v[r][i].x + v[r][i].y + v[r][i].z + v[r][i].w; }
#pragma unroll
        for (int r = 0; r < 2; ++r) {
            if (r == 1 && !has1) break;
            const int row = rowv[r];
            const float mu = wsum(s[r]) * (1.f / 1024.f);
            float q = 0.f;
#pragma unroll
            for (int i = 0; i < 4; ++i) { v[r][i].x -= mu; v[r][i].y -= mu; v[r][i].z -= mu; v[r][i].w -= mu; q += v[r][i].x * v[r][i].x + v[r][i].y * v[r][i].y + v[r][i].z * v[r][i].z + v[r][i].w * v[r][i].w; }
            const float rstd = rsqrtf(wsum(q) * (1.f / 1024.f) + 1e-5f);
            const float* mv = modv + row_sel(row) * 6144;
#pragma unroll
            for (int i = 0; i < 4; ++i) {
                const int c = i * 256 + lane * 4;
                const float4 g = *(const float4*)(p.ln1g + l * 1024 + c), bb = *(const float4*)(p.ln1b + l * 1024 + c);
                const float4 sh = *(const float4*)(mv + 3072 + c), sc = *(const float4*)(mv + 4096 + c);
                float4 o;
                o.x = v[r][i].x * rstd * g.x + bb.x; o.y = v[r][i].y * rstd * g.y + bb.y; o.z = v[r][i].z * rstd * g.z + bb.z; o.w = v[r][i].w * rstd * g.w + bb.w;
                *(float4*)(x1 + (size_t)row * 1024 + c) = o;
                uint2 hh;
                hh.x = (unsigned)f2bf(o.x * (1.f + sc.x) + sh.x) | ((unsigned)f2bf(o.y * (1.f + sc.y) + sh.y) << 16);
                hh.y = (unsigned)f2bf(o.z * (1.f + sc.z) + sh.z) | ((unsigned)f2bf(o.w * (1.f + sc.w) + sh.w) << 16);
                *(uint2*)(hm + (size_t)row * 1024 + c) = hh;
            }
        }
    }
}

DEVINL void ph_router(const P& p, int l, char* smem) {
    const int TIDX_ = tid_(); const int BIDX_ = bid_(); char* const WS_ = wsl_(p.ws); (void)TIDX_; (void)BIDX_; (void)WS_;
    const u16* hm = (const u16*)(WS_ + OFF_HM);
    const u16* wr = (const u16*)(WS_ + OFF_WR) + (size_t)l * 128 * 1024;
    float* lg = (float*)(WS_ + OFF_LOGITS);
    const int mt0 = (l == 0) ? 0 : 4;
    for (int u = BIDX_; u < 260 - mt0; u += gridDim.x) {
        const int mt = mt0 + u;
        const u16* A = hm + (size_t)mt * 128 * 1024;
        gemm128([&](int r) { return A + (size_t)r * 1024; }, wr, 1024, 1024, smem,
                [&](int m, int n, f32x4 a) {
                    if (n < 36) {
#pragma unroll
                        for (int j = 0; j < 4; ++j) lg[(size_t)(mt * 128 + m + j) * 64 + n] = a[j];
                    }
                });
    }
}

DEVINL void ph_route1(const P& p, int l, char* smem) {
    const int TIDX_ = tid_(); const int BIDX_ = bid_(); char* const WS_ = wsl_(p.ws); (void)TIDX_; (void)BIDX_; (void)WS_;
    const int tid = TIDX_;
    const float* lg = (const float*)(WS_ + OFF_LOGITS);
    int* toke = (int*)(WS_ + OFF_TOKE); float* tokw = (float*)(WS_ + OFF_TOKW);
    int* cnt = (int*)(WS_ + CTL_CNT) + l * 32;
    int* hist = (int*)smem;
    __syncthreads();
    if (tid < 32) hist[tid] = 0;
    __syncthreads();
    const int rstart = (l == 0) ? 0 : CTXROWS;
    for (int row = rstart + BIDX_ * 256 + tid; row < T; row += gridDim.x * 256) {
        const float* q = lg + (size_t)row * 64;
        float gl[4]; int gs = 0; float gm = -3.0e38f;
#pragma unroll
        for (int i = 0; i < 4; ++i) { gl[i] = q[i] + p.rgb[l * 4 + i]; if (gl[i] > gm) { gm = gl[i]; gs = i; } }
        float se = 0.f;
#pragma unroll
        for (int i = 0; i < 4; ++i) se += expf(gl[i] - gm);
        const float gw = 1.f / se;
        float v1 = -3.0e38f, v2 = -3.0e38f; int i1 = 0, i2 = 0;
#pragma unroll
        for (int i = 0; i < 8; ++i) {
            const float e = q[4 + gs * 8 + i] + p.reb[l * 32 + gs * 8 + i];
            if (e > v1) { v2 = v1; i2 = i1; v1 = e; i1 = i; }
            else if (e > v2) { v2 = e; i2 = i; }
        }
        const float e2 = expf(v2 - v1);
        const float w1 = gw / (1.f + e2), w2 = gw * e2 / (1.f + e2);
        const int ea = gs * 8 + i1, eb = gs * 8 + i2;
        toke[row * 2] = ea; toke[row * 2 + 1] = eb; tokw[row * 2] = w1; tokw[row * 2 + 1] = w2;
        atomicAdd(&hist[ea], 1); atomicAdd(&hist[eb], 1);
    }
    __syncthreads();
    if (tid < 32 && hist[tid] > 0) atomicAdd(&cnt[tid], hist[tid]);
}

DEVINL void ph_route2(const P& p, int l, char* smem) {
    const int TIDX_ = tid_(); const int BIDX_ = bid_(); char* const WS_ = wsl_(p.ws); (void)TIDX_; (void)BIDX_; (void)WS_;
    const int tid = TIDX_;
    const int* toke = (const int*)(WS_ + OFF_TOKE);
    int* toks = (int*)(WS_ + OFF_TOKS);
    int* slottok = (int*)(WS_ + OFF_SLOTTOK);
    const int* cnt = (const int*)(WS_ + CTL_CNT) + l * 32;
    int* cur = (int*)(WS_ + CTL_CUR) + l * 32;
    int* tiles = (int*)(WS_ + OFF_TILES);
    int* off = (int*)smem;
    int* hist = off + 64;
    int* base = hist + 32;
    __syncthreads();
    if (tid == 0) { int a = 0; for (int e = 0; e < 32; ++e) { off[e] = a; a += (cnt[e] + 127) & ~127; } off[32] = a; }
    if (tid < 32) hist[tid] = 0;
    __syncthreads();
    if (BIDX_ == 0) {
        if (tid == 0) {
            int nt = 0;
#pragma clang loop vectorize(disable) unroll(disable)
            for (int e = 0; e < 32; ++e) {
#pragma clang loop vectorize(disable) unroll(disable)
                for (int s = off[e]; s < off[e + 1]; s += 128) { tiles[64 + nt * 2] = e; tiles[64 + nt * 2 + 1] = s; ++nt; }
            }
            tiles[40] = nt;
        }
#pragma clang loop vectorize(disable) unroll(disable)
        for (int e = 0; e < 32; ++e) {
#pragma clang loop vectorize(disable) unroll(disable)
            for (int s = off[e] + cnt[e] + tid; s < off[e + 1]; s += 256) slottok[s] = (l == 0) ? 0 : CTXROWS;
        }
    }
    const int rstart = (l == 0) ? 0 : CTXROWS;
    for (int a0 = rstart * 2 + BIDX_ * 256; a0 < T * 2; a0 += gridDim.x * 256) {
        const int a = a0 + tid;
        int e = -1, lpos = 0;
        if (a < T * 2) { e = toke[a]; lpos = atomicAdd(&hist[e], 1); }
        __syncthreads();
        if (tid < 32) { base[tid] = hist[tid] > 0 ? atomicAdd(&cur[tid], hist[tid]) : 0; }
        __syncthreads();
        if (e >= 0) { const int s = off[e] + base[e] + lpos; toks[a] = s; slottok[s] = a >> 1; }
        __syncthreads();
        if (tid < 32) hist[tid] = 0;
        __syncthreads();
    }
}

DEVINL void ph_gateup(const P& p, char* smem) {
    const int TIDX_ = tid_(); const int BIDX_ = bid_(); char* const WS_ = wsl_(p.ws); (void)TIDX_; (void)BIDX_; (void)WS_;
    const int tid = TIDX_, lane = tid & 63, wid = tid >> 6, wr = wid >> 1, wc = wid & 1, fr = lane & 15, fq = lane >> 4;
    const u16* hm = (const u16*)(WS_ + OFF_HM);
    const u16* wgu = (const u16*)(WS_ + OFF_WGU);
    const int* tiles = (const int*)(WS_ + OFF_TILES);
    const int* slottok = (const int*)(WS_ + OFF_SLOTTOK);
    u16* act = (u16*)(WS_ + OFF_ACT);
    const int ntile = tiles[40] * 8;
    XCD_WALK(ntile, BIDX_, (int)gridDim.x);
    for (int u = xw_lo; u < xw_hi; u += xw_st) {
        const int ti = u >> 3, nt = u & 7;
        const int e = tiles[64 + ti * 2], s0 = tiles[64 + ti * 2 + 1];
        f32x4 acc[4][4];
        gemm128_acc([&](int r) { return hm + (size_t)slottok[s0 + r] * 1024; }, wgu + ((size_t)e * 1024 + nt * 128) * 1024, 1024, 1024, smem, acc);
        {
            u16* t = (u16*)smem;
            __syncthreads();
#pragma unroll
            for (int m = 0; m < 4; ++m)
#pragma unroll
                for (int n = 0; n < 4; n += 2) {
                    const int jc = (wc * 64 + n * 16) / 2 + fr;
                    const int r0 = wr * 64 + m * 16 + fq * 4;
                    float av[4];
#pragma unroll
                    for (int j = 0; j < 4; ++j) { const float gte = acc[m][n][j], up = acc[m][n + 1][j]; av[j] = gte / (1.f + __expf(-gte)) * up; }
                    const unsigned p01 = pk2bf(av[0], av[1]), p23 = pk2bf(av[2], av[3]);
                    t[(r0 + 0) * 72 + jc] = (u16)(p01 & 0xFFFFu); t[(r0 + 1) * 72 + jc] = (u16)(p01 >> 16);
                    t[(r0 + 2) * 72 + jc] = (u16)(p23 & 0xFFFFu); t[(r0 + 3) * 72 + jc] = (u16)(p23 >> 16);
                }
            __syncthreads();
#pragma unroll
            for (int i = 0; i < 4; ++i) {
                const int ci = tid + 256 * i, row = ci >> 3, c8 = (ci & 7) * 8;
                *(uint4*)(act + (size_t)(s0 + row) * 512 + nt * 64 + c8) = *(const uint4*)(t + row * 72 + c8);
            }
        }
    }
}

DEVINL void ph_down(const P& p, char* smem) {
    const int TIDX_ = tid_(); const int BIDX_ = bid_(); char* const WS_ = wsl_(p.ws); (void)TIDX_; (void)BIDX_; (void)WS_;
    const u16* act = (const u16*)(WS_ + OFF_ACT);
    const u16* wdn = (const u16*)(WS_ + OFF_WDN);
    const int* tiles = (const int*)(WS_ + OFF_TILES);
    u16* so = (u16*)(WS_ + OFF_SLOTOUT);
    const int ntile = tiles[40] * 8;
    XCD_WALK(ntile, BIDX_, (int)gridDim.x);
    for (int u = xw_lo; u < xw_hi; u += xw_st) {
        const int ti = u >> 3, nt = u & 7;
        const int e = tiles[64 + ti * 2], s0 = tiles[64 + ti * 2 + 1];
        const u16* A = act + (size_t)s0 * 512;
        f32x4 acc[4][4];
        gemm128_acc([&](int r) { return A + (size_t)r * 512; }, wdn + ((size_t)e * 1024 + nt * 128) * 512, 512, 512, smem, acc);
        stage_tile_bf16(acc, smem, [&](int row, int c8, uint4 v) { *(uint4*)(so + (size_t)(s0 + row) * 1024 + nt * 128 + c8) = v; });
    }
}

DEVINL void ph_ln2(const P& p, int l) {
    const int TIDX_ = tid_(); const int BIDX_ = bid_(); char* const WS_ = wsl_(p.ws); (void)TIDX_; (void)BIDX_; (void)WS_;
    const int lane = TIDX_ & 63, wid = TIDX_ >> 6;
    const float* modv = (const float*)(WS_ + OFF_MOD) + (size_t)l * 3 * 6144;
    const float* modn = (const float*)(WS_ + OFF_MOD) + (size_t)(l + 1) * 3 * 6144;
    const float* x1 = (const float*)(WS_ + OFF_X1);
    const u16* so = (const u16*)(WS_ + OFF_SLOTOUT);
    const int* toks = (const int*)(WS_ + OFF_TOKS);
    const float* tokw = (const float*)(WS_ + OFF_TOKW);
    float* x2c = (float*)(WS_ + OFF_X2CTX);
    u16* hm = (u16*)(WS_ + OFF_HM);
    const int rstart = (l == 0) ? 0 : CTXROWS;
    const int rstride = (int)gridDim.x * 4;
#pragma unroll 1
    for (int row0 = rstart + BIDX_ * 4 + wid; row0 < T; row0 += 2 * rstride) {
        int rowv[2]; rowv[0] = row0; rowv[1] = row0 + rstride;
        const bool has1 = rowv[1] < T;
        if (!has1) rowv[1] = row0;
        int sa[2], sb[2]; float wa[2], wb[2];
#pragma unroll
        for (int r = 0; r < 2; ++r) { sa[r] = toks[rowv[r] * 2]; sb[r] = toks[rowv[r] * 2 + 1]; wa[r] = tokw[rowv[r] * 2]; wb[r] = tokw[rowv[r] * 2 + 1]; }
        float4 v[2][4];
        float s[2] = {0.f, 0.f};
#pragma unroll
        for (int r = 0; r < 2; ++r) {
            const float* mv = modv + row_sel(rowv[r]) * 6144;
#pragma unroll
            for (int i = 0; i < 4; ++i) {
                const int c = i * 256 + lane * 4;
                const float4 xv = *(const float4*)(x1 + (size_t)rowv[r] * 1024 + c);
                const uint2 ua = *(const uint2*)(so + (size_t)sa[r] * 1024 + c), ub = *(const uint2*)(so + (size_t)sb[r] * 1024 + c);
                const float4 g2 = *(const float4*)(mv + 5120 + c);
                const float f0 = wa[r] * bf2f((u16)(ua.x & 0xFFFF)) + wb[r] * bf2f((u16)(ub.x & 0xFFFF));
                const float f1 = wa[r] * bf2f((u16)(ua.x >> 16)) + wb[r] * bf2f((u16)(ub.x >> 16));
                const float f2 = wa[r] * bf2f((u16)(ua.y & 0xFFFF)) + wb[r] * bf2f((u16)(ub.y & 0xFFFF));
                const float f3 = wa[r] * bf2f((u16)(ua.y >> 16)) + wb[r] * bf2f((u16)(ub.y >> 16));
                v[r][i].x = ALPHA * xv.x + g2.x * f0; v[r][i].y = ALPHA * xv.y + g2.y * f1; v[r][i].z = ALPHA * xv.z + g2.z * f2; v[r][i].w = ALPHA * xv.w + g2.w * f3;
                s[r] += v[r][i].x + v[r][i].y + v[r][i].z + v[r][i].w;
            }
        }
#pragma unroll
        for (int r = 0; r < 2; ++r) {
            if (r == 1 && !has1) break;
            const int row = rowv[r];
            const float mu = wsum(s[r]) * (1.f / 1024.f);
            float q = 0.f;
#pragma unroll
            for (int i = 0; i < 4; ++i) { v[r][i].x -= mu; v[r][i].y -= mu; v[r][i].z -= mu; v[r][i].w -= mu; q += v[r][i].x * v[r][i].x + v[r][i].y * v[r][i].y + v[r][i].z * v[r][i].z + v[r][i].w * v[r][i].w; }
            const float rstd = rsqrtf(wsum(q) * (1.f / 1024.f) + 1e-5f);
            float* dst = row < CTXROWS ? x2c + (size_t)row * 1024 : p.out + (size_t)(row - CTXROWS) * 1024;
            const float* mn = modn + row_sel(row) * 6144;
#pragma unroll
            for (int i = 0; i < 4; ++i) {
                const int c = i * 256 + lane * 4;
                const float4 g = *(const float4*)(p.ln2g + l * 1024 + c), bb = *(const float4*)(p.ln2b + l * 1024 + c);
                float4 o;
                o.x = v[r][i].x * rstd * g.x + bb.x; o.y = v[r][i].y * rstd * g.y + bb.y; o.z = v[r][i].z * rstd * g.z + bb.z; o.w = v[r][i].w * rstd * g.w + bb.w;
                *(float4*)(dst + c) = o;
                if (l == 0) {
                    const float4 sh = *(const float4*)(mn + c), sc = *(const float4*)(mn + 1024 + c);
                    uint2 hh;
                    hh.x = (unsigned)f2bf(o.x * (1.f + sc.x) + sh.x) | ((unsigned)f2bf(o.y * (1.f + sc.y) + sh.y) << 16);
                    hh.y = (unsigned)f2bf(o.z * (1.f + sc.z) + sh.z) | ((unsigned)f2bf(o.w * (1.f + sc.w) + sh.w) << 16);
                    *(uint2*)(hm + (size_t)row * 1024 + c) = hh;
                }
            }
        }
    }
}

DEVINL void gbar(XcdBarrier b) {
    unsigned x = b.x; GAS unsigned* q = (GAS unsigned*)b.bar;
    asm volatile("" : "+s"(x), "+s"(q));
    b.x = x; b.bar = (unsigned*)q;
    xcd_barrier(b);
}
#ifndef PROBE
#define PROBE 0
#endif
#ifndef TPROBE
#define TPROBE 0
#endif
__global__ void __launch_bounds__(256, 2) k_mega(P p) {
    __shared__ __attribute__((aligned(16))) char smem[SMEM_BYTES];
    if (threadIdx.x == 0) *(uint4*)(smem + SMEM_BYTES - 16) = make_uint4(0u, 0u, 0u, 0u);
    __syncthreads();
    XcdBarrier bar = xcd_barrier_post((unsigned*)p.ws, (volatile LAS unsigned*)(smem + SMEM_BYTES - 16));
    const int bid = blockIdx.x, nb = gridDim.x;
#if TPROBE
    unsigned long long tp_acc = 0, tp_last = wall_clock64();
#define TP(g) do { const unsigned long long _n = wall_clock64(); if ((g) == TPROBE) tp_acc += _n - tp_last; tp_last = _n; } while (0)
#else
#define TP(g) do { } while (0)
#endif
    if (threadIdx.x == 0) {
        const unsigned key = ((unsigned)__builtin_amdgcn_s_getreg((3 << 11) | 20) << 8) | ((unsigned)__builtin_amdgcn_s_getreg((7 << 11) | (8 << 6) | 4) & 0xFFu);
        ((unsigned*)(p.ws + CTL_CUKEY))[blockIdx.x] = key | 0x80000000u;
    }
    ph_prolog(p, smem);
    ph_convw(p, 0, smem);
    gbar(bar);
    TP(1);
    ph_xm0(p);
    gbar(bar);
    TP(1);
    constexpr int NSCAN = 16;
    bool quiet; int wrank, nwork, mate_of = -1;
    {
        const unsigned* keys = (const unsigned*)(p.ws + CTL_CUKEY);
        int* cnt = (int*)smem;
        if (threadIdx.x < 2) cnt[threadIdx.x] = 0;
        __syncthreads();
        for (int i = NSCAN + threadIdx.x; i < nb; i += 256) {
            const unsigned k = keys[i];
            bool qq = false;
            for (int j = 0; j < NSCAN && j < nb; ++j) qq = qq || (keys[j] == k);
            if (qq) { atomicAdd(&cnt[1], 1); if (i < bid) atomicAdd(&cnt[0], 1); }
        }
        __syncthreads();
        const int below = cnt[0], total = cnt[1];
        bool me = false;
        if (bid >= NSCAN) { const unsigned k = keys[bid]; for (int j = NSCAN - 1; j >= 0; --j) if (j < nb && keys[j] == k) { me = true; mate_of = j; } }
        __syncthreads();
        if (total > 2 * NSCAN) { quiet = false; wrank = bid - NSCAN; nwork = nb - NSCAN; mate_of = -1; }
        else { quiet = me; wrank = bid - NSCAN - below; nwork = nb - NSCAN - total; }
    }
#pragma unroll 1
    for (int l = 0; l < NLAYER; ++l) {
        ph_inproj(p, smem);
        gbar(bar);
    TP(2);
        ph_rwprep(p, l, 0, smem, bid, nb);
        ph_prepM(p, l, smem, nb - 1 - bid, nb);
        gbar(bar);
    TP(3);
        if (bid < NSCAN) ph_rwscan(p, l, 0, bid, NSCAN, smem);
        else if (!quiet) { if (nwork > 128) { if (wrank < 64) ph_mlB(p, wrank, 64, smem); else ph_na(p, l, smem, wrank - 64, nwork - 64); } else { ph_mlB(p, wrank, nwork, smem); ph_na(p, l, smem, wrank, nwork); } }
        gbar(bar);
    TP(4);
        ph_rwprep(p, l, 1, smem, bid, nb);
        gbar(bar);
    TP(5);
        if (bid < NSCAN) ph_rwscan(p, l, 1, bid, NSCAN, smem);
        else if (!quiet) { ph_mlC(p, l, smem, wrank, nwork); ph_convexp(p, l, smem, wrank, nwork); }
        gbar(bar);
    TP(6);
        ph_rwout(p, l);
        gbar(bar);
    TP(7);
        ph_outproj(p, l, smem);
        gbar(bar);
    TP(8);
        ph_ln1(p, l);
        gbar(bar);
    TP(9);
        ph_router(p, l, smem);
        gbar(bar);
    TP(9);
        ph_route1(p, l, smem);
        gbar(bar);
    TP(9);
        ph_route2(p, l, smem);
        gbar(bar);
    TP(9);
        ph_gateup(p, smem);
        gbar(bar);
    TP(10);
        ph_down(p, smem);
        gbar(bar);
    TP(11);
        ph_ln2(p, l);
        if (l + 1 < NLAYER) ph_convw(p, l + 1, smem);
        gbar(bar);
    TP(12);
    }
#if TPROBE
    if (bid == 0 && threadIdx.x == 0) { const unsigned long long t_end = wall_clock64() + tp_acc; while (wall_clock64() < t_end) __builtin_amdgcn_s_sleep(8); }
    __syncthreads();
    gbar(bar);
#endif
}


extern "C" void kernel_launch(void* const* d_in, const int* in_sizes, int n_in, void* d_out, int out_size, void* d_ws, size_t ws_size,
                              hipStream_t stream) {
    if (n_in != 37 || ws_size < WS_NEED) { fprintf(stderr, "kernel_launch: n_in %d ws %zu need %zu\n", n_in, ws_size, (size_t)WS_NEED); return; }
    static int grid = 0;
    if (!grid) {
        int dev = 0, cus = 0, per_cu = 0;
        (void)hipGetDevice(&dev);
        (void)hipDeviceGetAttribute(&cus, hipDeviceAttributeMultiprocessorCount, dev);
        (void)hipOccupancyMaxActiveBlocksPerMultiprocessor(&per_cu, (const void*)k_mega, 256, 0);
        if (per_cu < 1) per_cu = 1;
        grid = cus * (per_cu < 2 ? per_cu : 2);
    }
    P p{};
    const float** pp = (const float**)&p;
    for (int i = 0; i < 37; ++i) pp[i] = (const float*)d_in[i];
    p.out = (float*)d_out; p.ws = (char*)d_ws;
    (void)hipMemsetAsync(d_ws, 0, CTL_BYTES, stream);
    k_mega<<<dim3(grid), dim3(256), 0, stream>>>(p);
}
```

```cpp
#include <hip/hip_runtime.h>
#include <hip/hip_bf16.h>
#include <stdint.h>
#include <stdio.h>
#include <type_traits>

#define DEVINL __device__ __forceinline__
typedef unsigned short u16;
using bf16x8 = __attribute__((ext_vector_type(8))) short;
using f32x4 = __attribute__((ext_vector_type(4))) float;

constexpr int D = 1024, LAT = 16384, LCTX = 256, T = 33280, CTXROWS = 512;
constexpr int INP = 3536;
constexpr int NLAYER = 2;
constexpr float ALPHA = 1.41421356237309515f;
constexpr int NUNIT_CH = 520;
constexpr int NTC = 260;
constexpr int MAXSLOT = 70656;
constexpr int SMEM_BYTES = 81920;

constexpr size_t al(size_t x) { return (x + 255) & ~(size_t)255; }
constexpr size_t CTL_CNT = 16384;
constexpr size_t CTL_CUR = CTL_CNT + 256;
constexpr size_t CTL_CUKEY = 20480;
constexpr size_t CTL_PROG = 24576;
constexpr size_t CTL_BYTES = 32768;
constexpr size_t OFF_MOD = CTL_BYTES;
constexpr size_t OFF_ROPE = OFF_MOD + al(2 * 3 * 6144 * 4);
constexpr size_t OFF_WR = OFF_ROPE + al(10240 * 4);
constexpr size_t OFF_LORA = OFF_WR + al(2 * 128 * 1024 * 2);
constexpr size_t OFF_TILES = OFF_LORA + al(3 * 65536);
constexpr size_t OFF_TOKE = OFF_TILES + al((64 + 2048) * 4);
constexpr size_t OFF_TOKW = OFF_TOKE + al((size_t)T * 2 * 4);
constexpr size_t OFF_TOKS = OFF_TOKW + al((size_t)T * 2 * 4);
constexpr size_t OFF_SLOTTOK = OFF_TOKS + al((size_t)T * 2 * 4);
constexpr size_t OFF_X2CTX = OFF_SLOTTOK + al((size_t)MAXSLOT * 4);
constexpr size_t OFF_ZST = OFF_X2CTX + al((size_t)512 * 1024 * 4);
constexpr size_t OFF_WIN = OFF_ZST + al((size_t)16 * 4 * 64 * 16 * 4);
constexpr size_t OFF_WOUT = OFF_WIN + al((size_t)3584 * 1024 * 2);
constexpr size_t OFF_X1 = OFF_WOUT + al((size_t)1024 * 1024 * 2);
constexpr size_t OFF_HM = OFF_X1 + al((size_t)T * 1024 * 4);
constexpr size_t OFF_P = OFF_HM + al((size_t)T * 1024 * 2);
constexpr size_t OFF_PQK = OFF_P;
constexpr size_t OFF_VTL = OFF_PQK + (size_t)T * 1024 * 2;
constexpr size_t OFF_VTC = OFF_VTL + (size_t)2 * 8 * 64 * 16384 * 2;
constexpr size_t OFF_PB = OFF_VTC + (size_t)2 * 8 * 64 * 256 * 2;
constexpr size_t OFF_PC = OFF_PB + (size_t)T * 960 * 2;
constexpr size_t OFF_Y = OFF_PC + (size_t)T * 1040 * 2;
constexpr size_t OFF_MLF = OFF_Y + (size_t)T * 1024 * 2;
constexpr size_t OFF_GATE = OFF_MLF + (size_t)T * 512 * 2;
constexpr size_t OFF_MLG = OFF_GATE + (size_t)T * 256 * 2;
constexpr size_t OFF_MLS = OFF_MLG + (size_t)T * 16 * 4;
constexpr size_t OFF_MST = OFF_MLS + al(16 * 260 * 2 * 4);
constexpr size_t OFF_NST = OFF_MST + al(16 * 260 * 4);
constexpr size_t OFF_CST2 = OFF_NST + al(16 * 260 * 64 * 4);
constexpr size_t OFF_NST2 = OFF_CST2 + (size_t)16 * 260 * 4096 * 2;
constexpr size_t OFF_END1 = OFF_NST2 + al(16 * 260 * 64 * 4);
constexpr size_t OFF_WGU = OFF_P;
constexpr size_t OFF_WDN = OFF_WGU + (size_t)32 * 1024 * 1024 * 2;
constexpr size_t OFF_ACT = OFF_WDN + (size_t)32 * 1024 * 512 * 2;
constexpr size_t OFF_SLOTOUT = OFF_ACT + (size_t)MAXSLOT * 512 * 2;
constexpr size_t OFF_LOGITS = OFF_SLOTOUT + (size_t)MAXSLOT * 1024 * 2;
constexpr size_t OFF_END2 = OFF_LOGITS + (size_t)T * 64 * 4;
constexpr size_t WS_NEED = OFF_END1 > OFF_END2 ? OFF_END1 : OFF_END2;
static_assert(OFF_WDN <= OFF_Y, "Wexp must not overlap y");
static_assert(OFF_LOGITS >= OFF_MLF, "logits placement");

struct P {
    const float *x, *c, *ctx, *c_ctx, *w_mod, *b_mod, *w_in, *na_rpb, *mu_prev, *mu_next, *rw_w0, *rw_w2, *rw_a0, *rw_a2,
        *rw_g2, *rw_kk, *rw_ka, *rw_rk, *rw_lnw, *rw_lnb, *ml_cw, *ml_cb, *ml_ib, *ml_fb, *ml_nw, *w_out, *ln1g, *ln1b,
        *rgw, *rgb, *rew, *reb, *egate, *eup, *edown, *ln2g, *ln2b;
    float* out;
    char* ws;
};

#define XB_TMO      128
#define XB_XCNT(j)  (256  + 64 * (j))
#define XB_XSUB(j)  (1280 + 64 * (j))
#define XB_XGEN(j)  (2304 + 64 * (j))
#define XB_TOP      3328
#define XB_TOPGEN   3392
#define XCD_BAR_WORDS 3456
#define XB_SPIN_CAP (1u << 18)
#define LAS __attribute__((address_space(3)))

__device__ __forceinline__ unsigned xb_ld(unsigned* p)              { return __hip_atomic_load(p, __ATOMIC_RELAXED, __HIP_MEMORY_SCOPE_AGENT); }
__device__ __forceinline__ unsigned xb_add(unsigned* p, unsigned v) { return __hip_atomic_fetch_add(p, v, __ATOMIC_RELAXED, __HIP_MEMORY_SCOPE_AGENT); }
__device__ __forceinline__ unsigned xb_xcc_id() { return (unsigned)__builtin_amdgcn_s_getreg((3 << 11) | 20) & 0xFu; }
#define XB_SPIN(cond, bar) do { unsigned _sp = 0; while (cond) { __builtin_amdgcn_s_sleep(1); \
    if ((++_sp & 255u) == 0u) { if (xb_ld(&(bar)[XB_TMO])) break; if (_sp > XB_SPIN_CAP) { atomicAdd(&(bar)[XB_TMO], 1u); break; } } } } while (0)

struct XcdBarrier {
    unsigned* bar; unsigned x;
    volatile LAS unsigned* st;
};

__device__ __forceinline__ XcdBarrier xcd_barrier_post(unsigned* bar, volatile LAS unsigned* st) {
    XcdBarrier b; b.bar = bar; b.x = xb_xcc_id(); b.st = st;
    if (threadIdx.x == 0) (void)xb_add(&bar[XB_XCNT(b.x)], 1u);
    return b;
}
__device__ __forceinline__ void xcd_barrier_complete(unsigned* bar, unsigned x, unsigned& nloc, unsigned& nx) {
    const unsigned G = gridDim.x * gridDim.y * gridDim.z;
    unsigned sum, cnt, mine, sp = 0u;
    for (;;) {
        sum = 0u; cnt = 0u; mine = 0u;
#pragma unroll
        for (unsigned j = 0; j < 16; ++j) { const unsigned c = xb_ld(&bar[XB_XCNT(j)]); sum += c; cnt += (c > 0u) ? 1u : 0u; mine = (j == x) ? c : mine; }
        if (sum == G) break;
        __builtin_amdgcn_s_sleep(1);
        if ((++sp & 255u) == 0u) { if (xb_ld(&bar[XB_TMO])) break; if (sp > XB_SPIN_CAP) { atomicAdd(&bar[XB_TMO], 1u); break; } }
    }
    nloc = mine > 0u ? mine : 1u; nx = cnt > 0u ? cnt : 1u;
}

__device__ __forceinline__ void xcd_barrier(const XcdBarrier& b) {
    asm volatile("s_waitcnt vmcnt(0)" ::: "memory");
    __syncthreads();
    if (threadIdx.x == 0) {
        unsigned* bar = b.bar;
        __builtin_amdgcn_s_waitcnt(0);
        unsigned nloc = b.st[0], nx = b.st[1];
        if (nloc == 0u) { xcd_barrier_complete(bar, b.x, nloc, nx); b.st[0] = nloc; b.st[1] = nx; }
        const unsigned old = xb_add(&bar[XB_XSUB(b.x)], 1u);
        const unsigned gen = old / nloc;
        if (old + 1u == (gen + 1u) * nloc) {
            __builtin_amdgcn_fence(__ATOMIC_RELEASE, "agent");
            asm volatile("s_waitcnt vmcnt(0)" ::: "memory");
            const unsigned og = xb_add(&bar[XB_TOP], 1u);
            const unsigned tg = og / nx;
            if (og + 1u == (tg + 1u) * nx) xb_add(&bar[XB_TOPGEN], 1u);
            else XB_SPIN(xb_ld(&bar[XB_TOPGEN]) == tg, bar);
            __builtin_amdgcn_fence(__ATOMIC_ACQUIRE, "agent");
            xb_add(&bar[XB_XGEN(b.x)], 1u);
            asm volatile("s_waitcnt vmcnt(0)" ::: "memory");
        } else {
            XB_SPIN(xb_ld(&bar[XB_XGEN(b.x)]) == gen, bar);
            __builtin_amdgcn_fence(__ATOMIC_ACQUIRE, "agent");
            asm volatile("s_waitcnt vmcnt(0)" ::: "memory");
        }
    }
    __syncthreads();
}


DEVINL int tid_() { int t = threadIdx.x; asm volatile("" : "+v"(t)); return t; }
DEVINL int bid_() { int b = blockIdx.x; asm volatile("" : "+s"(b)); return b; }
#define GAS __attribute__((address_space(1)))
DEVINL char* wsl_(char* w) { GAS char* g = (GAS char*)w; asm volatile("" : "+s"(g)); return (char*)g; }
template <class Tp> DEVINL const Tp* gl_(const Tp* q) { const GAS Tp* g = (const GAS Tp*)q; asm volatile("" : "+s"(g)); return (const Tp*)g; }
typedef float f32x2_t __attribute__((ext_vector_type(2)));
typedef __bf16 bf16x2_t __attribute__((ext_vector_type(2)));
DEVINL unsigned pk2bf(float lo, float hi) { f32x2_t f = {lo, hi}; bf16x2_t b = __builtin_convertvector(f, bf16x2_t); return __builtin_bit_cast(unsigned, b); }
DEVINL u16 f2bf(float f) { return (u16)(pk2bf(f, f) & 0xFFFFu); }
DEVINL float bf2f(u16 h) { return __uint_as_float(((unsigned)h) << 16); }
DEVINL float wsum(float v) { for (int o = 32; o > 0; o >>= 1) v += __shfl_xor(v, o); return v; }
DEVINL float sigmoidf_(float x) { return 1.f / (1.f + __expf(-x)); }
DEVINL float siluf_(float x) { return x / (1.f + __expf(-x)); }
DEVINL float softplusf_(float x) { return fmaxf(x, 0.f) + log1pf(__expf(-fabsf(x))); }
DEVINL int row_sel(int row) { return row < CTXROWS ? 2 : ((row - CTXROWS) >> 14); }
template <int CTRL, int RM>
DEVINL float dpp_f(float v) { return __int_as_float(__builtin_amdgcn_update_dpp(0, __float_as_int(v), CTRL, RM, 0xF, false)); }
DEVINL float wave_sum_dpp(float v) {
    v += dpp_f<0xB1, 0xF>(v);
    v += dpp_f<0x4E, 0xF>(v);
    v += dpp_f<0x141, 0xF>(v);
    v += dpp_f<0x140, 0xF>(v);
    v += dpp_f<0x142, 0xA>(v);
    v += dpp_f<0x143, 0xC>(v);
    return __int_as_float(__builtin_amdgcn_readlane(__float_as_int(v), 63));
}
DEVINL unsigned lds_addr(const void* p) { return (unsigned)(size_t)(const __attribute__((address_space(3))) char*)p; }
using u32x4 = __attribute__((ext_vector_type(4))) unsigned;
using u32x2 = __attribute__((ext_vector_type(2))) unsigned;
template <int OFF> DEVINL u32x4 lds_rd128(unsigned a) { u32x4 v; asm volatile("ds_read_b128 %0, %1 offset:%2" : "=v"(v) : "v"(a), "n"(OFF)); return v; }
template <int OFF> DEVINL u32x2 lds_rd64(unsigned a) { u32x2 v; asm volatile("ds_read_b64 %0, %1 offset:%2" : "=v"(v) : "v"(a), "n"(OFF)); return v; }
DEVINL void glds4(const void* g, void* l) {
    __builtin_amdgcn_global_load_lds((const __attribute__((address_space(1))) void*)g, (__attribute__((address_space(3))) void*)l, 4, 0, 0);
}
DEVINL void glds16nt(const void* g, void* l) {
    __builtin_amdgcn_global_load_lds((const __attribute__((address_space(1))) void*)g, (__attribute__((address_space(3))) void*)l, 16, 0, 2);
}
DEVINL void glds16(const void* g, void* l) {
    __builtin_amdgcn_global_load_lds((const __attribute__((address_space(1))) void*)g, (__attribute__((address_space(3))) void*)l, 16, 0, 0);
}

#define XCD_WALK(total_, bid_v, nb_v) \
    const bool xw_8 = (((nb_v) & 7) == 0); \
    const int xw_per = xw_8 ? (((((total_) + 7) >> 3) + 7) & ~7) : (total_); \
    const int xw_base = xw_8 ? ((bid_v) & 7) * xw_per : 0; \
    const int xw_lo = xw_base + (xw_8 ? ((bid_v) >> 3) : (bid_v)); \
    const int xw_hi = min((int)(total_), xw_base + xw_per); \
    const int xw_st = xw_8 ? ((nb_v) >> 3) : (nb_v)

template <class RowA>
DEVINL void gemm128_acc(RowA rowA, const u16* __restrict__ Bt, int ldb, int K, char* smem, f32x4 (&acc)[4][4]) {
    const int tid = tid_(), lane = tid & 63, wid = tid >> 6, wr = wid >> 1, wc = wid & 1, fr = lane & 15, fq = lane >> 4;
#pragma unroll
    for (int m = 0; m < 4; ++m)
#pragma unroll
        for (int n = 0; n < 4; ++n) acc[m][n] = f32x4{0.f, 0.f, 0.f, 0.f};
    const int sc = ((tid & 7) ^ ((tid >> 3) & 7)) * 8;
    const u16* aS[4]; const u16* bS[4];
#pragma unroll
    for (int i = 0; i < 4; ++i) { const int r = (tid >> 3) + 32 * i; aS[i] = rowA(r) + sc; bS[i] = Bt + (size_t)r * ldb + sc; }
    const int nt = K >> 6;
    const unsigned pos0 = (unsigned)((fq ^ (fr & 7)) * 16);
    const unsigned adA0 = lds_addr(smem) + (unsigned)((wr * 64 + fr) * 128) + pos0, adA1 = adA0 ^ 64u;
    const unsigned adB0 = lds_addr(smem) + 16384u + (unsigned)((wc * 64 + fr) * 128) + pos0, adB1 = adB0 ^ 64u;
    __syncthreads();
#pragma unroll
    for (int s = 0; s < 2; ++s)
#pragma unroll
        for (int i = 0; i < 4; ++i) { glds16(aS[i] + s * 64, smem + s * 32768 + (tid + 256 * i) * 16); glds16(bS[i] + s * 64, smem + s * 32768 + 16384 + (tid + 256 * i) * 16); }
#define GEMM_MM(A_, B_, m_, n_) acc[m_][n_] = __builtin_amdgcn_mfma_f32_16x16x32_bf16(__builtin_bit_cast(bf16x8, A_), __builtin_bit_cast(bf16x8, B_), acc[m_][n_], 0, 0, 0)
#define GEMM_STEP(s, t) do { \
        if ((t) + 1 < nt) asm volatile("s_waitcnt vmcnt(8)" ::: "memory"); else asm volatile("s_waitcnt vmcnt(0)" ::: "memory"); \
        __builtin_amdgcn_s_barrier(); \
        u32x4 b0_, b1_, b2_, b3_, a0_, a1_, a2_, a3_, d0_, d1_, d2_, d3_, c0_, c1_, c2_, c3_; \
        asm volatile( \
            "ds_read_b128 %0, %17 offset:%20\n\t" \
            "ds_read_b128 %1, %17 offset:%20+2048\n\t" \
            "ds_read_b128 %2, %17 offset:%20+4096\n\t" \
            "ds_read_b128 %3, %17 offset:%20+6144\n\t" \
            "ds_read_b128 %4, %16 offset:%20\n\t" \
            "ds_read_b128 %5, %16 offset:%20+2048\n\t" \
            "ds_read_b128 %6, %16 offset:%20+4096\n\t" \
            "ds_read_b128 %7, %16 offset:%20+6144\n\t" \
            "ds_read_b128 %8, %19 offset:%20\n\t" \
            "ds_read_b128 %9, %19 offset:%20+2048\n\t" \
            "ds_read_b128 %10, %19 offset:%20+4096\n\t" \
            "ds_read_b128 %11, %19 offset:%20+6144\n\t" \
            "ds_read_b128 %12, %18 offset:%20\n\t" \
            "ds_read_b128 %13, %18 offset:%20+2048\n\t" \
            "ds_read_b128 %14, %18 offset:%20+4096\n\t" \
            "ds_read_b128 %15, %18 offset:%20+6144\n\t" \
            "s_waitcnt lgkmcnt(0)" \
            : "=&v"(b0_), "=&v"(b1_), "=&v"(b2_), "=&v"(b3_), "=&v"(a0_), "=&v"(a1_), "=&v"(a2_), "=&v"(a3_), \
              "=&v"(d0_), "=&v"(d1_), "=&v"(d2_), "=&v"(d3_), "=&v"(c0_), "=&v"(c1_), "=&v"(c2_), "=&v"(c3_) \
            : "v"(adA0), "v"(adB0), "v"(adA1), "v"(adB1), "n"((s) * 32768) : "memory"); \
        __builtin_amdgcn_s_barrier(); \
        if ((t) + 2 < nt) { \
            char* SA_ = smem + (s) * 32768; const int ko_ = ((t) + 2) * 64; \
            _Pragma("unroll") for (int i = 0; i < 4; ++i) { glds16(aS[i] + ko_, SA_ + (tid + 256 * i) * 16); glds16(bS[i] + ko_, SA_ + 16384 + (tid + 256 * i) * 16); } \
        } \
        GEMM_MM(a0_, b0_, 0, 0); GEMM_MM(a0_, b1_, 0, 1); GEMM_MM(a0_, b2_, 0, 2); GEMM_MM(a0_, b3_, 0, 3); \
        GEMM_MM(a1_, b0_, 1, 0); GEMM_MM(a1_, b1_, 1, 1); GEMM_MM(a1_, b2_, 1, 2); GEMM_MM(a1_, b3_, 1, 3); \
        GEMM_MM(a2_, b0_, 2, 0); GEMM_MM(a2_, b1_, 2, 1); GEMM_MM(a2_, b2_, 2, 2); GEMM_MM(a2_, b3_, 2, 3); \
        GEMM_MM(a3_, b0_, 3, 0); GEMM_MM(a3_, b1_, 3, 1); GEMM_MM(a3_, b2_, 3, 2); GEMM_MM(a3_, b3_, 3, 3); \
        GEMM_MM(c0_, d0_, 0, 0); GEMM_MM(c0_, d1_, 0, 1); GEMM_MM(c0_, d2_, 0, 2); GEMM_MM(c0_, d3_, 0, 3); \
        GEMM_MM(c1_, d0_, 1, 0); GEMM_MM(c1_, d1_, 1, 1); GEMM_MM(c1_, d2_, 1, 2); GEMM_MM(c1_, d3_, 1, 3); \
        GEMM_MM(c2_, d0_, 2, 0); GEMM_MM(c2_, d1_, 2, 1); GEMM_MM(c2_, d2_, 2, 2); GEMM_MM(c2_, d3_, 2, 3); \
        GEMM_MM(c3_, d0_, 3, 0); GEMM_MM(c3_, d1_, 3, 1); GEMM_MM(c3_, d2_, 3, 2); GEMM_MM(c3_, d3_, 3, 3); \
    } while (0)
#pragma unroll 1
    for (int t = 0; t < nt; t += 2) {
        GEMM_STEP(0, t); GEMM_STEP(1, t + 1);
    }
#undef GEMM_STEP
#undef GEMM_MM
}
template <class RowA, class Epi>
DEVINL void gemm128(RowA rowA, const u16* __restrict__ Bt, int ldb, int K, char* smem, Epi epi) {
    const int tid = tid_(), lane = tid & 63, wid = tid >> 6, wr = wid >> 1, wc = wid & 1, fr = lane & 15, fq = lane >> 4;
    f32x4 acc[4][4];
    gemm128_acc(rowA, Bt, ldb, K, smem, acc);
#pragma unroll
    for (int m = 0; m < 4; ++m)
#pragma unroll
        for (int n = 0; n < 4; ++n) epi(wr * 64 + m * 16 + fq * 4, wc * 64 + n * 16 + fr, acc[m][n]);
}

template <class Emit>
DEVINL void stage_tile_bf16(const f32x4 (&acc)[4][4], char* smem, Emit emit) {
    const int tid = tid_(), lane = tid & 63, wid = tid >> 6, wr = wid >> 1, wc = wid & 1, fr = lane & 15, fq = lane >> 4;
    u16* t = (u16*)smem;
    __syncthreads();
#pragma unroll
    for (int m = 0; m < 4; ++m)
#pragma unroll
        for (int n = 0; n < 4; ++n) {
            const int r0 = wr * 64 + m * 16 + fq * 4, c = wc * 64 + n * 16 + fr;
            const unsigned p01 = pk2bf(acc[m][n][0], acc[m][n][1]), p23 = pk2bf(acc[m][n][2], acc[m][n][3]);
            t[(r0 + 0) * 136 + c] = (u16)(p01 & 0xFFFFu); t[(r0 + 1) * 136 + c] = (u16)(p01 >> 16);
            t[(r0 + 2) * 136 + c] = (u16)(p23 & 0xFFFFu); t[(r0 + 3) * 136 + c] = (u16)(p23 >> 16);
        }
    __syncthreads();
#pragma unroll
    for (int i = 0; i < 8; ++i) {
        const int ci = tid + 256 * i, row = ci >> 4, c8 = (ci & 15) * 8;
        emit(row, c8, *(const uint4*)(t + row * 136 + c8));
    }
}

template <class Emit>
DEVINL void stage_tile_f32(const f32x4 (&acc)[4][4], char* smem, Emit emit) {
    const int tid = tid_(), lane = tid & 63, wid = tid >> 6, wr = wid >> 1, wc = wid & 1, fr = lane & 15, fq = lane >> 4;
    float* t = (float*)smem;
    __syncthreads();
#pragma unroll
    for (int m = 0; m < 4; ++m)
#pragma unroll
        for (int n = 0; n < 4; ++n) {
            const int r0 = wr * 64 + m * 16 + fq * 4, c = wc * 64 + n * 16 + fr;
#pragma unroll
            for (int j = 0; j < 4; ++j) t[(r0 + j) * 132 + c] = acc[m][n][j];
        }
    __syncthreads();
#pragma unroll 4
    for (int i = 0; i < 16; ++i) {
        const int ci = tid + 256 * i, row = ci >> 5, c4 = (ci & 31) * 4;
        emit(row, c4, *(const float4*)(t + row * 132 + c4));
    }
}

DEVINL void ph_prolog(const P& p, char* smem) {
    const int TIDX_ = tid_(); const int BIDX_ = bid_(); char* const WS_ = wsl_(p.ws); (void)TIDX_; (void)BIDX_; (void)WS_;
    const int tid = TIDX_;
    float* modv = (float*)(WS_ + OFF_MOD);
    float* sil = (float*)smem;
    float* red = sil + 3072;
    bool ready = false;
    for (int u = BIDX_; u < 192; u += gridDim.x) {
        if (!ready) {
            for (int i = tid; i < 3072; i += 256) { int v = i >> 10, k = i & 1023; float cv = v < 2 ? p.c[v * 1024 + k] : p.c_ctx[k]; sil[i] = cv / (1.f + expf(-cv)); }
            ready = true;
        }
        __syncthreads();
        const int l = u / 96, cg = u % 96;
        const float* W = p.w_mod + (size_t)l * 1024 * 6144 + cg * 64;
        const int c4 = (tid & 15) * 4, rg = tid >> 4;
        float a0[4] = {0, 0, 0, 0}, a1[4] = {0, 0, 0, 0}, a2[4] = {0, 0, 0, 0};
#pragma unroll 4
        for (int i = 0; i < 64; ++i) {
            const int k = rg + 16 * i;
            const float4 w = *(const float4*)(W + (size_t)k * 6144 + c4);
            const float s0 = sil[k], s1 = sil[1024 + k], s2 = sil[2048 + k];
            a0[0] += s0 * w.x; a0[1] += s0 * w.y; a0[2] += s0 * w.z; a0[3] += s0 * w.w;
            a1[0] += s1 * w.x; a1[1] += s1 * w.y; a1[2] += s1 * w.z; a1[3] += s1 * w.w;
            a2[0] += s2 * w.x; a2[1] += s2 * w.y; a2[2] += s2 * w.z; a2[3] += s2 * w.w;
        }
#pragma unroll
        for (int j = 0; j < 4; ++j) { red[(rg * 3 + 0) * 64 + c4 + j] = a0[j]; red[(rg * 3 + 1) * 64 + c4 + j] = a1[j]; red[(rg * 3 + 2) * 64 + c4 + j] = a2[j]; }
        __syncthreads();
        if (tid < 192) {
            const int v = tid >> 6, cc = tid & 63;
            float s = 0.f;
            for (int r = 0; r < 16; ++r) s += red[(r * 3 + v) * 64 + cc];
            const int col = cg * 64 + cc;
            modv[(l * 3 + v) * 6144 + col] = s + p.b_mod[l * 6144 + col];
        }
        __syncthreads();
    }
    float* rope = (float*)(WS_ + OFF_ROPE);
    for (int i = BIDX_ * 256 + tid; i < 320 * 16; i += gridDim.x * 256) {
        const int pos = (i < 4096) ? (i >> 4) : ((i - 4096) >> 4);
        const int f = i & 15;
        const float inv = powf(10000.0f, -(float)f / 16.0f);
        const float ang = (float)pos * inv;
        const double TWO_PI = 6.283185307179586476925;
        double a = (double)ang;
        a -= TWO_PI * rint(a / TWO_PI);
        const float cr = (float)cos(a), sr = (float)sin(a);
        if (i < 4096) { rope[i] = cr; rope[4096 + i] = sr; }
        else { rope[8192 + (i - 4096)] = cr; rope[8192 + 1024 + (i - 4096)] = sr; }
    }
    {
        u16* w2t = (u16*)(WS_ + OFF_LORA); u16* a2t = w2t + 2 * 2 * 256 * 32; u16* g2t = a2t + 2 * 2 * 256 * 32;
        for (int i = BIDX_ * 256 + tid; i < 2 * 2 * 256 * 32; i += gridDim.x * 256) {
            const int lz = i >> 13, c = (i >> 5) & 255, r = i & 31;
            w2t[i] = f2bf(p.rw_w2[((size_t)lz * 32 + r) * 256 + c]);
            a2t[i] = f2bf(p.rw_a2[((size_t)lz * 32 + r) * 256 + c]);
        }
        for (int i = BIDX_ * 256 + tid; i < 2 * 256 * 64; i += gridDim.x * 256) {
            const int l = i >> 14, c = (i >> 6) & 255, r = i & 63;
            g2t[i] = f2bf(p.rw_g2[((size_t)l * 64 + r) * 256 + c]);
        }
    }
    u16* wr = (u16*)(WS_ + OFF_WR);
    for (int i = BIDX_ * 256 + tid; i < 2 * 128 * 1024; i += gridDim.x * 256) {
        const int l = i >> 17, n = (i >> 10) & 127, k = i & 1023;
        float v = 0.f;
        if (n < 4) v = p.rgw[((size_t)l * 1024 + k) * 4 + n];
        else if (n < 36) v = p.rew[((size_t)l * 1024 + k) * 32 + (n - 4)];
        wr[i] = f2bf(v);
    }
}

DEVINL void conv_tile(const float* __restrict__ src, int N, int K, u16* __restrict__ dst, int k0, int n0, int mode, char* smem) {
    unsigned* t = (unsigned*)smem;
    const int tid = tid_();
    const int n4 = (tid & 15) * 4;
    const bool ok = n0 + n4 < N;
    float4 va[2], vb[2];
    __syncthreads();
#pragma unroll
    for (int i = 0; i < 2; ++i) {
        const int kp = i * 16 + (tid >> 4);
        const float* s0 = src + (size_t)(k0 + 2 * kp) * N + n0 + n4;
        va[i] = ok ? *(const float4*)s0 : make_float4(0.f, 0.f, 0.f, 0.f);
        vb[i] = ok ? *(const float4*)(s0 + N) : make_float4(0.f, 0.f, 0.f, 0.f);
    }
#pragma unroll
    for (int i = 0; i < 2; ++i) {
        const int kp = i * 16 + (tid >> 4);
        t[(n4 + 0) * 33 + kp] = pk2bf(va[i].x, vb[i].x);
        t[(n4 + 1) * 33 + kp] = pk2bf(va[i].y, vb[i].y);
        t[(n4 + 2) * 33 + kp] = pk2bf(va[i].z, vb[i].z);
        t[(n4 + 3) * 33 + kp] = pk2bf(va[i].w, vb[i].w);
    }
    __syncthreads();
    {
        const int n = tid >> 2, w0 = (tid & 3) * 8;
        const int ng = n0 + n;
        int nd = ng;
        if (mode == 1) nd = 32 * (ng >> 4) + (ng & 15);
        else if (mode == 2) nd = 32 * (ng >> 4) + 16 + (ng & 15);
        uint4 o0, o1;
        o0.x = t[n * 33 + w0 + 0]; o0.y = t[n * 33 + w0 + 1]; o0.z = t[n * 33 + w0 + 2]; o0.w = t[n * 33 + w0 + 3];
        o1.x = t[n * 33 + w0 + 4]; o1.y = t[n * 33 + w0 + 5]; o1.z = t[n * 33 + w0 + 6]; o1.w = t[n * 33 + w0 + 7];
        u16* q = dst + (size_t)nd * K + k0 + w0 * 2;
        *(uint4*)q = o0; *(uint4*)(q + 8) = o1;
    }
}
DEVINL void ph_convw(const P& p, int l, char* smem) {
    const int TIDX_ = tid_(); const int BIDX_ = bid_(); char* const WS_ = wsl_(p.ws); (void)TIDX_; (void)BIDX_; (void)WS_;
    u16* win = (u16*)(WS_ + OFF_WIN); u16* wout = (u16*)(WS_ + OFF_WOUT);
    for (int u = BIDX_; u < 896 + 256; u += gridDim.x) {
        if (u < 896) conv_tile(p.w_in + (size_t)l * 1024 * INP, INP, 1024, win, (u / 56) * 64, (u % 56) * 64, 0, smem);
        else { const int v = u - 896; conv_tile(p.w_out + (size_t)l * 1024 * 1024, 1024, 1024, wout, (v / 16) * 64, (v % 16) * 64, 0, smem); }
    }
}
DEVINL void ph_convexp(const P& p, int l, char* smem, int bid, int nb) {
    const int TIDX_ = tid_(); const int BIDX_ = bid_(); char* const WS_ = wsl_(p.ws); (void)TIDX_; (void)BIDX_; (void)WS_;
    u16* wgu = (u16*)(WS_ + OFF_WGU); u16* wdn = (u16*)(WS_ + OFF_WDN);
    for (int u = bid; u < 32 * 384; u += nb) {
        const int e = u / 384, v = u % 384;
        const size_t le = (size_t)l * 32 + e;
        if (v < 128) conv_tile(p.egate + le * 1024 * 512, 512, 1024, wgu + (size_t)e * 1024 * 1024, (v / 8) * 64, (v % 8) * 64, 1, smem);
        else if (v < 256) { const int w = v - 128; conv_tile(p.eup + le * 1024 * 512, 512, 1024, wgu + (size_t)e * 1024 * 1024, (w / 8) * 64, (w % 8) * 64, 2, smem); }
        else { const int w = v - 256; conv_tile(p.edown + le * 512 * 1024, 1024, 512, wdn + (size_t)e * 1024 * 512, (w / 16) * 64, (w % 16) * 64, 0, smem); }
    }
}

DEVINL void ph_xm0(const P& p) {
    const int TIDX_ = tid_(); const int BIDX_ = bid_(); char* const WS_ = wsl_(p.ws); (void)TIDX_; (void)BIDX_; (void)WS_;
    const float* modv = (const float*)(WS_ + OFF_MOD);
    u16* hm = (u16*)(WS_ + OFF_HM);
    for (size_t i = (size_t)BIDX_ * 256 + TIDX_; i < (size_t)T * 256; i += (size_t)gridDim.x * 256) {
        const int row = (int)(i >> 8), c4 = (int)(i & 255) * 4;
        const float* src = row < CTXROWS ? p.ctx + (size_t)row * 1024 : p.x + (size_t)(row - CTXROWS) * 1024;
        const float* mv = modv + row_sel(row) * 6144;
        const float4 v = *(const float4*)(src + c4);
        const float4 sh = *(const float4*)(mv + c4), sc = *(const float4*)(mv + 1024 + c4);
        uint2 o;
        o.x = (unsigned)f2bf(v.x * (1.f + sc.x) + sh.x) | ((unsigned)f2bf(v.y * (1.f + sc.y) + sh.y) << 16);
        o.y = (unsigned)f2bf(v.z * (1.f + sc.z) + sh.z) | ((unsigned)f2bf(v.w * (1.f + sc.w) + sh.w) << 16);
        *(uint2*)(hm + (size_t)row * 1024 + c4) = o;
    }
}

DEVINL void ph_inproj(const P& p, char* smem) {
    const int TIDX_ = tid_(); const int BIDX_ = bid_(); char* const WS_ = wsl_(p.ws); (void)TIDX_; (void)BIDX_; (void)WS_;
    const u16* hm = (const u16*)(WS_ + OFF_HM);
    const u16* win = (const u16*)(WS_ + OFF_WIN);
    u16* pqk = (u16*)(WS_ + OFF_PQK); u16* vtl = (u16*)(WS_ + OFF_VTL); u16* vtc = (u16*)(WS_ + OFF_VTC);
    u16* pb = (u16*)(WS_ + OFF_PB); u16* pc = (u16*)(WS_ + OFF_PC);
    XCD_WALK(260 * 28, BIDX_, (int)gridDim.x);
    for (int o = xw_lo; o < xw_hi; o += xw_st) {
        const int g = o / 224, w = o % 224;
        const int mt = g < 32 ? g * 8 + (w & 7) : 256 + (w & 3), nt = g < 32 ? (w >> 3) : (w >> 2);
        const u16* A = hm + (size_t)mt * 128 * 1024;
        f32x4 acc[4][4];
        gemm128_acc([&](int r) { return A + (size_t)r * 1024; }, win + (size_t)nt * 128 * 1024, 1024, 1024, smem, acc);
        if (nt >= 8 && nt < 12) {
            const int tid = tid_(), lane = tid & 63, wid = tid >> 6, wr = wid >> 1, wc = wid & 1, fr = lane & 15, fq = lane >> 4;
#pragma unroll
            for (int m = 0; m < 4; ++m)
#pragma unroll
                for (int n = 0; n < 4; ++n) {
                    const int R = mt * 128 + wr * 64 + m * 16 + fq * 4, N = nt * 128 + wc * 64 + n * 16 + fr;
                    const int hh = (N - 1024) >> 6, d = (N - 1024) & 63;
                    uint2 v; v.x = pk2bf(acc[m][n][0], acc[m][n][1]); v.y = pk2bf(acc[m][n][2], acc[m][n][3]);
                    if (R < CTXROWS) { const int b = R >> 8, t = R & 255; *(uint2*)(vtc + ((size_t)((b * 8 + hh) * 64 + d)) * 256 + t) = v; }
                    else { const int R2 = R - CTXROWS, b = R2 >> 14, t = R2 & 16383; *(uint2*)(vtl + ((size_t)((b * 8 + hh) * 64 + d)) * 16384 + t) = v; }
                }
        } else {
            stage_tile_bf16(acc, smem, [&](int row, int c8, uint4 v) {
                const int R = mt * 128 + row, N = nt * 128 + c8;
                if (N >= INP) return;
                if (N < 1024) *(uint4*)(pqk + (size_t)R * 1024 + N) = v;
                else if (N < 2496) *(uint4*)(pb + (size_t)R * 960 + (N - 1536)) = v;
                else *(uint4*)(pc + (size_t)R * 1040 + (N - 2496)) = v;
            });
        }
    }
}

constexpr size_t RWREC = 12288;
constexpr size_t RW_A1 = 0, RW_A4 = 2048, RW_A3 = 4096, RW_MKA = 8192, RW_TT = 8704, RW_MY = 9216, RW_V = 10240;
constexpr size_t OFF_RWOP = OFF_X1;
constexpr size_t OFF_RWWG = OFF_RWOP + (size_t)16 * 520 * RWREC;
constexpr size_t OFF_YRWB = OFF_RWWG + (size_t)16 * 130 * 64 * 4;
constexpr size_t OFF_BONUS = OFF_YRWB + (size_t)T * 256 * 2;
static_assert(OFF_BONUS + (size_t)T * 4 * 4 <= OFF_HM, "rw operand store must fit the X1 region");

DEVINL float rw_mix(const u16* __restrict__ pb, const float* __restrict__ mup, const float* __restrict__ mun, int row, int t, int seqlen, int col) {
    const float cu = bf2f(pb[(size_t)row * 960 + col]);
    const float pr = t > 0 ? bf2f(pb[(size_t)(row - 1) * 960 + col]) : 0.f;
    const float nx = t + 1 < seqlen ? bf2f(pb[(size_t)(row + 1) * 960 + col]) : 0.f;
    return cu + mup[col] * (pr - cu) + mun[col] * (nx - cu);
}

DEVINL void rw_mix8(const u16* __restrict__ pb, const float* __restrict__ mup, const float* __restrict__ mun, int row, int t, int seqlen, int col0, float (&o)[8]) {
    const bool hp = t > 0, hn = t + 1 < seqlen;
    const u32x4 c = *(const u32x4*)(pb + (size_t)row * 960 + col0);
    u32x4 pv = *(const u32x4*)(pb + (size_t)(hp ? row - 1 : row) * 960 + col0);
    u32x4 nx = *(const u32x4*)(pb + (size_t)(hn ? row + 1 : row) * 960 + col0);
    const unsigned mpv = hp ? 0xFFFFFFFFu : 0u, mnx = hn ? 0xFFFFFFFFu : 0u;
    const f32x4 mp0 = *(const f32x4*)(mup + col0), mp1 = *(const f32x4*)(mup + col0 + 4), mn0 = *(const f32x4*)(mun + col0), mn1 = *(const f32x4*)(mun + col0 + 4);
#pragma unroll
    for (int i = 0; i < 4; ++i) {
        const unsigned cw = c[i], pw = pv[i] & mpv, nw = nx[i] & mnx;
        const float c0 = __uint_as_float(cw << 16), c1 = __uint_as_float(cw & 0xFFFF0000u);
        const float p0 = __uint_as_float(pw << 16), p1 = __uint_as_float(pw & 0xFFFF0000u);
        const float n0 = __uint_as_float(nw << 16), n1 = __uint_as_float(nw & 0xFFFF0000u);
        const float ma = (i < 2) ? mp0[2 * i] : mp1[2 * i - 4], mb = (i < 2) ? mp0[2 * i + 1] : mp1[2 * i - 3];
        const float na = (i < 2) ? mn0[2 * i] : mn1[2 * i - 4], nb = (i < 2) ? mn0[2 * i + 1] : mn1[2 * i - 3];
        o[2 * i] = c0 + ma * (p0 - c0) + na * (n0 - c0);
        o[2 * i + 1] = c1 + mb * (p1 - c1) + nb * (n1 - c1);
    }
}
DEVINL uint4 pack8bf(const float (&v)[8]) { return make_uint4(pk2bf(v[0], v[1]), pk2bf(v[2], v[3]), pk2bf(v[4], v[5]), pk2bf(v[6], v[7])); }

DEVINL void ph_rwprep(const P& p, int l, int half, char* smem, int bid, int nb) {
    const int TIDX_ = tid_(); const int BIDX_ = bid_(); char* const WS_ = wsl_(p.ws);
    const int tid = TIDX_, lane = tid & 63, w = tid >> 6, fr = lane & 15, fq = lane >> 4;
    const u16* pb = (const u16*)(WS_ + OFF_PB);
    char* rwop = WS_ + OFF_RWOP;
    float* rwwg = (float*)(WS_ + OFF_RWWG);
    float* bonus = (float*)(WS_ + OFF_BONUS);
    u16* gate = (u16*)(WS_ + OFF_GATE);
    const float* mup = p.mu_prev + l * 960; const float* mun = p.mu_next + l * 960;
    u16* lwdh = (u16*)smem;
    u16* ladh = lwdh + 2048;
    u16* abuf = ladh + 2048;
    float* Lb = (float*)(smem + 16384);
    u16* SV = (u16*)(smem + 32768);
    float* tot = (float*)(smem + 32768);
    const u16* w2t = (const u16*)(WS_ + OFF_LORA);
    const u16* a2t = w2t + 2 * 2 * 256 * 32;
    const u16* g2t = a2t + 2 * 2 * 256 * 32;
    for (int uh = bid; uh < 2 * 2 * 130 * 4; uh += nb) {
        const int h = uh & 3, rest = uh >> 2;
        const int d = rest / 260, b = (rest % 260) / 130, gl = rest % 130;
        const int z = d;
        const int gscan = half * 130 + gl;
        int gi, row0, seqlen;
        if (gscan < 4) { gi = d ? 3 - gscan : gscan; row0 = b * 256 + gi * 64; seqlen = 256; }
        else { gi = d ? 255 - (gscan - 4) : gscan - 4; row0 = CTXROWS + b * LAT + gi * 64; seqlen = LAT; }
        const int t0 = gi * 64;
        __syncthreads();
        {
            const int j = tid >> 2, cq = tid & 3;
            float v[8];
            rw_mix8(pb, mup, mun, row0 + j, t0 + j, seqlen, 768 + z * 32 + 8 * cq, v);
#pragma unroll
            for (int i = 0; i < 8; ++i) v[i] = tanhf(v[i]);
            *(uint4*)(lwdh + j * 32 + 8 * cq) = pack8bf(v);
            rw_mix8(pb, mup, mun, row0 + j, t0 + j, seqlen, 832 + z * 32 + 8 * cq, v);
            *(uint4*)(ladh + j * 32 + 8 * cq) = pack8bf(v);
        }
        if (d == 0) {
            u16* lgd = (u16*)Lb;
            {
                const int j = tid >> 2, cq = tid & 3;
#pragma unroll
                for (int hh = 0; hh < 2; ++hh) {
                    float v[8];
                    rw_mix8(pb, mup, mun, row0 + j, t0 + j, seqlen, 896 + 16 * cq + 8 * hh, v);
#pragma unroll
                    for (int i = 0; i < 8; ++i) v[i] = sigmoidf_(v[i]);
                    *(uint4*)(lgd + j * 64 + 16 * cq + 8 * hh) = pack8bf(v);
                }
            }
            __syncthreads();
            const bf16x8 x0 = *(const bf16x8*)(lgd + (16 * w + fr) * 64 + 8 * fq), x1 = *(const bf16x8*)(lgd + (16 * w + fr) * 64 + 32 + 8 * fq);
#pragma unroll
            for (int nt = 0; nt < 4; ++nt) {
                const u16* bp = g2t + ((size_t)l * 256 + 64 * h + 16 * nt + fr) * 64 + 8 * fq;
                const bf16x8 b0 = *(const bf16x8*)bp, b1 = *(const bf16x8*)(bp + 32);
                f32x4 acc = f32x4{0.f, 0.f, 0.f, 0.f};
                acc = __builtin_amdgcn_mfma_f32_16x16x32_bf16(x0, b0, acc, 0, 0, 0);
                acc = __builtin_amdgcn_mfma_f32_16x16x32_bf16(x1, b1, acc, 0, 0, 0);
#pragma unroll
                for (int r = 0; r < 4; ++r) gate[(size_t)(row0 + 16 * w + 4 * fq + r) * 256 + 64 * h + 16 * nt + fr] = f2bf(acc[r]);
            }
        }
        {
            const int bh = b * 4 + h;
            const int ch = h * 64 + lane;
            __syncthreads();
            {
                const bf16x8 xw = *(const bf16x8*)(lwdh + (16 * w + fr) * 32 + 8 * fq);
                const bf16x8 xa = *(const bf16x8*)(ladh + (16 * w + fr) * 32 + 8 * fq);
#pragma unroll 1
                for (int kt = 0; kt < 4; ++kt) {
                    const int key = 16 * kt + fr;
                    const size_t wrow = ((size_t)(l * 2 + z) * 256 + h * 64 + key) * 32 + 8 * fq;
                    const bf16x8 bw = *(const bf16x8*)(w2t + wrow), ba = *(const bf16x8*)(a2t + wrow);
                    f32x4 ae = f32x4{0.f, 0.f, 0.f, 0.f}, aa = f32x4{0.f, 0.f, 0.f, 0.f};
                    ae = __builtin_amdgcn_mfma_f32_16x16x32_bf16(xw, bw, ae, 0, 0, 0);
                    aa = __builtin_amdgcn_mfma_f32_16x16x32_bf16(xa, ba, aa, 0, 0, 0);
                    const float w0 = p.rw_w0[(l * 2 + z) * 256 + h * 64 + key], a0 = p.rw_a0[(l * 2 + z) * 256 + h * 64 + key];
#pragma unroll
                    for (int r = 0; r < 4; ++r) {
                        const int tok = 16 * w + 4 * fq + r;
                        const int s = d ? 63 - tok : tok;
                        Lb[s * 64 + key] = 0.60653065971263342f * sigmoidf_(ae[r] + w0);
                        abuf[tok * 64 + key] = f2bf(sigmoidf_(aa[r] + a0));
                    }
                }
            }
            __syncthreads();
            {
                float pre[16]; float run = 0.f;
#pragma unroll
                for (int i = 0; i < 16; ++i) { run += Lb[(16 * w + i) * 64 + lane]; pre[i] = run; }
                tot[w * 64 + lane] = run;
                __syncthreads();
                float offs = 0.f;
#pragma unroll
                for (int ww = 0; ww < 3; ++ww) offs += (ww < w) ? tot[ww * 64 + lane] : 0.f;
#pragma unroll
                for (int i = 0; i < 16; ++i) Lb[(16 * w + i) * 64 + lane] = -(offs + pre[i]);
            }
            __syncthreads();
            {
                const int j = tid >> 2, kq = tid & 3, row = row0 + j, tt = t0 + j;
                const int c0 = h * 64 + 16 * kq;
                float kr[16];
                { float t8[8];
                  rw_mix8(pb, mup, mun, row, tt, seqlen, 256 + c0, t8);
#pragma unroll
                  for (int i = 0; i < 8; ++i) kr[i] = t8[i];
                  rw_mix8(pb, mup, mun, row, tt, seqlen, 256 + c0 + 8, t8);
#pragma unroll
                  for (int i = 0; i < 8; ++i) kr[8 + i] = t8[i]; }
                float ss = 0.f;
#pragma unroll
                for (int i = 0; i < 16; ++i) { const float kv = kr[i] * p.rw_kk[l * 256 + c0 + i]; ss += kv * kv; }
                ss += __shfl_xor(ss, 1); ss += __shfl_xor(ss, 2);
                const float inorm = 1.f / fmaxf(sqrtf(ss), 1e-12f);
                const int sidx = d ? 63 - j : j;
                const int cch = sidx >> 4, ts = sidx & 15;
                u16* sv = SV + (size_t)(cch * 4) * 1024 + ts * 64 + 16 * kq;
                float bs = 0.f;
#pragma unroll 1
                for (int hh = 0; hh < 2; ++hh) {
                    const int cb = c0 + 8 * hh;
                    float rr[8], av[8], oa[8], orr[8], ob[8], ok[8];
                    rw_mix8(pb, mup, mun, row, tt, seqlen, cb, rr);
                    { const uint4 a0 = *(const uint4*)(abuf + j * 64 + 16 * kq + 8 * hh);
                      const unsigned aw[4] = {a0.x, a0.y, a0.z, a0.w};
#pragma unroll
                      for (int i = 0; i < 4; ++i) { av[2 * i] = __uint_as_float(aw[i] << 16); av[2 * i + 1] = __uint_as_float(aw[i] & 0xFFFF0000u); } }
#pragma unroll
                    for (int i4 = 0; i4 < 2; ++i4) {
                        const float4 Lt4 = *(const float4*)(Lb + sidx * 64 + 16 * kq + 8 * hh + 4 * i4);
                        const float4 Lp4 = sidx > 0 ? *(const float4*)(Lb + (sidx - 1) * 64 + 16 * kq + 8 * hh + 4 * i4) : make_float4(0.f, 0.f, 0.f, 0.f);
                        const float Lt[4] = {Lt4.x, Lt4.y, Lt4.z, Lt4.w}, Lp[4] = {Lp4.x, Lp4.y, Lp4.z, Lp4.w};
#pragma unroll
                        for (int ii = 0; ii < 4; ++ii) {
                            const int i = 4 * i4 + ii;
                            const float kraw = hh ? kr[8 + i] : kr[i];
                            const float kkn = kraw * p.rw_kk[l * 256 + cb + i] * inorm, a = av[i];
                            const float et = __expf(Lt[ii]), einv = __builtin_amdgcn_rcpf(et);
                            oa[i] = -kkn * __expf(Lp[ii]);
                            orr[i] = rr[i] * et;
                            ob[i] = kkn * a * einv;
                            ok[i] = kraw * (1.f + (a - 1.f) * p.rw_ka[l * 256 + cb + i]) * einv;
                            bs += rr[i] * kraw * p.rw_rk[l * 256 + cb + i];
                            if (sidx == 63) rwwg[((size_t)(d * 8 + bh) * 130 + gl) * 64 + 16 * kq + 8 * hh + i] = et;
                        }
                    }
                    *(uint4*)(sv + 8 * hh) = pack8bf(oa);
                    *(uint4*)(sv + 1024 + 8 * hh) = pack8bf(orr);
                    *(uint4*)(sv + 2048 + 8 * hh) = pack8bf(ob);
                    *(uint4*)(sv + 3072 + 8 * hh) = pack8bf(ok);
                    rw_mix8(pb, mup, mun, row, tt, seqlen, 512 + cb, rr);
                    *(uint4*)(abuf + j * 64 + 16 * kq + 8 * hh) = pack8bf(rr);
                }
                if (d == 0) { bs += __shfl_xor(bs, 1); bs += __shfl_xor(bs, 2); if (kq == 0) bonus[(size_t)row * 4 + h] = bs; }
            }
            __syncthreads();
            {
                char* rec = rwop + ((size_t)(d * 8 + bh) * 520 + (size_t)gl * 4 + w) * RWREC;
                const u16* Av = SV + (size_t)(w * 4) * 1024; const u16* Rv = Av + 1024; const u16* Bv = Av + 2048; const u16* Kv = Av + 3072;
                bf16x8 fa[2], frr[2], fb[2], fk[2];
#pragma unroll
                for (int ks = 0; ks < 2; ++ks) {
                    fa[ks] = *(const bf16x8*)(Av + fr * 64 + ks * 32 + fq * 8);
                    frr[ks] = *(const bf16x8*)(Rv + fr * 64 + ks * 32 + fq * 8);
                    fb[ks] = *(const bf16x8*)(Bv + fr * 64 + ks * 32 + fq * 8);
                    fk[ks] = *(const bf16x8*)(Kv + fr * 64 + ks * 32 + fq * 8);
                }
                f32x4 mka = f32x4{0.f, 0.f, 0.f, 0.f}, mba = mka, mkr = mka, mbr = mka;
#pragma unroll
                for (int ks = 0; ks < 2; ++ks) {
                    mka = __builtin_amdgcn_mfma_f32_16x16x32_bf16(fa[ks], fk[ks], mka, 0, 0, 0);
                    mba = __builtin_amdgcn_mfma_f32_16x16x32_bf16(fa[ks], fb[ks], mba, 0, 0, 0);
                    mkr = __builtin_amdgcn_mfma_f32_16x16x32_bf16(frr[ks], fk[ks], mkr, 0, 0, 0);
                    mbr = __builtin_amdgcn_mfma_f32_16x16x32_bf16(frr[ks], fb[ks], mbr, 0, 0, 0);
                }
                float* Ns = Lb + w * 256;
                float* Ts = Lb + 1024 + w * 256;
                u16* rmka = (u16*)(rec + RW_MKA); u16* rmy = (u16*)(rec + RW_MY);
                const int i_ = fr;
#pragma unroll
                for (int r = 0; r < 4; ++r) {
                    const int t_ = 4 * fq + r;
                    const int lp = (i_ >> 2) * 16 + t_;
                    mka[r] = i_ < t_ ? mka[r] : 0.f;
                    rmy[lp * 8 + (i_ & 3)] = f2bf(i_ <= t_ ? mbr[r] : 0.f);
                    rmy[lp * 8 + 4 + (i_ & 3)] = f2bf(i_ <= t_ ? mkr[r] : 0.f);
                    Ns[t_ * 16 + i_] = i_ < t_ ? mba[r] : 0.f;
                }
                if (lane < 16) {
                    float Tr[16];
#pragma unroll
                    for (int ii = 0; ii < 16; ++ii) Tr[ii] = 0.f;
#pragma unroll 1
                    for (int t_ = 0; t_ < 16; ++t_) {
                        float acc = (lane == t_) ? 1.f : 0.f;
#pragma unroll
                        for (int i4 = 0; i4 < 4; ++i4) {
                            const float4 nv = *(const float4*)(Ns + t_ * 16 + 4 * i4);
                            acc += Tr[4 * i4] * nv.x + Tr[4 * i4 + 1] * nv.y + Tr[4 * i4 + 2] * nv.z + Tr[4 * i4 + 3] * nv.w;
                        }
#pragma unroll
                        for (int ii = 0; ii < 16; ++ii) Tr[ii] = (ii == t_) ? acc : Tr[ii];
                        Ts[lane * 16 + t_] = acc;
                    }
                }
                bf16x8 TTf;
                {
                    const float t0v = Ts[(4 * fq + 0) * 16 + fr], t1v = Ts[(4 * fq + 1) * 16 + fr], t2v = Ts[(4 * fq + 2) * 16 + fr], t3v = Ts[(4 * fq + 3) * 16 + fr];
                    union { u32x4 u; bf16x8 f; } x; x.u = u32x4{pk2bf(t0v, t1v), pk2bf(t2v, t3v), 0u, 0u}; TTf = x.f;
                }
                {
                    union { u32x4 u; bf16x8 f; } mb; mb.u = u32x4{pk2bf(mka[0], mka[1]), pk2bf(mka[2], mka[3]), 0u, 0u};
                    f32x4 mk2 = f32x4{0.f, 0.f, 0.f, 0.f};
                    mk2 = __builtin_amdgcn_mfma_f32_16x16x32_bf16(TTf, mb.f, mk2, 0, 0, 0);
#pragma unroll
                    for (int r = 0; r < 4; ++r) { const int t_ = 4 * fq + r; rmka[((i_ >> 2) * 16 + t_) * 4 + (i_ & 3)] = f2bf(mk2[r]); }
                }
                {
                    f32x4 ap[4];
#pragma unroll
                    for (int m = 0; m < 4; ++m) {
                        union { u32x4 u; bf16x8 f; } ag;
                        ag.u = u32x4{(unsigned)Av[(4 * fq + 0) * 64 + 16 * m + fr] | ((unsigned)Av[(4 * fq + 1) * 64 + 16 * m + fr] << 16),
                                     (unsigned)Av[(4 * fq + 2) * 64 + 16 * m + fr] | ((unsigned)Av[(4 * fq + 3) * 64 + 16 * m + fr] << 16), 0u, 0u};
                        ap[m] = f32x4{0.f, 0.f, 0.f, 0.f};
                        ap[m] = __builtin_amdgcn_mfma_f32_16x16x32_bf16(ag.f, TTf, ap[m], 0, 0, 0);
                    }
#pragma unroll
                    for (int ks = 0; ks < 2; ++ks) {
                        uint4 o;
                        o.x = pk2bf(ap[2 * ks][0], ap[2 * ks][1]); o.y = pk2bf(ap[2 * ks][2], ap[2 * ks][3]);
                        o.z = pk2bf(ap[2 * ks + 1][0], ap[2 * ks + 1][1]); o.w = pk2bf(ap[2 * ks + 1][2], ap[2 * ks + 1][3]);
                        *(uint4*)(rec + RW_A1 + (ks * 64 + lane) * 16) = o;
                    }
                }
#pragma unroll
                for (int ks = 0; ks < 2; ++ks) {
                    uint4 o;
                    const uint2 lo2 = *(const uint2*)(Rv + fr * 64 + 32 * ks + 4 * fq), hi2 = *(const uint2*)(Rv + fr * 64 + 32 * ks + 16 + 4 * fq);
                    o.x = lo2.x; o.y = lo2.y; o.z = hi2.x; o.w = hi2.y;
                    *(uint4*)(rec + RW_A4 + (ks * 64 + lane) * 16) = o;
                }
#pragma unroll
                for (int m = 0; m < 4; ++m) {
                    unsigned e[8];
#pragma unroll
                    for (int j = 0; j < 4; ++j) { e[j] = Bv[(4 * fq + j) * 64 + 16 * m + fr]; e[4 + j] = Kv[(4 * fq + j) * 64 + 16 * m + fr]; }
                    uint4 o; o.x = e[0] | (e[1] << 16); o.y = e[2] | (e[3] << 16); o.z = e[4] | (e[5] << 16); o.w = e[6] | (e[7] << 16);
                    *(uint4*)(rec + RW_A3 + (m * 64 + lane) * 16) = o;
                }
#pragma unroll
                for (int q = 0; q < 4; ++q) {
                    unsigned e[4];
#pragma unroll
                    for (int j = 0; j < 4; ++j) {
                        const int s = 16 * w + 4 * fq + j; const int jt = d ? 63 - s : s;
                        e[j] = abuf[jt * 64 + 16 * q + fr];
                    }
                    uint2 o; o.x = e[0] | (e[1] << 16); o.y = e[2] | (e[3] << 16);
                    *(uint2*)(rec + RW_V + (q * 64 + lane) * 8) = o;
                }
            }
        }
    }
}

constexpr int RWSLOT = 12544;
DEVINL void ph_rwscan(const P& p, int l, int half, int bid, int nb, char* smem) {
    const int TIDX_ = tid_(); char* const WS_ = wsl_(p.ws);
    const int tid = TIDX_, lane = tid & 63, q = tid >> 6, fr = lane & 15, fq = lane >> 4;
    const char* rwop = WS_ + OFF_RWOP;
    const float* rwwg = (const float*)(WS_ + OFF_RWWG);
    u16* yf = (u16*)(WS_ + OFF_Y);
    u16* yb = (u16*)(WS_ + OFF_YRWB);
    (void)l;
    float* zst = (float*)(WS_ + OFF_ZST);
    for (int dbh = bid; dbh < 16; dbh += nb) {
        const int d = dbh >> 3, bh = dbh & 7, b = bh >> 2, h = bh & 3;
        f32x4 z[4];
        float* zp = zst + ((size_t)(dbh * 4 + q) * 64 + lane) * 16;
#pragma unroll
        for (int m = 0; m < 4; ++m) {
            if (half == 0) z[m] = f32x4{0.f, 0.f, 0.f, 0.f};
            else { const float4 t4 = *(const float4*)(zp + 4 * m); z[m] = f32x4{t4.x, t4.y, t4.z, t4.w}; }
        }
        const int cbase = half * 520;
        const char* rec0 = rwop + (size_t)dbh * 520 * RWREC;
        const float* wg0 = rwwg + (size_t)dbh * 130 * 64;
        constexpr int RD = 6;
        u32x4 rb[RD][3]; float rwgA = 0.f, rwgB = 0.f;
        auto ldrec = [&](int c, auto I) {
            constexpr int i = decltype(I)::value;
            const int cc = c < 520 ? c : 519;
            const char* rec = rec0 + (size_t)cc * RWREC;
#pragma unroll
            for (int k = 0; k < 3; ++k) rb[i][k] = *(const u32x4*)(rec + (tid + 256 * k) * 16);
        };
        auto strec = [&](auto I, int slotidx) {
            constexpr int i = decltype(I)::value;
            char* slot = smem + slotidx * RWSLOT;
#pragma unroll
            for (int k = 0; k < 3; ++k) *(u32x4*)(slot + (tid + 256 * k) * 16) = rb[i][k];
        };
        auto asfrag = [](uint4 v) { union { uint4 u; bf16x8 f; } x; x.u = v; return x.f; };
        auto pack2 = [](float lo, float hi) { return pk2bf(lo, hi); };
        const unsigned b128 = lds_addr(smem) + lane * 16, b64 = lds_addr(smem) + lane * 8, bv = lds_addr(smem) + (q * 64 + lane) * 8, bg = lds_addr(smem) + 16 * fq;
        __syncthreads();
        __builtin_amdgcn_s_setprio(3);
#define IC(n) std::integral_constant<int, n>{}
        auto flush_y = [&](int cprev, int par) {
            if (tid < 128) {
                const int cg = cbase + cprev;
                const bool isctx = cg < 16;
                const int cc = isctx ? cg : cg - 16;
                const int n = isctx ? LCTX : LAT;
                const int rowbase = isctx ? b * LCTX : CTXROWS + b * LAT;
                const int ts = tid >> 3, c8 = (tid & 7) * 8;
                const int sidx = cc * 16 + ts;
                const int t = d ? n - 1 - sidx : sidx;
                const u32x4 v = *(const u32x4*)(smem + 4 * RWSLOT + par * 2048 + (ts * 64 + c8) * 2);
                u16* dst = d == 0 ? yf + (size_t)(rowbase + t) * 1024 + 512 + h * 64 + c8 : yb + (size_t)(rowbase + t) * 256 + h * 64 + c8;
                *(u32x4*)dst = v;
            }
        };
        u32x4 f4[2][6]; u32x2 f2[2][2];
#define RD_ISSUE(par, SBC) asm volatile( \
                "ds_read_b64 %6, %9 offset:%11+8192\n\t" \
                "ds_read_b64 %7, %10 offset:%11+10240\n\t" \
                "ds_read_b128 %0, %8 offset:%11+0\n\t" \
                "ds_read_b128 %1, %8 offset:%11+1024\n\t" \
                "ds_read_b128 %2, %8 offset:%11+4096\n\t" \
                "ds_read_b128 %3, %8 offset:%11+5120\n\t" \
                "ds_read_b128 %4, %8 offset:%11+6144\n\t" \
                "ds_read_b128 %5, %8 offset:%11+7168" \
                : "=&v"(f4[par][0]), "=&v"(f4[par][1]), "=&v"(f4[par][2]), "=&v"(f4[par][3]), "=&v"(f4[par][4]), "=&v"(f4[par][5]), \
                  "=&v"(f2[par][0]), "=&v"(f2[par][1]) \
                : "v"(b128), "v"(b64), "v"(bv), "n"(SBC) \
                : "memory")
#define RD_WAIT(par) asm volatile("s_waitcnt lgkmcnt(0)" \
                : "+v"(f4[par][0]), "+v"(f4[par][1]), "+v"(f4[par][2]), "+v"(f4[par][3]), "+v"(f4[par][4]), "+v"(f4[par][5]), \
                  "+v"(f2[par][0]), "+v"(f2[par][1]) \
                :: "memory")
        ldrec(0, IC(0)); ldrec(1, IC(1)); ldrec(2, IC(2)); ldrec(3, IC(3)); ldrec(4, IC(4)); ldrec(5, IC(5));
        strec(IC(0), 0); ldrec(RD, IC(0));
        strec(IC(1), 1); ldrec(RD + 1, IC(1));
        rwgA = wg0[lane]; rwgB = wg0[64 + lane];
        asm volatile("s_waitcnt lgkmcnt(0)" ::: "memory");
        __builtin_amdgcn_s_barrier();
        RD_ISSUE(0, 0); RD_WAIT(0);
#pragma unroll 1
        for (int c5 = 0; c5 < 528; c5 += 12) {
          auto body = [&](auto SJ) {
            constexpr int sj = decltype(SJ)::value;
            constexpr int par = sj & 1;
            const int c = c5 + sj;
            asm volatile("s_waitcnt lgkmcnt(0)" ::: "memory");
            __builtin_amdgcn_s_barrier();
            RD_ISSUE(par ^ 1, ((sj + 1) % 4) * RWSLOT);
            if (c > 0 && c <= 520) flush_y(c - 1, par ^ 1);
            strec(IC((sj + 2) % 6), (sj + 2) % 4);
            ldrec(c + 2 + RD, IC((sj + 2) % 6));
            if ((sj & 3) == 1) {
                const bool even = (((c >> 2) & 1) == 0);
                if (q == 0) *(float*)(smem + ((sj + 2) % 4) * RWSLOT + 12288 + lane * 4) = even ? rwgA : rwgB;
                const int gn = (c >> 2) + 2;
                const float nv = wg0[(size_t)(gn < 130 ? gn : 129) * 64 + lane];
                if (even) rwgA = nv; else rwgB = nv;
            }
            if (c < 520) {
            constexpr int SB = (sj % 4) * RWSLOT;
            auto asfrag4 = [](u32x4 v) { union { u32x4 u; bf16x8 f; } x; x.u = v; return x.f; };
            const bf16x8 A1_0 = asfrag4(f4[par][0]), A1_1 = asfrag4(f4[par][1]);
            const bf16x8 A3_0 = asfrag4(f4[par][2]), A3_1 = asfrag4(f4[par][3]), A3_2 = asfrag4(f4[par][4]), A3_3 = asfrag4(f4[par][5]);
            const u32x2 mka = f2[par][0], vcur = f2[par][1];
            const bf16x8 MKA = asfrag(make_uint4(mka.x, mka.y, 0u, 0u));
            const bf16x8 VB = asfrag(make_uint4(vcur.x, vcur.y, 0u, 0u));
            const bf16x8 ZB0 = asfrag(make_uint4(pack2(z[0][0], z[0][1]), pack2(z[0][2], z[0][3]), pack2(z[1][0], z[1][1]), pack2(z[1][2], z[1][3])));
            const bf16x8 ZB1 = asfrag(make_uint4(pack2(z[2][0], z[2][1]), pack2(z[2][2], z[2][3]), pack2(z[3][0], z[3][1]), pack2(z[3][2], z[3][3])));
            f32x4 Ua = f32x4{0.f, 0.f, 0.f, 0.f}, Ub = f32x4{0.f, 0.f, 0.f, 0.f};
            Ua = __builtin_amdgcn_mfma_f32_16x16x32_bf16(MKA, VB, Ua, 0, 0, 0);
            Ub = __builtin_amdgcn_mfma_f32_16x16x32_bf16(A1_1, ZB1, Ub, 0, 0, 0);
            Ua = __builtin_amdgcn_mfma_f32_16x16x32_bf16(A1_0, ZB0, Ua, 0, 0, 0);
            u32x4 r_a40, r_a41, r_my;
            asm volatile(
                "ds_read_b128 %0, %3 offset:%4+2048\n\t"
                "ds_read_b128 %1, %3 offset:%4+3072\n\t"
                "ds_read_b128 %2, %3 offset:%4+9216\n\t"
                "s_waitcnt lgkmcnt(0)"
                : "=&v"(r_a40), "=&v"(r_a41), "=&v"(r_my) : "v"(b128), "n"(SB) : "memory");
            const bf16x8 A4_0 = asfrag4(r_a40), A4_1 = asfrag4(r_a41), MY = asfrag4(r_my);
            f32x4 Y = f32x4{0.f, 0.f, 0.f, 0.f};
            Y = __builtin_amdgcn_mfma_f32_16x16x32_bf16(A4_0, ZB0, Y, 0, 0, 0);
            Y = __builtin_amdgcn_mfma_f32_16x16x32_bf16(A4_1, ZB1, Y, 0, 0, 0);
            const f32x4 U = Ua + Ub;
            const bf16x8 UV = asfrag(make_uint4(pack2(U[0], U[1]), pack2(U[2], U[3]), vcur.x, vcur.y));
            z[0] = __builtin_amdgcn_mfma_f32_16x16x32_bf16(A3_0, UV, z[0], 0, 0, 0);
            z[1] = __builtin_amdgcn_mfma_f32_16x16x32_bf16(A3_1, UV, z[1], 0, 0, 0);
            z[2] = __builtin_amdgcn_mfma_f32_16x16x32_bf16(A3_2, UV, z[2], 0, 0, 0);
            z[3] = __builtin_amdgcn_mfma_f32_16x16x32_bf16(A3_3, UV, z[3], 0, 0, 0);
            Y = __builtin_amdgcn_mfma_f32_16x16x32_bf16(MY, UV, Y, 0, 0, 0);
            asm volatile("s_waitcnt lgkmcnt(0)" ::: "memory");
            if ((c & 3) == 3) {
                u32x4 g0, g1, g2, g3;
                asm volatile(
                    "ds_read_b128 %0, %4 offset:%5+12288\n\t"
                    "ds_read_b128 %1, %4 offset:%5+12352\n\t"
                    "ds_read_b128 %2, %4 offset:%5+12416\n\t"
                    "ds_read_b128 %3, %4 offset:%5+12480\n\t"
                    "s_waitcnt lgkmcnt(0)"
                    : "=&v"(g0), "=&v"(g1), "=&v"(g2), "=&v"(g3) : "v"(bg), "n"(SB) : "memory");
                z[0][0] *= __uint_as_float(g0.x); z[0][1] *= __uint_as_float(g0.y); z[0][2] *= __uint_as_float(g0.z); z[0][3] *= __uint_as_float(g0.w);
                z[1][0] *= __uint_as_float(g1.x); z[1][1] *= __uint_as_float(g1.y); z[1][2] *= __uint_as_float(g1.z); z[1][3] *= __uint_as_float(g1.w);
                z[2][0] *= __uint_as_float(g2.x); z[2][1] *= __uint_as_float(g2.y); z[2][2] *= __uint_as_float(g2.z); z[2][3] *= __uint_as_float(g2.w);
                z[3][0] *= __uint_as_float(g3.x); z[3][1] *= __uint_as_float(g3.y); z[3][2] *= __uint_as_float(g3.z); z[3][3] *= __uint_as_float(g3.w);
            }
            {
                u16* yl = (u16*)(smem + 4 * RWSLOT + par * 2048);
                const unsigned y01 = pk2bf(Y[0], Y[1]), y23 = pk2bf(Y[2], Y[3]);
                yl[(4 * fq + 0) * 64 + 16 * q + fr] = (u16)(y01 & 0xFFFFu);
                yl[(4 * fq + 1) * 64 + 16 * q + fr] = (u16)(y01 >> 16);
                yl[(4 * fq + 2) * 64 + 16 * q + fr] = (u16)(y23 & 0xFFFFu);
                yl[(4 * fq + 3) * 64 + 16 * q + fr] = (u16)(y23 >> 16);
            }
            }
            RD_WAIT(par ^ 1);
          };
          body(IC(0)); body(IC(1)); body(IC(2)); body(IC(3)); body(IC(4)); body(IC(5)); body(IC(6)); body(IC(7)); body(IC(8)); body(IC(9)); body(IC(10)); body(IC(11));
        }
#pragma unroll
        for (int m = 0; m < 4; ++m) *(float4*)(zp + 4 * m) = make_float4(z[m][0], z[m][1], z[m][2], z[m][3]);
        asm volatile("s_waitcnt vmcnt(0)" ::: "memory");
        __builtin_amdgcn_s_setprio(0);
        __syncthreads();
    }
}

DEVINL void ph_rwout(const P& p, int l) {
    const int TIDX_ = tid_(); const int BIDX_ = bid_(); char* const WS_ = wsl_(p.ws);
    const int tid = TIDX_;
    const u16* pb = (const u16*)(WS_ + OFF_PB);
    const u16* yb = (const u16*)(WS_ + OFF_YRWB);
    const u16* gate = (const u16*)(WS_ + OFF_GATE);
    const float* bonus = (const float*)(WS_ + OFF_BONUS);
    u16* y = (u16*)(WS_ + OFF_Y);
    const float* mup = p.mu_prev + l * 960; const float* mun = p.mu_next + l * 960;
    const int c8 = (tid & 31) * 8, h = (tid & 31) >> 3;
    float lw[8], lb[8];
#pragma unroll
    for (int i = 0; i < 8; ++i) { lw[i] = p.rw_lnw[l * 256 + c8 + i]; lb[i] = p.rw_lnb[l * 256 + c8 + i]; }
    const int rstart = (l == 0) ? 0 : CTXROWS;
    for (int row = rstart + BIDX_ * 8 + (tid >> 5); row < T; row += gridDim.x * 8) {
        int t, seqlen;
        if (row < CTXROWS) { t = row & 255; seqlen = LCTX; } else { t = (row - CTXROWS) & (LAT - 1); seqlen = LAT; }
        const uint4 yfv = *(const uint4*)(y + (size_t)row * 1024 + 512 + c8), ybv = *(const uint4*)(yb + (size_t)row * 256 + c8);
        const uint4 gv = *(const uint4*)(gate + (size_t)row * 256 + c8);
        float v[8];
        rw_mix8(pb, mup, mun, row, t, seqlen, 512 + c8, v);
        const unsigned fw[4] = {yfv.x, yfv.y, yfv.z, yfv.w}, bw[4] = {ybv.x, ybv.y, ybv.z, ybv.w}, gw[4] = {gv.x, gv.y, gv.z, gv.w};
        float yv[8], gt[8]; float s1 = 0.f;
#pragma unroll
        for (int i = 0; i < 4; ++i) {
            yv[2 * i] = __uint_as_float(fw[i] << 16) + __uint_as_float(bw[i] << 16);
            yv[2 * i + 1] = __uint_as_float(fw[i] & 0xFFFF0000u) + __uint_as_float(bw[i] & 0xFFFF0000u);
            gt[2 * i] = __uint_as_float(gw[i] << 16); gt[2 * i + 1] = __uint_as_float(gw[i] & 0xFFFF0000u);
            s1 += yv[2 * i] + yv[2 * i + 1];
        }
        s1 += __shfl_xor(s1, 1); s1 += __shfl_xor(s1, 2); s1 += __shfl_xor(s1, 4);
        const float mu = s1 * (1.f / 64.f);
        float s2 = 0.f;
#pragma unroll
        for (int i = 0; i < 8; ++i) { const float dl = yv[i] - mu; s2 += dl * dl; }
        s2 += __shfl_xor(s2, 1); s2 += __shfl_xor(s2, 2); s2 += __shfl_xor(s2, 4);
        const float rstd = rsqrtf(s2 * (1.f / 64.f) + 64e-5f);
        const float bn = bonus[(size_t)row * 4 + h];
        float o[8];
#pragma unroll
        for (int i = 0; i < 8; ++i) o[i] = ((yv[i] - mu) * rstd * lw[i] + lb[i] + bn * v[i]) * gt[i];
        *(uint4*)(y + (size_t)row * 1024 + 512 + c8) = pack8bf(o);
    }
}
DEVINL void ph_prepM(const P& p, int l, char* smem, int bid, int nb) {
    const int TIDX_ = tid_(); const int BIDX_ = bid_(); char* const WS_ = wsl_(p.ws);
    const int tid = TIDX_, lane = tid & 63, wid = tid >> 6;
    const u16* pc = (const u16*)(WS_ + OFF_PC);
    u16* mlf = (u16*)(WS_ + OFF_MLF);
    float* mlg = (float*)(WS_ + OFF_MLG);
    float* mls = (float*)(WS_ + OFF_MLS);
    float* nst = (float*)(WS_ + OFF_NST);
    float* cst = (float*)(WS_ + OFF_HM);
    const float* rope = (const float*)(WS_ + OFF_ROPE);
    u16* kT = (u16*)smem;
    u16* vT = kT + 64 * 72;
    float* wsl = (float*)(vT + 64 * 72);
    float* lil = wsl + 128;
    for (int uh = bid; uh < NUNIT_CH * 4; uh += nb) {
        const int u = uh >> 2, h = uh & 3;
        int b, ch, row0, seqlen; bool isctx;
        if (u < 8) { isctx = true; b = u >> 2; ch = u & 3; row0 = b * 256 + ch * 64; seqlen = 256; }
        else { isctx = false; b = (u - 8) >> 8; ch = (u - 8) & 255; row0 = CTXROWS + b * LAT + ch * 64; seqlen = LAT; }
        const int t0 = ch * 64;
        const int tc = isctx ? ch : 4 + ch;
        __syncthreads();
        {
            const bool isk = wid >= 2;
            const int cch = (isk ? 256 : 0) + h * 64 + lane;
            const float* cw = p.ml_cw + (size_t)l * 3 * 512;
            const float w0 = cw[cch], w1 = cw[512 + cch], w2 = cw[1024 + cch], bb = p.ml_cb[l * 512 + cch];
            const int jb = (wid & 1) * 32;
            const int i16 = lane & 15; const bool second = (lane & 16) != 0; const int half = lane >> 5;
            float pv = (t0 + jb > 0) ? bf2f(pc[(size_t)(row0 + jb - 1) * 1040 + cch]) : 0.f;
            float cv = bf2f(pc[(size_t)(row0 + jb) * 1040 + cch]);
#pragma unroll 4
            for (int jj = 0; jj < 32; ++jj) {
                const int j = jb + jj;
                const float nv = (t0 + j + 1 < seqlen) ? bf2f(pc[(size_t)(row0 + j + 1) * 1040 + cch]) : 0.f;
                float val = siluf_(w0 * pv + w1 * cv + w2 * nv + bb);
                if (!isctx) {
                    const int t = t0 + j;
                    const int pos = half == 0 ? (t >> 6) : (t & 63);
                    const float cs = half == 0 ? rope[pos * 16 + i16] : rope[8192 + pos * 16 + i16];
                    const float sn = half == 0 ? rope[4096 + pos * 16 + i16] : rope[9216 + pos * 16 + i16];
                    const float ov = __shfl_xor(val, 16);
                    val = second ? (ov * sn + val * cs) : (val * cs - ov * sn);
                }
                if (isk) { const u16 kb = f2bf(val * 0.125f); mlf[(size_t)(row0 + j) * 512 + 256 + h * 64 + lane] = kb; kT[lane * 72 + j] = kb; }
                else mlf[(size_t)(row0 + j) * 512 + h * 64 + lane] = f2bf(val);
                pv = cv; cv = nv;
            }
            {
                const int j = tid >> 2, wh = tid & 3;
                const int idx = (wh < 2) ? (wh * 4 + h) : (8 + (wh - 2) * 4 + h);
                const float g = bf2f(pc[(size_t)(row0 + j) * 1040 + 1024 + idx]);
                float v;
                if (wh < 2) v = g + p.ml_ib[l * 8 + idx];
                else { const float xx = g + p.ml_fb[l * 8 + idx - 8]; v = fminf(xx, 0.f) - log1pf(__expf(-fabsf(xx))); }
                lil[j * 4 + wh] = v;
                if (wh < 2) mlg[(size_t)(row0 + j) * 16 + idx] = v;
            }
            for (int i = tid; i < 64 * 8; i += 256) {
                const int tok = i >> 3, d8 = (i & 7) * 8;
                const uint4 vv = *(const uint4*)(pc + (size_t)(row0 + tok) * 1040 + 512 + h * 64 + d8);
                const unsigned wv[4] = {vv.x, vv.y, vv.z, vv.w};
#pragma unroll
                for (int k = 0; k < 4; ++k) { vT[(d8 + 2 * k) * 72 + tok] = (u16)(wv[k] & 0xFFFFu); vT[(d8 + 2 * k + 1) * 72 + tok] = (u16)(wv[k] >> 16); }
            }
        }
        __syncthreads();
        if (wid < 2) {
            const int d = wid, tok = d ? 63 - lane : lane;
            float bsum = lil[tok * 4 + 2 + d];
#pragma unroll
            for (int off = 1; off < 64; off <<= 1) { const float o = __shfl_up(bsum, off); if (lane >= off) bsum += o; }
            const float Bs = __shfl(bsum, 63);
            const float gl = Bs - bsum + lil[tok * 4 + d];
            float G = gl;
#pragma unroll
            for (int off = 32; off > 0; off >>= 1) G = fmaxf(G, __shfl_xor(G, off));
            wsl[d * 64 + tok] = __expf(gl - G);
            mlg[(size_t)(row0 + tok) * 16 + 8 + d * 4 + h] = bsum;
            if (lane == 0) { const int bhd = (b * 4 + h) * 2 + d; mls[(bhd * NTC + tc) * 2 + 0] = G; mls[(bhd * NTC + tc) * 2 + 1] = Bs; }
        }
        __syncthreads();
        {
            const int fr = lane & 15, g = lane >> 4;
            const int bh0 = ((b * 4 + h) * 2 + 0) * NTC + tc, bh1 = ((b * 4 + h) * 2 + 1) * NTC + tc;
            bf16x8 va[2];
            va[0] = *(const bf16x8*)(vT + (16 * wid + fr) * 72 + 8 * g);
            va[1] = *(const bf16x8*)(vT + (16 * wid + fr) * 72 + 32 + 8 * g);
#pragma unroll 1
            for (int dkt = 0; dkt < 4; ++dkt) {
                f32x4 u0 = f32x4{0.f, 0.f, 0.f, 0.f}, u1 = f32x4{0.f, 0.f, 0.f, 0.f};
#pragma unroll
                for (int ks = 0; ks < 2; ++ks) {
                    const uint4 kv = *(const uint4*)(kT + (16 * dkt + fr) * 72 + 32 * ks + 8 * g);
                    const float4 wa0 = *(const float4*)(wsl + 32 * ks + 8 * g), wa1 = *(const float4*)(wsl + 32 * ks + 8 * g + 4);
                    const float4 wb0 = *(const float4*)(wsl + 64 + 32 * ks + 8 * g), wb1 = *(const float4*)(wsl + 64 + 32 * ks + 8 * g + 4);
                    const unsigned kw[4] = {kv.x, kv.y, kv.z, kv.w};
                    const float w0[8] = {wa0.x, wa0.y, wa0.z, wa0.w, wa1.x, wa1.y, wa1.z, wa1.w}, w1[8] = {wb0.x, wb0.y, wb0.z, wb0.w, wb1.x, wb1.y, wb1.z, wb1.w};
                    union { u32x4 u; bf16x8 f; } b0, b1;
#pragma unroll
                    for (int i = 0; i < 4; ++i) {
                        const float ka = __uint_as_float(kw[i] << 16), kb = __uint_as_float(kw[i] & 0xFFFF0000u);
                        b0.u[i] = pk2bf(ka * w0[2 * i], kb * w0[2 * i + 1]);
                        b1.u[i] = pk2bf(ka * w1[2 * i], kb * w1[2 * i + 1]);
                    }
                    u0 = __builtin_amdgcn_mfma_f32_16x16x32_bf16(va[ks], b0.f, u0, 0, 0, 0);
                    u1 = __builtin_amdgcn_mfma_f32_16x16x32_bf16(va[ks], b1.f, u1, 0, 0, 0);
                }
#pragma unroll
                for (int r = 0; r < 4; ++r) {
                    cst[(size_t)bh0 * 4096 + (16 * wid + 4 * g + r) * 64 + 16 * dkt + fr] = u0[r];
                    cst[(size_t)bh1 * 4096 + (16 * wid + 4 * g + r) * 64 + 16 * dkt + fr] = u1[r];
                }
            }
            if (tid < 128) {
                const int d = tid >> 6, dk = tid & 63;
                float acc = 0.f;
#pragma unroll 8
                for (int j = 0; j < 64; ++j) acc += bf2f(kT[dk * 72 + j]) * wsl[d * 64 + j];
                nst[(size_t)(d ? bh1 : bh0) * 64 + dk] = acc;
            }
        }
    }
}

DEVINL void ph_mlB(const P& p, int bid, int nb, char* smem) {
    const int TIDX_ = tid_(); char* const WS_ = wsl_(p.ws);
    const int tid = TIDX_;
    const float* mls = (const float*)(WS_ + OFF_MLS);
    float* mst = (float*)(WS_ + OFF_MST);
    float* nst = (float*)(WS_ + OFF_NST);
    const float* cst = (const float*)(WS_ + OFF_HM);
    u16* cst2 = (u16*)(WS_ + OFF_CST2);
    float* nst2 = (float*)(WS_ + OFF_NST2);
    float* gb = (float*)smem;
    float* dcu = gb + 1024;
    for (int u = bid; u < 64; u += nb) {
        const int bhd = u >> 2, q = u & 3, d = bhd & 1;
        auto tcof = [&](int cs) { return cs < 4 ? (d ? 3 - cs : cs) : 4 + (d ? 255 - (cs - 4) : cs - 4); };
        __syncthreads();
        for (int cs = tid; cs < NTC; cs += 256) { const int tc = tcof(cs); gb[cs * 2] = mls[(bhd * NTC + tc) * 2]; gb[cs * 2 + 1] = mls[(bhd * NTC + tc) * 2 + 1]; }
        __syncthreads();
        if (tid == 0) {
            float m = 0.f;
#pragma unroll 1
            for (int cs = 0; cs < NTC; ++cs) {
                const float G = gb[cs * 2], Bs = gb[cs * 2 + 1];
                if (q == 0) mst[bhd * NTC + tcof(cs)] = m;
                const float ml = fmaxf(Bs + m, G);
                dcu[cs * 2] = __expf(Bs + m - ml); dcu[cs * 2 + 1] = __expf(G - ml);
                m = ml;
            }
        }
        __syncthreads();
        float zz = 0.f; asm volatile("" : "+v"(zz));
        float4 C = make_float4(zz, zz, zz, zz);
        float nn = zz;
        const bool don = (q == 0) && (tid < 64);
        const float* cbase = cst + (size_t)bhd * NTC * 4096 + q * 1024 + tid * 4;
        const float* nbase = nst + (size_t)bhd * NTC * 64 + tid;
        u16* obase = cst2 + (size_t)bhd * NTC * 4096 + q * 1024 + tid * 4;
        float* onbase = nst2 + (size_t)bhd * NTC * 64 + tid;
        float4 Ub[8]; float Nb[8];
#pragma unroll
        for (int i = 0; i < 8; ++i) { Ub[i] = *(const float4*)(cbase + (size_t)tcof(i) * 4096); Nb[i] = don ? nbase[(size_t)tcof(i) * 64] : 0.f; }
#pragma unroll 1
        for (int cs0 = 0; cs0 < NTC; cs0 += 8) {
#pragma unroll
            for (int i = 0; i < 8; ++i) {
                const int cs = cs0 + i;
                if (cs < NTC) {
                    const float4 U = Ub[i]; const float nU = Nb[i];
                    const int tc = tcof(cs);
                    if (cs + 8 < NTC) { Ub[i] = *(const float4*)(cbase + (size_t)tcof(cs + 8) * 4096); Nb[i] = don ? nbase[(size_t)tcof(cs + 8) * 64] : 0.f; }
                    { uint2 o; o.x = pk2bf(C.x, C.y); o.y = pk2bf(C.z, C.w); *(uint2*)(obase + (size_t)tc * 4096) = o; }
                    if (don) onbase[(size_t)tc * 64] = nn;
                    const float dC = dcu[cs * 2], dU = dcu[cs * 2 + 1];
                    C.x = dC * C.x + dU * U.x; C.y = dC * C.y + dU * U.y; C.z = dC * C.z + dU * U.z; C.w = dC * C.w + dU * U.w;
                    nn = dC * nn + dU * nU;
                }
            }
        }
    }
}

DEVINL void ph_na(const P& p, int l, char* smem, int bid, int nb) {
    const int TIDX_ = tid_(); char* const WS_ = wsl_(p.ws);
    const int tid = TIDX_, lane = tid & 63, w = tid >> 6, fr = lane & 15, g = lane >> 4;
    const u16* pqk = (const u16*)(WS_ + OFF_PQK);
    const u16* vtl = (const u16*)(WS_ + OFF_VTL);
    const u16* vtc = (const u16*)(WS_ + OFF_VTC);
    u16* y = (u16*)(WS_ + OFF_Y);
    float* rpbl = (float*)(smem + 49152);
    const int nunit = 4096 + (l == 0 ? 64 : 0);
    const unsigned lbase = lds_addr(smem);
    const int lrow0 = tid >> 3, lrow1 = lrow0 + 32, lsc = ((tid & 7) ^ (lrow0 & 7)) * 8;
    for (int u = bid; u < nunit; u += nb) {
        const bool isctx = u >= 4096;
        int b, h, r = 0, qg = 0;
        if (!isctx) { b = u >> 11; h = (u >> 8) & 7; r = u & 255; }
        else { const int v = u - 4096; b = v >> 5; h = (v >> 2) & 7; qg = v & 3; }
        const int rs = min(max(r - 4, 0), 248);
        const int nwin = isctx ? 0 : 8, nst = nwin + 4;
        auto issue = [&](int st) {
            char* slot = smem + (st % 3) * 16384;
            const u16* ksrc; const u16* vsrc; size_t vstride;
            if (st < nwin) {
                const size_t tok0 = (size_t)CTXROWS + (size_t)b * LAT + (size_t)(rs + st) * 64;
                ksrc = pqk + tok0 * 1024 + 512 + h * 64;
                vsrc = vtl + (size_t)((b * 8 + h) * 64) * LAT + (size_t)(rs + st) * 64; vstride = LAT;
            } else {
                const size_t tok0 = (size_t)b * LCTX + (size_t)(st - nwin) * 64;
                ksrc = pqk + tok0 * 1024 + 512 + h * 64;
                vsrc = vtc + (size_t)((b * 8 + h) * 64) * LCTX + (size_t)(st - nwin) * 64; vstride = LCTX;
            }
            glds16(ksrc + (size_t)lrow0 * 1024 + lsc, slot + tid * 16);
            glds16(ksrc + (size_t)lrow1 * 1024 + lsc, slot + 4096 + tid * 16);
            glds16(vsrc + (size_t)lrow0 * vstride + lsc, slot + 8192 + tid * 16);
            glds16(vsrc + (size_t)lrow1 * vstride + lsc, slot + 8192 + 4096 + tid * 16);
        };
        __syncthreads();
        issue(0); issue(1);
        if (!isctx) for (int i = tid; i < 465; i += 256) rpbl[i] = p.na_rpb[((size_t)l * 8 + h) * 465 + i];
        asm volatile("s_waitcnt lgkmcnt(0)" ::: "memory");
        const int c = 16 * w + fr;
        const int qrow = isctx ? b * LCTX + qg * 64 + c : CTXROWS + b * LAT + r * 64 + c;
        bf16x8 qf[2];
        qf[0] = *(const bf16x8*)(pqk + (size_t)qrow * 1024 + h * 64 + 8 * g);
        qf[1] = *(const bf16x8*)(pqk + (size_t)qrow * 1024 + h * 64 + 32 + 8 * g);
        f32x4 O[4];
#pragma unroll
        for (int i = 0; i < 4; ++i) O[i] = f32x4{0.f, 0.f, 0.f, 0.f};
        float mrun = -1.0e30f, lrun = 0.f;
        const int cb = (w == 0) ? 0 : (w == 1) ? 8 : (w == 2) ? 24 : 32;
        const int cs = min(max(c - 8, 0), 48);
        auto chunk = [&](unsigned sl, int kb, const float* bias0, bool local) {
            const int key0 = kb + fr, key1 = kb + 16 + fr;
            const unsigned ka0 = sl + key0 * 128, ka1 = sl + key1 * 128;
            const unsigned k00a = ka0 + ((g ^ (key0 & 7)) << 4), k01a = ka0 + (((4 + g) ^ (key0 & 7)) << 4);
            const unsigned k10a = ka1 + ((g ^ (key1 & 7)) << 4), k11a = ka1 + (((4 + g) ^ (key1 & 7)) << 4);
            const int q0 = (kb >> 2) + g, q1 = q0 + 4;
            const unsigned vbase = sl + 8192 + fr * 128;
            const unsigned vo0 = ((((q0 >> 1) ^ (fr & 7)) << 4) + ((q0 & 1) << 3)), vo1 = ((((q1 >> 1) ^ (fr & 7)) << 4) + ((q1 & 1) << 3));
            u32x4 k00, k01, k10, k11; u32x2 vlo0, vhi0, vlo1, vhi1, vlo2, vhi2, vlo3, vhi3;
            asm volatile(
                "ds_read_b128 %0, %12\n\t"
                "ds_read_b128 %1, %13\n\t"
                "ds_read_b128 %2, %14\n\t"
                "ds_read_b128 %3, %15\n\t"
                "ds_read_b64 %4, %16\n\t"
                "ds_read_b64 %5, %17\n\t"
                "ds_read_b64 %6, %16 offset:2048\n\t"
                "ds_read_b64 %7, %17 offset:2048\n\t"
                "ds_read_b64 %8, %16 offset:4096\n\t"
                "ds_read_b64 %9, %17 offset:4096\n\t"
                "ds_read_b64 %10, %16 offset:6144\n\t"
                "ds_read_b64 %11, %17 offset:6144\n\t"
                "s_waitcnt lgkmcnt(0)"
                : "=&v"(k00), "=&v"(k01), "=&v"(k10), "=&v"(k11), "=&v"(vlo0), "=&v"(vhi0), "=&v"(vlo1), "=&v"(vhi1),
                  "=&v"(vlo2), "=&v"(vhi2), "=&v"(vlo3), "=&v"(vhi3)
                : "v"(k00a), "v"(k01a), "v"(k10a), "v"(k11a), "v"(vbase + vo0), "v"(vbase + vo1)
                : "memory");
            auto asf = [](u32x4 v) { union { u32x4 u; bf16x8 f; } x; x.u = v; return x.f; };
            f32x4 s0 = f32x4{0.f, 0.f, 0.f, 0.f}, s1 = f32x4{0.f, 0.f, 0.f, 0.f};
            s0 = __builtin_amdgcn_mfma_f32_16x16x32_bf16(asf(k00), qf[0], s0, 0, 0, 0);
            s0 = __builtin_amdgcn_mfma_f32_16x16x32_bf16(asf(k01), qf[1], s0, 0, 0, 0);
            s1 = __builtin_amdgcn_mfma_f32_16x16x32_bf16(asf(k10), qf[0], s1, 0, 0, 0);
            s1 = __builtin_amdgcn_mfma_f32_16x16x32_bf16(asf(k11), qf[1], s1, 0, 0, 0);
            float sv[8];
#pragma unroll
            for (int j = 0; j < 4; ++j) {
                float a = s0[j] * 0.125f, bb = s1[j] * 0.125f;
                if (local) {
                    const int k0c = kb + 4 * g + j, k1c = k0c + 16;
                    a = (k0c >= cs && k0c <= cs + 15) ? a + bias0[k0c] : -1.0e30f;
                    bb = (k1c >= cs && k1c <= cs + 15) ? bb + bias0[k1c] : -1.0e30f;
                }
                sv[j] = a; sv[4 + j] = bb;
            }
            float mx = sv[0];
#pragma unroll
            for (int j = 1; j < 8; ++j) mx = fmaxf(mx, sv[j]);
            mx = fmaxf(mx, __shfl_xor(mx, 16)); mx = fmaxf(mx, __shfl_xor(mx, 32));
            const float mnew = fmaxf(mrun, mx);
            const float sc = __expf(mrun - mnew);
            mrun = mnew;
            float ps = 0.f; float pv[8];
#pragma unroll
            for (int j = 0; j < 8; ++j) { pv[j] = __expf(sv[j] - mnew); ps += pv[j]; }
            lrun = lrun * sc + ps;
            union { u32x4 u; bf16x8 f; } pf; pf.u = u32x4{pk2bf(pv[0], pv[1]), pk2bf(pv[2], pv[3]), pk2bf(pv[4], pv[5]), pk2bf(pv[6], pv[7])};
            const u32x2 vl[4] = {vlo0, vlo1, vlo2, vlo3}, vh[4] = {vhi0, vhi1, vhi2, vhi3};
#pragma unroll
            for (int dt = 0; dt < 4; ++dt) {
                O[dt][0] *= sc; O[dt][1] *= sc; O[dt][2] *= sc; O[dt][3] *= sc;
                union { u32x4 u; bf16x8 f; } vf; vf.u = u32x4{vl[dt].x, vl[dt].y, vh[dt].x, vh[dt].y};
                O[dt] = __builtin_amdgcn_mfma_f32_16x16x32_bf16(vf.f, pf.f, O[dt], 0, 0, 0);
            }
        };
#pragma unroll 1
        for (int st = 0; st < nst; ++st) {
            if (st + 1 < nst) asm volatile("s_waitcnt vmcnt(4)" ::: "memory"); else asm volatile("s_waitcnt vmcnt(0)" ::: "memory");
            __builtin_amdgcn_s_barrier();
            if (st + 2 < nst) issue(st + 2);
            const unsigned sl = lbase + (st % 3) * 16384;
            if (st < nwin) {
                const int krow = rs + st;
                chunk(sl, cb, rpbl + (krow - r + 7) * 31 - c + 15, true);
            } else {
                chunk(sl, 0, nullptr, false);
                chunk(sl, 32, nullptr, false);
            }
        }
        float lt = lrun; lt += __shfl_xor(lt, 16); lt += __shfl_xor(lt, 32);
        const float inv = 1.f / lt;
#pragma unroll
        for (int dt = 0; dt < 4; ++dt) {
            uint2 o;
            o.x = pk2bf(O[dt][0] * inv, O[dt][1] * inv);
            o.y = pk2bf(O[dt][2] * inv, O[dt][3] * inv);
            *(uint2*)(y + (size_t)qrow * 1024 + h * 64 + dt * 16 + 4 * g) = o;
        }
    }
    asm volatile("s_waitcnt vmcnt(0)" ::: "memory");
    __syncthreads();
}

DEVINL void ph_mlC(const P& p, int l, char* smem, int bid, int nb) {
    const int TIDX_ = tid_(); char* const WS_ = wsl_(p.ws);
    const int tid = TIDX_, lane = tid & 63, w = tid >> 6, fr = lane & 15, g = lane >> 4;
    const u16* mlf = (const u16*)(WS_ + OFF_MLF);
    const u16* pc = (const u16*)(WS_ + OFF_PC);
    const float* mlg = (const float*)(WS_ + OFF_MLG);
    const float* mst = (const float*)(WS_ + OFF_MST);
    const float* nst = (const float*)(WS_ + OFF_NST2);
    const u16* cst = (const u16*)(WS_ + OFF_CST2);
    u16* y = (u16*)(WS_ + OFF_Y);
    u16* vt = (u16*)smem;
    float* btl = (float*)(smem + 9216);
    float* lil = btl + 128;
    float* nl = lil + 128;
    for (int uh = bid; uh < 2 * NTC * 4; uh += nb) {
        const int u = uh >> 2, h = uh & 3;
        const int b = u / NTC, tc = u % NTC;
        if (tc < 4 && l != 0) continue;
        const int row0 = tc < 4 ? b * LCTX + tc * 64 : CTXROWS + b * LAT + (tc - 4) * 64;
        __syncthreads();
        for (int i = tid; i < 64 * 8; i += 256) {
            const int tok = i >> 3, d8 = (i & 7) * 8;
            const uint4 vv = *(const uint4*)(pc + (size_t)(row0 + tok) * 1040 + 512 + h * 64 + d8);
            const unsigned wv[4] = {vv.x, vv.y, vv.z, vv.w};
#pragma unroll
            for (int k = 0; k < 4; ++k) { vt[(d8 + 2 * k) * 72 + tok] = (u16)(wv[k] & 0xFFFFu); vt[(d8 + 2 * k + 1) * 72 + tok] = (u16)(wv[k] >> 16); }
        }
        if (tid < 128) {
            const int d = tid >> 6, tok = tid & 63;
            lil[d * 64 + tok] = mlg[(size_t)(row0 + tok) * 16 + d * 4 + h];
            nl[d * 64 + tok] = nst[((size_t)((b * 4 + h) * 2 + d) * NTC + tc) * 64 + tok];
        }
        else { const int d = (tid - 128) >> 6, tok = tid & 63; btl[d * 64 + tok] = mlg[(size_t)(row0 + tok) * 16 + 8 + d * 4 + h]; }
        const int t = 16 * w + fr;
        bf16x8 qf[2];
        qf[0] = *(const bf16x8*)(mlf + (size_t)(row0 + t) * 512 + h * 64 + 8 * g);
        qf[1] = *(const bf16x8*)(mlf + (size_t)(row0 + t) * 512 + h * 64 + 32 + 8 * g);
        f32x4 S[4];
#pragma unroll
        for (int st = 0; st < 4; ++st) {
            const u16* kp = mlf + (size_t)(row0 + 16 * st + fr) * 512 + 256 + h * 64 + 8 * g;
            const bf16x8 k0 = *(const bf16x8*)kp, k1 = *(const bf16x8*)(kp + 32);
            S[st] = f32x4{0.f, 0.f, 0.f, 0.f};
            S[st] = __builtin_amdgcn_mfma_f32_16x16x32_bf16(k0, qf[0], S[st], 0, 0, 0);
            S[st] = __builtin_amdgcn_mfma_f32_16x16x32_bf16(k1, qf[1], S[st], 0, 0, 0);
        }
        __syncthreads();
        f32x4 hs[4];
#pragma unroll
        for (int i = 0; i < 4; ++i) hs[i] = f32x4{0.f, 0.f, 0.f, 0.f};
#pragma unroll 1
        for (int d = 0; d < 2; ++d) {
            const int bhd = (b * 4 + h) * 2 + d;
            const float m0 = mst[bhd * NTC + tc];
            const float bt = btl[d * 64 + t];
            float ld[16]; float mx = -3.0e38f;
#pragma unroll
            for (int st = 0; st < 4; ++st) {
                const float4 b4 = *(const float4*)(btl + d * 64 + 16 * st + 4 * g), l4 = *(const float4*)(lil + d * 64 + 16 * st + 4 * g);
                const float bs[4] = {b4.x, b4.y, b4.z, b4.w}, ls[4] = {l4.x, l4.y, l4.z, l4.w};
#pragma unroll
                for (int r = 0; r < 4; ++r) {
                    const int s = 16 * st + 4 * g + r;
                    const bool ok = d ? (s >= t) : (s <= t);
                    ld[4 * st + r] = ok ? (bt - bs[r] + ls[r]) : -3.0e38f;
                    mx = fmaxf(mx, ld[4 * st + r]);
                }
            }
            mx = fmaxf(mx, __shfl_xor(mx, 16)); mx = fmaxf(mx, __shfl_xor(mx, 32));
            const float mt = fmaxf(bt + m0, mx);
            float rsum = 0.f; float dw[16];
#pragma unroll
            for (int i = 0; i < 16; ++i) { dw[i] = (ld[i] > -1.0e38f) ? __expf(ld[i] - mt) * S[i >> 2][i & 3] : 0.f; rsum += dw[i]; }
            rsum += __shfl_xor(rsum, 16); rsum += __shfl_xor(rsum, 32);
            const float inter = __expf(bt + m0 - mt);
            float qn = 0.f;
#pragma unroll
            for (int j = 0; j < 8; ++j) {
                qn += bf2f((u16)qf[0][j]) * nl[d * 64 + 8 * g + j] + bf2f((u16)qf[1][j]) * nl[d * 64 + 32 + 8 * g + j];
            }
            qn += __shfl_xor(qn, 16); qn += __shfl_xor(qn, 32);
            const float den = rsum + inter * qn;
            const float dn = 1.f / fmaxf(fabsf(den), __expf(-mt));
            union { u32x4 u; bf16x8 f; } pf[2];
#pragma unroll
            for (int ks = 0; ks < 2; ++ks) pf[ks].u = u32x4{pk2bf(dw[8 * ks], dw[8 * ks + 1]), pk2bf(dw[8 * ks + 2], dw[8 * ks + 3]), pk2bf(dw[8 * ks + 4], dw[8 * ks + 5]), pk2bf(dw[8 * ks + 6], dw[8 * ks + 7])};
            const u16* cb = cst + ((size_t)bhd * NTC + tc) * 4096;
#pragma unroll
            for (int dvt = 0; dvt < 4; ++dvt) {
                f32x4 num = f32x4{0.f, 0.f, 0.f, 0.f}, qc = f32x4{0.f, 0.f, 0.f, 0.f};
#pragma unroll
                for (int ks = 0; ks < 2; ++ks) {
                    const uint2 lo = *(const uint2*)(vt + (16 * dvt + fr) * 72 + 32 * ks + 4 * g), hi = *(const uint2*)(vt + (16 * dvt + fr) * 72 + 32 * ks + 16 + 4 * g);
                    union { u32x4 u; bf16x8 f; } vf; vf.u = u32x4{lo.x, lo.y, hi.x, hi.y};
                    num = __builtin_amdgcn_mfma_f32_16x16x32_bf16(vf.f, pf[ks].f, num, 0, 0, 0);
                    const bf16x8 cf = *(const bf16x8*)(cb + (16 * dvt + fr) * 64 + 32 * ks + 8 * g);
                    qc = __builtin_amdgcn_mfma_f32_16x16x32_bf16(cf, qf[ks], qc, 0, 0, 0);
                }
#pragma unroll
                for (int r = 0; r < 4; ++r) hs[dvt][r] += (num[r] + inter * qc[r]) * dn;
            }
        }
        float s1 = 0.f;
#pragma unroll
        for (int i = 0; i < 4; ++i) s1 += hs[i][0] + hs[i][1] + hs[i][2] + hs[i][3];
        s1 += __shfl_xor(s1, 16); s1 += __shfl_xor(s1, 32);
        const float mu = s1 * (1.f / 64.f);
        float s2 = 0.f;
#pragma unroll
        for (int i = 0; i < 4; ++i)
#pragma unroll
            for (int r = 0; r < 4; ++r) { const float dl = hs[i][r] - mu; s2 += dl * dl; }
        s2 += __shfl_xor(s2, 16); s2 += __shfl_xor(s2, 32);
        const float rstd = rsqrtf(s2 * (1.f / 64.f) + 1e-6f);
        const int row = row0 + t;
#pragma unroll
        for (int dvt = 0; dvt < 4; ++dvt) {
            const int cc = h * 64 + 16 * dvt + 4 * g;
            const uint2 ov = *(const uint2*)(pc + (size_t)row * 1040 + 768 + cc);
            const float4 nw = *(const float4*)(p.ml_nw + l * 256 + cc);
            const float o0 = bf2f((u16)(ov.x & 0xFFFF)), o1 = bf2f((u16)(ov.x >> 16)), o2 = bf2f((u16)(ov.y & 0xFFFF)), o3 = bf2f((u16)(ov.y >> 16));
            uint2 out;
            out.x = pk2bf((hs[dvt][0] - mu) * rstd * nw.x * sigmoidf_(o0), (hs[dvt][1] - mu) * rstd * nw.y * sigmoidf_(o1));
            out.y = pk2bf((hs[dvt][2] - mu) * rstd * nw.z * sigmoidf_(o2), (hs[dvt][3] - mu) * rstd * nw.w * sigmoidf_(o3));
            *(uint2*)(y + (size_t)row * 1024 + 768 + cc) = out;
        }
    }
}

DEVINL void ph_outproj(const P& p, int l, char* smem) {
    const int TIDX_ = tid_(); const int BIDX_ = bid_(); char* const WS_ = wsl_(p.ws); (void)TIDX_; (void)BIDX_; (void)WS_;
    const u16* y = (const u16*)(WS_ + OFF_Y);
    const u16* wout = (const u16*)(WS_ + OFF_WOUT);
    const float* modv = (const float*)(WS_ + OFF_MOD) + (size_t)l * 3 * 6144;
    const float* x2c = (const float*)(WS_ + OFF_X2CTX);
    float* x1 = (float*)(WS_ + OFF_X1);
    const int mt0 = (l == 0) ? 0 : 4;
    const int ntile = (260 - mt0) * 8;
    XCD_WALK(ntile, BIDX_, (int)gridDim.x);
    for (int u = xw_lo; u < xw_hi; u += xw_st) {
        const int mt = mt0 + u / 8, nt = u % 8;
        const u16* A = y + (size_t)mt * 128 * 1024;
        const int R0 = mt * 128;
        const float* xin;
        if (l == 0) xin = R0 < CTXROWS ? p.ctx + (size_t)R0 * 1024 : p.x + (size_t)(R0 - CTXROWS) * 1024;
        else xin = R0 < CTXROWS ? x2c + (size_t)R0 * 1024 : p.out + (size_t)(R0 - CTXROWS) * 1024;
        const float* g1 = modv + row_sel(R0) * 6144 + 2048;
        f32x4 acc[4][4];
        gemm128_acc([&](int r) { return A + (size_t)r * 1024; }, wout + (size_t)nt * 128 * 1024, 1024, 1024, smem, acc);
        stage_tile_f32(acc, smem, [&](int row, int c4, float4 a) {
            const int N = nt * 128 + c4;
            const float4 gg = *(const float4*)(g1 + N);
            const float4 xv = *(const float4*)(xin + (size_t)row * 1024 + N);
            float4 o;
            o.x = ALPHA * xv.x + gg.x * a.x; o.y = ALPHA * xv.y + gg.y * a.y; o.z = ALPHA * xv.z + gg.z * a.z; o.w = ALPHA * xv.w + gg.w * a.w;
            *(float4*)(x1 + (size_t)(R0 + row) * 1024 + N) = o;
        });
    }
}

DEVINL void ph_ln1(const P& p, int l) {
    const int TIDX_ = tid_(); const int BIDX_ = bid_(); char* const WS_ = wsl_(p.ws); (void)TIDX_; (void)BIDX_; (void)WS_;
    const int lane = TIDX_ & 63, wid = TIDX_ >> 6;
    const float* modv = (const float*)(WS_ + OFF_MOD) + (size_t)l * 3 * 6144;
    float* x1 = (float*)(WS_ + OFF_X1);
    u16* hm = (u16*)(WS_ + OFF_HM);
    const int rstart = (l == 0) ? 0 : CTXROWS;
    const int rstride = (int)gridDim.x * 4;
#pragma unroll 1
    for (int row0 = rstart + BIDX_ * 4 + wid; row0 < T; row0 += 2 * rstride) {
        int rowv[2]; rowv[0] = row0; rowv[1] = row0 + rstride;
        const bool has1 = rowv[1] < T;
        if (!has1) rowv[1] = row0;
        float4 v[2][4];
        float s[2] = {0.f, 0.f};
#pragma unroll
        for (int r = 0; r < 2; ++r)
#pragma unroll
            for (int i = 0; i < 4; ++i) { v[r][i] = *(const float4*)(x1 + (size_t)rowv[r] * 1024 + i * 256 + lane * 4); s[r] += v[r][i].x + v[r][i].y + v[r][i].z + v[r][i].w; }
#pragma unroll
        for (int r = 0; r < 2; ++r) {
            if (r == 1 && !has1) break;
            const int row = rowv[r];
            const float mu = wsum(s[r]) * (1.f / 1024.f);
            float q = 0.f;
#pragma unroll
            for (int i = 0; i < 4; ++i) { v[r][i].x -= mu; v[r][i].y -= mu; v[r][i].z -= mu; v[r][i].w -= mu; q += v[r][i].x * v[r][i].x + v[r][i].y * v[r][i].y + v[r][i].z * v[r][i].z + v[r][i].w * v[r][i].w; }
            const float rstd = rsqrtf(wsum(q) * (1.f / 1024.f) + 1e-5f);
            const float* mv = modv + row_sel(row) * 6144;
#pragma unroll
            for (int i = 0; i < 4; ++i) {
                const int c = i * 256 + lane * 4;
                const float4 g = *(const float4*)(p.ln1g + l * 1024 + c), bb = *(const float4*)(p.ln1b + l * 1024 + c);
                const float4 sh = *(const float4*)(mv + 3072 + c), sc = *(const float4*)(mv + 4096 + c);
                float4 o;
                o.x = v[r][i].x * rstd * g.x + bb.x; o.y = v[r][i].y * rstd * g.y + bb.y; o.z = v[r][i].z * rstd * g.z + bb.z; o.w = v[r][i].w * rstd * g.w + bb.w;
                *(float4*)(x1 + (size_t)row * 1024 + c) = o;
                uint2 hh;
                hh.x = (unsigned)f2bf(o.x * (1.f + sc.x) + sh.x) | ((unsigned)f2bf(o.y * (1.f + sc.y) + sh.y) << 16);
                hh.y = (unsigned)f2bf(o.z * (1.f + sc.z) + sh.z) | ((unsigned)f2bf(o.w * (1.f + sc.w) + sh.w) << 16);
                *(uint2*)(hm + (size_t)row * 1024 + c) = hh;
            }
        }
    }
}

DEVINL void ph_router(const P& p, int l, char* smem) {
    const int TIDX_ = tid_(); const int BIDX_ = bid_(); char* const WS_ = wsl_(p.ws); (void)TIDX_; (void)BIDX_; (void)WS_;
    const u16* hm = (const u16*)(WS_ + OFF_HM);
    const u16* wr = (const u16*)(WS_ + OFF_WR) + (size_t)l * 128 * 1024;
    float* lg = (float*)(WS_ + OFF_LOGITS);
    const int mt0 = (l == 0) ? 0 : 4;
    for (int u = BIDX_; u < 260 - mt0; u += gridDim.x) {
        const int mt = mt0 + u;
        const u16* A = hm + (size_t)mt * 128 * 1024;
        gemm128([&](int r) { return A + (size_t)r * 1024; }, wr, 1024, 1024, smem,
                [&](int m, int n, f32x4 a) {
                    if (n < 36) {
#pragma unroll
                        for (int j = 0; j < 4; ++j) lg[(size_t)(mt * 128 + m + j) * 64 + n] = a[j];
                    }
                });
    }
}

DEVINL void ph_route1(const P& p, int l, char* smem) {
    const int TIDX_ = tid_(); const int BIDX_ = bid_(); char* const WS_ = wsl_(p.ws); (void)TIDX_; (void)BIDX_; (void)WS_;
    const int tid = TIDX_;
    const float* lg = (const float*)(WS_ + OFF_LOGITS);
    int* toke = (int*)(WS_ + OFF_TOKE); float* tokw = (float*)(WS_ + OFF_TOKW);
    int* cnt = (int*)(WS_ + CTL_CNT) + l * 32;
    int* hist = (int*)smem;
    __syncthreads();
    if (tid < 32) hist[tid] = 0;
    __syncthreads();
    const int rstart = (l == 0) ? 0 : CTXROWS;
    for (int row = rstart + BIDX_ * 256 + tid; row < T; row += gridDim.x * 256) {
        const float* q = lg + (size_t)row * 64;
        float gl[4]; int gs = 0; float gm = -3.0e38f;
#pragma unroll
        for (int i = 0; i < 4; ++i) { gl[i] = q[i] + p.rgb[l * 4 + i]; if (gl[i] > gm) { gm = gl[i]; gs = i; } }
        float se = 0.f;
#pragma unroll
        for (int i = 0; i < 4; ++i) se += expf(gl[i] - gm);
        const float gw = 1.f / se;
        float v1 = -3.0e38f, v2 = -3.0e38f; int i1 = 0, i2 = 0;
#pragma unroll
        for (int i = 0; i < 8; ++i) {
            const float e = q[4 + gs * 8 + i] + p.reb[l * 32 + gs * 8 + i];
            if (e > v1) { v2 = v1; i2 = i1; v1 = e; i1 = i; }
            else if (e > v2) { v2 = e; i2 = i; }
        }
        const float e2 = expf(v2 - v1);
        const float w1 = gw / (1.f + e2), w2 = gw * e2 / (1.f + e2);
        const int ea = gs * 8 + i1, eb = gs * 8 + i2;
        toke[row * 2] = ea; toke[row * 2 + 1] = eb; tokw[row * 2] = w1; tokw[row * 2 + 1] = w2;
        atomicAdd(&hist[ea], 1); atomicAdd(&hist[eb], 1);
    }
    __syncthreads();
    if (tid < 32 && hist[tid] > 0) atomicAdd(&cnt[tid], hist[tid]);
}

DEVINL void ph_route2(const P& p, int l, char* smem) {
    const int TIDX_ = tid_(); const int BIDX_ = bid_(); char* const WS_ = wsl_(p.ws); (void)TIDX_; (void)BIDX_; (void)WS_;
    const int tid = TIDX_;
    const int* toke = (const int*)(WS_ + OFF_TOKE);
    int* toks = (int*)(WS_ + OFF_TOKS);
    int* slottok = (int*)(WS_ + OFF_SLOTTOK);
    const int* cnt = (const int*)(WS_ + CTL_CNT) + l * 32;
    int* cur = (int*)(WS_ + CTL_CUR) + l * 32;
    int* tiles = (int*)(WS_ + OFF_TILES);
    int* off = (int*)smem;
    int* hist = off + 64;
    int* base = hist + 32;
    __syncthreads();
    if (tid == 0) { int a = 0; for (int e = 0; e < 32; ++e) { off[e] = a; a += (cnt[e] + 127) & ~127; } off[32] = a; }
    if (tid < 32) hist[tid] = 0;
    __syncthreads();
    if (BIDX_ == 0) {
        if (tid == 0) {
            int nt = 0;
#pragma clang loop vectorize(disable) unroll(disable)
            for (int e = 0; e < 32; ++e) {
#pragma clang loop vectorize(disable) unroll(disable)
                for (int s = off[e]; s < off[e + 1]; s += 128) { tiles[64 + nt * 2] = e; tiles[64 + nt * 2 + 1] = s; ++nt; }
            }
            tiles[40] = nt;
        }
#pragma clang loop vectorize(disable) unroll(disable)
        for (int e = 0; e < 32; ++e) {
#pragma clang loop vectorize(disable) unroll(disable)
            for (int s = off[e] + cnt[e] + tid; s < off[e + 1]; s += 256) slottok[s] = (l == 0) ? 0 : CTXROWS;
        }
    }
    const int rstart = (l == 0) ? 0 : CTXROWS;
    for (int a0 = rstart * 2 + BIDX_ * 256; a0 < T * 2; a0 += gridDim.x * 256) {
        const int a = a0 + tid;
        int e = -1, lpos = 0;
        if (a < T * 2) { e = toke[a]; lpos = atomicAdd(&hist[e], 1); }
        __syncthreads();
        if (tid < 32) { base[tid] = hist[tid] > 0 ? atomicAdd(&cur[tid], hist[tid]) : 0; }
        __syncthreads();
        if (e >= 0) { const int s = off[e] + base[e] + lpos; toks[a] = s; slottok[s] = a >> 1; }
        __syncthreads();
        if (tid < 32) hist[tid] = 0;
        __syncthreads();
    }
}

DEVINL void ph_gateup(const P& p, char* smem) {
    const int TIDX_ = tid_(); const int BIDX_ = bid_(); char* const WS_ = wsl_(p.ws); (void)TIDX_; (void)BIDX_; (void)WS_;
    const int tid = TIDX_, lane = tid & 63, wid = tid >> 6, wr = wid >> 1, wc = wid & 1, fr = lane & 15, fq = lane >> 4;
    const u16* hm = (const u16*)(WS_ + OFF_HM);
    const u16* wgu = (const u16*)(WS_ + OFF_WGU);
    const int* tiles = (const int*)(WS_ + OFF_TILES);
    const int* slottok = (const int*)(WS_ + OFF_SLOTTOK);
    u16* act = (u16*)(WS_ + OFF_ACT);
    const int ntile = tiles[40] * 8;
    XCD_WALK(ntile, BIDX_, (int)gridDim.x);
    for (int u = xw_lo; u < xw_hi; u += xw_st) {
        const int ti = u >> 3, nt = u & 7;
        const int e = tiles[64 + ti * 2], s0 = tiles[64 + ti * 2 + 1];
        f32x4 acc[4][4];
        gemm128_acc([&](int r) { return hm + (size_t)slottok[s0 + r] * 1024; }, wgu + ((size_t)e * 1024 + nt * 128) * 1024, 1024, 1024, smem, acc);
        {
            u16* t = (u16*)smem;
            __syncthreads();
#pragma unroll
            for (int m = 0; m < 4; ++m)
#pragma unroll
                for (int n = 0; n < 4; n += 2) {
                    const int jc = (wc * 64 + n * 16) / 2 + fr;
                    const int r0 = wr * 64 + m * 16 + fq * 4;
                    float av[4];
#pragma unroll
                    for (int j = 0; j < 4; ++j) { const float gte = acc[m][n][j], up = acc[m][n + 1][j]; av[j] = gte / (1.f + __expf(-gte)) * up; }
                    const unsigned p01 = pk2bf(av[0], av[1]), p23 = pk2bf(av[2], av[3]);
                    t[(r0 + 0) * 72 + jc] = (u16)(p01 & 0xFFFFu); t[(r0 + 1) * 72 + jc] = (u16)(p01 >> 16);
                    t[(r0 + 2) * 72 + jc] = (u16)(p23 & 0xFFFFu); t[(r0 + 3) * 72 + jc] = (u16)(p23 >> 16);
                }
            __syncthreads();
#pragma unroll
            for (int i = 0; i < 4; ++i) {
                const int ci = tid + 256 * i, row = ci >> 3, c8 = (ci & 7) * 8;
                *(uint4*)(act + (size_t)(s0 + row) * 512 + nt * 64 + c8) = *(const uint4*)(t + row * 72 + c8);
            }
        }
    }
}

DEVINL void ph_down(const P& p, char* smem) {
    const int TIDX_ = tid_(); const int BIDX_ = bid_(); char* const WS_ = wsl_(p.ws); (void)TIDX_; (void)BIDX_; (void)WS_;
    const u16* act = (const u16*)(WS_ + OFF_ACT);
    const u16* wdn = (const u16*)(WS_ + OFF_WDN);
    const int* tiles = (const int*)(WS_ + OFF_TILES);
    u16* so = (u16*)(WS_ + OFF_SLOTOUT);
    const int ntile = tiles[40] * 8;
    XCD_WALK(ntile, BIDX_, (int)gridDim.x);
    for (int u = xw_lo; u < xw_hi; u += xw_st) {
        const int ti = u >> 3, nt = u & 7;
        const int e = tiles[64 + ti * 2], s0 = tiles[64 + ti * 2 + 1];
        const u16* A = act + (size_t)s0 * 512;
        f32x4 acc[4][4];
        gemm128_acc([&](int r) { return A + (size_t)r * 512; }, wdn + ((size_t)e * 1024 + nt * 128) * 512, 512, 512, smem, acc);
        stage_tile_bf16(acc, smem, [&](int row, int c8, uint4 v) { *(uint4*)(so + (size_t)(s0 + row) * 1024 + nt * 128 + c8) = v; });
    }
}

DEVINL void ph_ln2(const P& p, int l) {
    const int TIDX_ = tid_(); const int BIDX_ = bid_(); char* const WS_ = wsl_(p.ws); (void)TIDX_; (void)BIDX_; (void)WS_;
    const int lane = TIDX_ & 63, wid = TIDX_ >> 6;
    const float* modv = (const float*)(WS_ + OFF_MOD) + (size_t)l * 3 * 6144;
    const float* modn = (const float*)(WS_ + OFF_MOD) + (size_t)(l + 1) * 3 * 6144;
    const float* x1 = (const float*)(WS_ + OFF_X1);
    const u16* so = (const u16*)(WS_ + OFF_SLOTOUT);
    const int* toks = (const int*)(WS_ + OFF_TOKS);
    const float* tokw = (const float*)(WS_ + OFF_TOKW);
    float* x2c = (float*)(WS_ + OFF_X2CTX);
    u16* hm = (u16*)(WS_ + OFF_HM);
    const int rstart = (l == 0) ? 0 : CTXROWS;
    const int rstride = (int)gridDim.x * 4;
#pragma unroll 1
    for (int row0 = rstart + BIDX_ * 4 + wid; row0 < T; row0 += 2 * rstride) {
        int rowv[2]; rowv[0] = row0; rowv[1] = row0 + rstride;
        const bool has1 = rowv[1] < T;
        if (!has1) rowv[1] = row0;
        int sa[2], sb[2]; float wa[2], wb[2];
#pragma unroll
        for (int r = 0; r < 2; ++r) { sa[r] = toks[rowv[r] * 2]; sb[r] = toks[rowv[r] * 2 + 1]; wa[r] = tokw[rowv[r] * 2]; wb[r] = tokw[rowv[r] * 2 + 1]; }
        float4 v[2][4];
        float s[2] = {0.f, 0.f};
#pragma unroll
        for (int r = 0; r < 2; ++r) {
            const float* mv = modv + row_sel(rowv[r]) * 6144;
#pragma unroll
            for (int i = 0; i < 4; ++i) {
                const int c = i * 256 + lane * 4;
                const float4 xv = *(const float4*)(x1 + (size_t)rowv[r] * 1024 + c);
                const uint2 ua = *(const uint2*)(so + (size_t)sa[r] * 1024 + c), ub = *(const uint2*)(so + (size_t)sb[r] * 1024 + c);
                const float4 g2 = *(const float4*)(mv + 5120 + c);
                const float f0 = wa[r] * bf2f((u16)(ua.x & 0xFFFF)) + wb[r] * bf2f((u16)(ub.x & 0xFFFF));
                const float f1 = wa[r] * bf2f((u16)(ua.x >> 16)) + wb[r] * bf2f((u16)(ub.x >> 16));
                const float f2 = wa[r] * bf2f((u16)(ua.y & 0xFFFF)) + wb[r] * bf2f((u16)(ub.y & 0xFFFF));
                const float f3 = wa[r] * bf2f((u16)(ua.y >> 16)) + wb[r] * bf2f((u16)(ub.y >> 16));
                v[r][i].x = ALPHA * xv.x + g2.x * f0; v[r][i].y = ALPHA * xv.y + g2.y * f1; v[r][i].z = ALPHA * xv.z + g2.z * f2; v[r][i].w = ALPHA * xv.w + g2.w * f3;
                s[r] += v[r][i].x + v[r][i].y + v[r][i].z + v[r][i].w;
            }
        }
#pragma unroll
        for (int r = 0; r < 2; ++r) {
            if (r == 1 && !has1) break;
            const int row = rowv[r];
            const float mu = wsum(s[r]) * (1.f / 1024.f);
            float q = 0.f;
#pragma unroll
            for (int i = 0; i < 4; ++i) { v[r][i].x -= mu; v[r][i].y -= mu; v[r][i].z -= mu; v[r][i].w -= mu; q += v[r][i].x * v[r][i].x + v[r][i].y * v[r][i].y + v[r][i].z * v[r][i].z + v[r][i].w * v[r][i].w; }
            const float rstd = rsqrtf(wsum(q) * (1.f / 1024.f) + 1e-5f);
            float* dst = row < CTXROWS ? x2c + (size_t)row * 1024 : p.out + (size_t)(row - CTXROWS) * 1024;
            const float* mn = modn + row_sel(row) * 6144;
#pragma unroll
            for (int i = 0; i < 4; ++i) {
                const int c = i * 256 + lane * 4;
                const float4 g = *(const float4*)(p.ln2g + l * 1024 + c), bb = *(const float4*)(p.ln2b + l * 1024 + c);
                float4 o;
                o.x = v[r][i].x * rstd * g.x + bb.x; o.y = v[r][i].y * rstd * g.y + bb.y; o.z = v[r][i].z * rstd * g.z + bb.z; o.w = v[r][i].w * rstd * g.w + bb.w;
                *(float4*)(dst + c) = o;
                if (l == 0) {
                    const float4 sh = *(const float4*)(mn + c), sc = *(const float4*)(mn + 1024 + c);
                    uint2 hh;
                    hh.x = (unsigned)f2bf(o.x * (1.f + sc.x) + sh.x) | ((unsigned)f2bf(o.y * (1.f + sc.y) + sh.y) << 16);
                    hh.y = (unsigned)f2bf(o.z * (1.f + sc.z) + sh.z) | ((unsigned)f2bf(o.w * (1.f + sc.w) + sh.w) << 16);
                    *(uint2*)(hm + (size_t)row * 1024 + c) = hh;
                }
            }
        }
    }
}

DEVINL void gbar(XcdBarrier b) {
    unsigned x = b.x; GAS unsigned* q = (GAS unsigned*)b.bar;
    asm volatile("" : "+s"(x), "+s"(q));
    b.x = x; b.bar = (unsigned*)q;
    xcd_barrier(b);
}
#ifndef PROBE
#define PROBE 0
#endif
#ifndef TPROBE
#define TPROBE 0
#endif
__global__ void __launch_bounds__(256, 2) k_mega(P p) {
    __shared__ __attribute__((aligned(16))) char smem[SMEM_BYTES];
    if (threadIdx.x == 0) *(uint4*)(smem + SMEM_BYTES - 16) = make_uint4(0u, 0u, 0u, 0u);
    __syncthreads();
    XcdBarrier bar = xcd_barrier_post((unsigned*)p.ws, (volatile LAS unsigned*)(smem + SMEM_BYTES - 16));
    const int bid = blockIdx.x, nb = gridDim.x;
#if TPROBE
    unsigned long long tp_acc = 0, tp_last = wall_clock64();
#define TP(g) do { const unsigned long long _n = wall_clock64(); if ((g) == TPROBE) tp_acc += _n - tp_last; tp_last = _n; } while (0)
#else
#define TP(g) do { } while (0)
#endif
    if (threadIdx.x == 0) {
        const unsigned key = ((unsigned)__builtin_amdgcn_s_getreg((3 << 11) | 20) << 8) | ((unsigned)__builtin_amdgcn_s_getreg((7 << 11) | (8 << 6) | 4) & 0xFFu);
        ((unsigned*)(p.ws + CTL_CUKEY))[blockIdx.x] = key | 0x80000000u;
    }
    ph_prolog(p, smem);
    ph_convw(p, 0, smem);
    gbar(bar);
    TP(1);
    ph_xm0(p);
    gbar(bar);
    TP(1);
    constexpr int NSCAN = 16;
    bool quiet; int wrank, nwork, mate_of = -1;
    {
        const unsigned* keys = (const unsigned*)(p.ws + CTL_CUKEY);
        int* cnt = (int*)smem;
        if (threadIdx.x < 2) cnt[threadIdx.x] = 0;
        __syncthreads();
        for (int i = NSCAN + threadIdx.x; i < nb; i += 256) {
            const unsigned k = keys[i];
            bool qq = false;
            for (int j = 0; j < NSCAN && j < nb; ++j) qq = qq || (keys[j] == k);
            if (qq) { atomicAdd(&cnt[1], 1); if (i < bid) atomicAdd(&cnt[0], 1); }
        }
        __syncthreads();
        const int below = cnt[0], total = cnt[1];
        bool me = false;
        if (bid >= NSCAN) { const unsigned k = keys[bid]; for (int j = NSCAN - 1; j >= 0; --j) if (j < nb && keys[j] == k) { me = true; mate_of = j; } }
        __syncthreads();
        if (total > 2 * NSCAN) { quiet = false; wrank = bid - NSCAN; nwork = nb - NSCAN; mate_of = -1; }
        else { quiet = me; wrank = bid - NSCAN - below; nwork = nb - NSCAN - total; }
    }
#pragma unroll 1
    for (int l = 0; l < NLAYER; ++l) {
        ph_inproj(p, smem);
        gbar(bar);
    TP(2);
        ph_rwprep(p, l, 0, smem, bid, nb);
        ph_prepM(p, l, smem, nb - 1 - bid, nb);
        gbar(bar);
    TP(3);
        if (bid < NSCAN) ph_rwscan(p, l, 0, bid, NSCAN, smem);
        else if (!quiet) { if (nwork > 128) { if (wrank < 64) ph_mlB(p, wrank, 64, smem); else ph_na(p, l, smem, wrank - 64, nwork - 64); } else { ph_mlB(p, wrank, nwork, smem); ph_na(p, l, smem, wrank, nwork); } }
        gbar(bar);
    TP(4);
        ph_rwprep(p, l, 1, smem, bid, nb);
        gbar(bar);
    TP(5);
        if (bid < NSCAN) ph_rwscan(p, l, 1, bid, NSCAN, smem);
        else if (!quiet) { ph_mlC(p, l, smem, wrank, nwork); ph_convexp(p, l, smem, wrank, nwork); }
        gbar(bar);
    TP(6);
        ph_rwout(p, l);
        gbar(bar);
    TP(7);
        ph_outproj(p, l, smem);
        gbar(bar);
    TP(8);
        ph_ln1(p, l);
        gbar(bar);
    TP(9);
        ph_router(p, l, smem);
        gbar(bar);
    TP(9);
        ph_route1(p, l, smem);
        gbar(bar);
    TP(9);
        ph_route2(p, l, smem);
        gbar(bar);
    TP(9);
        ph_gateup(p, smem);
        gbar(bar);
    TP(10);
        ph_down(p, smem);
        gbar(bar);
    TP(11);
        ph_ln2(p, l);
        if (l + 1 < NLAYER) ph_convw(p, l + 1, smem);
        gbar(bar);
    TP(12);
    }
#if TPROBE
    if (bid == 0 && threadIdx.x == 0) { const unsigned long long t_end = wall_clock64() + tp_acc; while (wall_clock64() < t_end) __builtin_amdgcn_s_sleep(8); }
    __syncthreads();
    gbar(bar);
#endif
}


extern "C" void kernel_launch(void* const* d_in, const int* in_sizes, int n_in, void* d_out, int out_size, void* d_ws, size_t ws_size,
                              hipStream_t stream) {
    if (n_in != 37 || ws_size < WS_NEED) { fprintf(stderr, "kernel_launch: n_in %d ws %zu need %zu\n", n_in, ws_size, (size_t)WS_NEED); return; }
    static int grid = 0;
    if (!grid) {
        int dev = 0, cus = 0, per_cu = 0;
        (void)hipGetDevice(&dev);
        (void)hipDeviceGetAttribute(&cus, hipDeviceAttributeMultiprocessorCount, dev);
        (void)hipOccupancyMaxActiveBlocksPerMultiprocessor(&per_cu, (const void*)k_mega, 256, 0);
        if (per_cu < 1) per_cu = 1;
        grid = cus * (per_cu < 2 ? per_cu : 2);
    }
    P p{};
    const float** pp = (const float**)&p;
    for (int i = 0; i < 37; ++i) pp[i] = (const float*)d_in[i];
    p.out = (float*)d_out; p.ws = (char*)d_ws;
    (void)hipMemsetAsync(d_ws, 0, CTL_BYTES, stream);
    k_mega<<<dim3(grid), dim3(256), 0, stream>>>(p);
}
```

```cpp
#include <hip/hip_runtime.h>
#include <hip/hip_bf16.h>
#include <stdint.h>
#include <stdio.h>
#include <type_traits>
#ifndef TPROBE
#define TPROBE 0
#endif
#if TPROBE >= 30
__device__ unsigned long long g_tp_acc, g_tp_last;
#define RWTP(g) do { if (blockIdx.x == 0 && threadIdx.x == 0) { const unsigned long long _n = wall_clock64(); if ((g) == TPROBE) g_tp_acc += _n - g_tp_last; g_tp_last = _n; } } while (0)
#else
#define RWTP(g) do { } while (0)
#endif


#define DEVINL __device__ __forceinline__
typedef unsigned short u16;
using bf16x8 = __attribute__((ext_vector_type(8))) short;
using f32x4 = __attribute__((ext_vector_type(4))) float;

constexpr int D = 1024, LAT = 16384, LCTX = 256, T = 33280, CTXROWS = 512;
constexpr int INP = 3536;
constexpr int NLAYER = 2;
constexpr float ALPHA = 1.41421356237309515f;
constexpr int NUNIT_CH = 520;
constexpr int NTC = 260;
constexpr int MAXSLOT = 70656;
constexpr int SMEM_BYTES = 81920;

constexpr size_t al(size_t x) { return (x + 255) & ~(size_t)255; }
constexpr size_t CTL_CNT = 16384;
constexpr size_t CTL_CUR = CTL_CNT + 256;
constexpr size_t CTL_CUKEY = 20480;
constexpr size_t CTL_PROG = 24576;
constexpr size_t CTL_BYTES = 32768;
constexpr size_t OFF_MOD = CTL_BYTES;
constexpr size_t OFF_ROPE = OFF_MOD + al(2 * 3 * 6144 * 4);
constexpr size_t OFF_WR = OFF_ROPE + al(10240 * 4);
constexpr size_t OFF_LORA = OFF_WR + al(2 * 128 * 1024 * 2);
constexpr size_t OFF_TILES = OFF_LORA + al(3 * 65536);
constexpr size_t OFF_TOKE = OFF_TILES + al((64 + 2048) * 4);
constexpr size_t OFF_TOKW = OFF_TOKE + al((size_t)T * 2 * 4);
constexpr size_t OFF_TOKS = OFF_TOKW + al((size_t)T * 2 * 4);
constexpr size_t OFF_SLOTTOK = OFF_TOKS + al((size_t)T * 2 * 4);
constexpr size_t OFF_X2CTX = OFF_SLOTTOK + al((size_t)MAXSLOT * 4);
constexpr size_t OFF_ZST = OFF_X2CTX + al((size_t)512 * 1024 * 4);
constexpr size_t OFF_WIN = OFF_ZST + al((size_t)16 * 4 * 64 * 16 * 4);
constexpr size_t OFF_WOUT = OFF_WIN + al((size_t)3584 * 1024 * 2);
constexpr size_t OFF_X1 = OFF_WOUT + al((size_t)1024 * 1024 * 2);
constexpr size_t OFF_HM = OFF_X1 + al((size_t)T * 1024 * 4);
constexpr size_t OFF_P = OFF_HM + al((size_t)T * 1024 * 2);
constexpr size_t OFF_PQK = OFF_P;
constexpr size_t OFF_VTL = OFF_PQK + (size_t)T * 1024 * 2;
constexpr size_t OFF_VTC = OFF_VTL + (size_t)2 * 8 * 64 * 16384 * 2;
constexpr size_t OFF_PB = OFF_VTC + (size_t)2 * 8 * 64 * 256 * 2;
constexpr size_t OFF_PC = OFF_PB + (size_t)T * 960 * 2;
constexpr size_t OFF_Y = OFF_PC + (size_t)T * 1040 * 2;
constexpr size_t OFF_MLF = OFF_Y + (size_t)T * 1024 * 2;
constexpr size_t OFF_GATE = OFF_MLF + (size_t)T * 512 * 2;
constexpr size_t OFF_MLG = OFF_GATE + (size_t)T * 256 * 2;
constexpr size_t OFF_MLS = OFF_MLG + (size_t)T * 16 * 4;
constexpr size_t OFF_MST = OFF_MLS + al(16 * 260 * 2 * 4);
constexpr size_t OFF_NST = OFF_MST + al(16 * 260 * 4);
constexpr size_t OFF_CST2 = OFF_NST + al(16 * 260 * 64 * 4);
constexpr size_t OFF_NST2 = OFF_CST2 + (size_t)16 * 260 * 4096 * 2;
constexpr size_t OFF_END1 = OFF_NST2 + al(16 * 260 * 64 * 4);
constexpr size_t OFF_WGU = OFF_P;
constexpr size_t OFF_WDN = OFF_WGU + (size_t)32 * 1024 * 1024 * 2;
constexpr size_t OFF_ACT = OFF_WDN + (size_t)32 * 1024 * 512 * 2;
constexpr size_t OFF_SLOTOUT = OFF_ACT + (size_t)MAXSLOT * 512 * 2;
constexpr size_t OFF_LOGITS = OFF_SLOTOUT + (size_t)MAXSLOT * 1024 * 2;
constexpr size_t OFF_END2 = OFF_LOGITS + (size_t)T * 64 * 4;
constexpr size_t WS_NEED = OFF_END1 > OFF_END2 ? OFF_END1 : OFF_END2;
static_assert(OFF_WDN <= OFF_Y, "Wexp must not overlap y");
static_assert(OFF_LOGITS >= OFF_MLF, "logits placement");

struct P {
    const float *x, *c, *ctx, *c_ctx, *w_mod, *b_mod, *w_in, *na_rpb, *mu_prev, *mu_next, *rw_w0, *rw_w2, *rw_a0, *rw_a2,
        *rw_g2, *rw_kk, *rw_ka, *rw_rk, *rw_lnw, *rw_lnb, *ml_cw, *ml_cb, *ml_ib, *ml_fb, *ml_nw, *w_out, *ln1g, *ln1b,
        *rgw, *rgb, *rew, *reb, *egate, *eup, *edown, *ln2g, *ln2b;
    float* out;
    char* ws;
};

#define XB_TMO      128
#define XB_XCNT(j)  (256  + 64 * (j))
#define XB_XSUB(j)  (1280 + 64 * (j))
#define XB_XGEN(j)  (2304 + 64 * (j))
#define XB_TOP      3328
#define XB_TOPGEN   3392
#define XCD_BAR_WORDS 3456
#define XB_SPIN_CAP (1u << 18)
#define LAS __attribute__((address_space(3)))

__device__ __forceinline__ unsigned xb_ld(unsigned* p)              { return __hip_atomic_load(p, __ATOMIC_RELAXED, __HIP_MEMORY_SCOPE_AGENT); }
__device__ __forceinline__ unsigned xb_add(unsigned* p, unsigned v) { return __hip_atomic_fetch_add(p, v, __ATOMIC_RELAXED, __HIP_MEMORY_SCOPE_AGENT); }
__device__ __forceinline__ unsigned xb_xcc_id() { return (unsigned)__builtin_amdgcn_s_getreg((3 << 11) | 20) & 0xFu; }
#define XB_SPIN(cond, bar) do { unsigned _sp = 0; while (cond) { __builtin_amdgcn_s_sleep(1); \
    if ((++_sp & 255u) == 0u) { if (xb_ld(&(bar)[XB_TMO])) break; if (_sp > XB_SPIN_CAP) { atomicAdd(&(bar)[XB_TMO], 1u); break; } } } } while (0)

struct XcdBarrier {
    unsigned* bar; unsigned x;
    volatile LAS unsigned* st;
};

__device__ __forceinline__ XcdBarrier xcd_barrier_post(unsigned* bar, volatile LAS unsigned* st) {
    XcdBarrier b; b.bar = bar; b.x = xb_xcc_id(); b.st = st;
    if (threadIdx.x == 0) (void)xb_add(&bar[XB_XCNT(b.x)], 1u);
    return b;
}
__device__ __forceinline__ void xcd_barrier_complete(unsigned* bar, unsigned x, unsigned& nloc, unsigned& nx) {
    const unsigned G = gridDim.x * gridDim.y * gridDim.z;
    unsigned sum, cnt, mine, sp = 0u;
    for (;;) {
        sum = 0u; cnt = 0u; mine = 0u;
#pragma unroll
        for (unsigned j = 0; j < 16; ++j) { const unsigned c = xb_ld(&bar[XB_XCNT(j)]); sum += c; cnt += (c > 0u) ? 1u : 0u; mine = (j == x) ? c : mine; }
        if (sum == G) break;
        __builtin_amdgcn_s_sleep(1);
        if ((++sp & 255u) == 0u) { if (xb_ld(&bar[XB_TMO])) break; if (sp > XB_SPIN_CAP) { atomicAdd(&bar[XB_TMO], 1u); break; } }
    }
    nloc = mine > 0u ? mine : 1u; nx = cnt > 0u ? cnt : 1u;
}

__device__ __forceinline__ void xcd_barrier(const XcdBarrier& b) {
    asm volatile("s_waitcnt vmcnt(0)" ::: "memory");
    __syncthreads();
    if (threadIdx.x == 0) {
        unsigned* bar = b.bar;
        __builtin_amdgcn_s_waitcnt(0);
        unsigned nloc = b.st[0], nx = b.st[1];
        if (nloc == 0u) { xcd_barrier_complete(bar, b.x, nloc, nx); b.st[0] = nloc; b.st[1] = nx; }
        const unsigned old = xb_add(&bar[XB_XSUB(b.x)], 1u);
        const unsigned gen = old / nloc;
        if (old + 1u == (gen + 1u) * nloc) {
            __builtin_amdgcn_fence(__ATOMIC_RELEASE, "agent");
            asm volatile("s_waitcnt vmcnt(0)" ::: "memory");
            const unsigned og = xb_add(&bar[XB_TOP], 1u);
            const unsigned tg = og / nx;
            if (og + 1u == (tg + 1u) * nx) xb_add(&bar[XB_TOPGEN], 1u);
            else XB_SPIN(xb_ld(&bar[XB_TOPGEN]) == tg, bar);
            __builtin_amdgcn_fence(__ATOMIC_ACQUIRE, "agent");
            xb_add(&bar[XB_XGEN(b.x)], 1u);
            asm volatile("s_waitcnt vmcnt(0)" ::: "memory");
        } else {
            XB_SPIN(xb_ld(&bar[XB_XGEN(b.x)]) == gen, bar);
            __builtin_amdgcn_fence(__ATOMIC_ACQUIRE, "agent");
            asm volatile("s_waitcnt vmcnt(0)" ::: "memory");
        }
    }
    __syncthreads();
}


DEVINL int tid_() { int t = threadIdx.x; asm volatile("" : "+v"(t)); return t; }
DEVINL int bid_() { int b = blockIdx.x; asm volatile("" : "+s"(b)); return b; }
#define GAS __attribute__((address_space(1)))
DEVINL char* wsl_(char* w) { GAS char* g = (GAS char*)w; asm volatile("" : "+s"(g)); return (char*)g; }
template <class Tp> DEVINL const Tp* gl_(const Tp* q) { const GAS Tp* g = (const GAS Tp*)q; asm volatile("" : "+s"(g)); return (const Tp*)g; }
typedef float f32x2_t __attribute__((ext_vector_type(2)));
typedef __bf16 bf16x2_t __attribute__((ext_vector_type(2)));
DEVINL unsigned pk2bf(float lo, float hi) { f32x2_t f = {lo, hi}; bf16x2_t b = __builtin_convertvector(f, bf16x2_t); return __builtin_bit_cast(unsigned, b); }
DEVINL u16 f2bf(float f) { return (u16)(pk2bf(f, f) & 0xFFFFu); }
DEVINL float bf2f(u16 h) { return __uint_as_float(((unsigned)h) << 16); }
DEVINL float wsum(float v) { for (int o = 32; o > 0; o >>= 1) v += __shfl_xor(v, o); return v; }
DEVINL float sigmoidf_(float x) { return 1.f / (1.f + __expf(-x)); }
DEVINL float siluf_(float x) { return x / (1.f + __expf(-x)); }
DEVINL float softplusf_(float x) { return fmaxf(x, 0.f) + log1pf(__expf(-fabsf(x))); }
DEVINL int row_sel(int row) { return row < CTXROWS ? 2 : ((row - CTXROWS) >> 14); }
template <int CTRL, int RM>
DEVINL float dpp_f(float v) { return __int_as_float(__builtin_amdgcn_update_dpp(0, __float_as_int(v), CTRL, RM, 0xF, false)); }
DEVINL float wave_sum_dpp(float v) {
    v += dpp_f<0xB1, 0xF>(v);
    v += dpp_f<0x4E, 0xF>(v);
    v += dpp_f<0x141, 0xF>(v);
    v += dpp_f<0x140, 0xF>(v);
    v += dpp_f<0x142, 0xA>(v);
    v += dpp_f<0x143, 0xC>(v);
    return __int_as_float(__builtin_amdgcn_readlane(__float_as_int(v), 63));
}
DEVINL unsigned lds_addr(const void* p) { return (unsigned)(size_t)(const __attribute__((address_space(3))) char*)p; }
using u32x4 = __attribute__((ext_vector_type(4))) unsigned;
using u32x2 = __attribute__((ext_vector_type(2))) unsigned;
template <int OFF> DEVINL u32x4 lds_rd128(unsigned a) { u32x4 v; asm volatile("ds_read_b128 %0, %1 offset:%2" : "=v"(v) : "v"(a), "n"(OFF)); return v; }
template <int OFF> DEVINL u32x2 lds_rd64(unsigned a) { u32x2 v; asm volatile("ds_read_b64 %0, %1 offset:%2" : "=v"(v) : "v"(a), "n"(OFF)); return v; }
DEVINL void glds4(const void* g, void* l) {
    __builtin_amdgcn_global_load_lds((const __attribute__((address_space(1))) void*)g, (__attribute__((address_space(3))) void*)l, 4, 0, 0);
}
DEVINL void glds16nt(const void* g, void* l) {
    __builtin_amdgcn_global_load_lds((const __attribute__((address_space(1))) void*)g, (__attribute__((address_space(3))) void*)l, 16, 0, 2);
}
DEVINL void glds16(const void* g, void* l) {
    __builtin_amdgcn_global_load_lds((const __attribute__((address_space(1))) void*)g, (__attribute__((address_space(3))) void*)l, 16, 0, 0);
}

#define XCD_WALK(total_, bid_v, nb_v) \
    const bool xw_8 = (((nb_v) & 7) == 0); \
    const int xw_per = xw_8 ? (((((total_) + 7) >> 3) + 7) & ~7) : (total_); \
    const int xw_base = xw_8 ? ((bid_v) & 7) * xw_per : 0; \
    const int xw_lo = xw_base + (xw_8 ? ((bid_v) >> 3) : (bid_v)); \
    const int xw_hi = min((int)(total_), xw_base + xw_per); \
    const int xw_st = xw_8 ? ((nb_v) >> 3) : (nb_v)

template <class RowA>
DEVINL void gemm128_acc(RowA rowA, const u16* __restrict__ Bt, int ldb, int K, char* smem, f32x4 (&acc)[4][4]) {
    const int tid = tid_(), lane = tid & 63, wid = tid >> 6, wr = wid >> 1, wc = wid & 1, fr = lane & 15, fq = lane >> 4;
#pragma unroll
    for (int m = 0; m < 4; ++m)
#pragma unroll
        for (int n = 0; n < 4; ++n) acc[m][n] = f32x4{0.f, 0.f, 0.f, 0.f};
    const int sc = ((tid & 7) ^ ((tid >> 3) & 7)) * 8;
    const u16* aS[4]; const u16* bS[4];
#pragma unroll
    for (int i = 0; i < 4; ++i) { const int r = (tid >> 3) + 32 * i; aS[i] = rowA(r) + sc; bS[i] = Bt + (size_t)r * ldb + sc; }
    const int nt = K >> 6;
    const unsigned pos0 = (unsigned)((fq ^ (fr & 7)) * 16);
    const unsigned adA0 = lds_addr(smem) + (unsigned)((wr * 64 + fr) * 128) + pos0, adA1 = adA0 ^ 64u;
    const unsigned adB0 = lds_addr(smem) + 16384u + (unsigned)((wc * 64 + fr) * 128) + pos0, adB1 = adB0 ^ 64u;
    __syncthreads();
#pragma unroll
    for (int s = 0; s < 2; ++s)
#pragma unroll
        for (int i = 0; i < 4; ++i) { glds16(aS[i] + s * 64, smem + s * 32768 + (tid + 256 * i) * 16); glds16(bS[i] + s * 64, smem + s * 32768 + 16384 + (tid + 256 * i) * 16); }
#define GEMM_MM(A_, B_, m_, n_) acc[m_][n_] = __builtin_amdgcn_mfma_f32_16x16x32_bf16(__builtin_bit_cast(bf16x8, A_), __builtin_bit_cast(bf16x8, B_), acc[m_][n_], 0, 0, 0)
#define GEMM_STEP(s, t) do { \
        if ((t) + 1 < nt) asm volatile("s_waitcnt vmcnt(8)" ::: "memory"); else asm volatile("s_waitcnt vmcnt(0)" ::: "memory"); \
        __builtin_amdgcn_s_barrier(); \
        u32x4 b0_, b1_, b2_, b3_, a0_, a1_, a2_, a3_, d0_, d1_, d2_, d3_, c0_, c1_, c2_, c3_; \
        asm volatile( \
            "ds_read_b128 %0, %17 offset:%20\n\t" \
            "ds_read_b128 %1, %17 offset:%20+2048\n\t" \
            "ds_read_b128 %2, %17 offset:%20+4096\n\t" \
            "ds_read_b128 %3, %17 offset:%20+6144\n\t" \
            "ds_read_b128 %4, %16 offset:%20\n\t" \
            "ds_read_b128 %5, %16 offset:%20+2048\n\t" \
            "ds_read_b128 %6, %16 offset:%20+4096\n\t" \
            "ds_read_b128 %7, %16 offset:%20+6144\n\t" \
            "ds_read_b128 %8, %19 offset:%20\n\t" \
            "ds_read_b128 %9, %19 offset:%20+2048\n\t" \
            "ds_read_b128 %10, %19 offset:%20+4096\n\t" \
            "ds_read_b128 %11, %19 offset:%20+6144\n\t" \
            "ds_read_b128 %12, %18 offset:%20\n\t" \
            "ds_read_b128 %13, %18 offset:%20+2048\n\t" \
            "ds_read_b128 %14, %18 offset:%20+4096\n\t" \
            "ds_read_b128 %15, %18 offset:%20+6144\n\t" \
            "s_waitcnt lgkmcnt(0)" \
            : "=&v"(b0_), "=&v"(b1_), "=&v"(b2_), "=&v"(b3_), "=&v"(a0_), "=&v"(a1_), "=&v"(a2_), "=&v"(a3_), \
              "=&v"(d0_), "=&v"(d1_), "=&v"(d2_), "=&v"(d3_), "=&v"(c0_), "=&v"(c1_), "=&v"(c2_), "=&v"(c3_) \
            : "v"(adA0), "v"(adB0), "v"(adA1), "v"(adB1), "n"((s) * 32768) : "memory"); \
        __builtin_amdgcn_s_barrier(); \
        if ((t) + 2 < nt) { \
            char* SA_ = smem + (s) * 32768; const int ko_ = ((t) + 2) * 64; \
            _Pragma("unroll") for (int i = 0; i < 4; ++i) { glds16(aS[i] + ko_, SA_ + (tid + 256 * i) * 16); glds16(bS[i] + ko_, SA_ + 16384 + (tid + 256 * i) * 16); } \
        } \
        GEMM_MM(a0_, b0_, 0, 0); GEMM_MM(a0_, b1_, 0, 1); GEMM_MM(a0_, b2_, 0, 2); GEMM_MM(a0_, b3_, 0, 3); \
        GEMM_MM(a1_, b0_, 1, 0); GEMM_MM(a1_, b1_, 1, 1); GEMM_MM(a1_, b2_, 1, 2); GEMM_MM(a1_, b3_, 1, 3); \
        GEMM_MM(a2_, b0_, 2, 0); GEMM_MM(a2_, b1_, 2, 1); GEMM_MM(a2_, b2_, 2, 2); GEMM_MM(a2_, b3_, 2, 3); \
        GEMM_MM(a3_, b0_, 3, 0); GEMM_MM(a3_, b1_, 3, 1); GEMM_MM(a3_, b2_, 3, 2); GEMM_MM(a3_, b3_, 3, 3); \
        GEMM_MM(c0_, d0_, 0, 0); GEMM_MM(c0_, d1_, 0, 1); GEMM_MM(c0_, d2_, 0, 2); GEMM_MM(c0_, d3_, 0, 3); \
        GEMM_MM(c1_, d0_, 1, 0); GEMM_MM(c1_, d1_, 1, 1); GEMM_MM(c1_, d2_, 1, 2); GEMM_MM(c1_, d3_, 1, 3); \
        GEMM_MM(c2_, d0_, 2, 0); GEMM_MM(c2_, d1_, 2, 1); GEMM_MM(c2_, d2_, 2, 2); GEMM_MM(c2_, d3_, 2, 3); \
        GEMM_MM(c3_, d0_, 3, 0); GEMM_MM(c3_, d1_, 3, 1); GEMM_MM(c3_, d2_, 3, 2); GEMM_MM(c3_, d3_, 3, 3); \
    } while (0)
#pragma unroll 1
    for (int t = 0; t < nt; t += 2) {
        GEMM_STEP(0, t); GEMM_STEP(1, t + 1);
    }
#undef GEMM_STEP
#undef GEMM_MM
}
template <class RowA, class Epi>
DEVINL void gemm128(RowA rowA, const u16* __restrict__ Bt, int ldb, int K, char* smem, Epi epi) {
    const int tid = tid_(), lane = tid & 63, wid = tid >> 6, wr = wid >> 1, wc = wid & 1, fr = lane & 15, fq = lane >> 4;
    f32x4 acc[4][4];
    gemm128_acc(rowA, Bt, ldb, K, smem, acc);
#pragma unroll
    for (int m = 0; m < 4; ++m)
#pragma unroll
        for (int n = 0; n < 4; ++n) epi(wr * 64 + m * 16 + fq * 4, wc * 64 + n * 16 + fr, acc[m][n]);
}

template <class Emit>
DEVINL void stage_tile_bf16(const f32x4 (&acc)[4][4], char* smem, Emit emit) {
    const int tid = tid_(), lane = tid & 63, wid = tid >> 6, wr = wid >> 1, wc = wid & 1, fr = lane & 15, fq = lane >> 4;
    u16* t = (u16*)smem;
    __syncthreads();
#pragma unroll
    for (int m = 0; m < 4; ++m)
#pragma unroll
        for (int n = 0; n < 4; ++n) {
            const int r0 = wr * 64 + m * 16 + fq * 4, c = wc * 64 + n * 16 + fr;
            const unsigned p01 = pk2bf(acc[m][n][0], acc[m][n][1]), p23 = pk2bf(acc[m][n][2], acc[m][n][3]);
            t[(r0 + 0) * 136 + c] = (u16)(p01 & 0xFFFFu); t[(r0 + 1) * 136 + c] = (u16)(p01 >> 16);
            t[(r0 + 2) * 136 + c] = (u16)(p23 & 0xFFFFu); t[(r0 + 3) * 136 + c] = (u16)(p23 >> 16);
        }
    __syncthreads();
#pragma unroll
    for (int i = 0; i < 8; ++i) {
        const int ci = tid + 256 * i, row = ci >> 4, c8 = (ci & 15) * 8;
        emit(row, c8, *(const uint4*)(t + row * 136 + c8));
    }
}

template <class Emit>
DEVINL void stage_tile_f32(const f32x4 (&acc)[4][4], char* smem, Emit emit) {
    const int tid = tid_(), lane = tid & 63, wid = tid >> 6, wr = wid >> 1, wc = wid & 1, fr = lane & 15, fq = lane >> 4;
    float* t = (float*)smem;
    __syncthreads();
#pragma unroll
    for (int m = 0; m < 4; ++m)
#pragma unroll
        for (int n = 0; n < 4; ++n) {
            const int r0 = wr * 64 + m * 16 + fq * 4, c = wc * 64 + n * 16 + fr;
#pragma unroll
            for (int j = 0; j < 4; ++j) t[(r0 + j) * 132 + c] = acc[m][n][j];
        }
    __syncthreads();
#pragma unroll 4
    for (int i = 0; i < 16; ++i) {
        const int ci = tid + 256 * i, row = ci >> 5, c4 = (ci & 31) * 4;
        emit(row, c4, *(const float4*)(t + row * 132 + c4));
    }
}

DEVINL void ph_prolog(const P& p, char* smem) {
    const int TIDX_ = tid_(); const int BIDX_ = bid_(); char* const WS_ = wsl_(p.ws); (void)TIDX_; (void)BIDX_; (void)WS_;
    const int tid = TIDX_;
    float* modv = (float*)(WS_ + OFF_MOD);
    float* sil = (float*)smem;
    float* red = sil + 3072;
    bool ready = false;
    for (int u = BIDX_; u < 192; u += gridDim.x) {
        if (!ready) {
            for (int i = tid; i < 3072; i += 256) { int v = i >> 10, k = i & 1023; float cv = v < 2 ? p.c[v * 1024 + k] : p.c_ctx[k]; sil[i] = cv / (1.f + expf(-cv)); }
            ready = true;
        }
        __syncthreads();
        const int l = u / 96, cg = u % 96;
        const float* W = p.w_mod + (size_t)l * 1024 * 6144 + cg * 64;
        const int c4 = (tid & 15) * 4, rg = tid >> 4;
        float a0[4] = {0, 0, 0, 0}, a1[4] = {0, 0, 0, 0}, a2[4] = {0, 0, 0, 0};
#pragma unroll 4
        for (int i = 0; i < 64; ++i) {
            const int k = rg + 16 * i;
            const float4 w = *(const float4*)(W + (size_t)k * 6144 + c4);
            const float s0 = sil[k], s1 = sil[1024 + k], s2 = sil[2048 + k];
            a0[0] += s0 * w.x; a0[1] += s0 * w.y; a0[2] += s0 * w.z; a0[3] += s0 * w.w;
            a1[0] += s1 * w.x; a1[1] += s1 * w.y; a1[2] += s1 * w.z; a1[3] += s1 * w.w;
            a2[0] += s2 * w.x; a2[1] += s2 * w.y; a2[2] += s2 * w.z; a2[3] += s2 * w.w;
        }
#pragma unroll
        for (int j = 0; j < 4; ++j) { red[(rg * 3 + 0) * 64 + c4 + j] = a0[j]; red[(rg * 3 + 1) * 64 + c4 + j] = a1[j]; red[(rg * 3 + 2) * 64 + c4 + j] = a2[j]; }
        __syncthreads();
        if (tid < 192) {
            const int v = tid >> 6, cc = tid & 63;
            float s = 0.f;
            for (int r = 0; r < 16; ++r) s += red[(r * 3 + v) * 64 + cc];
            const int col = cg * 64 + cc;
            modv[(l * 3 + v) * 6144 + col] = s + p.b_mod[l * 6144 + col];
        }
        __syncthreads();
    }
    float* rope = (float*)(WS_ + OFF_ROPE);
    for (int i = BIDX_ * 256 + tid; i < 320 * 16; i += gridDim.x * 256) {
        const int pos = (i < 4096) ? (i >> 4) : ((i - 4096) >> 4);
        const int f = i & 15;
        const float inv = powf(10000.0f, -(float)f / 16.0f);
        const float ang = (float)pos * inv;
        const double TWO_PI = 6.283185307179586476925;
        double a = (double)ang;
        a -= TWO_PI * rint(a / TWO_PI);
        const float cr = (float)cos(a), sr = (float)sin(a);
        if (i < 4096) { rope[i] = cr; rope[4096 + i] = sr; }
        else { rope[8192 + (i - 4096)] = cr; rope[8192 + 1024 + (i - 4096)] = sr; }
    }
    {
        u16* w2t = (u16*)(WS_ + OFF_LORA); u16* a2t = w2t + 2 * 2 * 256 * 32; u16* g2t = a2t + 2 * 2 * 256 * 32;
        for (int i = BIDX_ * 256 + tid; i < 2 * 2 * 256 * 32; i += gridDim.x * 256) {
            const int lz = i >> 13, c = (i >> 5) & 255, r = i & 31;
            w2t[i] = f2bf(p.rw_w2[((size_t)lz * 32 + r) * 256 + c]);
            a2t[i] = f2bf(p.rw_a2[((size_t)lz * 32 + r) * 256 + c]);
        }
        for (int i = BIDX_ * 256 + tid; i < 2 * 256 * 64; i += gridDim.x * 256) {
            const int l = i >> 14, c = (i >> 6) & 255, r = i & 63;
            g2t[i] = f2bf(p.rw_g2[((size_t)l * 64 + r) * 256 + c]);
        }
    }
    u16* wr = (u16*)(WS_ + OFF_WR);
    for (int i = BIDX_ * 256 + tid; i < 2 * 128 * 1024; i += gridDim.x * 256) {
        const int l = i >> 17, n = (i >> 10) & 127, k = i & 1023;
        float v = 0.f;
        if (n < 4) v = p.rgw[((size_t)l * 1024 + k) * 4 + n];
        else if (n < 36) v = p.rew[((size_t)l * 1024 + k) * 32 + (n - 4)];
        wr[i] = f2bf(v);
    }
}

DEVINL void conv_tile(const float* __restrict__ src, int N, int K, u16* __restrict__ dst, int k0, int n0, int mode, char* smem) {
    unsigned* t = (unsigned*)smem;
    const int tid = tid_();
    const int n4 = (tid & 15) * 4;
    const bool ok = n0 + n4 < N;
    float4 va[2], vb[2];
    __syncthreads();
#pragma unroll
    for (int i = 0; i < 2; ++i) {
        const int kp = i * 16 + (tid >> 4);
        const float* s0 = src + (size_t)(k0 + 2 * kp) * N + n0 + n4;
        va[i] = ok ? *(const float4*)s0 : make_float4(0.f, 0.f, 0.f, 0.f);
        vb[i] = ok ? *(const float4*)(s0 + N) : make_float4(0.f, 0.f, 0.f, 0.f);
    }
#pragma unroll
    for (int i = 0; i < 2; ++i) {
        const int kp = i * 16 + (tid >> 4);
        t[(n4 + 0) * 33 + kp] = pk2bf(va[i].x, vb[i].x);
        t[(n4 + 1) * 33 + kp] = pk2bf(va[i].y, vb[i].y);
        t[(n4 + 2) * 33 + kp] = pk2bf(va[i].z, vb[i].z);
        t[(n4 + 3) * 33 + kp] = pk2bf(va[i].w, vb[i].w);
    }
    __syncthreads();
    {
        const int n = tid >> 2, w0 = (tid & 3) * 8;
        const int ng = n0 + n;
        int nd = ng;
        if (mode == 1) nd = 32 * (ng >> 4) + (ng & 15);
        else if (mode == 2) nd = 32 * (ng >> 4) + 16 + (ng & 15);
        uint4 o0, o1;
        o0.x = t[n * 33 + w0 + 0]; o0.y = t[n * 33 + w0 + 1]; o0.z = t[n * 33 + w0 + 2]; o0.w = t[n * 33 + w0 + 3];
        o1.x = t[n * 33 + w0 + 4]; o1.y = t[n * 33 + w0 + 5]; o1.z = t[n * 33 + w0 + 6]; o1.w = t[n * 33 + w0 + 7];
        u16* q = dst + (size_t)nd * K + k0 + w0 * 2;
        *(uint4*)q = o0; *(uint4*)(q + 8) = o1;
    }
}
DEVINL void ph_convw(const P& p, int l, char* smem) {
    const int TIDX_ = tid_(); const int BIDX_ = bid_(); char* const WS_ = wsl_(p.ws); (void)TIDX_; (void)BIDX_; (void)WS_;
    u16* win = (u16*)(WS_ + OFF_WIN); u16* wout = (u16*)(WS_ + OFF_WOUT);
    for (int u = BIDX_; u < 896 + 256; u += gridDim.x) {
        if (u < 896) conv_tile(p.w_in + (size_t)l * 1024 * INP, INP, 1024, win, (u / 56) * 64, (u % 56) * 64, 0, smem);
        else { const int v = u - 896; conv_tile(p.w_out + (size_t)l * 1024 * 1024, 1024, 1024, wout, (v / 16) * 64, (v % 16) * 64, 0, smem); }
    }
}
DEVINL void ph_convexp(const P& p, int l, char* smem, int bid, int nb) {
    const int TIDX_ = tid_(); const int BIDX_ = bid_(); char* const WS_ = wsl_(p.ws); (void)TIDX_; (void)BIDX_; (void)WS_;
    u16* wgu = (u16*)(WS_ + OFF_WGU); u16* wdn = (u16*)(WS_ + OFF_WDN);
    for (int u = bid; u < 32 * 384; u += nb) {
        const int e = u / 384, v = u % 384;
        const size_t le = (size_t)l * 32 + e;
        if (v < 128) conv_tile(p.egate + le * 1024 * 512, 512, 1024, wgu + (size_t)e * 1024 * 1024, (v / 8) * 64, (v % 8) * 64, 1, smem);
        else if (v < 256) { const int w = v - 128; conv_tile(p.eup + le * 1024 * 512, 512, 1024, wgu + (size_t)e * 1024 * 1024, (w / 8) * 64, (w % 8) * 64, 2, smem); }
        else { const int w = v - 256; conv_tile(p.edown + le * 512 * 1024, 1024, 512, wdn + (size_t)e * 1024 * 512, (w / 16) * 64, (w % 16) * 64, 0, smem); }
    }
}

DEVINL void ph_xm0(const P& p) {
    const int TIDX_ = tid_(); const int BIDX_ = bid_(); char* const WS_ = wsl_(p.ws); (void)TIDX_; (void)BIDX_; (void)WS_;
    const float* modv = (const float*)(WS_ + OFF_MOD);
    u16* hm = (u16*)(WS_ + OFF_HM);
    for (size_t i = (size_t)BIDX_ * 256 + TIDX_; i < (size_t)T * 256; i += (size_t)gridDim.x * 256) {
        const int row = (int)(i >> 8), c4 = (int)(i & 255) * 4;
        const float* src = row < CTXROWS ? p.ctx + (size_t)row * 1024 : p.x + (size_t)(row - CTXROWS) * 1024;
        const float* mv = modv + row_sel(row) * 6144;
        const float4 v = *(const float4*)(src + c4);
        const float4 sh = *(const float4*)(mv + c4), sc = *(const float4*)(mv + 1024 + c4);
        uint2 o;
        o.x = (unsigned)f2bf(v.x * (1.f + sc.x) + sh.x) | ((unsigned)f2bf(v.y * (1.f + sc.y) + sh.y) << 16);
        o.y = (unsigned)f2bf(v.z * (1.f + sc.z) + sh.z) | ((unsigned)f2bf(v.w * (1.f + sc.w) + sh.w) << 16);
        *(uint2*)(hm + (size_t)row * 1024 + c4) = o;
    }
}

DEVINL void ph_inproj(const P& p, char* smem) {
    const int TIDX_ = tid_(); const int BIDX_ = bid_(); char* const WS_ = wsl_(p.ws); (void)TIDX_; (void)BIDX_; (void)WS_;
    const u16* hm = (const u16*)(WS_ + OFF_HM);
    const u16* win = (const u16*)(WS_ + OFF_WIN);
    u16* pqk = (u16*)(WS_ + OFF_PQK); u16* vtl = (u16*)(WS_ + OFF_VTL); u16* vtc = (u16*)(WS_ + OFF_VTC);
    u16* pb = (u16*)(WS_ + OFF_PB); u16* pc = (u16*)(WS_ + OFF_PC);
    XCD_WALK(260 * 28, BIDX_, (int)gridDim.x);
    for (int o = xw_lo; o < xw_hi; o += xw_st) {
        const int g = o / 224, w = o % 224;
        const int mt = g < 32 ? g * 8 + (w & 7) : 256 + (w & 3), nt = g < 32 ? (w >> 3) : (w >> 2);
        const u16* A = hm + (size_t)mt * 128 * 1024;
        f32x4 acc[4][4];
        gemm128_acc([&](int r) { return A + (size_t)r * 1024; }, win + (size_t)nt * 128 * 1024, 1024, 1024, smem, acc);
        if (nt >= 8 && nt < 12) {
            const int tid = tid_(), lane = tid & 63, wid = tid >> 6, wr = wid >> 1, wc = wid & 1, fr = lane & 15, fq = lane >> 4;
#pragma unroll
            for (int m = 0; m < 4; ++m)
#pragma unroll
                for (int n = 0; n < 4; ++n) {
                    const int R = mt * 128 + wr * 64 + m * 16 + fq * 4, N = nt * 128 + wc * 64 + n * 16 + fr;
                    const int hh = (N - 1024) >> 6, d = (N - 1024) & 63;
                    uint2 v; v.x = pk2bf(acc[m][n][0], acc[m][n][1]); v.y = pk2bf(acc[m][n][2], acc[m][n][3]);
                    if (R < CTXROWS) { const int b = R >> 8, t = R & 255; *(uint2*)(vtc + ((size_t)((b * 8 + hh) * 64 + d)) * 256 + t) = v; }
                    else { const int R2 = R - CTXROWS, b = R2 >> 14, t = R2 & 16383; *(uint2*)(vtl + ((size_t)((b * 8 + hh) * 64 + d)) * 16384 + t) = v; }
                }
        } else {
            stage_tile_bf16(acc, smem, [&](int row, int c8, uint4 v) {
                const int R = mt * 128 + row, N = nt * 128 + c8;
                if (N >= INP) return;
                if (N < 1024) *(uint4*)(pqk + (size_t)R * 1024 + N) = v;
                else if (N < 2496) *(uint4*)(pb + (size_t)R * 960 + (N - 1536)) = v;
                else *(uint4*)(pc + (size_t)R * 1040 + (N - 2496)) = v;
            });
        }
    }
}

constexpr size_t RWREC = 12288;
constexpr size_t RW_A1 = 0, RW_A4 = 2048, RW_A3 = 4096, RW_MKA = 8192, RW_TT = 8704, RW_MY = 9216, RW_V = 10240;
constexpr size_t OFF_RWOP = OFF_X1;
constexpr size_t OFF_RWWG = OFF_RWOP + (size_t)16 * 520 * RWREC;
constexpr size_t OFF_YRWB = OFF_RWWG + (size_t)16 * 130 * 64 * 4;
constexpr size_t OFF_BONUS = OFF_YRWB + (size_t)T * 256 * 2;
static_assert(OFF_BONUS + (size_t)T * 4 * 4 <= OFF_HM, "rw operand store must fit the X1 region");

DEVINL float rw_mix(const u16* __restrict__ pb, const float* __restrict__ mup, const float* __restrict__ mun, int row, int t, int seqlen, int col) {
    const float cu = bf2f(pb[(size_t)row * 960 + col]);
    const float pr = t > 0 ? bf2f(pb[(size_t)(row - 1) * 960 + col]) : 0.f;
    const float nx = t + 1 < seqlen ? bf2f(pb[(size_t)(row + 1) * 960 + col]) : 0.f;
    return cu + mup[col] * (pr - cu) + mun[col] * (nx - cu);
}

DEVINL void rw_mix8(const u16* __restrict__ pb, const float* __restrict__ mup, const float* __restrict__ mun, int row, int t, int seqlen, int col0, float (&o)[8]) {
    const bool hp = t > 0, hn = t + 1 < seqlen;
    const u32x4 c = *(const u32x4*)(pb + (size_t)row * 960 + col0);
    u32x4 pv = *(const u32x4*)(pb + (size_t)(hp ? row - 1 : row) * 960 + col0);
    u32x4 nx = *(const u32x4*)(pb + (size_t)(hn ? row + 1 : row) * 960 + col0);
    const unsigned mpv = hp ? 0xFFFFFFFFu : 0u, mnx = hn ? 0xFFFFFFFFu : 0u;
    const f32x4 mp0 = *(const f32x4*)(mup + col0), mp1 = *(const f32x4*)(mup + col0 + 4), mn0 = *(const f32x4*)(mun + col0), mn1 = *(const f32x4*)(mun + col0 + 4);
#pragma unroll
    for (int i = 0; i < 4; ++i) {
        const unsigned cw = c[i], pw = pv[i] & mpv, nw = nx[i] & mnx;
        const float c0 = __uint_as_float(cw << 16), c1 = __uint_as_float(cw & 0xFFFF0000u);
        const float p0 = __uint_as_float(pw << 16), p1 = __uint_as_float(pw & 0xFFFF0000u);
        const float n0 = __uint_as_float(nw << 16), n1 = __uint_as_float(nw & 0xFFFF0000u);
        const float ma = (i < 2) ? mp0[2 * i] : mp1[2 * i - 4], mb = (i < 2) ? mp0[2 * i + 1] : mp1[2 * i - 3];
        const float na = (i < 2) ? mn0[2 * i] : mn1[2 * i - 4], nb = (i < 2) ? mn0[2 * i + 1] : mn1[2 * i - 3];
        o[2 * i] = c0 + ma * (p0 - c0) + na * (n0 - c0);
        o[2 * i + 1] = c1 + mb * (p1 - c1) + nb * (n1 - c1);
    }
}
DEVINL void rw_mix8_ld(const u16* __restrict__ pb, int row, int t, int seqlen, int col0, u32x4& c, u32x4& pv, u32x4& nx) {
    const bool hp = t > 0, hn = t + 1 < seqlen;
    c = *(const u32x4*)(pb + (size_t)row * 960 + col0);
    pv = *(const u32x4*)(pb + (size_t)(hp ? row - 1 : row) * 960 + col0);
    nx = *(const u32x4*)(pb + (size_t)(hn ? row + 1 : row) * 960 + col0);
}
DEVINL void rw_mix8_fin(const float* __restrict__ mup, const float* __restrict__ mun, int t, int seqlen, int col0, const u32x4& c, const u32x4& pv, const u32x4& nx, float (&o)[8]) {
    const bool hp = t > 0, hn = t + 1 < seqlen;
    const unsigned mpv = hp ? 0xFFFFFFFFu : 0u, mnx = hn ? 0xFFFFFFFFu : 0u;
    const f32x4 mp0 = *(const f32x4*)(mup + col0), mp1 = *(const f32x4*)(mup + col0 + 4), mn0 = *(const f32x4*)(mun + col0), mn1 = *(const f32x4*)(mun + col0 + 4);
#pragma unroll
    for (int i = 0; i < 4; ++i) {
        const unsigned cw = c[i], pw = pv[i] & mpv, nw = nx[i] & mnx;
        const float c0 = __uint_as_float(cw << 16), c1 = __uint_as_float(cw & 0xFFFF0000u);
        const float p0 = __uint_as_float(pw << 16), p1 = __uint_as_float(pw & 0xFFFF0000u);
        const float n0 = __uint_as_float(nw << 16), n1 = __uint_as_float(nw & 0xFFFF0000u);
        const float ma = (i < 2) ? mp0[2 * i] : mp1[2 * i - 4], mb = (i < 2) ? mp0[2 * i + 1] : mp1[2 * i - 3];
        const float na = (i < 2) ? mn0[2 * i] : mn1[2 * i - 4], nb = (i < 2) ? mn0[2 * i + 1] : mn1[2 * i - 3];
        o[2 * i] = c0 + ma * (p0 - c0) + na * (n0 - c0);
        o[2 * i + 1] = c1 + mb * (p1 - c1) + nb * (n1 - c1);
    }
}
DEVINL uint4 pack8bf(const float (&v)[8]) { return make_uint4(pk2bf(v[0], v[1]), pk2bf(v[2], v[3]), pk2bf(v[4], v[5]), pk2bf(v[6], v[7])); }

DEVINL void ph_rwprep(const P& p, int l, int half, char* smem, int bid, int nb) {
    const int TIDX_ = tid_(); const int BIDX_ = bid_(); char* const WS_ = wsl_(p.ws);
    const int tid = TIDX_, lane = tid & 63, w = tid >> 6, fr = lane & 15, fq = lane >> 4;
    const u16* pb = (const u16*)(WS_ + OFF_PB);
    char* rwop = WS_ + OFF_RWOP;
    float* rwwg = (float*)(WS_ + OFF_RWWG);
    float* bonus = (float*)(WS_ + OFF_BONUS);
    u16* gate = (u16*)(WS_ + OFF_GATE);
    const float* mup = p.mu_prev + l * 960; const float* mun = p.mu_next + l * 960;
    u16* lwdh = (u16*)smem;
    u16* ladh = lwdh + 2048;
    u16* abuf = ladh + 2048;
    float* Lb = (float*)(smem + 16384);
    u16* SV = (u16*)(smem + 32768);
    float* tot = (float*)(smem + 32768);
    const u16* w2t = (const u16*)(WS_ + OFF_LORA);
    const u16* a2t = w2t + 2 * 2 * 256 * 32;
    const u16* g2t = a2t + 2 * 2 * 256 * 32;
    RWTP(99);
    for (int uh = bid; uh < 2 * 2 * 130 * 4; uh += nb) {
        const int h = uh & 3, rest = uh >> 2;
        const int d = rest / 260, b = (rest % 260) / 130, gl = rest % 130;
        const int z = d;
        const int gscan = half * 130 + gl;
        int gi, row0, seqlen;
        if (gscan < 4) { gi = d ? 3 - gscan : gscan; row0 = b * 256 + gi * 64; seqlen = 256; }
        else { gi = d ? 255 - (gscan - 4) : gscan - 4; row0 = CTXROWS + b * LAT + gi * 64; seqlen = LAT; }
        const int t0 = gi * 64;
        __syncthreads();
        RWTP(30);
        {
            const int j = tid >> 2, cq = tid & 3;
            float v[8];
            rw_mix8(pb, mup, mun, row0 + j, t0 + j, seqlen, 768 + z * 32 + 8 * cq, v);
#pragma unroll
            for (int i = 0; i < 8; ++i) v[i] = tanhf(v[i]);
            *(uint4*)(lwdh + j * 32 + 8 * cq) = pack8bf(v);
            rw_mix8(pb, mup, mun, row0 + j, t0 + j, seqlen, 832 + z * 32 + 8 * cq, v);
            *(uint4*)(ladh + j * 32 + 8 * cq) = pack8bf(v);
        }
        if (d == 0) {
            u16* lgd = (u16*)Lb;
            {
                const int j = tid >> 2, cq = tid & 3;
#pragma unroll
                for (int hh = 0; hh < 2; ++hh) {
                    float v[8];
                    rw_mix8(pb, mup, mun, row0 + j, t0 + j, seqlen, 896 + 16 * cq + 8 * hh, v);
#pragma unroll
                    for (int i = 0; i < 8; ++i) v[i] = sigmoidf_(v[i]);
                    *(uint4*)(lgd + j * 64 + 16 * cq + 8 * hh) = pack8bf(v);
                }
            }
            __syncthreads();
            const bf16x8 x0 = *(const bf16x8*)(lgd + (16 * w + fr) * 64 + 8 * fq), x1 = *(const bf16x8*)(lgd + (16 * w + fr) * 64 + 32 + 8 * fq);
#pragma unroll
            for (int nt = 0; nt < 4; ++nt) {
                const u16* bp = g2t + ((size_t)l * 256 + 64 * h + 16 * nt + fr) * 64 + 8 * fq;
                const bf16x8 b0 = *(const bf16x8*)bp, b1 = *(const bf16x8*)(bp + 32);
                f32x4 acc = f32x4{0.f, 0.f, 0.f, 0.f};
                acc = __builtin_amdgcn_mfma_f32_16x16x32_bf16(x0, b0, acc, 0, 0, 0);
                acc = __builtin_amdgcn_mfma_f32_16x16x32_bf16(x1, b1, acc, 0, 0, 0);
#pragma unroll
                for (int r = 0; r < 4; ++r) gate[(size_t)(row0 + 16 * w + 4 * fq + r) * 256 + 64 * h + 16 * nt + fr] = f2bf(acc[r]);
            }
        }
        {
            const int bh = b * 4 + h;
            const int ch = h * 64 + lane;
            __syncthreads();
            RWTP(31);
            {
                const bf16x8 xw = *(const bf16x8*)(lwdh + (16 * w + fr) * 32 + 8 * fq);
                const bf16x8 xa = *(const bf16x8*)(ladh + (16 * w + fr) * 32 + 8 * fq);
#pragma unroll 1
                for (int kt = 0; kt < 4; ++kt) {
                    const int key = 16 * kt + fr;
                    const size_t wrow = ((size_t)(l * 2 + z) * 256 + h * 64 + key) * 32 + 8 * fq;
                    const bf16x8 bw = *(const bf16x8*)(w2t + wrow), ba = *(const bf16x8*)(a2t + wrow);
                    f32x4 ae = f32x4{0.f, 0.f, 0.f, 0.f}, aa = f32x4{0.f, 0.f, 0.f, 0.f};
                    ae = __builtin_amdgcn_mfma_f32_16x16x32_bf16(xw, bw, ae, 0, 0, 0);
                    aa = __builtin_amdgcn_mfma_f32_16x16x32_bf16(xa, ba, aa, 0, 0, 0);
                    const float w0 = p.rw_w0[(l * 2 + z) * 256 + h * 64 + key], a0 = p.rw_a0[(l * 2 + z) * 256 + h * 64 + key];
#pragma unroll
                    for (int r = 0; r < 4; ++r) {
                        const int tok = 16 * w + 4 * fq + r;
                        const int s = d ? 63 - tok : tok;
                        Lb[s * 64 + key] = 0.60653065971263342f * sigmoidf_(ae[r] + w0);
                        abuf[tok * 64 + key] = f2bf(sigmoidf_(aa[r] + a0));
                    }
                }
            }
            __syncthreads();
            RWTP(32);
            {
                float pre[16]; float run = 0.f;
#pragma unroll
                for (int i = 0; i < 16; ++i) { run += Lb[(16 * w + i) * 64 + lane]; pre[i] = run; }
                tot[w * 64 + lane] = run;
                __syncthreads();
                float offs = 0.f;
#pragma unroll
                for (int ww = 0; ww < 3; ++ww) offs += (ww < w) ? tot[ww * 64 + lane] : 0.f;
#pragma unroll
                for (int i = 0; i < 16; ++i) Lb[(16 * w + i) * 64 + lane] = -(offs + pre[i]);
            }
            __syncthreads();
            RWTP(33);
            {
                const int j = tid >> 2, kq = tid & 3, row = row0 + j, tt = t0 + j;
                const int c0 = h * 64 + 16 * kq;
                float kr[16];
                u32x4 qc[6], qp[6], qn[6];
#pragma unroll
                for (int i = 0; i < 2; ++i) {
                    rw_mix8_ld(pb, row, tt, seqlen, 256 + c0 + 8 * i, qc[i], qp[i], qn[i]);
                    rw_mix8_ld(pb, row, tt, seqlen, c0 + 8 * i, qc[2 + i], qp[2 + i], qn[2 + i]);
                    rw_mix8_ld(pb, row, tt, seqlen, 512 + c0 + 8 * i, qc[4 + i], qp[4 + i], qn[4 + i]);
                }
                { float t8[8];
                  rw_mix8_fin(mup, mun, tt, seqlen, 256 + c0, qc[0], qp[0], qn[0], t8);
#pragma unroll
                  for (int i = 0; i < 8; ++i) kr[i] = t8[i];
                  rw_mix8_fin(mup, mun, tt, seqlen, 256 + c0 + 8, qc[1], qp[1], qn[1], t8);
#pragma unroll
                  for (int i = 0; i < 8; ++i) kr[8 + i] = t8[i]; }
                float ss = 0.f;
#pragma unroll
                for (int i = 0; i < 16; ++i) { const float kv = kr[i] * p.rw_kk[l * 256 + c0 + i]; ss += kv * kv; }
                ss += __shfl_xor(ss, 1); ss += __shfl_xor(ss, 2);
                const float inorm = 1.f / fmaxf(sqrtf(ss), 1e-12f);
                const int sidx = d ? 63 - j : j;
                const int cch = sidx >> 4, ts = sidx & 15;
                u16* sv = SV + (size_t)(cch * 4) * 1024 + ts * 64 + 16 * kq;
                float bs = 0.f;
#pragma unroll
                for (int hh = 0; hh < 2; ++hh) {
                    const int cb = c0 + 8 * hh;
                    float rr[8], av[8], oa[8], orr[8], ob[8], ok[8];
                    rw_mix8_fin(mup, mun, tt, seqlen, cb, qc[2 + hh], qp[2 + hh], qn[2 + hh], rr);
                    { const uint4 a0 = *(const uint4*)(abuf + j * 64 + 16 * kq + 8 * hh);
                      const unsigned aw[4] = {a0.x, a0.y, a0.z, a0.w};
#pragma unroll
                      for (int i = 0; i < 4; ++i) { av[2 * i] = __uint_as_float(aw[i] << 16); av[2 * i + 1] = __uint_as_float(aw[i] & 0xFFFF0000u); } }
#pragma unroll
                    for (int i4 = 0; i4 < 2; ++i4) {
                        const float4 Lt4 = *(const float4*)(Lb + sidx * 64 + 16 * kq + 8 * hh + 4 * i4);
                        const float4 Lp4 = sidx > 0 ? *(const float4*)(Lb + (sidx - 1) * 64 + 16 * kq + 8 * hh + 4 * i4) : make_float4(0.f, 0.f, 0.f, 0.f);
                        const float Lt[4] = {Lt4.x, Lt4.y, Lt4.z, Lt4.w}, Lp[4] = {Lp4.x, Lp4.y, Lp4.z, Lp4.w};
#pragma unroll
                        for (int ii = 0; ii < 4; ++ii) {
                            const int i = 4 * i4 + ii;
                            const float kraw = hh ? kr[8 + i] : kr[i];
                            const float kkn = kraw * p.rw_kk[l * 256 + cb + i] * inorm, a = av[i];
                            const float et = __expf(Lt[ii]), einv = __builtin_amdgcn_rcpf(et);
                            oa[i] = -kkn * __expf(Lp[ii]);
                            orr[i] = rr[i] * et;
                            ob[i] = kkn * a * einv;
                            ok[i] = kraw * (1.f + (a - 1.f) * p.rw_ka[l * 256 + cb + i]) * einv;
                            bs += rr[i] * kraw * p.rw_rk[l * 256 + cb + i];
                            if (sidx == 63) rwwg[((size_t)(d * 8 + bh) * 130 + gl) * 64 + 16 * kq + 8 * hh + i] = et;
                        }
                    }
                    *(uint4*)(sv + 8 * hh) = pack8bf(oa);
                    *(uint4*)(sv + 1024 + 8 * hh) = pack8bf(orr);
                    *(uint4*)(sv + 2048 + 8 * hh) = pack8bf(ob);
                    *(uint4*)(sv + 3072 + 8 * hh) = pack8bf(ok);
                    rw_mix8_fin(mup, mun, tt, seqlen, 512 + cb, qc[4 + hh], qp[4 + hh], qn[4 + hh], rr);
                    *(uint4*)(abuf + j * 64 + 16 * kq + 8 * hh) = pack8bf(rr);
                }
                if (d == 0) { bs += __shfl_xor(bs, 1); bs += __shfl_xor(bs, 2); if (kq == 0) bonus[(size_t)row * 4 + h] = bs; }
            }
            __syncthreads();
            RWTP(34);
            {
                char* rec = rwop + ((size_t)(d * 8 + bh) * 520 + (size_t)gl * 4 + w) * RWREC;
                const u16* Av = SV + (size_t)(w * 4) * 1024; const u16* Rv = Av + 1024; const u16* Bv = Av + 2048; const u16* Kv = Av + 3072;
                bf16x8 fa[2], frr[2], fb[2], fk[2];
#pragma unroll
                for (int ks = 0; ks < 2; ++ks) {
                    fa[ks] = *(const bf16x8*)(Av + fr * 64 + ks * 32 + fq * 8);
                    frr[ks] = *(const bf16x8*)(Rv + fr * 64 + ks * 32 + fq * 8);
                    fb[ks] = *(const bf16x8*)(Bv + fr * 64 + ks * 32 + fq * 8);
                    fk[ks] = *(const bf16x8*)(Kv + fr * 64 + ks * 32 + fq * 8);
                }
                f32x4 mka = f32x4{0.f, 0.f, 0.f, 0.f}, mba = mka, mkr = mka, mbr = mka;
#pragma unroll
                for (int ks = 0; ks < 2; ++ks) {
                    mka = __builtin_amdgcn_mfma_f32_16x16x32_bf16(fa[ks], fk[ks], mka, 0, 0, 0);
                    mba = __builtin_amdgcn_mfma_f32_16x16x32_bf16(fa[ks], fb[ks], mba, 0, 0, 0);
                    mkr = __builtin_amdgcn_mfma_f32_16x16x32_bf16(frr[ks], fk[ks], mkr, 0, 0, 0);
                    mbr = __builtin_amdgcn_mfma_f32_16x16x32_bf16(frr[ks], fb[ks], mbr, 0, 0, 0);
                }
                float* Ns = Lb + w * 256;
                float* Ts = Lb + 1024 + w * 256;
                u16* rmka = (u16*)(rec + RW_MKA); u16* rmy = (u16*)(rec + RW_MY);
                const int i_ = fr;
#pragma unroll
                for (int r = 0; r < 4; ++r) {
                    const int t_ = 4 * fq + r;
                    const int lp = (i_ >> 2) * 16 + t_;
                    mka[r] = i_ < t_ ? mka[r] : 0.f;
                    rmy[lp * 8 + (i_ & 3)] = f2bf(i_ <= t_ ? mbr[r] : 0.f);
                    rmy[lp * 8 + 4 + (i_ & 3)] = f2bf(i_ <= t_ ? mkr[r] : 0.f);
                    Ns[t_ * 16 + i_] = i_ < t_ ? mba[r] : 0.f;
                }
                if (lane < 16) {
                    float Tr[16];
#pragma unroll
                    for (int ii = 0; ii < 16; ++ii) Tr[ii] = 0.f;
#pragma unroll 1
                    for (int t_ = 0; t_ < 16; ++t_) {
                        float acc = (lane == t_) ? 1.f : 0.f;
#pragma unroll
                        for (int i4 = 0; i4 < 4; ++i4) {
                            const float4 nv = *(const float4*)(Ns + t_ * 16 + 4 * i4);
                            acc += Tr[4 * i4] * nv.x + Tr[4 * i4 + 1] * nv.y + Tr[4 * i4 + 2] * nv.z + Tr[4 * i4 + 3] * nv.w;
                        }
#pragma unroll
                        for (int ii = 0; ii < 16; ++ii) Tr[ii] = (ii == t_) ? acc : Tr[ii];
                        Ts[lane * 16 + t_] = acc;
                    }
                }
                bf16x8 TTf;
                {
                    const float t0v = Ts[(4 * fq + 0) * 16 + fr], t1v = Ts[(4 * fq + 1) * 16 + fr], t2v = Ts[(4 * fq + 2) * 16 + fr], t3v = Ts[(4 * fq + 3) * 16 + fr];
                    union { u32x4 u; bf16x8 f; } x; x.u = u32x4{pk2bf(t0v, t1v), pk2bf(t2v, t3v), 0u, 0u}; TTf = x.f;
                }
                {
                    union { u32x4 u; bf16x8 f; } mb; mb.u = u32x4{pk2bf(mka[0], mka[1]), pk2bf(mka[2], mka[3]), 0u, 0u};
                    f32x4 mk2 = f32x4{0.f, 0.f, 0.f, 0.f};
                    mk2 = __builtin_amdgcn_mfma_f32_16x16x32_bf16(TTf, mb.f, mk2, 0, 0, 0);
#pragma unroll
                    for (int r = 0; r < 4; ++r) { const int t_ = 4 * fq + r; rmka[((i_ >> 2) * 16 + t_) * 4 + (i_ & 3)] = f2bf(mk2[r]); }
                }
                {
                    f32x4 ap[4];
#pragma unroll
                    for (int m = 0; m < 4; ++m) {
                        union { u32x4 u; bf16x8 f; } ag;
                        ag.u = u32x4{(unsigned)Av[(4 * fq + 0) * 64 + 16 * m + fr] | ((unsigned)Av[(4 * fq + 1) * 64 + 16 * m + fr] << 16),
                                     (unsigned)Av[(4 * fq + 2) * 64 + 16 * m + fr] | ((unsigned)Av[(4 * fq + 3) * 64 + 16 * m + fr] << 16), 0u, 0u};
                        ap[m] = f32x4{0.f, 0.f, 0.f, 0.f};
                        ap[m] = __builtin_amdgcn_mfma_f32_16x16x32_bf16(ag.f, TTf, ap[m], 0, 0, 0);
                    }
#pragma unroll
                    for (int ks = 0; ks < 2; ++ks) {
                        uint4 o;
                        o.x = pk2bf(ap[2 * ks][0], ap[2 * ks][1]); o.y = pk2bf(ap[2 * ks][2], ap[2 * ks][3]);
                        o.z = pk2bf(ap[2 * ks + 1][0], ap[2 * ks + 1][1]); o.w = pk2bf(ap[2 * ks + 1][2], ap[2 * ks + 1][3]);
                        *(uint4*)(rec + RW_A1 + (ks * 64 + lane) * 16) = o;
                    }
                }
#pragma unroll
                for (int ks = 0; ks < 2; ++ks) {
                    uint4 o;
                    const uint2 lo2 = *(const uint2*)(Rv + fr * 64 + 32 * ks + 4 * fq), hi2 = *(const uint2*)(Rv + fr * 64 + 32 * ks + 16 + 4 * fq);
                    o.x = lo2.x; o.y = lo2.y; o.z = hi2.x; o.w = hi2.y;
                    *(uint4*)(rec + RW_A4 + (ks * 64 + lane) * 16) = o;
                }
#pragma unroll
                for (int m = 0; m < 4; ++m) {
                    unsigned e[8];
#pragma unroll
                    for (int j = 0; j < 4; ++j) { e[j] = Bv[(4 * fq + j) * 64 + 16 * m + fr]; e[4 + j] = Kv[(4 * fq + j) * 64 + 16 * m + fr]; }
                    uint4 o; o.x = e[0] | (e[1] << 16); o.y = e[2] | (e[3] << 16); o.z = e[4] | (e[5] << 16); o.w = e[6] | (e[7] << 16);
                    *(uint4*)(rec + RW_A3 + (m * 64 + lane) * 16) = o;
                }
#pragma unroll
                for (int q = 0; q < 4; ++q) {
                    unsigned e[4];
#pragma unroll
                    for (int j = 0; j < 4; ++j) {
                        const int s = 16 * w + 4 * fq + j; const int jt = d ? 63 - s : s;
                        e[j] = abuf[jt * 64 + 16 * q + fr];
                    }
                    uint2 o; o.x = e[0] | (e[1] << 16); o.y = e[2] | (e[3] << 16);
                    *(uint2*)(rec + RW_V + (q * 64 + lane) * 8) = o;
                }
            }
        }
        RWTP(35);
    }
}

constexpr int RWSLOT = 12544;
DEVINL void ph_rwscan(const P& p, int l, int half, int bid, int nb, char* smem) {
    const int TIDX_ = tid_(); char* const WS_ = wsl_(p.ws);
    const int tid = TIDX_, lane = tid & 63, q = tid >> 6, fr = lane & 15, fq = lane >> 4;
    const char* rwop = WS_ + OFF_RWOP;
    const float* rwwg = (const float*)(WS_ + OFF_RWWG);
    u16* yf = (u16*)(WS_ + OFF_Y);
    u16* yb = (u16*)(WS_ + OFF_YRWB);
    (void)l;
    float* zst = (float*)(WS_ + OFF_ZST);
    for (int dbh = bid; dbh < 16; dbh += nb) {
        const int d = dbh >> 3, bh = dbh & 7, b = bh >> 2, h = bh & 3;
        f32x4 z[4];
        float* zp = zst + ((size_t)(dbh * 4 + q) * 64 + lane) * 16;
#pragma unroll
        for (int m = 0; m < 4; ++m) {
            if (half == 0) z[m] = f32x4{0.f, 0.f, 0.f, 0.f};
            else { const float4 t4 = *(const float4*)(zp + 4 * m); z[m] = f32x4{t4.x, t4.y, t4.z, t4.w}; }
        }
        const int cbase = half * 520;
        const char* rec0 = rwop + (size_t)dbh * 520 * RWREC;
        const float* wg0 = rwwg + (size_t)dbh * 130 * 64;
        constexpr int RD = 6;
        u32x4 rb[RD][3]; float rwgA = 0.f, rwgB = 0.f;
        auto ldrec = [&](int c, auto I) {
            constexpr int i = decltype(I)::value;
            const int cc = c < 520 ? c : 519;
            const char* rec = rec0 + (size_t)cc * RWREC;
#pragma unroll
            for (int k = 0; k < 3; ++k) rb[i][k] = *(const u32x4*)(rec + (tid + 256 * k) * 16);
        };
        auto strec = [&](auto I, int slotidx) {
            constexpr int i = decltype(I)::value;
            char* slot = smem + slotidx * RWSLOT;
#pragma unroll
            for (int k = 0; k < 3; ++k) *(u32x4*)(slot + (tid + 256 * k) * 16) = rb[i][k];
        };
        auto asfrag = [](uint4 v) { union { uint4 u; bf16x8 f; } x; x.u = v; return x.f; };
        auto pack2 = [](float lo, float hi) { return pk2bf(lo, hi); };
        const unsigned b128 = lds_addr(smem) + lane * 16, b64 = lds_addr(smem) + lane * 8, bv = lds_addr(smem) + (q * 64 + lane) * 8, bg = lds_addr(smem) + 16 * fq;
        __syncthreads();
        __builtin_amdgcn_s_setprio(3);
#define IC(n) std::integral_constant<int, n>{}
        auto flush_y = [&](int cprev, int par) {
            if (tid < 128) {
                const int cg = cbase + cprev;
                const bool isctx = cg < 16;
                const int cc = isctx ? cg : cg - 16;
                const int n = isctx ? LCTX : LAT;
                const int rowbase = isctx ? b * LCTX : CTXROWS + b * LAT;
                const int ts = tid >> 3, c8 = (tid & 7) * 8;
                const int sidx = cc * 16 + ts;
                const int t = d ? n - 1 - sidx : sidx;
                const u32x4 v = *(const u32x4*)(smem + 4 * RWSLOT + par * 2048 + (ts * 64 + c8) * 2);
                u16* dst = d == 0 ? yf + (size_t)(rowbase + t) * 1024 + 512 + h * 64 + c8 : yb + (size_t)(rowbase + t) * 256 + h * 64 + c8;
                *(u32x4*)dst = v;
            }
        };
        u32x4 f4[2][2]; u32x2 f2[2][2]; u32x4 fl[7];
#define RD_ISSUE(par, SBN, SBC) asm volatile( \
                "ds_read_b128 %0, %11 offset:%15+4096\n\t" \
                "ds_read_b128 %1, %11 offset:%15+5120\n\t" \
                "ds_read_b128 %2, %11 offset:%15+6144\n\t" \
                "ds_read_b128 %3, %11 offset:%15+7168\n\t" \
                "ds_read_b128 %4, %11 offset:%15+2048\n\t" \
                "ds_read_b128 %5, %11 offset:%15+3072\n\t" \
                "ds_read_b128 %6, %11 offset:%15+9216\n\t" \
                "ds_read_b128 %7, %11 offset:%14+0\n\t" \
                "ds_read_b128 %8, %11 offset:%14+1024\n\t" \
                "ds_read_b64 %9, %12 offset:%14+8192\n\t" \
                "ds_read_b64 %10, %13 offset:%14+10240" \
                : "=&v"(fl[0]), "=&v"(fl[1]), "=&v"(fl[2]), "=&v"(fl[3]), "=&v"(fl[4]), "=&v"(fl[5]), "=&v"(fl[6]), \
                  "=&v"(f4[par][0]), "=&v"(f4[par][1]), "=&v"(f2[par][0]), "=&v"(f2[par][1]) \
                : "v"(b128), "v"(b64), "v"(bv), "n"(SBN), "n"(SBC) \
                : "memory")
#define RD_EARLY(par, SBN) asm volatile( \
                "ds_read_b128 %0, %4 offset:%7+0\n\t" \
                "ds_read_b128 %1, %4 offset:%7+1024\n\t" \
                "ds_read_b64 %2, %5 offset:%7+8192\n\t" \
                "ds_read_b64 %3, %6 offset:%7+10240\n\t" \
                "s_waitcnt lgkmcnt(0)" \
                : "=&v"(f4[par][0]), "=&v"(f4[par][1]), "=&v"(f2[par][0]), "=&v"(f2[par][1]) \
                : "v"(b128), "v"(b64), "v"(bv), "n"(SBN) \
                : "memory")
#define LATE_WAIT() asm volatile("s_waitcnt lgkmcnt(4)" \
                : "+v"(fl[0]), "+v"(fl[1]), "+v"(fl[2]), "+v"(fl[3]), "+v"(fl[4]), "+v"(fl[5]), "+v"(fl[6]) :: "memory")
#define RD_WAIT(par) asm volatile("s_waitcnt lgkmcnt(0)" \
                : "+v"(f4[par][0]), "+v"(f4[par][1]), "+v"(f2[par][0]), "+v"(f2[par][1]) :: "memory")
        ldrec(0, IC(0)); ldrec(1, IC(1)); ldrec(2, IC(2)); ldrec(3, IC(3)); ldrec(4, IC(4)); ldrec(5, IC(5));
        strec(IC(0), 0); ldrec(RD, IC(0));
        strec(IC(1), 1); ldrec(RD + 1, IC(1));
        rwgA = wg0[lane]; rwgB = wg0[64 + lane];
        asm volatile("s_waitcnt lgkmcnt(0)" ::: "memory");
        __builtin_amdgcn_s_barrier();
        RD_EARLY(0, 0);
#pragma unroll 1
        for (int c5 = 0; c5 < 528; c5 += 12) {
          auto body = [&](auto SJ) {
            constexpr int sj = decltype(SJ)::value;
            constexpr int par = sj & 1;
            const int c = c5 + sj;
            asm volatile("s_waitcnt lgkmcnt(0)" ::: "memory");
            __builtin_amdgcn_s_barrier();
            RD_ISSUE(par ^ 1, ((sj + 1) % 4) * RWSLOT, (sj % 4) * RWSLOT);
            if (c > 0 && c <= 520) flush_y(c - 1, par ^ 1);
            strec(IC((sj + 2) % RD), (sj + 2) % 4);
            ldrec(c + 2 + RD, IC((sj + 2) % RD));
            if ((sj & 3) == 1) {
                const bool even = (((c >> 2) & 1) == 0);
                if (q == 0) *(float*)(smem + ((sj + 2) % 4) * RWSLOT + 12288 + lane * 4) = even ? rwgA : rwgB;
                const int gn = (c >> 2) + 2;
                const float nv = wg0[(size_t)(gn < 130 ? gn : 129) * 64 + lane];
                if (even) rwgA = nv; else rwgB = nv;
            }
            if (c < 520) {
            constexpr int SB = (sj % 4) * RWSLOT;
            auto asfrag4 = [](u32x4 v) { union { u32x4 u; bf16x8 f; } x; x.u = v; return x.f; };
            const bf16x8 A1_0 = asfrag4(f4[par][0]), A1_1 = asfrag4(f4[par][1]);
            const u32x2 mka = f2[par][0], vcur = f2[par][1];
            const bf16x8 MKA = asfrag(make_uint4(mka.x, mka.y, 0u, 0u));
            const bf16x8 VB = asfrag(make_uint4(vcur.x, vcur.y, 0u, 0u));
            const bf16x8 ZB0 = asfrag(make_uint4(pack2(z[0][0], z[0][1]), pack2(z[0][2], z[0][3]), pack2(z[1][0], z[1][1]), pack2(z[1][2], z[1][3])));
            const bf16x8 ZB1 = asfrag(make_uint4(pack2(z[2][0], z[2][1]), pack2(z[2][2], z[2][3]), pack2(z[3][0], z[3][1]), pack2(z[3][2], z[3][3])));
            f32x4 Ua = f32x4{0.f, 0.f, 0.f, 0.f}, Ub = f32x4{0.f, 0.f, 0.f, 0.f};
            Ua = __builtin_amdgcn_mfma_f32_16x16x32_bf16(MKA, VB, Ua, 0, 0, 0);
            Ub = __builtin_amdgcn_mfma_f32_16x16x32_bf16(A1_1, ZB1, Ub, 0, 0, 0);
            Ua = __builtin_amdgcn_mfma_f32_16x16x32_bf16(A1_0, ZB0, Ua, 0, 0, 0);
            LATE_WAIT();
            const bf16x8 A3_0 = asfrag4(fl[0]), A3_1 = asfrag4(fl[1]), A3_2 = asfrag4(fl[2]), A3_3 = asfrag4(fl[3]);
            const bf16x8 A4_0 = asfrag4(fl[4]), A4_1 = asfrag4(fl[5]), MY = asfrag4(fl[6]);
            f32x4 Y = f32x4{0.f, 0.f, 0.f, 0.f};
            Y = __builtin_amdgcn_mfma_f32_16x16x32_bf16(A4_0, ZB0, Y, 0, 0, 0);
            Y = __builtin_amdgcn_mfma_f32_16x16x32_bf16(A4_1, ZB1, Y, 0, 0, 0);
            const f32x4 U = Ua + Ub;
            const bf16x8 UV = asfrag(make_uint4(pack2(U[0], U[1]), pack2(U[2], U[3]), vcur.x, vcur.y));
            z[0] = __builtin_amdgcn_mfma_f32_16x16x32_bf16(A3_0, UV, z[0], 0, 0, 0);
            z[1] = __builtin_amdgcn_mfma_f32_16x16x32_bf16(A3_1, UV, z[1], 0, 0, 0);
            z[2] = __builtin_amdgcn_mfma_f32_16x16x32_bf16(A3_2, UV, z[2], 0, 0, 0);
            z[3] = __builtin_amdgcn_mfma_f32_16x16x32_bf16(A3_3, UV, z[3], 0, 0, 0);
            Y = __builtin_amdgcn_mfma_f32_16x16x32_bf16(MY, UV, Y, 0, 0, 0);
            asm volatile("s_waitcnt lgkmcnt(0)" ::: "memory");
            if ((c & 3) == 3) {
                u32x4 g0, g1, g2, g3;
                asm volatile(
                    "ds_read_b128 %0, %4 offset:%5+12288\n\t"
                    "ds_read_b128 %1, %4 offset:%5+12352\n\t"
                    "ds_read_b128 %2, %4 offset:%5+12416\n\t"
                    "ds_read_b128 %3, %4 offset:%5+12480\n\t"
                    "s_waitcnt lgkmcnt(0)"
                    : "=&v"(g0), "=&v"(g1), "=&v"(g2), "=&v"(g3) : "v"(bg), "n"(SB) : "memory");
                z[0][0] *= __uint_as_float(g0.x); z[0][1] *= __uint_as_float(g0.y); z[0][2] *= __uint_as_float(g0.z); z[0][3] *= __uint_as_float(g0.w);
                z[1][0] *= __uint_as_float(g1.x); z[1][1] *= __uint_as_float(g1.y); z[1][2] *= __uint_as_float(g1.z); z[1][3] *= __uint_as_float(g1.w);
                z[2][0] *= __uint_as_float(g2.x); z[2][1] *= __uint_as_float(g2.y); z[2][2] *= __uint_as_float(g2.z); z[2][3] *= __uint_as_float(g2.w);
                z[3][0] *= __uint_as_float(g3.x); z[3][1] *= __uint_as_float(g3.y); z[3][2] *= __uint_as_float(g3.z); z[3][3] *= __uint_as_float(g3.w);
            }
            {
                u16* yl = (u16*)(smem + 4 * RWSLOT + par * 2048);
                const unsigned y01 = pk2bf(Y[0], Y[1]), y23 = pk2bf(Y[2], Y[3]);
                yl[(4 * fq + 0) * 64 + 16 * q + fr] = (u16)(y01 & 0xFFFFu);
                yl[(4 * fq + 1) * 64 + 16 * q + fr] = (u16)(y01 >> 16);
                yl[(4 * fq + 2) * 64 + 16 * q + fr] = (u16)(y23 & 0xFFFFu);
                yl[(4 * fq + 3) * 64 + 16 * q + fr] = (u16)(y23 >> 16);
            }
            }
            RD_WAIT(par ^ 1);
          };
          body(IC(0)); body(IC(1)); body(IC(2)); body(IC(3)); body(IC(4)); body(IC(5)); body(IC(6)); body(IC(7)); body(IC(8)); body(IC(9)); body(IC(10)); body(IC(11));
        }
#pragma unroll
        for (int m = 0; m < 4; ++m) *(float4*)(zp + 4 * m) = make_float4(z[m][0], z[m][1], z[m][2], z[m][3]);
        asm volatile("s_waitcnt vmcnt(0)" ::: "memory");
        __builtin_amdgcn_s_setprio(0);
        __syncthreads();
    }
}

DEVINL void ph_rwout(const P& p, int l) {
    const int TIDX_ = tid_(); const int BIDX_ = bid_(); char* const WS_ = wsl_(p.ws);
    const int tid = TIDX_;
    const u16* pb = (const u16*)(WS_ + OFF_PB);
    const u16* yb = (const u16*)(WS_ + OFF_YRWB);
    const u16* gate = (const u16*)(WS_ + OFF_GATE);
    const float* bonus = (const float*)(WS_ + OFF_BONUS);
    u16* y = (u16*)(WS_ + OFF_Y);
    const float* mup = p.mu_prev + l * 960; const float* mun = p.mu_next + l * 960;
    const int c8 = (tid & 31) * 8, h = (tid & 31) >> 3;
    float lw[8], lb[8];
#pragma unroll
    for (int i = 0; i < 8; ++i) { lw[i] = p.rw_lnw[l * 256 + c8 + i]; lb[i] = p.rw_lnb[l * 256 + c8 + i]; }
    const int rstart = (l == 0) ? 0 : CTXROWS;
    for (int row = rstart + BIDX_ * 8 + (tid >> 5); row < T; row += gridDim.x * 8) {
        int t, seqlen;
        if (row < CTXROWS) { t = row & 255; seqlen = LCTX; } else { t = (row - CTXROWS) & (LAT - 1); seqlen = LAT; }
        const uint4 yfv = *(const uint4*)(y + (size_t)row * 1024 + 512 + c8), ybv = *(const uint4*)(yb + (size_t)row * 256 + c8);
        const uint4 gv = *(const uint4*)(gate + (size_t)row * 256 + c8);
        float v[8];
        rw_mix8(pb, mup, mun, row, t, seqlen, 512 + c8, v);
        const unsigned fw[4] = {yfv.x, yfv.y, yfv.z, yfv.w}, bw[4] = {ybv.x, ybv.y, ybv.z, ybv.w}, gw[4] = {gv.x, gv.y, gv.z, gv.w};
        float yv[8], gt[8]; float s1 = 0.f;
#pragma unroll
        for (int i = 0; i < 4; ++i) {
            yv[2 * i] = __uint_as_float(fw[i] << 16) + __uint_as_float(bw[i] << 16);
            yv[2 * i + 1] = __uint_as_float(fw[i] & 0xFFFF0000u) + __uint_as_float(bw[i] & 0xFFFF0000u);
            gt[2 * i] = __uint_as_float(gw[i] << 16); gt[2 * i + 1] = __uint_as_float(gw[i] & 0xFFFF0000u);
            s1 += yv[2 * i] + yv[2 * i + 1];
        }
        s1 += __shfl_xor(s1, 1); s1 += __shfl_xor(s1, 2); s1 += __shfl_xor(s1, 4);
        const float mu = s1 * (1.f / 64.f);
        float s2 = 0.f;
#pragma unroll
        for (int i = 0; i < 8; ++i) { const float dl = yv[i] - mu; s2 += dl * dl; }
        s2 += __shfl_xor(s2, 1); s2 += __shfl_xor(s2, 2); s2 += __shfl_xor(s2, 4);
        const float rstd = rsqrtf(s2 * (1.f / 64.f) + 64e-5f);
        const float bn = bonus[(size_t)row * 4 + h];
        float o[8];
#pragma unroll
        for (int i = 0; i < 8; ++i) o[i] = ((yv[i] - mu) * rstd * lw[i] + lb[i] + bn * v[i]) * gt[i];
        *(uint4*)(y + (size_t)row * 1024 + 512 + c8) = pack8bf(o);
    }
}
DEVINL void ph_prepM(const P& p, int l, char* smem, int bid, int nb) {
    const int TIDX_ = tid_(); const int BIDX_ = bid_(); char* const WS_ = wsl_(p.ws);
    const int tid = TIDX_, lane = tid & 63, wid = tid >> 6;
    const u16* pc = (const u16*)(WS_ + OFF_PC);
    u16* mlf = (u16*)(WS_ + OFF_MLF);
    float* mlg = (float*)(WS_ + OFF_MLG);
    float* mls = (float*)(WS_ + OFF_MLS);
    float* nst = (float*)(WS_ + OFF_NST);
    float* cst = (float*)(WS_ + OFF_HM);
    const float* rope = (const float*)(WS_ + OFF_ROPE);
    u16* kT = (u16*)smem;
    u16* vT = kT + 64 * 72;
    float* wsl = (float*)(vT + 64 * 72);
    float* lil = wsl + 128;
    for (int uh = bid; uh < NUNIT_CH * 4; uh += nb) {
        const int u = uh >> 2, h = uh & 3;
        int b, ch, row0, seqlen; bool isctx;
        if (u < 8) { isctx = true; b = u >> 2; ch = u & 3; row0 = b * 256 + ch * 64; seqlen = 256; }
        else { isctx = false; b = (u - 8) >> 8; ch = (u - 8) & 255; row0 = CTXROWS + b * LAT + ch * 64; seqlen = LAT; }
        const int t0 = ch * 64;
        const int tc = isctx ? ch : 4 + ch;
        __syncthreads();
        {
            const bool isk = wid >= 2;
            const int cch = (isk ? 256 : 0) + h * 64 + lane;
            const float* cw = p.ml_cw + (size_t)l * 3 * 512;
            const float w0 = cw[cch], w1 = cw[512 + cch], w2 = cw[1024 + cch], bb = p.ml_cb[l * 512 + cch];
            const int jb = (wid & 1) * 32;
            const int i16 = lane & 15; const bool second = (lane & 16) != 0; const int half = lane >> 5;
#pragma unroll 1
            for (int j0 = 0; j0 < 32; j0 += 16) {
            u16 xr[18];
#pragma unroll
            for (int jj = 0; jj < 18; ++jj) {
                const int tj = t0 + jb + j0 + jj - 1;
                const int rj = (tj >= 0 && tj < seqlen) ? row0 + jb + j0 + jj - 1 : row0 + jb;
                xr[jj] = pc[(size_t)rj * 1040 + cch];
            }
#pragma unroll
            for (int jj = 0; jj < 16; ++jj) {
                const int j = jb + j0 + jj;
                const float pv = (t0 + j > 0) ? bf2f(xr[jj]) : 0.f, cv = bf2f(xr[jj + 1]);
                const float nv = (t0 + j + 1 < seqlen) ? bf2f(xr[jj + 2]) : 0.f;
                float val = siluf_(w0 * pv + w1 * cv + w2 * nv + bb);
                if (!isctx) {
                    const int t = t0 + j;
                    const int pos = half == 0 ? (t >> 6) : (t & 63);
                    const float cs = half == 0 ? rope[pos * 16 + i16] : rope[8192 + pos * 16 + i16];
                    const float sn = half == 0 ? rope[4096 + pos * 16 + i16] : rope[9216 + pos * 16 + i16];
                    const float ov = __shfl_xor(val, 16);
                    val = second ? (ov * sn + val * cs) : (val * cs - ov * sn);
                }
                if (isk) { const u16 kb = f2bf(val * 0.125f); mlf[(size_t)(row0 + j) * 512 + 256 + h * 64 + lane] = kb; kT[lane * 72 + j] = kb; }
                else mlf[(size_t)(row0 + j) * 512 + h * 64 + lane] = f2bf(val);
            }
            }
            {
                const int j = tid >> 2, wh = tid & 3;
                const int idx = (wh < 2) ? (wh * 4 + h) : (8 + (wh - 2) * 4 + h);
                const float g = bf2f(pc[(size_t)(row0 + j) * 1040 + 1024 + idx]);
                float v;
                if (wh < 2) v = g + p.ml_ib[l * 8 + idx];
                else { const float xx = g + p.ml_fb[l * 8 + idx - 8]; v = fminf(xx, 0.f) - log1pf(__expf(-fabsf(xx))); }
                lil[j * 4 + wh] = v;
                if (wh < 2) mlg[(size_t)(row0 + j) * 16 + idx] = v;
            }
            for (int i = tid; i < 64 * 8; i += 256) {
                const int tok = i >> 3, d8 = (i & 7) * 8;
                const uint4 vv = *(const uint4*)(pc + (size_t)(row0 + tok) * 1040 + 512 + h * 64 + d8);
                const unsigned wv[4] = {vv.x, vv.y, vv.z, vv.w};
#pragma unroll
                for (int k = 0; k < 4; ++k) { vT[(d8 + 2 * k) * 72 + tok] = (u16)(wv[k] & 0xFFFFu); vT[(d8 + 2 * k + 1) * 72 + tok] = (u16)(wv[k] >> 16); }
            }
        }
        __syncthreads();
        if (wid < 2) {
            const int d = wid, tok = d ? 63 - lane : lane;
            float bsum = lil[tok * 4 + 2 + d];
#pragma unroll
            for (int off = 1; off < 64; off <<= 1) { const float o = __shfl_up(bsum, off); if (lane >= off) bsum += o; }
            const float Bs = __shfl(bsum, 63);
            const float gl = Bs - bsum + lil[tok * 4 + d];
            float G = gl;
#pragma unroll
            for (int off = 32; off > 0; off >>= 1) G = fmaxf(G, __shfl_xor(G, off));
            wsl[d * 64 + tok] = __expf(gl - G);
            mlg[(size_t)(row0 + tok) * 16 + 8 + d * 4 + h] = bsum;
            if (lane == 0) { const int bhd = (b * 4 + h) * 2 + d; mls[(bhd * NTC + tc) * 2 + 0] = G; mls[(bhd * NTC + tc) * 2 + 1] = Bs; }
        }
        __syncthreads();
        {
            const int fr = lane & 15, g = lane >> 4;
            const int bh0 = ((b * 4 + h) * 2 + 0) * NTC + tc, bh1 = ((b * 4 + h) * 2 + 1) * NTC + tc;
            bf16x8 va[2];
            va[0] = *(const bf16x8*)(vT + (16 * wid + fr) * 72 + 8 * g);
            va[1] = *(const bf16x8*)(vT + (16 * wid + fr) * 72 + 32 + 8 * g);
#pragma unroll 1
            for (int dkt = 0; dkt < 4; ++dkt) {
                f32x4 u0 = f32x4{0.f, 0.f, 0.f, 0.f}, u1 = f32x4{0.f, 0.f, 0.f, 0.f};
#pragma unroll
                for (int ks = 0; ks < 2; ++ks) {
                    const uint4 kv = *(const uint4*)(kT + (16 * dkt + fr) * 72 + 32 * ks + 8 * g);
                    const float4 wa0 = *(const float4*)(wsl + 32 * ks + 8 * g), wa1 = *(const float4*)(wsl + 32 * ks + 8 * g + 4);
                    const float4 wb0 = *(const float4*)(wsl + 64 + 32 * ks + 8 * g), wb1 = *(const float4*)(wsl + 64 + 32 * ks + 8 * g + 4);
                    const unsigned kw[4] = {kv.x, kv.y, kv.z, kv.w};
                    const float w0[8] = {wa0.x, wa0.y, wa0.z, wa0.w, wa1.x, wa1.y, wa1.z, wa1.w}, w1[8] = {wb0.x, wb0.y, wb0.z, wb0.w, wb1.x, wb1.y, wb1.z, wb1.w};
                    union { u32x4 u; bf16x8 f; } b0, b1;
#pragma unroll
                    for (int i = 0; i < 4; ++i) {
                        const float ka = __uint_as_float(kw[i] << 16), kb = __uint_as_float(kw[i] & 0xFFFF0000u);
                        b0.u[i] = pk2bf(ka * w0[2 * i], kb * w0[2 * i + 1]);
                        b1.u[i] = pk2bf(ka * w1[2 * i], kb * w1[2 * i + 1]);
                    }
                    u0 = __builtin_amdgcn_mfma_f32_16x16x32_bf16(va[ks], b0.f, u0, 0, 0, 0);
                    u1 = __builtin_amdgcn_mfma_f32_16x16x32_bf16(va[ks], b1.f, u1, 0, 0, 0);
                }
#pragma unroll
                for (int r = 0; r < 4; ++r) {
                    cst[(size_t)bh0 * 4096 + (16 * wid + 4 * g + r) * 64 + 16 * dkt + fr] = u0[r];
                    cst[(size_t)bh1 * 4096 + (16 * wid + 4 * g + r) * 64 + 16 * dkt + fr] = u1[r];
                }
            }
            if (tid < 128) {
                const int d = tid >> 6, dk = tid & 63;
                float acc = 0.f;
#pragma unroll 8
                for (int j = 0; j < 64; ++j) acc += bf2f(kT[dk * 72 + j]) * wsl[d * 64 + j];
                nst[(size_t)(d ? bh1 : bh0) * 64 + dk] = acc;
            }
        }
    }
}

DEVINL void ph_mlB(const P& p, int bid, int nb, char* smem) {
    const int TIDX_ = tid_(); char* const WS_ = wsl_(p.ws);
    const int tid = TIDX_;
    const float* mls = (const float*)(WS_ + OFF_MLS);
    float* mst = (float*)(WS_ + OFF_MST);
    float* nst = (float*)(WS_ + OFF_NST);
    const float* cst = (const float*)(WS_ + OFF_HM);
    u16* cst2 = (u16*)(WS_ + OFF_CST2);
    float* nst2 = (float*)(WS_ + OFF_NST2);
    float* gb = (float*)smem;
    float* dcu = gb + 1024;
    for (int u = bid; u < 64; u += nb) {
        const int bhd = u >> 2, q = u & 3, d = bhd & 1;
        auto tcof = [&](int cs) { return cs < 4 ? (d ? 3 - cs : cs) : 4 + (d ? 255 - (cs - 4) : cs - 4); };
        __syncthreads();
        for (int cs = tid; cs < NTC; cs += 256) { const int tc = tcof(cs); gb[cs * 2] = mls[(bhd * NTC + tc) * 2]; gb[cs * 2 + 1] = mls[(bhd * NTC + tc) * 2 + 1]; }
        __syncthreads();
        if (tid == 0) {
            float m = 0.f;
#pragma unroll 1
            for (int cs = 0; cs < NTC; ++cs) {
                const float G = gb[cs * 2], Bs = gb[cs * 2 + 1];
                if (q == 0) mst[bhd * NTC + tcof(cs)] = m;
                const float ml = fmaxf(Bs + m, G);
                dcu[cs * 2] = __expf(Bs + m - ml); dcu[cs * 2 + 1] = __expf(G - ml);
                m = ml;
            }
        }
        __syncthreads();
        float zz = 0.f; asm volatile("" : "+v"(zz));
        float4 C = make_float4(zz, zz, zz, zz);
        float nn = zz;
        const bool don = (q == 0) && (tid < 64);
        const float* cbase = cst + (size_t)bhd * NTC * 4096 + q * 1024 + tid * 4;
        const float* nbase = nst + (size_t)bhd * NTC * 64 + tid;
        u16* obase = cst2 + (size_t)bhd * NTC * 4096 + q * 1024 + tid * 4;
        float* onbase = nst2 + (size_t)bhd * NTC * 64 + tid;
        float4 Ub[8]; float Nb[8];
#pragma unroll
        for (int i = 0; i < 8; ++i) { Ub[i] = *(const float4*)(cbase + (size_t)tcof(i) * 4096); Nb[i] = don ? nbase[(size_t)tcof(i) * 64] : 0.f; }
#pragma unroll 1
        for (int cs0 = 0; cs0 < NTC; cs0 += 8) {
#pragma unroll
            for (int i = 0; i < 8; ++i) {
                const int cs = cs0 + i;
                if (cs < NTC) {
                    const float4 U = Ub[i]; const float nU = Nb[i];
                    const int tc = tcof(cs);
                    if (cs + 8 < NTC) { Ub[i] = *(const float4*)(cbase + (size_t)tcof(cs + 8) * 4096); Nb[i] = don ? nbase[(size_t)tcof(cs + 8) * 64] : 0.f; }
                    { uint2 o; o.x = pk2bf(C.x, C.y); o.y = pk2bf(C.z, C.w); *(uint2*)(obase + (size_t)tc * 4096) = o; }
                    if (don) onbase[(size_t)tc * 64] = nn;
                    const float dC = dcu[cs * 2], dU = dcu[cs * 2 + 1];
                    C.x = dC * C.x + dU * U.x; C.y = dC * C.y + dU * U.y; C.z = dC * C.z + dU * U.z; C.w = dC * C.w + dU * U.w;
                    nn = dC * nn + dU * nU;
                }
            }
        }
    }
}

DEVINL void ph_na(const P& p, int l, char* smem, int bid, int nb) {
    const int TIDX_ = tid_(); char* const WS_ = wsl_(p.ws);
    const int tid = TIDX_, lane = tid & 63, w = tid >> 6, fr = lane & 15, g = lane >> 4;
    const u16* pqk = (const u16*)(WS_ + OFF_PQK);
    const u16* vtl = (const u16*)(WS_ + OFF_VTL);
    const u16* vtc = (const u16*)(WS_ + OFF_VTC);
    u16* y = (u16*)(WS_ + OFF_Y);
    float* rpbl = (float*)(smem + 49152);
    const int nunit = 4096 + (l == 0 ? 64 : 0);
    const unsigned lbase = lds_addr(smem);
    const int lrow0 = tid >> 3, lrow1 = lrow0 + 32, lsc = ((tid & 7) ^ (lrow0 & 7)) * 8;
    for (int u = bid; u < nunit; u += nb) {
        const bool isctx = u >= 4096;
        int b, h, r = 0, qg = 0;
        if (!isctx) { b = u >> 11; h = (u >> 8) & 7; r = u & 255; }
        else { const int v = u - 4096; b = v >> 5; h = (v >> 2) & 7; qg = v & 3; }
        const int rs = min(max(r - 4, 0), 248);
        const int nwin = isctx ? 0 : 8, nst = nwin + 4;
        auto issue = [&](int st) {
            char* slot = smem + (st % 3) * 16384;
            const u16* ksrc; const u16* vsrc; size_t vstride;
            if (st < nwin) {
                const size_t tok0 = (size_t)CTXROWS + (size_t)b * LAT + (size_t)(rs + st) * 64;
                ksrc = pqk + tok0 * 1024 + 512 + h * 64;
                vsrc = vtl + (size_t)((b * 8 + h) * 64) * LAT + (size_t)(rs + st) * 64; vstride = LAT;
            } else {
                const size_t tok0 = (size_t)b * LCTX + (size_t)(st - nwin) * 64;
                ksrc = pqk + tok0 * 1024 + 512 + h * 64;
                vsrc = vtc + (size_t)((b * 8 + h) * 64) * LCTX + (size_t)(st - nwin) * 64; vstride = LCTX;
            }
            glds16(ksrc + (size_t)lrow0 * 1024 + lsc, slot + tid * 16);
            glds16(ksrc + (size_t)lrow1 * 1024 + lsc, slot + 4096 + tid * 16);
            glds16(vsrc + (size_t)lrow0 * vstride + lsc, slot + 8192 + tid * 16);
            glds16(vsrc + (size_t)lrow1 * vstride + lsc, slot + 8192 + 4096 + tid * 16);
        };
        __syncthreads();
        issue(0); issue(1);
        if (!isctx) for (int i = tid; i < 465; i += 256) rpbl[i] = p.na_rpb[((size_t)l * 8 + h) * 465 + i];
        asm volatile("s_waitcnt lgkmcnt(0)" ::: "memory");
        const int c = 16 * w + fr;
        const int qrow = isctx ? b * LCTX + qg * 64 + c : CTXROWS + b * LAT + r * 64 + c;
        bf16x8 qf[2];
        qf[0] = *(const bf16x8*)(pqk + (size_t)qrow * 1024 + h * 64 + 8 * g);
        qf[1] = *(const bf16x8*)(pqk + (size_t)qrow * 1024 + h * 64 + 32 + 8 * g);
        f32x4 O[4];
#pragma unroll
        for (int i = 0; i < 4; ++i) O[i] = f32x4{0.f, 0.f, 0.f, 0.f};
        float mrun = -1.0e30f, lrun = 0.f;
        const int cb = (w == 0) ? 0 : (w == 1) ? 8 : (w == 2) ? 24 : 32;
        const int cs = min(max(c - 8, 0), 48);
        auto chunk = [&](unsigned sl, int kb, const float* bias0, bool local) {
            const int key0 = kb + fr, key1 = kb + 16 + fr;
            const unsigned ka0 = sl + key0 * 128, ka1 = sl + key1 * 128;
            const unsigned k00a = ka0 + ((g ^ (key0 & 7)) << 4), k01a = ka0 + (((4 + g) ^ (key0 & 7)) << 4);
            const unsigned k10a = ka1 + ((g ^ (key1 & 7)) << 4), k11a = ka1 + (((4 + g) ^ (key1 & 7)) << 4);
            const int q0 = (kb >> 2) + g, q1 = q0 + 4;
            const unsigned vbase = sl + 8192 + fr * 128;
            const unsigned vo0 = ((((q0 >> 1) ^ (fr & 7)) << 4) + ((q0 & 1) << 3)), vo1 = ((((q1 >> 1) ^ (fr & 7)) << 4) + ((q1 & 1) << 3));
            u32x4 k00, k01, k10, k11; u32x2 vlo0, vhi0, vlo1, vhi1, vlo2, vhi2, vlo3, vhi3;
            asm volatile(
                "ds_read_b128 %0, %12\n\t"
                "ds_read_b128 %1, %13\n\t"
                "ds_read_b128 %2, %14\n\t"
                "ds_read_b128 %3, %15\n\t"
                "ds_read_b64 %4, %16\n\t"
                "ds_read_b64 %5, %17\n\t"
                "ds_read_b64 %6, %16 offset:2048\n\t"
                "ds_read_b64 %7, %17 offset:2048\n\t"
                "ds_read_b64 %8, %16 offset:4096\n\t"
                "ds_read_b64 %9, %17 offset:4096\n\t"
                "ds_read_b64 %10, %16 offset:6144\n\t"
                "ds_read_b64 %11, %17 offset:6144\n\t"
                "s_waitcnt lgkmcnt(0)"
                : "=&v"(k00), "=&v"(k01), "=&v"(k10), "=&v"(k11), "=&v"(vlo0), "=&v"(vhi0), "=&v"(vlo1), "=&v"(vhi1),
                  "=&v"(vlo2), "=&v"(vhi2), "=&v"(vlo3), "=&v"(vhi3)
                : "v"(k00a), "v"(k01a), "v"(k10a), "v"(k11a), "v"(vbase + vo0), "v"(vbase + vo1)
                : "memory");
            auto asf = [](u32x4 v) { union { u32x4 u; bf16x8 f; } x; x.u = v; return x.f; };
            f32x4 s0 = f32x4{0.f, 0.f, 0.f, 0.f}, s1 = f32x4{0.f, 0.f, 0.f, 0.f};
            s0 = __builtin_amdgcn_mfma_f32_16x16x32_bf16(asf(k00), qf[0], s0, 0, 0, 0);
            s0 = __builtin_amdgcn_mfma_f32_16x16x32_bf16(asf(k01), qf[1], s0, 0, 0, 0);
            s1 = __builtin_amdgcn_mfma_f32_16x16x32_bf16(asf(k10), qf[0], s1, 0, 0, 0);
            s1 = __builtin_amdgcn_mfma_f32_16x16x32_bf16(asf(k11), qf[1], s1, 0, 0, 0);
            float sv[8];
#pragma unroll
            for (int j = 0; j < 4; ++j) {
                float a = s0[j] * 0.125f, bb = s1[j] * 0.125f;
                if (local) {
                    const int k0c = kb + 4 * g + j, k1c = k0c + 16;
                    a = (k0c >= cs && k0c <= cs + 15) ? a + bias0[k0c] : -1.0e30f;
                    bb = (k1c >= cs && k1c <= cs + 15) ? bb + bias0[k1c] : -1.0e30f;
                }
                sv[j] = a; sv[4 + j] = bb;
            }
            float mx = sv[0];
#pragma unroll
            for (int j = 1; j < 8; ++j) mx = fmaxf(mx, sv[j]);
            mx = fmaxf(mx, __shfl_xor(mx, 16)); mx = fmaxf(mx, __shfl_xor(mx, 32));
            const float mnew = fmaxf(mrun, mx);
            const float sc = __expf(mrun - mnew);
            mrun = mnew;
            float ps = 0.f; float pv[8];
#pragma unroll
            for (int j = 0; j < 8; ++j) { pv[j] = __expf(sv[j] - mnew); ps += pv[j]; }
            lrun = lrun * sc + ps;
            union { u32x4 u; bf16x8 f; } pf; pf.u = u32x4{pk2bf(pv[0], pv[1]), pk2bf(pv[2], pv[3]), pk2bf(pv[4], pv[5]), pk2bf(pv[6], pv[7])};
            const u32x2 vl[4] = {vlo0, vlo1, vlo2, vlo3}, vh[4] = {vhi0, vhi1, vhi2, vhi3};
#pragma unroll
            for (int dt = 0; dt < 4; ++dt) {
                O[dt][0] *= sc; O[dt][1] *= sc; O[dt][2] *= sc; O[dt][3] *= sc;
                union { u32x4 u; bf16x8 f; } vf; vf.u = u32x4{vl[dt].x, vl[dt].y, vh[dt].x, vh[dt].y};
                O[dt] = __builtin_amdgcn_mfma_f32_16x16x32_bf16(vf.f, pf.f, O[dt], 0, 0, 0);
            }
        };
#pragma unroll 1
        for (int st = 0; st < nst; ++st) {
            if (st + 1 < nst) asm volatile("s_waitcnt vmcnt(4)" ::: "memory"); else asm volatile("s_waitcnt vmcnt(0)" ::: "memory");
            __builtin_amdgcn_s_barrier();
            if (st + 2 < nst) issue(st + 2);
            const unsigned sl = lbase + (st % 3) * 16384;
            if (st < nwin) {
                const int krow = rs + st;
                chunk(sl, cb, rpbl + (krow - r + 7) * 31 - c + 15, true);
            } else {
                chunk(sl, 0, nullptr, false);
                chunk(sl, 32, nullptr, false);
            }
        }
        float lt = lrun; lt += __shfl_xor(lt, 16); lt += __shfl_xor(lt, 32);
        const float inv = 1.f / lt;
#pragma unroll
        for (int dt = 0; dt < 4; ++dt) {
            uint2 o;
            o.x = pk2bf(O[dt][0] * inv, O[dt][1] * inv);
            o.y = pk2bf(O[dt][2] * inv, O[dt][3] * inv);
            *(uint2*)(y + (size_t)qrow * 1024 + h * 64 + dt * 16 + 4 * g) = o;
        }
    }
    asm volatile("s_waitcnt vmcnt(0)" ::: "memory");
    __syncthreads();
}

DEVINL void ph_mlC(const P& p, int l, char* smem, int bid, int nb) {
    const int TIDX_ = tid_(); char* const WS_ = wsl_(p.ws);
    const int tid = TIDX_, lane = tid & 63, w = tid >> 6, fr = lane & 15, g = lane >> 4;
    const u16* mlf = (const u16*)(WS_ + OFF_MLF);
    const u16* pc = (const u16*)(WS_ + OFF_PC);
    const float* mlg = (const float*)(WS_ + OFF_MLG);
    const float* mst = (const float*)(WS_ + OFF_MST);
    const float* nst = (const float*)(WS_ + OFF_NST2);
    const u16* cst = (const u16*)(WS_ + OFF_CST2);
    u16* y = (u16*)(WS_ + OFF_Y);
    u16* vt = (u16*)smem;
    float* btl = (float*)(smem + 9216);
    float* lil = btl + 128;
    float* nl = lil + 128;
    for (int uh = bid; uh < 2 * NTC * 4; uh += nb) {
        const int u = uh >> 2, h = uh & 3;
        const int b = u / NTC, tc = u % NTC;
        if (tc < 4 && l != 0) continue;
        const int row0 = tc < 4 ? b * LCTX + tc * 64 : CTXROWS + b * LAT + (tc - 4) * 64;
        __syncthreads();
        for (int i = tid; i < 64 * 8; i += 256) {
            const int tok = i >> 3, d8 = (i & 7) * 8;
            const uint4 vv = *(const uint4*)(pc + (size_t)(row0 + tok) * 1040 + 512 + h * 64 + d8);
            const unsigned wv[4] = {vv.x, vv.y, vv.z, vv.w};
#pragma unroll
            for (int k = 0; k < 4; ++k) { vt[(d8 + 2 * k) * 72 + tok] = (u16)(wv[k] & 0xFFFFu); vt[(d8 + 2 * k + 1) * 72 + tok] = (u16)(wv[k] >> 16); }
        }
        if (tid < 128) {
            const int d = tid >> 6, tok = tid & 63;
            lil[d * 64 + tok] = mlg[(size_t)(row0 + tok) * 16 + d * 4 + h];
            nl[d * 64 + tok] = nst[((size_t)((b * 4 + h) * 2 + d) * NTC + tc) * 64 + tok];
        }
        else { const int d = (tid - 128) >> 6, tok = tid & 63; btl[d * 64 + tok] = mlg[(size_t)(row0 + tok) * 16 + 8 + d * 4 + h]; }
        const int t = 16 * w + fr;
        bf16x8 qf[2];
        qf[0] = *(const bf16x8*)(mlf + (size_t)(row0 + t) * 512 + h * 64 + 8 * g);
        qf[1] = *(const bf16x8*)(mlf + (size_t)(row0 + t) * 512 + h * 64 + 32 + 8 * g);
        f32x4 S[4];
#pragma unroll
        for (int st = 0; st < 4; ++st) {
            const u16* kp = mlf + (size_t)(row0 + 16 * st + fr) * 512 + 256 + h * 64 + 8 * g;
            const bf16x8 k0 = *(const bf16x8*)kp, k1 = *(const bf16x8*)(kp + 32);
            S[st] = f32x4{0.f, 0.f, 0.f, 0.f};
            S[st] = __builtin_amdgcn_mfma_f32_16x16x32_bf16(k0, qf[0], S[st], 0, 0, 0);
            S[st] = __builtin_amdgcn_mfma_f32_16x16x32_bf16(k1, qf[1], S[st], 0, 0, 0);
        }
        __syncthreads();
        f32x4 hs[4];
#pragma unroll
        for (int i = 0; i < 4; ++i) hs[i] = f32x4{0.f, 0.f, 0.f, 0.f};
#pragma unroll 1
        for (int d = 0; d < 2; ++d) {
            const int bhd = (b * 4 + h) * 2 + d;
            const float m0 = mst[bhd * NTC + tc];
            const float bt = btl[d * 64 + t];
            float ld[16]; float mx = -3.0e38f;
#pragma unroll
            for (int st = 0; st < 4; ++st) {
                const float4 b4 = *(const float4*)(btl + d * 64 + 16 * st + 4 * g), l4 = *(const float4*)(lil + d * 64 + 16 * st + 4 * g);
                const float bs[4] = {b4.x, b4.y, b4.z, b4.w}, ls[4] = {l4.x, l4.y, l4.z, l4.w};
#pragma unroll
                for (int r = 0; r < 4; ++r) {
                    const int s = 16 * st + 4 * g + r;
                    const bool ok = d ? (s >= t) : (s <= t);
                    ld[4 * st + r] = ok ? (bt - bs[r] + ls[r]) : -3.0e38f;
                    mx = fmaxf(mx, ld[4 * st + r]);
                }
            }
            mx = fmaxf(mx, __shfl_xor(mx, 16)); mx = fmaxf(mx, __shfl_xor(mx, 32));
            const float mt = fmaxf(bt + m0, mx);
            float rsum = 0.f; float dw[16];
#pragma unroll
            for (int i = 0; i < 16; ++i) { dw[i] = (ld[i] > -1.0e38f) ? __expf(ld[i] - mt) * S[i >> 2][i & 3] : 0.f; rsum += dw[i]; }
            rsum += __shfl_xor(rsum, 16); rsum += __shfl_xor(rsum, 32);
            const float inter = __expf(bt + m0 - mt);
            float qn = 0.f;
#pragma unroll
            for (int j = 0; j < 8; ++j) {
                qn += bf2f((u16)qf[0][j]) * nl[d * 64 + 8 * g + j] + bf2f((u16)qf[1][j]) * nl[d * 64 + 32 + 8 * g + j];
            }
            qn += __shfl_xor(qn, 16); qn += __shfl_xor(qn, 32);
            const float den = rsum + inter * qn;
            const float dn = 1.f / fmaxf(fabsf(den), __expf(-mt));
            union { u32x4 u; bf16x8 f; } pf[2];
#pragma unroll
            for (int ks = 0; ks < 2; ++ks) pf[ks].u = u32x4{pk2bf(dw[8 * ks], dw[8 * ks + 1]), pk2bf(dw[8 * ks + 2], dw[8 * ks + 3]), pk2bf(dw[8 * ks + 4], dw[8 * ks + 5]), pk2bf(dw[8 * ks + 6], dw[8 * ks + 7])};
            const u16* cb = cst + ((size_t)bhd * NTC + tc) * 4096;
#pragma unroll
            for (int dvt = 0; dvt < 4; ++dvt) {
                f32x4 num = f32x4{0.f, 0.f, 0.f, 0.f}, qc = f32x4{0.f, 0.f, 0.f, 0.f};
#pragma unroll
                for (int ks = 0; ks < 2; ++ks) {
                    const uint2 lo = *(const uint2*)(vt + (16 * dvt + fr) * 72 + 32 * ks + 4 * g), hi = *(const uint2*)(vt + (16 * dvt + fr) * 72 + 32 * ks + 16 + 4 * g);
                    union { u32x4 u; bf16x8 f; } vf; vf.u = u32x4{lo.x, lo.y, hi.x, hi.y};
                    num = __builtin_amdgcn_mfma_f32_16x16x32_bf16(vf.f, pf[ks].f, num, 0, 0, 0);
                    const bf16x8 cf = *(const bf16x8*)(cb + (16 * dvt + fr) * 64 + 32 * ks + 8 * g);
                    qc = __builtin_amdgcn_mfma_f32_16x16x32_bf16(cf, qf[ks], qc, 0, 0, 0);
                }
#pragma unroll
                for (int r = 0; r < 4; ++r) hs[dvt][r] += (num[r] + inter * qc[r]) * dn;
            }
        }
        float s1 = 0.f;
#pragma unroll
        for (int i = 0; i < 4; ++i) s1 += hs[i][0] + hs[i][1] + hs[i][2] + hs[i][3];
        s1 += __shfl_xor(s1, 16); s1 += __shfl_xor(s1, 32);
        const float mu = s1 * (1.f / 64.f);
        float s2 = 0.f;
#pragma unroll
        for (int i = 0; i < 4; ++i)
#pragma unroll
            for (int r = 0; r < 4; ++r) { const float dl = hs[i][r] - mu; s2 += dl * dl; }
        s2 += __shfl_xor(s2, 16); s2 += __shfl_xor(s2, 32);
        const float rstd = rsqrtf(s2 * (1.f / 64.f) + 1e-6f);
        const int row = row0 + t;
#pragma unroll
        for (int dvt = 0; dvt < 4; ++dvt) {
            const int cc = h * 64 + 16 * dvt + 4 * g;
            const uint2 ov = *(const uint2*)(pc + (size_t)row * 1040 + 768 + cc);
            const float4 nw = *(const float4*)(p.ml_nw + l * 256 + cc);
            const float o0 = bf2f((u16)(ov.x & 0xFFFF)), o1 = bf2f((u16)(ov.x >> 16)), o2 = bf2f((u16)(ov.y & 0xFFFF)), o3 = bf2f((u16)(ov.y >> 16));
            uint2 out;
            out.x = pk2bf((hs[dvt][0] - mu) * rstd * nw.x * sigmoidf_(o0), (hs[dvt][1] - mu) * rstd * nw.y * sigmoidf_(o1));
            out.y = pk2bf((hs[dvt][2] - mu) * rstd * nw.z * sigmoidf_(o2), (hs[dvt][3] - mu) * rstd * nw.w * sigmoidf_(o3));
            *(uint2*)(y + (size_t)row * 1024 + 768 + cc) = out;
        }
    }
}

DEVINL void ph_outproj(const P& p, int l, char* smem) {
    const int TIDX_ = tid_(); const int BIDX_ = bid_(); char* const WS_ = wsl_(p.ws); (void)TIDX_; (void)BIDX_; (void)WS_;
    const u16* y = (const u16*)(WS_ + OFF_Y);
    const u16* wout = (const u16*)(WS_ + OFF_WOUT);
    const float* modv = (const float*)(WS_ + OFF_MOD) + (size_t)l * 3 * 6144;
    const float* x2c = (const float*)(WS_ + OFF_X2CTX);
    float* x1 = (float*)(WS_ + OFF_X1);
    const int mt0 = (l == 0) ? 0 : 4;
    const int ntile = (260 - mt0) * 8;
    XCD_WALK(ntile, BIDX_, (int)gridDim.x);
    for (int u = xw_lo; u < xw_hi; u += xw_st) {
        const int mt = mt0 + u / 8, nt = u % 8;
        const u16* A = y + (size_t)mt * 128 * 1024;
        const int R0 = mt * 128;
        const float* xin;
        if (l == 0) xin = R0 < CTXROWS ? p.ctx + (size_t)R0 * 1024 : p.x + (size_t)(R0 - CTXROWS) * 1024;
        else xin = R0 < CTXROWS ? x2c + (size_t)R0 * 1024 : p.out + (size_t)(R0 - CTXROWS) * 1024;
        const float* g1 = modv + row_sel(R0) * 6144 + 2048;
        f32x4 acc[4][4];
        gemm128_acc([&](int r) { return A + (size_t)r * 1024; }, wout + (size_t)nt * 128 * 1024, 1024, 1024, smem, acc);
        stage_tile_f32(acc, smem, [&](int row, int c4, float4 a) {
            const int N = nt * 128 + c4;
            const float4 gg = *(const float4*)(g1 + N);
            const float4 xv = *(const float4*)(xin + (size_t)row * 1024 + N);
            float4 o;
            o.x = ALPHA * xv.x + gg.x * a.x; o.y = ALPHA * xv.y + gg.y * a.y; o.z = ALPHA * xv.z + gg.z * a.z; o.w = ALPHA * xv.w + gg.w * a.w;
            *(float4*)(x1 + (size_t)(R0 + row) * 1024 + N) = o;
        });
    }
}

DEVINL void ph_ln1(const P& p, int l) {
    const int TIDX_ = tid_(); const int BIDX_ = bid_(); char* const WS_ = wsl_(p.ws); (void)TIDX_; (void)BIDX_; (void)WS_;
    const int lane = TIDX_ & 63, wid = TIDX_ >> 6;
    const float* modv = (const float*)(WS_ + OFF_MOD) + (size_t)l * 3 * 6144;
    float* x1 = (float*)(WS_ + OFF_X1);
    u16* hm = (u16*)(WS_ + OFF_HM);
    const int rstart = (l == 0) ? 0 : CTXROWS;
    const int rstride = (int)gridDim.x * 4;
#pragma unroll 1
    for (int row0 = rstart + BIDX_ * 4 + wid; row0 < T; row0 += 2 * rstride) {
        int rowv[2]; rowv[0] = row0; rowv[1] = row0 + rstride;
        const bool has1 = rowv[1] < T;
        if (!has1) rowv[1] = row0;
        float4 v[2][4];
        float s[2] = {0.f, 0.f};
#pragma unroll
        for (int r = 0; r < 2; ++r)
#pragma unroll
            for (int i = 0; i < 4; ++i) { v[r][i] = *(const float4*)(x1 + (size_t)rowv[r] * 1024 + i * 256 + lane * 4); s[r] += v[r][i].x + v[r][i].y + v[r][i].z + v[r][i].w; }
#pragma unroll
        for (int r = 0; r < 2; ++r) {
            if (r == 1 && !has1) break;
            const int row = rowv[r];
            const float mu = wsum(s[r]) * (1.f / 1024.f);
            float q = 0.f;
#pragma unroll
            for (int i = 0; i < 4; ++i) { v[r][i].x -= mu; v[r][i].y -= mu; v[r][i].z -= mu; v[r][i].w -= mu; q += v[r][i].x * v[r][i].x + v[r][i].y * v[r][i].y + v[r][i].z * v[r][i].z + v[r][i].w * v[r][i].w; }
            const float rstd = rsqrtf(wsum(q) * (1.f / 1024.f) + 1e-5f);
            const float* mv = modv + row_sel(row) * 6144;
#pragma unroll
            for (int i = 0; i < 4; ++i) {
                const int c = i * 256 + lane * 4;
                const float4 g = *(const float4*)(p.ln1g + l * 1024 + c), bb = *(const float4*)(p.ln1b + l * 1024 + c);
                const float4 sh = *(const float4*)(mv + 3072 + c), sc = *(const float4*)(mv + 4096 + c);
                float4 o;
                o.x = v[r][i].x * rstd * g.x + bb.x; o.y = v[r][i].y * rstd * g.y + bb.y; o.z = v[r][i].z * rstd * g.z + bb.z; o.w = v[r][i].w * rstd * g.w + bb.w;
                *(float4*)(x1 + (size_t)row * 1024 + c) = o;
                uint2 hh;
                hh.x = (unsigned)f2bf(o.x * (1.f + sc.x) + sh.x) | ((unsigned)f2bf(o.y * (1.f + sc.y) + sh.y) << 16);
                hh.y = (unsigned)f2bf(o.z * (1.f + sc.z) + sh.z) | ((unsigned)f2bf(o.w * (1.f + sc.w) + sh.w) << 16);
                *(uint2*)(hm + (size_t)row * 1024 + c) = hh;
            }
        }
    }
}

DEVINL void ph_router(const P& p, int l, char* smem) {
    const int TIDX_ = tid_(); const int BIDX_ = bid_(); char* const WS_ = wsl_(p.ws); (void)TIDX_; (void)BIDX_; (void)WS_;
    const u16* hm = (const u16*)(WS_ + OFF_HM);
    const u16* wr = (const u16*)(WS_ + OFF_WR) + (size_t)l * 128 * 1024;
    float* lg = (float*)(WS_ + OFF_LOGITS);
    const int mt0 = (l == 0) ? 0 : 4;
    for (int u = BIDX_; u < 260 - mt0; u += gridDim.x) {
        const int mt = mt0 + u;
        const u16* A = hm + (size_t)mt * 128 * 1024;
        gemm128([&](int r) { return A + (size_t)r * 1024; }, wr, 1024, 1024, smem,
                [&](int m, int n, f32x4 a) {
                    if (n < 36) {
#pragma unroll
                        for (int j = 0; j < 4; ++j) lg[(size_t)(mt * 128 + m + j) * 64 + n] = a[j];
                    }
                });
    }
}

DEVINL void ph_route1(const P& p, int l, char* smem) {
    const int TIDX_ = tid_(); const int BIDX_ = bid_(); char* const WS_ = wsl_(p.ws); (void)TIDX_; (void)BIDX_; (void)WS_;
    const int tid = TIDX_;
    const float* lg = (const float*)(WS_ + OFF_LOGITS);
    int* toke = (int*)(WS_ + OFF_TOKE); float* tokw = (float*)(WS_ + OFF_TOKW);
    int* cnt = (int*)(WS_ + CTL_CNT) + l * 32;
    int* hist = (int*)smem;
    __syncthreads();
    if (tid < 32) hist[tid] = 0;
    __syncthreads();
    const int rstart = (l == 0) ? 0 : CTXROWS;
    for (int row = rstart + BIDX_ * 256 + tid; row < T; row += gridDim.x * 256) {
        const float* q = lg + (size_t)row * 64;
        float gl[4]; int gs = 0; float gm = -3.0e38f;
#pragma unroll
        for (int i = 0; i < 4; ++i) { gl[i] = q[i] + p.rgb[l * 4 + i]; if (gl[i] > gm) { gm = gl[i]; gs = i; } }
        float se = 0.f;
#pragma unroll
        for (int i = 0; i < 4; ++i) se += expf(gl[i] - gm);
        const float gw = 1.f / se;
        float v1 = -3.0e38f, v2 = -3.0e38f; int i1 = 0, i2 = 0;
#pragma unroll
        for (int i = 0; i < 8; ++i) {
            const float e = q[4 + gs * 8 + i] + p.reb[l * 32 + gs * 8 + i];
            if (e > v1) { v2 = v1; i2 = i1; v1 = e; i1 = i; }
            else if (e > v2) { v2 = e; i2 = i; }
        }
        const float e2 = expf(v2 - v1);
        const float w1 = gw / (1.f + e2), w2 = gw * e2 / (1.f + e2);
        const int ea = gs * 8 + i1, eb = gs * 8 + i2;
        toke[row * 2] = ea; toke[row * 2 + 1] = eb; tokw[row * 2] = w1; tokw[row * 2 + 1] = w2;
        atomicAdd(&hist[ea], 1); atomicAdd(&hist[eb], 1);
    }
    __syncthreads();
    if (tid < 32 && hist[tid] > 0) atomicAdd(&cnt[tid], hist[tid]);
}

DEVINL void ph_route2(const P& p, int l, char* smem) {
    const int TIDX_ = tid_(); const int BIDX_ = bid_(); char* const WS_ = wsl_(p.ws); (void)TIDX_; (void)BIDX_; (void)WS_;
    const int tid = TIDX_;
    const int* toke = (const int*)(WS_ + OFF_TOKE);
    int* toks = (int*)(WS_ + OFF_TOKS);
    int* slottok = (int*)(WS_ + OFF_SLOTTOK);
    const int* cnt = (const int*)(WS_ + CTL_CNT) + l * 32;
    int* cur = (int*)(WS_ + CTL_CUR) + l * 32;
    int* tiles = (int*)(WS_ + OFF_TILES);
    int* off = (int*)smem;
    int* hist = off + 64;
    int* base = hist + 32;
    __syncthreads();
    if (tid == 0) { int a = 0; for (int e = 0; e < 32; ++e) { off[e] = a; a += (cnt[e] + 127) & ~127; } off[32] = a; }
    if (tid < 32) hist[tid] = 0;
    __syncthreads();
    if (BIDX_ == 0) {
        if (tid == 0) {
            int nt = 0;
#pragma clang loop vectorize(disable) unroll(disable)
            for (int e = 0; e < 32; ++e) {
#pragma clang loop vectorize(disable) unroll(disable)
                for (int s = off[e]; s < off[e + 1]; s += 128) { tiles[64 + nt * 2] = e; tiles[64 + nt * 2 + 1] = s; ++nt; }
            }
            tiles[40] = nt;
        }
#pragma clang loop vectorize(disable) unroll(disable)
        for (int e = 0; e < 32; ++e) {
#pragma clang loop vectorize(disable) unroll(disable)
            for (int s = off[e] + cnt[e] + tid; s < off[e + 1]; s += 256) slottok[s] = (l == 0) ? 0 : CTXROWS;
        }
    }
    const int rstart = (l == 0) ? 0 : CTXROWS;
    for (int a0 = rstart * 2 + BIDX_ * 256; a0 < T * 2; a0 += gridDim.x * 256) {
        const int a = a0 + tid;
        int e = -1, lpos = 0;
        if (a < T * 2) { e = toke[a]; lpos = atomicAdd(&hist[e], 1); }
        __syncthreads();
        if (tid < 32) { base[tid] = hist[tid] > 0 ? atomicAdd(&cur[tid], hist[tid]) : 0; }
        __syncthreads();
        if (e >= 0) { const int s = off[e] + base[e] + lpos; toks[a] = s; slottok[s] = a >> 1; }
        __syncthreads();
        if (tid < 32) hist[tid] = 0;
        __syncthreads();
    }
}

DEVINL void ph_gateup(const P& p, char* smem) {
    const int TIDX_ = tid_(); const int BIDX_ = bid_(); char* const WS_ = wsl_(p.ws); (void)TIDX_; (void)BIDX_; (void)WS_;
    const int tid = TIDX_, lane = tid & 63, wid = tid >> 6, wr = wid >> 1, wc = wid & 1, fr = lane & 15, fq = lane >> 4;
    const u16* hm = (const u16*)(WS_ + OFF_HM);
    const u16* wgu = (const u16*)(WS_ + OFF_WGU);
    const int* tiles = (const int*)(WS_ + OFF_TILES);
    const int* slottok = (const int*)(WS_ + OFF_SLOTTOK);
    u16* act = (u16*)(WS_ + OFF_ACT);
    const int ntile = tiles[40] * 8;
    XCD_WALK(ntile, BIDX_, (int)gridDim.x);
    for (int u = xw_lo; u < xw_hi; u += xw_st) {
        const int ti = u >> 3, nt = u & 7;
        const int e = tiles[64 + ti * 2], s0 = tiles[64 + ti * 2 + 1];
        f32x4 acc[4][4];
        gemm128_acc([&](int r) { return hm + (size_t)slottok[s0 + r] * 1024; }, wgu + ((size_t)e * 1024 + nt * 128) * 1024, 1024, 1024, smem, acc);
        {
            u16* t = (u16*)smem;
            __syncthreads();
#pragma unroll
            for (int m = 0; m < 4; ++m)
#pragma unroll
                for (int n = 0; n < 4; n += 2) {
                    const int jc = (wc * 64 + n * 16) / 2 + fr;
                    const int r0 = wr * 64 + m * 16 + fq * 4;
                    float av[4];
#pragma unroll
                    for (int j = 0; j < 4; ++j) { const float gte = acc[m][n][j], up = acc[m][n + 1][j]; av[j] = gte / (1.f + __expf(-gte)) * up; }
                    const unsigned p01 = pk2bf(av[0], av[1]), p23 = pk2bf(av[2], av[3]);
                    t[(r0 + 0) * 72 + jc] = (u16)(p01 & 0xFFFFu); t[(r0 + 1) * 72 + jc] = (u16)(p01 >> 16);
                    t[(r0 + 2) * 72 + jc] = (u16)(p23 & 0xFFFFu); t[(r0 + 3) * 72 + jc] = (u16)(p23 >> 16);
                }
            __syncthreads();
#pragma unroll
            for (int i = 0; i < 4; ++i) {
                const int ci = tid + 256 * i, row = ci >> 3, c8 = (ci & 7) * 8;
                *(uint4*)(act + (size_t)(s0 + row) * 512 + nt * 64 + c8) = *(const uint4*)(t + row * 72 + c8);
            }
        }
    }
}

DEVINL void ph_down(const P& p, char* smem) {
    const int TIDX_ = tid_(); const int BIDX_ = bid_(); char* const WS_ = wsl_(p.ws); (void)TIDX_; (void)BIDX_; (void)WS_;
    const u16* act = (const u16*)(WS_ + OFF_ACT);
    const u16* wdn = (const u16*)(WS_ + OFF_WDN);
    const int* tiles = (const int*)(WS_ + OFF_TILES);
    u16* so = (u16*)(WS_ + OFF_SLOTOUT);
    const int ntile = tiles[40] * 8;
    XCD_WALK(ntile, BIDX_, (int)gridDim.x);
    for (int u = xw_lo; u < xw_hi; u += xw_st) {
        const int ti = u >> 3, nt = u & 7;
        const int e = tiles[64 + ti * 2], s0 = tiles[64 + ti * 2 + 1];
        const u16* A = act + (size_t)s0 * 512;
        f32x4 acc[4][4];
        gemm128_acc([&](int r) { return A + (size_t)r * 512; }, wdn + ((size_t)e * 1024 + nt * 128) * 512, 512, 512, smem, acc);
        stage_tile_bf16(acc, smem, [&](int row, int c8, uint4 v) { *(uint4*)(so + (size_t)(s0 + row) * 1024 + nt * 128 + c8) = v; });
    }
}

DEVINL void ph_ln2(const P& p, int l) {
    const int TIDX_ = tid_(); const int BIDX_ = bid_(); char* const WS_ = wsl_(p.ws); (void)TIDX_; (void)BIDX_; (void)WS_;
    const int lane = TIDX_ & 63, wid = TIDX_ >> 6;
    const float* modv = (const float*)(WS_ + OFF_MOD) + (size_t)l * 3 * 6144;
    const float* modn = (const float*)(WS_ + OFF_MOD) + (size_t)(l + 1) * 3 * 6144;
    const float* x1 = (const float*)(WS_ + OFF_X1);
    const u16* so = (const u16*)(WS_ + OFF_SLOTOUT);
    const int* toks = (const int*)(WS_ + OFF_TOKS);
    const float* tokw = (const float*)(WS_ + OFF_TOKW);
    float* x2c = (float*)(WS_ + OFF_X2CTX);
    u16* hm = (u16*)(WS_ + OFF_HM);
    const int rstart = (l == 0) ? 0 : CTXROWS;
    const int rstride = (int)gridDim.x * 4;
#pragma unroll 1
    for (int row0 = rstart + BIDX_ * 4 + wid; row0 < T; row0 += 2 * rstride) {
        int rowv[2]; rowv[0] = row0; rowv[1] = row0 + rstride;
        const bool has1 = rowv[1] < T;
        if (!has1) rowv[1] = row0;
        int sa[2], sb[2]; float wa[2], wb[2];
#pragma unroll
        for (int r = 0; r < 2; ++r) { sa[r] = toks[rowv[r] * 2]; sb[r] = toks[rowv[r] * 2 + 1]; wa[r] = tokw[rowv[r] * 2]; wb[r] = tokw[rowv[r] * 2 + 1]; }
        float4 v[2][4];
        float s[2] = {0.f, 0.f};
#pragma unroll
        for (int r = 0; r < 2; ++r) {
            const float* mv = modv + row_sel(rowv[r]) * 6144;
#pragma unroll
            for (int i = 0; i < 4; ++i) {
                const int c = i * 256 + lane * 4;
                const float4 xv = *(const float4*)(x1 + (size_t)rowv[r] * 1024 + c);
                const uint2 ua = *(const uint2*)(so + (size_t)sa[r] * 1024 + c), ub = *(const uint2*)(so + (size_t)sb[r] * 1024 + c);
                const float4 g2 = *(const float4*)(mv + 5120 + c);
                const float f0 = wa[r] * bf2f((u16)(ua.x & 0xFFFF)) + wb[r] * bf2f((u16)(ub.x & 0xFFFF));
                const float f1 = wa[r] * bf2f((u16)(ua.x >> 16)) + wb[r] * bf2f((u16)(ub.x >> 16));
                const float f2 = wa[r] * bf2f((u16)(ua.y & 0xFFFF)) + wb[r] * bf2f((u16)(ub.y & 0xFFFF));
                const float f3 = wa[r] * bf2f((u16)(ua.y >> 16)) + wb[r] * bf2f((u16)(ub.y >> 16));
                v[r][i].x = ALPHA * xv.x + g2.x * f0; v[r][i].y = ALPHA * xv.y + g2.y * f1; v[r][i].z = ALPHA * xv.z + g2.z * f2; v[r][i].w = ALPHA * xv.w + g2.w * f3;
                s[r] += v[r][i].x + v[r][i].y + v[r][i].z + v[r][i].w;
            }
        }
#pragma unroll
        for (int r = 0; r < 2; ++r) {
            if (r == 1 && !has1) break;
            const int row = rowv[r];
            const float mu = wsum(s[r]) * (1.f / 1024.f);
            float q = 0.f;
#pragma unroll
            for (int i = 0; i < 4; ++i) { v[r][i].x -= mu; v[r][i].y -= mu; v[r][i].z -= mu; v[r][i].w -= mu; q += v[r][i].x * v[r][i].x + v[r][i].y * v[r][i].y + v[r][i].z * v[r][i].z + v[r][i].w * v[r][i].w; }
            const float rstd = rsqrtf(wsum(q) * (1.f / 1024.f) + 1e-5f);
            float* dst = row < CTXROWS ? x2c + (size_t)row * 1024 : p.out + (size_t)(row - CTXROWS) * 1024;
            const float* mn = modn + row_sel(row) * 6144;
#pragma unroll
            for (int i = 0; i < 4; ++i) {
                const int c = i * 256 + lane * 4;
                const float4 g = *(const float4*)(p.ln2g + l * 1024 + c), bb = *(const float4*)(p.ln2b + l * 1024 + c);
                float4 o;
                o.x = v[r][i].x * rstd * g.x + bb.x; o.y = v[r][i].y * rstd * g.y + bb.y; o.z = v[r][i].z * rstd * g.z + bb.z; o.w = v[r][i].w * rstd * g.w + bb.w;
                *(float4*)(dst + c) = o;
                if (l == 0) {
                    const float4 sh = *(const float4*)(mn + c), sc = *(const float4*)(mn + 1024 + c);
                    uint2 hh;
                    hh.x = (unsigned)f2bf(o.x * (1.f + sc.x) + sh.x) | ((unsigned)f2bf(o.y * (1.f + sc.y) + sh.y) << 16);
                    hh.y = (unsigned)f2bf(o.z * (1.f + sc.z) + sh.z) | ((unsigned)f2bf(o.w * (1.f + sc.w) + sh.w) << 16);
                    *(uint2*)(hm + (size_t)row * 1024 + c) = hh;
                }
            }
        }
    }
}

DEVINL void gbar(XcdBarrier b) {
    unsigned x = b.x; GAS unsigned* q = (GAS unsigned*)b.bar;
    asm volatile("" : "+s"(x), "+s"(q));
    b.x = x; b.bar = (unsigned*)q;
    xcd_barrier(b);
}
#ifndef PROBE
#define PROBE 0
#endif
__global__ void __launch_bounds__(256, 2) k_mega(P p) {
    __shared__ __attribute__((aligned(16))) char smem[SMEM_BYTES];
    if (threadIdx.x == 0) *(uint4*)(smem + SMEM_BYTES - 16) = make_uint4(0u, 0u, 0u, 0u);
    __syncthreads();
    XcdBarrier bar = xcd_barrier_post((unsigned*)p.ws, (volatile LAS unsigned*)(smem + SMEM_BYTES - 16));
    const int bid = blockIdx.x, nb = gridDim.x;
#if TPROBE
    unsigned long long tp_acc = 0, tp_last = wall_clock64();
#if TPROBE >= 30
    if (bid == 0 && threadIdx.x == 0) { g_tp_acc = 0; g_tp_last = wall_clock64(); }
#endif
#define TP(g) do { const unsigned long long _n = wall_clock64(); if ((g) == TPROBE) tp_acc += _n - tp_last; tp_last = _n; } while (0)
#else
#define TP(g) do { } while (0)
#endif
    if (threadIdx.x == 0) {
        const unsigned key = ((unsigned)__builtin_amdgcn_s_getreg((3 << 11) | 20) << 8) | ((unsigned)__builtin_amdgcn_s_getreg((7 << 11) | (8 << 6) | 4) & 0xFFu);
        ((unsigned*)(p.ws + CTL_CUKEY))[blockIdx.x] = key | 0x80000000u;
    }
    ph_prolog(p, smem);
    ph_convw(p, 0, smem);
    gbar(bar);
    TP(1);
    ph_xm0(p);
    gbar(bar);
    TP(1);
    constexpr int NSCAN = 16;
    bool quiet; int wrank, nwork, mate_of = -1;
    {
        const unsigned* keys = (const unsigned*)(p.ws + CTL_CUKEY);
        int* cnt = (int*)smem;
        if (threadIdx.x < 2) cnt[threadIdx.x] = 0;
        __syncthreads();
        for (int i = NSCAN + threadIdx.x; i < nb; i += 256) {
            const unsigned k = keys[i];
            bool qq = false;
            for (int j = 0; j < NSCAN && j < nb; ++j) qq = qq || (keys[j] == k);
            if (qq) { atomicAdd(&cnt[1], 1); if (i < bid) atomicAdd(&cnt[0], 1); }
        }
        __syncthreads();
        const int below = cnt[0], total = cnt[1];
        bool me = false;
        if (bid >= NSCAN) { const unsigned k = keys[bid]; for (int j = NSCAN - 1; j >= 0; --j) if (j < nb && keys[j] == k) { me = true; mate_of = j; } }
        __syncthreads();
        if (total > 2 * NSCAN) { quiet = false; wrank = bid - NSCAN; nwork = nb - NSCAN; mate_of = -1; }
        else { quiet = me; wrank = bid - NSCAN - below; nwork = nb - NSCAN - total; }
    }
#pragma unroll 1
    for (int l = 0; l < NLAYER; ++l) {
        ph_inproj(p, smem);
        gbar(bar);
    TP(2);
        ph_rwprep(p, l, 0, smem, bid, nb);
        ph_prepM(p, l, smem, nb - 1 - bid, nb);
        gbar(bar);
    TP(3);
        if (bid < NSCAN) { ph_rwscan(p, l, 0, bid, NSCAN, smem); TP(20); }
        else if (!quiet) { if (nwork > 128) { if (wrank < 64) ph_mlB(p, wrank, 64, smem); else ph_na(p, l, smem, wrank - 64, nwork - 64); } else { ph_mlB(p, wrank, nwork, smem); ph_na(p, l, smem, wrank, nwork); } }
        gbar(bar);
    TP(4);
        ph_rwprep(p, l, 1, smem, bid, nb);
        gbar(bar);
    TP(5);
        if (bid < NSCAN) { ph_rwscan(p, l, 1, bid, NSCAN, smem); TP(21); }
        else if (!quiet) { ph_mlC(p, l, smem, wrank, nwork); ph_convexp(p, l, smem, wrank, nwork); }
        gbar(bar);
    TP(6);
        ph_rwout(p, l);
        gbar(bar);
    TP(7);
        ph_outproj(p, l, smem);
        gbar(bar);
    TP(8);
        ph_ln1(p, l);
        gbar(bar);
    TP(9);
        ph_router(p, l, smem);
        gbar(bar);
    TP(9);
        ph_route1(p, l, smem);
        gbar(bar);
    TP(9);
        ph_route2(p, l, smem);
        gbar(bar);
    TP(9);
        ph_gateup(p, smem);
        gbar(bar);
    TP(10);
        ph_down(p, smem);
        gbar(bar);
    TP(11);
        ph_ln2(p, l);
        if (l + 1 < NLAYER) ph_convw(p, l + 1, smem);
        gbar(bar);
    TP(12);
    }
#if TPROBE
#if TPROBE >= 30
    if (bid == 0 && threadIdx.x == 0) tp_acc += g_tp_acc;
#endif
    if (bid == 0 && threadIdx.x == 0) { const unsigned long long t_end = wall_clock64() + tp_acc; while (wall_clock64() < t_end) __builtin_amdgcn_s_sleep(8); }
    __syncthreads();
    gbar(bar);
#endif
}


extern "C" void kernel_launch(void* const* d_in, const int* in_sizes, int n_in, void* d_out, int out_size, void* d_ws, size_t ws_size,
                              hipStream_t stream) {
    if (n_in != 37 || ws_size < WS_NEED) { fprintf(stderr, "kernel_launch: n_in %d ws %zu need %zu\n", n_in, ws_size, (size_t)WS_NEED); return; }
    static int grid = 0;
    if (!grid) {
        int dev = 0, cus = 0, per_cu = 0;
        (void)hipGetDevice(&dev);
        (void)hipDeviceGetAttribute(&cus, hipDeviceAttributeMultiprocessorCount, dev);
        (void)hipOccupancyMaxActiveBlocksPerMultiprocessor(&per_cu, (const void*)k_mega, 256, 0);
        if (per_cu < 1) per_cu = 1;
        grid = cus * (per_cu < 2 ? per_cu : 2);
    }
    P p{};
    const float** pp = (const float**)&p;
    for (int i = 0; i < 37; ++i) pp[i] = (const float*)d_in[i];
    p.out = (float*)d_out; p.ws = (char*)d_ws;
    (void)hipMemsetAsync(d_ws, 0, CTL_BYTES, stream);
    k_mega<<<dim3(grid), dim3(256), 0, stream>>>(p);
}
```

```cpp
#include <hip/hip_runtime.h>
#include <hip/hip_bf16.h>
#include <stdint.h>
#include <stdio.h>
#include <type_traits>
#ifndef TPROBE
#define TPROBE 0
#endif
#if TPROBE >= 30
__device__ unsigned long long g_tp_acc, g_tp_last;
#define RWTP(g) do { if (blockIdx.x == 0 && threadIdx.x == 0) { const unsigned long long _n = wall_clock64(); if ((g) == TPROBE) g_tp_acc += _n - g_tp_last; g_tp_last = _n; } } while (0)
#else
#define RWTP(g) do { } while (0)
#endif


#define DEVINL __device__ __forceinline__
typedef unsigned short u16;
using bf16x8 = __attribute__((ext_vector_type(8))) short;
using f32x4 = __attribute__((ext_vector_type(4))) float;

constexpr int D = 1024, LAT = 16384, LCTX = 256, T = 33280, CTXROWS = 512;
constexpr int INP = 3536;
constexpr int NLAYER = 2;
constexpr float ALPHA = 1.41421356237309515f;
constexpr int NUNIT_CH = 520;
constexpr int NTC = 260;
constexpr int MAXSLOT = 70656;
constexpr int SMEM_BYTES = 81920;

constexpr size_t al(size_t x) { return (x + 255) & ~(size_t)255; }
constexpr size_t CTL_CNT = 16384;
constexpr size_t CTL_CUR = CTL_CNT + 256;
constexpr size_t CTL_CUKEY = 20480;
constexpr size_t CTL_PROG = 24576;
constexpr size_t CTL_BYTES = 32768;
constexpr size_t OFF_MOD = CTL_BYTES;
constexpr size_t OFF_ROPE = OFF_MOD + al(2 * 3 * 6144 * 4);
constexpr size_t OFF_WR = OFF_ROPE + al(10240 * 4);
constexpr size_t OFF_LORA = OFF_WR + al(2 * 128 * 1024 * 2);
constexpr size_t OFF_TILES = OFF_LORA + al(3 * 65536);
constexpr size_t OFF_BH = OFF_TILES + al((64 + 2048) * 4);
constexpr size_t OFF_TOKE = OFF_BH + al(260 * 32 * 4);
constexpr size_t OFF_TOKW = OFF_TOKE + al((size_t)T * 2 * 4);
constexpr size_t OFF_TOKS = OFF_TOKW + al((size_t)T * 2 * 4);
constexpr size_t OFF_SLOTTOK = OFF_TOKS + al((size_t)T * 2 * 4);
constexpr size_t OFF_X2CTX = OFF_SLOTTOK + al((size_t)MAXSLOT * 4);
constexpr size_t OFF_ZST = OFF_X2CTX + al((size_t)512 * 1024 * 4);
constexpr size_t OFF_WIN = OFF_ZST + al((size_t)16 * 4 * 64 * 16 * 4);
constexpr size_t OFF_WOUT = OFF_WIN + al((size_t)3584 * 1024 * 2);
constexpr size_t OFF_X1 = OFF_WOUT + al((size_t)1024 * 1024 * 2);
constexpr size_t OFF_HM = OFF_X1 + al((size_t)T * 1024 * 4);
constexpr size_t OFF_P = OFF_HM + al((size_t)T * 1024 * 2);
constexpr size_t OFF_PQK = OFF_P;
constexpr size_t OFF_VTL = OFF_PQK + (size_t)T * 1024 * 2;
constexpr size_t OFF_VTC = OFF_VTL + (size_t)2 * 8 * 64 * 16384 * 2;
constexpr size_t OFF_PB = OFF_VTC + (size_t)2 * 8 * 64 * 256 * 2;
constexpr size_t OFF_PC = OFF_PB + (size_t)T * 960 * 2;
constexpr size_t OFF_Y = OFF_PC + (size_t)T * 1040 * 2;
constexpr size_t OFF_MLF = OFF_Y + (size_t)T * 1024 * 2;
constexpr size_t OFF_GATE = OFF_MLF + (size_t)T * 512 * 2;
constexpr size_t OFF_MLG = OFF_GATE + (size_t)T * 256 * 2;
constexpr size_t OFF_MLS = OFF_MLG + (size_t)T * 16 * 4;
constexpr size_t OFF_MST = OFF_MLS + al(16 * 260 * 2 * 4);
constexpr size_t OFF_NST = OFF_MST + al(16 * 260 * 4);
constexpr size_t OFF_CST2 = OFF_NST + al(16 * 260 * 64 * 4);
constexpr size_t OFF_NST2 = OFF_CST2 + (size_t)16 * 260 * 4096 * 2;
constexpr size_t OFF_END1 = OFF_NST2 + al(16 * 260 * 64 * 4);
constexpr size_t OFF_WGU = OFF_P;
constexpr size_t OFF_WDN = OFF_WGU + (size_t)32 * 1024 * 1024 * 2;
constexpr size_t OFF_ACT = OFF_WDN + (size_t)32 * 1024 * 512 * 2;
constexpr size_t OFF_SLOTOUT = OFF_ACT + (size_t)MAXSLOT * 512 * 2;
constexpr size_t OFF_LOGITS = OFF_SLOTOUT + (size_t)MAXSLOT * 1024 * 2;
constexpr size_t OFF_END2 = OFF_LOGITS + (size_t)T * 64 * 4;
constexpr size_t WS_NEED = OFF_END1 > OFF_END2 ? OFF_END1 : OFF_END2;
static_assert(OFF_WDN <= OFF_Y, "Wexp must not overlap y");
static_assert(OFF_LOGITS >= OFF_MLF, "logits placement");

struct P {
    const float *x, *c, *ctx, *c_ctx, *w_mod, *b_mod, *w_in, *na_rpb, *mu_prev, *mu_next, *rw_w0, *rw_w2, *rw_a0, *rw_a2,
        *rw_g2, *rw_kk, *rw_ka, *rw_rk, *rw_lnw, *rw_lnb, *ml_cw, *ml_cb, *ml_ib, *ml_fb, *ml_nw, *w_out, *ln1g, *ln1b,
        *rgw, *rgb, *rew, *reb, *egate, *eup, *edown, *ln2g, *ln2b;
    float* out;
    char* ws;
};

#define XB_TMO      128
#define XB_XCNT(j)  (256  + 64 * (j))
#define XB_XSUB(j)  (1280 + 64 * (j))
#define XB_XGEN(j)  (2304 + 64 * (j))
#define XB_TOP      3328
#define XB_TOPGEN   3392
#define XCD_BAR_WORDS 3456
#define XB_SPIN_CAP (1u << 18)
#define LAS __attribute__((address_space(3)))

__device__ __forceinline__ unsigned xb_ld(unsigned* p)              { return __hip_atomic_load(p, __ATOMIC_RELAXED, __HIP_MEMORY_SCOPE_AGENT); }
__device__ __forceinline__ unsigned xb_add(unsigned* p, unsigned v) { return __hip_atomic_fetch_add(p, v, __ATOMIC_RELAXED, __HIP_MEMORY_SCOPE_AGENT); }
__device__ __forceinline__ unsigned xb_xcc_id() { return (unsigned)__builtin_amdgcn_s_getreg((3 << 11) | 20) & 0xFu; }
#define XB_SPIN(cond, bar) do { unsigned _sp = 0; while (cond) { __builtin_amdgcn_s_sleep(1); \
    if ((++_sp & 255u) == 0u) { if (xb_ld(&(bar)[XB_TMO])) break; if (_sp > XB_SPIN_CAP) { atomicAdd(&(bar)[XB_TMO], 1u); break; } } } } while (0)

struct XcdBarrier {
    unsigned* bar; unsigned x;
    volatile LAS unsigned* st;
};

__device__ __forceinline__ XcdBarrier xcd_barrier_post(unsigned* bar, volatile LAS unsigned* st) {
    XcdBarrier b; b.bar = bar; b.x = xb_xcc_id(); b.st = st;
    if (threadIdx.x == 0) (void)xb_add(&bar[XB_XCNT(b.x)], 1u);
    return b;
}
__device__ __forceinline__ void xcd_barrier_complete(unsigned* bar, unsigned x, unsigned& nloc, unsigned& nx) {
    const unsigned G = gridDim.x * gridDim.y * gridDim.z;
    unsigned sum, cnt, mine, sp = 0u;
    for (;;) {
        sum = 0u; cnt = 0u; mine = 0u;
#pragma unroll
        for (unsigned j = 0; j < 16; ++j) { const unsigned c = xb_ld(&bar[XB_XCNT(j)]); sum += c; cnt += (c > 0u) ? 1u : 0u; mine = (j == x) ? c : mine; }
        if (sum == G) break;
        __builtin_amdgcn_s_sleep(1);
        if ((++sp & 255u) == 0u) { if (xb_ld(&bar[XB_TMO])) break; if (sp > XB_SPIN_CAP) { atomicAdd(&bar[XB_TMO], 1u); break; } }
    }
    nloc = mine > 0u ? mine : 1u; nx = cnt > 0u ? cnt : 1u;
}

__device__ __forceinline__ void xcd_barrier(const XcdBarrier& b) {
    asm volatile("s_waitcnt vmcnt(0)" ::: "memory");
    __syncthreads();
    if (threadIdx.x == 0) {
        unsigned* bar = b.bar;
        __builtin_amdgcn_s_waitcnt(0);
        unsigned nloc = b.st[0], nx = b.st[1];
        if (nloc == 0u) { xcd_barrier_complete(bar, b.x, nloc, nx); b.st[0] = nloc; b.st[1] = nx; }
        const unsigned old = xb_add(&bar[XB_XSUB(b.x)], 1u);
        const unsigned gen = old / nloc;
        if (old + 1u == (gen + 1u) * nloc) {
            __builtin_amdgcn_fence(__ATOMIC_RELEASE, "agent");
            asm volatile("s_waitcnt vmcnt(0)" ::: "memory");
            const unsigned og = xb_add(&bar[XB_TOP], 1u);
            const unsigned tg = og / nx;
            if (og + 1u == (tg + 1u) * nx) xb_add(&bar[XB_TOPGEN], 1u);
            else XB_SPIN(xb_ld(&bar[XB_TOPGEN]) == tg, bar);
            __builtin_amdgcn_fence(__ATOMIC_ACQUIRE, "agent");
            xb_add(&bar[XB_XGEN(b.x)], 1u);
            asm volatile("s_waitcnt vmcnt(0)" ::: "memory");
        } else {
            XB_SPIN(xb_ld(&bar[XB_XGEN(b.x)]) == gen, bar);
            __builtin_amdgcn_fence(__ATOMIC_ACQUIRE, "agent");
            asm volatile("s_waitcnt vmcnt(0)" ::: "memory");
        }
    }
    __syncthreads();
}


DEVINL int tid_() { int t = threadIdx.x; asm volatile("" : "+v"(t)); return t; }
DEVINL int bid_() { int b = blockIdx.x; asm volatile("" : "+s"(b)); return b; }
#define GAS __attribute__((address_space(1)))
DEVINL char* wsl_(char* w) { GAS char* g = (GAS char*)w; asm volatile("" : "+s"(g)); return (char*)g; }
template <class Tp> DEVINL const Tp* gl_(const Tp* q) { const GAS Tp* g = (const GAS Tp*)q; asm volatile("" : "+s"(g)); return (const Tp*)g; }
typedef float f32x2_t __attribute__((ext_vector_type(2)));
typedef __bf16 bf16x2_t __attribute__((ext_vector_type(2)));
DEVINL unsigned pk2bf(float lo, float hi) { f32x2_t f = {lo, hi}; bf16x2_t b = __builtin_convertvector(f, bf16x2_t); return __builtin_bit_cast(unsigned, b); }
DEVINL u16 f2bf(float f) { return (u16)(pk2bf(f, f) & 0xFFFFu); }
DEVINL float bf2f(u16 h) { return __uint_as_float(((unsigned)h) << 16); }
DEVINL float wsum(float v) { for (int o = 32; o > 0; o >>= 1) v += __shfl_xor(v, o); return v; }
DEVINL float sigmoidf_(float x) { return __builtin_amdgcn_rcpf(1.f + __expf(-x)); }
DEVINL float siluf_(float x) { return x * __builtin_amdgcn_rcpf(1.f + __expf(-x)); }
DEVINL float tanhf_(float x) { return 1.f - 2.f * __builtin_amdgcn_rcpf(1.f + __expf(2.f * x)); }
DEVINL float softplusf_(float x) { return fmaxf(x, 0.f) + log1pf(__expf(-fabsf(x))); }
DEVINL int row_sel(int row) { return row < CTXROWS ? 2 : ((row - CTXROWS) >> 14); }
template <int CTRL, int RM>
DEVINL float dpp_f(float v) { return __int_as_float(__builtin_amdgcn_update_dpp(0, __float_as_int(v), CTRL, RM, 0xF, false)); }
DEVINL float wave_sum_dpp(float v) {
    v += dpp_f<0xB1, 0xF>(v);
    v += dpp_f<0x4E, 0xF>(v);
    v += dpp_f<0x141, 0xF>(v);
    v += dpp_f<0x140, 0xF>(v);
    v += dpp_f<0x142, 0xA>(v);
    v += dpp_f<0x143, 0xC>(v);
    return __int_as_float(__builtin_amdgcn_readlane(__float_as_int(v), 63));
}
DEVINL unsigned lds_addr(const void* p) { return (unsigned)(size_t)(const __attribute__((address_space(3))) char*)p; }
using u32x4 = __attribute__((ext_vector_type(4))) unsigned;
using u32x2 = __attribute__((ext_vector_type(2))) unsigned;
DEVINL void st_nt16(void* q, uint4 v) { __builtin_nontemporal_store(u32x4{v.x, v.y, v.z, v.w}, (u32x4*)q); }
DEVINL void st_nt8(void* q, uint2 v) { __builtin_nontemporal_store(u32x2{v.x, v.y}, (u32x2*)q); }
DEVINL float4 ld_nt16f(const float* q) { const f32x4 t = __builtin_nontemporal_load((const f32x4*)q); return make_float4(t[0], t[1], t[2], t[3]); }
template <int OFF> DEVINL u32x4 lds_rd128(unsigned a) { u32x4 v; asm volatile("ds_read_b128 %0, %1 offset:%2" : "=v"(v) : "v"(a), "n"(OFF)); return v; }
template <int OFF> DEVINL u32x2 lds_rd64(unsigned a) { u32x2 v; asm volatile("ds_read_b64 %0, %1 offset:%2" : "=v"(v) : "v"(a), "n"(OFF)); return v; }
DEVINL void glds4(const void* g, void* l) {
    __builtin_amdgcn_global_load_lds((const __attribute__((address_space(1))) void*)g, (__attribute__((address_space(3))) void*)l, 4, 0, 0);
}
DEVINL void glds16nt(const void* g, void* l) {
    __builtin_amdgcn_global_load_lds((const __attribute__((address_space(1))) void*)g, (__attribute__((address_space(3))) void*)l, 16, 0, 2);
}
DEVINL void glds16(const void* g, void* l) {
    __builtin_amdgcn_global_load_lds((const __attribute__((address_space(1))) void*)g, (__attribute__((address_space(3))) void*)l, 16, 0, 0);
}

#define XCD_WALK(total_, bid_v, nb_v) \
    const bool xw_8 = (((nb_v) & 7) == 0); \
    const int xw_per = xw_8 ? (((((total_) + 7) >> 3) + 7) & ~7) : (total_); \
    const int xw_base = xw_8 ? ((bid_v) & 7) * xw_per : 0; \
    const int xw_lo = xw_base + (xw_8 ? ((bid_v) >> 3) : (bid_v)); \
    const int xw_hi = min((int)(total_), xw_base + xw_per); \
    const int xw_st = xw_8 ? ((nb_v) >> 3) : (nb_v)

template <class RowA>
DEVINL void gemm128_acc(RowA rowA, const u16* __restrict__ Bt, int ldb, int K, char* smem, f32x4 (&acc)[4][4]) {
    const int tid = tid_(), lane = tid & 63, wid = tid >> 6, wr = wid >> 1, wc = wid & 1, fr = lane & 15, fq = lane >> 4;
#pragma unroll
    for (int m = 0; m < 4; ++m)
#pragma unroll
        for (int n = 0; n < 4; ++n) acc[m][n] = f32x4{0.f, 0.f, 0.f, 0.f};
    const int sc = ((tid & 7) ^ ((tid >> 3) & 7)) * 8;
    const u16* aS[4]; const u16* bS[4];
#pragma unroll
    for (int i = 0; i < 4; ++i) { const int r = (tid >> 3) + 32 * i; aS[i] = rowA(r) + sc; bS[i] = Bt + (size_t)r * ldb + sc; }
    const int nt = K >> 6;
    const unsigned pos0 = (unsigned)((fq ^ (fr & 7)) * 16);
    const unsigned adA0 = lds_addr(smem) + (unsigned)((wr * 64 + fr) * 128) + pos0, adA1 = adA0 ^ 64u;
    const unsigned adB0 = lds_addr(smem) + 16384u + (unsigned)((wc * 64 + fr) * 128) + pos0, adB1 = adB0 ^ 64u;
    __syncthreads();
#pragma unroll
    for (int s = 0; s < 2; ++s)
#pragma unroll
        for (int i = 0; i < 4; ++i) { glds16(aS[i] + s * 64, smem + s * 32768 + (tid + 256 * i) * 16); glds16(bS[i] + s * 64, smem + s * 32768 + 16384 + (tid + 256 * i) * 16); }
#define GEMM_MM(A_, B_, m_, n_) acc[m_][n_] = __builtin_amdgcn_mfma_f32_16x16x32_bf16(__builtin_bit_cast(bf16x8, A_), __builtin_bit_cast(bf16x8, B_), acc[m_][n_], 0, 0, 0)
#define GEMM_STEP(s, t) do { \
        if ((t) + 1 < nt) asm volatile("s_waitcnt vmcnt(8)" ::: "memory"); else asm volatile("s_waitcnt vmcnt(0)" ::: "memory"); \
        __builtin_amdgcn_s_barrier(); \
        u32x4 b0_, b1_, b2_, b3_, a0_, a1_, a2_, a3_, d0_, d1_, d2_, d3_, c0_, c1_, c2_, c3_; \
        asm volatile( \
            "ds_read_b128 %0, %17 offset:%20\n\t" \
            "ds_read_b128 %1, %17 offset:%20+2048\n\t" \
            "ds_read_b128 %2, %17 offset:%20+4096\n\t" \
            "ds_read_b128 %3, %17 offset:%20+6144\n\t" \
            "ds_read_b128 %4, %16 offset:%20\n\t" \
            "ds_read_b128 %5, %16 offset:%20+2048\n\t" \
            "ds_read_b128 %6, %16 offset:%20+4096\n\t" \
            "ds_read_b128 %7, %16 offset:%20+6144\n\t" \
            "ds_read_b128 %8, %19 offset:%20\n\t" \
            "ds_read_b128 %9, %19 offset:%20+2048\n\t" \
            "ds_read_b128 %10, %19 offset:%20+4096\n\t" \
            "ds_read_b128 %11, %19 offset:%20+6144\n\t" \
            "ds_read_b128 %12, %18 offset:%20\n\t" \
            "ds_read_b128 %13, %18 offset:%20+2048\n\t" \
            "ds_read_b128 %14, %18 offset:%20+4096\n\t" \
            "ds_read_b128 %15, %18 offset:%20+6144\n\t" \
            "s_waitcnt lgkmcnt(0)" \
            : "=&v"(b0_), "=&v"(b1_), "=&v"(b2_), "=&v"(b3_), "=&v"(a0_), "=&v"(a1_), "=&v"(a2_), "=&v"(a3_), \
              "=&v"(d0_), "=&v"(d1_), "=&v"(d2_), "=&v"(d3_), "=&v"(c0_), "=&v"(c1_), "=&v"(c2_), "=&v"(c3_) \
            : "v"(adA0), "v"(adB0), "v"(adA1), "v"(adB1), "n"((s) * 32768) : "memory"); \
        __builtin_amdgcn_s_barrier(); \
        if ((t) + 2 < nt) { \
            char* SA_ = smem + (s) * 32768; const int ko_ = ((t) + 2) * 64; \
            _Pragma("unroll") for (int i = 0; i < 4; ++i) { glds16(aS[i] + ko_, SA_ + (tid + 256 * i) * 16); glds16(bS[i] + ko_, SA_ + 16384 + (tid + 256 * i) * 16); } \
        } \
        GEMM_MM(a0_, b0_, 0, 0); GEMM_MM(a0_, b1_, 0, 1); GEMM_MM(a0_, b2_, 0, 2); GEMM_MM(a0_, b3_, 0, 3); \
        GEMM_MM(a1_, b0_, 1, 0); GEMM_MM(a1_, b1_, 1, 1); GEMM_MM(a1_, b2_, 1, 2); GEMM_MM(a1_, b3_, 1, 3); \
        GEMM_MM(a2_, b0_, 2, 0); GEMM_MM(a2_, b1_, 2, 1); GEMM_MM(a2_, b2_, 2, 2); GEMM_MM(a2_, b3_, 2, 3); \
        GEMM_MM(a3_, b0_, 3, 0); GEMM_MM(a3_, b1_, 3, 1); GEMM_MM(a3_, b2_, 3, 2); GEMM_MM(a3_, b3_, 3, 3); \
        GEMM_MM(c0_, d0_, 0, 0); GEMM_MM(c0_, d1_, 0, 1); GEMM_MM(c0_, d2_, 0, 2); GEMM_MM(c0_, d3_, 0, 3); \
        GEMM_MM(c1_, d0_, 1, 0); GEMM_MM(c1_, d1_, 1, 1); GEMM_MM(c1_, d2_, 1, 2); GEMM_MM(c1_, d3_, 1, 3); \
        GEMM_MM(c2_, d0_, 2, 0); GEMM_MM(c2_, d1_, 2, 1); GEMM_MM(c2_, d2_, 2, 2); GEMM_MM(c2_, d3_, 2, 3); \
        GEMM_MM(c3_, d0_, 3, 0); GEMM_MM(c3_, d1_, 3, 1); GEMM_MM(c3_, d2_, 3, 2); GEMM_MM(c3_, d3_, 3, 3); \
    } while (0)
#pragma unroll 1
    for (int t = 0; t < nt; t += 2) {
        GEMM_STEP(0, t); GEMM_STEP(1, t + 1);
    }
#undef GEMM_STEP
#undef GEMM_MM
}
template <class RowA, class Epi>
DEVINL void gemm128(RowA rowA, const u16* __restrict__ Bt, int ldb, int K, char* smem, Epi epi) {
    const int tid = tid_(), lane = tid & 63, wid = tid >> 6, wr = wid >> 1, wc = wid & 1, fr = lane & 15, fq = lane >> 4;
    f32x4 acc[4][4];
    gemm128_acc(rowA, Bt, ldb, K, smem, acc);
#pragma unroll
    for (int m = 0; m < 4; ++m)
#pragma unroll
        for (int n = 0; n < 4; ++n) epi(wr * 64 + m * 16 + fq * 4, wc * 64 + n * 16 + fr, acc[m][n]);
}

template <class Emit>
DEVINL void stage_tile_bf16(const f32x4 (&acc)[4][4], char* smem, Emit emit) {
    const int tid = tid_(), lane = tid & 63, wid = tid >> 6, wr = wid >> 1, wc = wid & 1, fr = lane & 15, fq = lane >> 4;
    u16* t = (u16*)smem;
    __syncthreads();
#pragma unroll
    for (int m = 0; m < 4; ++m)
#pragma unroll
        for (int n = 0; n < 4; ++n) {
            const int r0 = wr * 64 + m * 16 + fq * 4, c = wc * 64 + n * 16 + fr;
            const unsigned p01 = pk2bf(acc[m][n][0], acc[m][n][1]), p23 = pk2bf(acc[m][n][2], acc[m][n][3]);
            t[(r0 + 0) * 136 + c] = (u16)(p01 & 0xFFFFu); t[(r0 + 1) * 136 + c] = (u16)(p01 >> 16);
            t[(r0 + 2) * 136 + c] = (u16)(p23 & 0xFFFFu); t[(r0 + 3) * 136 + c] = (u16)(p23 >> 16);
        }
    __syncthreads();
#pragma unroll
    for (int i = 0; i < 8; ++i) {
        const int ci = tid + 256 * i, row = ci >> 4, c8 = (ci & 15) * 8;
        emit(row, c8, *(const uint4*)(t + row * 136 + c8));
    }
}

template <class Emit>
DEVINL void stage_tile_f32(const f32x4 (&acc)[4][4], char* smem, Emit emit) {
    const int tid = tid_(), lane = tid & 63, wid = tid >> 6, wr = wid >> 1, wc = wid & 1, fr = lane & 15, fq = lane >> 4;
    float* t = (float*)smem;
    __syncthreads();
#pragma unroll
    for (int m = 0; m < 4; ++m)
#pragma unroll
        for (int n = 0; n < 4; ++n) {
            const int r0 = wr * 64 + m * 16 + fq * 4, c = wc * 64 + n * 16 + fr;
#pragma unroll
            for (int j = 0; j < 4; ++j) t[(r0 + j) * 132 + c] = acc[m][n][j];
        }
    __syncthreads();
#pragma unroll 4
    for (int i = 0; i < 16; ++i) {
        const int ci = tid + 256 * i, row = ci >> 5, c4 = (ci & 31) * 4;
        emit(row, c4, *(const float4*)(t + row * 132 + c4));
    }
}

DEVINL void ph_prolog(const P& p, char* smem) {
    const int TIDX_ = tid_(); const int BIDX_ = bid_(); char* const WS_ = wsl_(p.ws); (void)TIDX_; (void)BIDX_; (void)WS_;
    const int tid = TIDX_;
    float* modv = (float*)(WS_ + OFF_MOD);
    float* sil = (float*)smem;
    float* red = sil + 3072;
    bool ready = false;
    for (int u = BIDX_; u < 384; u += gridDim.x) {
        if (!ready) {
            for (int i = tid; i < 3072; i += 256) { int v = i >> 10, k = i & 1023; float cv = v < 2 ? p.c[v * 1024 + k] : p.c_ctx[k]; sil[i] = cv / (1.f + expf(-cv)); }
            ready = true;
        }
        __syncthreads();
        const int l = u / 192, cg = u % 192;
        const float* W = p.w_mod + (size_t)l * 1024 * 6144 + cg * 32;
        const int c4 = (tid & 7) * 4, rg = tid >> 3;
        float a0[4] = {0, 0, 0, 0}, a1[4] = {0, 0, 0, 0}, a2[4] = {0, 0, 0, 0};
#pragma unroll 16
        for (int i = 0; i < 32; ++i) {
            const int k = rg + 32 * i;
            const float4 w = *(const float4*)(W + (size_t)k * 6144 + c4);
            const float s0 = sil[k], s1 = sil[1024 + k], s2 = sil[2048 + k];
            a0[0] += s0 * w.x; a0[1] += s0 * w.y; a0[2] += s0 * w.z; a0[3] += s0 * w.w;
            a1[0] += s1 * w.x; a1[1] += s1 * w.y; a1[2] += s1 * w.z; a1[3] += s1 * w.w;
            a2[0] += s2 * w.x; a2[1] += s2 * w.y; a2[2] += s2 * w.z; a2[3] += s2 * w.w;
        }
#pragma unroll
        for (int j = 0; j < 4; ++j) { red[(rg * 3 + 0) * 32 + c4 + j] = a0[j]; red[(rg * 3 + 1) * 32 + c4 + j] = a1[j]; red[(rg * 3 + 2) * 32 + c4 + j] = a2[j]; }
        __syncthreads();
        if (tid < 96) {
            const int v = tid >> 5, cc = tid & 31;
            float s = 0.f;
            for (int r = 0; r < 32; ++r) s += red[(r * 3 + v) * 32 + cc];
            const int col = cg * 32 + cc;
            modv[(l * 3 + v) * 6144 + col] = s + p.b_mod[l * 6144 + col];
        }
        __syncthreads();
    }
    float* rope = (float*)(WS_ + OFF_ROPE);
    for (int i = BIDX_ * 256 + tid; i < 320 * 16; i += gridDim.x * 256) {
        const int pos = (i < 4096) ? (i >> 4) : ((i - 4096) >> 4);
        const int f = i & 15;
        const float inv = powf(10000.0f, -(float)f / 16.0f);
        const float ang = (float)pos * inv;
        const double TWO_PI = 6.283185307179586476925;
        double a = (double)ang;
        a -= TWO_PI * rint(a / TWO_PI);
        const float cr = (float)cos(a), sr = (float)sin(a);
        if (i < 4096) { rope[i] = cr; rope[4096 + i] = sr; }
        else { rope[8192 + (i - 4096)] = cr; rope[8192 + 1024 + (i - 4096)] = sr; }
    }
    {
        u16* w2t = (u16*)(WS_ + OFF_LORA); u16* a2t = w2t + 2 * 2 * 256 * 32; u16* g2t = a2t + 2 * 2 * 256 * 32;
        for (int i = BIDX_ * 256 + tid; i < 2 * 2 * 256 * 32; i += gridDim.x * 256) {
            const int lz = i >> 13, c = (i >> 5) & 255, r = i & 31;
            w2t[i] = f2bf(p.rw_w2[((size_t)lz * 32 + r) * 256 + c]);
            a2t[i] = f2bf(p.rw_a2[((size_t)lz * 32 + r) * 256 + c]);
        }
        for (int i = BIDX_ * 256 + tid; i < 2 * 256 * 64; i += gridDim.x * 256) {
            const int l = i >> 14, c = (i >> 6) & 255, r = i & 63;
            g2t[i] = f2bf(p.rw_g2[((size_t)l * 64 + r) * 256 + c]);
        }
    }
    u16* wr = (u16*)(WS_ + OFF_WR);
    for (int i = BIDX_ * 256 + tid; i < 2 * 128 * 1024; i += gridDim.x * 256) {
        const int l = i >> 17, n = (i >> 10) & 127, k = i & 1023;
        float v = 0.f;
        if (n < 4) v = p.rgw[((size_t)l * 1024 + k) * 4 + n];
        else if (n < 36) v = p.rew[((size_t)l * 1024 + k) * 32 + (n - 4)];
        wr[i] = f2bf(v);
    }
}

DEVINL void conv_tile(const float* __restrict__ src, int N, int K, u16* __restrict__ dst, int k0, int n0, int mode, char* smem) {
    unsigned* t = (unsigned*)smem;
    const int tid = tid_();
    const int n4 = (tid & 15) * 4;
    const bool ok = n0 + n4 < N;
    float4 va[2], vb[2];
    __syncthreads();
#pragma unroll
    for (int i = 0; i < 2; ++i) {
        const int kp = i * 16 + (tid >> 4);
        const float* s0 = src + (size_t)(k0 + 2 * kp) * N + n0 + n4;
        va[i] = ok ? ld_nt16f(s0) : make_float4(0.f, 0.f, 0.f, 0.f);
        vb[i] = ok ? ld_nt16f(s0 + N) : make_float4(0.f, 0.f, 0.f, 0.f);
    }
#pragma unroll
    for (int i = 0; i < 2; ++i) {
        const int kp = i * 16 + (tid >> 4);
        t[(n4 + 0) * 33 + kp] = pk2bf(va[i].x, vb[i].x);
        t[(n4 + 1) * 33 + kp] = pk2bf(va[i].y, vb[i].y);
        t[(n4 + 2) * 33 + kp] = pk2bf(va[i].z, vb[i].z);
        t[(n4 + 3) * 33 + kp] = pk2bf(va[i].w, vb[i].w);
    }
    __syncthreads();
    {
        const int n = tid >> 2, w0 = (tid & 3) * 8;
        const int ng = n0 + n;
        int nd = ng;
        if (mode == 1) nd = 32 * (ng >> 4) + (ng & 15);
        else if (mode == 2) nd = 32 * (ng >> 4) + 16 + (ng & 15);
        uint4 o0, o1;
        o0.x = t[n * 33 + w0 + 0]; o0.y = t[n * 33 + w0 + 1]; o0.z = t[n * 33 + w0 + 2]; o0.w = t[n * 33 + w0 + 3];
        o1.x = t[n * 33 + w0 + 4]; o1.y = t[n * 33 + w0 + 5]; o1.z = t[n * 33 + w0 + 6]; o1.w = t[n * 33 + w0 + 7];
        u16* q = dst + (size_t)nd * K + k0 + w0 * 2;
        st_nt16(q, o0); st_nt16(q + 8, o1);
    }
}
DEVINL void ph_convw(const P& p, int l, char* smem, bool win_too = true) {
    const int TIDX_ = tid_(); const int BIDX_ = bid_(); char* const WS_ = wsl_(p.ws); (void)TIDX_; (void)BIDX_; (void)WS_;
    u16* win = (u16*)(WS_ + OFF_WIN); u16* wout = (u16*)(WS_ + OFF_WOUT);
    for (int u = (win_too ? 0 : 896) + BIDX_; u < 896 + 256; u += gridDim.x) {
        if (u < 896) conv_tile(p.w_in + (size_t)l * 1024 * INP, INP, 1024, win, (u / 56) * 64, (u % 56) * 64, 0, smem);
        else { const int v = u - 896; conv_tile(p.w_out + (size_t)l * 1024 * 1024, 1024, 1024, wout, (v / 16) * 64, (v % 16) * 64, 0, smem); }
    }
}
DEVINL void ph_convexp(const P& p, int l, char* smem, int nworkers) {
    const int TIDX_ = tid_(); const int BIDX_ = bid_(); char* const WS_ = wsl_(p.ws); (void)TIDX_; (void)BIDX_; (void)WS_;
    const int tid = TIDX_;
    u16* wgu = (u16*)(WS_ + OFF_WGU); u16* wdn = (u16*)(WS_ + OFF_WDN);
    unsigned* headw = (unsigned*)(WS_ + CTL_CNT) + l * 128 + (BIDX_ & 7) * 16;
    unsigned* nadone = (unsigned*)(WS_ + CTL_PROG) + l * 16;
    int* tkl = (int*)(smem + 16384);
    const int NXT = (l + 1 < NLAYER) ? 896 : 0;
    const int SHARD = (32 * 384 + NXT) / 8, NTK = SHARD / 2;
    const int tbase = (BIDX_ & 7) * SHARD;
    __syncthreads();
    if (tid == 0) {
        unsigned spins = 0;
        while (__hip_atomic_load(nadone, __ATOMIC_RELAXED, __HIP_MEMORY_SCOPE_AGENT) < (unsigned)nworkers) { __builtin_amdgcn_s_sleep(4); if (++spins > (1u << 22)) break; }
        tkl[0] = (int)__hip_atomic_fetch_add(headw, 1u, __ATOMIC_RELAXED, __HIP_MEMORY_SCOPE_AGENT);
    }
    __syncthreads();
    int tk = tkl[0];
    while (tk < NTK) {
        unsigned nxt = 0;
        if (tid == 0) nxt = __hip_atomic_fetch_add(headw, 1u, __ATOMIC_RELAXED, __HIP_MEMORY_SCOPE_AGENT);
#pragma unroll 1
        for (int k = 0; k < 2; ++k) {
            const int u = tbase + 2 * tk + k;
            if (u >= 32 * 384) { const int x = u - 32 * 384; conv_tile(p.w_in + (size_t)(l + 1) * 1024 * INP, INP, 1024, (u16*)(WS_ + OFF_WIN), (x / 56) * 64, (x % 56) * 64, 0, smem); continue; }
            const int e = u / 384, v = u % 384;
            const size_t le = (size_t)l * 32 + e;
            if (v < 128) conv_tile(p.egate + le * 1024 * 512, 512, 1024, wgu + (size_t)e * 1024 * 1024, (v / 8) * 64, (v % 8) * 64, 1, smem);
            else if (v < 256) { const int w = v - 128; conv_tile(p.eup + le * 1024 * 512, 512, 1024, wgu + (size_t)e * 1024 * 1024, (w / 8) * 64, (w % 8) * 64, 2, smem); }
            else { const int w = v - 256; conv_tile(p.edown + le * 512 * 1024, 1024, 512, wdn + (size_t)e * 1024 * 512, (w / 16) * 64, (w % 16) * 64, 0, smem); }
        }
        if (tid == 0) tkl[0] = (int)nxt;
        __syncthreads();
        tk = tkl[0];
    }
}

DEVINL void ph_xm0(const P& p) {
    const int TIDX_ = tid_(); const int BIDX_ = bid_(); char* const WS_ = wsl_(p.ws); (void)TIDX_; (void)BIDX_; (void)WS_;
    const float* modv = (const float*)(WS_ + OFF_MOD);
    u16* hm = (u16*)(WS_ + OFF_HM);
    constexpr int XR = 8;
    const size_t stride = (size_t)gridDim.x * 256, total = (size_t)T * 256;
#pragma unroll 1
    for (size_t i0 = (size_t)BIDX_ * 256 + TIDX_; i0 < total; i0 += XR * stride) {
        float4 v[XR]; int rowv[XR]; bool ok[XR];
        const int c4 = (int)(i0 & 255) * 4;
#pragma unroll
        for (int r = 0; r < XR; ++r) {
            const size_t i = i0 + r * stride;
            ok[r] = i < total;
            rowv[r] = ok[r] ? (int)(i >> 8) : (int)(i0 >> 8);
            const float* src = rowv[r] < CTXROWS ? p.ctx + (size_t)rowv[r] * 1024 : p.x + (size_t)(rowv[r] - CTXROWS) * 1024;
            { const f32x4 t4 = __builtin_nontemporal_load((const f32x4*)(src + c4)); v[r] = make_float4(t4[0], t4[1], t4[2], t4[3]); }
        }
#pragma unroll
        for (int r = 0; r < XR; ++r) {
            if (!ok[r]) continue;
            const float* mv = modv + row_sel(rowv[r]) * 6144;
            const float4 sh = *(const float4*)(mv + c4), sc = *(const float4*)(mv + 1024 + c4);
            uint2 o;
            o.x = (unsigned)f2bf(v[r].x * (1.f + sc.x) + sh.x) | ((unsigned)f2bf(v[r].y * (1.f + sc.y) + sh.y) << 16);
            o.y = (unsigned)f2bf(v[r].z * (1.f + sc.z) + sh.z) | ((unsigned)f2bf(v[r].w * (1.f + sc.w) + sh.w) << 16);
            *(uint2*)(hm + (size_t)rowv[r] * 1024 + c4) = o;
        }
    }
}

DEVINL void ph_inproj(const P& p, char* smem) {
    const int TIDX_ = tid_(); const int BIDX_ = bid_(); char* const WS_ = wsl_(p.ws); (void)TIDX_; (void)BIDX_; (void)WS_;
    const u16* hm = (const u16*)(WS_ + OFF_HM);
    const u16* win = (const u16*)(WS_ + OFF_WIN);
    u16* pqk = (u16*)(WS_ + OFF_PQK); u16* vtl = (u16*)(WS_ + OFF_VTL); u16* vtc = (u16*)(WS_ + OFF_VTC);
    u16* pb = (u16*)(WS_ + OFF_PB); u16* pc = (u16*)(WS_ + OFF_PC);
    XCD_WALK(260 * 28, BIDX_, (int)gridDim.x);
    for (int o = xw_lo; o < xw_hi; o += xw_st) {
        const int g = o / 224, w = o % 224;
        const int mt = g < 32 ? g * 8 + (w & 7) : 256 + (w & 3), nt = g < 32 ? (w >> 3) : (w >> 2);
        const u16* A = hm + (size_t)mt * 128 * 1024;
        f32x4 acc[4][4];
        gemm128_acc([&](int r) { return A + (size_t)r * 1024; }, win + (size_t)nt * 128 * 1024, 1024, 1024, smem, acc);
        if (nt >= 8 && nt < 12) {
            const int tid = tid_(), lane = tid & 63, wid = tid >> 6, wr = wid >> 1, wc = wid & 1, fr = lane & 15, fq = lane >> 4;
#pragma unroll
            for (int m = 0; m < 4; ++m)
#pragma unroll
                for (int n = 0; n < 4; ++n) {
                    const int R = mt * 128 + wr * 64 + m * 16 + fq * 4, N = nt * 128 + wc * 64 + n * 16 + fr;
                    const int hh = (N - 1024) >> 6, d = (N - 1024) & 63;
                    uint2 v; v.x = pk2bf(acc[m][n][0], acc[m][n][1]); v.y = pk2bf(acc[m][n][2], acc[m][n][3]);
                    if (R < CTXROWS) { const int b = R >> 8, t = R & 255; st_nt8(vtc + ((size_t)((b * 8 + hh) * 64 + d)) * 256 + t, v); }
                    else { const int R2 = R - CTXROWS, b = R2 >> 14, t = R2 & 16383; st_nt8(vtl + ((size_t)((b * 8 + hh) * 64 + d)) * 16384 + t, v); }
                }
        } else {
            stage_tile_bf16(acc, smem, [&](int row, int c8, uint4 v) {
                const int R = mt * 128 + row, N = nt * 128 + c8;
                if (N >= INP) return;
                if (N < 1024) st_nt16(pqk + (size_t)R * 1024 + N, v);
                else if (N < 2496) st_nt16(pb + (size_t)R * 960 + (N - 1536), v);
                else st_nt16(pc + (size_t)R * 1040 + (N - 2496), v);
            });
        }
    }
}

constexpr size_t RWREC = 12288;
constexpr size_t RW_A1 = 0, RW_A4 = 2048, RW_A3 = 4096, RW_MKA = 8192, RW_TT = 8704, RW_MY = 9216, RW_V = 10240;
constexpr size_t OFF_RWOP = OFF_X1;
constexpr int RW_CH0 = 528, RW_G0 = 132;
constexpr size_t OFF_RWWG = OFF_RWOP + (size_t)16 * RW_CH0 * RWREC;
constexpr size_t OFF_YRWB = OFF_RWWG + (size_t)16 * RW_G0 * 64 * 4;
constexpr size_t OFF_BONUS = OFF_YRWB + (size_t)T * 256 * 2;
static_assert(OFF_BONUS + (size_t)T * 4 * 4 <= OFF_HM, "rw operand store must fit the X1 region");

DEVINL float rw_mix(const u16* __restrict__ pb, const float* __restrict__ mup, const float* __restrict__ mun, int row, int t, int seqlen, int col) {
    const float cu = bf2f(pb[(size_t)row * 960 + col]);
    const float pr = t > 0 ? bf2f(pb[(size_t)(row - 1) * 960 + col]) : 0.f;
    const float nx = t + 1 < seqlen ? bf2f(pb[(size_t)(row + 1) * 960 + col]) : 0.f;
    return cu + mup[col] * (pr - cu) + mun[col] * (nx - cu);
}

DEVINL void rw_mix8(const u16* __restrict__ pb, const float* __restrict__ mup, const float* __restrict__ mun, int row, int t, int seqlen, int col0, float (&o)[8]) {
    const bool hp = t > 0, hn = t + 1 < seqlen;
    const u32x4 c = *(const u32x4*)(pb + (size_t)row * 960 + col0);
    u32x4 pv = *(const u32x4*)(pb + (size_t)(hp ? row - 1 : row) * 960 + col0);
    u32x4 nx = *(const u32x4*)(pb + (size_t)(hn ? row + 1 : row) * 960 + col0);
    const unsigned mpv = hp ? 0xFFFFFFFFu : 0u, mnx = hn ? 0xFFFFFFFFu : 0u;
    const f32x4 mp0 = *(const f32x4*)(mup + col0), mp1 = *(const f32x4*)(mup + col0 + 4), mn0 = *(const f32x4*)(mun + col0), mn1 = *(const f32x4*)(mun + col0 + 4);
#pragma unroll
    for (int i = 0; i < 4; ++i) {
        const unsigned cw = c[i], pw = pv[i] & mpv, nw = nx[i] & mnx;
        const float c0 = __uint_as_float(cw << 16), c1 = __uint_as_float(cw & 0xFFFF0000u);
        const float p0 = __uint_as_float(pw << 16), p1 = __uint_as_float(pw & 0xFFFF0000u);
        const float n0 = __uint_as_float(nw << 16), n1 = __uint_as_float(nw & 0xFFFF0000u);
        const float ma = (i < 2) ? mp0[2 * i] : mp1[2 * i - 4], mb = (i < 2) ? mp0[2 * i + 1] : mp1[2 * i - 3];
        const float na = (i < 2) ? mn0[2 * i] : mn1[2 * i - 4], nb = (i < 2) ? mn0[2 * i + 1] : mn1[2 * i - 3];
        o[2 * i] = c0 + ma * (p0 - c0) + na * (n0 - c0);
        o[2 * i + 1] = c1 + mb * (p1 - c1) + nb * (n1 - c1);
    }
}
DEVINL void rw_mix8_ld(const u16* __restrict__ pb, int row, int t, int seqlen, int col0, u32x4& c, u32x4& pv, u32x4& nx) {
    const bool hp = t > 0, hn = t + 1 < seqlen;
    c = *(const u32x4*)(pb + (size_t)row * 960 + col0);
    pv = *(const u32x4*)(pb + (size_t)(hp ? row - 1 : row) * 960 + col0);
    nx = *(const u32x4*)(pb + (size_t)(hn ? row + 1 : row) * 960 + col0);
}
DEVINL void rw_mix8_fin(const float* __restrict__ mup, const float* __restrict__ mun, int t, int seqlen, int col0, const u32x4& c, const u32x4& pv, const u32x4& nx, float (&o)[8]) {
    const bool hp = t > 0, hn = t + 1 < seqlen;
    const unsigned mpv = hp ? 0xFFFFFFFFu : 0u, mnx = hn ? 0xFFFFFFFFu : 0u;
    const f32x4 mp0 = *(const f32x4*)(mup + col0), mp1 = *(const f32x4*)(mup + col0 + 4), mn0 = *(const f32x4*)(mun + col0), mn1 = *(const f32x4*)(mun + col0 + 4);
#pragma unroll
    for (int i = 0; i < 4; ++i) {
        const unsigned cw = c[i], pw = pv[i] & mpv, nw = nx[i] & mnx;
        const float c0 = __uint_as_float(cw << 16), c1 = __uint_as_float(cw & 0xFFFF0000u);
        const float p0 = __uint_as_float(pw << 16), p1 = __uint_as_float(pw & 0xFFFF0000u);
        const float n0 = __uint_as_float(nw << 16), n1 = __uint_as_float(nw & 0xFFFF0000u);
        const float ma = (i < 2) ? mp0[2 * i] : mp1[2 * i - 4], mb = (i < 2) ? mp0[2 * i + 1] : mp1[2 * i - 3];
        const float na = (i < 2) ? mn0[2 * i] : mn1[2 * i - 4], nb = (i < 2) ? mn0[2 * i + 1] : mn1[2 * i - 3];
        o[2 * i] = c0 + ma * (p0 - c0) + na * (n0 - c0);
        o[2 * i + 1] = c1 + mb * (p1 - c1) + nb * (n1 - c1);
    }
}
DEVINL uint4 pack8bf(const float (&v)[8]) { return make_uint4(pk2bf(v[0], v[1]), pk2bf(v[2], v[3]), pk2bf(v[4], v[5]), pk2bf(v[6], v[7])); }

DEVINL void ph_rwprep(const P& p, int l, int half, char* smem, int bid, int nb) {
    const int TIDX_ = tid_(); const int BIDX_ = bid_(); char* const WS_ = wsl_(p.ws);
    const int tid = TIDX_, lane = tid & 63, w = tid >> 6, fr = lane & 15, fq = lane >> 4;
    const u16* pb = (const u16*)(WS_ + OFF_PB);
    char* rwop = WS_ + OFF_RWOP;
    float* rwwg = (float*)(WS_ + OFF_RWWG);
    float* bonus = (float*)(WS_ + OFF_BONUS);
    u16* gate = (u16*)(WS_ + OFF_GATE);
    const float* mup = p.mu_prev + l * 960; const float* mun = p.mu_next + l * 960;
    u16* lwdh = (u16*)smem;
    u16* ladh = lwdh + 2048;
    u16* abuf = ladh + 2048;
    float* Lb = (float*)(smem + 16384);
    u16* SV = (u16*)(smem + 32768);
    float* tot = (float*)(smem + 32768);
    const u16* w2t = (const u16*)(WS_ + OFF_LORA);
    const u16* a2t = w2t + 2 * 2 * 256 * 32;
    const u16* g2t = a2t + 2 * 2 * 256 * 32;
    RWTP(99);
    const int ng = half == 0 ? RW_G0 : 260 - RW_G0;
    for (int uh = bid; uh < 16 * ng; uh += nb) {
        const int h = uh & 3, rest = uh >> 2;
        const int d = rest / (2 * ng), b = (rest % (2 * ng)) / ng, gl = rest % ng;
        const int z = d;
        const int gscan = half * RW_G0 + gl;
        int gi, row0, seqlen;
        if (gscan < 4) { gi = d ? 3 - gscan : gscan; row0 = b * 256 + gi * 64; seqlen = 256; }
        else { gi = d ? 255 - (gscan - 4) : gscan - 4; row0 = CTXROWS + b * LAT + gi * 64; seqlen = LAT; }
        const int t0 = gi * 64;
        __syncthreads();
        RWTP(30);
        {
            const int j = tid >> 2, cq = tid & 3;
            float v[8];
            u32x4 sc0[2], sp0[2], sn0[2];
            rw_mix8_ld(pb, row0 + j, t0 + j, seqlen, 768 + z * 32 + 8 * cq, sc0[0], sp0[0], sn0[0]);
            rw_mix8_ld(pb, row0 + j, t0 + j, seqlen, 832 + z * 32 + 8 * cq, sc0[1], sp0[1], sn0[1]);
            rw_mix8_fin(mup, mun, t0 + j, seqlen, 768 + z * 32 + 8 * cq, sc0[0], sp0[0], sn0[0], v);
#pragma unroll
            for (int i = 0; i < 8; ++i) v[i] = tanhf_(v[i]);
            *(uint4*)(lwdh + j * 32 + 8 * cq) = pack8bf(v);
            rw_mix8_fin(mup, mun, t0 + j, seqlen, 832 + z * 32 + 8 * cq, sc0[1], sp0[1], sn0[1], v);
            *(uint4*)(ladh + j * 32 + 8 * cq) = pack8bf(v);
            if (d == 0) {
                u16* lgd0 = (u16*)Lb;
                rw_mix8_ld(pb, row0 + j, t0 + j, seqlen, 896 + 16 * cq, sc0[0], sp0[0], sn0[0]);
                rw_mix8_ld(pb, row0 + j, t0 + j, seqlen, 896 + 16 * cq + 8, sc0[1], sp0[1], sn0[1]);
#pragma unroll
                for (int hh = 0; hh < 2; ++hh) {
                    rw_mix8_fin(mup, mun, t0 + j, seqlen, 896 + 16 * cq + 8 * hh, sc0[hh], sp0[hh], sn0[hh], v);
#pragma unroll
                    for (int i = 0; i < 8; ++i) v[i] = sigmoidf_(v[i]);
                    *(uint4*)(lgd0 + j * 64 + 16 * cq + 8 * hh) = pack8bf(v);
                }
            }
        }
        if (d == 0) {
            u16* lgd = (u16*)Lb;
            __syncthreads();
            const bf16x8 x0 = *(const bf16x8*)(lgd + (16 * w + fr) * 64 + 8 * fq), x1 = *(const bf16x8*)(lgd + (16 * w + fr) * 64 + 32 + 8 * fq);
#pragma unroll
            for (int nt = 0; nt < 4; ++nt) {
                const u16* bp = g2t + ((size_t)l * 256 + 64 * h + 16 * nt + fr) * 64 + 8 * fq;
                const bf16x8 b0 = *(const bf16x8*)bp, b1 = *(const bf16x8*)(bp + 32);
                f32x4 acc = f32x4{0.f, 0.f, 0.f, 0.f};
                acc = __builtin_amdgcn_mfma_f32_16x16x32_bf16(x0, b0, acc, 0, 0, 0);
                acc = __builtin_amdgcn_mfma_f32_16x16x32_bf16(x1, b1, acc, 0, 0, 0);
#pragma unroll
                for (int r = 0; r < 4; ++r) ((u16*)SV)[(16 * w + 4 * fq + r) * 64 + 16 * nt + fr] = f2bf(acc[r]);
            }
        }
        {
            const int bh = b * 4 + h;
            const int ch = h * 64 + lane;
            __syncthreads();
            RWTP(31);
            if (d == 0) {
                const int gj = tid >> 2, gc = (tid & 3) * 16;
                const uint4 g0 = *(const uint4*)((const u16*)SV + gj * 64 + gc), g1 = *(const uint4*)((const u16*)SV + gj * 64 + gc + 8);
                u16* gd = gate + (size_t)(row0 + gj) * 256 + 64 * h + gc;
                *(uint4*)gd = g0; *(uint4*)(gd + 8) = g1;
            }
            {
                const bf16x8 xw = *(const bf16x8*)(lwdh + (16 * w + fr) * 32 + 8 * fq);
                const bf16x8 xa = *(const bf16x8*)(ladh + (16 * w + fr) * 32 + 8 * fq);
                bf16x8 bwv[4], bav[4]; float w0v[4], a0v[4];
#pragma unroll
                for (int kt = 0; kt < 4; ++kt) {
                    const int key = 16 * kt + fr;
                    const size_t wrow = ((size_t)(l * 2 + z) * 256 + h * 64 + key) * 32 + 8 * fq;
                    bwv[kt] = *(const bf16x8*)(w2t + wrow); bav[kt] = *(const bf16x8*)(a2t + wrow);
                    w0v[kt] = p.rw_w0[(l * 2 + z) * 256 + h * 64 + key]; a0v[kt] = p.rw_a0[(l * 2 + z) * 256 + h * 64 + key];
                }
#pragma unroll
                for (int kt = 0; kt < 4; ++kt) {
                    const int key = 16 * kt + fr;
                    const bf16x8 bw = bwv[kt], ba = bav[kt];
                    f32x4 ae = f32x4{0.f, 0.f, 0.f, 0.f}, aa = f32x4{0.f, 0.f, 0.f, 0.f};
                    ae = __builtin_amdgcn_mfma_f32_16x16x32_bf16(xw, bw, ae, 0, 0, 0);
                    aa = __builtin_amdgcn_mfma_f32_16x16x32_bf16(xa, ba, aa, 0, 0, 0);
                    const float w0 = w0v[kt], a0 = a0v[kt];
#pragma unroll
                    for (int r = 0; r < 4; ++r) {
                        const int tok = 16 * w + 4 * fq + r;
                        const int s = d ? 63 - tok : tok;
                        Lb[s * 64 + key] = 0.60653065971263342f * sigmoidf_(ae[r] + w0);
                        abuf[tok * 64 + key] = f2bf(sigmoidf_(aa[r] + a0));
                    }
                }
            }
            __syncthreads();
            RWTP(32);
            {
                float pre[16]; float run = 0.f;
#pragma unroll
                for (int i = 0; i < 16; ++i) { run += Lb[(16 * w + i) * 64 + lane]; pre[i] = run; }
                tot[w * 64 + lane] = run;
                __syncthreads();
                float offs = 0.f;
#pragma unroll
                for (int ww = 0; ww < 3; ++ww) offs += (ww < w) ? tot[ww * 64 + lane] : 0.f;
#pragma unroll
                for (int i = 0; i < 16; ++i) Lb[(16 * w + i) * 64 + lane] = -(offs + pre[i]);
            }
            __syncthreads();
            RWTP(33);
            {
                const int j = tid >> 2, kq = tid & 3, row = row0 + j, tt = t0 + j;
                const int c0 = h * 64 + 16 * kq;
                float kr[16];
                u32x4 qc[6], qp[6], qn[6];
#pragma unroll
                for (int i = 0; i < 2; ++i) {
                    rw_mix8_ld(pb, row, tt, seqlen, 256 + c0 + 8 * i, qc[i], qp[i], qn[i]);
                    rw_mix8_ld(pb, row, tt, seqlen, c0 + 8 * i, qc[2 + i], qp[2 + i], qn[2 + i]);
                    rw_mix8_ld(pb, row, tt, seqlen, 512 + c0 + 8 * i, qc[4 + i], qp[4 + i], qn[4 + i]);
                }
                { float t8[8];
                  rw_mix8_fin(mup, mun, tt, seqlen, 256 + c0, qc[0], qp[0], qn[0], t8);
#pragma unroll
                  for (int i = 0; i < 8; ++i) kr[i] = t8[i];
                  rw_mix8_fin(mup, mun, tt, seqlen, 256 + c0 + 8, qc[1], qp[1], qn[1], t8);
#pragma unroll
                  for (int i = 0; i < 8; ++i) kr[8 + i] = t8[i]; }
                float ss = 0.f;
#pragma unroll
                for (int i = 0; i < 16; ++i) { const float kv = kr[i] * p.rw_kk[l * 256 + c0 + i]; ss += kv * kv; }
                ss += __shfl_xor(ss, 1); ss += __shfl_xor(ss, 2);
                const float inorm = 1.f / fmaxf(sqrtf(ss), 1e-12f);
                const int sidx = d ? 63 - j : j;
                const int cch = sidx >> 4, ts = sidx & 15;
                u16* sv = SV + (size_t)(cch * 4) * 1024 + ts * 64 + 16 * kq;
                float bs = 0.f;
#pragma unroll
                for (int hh = 0; hh < 2; ++hh) {
                    const int cb = c0 + 8 * hh;
                    float rr[8], av[8], oa[8], orr[8], ob[8], ok[8];
                    rw_mix8_fin(mup, mun, tt, seqlen, cb, qc[2 + hh], qp[2 + hh], qn[2 + hh], rr);
                    { const uint4 a0 = *(const uint4*)(abuf + j * 64 + 16 * kq + 8 * hh);
                      const unsigned aw[4] = {a0.x, a0.y, a0.z, a0.w};
#pragma unroll
                      for (int i = 0; i < 4; ++i) { av[2 * i] = __uint_as_float(aw[i] << 16); av[2 * i + 1] = __uint_as_float(aw[i] & 0xFFFF0000u); } }
#pragma unroll
                    for (int i4 = 0; i4 < 2; ++i4) {
                        const float4 Lt4 = *(const float4*)(Lb + sidx * 64 + 16 * kq + 8 * hh + 4 * i4);
                        const float4 Lp4 = sidx > 0 ? *(const float4*)(Lb + (sidx - 1) * 64 + 16 * kq + 8 * hh + 4 * i4) : make_float4(0.f, 0.f, 0.f, 0.f);
                        const float Lt[4] = {Lt4.x, Lt4.y, Lt4.z, Lt4.w}, Lp[4] = {Lp4.x, Lp4.y, Lp4.z, Lp4.w};
#pragma unroll
                        for (int ii = 0; ii < 4; ++ii) {
                            const int i = 4 * i4 + ii;
                            const float kraw = hh ? kr[8 + i] : kr[i];
                            const float kkn = kraw * p.rw_kk[l * 256 + cb + i] * inorm, a = av[i];
                            const float et = __expf(Lt[ii]), einv = __builtin_amdgcn_rcpf(et);
                            oa[i] = -kkn * __expf(Lp[ii]);
                            orr[i] = rr[i] * et;
                            ob[i] = kkn * a * einv;
                            ok[i] = kraw * (1.f + (a - 1.f) * p.rw_ka[l * 256 + cb + i]) * einv;
                            bs += rr[i] * kraw * p.rw_rk[l * 256 + cb + i];
                            if (sidx == 63) rwwg[((size_t)(d * 8 + bh) * RW_G0 + gl) * 64 + 16 * kq + 8 * hh + i] = et;
                        }
                    }
                    *(uint4*)(sv + 8 * hh) = pack8bf(oa);
                    *(uint4*)(sv + 1024 + 8 * hh) = pack8bf(orr);
                    *(uint4*)(sv + 2048 + 8 * hh) = pack8bf(ob);
                    *(uint4*)(sv + 3072 + 8 * hh) = pack8bf(ok);
                    rw_mix8_fin(mup, mun, tt, seqlen, 512 + cb, qc[4 + hh], qp[4 + hh], qn[4 + hh], rr);
                    *(uint4*)(abuf + j * 64 + 16 * kq + 8 * hh) = pack8bf(rr);
                }
                if (d == 0) { bs += __shfl_xor(bs, 1); bs += __shfl_xor(bs, 2); if (kq == 0) bonus[(size_t)row * 4 + h] = bs; }
            }
            __syncthreads();
            RWTP(34);
            {
                char* rec = rwop + ((size_t)(d * 8 + bh) * RW_CH0 + (size_t)gl * 4 + w) * RWREC;
                const u16* Av = SV + (size_t)(w * 4) * 1024; const u16* Rv = Av + 1024; const u16* Bv = Av + 2048; const u16* Kv = Av + 3072;
                const unsigned trA = lds_addr(Av) + (unsigned)(((4 * fq + (fr >> 2)) * 64 + 4 * (fr & 3)) * 2);
                const unsigned trV = lds_addr(abuf) + (unsigned)((((d ? 60 - 16 * w - 4 * fq : 16 * w + 4 * fq) + (fr >> 2)) * 64 + 4 * (fr & 3)) * 2);
                bf16x8 fa[2], frr[2], fb[2], fk[2];
#pragma unroll
                for (int ks = 0; ks < 2; ++ks) {
                    fa[ks] = *(const bf16x8*)(Av + fr * 64 + ks * 32 + fq * 8);
                    frr[ks] = *(const bf16x8*)(Rv + fr * 64 + ks * 32 + fq * 8);
                    fb[ks] = *(const bf16x8*)(Bv + fr * 64 + ks * 32 + fq * 8);
                    fk[ks] = *(const bf16x8*)(Kv + fr * 64 + ks * 32 + fq * 8);
                }
                f32x4 mka = f32x4{0.f, 0.f, 0.f, 0.f}, mba = mka, mkr = mka, mbr = mka;
#pragma unroll
                for (int ks = 0; ks < 2; ++ks) {
                    mka = __builtin_amdgcn_mfma_f32_16x16x32_bf16(fa[ks], fk[ks], mka, 0, 0, 0);
                    mba = __builtin_amdgcn_mfma_f32_16x16x32_bf16(fa[ks], fb[ks], mba, 0, 0, 0);
                    mkr = __builtin_amdgcn_mfma_f32_16x16x32_bf16(frr[ks], fk[ks], mkr, 0, 0, 0);
                    mbr = __builtin_amdgcn_mfma_f32_16x16x32_bf16(frr[ks], fb[ks], mbr, 0, 0, 0);
                }
                float* Ns = Lb + w * 256;
                float* Ts = Lb + 1024 + w * 256;
                u16* rmka = (u16*)(rec + RW_MKA); u16* rmy = (u16*)(rec + RW_MY);
                const int i_ = fr;
#pragma unroll
                for (int r = 0; r < 4; ++r) {
                    const int t_ = 4 * fq + r;
                    const int lp = (i_ >> 2) * 16 + t_;
                    mka[r] = i_ < t_ ? mka[r] : 0.f;
                    rmy[lp * 8 + (i_ & 3)] = f2bf(i_ <= t_ ? mbr[r] : 0.f);
                    rmy[lp * 8 + 4 + (i_ & 3)] = f2bf(i_ <= t_ ? mkr[r] : 0.f);
                    Ns[t_ * 16 + i_] = i_ < t_ ? mba[r] : 0.f;
                }
                {
                    const int rho = lane >> 2, part = lane & 3;
                    float Tp0 = 0.f, Tp1 = 0.f, Tp2 = 0.f, Tp3 = 0.f;
#pragma unroll 1
                    for (int t_ = 0; t_ < 16; ++t_) {
                        const float4 nv = *(const float4*)(Ns + t_ * 16 + 4 * part);
                        float acc = Tp0 * nv.x + Tp1 * nv.y + Tp2 * nv.z + Tp3 * nv.w;
                        acc += dpp_f<0xB1, 0xF>(acc);
                        acc += dpp_f<0x4E, 0xF>(acc);
                        acc += (rho == t_) ? 1.f : 0.f;
                        const bool mine = part == (t_ >> 2);
                        const int k_ = t_ & 3;
                        Tp0 = (mine && k_ == 0) ? acc : Tp0; Tp1 = (mine && k_ == 1) ? acc : Tp1;
                        Tp2 = (mine && k_ == 2) ? acc : Tp2; Tp3 = (mine && k_ == 3) ? acc : Tp3;
                        if (part == 0) Ts[rho * 16 + t_] = acc;
                    }
                }
                bf16x8 TTf;
                {
                    const float t0v = Ts[(4 * fq + 0) * 16 + fr], t1v = Ts[(4 * fq + 1) * 16 + fr], t2v = Ts[(4 * fq + 2) * 16 + fr], t3v = Ts[(4 * fq + 3) * 16 + fr];
                    union { u32x4 u; bf16x8 f; } x; x.u = u32x4{pk2bf(t0v, t1v), pk2bf(t2v, t3v), 0u, 0u}; TTf = x.f;
                }
                {
                    union { u32x4 u; bf16x8 f; } mb; mb.u = u32x4{pk2bf(mka[0], mka[1]), pk2bf(mka[2], mka[3]), 0u, 0u};
                    f32x4 mk2 = f32x4{0.f, 0.f, 0.f, 0.f};
                    mk2 = __builtin_amdgcn_mfma_f32_16x16x32_bf16(TTf, mb.f, mk2, 0, 0, 0);
#pragma unroll
                    for (int r = 0; r < 4; ++r) { const int t_ = 4 * fq + r; rmka[((i_ >> 2) * 16 + t_) * 4 + (i_ & 3)] = f2bf(mk2[r]); }
                }
                {
                    f32x4 ap[4];
                    u32x2 agr0, agr1, agr2, agr3;
                    asm volatile("ds_read_b64_tr_b16 %0, %4\n\tds_read_b64_tr_b16 %1, %4 offset:32\n\tds_read_b64_tr_b16 %2, %4 offset:64\n\tds_read_b64_tr_b16 %3, %4 offset:96\n\ts_waitcnt lgkmcnt(0)"
                                 : "=&v"(agr0), "=&v"(agr1), "=&v"(agr2), "=&v"(agr3) : "v"(trA) : "memory");
                    const u32x2 agr[4] = {agr0, agr1, agr2, agr3};
#pragma unroll
                    for (int m = 0; m < 4; ++m) {
                        union { u32x4 u; bf16x8 f; } ag;
                        ag.u = u32x4{agr[m].x, agr[m].y, 0u, 0u};
                        ap[m] = f32x4{0.f, 0.f, 0.f, 0.f};
                        ap[m] = __builtin_amdgcn_mfma_f32_16x16x32_bf16(ag.f, TTf, ap[m], 0, 0, 0);
                    }
#pragma unroll
                    for (int ks = 0; ks < 2; ++ks) {
                        uint4 o;
                        o.x = pk2bf(ap[2 * ks][0], ap[2 * ks][1]); o.y = pk2bf(ap[2 * ks][2], ap[2 * ks][3]);
                        o.z = pk2bf(ap[2 * ks + 1][0], ap[2 * ks + 1][1]); o.w = pk2bf(ap[2 * ks + 1][2], ap[2 * ks + 1][3]);
                        *(uint4*)(rec + RW_A1 + (ks * 64 + lane) * 16) = o;
                    }
                }
#pragma unroll
                for (int ks = 0; ks < 2; ++ks) {
                    uint4 o;
                    const uint2 lo2 = *(const uint2*)(Rv + fr * 64 + 32 * ks + 4 * fq), hi2 = *(const uint2*)(Rv + fr * 64 + 32 * ks + 16 + 4 * fq);
                    o.x = lo2.x; o.y = lo2.y; o.z = hi2.x; o.w = hi2.y;
                    *(uint4*)(rec + RW_A4 + (ks * 64 + lane) * 16) = o;
                }
                {
                    u32x2 b0, b1, b2, b3, k0, k1, k2, k3;
                    asm volatile("ds_read_b64_tr_b16 %0, %8 offset:4096\n\tds_read_b64_tr_b16 %1, %8 offset:4096+32\n\tds_read_b64_tr_b16 %2, %8 offset:4096+64\n\tds_read_b64_tr_b16 %3, %8 offset:4096+96\n\t"
                                 "ds_read_b64_tr_b16 %4, %8 offset:6144\n\tds_read_b64_tr_b16 %5, %8 offset:6144+32\n\tds_read_b64_tr_b16 %6, %8 offset:6144+64\n\tds_read_b64_tr_b16 %7, %8 offset:6144+96\n\ts_waitcnt lgkmcnt(0)"
                                 : "=&v"(b0), "=&v"(b1), "=&v"(b2), "=&v"(b3), "=&v"(k0), "=&v"(k1), "=&v"(k2), "=&v"(k3) : "v"(trA) : "memory");
                    *(uint4*)(rec + RW_A3 + (0 * 64 + lane) * 16) = make_uint4(b0.x, b0.y, k0.x, k0.y);
                    *(uint4*)(rec + RW_A3 + (1 * 64 + lane) * 16) = make_uint4(b1.x, b1.y, k1.x, k1.y);
                    *(uint4*)(rec + RW_A3 + (2 * 64 + lane) * 16) = make_uint4(b2.x, b2.y, k2.x, k2.y);
                    *(uint4*)(rec + RW_A3 + (3 * 64 + lane) * 16) = make_uint4(b3.x, b3.y, k3.x, k3.y);
                }
                {
                    u32x2 v0, v1, v2, v3;
                    asm volatile("ds_read_b64_tr_b16 %0, %4\n\tds_read_b64_tr_b16 %1, %4 offset:32\n\tds_read_b64_tr_b16 %2, %4 offset:64\n\tds_read_b64_tr_b16 %3, %4 offset:96\n\ts_waitcnt lgkmcnt(0)"
                                 : "=&v"(v0), "=&v"(v1), "=&v"(v2), "=&v"(v3) : "v"(trV) : "memory");
                    const u32x2 vv[4] = {v0, v1, v2, v3};
#pragma unroll
                    for (int q = 0; q < 4; ++q) {
                        uint2 o;
                        if (d == 0) { o.x = vv[q].x; o.y = vv[q].y; }
                        else { o.x = (vv[q].y >> 16) | (vv[q].y << 16); o.y = (vv[q].x >> 16) | (vv[q].x << 16); }
                        *(uint2*)(rec + RW_V + (q * 64 + lane) * 8) = o;
                    }
                }
            }
        }
        RWTP(35);
    }
}

constexpr int RWSLOT = 12544;
DEVINL void ph_rwscan(const P& p, int l, int half, int bid, int nb, char* smem) {
    const int TIDX_ = tid_(); char* const WS_ = wsl_(p.ws);
    const int tid = TIDX_, lane = tid & 63, q = tid >> 6, fr = lane & 15, fq = lane >> 4;
    const char* rwop = WS_ + OFF_RWOP;
    const float* rwwg = (const float*)(WS_ + OFF_RWWG);
    u16* yf = (u16*)(WS_ + OFF_Y);
    u16* yb = (u16*)(WS_ + OFF_YRWB);
    (void)l;
    float* zst = (float*)(WS_ + OFF_ZST);
    for (int dbh = bid; dbh < 16; dbh += nb) {
        const int d = dbh >> 3, bh = dbh & 7, b = bh >> 2, h = bh & 3;
        f32x4 z[4];
        float* zp = zst + ((size_t)(dbh * 4 + q) * 64 + lane) * 16;
#pragma unroll
        for (int m = 0; m < 4; ++m) {
            if (half == 0) z[m] = f32x4{0.f, 0.f, 0.f, 0.f};
            else { const float4 t4 = *(const float4*)(zp + 4 * m); z[m] = f32x4{t4.x, t4.y, t4.z, t4.w}; }
        }
        const int nch = half == 0 ? RW_CH0 : 1040 - RW_CH0, ngr = nch >> 2;
        const int cbase = half * RW_CH0;
        const char* rec0 = rwop + (size_t)dbh * RW_CH0 * RWREC;
        const float* wg0 = rwwg + (size_t)dbh * RW_G0 * 64;
        constexpr int RD = 6;
        u32x4 rb[RD][3]; float rwgA = 0.f, rwgB = 0.f;
        const __amdgpu_buffer_rsrc_t rsrc = __builtin_amdgcn_make_buffer_rsrc((void*)rec0, 0, 0x7FFFFFFF, 0x00020000);
        auto ldrec = [&](int c, auto I) {
            constexpr int i = decltype(I)::value;
            const int cc = c < nch ? c : nch - 1;
#pragma unroll
            for (int k = 0; k < 3; ++k) rb[i][k] = __builtin_amdgcn_raw_buffer_load_b128(rsrc, (tid + 256 * k) * 16, cc * RWREC, 0);
        };
        auto strec = [&](auto I, int slotidx) {
            constexpr int i = decltype(I)::value;
            char* slot = smem + slotidx * RWSLOT;
#pragma unroll
            for (int k = 0; k < 3; ++k) *(u32x4*)(slot + (tid + 256 * k) * 16) = rb[i][k];
        };
        auto asfrag = [](uint4 v) { union { uint4 u; bf16x8 f; } x; x.u = v; return x.f; };
        auto pack2 = [](float lo, float hi) { return pk2bf(lo, hi); };
        const unsigned b128 = lds_addr(smem) + lane * 16, b64 = lds_addr(smem) + lane * 8, bv = lds_addr(smem) + (q * 64 + lane) * 8, bg = lds_addr(smem) + 16 * fq;
        __syncthreads();
        __builtin_amdgcn_s_setprio(3);
#define IC(n) std::integral_constant<int, n>{}
        auto ybase = [&](int cg) -> u16* {
            const bool isctx = cg < 16;
            const int cc = isctx ? cg : cg - 16;
            const int n = isctx ? LCTX : LAT;
            const int rowbase = isctx ? b * LCTX : CTXROWS + b * LAT;
            const int ts = (tid >> 3) & 15, c8 = (tid & 7) * 8;
            const int sidx = cc * 16 + ts;
            const int t = d ? n - 1 - sidx : sidx;
            return d == 0 ? yf + (size_t)(rowbase + t) * 1024 + 512 + h * 64 + c8 : yb + (size_t)(rowbase + t) * 256 + h * 64 + c8;
        };
        const int fpair = tid >> 7;
        u16* ydst = ybase(cbase + fpair);
        const long ystep2 = d == 0 ? 32L * 1024 : -32L * 256;
        auto flush_y = [&](int cprev, int par) {
            if ((cprev & 1) == fpair) {
                const u32x4 v = *(const u32x4*)(smem + 4 * RWSLOT + par * 2048 + (((tid >> 3) & 15) * 64 + (tid & 7) * 8) * 2);
                *(u32x4*)ydst = v;
                const int cg = cbase + cprev;
                if (cg < 16 && cg + 2 >= 16) ydst = ybase(cg + 2); else ydst += ystep2;
            }
        };
        u32x4 f4[2][2]; u32x2 f2[2][2]; u32x4 fl[7];
#define RD_ISSUE(par, SBN, SBC) asm volatile( \
                "ds_read_b128 %0, %11 offset:%15+4096\n\t" \
                "ds_read_b128 %1, %11 offset:%15+5120\n\t" \
                "ds_read_b128 %2, %11 offset:%15+6144\n\t" \
                "ds_read_b128 %3, %11 offset:%15+7168\n\t" \
                "ds_read_b128 %4, %11 offset:%15+2048\n\t" \
                "ds_read_b128 %5, %11 offset:%15+3072\n\t" \
                "ds_read_b128 %6, %11 offset:%15+9216\n\t" \
                "ds_read_b128 %7, %11 offset:%14+0\n\t" \
                "ds_read_b128 %8, %11 offset:%14+1024\n\t" \
                "ds_read_b64 %9, %12 offset:%14+8192\n\t" \
                "ds_read_b64 %10, %13 offset:%14+10240" \
                : "=&v"(fl[0]), "=&v"(fl[1]), "=&v"(fl[2]), "=&v"(fl[3]), "=&v"(fl[4]), "=&v"(fl[5]), "=&v"(fl[6]), \
                  "=&v"(f4[par][0]), "=&v"(f4[par][1]), "=&v"(f2[par][0]), "=&v"(f2[par][1]) \
                : "v"(b128), "v"(b64), "v"(bv), "n"(SBN), "n"(SBC) \
                : "memory")
#define RD_EARLY(par, SBN) asm volatile( \
                "ds_read_b128 %0, %4 offset:%7+0\n\t" \
                "ds_read_b128 %1, %4 offset:%7+1024\n\t" \
                "ds_read_b64 %2, %5 offset:%7+8192\n\t" \
                "ds_read_b64 %3, %6 offset:%7+10240\n\t" \
                "s_waitcnt lgkmcnt(0)" \
                : "=&v"(f4[par][0]), "=&v"(f4[par][1]), "=&v"(f2[par][0]), "=&v"(f2[par][1]) \
                : "v"(b128), "v"(b64), "v"(bv), "n"(SBN) \
                : "memory")
#define LATE_WAIT() asm volatile("s_waitcnt lgkmcnt(4)" \
                : "+v"(fl[0]), "+v"(fl[1]), "+v"(fl[2]), "+v"(fl[3]), "+v"(fl[4]), "+v"(fl[5]), "+v"(fl[6]) :: "memory")
#define RD_WAIT(par) asm volatile("s_waitcnt lgkmcnt(0)" \
                : "+v"(f4[par][0]), "+v"(f4[par][1]), "+v"(f2[par][0]), "+v"(f2[par][1]) :: "memory")
        ldrec(0, IC(0)); ldrec(1, IC(1)); ldrec(2, IC(2)); ldrec(3, IC(3)); ldrec(4, IC(4)); ldrec(5, IC(5));
        strec(IC(0), 0); ldrec(RD, IC(0));
        strec(IC(1), 1); ldrec(RD + 1, IC(1));
        rwgA = wg0[lane]; rwgB = wg0[64 + lane];
        asm volatile("s_waitcnt lgkmcnt(0)" ::: "memory");
        __builtin_amdgcn_s_barrier();
        RD_EARLY(0, 0);
#pragma unroll 1
        for (int c5 = 0; c5 <= nch; c5 += 12) {
          auto body = [&](auto SJ) {
            constexpr int sj = decltype(SJ)::value;
            constexpr int par = sj & 1;
            const int c = c5 + sj;
            asm volatile("s_waitcnt lgkmcnt(0)" ::: "memory");
            __builtin_amdgcn_s_barrier();
            RD_ISSUE(par ^ 1, ((sj + 1) % 4) * RWSLOT, (sj % 4) * RWSLOT);
            if (c > 0 && c <= nch) flush_y(c - 1, par ^ 1);
            strec(IC((sj + 2) % RD), (sj + 2) % 4);
            ldrec(c + 2 + RD, IC((sj + 2) % RD));
            if ((sj & 3) == 1) {
                const bool even = (((c >> 2) & 1) == 0);
                if (q == 0) *(float*)(smem + ((sj + 2) % 4) * RWSLOT + 12288 + lane * 4) = even ? rwgA : rwgB;
                const int gn = (c >> 2) + 2;
                const float nv = wg0[(size_t)(gn < ngr ? gn : ngr - 1) * 64 + lane];
                if (even) rwgA = nv; else rwgB = nv;
            }
            if (c < nch) {
            constexpr int SB = (sj % 4) * RWSLOT;
            auto asfrag4 = [](u32x4 v) { union { u32x4 u; bf16x8 f; } x; x.u = v; return x.f; };
            const bf16x8 A1_0 = asfrag4(f4[par][0]), A1_1 = asfrag4(f4[par][1]);
            const u32x2 mka = f2[par][0], vcur = f2[par][1];
            const bf16x8 ZB0 = asfrag(make_uint4(pack2(z[0][0], z[0][1]), pack2(z[0][2], z[0][3]), pack2(z[1][0], z[1][1]), pack2(z[1][2], z[1][3])));
            const bf16x8 ZB1 = asfrag(make_uint4(pack2(z[2][0], z[2][1]), pack2(z[2][2], z[2][3]), pack2(z[3][0], z[3][1]), pack2(z[3][2], z[3][3])));
            f32x4 Ua = f32x4{0.f, 0.f, 0.f, 0.f}, Ub = f32x4{0.f, 0.f, 0.f, 0.f};
            { typedef short s16x4 __attribute__((ext_vector_type(4)));
              Ua = __builtin_amdgcn_mfma_f32_16x16x16bf16_1k(__builtin_bit_cast(s16x4, mka), __builtin_bit_cast(s16x4, vcur), Ua, 0, 0, 0); }
            Ub = __builtin_amdgcn_mfma_f32_16x16x32_bf16(A1_1, ZB1, Ub, 0, 0, 0);
            Ua = __builtin_amdgcn_mfma_f32_16x16x32_bf16(A1_0, ZB0, Ua, 0, 0, 0);
            LATE_WAIT();
            const bf16x8 A3_0 = asfrag4(fl[0]), A3_1 = asfrag4(fl[1]), A3_2 = asfrag4(fl[2]), A3_3 = asfrag4(fl[3]);
            const bf16x8 A4_0 = asfrag4(fl[4]), A4_1 = asfrag4(fl[5]), MY = asfrag4(fl[6]);
            f32x4 Y = f32x4{0.f, 0.f, 0.f, 0.f};
            Y = __builtin_amdgcn_mfma_f32_16x16x32_bf16(A4_0, ZB0, Y, 0, 0, 0);
            Y = __builtin_amdgcn_mfma_f32_16x16x32_bf16(A4_1, ZB1, Y, 0, 0, 0);
            const f32x4 U = Ua + Ub;
            const bf16x8 UV = asfrag(make_uint4(pack2(U[0], U[1]), pack2(U[2], U[3]), vcur.x, vcur.y));
            z[0] = __builtin_amdgcn_mfma_f32_16x16x32_bf16(A3_0, UV, z[0], 0, 0, 0);
            z[1] = __builtin_amdgcn_mfma_f32_16x16x32_bf16(A3_1, UV, z[1], 0, 0, 0);
            z[2] = __builtin_amdgcn_mfma_f32_16x16x32_bf16(A3_2, UV, z[2], 0, 0, 0);
            z[3] = __builtin_amdgcn_mfma_f32_16x16x32_bf16(A3_3, UV, z[3], 0, 0, 0);
            Y = __builtin_amdgcn_mfma_f32_16x16x32_bf16(MY, UV, Y, 0, 0, 0);
            if ((c & 3) == 3) {
                u32x4 g0, g1, g2, g3;
                asm volatile(
                    "ds_read_b128 %0, %4 offset:%5+12288\n\t"
                    "ds_read_b128 %1, %4 offset:%5+12352\n\t"
                    "ds_read_b128 %2, %4 offset:%5+12416\n\t"
                    "ds_read_b128 %3, %4 offset:%5+12480\n\t"
                    "s_waitcnt lgkmcnt(0)"
                    : "=&v"(g0), "=&v"(g1), "=&v"(g2), "=&v"(g3) : "v"(bg), "n"(SB) : "memory");
                z[0][0] *= __uint_as_float(g0.x); z[0][1] *= __uint_as_float(g0.y); z[0][2] *= __uint_as_float(g0.z); z[0][3] *= __uint_as_float(g0.w);
                z[1][0] *= __uint_as_float(g1.x); z[1][1] *= __uint_as_float(g1.y); z[1][2] *= __uint_as_float(g1.z); z[1][3] *= __uint_as_float(g1.w);
                z[2][0] *= __uint_as_float(g2.x); z[2][1] *= __uint_as_float(g2.y); z[2][2] *= __uint_as_float(g2.z); z[2][3] *= __uint_as_float(g2.w);
                z[3][0] *= __uint_as_float(g3.x); z[3][1] *= __uint_as_float(g3.y); z[3][2] *= __uint_as_float(g3.z); z[3][3] *= __uint_as_float(g3.w);
            }
            {
                u16* yl = (u16*)(smem + 4 * RWSLOT + par * 2048);
                const unsigned y01 = pk2bf(Y[0], Y[1]), y23 = pk2bf(Y[2], Y[3]);
                yl[(4 * fq + 0) * 64 + 16 * q + fr] = (u16)(y01 & 0xFFFFu);
                yl[(4 * fq + 1) * 64 + 16 * q + fr] = (u16)(y01 >> 16);
                yl[(4 * fq + 2) * 64 + 16 * q + fr] = (u16)(y23 & 0xFFFFu);
                yl[(4 * fq + 3) * 64 + 16 * q + fr] = (u16)(y23 >> 16);
            }
            }
            RD_WAIT(par ^ 1);
          };
          body(IC(0)); body(IC(1)); body(IC(2)); body(IC(3)); body(IC(4)); body(IC(5)); body(IC(6)); body(IC(7)); body(IC(8)); body(IC(9)); body(IC(10)); body(IC(11));
        }
#pragma unroll
        for (int m = 0; m < 4; ++m) *(float4*)(zp + 4 * m) = make_float4(z[m][0], z[m][1], z[m][2], z[m][3]);
        asm volatile("s_waitcnt vmcnt(0)" ::: "memory");
        __builtin_amdgcn_s_setprio(0);
        __syncthreads();
    }
}

DEVINL void ph_rwout(const P& p, int l) {
    const int TIDX_ = tid_(); const int BIDX_ = bid_(); char* const WS_ = wsl_(p.ws);
    const int tid = TIDX_;
    const u16* pb = (const u16*)(WS_ + OFF_PB);
    const u16* yb = (const u16*)(WS_ + OFF_YRWB);
    const u16* gate = (const u16*)(WS_ + OFF_GATE);
    const float* bonus = (const float*)(WS_ + OFF_BONUS);
    u16* y = (u16*)(WS_ + OFF_Y);
    const float* mup = p.mu_prev + l * 960; const float* mun = p.mu_next + l * 960;
    const int c8 = (tid & 31) * 8, h = (tid & 31) >> 3;
    float lw[8], lb[8];
#pragma unroll
    for (int i = 0; i < 8; ++i) { lw[i] = p.rw_lnw[l * 256 + c8 + i]; lb[i] = p.rw_lnb[l * 256 + c8 + i]; }
    const int rstart = (l == 0) ? 0 : CTXROWS;
    const int rstep = (int)gridDim.x * 8;
#pragma unroll 1
    for (int row0 = rstart + BIDX_ * 8 + (tid >> 5); row0 < T; row0 += 2 * rstep) {
        int rowv[2]; rowv[0] = row0; rowv[1] = row0 + rstep;
        const bool has1 = rowv[1] < T;
        if (!has1) rowv[1] = row0;
        uint4 yfv[2], ybv[2], gv[2]; u32x4 mc[2], mp[2], mn[2]; float bn[2]; int tv[2], sl[2];
#pragma unroll
        for (int r = 0; r < 2; ++r) {
            const int row = rowv[r];
            if (row < CTXROWS) { tv[r] = row & 255; sl[r] = LCTX; } else { tv[r] = (row - CTXROWS) & (LAT - 1); sl[r] = LAT; }
            yfv[r] = *(const uint4*)(y + (size_t)row * 1024 + 512 + c8); ybv[r] = *(const uint4*)(yb + (size_t)row * 256 + c8);
            gv[r] = *(const uint4*)(gate + (size_t)row * 256 + c8);
            rw_mix8_ld(pb, row, tv[r], sl[r], 512 + c8, mc[r], mp[r], mn[r]);
            bn[r] = bonus[(size_t)row * 4 + h];
        }
#pragma unroll
        for (int r = 0; r < 2; ++r) {
            if (r == 1 && !has1) break;
            const int row = rowv[r];
            float v[8];
            rw_mix8_fin(mup, mun, tv[r], sl[r], 512 + c8, mc[r], mp[r], mn[r], v);
            const unsigned fw[4] = {yfv[r].x, yfv[r].y, yfv[r].z, yfv[r].w}, bw[4] = {ybv[r].x, ybv[r].y, ybv[r].z, ybv[r].w}, gw[4] = {gv[r].x, gv[r].y, gv[r].z, gv[r].w};
            float yv[8], gt[8]; float s1 = 0.f;
#pragma unroll
            for (int i = 0; i < 4; ++i) {
                yv[2 * i] = __uint_as_float(fw[i] << 16) + __uint_as_float(bw[i] << 16);
                yv[2 * i + 1] = __uint_as_float(fw[i] & 0xFFFF0000u) + __uint_as_float(bw[i] & 0xFFFF0000u);
                gt[2 * i] = __uint_as_float(gw[i] << 16); gt[2 * i + 1] = __uint_as_float(gw[i] & 0xFFFF0000u);
                s1 += yv[2 * i] + yv[2 * i + 1];
            }
            s1 += __shfl_xor(s1, 1); s1 += __shfl_xor(s1, 2); s1 += __shfl_xor(s1, 4);
            const float mu = s1 * (1.f / 64.f);
            float s2 = 0.f;
#pragma unroll
            for (int i = 0; i < 8; ++i) { const float dl = yv[i] - mu; s2 += dl * dl; }
            s2 += __shfl_xor(s2, 1); s2 += __shfl_xor(s2, 2); s2 += __shfl_xor(s2, 4);
            const float rstd = rsqrtf(s2 * (1.f / 64.f) + 64e-5f);
            float o[8];
#pragma unroll
            for (int i = 0; i < 8; ++i) o[i] = ((yv[i] - mu) * rstd * lw[i] + lb[i] + bn[r] * v[i]) * gt[i];
            *(uint4*)(y + (size_t)row * 1024 + 512 + c8) = pack8bf(o);
        }
    }
}
DEVINL void ph_prepM(const P& p, int l, char* smem, int bid, int nb) {
    const int TIDX_ = tid_(); const int BIDX_ = bid_(); char* const WS_ = wsl_(p.ws);
    const int tid = TIDX_, lane = tid & 63, wid = tid >> 6;
    const u16* pc = (const u16*)(WS_ + OFF_PC);
    u16* mlf = (u16*)(WS_ + OFF_MLF);
    float* mlg = (float*)(WS_ + OFF_MLG);
    float* mls = (float*)(WS_ + OFF_MLS);
    float* nst = (float*)(WS_ + OFF_NST);
    float* cst = (float*)(WS_ + OFF_HM);
    const float* rope = (const float*)(WS_ + OFF_ROPE);
    u16* kT = (u16*)smem;
    u16* vT = kT + 64 * 72;
    float* wsl = (float*)(vT + 64 * 72);
    float* lil = wsl + 128;
    u16* qkL = (u16*)(smem + 32768);
    float* ropeL = (float*)(smem + 24576);
    __syncthreads();
    for (int i = tid; i < 2048; i += 256) ropeL[i] = rope[8192 + i];
    for (int uh = bid; uh < NUNIT_CH * 4; uh += nb) {
        const int u = uh >> 2, h = uh & 3;
        int b, ch, row0, seqlen; bool isctx;
        if (u < 8) { isctx = true; b = u >> 2; ch = u & 3; row0 = b * 256 + ch * 64; seqlen = 256; }
        else { isctx = false; b = (u - 8) >> 8; ch = (u - 8) & 255; row0 = CTXROWS + b * LAT + ch * 64; seqlen = LAT; }
        const int t0 = ch * 64;
        const int tc = isctx ? ch : 4 + ch;
        __syncthreads();
        {
            const bool isk = wid >= 2;
            const int cch = (isk ? 256 : 0) + h * 64 + lane;
            const float* cw = p.ml_cw + (size_t)l * 3 * 512;
            const float w0 = cw[cch], w1 = cw[512 + cch], w2 = cw[1024 + cch], bb = p.ml_cb[l * 512 + cch];
            const int jb = (wid & 1) * 32;
            const int i16 = lane & 15; const bool second = (lane & 16) != 0; const int half = lane >> 5;
            const float cs0 = isctx ? 1.f : rope[ch * 16 + i16], sn0 = isctx ? 0.f : rope[4096 + ch * 16 + i16];
#pragma unroll 1
            for (int j0 = 0; j0 < 32; j0 += 16) {
            u16 xr[18];
#pragma unroll
            for (int jj = 0; jj < 18; ++jj) {
                const int tj = t0 + jb + j0 + jj - 1;
                const int rj = (tj >= 0 && tj < seqlen) ? row0 + jb + j0 + jj - 1 : row0 + jb;
                xr[jj] = pc[(size_t)rj * 1040 + cch];
            }
#pragma unroll
            for (int jj = 0; jj < 16; ++jj) {
                const int j = jb + j0 + jj;
                const float pv = (t0 + j > 0) ? bf2f(xr[jj]) : 0.f, cv = bf2f(xr[jj + 1]);
                const float nv = (t0 + j + 1 < seqlen) ? bf2f(xr[jj + 2]) : 0.f;
                float val = siluf_(w0 * pv + w1 * cv + w2 * nv + bb);
                if (!isctx) {
                    const float cs = half == 0 ? cs0 : ropeL[j * 16 + i16];
                    const float sn = half == 0 ? sn0 : ropeL[1024 + j * 16 + i16];
                    const float ov = __shfl_xor(val, 16);
                    val = second ? (ov * sn + val * cs) : (val * cs - ov * sn);
                }
                if (isk) { const u16 kb = f2bf(val * 0.125f); qkL[j * 128 + 64 + lane] = kb; kT[lane * 72 + j] = kb; }
                else qkL[j * 128 + lane] = f2bf(val);
            }
            }
            {
                const int j = tid >> 2, wh = tid & 3;
                const int idx = (wh < 2) ? (wh * 4 + h) : (8 + (wh - 2) * 4 + h);
                const float g = bf2f(pc[(size_t)(row0 + j) * 1040 + 1024 + idx]);
                float v;
                if (wh < 2) v = g + p.ml_ib[l * 8 + idx];
                else { const float xx = g + p.ml_fb[l * 8 + idx - 8]; v = fminf(xx, 0.f) - log1pf(__expf(-fabsf(xx))); }
                lil[j * 4 + wh] = v;
                if (wh < 2) mlg[(size_t)(row0 + j) * 16 + idx] = v;
            }
            for (int i = tid; i < 64 * 8; i += 256) {
                const int tok = i >> 3, d8 = (i & 7) * 8;
                const uint4 vv = *(const uint4*)(pc + (size_t)(row0 + tok) * 1040 + 512 + h * 64 + d8);
                const unsigned wv[4] = {vv.x, vv.y, vv.z, vv.w};
#pragma unroll
                for (int k = 0; k < 4; ++k) { vT[(d8 + 2 * k) * 72 + tok] = (u16)(wv[k] & 0xFFFFu); vT[(d8 + 2 * k + 1) * 72 + tok] = (u16)(wv[k] >> 16); }
            }
        }
        __syncthreads();
#pragma unroll
        for (int i = 0; i < 4; ++i) {
            const int c = tid + 256 * i, tok = c >> 4, part = c & 15;
            const uint4 v = *(const uint4*)(qkL + tok * 128 + part * 8);
            *(uint4*)(mlf + (size_t)(row0 + tok) * 512 + (part < 8 ? h * 64 + part * 8 : 256 + h * 64 + (part - 8) * 8)) = v;
        }
        if (wid < 2) {
            const int d = wid, tok = d ? 63 - lane : lane;
            float bsum = lil[tok * 4 + 2 + d];
#pragma unroll
            for (int off = 1; off < 64; off <<= 1) { const float o = __shfl_up(bsum, off); if (lane >= off) bsum += o; }
            const float Bs = __shfl(bsum, 63);
            const float gl = Bs - bsum + lil[tok * 4 + d];
            float G = gl;
#pragma unroll
            for (int off = 32; off > 0; off >>= 1) G = fmaxf(G, __shfl_xor(G, off));
            wsl[d * 64 + tok] = __expf(gl - G);
            mlg[(size_t)(row0 + tok) * 16 + 8 + d * 4 + h] = bsum;
            if (lane == 0) { const int bhd = (b * 4 + h) * 2 + d; mls[(bhd * NTC + tc) * 2 + 0] = G; mls[(bhd * NTC + tc) * 2 + 1] = Bs; }
        }
        __syncthreads();
        {
            const int fr = lane & 15, g = lane >> 4;
            const int bh0 = ((b * 4 + h) * 2 + 0) * NTC + tc, bh1 = ((b * 4 + h) * 2 + 1) * NTC + tc;
            float* ust = (float*)(smem + 32768) + wid * 2048;
            bf16x8 va[2];
            va[0] = *(const bf16x8*)(vT + (16 * wid + fr) * 72 + 8 * g);
            va[1] = *(const bf16x8*)(vT + (16 * wid + fr) * 72 + 32 + 8 * g);
#pragma unroll 1
            for (int dkt = 0; dkt < 4; ++dkt) {
                f32x4 u0 = f32x4{0.f, 0.f, 0.f, 0.f}, u1 = f32x4{0.f, 0.f, 0.f, 0.f};
#pragma unroll
                for (int ks = 0; ks < 2; ++ks) {
                    const uint4 kv = *(const uint4*)(kT + (16 * dkt + fr) * 72 + 32 * ks + 8 * g);
                    const float4 wa0 = *(const float4*)(wsl + 32 * ks + 8 * g), wa1 = *(const float4*)(wsl + 32 * ks + 8 * g + 4);
                    const float4 wb0 = *(const float4*)(wsl + 64 + 32 * ks + 8 * g), wb1 = *(const float4*)(wsl + 64 + 32 * ks + 8 * g + 4);
                    const unsigned kw[4] = {kv.x, kv.y, kv.z, kv.w};
                    const float w0[8] = {wa0.x, wa0.y, wa0.z, wa0.w, wa1.x, wa1.y, wa1.z, wa1.w}, w1[8] = {wb0.x, wb0.y, wb0.z, wb0.w, wb1.x, wb1.y, wb1.z, wb1.w};
                    union { u32x4 u; bf16x8 f; } b0, b1;
#pragma unroll
                    for (int i = 0; i < 4; ++i) {
                        const float ka = __uint_as_float(kw[i] << 16), kb = __uint_as_float(kw[i] & 0xFFFF0000u);
                        b0.u[i] = pk2bf(ka * w0[2 * i], kb * w0[2 * i + 1]);
                        b1.u[i] = pk2bf(ka * w1[2 * i], kb * w1[2 * i + 1]);
                    }
                    u0 = __builtin_amdgcn_mfma_f32_16x16x32_bf16(va[ks], b0.f, u0, 0, 0, 0);
                    u1 = __builtin_amdgcn_mfma_f32_16x16x32_bf16(va[ks], b1.f, u1, 0, 0, 0);
                }
#pragma unroll
                for (int r = 0; r < 4; ++r) {
                    ust[(4 * g + r) * 64 + 16 * dkt + fr] = u0[r];
                    ust[1024 + (4 * g + r) * 64 + 16 * dkt + fr] = u1[r];
                }
            }
#pragma unroll
            for (int i = 0; i < 4; ++i) {
                const int rr = 4 * i + (lane >> 4), c4 = (lane & 15) * 4;
                const float4 a0 = *(const float4*)(ust + rr * 64 + c4), a1 = *(const float4*)(ust + 1024 + rr * 64 + c4);
                *(float4*)(cst + (size_t)bh0 * 4096 + (16 * wid + rr) * 64 + c4) = a0;
                *(float4*)(cst + (size_t)bh1 * 4096 + (16 * wid + rr) * 64 + c4) = a1;
            }
            if (tid < 128) {
                const int d = tid >> 6, dk = tid & 63;
                float acc = 0.f;
#pragma unroll 8
                for (int j = 0; j < 64; ++j) acc += bf2f(kT[dk * 72 + j]) * wsl[d * 64 + j];
                nst[(size_t)(d ? bh1 : bh0) * 64 + dk] = acc;
            }
        }
    }
}

DEVINL void ph_mlB(const P& p, int bid, int nb, char* smem) {
    const int TIDX_ = tid_(); char* const WS_ = wsl_(p.ws);
    const int tid = TIDX_;
    const float* mls = (const float*)(WS_ + OFF_MLS);
    float* mst = (float*)(WS_ + OFF_MST);
    float* nst = (float*)(WS_ + OFF_NST);
    const float* cst = (const float*)(WS_ + OFF_HM);
    u16* cst2 = (u16*)(WS_ + OFF_CST2);
    float* nst2 = (float*)(WS_ + OFF_NST2);
    float* gb = (float*)smem;
    float* dcu = gb + 1024;
    for (int u = bid; u < 64; u += nb) {
        const int bhd = u >> 2, q = u & 3, d = bhd & 1;
        auto tcof = [&](int cs) { return cs < 4 ? (d ? 3 - cs : cs) : 4 + (d ? 255 - (cs - 4) : cs - 4); };
        __syncthreads();
        for (int cs = tid; cs < NTC; cs += 256) { const int tc = tcof(cs); gb[cs * 2] = mls[(bhd * NTC + tc) * 2]; gb[cs * 2 + 1] = mls[(bhd * NTC + tc) * 2 + 1]; }
        __syncthreads();
        if (tid == 0) {
            float m = 0.f;
#pragma unroll 1
            for (int cs = 0; cs < NTC; ++cs) {
                const float G = gb[cs * 2], Bs = gb[cs * 2 + 1];
                if (q == 0) mst[bhd * NTC + tcof(cs)] = m;
                const float ml = fmaxf(Bs + m, G);
                dcu[cs * 2] = __expf(Bs + m - ml); dcu[cs * 2 + 1] = __expf(G - ml);
                m = ml;
            }
        }
        __syncthreads();
        float zz = 0.f; asm volatile("" : "+v"(zz));
        float4 C = make_float4(zz, zz, zz, zz);
        float nn = zz;
        const bool don = (q == 0) && (tid < 64);
        const float* cbase = cst + (size_t)bhd * NTC * 4096 + q * 1024 + tid * 4;
        const float* nbase = nst + (size_t)bhd * NTC * 64 + tid;
        u16* obase = cst2 + (size_t)bhd * NTC * 4096 + q * 1024 + tid * 4;
        float* onbase = nst2 + (size_t)bhd * NTC * 64 + tid;
        float4 Ub[8]; float Nb[8];
#pragma unroll
        for (int i = 0; i < 8; ++i) { Ub[i] = ld_nt16f(cbase + (size_t)tcof(i) * 4096); Nb[i] = don ? nbase[(size_t)tcof(i) * 64] : 0.f; }
#pragma unroll 1
        for (int cs0 = 0; cs0 < NTC; cs0 += 8) {
#pragma unroll
            for (int i = 0; i < 8; ++i) {
                const int cs = cs0 + i;
                if (cs < NTC) {
                    const float4 U = Ub[i]; const float nU = Nb[i];
                    const int tc = tcof(cs);
                    if (cs + 8 < NTC) { Ub[i] = ld_nt16f(cbase + (size_t)tcof(cs + 8) * 4096); Nb[i] = don ? nbase[(size_t)tcof(cs + 8) * 64] : 0.f; }
                    { uint2 o; o.x = pk2bf(C.x, C.y); o.y = pk2bf(C.z, C.w); st_nt8(obase + (size_t)tc * 4096, o); }
                    if (don) onbase[(size_t)tc * 64] = nn;
                    const float dC = dcu[cs * 2], dU = dcu[cs * 2 + 1];
                    C.x = dC * C.x + dU * U.x; C.y = dC * C.y + dU * U.y; C.z = dC * C.z + dU * U.z; C.w = dC * C.w + dU * U.w;
                    nn = dC * nn + dU * nU;
                }
            }
        }
    }
}

DEVINL void ph_na(const P& p, int l, char* smem, int bid, int nb, int ulo, int uhi) {
    const int TIDX_ = tid_(); char* const WS_ = wsl_(p.ws);
    const int tid = TIDX_, lane = tid & 63, w = tid >> 6, fr = lane & 15, g = lane >> 4;
    const u16* pqk = (const u16*)(WS_ + OFF_PQK);
    const u16* vtl = (const u16*)(WS_ + OFF_VTL);
    const u16* vtc = (const u16*)(WS_ + OFF_VTC);
    u16* y = (u16*)(WS_ + OFF_Y);
    float* rpbl = (float*)(smem + 49152);
    const int nunit = 4096 + (l == 0 ? 64 : 0);
    const unsigned lbase = lds_addr(smem);
    const int lrow0 = tid >> 3, lrow1 = lrow0 + 32, lsc = ((tid & 7) ^ (lrow0 & 7)) * 8;
    for (int u = ulo + bid; u < min(uhi, nunit); u += nb) {
        const bool isctx = u >= 4096;
        int b, h, r = 0, qg = 0;
        if (!isctx) { b = u >> 11; h = (u >> 8) & 7; r = u & 255; }
        else { const int v = u - 4096; b = v >> 5; h = (v >> 2) & 7; qg = v & 3; }
        const int rs = min(max(r - 4, 0), 248);
        const int nwin = isctx ? 0 : 8, nst = nwin + 4;
        auto issue = [&](int st) {
            char* slot = smem + (st % 3) * 16384;
            const u16* ksrc; const u16* vsrc; size_t vstride;
            if (st < nwin) {
                const size_t tok0 = (size_t)CTXROWS + (size_t)b * LAT + (size_t)(rs + st) * 64;
                ksrc = pqk + tok0 * 1024 + 512 + h * 64;
                vsrc = vtl + (size_t)((b * 8 + h) * 64) * LAT + (size_t)(rs + st) * 64; vstride = LAT;
            } else {
                const size_t tok0 = (size_t)b * LCTX + (size_t)(st - nwin) * 64;
                ksrc = pqk + tok0 * 1024 + 512 + h * 64;
                vsrc = vtc + (size_t)((b * 8 + h) * 64) * LCTX + (size_t)(st - nwin) * 64; vstride = LCTX;
            }
            glds16(ksrc + (size_t)lrow0 * 1024 + lsc, slot + tid * 16);
            glds16(ksrc + (size_t)lrow1 * 1024 + lsc, slot + 4096 + tid * 16);
            glds16(vsrc + (size_t)lrow0 * vstride + lsc, slot + 8192 + tid * 16);
            glds16(vsrc + (size_t)lrow1 * vstride + lsc, slot + 8192 + 4096 + tid * 16);
        };
        __syncthreads();
        issue(0); issue(1);
        if (!isctx) for (int i = tid; i < 465; i += 256) rpbl[i] = p.na_rpb[((size_t)l * 8 + h) * 465 + i];
        asm volatile("s_waitcnt lgkmcnt(0)" ::: "memory");
        const int c = 16 * w + fr;
        const int qrow = isctx ? b * LCTX + qg * 64 + c : CTXROWS + b * LAT + r * 64 + c;
        bf16x8 qf[2];
        qf[0] = *(const bf16x8*)(pqk + (size_t)qrow * 1024 + h * 64 + 8 * g);
        qf[1] = *(const bf16x8*)(pqk + (size_t)qrow * 1024 + h * 64 + 32 + 8 * g);
        f32x4 O[4];
#pragma unroll
        for (int i = 0; i < 4; ++i) O[i] = f32x4{0.f, 0.f, 0.f, 0.f};
        float mrun = -1.0e30f, lrun = 0.f;
        const int cb = (w == 0) ? 0 : (w == 1) ? 8 : (w == 2) ? 24 : 32;
        const int cs = min(max(c - 8, 0), 48);
        auto chunk = [&](unsigned sl, int kb, const float* bias0, bool local) {
            const int key0 = kb + fr, key1 = kb + 16 + fr;
            const unsigned ka0 = sl + key0 * 128, ka1 = sl + key1 * 128;
            const unsigned k00a = ka0 + ((g ^ (key0 & 7)) << 4), k01a = ka0 + (((4 + g) ^ (key0 & 7)) << 4);
            const unsigned k10a = ka1 + ((g ^ (key1 & 7)) << 4), k11a = ka1 + (((4 + g) ^ (key1 & 7)) << 4);
            const int q0 = (kb >> 2) + g, q1 = q0 + 4;
            const unsigned vbase = sl + 8192 + fr * 128;
            const unsigned vo0 = ((((q0 >> 1) ^ (fr & 7)) << 4) + ((q0 & 1) << 3)), vo1 = ((((q1 >> 1) ^ (fr & 7)) << 4) + ((q1 & 1) << 3));
            u32x4 k00, k01, k10, k11; u32x2 vlo0, vhi0, vlo1, vhi1, vlo2, vhi2, vlo3, vhi3;
            asm volatile(
                "ds_read_b128 %0, %12\n\t"
                "ds_read_b128 %1, %13\n\t"
                "ds_read_b128 %2, %14\n\t"
                "ds_read_b128 %3, %15\n\t"
                "ds_read_b64 %4, %16\n\t"
                "ds_read_b64 %5, %17\n\t"
                "ds_read_b64 %6, %16 offset:2048\n\t"
                "ds_read_b64 %7, %17 offset:2048\n\t"
                "ds_read_b64 %8, %16 offset:4096\n\t"
                "ds_read_b64 %9, %17 offset:4096\n\t"
                "ds_read_b64 %10, %16 offset:6144\n\t"
                "ds_read_b64 %11, %17 offset:6144\n\t"
                "s_waitcnt lgkmcnt(0)"
                : "=&v"(k00), "=&v"(k01), "=&v"(k10), "=&v"(k11), "=&v"(vlo0), "=&v"(vhi0), "=&v"(vlo1), "=&v"(vhi1),
                  "=&v"(vlo2), "=&v"(vhi2), "=&v"(vlo3), "=&v"(vhi3)
                : "v"(k00a), "v"(k01a), "v"(k10a), "v"(k11a), "v"(vbase + vo0), "v"(vbase + vo1)
                : "memory");
            auto asf = [](u32x4 v) { union { u32x4 u; bf16x8 f; } x; x.u = v; return x.f; };
            f32x4 s0 = f32x4{0.f, 0.f, 0.f, 0.f}, s1 = f32x4{0.f, 0.f, 0.f, 0.f};
            s0 = __builtin_amdgcn_mfma_f32_16x16x32_bf16(asf(k00), qf[0], s0, 0, 0, 0);
            s0 = __builtin_amdgcn_mfma_f32_16x16x32_bf16(asf(k01), qf[1], s0, 0, 0, 0);
            s1 = __builtin_amdgcn_mfma_f32_16x16x32_bf16(asf(k10), qf[0], s1, 0, 0, 0);
            s1 = __builtin_amdgcn_mfma_f32_16x16x32_bf16(asf(k11), qf[1], s1, 0, 0, 0);
            float sv[8];
#pragma unroll
            for (int j = 0; j < 4; ++j) {
                float a = s0[j] * 0.125f, bb = s1[j] * 0.125f;
                if (local) {
                    const int k0c = kb + 4 * g + j, k1c = k0c + 16;
                    a = (k0c >= cs && k0c <= cs + 15) ? a + bias0[k0c] : -1.0e30f;
                    bb = (k1c >= cs && k1c <= cs + 15) ? bb + bias0[k1c] : -1.0e30f;
                }
                sv[j] = a; sv[4 + j] = bb;
            }
            float mx = sv[0];
#pragma unroll
            for (int j = 1; j < 8; ++j) mx = fmaxf(mx, sv[j]);
            mx = fmaxf(mx, __shfl_xor(mx, 16)); mx = fmaxf(mx, __shfl_xor(mx, 32));
            const float mnew = fmaxf(mrun, mx);
            const float sc = __expf(mrun - mnew);
            mrun = mnew;
            float ps = 0.f; float pv[8];
#pragma unroll
            for (int j = 0; j < 8; ++j) { pv[j] = __expf(sv[j] - mnew); ps += pv[j]; }
            lrun = lrun * sc + ps;
            union { u32x4 u; bf16x8 f; } pf; pf.u = u32x4{pk2bf(pv[0], pv[1]), pk2bf(pv[2], pv[3]), pk2bf(pv[4], pv[5]), pk2bf(pv[6], pv[7])};
            const u32x2 vl[4] = {vlo0, vlo1, vlo2, vlo3}, vh[4] = {vhi0, vhi1, vhi2, vhi3};
#pragma unroll
            for (int dt = 0; dt < 4; ++dt) {
                O[dt][0] *= sc; O[dt][1] *= sc; O[dt][2] *= sc; O[dt][3] *= sc;
                union { u32x4 u; bf16x8 f; } vf; vf.u = u32x4{vl[dt].x, vl[dt].y, vh[dt].x, vh[dt].y};
                O[dt] = __builtin_amdgcn_mfma_f32_16x16x32_bf16(vf.f, pf.f, O[dt], 0, 0, 0);
            }
        };
#pragma unroll 1
        for (int st = 0; st < nst; ++st) {
            if (st + 1 < nst) asm volatile("s_waitcnt vmcnt(4)" ::: "memory"); else asm volatile("s_waitcnt vmcnt(0)" ::: "memory");
            __builtin_amdgcn_s_barrier();
            if (st + 2 < nst) issue(st + 2);
            const unsigned sl = lbase + (st % 3) * 16384;
            if (st < nwin) {
                const int krow = rs + st;
                chunk(sl, cb, rpbl + (krow - r + 7) * 31 - c + 15, true);
            } else {
                chunk(sl, 0, nullptr, false);
                chunk(sl, 32, nullptr, false);
            }
        }
        float lt = lrun; lt += __shfl_xor(lt, 16); lt += __shfl_xor(lt, 32);
        const float inv = 1.f / lt;
#pragma unroll
        for (int dt = 0; dt < 4; ++dt) {
            uint2 o;
            o.x = pk2bf(O[dt][0] * inv, O[dt][1] * inv);
            o.y = pk2bf(O[dt][2] * inv, O[dt][3] * inv);
            *(uint2*)(y + (size_t)qrow * 1024 + h * 64 + dt * 16 + 4 * g) = o;
        }
    }
    asm volatile("s_waitcnt vmcnt(0)" ::: "memory");
    __syncthreads();
}

DEVINL void ph_mlC(const P& p, int l, char* smem, int bid, int nb) {
    const int TIDX_ = tid_(); char* const WS_ = wsl_(p.ws);
    const int tid = TIDX_, lane = tid & 63, w = tid >> 6, fr = lane & 15, g = lane >> 4;
    const u16* mlf = (const u16*)(WS_ + OFF_MLF);
    const u16* pc = (const u16*)(WS_ + OFF_PC);
    const float* mlg = (const float*)(WS_ + OFF_MLG);
    const float* mst = (const float*)(WS_ + OFF_MST);
    const float* nst = (const float*)(WS_ + OFF_NST2);
    const u16* cst = (const u16*)(WS_ + OFF_CST2);
    u16* y = (u16*)(WS_ + OFF_Y);
    u16* vt = (u16*)smem;
    float* btl = (float*)(smem + 9216);
    float* lil = btl + 128;
    float* nl = lil + 128;
    for (int uh = bid; uh < 2 * NTC * 4; uh += nb) {
        const int u = uh >> 2, h = uh & 3;
        const int b = u / NTC, tc = u % NTC;
        if (tc < 4 && l != 0) continue;
        const int row0 = tc < 4 ? b * LCTX + tc * 64 : CTXROWS + b * LAT + (tc - 4) * 64;
        __syncthreads();
        for (int i = tid; i < 64 * 8; i += 256) {
            const int tok = i >> 3, d8 = (i & 7) * 8;
            const uint4 vv = *(const uint4*)(pc + (size_t)(row0 + tok) * 1040 + 512 + h * 64 + d8);
            const unsigned wv[4] = {vv.x, vv.y, vv.z, vv.w};
#pragma unroll
            for (int k = 0; k < 4; ++k) { vt[(d8 + 2 * k) * 72 + tok] = (u16)(wv[k] & 0xFFFFu); vt[(d8 + 2 * k + 1) * 72 + tok] = (u16)(wv[k] >> 16); }
        }
        if (tid < 128) {
            const int d = tid >> 6, tok = tid & 63;
            lil[d * 64 + tok] = mlg[(size_t)(row0 + tok) * 16 + d * 4 + h];
            nl[d * 64 + tok] = nst[((size_t)((b * 4 + h) * 2 + d) * NTC + tc) * 64 + tok];
        }
        else { const int d = (tid - 128) >> 6, tok = tid & 63; btl[d * 64 + tok] = mlg[(size_t)(row0 + tok) * 16 + 8 + d * 4 + h]; }
        const int t = 16 * w + fr;
        bf16x8 qf[2];
        qf[0] = *(const bf16x8*)(mlf + (size_t)(row0 + t) * 512 + h * 64 + 8 * g);
        qf[1] = *(const bf16x8*)(mlf + (size_t)(row0 + t) * 512 + h * 64 + 32 + 8 * g);
        f32x4 S[4];
#pragma unroll
        for (int st = 0; st < 4; ++st) {
            const u16* kp = mlf + (size_t)(row0 + 16 * st + fr) * 512 + 256 + h * 64 + 8 * g;
            const bf16x8 k0 = *(const bf16x8*)kp, k1 = *(const bf16x8*)(kp + 32);
            S[st] = f32x4{0.f, 0.f, 0.f, 0.f};
            S[st] = __builtin_amdgcn_mfma_f32_16x16x32_bf16(k0, qf[0], S[st], 0, 0, 0);
            S[st] = __builtin_amdgcn_mfma_f32_16x16x32_bf16(k1, qf[1], S[st], 0, 0, 0);
        }
        __syncthreads();
        f32x4 hs[4];
#pragma unroll
        for (int i = 0; i < 4; ++i) hs[i] = f32x4{0.f, 0.f, 0.f, 0.f};
#pragma unroll 1
        for (int d = 0; d < 2; ++d) {
            const int bhd = (b * 4 + h) * 2 + d;
            const float m0 = mst[bhd * NTC + tc];
            const float bt = btl[d * 64 + t];
            float ld[16]; float mx = -3.0e38f;
#pragma unroll
            for (int st = 0; st < 4; ++st) {
                const float4 b4 = *(const float4*)(btl + d * 64 + 16 * st + 4 * g), l4 = *(const float4*)(lil + d * 64 + 16 * st + 4 * g);
                const float bs[4] = {b4.x, b4.y, b4.z, b4.w}, ls[4] = {l4.x, l4.y, l4.z, l4.w};
#pragma unroll
                for (int r = 0; r < 4; ++r) {
                    const int s = 16 * st + 4 * g + r;
                    const bool ok = d ? (s >= t) : (s <= t);
                    ld[4 * st + r] = ok ? (bt - bs[r] + ls[r]) : -3.0e38f;
                    mx = fmaxf(mx, ld[4 * st + r]);
                }
            }
            mx = fmaxf(mx, __shfl_xor(mx, 16)); mx = fmaxf(mx, __shfl_xor(mx, 32));
            const float mt = fmaxf(bt + m0, mx);
            float rsum = 0.f; float dw[16];
#pragma unroll
            for (int i = 0; i < 16; ++i) { dw[i] = (ld[i] > -1.0e38f) ? __expf(ld[i] - mt) * S[i >> 2][i & 3] : 0.f; rsum += dw[i]; }
            rsum += __shfl_xor(rsum, 16); rsum += __shfl_xor(rsum, 32);
            const float inter = __expf(bt + m0 - mt);
            float qn = 0.f;
#pragma unroll
            for (int j = 0; j < 8; ++j) {
                qn += bf2f((u16)qf[0][j]) * nl[d * 64 + 8 * g + j] + bf2f((u16)qf[1][j]) * nl[d * 64 + 32 + 8 * g + j];
            }
            qn += __shfl_xor(qn, 16); qn += __shfl_xor(qn, 32);
            const float den = rsum + inter * qn;
            const float dn = 1.f / fmaxf(fabsf(den), __expf(-mt));
            union { u32x4 u; bf16x8 f; } pf[2];
#pragma unroll
            for (int ks = 0; ks < 2; ++ks) pf[ks].u = u32x4{pk2bf(dw[8 * ks], dw[8 * ks + 1]), pk2bf(dw[8 * ks + 2], dw[8 * ks + 3]), pk2bf(dw[8 * ks + 4], dw[8 * ks + 5]), pk2bf(dw[8 * ks + 6], dw[8 * ks + 7])};
            const u16* cb = cst + ((size_t)bhd * NTC + tc) * 4096;
#pragma unroll
            for (int dvt = 0; dvt < 4; ++dvt) {
                f32x4 num = f32x4{0.f, 0.f, 0.f, 0.f}, qc = f32x4{0.f, 0.f, 0.f, 0.f};
#pragma unroll
                for (int ks = 0; ks < 2; ++ks) {
                    const uint2 lo = *(const uint2*)(vt + (16 * dvt + fr) * 72 + 32 * ks + 4 * g), hi = *(const uint2*)(vt + (16 * dvt + fr) * 72 + 32 * ks + 16 + 4 * g);
                    union { u32x4 u; bf16x8 f; } vf; vf.u = u32x4{lo.x, lo.y, hi.x, hi.y};
                    num = __builtin_amdgcn_mfma_f32_16x16x32_bf16(vf.f, pf[ks].f, num, 0, 0, 0);
                    const bf16x8 cf = *(const bf16x8*)(cb + (16 * dvt + fr) * 64 + 32 * ks + 8 * g);
                    qc = __builtin_amdgcn_mfma_f32_16x16x32_bf16(cf, qf[ks], qc, 0, 0, 0);
                }
#pragma unroll
                for (int r = 0; r < 4; ++r) hs[dvt][r] += (num[r] + inter * qc[r]) * dn;
            }
        }
        float s1 = 0.f;
#pragma unroll
        for (int i = 0; i < 4; ++i) s1 += hs[i][0] + hs[i][1] + hs[i][2] + hs[i][3];
        s1 += __shfl_xor(s1, 16); s1 += __shfl_xor(s1, 32);
        const float mu = s1 * (1.f / 64.f);
        float s2 = 0.f;
#pragma unroll
        for (int i = 0; i < 4; ++i)
#pragma unroll
            for (int r = 0; r < 4; ++r) { const float dl = hs[i][r] - mu; s2 += dl * dl; }
        s2 += __shfl_xor(s2, 16); s2 += __shfl_xor(s2, 32);
        const float rstd = rsqrtf(s2 * (1.f / 64.f) + 1e-6f);
        const int row = row0 + t;
#pragma unroll
        for (int dvt = 0; dvt < 4; ++dvt) {
            const int cc = h * 64 + 16 * dvt + 4 * g;
            const uint2 ov = *(const uint2*)(pc + (size_t)row * 1040 + 768 + cc);
            const float4 nw = *(const float4*)(p.ml_nw + l * 256 + cc);
            const float o0 = bf2f((u16)(ov.x & 0xFFFF)), o1 = bf2f((u16)(ov.x >> 16)), o2 = bf2f((u16)(ov.y & 0xFFFF)), o3 = bf2f((u16)(ov.y >> 16));
            uint2 out;
            out.x = pk2bf((hs[dvt][0] - mu) * rstd * nw.x * sigmoidf_(o0), (hs[dvt][1] - mu) * rstd * nw.y * sigmoidf_(o1));
            out.y = pk2bf((hs[dvt][2] - mu) * rstd * nw.z * sigmoidf_(o2), (hs[dvt][3] - mu) * rstd * nw.w * sigmoidf_(o3));
            *(uint2*)(y + (size_t)row * 1024 + 768 + cc) = out;
        }
    }
}

DEVINL void ph_outproj(const P& p, int l, char* smem) {
    const int TIDX_ = tid_(); const int BIDX_ = bid_(); char* const WS_ = wsl_(p.ws); (void)TIDX_; (void)BIDX_; (void)WS_;
    const u16* y = (const u16*)(WS_ + OFF_Y);
    const u16* wout = (const u16*)(WS_ + OFF_WOUT);
    const float* modv = (const float*)(WS_ + OFF_MOD) + (size_t)l * 3 * 6144;
    const float* x2c = (const float*)(WS_ + OFF_X2CTX);
    u16* x1 = (u16*)(WS_ + OFF_X1);
    const int mt0 = (l == 0) ? 0 : 4;
    const int ntile = (260 - mt0) * 8;
    XCD_WALK(ntile, BIDX_, (int)gridDim.x);
    for (int u = xw_lo; u < xw_hi; u += xw_st) {
        const int mt = mt0 + u / 8, nt = u % 8;
        const u16* A = y + (size_t)mt * 128 * 1024;
        const int R0 = mt * 128;
        const float* xin;
        if (l == 0) xin = R0 < CTXROWS ? p.ctx + (size_t)R0 * 1024 : p.x + (size_t)(R0 - CTXROWS) * 1024;
        else xin = R0 < CTXROWS ? x2c + (size_t)R0 * 1024 : p.out + (size_t)(R0 - CTXROWS) * 1024;
        const float* g1 = modv + row_sel(R0) * 6144 + 2048;
        f32x4 acc[4][4];
        gemm128_acc([&](int r) { return A + (size_t)r * 1024; }, wout + (size_t)nt * 128 * 1024, 1024, 1024, smem, acc);
        stage_tile_f32(acc, smem, [&](int row, int c4, float4 a) {
            const int N = nt * 128 + c4;
            const float4 gg = *(const float4*)(g1 + N);
            const float4 xv = *(const float4*)(xin + (size_t)row * 1024 + N);
            float4 o;
            o.x = ALPHA * xv.x + gg.x * a.x; o.y = ALPHA * xv.y + gg.y * a.y; o.z = ALPHA * xv.z + gg.z * a.z; o.w = ALPHA * xv.w + gg.w * a.w;
            uint2 ob; ob.x = pk2bf(o.x, o.y); ob.y = pk2bf(o.z, o.w);
            st_nt8(x1 + (size_t)(R0 + row) * 1024 + N, ob);
        });
    }
}

DEVINL void ph_ln1(const P& p, int l) {
    const int TIDX_ = tid_(); const int BIDX_ = bid_(); char* const WS_ = wsl_(p.ws); (void)TIDX_; (void)BIDX_; (void)WS_;
    const int lane = TIDX_ & 63, wid = TIDX_ >> 6;
    const float* modv = (const float*)(WS_ + OFF_MOD) + (size_t)l * 3 * 6144;
    u16* x1 = (u16*)(WS_ + OFF_X1);
    u16* hm = (u16*)(WS_ + OFF_HM);
    const int rstart = (l == 0) ? 0 : CTXROWS;
    constexpr int NR = 4;
    const int rstride = (int)gridDim.x * 4;
    u32x4 raw[NR][2];
    auto ldraw = [&](int rbase) {
#pragma unroll
        for (int r = 0; r < NR; ++r) {
            const int rr = rbase + r * rstride, rc = rr < T ? rr : rbase;
#pragma unroll
            for (int i = 0; i < 2; ++i) raw[r][i] = *(const u32x4*)(x1 + (size_t)rc * 1024 + i * 512 + lane * 8);
        }
    };
    const int rfirst = rstart + BIDX_ * 4 + wid;
    if (rfirst < T) ldraw(rfirst);
#pragma unroll 1
    for (int row0 = rfirst; row0 < T; row0 += NR * rstride) {
        int rowv[NR]; bool has[NR];
#pragma unroll
        for (int r = 0; r < NR; ++r) { const int rr = row0 + r * rstride; has[r] = rr < T; rowv[r] = has[r] ? rr : row0; }
        float v[NR][2][8];
        float s[NR];
#pragma unroll
        for (int r = 0; r < NR; ++r) {
            s[r] = 0.f;
#pragma unroll
            for (int i = 0; i < 2; ++i) {
#pragma unroll
                for (int k = 0; k < 4; ++k) { const unsigned xw = raw[r][i][k]; v[r][i][2 * k] = __uint_as_float(xw << 16); v[r][i][2 * k + 1] = __uint_as_float(xw & 0xFFFF0000u); s[r] += v[r][i][2 * k] + v[r][i][2 * k + 1]; }
            }
        }
        if (row0 + NR * rstride < T) ldraw(row0 + NR * rstride);
#pragma unroll
        for (int r = 0; r < NR; ++r) {
            if (!has[r]) continue;
            const int row = rowv[r];
            const float mu = wsum(s[r]) * (1.f / 1024.f);
            float q = 0.f;
#pragma unroll
            for (int i = 0; i < 2; ++i)
#pragma unroll
                for (int k = 0; k < 8; ++k) { v[r][i][k] -= mu; q += v[r][i][k] * v[r][i][k]; }
            const float rstd = rsqrtf(wsum(q) * (1.f / 1024.f) + 1e-5f);
            const float* mv = modv + row_sel(row) * 6144;
#pragma unroll
            for (int i = 0; i < 2; ++i) {
                const int c = i * 512 + lane * 8;
                float o[8], hh[8];
#pragma unroll
                for (int k4 = 0; k4 < 2; ++k4) {
                    const float4 g = *(const float4*)(p.ln1g + l * 1024 + c + 4 * k4), bb = *(const float4*)(p.ln1b + l * 1024 + c + 4 * k4);
                    const float4 sh = *(const float4*)(mv + 3072 + c + 4 * k4), sc = *(const float4*)(mv + 4096 + c + 4 * k4);
                    o[4 * k4 + 0] = v[r][i][4 * k4 + 0] * rstd * g.x + bb.x; o[4 * k4 + 1] = v[r][i][4 * k4 + 1] * rstd * g.y + bb.y;
                    o[4 * k4 + 2] = v[r][i][4 * k4 + 2] * rstd * g.z + bb.z; o[4 * k4 + 3] = v[r][i][4 * k4 + 3] * rstd * g.w + bb.w;
                    hh[4 * k4 + 0] = o[4 * k4 + 0] * (1.f + sc.x) + sh.x; hh[4 * k4 + 1] = o[4 * k4 + 1] * (1.f + sc.y) + sh.y;
                    hh[4 * k4 + 2] = o[4 * k4 + 2] * (1.f + sc.z) + sh.z; hh[4 * k4 + 3] = o[4 * k4 + 3] * (1.f + sc.w) + sh.w;
                }
                *(uint4*)(x1 + (size_t)row * 1024 + c) = make_uint4(pk2bf(o[0], o[1]), pk2bf(o[2], o[3]), pk2bf(o[4], o[5]), pk2bf(o[6], o[7]));
                *(uint4*)(hm + (size_t)row * 1024 + c) = make_uint4(pk2bf(hh[0], hh[1]), pk2bf(hh[2], hh[3]), pk2bf(hh[4], hh[5]), pk2bf(hh[6], hh[7]));
            }
        }
    }
}

DEVINL void ph_router(const P& p, int l, char* smem) {
    const int TIDX_ = tid_(); const int BIDX_ = bid_(); char* const WS_ = wsl_(p.ws); (void)TIDX_; (void)BIDX_; (void)WS_;
    const int tid = TIDX_;
    const u16* hm = (const u16*)(WS_ + OFF_HM);
    const u16* wr = (const u16*)(WS_ + OFF_WR) + (size_t)l * 128 * 1024;
    int* toke = (int*)(WS_ + OFF_TOKE); float* tokw = (float*)(WS_ + OFF_TOKW);
    int* bh = (int*)(WS_ + OFF_BH);
    float* lgs = (float*)smem;
    int* hist = (int*)(smem + 32768);
    const int mt0 = (l == 0) ? 0 : 4;
    for (int u = BIDX_; u < 260 - mt0; u += gridDim.x) {
        const int mt = mt0 + u;
        const u16* A = hm + (size_t)mt * 128 * 1024;
        gemm128([&](int r) { return A + (size_t)r * 1024; }, wr, 1024, 1024, smem,
                [&](int m, int n, f32x4 a) {
                    if (n < 36) {
#pragma unroll
                        for (int j = 0; j < 4; ++j) lgs[(m + j) * 37 + n] = a[j];
                    }
                });
        if (tid < 32) hist[tid] = 0;
        __syncthreads();
        if (tid < 128) {
            const int row = mt * 128 + tid;
            const float* q = lgs + tid * 37;
            float gl[4]; int gs = 0; float gm = -3.0e38f;
#pragma unroll
            for (int i = 0; i < 4; ++i) { gl[i] = q[i] + p.rgb[l * 4 + i]; if (gl[i] > gm) { gm = gl[i]; gs = i; } }
            float se = 0.f;
#pragma unroll
            for (int i = 0; i < 4; ++i) se += expf(gl[i] - gm);
            const float gw = 1.f / se;
            float v1 = -3.0e38f, v2 = -3.0e38f; int i1 = 0, i2 = 0;
#pragma unroll
            for (int i = 0; i < 8; ++i) {
                const float ev = q[4 + gs * 8 + i] + p.reb[l * 32 + gs * 8 + i];
                if (ev > v1) { v2 = v1; i2 = i1; v1 = ev; i1 = i; }
                else if (ev > v2) { v2 = ev; i2 = i; }
            }
            const float e2 = expf(v2 - v1);
            const float w1 = gw / (1.f + e2), w2 = gw * e2 / (1.f + e2);
            const int ea = gs * 8 + i1, eb = gs * 8 + i2;
            toke[row * 2] = ea; toke[row * 2 + 1] = eb; tokw[row * 2] = w1; tokw[row * 2 + 1] = w2;
            atomicAdd(&hist[ea], 1); atomicAdd(&hist[eb], 1);
        }
        __syncthreads();
        if (tid < 32) bh[u * 32 + tid] = hist[tid];
    }
}

DEVINL void ph_route2(const P& p, int l, char* smem) {
    const int TIDX_ = tid_(); const int BIDX_ = bid_(); char* const WS_ = wsl_(p.ws); (void)TIDX_; (void)BIDX_; (void)WS_;
    const int tid = TIDX_;
    const int* toke = (const int*)(WS_ + OFF_TOKE);
    int* toks = (int*)(WS_ + OFF_TOKS);
    int* slottok = (int*)(WS_ + OFF_SLOTTOK);
    const int* bh = (const int*)(WS_ + OFF_BH);
    int* tiles = (int*)(WS_ + OFF_TILES);
    int* off = (int*)smem;
    int* hist = off + 64;
    int* cntl = hist + 32;
    int* basel = cntl + 32;
    int* ptot = basel + 32;
    int* pbel = ptot + 256;
    const int rstart = (l == 0) ? 0 : CTXROWS;
    const int nstripe = (T - rstart) >> 7;
    for (int st = BIDX_, pass = 0; pass == 0 || st < nstripe; st += gridDim.x, ++pass) {
        const int mine = st < nstripe ? st : nstripe;
        __syncthreads();
        {
            const int e = tid & 31, part = tid >> 5;
            const int s0 = part * 33;
            int tot = 0, bel = 0;
#pragma unroll
            for (int i = 0; i < 33; ++i) {
                const int s = s0 + i;
                const int v = s < nstripe ? bh[s * 32 + e] : 0;
                tot += v; bel += s < mine ? v : 0;
            }
            ptot[part * 32 + e] = tot; pbel[part * 32 + e] = bel;
        }
        if (tid < 32) hist[tid] = 0;
        __syncthreads();
        if (tid < 32) {
            int tot = 0, bel = 0;
#pragma unroll
            for (int q = 0; q < 8; ++q) { tot += ptot[q * 32 + tid]; bel += pbel[q * 32 + tid]; }
            cntl[tid] = tot; basel[tid] = bel;
        }
        __syncthreads();
        if (tid == 0) { int a = 0; for (int e = 0; e < 32; ++e) { off[e] = a; a += (cntl[e] + 127) & ~127; } off[32] = a; }
        __syncthreads();
        if (pass == 0) {
            if (BIDX_ == 0) {
                if (tid < 32) {
                    int nt = off[tid] >> 7;
#pragma clang loop vectorize(disable) unroll(disable)
                    for (int s = off[tid]; s < off[tid + 1]; s += 128) { tiles[64 + nt * 2] = tid; tiles[64 + nt * 2 + 1] = s; ++nt; }
                }
                if (tid == 0) tiles[40] = off[32] >> 7;
            }
            for (int e = BIDX_; e < 32; e += gridDim.x) {
                const int s = off[e] + cntl[e] + tid;
                if (tid < 128 && s < off[e + 1]) slottok[s] = (l == 0) ? 0 : CTXROWS;
            }
        }
        if (st < nstripe) {
            const int a = (rstart + st * 128) * 2 + tid;
            const int e = toke[a];
            const int lpos = atomicAdd(&hist[e], 1);
            const int s = off[e] + basel[e] + lpos;
            toks[a] = s; slottok[s] = a >> 1;
        }
    }
}

DEVINL void ph_gateup(const P& p, char* smem) {
    const int TIDX_ = tid_(); const int BIDX_ = bid_(); char* const WS_ = wsl_(p.ws); (void)TIDX_; (void)BIDX_; (void)WS_;
    const int tid = TIDX_, lane = tid & 63, wid = tid >> 6, wr = wid >> 1, wc = wid & 1, fr = lane & 15, fq = lane >> 4;
    const u16* hm = (const u16*)(WS_ + OFF_HM);
    const u16* wgu = (const u16*)(WS_ + OFF_WGU);
    const int* tiles = (const int*)(WS_ + OFF_TILES);
    const int* slottok = (const int*)(WS_ + OFF_SLOTTOK);
    u16* act = (u16*)(WS_ + OFF_ACT);
    const int ntile = tiles[40] * 8;
    XCD_WALK(ntile, BIDX_, (int)gridDim.x);
    for (int u = xw_lo; u < xw_hi; u += xw_st) {
        const int ti = u >> 3, nt = u & 7;
        const int e = tiles[64 + ti * 2], s0 = tiles[64 + ti * 2 + 1];
        f32x4 acc[4][4];
        gemm128_acc([&](int r) { return hm + (size_t)slottok[s0 + r] * 1024; }, wgu + ((size_t)e * 1024 + nt * 128) * 1024, 1024, 1024, smem, acc);
        {
            u16* t = (u16*)smem;
            __syncthreads();
#pragma unroll
            for (int m = 0; m < 4; ++m)
#pragma unroll
                for (int n = 0; n < 4; n += 2) {
                    const int jc = (wc * 64 + n * 16) / 2 + fr;
                    const int r0 = wr * 64 + m * 16 + fq * 4;
                    float av[4];
#pragma unroll
                    for (int j = 0; j < 4; ++j) { const float gte = acc[m][n][j], up = acc[m][n + 1][j]; av[j] = siluf_(gte) * up; }
                    const unsigned p01 = pk2bf(av[0], av[1]), p23 = pk2bf(av[2], av[3]);
                    t[(r0 + 0) * 72 + jc] = (u16)(p01 & 0xFFFFu); t[(r0 + 1) * 72 + jc] = (u16)(p01 >> 16);
                    t[(r0 + 2) * 72 + jc] = (u16)(p23 & 0xFFFFu); t[(r0 + 3) * 72 + jc] = (u16)(p23 >> 16);
                }
            __syncthreads();
#pragma unroll
            for (int i = 0; i < 4; ++i) {
                const int ci = tid + 256 * i, row = ci >> 3, c8 = (ci & 7) * 8;
                st_nt16(act + (size_t)(s0 + row) * 512 + nt * 64 + c8, *(const uint4*)(t + row * 72 + c8));
            }
        }
    }
}

DEVINL void ph_down(const P& p, char* smem) {
    const int TIDX_ = tid_(); const int BIDX_ = bid_(); char* const WS_ = wsl_(p.ws); (void)TIDX_; (void)BIDX_; (void)WS_;
    const u16* act = (const u16*)(WS_ + OFF_ACT);
    const u16* wdn = (const u16*)(WS_ + OFF_WDN);
    const int* tiles = (const int*)(WS_ + OFF_TILES);
    u16* so = (u16*)(WS_ + OFF_SLOTOUT);
    const int ntile = tiles[40] * 8;
    XCD_WALK(ntile, BIDX_, (int)gridDim.x);
    for (int u = xw_lo; u < xw_hi; u += xw_st) {
        const int ti = u >> 3, nt = u & 7;
        const int e = tiles[64 + ti * 2], s0 = tiles[64 + ti * 2 + 1];
        const u16* A = act + (size_t)s0 * 512;
        f32x4 acc[4][4];
        gemm128_acc([&](int r) { return A + (size_t)r * 512; }, wdn + ((size_t)e * 1024 + nt * 128) * 512, 512, 512, smem, acc);
        stage_tile_bf16(acc, smem, [&](int row, int c8, uint4 v) { st_nt16(so + (size_t)(s0 + row) * 1024 + nt * 128 + c8, v); });
    }
}

DEVINL void ph_ln2(const P& p, int l) {
    const int TIDX_ = tid_(); const int BIDX_ = bid_(); char* const WS_ = wsl_(p.ws); (void)TIDX_; (void)BIDX_; (void)WS_;
    const int lane = TIDX_ & 63, wid = TIDX_ >> 6;
    const float* modv = (const float*)(WS_ + OFF_MOD) + (size_t)l * 3 * 6144;
    const float* modn = (const float*)(WS_ + OFF_MOD) + (size_t)(l + 1) * 3 * 6144;
    const u16* x1 = (const u16*)(WS_ + OFF_X1);
    const u16* so = (const u16*)(WS_ + OFF_SLOTOUT);
    const int* toks = (const int*)(WS_ + OFF_TOKS);
    const float* tokw = (const float*)(WS_ + OFF_TOKW);
    float* x2c = (float*)(WS_ + OFF_X2CTX);
    u16* hm = (u16*)(WS_ + OFF_HM);
    const int rstart = (l == 0) ? 0 : CTXROWS;
    const int rstride = (int)gridDim.x * 4;
#pragma unroll 1
    for (int row0 = rstart + BIDX_ * 4 + wid; row0 < T; row0 += 2 * rstride) {
        int rowv[2]; rowv[0] = row0; rowv[1] = row0 + rstride;
        const bool has1 = rowv[1] < T;
        if (!has1) rowv[1] = row0;
        int sa[2], sb[2]; float wa[2], wb[2];
#pragma unroll
        for (int r = 0; r < 2; ++r) { sa[r] = toks[rowv[r] * 2]; sb[r] = toks[rowv[r] * 2 + 1]; wa[r] = tokw[rowv[r] * 2]; wb[r] = tokw[rowv[r] * 2 + 1]; }
        float v[2][2][8];
        float s[2] = {0.f, 0.f};
#pragma unroll
        for (int r = 0; r < 2; ++r) {
            const float* mv = modv + row_sel(rowv[r]) * 6144;
#pragma unroll
            for (int i = 0; i < 2; ++i) {
                const int c = i * 512 + lane * 8;
                const uint4 xb = *(const uint4*)(x1 + (size_t)rowv[r] * 1024 + c);
                const uint4 ua = *(const uint4*)(so + (size_t)sa[r] * 1024 + c), ub = *(const uint4*)(so + (size_t)sb[r] * 1024 + c);
                const unsigned xw[4] = {xb.x, xb.y, xb.z, xb.w}, aw[4] = {ua.x, ua.y, ua.z, ua.w}, bw[4] = {ub.x, ub.y, ub.z, ub.w};
                float g2[8];
                { const float4 t0 = *(const float4*)(mv + 5120 + c), t1 = *(const float4*)(mv + 5120 + c + 4);
                  g2[0] = t0.x; g2[1] = t0.y; g2[2] = t0.z; g2[3] = t0.w; g2[4] = t1.x; g2[5] = t1.y; g2[6] = t1.z; g2[7] = t1.w; }
#pragma unroll
                for (int k = 0; k < 4; ++k) {
                    const float x0 = __uint_as_float(xw[k] << 16), x1v = __uint_as_float(xw[k] & 0xFFFF0000u);
                    const float f0 = wa[r] * __uint_as_float(aw[k] << 16) + wb[r] * __uint_as_float(bw[k] << 16);
                    const float f1 = wa[r] * __uint_as_float(aw[k] & 0xFFFF0000u) + wb[r] * __uint_as_float(bw[k] & 0xFFFF0000u);
                    v[r][i][2 * k] = ALPHA * x0 + g2[2 * k] * f0; v[r][i][2 * k + 1] = ALPHA * x1v + g2[2 * k + 1] * f1;
                    s[r] += v[r][i][2 * k] + v[r][i][2 * k + 1];
                }
            }
        }
#pragma unroll
        for (int r = 0; r < 2; ++r) {
            if (r == 1 && !has1) break;
            const int row = rowv[r];
            const float mu = wsum(s[r]) * (1.f / 1024.f);
            float q = 0.f;
#pragma unroll
            for (int i = 0; i < 2; ++i)
#pragma unroll
                for (int k = 0; k < 8; ++k) { v[r][i][k] -= mu; q += v[r][i][k] * v[r][i][k]; }
            const float rstd = rsqrtf(wsum(q) * (1.f / 1024.f) + 1e-5f);
            float* dst = row < CTXROWS ? x2c + (size_t)row * 1024 : p.out + (size_t)(row - CTXROWS) * 1024;
            const float* mn = modn + row_sel(row) * 6144;
#pragma unroll
            for (int i = 0; i < 2; ++i) {
                const int c = i * 512 + lane * 8;
                float o[8];
#pragma unroll
                for (int k4 = 0; k4 < 2; ++k4) {
                    const float4 g = *(const float4*)(p.ln2g + l * 1024 + c + 4 * k4), bb = *(const float4*)(p.ln2b + l * 1024 + c + 4 * k4);
                    o[4 * k4 + 0] = v[r][i][4 * k4 + 0] * rstd * g.x + bb.x; o[4 * k4 + 1] = v[r][i][4 * k4 + 1] * rstd * g.y + bb.y;
                    o[4 * k4 + 2] = v[r][i][4 * k4 + 2] * rstd * g.z + bb.z; o[4 * k4 + 3] = v[r][i][4 * k4 + 3] * rstd * g.w + bb.w;
                    *(float4*)(dst + c + 4 * k4) = make_float4(o[4 * k4 + 0], o[4 * k4 + 1], o[4 * k4 + 2], o[4 * k4 + 3]);
                }
                if (l == 0) {
                    float hh[8];
#pragma unroll
                    for (int k4 = 0; k4 < 2; ++k4) {
                        const float4 sh = *(const float4*)(mn + c + 4 * k4), sc = *(const float4*)(mn + 1024 + c + 4 * k4);
                        hh[4 * k4 + 0] = o[4 * k4 + 0] * (1.f + sc.x) + sh.x; hh[4 * k4 + 1] = o[4 * k4 + 1] * (1.f + sc.y) + sh.y;
                        hh[4 * k4 + 2] = o[4 * k4 + 2] * (1.f + sc.z) + sh.z; hh[4 * k4 + 3] = o[4 * k4 + 3] * (1.f + sc.w) + sh.w;
                    }
                    *(uint4*)(hm + (size_t)row * 1024 + c) = make_uint4(pk2bf(hh[0], hh[1]), pk2bf(hh[2], hh[3]), pk2bf(hh[4], hh[5]), pk2bf(hh[6], hh[7]));
                }
            }
        }
    }
}

DEVINL void gbar(XcdBarrier b) {
    unsigned x = b.x; GAS unsigned* q = (GAS unsigned*)b.bar;
    asm volatile("" : "+s"(x), "+s"(q));
    b.x = x; b.bar = (unsigned*)q;
    xcd_barrier(b);
}
#ifndef PROBE
#define PROBE 0
#endif
__global__ void __launch_bounds__(256, 2) k_mega(P p) {
    __shared__ __attribute__((aligned(16))) char smem[SMEM_BYTES];
    if (threadIdx.x == 0) *(uint4*)(smem + SMEM_BYTES - 16) = make_uint4(0u, 0u, 0u, 0u);
    __syncthreads();
    XcdBarrier bar = xcd_barrier_post((unsigned*)p.ws, (volatile LAS unsigned*)(smem + SMEM_BYTES - 16));
    const int bid = blockIdx.x, nb = gridDim.x;
#if TPROBE
    unsigned long long tp_acc = 0, tp_last = wall_clock64();
#if TPROBE >= 30
    if (bid == 0 && threadIdx.x == 0) { g_tp_acc = 0; g_tp_last = wall_clock64(); }
#endif
#define TP(g) do { const unsigned long long _n = wall_clock64(); if ((g) == TPROBE) tp_acc += _n - tp_last; tp_last = _n; } while (0)
#else
#define TP(g) do { } while (0)
#endif
    if (threadIdx.x == 0) {
        const unsigned key = ((unsigned)__builtin_amdgcn_s_getreg((3 << 11) | 20) << 8) | ((unsigned)__builtin_amdgcn_s_getreg((7 << 11) | (8 << 6) | 4) & 0xFFu);
        ((unsigned*)(p.ws + CTL_CUKEY))[blockIdx.x] = key | 0x80000000u;
    }
    ph_prolog(p, smem);
    ph_convw(p, 0, smem);
    gbar(bar);
    TP(1);
    ph_xm0(p);
    gbar(bar);
    TP(17);
    constexpr int NSCAN = 16;
    bool quiet; int wrank, nwork, mate_of = -1;
    {
        const unsigned* keys = (const unsigned*)(p.ws + CTL_CUKEY);
        int* cnt = (int*)smem;
        if (threadIdx.x < 2) cnt[threadIdx.x] = 0;
        __syncthreads();
        for (int i = NSCAN + threadIdx.x; i < nb; i += 256) {
            const unsigned k = keys[i];
            bool qq = false;
            for (int j = 0; j < NSCAN && j < nb; ++j) qq = qq || (keys[j] == k);
            if (qq) { atomicAdd(&cnt[1], 1); if (i < bid) atomicAdd(&cnt[0], 1); }
        }
        __syncthreads();
        const int below = cnt[0], total = cnt[1];
        bool me = false;
        if (bid >= NSCAN) { const unsigned k = keys[bid]; for (int j = NSCAN - 1; j >= 0; --j) if (j < nb && keys[j] == k) { me = true; mate_of = j; } }
        __syncthreads();
        if (total > 2 * NSCAN) { quiet = false; wrank = bid - NSCAN; nwork = nb - NSCAN; mate_of = -1; }
        else { quiet = me; wrank = bid - NSCAN - below; nwork = nb - NSCAN - total; }
    }
#pragma unroll 1
    for (int l = 0; l < NLAYER; ++l) {
        ph_inproj(p, smem);
        gbar(bar);
    TP(2);
        ph_rwprep(p, l, 0, smem, bid, nb);
        ph_prepM(p, l, smem, nb - 1 - bid, nb);
        gbar(bar);
    TP(3);
        const int na1 = (nwork > 128) ? 9 * (nwork - 64) : (1 << 30);
        if (bid < NSCAN) { ph_rwscan(p, l, 0, bid, NSCAN, smem); TP(20); }
        else if (!quiet) { if (nwork > 128) { if (wrank < 64) ph_mlB(p, wrank, 64, smem); else ph_na(p, l, smem, wrank - 64, nwork - 64, 0, na1); } else { ph_mlB(p, wrank, nwork, smem); ph_na(p, l, smem, wrank, nwork, 0, na1); } }
        gbar(bar);
    TP(4);
        ph_rwprep(p, l, 1, smem, bid, nb);
        gbar(bar);
    TP(5);
        if (bid < NSCAN) { ph_rwscan(p, l, 1, bid, NSCAN, smem); TP(21); }
        else if (!quiet) {
            ph_na(p, l, smem, wrank, nwork, na1, 1 << 30);
            if (threadIdx.x == 0) (void)__hip_atomic_fetch_add((unsigned*)(p.ws + CTL_PROG) + l * 16, 1u, __ATOMIC_RELAXED, __HIP_MEMORY_SCOPE_AGENT);
            ph_mlC(p, l, smem, wrank, nwork);
            ph_convexp(p, l, smem, nwork);
        }
        gbar(bar);
    TP(6);
        ph_rwout(p, l);
        gbar(bar);
    TP(7);
        ph_outproj(p, l, smem);
        gbar(bar);
    TP(8);
        ph_ln1(p, l);
        gbar(bar);
    TP(9);
        ph_router(p, l, smem);
        gbar(bar);
    TP(14);
        ph_route2(p, l, smem);
        gbar(bar);
    TP(16);
        ph_gateup(p, smem);
        gbar(bar);
    TP(10);
        ph_down(p, smem);
        gbar(bar);
    TP(11);
        ph_ln2(p, l);
        if (l + 1 < NLAYER) ph_convw(p, l + 1, smem, false);
        gbar(bar);
    TP(12);
    }
#if TPROBE
#if TPROBE >= 30
    if (bid == 0 && threadIdx.x == 0) tp_acc += g_tp_acc;
#endif
    if (bid == 0 && threadIdx.x == 0) { const unsigned long long t_end = wall_clock64() + tp_acc; while (wall_clock64() < t_end) __builtin_amdgcn_s_sleep(8); }
    __syncthreads();
    gbar(bar);
#endif
}


extern "C" void kernel_launch(void* const* d_in, const int* in_sizes, int n_in, void* d_out, int out_size, void* d_ws, size_t ws_size,
                              hipStream_t stream) {
    if (n_in != 37 || ws_size < WS_NEED) { fprintf(stderr, "kernel_launch: n_in %d ws %zu need %zu\n", n_in, ws_size, (size_t)WS_NEED); return; }
    static int grid = 0;
    if (!grid) {
        int dev = 0, cus = 0, per_cu = 0;
        (void)hipGetDevice(&dev);
        (void)hipDeviceGetAttribute(&cus, hipDeviceAttributeMultiprocessorCount, dev);
        (void)hipOccupancyMaxActiveBlocksPerMultiprocessor(&per_cu, (const void*)k_mega, 256, 0);
        if (per_cu < 1) per_cu = 1;
        grid = cus * (per_cu < 2 ? per_cu : 2);
    }
    P p{};
    const float** pp = (const float**)&p;
    for (int i = 0; i < 37; ++i) pp[i] = (const float*)d_in[i];
    p.out = (float*)d_out; p.ws = (char*)d_ws;
    (void)hipMemsetAsync(d_ws, 0, CTL_BYTES, stream);
    k_mega<<<dim3(grid), dim3(256), 0, stream>>>(p);
}
```
